# Optimizing an MI355X kernel written in HIP

```python
import jax, jax.numpy as jnp
from jax import lax
import numpy as np

D_MODEL = 1024
BATCH = 2
SEQ = 8192
DEPTH = 1

MEM_LEN = 256
FOX_HEADS = 8
FOX_HEAD_DIM = 64
DSA_HEADS = 8
DSA_HEAD_DIM = 64
IDX_HEADS = 8
IDX_DIM = 64
MEM_HEADS = 4
MEM_HEAD_DIM = 128
BRANCH_WIDTH = 512
N_BRANCHES = 3
D_FF = 2816
ROPE_THETA = 10000.0
Q_BLOCK = 128
TOPK_MAX = 256
EPS = 1e-6

SPLIT_SIZES = (
    BRANCH_WIDTH, BRANCH_WIDTH, BRANCH_WIDTH,
    FOX_HEADS,
    BRANCH_WIDTH, DSA_HEAD_DIM, DSA_HEAD_DIM,
    IDX_HEADS * IDX_DIM, IDX_DIM, IDX_HEADS,
    BRANCH_WIDTH,
    N_BRANCHES * D_MODEL,
)
SPLIT_POINTS = tuple(int(v) for v in np.cumsum(SPLIT_SIZES)[:-1])
D_IN = int(sum(SPLIT_SIZES))

kernel_name = "hybrid_fox_dsa_mem_macaron"


def rmsnorm(x, g):
    xf = x.astype(jnp.float32)
    y = xf * lax.rsqrt(jnp.mean(xf * xf, axis=-1, keepdims=True) + EPS)
    return (y * g.astype(jnp.float32)).astype(x.dtype)


def swiglu(x, w_gate, w_up, w_down):
    return (jax.nn.silu(x @ w_gate) * (x @ w_up)) @ w_down


def rope_tables(positions, dim, dtype):
    inv_freq = ROPE_THETA ** (-jnp.arange(0, dim, 2, dtype=jnp.float32) / dim)
    ang = positions.astype(jnp.float32)[..., None] * inv_freq
    return jnp.cos(ang)[:, :, None, :].astype(dtype), jnp.sin(ang)[:, :, None, :].astype(dtype)


def rope(x, cos, sin):
    x1, x2 = jnp.split(x, 2, axis=-1)
    return jnp.concatenate([x1 * cos - x2 * sin, x2 * cos + x1 * sin], axis=-1)


def to_blocks(a):
    B, S = a.shape[:2]
    return a.reshape((B, S // Q_BLOCK, Q_BLOCK) + a.shape[2:]).swapaxes(0, 1)


def from_blocks(a):
    nb, B, Q = a.shape[:3]
    return a.swapaxes(0, 1).reshape((B, nb * Q) + a.shape[3:])


def fox_attention(q, k, v, logf):
    B, S, H, hd = q.shape
    c = jnp.cumsum(logf, axis=1)
    c_keys = c.transpose(0, 2, 1)
    key_pos = jnp.arange(S)
    scale = hd ** -0.5

    def block(args):
        qi, ci, bi = args
        qpos = bi * Q_BLOCK + jnp.arange(Q_BLOCK)
        s = jnp.einsum('bqhd,bkhd->bhqk', qi, k).astype(jnp.float32) * scale
        s = s + ci.transpose(0, 2, 1)[..., None] - c_keys[:, :, None, :]
        s = jnp.where(key_pos[None, :] <= qpos[:, None], s, -jnp.inf)
        p = jax.nn.softmax(s, axis=-1)
        return jnp.einsum('bhqk,bkhd->bqhd', p.astype(v.dtype), v)

    out = lax.map(block, (to_blocks(q), to_blocks(c), jnp.arange(S // Q_BLOCK)))
    return from_blocks(out).reshape(B, S, H * hd)


def dsa_attention(q, k, v, iq, ik, iw, k_sel):
    B, S, H, hd = q.shape
    key_pos = jnp.arange(S)
    scale = hd ** -0.5
    gather = jax.vmap(lambda a, i: a[i])

    def block(args):
        qi, iqi, iwi, bi = args
        qpos = bi * Q_BLOCK + jnp.arange(Q_BLOCK)
        sc = jnp.einsum('bqhd,bkd->bqhk', iqi, ik).astype(jnp.float32)
        score = jnp.einsum('bqh,bqhk->bqk', iwi.astype(jnp.float32), jax.nn.relu(sc))
        score = jnp.where((key_pos[None, :] <= qpos[:, None])[None], score, -jnp.inf)
        _, idx = lax.top_k(score, k_sel)
        valid = idx <= qpos[None, :, None]
        ks = gather(k, idx)
        vs = gather(v, idx)
        s = jnp.einsum('bqhd,bqkd->bqhk', qi, ks).astype(jnp.float32) * scale
        s = jnp.where(valid[:, :, None, :], s, -jnp.inf)
        p = jax.nn.softmax(s, axis=-1)
        return jnp.einsum('bqhk,bqkd->bqhd', p.astype(vs.dtype), vs)

    out = lax.map(block, (to_blocks(q), to_blocks(iq), to_blocks(iw), jnp.arange(S // Q_BLOCK)))
    return from_blocks(out).reshape(B, S, H * hd)


def memory_attention(q, km, vm):
    B, S, H, hd = q.shape
    s = jnp.einsum('bshd,bmhd->bhsm', q, km).astype(jnp.float32) * hd ** -0.5
    p = jax.nn.softmax(s, axis=-1)
    return jnp.einsum('bhsm,bmhd->bshd', p.astype(vm.dtype), vm).reshape(B, S, H * hd)


def setup_inputs(seed: int = 0) -> dict:
    key = jax.random.key(seed)
    ks = jax.random.split(key, 24)
    f32 = jnp.float32

    def w(k, shape, fan_in):
        return jax.random.normal(k, shape, f32) * fan_in ** -0.5

    def gain(k, shape):
        return 1.0 + 0.02 * jax.random.normal(k, shape, f32)

    L = DEPTH
    return {
        "x": jax.random.normal(ks[0], (BATCH, SEQ, D_MODEL), f32),
        "mem": jax.random.normal(ks[1], (BATCH, MEM_LEN, D_MODEL), f32),
        "positions": jnp.broadcast_to(jnp.arange(SEQ, dtype=jnp.int32), (BATCH, SEQ)),
        "ffn1_norm": gain(ks[2], (L, D_MODEL)),
        "ffn1_w_gate": w(ks[3], (L, D_MODEL, D_FF), D_MODEL),
        "ffn1_w_up": w(ks[4], (L, D_MODEL, D_FF), D_MODEL),
        "ffn1_w_down": w(ks[5], (L, D_FF, D_MODEL), D_FF),
        "mix_norm": gain(ks[6], (L, D_MODEL)),
        "mem_norm": gain(ks[7], (L, D_MODEL)),
        "w_in": w(ks[8], (L, D_MODEL, D_IN), D_MODEL),
        "b_forget": 3.0 + 0.5 * jax.random.normal(ks[9], (L, FOX_HEADS), f32),
        "fox_q_norm": gain(ks[10], (L, FOX_HEAD_DIM)),
        "fox_k_norm": gain(ks[11], (L, FOX_HEAD_DIM)),
        "dsa_q_norm": gain(ks[12], (L, DSA_HEAD_DIM)),
        "dsa_k_norm": gain(ks[13], (L, DSA_HEAD_DIM)),
        "mem_q_norm": gain(ks[14], (L, MEM_HEAD_DIM)),
        "mem_k_norm": gain(ks[15], (L, MEM_HEAD_DIM)),
        "w_mem_kv": w(ks[16], (L, D_MODEL, 2 * BRANCH_WIDTH), D_MODEL),
        "w_branch": w(ks[17], (L, N_BRANCHES, BRANCH_WIDTH, D_MODEL), BRANCH_WIDTH),
        "w_out": w(ks[18], (L, D_MODEL, D_MODEL), D_MODEL),
        "ffn2_norm": gain(ks[19], (L, D_MODEL)),
        "ffn2_w_gate": w(ks[20], (L, D_MODEL, D_FF), D_MODEL),
        "ffn2_w_up": w(ks[21], (L, D_MODEL, D_FF), D_MODEL),
        "ffn2_w_down": w(ks[22], (L, D_FF, D_MODEL), D_FF),
    }


def reference(x, mem, positions, ffn1_norm, ffn1_w_gate, ffn1_w_up, ffn1_w_down, mix_norm,
              mem_norm, w_in, b_forget, fox_q_norm, fox_k_norm, dsa_q_norm, dsa_k_norm,
              mem_q_norm, mem_k_norm, w_mem_kv, w_branch, w_out, ffn2_norm, ffn2_w_gate,
              ffn2_w_up, ffn2_w_down):
    B, S, D = x.shape
    M = mem.shape[1]
    k_sel = min(TOPK_MAX, S // 4)
    cos, sin = rope_tables(positions, DSA_HEAD_DIM, x.dtype)
    cos_i, sin_i = rope_tables(positions, IDX_DIM, x.dtype)
    h = x
    for l in range(DEPTH):
        h = h + 0.5 * swiglu(rmsnorm(h, ffn1_norm[l]), ffn1_w_gate[l], ffn1_w_up[l], ffn1_w_down[l])

        u = rmsnorm(h, mix_norm[l])
        (fq, fk, fv, ff, dq, dk, dv, iq, ik, iw, mq, g) = jnp.split(u @ w_in[l], SPLIT_POINTS, axis=-1)

        fq = rmsnorm(fq.reshape(B, S, FOX_HEADS, FOX_HEAD_DIM), fox_q_norm[l])
        fk = rmsnorm(fk.reshape(B, S, FOX_HEADS, FOX_HEAD_DIM), fox_k_norm[l])
        fv = fv.reshape(B, S, FOX_HEADS, FOX_HEAD_DIM)
        logf = jax.nn.log_sigmoid(ff.astype(jnp.float32) + b_forget[l].astype(jnp.float32))
        o_a = fox_attention(fq, fk, fv, logf)

        dq = rope(rmsnorm(dq.reshape(B, S, DSA_HEADS, DSA_HEAD_DIM), dsa_q_norm[l]), cos, sin)
        dk = rope(rmsnorm(dk[:, :, None, :], dsa_k_norm[l]), cos, sin)[:, :, 0, :]
        iq = rope(iq.reshape(B, S, IDX_HEADS, IDX_DIM), cos_i, sin_i)
        ik = rope(ik[:, :, None, :], cos_i, sin_i)[:, :, 0, :]
        iw = iw * (IDX_HEADS ** -0.5 * IDX_DIM ** -0.5)
        o_b = dsa_attention(dq, dk, dv, iq, ik, iw, k_sel)

        km, vm = jnp.split(rmsnorm(mem, mem_norm[l]) @ w_mem_kv[l], 2, axis=-1)
        km = rmsnorm(km.reshape(B, M, MEM_HEADS, MEM_HEAD_DIM), mem_k_norm[l])
        vm = vm.reshape(B, M, MEM_HEADS, MEM_HEAD_DIM)
        mq = rmsnorm(mq.reshape(B, S, MEM_HEADS, MEM_HEAD_DIM), mem_q_norm[l])
        o_c = memory_attention(mq, km, vm)

        branches = jnp.stack([o_a, o_b, o_c], axis=2)
        proj = jnp.einsum('bsnw,nwd->bsnd', branches, w_branch[l])
        gates = jax.nn.sigmoid(g.reshape(B, S, N_BRANCHES, D))
        h = h + jnp.sum(gates * proj, axis=2) @ w_out[l]

        h = h + 0.5 * swiglu(rmsnorm(h, ffn2_norm[l]), ffn2_w_gate[l], ffn2_w_up[l], ffn2_w_down[l])
    return h
```

```cpp
#include <hip/hip_runtime.h>
#include <cstdio>
#include <cstdint>
namespace pg8 {
#define PG8_LAS __attribute__((address_space(3)))
typedef unsigned short bf16_t;
typedef short bf16x8 __attribute__((ext_vector_type(8)));
typedef float f32x4 __attribute__((ext_vector_type(4)));
typedef unsigned u32x4 __attribute__((ext_vector_type(4)));
constexpr int BM = 256, BK = 64, HALF = 128, HTB = HALF * BK * 2  , STAGE_BYTES = 8 * HTB, NXCD = 8, WGM = 8;

__host__ __device__ __forceinline__ int lds_byte(int r, int c) { const int st = (r >> 4) * 2 + (c >> 5), rr = r & 15, cc = c & 31, ob = rr * 64 + cc * 2; return st * 1024 + (ob ^ (((ob >> 9) & 1) << 5)); }
__host__ __device__ __forceinline__ void stage_rc(int b, int& R, int& C) { const int st = b / 1024, sb = b % 1024, swz = sb ^ (((sb >> 9) & 1) << 5); R = (st >> 1) * 16 + swz / 64; C = (st & 1) * 32 + (swz % 64) / 2; }
__host__ __device__ __forceinline__ int perm32(int rho) { const int n = rho >> 4, i = rho & 15; return 8 * (i >> 2) + 4 * n + (i & 3); }

struct Unit { int pm, pn; };
struct Gemm { const bf16_t* A; const bf16_t* Bt; int M, N, K; };

struct StaticOrder {
    int nM, nN, nwg, G, c;
    __host__ __device__ void init(int M, int N, int G_, int c_) { nM = M / BM; nN = N / BM; nwg = nM * nN; G = G_; c = c_; }
    __host__ __device__ bool next(int i, Unit& u) const {
        const long L = (long)i * G + c; if (L >= nwg) return false;
        int wgid = (int)L; { const int q = nwg / NXCD, r = nwg % NXCD, xcd = wgid % NXCD, off = wgid / NXCD; wgid = (xcd < r ? xcd * (q + 1) : r * (q + 1) + (xcd - r) * q) + off; }
        const int nig = WGM * nN, gid = wgid / nig, fm = gid * WGM, gsz = (nM - fm) < WGM ? (nM - fm) : WGM;
        u.pm = fm + ((wgid % nig) % gsz); u.pn = (wgid % nig) / gsz; return true;
    }
    __device__ __forceinline__ void a_ready(const Unit&) const {}
    __device__ __forceinline__ void done(const Unit&) const {}
};

typedef float f32x2cv __attribute__((ext_vector_type(2))); typedef __bf16 bf16x2cv __attribute__((ext_vector_type(2)));
__device__ __forceinline__ unsigned cvt_pk_bf16(float lo, float hi) { const f32x2cv v = {lo, hi}; const bf16x2cv b = __builtin_convertvector(v, bf16x2cv); return __builtin_bit_cast(unsigned, b); }
typedef float f32x2 __attribute__((ext_vector_type(2)));
template <class Epi, class Sched, bool ALIGN_EPI = false, bool SP2 = false>
__device__ __forceinline__ void gemm_phase(PG8_LAS unsigned char* lds, const Gemm g, const Sched& S, const Epi& E) {
    int tid_ = threadIdx.x; asm volatile("" : "+v"(tid_));
    const int tid = tid_, wid = __builtin_amdgcn_readfirstlane(tid >> 6), lane = tid & 63, wr = wid >> 2, wc = wid & 3, fr = lane & 15, fq = lane >> 4;
    const int K = g.K, nt = K / BK;
    unsigned voffA[2], voffB[2];
#pragma unroll
    for (int i = 0; i < 2; ++i) { int R, C; stage_rc(tid * 16 + i * 8192, R, C); const int Rb = Epi::PERM ? ((R & ~31) + perm32(R & 31)) : R;
        voffA[i] = (unsigned)(R * K + C) * 2u; voffB[i] = (unsigned)(Rb * K + C) * 2u; }
    const size_t kstep = (size_t)(BK * 2);
    const size_t hstep = (size_t)HALF * K * 2;
    const size_t tstep = 2 * hstep;
    const unsigned ldsw = (unsigned)wid * 1024u;
    const int aoff = lds_byte(wr * 64 + fr, fq * 8), boff = lds_byte(wc * 32 + fr, fq * 8);
#define PG8_SA(b, h) (((b) * 2 + (h)) * HTB)
#define PG8_SB(b, h) ((4 + (b) * 2 + (h)) * HTB)
#define PG8_STAGE(bufoff, gbase, voff) do { _Pragma("unroll") for (int _i = 0; _i < 2; ++_i) \
        __builtin_amdgcn_global_load_lds((const unsigned*)((const char*)(gbase) + (voff)[_i]), (PG8_LAS unsigned*)(lds + (bufoff) + ldsw + _i * 8192), 16, 0, 0); } while (0)
#define PG8_LDA(dst, b, h) do { _Pragma("unroll") for (int m = 0; m < 4; ++m) _Pragma("unroll") for (int k = 0; k < 2; ++k) dst[m][k] = *(const PG8_LAS bf16x8*)(lds + PG8_SA(b, h) + aoff + m * 2048 + k * 1024); } while (0)
#define PG8_LDB(dst, b, h) do { _Pragma("unroll") for (int n = 0; n < 2; ++n) _Pragma("unroll") for (int k = 0; k < 2; ++k) dst[n][k] = *(const PG8_LAS bf16x8*)(lds + PG8_SB(b, h) + boff + n * 2048 + k * 1024); } while (0)
#define PG8_MMA(ai, bj, At, Bt) do { __builtin_amdgcn_s_setprio(1); _Pragma("unroll") for (int m = 0; m < 4; ++m) _Pragma("unroll") for (int n = 0; n < 2; ++n) _Pragma("unroll") for (int k = 0; k < 2; ++k) \
        acc[ai][bj][m][n] = __builtin_amdgcn_mfma_f32_16x16x32_bf16(Bt[n][k], At[m][k], acc[ai][bj][m][n], 0, 0, 0); __builtin_amdgcn_s_setprio(0); } while (0)
#define PG8_WAIT_V(n) asm volatile("s_waitcnt vmcnt(" #n ")" ::: "memory")
#define PG8_WAIT_L(n) asm volatile("s_waitcnt lgkmcnt(" #n ")" ::: "memory")
#define PG8_BAR __builtin_amdgcn_s_barrier()
#define PG8_SCHED __builtin_amdgcn_sched_barrier(0)
    Unit cur, nxt; int ui = 0;
    if (!S.next(0, cur)) return;
    f32x4 acc[2][2][4][2];
#pragma unroll
    for (int a = 0; a < 2; ++a)
#pragma unroll
        for (int b = 0; b < 2; ++b)
#pragma unroll
            for (int m = 0; m < 4; ++m)
#pragma unroll
                for (int n = 0; n < 2; ++n) acc[a][b][m][n] = (f32x4){0.f, 0.f, 0.f, 0.f};
    bf16x8 At[4][2], B0[2][2], B1[2][2];
    const char* cA = (const char*)g.A + (size_t)cur.pm * tstep; const char* cB = (const char*)g.Bt + (size_t)cur.pn * tstep;
    S.a_ready(cur);
    if constexpr (SP2) {
        PG8_STAGE(PG8_SB(0, 0), cB, voffB); PG8_STAGE(PG8_SB(0, 1), cB + hstep, voffB); PG8_STAGE(PG8_SA(0, 0), cA, voffA); PG8_STAGE(PG8_SA(0, 1), cA + hstep, voffA);
        if (wr == 1) PG8_BAR;
        PG8_WAIT_V(2); PG8_BAR;
        PG8_STAGE(PG8_SB(1, 0), cB + kstep, voffB); PG8_STAGE(PG8_SA(1, 0), cA + kstep, voffA); PG8_STAGE(PG8_SB(1, 1), cB + hstep + kstep, voffB);
        PG8_WAIT_V(6); PG8_BAR;
    } else {
        PG8_STAGE(PG8_SB(0, 0), cB, voffB); PG8_STAGE(PG8_SA(0, 0), cA, voffA); PG8_STAGE(PG8_SB(0, 1), cB + hstep, voffB); PG8_STAGE(PG8_SA(0, 1), cA + hstep, voffA);
        if (wr == 1) PG8_BAR;
        PG8_WAIT_V(4); PG8_BAR;
        PG8_STAGE(PG8_SB(1, 0), cB + kstep, voffB); PG8_STAGE(PG8_SA(1, 0), cA + kstep, voffA); PG8_STAGE(PG8_SB(1, 1), cB + hstep + kstep, voffB);
        PG8_WAIT_V(6); PG8_BAR;
    }
    for (;;) {
        const bool has_next = S.next(ui + 1, nxt);
        const char* nA = has_next ? (const char*)g.A + (size_t)nxt.pm * tstep : cA; const char* nB = has_next ? (const char*)g.Bt + (size_t)nxt.pn * tstep : cB;
        for (int t = 0; t < nt; t += 2) {
            const bool last = (t == nt - 2);
            const char* a1 = cA + (size_t)(t + 1) * kstep;
            const char* a2 = last ? nA : cA + (size_t)(t + 2) * kstep; const char* b2 = last ? nB : cB + (size_t)(t + 2) * kstep;
            const char* a3 = a2 + kstep; const char* b3 = b2 + kstep;
            if (last && has_next) S.a_ready(nxt);
            if constexpr (SP2) {
            PG8_LDB(B0, 0, 0); PG8_LDB(B1, 0, 1); PG8_SCHED; PG8_LDA(At, 0, 0); PG8_STAGE(PG8_SA(1, 1), a1 + hstep, voffA);
            PG8_WAIT_V(8); PG8_WAIT_L(0); PG8_BAR; PG8_MMA(0, 0, At, B0); PG8_MMA(0, 1, At, B1); PG8_BAR; PG8_SCHED;
            PG8_LDA(At, 0, 1); PG8_STAGE(PG8_SB(0, 0), b2, voffB); PG8_STAGE(PG8_SB(0, 1), b2 + hstep, voffB); PG8_STAGE(PG8_SA(0, 0), a2, voffA);
            PG8_WAIT_V(8); PG8_WAIT_L(0); PG8_BAR; PG8_MMA(1, 0, At, B0); PG8_MMA(1, 1, At, B1); PG8_BAR; PG8_SCHED;
            PG8_LDB(B0, 1, 0); PG8_LDB(B1, 1, 1); PG8_SCHED; PG8_LDA(At, 1, 0); PG8_STAGE(PG8_SA(0, 1), a2 + hstep, voffA);
            PG8_WAIT_V(8); PG8_WAIT_L(0); PG8_BAR; PG8_MMA(0, 0, At, B0); PG8_MMA(0, 1, At, B1); PG8_BAR; PG8_SCHED;
            PG8_LDA(At, 1, 1); PG8_STAGE(PG8_SB(1, 0), b3, voffB); PG8_STAGE(PG8_SB(1, 1), b3 + hstep, voffB); PG8_STAGE(PG8_SA(1, 0), a3, voffA);
            PG8_WAIT_V(8); PG8_WAIT_L(0); PG8_BAR; PG8_MMA(1, 0, At, B0); PG8_MMA(1, 1, At, B1); PG8_BAR; PG8_SCHED;
            } else {
            PG8_LDB(B0, 0, 0); PG8_SCHED; PG8_LDA(At, 0, 0); PG8_STAGE(PG8_SA(1, 1), a1 + hstep, voffA);
            PG8_WAIT_L(8); PG8_BAR; PG8_WAIT_L(0); PG8_MMA(0, 0, At, B0); PG8_BAR; PG8_SCHED;
            PG8_LDB(B1, 0, 1); PG8_STAGE(PG8_SB(0, 0), b2, voffB);
            PG8_BAR; PG8_WAIT_L(0); PG8_MMA(0, 1, At, B1); PG8_BAR;
            PG8_LDA(At, 0, 1); PG8_STAGE(PG8_SA(0, 0), a2, voffA);
            PG8_BAR; PG8_WAIT_L(0); PG8_MMA(1, 0, At, B0); PG8_BAR; PG8_SCHED;
            PG8_STAGE(PG8_SB(0, 1), b2 + hstep, voffB);
            PG8_WAIT_V(6); PG8_BAR; PG8_MMA(1, 1, At, B1); PG8_BAR;
            PG8_LDB(B0, 1, 0); PG8_SCHED; PG8_LDA(At, 1, 0); PG8_STAGE(PG8_SA(0, 1), a2 + hstep, voffA);
            PG8_WAIT_L(8); PG8_BAR; PG8_WAIT_L(0); PG8_MMA(0, 0, At, B0); PG8_BAR; PG8_SCHED;
            PG8_LDB(B1, 1, 1); PG8_STAGE(PG8_SB(1, 0), b3, voffB);
            PG8_BAR; PG8_WAIT_L(0); PG8_MMA(0, 1, At, B1); PG8_BAR;
            PG8_LDA(At, 1, 1); PG8_STAGE(PG8_SA(1, 0), a3, voffA);
            PG8_BAR; PG8_WAIT_L(0); PG8_MMA(1, 0, At, B0); PG8_BAR; PG8_SCHED;
            PG8_STAGE(PG8_SB(1, 1), b3 + hstep, voffB);
            PG8_WAIT_V(6); PG8_BAR; PG8_MMA(1, 1, At, B1); PG8_BAR;
            }
        }
        if constexpr (ALIGN_EPI) { if (wr == 0) PG8_BAR; }
        if constexpr (!Epi::AFTER_DRAIN) { E(acc, cur, wr, wc, fr, fq); S.done(cur); }
        if (!has_next) break;
#pragma unroll
        for (int a = 0; a < 2; ++a)
#pragma unroll
            for (int b = 0; b < 2; ++b)
#pragma unroll
                for (int m = 0; m < 4; ++m)
#pragma unroll
                    for (int n = 0; n < 2; ++n) acc[a][b][m][n] = (f32x4){0.f, 0.f, 0.f, 0.f};
        cur = nxt; cA = nA; cB = nB; ++ui;
        if constexpr (ALIGN_EPI) { if (wr == 1) PG8_BAR; }
    }
    PG8_WAIT_V(0);
    if constexpr (!ALIGN_EPI) { if (wr == 0) PG8_BAR; }
    PG8_BAR;
    if constexpr (Epi::AFTER_DRAIN) { E.fused(acc, cur, wr, wc, fr, fq, lds, wid, lane); S.done(cur); }
#undef PG8_SA
#undef PG8_SB
#undef PG8_STAGE
#undef PG8_LDA
#undef PG8_LDB
#undef PG8_MMA
#undef PG8_WAIT_V
#undef PG8_WAIT_L
#undef PG8_BAR
#undef PG8_SCHED
}
}
namespace pg8 {
constexpr int TOK = 16384;
constexpr float RMS_EPS = 1e-6f;
typedef float f32x2e __attribute__((ext_vector_type(2)));
template <int NP> __device__ __forceinline__ void row_scales(const float* src, int rowbase, int lane, int fr, float (&r)[2][4]) {
#pragma unroll
    for (int ai = 0; ai < 2; ++ai) {
        const int row = rowbase + 128 * ai + lane; float v;
        if (NP == 0) v = src[row];
        else { float s = 0.f;
#pragma unroll
            for (int p = 0; p < NP; ++p) s += src[(size_t)p * TOK + row];
            v = __builtin_amdgcn_rsqf(s * (1.0f / 1024.0f) + RMS_EPS); }
#pragma unroll
        for (int m = 0; m < 4; ++m) r[ai][m] = __shfl(v, 16 * m + fr);
    }
}
__device__ __forceinline__ float silu_f(float x) { return x * __builtin_amdgcn_rcpf(1.0f + __expf(-x)); }
__device__ __forceinline__ float sigmoid_f(float x) { return __builtin_amdgcn_rcpf(1.0f + __expf(-x)); }

template <int NP> struct EpiSwiGLU {
    static constexpr bool PERM = true, AFTER_DRAIN = false;
    bf16_t* H; int ldh; const float* rs;
    __device__ __forceinline__ void operator()(const f32x4 (&acc)[2][2][4][2], const Unit& u, int wr, int wc, int fr0, int fq0) const {
        int fr = fr0, fq = fq0; asm volatile("" : "+v"(fr), "+v"(fq));
        float r[2][4]; row_scales<NP>(rs, u.pm * BM + wr * 64, (int)(threadIdx.x & 63), fr, r);
        const int col0 = u.pn * 128 + wc * 32 + 8 * fq;
#pragma unroll
        for (int ai = 0; ai < 2; ++ai)
#pragma unroll
            for (int m = 0; m < 4; ++m) {
                const int row = u.pm * BM + ai * HALF + wr * 64 + m * 16 + fr; const float rr = r[ai][m];
                float o[8];
#pragma unroll
                for (int n = 0; n < 2; ++n)
#pragma unroll
                    for (int j = 0; j < 4; ++j) { const float g = acc[ai][0][m][n][j] * rr, up = acc[ai][1][m][n][j] * rr; o[4 * n + j] = silu_f(g) * up; }
                u32x4 w; w.x = cvt_pk_bf16(o[0], o[1]); w.y = cvt_pk_bf16(o[2], o[3]); w.z = cvt_pk_bf16(o[4], o[5]); w.w = cvt_pk_bf16(o[6], o[7]);
                *(u32x4*)(H + (size_t)row * ldh + col0) = w;
            }
    }
};
template <bool WRITE_HB> struct EpiResid {
    static constexpr bool PERM = true, AFTER_DRAIN = false;
    const float* base; float* out; bf16_t* hb; float* part; float sc;
    __device__ __forceinline__ void operator()(const f32x4 (&acc)[2][2][4][2], const Unit& u, int wr, int wc, int fr0, int fq0) const {
        int fr = fr0, fq = fq0; asm volatile("" : "+v"(fr), "+v"(fq));
        const int col0 = u.pn * BM + wc * 32 + 8 * fq;
#pragma unroll
        for (int ai = 0; ai < 2; ++ai)
#pragma unroll
            for (int m = 0; m < 4; ++m) {
                const int row = u.pm * BM + ai * HALF + wr * 64 + m * 16 + fr; float ss = 0.f;
#pragma unroll
                for (int bj = 0; bj < 2; ++bj) {
                    const size_t off = (size_t)row * 1024 + col0 + bj * HALF;
                    const f32x4 b0 = *(const f32x4*)(base + off), b1 = *(const f32x4*)(base + off + 4);
                    const f32x4 o0 = b0 + acc[ai][bj][m][0] * sc, o1 = b1 + acc[ai][bj][m][1] * sc;
                    *(f32x4*)(out + off) = o0; *(f32x4*)(out + off + 4) = o1;
                    if (WRITE_HB) {
                        ss += (o0[0] * o0[0] + o0[1] * o0[1]) + (o0[2] * o0[2] + o0[3] * o0[3]) + (o1[0] * o1[0] + o1[1] * o1[1]) + (o1[2] * o1[2] + o1[3] * o1[3]);
                        u32x4 w; w.x = cvt_pk_bf16(o0[0], o0[1]); w.y = cvt_pk_bf16(o0[2], o0[3]); w.z = cvt_pk_bf16(o1[0], o1[1]); w.w = cvt_pk_bf16(o1[2], o1[3]);
                        *(u32x4*)(hb + off) = w; }
                }
                if (WRITE_HB) { ss += __shfl_xor(ss, 16); ss += __shfl_xor(ss, 32); if (fq == 0) part[(size_t)(u.pn * 4 + wc) * TOK + row] = ss; }
                if (m & 1) asm volatile("" ::: "memory");
            }
    }
};
struct EpiMemKV {
    static constexpr bool PERM = true, AFTER_DRAIN = false;
    float* KV; const float* rs;
    __device__ __forceinline__ void operator()(const f32x4 (&acc)[2][2][4][2], const Unit& u, int wr, int wc, int fr0, int fq0) const {
        int fr = fr0, fq = fq0; asm volatile("" : "+v"(fr), "+v"(fq));
        float r[2][4]; row_scales<0>(rs, u.pm * BM + wr * 64, (int)(threadIdx.x & 63), fr, r);
        const int col0 = u.pn * BM + wc * 32 + 8 * fq;
#pragma unroll
        for (int ai = 0; ai < 2; ++ai)
#pragma unroll
            for (int m = 0; m < 4; ++m) { const int row = u.pm * BM + ai * HALF + wr * 64 + m * 16 + fr;
#pragma unroll
                for (int bj = 0; bj < 2; ++bj) { const size_t off = (size_t)row * 1024 + col0 + bj * HALF;
                    *(f32x4*)(KV + off) = acc[ai][bj][m][0] * r[ai][m]; *(f32x4*)(KV + off + 4) = acc[ai][bj][m][1] * r[ai][m]; } }
    }
};
template <int NP> struct EpiGate {
    static constexpr bool PERM = true, AFTER_DRAIN = false;
    bf16_t* scr; const float* rs;
    __device__ __forceinline__ void operator()(const f32x4 (&acc)[2][2][4][2], const Unit& u, int wr, int wc, int fr0, int fq0) const {
        int fr = fr0, fq = fq0; asm volatile("" : "+v"(fr), "+v"(fq));
        float r[2][4];
#ifdef DBG_GATE_NOSCALE
        for (int a_ = 0; a_ < 2; ++a_) for (int m_ = 0; m_ < 4; ++m_) r[a_][m_] = 1.0f;
#else
        row_scales<NP>(rs, u.pm * BM + wr * 64, (int)(threadIdx.x & 63), fr, r);
#endif
        bf16_t* t = scr + (size_t)(u.pm * 4 + u.pn) * 65536;
#pragma unroll
        for (int ai = 0; ai < 2; ++ai)
#pragma unroll
            for (int m = 0; m < 4; ++m) { const int lr = ai * HALF + wr * 64 + m * 16 + fr; const float rr = r[ai][m];
#pragma unroll
                for (int bj = 0; bj < 2; ++bj) { float o[8];
#pragma unroll
                    for (int n = 0; n < 2; ++n)
#pragma unroll
                        for (int j = 0; j < 4; ++j) o[4 * n + j] = sigmoid_f(acc[ai][bj][m][n][j] * rr);
                    u32x4 w; w.x = cvt_pk_bf16(o[0], o[1]); w.y = cvt_pk_bf16(o[2], o[3]); w.z = cvt_pk_bf16(o[4], o[5]); w.w = cvt_pk_bf16(o[6], o[7]);
                    *(u32x4*)(t + lr * 256 + bj * HALF + wc * 32 + 8 * fq) = w; } }
    }
};
__device__ __forceinline__ float bf_lo(unsigned w) { return __uint_as_float(w << 16); }
__device__ __forceinline__ float bf_hi(unsigned w) { return __uint_as_float(w & 0xffff0000u); }
struct EpiBranch {
    static constexpr bool PERM = true, AFTER_DRAIN = false;
    const bf16_t* scr; bf16_t* mg; bool first; float bscale;
    __device__ __forceinline__ void operator()(const f32x4 (&acc)[2][2][4][2], const Unit& u, int wr, int wc, int fr0, int fq0) const {
        int fr = fr0, fq = fq0; asm volatile("" : "+v"(fr), "+v"(fq));
        const bf16_t* t = scr + (size_t)(u.pm * 4 + u.pn) * 65536;
        __builtin_amdgcn_fence(__ATOMIC_ACQUIRE, "agent");
        asm volatile("s_waitcnt vmcnt(0)" ::: "memory");
#pragma unroll
        for (int ai = 0; ai < 2; ++ai)
#pragma unroll
            for (int m = 0; m < 4; ++m) { const int lr = ai * HALF + wr * 64 + m * 16 + fr; const int row = u.pm * BM + lr;
#pragma unroll
                for (int bj = 0; bj < 2; ++bj) { const int lc = bj * HALF + wc * 32 + 8 * fq;
#if defined(DBG_NOGATE) && DBG_NOGATE
                    const u32x4 g = (u32x4){0x3f803f80u, 0x3f803f80u, 0x3f803f80u, 0x3f803f80u};
#else
                    const u32x4 g = *(const u32x4*)(t + lr * 256 + lc);
#endif
                    bf16_t* mp = mg + (size_t)row * 1024 + u.pn * BM + lc;
                    float o[8];
                    o[0] = bf_lo(g.x) * acc[ai][bj][m][0][0]; o[1] = bf_hi(g.x) * acc[ai][bj][m][0][1]; o[2] = bf_lo(g.y) * acc[ai][bj][m][0][2]; o[3] = bf_hi(g.y) * acc[ai][bj][m][0][3];
                    o[4] = bf_lo(g.z) * acc[ai][bj][m][1][0]; o[5] = bf_hi(g.z) * acc[ai][bj][m][1][1]; o[6] = bf_lo(g.w) * acc[ai][bj][m][1][2]; o[7] = bf_hi(g.w) * acc[ai][bj][m][1][3];
#ifdef DBG_BRANCH_SIGMOID
#pragma unroll
                    for (int e = 0; e < 8; ++e) o[e] = DBG_NONLIN(o[e]);
#endif
#pragma unroll
                    for (int e = 0; e < 8; ++e) o[e] *= bscale;
                    if (!first) { const u32x4 p = *(const u32x4*)mp;
                        o[0] += bf_lo(p.x); o[1] += bf_hi(p.x); o[2] += bf_lo(p.y); o[3] += bf_hi(p.y); o[4] += bf_lo(p.z); o[5] += bf_hi(p.z); o[6] += bf_lo(p.w); o[7] += bf_hi(p.w); }
                    u32x4 w; w.x = cvt_pk_bf16(o[0], o[1]); w.y = cvt_pk_bf16(o[2], o[3]); w.z = cvt_pk_bf16(o[4], o[5]); w.w = cvt_pk_bf16(o[6], o[7]);
                    *(u32x4*)mp = w; asm volatile("" ::: "memory"); } }
    }
};
struct ProjOut { bf16_t *FQ, *FK, *FV, *DQ, *IQ, *MQ, *DK, *DV, *IK; float *LOGF, *IW; const float *cosT, *sinT, *g_fq, *g_fk, *g_dq, *g_dk, *b_forget; };
__device__ __forceinline__ float log_sigmoid_f(float z) { return z >= 0.f ? -log1pf(expf(-z)) : z - log1pf(expf(z)); }
template <int NP> struct EpiProj {
    static constexpr bool PERM = true, AFTER_DRAIN = false;
    ProjOut P; const float* rs; float qscale;
    __device__ __forceinline__ void operator()(const f32x4 (&acc)[2][2][4][2], const Unit& u, int wr, int wc, int fr0, int fq0) const {
        int fr = fr0, fq = fq0; asm volatile("" : "+v"(fr), "+v"(fq));
        float r[2][4]; row_scales<NP>(rs, u.pm * BM + wr * 64, (int)(threadIdx.x & 63), fr, r);
        const int pn = u.pn;
        bool do_norm = false, do_rope = false; const float* gain = nullptr; bf16_t* dst = nullptr; int pitch = 512, hoff = 0; float osc = 1.f;
        if (pn < 2)       { do_norm = true; gain = P.g_fq; dst = P.FQ; hoff = (4 * pn + wc) * 64; osc = qscale; }
        else if (pn < 4)  { do_norm = true; gain = P.g_fk; dst = P.FK; hoff = (4 * (pn - 2) + wc) * 64; }
        else if (pn < 6)  { dst = P.FV; hoff = (4 * (pn - 4) + wc) * 64; }
        else if (pn < 8)  { do_norm = true; do_rope = true; gain = P.g_dq; dst = P.DQ; hoff = (4 * (pn - 6) + wc) * 64; osc = qscale; }
        else if (pn < 10) { do_rope = true; dst = P.IQ; hoff = (4 * (pn - 8) + wc) * 64; }
        else if (pn < 12) { dst = P.MQ; hoff = (2 * (pn - 10) + (wc >> 1)) * 128 + (wc & 1) * 64; }
        else { pitch = 64;
            if (wc == 0)      { do_norm = true; do_rope = true; gain = P.g_dk; dst = P.DK; }
            else if (wc == 1) { dst = P.DV; }
            else if (wc == 2) { do_rope = true; dst = P.IK; }
            else dst = nullptr; }
        if (dst == nullptr) {
            if (fq < 2) {
#pragma unroll
                for (int ai = 0; ai < 2; ++ai)
#pragma unroll
                    for (int m = 0; m < 4; ++m) { const int row = u.pm * BM + ai * HALF + wr * 64 + m * 16 + fr; const float rr = r[ai][m];
                        f32x4 v0 = acc[ai][0][m][0] * rr, v1 = acc[ai][0][m][1] * rr;
                        if (fq == 0) {
                            const f32x4 b0 = *(const f32x4*)(P.b_forget), b1 = *(const f32x4*)(P.b_forget + 4);
#pragma unroll
                            for (int j = 0; j < 4; ++j) { v0[j] = log_sigmoid_f(v0[j] + b0[j]); v1[j] = log_sigmoid_f(v1[j] + b1[j]); }
                            *(f32x4*)(P.LOGF + (size_t)row * 8) = v0; *(f32x4*)(P.LOGF + (size_t)row * 8 + 4) = v1;
                        } else { const float c = 0.04419417382f; *(f32x4*)(P.IW + (size_t)row * 8) = v0 * c; *(f32x4*)(P.IW + (size_t)row * 8 + 4) = v1 * c; } }
            }
            return;
        }
        f32x4 gv[2][2];
        if (do_norm) {
#pragma unroll
            for (int bj = 0; bj < 2; ++bj)
#pragma unroll
                for (int n = 0; n < 2; ++n) gv[bj][n] = *(const f32x4*)(gain + bj * 32 + 8 * fq + 4 * n);
        }
#pragma unroll
        for (int ai = 0; ai < 2; ++ai)
#pragma unroll
            for (int m = 0; m < 4; ++m) {
                const int row = u.pm * BM + ai * HALF + wr * 64 + m * 16 + fr; const float rr = r[ai][m];
                f32x4 v[2][2];
#pragma unroll
                for (int bj = 0; bj < 2; ++bj)
#pragma unroll
                    for (int n = 0; n < 2; ++n) v[bj][n] = acc[ai][bj][m][n] * rr;
                if (do_norm) {
                    float ss = 0.f;
#pragma unroll
                    for (int bj = 0; bj < 2; ++bj)
#pragma unroll
                        for (int n = 0; n < 2; ++n) ss += (v[bj][n][0] * v[bj][n][0] + v[bj][n][1] * v[bj][n][1]) + (v[bj][n][2] * v[bj][n][2] + v[bj][n][3] * v[bj][n][3]);
                    ss += __shfl_xor(ss, 16); ss += __shfl_xor(ss, 32);
                    const float inv = __builtin_amdgcn_rsqf(ss * (1.0f / 64.0f) + RMS_EPS);
#pragma unroll
                    for (int bj = 0; bj < 2; ++bj)
#pragma unroll
                        for (int n = 0; n < 2; ++n) v[bj][n] = v[bj][n] * inv * gv[bj][n];
                }
                if (do_rope) {
#pragma unroll
                    for (int n = 0; n < 2; ++n) {
                        const f32x4 c = *(const f32x4*)(P.cosT + (size_t)row * 32 + 8 * fq + 4 * n), s = *(const f32x4*)(P.sinT + (size_t)row * 32 + 8 * fq + 4 * n);
                        const f32x4 x1 = v[0][n], x2 = v[1][n];
                        v[0][n] = x1 * c - x2 * s; v[1][n] = x2 * c + x1 * s; }
                }
#pragma unroll
                for (int bj = 0; bj < 2; ++bj) {
                    const f32x4 a = v[bj][0] * osc, b = v[bj][1] * osc;
                    u32x4 w; w.x = cvt_pk_bf16(a[0], a[1]); w.y = cvt_pk_bf16(a[2], a[3]); w.z = cvt_pk_bf16(b[0], b[1]); w.w = cvt_pk_bf16(b[2], b[3]);
                    *(u32x4*)(dst + (size_t)row * pitch + hoff + bj * 32 + 8 * fq) = w; }
            }
    }
};
}
#define GAS __attribute__((address_space(1)))
#define LAS __attribute__((address_space(3)))
typedef unsigned short bf16;
typedef unsigned v4u __attribute__((ext_vector_type(4)));
typedef float f32x4 __attribute__((ext_vector_type(4)));
typedef short bf16x8 __attribute__((ext_vector_type(8)));
typedef GAS unsigned gu32;
typedef GAS unsigned long long gu64;
#define RLX_AGENT __ATOMIC_RELAXED, __HIP_MEMORY_SCOPE_AGENT
#define LDS_WAIT() asm volatile("s_waitcnt lgkmcnt(0)" ::: "memory")
#define VM_WAIT() asm volatile("s_waitcnt vmcnt(0)" ::: "memory")
__device__ __forceinline__ unsigned long long rt() { return __builtin_amdgcn_s_memrealtime(); }
__device__ __forceinline__ unsigned f2bf(float f) { unsigned u = __builtin_bit_cast(unsigned, f); return (u + 0x7fffu + ((u >> 16) & 1u)) >> 16; }
__device__ __forceinline__ unsigned pk2(float lo, float hi) { return f2bf(lo) | (f2bf(hi) << 16); }
typedef float f32x2g __attribute__((ext_vector_type(2)));
__device__ __forceinline__ float bf_lo32(unsigned w) { return __uint_as_float(w << 16); }
__device__ __forceinline__ float bf_hi32(unsigned w) { return __uint_as_float(w & 0xffff0000u); }
constexpr int NWAVES = 8;
constexpr int BATCH = 2, SEQ = 8192, DM = 1024, T = BATCH * SEQ, DFF = 2816, MEMLEN = 256, BW = 512, DIN = 6352;
constexpr int NPROJ = 13 * 256, NGATE = 3072;
constexpr float L2E = 1.4426950408889634f;
constexpr float C2_64 = 0.125f * L2E;
constexpr float C2_128 = 0.08838834764831845f * L2E;
constexpr size_t MiB = 1u << 20;
constexpr size_t WS_CTL = 0, CTL_ZERO_BYTES = 1 * MiB;
constexpr size_t WS_RSTDX = 1 * MiB;
constexpr size_t WS_RSTDM = WS_RSTDX + 64 * 1024;
constexpr size_t WS_SSQ1 = 2 * MiB;
constexpr size_t WS_SSQ2 = 3 * MiB;
constexpr size_t WS_LOGF = 4 * MiB;
constexpr size_t WS_CUM = WS_LOGF + 512 * 1024;
constexpr size_t WS_IW = 5 * MiB;
constexpr size_t WS_COS = 6 * MiB, WS_SIN = 8 * MiB;
constexpr size_t WS_MEMB = 10 * MiB;
constexpr size_t WS_KVM = 11 * MiB;
constexpr size_t WS_KMB = 13 * MiB, WS_VMB = 14 * MiB;
constexpr size_t WS_WGU1 = 16 * MiB;
constexpr size_t WS_WD1 = 27 * MiB;
constexpr size_t WS_WIN = 33 * MiB;
constexpr size_t WS_WGATE = 40 * MiB;
constexpr size_t WS_WBR = 46 * MiB;
constexpr size_t WS_WOUT = 49 * MiB;
constexpr size_t WS_WGU2 = 51 * MiB;
constexpr size_t WS_WD2 = 62 * MiB;
constexpr size_t WS_WMKV = 68 * MiB;
constexpr size_t WS_HB = 70 * MiB;
constexpr size_t WS_ACT = 102 * MiB;
constexpr size_t WS_HID = WS_ACT;
constexpr size_t WS_FQ = WS_ACT, WS_FK = WS_ACT + 16 * MiB, WS_FV = WS_ACT + 32 * MiB, WS_DQ = WS_ACT + 48 * MiB, WS_IQ = WS_ACT + 64 * MiB, WS_MQ = WS_ACT + 80 * MiB;
constexpr size_t WS_DK = WS_ACT + 96 * MiB, WS_DV = WS_ACT + 98 * MiB, WS_IK = WS_ACT + 100 * MiB;
#if defined(DBG_SUBST) && DBG_SUBST == 2
constexpr size_t WS_MERGED = WS_DQ;
#else
constexpr size_t WS_MERGED = WS_FK;
#endif
#ifdef DBG_GSCR_AT
constexpr size_t WS_GSCR = DBG_GSCR_AT;
#else
constexpr size_t WS_GSCR = 204 * MiB;
#endif
constexpr size_t WS_END = 236 * MiB;
#ifndef DBG_GSCR_AT
static_assert(WS_HID + (size_t)T * DFF * 2 <= WS_GSCR && WS_IK + (size_t)T * 64 * 2 <= WS_GSCR, "d_ws map");
#endif
constexpr int CW_BAR = 4096;
constexpr int RING_OFF = 0, RING_BYTES = 131072;
constexpr int LDSCTL_OFF = RING_BYTES, MISC_OFF = LDSCTL_OFF + 320;
constexpr int LIST_OFF = RING_BYTES + 1024;
constexpr int SCANX_OFF = RING_BYTES + 6144;
constexpr int LDS_BYTES = 147456;
#define XB_TMO      128
#define XB_XCNT(j)  (256  + 64 * (j))
#define XB_XSUB(j)  (1280 + 64 * (j))
#define XB_XGEN(j)  (2304 + 64 * (j))
#define XB_TOP      3328
#define XB_TOPGEN   3392
#define XCD_BAR_WORDS 3456
#define XB_SPIN_CAP (1u << 18)

__device__ __forceinline__ unsigned xb_ld(unsigned* p)              { return __hip_atomic_load(p, __ATOMIC_RELAXED, __HIP_MEMORY_SCOPE_AGENT); }
__device__ __forceinline__ unsigned xb_add(unsigned* p, unsigned v) { return __hip_atomic_fetch_add(p, v, __ATOMIC_RELAXED, __HIP_MEMORY_SCOPE_AGENT); }
__device__ __forceinline__ unsigned xb_xcc_id() { return (unsigned)__builtin_amdgcn_s_getreg((3 << 11) | 20) & 0xFu; }
#define XB_SPIN(cond, bar) do { unsigned _sp = 0; while (cond) { __builtin_amdgcn_s_sleep(1); \
    if ((++_sp & 255u) == 0u) { if (xb_ld(&(bar)[XB_TMO])) break; if (_sp > XB_SPIN_CAP) { atomicAdd(&(bar)[XB_TMO], 1u); break; } } } } while (0)

struct XcdBarrier {
    unsigned* bar; unsigned x;
    volatile LAS unsigned* st;
};

__device__ __forceinline__ XcdBarrier xcd_barrier_post(unsigned* bar, volatile LAS unsigned* st) {
    XcdBarrier b; b.bar = bar; b.x = xb_xcc_id(); b.st = st;
    if (threadIdx.x == 0) (void)xb_add(&bar[XB_XCNT(b.x)], 1u);
    return b;
}
__device__ __forceinline__ void xcd_barrier_complete(unsigned* bar, unsigned x, unsigned& nloc, unsigned& nx) {
    const unsigned G = gridDim.x * gridDim.y * gridDim.z;
    unsigned sum, cnt, mine, sp = 0u;
    for (;;) {
        sum = 0u; cnt = 0u; mine = 0u;
#pragma unroll
        for (unsigned j = 0; j < 16; ++j) { const unsigned c = xb_ld(&bar[XB_XCNT(j)]); sum += c; cnt += (c > 0u) ? 1u : 0u; mine = (j == x) ? c : mine; }
        if (sum == G) break;
        __builtin_amdgcn_s_sleep(1);
        if ((++sp & 255u) == 0u) { if (xb_ld(&bar[XB_TMO])) break; if (sp > XB_SPIN_CAP) { atomicAdd(&bar[XB_TMO], 1u); break; } }
    }
    nloc = mine > 0u ? mine : 1u; nx = cnt > 0u ? cnt : 1u;
}

__device__ __forceinline__ void xcd_barrier(const XcdBarrier& b) {
    asm volatile("s_waitcnt vmcnt(0)" ::: "memory");
    __syncthreads();
    if (threadIdx.x == 0) {
        unsigned* bar = b.bar;
        __builtin_amdgcn_s_waitcnt(0);
        unsigned nloc = b.st[0], nx = b.st[1];
        if (nloc == 0u) { xcd_barrier_complete(bar, b.x, nloc, nx); b.st[0] = nloc; b.st[1] = nx; }
        const unsigned old = xb_add(&bar[XB_XSUB(b.x)], 1u);
        const unsigned gen = old / nloc;
        if (old + 1u == (gen + 1u) * nloc) {
            __builtin_amdgcn_fence(__ATOMIC_RELEASE, "agent");
            asm volatile("s_waitcnt vmcnt(0)" ::: "memory");
            const unsigned og = xb_add(&bar[XB_TOP], 1u);
            const unsigned tg = og / nx;
            if (og + 1u == (tg + 1u) * nx) xb_add(&bar[XB_TOPGEN], 1u);
            else XB_SPIN(xb_ld(&bar[XB_TOPGEN]) == tg, bar);
            __builtin_amdgcn_fence(__ATOMIC_ACQUIRE, "agent");
            xb_add(&bar[XB_XGEN(b.x)], 1u);
            asm volatile("s_waitcnt vmcnt(0)" ::: "memory");
        } else {
            XB_SPIN(xb_ld(&bar[XB_XGEN(b.x)]) == gen, bar);
            __builtin_amdgcn_fence(__ATOMIC_ACQUIRE, "agent");
            asm volatile("s_waitcnt vmcnt(0)" ::: "memory");
        }
    }
    __syncthreads();
}
__device__ __forceinline__ float wave_sum(float v) {
#pragma unroll
    for (int o = 1; o < 64; o <<= 1) v += __shfl_xor(v, o);
    return v;
}
__device__ __forceinline__ float wave_max(float v) {
#pragma unroll
    for (int o = 1; o < 64; o <<= 1) v = fmaxf(v, __shfl_xor(v, o));
    return v;
}
__device__ __forceinline__ int colmap(int mat, int n) {
    if (mat == 1) return n;
    if (mat == 3) return 3280 + n;
    const int tile = n >> 8, t = n & 255;
    if (mat == 0) return (t < 128 ? 0 : DFF) + 128 * tile + (t & 127);
    const int bj = t >> 7, wc = (t >> 5) & 3, i = t & 31, d = bj * 32 + i;
    if (tile < 2) return 0 + (4 * tile + wc) * 64 + d;
    if (tile < 4) return 512 + (4 * (tile - 2) + wc) * 64 + d;
    if (tile < 6) return 1024 + (4 * (tile - 4) + wc) * 64 + d;
    if (tile < 8) return 1544 + (4 * (tile - 6) + wc) * 64 + d;
    if (tile < 10) return 2184 + (4 * (tile - 8) + wc) * 64 + d;
    if (tile < 12) return 2768 + (2 * (tile - 10) + (wc >> 1)) * 128 + (wc & 1) * 64 + d;
    if (wc == 0) return 2056 + d;
    if (wc == 1) return 2120 + d;
    if (wc == 2) return 2696 + d;
    if (bj == 0 && i < 8) return 1536 + i;
    if (bj == 0 && i < 16) return 2760 + (i - 8);
    return -1;
}
__device__ __forceinline__ void transpose_item(int mat, const float* Wa, const float* Wb, int K, int Nsrc, const float* gain, bf16* WT, LAS float* scr, int item, int nblk, int lane) {
    const int kb = item / nblk, nb = item % nblk, k0 = 64 * kb, n0 = 32 * nb;
    int col = colmap(mat, n0 + (lane & 31)); const float* W = Wa;
    if (mat == 0 && col >= DFF) { W = Wb; col -= DFF; }
#pragma unroll 8
    for (int i = 0; i < 32; ++i) { const int kk = 2 * i + (lane >> 5); float v = 0.f; if (col >= 0) v = W[(size_t)(k0 + kk) * Nsrc + col]; if (gain) v *= gain[k0 + kk]; scr[kk * 33 + (lane & 31)] = v; }
    LDS_WAIT(); asm volatile("" ::: "memory");
    const int c = lane & 7;
#pragma unroll
    for (int j = 0; j < 4; ++j) { const int n = (lane >> 3) + 8 * j; const LAS float* s = scr + (8 * c) * 33 + n;
        v4u o; o.x = pk2(s[0 * 33], s[1 * 33]); o.y = pk2(s[2 * 33], s[3 * 33]); o.z = pk2(s[4 * 33], s[5 * 33]); o.w = pk2(s[6 * 33], s[7 * 33]);
        *(GAS v4u*)(WT + (size_t)(n0 + n) * K + k0 + 8 * c) = o; }
    LDS_WAIT(); asm volatile("" ::: "memory");
}
__device__ __forceinline__ void row_to_bf16_rstd(const float* xrow, bf16* orow, float* rstd_out, int lane) {
    const GAS f32x4* xr = (const GAS f32x4*)xrow + lane;
    f32x4 v[4]; float s = 0.f;
#pragma unroll
    for (int j = 0; j < 4; ++j) { v[j] = xr[64 * j]; s += (v[j].x * v[j].x + v[j].y * v[j].y) + (v[j].z * v[j].z + v[j].w * v[j].w); }
    const float rstd = 1.0f / sqrtf(wave_sum(s) * (1.f / 1024.f) + 1e-6f);
    GAS unsigned long long* o8 = (GAS unsigned long long*)orow + lane;
#pragma unroll
    for (int j = 0; j < 4; ++j) o8[64 * j] = (unsigned long long)pk2(v[j].x, v[j].y) | ((unsigned long long)pk2(v[j].z, v[j].w) << 32);
    if (lane == 0) *rstd_out = rstd;
}
typedef float f32x16 __attribute__((ext_vector_type(16)));
typedef unsigned u32x2 __attribute__((ext_vector_type(2)));
__device__ __forceinline__ int crow(int r, int hi) { return (r & 3) + 8 * (r >> 2) + 4 * hi; }
__device__ __forceinline__ float bf2f(bf16 v) { return __uint_as_float((unsigned)v << 16); }
__device__ __forceinline__ unsigned cvtpk(float lo, float hi) { return pg8::cvt_pk_bf16(lo, hi); }
template <int HD, bool FOX, bool VT>
__device__ __forceinline__ void attn_wave_simple(const bf16x8 (&qr)[HD / 16], const bf16* Kp, int kpitch, const bf16* Vp, int vpitch, int ntiles, int qlocal, const float* cb, bf16* Op, int opitch, int lane) {
    const int r32 = lane & 31, hi = lane >> 5;
    f32x16 o[HD / 32];
#pragma unroll
    for (int d0 = 0; d0 < HD / 32; ++d0)
#pragma unroll
        for (int r = 0; r < 16; ++r) o[d0][r] = 0.f;
    float m = -1e30f, l = 0.f;
    for (int t = 0; t < ntiles; ++t) {
        const int kv0 = 32 * t;
        f32x16 p;
#pragma unroll
        for (int r = 0; r < 16; ++r) p[r] = 0.f;
        const bf16* kr = Kp + (size_t)(kv0 + r32) * kpitch + hi * 8;
#pragma unroll
        for (int ks = 0; ks < HD / 16; ++ks) { const bf16x8 kf = *(const bf16x8*)(kr + ks * 16); p = __builtin_amdgcn_mfma_f32_32x32x16_bf16(kf, qr[ks], p, 0, 0, 0); }
        if (FOX) {
#pragma unroll
            for (int g = 0; g < 4; ++g) { const f32x4 c4 = *(const f32x4*)(cb + kv0 + 8 * g + 4 * hi);
#pragma unroll
                for (int jj = 0; jj < 4; ++jj) p[4 * g + jj] -= L2E * c4[jj]; }
            if (t == ntiles - 1) {
#pragma unroll
                for (int r = 0; r < 16; ++r) if (kv0 + crow(r, hi) > qlocal) p[r] = -INFINITY;
            }
        }
        float mt = p[0];
#pragma unroll
        for (int r = 1; r < 16; ++r) mt = fmaxf(mt, p[r]);
        mt = fmaxf(mt, __shfl_xor(mt, 32));
        const float mn = fmaxf(m, mt); const float alpha = __builtin_amdgcn_exp2f(m - mn); m = mn;
        l *= alpha;
#pragma unroll
        for (int d0 = 0; d0 < HD / 32; ++d0)
#pragma unroll
            for (int r = 0; r < 16; ++r) o[d0][r] *= alpha;
        float ls = 0.f;
#pragma unroll
        for (int r = 0; r < 16; ++r) { p[r] = __builtin_amdgcn_exp2f(p[r] - mn); ls += p[r]; }
        l += ls;
        bf16x8 pa[2];
#pragma unroll
        for (int s = 0; s < 2; ++s) { v4u w; w.x = cvtpk(p[8 * s + 0], p[8 * s + 1]); w.y = cvtpk(p[8 * s + 2], p[8 * s + 3]); w.z = cvtpk(p[8 * s + 4], p[8 * s + 5]); w.w = cvtpk(p[8 * s + 6], p[8 * s + 7]); pa[s] = __builtin_bit_cast(bf16x8, w); }
#pragma unroll
        for (int d0 = 0; d0 < HD / 32; ++d0)
#pragma unroll
            for (int s = 0; s < 2; ++s) {
                bf16x8 vf;
                if (VT) {
                    const bf16* vp = Vp + (size_t)(d0 * 32 + r32) * vpitch + kv0 + 16 * s + 4 * hi;
                    const u32x2 lo = *(const u32x2*)vp, hi2 = *(const u32x2*)(vp + 8);
                    vf = __builtin_bit_cast(bf16x8, (v4u){lo.x, lo.y, hi2.x, hi2.y});
                } else {
#pragma unroll
                    for (int j = 0; j < 8; ++j) vf[j] = (short)Vp[(size_t)(kv0 + 16 * s + 8 * (j >> 2) + 4 * hi + (j & 3)) * vpitch + d0 * 32 + r32];
                }
                o[d0] = __builtin_amdgcn_mfma_f32_32x32x16_bf16(vf, pa[s], o[d0], 0, 0, 0);
            }
    }
    l += __shfl_xor(l, 32);
    const float inv = 1.0f / l;
    bf16* orow = Op + (size_t)r32 * opitch;
#pragma unroll
    for (int d0 = 0; d0 < HD / 32; ++d0)
#pragma unroll
        for (int g = 0; g < 4; ++g) { u32x2 w; w.x = cvtpk(o[d0][4 * g] * inv, o[d0][4 * g + 1] * inv); w.y = cvtpk(o[d0][4 * g + 2] * inv, o[d0][4 * g + 3] * inv);
            *(u32x2*)(orow + d0 * 32 + 8 * g + 4 * hi) = w; }
}
__device__ __forceinline__ void fox_unit(int bh, int qb, bf16* FQ, const bf16* FK, const bf16* FV, const float* CUM, int wave, int lane) {
    const int b = bh >> 3, h = bh & 7, r32 = lane & 31, hi = lane >> 5; const size_t rowbase = (size_t)b * SEQ; const int q0 = qb * 256 + wave * 32;
    bf16* Qw = FQ + (rowbase + q0) * 512 + h * 64;
    bf16x8 qr[4];
#pragma unroll
    for (int ks = 0; ks < 4; ++ks) qr[ks] = *(const bf16x8*)(Qw + (size_t)r32 * 512 + ks * 16 + hi * 8);
    attn_wave_simple<64, true, false>(qr, FK + rowbase * 512 + h * 64, 512, FV + rowbase * 512 + h * 64, 512, q0 / 32 + 1, q0 + r32, CUM + (size_t)bh * SEQ, Qw, 512, lane);
}
__device__ __forceinline__ void mem_unit(int rg, int head, bf16* MQ, const bf16* KMB, const bf16* VMB, const float* gq, int lane) {
    const int r32 = lane & 31, hi = lane >> 5; const int row0 = rg * 32; const int b = row0 / SEQ;
    bf16* Qw = MQ + (size_t)row0 * 512 + head * 128;
    bf16x8 raw[8]; float ss = 0.f;
#pragma unroll
    for (int ks = 0; ks < 8; ++ks) { raw[ks] = *(const bf16x8*)(Qw + (size_t)r32 * 512 + ks * 16 + hi * 8);
#pragma unroll
        for (int j = 0; j < 8; ++j) { const float f = bf2f((bf16)raw[ks][j]); ss += f * f; } }
    ss += __shfl_xor(ss, 32);
    const float rstd = __builtin_amdgcn_rsqf(ss * (1.0f / 128.0f) + 1e-6f) * C2_128;
    bf16x8 qr[8];
#pragma unroll
    for (int ks = 0; ks < 8; ++ks) { const f32x4 g0 = *(const f32x4*)(gq + ks * 16 + hi * 8), g1 = *(const f32x4*)(gq + ks * 16 + hi * 8 + 4); v4u w;
        w.x = cvtpk(bf2f((bf16)raw[ks][0]) * rstd * g0[0], bf2f((bf16)raw[ks][1]) * rstd * g0[1]); w.y = cvtpk(bf2f((bf16)raw[ks][2]) * rstd * g0[2], bf2f((bf16)raw[ks][3]) * rstd * g0[3]);
        w.z = cvtpk(bf2f((bf16)raw[ks][4]) * rstd * g1[0], bf2f((bf16)raw[ks][5]) * rstd * g1[1]); w.w = cvtpk(bf2f((bf16)raw[ks][6]) * rstd * g1[2], bf2f((bf16)raw[ks][7]) * rstd * g1[3]);
        qr[ks] = __builtin_bit_cast(bf16x8, w); }
    attn_wave_simple<128, false, true>(qr, KMB + (size_t)b * MEMLEN * 512 + head * 128, 512, VMB + (size_t)(b * 4 + head) * 128 * MEMLEN, MEMLEN, MEMLEN / 32, 0, nullptr, Qw, 512, lane);
}
__device__ __forceinline__ void scan_unit(int bh, const float* LOGF, float* CUM, LAS float* sx, int tid) {
    const int b = bh >> 3, h = bh & 7, lane = tid & 63, wave = tid >> 6;
    float v[16]; float run = 0.f;
#pragma unroll
    for (int i = 0; i < 16; ++i) v[i] = LOGF[((size_t)b * SEQ + 16 * tid + i) * 8 + h];
#pragma unroll
    for (int i = 0; i < 16; ++i) { run += v[i]; v[i] = run; }
    float tot = run;
#pragma unroll
    for (int off = 1; off < 64; off <<= 1) { const float nb = __shfl_up(tot, off); if (lane >= off) tot += nb; }
    if (lane == 63) sx[wave] = tot;
    __syncthreads();
    float woff = 0.f;
    for (int w = 0; w < wave; ++w) woff += sx[w];
    const float excl = tot - run + woff;
    float* dst = CUM + (size_t)bh * SEQ + 16 * tid;
#pragma unroll
    for (int i = 0; i < 16; i += 4) *(f32x4*)(dst + i) = (f32x4){v[i] + excl, v[i + 1] + excl, v[i + 2] + excl, v[i + 3] + excl};
    __syncthreads();
}
__device__ __forceinline__ unsigned sortable_u32(float f) { const unsigned u = __float_as_uint(f); return u ^ ((u >> 31) ? 0xFFFFFFFFu : 0x80000000u); }
__device__ __forceinline__ int lane_rank(unsigned long long mask) { return (int)__builtin_amdgcn_mbcnt_hi((unsigned)(mask >> 32), __builtin_amdgcn_mbcnt_lo((unsigned)mask, 0u)); }
__device__ __forceinline__ void dsa_unit(int b, int qg, const bf16* IQ, const bf16* IK, const float* IW, bf16* DQ, const bf16* DK, const bf16* DV, LAS unsigned char* lds, int wave, int lane) {
    LAS unsigned* sc = (LAS unsigned*)lds;
    LAS unsigned* lists = (LAS unsigned*)(lds + LIST_OFF);
    const int q0 = 4 * qg, r32 = lane & 31, hi = lane >> 5; const size_t rowbase = (size_t)b * SEQ;
    const int ntile = (q0 + 3) / 32 + 1, npad = ntile * 32;
    {
        const int qi = 2 * ((r32 >> 2) & 1) + (r32 >> 4), hd = 4 * ((r32 >> 3) & 1) + (r32 & 3);
        bf16x8 aq[4];
#pragma unroll
        for (int ks = 0; ks < 4; ++ks) aq[ks] = *(const bf16x8*)(IQ + (rowbase + q0 + qi) * 512 + hd * 64 + ks * 16 + hi * 8);
        const float* w0p = IW + (rowbase + q0 + 2 * hi) * 8;
        const f32x4 w0a = *(const f32x4*)(w0p), w0b = *(const f32x4*)(w0p + 4), w1a = *(const f32x4*)(w0p + 8), w1b = *(const f32x4*)(w0p + 12);
        for (int t = wave; t < ntile; t += 8) {
            const int key = 32 * t + r32;
            f32x16 a;
#pragma unroll
            for (int r = 0; r < 16; ++r) a[r] = 0.f;
            const bf16* kr = IK + (rowbase + key) * 64 + hi * 8;
#pragma unroll
            for (int ks = 0; ks < 4; ++ks) { const bf16x8 bk = *(const bf16x8*)(kr + ks * 16); a = __builtin_amdgcn_mfma_f32_32x32x16_bf16(aq[ks], bk, a, 0, 0, 0); }
            float s0 = 0.f, s1 = 0.f;
#pragma unroll
            for (int j = 0; j < 4; ++j) { s0 += w0a[j] * fmaxf(a[j], 0.f); s1 += w1a[j] * fmaxf(a[8 + j], 0.f); }
#pragma unroll
            for (int j = 0; j < 4; ++j) { s0 += w0b[j] * fmaxf(a[4 + j], 0.f); s1 += w1b[j] * fmaxf(a[12 + j], 0.f); }
            sc[(2 * hi) * 8192 + key] = (key <= q0 + 2 * hi) ? sortable_u32(s0) : 0u;
            sc[(2 * hi + 1) * 8192 + key] = (key <= q0 + 2 * hi + 1) ? sortable_u32(s1) : 0u;
        }
    }
    __syncthreads();
    if (wave < 4) {
        const int q = q0 + wave, n = q + 1;
        LAS unsigned* my = sc + wave * 8192; LAS unsigned* lst = lists + wave * 256;
        int nsel;
        if (n <= 256) { for (int i = lane; i < n; i += 64) lst[i] = (unsigned)i; nsel = n; }
        else {
            unsigned thr = 0u;
            for (int bit = 31; bit >= 0; --bit) {
                const unsigned cand = thr | (1u << bit); int cnt = 0;
                for (int i0 = 0; i0 < npad; i0 += 256) { const int idx = i0 + 4 * lane; v4u v = (v4u){0u, 0u, 0u, 0u}; if (idx < npad) v = *(const LAS v4u*)(my + idx);
                    cnt += __popcll(__ballot(v.x >= cand)) + __popcll(__ballot(v.y >= cand)) + __popcll(__ballot(v.z >= cand)) + __popcll(__ballot(v.w >= cand)); }
                if (cnt >= 256) thr = cand;
            }
            int cgt = 0;
            for (int i0 = 0; i0 < npad; i0 += 256) { const int idx = i0 + 4 * lane; v4u v = (v4u){0u, 0u, 0u, 0u}; if (idx < npad) v = *(const LAS v4u*)(my + idx);
                cgt += __popcll(__ballot(v.x > thr)) + __popcll(__ballot(v.y > thr)) + __popcll(__ballot(v.z > thr)) + __popcll(__ballot(v.w > thr)); }
            const int quota = 256 - cgt; int eqseen = 0; nsel = 0;
            for (int base = 0; base < npad; base += 64) { const int idx = base + lane; unsigned u = 0u; if (idx < npad) u = my[idx];
                const bool gt = u > thr, eq = (u == thr);
                const unsigned long long em = __ballot(eq); const int er = eqseen + lane_rank(em);
                const bool sel = gt || (eq && er < quota);
                const unsigned long long sm = __ballot(sel); const int pos = nsel + lane_rank(sm);
                if (sel && pos < 256) lst[pos] = (unsigned)idx;
                nsel += __popcll(sm); eqseen += __popcll(em); }
            if (nsel > 256) nsel = 256;
        }
        LAS float* qf = (LAS float*)my; LAS float* pl = qf + 512;
        bf16* Qrow = DQ + (rowbase + q) * 512;
#pragma unroll
        for (int h = 0; h < 8; ++h) qf[h * 64 + lane] = bf2f(Qrow[h * 64 + lane]);
        float s[4][8]; int kidx[4];
#pragma unroll
        for (int jj = 0; jj < 4; ++jj) { const int j = lane + 64 * jj; kidx[jj] = (int)lst[j < nsel ? j : nsel - 1];
#pragma unroll
            for (int h = 0; h < 8; ++h) s[jj][h] = 0.f; }
#pragma unroll 2
        for (int c = 0; c < 8; ++c) {
            float kk[4][8];
#pragma unroll
            for (int jj = 0; jj < 4; ++jj) { const v4u raw = *(const v4u*)(DK + (rowbase + kidx[jj]) * 64 + c * 8);
                kk[jj][0] = bf_lo32(raw.x); kk[jj][1] = bf_hi32(raw.x); kk[jj][2] = bf_lo32(raw.y); kk[jj][3] = bf_hi32(raw.y); kk[jj][4] = bf_lo32(raw.z); kk[jj][5] = bf_hi32(raw.z); kk[jj][6] = bf_lo32(raw.w); kk[jj][7] = bf_hi32(raw.w); }
#pragma unroll
            for (int h = 0; h < 8; ++h) { const f32x4 qa = *(const LAS f32x4*)(qf + h * 64 + c * 8), qb = *(const LAS f32x4*)(qf + h * 64 + c * 8 + 4);
#pragma unroll
                for (int jj = 0; jj < 4; ++jj) s[jj][h] += (kk[jj][0] * qa[0] + kk[jj][1] * qa[1]) + (kk[jj][2] * qa[2] + kk[jj][3] * qa[3]) + (kk[jj][4] * qb[0] + kk[jj][5] * qb[1]) + (kk[jj][6] * qb[2] + kk[jj][7] * qb[3]); }
        }
        float linv[8];
#pragma unroll
        for (int h = 0; h < 8; ++h) {
            float mx = -INFINITY;
#pragma unroll
            for (int jj = 0; jj < 4; ++jj) { if (lane + 64 * jj >= nsel) s[jj][h] = -INFINITY; mx = fmaxf(mx, s[jj][h]); }
            mx = wave_max(mx); float ps = 0.f;
#pragma unroll
            for (int jj = 0; jj < 4; ++jj) { s[jj][h] = __builtin_amdgcn_exp2f(s[jj][h] - mx); ps += s[jj][h]; }
            linv[h] = 1.0f / wave_sum(ps);
        }
#pragma unroll
        for (int jj = 0; jj < 4; ++jj) { LAS float* pp = pl + (lane + 64 * jj) * 8;
            *(LAS f32x4*)pp = (f32x4){s[jj][0], s[jj][1], s[jj][2], s[jj][3]}; *(LAS f32x4*)(pp + 4) = (f32x4){s[jj][4], s[jj][5], s[jj][6], s[jj][7]}; }
        float o[8];
#pragma unroll
        for (int h = 0; h < 8; ++h) o[h] = 0.f;
#pragma unroll 4
        for (int j = 0; j < nsel; ++j) { const int idx = (int)lst[j]; const float v = bf2f(DV[(rowbase + idx) * 64 + lane]);
            const f32x4 pa = *(const LAS f32x4*)(pl + j * 8), pb = *(const LAS f32x4*)(pl + j * 8 + 4);
            o[0] += pa[0] * v; o[1] += pa[1] * v; o[2] += pa[2] * v; o[3] += pa[3] * v; o[4] += pb[0] * v; o[5] += pb[1] * v; o[6] += pb[2] * v; o[7] += pb[3] * v; }
#pragma unroll
        for (int h = 0; h < 8; ++h) Qrow[h * 64 + lane] = (bf16)f2bf(o[h] * linv[h]);
    }
    __syncthreads();
}
#ifndef DBG_BRANCH_MASK
#define DBG_BRANCH_MASK 7
#endif
#ifndef DBG_NBR
#define DBG_NBR 3
#endif
#ifndef DBG_NOGATE
#define DBG_NOGATE 0
#endif
#ifndef DBG_NOBRANCH
#define DBG_NOBRANCH 0
#endif
#ifndef DBG_GATE_W
#define DBG_GATE_W WS_WGATE
#endif
#ifndef DBG_GATE_AS_BRANCH
#define DBG_GATE_AS_BRANCH 0
#endif
#ifndef DBG_SUBST
#define DBG_SUBST 0
#endif
#ifndef P7SEL
#define P7SEL 3
#endif
#ifndef PHMASK
#define PHMASK 0xFFFF
#endif
struct Args { const void* in[24]; float* out; unsigned char* ws; };
__global__ void __launch_bounds__(NWAVES * 64, 2) fwd_mega(Args args) {
    extern __shared__ __attribute__((aligned(16))) unsigned char lds[];
    LAS unsigned char* L = (LAS unsigned char*)lds;
    volatile LAS unsigned* MISC = (volatile LAS unsigned*)(L + MISC_OFF);
    const int tid = threadIdx.x, lane = tid & 63, wave = __builtin_amdgcn_readfirstlane(tid >> 6);
    const int G = gridDim.x; const int bx = blockIdx.x; const int vcu = (G % 8 == 0) ? (bx % 8) * (G / 8) + bx / 8 : bx;
    const Args* ap = (const Args*)__builtin_amdgcn_kernarg_segment_ptr();
#define ARG_IN(k) ((const float*)ap->in[k])
#define WSP(type, off) ((type*)(ap->ws + (off)))
    gu32* ctl = (gu32*)(ap->ws + WS_CTL);
    for (int u = tid; u < (LDS_BYTES - LDSCTL_OFF) / 4; u += NWAVES * 64) ((LAS unsigned*)(L + LDSCTL_OFF))[u] = 0u;
    __syncthreads();
    XcdBarrier bar = xcd_barrier_post((unsigned*)(ctl + CW_BAR), MISC + 8);
#define GRID_BAR() xcd_barrier(bar)
    const int gw = vcu * NWAVES + wave, NGW = G * NWAVES;

#if (PHMASK >> 0) & 1
    {
        LAS float* scr = (LAS float*)(L + RING_OFF + wave * 16384);
        constexpr int I_GU = 16 * 176, I_D = 44 * 32, I_IN = 16 * 104, I_GT = 16 * 96, I_BR = 8 * 32, I_SQ = 16 * 32;
        constexpr int NITEMS = 2 * I_GU + 2 * I_D + I_IN + I_GT + 3 * I_BR + 2 * I_SQ;
        for (int it = gw; it < NITEMS; it += NGW) {
            int r = it;
            if (r < I_GU) { transpose_item(0, ARG_IN(4), ARG_IN(5), 1024, DFF, ARG_IN(3), WSP(bf16, WS_WGU1), scr, r, 176, lane); continue; } r -= I_GU;
            if (r < I_GU) { transpose_item(0, ARG_IN(21), ARG_IN(22), 1024, DFF, ARG_IN(20), WSP(bf16, WS_WGU2), scr, r, 176, lane); continue; } r -= I_GU;
            if (r < I_D) { transpose_item(1, ARG_IN(6), nullptr, DFF, 1024, nullptr, WSP(bf16, WS_WD1), scr, r, 32, lane); continue; } r -= I_D;
            if (r < I_D) { transpose_item(1, ARG_IN(23), nullptr, DFF, 1024, nullptr, WSP(bf16, WS_WD2), scr, r, 32, lane); continue; } r -= I_D;
            if (r < I_IN) { transpose_item(2, ARG_IN(9), nullptr, 1024, DIN, ARG_IN(7), WSP(bf16, WS_WIN), scr, r, 104, lane); continue; } r -= I_IN;
            if (r < I_GT) { transpose_item(3, ARG_IN(9), nullptr, 1024, DIN, ARG_IN(7), WSP(bf16, WS_WGATE), scr, r, 96, lane); continue; } r -= I_GT;
            if (r < 3 * I_BR) { const int i = r / I_BR; transpose_item(1, ARG_IN(18) + (size_t)i * 512 * 1024, nullptr, 512, 1024, nullptr, WSP(bf16, WS_WBR) + (size_t)i * 1024 * 512, scr, r % I_BR, 32, lane); continue; } r -= 3 * I_BR;
            if (r < I_SQ) { transpose_item(1, ARG_IN(19), nullptr, 1024, 1024, nullptr, WSP(bf16, WS_WOUT), scr, r, 32, lane); continue; } r -= I_SQ;
            transpose_item(1, ARG_IN(17), nullptr, 1024, 1024, ARG_IN(8), WSP(bf16, WS_WMKV), scr, r, 32, lane);
        }
        for (int m = gw; m < T + 512; m += NGW) {
            if (m < T) row_to_bf16_rstd(ARG_IN(0) + (size_t)m * 1024, WSP(bf16, WS_HB) + (size_t)m * 1024, WSP(float, WS_RSTDX) + m, lane);
            else row_to_bf16_rstd(ARG_IN(1) + (size_t)(m - T) * 1024, WSP(bf16, WS_MEMB) + (size_t)(m - T) * 1024, WSP(float, WS_RSTDM) + (m - T), lane);
        }
        for (int e = (vcu * NWAVES * 64 + tid); e < T * 32; e += G * NWAVES * 64) {
            const int row = e >> 5, i = e & 31; const float inv_freq = powf(10000.0f, -(float)i * (1.0f / 32.0f));
            const float ang = (float)((const int*)ap->in[2])[row] * inv_freq; float sn, cs; sincosf(ang, &sn, &cs); WSP(float, WS_COS)[e] = cs; WSP(float, WS_SIN)[e] = sn;
        }
        VM_WAIT(); __syncthreads();
        GRID_BAR();
    }
#endif
#if (PHMASK >> 1) & 1
    {
        pg8::Gemm g{WSP(bf16, WS_MEMB), WSP(bf16, WS_WMKV), 512, 1024, 1024}; pg8::StaticOrder S; S.init(512, 1024, G, bx);
        pg8::EpiMemKV E{WSP(float, WS_KVM), WSP(float, WS_RSTDM)};
        pg8::gemm_phase<pg8::EpiMemKV, pg8::StaticOrder, true, true>(L + RING_OFF, g, S, E);
    }
#endif
#if (PHMASK >> 2) & 1
    {
        pg8::Gemm g{WSP(bf16, WS_HB), WSP(bf16, WS_WGU1), T, 2 * DFF, 1024}; pg8::StaticOrder S; S.init(T, 2 * DFF, G, bx);
        pg8::EpiSwiGLU<0> E{WSP(bf16, WS_HID), DFF, WSP(float, WS_RSTDX)};
        pg8::gemm_phase<pg8::EpiSwiGLU<0>, pg8::StaticOrder, true, true>(L + RING_OFF, g, S, E);
        GRID_BAR();
    }
#endif
#if (PHMASK >> 3) & 1
    {
        for (int it = gw; it < 2048; it += NGW) { const int row = it >> 2, h = it & 3;
            const f32x2g kv = *(const f32x2g*)(WSP(float, WS_KVM) + (size_t)row * 1024 + h * 128 + 2 * lane); const f32x2g vv = *(const f32x2g*)(WSP(float, WS_KVM) + (size_t)row * 1024 + 512 + h * 128 + 2 * lane);
            const float ss = wave_sum(kv.x * kv.x + kv.y * kv.y); const float rstd = 1.0f / sqrtf(ss * (1.0f / 128.0f) + 1e-6f);
            const f32x2g gk = *(const f32x2g*)(ARG_IN(16) + 2 * lane);
            *(unsigned*)(WSP(bf16, WS_KMB) + (size_t)row * 512 + h * 128 + 2 * lane) = pk2(kv.x * rstd * gk.x, kv.y * rstd * gk.y);
            { const int bb = row >> 8, key = row & 255; bf16* vt = WSP(bf16, WS_VMB) + ((size_t)(bb * 4 + h) * 128 + 2 * lane) * MEMLEN + key; vt[0] = (bf16)f2bf(vv.x); vt[MEMLEN] = (bf16)f2bf(vv.y); } }
        pg8::Gemm g{WSP(bf16, WS_HID), WSP(bf16, WS_WD1), T, 1024, DFF}; pg8::StaticOrder S; S.init(T, 1024, G, bx);
        pg8::EpiResid<true> E{ARG_IN(0), ap->out, WSP(bf16, WS_HB), WSP(float, WS_SSQ1), 0.5f};
        pg8::gemm_phase<pg8::EpiResid<true>, pg8::StaticOrder, true, true>(L + RING_OFF, g, S, E);
        GRID_BAR();
    }
#endif
#if (PHMASK >> 4) & 1
    {
        pg8::Gemm g{WSP(bf16, WS_HB), WSP(bf16, WS_WIN), T, NPROJ, 1024}; pg8::StaticOrder S; S.init(T, NPROJ, G, bx);
        pg8::ProjOut PO{WSP(bf16, WS_FQ), WSP(bf16, WS_FK), WSP(bf16, WS_FV), WSP(bf16, WS_DQ), WSP(bf16, WS_IQ), WSP(bf16, WS_MQ), WSP(bf16, WS_DK), WSP(bf16, WS_DV), WSP(bf16, WS_IK), WSP(float, WS_LOGF), WSP(float, WS_IW), WSP(float, WS_COS), WSP(float, WS_SIN), ARG_IN(11), ARG_IN(12), ARG_IN(13), ARG_IN(14), ARG_IN(10)};
        pg8::EpiProj<16> E{PO, WSP(float, WS_SSQ1), C2_64};
        pg8::gemm_phase<pg8::EpiProj<16>, pg8::StaticOrder, true, true>(L + RING_OFF, g, S, E);
        GRID_BAR();
#if defined(DBG_DUMP_AFTER) && DBG_DUMP_AFTER == 4
        {
            const bf16* sa = WSP(bf16, DBG_DUMP_A); const bf16* sb = WSP(bf16, DBG_DUMP_B);
            for (size_t e = (size_t)vcu * 512 + tid; e < (size_t)T * 512; e += (size_t)G * 512) { const size_t row = e >> 9, c = e & 511;
                ap->out[row * 1024 + c] = bf2f(sa[row * DBG_PITCH + c]); ap->out[row * 1024 + 512 + c] = bf2f(sb[row * DBG_PITCH + c]); }
            return;
        }
#endif

    }
#endif
#if ((PHMASK >> 5) & 1) && !DBG_SUBST
    {
        if (vcu < 16) scan_unit(vcu, WSP(float, WS_LOGF), WSP(float, WS_CUM), (LAS float*)(L + SCANX_OFF), tid);
        for (int it = gw; it < 2048; it += NGW) mem_unit(it >> 2, it & 3, WSP(bf16, WS_MQ), WSP(bf16, WS_KMB), WSP(bf16, WS_VMB), ARG_IN(15), lane);
        GRID_BAR();
    }
#endif
#if ((PHMASK >> 6) & 1) && !DBG_SUBST
    {
        for (int v = vcu; v < 256; v += G) { const int bh = v >> 4, s = v & 15;
            fox_unit(bh, s, WSP(bf16, WS_FQ), WSP(bf16, WS_FK), WSP(bf16, WS_FV), WSP(float, WS_CUM), wave, lane); fox_unit(bh, 31 - s, WSP(bf16, WS_FQ), WSP(bf16, WS_FK), WSP(bf16, WS_FV), WSP(float, WS_CUM), wave, lane); }
        for (int v = vcu; v < 256; v += G)
            for (int r = 0; r < 16; ++r) { const int b = r & 1, k = r >> 1; const int qg = (k < 4) ? k * 256 + v : 2047 - ((k - 4) * 256 + v);
                dsa_unit(b, qg, WSP(bf16, WS_IQ), WSP(bf16, WS_IK), WSP(float, WS_IW), WSP(bf16, WS_DQ), WSP(bf16, WS_DK), WSP(bf16, WS_DV), L, wave, lane); }
        GRID_BAR();
    }
#endif
#if (PHMASK >> 7) & 1
    {
        pg8::StaticOrder S; S.init(T, 1024, G, bx);
#pragma unroll 1
        for (int i = 0; i < DBG_NBR; ++i) {
#if DBG_GATE_AS_BRANCH
            {   pg8::Gemm g{WSP(bf16, WS_HB), WSP(bf16, DBG_GATE_W), T, 1024, 1024}; pg8::EpiBranch E{WSP(bf16, WS_GSCR), WSP(bf16, WS_MERGED), true, 1.0f}; pg8::gemm_phase<pg8::EpiBranch, pg8::StaticOrder, true, true>(L + RING_OFF, g, S, E); }
#elif !DBG_NOGATE
            {   pg8::Gemm g{WSP(bf16, WS_HB), WSP(bf16, DBG_GATE_W) + (size_t)i * 1024 * 1024, T, 1024, 1024}; pg8::EpiGate<16> E{WSP(bf16, WS_GSCR), WSP(float, WS_SSQ1)}; pg8::gemm_phase<pg8::EpiGate<16>, pg8::StaticOrder, true, true>(L + RING_OFF, g, S, E); }
#endif
#if !DBG_NOBRANCH
#if DBG_SUBST == 1
            {   const bf16* A = (i == 0) ? WSP(bf16, WS_FQ) : (i == 1) ? WSP(bf16, WS_DQ) : WSP(bf16, WS_IQ);
#elif DBG_SUBST == 2
            {   const bf16* A = (i == 0) ? WSP(bf16, WS_FK) : (i == 1) ? WSP(bf16, WS_FV) : WSP(bf16, WS_MQ);
#else
            {   const bf16* A = (i == 0) ? WSP(bf16, WS_FQ) : (i == 1) ? WSP(bf16, WS_DQ) : WSP(bf16, WS_MQ);
#endif
                pg8::Gemm g{A, WSP(bf16, WS_WBR) + (size_t)i * 1024 * 512, T, 1024, 512}; pg8::EpiBranch E{WSP(bf16, WS_GSCR), WSP(bf16, WS_MERGED), i == 0, ((DBG_BRANCH_MASK >> i) & 1) ? 1.0f : 0.0f}; pg8::gemm_phase<pg8::EpiBranch, pg8::StaticOrder, true, true>(L + RING_OFF, g, S, E); }
#endif
        }
        GRID_BAR();
#if defined(DBG_DUMP_AFTER) && DBG_DUMP_AFTER == 7
        {
            const bf16* sa = WSP(bf16, DBG_DUMP_A); const bf16* sb = WSP(bf16, DBG_DUMP_B);
            for (size_t e = (size_t)vcu * 512 + tid; e < (size_t)T * 512; e += (size_t)G * 512) { const size_t row = e >> 9, c = e & 511;
                ap->out[row * 1024 + c] = bf2f(sa[row * DBG_PITCH + c]); ap->out[row * 1024 + 512 + c] = bf2f(sb[row * DBG_PITCH + c]); }
            return;
        }
#endif

    }
#endif
#if (PHMASK >> 8) & 1
    {
        pg8::Gemm g{WSP(bf16, WS_MERGED), WSP(bf16, WS_WOUT), T, 1024, 1024}; pg8::StaticOrder S; S.init(T, 1024, G, bx);
        pg8::EpiResid<true> E{ap->out, ap->out, WSP(bf16, WS_HB), WSP(float, WS_SSQ2), 1.0f};
        pg8::gemm_phase<pg8::EpiResid<true>, pg8::StaticOrder, true, true>(L + RING_OFF, g, S, E);
        GRID_BAR();
    }
#endif
#if (PHMASK >> 9) & 1
    {
        pg8::Gemm g{WSP(bf16, WS_HB), WSP(bf16, WS_WGU2), T, 2 * DFF, 1024}; pg8::StaticOrder S; S.init(T, 2 * DFF, G, bx);
        pg8::EpiSwiGLU<16> E{WSP(bf16, WS_HID), DFF, WSP(float, WS_SSQ2)};
        pg8::gemm_phase<pg8::EpiSwiGLU<16>, pg8::StaticOrder, true, true>(L + RING_OFF, g, S, E);
        GRID_BAR();
    }
#endif
#if (PHMASK >> 10) & 1
    {
        pg8::Gemm g{WSP(bf16, WS_HID), WSP(bf16, WS_WD2), T, 1024, DFF}; pg8::StaticOrder S; S.init(T, 1024, G, bx);
        pg8::EpiResid<false> E{ap->out, ap->out, nullptr, nullptr, 0.5f};
        pg8::gemm_phase<pg8::EpiResid<false>, pg8::StaticOrder, true, true>(L + RING_OFF, g, S, E);
    }
#endif
}

extern "C" void kernel_launch(void* const* d_in, const int* in_sizes, int n_in, void* d_out, int out_size, void* d_ws, size_t ws_size, hipStream_t stream) {
    static int grid = 0;
    if (grid == 0) {
        if (n_in != 24 || out_size != T * DM || ws_size < WS_END) { fprintf(stderr, "kernel_launch: unexpected problem (n_in %d, out %d, ws %zu)\n", n_in, out_size, ws_size); grid = -1; return; }
        int dev = 0, cus = 0, per_cu = 0;
        if (hipGetDevice(&dev) != hipSuccess || hipDeviceGetAttribute(&cus, hipDeviceAttributeMultiprocessorCount, dev) != hipSuccess) { grid = -1; return; }
        if (hipFuncSetAttribute((const void*)fwd_mega, hipFuncAttributeMaxDynamicSharedMemorySize, LDS_BYTES) != hipSuccess) { fprintf(stderr, "kernel_launch: hipFuncSetAttribute failed\n"); grid = -1; return; }
        if (hipOccupancyMaxActiveBlocksPerMultiprocessor(&per_cu, (const void*)fwd_mega, NWAVES * 64, LDS_BYTES) != hipSuccess || per_cu < 1) { fprintf(stderr, "kernel_launch: occupancy query says %d blocks per CU\n", per_cu); (void)hipGetLastError(); grid = -1; return; }
        grid = cus;
    }
    if (grid < 0) return;
    (void)hipMemsetAsync((char*)d_ws + WS_CTL, 0, CTL_ZERO_BYTES, stream);
    Args a{};
    for (int i = 0; i < 24; ++i) a.in[i] = d_in[i];
    a.out = (float*)d_out; a.ws = (unsigned char*)d_ws;
    hipLaunchKernelGGL(fwd_mega, dim3(grid), dim3(NWAVES * 64), LDS_BYTES, stream, a);
}
```

```cpp
#include <hip/hip_runtime.h>
#include <cstdio>
#include <cstdint>
namespace pg8 {
#define PG8_LAS __attribute__((address_space(3)))
typedef unsigned short bf16_t;
typedef short bf16x8 __attribute__((ext_vector_type(8)));
typedef float f32x4 __attribute__((ext_vector_type(4)));
typedef unsigned u32x4 __attribute__((ext_vector_type(4)));
constexpr int BM = 256, BK = 64, HALF = 128, HTB = HALF * BK * 2  , STAGE_BYTES = 8 * HTB, NXCD = 8, WGM = 8;

__host__ __device__ __forceinline__ int lds_byte(int r, int c) { const int st = (r >> 4) * 2 + (c >> 5), rr = r & 15, cc = c & 31, ob = rr * 64 + cc * 2; return st * 1024 + (ob ^ (((ob >> 9) & 1) << 5)); }
__host__ __device__ __forceinline__ void stage_rc(int b, int& R, int& C) { const int st = b / 1024, sb = b % 1024, swz = sb ^ (((sb >> 9) & 1) << 5); R = (st >> 1) * 16 + swz / 64; C = (st & 1) * 32 + (swz % 64) / 2; }
__host__ __device__ __forceinline__ int perm32(int rho) { const int n = rho >> 4, i = rho & 15; return 8 * (i >> 2) + 4 * n + (i & 3); }

struct Unit { int pm, pn; };
struct Gemm { const bf16_t* A; const bf16_t* Bt; int M, N, K; };
template <int NS> __device__ __forceinline__ void wait_vm8(int relax) {
    if constexpr (NS == 0) asm volatile("s_waitcnt vmcnt(8)" ::: "memory");
    else asm volatile("s_cmp_eq_u32 %0, 0\n\ts_cbranch_scc1 .Lwv%=\n\ts_waitcnt vmcnt(%1)\n\ts_branch .Lwx%=\n.Lwv%=:\n\ts_waitcnt vmcnt(8)\n.Lwx%=:" :: "s"(__builtin_amdgcn_readfirstlane(relax)), "n"(8 + NS) : "memory", "scc");
}

struct StaticOrder {
    int nM, nN, nwg, G, c;
    __host__ __device__ void init(int M, int N, int G_, int c_) { nM = M / BM; nN = N / BM; nwg = nM * nN; G = G_; c = c_; }
    __host__ __device__ bool next(int i, Unit& u) const {
        const long L = (long)i * G + c; if (L >= nwg) return false;
        int wgid = (int)L; { const int q = nwg / NXCD, r = nwg % NXCD, xcd = wgid % NXCD, off = wgid / NXCD; wgid = (xcd < r ? xcd * (q + 1) : r * (q + 1) + (xcd - r) * q) + off; }
        const int nig = WGM * nN, gid = wgid / nig, fm = gid * WGM, gsz = (nM - fm) < WGM ? (nM - fm) : WGM;
        u.pm = fm + ((wgid % nig) % gsz); u.pn = (wgid % nig) / gsz; return true;
    }
    __device__ __forceinline__ void a_ready(const Unit&) const {}
    __device__ __forceinline__ void done(const Unit&) const {}
};

typedef float f32x2cv __attribute__((ext_vector_type(2))); typedef __bf16 bf16x2cv __attribute__((ext_vector_type(2)));
__device__ __forceinline__ unsigned cvt_pk_bf16(float lo, float hi) { const f32x2cv v = {lo, hi}; const bf16x2cv b = __builtin_convertvector(v, bf16x2cv); return __builtin_bit_cast(unsigned, b); }
typedef float f32x2 __attribute__((ext_vector_type(2)));
template <class Epi, class Sched, bool ALIGN_EPI = false, bool SP2 = false>
__device__ __forceinline__ void gemm_phase(PG8_LAS unsigned char* lds, const Gemm g, const Sched& S, const Epi& E) {
    int tid_ = threadIdx.x; asm volatile("" : "+v"(tid_));
    const int tid = tid_, wid = __builtin_amdgcn_readfirstlane(tid >> 6), lane = tid & 63, wr = wid >> 2, wc = wid & 3, fr = lane & 15, fq = lane >> 4;
    const int K = g.K, nt = K / BK;
    unsigned voffA[2], voffB[2];
#pragma unroll
    for (int i = 0; i < 2; ++i) { int R, C; stage_rc(tid * 16 + i * 8192, R, C); const int Rb = Epi::PERM ? ((R & ~31) + perm32(R & 31)) : R;
        voffA[i] = (unsigned)(R * K + C) * 2u; voffB[i] = (unsigned)(Rb * K + C) * 2u; }
    const size_t kstep = (size_t)(BK * 2);
    const size_t hstep = (size_t)HALF * K * 2;
    const size_t tstep = 2 * hstep;
    const unsigned ldsw = (unsigned)wid * 1024u;
    const int aoff = lds_byte(wr * 64 + fr, fq * 8), boff = lds_byte(wc * 32 + fr, fq * 8);
#define PG8_SA(b, h) (((b) * 2 + (h)) * HTB)
#define PG8_SB(b, h) ((4 + (b) * 2 + (h)) * HTB)
#define PG8_STAGE(bufoff, gbase, voff) do { _Pragma("unroll") for (int _i = 0; _i < 2; ++_i) \
        __builtin_amdgcn_global_load_lds((const unsigned*)((const char*)(gbase) + (voff)[_i]), (PG8_LAS unsigned*)(lds + (bufoff) + ldsw + _i * 8192), 16, 0, 0); } while (0)
#define PG8_LDA(dst, b, h) do { _Pragma("unroll") for (int m = 0; m < 4; ++m) _Pragma("unroll") for (int k = 0; k < 2; ++k) dst[m][k] = *(const PG8_LAS bf16x8*)(lds + PG8_SA(b, h) + aoff + m * 2048 + k * 1024); } while (0)
#define PG8_LDB(dst, b, h) do { _Pragma("unroll") for (int n = 0; n < 2; ++n) _Pragma("unroll") for (int k = 0; k < 2; ++k) dst[n][k] = *(const PG8_LAS bf16x8*)(lds + PG8_SB(b, h) + boff + n * 2048 + k * 1024); } while (0)
#define PG8_MMA(ai, bj, At, Bt) do { __builtin_amdgcn_s_setprio(1); _Pragma("unroll") for (int m = 0; m < 4; ++m) _Pragma("unroll") for (int n = 0; n < 2; ++n) _Pragma("unroll") for (int k = 0; k < 2; ++k) \
        acc[ai][bj][m][n] = __builtin_amdgcn_mfma_f32_16x16x32_bf16(Bt[n][k], At[m][k], acc[ai][bj][m][n], 0, 0, 0); __builtin_amdgcn_s_setprio(0); } while (0)
#define PG8_WAIT_V(n) asm volatile("s_waitcnt vmcnt(" #n ")" ::: "memory")
#define PG8_WAIT_L(n) asm volatile("s_waitcnt lgkmcnt(" #n ")" ::: "memory")
#define PG8_BAR __builtin_amdgcn_s_barrier()
#define PG8_SCHED __builtin_amdgcn_sched_barrier(0)
    Unit cur, nxt; int ui = 0;
    if (!S.next(0, cur)) return;
    f32x4 acc[2][2][4][2];
#pragma unroll
    for (int a = 0; a < 2; ++a)
#pragma unroll
        for (int b = 0; b < 2; ++b)
#pragma unroll
            for (int m = 0; m < 4; ++m)
#pragma unroll
                for (int n = 0; n < 2; ++n) acc[a][b][m][n] = (f32x4){0.f, 0.f, 0.f, 0.f};
    bf16x8 At[4][2], B0[2][2], B1[2][2];
    const char* cA = (const char*)g.A + (size_t)cur.pm * tstep; const char* cB = (const char*)g.Bt + (size_t)cur.pn * tstep;
    S.a_ready(cur);
    if constexpr (SP2) {
        PG8_STAGE(PG8_SB(0, 0), cB, voffB); PG8_STAGE(PG8_SB(0, 1), cB + hstep, voffB); PG8_STAGE(PG8_SA(0, 0), cA, voffA); PG8_STAGE(PG8_SA(0, 1), cA + hstep, voffA);
        if (wr == 1) PG8_BAR;
        PG8_WAIT_V(2); PG8_BAR;
        PG8_STAGE(PG8_SB(1, 0), cB + kstep, voffB); PG8_STAGE(PG8_SA(1, 0), cA + kstep, voffA); PG8_STAGE(PG8_SB(1, 1), cB + hstep + kstep, voffB);
        PG8_WAIT_V(6); PG8_BAR;
    } else {
        PG8_STAGE(PG8_SB(0, 0), cB, voffB); PG8_STAGE(PG8_SA(0, 0), cA, voffA); PG8_STAGE(PG8_SB(0, 1), cB + hstep, voffB); PG8_STAGE(PG8_SA(0, 1), cA + hstep, voffA);
        if (wr == 1) PG8_BAR;
        PG8_WAIT_V(4); PG8_BAR;
        PG8_STAGE(PG8_SB(1, 0), cB + kstep, voffB); PG8_STAGE(PG8_SA(1, 0), cA + kstep, voffA); PG8_STAGE(PG8_SB(1, 1), cB + hstep + kstep, voffB);
        PG8_WAIT_V(6); PG8_BAR;
    }
    for (;;) {
        const bool has_next = S.next(ui + 1, nxt);
        const char* nA = has_next ? (const char*)g.A + (size_t)nxt.pm * tstep : cA; const char* nB = has_next ? (const char*)g.Bt + (size_t)nxt.pn * tstep : cB;
        for (int t = 0; t < nt; t += 2) {
            const bool last = (t == nt - 2);
            const char* a1 = cA + (size_t)(t + 1) * kstep;
            const char* a2 = last ? nA : cA + (size_t)(t + 2) * kstep; const char* b2 = last ? nB : cB + (size_t)(t + 2) * kstep;
            const char* a3 = a2 + kstep; const char* b3 = b2 + kstep;
            if (last && has_next) S.a_ready(nxt);
            if constexpr (SP2) {
            const int relax = (Epi::NS > 0 && t == 0 && ui > 0) ? 1 : 0;
            PG8_LDB(B0, 0, 0); PG8_LDB(B1, 0, 1); PG8_SCHED; PG8_LDA(At, 0, 0); PG8_STAGE(PG8_SA(1, 1), a1 + hstep, voffA);
            wait_vm8<Epi::NS>(relax); PG8_WAIT_L(0); PG8_BAR; PG8_MMA(0, 0, At, B0); PG8_MMA(0, 1, At, B1); PG8_BAR; PG8_SCHED;
            PG8_LDA(At, 0, 1); PG8_STAGE(PG8_SB(0, 0), b2, voffB); PG8_STAGE(PG8_SB(0, 1), b2 + hstep, voffB); PG8_STAGE(PG8_SA(0, 0), a2, voffA);
            wait_vm8<Epi::NS>(relax); PG8_WAIT_L(0); PG8_BAR; PG8_MMA(1, 0, At, B0); PG8_MMA(1, 1, At, B1); PG8_BAR; PG8_SCHED;
            PG8_LDB(B0, 1, 0); PG8_LDB(B1, 1, 1); PG8_SCHED; PG8_LDA(At, 1, 0); PG8_STAGE(PG8_SA(0, 1), a2 + hstep, voffA);
            PG8_WAIT_V(8); PG8_WAIT_L(0); PG8_BAR; PG8_MMA(0, 0, At, B0); PG8_MMA(0, 1, At, B1); PG8_BAR; PG8_SCHED;
            PG8_LDA(At, 1, 1); PG8_STAGE(PG8_SB(1, 0), b3, voffB); PG8_STAGE(PG8_SB(1, 1), b3 + hstep, voffB); PG8_STAGE(PG8_SA(1, 0), a3, voffA);
            PG8_WAIT_V(8); PG8_WAIT_L(0); PG8_BAR; PG8_MMA(1, 0, At, B0); PG8_MMA(1, 1, At, B1); PG8_BAR; PG8_SCHED;
            } else {
            PG8_LDB(B0, 0, 0); PG8_SCHED; PG8_LDA(At, 0, 0); PG8_STAGE(PG8_SA(1, 1), a1 + hstep, voffA);
            PG8_WAIT_L(8); PG8_BAR; PG8_WAIT_L(0); PG8_MMA(0, 0, At, B0); PG8_BAR; PG8_SCHED;
            PG8_LDB(B1, 0, 1); PG8_STAGE(PG8_SB(0, 0), b2, voffB);
            PG8_BAR; PG8_WAIT_L(0); PG8_MMA(0, 1, At, B1); PG8_BAR;
            PG8_LDA(At, 0, 1); PG8_STAGE(PG8_SA(0, 0), a2, voffA);
            PG8_BAR; PG8_WAIT_L(0); PG8_MMA(1, 0, At, B0); PG8_BAR; PG8_SCHED;
            PG8_STAGE(PG8_SB(0, 1), b2 + hstep, voffB);
            PG8_WAIT_V(6); PG8_BAR; PG8_MMA(1, 1, At, B1); PG8_BAR;
            PG8_LDB(B0, 1, 0); PG8_SCHED; PG8_LDA(At, 1, 0); PG8_STAGE(PG8_SA(0, 1), a2 + hstep, voffA);
            PG8_WAIT_L(8); PG8_BAR; PG8_WAIT_L(0); PG8_MMA(0, 0, At, B0); PG8_BAR; PG8_SCHED;
            PG8_LDB(B1, 1, 1); PG8_STAGE(PG8_SB(1, 0), b3, voffB);
            PG8_BAR; PG8_WAIT_L(0); PG8_MMA(0, 1, At, B1); PG8_BAR;
            PG8_LDA(At, 1, 1); PG8_STAGE(PG8_SA(1, 0), a3, voffA);
            PG8_BAR; PG8_WAIT_L(0); PG8_MMA(1, 0, At, B0); PG8_BAR; PG8_SCHED;
            PG8_STAGE(PG8_SB(1, 1), b3 + hstep, voffB);
            PG8_WAIT_V(6); PG8_BAR; PG8_MMA(1, 1, At, B1); PG8_BAR;
            }
        }
        if constexpr (ALIGN_EPI) { if (wr == 0) PG8_BAR; }
        if constexpr (!Epi::AFTER_DRAIN) { E(acc, cur, wr, wc, fr, fq); S.done(cur); }
        if (!has_next) break;
#pragma unroll
        for (int a = 0; a < 2; ++a)
#pragma unroll
            for (int b = 0; b < 2; ++b)
#pragma unroll
                for (int m = 0; m < 4; ++m)
#pragma unroll
                    for (int n = 0; n < 2; ++n) acc[a][b][m][n] = (f32x4){0.f, 0.f, 0.f, 0.f};
        cur = nxt; cA = nA; cB = nB; ++ui;
        if constexpr (ALIGN_EPI) { if (wr == 1) PG8_BAR; }
    }
    PG8_WAIT_V(0);
    if constexpr (!ALIGN_EPI) { if (wr == 0) PG8_BAR; }
    PG8_BAR;
    if constexpr (Epi::AFTER_DRAIN) { E.fused(acc, cur, wr, wc, fr, fq, lds, wid, lane); S.done(cur); }
#undef PG8_SA
#undef PG8_SB
#undef PG8_STAGE
#undef PG8_LDA
#undef PG8_LDB
#undef PG8_MMA
#undef PG8_WAIT_V
#undef PG8_WAIT_L
#undef PG8_BAR
#undef PG8_SCHED
}

struct UnitX { int pm, pn, kind, round; };
struct OpsX { const char* A; const char* Bt; int K; };
template <class Epi, class Sched>
__device__ __forceinline__ void gemm_stream(PG8_LAS unsigned char* lds, const Sched& S, const Epi& E) {
    int tid_ = threadIdx.x; asm volatile("" : "+v"(tid_));
    const int tid = tid_, wid = __builtin_amdgcn_readfirstlane(tid >> 6), lane = tid & 63, wr = wid >> 2, wc = wid & 3, fr = lane & 15, fq = lane >> 4;
    unsigned rA[2], rB[2], c2[2];
#pragma unroll
    for (int i = 0; i < 2; ++i) { int R, C; stage_rc(tid * 16 + i * 8192, R, C); rA[i] = (unsigned)R; rB[i] = (unsigned)((R & ~31) + perm32(R & 31)); c2[i] = (unsigned)C * 2u; }
    const size_t kstep = (size_t)(BK * 2);
    const unsigned ldsw = (unsigned)wid * 1024u;
    const int aoff = lds_byte(wr * 64 + fr, fq * 8), boff = lds_byte(wc * 32 + fr, fq * 8);
#define PG8_SA(b, h) (((b) * 2 + (h)) * HTB)
#define PG8_SB(b, h) ((4 + (b) * 2 + (h)) * HTB)
#define PGX_STAGE(bufoff, gbase, rr, pb) do { _Pragma("unroll") for (int _i = 0; _i < 2; ++_i) \
        __builtin_amdgcn_global_load_lds((const unsigned*)((const char*)(gbase) + ((rr)[_i] * (pb) + c2[_i])), (PG8_LAS unsigned*)(lds + (bufoff) + ldsw + _i * 8192), 16, 0, 0); } while (0)
#define PG8_LDA(dst, b, h) do { _Pragma("unroll") for (int m = 0; m < 4; ++m) _Pragma("unroll") for (int k = 0; k < 2; ++k) dst[m][k] = *(const PG8_LAS bf16x8*)(lds + PG8_SA(b, h) + aoff + m * 2048 + k * 1024); } while (0)
#define PG8_LDB(dst, b, h) do { _Pragma("unroll") for (int n = 0; n < 2; ++n) _Pragma("unroll") for (int k = 0; k < 2; ++k) dst[n][k] = *(const PG8_LAS bf16x8*)(lds + PG8_SB(b, h) + boff + n * 2048 + k * 1024); } while (0)
#define PG8_MMA(ai, bj, At, Bt) do { __builtin_amdgcn_s_setprio(1); _Pragma("unroll") for (int m = 0; m < 4; ++m) _Pragma("unroll") for (int n = 0; n < 2; ++n) _Pragma("unroll") for (int k = 0; k < 2; ++k) \
        acc[ai][bj][m][n] = __builtin_amdgcn_mfma_f32_16x16x32_bf16(Bt[n][k], At[m][k], acc[ai][bj][m][n], 0, 0, 0); __builtin_amdgcn_s_setprio(0); } while (0)
#define PG8_WAIT_V(n) asm volatile("s_waitcnt vmcnt(" #n ")" ::: "memory")
#define PG8_WAIT_L(n) asm volatile("s_waitcnt lgkmcnt(" #n ")" ::: "memory")
#define PG8_BAR __builtin_amdgcn_s_barrier()
#define PG8_SCHED __builtin_amdgcn_sched_barrier(0)
    UnitX cur, nxt; int ui = 0;
    if (!S.next(0, cur)) return;
    f32x4 acc[2][2][4][2];
#pragma unroll
    for (int a = 0; a < 2; ++a)
#pragma unroll
        for (int b = 0; b < 2; ++b)
#pragma unroll
            for (int m = 0; m < 4; ++m)
#pragma unroll
                for (int n = 0; n < 2; ++n) acc[a][b][m][n] = (f32x4){0.f, 0.f, 0.f, 0.f};
    bf16x8 At[4][2], B0[2][2], B1[2][2];
    OpsX oc = S.ops(cur);
    const char* cA = oc.A; const char* cB = oc.Bt; int Kc = oc.K;
    {   const unsigned pb = (unsigned)Kc * 2u; const size_t hstep = (size_t)HALF * pb;
        PGX_STAGE(PG8_SB(0, 0), cB, rB, pb); PGX_STAGE(PG8_SB(0, 1), cB + hstep, rB, pb); PGX_STAGE(PG8_SA(0, 0), cA, rA, pb); PGX_STAGE(PG8_SA(0, 1), cA + hstep, rA, pb);
        if (wr == 1) PG8_BAR;
        PG8_WAIT_V(2); PG8_BAR;
        PGX_STAGE(PG8_SB(1, 0), cB + kstep, rB, pb); PGX_STAGE(PG8_SA(1, 0), cA + kstep, rA, pb); PGX_STAGE(PG8_SB(1, 1), cB + hstep + kstep, rB, pb);
        PG8_WAIT_V(6); PG8_BAR; }
    for (;;) {
        const bool has_next = S.next(ui + 1, nxt);
        OpsX on = oc; if (has_next) on = S.ops(nxt);
        const char* nA = on.A; const char* nB = on.Bt; const int Kn = on.K;
        const int nt = Kc / BK; const unsigned pbc = (unsigned)Kc * 2u; const size_t hstep = (size_t)HALF * pbc;
        for (int t = 0; t < nt; t += 2) {
            const bool last = (t == nt - 2);
            const char* a1 = cA + (size_t)(t + 1) * kstep;
            const char* a2 = last ? nA : cA + (size_t)(t + 2) * kstep; const char* b2 = last ? nB : cB + (size_t)(t + 2) * kstep;
            const char* a3 = a2 + kstep; const char* b3 = b2 + kstep;
            const unsigned pb2 = last ? (unsigned)Kn * 2u : pbc; const size_t h2 = (size_t)HALF * pb2;
            const int relax = (Epi::NS > 0 && t == 0 && ui > 0) ? 1 : 0;
            PG8_LDB(B0, 0, 0); PG8_LDB(B1, 0, 1); PG8_SCHED; PG8_LDA(At, 0, 0); PGX_STAGE(PG8_SA(1, 1), a1 + hstep, rA, pbc);
            wait_vm8<Epi::NS>(relax); PG8_WAIT_L(0); PG8_BAR; PG8_MMA(0, 0, At, B0); PG8_MMA(0, 1, At, B1); PG8_BAR; PG8_SCHED;
            PG8_LDA(At, 0, 1); PGX_STAGE(PG8_SB(0, 0), b2, rB, pb2); PGX_STAGE(PG8_SB(0, 1), b2 + h2, rB, pb2); PGX_STAGE(PG8_SA(0, 0), a2, rA, pb2);
            wait_vm8<Epi::NS>(relax); PG8_WAIT_L(0); PG8_BAR; PG8_MMA(1, 0, At, B0); PG8_MMA(1, 1, At, B1); PG8_BAR; PG8_SCHED;
            PG8_LDB(B0, 1, 0); PG8_LDB(B1, 1, 1); PG8_SCHED; PG8_LDA(At, 1, 0); PGX_STAGE(PG8_SA(0, 1), a2 + h2, rA, pb2);
            PG8_WAIT_V(8); PG8_WAIT_L(0); PG8_BAR; PG8_MMA(0, 0, At, B0); PG8_MMA(0, 1, At, B1); PG8_BAR; PG8_SCHED;
            PG8_LDA(At, 1, 1); PGX_STAGE(PG8_SB(1, 0), b3, rB, pb2); PGX_STAGE(PG8_SB(1, 1), b3 + h2, rB, pb2); PGX_STAGE(PG8_SA(1, 0), a3, rA, pb2);
            PG8_WAIT_V(8); PG8_WAIT_L(0); PG8_BAR; PG8_MMA(1, 0, At, B0); PG8_MMA(1, 1, At, B1); PG8_BAR; PG8_SCHED;
        }
        if (wr == 0) PG8_BAR;
        E(acc, cur, wr, wc, fr, fq);
        if (!has_next) break;
#pragma unroll
        for (int a = 0; a < 2; ++a)
#pragma unroll
            for (int b = 0; b < 2; ++b)
#pragma unroll
                for (int m = 0; m < 4; ++m)
#pragma unroll
                    for (int n = 0; n < 2; ++n) acc[a][b][m][n] = (f32x4){0.f, 0.f, 0.f, 0.f};
        cur = nxt; oc = on; cA = nA; cB = nB; Kc = Kn; ++ui;
        if (wr == 1) PG8_BAR;
    }
    PG8_WAIT_V(0);
    PG8_BAR;
#undef PG8_SA
#undef PG8_SB
#undef PGX_STAGE
#undef PG8_LDA
#undef PG8_LDB
#undef PG8_MMA
#undef PG8_WAIT_V
#undef PG8_WAIT_L
#undef PG8_BAR
#undef PG8_SCHED
}
}
namespace pg8 {
constexpr int TOK = 16384;
constexpr float RMS_EPS = 1e-6f;
typedef float f32x2e __attribute__((ext_vector_type(2)));
template <int NP> __device__ __forceinline__ void row_scales(const float* src, int rowbase, int lane, int fr, float (&r)[2][4]) {
#pragma unroll
    for (int ai = 0; ai < 2; ++ai) {
        const int row = rowbase + 128 * ai + lane; float v;
        if (NP == 0) v = src[row];
        else { float s = 0.f;
#pragma unroll
            for (int p = 0; p < NP; ++p) s += src[(size_t)p * TOK + row];
            v = __builtin_amdgcn_rsqf(s * (1.0f / 1024.0f) + RMS_EPS); }
#pragma unroll
        for (int m = 0; m < 4; ++m) r[ai][m] = __shfl(v, 16 * m + fr);
    }
}
template <int NP, class Sched> __device__ __forceinline__ void build_row_tab(const float* src, const Sched& S, PG8_LAS float* tab) {
    Unit u;
    for (int i = 0; S.next(i, u); ++i)
        for (int r = (int)threadIdx.x; r < 256; r += 512) { const int row = u.pm * BM + r; float v;
            if (NP == 0) v = src[row];
            else { float s = 0.f;
#pragma unroll
                for (int p = 0; p < NP; ++p) s += src[(size_t)p * TOK + row];
                v = __builtin_amdgcn_rsqf(s * (1.0f / 1024.0f) + RMS_EPS); }
            tab[i * 256 + r] = v; }
    __syncthreads();
}
__device__ __forceinline__ void row_scales_tab(const PG8_LAS float* tab, int ui, int wr, int fr, float (&r)[2][4]) {
#pragma unroll
    for (int ai = 0; ai < 2; ++ai)
#pragma unroll
        for (int m = 0; m < 4; ++m) r[ai][m] = tab[ui * 256 + ai * 128 + wr * 64 + 16 * m + fr];
}
__device__ __forceinline__ float silu_f(float x) { return x * __builtin_amdgcn_rcpf(1.0f + __expf(-x)); }
__device__ __forceinline__ float sigmoid_f(float x) { return __builtin_amdgcn_rcpf(1.0f + __expf(-x)); }

template <int NP> struct EpiSwiGLU {
    static constexpr int NS = 8;
    static constexpr bool PERM = true, AFTER_DRAIN = false;
    bf16_t* H; int ldh; const PG8_LAS float* tab; mutable int ui = 0;
    __device__ __forceinline__ void operator()(const f32x4 (&acc)[2][2][4][2], const Unit& u, int wr, int wc, int fr0, int fq0) const {
        int fr = fr0, fq = fq0; asm volatile("" : "+v"(fr), "+v"(fq));
        float r[2][4]; row_scales_tab(tab, ui++, wr, fr, r);
        const int col0 = u.pn * 128 + wc * 32 + 8 * fq;
#pragma unroll
        for (int ai = 0; ai < 2; ++ai)
#pragma unroll
            for (int m = 0; m < 4; ++m) {
                const int row = u.pm * BM + ai * HALF + wr * 64 + m * 16 + fr; const float rr = r[ai][m];
                float o[8];
#pragma unroll
                for (int n = 0; n < 2; ++n)
#pragma unroll
                    for (int j = 0; j < 4; ++j) { const float g = acc[ai][0][m][n][j] * rr, up = acc[ai][1][m][n][j] * rr; o[4 * n + j] = silu_f(g) * up; }
                u32x4 w; w.x = cvt_pk_bf16(o[0], o[1]); w.y = cvt_pk_bf16(o[2], o[3]); w.z = cvt_pk_bf16(o[4], o[5]); w.w = cvt_pk_bf16(o[6], o[7]);
                *(u32x4*)(H + (size_t)row * ldh + col0) = w;
            }
    }
};
template <bool WRITE_HB> struct EpiResid {
    static constexpr int NS = 0;
    static constexpr bool PERM = true, AFTER_DRAIN = false;
    const float* base; float* out; bf16_t* hb; float* part; float sc;
    __device__ __forceinline__ void operator()(const f32x4 (&acc)[2][2][4][2], const Unit& u, int wr, int wc, int fr0, int fq0) const {
        int fr = fr0, fq = fq0; asm volatile("" : "+v"(fr), "+v"(fq));
        const int col0 = u.pn * BM + wc * 32 + 8 * fq;
#pragma unroll
        for (int ai = 0; ai < 2; ++ai)
#pragma unroll
            for (int m = 0; m < 4; ++m) {
                const int row = u.pm * BM + ai * HALF + wr * 64 + m * 16 + fr; float ss = 0.f;
#pragma unroll
                for (int bj = 0; bj < 2; ++bj) {
                    const size_t off = (size_t)row * 1024 + col0 + bj * HALF;
                    const f32x4 b0 = *(const f32x4*)(base + off), b1 = *(const f32x4*)(base + off + 4);
                    const f32x4 o0 = b0 + acc[ai][bj][m][0] * sc, o1 = b1 + acc[ai][bj][m][1] * sc;
                    *(f32x4*)(out + off) = o0; *(f32x4*)(out + off + 4) = o1;
                    if (WRITE_HB) {
                        ss += (o0[0] * o0[0] + o0[1] * o0[1]) + (o0[2] * o0[2] + o0[3] * o0[3]) + (o1[0] * o1[0] + o1[1] * o1[1]) + (o1[2] * o1[2] + o1[3] * o1[3]);
                        u32x4 w; w.x = cvt_pk_bf16(o0[0], o0[1]); w.y = cvt_pk_bf16(o0[2], o0[3]); w.z = cvt_pk_bf16(o1[0], o1[1]); w.w = cvt_pk_bf16(o1[2], o1[3]);
                        *(u32x4*)(hb + off) = w; }
                }
                if (WRITE_HB) { ss += __shfl_xor(ss, 16); ss += __shfl_xor(ss, 32); if (fq == 0) part[(size_t)(u.pn * 4 + wc) * TOK + row] = ss; }
                if (m == 3) asm volatile("" ::: "memory");
            }
    }
};
template <bool WRITE_HB> struct EpiResid2 {
    static constexpr int NS = 0;
    static constexpr bool PERM = true, AFTER_DRAIN = false;
    const float* base; float* out; bf16_t* hb; float* part; float sc;
    __device__ __forceinline__ void operator()(const f32x4 (&acc)[2][2][4][2], const Unit& u, int wr, int wc, int fr0, int fq0) const {
        int fr = fr0, fq = fq0; asm volatile("" : "+v"(fr), "+v"(fq));
        const int row0 = u.pm * BM + wr * 64 + fr; const size_t o00 = (size_t)row0 * 1024 + u.pn * BM + wc * 32 + 8 * fq;
        const float* bp = base + o00; float* op = out + o00; bf16_t* hp = hb + o00;
        f32x4 bq[2][8];
#define ER2_ISSUE(G, B) do { _Pragma("unroll") for (int c = 0; c < 8; ++c) { const int ai = (G) >> 1, m = 2 * ((G) & 1) + (c >> 2), bj = (c >> 1) & 1, n = c & 1; \
            bq[B][c] = *(const f32x4*)(bp + (size_t)(ai * 128 + m * 16) * 1024 + bj * 128 + 4 * n); } } while (0)
        ER2_ISSUE(0, 0);
#pragma unroll
        for (int G = 0; G < 4; ++G) {
            if (G + 1 < 4) { if ((G & 1) == 0) ER2_ISSUE(G + 1, 1); else ER2_ISSUE(G + 1, 0); }
            asm volatile("" ::: "memory");
#pragma unroll
            for (int mm = 0; mm < 2; ++mm) { const int ai = G >> 1, m = 2 * (G & 1) + mm; float ss = 0.f;
#pragma unroll
                for (int bj = 0; bj < 2; ++bj) { const size_t off = (size_t)(ai * 128 + m * 16) * 1024 + bj * 128;
                    const f32x4 o0 = bq[G & 1][mm * 4 + bj * 2] + acc[ai][bj][m][0] * sc, o1 = bq[G & 1][mm * 4 + bj * 2 + 1] + acc[ai][bj][m][1] * sc;
                    *(f32x4*)(op + off) = o0; *(f32x4*)(op + off + 4) = o1;
                    if (WRITE_HB) {
                        ss += (o0[0] * o0[0] + o0[1] * o0[1]) + (o0[2] * o0[2] + o0[3] * o0[3]) + (o1[0] * o1[0] + o1[1] * o1[1]) + (o1[2] * o1[2] + o1[3] * o1[3]);
                        u32x4 w; w.x = cvt_pk_bf16(o0[0], o0[1]); w.y = cvt_pk_bf16(o0[2], o0[3]); w.z = cvt_pk_bf16(o1[0], o1[1]); w.w = cvt_pk_bf16(o1[2], o1[3]);
                        *(u32x4*)(hp + off) = w; } }
                if (WRITE_HB) { ss += __shfl_xor(ss, 16); ss += __shfl_xor(ss, 32); if (fq == 0) part[(size_t)(u.pn * 4 + wc) * TOK + row0 + ai * 128 + m * 16] = ss; } }
            asm volatile("" ::: "memory");
        }
#undef ER2_ISSUE
    }
};
struct EpiMemKV {
    static constexpr int NS = 0;
    static constexpr bool PERM = true, AFTER_DRAIN = false;
    float* KV; const float* rs;
    __device__ __forceinline__ void operator()(const f32x4 (&acc)[2][2][4][2], const Unit& u, int wr, int wc, int fr0, int fq0) const {
        int fr = fr0, fq = fq0; asm volatile("" : "+v"(fr), "+v"(fq));
        float r[2][4]; row_scales<0>(rs, u.pm * BM + wr * 64, (int)(threadIdx.x & 63), fr, r);
        const int col0 = u.pn * BM + wc * 32 + 8 * fq;
#pragma unroll
        for (int ai = 0; ai < 2; ++ai)
#pragma unroll
            for (int m = 0; m < 4; ++m) { const int row = u.pm * BM + ai * HALF + wr * 64 + m * 16 + fr;
#pragma unroll
                for (int bj = 0; bj < 2; ++bj) { const size_t off = (size_t)row * 1024 + col0 + bj * HALF;
                    *(f32x4*)(KV + off) = acc[ai][bj][m][0] * r[ai][m]; *(f32x4*)(KV + off + 4) = acc[ai][bj][m][1] * r[ai][m]; } }
    }
};
template <int NP> struct EpiGate {
    static constexpr int NS = 16;
    static constexpr bool PERM = true, AFTER_DRAIN = false;
    bf16_t* scr; const PG8_LAS float* tab; mutable int ui = 0;
    __device__ __forceinline__ void operator()(const f32x4 (&acc)[2][2][4][2], const Unit& u, int wr, int wc, int fr0, int fq0) const {
        int fr = fr0, fq = fq0; asm volatile("" : "+v"(fr), "+v"(fq));
        float r[2][4];
#ifdef DBG_GATE_NOSCALE
        for (int a_ = 0; a_ < 2; ++a_) for (int m_ = 0; m_ < 4; ++m_) r[a_][m_] = 1.0f;
#else
        row_scales_tab(tab, ui++, wr, fr, r);
#endif
        bf16_t* t = scr + (size_t)(u.pm * 4 + u.pn) * 65536;
#pragma unroll
        for (int ai = 0; ai < 2; ++ai)
#pragma unroll
            for (int m = 0; m < 4; ++m) { const int lr = ai * HALF + wr * 64 + m * 16 + fr; const float rr = r[ai][m];
#pragma unroll
                for (int bj = 0; bj < 2; ++bj) { float o[8];
#pragma unroll
                    for (int n = 0; n < 2; ++n)
#pragma unroll
                        for (int j = 0; j < 4; ++j) o[4 * n + j] = sigmoid_f(acc[ai][bj][m][n][j] * rr);
                    u32x4 w; w.x = cvt_pk_bf16(o[0], o[1]); w.y = cvt_pk_bf16(o[2], o[3]); w.z = cvt_pk_bf16(o[4], o[5]); w.w = cvt_pk_bf16(o[6], o[7]);
                    *(u32x4*)(t + lr * 256 + bj * HALF + wc * 32 + 8 * fq) = w; } }
    }
};
__device__ __forceinline__ float bf_lo(unsigned w) { return __uint_as_float(w << 16); }
__device__ __forceinline__ float bf_hi(unsigned w) { return __uint_as_float(w & 0xffff0000u); }
struct EpiBranch {
    static constexpr int NS = 0;
    static constexpr bool PERM = true, AFTER_DRAIN = false;
    const bf16_t* scr; bf16_t* mg; bool first; float bscale;
    __device__ __forceinline__ void operator()(const f32x4 (&acc)[2][2][4][2], const Unit& u, int wr, int wc, int fr0, int fq0) const {
        int fr = fr0, fq = fq0; asm volatile("" : "+v"(fr), "+v"(fq));
        const bf16_t* t = scr + (size_t)(u.pm * 4 + u.pn) * 65536;
        __builtin_amdgcn_fence(__ATOMIC_ACQUIRE, "agent");
        asm volatile("s_waitcnt vmcnt(0)" ::: "memory");
#pragma unroll
        for (int ai = 0; ai < 2; ++ai)
#pragma unroll
            for (int m = 0; m < 4; ++m) { const int lr = ai * HALF + wr * 64 + m * 16 + fr; const int row = u.pm * BM + lr;
#pragma unroll
                for (int bj = 0; bj < 2; ++bj) { const int lc = bj * HALF + wc * 32 + 8 * fq;
#if defined(DBG_NOGATE) && DBG_NOGATE
                    const u32x4 g = (u32x4){0x3f803f80u, 0x3f803f80u, 0x3f803f80u, 0x3f803f80u};
#else
                    const u32x4 g = *(const u32x4*)(t + lr * 256 + lc);
#endif
                    bf16_t* mp = mg + (size_t)row * 1024 + u.pn * BM + lc;
                    float o[8];
                    o[0] = bf_lo(g.x) * acc[ai][bj][m][0][0]; o[1] = bf_hi(g.x) * acc[ai][bj][m][0][1]; o[2] = bf_lo(g.y) * acc[ai][bj][m][0][2]; o[3] = bf_hi(g.y) * acc[ai][bj][m][0][3];
                    o[4] = bf_lo(g.z) * acc[ai][bj][m][1][0]; o[5] = bf_hi(g.z) * acc[ai][bj][m][1][1]; o[6] = bf_lo(g.w) * acc[ai][bj][m][1][2]; o[7] = bf_hi(g.w) * acc[ai][bj][m][1][3];
#ifdef DBG_BRANCH_SIGMOID
#pragma unroll
                    for (int e = 0; e < 8; ++e) o[e] = DBG_NONLIN(o[e]);
#endif
#pragma unroll
                    for (int e = 0; e < 8; ++e) o[e] *= bscale;
                    if (!first) { const u32x4 p = *(const u32x4*)mp;
                        o[0] += bf_lo(p.x); o[1] += bf_hi(p.x); o[2] += bf_lo(p.y); o[3] += bf_hi(p.y); o[4] += bf_lo(p.z); o[5] += bf_hi(p.z); o[6] += bf_lo(p.w); o[7] += bf_hi(p.w); }
                    u32x4 w; w.x = cvt_pk_bf16(o[0], o[1]); w.y = cvt_pk_bf16(o[2], o[3]); w.z = cvt_pk_bf16(o[4], o[5]); w.w = cvt_pk_bf16(o[6], o[7]);
                    *(u32x4*)mp = w; }
                if (m & 1) asm volatile("" ::: "memory"); }
    }
};
template <bool FIRST> struct EpiBranch2 {
    const bf16_t* scr; bf16_t* mg;
    __device__ __forceinline__ void operator()(const f32x4 (&acc)[2][2][4][2], const Unit& u, int wr, int wc, int fr0, int fq0) const {
        int fr = fr0, fq = fq0; asm volatile("" : "+v"(fr), "+v"(fq));
        const bf16_t* t = scr + (size_t)(u.pm * 4 + u.pn) * 65536 + (wr * 64 + fr) * 256 + wc * 32 + 8 * fq;
        bf16_t* mp0 = mg + (size_t)(u.pm * BM + wr * 64 + fr) * 1024 + u.pn * BM + wc * 32 + 8 * fq;
        u32x4 gq[2][4], pq[2][4];
#define EB2_ISSUE(G, B) do { _Pragma("unroll") for (int c = 0; c < 4; ++c) { const int ai = (G) >> 1, m = 2 * ((G) & 1) + (c >> 1), bj = c & 1; \
            gq[B][c] = *(const u32x4*)(t + (ai * 128 + m * 16) * 256 + bj * 128); if (!FIRST) pq[B][c] = *(const u32x4*)(mp0 + (size_t)(ai * 128 + m * 16) * 1024 + bj * 128); } } while (0)
        EB2_ISSUE(0, 0);
#pragma unroll
        for (int G = 0; G < 4; ++G) {
            if (G + 1 < 4) { if ((G & 1) == 0) EB2_ISSUE(G + 1, 1); else EB2_ISSUE(G + 1, 0); }
            asm volatile("" ::: "memory");
#pragma unroll
            for (int c = 0; c < 4; ++c) { const int ai = G >> 1, m = 2 * (G & 1) + (c >> 1), bj = c & 1; const u32x4 g = gq[G & 1][c];
                float o[8];
                o[0] = bf_lo(g.x) * acc[ai][bj][m][0][0]; o[1] = bf_hi(g.x) * acc[ai][bj][m][0][1]; o[2] = bf_lo(g.y) * acc[ai][bj][m][0][2]; o[3] = bf_hi(g.y) * acc[ai][bj][m][0][3];
                o[4] = bf_lo(g.z) * acc[ai][bj][m][1][0]; o[5] = bf_hi(g.z) * acc[ai][bj][m][1][1]; o[6] = bf_lo(g.w) * acc[ai][bj][m][1][2]; o[7] = bf_hi(g.w) * acc[ai][bj][m][1][3];
                if (!FIRST) { const u32x4 p = pq[G & 1][c];
                    o[0] += bf_lo(p.x); o[1] += bf_hi(p.x); o[2] += bf_lo(p.y); o[3] += bf_hi(p.y); o[4] += bf_lo(p.z); o[5] += bf_hi(p.z); o[6] += bf_lo(p.w); o[7] += bf_hi(p.w); }
                u32x4 w; w.x = cvt_pk_bf16(o[0], o[1]); w.y = cvt_pk_bf16(o[2], o[3]); w.z = cvt_pk_bf16(o[4], o[5]); w.w = cvt_pk_bf16(o[6], o[7]);
                *(u32x4*)(mp0 + (size_t)(ai * 128 + m * 16) * 1024 + bj * 128) = w; }
            asm volatile("" ::: "memory");
        }
#undef EB2_ISSUE
    }
};
template <size_t O_HB, size_t O_WG, size_t O_A0, size_t O_A1, size_t O_A2, size_t O_WB> struct P7Order {
    StaticOrder T; const char* ws;
    __device__ __forceinline__ bool next(int i, UnitX& u) const { const int rd = i / 6; Unit t; if (!T.next(rd, t)) return false; u.pm = t.pm; u.pn = t.pn; u.kind = i - 6 * rd; u.round = rd; return true; }
    __device__ __forceinline__ OpsX ops(const UnitX& u) const { const int j = u.kind >> 1; OpsX o;
        if (u.kind & 1) { o.K = 512; o.A = ws + (j == 0 ? O_A0 : j == 1 ? O_A1 : O_A2) + (size_t)u.pm * (256 * 512 * 2); o.Bt = ws + O_WB + (size_t)j * (1024 * 512 * 2) + (size_t)u.pn * (256 * 512 * 2); }
        else { o.K = 1024; o.A = ws + O_HB + (size_t)u.pm * (256 * 1024 * 2); o.Bt = ws + O_WG + (size_t)j * (1024 * 1024 * 2) + (size_t)u.pn * (256 * 1024 * 2); }
        return o; }
};
struct EpiP7 {
    static constexpr int NS = 16;
    bf16_t* scr; bf16_t* mg; const PG8_LAS float* tab;
    __device__ __forceinline__ void operator()(const f32x4 (&acc)[2][2][4][2], const UnitX& u, int wr, int wc, int fr, int fq) const {
        const Unit uu{u.pm, u.pn};
        if (u.kind == 1) { const EpiBranch2<true> b{scr, mg}; b(acc, uu, wr, wc, fr, fq); }
        else if (u.kind & 1) { const EpiBranch2<false> b{scr, mg}; b(acc, uu, wr, wc, fr, fq); }
        else { const EpiGate<16> g{scr, tab, u.round}; g(acc, uu, wr, wc, fr, fq); }
    }
};
struct ProjOut { bf16_t *FQ, *FK, *FV, *DQ, *IQ, *MQ, *DK, *DV, *IK; float *LOGF, *IW; const float *cosT, *sinT, *g_fq, *g_fk, *g_dq, *g_dk, *b_forget; };
__device__ __forceinline__ float log_sigmoid_f(float z) { return z >= 0.f ? -log1pf(expf(-z)) : z - log1pf(expf(z)); }
template <int NP> struct EpiProj {
    static constexpr int NS = 0;
    static constexpr bool PERM = true, AFTER_DRAIN = false;
    ProjOut P; const PG8_LAS float* tab; float qscale; mutable int ui = 0;
    __device__ __forceinline__ void operator()(const f32x4 (&acc)[2][2][4][2], const Unit& u, int wr, int wc, int fr0, int fq0) const {
        int fr = fr0, fq = fq0; asm volatile("" : "+v"(fr), "+v"(fq));
        float r[2][4]; row_scales_tab(tab, ui++, wr, fr, r);
        const int pn = u.pn;
        bool do_norm = false, do_rope = false; const float* gain = nullptr; bf16_t* dst = nullptr; int pitch = 512, hoff = 0; float osc = 1.f;
        if (pn < 2)       { do_norm = true; gain = P.g_fq; dst = P.FQ; hoff = (4 * pn + wc) * 64; osc = qscale; }
        else if (pn < 4)  { do_norm = true; gain = P.g_fk; dst = P.FK; hoff = (4 * (pn - 2) + wc) * 64; }
        else if (pn < 6)  { dst = P.FV; hoff = (4 * (pn - 4) + wc) * 64; }
        else if (pn < 8)  { do_norm = true; do_rope = true; gain = P.g_dq; dst = P.DQ; hoff = (4 * (pn - 6) + wc) * 64; osc = qscale; }
        else if (pn < 10) { do_rope = true; dst = P.IQ; hoff = (4 * (pn - 8) + wc) * 64; }
        else if (pn < 12) { dst = P.MQ; hoff = (2 * (pn - 10) + (wc >> 1)) * 128 + (wc & 1) * 64; }
        else { pitch = 64;
            if (wc == 0)      { do_norm = true; do_rope = true; gain = P.g_dk; dst = P.DK; }
            else if (wc == 1) { dst = P.DV; }
            else if (wc == 2) { do_rope = true; dst = P.IK; }
            else dst = nullptr; }
        if (dst == nullptr) {
            if (fq < 2) {
#pragma unroll
                for (int ai = 0; ai < 2; ++ai)
#pragma unroll
                    for (int m = 0; m < 4; ++m) { const int row = u.pm * BM + ai * HALF + wr * 64 + m * 16 + fr; const float rr = r[ai][m];
                        f32x4 v0 = acc[ai][0][m][0] * rr, v1 = acc[ai][0][m][1] * rr;
                        if (fq == 0) {
                            const f32x4 b0 = *(const f32x4*)(P.b_forget), b1 = *(const f32x4*)(P.b_forget + 4);
#pragma unroll
                            for (int j = 0; j < 4; ++j) { v0[j] = log_sigmoid_f(v0[j] + b0[j]); v1[j] = log_sigmoid_f(v1[j] + b1[j]); }
                            *(f32x4*)(P.LOGF + (size_t)row * 8) = v0; *(f32x4*)(P.LOGF + (size_t)row * 8 + 4) = v1;
                        } else { const float c = 0.04419417382f; *(f32x4*)(P.IW + (size_t)row * 8) = v0 * c; *(f32x4*)(P.IW + (size_t)row * 8 + 4) = v1 * c; } }
            }
            return;
        }
        f32x4 gv[2][2];
        if (do_norm) {
#pragma unroll
            for (int bj = 0; bj < 2; ++bj)
#pragma unroll
                for (int n = 0; n < 2; ++n) gv[bj][n] = *(const f32x4*)(gain + bj * 32 + 8 * fq + 4 * n);
        }
#pragma unroll
        for (int ai = 0; ai < 2; ++ai)
#pragma unroll
            for (int m = 0; m < 4; ++m) {
                const int row = u.pm * BM + ai * HALF + wr * 64 + m * 16 + fr; const float rr = r[ai][m];
                f32x4 v[2][2];
#pragma unroll
                for (int bj = 0; bj < 2; ++bj)
#pragma unroll
                    for (int n = 0; n < 2; ++n) v[bj][n] = acc[ai][bj][m][n] * rr;
                if (do_norm) {
                    float ss = 0.f;
#pragma unroll
                    for (int bj = 0; bj < 2; ++bj)
#pragma unroll
                        for (int n = 0; n < 2; ++n) ss += (v[bj][n][0] * v[bj][n][0] + v[bj][n][1] * v[bj][n][1]) + (v[bj][n][2] * v[bj][n][2] + v[bj][n][3] * v[bj][n][3]);
                    ss += __shfl_xor(ss, 16); ss += __shfl_xor(ss, 32);
                    const float inv = __builtin_amdgcn_rsqf(ss * (1.0f / 64.0f) + RMS_EPS);
#pragma unroll
                    for (int bj = 0; bj < 2; ++bj)
#pragma unroll
                        for (int n = 0; n < 2; ++n) v[bj][n] = v[bj][n] * inv * gv[bj][n];
                }
                if (do_rope) {
#pragma unroll
                    for (int n = 0; n < 2; ++n) {
                        const f32x4 c = *(const f32x4*)(P.cosT + (size_t)row * 32 + 8 * fq + 4 * n), s = *(const f32x4*)(P.sinT + (size_t)row * 32 + 8 * fq + 4 * n);
                        const f32x4 x1 = v[0][n], x2 = v[1][n];
                        v[0][n] = x1 * c - x2 * s; v[1][n] = x2 * c + x1 * s; }
                }
#pragma unroll
                for (int bj = 0; bj < 2; ++bj) {
                    const f32x4 a = v[bj][0] * osc, b = v[bj][1] * osc;
                    u32x4 w; w.x = cvt_pk_bf16(a[0], a[1]); w.y = cvt_pk_bf16(a[2], a[3]); w.z = cvt_pk_bf16(b[0], b[1]); w.w = cvt_pk_bf16(b[2], b[3]);
                    if (pn == 12 && wc == 2) {
                        const int d = bj * 32 + 8 * fq; *(u32x4*)(dst + (size_t)(row >> 5) * 2048 + (d >> 4) * 512 + ((d >> 3) & 1) * 256 + (row & 31) * 8) = w;
                    } else *(u32x4*)(dst + (size_t)row * pitch + hoff + bj * 32 + 8 * fq) = w; }
            }
    }
};
}
#define GAS __attribute__((address_space(1)))
#define LAS __attribute__((address_space(3)))
typedef unsigned short bf16;
typedef unsigned v4u __attribute__((ext_vector_type(4)));
typedef float f32x4 __attribute__((ext_vector_type(4)));
typedef short bf16x8 __attribute__((ext_vector_type(8)));
typedef GAS unsigned gu32;
typedef GAS unsigned long long gu64;
#define RLX_AGENT __ATOMIC_RELAXED, __HIP_MEMORY_SCOPE_AGENT
#define LDS_WAIT() asm volatile("s_waitcnt lgkmcnt(0)" ::: "memory")
#define VM_WAIT() asm volatile("s_waitcnt vmcnt(0)" ::: "memory")
__device__ __forceinline__ unsigned long long rt() { return __builtin_amdgcn_s_memrealtime(); }
__device__ __forceinline__ unsigned f2bf(float f) { unsigned u = __builtin_bit_cast(unsigned, f); return (u + 0x7fffu + ((u >> 16) & 1u)) >> 16; }
__device__ __forceinline__ unsigned pk2(float lo, float hi) { return f2bf(lo) | (f2bf(hi) << 16); }
typedef float f32x2g __attribute__((ext_vector_type(2)));
__device__ __forceinline__ float bf_lo32(unsigned w) { return __uint_as_float(w << 16); }
__device__ __forceinline__ float bf_hi32(unsigned w) { return __uint_as_float(w & 0xffff0000u); }
constexpr int NWAVES = 8;
constexpr int BATCH = 2, SEQ = 8192, DM = 1024, T = BATCH * SEQ, DFF = 2816, MEMLEN = 256, BW = 512, DIN = 6352;
constexpr int NPROJ = 13 * 256, NGATE = 3072;
constexpr float L2E = 1.4426950408889634f;
constexpr float C2_64 = 0.125f * L2E;
constexpr float C2_128 = 0.08838834764831845f * L2E;
constexpr size_t MiB = 1u << 20;
constexpr size_t WS_CTL = 0, CTL_ZERO_BYTES = 128 * 1024;
constexpr size_t WS_RSTDX = 1 * MiB;
constexpr size_t WS_RSTDM = WS_RSTDX + 64 * 1024;
constexpr size_t WS_T0 = WS_RSTDM + 4096;
constexpr size_t WS_SSQ1 = 2 * MiB;
constexpr size_t WS_SSQ2 = 3 * MiB;
constexpr size_t WS_LOGF = 4 * MiB;
constexpr size_t WS_CUM = WS_LOGF + 512 * 1024;
constexpr size_t WS_IW = 5 * MiB;
constexpr size_t WS_COS = 6 * MiB, WS_SIN = 8 * MiB;
constexpr size_t WS_MEMB = 10 * MiB;
constexpr size_t WS_KVM = 11 * MiB;
constexpr size_t WS_KMB = 13 * MiB, WS_VMB = 14 * MiB;
constexpr size_t WS_WGU1 = 16 * MiB;
constexpr size_t WS_WD1 = 27 * MiB;
constexpr size_t WS_WIN = 33 * MiB;
constexpr size_t WS_WGATE = 40 * MiB;
constexpr size_t WS_WBR = 46 * MiB;
constexpr size_t WS_WOUT = 49 * MiB;
constexpr size_t WS_WGU2 = 51 * MiB;
constexpr size_t WS_WD2 = 62 * MiB;
constexpr size_t WS_WMKV = 68 * MiB;
constexpr size_t WS_HB = 70 * MiB;
constexpr size_t WS_ACT = 102 * MiB;
constexpr size_t WS_HID = WS_ACT;
constexpr size_t WS_FQ = WS_ACT, WS_FK = WS_ACT + 16 * MiB, WS_FV = WS_ACT + 32 * MiB, WS_DQ = WS_ACT + 48 * MiB, WS_IQ = WS_ACT + 64 * MiB, WS_MQ = WS_ACT + 80 * MiB;
constexpr size_t WS_DK = WS_ACT + 96 * MiB, WS_DV = WS_ACT + 98 * MiB, WS_IK = WS_ACT + 100 * MiB;
#if defined(DBG_SUBST) && DBG_SUBST == 2
constexpr size_t WS_MERGED = WS_DQ;
#else
constexpr size_t WS_MERGED = WS_FK;
#endif
#ifdef DBG_GSCR_AT
constexpr size_t WS_GSCR = DBG_GSCR_AT;
#else
constexpr size_t WS_GSCR = 204 * MiB;
#endif
constexpr size_t WS_OA = 236 * MiB;
constexpr size_t WS_OB = 16 * MiB;
constexpr size_t WS_END = 252 * MiB;
#ifndef DBG_GSCR_AT
static_assert(WS_HID + (size_t)T * DFF * 2 <= WS_GSCR && WS_IK + (size_t)T * 64 * 2 <= WS_GSCR, "d_ws map");
#endif
constexpr int CW_BAR = 4096;
constexpr int CW_Q = 16384;
constexpr int RING_OFF = 0, RING_BYTES = 131072;
constexpr int LDSCTL_OFF = RING_BYTES, MISC_OFF = LDSCTL_OFF + 320;
constexpr int LIST_OFF = RING_BYTES + 1024;
constexpr int SCANX_OFF = RING_BYTES + 6144;
constexpr int LDS_BYTES = 163840;
#define XB_TMO      128
#define XB_XCNT(j)  (256  + 64 * (j))
#define XB_XSUB(j)  (1280 + 64 * (j))
#define XB_XGEN(j)  (2304 + 64 * (j))
#define XB_TOP      3328
#define XB_TOPGEN   3392
#define XCD_BAR_WORDS 3456
#define XB_SPIN_CAP (1u << 18)

__device__ __forceinline__ unsigned xb_ld(unsigned* p)              { return __hip_atomic_load(p, __ATOMIC_RELAXED, __HIP_MEMORY_SCOPE_AGENT); }
__device__ __forceinline__ unsigned xb_add(unsigned* p, unsigned v) { return __hip_atomic_fetch_add(p, v, __ATOMIC_RELAXED, __HIP_MEMORY_SCOPE_AGENT); }
__device__ __forceinline__ unsigned xb_xcc_id() { return (unsigned)__builtin_amdgcn_s_getreg((3 << 11) | 20) & 0xFu; }
#define XB_SPIN(cond, bar) do { unsigned _sp = 0; while (cond) { __builtin_amdgcn_s_sleep(1); \
    if ((++_sp & 255u) == 0u) { if (xb_ld(&(bar)[XB_TMO])) break; if (_sp > XB_SPIN_CAP) { atomicAdd(&(bar)[XB_TMO], 1u); break; } } } } while (0)

struct XcdBarrier {
    unsigned* bar; unsigned x;
    volatile LAS unsigned* st;
};

__device__ __forceinline__ XcdBarrier xcd_barrier_post(unsigned* bar, volatile LAS unsigned* st) {
    XcdBarrier b; b.bar = bar; b.x = xb_xcc_id(); b.st = st;
    if (threadIdx.x == 0) (void)xb_add(&bar[XB_XCNT(b.x)], 1u);
    return b;
}
__device__ __forceinline__ void xcd_barrier_complete(unsigned* bar, unsigned x, unsigned& nloc, unsigned& nx) {
    const unsigned G = gridDim.x * gridDim.y * gridDim.z;
    unsigned sum, cnt, mine, sp = 0u;
    for (;;) {
        sum = 0u; cnt = 0u; mine = 0u;
#pragma unroll
        for (unsigned j = 0; j < 16; ++j) { const unsigned c = xb_ld(&bar[XB_XCNT(j)]); sum += c; cnt += (c > 0u) ? 1u : 0u; mine = (j == x) ? c : mine; }
        if (sum == G) break;
        __builtin_amdgcn_s_sleep(1);
        if ((++sp & 255u) == 0u) { if (xb_ld(&bar[XB_TMO])) break; if (sp > XB_SPIN_CAP) { atomicAdd(&bar[XB_TMO], 1u); break; } }
    }
    nloc = mine > 0u ? mine : 1u; nx = cnt > 0u ? cnt : 1u;
}

__device__ __forceinline__ void xcd_barrier(const XcdBarrier& b) {
    asm volatile("s_waitcnt vmcnt(0)" ::: "memory");
    __syncthreads();
    if (threadIdx.x == 0) {
        unsigned* bar = b.bar;
        __builtin_amdgcn_s_waitcnt(0);
        unsigned nloc = b.st[0], nx = b.st[1];
        if (nloc == 0u) { xcd_barrier_complete(bar, b.x, nloc, nx); b.st[0] = nloc; b.st[1] = nx; }
        const unsigned old = xb_add(&bar[XB_XSUB(b.x)], 1u);
        const unsigned gen = old / nloc;
        if (old + 1u == (gen + 1u) * nloc) {
            __builtin_amdgcn_fence(__ATOMIC_RELEASE, "agent");
            asm volatile("s_waitcnt vmcnt(0)" ::: "memory");
            const unsigned og = xb_add(&bar[XB_TOP], 1u);
            const unsigned tg = og / nx;
            if (og + 1u == (tg + 1u) * nx) xb_add(&bar[XB_TOPGEN], 1u);
            else XB_SPIN(xb_ld(&bar[XB_TOPGEN]) == tg, bar);
            __builtin_amdgcn_fence(__ATOMIC_ACQUIRE, "agent");
            xb_add(&bar[XB_XGEN(b.x)], 1u);
            asm volatile("s_waitcnt vmcnt(0)" ::: "memory");
        } else {
            XB_SPIN(xb_ld(&bar[XB_XGEN(b.x)]) == gen, bar);
            __builtin_amdgcn_fence(__ATOMIC_ACQUIRE, "agent");
            asm volatile("s_waitcnt vmcnt(0)" ::: "memory");
        }
    }
    __syncthreads();
}
__device__ __forceinline__ float wave_sum(float v) {
#pragma unroll
    for (int o = 1; o < 64; o <<= 1) v += __shfl_xor(v, o);
    return v;
}
__device__ __forceinline__ float wave_max(float v) {
#pragma unroll
    for (int o = 1; o < 64; o <<= 1) v = fmaxf(v, __shfl_xor(v, o));
    return v;
}
__device__ __forceinline__ int colmap(int mat, int n) {
    if (mat == 1) return n;
    if (mat == 3) return 3280 + n;
    const int tile = n >> 8, t = n & 255;
    if (mat == 0) return (t < 128 ? 0 : DFF) + 128 * tile + (t & 127);
    const int bj = t >> 7, wc = (t >> 5) & 3, i = t & 31, d = bj * 32 + i;
    if (tile < 2) return 0 + (4 * tile + wc) * 64 + d;
    if (tile < 4) return 512 + (4 * (tile - 2) + wc) * 64 + d;
    if (tile < 6) return 1024 + (4 * (tile - 4) + wc) * 64 + d;
    if (tile < 8) return 1544 + (4 * (tile - 6) + wc) * 64 + d;
    if (tile < 10) return 2184 + (4 * (tile - 8) + wc) * 64 + d;
    if (tile < 12) return 2768 + (2 * (tile - 10) + (wc >> 1)) * 128 + (wc & 1) * 64 + d;
    if (wc == 0) return 2056 + d;
    if (wc == 1) return 2120 + d;
    if (wc == 2) return 2696 + d;
    if (bj == 0 && i < 8) return 1536 + i;
    if (bj == 0 && i < 16) return 2760 + (i - 8);
    return -1;
}
__device__ __forceinline__ void transpose_item(int mat, const float* Wa, const float* Wb, int K, int Nsrc, const float* gain, bf16* WT, LAS float* scr, int item, int nblk, int lane) {
    const int kb = item / nblk, nb = item % nblk, k0 = 64 * kb, n0 = 32 * nb;
    int col = colmap(mat, n0 + (lane & 31)); const float* W = Wa;
    if (mat == 0 && col >= DFF) { W = Wb; col -= DFF; }
#pragma unroll 8
    for (int i = 0; i < 32; ++i) { const int kk = 2 * i + (lane >> 5); float v = 0.f; if (col >= 0) v = W[(size_t)(k0 + kk) * Nsrc + col]; if (gain) v *= gain[k0 + kk]; scr[kk * 33 + (lane & 31)] = v; }
    LDS_WAIT(); asm volatile("" ::: "memory");
    const int c = lane & 7;
#pragma unroll
    for (int j = 0; j < 4; ++j) { const int n = (lane >> 3) + 8 * j; const LAS float* s = scr + (8 * c) * 33 + n;
        v4u o; o.x = pk2(s[0 * 33], s[1 * 33]); o.y = pk2(s[2 * 33], s[3 * 33]); o.z = pk2(s[4 * 33], s[5 * 33]); o.w = pk2(s[6 * 33], s[7 * 33]);
        *(GAS v4u*)(WT + (size_t)(n0 + n) * K + k0 + 8 * c) = o; }
    LDS_WAIT(); asm volatile("" ::: "memory");
}
__device__ __forceinline__ void row_to_bf16_rstd(const float* xrow, bf16* orow, float* rstd_out, int lane) {
    const GAS f32x4* xr = (const GAS f32x4*)xrow + lane;
    f32x4 v[4]; float s = 0.f;
#pragma unroll
    for (int j = 0; j < 4; ++j) { v[j] = xr[64 * j]; s += (v[j].x * v[j].x + v[j].y * v[j].y) + (v[j].z * v[j].z + v[j].w * v[j].w); }
    const float rstd = 1.0f / sqrtf(wave_sum(s) * (1.f / 1024.f) + 1e-6f);
    GAS unsigned long long* o8 = (GAS unsigned long long*)orow + lane;
#pragma unroll
    for (int j = 0; j < 4; ++j) o8[64 * j] = (unsigned long long)pk2(v[j].x, v[j].y) | ((unsigned long long)pk2(v[j].z, v[j].w) << 32);
    if (lane == 0) *rstd_out = rstd;
}
__device__ __forceinline__ void rows4_to_bf16_rstd(const float* const (&xrow)[4], bf16* const (&orow)[4], float* const (&rout)[4], const bool (&ok)[4], int lane) {
    f32x4 v[4][4];
#pragma unroll
    for (int r = 0; r < 4; ++r) { const GAS f32x4* xr = (const GAS f32x4*)xrow[r] + lane;
#pragma unroll
        for (int j = 0; j < 4; ++j) v[r][j] = xr[64 * j]; }
#pragma unroll
    for (int r = 0; r < 4; ++r) { float s = 0.f;
#pragma unroll
        for (int j = 0; j < 4; ++j) s += (v[r][j].x * v[r][j].x + v[r][j].y * v[r][j].y) + (v[r][j].z * v[r][j].z + v[r][j].w * v[r][j].w);
        const float rstd = 1.0f / sqrtf(wave_sum(s) * (1.f / 1024.f) + 1e-6f);
        if (ok[r]) { GAS unsigned long long* o8 = (GAS unsigned long long*)orow[r] + lane;
#pragma unroll
            for (int j = 0; j < 4; ++j) o8[64 * j] = (unsigned long long)pk2(v[r][j].x, v[r][j].y) | ((unsigned long long)pk2(v[r][j].z, v[r][j].w) << 32);
            if (lane == 0) *rout[r] = rstd; } }
}
typedef float f32x16 __attribute__((ext_vector_type(16)));
typedef unsigned u32x2 __attribute__((ext_vector_type(2)));
__device__ __forceinline__ int crow(int r, int hi) { return (r & 3) + 8 * (r >> 2) + 4 * hi; }
__device__ __forceinline__ float bf2f(bf16 v) { return __uint_as_float((unsigned)v << 16); }
__device__ __forceinline__ unsigned cvtpk(float lo, float hi) { return pg8::cvt_pk_bf16(lo, hi); }
template <int HD, bool FOX, bool VT>
__device__ __forceinline__ void attn_wave_simple(const bf16x8 (&qr)[HD / 16], const bf16* Kp, int kpitch, const bf16* Vp, int vpitch, int tstart, int ntiles, int qlocal, const float* cb, bf16* Op, int opitch, int lane) {
    const int r32 = lane & 31, hi = lane >> 5;
    f32x16 o[HD / 32];
#pragma unroll
    for (int d0 = 0; d0 < HD / 32; ++d0)
#pragma unroll
        for (int r = 0; r < 16; ++r) o[d0][r] = 0.f;
    float m = -1e30f, l = 0.f;
    for (int t = tstart; t < ntiles; ++t) {
        const int kv0 = 32 * t;
        f32x16 p;
#pragma unroll
        for (int r = 0; r < 16; ++r) p[r] = 0.f;
        const bf16* kr = Kp + (size_t)(kv0 + r32) * kpitch + hi * 8;
#pragma unroll
        for (int ks = 0; ks < HD / 16; ++ks) { const bf16x8 kf = *(const bf16x8*)(kr + ks * 16); p = __builtin_amdgcn_mfma_f32_32x32x16_bf16(kf, qr[ks], p, 0, 0, 0); }
        if (FOX) {
#pragma unroll
            for (int g = 0; g < 4; ++g) { const f32x4 c4 = *(const f32x4*)(cb + kv0 + 8 * g + 4 * hi);
#pragma unroll
                for (int jj = 0; jj < 4; ++jj) p[4 * g + jj] -= L2E * c4[jj]; }
            if (t == ntiles - 1) {
#pragma unroll
                for (int r = 0; r < 16; ++r) if (kv0 + crow(r, hi) > qlocal) p[r] = -INFINITY;
            }
        }
        float mt = p[0];
#pragma unroll
        for (int r = 1; r < 16; ++r) mt = fmaxf(mt, p[r]);
        mt = fmaxf(mt, __shfl_xor(mt, 32));
        const float mn = fmaxf(m, mt); const float alpha = __builtin_amdgcn_exp2f(m - mn); m = mn;
        l *= alpha;
#pragma unroll
        for (int d0 = 0; d0 < HD / 32; ++d0)
#pragma unroll
            for (int r = 0; r < 16; ++r) o[d0][r] *= alpha;
        float ls = 0.f;
#pragma unroll
        for (int r = 0; r < 16; ++r) { p[r] = __builtin_amdgcn_exp2f(p[r] - mn); ls += p[r]; }
        l += ls;
        bf16x8 pa[2];
#pragma unroll
        for (int s = 0; s < 2; ++s) { v4u w; w.x = cvtpk(p[8 * s + 0], p[8 * s + 1]); w.y = cvtpk(p[8 * s + 2], p[8 * s + 3]); w.z = cvtpk(p[8 * s + 4], p[8 * s + 5]); w.w = cvtpk(p[8 * s + 6], p[8 * s + 7]); pa[s] = __builtin_bit_cast(bf16x8, w); }
#pragma unroll
        for (int d0 = 0; d0 < HD / 32; ++d0)
#pragma unroll
            for (int s = 0; s < 2; ++s) {
                bf16x8 vf;
                if (VT) {
                    const bf16* vp = Vp + (size_t)(d0 * 32 + r32) * vpitch + kv0 + 16 * s + 4 * hi;
                    const u32x2 lo = *(const u32x2*)vp, hi2 = *(const u32x2*)(vp + 8);
                    vf = __builtin_bit_cast(bf16x8, (v4u){lo.x, lo.y, hi2.x, hi2.y});
                } else {
#pragma unroll
                    for (int j = 0; j < 8; ++j) vf[j] = (short)Vp[(size_t)(kv0 + 16 * s + 8 * (j >> 2) + 4 * hi + (j & 3)) * vpitch + d0 * 32 + r32];
                }
                o[d0] = __builtin_amdgcn_mfma_f32_32x32x16_bf16(vf, pa[s], o[d0], 0, 0, 0);
            }
    }
    l += __shfl_xor(l, 32);
    const float inv = 1.0f / l;
    bf16* orow = Op + (size_t)r32 * opitch;
#pragma unroll
    for (int d0 = 0; d0 < HD / 32; ++d0)
#pragma unroll
        for (int g = 0; g < 4; ++g) { u32x2 w; w.x = cvtpk(o[d0][4 * g] * inv, o[d0][4 * g + 1] * inv); w.y = cvtpk(o[d0][4 * g + 2] * inv, o[d0][4 * g + 3] * inv);
            *(u32x2*)(orow + d0 * 32 + 8 * g + 4 * hi) = w; }
}
__device__ __forceinline__ void fox_unit(int bh, int qb, const bf16* FQ, const bf16* FK, const bf16* FV, const float* CUM, const int* T0, bf16* OA, int wave, int lane) {
    const int b = bh >> 3, h = bh & 7, r32 = lane & 31, hi = lane >> 5; const size_t rowbase = (size_t)b * SEQ; const int q0 = qb * 256 + wave * 32;
    const bf16* Qw = FQ + (rowbase + q0) * 512 + h * 64; bf16* Ow = OA + (rowbase + q0) * 512 + h * 64;
    bf16x8 qr[4];
#pragma unroll
    for (int ks = 0; ks < 4; ++ks) qr[ks] = *(const bf16x8*)(Qw + (size_t)r32 * 512 + ks * 16 + hi * 8);
    attn_wave_simple<64, true, false>(qr, FK + rowbase * 512 + h * 64, 512, FV + rowbase * 512 + h * 64, 512, T0[bh * 256 + q0 / 32], q0 / 32 + 1, q0 + r32, CUM + (size_t)bh * SEQ, Ow, 512, lane);
}
__device__ __forceinline__ void mem_unit(int rg, int head, bf16* MQ, const bf16* KMB, const bf16* VMB, const float* gq, int lane) {
    const int r32 = lane & 31, hi = lane >> 5; const int row0 = rg * 32; const int b = row0 / SEQ;
    bf16* Qw = MQ + (size_t)row0 * 512 + head * 128;
    bf16x8 raw[8]; float ss = 0.f;
#pragma unroll
    for (int ks = 0; ks < 8; ++ks) { raw[ks] = *(const bf16x8*)(Qw + (size_t)r32 * 512 + ks * 16 + hi * 8);
#pragma unroll
        for (int j = 0; j < 8; ++j) { const float f = bf2f((bf16)raw[ks][j]); ss += f * f; } }
    ss += __shfl_xor(ss, 32);
    const float rstd = __builtin_amdgcn_rsqf(ss * (1.0f / 128.0f) + 1e-6f) * C2_128;
    bf16x8 qr[8];
#pragma unroll
    for (int ks = 0; ks < 8; ++ks) { const f32x4 g0 = *(const f32x4*)(gq + ks * 16 + hi * 8), g1 = *(const f32x4*)(gq + ks * 16 + hi * 8 + 4); v4u w;
        w.x = cvtpk(bf2f((bf16)raw[ks][0]) * rstd * g0[0], bf2f((bf16)raw[ks][1]) * rstd * g0[1]); w.y = cvtpk(bf2f((bf16)raw[ks][2]) * rstd * g0[2], bf2f((bf16)raw[ks][3]) * rstd * g0[3]);
        w.z = cvtpk(bf2f((bf16)raw[ks][4]) * rstd * g1[0], bf2f((bf16)raw[ks][5]) * rstd * g1[1]); w.w = cvtpk(bf2f((bf16)raw[ks][6]) * rstd * g1[2], bf2f((bf16)raw[ks][7]) * rstd * g1[3]);
        qr[ks] = __builtin_bit_cast(bf16x8, w); }
    attn_wave_simple<128, false, true>(qr, KMB + (size_t)b * MEMLEN * 512 + head * 128, 512, VMB + (size_t)(b * 4 + head) * 128 * MEMLEN, MEMLEN, 0, MEMLEN / 32, 0, nullptr, Qw, 512, lane);
}
__device__ __forceinline__ void scan_unit(int bh, const float* LOGF, float* CUM, int* T0, const float* gq, const float* gk, LAS float* sx, LAS float* cl, int tid) {
    const int b = bh >> 3, h = bh & 7, lane = tid & 63, wave = tid >> 6;
    float v[16]; float run = 0.f;
#pragma unroll
    for (int i = 0; i < 16; ++i) v[i] = LOGF[((size_t)b * SEQ + 16 * tid + i) * 8 + h];
#pragma unroll
    for (int i = 0; i < 16; ++i) { run += v[i]; v[i] = run; }
    float tot = run;
#pragma unroll
    for (int off = 1; off < 64; off <<= 1) { const float nb = __shfl_up(tot, off); if (lane >= off) tot += nb; }
    if (lane == 63) sx[wave] = tot;
    __syncthreads();
    float woff = 0.f;
    for (int w = 0; w < wave; ++w) woff += sx[w];
    const float excl = tot - run + woff;
    float* dst = CUM + (size_t)bh * SEQ + 16 * tid;
#pragma unroll
    for (int i = 0; i < 16; i += 4) { const f32x4 o4 = (f32x4){v[i] + excl, v[i + 1] + excl, v[i + 2] + excl, v[i + 3] + excl}; *(f32x4*)(dst + i) = o4; *(LAS f32x4*)(cl + 16 * tid + i) = o4; }
    const float smax = 8.0f * wave_max(fabsf(gq[lane])) * wave_max(fabsf(gk[lane]));
    __syncthreads();
    if (tid < 256) { const float cq = cl[32 * tid]; const float lim = -(30.0f + 2.0f * smax);
        int lo = 0, hi = tid;
        while (lo < hi) { const int mid = (lo + hi) >> 1; if (cq - cl[32 * mid + 31] >= lim) hi = mid; else lo = mid + 1; }
        T0[bh * 256 + tid] = lo; }
    __syncthreads();
}
constexpr int D2_LST = RING_BYTES + 1024;
constexpr int D2_CNT = RING_BYTES + 3072;
constexpr int D2_CL = RING_BYTES + 4096;
typedef short v4i16_t __attribute__((ext_vector_type(4)));
typedef float f32x4d __attribute__((ext_vector_type(4)));
__device__ __forceinline__ unsigned sortable_u32(float f) { const unsigned u = __float_as_uint(f); return u ^ ((u >> 31) ? 0xFFFFFFFFu : 0x80000000u); }
__device__ __forceinline__ int lane_rank(unsigned long long mask) { return (int)__builtin_amdgcn_mbcnt_hi((unsigned)(mask >> 32), __builtin_amdgcn_mbcnt_lo((unsigned)mask, 0u)); }
__device__ __forceinline__ int bcount(bool p) { return (int)__popcll(__ballot(p)); }
__device__ __forceinline__ void select_full(const LAS unsigned* my, int npad, LAS unsigned short* lst, int lane) {
    unsigned thr = 0u;
    for (int bit = 31; bit >= 0; --bit) {
        const unsigned cand = thr | (1u << bit); int cnt = 0;
        for (int i0 = 0; i0 < npad; i0 += 256) { const int idx = i0 + 4 * lane; v4u v = (v4u){0u, 0u, 0u, 0u}; if (idx < npad) v = *(const LAS v4u*)(my + idx);
            cnt += bcount(v.x >= cand) + bcount(v.y >= cand) + bcount(v.z >= cand) + bcount(v.w >= cand); }
        if (cnt >= 256) thr = cand;
    }
    int cgt = 0;
    for (int i0 = 0; i0 < npad; i0 += 256) { const int idx = i0 + 4 * lane; v4u v = (v4u){0u, 0u, 0u, 0u}; if (idx < npad) v = *(const LAS v4u*)(my + idx);
        cgt += bcount(v.x > thr) + bcount(v.y > thr) + bcount(v.z > thr) + bcount(v.w > thr); }
    const int quota = 256 - cgt; int eqseen = 0, nsel = 0;
    for (int base = 0; base < npad; base += 64) { const int idx = base + lane; unsigned u = 0u; if (idx < npad) u = my[idx];
        const bool gt = u > thr, eq = (u == thr);
        const unsigned long long em = __ballot(eq); const int er = eqseen + lane_rank(em);
        const bool sel = gt || (eq && er < quota);
        const unsigned long long sm = __ballot(sel); const int pos = nsel + lane_rank(sm);
        if (sel && pos < 256) lst[pos] = (unsigned short)idx;
        nsel += __popcll(sm); eqseen += __popcll(em); }
}
template <int KMAX> __device__ __forceinline__ void select_cands(const unsigned (&uu)[16], const unsigned (&id)[16], LAS unsigned short* lst, int lane) {
    unsigned thr = 0u;
    for (int bit = 31; bit >= 0; --bit) {
        const unsigned cand = thr | (1u << bit); int cnt = 0;
#pragma unroll
        for (int k = 0; k < KMAX; ++k) cnt += bcount(uu[k] >= cand);
        if (cnt >= 256) { thr = cand; if (cnt == 256) break; }
    }
    int cgt = 0, ceq = 0;
#pragma unroll
    for (int k = 0; k < KMAX; ++k) { cgt += bcount(uu[k] > thr); ceq += bcount(uu[k] == thr); }
    const int quota = 256 - cgt; unsigned ilim = 0xFFFFu;
    if (ceq != quota) {
        unsigned I = 0u;
        for (int bit = 12; bit >= 0; --bit) { const unsigned cand = I | (1u << bit); int cnt = 0;
#pragma unroll
            for (int k = 0; k < KMAX; ++k) cnt += bcount(uu[k] == thr && id[k] < cand);
            if (cnt < quota) I = cand; }
        ilim = I;
    }
    int nsel = 0;
#pragma unroll
    for (int k = 0; k < KMAX; ++k) { const bool sel = (uu[k] > thr) || (uu[k] == thr && id[k] <= ilim);
        const unsigned long long sm = __ballot(sel); const int pos = nsel + lane_rank(sm);
        if (sel && pos < 256) lst[pos] = (unsigned short)id[k];
        nsel += __popcll(sm); }
}
__device__ __forceinline__ void dsa2_unit(int b, int qg, const bf16* IQ, const bf16* IK, const float* IW, const bf16* DQ, const bf16* DK, const bf16* DV, bf16* OB, LAS unsigned char* lds, int wave, int lane) {
    LAS unsigned* sc = (LAS unsigned*)lds;
    LAS unsigned short* LST = (LAS unsigned short*)(lds + D2_LST);
    LAS int* CNT = (LAS int*)(lds + D2_CNT);
    LAS unsigned short* CL = (LAS unsigned short*)(lds + D2_CL);
    const int q0 = 4 * qg, r32 = lane & 31, hi = lane >> 5; const size_t rowbase = (size_t)b * SEQ;
    const int ntile = (q0 + 3) / 32 + 1, npad = ntile * 32;
#ifndef REP_A
#define REP_A 1
#define REP_B1 1
#define REP_B2 1
#define REP_C 1
#endif
    for (int repa = 0; repa < REP_A; ++repa)
    {
        const int qi = 2 * ((r32 >> 2) & 1) + (r32 >> 4), hd = 4 * ((r32 >> 3) & 1) + (r32 & 3);
        bf16x8 aq[4];
#pragma unroll
        for (int ks = 0; ks < 4; ++ks) aq[ks] = *(const bf16x8*)(IQ + (rowbase + q0 + qi) * 512 + hd * 64 + ks * 16 + hi * 8);
        const float* w0p = IW + (rowbase + q0 + 2 * hi) * 8;
        const f32x4 w0a = *(const f32x4*)(w0p), w0b = *(const f32x4*)(w0p + 4), w1a = *(const f32x4*)(w0p + 8), w1b = *(const f32x4*)(w0p + 12);
        for (int t = wave; t < ntile; t += 32) {
            bf16x8 bk[4][4];
#pragma unroll
            for (int u = 0; u < 4; ++u) { const int tt = t + 8 * u; const bf16* kr = IK + (rowbase + 32 * (tt < ntile ? tt : t)) * 64 + lane * 8;
#pragma unroll
                for (int ks = 0; ks < 4; ++ks) bk[u][ks] = *(const bf16x8*)(kr + ks * 512); }
#pragma unroll
            for (int u = 0; u < 4; ++u) { const int tt = t + 8 * u;
                if (tt < ntile) {
                    const int key = 32 * tt + r32;
                    f32x16 a;
#pragma unroll
                    for (int r = 0; r < 16; ++r) a[r] = 0.f;
#pragma unroll
                    for (int ks = 0; ks < 4; ++ks) a = __builtin_amdgcn_mfma_f32_32x32x16_bf16(aq[ks], bk[u][ks], a, 0, 0, 0);
                    float s0 = 0.f, s1 = 0.f;
#pragma unroll
                    for (int j = 0; j < 4; ++j) { s0 += w0a[j] * fmaxf(a[j], 0.f); s1 += w1a[j] * fmaxf(a[8 + j], 0.f); }
#pragma unroll
                    for (int j = 0; j < 4; ++j) { s0 += w0b[j] * fmaxf(a[4 + j], 0.f); s1 += w1b[j] * fmaxf(a[12 + j], 0.f); }
                    sc[(2 * hi) * 8192 + key] = (key <= q0 + 2 * hi) ? sortable_u32(s0) : 0u;
                    sc[(2 * hi + 1) * 8192 + key] = (key <= q0 + 2 * hi + 1) ? sortable_u32(s1) : 0u;
                } }
        }
    }
    __syncthreads();
    const int qi = wave & 3, hf = wave >> 2, q = q0 + qi, n = q + 1;
    const LAS unsigned* my = sc + qi * 8192;
    for (int repb = 0; repb < REP_B1; ++repb)
    {
        int c = 0; bool ovf = false;
        if (n > 256) {
            unsigned pivot = 1u;
            if (n > 640) {
                unsigned s[8];
#pragma unroll
                for (int k = 0; k < 8; ++k) s[k] = my[(int)(((unsigned)(lane * 8 + k) * (unsigned)n) >> 9)];
                const int r = (256 * 512 * 7 / 4) / n + 8;
                unsigned t16 = 0u;
                for (int bit = 15; bit >= 0; --bit) { const unsigned cand = (t16 | (1u << bit)) << 16; int cnt = 0;
#pragma unroll
                    for (int k = 0; k < 8; ++k) cnt += bcount(s[k] >= cand);
                    if (cnt >= r) t16 |= (1u << bit); }
                pivot = t16 << 16; if (pivot == 0u) pivot = 1u;
            }
            const int half = ((npad + 511) >> 9) << 8; const int lo = hf * half; const int hiend = (lo + half < npad) ? lo + half : npad;
            LAS unsigned short* cl = CL + wave * 1024;
            for (int i0 = lo; i0 < hiend; i0 += 256) { const int idx = i0 + 4 * lane; v4u v = (v4u){0u, 0u, 0u, 0u}; if (idx < hiend) v = *(const LAS v4u*)(my + idx);
#pragma unroll
                for (int e = 0; e < 4; ++e) { const bool f = v[e] >= pivot; const unsigned long long m = __ballot(f); const int pos = c + lane_rank(m);
                    if (f) { if (pos < 1024) cl[pos] = (unsigned short)(idx + e); }
                    c += __popcll(m); } }
            if (c > 1024) ovf = true;
        }
        if (lane == 0) CNT[wave] = ovf ? -1 : c;
    }
    __syncthreads();
    for (int repb2 = 0; repb2 < REP_B2; ++repb2)
    if (wave < 4) {
        LAS unsigned short* lst = LST + wave * 256; int nsel;
        if (n <= 256) { for (int i = lane; i < n; i += 64) lst[i] = (unsigned short)i; nsel = n; }
        else {
            const int c0 = CNT[wave], c1 = CNT[wave + 4]; const int c = c0 + c1;
            if (c0 < 0 || c1 < 0 || c < 256 || c > 1024) select_full(my, npad, lst, lane);
            else {
                unsigned uu[16], id[16];
#pragma unroll
                for (int k = 0; k < 16; ++k) { const int j = k * 64 + lane; unsigned ix = 0u, u = 0u;
                    if (j < c) { ix = (j < c0) ? (unsigned)CL[wave * 1024 + j] : (unsigned)CL[(wave + 4) * 1024 + (j - c0)]; u = my[ix]; }
                    uu[k] = u; id[k] = ix; }
                if (c <= 512) select_cands<8>(uu, id, lst, lane); else select_cands<16>(uu, id, lst, lane);
            }
            nsel = 256;
        }
        if (lane == 0) CNT[8 + wave] = nsel;
    }
    __syncthreads();
    for (int repc = 0; repc < REP_C; ++repc)
    {
        const int nsel = CNT[8 + qi]; const int j0 = 128 * hf; int cntk = nsel - j0; cntk = cntk < 0 ? 0 : (cntk > 128 ? 128 : cntk);
        const LAS unsigned short* lst = LST + qi * 256;
        LAS unsigned char* tile = lds + wave * 16384;
        LAS float* tf = (LAS float*)tile;
        const int l15 = lane & 15, kq = lane >> 4;
        if (cntk == 0) {
#pragma unroll
            for (int i = 0; i < 8; ++i) tf[i * 64 + lane] = 0.f;
            if (lane < 8) { tf[512 + lane] = -INFINITY; tf[520 + lane] = 0.f; }
        } else {
#pragma unroll
            for (int it = 0; it < 16; ++it) { const int r = 8 * it + (lane >> 3), ch = lane & 7; int j = j0 + r; j = j < nsel ? j : nsel - 1;
                const int idxv = (int)lst[j]; const v4u v = *(const v4u*)(DV + (rowbase + idxv) * 64 + 8 * ch);
                *(LAS v4u*)(tile + r * 128 + ch * 16) = v; }
            bf16x8 qf[2];
#pragma unroll
            for (int ks = 0; ks < 2; ++ks) { v4u z = (v4u){0u, 0u, 0u, 0u}; if (l15 < 8) z = *(const v4u*)(DQ + (rowbase + q) * 512 + l15 * 64 + 32 * ks + 8 * kq); qf[ks] = __builtin_bit_cast(bf16x8, z); }
            f32x4d acc[8];
#pragma unroll
            for (int g = 0; g < 8; ++g) { int j = j0 + 16 * g + l15; j = j < nsel ? j : nsel - 1; const int idxk = (int)lst[j];
                const bf16* kp = DK + (rowbase + idxk) * 64 + 8 * kq;
                const bf16x8 k0 = *(const bf16x8*)(kp), k1 = *(const bf16x8*)(kp + 32);
                f32x4d a = (f32x4d){0.f, 0.f, 0.f, 0.f};
                a = __builtin_amdgcn_mfma_f32_16x16x32_bf16(k0, qf[0], a, 0, 0, 0); a = __builtin_amdgcn_mfma_f32_16x16x32_bf16(k1, qf[1], a, 0, 0, 0); acc[g] = a; }
            float mx = -INFINITY;
#pragma unroll
            for (int g = 0; g < 8; ++g)
#pragma unroll
                for (int e = 0; e < 4; ++e) { if (16 * g + 4 * kq + e >= cntk) acc[g][e] = -INFINITY; mx = fmaxf(mx, acc[g][e]); }
            mx = fmaxf(mx, __shfl_xor(mx, 16)); mx = fmaxf(mx, __shfl_xor(mx, 32));
            float ls = 0.f;
#pragma unroll
            for (int g = 0; g < 8; ++g)
#pragma unroll
                for (int e = 0; e < 4; ++e) { acc[g][e] = __builtin_amdgcn_exp2f(acc[g][e] - mx); ls += acc[g][e]; }
            ls += __shfl_xor(ls, 16); ls += __shfl_xor(ls, 32);
            bf16x8 pa[4];
#pragma unroll
            for (int t = 0; t < 4; ++t) { v4u w; w.x = cvtpk(acc[2 * t][0], acc[2 * t][1]); w.y = cvtpk(acc[2 * t][2], acc[2 * t][3]); w.z = cvtpk(acc[2 * t + 1][0], acc[2 * t + 1][1]); w.w = cvtpk(acc[2 * t + 1][2], acc[2 * t + 1][3]); pa[t] = __builtin_bit_cast(bf16x8, w); }
            f32x4d o[4];
            const int q_ = l15 >> 2, p_ = lane & 3;
#pragma unroll
            for (int cb = 0; cb < 4; ++cb) { f32x4d oc = (f32x4d){0.f, 0.f, 0.f, 0.f};
#pragma unroll
                for (int t = 0; t < 4; ++t) {
                    const LAS unsigned char* a1 = tile + (32 * t + 4 * kq + q_) * 128 + (16 * cb + 4 * p_) * 2;
                    const v4i16_t lo4 = __builtin_amdgcn_ds_read_tr16_b64_v4i16((LAS v4i16_t*)a1), hi4 = __builtin_amdgcn_ds_read_tr16_b64_v4i16((LAS v4i16_t*)(a1 + 16 * 128));
                    const bf16x8 vf = (bf16x8){lo4[0], lo4[1], lo4[2], lo4[3], hi4[0], hi4[1], hi4[2], hi4[3]};
                    oc = __builtin_amdgcn_mfma_f32_16x16x32_bf16(pa[t], vf, oc, 0, 0, 0); }
                o[cb] = oc; }
            if (kq < 2) {
#pragma unroll
                for (int cb = 0; cb < 4; ++cb)
#pragma unroll
                    for (int e = 0; e < 4; ++e) tf[(4 * kq + e) * 64 + 16 * cb + l15] = o[cb][e];
            }
            if (lane < 8) { tf[512 + lane] = mx; tf[520 + lane] = ls; }
        }
    }
    __syncthreads();
    if (wave < 4) {
        const LAS float* ta = (const LAS float*)(lds + wave * 16384); const LAS float* tb = (const LAS float*)(lds + (wave + 4) * 16384);
        const int h = lane >> 3, d0 = (lane & 7) * 8;
        const float ma = ta[512 + h], mb = tb[512 + h], la = ta[520 + h], lb = tb[520 + h];
        const float m = fmaxf(ma, mb), fa = __builtin_amdgcn_exp2f(ma - m), fb = __builtin_amdgcn_exp2f(mb - m);
        const float inv = 1.0f / (la * fa + lb * fb);
        const f32x4 a0 = *(const LAS f32x4*)(ta + h * 64 + d0), a1 = *(const LAS f32x4*)(ta + h * 64 + d0 + 4), b0 = *(const LAS f32x4*)(tb + h * 64 + d0), b1 = *(const LAS f32x4*)(tb + h * 64 + d0 + 4);
        const f32x4 r0 = (a0 * fa + b0 * fb) * inv, r1 = (a1 * fa + b1 * fb) * inv;
        v4u w; w.x = cvtpk(r0[0], r0[1]); w.y = cvtpk(r0[2], r0[3]); w.z = cvtpk(r1[0], r1[1]); w.w = cvtpk(r1[2], r1[3]);
        *(v4u*)(OB + (rowbase + q) * 512 + h * 64 + d0) = w;
    }
    __syncthreads();
}
constexpr int D3_RING = RING_BYTES + 1024;
constexpr int D3_LST = D3_RING + 16384;
constexpr int D3_CNT = D3_LST + 8192;
constexpr int D3_QW = D3_CNT + 512;
typedef unsigned long long u64d;
template <int KMAX> __device__ __forceinline__ void select_cands3(const unsigned (&uu)[16], const unsigned (&id)[16], LAS unsigned short* lst, int lane) { select_cands<KMAX>(uu, id, lst, lane); }
__device__ __forceinline__ void dsa3_unit(int b, int g16, const bf16* IQ, const bf16* IK, const float* IW, const bf16* DQ, const bf16* DK, const bf16* DV, bf16* OB, LAS unsigned char* lds, int wave, int lane_in) {
    int lane = lane_in; asm volatile("" : "+v"(lane));
    LAS u64d* LISTS = (LAS u64d*)lds;
    LAS unsigned short* LST = (LAS unsigned short*)(lds + D3_LST);
    LAS int* CNT = (LAS int*)(lds + D3_CNT);
    const int tid = wave * 64 + lane, r32 = lane & 31, hi = lane >> 5; const size_t rowbase = (size_t)b * SEQ;
    const int q0 = 16 * g16, ntile = (q0 + 15) / 32 + 1, nstep = (ntile + 1) >> 1;
    const int qgrp = wave & 3, par = wave >> 2;
    const int qA = q0 + 4 * qgrp + 2 * hi, qB = qA + 1;
    const int qi = 2 * ((r32 >> 2) & 1) + (r32 >> 4), hd = 4 * ((r32 >> 3) & 1) + (r32 & 3);
    bf16x8 aq[4];
#pragma unroll
    for (int ks = 0; ks < 4; ++ks) aq[ks] = *(const bf16x8*)(IQ + (rowbase + q0 + 4 * qgrp + qi) * 512 + hd * 64 + ks * 16 + hi * 8);
    const float* w0p = IW + (rowbase + qA) * 8;
    const f32x4 w0a = *(const f32x4*)(w0p), w0b = *(const f32x4*)(w0p + 4), w1a = *(const f32x4*)(w0p + 8), w1b = *(const f32x4*)(w0p + 12);
    f32x4 l0a, l0b, l1a, l1b;
#pragma unroll
    for (int j = 0; j < 4; ++j) { l0a[j] = w0a[j] >= 0.f ? INFINITY : -INFINITY; l0b[j] = w0b[j] >= 0.f ? INFINITY : -INFINITY; l1a[j] = w1a[j] >= 0.f ? INFINITY : -INFINITY; l1b[j] = w1b[j] >= 0.f ? INFINITY : -INFINITY; }
#define D3_SCORE(BK, S0, S1) do { f32x16 a_; _Pragma("unroll") for (int r = 0; r < 16; ++r) a_[r] = 0.f; \
        _Pragma("unroll") for (int ks = 0; ks < 4; ++ks) a_ = __builtin_amdgcn_mfma_f32_32x32x16_bf16(aq[ks], BK[ks], a_, 0, 0, 0); \
        S0 = 0.f; S1 = 0.f; \
        _Pragma("unroll") for (int j = 0; j < 4; ++j) { S0 += __builtin_amdgcn_fmed3f(w0a[j] * a_[j], 0.f, l0a[j]); S1 += __builtin_amdgcn_fmed3f(w1a[j] * a_[8 + j], 0.f, l1a[j]); } \
        _Pragma("unroll") for (int j = 0; j < 4; ++j) { S0 += __builtin_amdgcn_fmed3f(w0b[j] * a_[4 + j], 0.f, l0b[j]); S1 += __builtin_amdgcn_fmed3f(w1b[j] * a_[12 + j], 0.f, l1b[j]); } } while (0)
#ifndef REP_S
#define REP_S 1
#define REP_M 1
#define REP_B 1
#define REP_CD 1
#endif
    unsigned pivA = 1u, pivB = 1u;
    for (int reps = 0; reps < REP_S; ++reps)
    if (ntile > 16) {
#pragma unroll
        for (int k = 0; k < 4; ++k) { const int c = tid + 512 * k; const int ts = ((c >> 8) * ntile) >> 3;
            *(LAS v4u*)(lds + c * 16) = *(const v4u*)(IK + (rowbase + 32 * ts) * 64 + (c & 255) * 8); }
        __syncthreads();
        unsigned uA[8], uB[8];
#pragma unroll
        for (int i = 0; i < 8; ++i) { bf16x8 bk[4];
#pragma unroll
            for (int ks = 0; ks < 4; ++ks) bk[ks] = *(const LAS bf16x8*)(lds + i * 4096 + ks * 1024 + lane * 16);
            float s0, s1; D3_SCORE(bk, s0, s1); uA[i] = sortable_u32(s0); uB[i] = sortable_u32(s1); asm volatile("" ::: "memory"); }
        const int rA = (256 * 256 * 7 / 4) / (qA + 1) + 6, rB = (256 * 256 * 7 / 4) / (qB + 1) + 6;
        unsigned tA = 0u, tB = 0u;
        for (int bit = 15; bit >= 0; --bit) {
            const unsigned cA = (tA | (1u << bit)) << 16, cB = (tB | (1u << bit)) << 16; int nA = 0, nB = 0;
#pragma unroll
            for (int i = 0; i < 8; ++i) { const unsigned long long mA = __ballot(uA[i] >= cA), mB = __ballot(uB[i] >= cB);
                nA += hi ? __popc((unsigned)(mA >> 32)) : __popc((unsigned)mA); nB += hi ? __popc((unsigned)(mB >> 32)) : __popc((unsigned)mB); }
            if (nA >= rA) tA |= (1u << bit);
            if (nB >= rB) tB |= (1u << bit);
        }
        pivA = tA << 16; pivB = tB << 16; if (pivA == 0u) pivA = 1u; if (pivB == 0u) pivB = 1u;
        __syncthreads();
    }
    for (int repm = 0; repm < REP_M; ++repm)
    {
        const bf16* src0 = IK + rowbase * 64 + (size_t)(tid & 255) * 8;
#define D3_LOAD(k_) (*(const v4u*)(src0 + (size_t)32 * ((2 * (k_) + (tid >> 8)) < ntile ? (2 * (k_) + (tid >> 8)) : ntile - 1) * 64))
        v4u st0 = (v4u){0u, 0u, 0u, 0u}, st1 = st0, st2 = st0, st3 = st0;
        st0 = D3_LOAD(0); st1 = D3_LOAD(1); st2 = D3_LOAD(2); st3 = D3_LOAD(3);
        *(LAS v4u*)(lds + D3_RING + tid * 16) = st0;
        __syncthreads();
        int cntA = 0, cntB = 0;
        LAS u64d* lA = LISTS + ((4 * qgrp + 2 * hi) * 2 + par) * 512; LAS u64d* lB = lA + 1024;
        f32x16 acc;
#pragma unroll
        for (int r = 0; r < 16; ++r) acc[r] = 0.f;
#define D3_SUMS(S0, S1) do { S0 = 0.f; S1 = 0.f; \
            _Pragma("unroll") for (int j = 0; j < 4; ++j) { S0 += __builtin_amdgcn_fmed3f(w0a[j] * acc[j], 0.f, l0a[j]); S1 += __builtin_amdgcn_fmed3f(w1a[j] * acc[8 + j], 0.f, l1a[j]); } \
            _Pragma("unroll") for (int j = 0; j < 4; ++j) { S0 += __builtin_amdgcn_fmed3f(w0b[j] * acc[4 + j], 0.f, l0b[j]); S1 += __builtin_amdgcn_fmed3f(w1b[j] * acc[12 + j], 0.f, l1b[j]); } } while (0)
#define D3_FILTER(TP, S0, S1) do { const int key = 32 * (TP) + r32; const unsigned u0 = sortable_u32(S0), u1 = sortable_u32(S1); \
                { const bool ps = (key <= qA) && (u0 >= pivA); const unsigned long long m = __ballot(ps); const unsigned ml = (unsigned)m, mh = (unsigned)(m >> 32); \
                  const int pos = cntA + (int)__builtin_amdgcn_mbcnt_hi(mh, __builtin_amdgcn_mbcnt_lo(ml, 0u)) - (hi ? __popc(ml) : 0); \
                  if (ps && pos < 512) lA[pos] = ((u64d)(unsigned)key << 32) | u0; cntA += hi ? __popc(mh) : __popc(ml); } \
                { const bool ps = (key <= qB) && (u1 >= pivB); const unsigned long long m = __ballot(ps); const unsigned ml = (unsigned)m, mh = (unsigned)(m >> 32); \
                  const int pos = cntB + (int)__builtin_amdgcn_mbcnt_hi(mh, __builtin_amdgcn_mbcnt_lo(ml, 0u)) - (hi ? __popc(ml) : 0); \
                  if (ps && pos < 512) lB[pos] = ((u64d)(unsigned)key << 32) | u1; cntB += hi ? __popc(mh) : __popc(ml); } } while (0)
#define D3_STEP(k_, STNEXT, STFREE) do { \
            STFREE = D3_LOAD((k_) + 4); \
            const int tp_ = 2 * (k_) - 2 + par; \
            const LAS unsigned char* sb = lds + D3_RING + ((k_) & 1) * 8192 + par * 4096; bf16x8 bk[4]; \
            _Pragma("unroll") for (int ks = 0; ks < 4; ++ks) bk[ks] = *(const LAS bf16x8*)(sb + ks * 1024 + lane * 16); \
            __builtin_amdgcn_sched_barrier(0); \
            float s0, s1; D3_SUMS(s0, s1); asm volatile("" : "+v"(s0), "+v"(s1));     \
            __builtin_amdgcn_sched_barrier(0); \
            _Pragma("unroll") for (int r = 0; r < 16; ++r) acc[r] = 0.f; \
            _Pragma("unroll") for (int ks = 0; ks < 4; ++ks) acc = __builtin_amdgcn_mfma_f32_32x32x16_bf16(aq[ks], bk[ks], acc, 0, 0, 0); \
            __builtin_amdgcn_sched_barrier(0); \
            if (tp_ >= 0 && tp_ < ntile) D3_FILTER(tp_, s0, s1); \
            *(LAS v4u*)(lds + D3_RING + (((k_) + 1) & 1) * 8192 + tid * 16) = STNEXT; \
            asm volatile("s_waitcnt lgkmcnt(0)" ::: "memory"); __builtin_amdgcn_s_barrier(); asm volatile("" ::: "memory"); } while (0)
        int kend = 0;
        for (int k = 0; k < nstep; k += 4) {
            D3_STEP(k, st1, st0); D3_STEP(k + 1, st2, st1); D3_STEP(k + 2, st3, st2); D3_STEP(k + 3, st0, st3); kend = k + 4;
        }
        {   const int tp_ = 2 * kend - 2 + par; if (tp_ < ntile) { float s0, s1; D3_SUMS(s0, s1); D3_FILTER(tp_, s0, s1); } }
#undef D3_SUMS
#undef D3_FILTER
#undef D3_STEP
#undef D3_LOAD
        if (r32 == 0) { CNT[(4 * qgrp + 2 * hi) * 2 + par] = cntA; CNT[(4 * qgrp + 2 * hi + 1) * 2 + par] = cntB; }
        if (tid < 4) CNT[48 + tid] = 0;
    }
#undef D3_SCORE
    __syncthreads();
#if defined(DBG_D3_STAGE) && DBG_D3_STAGE == 1
    for (int grp = 0; grp < 4; ++grp) dsa2_unit(b, 4 * g16 + grp, IQ, IK, IW, DQ, DK, DV, OB, lds, wave, lane);
    return;
#endif
#pragma unroll 1
    for (int rr = 0; rr < 2 * REP_B; ++rr) {
        const int qx = wave + 8 * (rr & 1), q = q0 + qx, n = q + 1; LAS unsigned short* lst = LST + qx * 256; int nsel;
        if (n <= 256) { for (int i = lane; i < n; i += 64) lst[i] = (unsigned short)i; nsel = n; }
        else {
            const int c0 = CNT[2 * qx], c1 = CNT[2 * qx + 1]; const int c = c0 + c1;
#ifdef DBG_D3_ALLFAIL
            if (true) { if (lane == 0) CNT[48 + (qx >> 2)] = 1; nsel = 0; }
#else
            if (c0 > 512 || c1 > 512 || c < 256) { if (lane == 0) CNT[48 + (qx >> 2)] = 1; nsel = 0; }
#endif
            else {
                unsigned uu[16], id[16]; const LAS u64d* L0 = LISTS + (qx * 2) * 512; const LAS u64d* L1 = L0 + 512;
#pragma unroll
                for (int k = 0; k < 16; ++k) { const int j = k * 64 + lane; u64d e = 0ull; if (j < c) e = (j < c0) ? L0[j] : L1[j - c0]; uu[k] = (unsigned)e; id[k] = (unsigned)(e >> 32); }
                if (c <= 512) select_cands<8>(uu, id, lst, lane); else select_cands<16>(uu, id, lst, lane);
                nsel = 256;
            }
        }
        if (lane == 0) CNT[32 + qx] = nsel;
    }
    __syncthreads();
#pragma unroll 1
    for (int rr = 0; rr < 2; ++rr) {
        const int qx = wave + 8 * rr, q = q0 + qx; const int nsel = CNT[32 + qx];
        const LAS unsigned short* lst = LST + qx * 256;
        LAS unsigned char* tile = lds + wave * 16384; LAS float* tf = (LAS float*)tile;
        const int l15 = lane & 15, kq = lane >> 4, q_ = l15 >> 2, p_ = lane & 3;
        bf16x8 qf[2];
#pragma unroll
        for (int ks = 0; ks < 2; ++ks) { v4u z = (v4u){0u, 0u, 0u, 0u}; if (l15 < 8) z = *(const v4u*)(DQ + (rowbase + q) * 512 + l15 * 64 + 32 * ks + 8 * kq); qf[ks] = __builtin_bit_cast(bf16x8, z); }
        float mrun = -INFINITY, lrun = 0.f; f32x4d orun[4];
#pragma unroll
        for (int cb = 0; cb < 4; ++cb) orun[cb] = (f32x4d){0.f, 0.f, 0.f, 0.f};
#pragma unroll 1
        for (int hf = 0; hf < 2; ++hf) {
            const int j0 = 128 * hf; int cntk = nsel - j0; cntk = cntk > 128 ? 128 : cntk;
            if (cntk <= 0) break;
#pragma unroll
            for (int it = 0; it < 16; ++it) { const int r = 8 * it + (lane >> 3), ch = lane & 7; int j = j0 + r; j = j < nsel ? j : nsel - 1;
                const int idxv = (int)lst[j]; const v4u v = *(const v4u*)(DV + (rowbase + idxv) * 64 + 8 * ch);
                *(LAS v4u*)(tile + r * 128 + ch * 16) = v; }
            f32x4d acc[8];
#pragma unroll
            for (int g = 0; g < 8; ++g) { int j = j0 + 16 * g + l15; j = j < nsel ? j : nsel - 1; const int idxk = (int)lst[j];
                const bf16* kp = DK + (rowbase + idxk) * 64 + 8 * kq;
                const bf16x8 k0 = *(const bf16x8*)(kp), k1 = *(const bf16x8*)(kp + 32);
                f32x4d a = (f32x4d){0.f, 0.f, 0.f, 0.f};
                a = __builtin_amdgcn_mfma_f32_16x16x32_bf16(k0, qf[0], a, 0, 0, 0); a = __builtin_amdgcn_mfma_f32_16x16x32_bf16(k1, qf[1], a, 0, 0, 0); acc[g] = a; }
            float mx = -INFINITY;
#pragma unroll
            for (int g = 0; g < 8; ++g)
#pragma unroll
                for (int e = 0; e < 4; ++e) { if (16 * g + 4 * kq + e >= cntk) acc[g][e] = -INFINITY; mx = fmaxf(mx, acc[g][e]); }
            mx = fmaxf(mx, __shfl_xor(mx, 16)); mx = fmaxf(mx, __shfl_xor(mx, 32));
            const float mnew = fmaxf(mrun, mx), fold = __builtin_amdgcn_exp2f(mrun - mnew);
            float ls = 0.f;
#pragma unroll
            for (int g = 0; g < 8; ++g)
#pragma unroll
                for (int e = 0; e < 4; ++e) { acc[g][e] = __builtin_amdgcn_exp2f(acc[g][e] - mnew); ls += acc[g][e]; }
            ls += __shfl_xor(ls, 16); ls += __shfl_xor(ls, 32);
            lrun = lrun * fold + ls; mrun = mnew;
            float fo[4];
#pragma unroll
            for (int e = 0; e < 4; ++e) fo[e] = __shfl(fold, 4 * kq + e);
            bf16x8 pa[4];
#pragma unroll
            for (int t = 0; t < 4; ++t) { v4u w; w.x = cvtpk(acc[2 * t][0], acc[2 * t][1]); w.y = cvtpk(acc[2 * t][2], acc[2 * t][3]); w.z = cvtpk(acc[2 * t + 1][0], acc[2 * t + 1][1]); w.w = cvtpk(acc[2 * t + 1][2], acc[2 * t + 1][3]); pa[t] = __builtin_bit_cast(bf16x8, w); }
#pragma unroll
            for (int cb = 0; cb < 4; ++cb) { f32x4d oc = orun[cb];
#pragma unroll
                for (int e = 0; e < 4; ++e) oc[e] *= fo[e];
#pragma unroll
                for (int t = 0; t < 4; ++t) {
                    const LAS unsigned char* a1 = tile + (32 * t + 4 * kq + q_) * 128 + (16 * cb + 4 * p_) * 2;
                    const v4i16_t lo4 = __builtin_amdgcn_ds_read_tr16_b64_v4i16((LAS v4i16_t*)a1), hi4 = __builtin_amdgcn_ds_read_tr16_b64_v4i16((LAS v4i16_t*)(a1 + 16 * 128));
                    const bf16x8 vf = (bf16x8){lo4[0], lo4[1], lo4[2], lo4[3], hi4[0], hi4[1], hi4[2], hi4[3]};
                    oc = __builtin_amdgcn_mfma_f32_16x16x32_bf16(pa[t], vf, oc, 0, 0, 0); }
                orun[cb] = oc; }
        }
        float li[4];
#pragma unroll
        for (int e = 0; e < 4; ++e) li[e] = 1.0f / __shfl(lrun, 4 * kq + e);
        if (kq < 2) {
#pragma unroll
            for (int cb = 0; cb < 4; ++cb)
#pragma unroll
                for (int e = 0; e < 4; ++e) tf[(4 * kq + e) * 64 + 16 * cb + l15] = orun[cb][e] * li[e];
        }
        { const int h = lane >> 3, d0 = (lane & 7) * 8;
          const f32x4 r0 = *(const LAS f32x4*)(tf + h * 64 + d0), r1 = *(const LAS f32x4*)(tf + h * 64 + d0 + 4);
          v4u w; w.x = cvtpk(r0[0], r0[1]); w.y = cvtpk(r0[2], r0[3]); w.z = cvtpk(r1[0], r1[1]); w.w = cvtpk(r1[2], r1[3]);
          *(v4u*)(OB + (rowbase + q) * 512 + h * 64 + d0) = w; }
    }
    __syncthreads();
    const int f0 = CNT[48], f1 = CNT[49], f2 = CNT[50], f3 = CNT[51];
    __syncthreads();
    const int fm = (f0 ? 1 : 0) | (f1 ? 2 : 0) | (f2 ? 4 : 0) | (f3 ? 8 : 0);
#pragma unroll 1
    for (int grp = 0; grp < 4; ++grp) if ((fm >> grp) & 1) dsa2_unit(b, 4 * g16 + grp, IQ, IK, IW, DQ, DK, DV, OB, lds, wave, lane);
}
__device__ __forceinline__ void fox_unit2(int bh, int qb, const bf16* FQ, const bf16* FK, const bf16* FV, const float* CUM, const int* T0, bf16* OA, LAS unsigned char* lds, int wave, int lane) {
    const int b = bh >> 3, h = bh & 7, r32 = lane & 31, hi = lane >> 5; const size_t rowbase = (size_t)b * SEQ; const int q0 = qb * 256 + wave * 32;
    const bf16* Qw = FQ + (rowbase + q0) * 512 + h * 64; bf16* Ow = OA + (rowbase + q0) * 512 + h * 64;
    const bf16* Kp = FK + rowbase * 512 + h * 64; const bf16* Vp = FV + rowbase * 512 + h * 64; const float* cb = CUM + (size_t)bh * SEQ;
    LAS unsigned char* wl = lds + wave * 16384;
    LAS float* bl = (LAS float*)(lds + RING_BYTES + 8192 + wave * 256);
    bf16x8 qr[4];
#pragma unroll
    for (int ks = 0; ks < 4; ++ks) qr[ks] = *(const bf16x8*)(Qw + (size_t)r32 * 512 + ks * 16 + hi * 8);
    const int tstart = T0[bh * 256 + q0 / 32], ntiles = q0 / 32 + 1, qlocal = q0 + r32;
    f32x16 o[2];
#pragma unroll
    for (int d0 = 0; d0 < 2; ++d0)
#pragma unroll
        for (int r = 0; r < 16; ++r) o[d0][r] = 0.f;
    float m = -1e30f, l = 0.f;
    const int lrow = lane >> 3, lch = lane & 7;
#define FOX_LOAD(KR, VR, BR, tt) do { _Pragma("unroll") for (int it = 0; it < 4; ++it) { const size_t ro = (size_t)(32 * (tt) + 8 * it + lrow) * 512 + lch * 8; KR[it] = *(const v4u*)(Kp + ro); VR[it] = *(const v4u*)(Vp + ro); } BR = cb[32 * (tt) + r32]; } while (0)
#define FOX_STORE(KR, VR, BR, bf) do { _Pragma("unroll") for (int it = 0; it < 4; ++it) { const int row = 8 * it + lrow; *(LAS v4u*)(wl + (bf) * 4096 + row * 128 + ((lch ^ (row & 7)) * 16)) = KR[it]; *(LAS v4u*)(wl + 8192 + (bf) * 4096 + row * 128 + lch * 16) = VR[it]; } if (lane < 32) bl[(bf) * 32 + lane] = -L2E * BR; } while (0)
    v4u krA[4], vrA[4], krB[4], vrB[4]; float brA = 0.f, brB = 0.f;
    const int kq = (lane >> 4) & 1, q_ = (lane & 15) >> 2, p_ = lane & 3;
    FOX_LOAD(krA, vrA, brA, tstart);
    if (tstart + 1 < ntiles) FOX_LOAD(krB, vrB, brB, tstart + 1);
    FOX_STORE(krA, vrA, brA, 0);
    auto compute = [&](int t, int buf) {
        const LAS unsigned char* kb = wl + buf * 4096; const LAS unsigned char* vb = wl + 8192 + buf * 4096; const LAS float* bb = bl + buf * 32;
        f32x16 p;
#pragma unroll
        for (int r = 0; r < 16; ++r) p[r] = 0.f;
#pragma unroll
        for (int ks = 0; ks < 4; ++ks) { const bf16x8 kf = *(const LAS bf16x8*)(kb + r32 * 128 + (((2 * ks + hi) ^ (r32 & 7)) * 16)); p = __builtin_amdgcn_mfma_f32_32x32x16_bf16(kf, qr[ks], p, 0, 0, 0); }
#pragma unroll
        for (int g = 0; g < 4; ++g) { const f32x4 c4 = *(const LAS f32x4*)(bb + 8 * g + 4 * hi);
#pragma unroll
            for (int jj = 0; jj < 4; ++jj) p[4 * g + jj] += c4[jj]; }
        if (t == ntiles - 1) {
#pragma unroll
            for (int r = 0; r < 16; ++r) if (32 * t + crow(r, hi) > qlocal) p[r] = -INFINITY;
        }
        float mt = p[0];
#pragma unroll
        for (int r = 1; r < 16; ++r) mt = fmaxf(mt, p[r]);
        mt = fmaxf(mt, __shfl_xor(mt, 32));
        const float mn = fmaxf(m, mt); const float alpha = __builtin_amdgcn_exp2f(m - mn); m = mn;
        l *= alpha;
#pragma unroll
        for (int d0 = 0; d0 < 2; ++d0)
#pragma unroll
            for (int r = 0; r < 16; ++r) o[d0][r] *= alpha;
        float ls = 0.f;
#pragma unroll
        for (int r = 0; r < 16; ++r) { p[r] = __builtin_amdgcn_exp2f(p[r] - mn); ls += p[r]; }
        l += ls;
        bf16x8 pa[2];
#pragma unroll
        for (int s2 = 0; s2 < 2; ++s2) { v4u w; w.x = cvtpk(p[8 * s2 + 0], p[8 * s2 + 1]); w.y = cvtpk(p[8 * s2 + 2], p[8 * s2 + 3]); w.z = cvtpk(p[8 * s2 + 4], p[8 * s2 + 5]); w.w = cvtpk(p[8 * s2 + 6], p[8 * s2 + 7]); pa[s2] = __builtin_bit_cast(bf16x8, w); }
#pragma unroll
        for (int d0 = 0; d0 < 2; ++d0)
#pragma unroll
            for (int s2 = 0; s2 < 2; ++s2) {
                const LAS unsigned char* a1 = vb + (16 * s2 + 4 * hi + q_) * 128 + (32 * d0 + 16 * kq + 4 * p_) * 2;
                const v4i16_t lo4 = __builtin_amdgcn_ds_read_tr16_b64_v4i16((LAS v4i16_t*)a1), hi4 = __builtin_amdgcn_ds_read_tr16_b64_v4i16((LAS v4i16_t*)(a1 + 8 * 128));
                const bf16x8 vf = (bf16x8){lo4[0], lo4[1], lo4[2], lo4[3], hi4[0], hi4[1], hi4[2], hi4[3]};
                o[d0] = __builtin_amdgcn_mfma_f32_32x32x16_bf16(vf, pa[s2], o[d0], 0, 0, 0);
            }
    };
    for (int t = tstart; t < ntiles; t += 2) {
        if (t + 2 < ntiles) FOX_LOAD(krA, vrA, brA, t + 2);
        compute(t, 0);
        if (t + 1 < ntiles) {
            FOX_STORE(krB, vrB, brB, 1);
            if (t + 3 < ntiles) FOX_LOAD(krB, vrB, brB, t + 3);
            compute(t + 1, 1);
            if (t + 2 < ntiles) FOX_STORE(krA, vrA, brA, 0);
        }
    }
#undef FOX_LOAD
#undef FOX_STORE
    l += __shfl_xor(l, 32);
    const float inv = 1.0f / l;
    bf16* orow = Ow + (size_t)r32 * 512;
#pragma unroll
    for (int d0 = 0; d0 < 2; ++d0)
#pragma unroll
        for (int g = 0; g < 4; ++g) { u32x2 w; w.x = cvtpk(o[d0][4 * g] * inv, o[d0][4 * g + 1] * inv); w.y = cvtpk(o[d0][4 * g + 2] * inv, o[d0][4 * g + 3] * inv);
            *(u32x2*)(orow + d0 * 32 + 8 * g + 4 * hi) = w; }
}
__device__ __forceinline__ void fox_unit4(int bh, int qb, const bf16* FQ, const bf16* FK, const bf16* FV, const float* CUM, const int* T0, const float* gq, const float* gk, bf16* OA, LAS unsigned char* lds, int wave, int lane) {
    const int b = bh >> 3, h = bh & 7, r32 = lane & 31, hi = lane >> 5; const size_t rowbase = (size_t)b * SEQ; const int q0 = qb * 256 + wave * 32;
    const bf16* Qw = FQ + (rowbase + q0) * 512 + h * 64; bf16* Ow = OA + (rowbase + q0) * 512 + h * 64;
    const bf16* Kp = FK + rowbase * 512 + h * 64; const bf16* Vp = FV + rowbase * 512 + h * 64; const float* cb = CUM + (size_t)bh * SEQ;
    LAS unsigned char* wl = lds + wave * 16384;
    LAS float* bl = (LAS float*)(lds + RING_BYTES + 8192 + wave * 256);
    bf16x8 qr[4];
#pragma unroll
    for (int ks = 0; ks < 4; ++ks) qr[ks] = *(const bf16x8*)(Qw + (size_t)r32 * 512 + ks * 16 + hi * 8);
    const int tstart = T0[bh * 256 + q0 / 32], tlast = q0 / 32, nseq = tlast - tstart + 1, qlocal = q0 + r32;
    const float stopc = (8.0f * wave_max(fabsf(gq[lane])) * wave_max(fabsf(gk[lane])) + 30.0f) * L2E;
    f32x16 o[2];
#pragma unroll
    for (int d0 = 0; d0 < 2; ++d0)
#pragma unroll
        for (int r = 0; r < 16; ++r) o[d0][r] = 0.f;
    float m = -1e30f, l = 0.f;
    const int lrow = lane >> 3, lch = lane & 7;
#define FOX_LOAD(KR, VR, BR, tt) do { _Pragma("unroll") for (int it = 0; it < 4; ++it) { const size_t ro = (size_t)(32 * (tt) + 8 * it + lrow) * 512 + lch * 8; KR[it] = *(const v4u*)(Kp + ro); VR[it] = *(const v4u*)(Vp + ro); } BR = cb[32 * (tt) + r32]; } while (0)
#define FOX_STORE(KR, VR, BR, bf) do { _Pragma("unroll") for (int it = 0; it < 4; ++it) { const int row = 8 * it + lrow; *(LAS v4u*)(wl + (bf) * 4096 + row * 128 + ((lch ^ (row & 7)) * 16)) = KR[it]; *(LAS v4u*)(wl + 8192 + (bf) * 4096 + row * 128 + lch * 16) = VR[it]; } if (lane < 32) bl[(bf) * 32 + lane] = -L2E * BR; } while (0)
    v4u krA[4], vrA[4], krB[4], vrB[4]; float brA = 0.f, brB = 0.f;
    const int kq = (lane >> 4) & 1, q_ = (lane & 15) >> 2, p_ = lane & 3;
    FOX_LOAD(krA, vrA, brA, tlast);
    if (1 < nseq) FOX_LOAD(krB, vrB, brB, tlast - 1);
    FOX_STORE(krA, vrA, brA, 0);
    auto compute = [&](int t, int buf) -> bool {
        const LAS unsigned char* kb = wl + buf * 4096; const LAS unsigned char* vb = wl + 8192 + buf * 4096; const LAS float* bb = bl + buf * 32;
        if (t != tlast) { const float bmax = bb[31]; if (__all(m > bmax + stopc)) return true; }
        f32x16 p;
#pragma unroll
        for (int r = 0; r < 16; ++r) p[r] = 0.f;
#pragma unroll
        for (int ks = 0; ks < 4; ++ks) { const bf16x8 kf = *(const LAS bf16x8*)(kb + r32 * 128 + (((2 * ks + hi) ^ (r32 & 7)) * 16)); p = __builtin_amdgcn_mfma_f32_32x32x16_bf16(kf, qr[ks], p, 0, 0, 0); }
#pragma unroll
        for (int g = 0; g < 4; ++g) { const f32x4 c4 = *(const LAS f32x4*)(bb + 8 * g + 4 * hi);
#pragma unroll
            for (int jj = 0; jj < 4; ++jj) p[4 * g + jj] += c4[jj]; }
        if (t == tlast) {
#pragma unroll
            for (int r = 0; r < 16; ++r) if (32 * t + crow(r, hi) > qlocal) p[r] = -INFINITY;
        }
        float mt = p[0];
#pragma unroll
        for (int r = 1; r < 16; ++r) mt = fmaxf(mt, p[r]);
        mt = fmaxf(mt, __shfl_xor(mt, 32));
        if (__any(mt > m)) {
            const float mn = fmaxf(m, mt); const float alpha = __builtin_amdgcn_exp2f(m - mn); m = mn;
            l *= alpha;
#pragma unroll
            for (int d0 = 0; d0 < 2; ++d0)
#pragma unroll
                for (int r = 0; r < 16; ++r) o[d0][r] *= alpha;
        }
        const float mn = m;
        float ls = 0.f;
#pragma unroll
        for (int r = 0; r < 16; ++r) { p[r] = __builtin_amdgcn_exp2f(p[r] - mn); ls += p[r]; }
        l += ls;
        bf16x8 pa[2];
#pragma unroll
        for (int s2 = 0; s2 < 2; ++s2) { v4u w; w.x = cvtpk(p[8 * s2 + 0], p[8 * s2 + 1]); w.y = cvtpk(p[8 * s2 + 2], p[8 * s2 + 3]); w.z = cvtpk(p[8 * s2 + 4], p[8 * s2 + 5]); w.w = cvtpk(p[8 * s2 + 6], p[8 * s2 + 7]); pa[s2] = __builtin_bit_cast(bf16x8, w); }
#pragma unroll
        for (int d0 = 0; d0 < 2; ++d0)
#pragma unroll
            for (int s2 = 0; s2 < 2; ++s2) {
                const LAS unsigned char* a1 = vb + (16 * s2 + 4 * hi + q_) * 128 + (32 * d0 + 16 * kq + 4 * p_) * 2;
                const v4i16_t lo4 = __builtin_amdgcn_ds_read_tr16_b64_v4i16((LAS v4i16_t*)a1), hi4 = __builtin_amdgcn_ds_read_tr16_b64_v4i16((LAS v4i16_t*)(a1 + 8 * 128));
                const bf16x8 vf = (bf16x8){lo4[0], lo4[1], lo4[2], lo4[3], hi4[0], hi4[1], hi4[2], hi4[3]};
                o[d0] = __builtin_amdgcn_mfma_f32_32x32x16_bf16(vf, pa[s2], o[d0], 0, 0, 0);
            }
        return false;
    };
    for (int i = 0; i < nseq; i += 2) {
        if (i + 2 < nseq) FOX_LOAD(krA, vrA, brA, tlast - (i + 2));
        if (compute(tlast - i, 0)) break;
        if (i + 1 < nseq) {
            FOX_STORE(krB, vrB, brB, 1);
            if (i + 3 < nseq) FOX_LOAD(krB, vrB, brB, tlast - (i + 3));
            if (compute(tlast - (i + 1), 1)) break;
            if (i + 2 < nseq) FOX_STORE(krA, vrA, brA, 0);
        }
    }
#undef FOX_LOAD
#undef FOX_STORE
    l += __shfl_xor(l, 32);
    const float inv = 1.0f / l;
    bf16* orow = Ow + (size_t)r32 * 512;
#pragma unroll
    for (int d0 = 0; d0 < 2; ++d0)
#pragma unroll
        for (int g = 0; g < 4; ++g) { u32x2 w; w.x = cvtpk(o[d0][4 * g] * inv, o[d0][4 * g + 1] * inv); w.y = cvtpk(o[d0][4 * g + 2] * inv, o[d0][4 * g + 3] * inv);
            *(u32x2*)(orow + d0 * 32 + 8 * g + 4 * hi) = w; }
}
#ifndef DBG_BRANCH_MASK
#define DBG_BRANCH_MASK 7
#endif
#ifndef DBG_NBR
#define DBG_NBR 3
#endif
#ifndef DBG_NOGATE
#define DBG_NOGATE 0
#endif
#ifndef DBG_NOBRANCH
#define DBG_NOBRANCH 0
#endif
#ifndef DBG_GATE_W
#define DBG_GATE_W WS_WGATE
#endif
#ifndef DBG_GATE_AS_BRANCH
#define DBG_GATE_AS_BRANCH 0
#endif
#ifndef REP_FOX
#define REP_FOX 1
#endif
#ifndef REP_DSA
#define REP_DSA 1
#endif
#ifndef REP_GEMM
#define REP_GEMM 1
#endif
#ifndef DBG_SUBST
#define DBG_SUBST 0
#endif
#ifndef P7SEL
#define P7SEL 3
#endif
#ifndef PHMASK
#define PHMASK 0xFFFF
#endif
struct Args { const void* in[24]; float* out; unsigned char* ws; };
#define CONVERT_GROUP(GRP, w_, nw_) do { \
    constexpr int I_GU = 16 * 176, I_D = 44 * 32, I_IN = 16 * 104, I_GT = 16 * 96, I_BR = 8 * 32, I_SQ = 16 * 32; \
    constexpr int NIT = (GRP) == 0 ? I_GU + I_SQ : (GRP) == 1 ? I_D + I_IN + I_GT + 3 * I_BR + I_SQ : I_GU + I_D; \
    LAS float* scr_ = (LAS float*)(L + RING_OFF + wave * 16384); \
    for (int it = (w_); it < NIT; it += (nw_)) { int r = it; \
        if ((GRP) == 0) { \
            if (r < I_GU) { transpose_item(0, ARG_IN(4), ARG_IN(5), 1024, DFF, ARG_IN(3), WSP(bf16, WS_WGU1), scr_, r, 176, lane); continue; } r -= I_GU; \
            transpose_item(1, ARG_IN(17), nullptr, 1024, 1024, ARG_IN(8), WSP(bf16, WS_WMKV), scr_, r, 32, lane); \
        } else if ((GRP) == 1) { \
            if (r < I_D) { transpose_item(1, ARG_IN(6), nullptr, DFF, 1024, nullptr, WSP(bf16, WS_WD1), scr_, r, 32, lane); continue; } r -= I_D; \
            if (r < I_IN) { transpose_item(2, ARG_IN(9), nullptr, 1024, DIN, ARG_IN(7), WSP(bf16, WS_WIN), scr_, r, 104, lane); continue; } r -= I_IN; \
            if (r < I_GT) { transpose_item(3, ARG_IN(9), nullptr, 1024, DIN, ARG_IN(7), WSP(bf16, WS_WGATE), scr_, r, 96, lane); continue; } r -= I_GT; \
            if (r < 3 * I_BR) { const int i = r / I_BR; transpose_item(1, ARG_IN(18) + (size_t)i * 512 * 1024, nullptr, 512, 1024, nullptr, WSP(bf16, WS_WBR) + (size_t)i * 1024 * 512, scr_, r % I_BR, 32, lane); continue; } r -= 3 * I_BR; \
            transpose_item(1, ARG_IN(19), nullptr, 1024, 1024, nullptr, WSP(bf16, WS_WOUT), scr_, r, 32, lane); \
        } else { \
            if (r < I_GU) { transpose_item(0, ARG_IN(21), ARG_IN(22), 1024, DFF, ARG_IN(20), WSP(bf16, WS_WGU2), scr_, r, 176, lane); continue; } r -= I_GU; \
            transpose_item(1, ARG_IN(23), nullptr, DFF, 1024, nullptr, WSP(bf16, WS_WD2), scr_, r, 32, lane); \
        } } } while (0)
__global__ void __launch_bounds__(NWAVES * 64, 2) fwd_mega(Args args) {
    extern __shared__ __attribute__((aligned(16))) unsigned char lds[];
    LAS unsigned char* L = (LAS unsigned char*)lds;
    volatile LAS unsigned* MISC = (volatile LAS unsigned*)(L + MISC_OFF);
    const int tid = threadIdx.x, lane = tid & 63, wave = __builtin_amdgcn_readfirstlane(tid >> 6);
    const int G = gridDim.x; const int bx = blockIdx.x; const int vcu = (G % 8 == 0) ? (bx % 8) * (G / 8) + bx / 8 : bx;
    const Args* ap = (const Args*)__builtin_amdgcn_kernarg_segment_ptr();
#define ARG_IN(k) ((const float*)ap->in[k])
#define WSP(type, off) ((type*)(ap->ws + (off)))
    gu32* ctl = (gu32*)(ap->ws + WS_CTL);
    for (int u = tid; u < (LDS_BYTES - LDSCTL_OFF) / 4; u += NWAVES * 64) ((LAS unsigned*)(L + LDSCTL_OFF))[u] = 0u;
    __syncthreads();
    XcdBarrier bar = xcd_barrier_post((unsigned*)(ctl + CW_BAR), MISC + 8);
#define GRID_BAR() xcd_barrier(bar)
    const int gw = vcu * NWAVES + wave, NGW = G * NWAVES;

#if (PHMASK >> 0) & 1
    {
        LAS float* scr = (LAS float*)(L + RING_OFF + wave * 16384);
        CONVERT_GROUP(0, gw, NGW);
        for (int m0 = gw; m0 < T + 512; m0 += 4 * NGW) {
            const float* xr[4]; bf16* orw[4]; float* ro[4]; bool ok[4];
#pragma unroll
            for (int r = 0; r < 4; ++r) { const int m = m0 + r * NGW; ok[r] = m < T + 512; const int mc = ok[r] ? m : gw;
                if (mc < T) { xr[r] = ARG_IN(0) + (size_t)mc * 1024; orw[r] = WSP(bf16, WS_HB) + (size_t)mc * 1024; ro[r] = WSP(float, WS_RSTDX) + mc; }
                else { xr[r] = ARG_IN(1) + (size_t)(mc - T) * 1024; orw[r] = WSP(bf16, WS_MEMB) + (size_t)(mc - T) * 1024; ro[r] = WSP(float, WS_RSTDM) + (mc - T); } }
            rows4_to_bf16_rstd(xr, orw, ro, ok, lane);
        }
        VM_WAIT(); __syncthreads();
        GRID_BAR();
    }
#endif
#if (PHMASK >> 1) & 1
    {
        if (bx >= G - 8) { pg8::Gemm g{WSP(bf16, WS_MEMB), WSP(bf16, WS_WMKV), 512, 1024, 1024}; pg8::StaticOrder S; S.init(512, 1024, G, bx - (G - 8));
        pg8::EpiMemKV E{WSP(float, WS_KVM), WSP(float, WS_RSTDM)};
        pg8::gemm_phase<pg8::EpiMemKV, pg8::StaticOrder, true, true>(L + RING_OFF, g, S, E); }
    }
#endif
#if (PHMASK >> 2) & 1
    {
        pg8::Gemm g{WSP(bf16, WS_HB), WSP(bf16, WS_WGU1), T, 2 * DFF, 1024}; pg8::StaticOrder S; S.init(T, 2 * DFF, G, bx);
        pg8::build_row_tab<0>(WSP(float, WS_RSTDX), S, (LAS float*)(L + RING_BYTES + 1024)); pg8::EpiSwiGLU<0> E{WSP(bf16, WS_HID), DFF, (LAS float*)(L + RING_BYTES + 1024)};
#pragma unroll 1
        for (int rep_ = 0; rep_ < REP_GEMM; ++rep_)
        pg8::gemm_phase<pg8::EpiSwiGLU<0>, pg8::StaticOrder, true, true>(L + RING_OFF, g, S, E);
        {
            const int nfull = (64 * 22) % G; const int nidle = (nfull == 0) ? G : G - nfull; const int first = G - nidle;
            if (bx >= first) { CONVERT_GROUP(1, (bx - first) * NWAVES + wave, nidle * NWAVES);
                for (int e = (bx - first) * NWAVES * 64 + tid; e < T * 32; e += nidle * NWAVES * 64) {
                    const int row = e >> 5, i = e & 31; const float inv_freq = powf(10000.0f, -(float)i * (1.0f / 32.0f));
                    const float ang = (float)((const int*)ap->in[2])[row] * inv_freq; float sn, cs; sincosf(ang, &sn, &cs); WSP(float, WS_COS)[e] = cs; WSP(float, WS_SIN)[e] = sn; } }
        }
        GRID_BAR();
    }
#endif
#if (PHMASK >> 3) & 1
    {
        pg8::Gemm g{WSP(bf16, WS_HID), WSP(bf16, WS_WD1), T, 1024, DFF}; pg8::StaticOrder S; S.init(T, 1024, G, bx);
        pg8::EpiResid2<true> E{ARG_IN(0), ap->out, WSP(bf16, WS_HB), WSP(float, WS_SSQ1), 0.5f};
#pragma unroll 1
        for (int rep_ = 0; rep_ < REP_GEMM; ++rep_)
        pg8::gemm_phase<pg8::EpiResid2<true>, pg8::StaticOrder, true, true>(L + RING_OFF, g, S, E);
        GRID_BAR();
    }
#endif
#if (PHMASK >> 4) & 1
    {
        pg8::Gemm g{WSP(bf16, WS_HB), WSP(bf16, WS_WIN), T, NPROJ, 1024}; pg8::StaticOrder S; S.init(T, NPROJ, G, bx);
        pg8::ProjOut PO{WSP(bf16, WS_FQ), WSP(bf16, WS_FK), WSP(bf16, WS_FV), WSP(bf16, WS_DQ), WSP(bf16, WS_IQ), WSP(bf16, WS_MQ), WSP(bf16, WS_DK), WSP(bf16, WS_DV), WSP(bf16, WS_IK), WSP(float, WS_LOGF), WSP(float, WS_IW), WSP(float, WS_COS), WSP(float, WS_SIN), ARG_IN(11), ARG_IN(12), ARG_IN(13), ARG_IN(14), ARG_IN(10)};
        pg8::build_row_tab<16>(WSP(float, WS_SSQ1), S, (LAS float*)(L + RING_BYTES + 1024)); pg8::EpiProj<16> E{PO, (LAS float*)(L + RING_BYTES + 1024), C2_64};
#pragma unroll 1
        for (int rep_ = 0; rep_ < REP_GEMM; ++rep_)
        pg8::gemm_phase<pg8::EpiProj<16>, pg8::StaticOrder, true, true>(L + RING_OFF, g, S, E);
        {
            const int nfull = (64 * 13) % G; const int nidle = (nfull == 0) ? G : G - nfull; const int first = G - nidle;
            if (bx >= first) { CONVERT_GROUP(2, (bx - first) * NWAVES + wave, nidle * NWAVES);
        for (int it = (bx - first) * NWAVES + wave; it < 2048; it += nidle * NWAVES) { const int row = it >> 2, h = it & 3;
                    const f32x2g kv = *(const f32x2g*)(WSP(float, WS_KVM) + (size_t)row * 1024 + h * 128 + 2 * lane); const f32x2g vv = *(const f32x2g*)(WSP(float, WS_KVM) + (size_t)row * 1024 + 512 + h * 128 + 2 * lane);
                    const float ss = wave_sum(kv.x * kv.x + kv.y * kv.y); const float rstd = 1.0f / sqrtf(ss * (1.0f / 128.0f) + 1e-6f);
                    const f32x2g gk = *(const f32x2g*)(ARG_IN(16) + 2 * lane);
                    *(unsigned*)(WSP(bf16, WS_KMB) + (size_t)row * 512 + h * 128 + 2 * lane) = pk2(kv.x * rstd * gk.x, kv.y * rstd * gk.y);
                    { const int bb = row >> 8, key = row & 255; bf16* vt = WSP(bf16, WS_VMB) + ((size_t)(bb * 4 + h) * 128 + 2 * lane) * MEMLEN + key; vt[0] = (bf16)f2bf(vv.x); vt[MEMLEN] = (bf16)f2bf(vv.y); } } }
        }
        GRID_BAR();
#if defined(DBG_DUMP_AFTER) && DBG_DUMP_AFTER == 4
        {
            const bf16* sa = WSP(bf16, DBG_DUMP_A); const bf16* sb = WSP(bf16, DBG_DUMP_B);
            for (size_t e = (size_t)vcu * 512 + tid; e < (size_t)T * 512; e += (size_t)G * 512) { const size_t row = e >> 9, c = e & 511;
                ap->out[row * 1024 + c] = bf2f(sa[row * DBG_PITCH + c]); ap->out[row * 1024 + 512 + c] = bf2f(sb[row * DBG_PITCH + c]); }
            return;
        }
#endif

    }
#endif
#if ((PHMASK >> 5) & 1) && !DBG_SUBST
    {
        for (int it = gw; it < 2048; it += NGW) mem_unit(it >> 2, it & 3, WSP(bf16, WS_MQ), WSP(bf16, WS_KMB), WSP(bf16, WS_VMB), ARG_IN(15), lane);
    }
#endif
#if ((PHMASK >> 6) & 1) && !DBG_SUBST
    {
        for (int rep_ = 0; rep_ < REP_FOX; ++rep_)
        for (int v = vcu; v < 256; v += G) { const int bh = v >> 4, s = v & 15;
            scan_unit(bh, WSP(float, WS_LOGF), WSP(float, WS_CUM), WSP(int, WS_T0), ARG_IN(11), ARG_IN(12), (LAS float*)(L + SCANX_OFF), (LAS float*)(L + RING_OFF), tid);
            asm volatile("s_waitcnt vmcnt(0)" ::: "memory"); __syncthreads();
            fox_unit4(bh, s, WSP(bf16, WS_FQ), WSP(bf16, WS_FK), WSP(bf16, WS_FV), WSP(float, WS_CUM), WSP(int, WS_T0), ARG_IN(11), ARG_IN(12), WSP(bf16, WS_OA), L, wave, lane); fox_unit4(bh, 31 - s, WSP(bf16, WS_FQ), WSP(bf16, WS_FK), WSP(bf16, WS_FV), WSP(float, WS_CUM), WSP(int, WS_T0), ARG_IN(11), ARG_IN(12), WSP(bf16, WS_OA), L, wave, lane); }
        __syncthreads();
        {
            gu32* qctr = ctl + CW_Q; LAS int* QW = (LAS int*)(L + D3_QW);
            const int pref = (vcu >> 5) & 1;
            unsigned raw = 0u; int cur;
            if (tid == 0) { unsigned u = __hip_atomic_fetch_add(qctr + 64 * pref, 1u, RLX_AGENT); int bsel = pref; if (u >= 512u) { bsel = pref ^ 1; u = __hip_atomic_fetch_add(qctr + 64 * bsel, 1u, RLX_AGENT); } QW[0] = (u < 512u) ? ((bsel << 16) | (int)u) : -1; }
            __syncthreads(); cur = QW[0]; __syncthreads();
            while (cur >= 0) {
                if (tid == 0) raw = __hip_atomic_fetch_add(qctr + 64 * pref, 1u, RLX_AGENT);
                dsa3_unit(cur >> 16, 511 - (cur & 0xffff), WSP(bf16, WS_IQ), WSP(bf16, WS_IK), WSP(float, WS_IW), WSP(bf16, WS_DQ), WSP(bf16, WS_DK), WSP(bf16, WS_DV), WSP(bf16, WS_OB), L, wave, lane);
                if (tid == 0) { unsigned u = raw; int bsel = pref; if (u >= 512u) { bsel = pref ^ 1; u = __hip_atomic_fetch_add(qctr + 64 * bsel, 1u, RLX_AGENT); } QW[0] = (u < 512u) ? ((bsel << 16) | (int)u) : -1; }
                __syncthreads(); cur = QW[0]; __syncthreads();
            }
        }
        GRID_BAR();
    }
#endif
#if (PHMASK >> 7) & 1
    {
        pg8::StaticOrder S; S.init(T, 1024, G, bx); pg8::build_row_tab<16>(WSP(float, WS_SSQ1), S, (LAS float*)(L + RING_BYTES + 1024));
#ifndef P7STREAM
#define P7STREAM 1
#endif
#if P7STREAM
        {   typedef pg8::P7Order<WS_HB, WS_WGATE, WS_OA, WS_OB, WS_MQ, WS_WBR> P7O; P7O O{S, (const char*)WSP(char, 0)};
            pg8::EpiP7 E{WSP(bf16, WS_GSCR), WSP(bf16, WS_MERGED), (LAS float*)(L + RING_BYTES + 1024)};
#ifndef REP_P7
#define REP_P7 1
#endif
#pragma unroll 1
            for (int rep7_ = 0; rep7_ < REP_P7; ++rep7_) pg8::gemm_stream<pg8::EpiP7, P7O>(L + RING_OFF, O, E); }
#pragma unroll 1
        for (int i = 0; i < 0; ++i) {
#else
#pragma unroll 1
        for (int rep_ = 0; rep_ < REP_GEMM; ++rep_)
#pragma unroll 1
        for (int i = 0; i < DBG_NBR; ++i) {
#endif
#if DBG_GATE_AS_BRANCH
            {   pg8::Gemm g{WSP(bf16, WS_HB), WSP(bf16, DBG_GATE_W), T, 1024, 1024}; pg8::EpiBranch E{WSP(bf16, WS_GSCR), WSP(bf16, WS_MERGED), true, 1.0f}; pg8::gemm_phase<pg8::EpiBranch, pg8::StaticOrder, true, true>(L + RING_OFF, g, S, E); }
#elif !DBG_NOGATE
            {   pg8::Gemm g{WSP(bf16, WS_HB), WSP(bf16, DBG_GATE_W) + (size_t)i * 1024 * 1024, T, 1024, 1024}; pg8::EpiGate<16> E{WSP(bf16, WS_GSCR), (LAS float*)(L + RING_BYTES + 1024)}; pg8::gemm_phase<pg8::EpiGate<16>, pg8::StaticOrder, true, true>(L + RING_OFF, g, S, E); }
#endif
#if !DBG_NOBRANCH
#if DBG_SUBST == 1
            {   const bf16* A = (i == 0) ? WSP(bf16, WS_FQ) : (i == 1) ? WSP(bf16, WS_DQ) : WSP(bf16, WS_IQ);
#elif DBG_SUBST == 2
            {   const bf16* A = (i == 0) ? WSP(bf16, WS_FK) : (i == 1) ? WSP(bf16, WS_FV) : WSP(bf16, WS_MQ);
#else
            {   const bf16* A = (i == 0) ? WSP(bf16, WS_OA) : (i == 1) ? WSP(bf16, WS_OB) : WSP(bf16, WS_MQ);
#endif
                pg8::Gemm g{A, WSP(bf16, WS_WBR) + (size_t)i * 1024 * 512, T, 1024, 512}; pg8::EpiBranch E{WSP(bf16, WS_GSCR), WSP(bf16, WS_MERGED), i == 0, ((DBG_BRANCH_MASK >> i) & 1) ? 1.0f : 0.0f}; pg8::gemm_phase<pg8::EpiBranch, pg8::StaticOrder, true, true>(L + RING_OFF, g, S, E); }
#endif
        }
        GRID_BAR();
#if defined(DBG_DUMP_AFTER) && DBG_DUMP_AFTER == 7
        {
            const bf16* sa = WSP(bf16, DBG_DUMP_A); const bf16* sb = WSP(bf16, DBG_DUMP_B);
            for (size_t e = (size_t)vcu * 512 + tid; e < (size_t)T * 512; e += (size_t)G * 512) { const size_t row = e >> 9, c = e & 511;
                ap->out[row * 1024 + c] = bf2f(sa[row * DBG_PITCH + c]); ap->out[row * 1024 + 512 + c] = bf2f(sb[row * DBG_PITCH + c]); }
            return;
        }
#endif

    }
#endif
#if (PHMASK >> 8) & 1
    {
        pg8::Gemm g{WSP(bf16, WS_MERGED), WSP(bf16, WS_WOUT), T, 1024, 1024}; pg8::StaticOrder S; S.init(T, 1024, G, bx);
        pg8::EpiResid2<true> E{ap->out, ap->out, WSP(bf16, WS_HB), WSP(float, WS_SSQ2), 1.0f};
        pg8::gemm_phase<pg8::EpiResid2<true>, pg8::StaticOrder, true, true>(L + RING_OFF, g, S, E);
        GRID_BAR();
    }
#endif
#if (PHMASK >> 9) & 1
    {
        pg8::Gemm g{WSP(bf16, WS_HB), WSP(bf16, WS_WGU2), T, 2 * DFF, 1024}; pg8::StaticOrder S; S.init(T, 2 * DFF, G, bx);
        pg8::build_row_tab<16>(WSP(float, WS_SSQ2), S, (LAS float*)(L + RING_BYTES + 1024)); pg8::EpiSwiGLU<16> E{WSP(bf16, WS_HID), DFF, (LAS float*)(L + RING_BYTES + 1024)};
#pragma unroll 1
        for (int rep_ = 0; rep_ < REP_GEMM; ++rep_)
        pg8::gemm_phase<pg8::EpiSwiGLU<16>, pg8::StaticOrder, true, true>(L + RING_OFF, g, S, E);
        GRID_BAR();
    }
#endif
#if (PHMASK >> 10) & 1
    {
        pg8::Gemm g{WSP(bf16, WS_HID), WSP(bf16, WS_WD2), T, 1024, DFF}; pg8::StaticOrder S; S.init(T, 1024, G, bx);
        pg8::EpiResid2<false> E{ap->out, ap->out, nullptr, nullptr, 0.5f};
        pg8::gemm_phase<pg8::EpiResid2<false>, pg8::StaticOrder, true, true>(L + RING_OFF, g, S, E);
    }
#endif
}

extern "C" void kernel_launch(void* const* d_in, const int* in_sizes, int n_in, void* d_out, int out_size, void* d_ws, size_t ws_size, hipStream_t stream) {
    static int grid = 0;
    if (grid == 0) {
        if (n_in != 24 || out_size != T * DM || ws_size < WS_END) { fprintf(stderr, "kernel_launch: unexpected problem (n_in %d, out %d, ws %zu)\n", n_in, out_size, ws_size); grid = -1; return; }
        int dev = 0, cus = 0, per_cu = 0;
        if (hipGetDevice(&dev) != hipSuccess || hipDeviceGetAttribute(&cus, hipDeviceAttributeMultiprocessorCount, dev) != hipSuccess) { grid = -1; return; }
        if (hipFuncSetAttribute((const void*)fwd_mega, hipFuncAttributeMaxDynamicSharedMemorySize, LDS_BYTES) != hipSuccess) { fprintf(stderr, "kernel_launch: hipFuncSetAttribute failed\n"); grid = -1; return; }
        if (hipOccupancyMaxActiveBlocksPerMultiprocessor(&per_cu, (const void*)fwd_mega, NWAVES * 64, LDS_BYTES) != hipSuccess || per_cu < 1) { fprintf(stderr, "kernel_launch: occupancy query says %d blocks per CU\n", per_cu); (void)hipGetLastError(); grid = -1; return; }
        grid = cus;
    }
    if (grid < 0) return;
    (void)hipMemsetAsync((char*)d_ws + WS_CTL, 0, CTL_ZERO_BYTES, stream);
    Args a{};
    for (int i = 0; i < 24; ++i) a.in[i] = d_in[i];
    a.out = (float*)d_out; a.ws = (unsigned char*)d_ws;
    hipLaunchKernelGGL(fwd_mega, dim3(grid), dim3(NWAVES * 64), LDS_BYTES, stream, a);
}
```

```cpp
#include <hip/hip_runtime.h>
#include <cstdio>
#include <cstdint>
namespace pg8 {
#define PG8_LAS __attribute__((address_space(3)))
typedef unsigned short bf16_t;
typedef short bf16x8 __attribute__((ext_vector_type(8)));
typedef float f32x4 __attribute__((ext_vector_type(4)));
typedef unsigned u32x4 __attribute__((ext_vector_type(4)));
constexpr int BM = 256, BK = 64, HALF = 128, HTB = HALF * BK * 2  , STAGE_BYTES = 8 * HTB, NXCD = 8, WGM = 8;

__host__ __device__ __forceinline__ int lds_byte(int r, int c) { const int st = (r >> 4) * 2 + (c >> 5), rr = r & 15, cc = c & 31, ob = rr * 64 + cc * 2; return st * 1024 + (ob ^ (((ob >> 9) & 1) << 5)); }
__host__ __device__ __forceinline__ void stage_rc(int b, int& R, int& C) { const int st = b / 1024, sb = b % 1024, swz = sb ^ (((sb >> 9) & 1) << 5); R = (st >> 1) * 16 + swz / 64; C = (st & 1) * 32 + (swz % 64) / 2; }
__host__ __device__ __forceinline__ int perm32(int rho) { const int n = rho >> 4, i = rho & 15; return 8 * (i >> 2) + 4 * n + (i & 3); }

struct Unit { int pm, pn; };
struct Gemm { const bf16_t* A; const bf16_t* Bt; int M, N, K; };

struct StaticOrder {
    int nM, nN, nwg, G, c;
    __host__ __device__ void init(int M, int N, int G_, int c_) { nM = M / BM; nN = N / BM; nwg = nM * nN; G = G_; c = c_; }
    __host__ __device__ bool next(int i, Unit& u) const {
        const long L = (long)i * G + c; if (L >= nwg) return false;
        int wgid = (int)L; { const int q = nwg / NXCD, r = nwg % NXCD, xcd = wgid % NXCD, off = wgid / NXCD; wgid = (xcd < r ? xcd * (q + 1) : r * (q + 1) + (xcd - r) * q) + off; }
        const int nig = WGM * nN, gid = wgid / nig, fm = gid * WGM, gsz = (nM - fm) < WGM ? (nM - fm) : WGM;
        u.pm = fm + ((wgid % nig) % gsz); u.pn = (wgid % nig) / gsz; return true;
    }
    __device__ __forceinline__ void a_ready(const Unit&) const {}
    __device__ __forceinline__ void done(const Unit&) const {}
};

typedef float f32x2cv __attribute__((ext_vector_type(2))); typedef __bf16 bf16x2cv __attribute__((ext_vector_type(2)));
__device__ __forceinline__ unsigned cvt_pk_bf16(float lo, float hi) { const f32x2cv v = {lo, hi}; const bf16x2cv b = __builtin_convertvector(v, bf16x2cv); return __builtin_bit_cast(unsigned, b); }
typedef float f32x2 __attribute__((ext_vector_type(2)));
template <class Epi, class Sched, bool ALIGN_EPI = false, bool SP2 = false>
__device__ __forceinline__ void gemm_phase(PG8_LAS unsigned char* lds, const Gemm g, const Sched& S, const Epi& E) {
    int tid_ = threadIdx.x; asm volatile("" : "+v"(tid_));
    const int tid = tid_, wid = __builtin_amdgcn_readfirstlane(tid >> 6), lane = tid & 63, wr = wid >> 2, wc = wid & 3, fr = lane & 15, fq = lane >> 4;
    const int K = g.K, nt = K / BK;
    unsigned voffA[2], voffB[2];
#pragma unroll
    for (int i = 0; i < 2; ++i) { int R, C; stage_rc(tid * 16 + i * 8192, R, C); const int Rb = Epi::PERM ? ((R & ~31) + perm32(R & 31)) : R;
        voffA[i] = (unsigned)(R * K + C) * 2u; voffB[i] = (unsigned)(Rb * K + C) * 2u; }
    const size_t kstep = (size_t)(BK * 2);
    const size_t hstep = (size_t)HALF * K * 2;
    const size_t tstep = 2 * hstep;
    const unsigned ldsw = (unsigned)wid * 1024u;
    const int aoff = lds_byte(wr * 64 + fr, fq * 8), boff = lds_byte(wc * 32 + fr, fq * 8);
#define PG8_SA(b, h) (((b) * 2 + (h)) * HTB)
#define PG8_SB(b, h) ((4 + (b) * 2 + (h)) * HTB)
#define PG8_STAGE(bufoff, gbase, voff) do { _Pragma("unroll") for (int _i = 0; _i < 2; ++_i) \
        __builtin_amdgcn_global_load_lds((const unsigned*)((const char*)(gbase) + (voff)[_i]), (PG8_LAS unsigned*)(lds + (bufoff) + ldsw + _i * 8192), 16, 0, 0); } while (0)
#define PG8_LDA(dst, b, h) do { _Pragma("unroll") for (int m = 0; m < 4; ++m) _Pragma("unroll") for (int k = 0; k < 2; ++k) dst[m][k] = *(const PG8_LAS bf16x8*)(lds + PG8_SA(b, h) + aoff + m * 2048 + k * 1024); } while (0)
#define PG8_LDB(dst, b, h) do { _Pragma("unroll") for (int n = 0; n < 2; ++n) _Pragma("unroll") for (int k = 0; k < 2; ++k) dst[n][k] = *(const PG8_LAS bf16x8*)(lds + PG8_SB(b, h) + boff + n * 2048 + k * 1024); } while (0)
#define PG8_MMA(ai, bj, At, Bt) do { __builtin_amdgcn_s_setprio(1); _Pragma("unroll") for (int m = 0; m < 4; ++m) _Pragma("unroll") for (int n = 0; n < 2; ++n) _Pragma("unroll") for (int k = 0; k < 2; ++k) \
        acc[ai][bj][m][n] = __builtin_amdgcn_mfma_f32_16x16x32_bf16(Bt[n][k], At[m][k], acc[ai][bj][m][n], 0, 0, 0); __builtin_amdgcn_s_setprio(0); } while (0)
#define PG8_WAIT_V(n) asm volatile("s_waitcnt vmcnt(" #n ")" ::: "memory")
#define PG8_WAIT_L(n) asm volatile("s_waitcnt lgkmcnt(" #n ")" ::: "memory")
#define PG8_BAR __builtin_amdgcn_s_barrier()
#define PG8_SCHED __builtin_amdgcn_sched_barrier(0)
    Unit cur, nxt; int ui = 0;
    if (!S.next(0, cur)) return;
    f32x4 acc[2][2][4][2];
#pragma unroll
    for (int a = 0; a < 2; ++a)
#pragma unroll
        for (int b = 0; b < 2; ++b)
#pragma unroll
            for (int m = 0; m < 4; ++m)
#pragma unroll
                for (int n = 0; n < 2; ++n) acc[a][b][m][n] = (f32x4){0.f, 0.f, 0.f, 0.f};
    bf16x8 At[4][2], B0[2][2], B1[2][2];
    const char* cA = (const char*)g.A + (size_t)cur.pm * tstep; const char* cB = (const char*)g.Bt + (size_t)cur.pn * tstep;
    S.a_ready(cur);
    if constexpr (SP2) {
        PG8_STAGE(PG8_SB(0, 0), cB, voffB); PG8_STAGE(PG8_SB(0, 1), cB + hstep, voffB); PG8_STAGE(PG8_SA(0, 0), cA, voffA); PG8_STAGE(PG8_SA(0, 1), cA + hstep, voffA);
        if (wr == 1) PG8_BAR;
        PG8_WAIT_V(2); PG8_BAR;
        PG8_STAGE(PG8_SB(1, 0), cB + kstep, voffB); PG8_STAGE(PG8_SA(1, 0), cA + kstep, voffA); PG8_STAGE(PG8_SB(1, 1), cB + hstep + kstep, voffB);
        PG8_WAIT_V(6); PG8_BAR;
    } else {
        PG8_STAGE(PG8_SB(0, 0), cB, voffB); PG8_STAGE(PG8_SA(0, 0), cA, voffA); PG8_STAGE(PG8_SB(0, 1), cB + hstep, voffB); PG8_STAGE(PG8_SA(0, 1), cA + hstep, voffA);
        if (wr == 1) PG8_BAR;
        PG8_WAIT_V(4); PG8_BAR;
        PG8_STAGE(PG8_SB(1, 0), cB + kstep, voffB); PG8_STAGE(PG8_SA(1, 0), cA + kstep, voffA); PG8_STAGE(PG8_SB(1, 1), cB + hstep + kstep, voffB);
        PG8_WAIT_V(6); PG8_BAR;
    }
    for (;;) {
        const bool has_next = S.next(ui + 1, nxt);
        const char* nA = has_next ? (const char*)g.A + (size_t)nxt.pm * tstep : cA; const char* nB = has_next ? (const char*)g.Bt + (size_t)nxt.pn * tstep : cB;
        for (int t = 0; t < nt; t += 2) {
            const bool last = (t == nt - 2);
            const char* a1 = cA + (size_t)(t + 1) * kstep;
            const char* a2 = last ? nA : cA + (size_t)(t + 2) * kstep; const char* b2 = last ? nB : cB + (size_t)(t + 2) * kstep;
            const char* a3 = a2 + kstep; const char* b3 = b2 + kstep;
            if (last && has_next) S.a_ready(nxt);
            if constexpr (SP2) {
            PG8_LDB(B0, 0, 0); PG8_LDB(B1, 0, 1); PG8_SCHED; PG8_LDA(At, 0, 0); PG8_STAGE(PG8_SA(1, 1), a1 + hstep, voffA);
            PG8_WAIT_V(8); PG8_WAIT_L(0); PG8_BAR; PG8_MMA(0, 0, At, B0); PG8_MMA(0, 1, At, B1); PG8_BAR; PG8_SCHED;
            PG8_LDA(At, 0, 1); PG8_STAGE(PG8_SB(0, 0), b2, voffB); PG8_STAGE(PG8_SB(0, 1), b2 + hstep, voffB); PG8_STAGE(PG8_SA(0, 0), a2, voffA);
            PG8_WAIT_V(8); PG8_WAIT_L(0); PG8_BAR; PG8_MMA(1, 0, At, B0); PG8_MMA(1, 1, At, B1); PG8_BAR; PG8_SCHED;
            PG8_LDB(B0, 1, 0); PG8_LDB(B1, 1, 1); PG8_SCHED; PG8_LDA(At, 1, 0); PG8_STAGE(PG8_SA(0, 1), a2 + hstep, voffA);
            PG8_WAIT_V(8); PG8_WAIT_L(0); PG8_BAR; PG8_MMA(0, 0, At, B0); PG8_MMA(0, 1, At, B1); PG8_BAR; PG8_SCHED;
            PG8_LDA(At, 1, 1); PG8_STAGE(PG8_SB(1, 0), b3, voffB); PG8_STAGE(PG8_SB(1, 1), b3 + hstep, voffB); PG8_STAGE(PG8_SA(1, 0), a3, voffA);
            PG8_WAIT_V(8); PG8_WAIT_L(0); PG8_BAR; PG8_MMA(1, 0, At, B0); PG8_MMA(1, 1, At, B1); PG8_BAR; PG8_SCHED;
            } else {
            PG8_LDB(B0, 0, 0); PG8_SCHED; PG8_LDA(At, 0, 0); PG8_STAGE(PG8_SA(1, 1), a1 + hstep, voffA);
            PG8_WAIT_L(8); PG8_BAR; PG8_WAIT_L(0); PG8_MMA(0, 0, At, B0); PG8_BAR; PG8_SCHED;
            PG8_LDB(B1, 0, 1); PG8_STAGE(PG8_SB(0, 0), b2, voffB);
            PG8_BAR; PG8_WAIT_L(0); PG8_MMA(0, 1, At, B1); PG8_BAR;
            PG8_LDA(At, 0, 1); PG8_STAGE(PG8_SA(0, 0), a2, voffA);
            PG8_BAR; PG8_WAIT_L(0); PG8_MMA(1, 0, At, B0); PG8_BAR; PG8_SCHED;
            PG8_STAGE(PG8_SB(0, 1), b2 + hstep, voffB);
            PG8_WAIT_V(6); PG8_BAR; PG8_MMA(1, 1, At, B1); PG8_BAR;
            PG8_LDB(B0, 1, 0); PG8_SCHED; PG8_LDA(At, 1, 0); PG8_STAGE(PG8_SA(0, 1), a2 + hstep, voffA);
            PG8_WAIT_L(8); PG8_BAR; PG8_WAIT_L(0); PG8_MMA(0, 0, At, B0); PG8_BAR; PG8_SCHED;
            PG8_LDB(B1, 1, 1); PG8_STAGE(PG8_SB(1, 0), b3, voffB);
            PG8_BAR; PG8_WAIT_L(0); PG8_MMA(0, 1, At, B1); PG8_BAR;
            PG8_LDA(At, 1, 1); PG8_STAGE(PG8_SA(1, 0), a3, voffA);
            PG8_BAR; PG8_WAIT_L(0); PG8_MMA(1, 0, At, B0); PG8_BAR; PG8_SCHED;
            PG8_STAGE(PG8_SB(1, 1), b3 + hstep, voffB);
            PG8_WAIT_V(6); PG8_BAR; PG8_MMA(1, 1, At, B1); PG8_BAR;
            }
        }
        if constexpr (ALIGN_EPI) { if (wr == 0) PG8_BAR; }
        if constexpr (!Epi::AFTER_DRAIN) { E(acc, cur, wr, wc, fr, fq); S.done(cur); }
        if (!has_next) break;
#pragma unroll
        for (int a = 0; a < 2; ++a)
#pragma unroll
            for (int b = 0; b < 2; ++b)
#pragma unroll
                for (int m = 0; m < 4; ++m)
#pragma unroll
                    for (int n = 0; n < 2; ++n) acc[a][b][m][n] = (f32x4){0.f, 0.f, 0.f, 0.f};
        cur = nxt; cA = nA; cB = nB; ++ui;
        if constexpr (ALIGN_EPI) { if (wr == 1) PG8_BAR; }
    }
    PG8_WAIT_V(0);
    if constexpr (!ALIGN_EPI) { if (wr == 0) PG8_BAR; }
    PG8_BAR;
    if constexpr (Epi::AFTER_DRAIN) { E.fused(acc, cur, wr, wc, fr, fq, lds, wid, lane); S.done(cur); }
#undef PG8_SA
#undef PG8_SB
#undef PG8_STAGE
#undef PG8_LDA
#undef PG8_LDB
#undef PG8_MMA
#undef PG8_WAIT_V
#undef PG8_WAIT_L
#undef PG8_BAR
#undef PG8_SCHED
}

struct UnitX { int pm, pn, kind, round; };
struct OpsX { const char* A; const char* Bt; int K; };
template <class Epi, class Sched>
__device__ __forceinline__ void gemm_stream(PG8_LAS unsigned char* lds, const Sched& S, const Epi& E) {
    int tid_ = threadIdx.x; asm volatile("" : "+v"(tid_));
    const int tid = tid_, wid = __builtin_amdgcn_readfirstlane(tid >> 6), lane = tid & 63, wr = wid >> 2, wc = wid & 3, fr = lane & 15, fq = lane >> 4;
    unsigned rA[2], rB[2], c2[2];
#pragma unroll
    for (int i = 0; i < 2; ++i) { int R, C; stage_rc(tid * 16 + i * 8192, R, C); rA[i] = (unsigned)R; rB[i] = (unsigned)((R & ~31) + perm32(R & 31)); c2[i] = (unsigned)C * 2u; }
    const size_t kstep = (size_t)(BK * 2);
    const unsigned ldsw = (unsigned)wid * 1024u;
    const int aoff = lds_byte(wr * 64 + fr, fq * 8), boff = lds_byte(wc * 32 + fr, fq * 8);
#define PG8_SA(b, h) (((b) * 2 + (h)) * HTB)
#define PG8_SB(b, h) ((4 + (b) * 2 + (h)) * HTB)
#define PGX_STAGE(bufoff, gbase, rr, pb) do { _Pragma("unroll") for (int _i = 0; _i < 2; ++_i) \
        __builtin_amdgcn_global_load_lds((const unsigned*)((const char*)(gbase) + ((rr)[_i] * (pb) + c2[_i])), (PG8_LAS unsigned*)(lds + (bufoff) + ldsw + _i * 8192), 16, 0, 0); } while (0)
#define PG8_LDA(dst, b, h) do { _Pragma("unroll") for (int m = 0; m < 4; ++m) _Pragma("unroll") for (int k = 0; k < 2; ++k) dst[m][k] = *(const PG8_LAS bf16x8*)(lds + PG8_SA(b, h) + aoff + m * 2048 + k * 1024); } while (0)
#define PG8_LDB(dst, b, h) do { _Pragma("unroll") for (int n = 0; n < 2; ++n) _Pragma("unroll") for (int k = 0; k < 2; ++k) dst[n][k] = *(const PG8_LAS bf16x8*)(lds + PG8_SB(b, h) + boff + n * 2048 + k * 1024); } while (0)
#define PG8_MMA(ai, bj, At, Bt) do { __builtin_amdgcn_s_setprio(1); _Pragma("unroll") for (int m = 0; m < 4; ++m) _Pragma("unroll") for (int n = 0; n < 2; ++n) _Pragma("unroll") for (int k = 0; k < 2; ++k) \
        acc[ai][bj][m][n] = __builtin_amdgcn_mfma_f32_16x16x32_bf16(Bt[n][k], At[m][k], acc[ai][bj][m][n], 0, 0, 0); __builtin_amdgcn_s_setprio(0); } while (0)
#define PG8_WAIT_V(n) asm volatile("s_waitcnt vmcnt(" #n ")" ::: "memory")
#define PG8_WAIT_L(n) asm volatile("s_waitcnt lgkmcnt(" #n ")" ::: "memory")
#define PG8_BAR __builtin_amdgcn_s_barrier()
#define PG8_SCHED __builtin_amdgcn_sched_barrier(0)
    UnitX cur, nxt; int ui = 0;
    if (!S.next(0, cur)) return;
    f32x4 acc[2][2][4][2];
#pragma unroll
    for (int a = 0; a < 2; ++a)
#pragma unroll
        for (int b = 0; b < 2; ++b)
#pragma unroll
            for (int m = 0; m < 4; ++m)
#pragma unroll
                for (int n = 0; n < 2; ++n) acc[a][b][m][n] = (f32x4){0.f, 0.f, 0.f, 0.f};
    bf16x8 At[4][2], B0[2][2], B1[2][2];
    OpsX oc = S.ops(cur);
    const char* cA = oc.A; const char* cB = oc.Bt; int Kc = oc.K;
    {   const unsigned pb = (unsigned)Kc * 2u; const size_t hstep = (size_t)HALF * pb;
        PGX_STAGE(PG8_SB(0, 0), cB, rB, pb); PGX_STAGE(PG8_SB(0, 1), cB + hstep, rB, pb); PGX_STAGE(PG8_SA(0, 0), cA, rA, pb); PGX_STAGE(PG8_SA(0, 1), cA + hstep, rA, pb);
        if (wr == 1) PG8_BAR;
        PG8_WAIT_V(2); PG8_BAR;
        PGX_STAGE(PG8_SB(1, 0), cB + kstep, rB, pb); PGX_STAGE(PG8_SA(1, 0), cA + kstep, rA, pb); PGX_STAGE(PG8_SB(1, 1), cB + hstep + kstep, rB, pb);
        PG8_WAIT_V(6); PG8_BAR; }
    for (;;) {
        const bool has_next = S.next(ui + 1, nxt);
        OpsX on = oc; if (has_next) on = S.ops(nxt);
        const char* nA = on.A; const char* nB = on.Bt; const int Kn = on.K;
        const int nt = Kc / BK; const unsigned pbc = (unsigned)Kc * 2u; const size_t hstep = (size_t)HALF * pbc;
        for (int t = 0; t < nt; t += 2) {
            const bool last = (t == nt - 2);
            const char* a1 = cA + (size_t)(t + 1) * kstep;
            const char* a2 = last ? nA : cA + (size_t)(t + 2) * kstep; const char* b2 = last ? nB : cB + (size_t)(t + 2) * kstep;
            const char* a3 = a2 + kstep; const char* b3 = b2 + kstep;
            const unsigned pb2 = last ? (unsigned)Kn * 2u : pbc; const size_t h2 = (size_t)HALF * pb2;
            PG8_LDB(B0, 0, 0); PG8_LDB(B1, 0, 1); PG8_SCHED; PG8_LDA(At, 0, 0); PGX_STAGE(PG8_SA(1, 1), a1 + hstep, rA, pbc);
            PG8_WAIT_V(8); PG8_WAIT_L(0); PG8_BAR; PG8_MMA(0, 0, At, B0); PG8_MMA(0, 1, At, B1); PG8_BAR; PG8_SCHED;
            PG8_LDA(At, 0, 1); PGX_STAGE(PG8_SB(0, 0), b2, rB, pb2); PGX_STAGE(PG8_SB(0, 1), b2 + h2, rB, pb2); PGX_STAGE(PG8_SA(0, 0), a2, rA, pb2);
            PG8_WAIT_V(8); PG8_WAIT_L(0); PG8_BAR; PG8_MMA(1, 0, At, B0); PG8_MMA(1, 1, At, B1); PG8_BAR; PG8_SCHED;
            PG8_LDB(B0, 1, 0); PG8_LDB(B1, 1, 1); PG8_SCHED; PG8_LDA(At, 1, 0); PGX_STAGE(PG8_SA(0, 1), a2 + h2, rA, pb2);
            PG8_WAIT_V(8); PG8_WAIT_L(0); PG8_BAR; PG8_MMA(0, 0, At, B0); PG8_MMA(0, 1, At, B1); PG8_BAR; PG8_SCHED;
            PG8_LDA(At, 1, 1); PGX_STAGE(PG8_SB(1, 0), b3, rB, pb2); PGX_STAGE(PG8_SB(1, 1), b3 + h2, rB, pb2); PGX_STAGE(PG8_SA(1, 0), a3, rA, pb2);
            PG8_WAIT_V(8); PG8_WAIT_L(0); PG8_BAR; PG8_MMA(1, 0, At, B0); PG8_MMA(1, 1, At, B1); PG8_BAR; PG8_SCHED;
        }
        if (wr == 0) PG8_BAR;
        E(acc, cur, wr, wc, fr, fq);
        if (!has_next) break;
#pragma unroll
        for (int a = 0; a < 2; ++a)
#pragma unroll
            for (int b = 0; b < 2; ++b)
#pragma unroll
                for (int m = 0; m < 4; ++m)
#pragma unroll
                    for (int n = 0; n < 2; ++n) acc[a][b][m][n] = (f32x4){0.f, 0.f, 0.f, 0.f};
        cur = nxt; oc = on; cA = nA; cB = nB; Kc = Kn; ++ui;
        if (wr == 1) PG8_BAR;
    }
    PG8_WAIT_V(0);
    PG8_BAR;
#undef PG8_SA
#undef PG8_SB
#undef PGX_STAGE
#undef PG8_LDA
#undef PG8_LDB
#undef PG8_MMA
#undef PG8_WAIT_V
#undef PG8_WAIT_L
#undef PG8_BAR
#undef PG8_SCHED
}
}
namespace pg8 {
constexpr int TOK = 16384;
constexpr float RMS_EPS = 1e-6f;
typedef float f32x2e __attribute__((ext_vector_type(2)));
template <int NP> __device__ __forceinline__ void row_scales(const float* src, int rowbase, int lane, int fr, float (&r)[2][4]) {
#pragma unroll
    for (int ai = 0; ai < 2; ++ai) {
        const int row = rowbase + 128 * ai + lane; float v;
        if (NP == 0) v = src[row];
        else { float s = 0.f;
#pragma unroll
            for (int p = 0; p < NP; ++p) s += src[(size_t)p * TOK + row];
            v = __builtin_amdgcn_rsqf(s * (1.0f / 1024.0f) + RMS_EPS); }
#pragma unroll
        for (int m = 0; m < 4; ++m) r[ai][m] = __shfl(v, 16 * m + fr);
    }
}
template <int NP, class Sched> __device__ __forceinline__ void build_row_tab(const float* src, const Sched& S, PG8_LAS float* tab) {
    Unit u;
    for (int i = 0; S.next(i, u); ++i)
        for (int r = (int)threadIdx.x; r < 256; r += 512) { const int row = u.pm * BM + r; float v;
            if (NP == 0) v = src[row];
            else { float s = 0.f;
#pragma unroll
                for (int p = 0; p < NP; ++p) s += src[(size_t)p * TOK + row];
                v = __builtin_amdgcn_rsqf(s * (1.0f / 1024.0f) + RMS_EPS); }
            tab[i * 256 + r] = v; }
    __syncthreads();
}
__device__ __forceinline__ void row_scales_tab(const PG8_LAS float* tab, int ui, int wr, int fr, float (&r)[2][4]) {
#pragma unroll
    for (int ai = 0; ai < 2; ++ai)
#pragma unroll
        for (int m = 0; m < 4; ++m) r[ai][m] = tab[ui * 256 + ai * 128 + wr * 64 + 16 * m + fr];
}
__device__ __forceinline__ float silu_f(float x) { return x * __builtin_amdgcn_rcpf(1.0f + __expf(-x)); }
__device__ __forceinline__ float sigmoid_f(float x) { return __builtin_amdgcn_rcpf(1.0f + __expf(-x)); }

template <int NP> struct EpiSwiGLU {
    static constexpr bool PERM = true, AFTER_DRAIN = false;
    bf16_t* H; int ldh; const PG8_LAS float* tab; mutable int ui = 0;
    __device__ __forceinline__ void operator()(const f32x4 (&acc)[2][2][4][2], const Unit& u, int wr, int wc, int fr0, int fq0) const {
        int fr = fr0, fq = fq0; asm volatile("" : "+v"(fr), "+v"(fq));
        float r[2][4]; row_scales_tab(tab, ui++, wr, fr, r);
        const int col0 = u.pn * 128 + wc * 32 + 8 * fq;
#pragma unroll
        for (int ai = 0; ai < 2; ++ai)
#pragma unroll
            for (int m = 0; m < 4; ++m) {
                const int row = u.pm * BM + ai * HALF + wr * 64 + m * 16 + fr; const float rr = r[ai][m];
                float o[8]; const float k1 = -1.44269504f * rr, rr2 = rr * rr;
#pragma unroll
                for (int n = 0; n < 2; ++n)
#pragma unroll
                    for (int j = 0; j < 4; j += 2) { const f32x2 g2 = (f32x2){acc[ai][0][m][n][j], acc[ai][0][m][n][j + 1]}, u2 = (f32x2){acc[ai][1][m][n][j], acc[ai][1][m][n][j + 1]};
                        const f32x2 t2 = g2 * k1; const f32x2 d2 = (f32x2){__builtin_amdgcn_exp2f(t2[0]), __builtin_amdgcn_exp2f(t2[1])} + 1.0f;
                        const f32x2 r2 = (f32x2){__builtin_amdgcn_rcpf(d2[0]), __builtin_amdgcn_rcpf(d2[1])} * rr2; const f32x2 o2 = (g2 * u2) * r2;
                        o[4 * n + j] = o2[0]; o[4 * n + j + 1] = o2[1]; }
                u32x4 w; w.x = cvt_pk_bf16(o[0], o[1]); w.y = cvt_pk_bf16(o[2], o[3]); w.z = cvt_pk_bf16(o[4], o[5]); w.w = cvt_pk_bf16(o[6], o[7]);
                *(u32x4*)(H + (size_t)row * ldh + col0) = w;
            }
    }
};
template <bool WRITE_HB> struct EpiResid {
    static constexpr bool PERM = true, AFTER_DRAIN = false;
    const float* base; float* out; bf16_t* hb; float* part; float sc;
    __device__ __forceinline__ void operator()(const f32x4 (&acc)[2][2][4][2], const Unit& u, int wr, int wc, int fr0, int fq0) const {
        int fr = fr0, fq = fq0; asm volatile("" : "+v"(fr), "+v"(fq));
        const int col0 = u.pn * BM + wc * 32 + 8 * fq;
#pragma unroll
        for (int ai = 0; ai < 2; ++ai)
#pragma unroll
            for (int m = 0; m < 4; ++m) {
                const int row = u.pm * BM + ai * HALF + wr * 64 + m * 16 + fr; float ss = 0.f;
#pragma unroll
                for (int bj = 0; bj < 2; ++bj) {
                    const size_t off = (size_t)row * 1024 + col0 + bj * HALF;
                    const f32x4 b0 = *(const f32x4*)(base + off), b1 = *(const f32x4*)(base + off + 4);
                    const f32x4 o0 = b0 + acc[ai][bj][m][0] * sc, o1 = b1 + acc[ai][bj][m][1] * sc;
                    *(f32x4*)(out + off) = o0; *(f32x4*)(out + off + 4) = o1;
                    if (WRITE_HB) {
                        ss += (o0[0] * o0[0] + o0[1] * o0[1]) + (o0[2] * o0[2] + o0[3] * o0[3]) + (o1[0] * o1[0] + o1[1] * o1[1]) + (o1[2] * o1[2] + o1[3] * o1[3]);
                        u32x4 w; w.x = cvt_pk_bf16(o0[0], o0[1]); w.y = cvt_pk_bf16(o0[2], o0[3]); w.z = cvt_pk_bf16(o1[0], o1[1]); w.w = cvt_pk_bf16(o1[2], o1[3]);
                        *(u32x4*)(hb + off) = w; }
                }
                if (WRITE_HB) { ss += __shfl_xor(ss, 16); ss += __shfl_xor(ss, 32); if (fq == 0) part[(size_t)(u.pn * 4 + wc) * TOK + row] = ss; }
                if (m == 3) asm volatile("" ::: "memory");
            }
    }
};
template <bool WRITE_HB> struct EpiResid2 {
    static constexpr bool PERM = true, AFTER_DRAIN = false;
    const float* base; float* out; bf16_t* hb; float* part; float sc;
    __device__ __forceinline__ void operator()(const f32x4 (&acc)[2][2][4][2], const Unit& u, int wr, int wc, int fr0, int fq0) const {
        int fr = fr0, fq = fq0; asm volatile("" : "+v"(fr), "+v"(fq));
        const int row0 = u.pm * BM + wr * 64 + fr; const size_t o00 = (size_t)row0 * 1024 + u.pn * BM + wc * 32 + 8 * fq;
        const float* bp = base + o00; float* op = out + o00; bf16_t* hp = hb + o00;
        f32x4 bq[2][8];
#define ER2_ISSUE(G, B) do { _Pragma("unroll") for (int c = 0; c < 8; ++c) { const int ai = (G) >> 1, m = 2 * ((G) & 1) + (c >> 2), bj = (c >> 1) & 1, n = c & 1; \
            bq[B][c] = *(const f32x4*)(bp + (size_t)(ai * 128 + m * 16) * 1024 + bj * 128 + 4 * n); } } while (0)
        ER2_ISSUE(0, 0);
#pragma unroll
        for (int G = 0; G < 4; ++G) {
            if (G + 1 < 4) { if ((G & 1) == 0) ER2_ISSUE(G + 1, 1); else ER2_ISSUE(G + 1, 0); }
            asm volatile("" ::: "memory");
#pragma unroll
            for (int mm = 0; mm < 2; ++mm) { const int ai = G >> 1, m = 2 * (G & 1) + mm; float ss = 0.f;
#pragma unroll
                for (int bj = 0; bj < 2; ++bj) { const size_t off = (size_t)(ai * 128 + m * 16) * 1024 + bj * 128;
                    const f32x4 o0 = bq[G & 1][mm * 4 + bj * 2] + acc[ai][bj][m][0] * sc, o1 = bq[G & 1][mm * 4 + bj * 2 + 1] + acc[ai][bj][m][1] * sc;
                    *(f32x4*)(op + off) = o0; *(f32x4*)(op + off + 4) = o1;
                    if (WRITE_HB) {
                        ss += (o0[0] * o0[0] + o0[1] * o0[1]) + (o0[2] * o0[2] + o0[3] * o0[3]) + (o1[0] * o1[0] + o1[1] * o1[1]) + (o1[2] * o1[2] + o1[3] * o1[3]);
                        u32x4 w; w.x = cvt_pk_bf16(o0[0], o0[1]); w.y = cvt_pk_bf16(o0[2], o0[3]); w.z = cvt_pk_bf16(o1[0], o1[1]); w.w = cvt_pk_bf16(o1[2], o1[3]);
                        *(u32x4*)(hp + off) = w; } }
                if (WRITE_HB) { ss += __shfl_xor(ss, 16); ss += __shfl_xor(ss, 32); if (fq == 0) part[(size_t)(u.pn * 4 + wc) * TOK + row0 + ai * 128 + m * 16] = ss; } }
            asm volatile("" ::: "memory");
        }
#undef ER2_ISSUE
    }
};
struct EpiMemKV {
    static constexpr bool PERM = true, AFTER_DRAIN = false;
    float* KV; const float* rs;
    __device__ __forceinline__ void operator()(const f32x4 (&acc)[2][2][4][2], const Unit& u, int wr, int wc, int fr0, int fq0) const {
        int fr = fr0, fq = fq0; asm volatile("" : "+v"(fr), "+v"(fq));
        float r[2][4]; row_scales<0>(rs, u.pm * BM + wr * 64, (int)(threadIdx.x & 63), fr, r);
        const int col0 = u.pn * BM + wc * 32 + 8 * fq;
#pragma unroll
        for (int ai = 0; ai < 2; ++ai)
#pragma unroll
            for (int m = 0; m < 4; ++m) { const int row = u.pm * BM + ai * HALF + wr * 64 + m * 16 + fr;
#pragma unroll
                for (int bj = 0; bj < 2; ++bj) { const size_t off = (size_t)row * 1024 + col0 + bj * HALF;
                    *(f32x4*)(KV + off) = acc[ai][bj][m][0] * r[ai][m]; *(f32x4*)(KV + off + 4) = acc[ai][bj][m][1] * r[ai][m]; } }
    }
};
template <int NP> struct EpiGate {
    static constexpr bool PERM = true, AFTER_DRAIN = false;
    bf16_t* scr; const PG8_LAS float* tab; mutable int ui = 0;
    __device__ __forceinline__ void operator()(const f32x4 (&acc)[2][2][4][2], const Unit& u, int wr, int wc, int fr0, int fq0) const {
        int fr = fr0, fq = fq0; asm volatile("" : "+v"(fr), "+v"(fq));
        float r[2][4];
#ifdef DBG_GATE_NOSCALE
        for (int a_ = 0; a_ < 2; ++a_) for (int m_ = 0; m_ < 4; ++m_) r[a_][m_] = 1.0f;
#else
        row_scales_tab(tab, ui++, wr, fr, r);
#endif
        bf16_t* t = scr + (size_t)(u.pm * 4 + u.pn) * 65536;
#pragma unroll
        for (int ai = 0; ai < 2; ++ai)
#pragma unroll
            for (int m = 0; m < 4; ++m) { const int lr = ai * HALF + wr * 64 + m * 16 + fr; const float rr = r[ai][m];
#pragma unroll
                for (int bj = 0; bj < 2; ++bj) { float o[8];
#pragma unroll
                    for (int n = 0; n < 2; ++n)
#pragma unroll
                        for (int j = 0; j < 4; ++j) o[4 * n + j] = sigmoid_f(acc[ai][bj][m][n][j] * rr);
                    u32x4 w; w.x = cvt_pk_bf16(o[0], o[1]); w.y = cvt_pk_bf16(o[2], o[3]); w.z = cvt_pk_bf16(o[4], o[5]); w.w = cvt_pk_bf16(o[6], o[7]);
                    *(u32x4*)(t + lr * 256 + bj * HALF + wc * 32 + 8 * fq) = w; } }
    }
};
__device__ __forceinline__ float bf_lo(unsigned w) { return __uint_as_float(w << 16); }
__device__ __forceinline__ float bf_hi(unsigned w) { return __uint_as_float(w & 0xffff0000u); }
struct EpiBranch {
    static constexpr bool PERM = true, AFTER_DRAIN = false;
    const bf16_t* scr; bf16_t* mg; bool first; float bscale;
    __device__ __forceinline__ void operator()(const f32x4 (&acc)[2][2][4][2], const Unit& u, int wr, int wc, int fr0, int fq0) const {
        int fr = fr0, fq = fq0; asm volatile("" : "+v"(fr), "+v"(fq));
        const bf16_t* t = scr + (size_t)(u.pm * 4 + u.pn) * 65536;
        __builtin_amdgcn_fence(__ATOMIC_ACQUIRE, "agent");
        asm volatile("s_waitcnt vmcnt(0)" ::: "memory");
#pragma unroll
        for (int ai = 0; ai < 2; ++ai)
#pragma unroll
            for (int m = 0; m < 4; ++m) { const int lr = ai * HALF + wr * 64 + m * 16 + fr; const int row = u.pm * BM + lr;
#pragma unroll
                for (int bj = 0; bj < 2; ++bj) { const int lc = bj * HALF + wc * 32 + 8 * fq;
#if defined(DBG_NOGATE) && DBG_NOGATE
                    const u32x4 g = (u32x4){0x3f803f80u, 0x3f803f80u, 0x3f803f80u, 0x3f803f80u};
#else
                    const u32x4 g = *(const u32x4*)(t + lr * 256 + lc);
#endif
                    bf16_t* mp = mg + (size_t)row * 1024 + u.pn * BM + lc;
                    float o[8];
                    o[0] = bf_lo(g.x) * acc[ai][bj][m][0][0]; o[1] = bf_hi(g.x) * acc[ai][bj][m][0][1]; o[2] = bf_lo(g.y) * acc[ai][bj][m][0][2]; o[3] = bf_hi(g.y) * acc[ai][bj][m][0][3];
                    o[4] = bf_lo(g.z) * acc[ai][bj][m][1][0]; o[5] = bf_hi(g.z) * acc[ai][bj][m][1][1]; o[6] = bf_lo(g.w) * acc[ai][bj][m][1][2]; o[7] = bf_hi(g.w) * acc[ai][bj][m][1][3];
#ifdef DBG_BRANCH_SIGMOID
#pragma unroll
                    for (int e = 0; e < 8; ++e) o[e] = DBG_NONLIN(o[e]);
#endif
#pragma unroll
                    for (int e = 0; e < 8; ++e) o[e] *= bscale;
                    if (!first) { const u32x4 p = *(const u32x4*)mp;
                        o[0] += bf_lo(p.x); o[1] += bf_hi(p.x); o[2] += bf_lo(p.y); o[3] += bf_hi(p.y); o[4] += bf_lo(p.z); o[5] += bf_hi(p.z); o[6] += bf_lo(p.w); o[7] += bf_hi(p.w); }
                    u32x4 w; w.x = cvt_pk_bf16(o[0], o[1]); w.y = cvt_pk_bf16(o[2], o[3]); w.z = cvt_pk_bf16(o[4], o[5]); w.w = cvt_pk_bf16(o[6], o[7]);
                    *(u32x4*)mp = w; }
                if (m & 1) asm volatile("" ::: "memory"); }
    }
};
template <bool FIRST> struct EpiBranch2 {
    const bf16_t* scr; bf16_t* mg;
    __device__ __forceinline__ void operator()(const f32x4 (&acc)[2][2][4][2], const Unit& u, int wr, int wc, int fr0, int fq0) const {
        int fr = fr0, fq = fq0; asm volatile("" : "+v"(fr), "+v"(fq));
        const bf16_t* t = scr + (size_t)(u.pm * 4 + u.pn) * 65536 + (wr * 64 + fr) * 256 + wc * 32 + 8 * fq;
        bf16_t* mp0 = mg + (size_t)(u.pm * BM + wr * 64 + fr) * 1024 + u.pn * BM + wc * 32 + 8 * fq;
        u32x4 gq[2][4], pq[2][4];
#define EB2_ISSUE(G, B) do { _Pragma("unroll") for (int c = 0; c < 4; ++c) { const int ai = (G) >> 1, m = 2 * ((G) & 1) + (c >> 1), bj = c & 1; \
            gq[B][c] = *(const u32x4*)(t + (ai * 128 + m * 16) * 256 + bj * 128); if (!FIRST) pq[B][c] = *(const u32x4*)(mp0 + (size_t)(ai * 128 + m * 16) * 1024 + bj * 128); } } while (0)
        EB2_ISSUE(0, 0);
#pragma unroll
        for (int G = 0; G < 4; ++G) {
            if (G + 1 < 4) { if ((G & 1) == 0) EB2_ISSUE(G + 1, 1); else EB2_ISSUE(G + 1, 0); }
            asm volatile("" ::: "memory");
#pragma unroll
            for (int c = 0; c < 4; ++c) { const int ai = G >> 1, m = 2 * (G & 1) + (c >> 1), bj = c & 1; const u32x4 g = gq[G & 1][c];
                float o[8];
                o[0] = bf_lo(g.x) * acc[ai][bj][m][0][0]; o[1] = bf_hi(g.x) * acc[ai][bj][m][0][1]; o[2] = bf_lo(g.y) * acc[ai][bj][m][0][2]; o[3] = bf_hi(g.y) * acc[ai][bj][m][0][3];
                o[4] = bf_lo(g.z) * acc[ai][bj][m][1][0]; o[5] = bf_hi(g.z) * acc[ai][bj][m][1][1]; o[6] = bf_lo(g.w) * acc[ai][bj][m][1][2]; o[7] = bf_hi(g.w) * acc[ai][bj][m][1][3];
                if (!FIRST) { const u32x4 p = pq[G & 1][c];
                    o[0] += bf_lo(p.x); o[1] += bf_hi(p.x); o[2] += bf_lo(p.y); o[3] += bf_hi(p.y); o[4] += bf_lo(p.z); o[5] += bf_hi(p.z); o[6] += bf_lo(p.w); o[7] += bf_hi(p.w); }
                u32x4 w; w.x = cvt_pk_bf16(o[0], o[1]); w.y = cvt_pk_bf16(o[2], o[3]); w.z = cvt_pk_bf16(o[4], o[5]); w.w = cvt_pk_bf16(o[6], o[7]);
                *(u32x4*)(mp0 + (size_t)(ai * 128 + m * 16) * 1024 + bj * 128) = w; }
            asm volatile("" ::: "memory");
        }
#undef EB2_ISSUE
    }
};
template <size_t O_HB, size_t O_WG, size_t O_A0, size_t O_A1, size_t O_A2, size_t O_WB> struct P7Order {
    StaticOrder T; const char* ws;
    __device__ __forceinline__ bool next(int i, UnitX& u) const { const int rd = i / 6; Unit t; if (!T.next(rd, t)) return false; u.pm = t.pm; u.pn = t.pn; u.kind = i - 6 * rd; u.round = rd; return true; }
    __device__ __forceinline__ OpsX ops(const UnitX& u) const { const int j = u.kind >> 1; OpsX o;
        if (u.kind & 1) { o.K = 512; o.A = ws + (j == 0 ? O_A0 : j == 1 ? O_A1 : O_A2) + (size_t)u.pm * (256 * 512 * 2); o.Bt = ws + O_WB + (size_t)j * (1024 * 512 * 2) + (size_t)u.pn * (256 * 512 * 2); }
        else { o.K = 1024; o.A = ws + O_HB + (size_t)u.pm * (256 * 1024 * 2); o.Bt = ws + O_WG + (size_t)j * (1024 * 1024 * 2) + (size_t)u.pn * (256 * 1024 * 2); }
        return o; }
};
struct EpiP7 {
    bf16_t* scr; bf16_t* mg; const PG8_LAS float* tab;
    __device__ __forceinline__ void operator()(const f32x4 (&acc)[2][2][4][2], const UnitX& u, int wr, int wc, int fr, int fq) const {
        const Unit uu{u.pm, u.pn};
        if (u.kind == 1) { const EpiBranch2<true> b{scr, mg}; b(acc, uu, wr, wc, fr, fq); }
        else if (u.kind & 1) { const EpiBranch2<false> b{scr, mg}; b(acc, uu, wr, wc, fr, fq); }
        else { const EpiGate<16> g{scr, tab, u.round}; g(acc, uu, wr, wc, fr, fq); }
    }
};
struct ProjOut { bf16_t *FQ, *FK, *FV, *DQ, *IQ, *MQ, *DK, *DV, *IK; float *LOGF, *IW; const float *cosT, *sinT, *g_fq, *g_fk, *g_dq, *g_dk, *b_forget; };
__device__ __forceinline__ float log_sigmoid_f(float z) { return z >= 0.f ? -log1pf(expf(-z)) : z - log1pf(expf(z)); }
template <int NP> struct EpiProj {
    static constexpr bool PERM = true, AFTER_DRAIN = false;
    ProjOut P; const PG8_LAS float* tab; float qscale; mutable int ui = 0;
    __device__ __forceinline__ void operator()(const f32x4 (&acc)[2][2][4][2], const Unit& u, int wr, int wc, int fr0, int fq0) const {
        int fr = fr0, fq = fq0; asm volatile("" : "+v"(fr), "+v"(fq));
        float r[2][4]; row_scales_tab(tab, ui++, wr, fr, r);
        const int pn = u.pn;
        bool do_norm = false, do_rope = false; const float* gain = nullptr; bf16_t* dst = nullptr; int pitch = 512, hoff = 0; float osc = 1.f;
        if (pn < 2)       { do_norm = true; gain = P.g_fq; dst = P.FQ; hoff = (4 * pn + wc) * 64; osc = qscale; }
        else if (pn < 4)  { do_norm = true; gain = P.g_fk; dst = P.FK; hoff = (4 * (pn - 2) + wc) * 64; }
        else if (pn < 6)  { dst = P.FV; hoff = (4 * (pn - 4) + wc) * 64; }
        else if (pn < 8)  { do_norm = true; do_rope = true; gain = P.g_dq; dst = P.DQ; hoff = (4 * (pn - 6) + wc) * 64; osc = qscale; }
        else if (pn < 10) { do_rope = true; dst = P.IQ; hoff = (4 * (pn - 8) + wc) * 64; }
        else if (pn < 12) { dst = P.MQ; hoff = (2 * (pn - 10) + (wc >> 1)) * 128 + (wc & 1) * 64; }
        else { pitch = 64;
            if (wc == 0)      { do_norm = true; do_rope = true; gain = P.g_dk; dst = P.DK; }
            else if (wc == 1) { dst = P.DV; }
            else if (wc == 2) { do_rope = true; dst = P.IK; }
            else dst = nullptr; }
        if (dst == nullptr) {
            if (fq < 2) {
#pragma unroll
                for (int ai = 0; ai < 2; ++ai)
#pragma unroll
                    for (int m = 0; m < 4; ++m) { const int row = u.pm * BM + ai * HALF + wr * 64 + m * 16 + fr; const float rr = r[ai][m];
                        f32x4 v0 = acc[ai][0][m][0] * rr, v1 = acc[ai][0][m][1] * rr;
                        if (fq == 0) {
                            const f32x4 b0 = *(const f32x4*)(P.b_forget), b1 = *(const f32x4*)(P.b_forget + 4);
#pragma unroll
                            for (int j = 0; j < 4; ++j) { v0[j] = log_sigmoid_f(v0[j] + b0[j]); v1[j] = log_sigmoid_f(v1[j] + b1[j]); }
                            *(f32x4*)(P.LOGF + (size_t)row * 8) = v0; *(f32x4*)(P.LOGF + (size_t)row * 8 + 4) = v1;
                        } else { const float c = 0.04419417382f; *(f32x4*)(P.IW + (size_t)row * 8) = v0 * c; *(f32x4*)(P.IW + (size_t)row * 8 + 4) = v1 * c; } }
            }
            return;
        }
        f32x4 gv[2][2];
        if (do_norm) {
#pragma unroll
            for (int bj = 0; bj < 2; ++bj)
#pragma unroll
                for (int n = 0; n < 2; ++n) gv[bj][n] = *(const f32x4*)(gain + bj * 32 + 8 * fq + 4 * n);
        }
#pragma unroll
        for (int ai = 0; ai < 2; ++ai)
#pragma unroll
            for (int m = 0; m < 4; ++m) {
                const int row = u.pm * BM + ai * HALF + wr * 64 + m * 16 + fr; const float rr = r[ai][m];
                f32x4 v[2][2];
#pragma unroll
                for (int bj = 0; bj < 2; ++bj)
#pragma unroll
                    for (int n = 0; n < 2; ++n) v[bj][n] = acc[ai][bj][m][n] * rr;
                if (do_norm) {
                    float ss = 0.f;
#pragma unroll
                    for (int bj = 0; bj < 2; ++bj)
#pragma unroll
                        for (int n = 0; n < 2; ++n) ss += (v[bj][n][0] * v[bj][n][0] + v[bj][n][1] * v[bj][n][1]) + (v[bj][n][2] * v[bj][n][2] + v[bj][n][3] * v[bj][n][3]);
                    ss += __shfl_xor(ss, 16); ss += __shfl_xor(ss, 32);
                    const float inv = __builtin_amdgcn_rsqf(ss * (1.0f / 64.0f) + RMS_EPS);
#pragma unroll
                    for (int bj = 0; bj < 2; ++bj)
#pragma unroll
                        for (int n = 0; n < 2; ++n) v[bj][n] = v[bj][n] * inv * gv[bj][n];
                }
                if (do_rope) {
#pragma unroll
                    for (int n = 0; n < 2; ++n) {
                        const f32x4 c = *(const f32x4*)(P.cosT + (size_t)row * 32 + 8 * fq + 4 * n), s = *(const f32x4*)(P.sinT + (size_t)row * 32 + 8 * fq + 4 * n);
                        const f32x4 x1 = v[0][n], x2 = v[1][n];
                        v[0][n] = x1 * c - x2 * s; v[1][n] = x2 * c + x1 * s; }
                }
#pragma unroll
                for (int bj = 0; bj < 2; ++bj) {
                    const f32x4 a = v[bj][0] * osc, b = v[bj][1] * osc;
                    u32x4 w; w.x = cvt_pk_bf16(a[0], a[1]); w.y = cvt_pk_bf16(a[2], a[3]); w.z = cvt_pk_bf16(b[0], b[1]); w.w = cvt_pk_bf16(b[2], b[3]);
                    if (pn == 12 && wc == 2) {
                        const int d = bj * 32 + 8 * fq; *(u32x4*)(dst + (size_t)(row >> 5) * 2048 + (d >> 4) * 512 + ((d >> 3) & 1) * 256 + (row & 31) * 8) = w;
                    } else *(u32x4*)(dst + (size_t)row * pitch + hoff + bj * 32 + 8 * fq) = w; }
            }
    }
};
}
#define GAS __attribute__((address_space(1)))
#define LAS __attribute__((address_space(3)))
typedef unsigned short bf16;
typedef unsigned v4u __attribute__((ext_vector_type(4)));
typedef float f32x4 __attribute__((ext_vector_type(4)));
typedef short bf16x8 __attribute__((ext_vector_type(8)));
typedef GAS unsigned gu32;
typedef GAS unsigned long long gu64;
#define RLX_AGENT __ATOMIC_RELAXED, __HIP_MEMORY_SCOPE_AGENT
#define LDS_WAIT() asm volatile("s_waitcnt lgkmcnt(0)" ::: "memory")
#define VM_WAIT() asm volatile("s_waitcnt vmcnt(0)" ::: "memory")
__device__ __forceinline__ unsigned long long rt() { return __builtin_amdgcn_s_memrealtime(); }
__device__ __forceinline__ unsigned f2bf(float f) { unsigned u = __builtin_bit_cast(unsigned, f); return (u + 0x7fffu + ((u >> 16) & 1u)) >> 16; }
__device__ __forceinline__ unsigned pk2(float lo, float hi) { return f2bf(lo) | (f2bf(hi) << 16); }
typedef float f32x2g __attribute__((ext_vector_type(2)));
__device__ __forceinline__ float bf_lo32(unsigned w) { return __uint_as_float(w << 16); }
__device__ __forceinline__ float bf_hi32(unsigned w) { return __uint_as_float(w & 0xffff0000u); }
constexpr int NWAVES = 8;
constexpr int BATCH = 2, SEQ = 8192, DM = 1024, T = BATCH * SEQ, DFF = 2816, MEMLEN = 256, BW = 512, DIN = 6352;
constexpr int NPROJ = 13 * 256, NGATE = 3072;
constexpr float L2E = 1.4426950408889634f;
constexpr float C2_64 = 0.125f * L2E;
constexpr float C2_128 = 0.08838834764831845f * L2E;
constexpr size_t MiB = 1u << 20;
constexpr size_t WS_CTL = 0, CTL_ZERO_BYTES = 128 * 1024;
constexpr size_t WS_RSTDX = 1 * MiB;
constexpr size_t WS_RSTDM = WS_RSTDX + 64 * 1024;
constexpr size_t WS_T0 = WS_RSTDM + 4096;
constexpr size_t WS_SSQ1 = 2 * MiB;
constexpr size_t WS_SSQ2 = 3 * MiB;
constexpr size_t WS_LOGF = 4 * MiB;
constexpr size_t WS_CUM = WS_LOGF + 512 * 1024;
constexpr size_t WS_IW = 5 * MiB;
constexpr size_t WS_COS = 6 * MiB, WS_SIN = 8 * MiB;
constexpr size_t WS_MEMB = 10 * MiB;
constexpr size_t WS_KVM = 11 * MiB;
constexpr size_t WS_KMB = 13 * MiB, WS_VMB = 14 * MiB;
constexpr size_t WS_WGU1 = 16 * MiB;
constexpr size_t WS_WD1 = 27 * MiB;
constexpr size_t WS_WIN = 33 * MiB;
constexpr size_t WS_WGATE = 40 * MiB;
constexpr size_t WS_WBR = 46 * MiB;
constexpr size_t WS_WOUT = 49 * MiB;
constexpr size_t WS_WGU2 = 51 * MiB;
constexpr size_t WS_WD2 = 62 * MiB;
constexpr size_t WS_WMKV = 68 * MiB;
constexpr size_t WS_HB = 70 * MiB;
constexpr size_t WS_ACT = 102 * MiB;
constexpr size_t WS_HID = WS_ACT;
constexpr size_t WS_FQ = WS_ACT, WS_FK = WS_ACT + 16 * MiB, WS_FV = WS_ACT + 32 * MiB, WS_DQ = WS_ACT + 48 * MiB, WS_IQ = WS_ACT + 64 * MiB, WS_MQ = WS_ACT + 80 * MiB;
constexpr size_t WS_DK = WS_ACT + 96 * MiB, WS_DV = WS_ACT + 98 * MiB, WS_IK = WS_ACT + 100 * MiB;
#if defined(DBG_SUBST) && DBG_SUBST == 2
constexpr size_t WS_MERGED = WS_DQ;
#else
constexpr size_t WS_MERGED = WS_FK;
#endif
#ifdef DBG_GSCR_AT
constexpr size_t WS_GSCR = DBG_GSCR_AT;
#else
constexpr size_t WS_GSCR = 204 * MiB;
#endif
constexpr size_t WS_OA = 236 * MiB;
constexpr size_t WS_OB = 16 * MiB;
constexpr size_t WS_END = 252 * MiB;
#ifndef DBG_GSCR_AT
static_assert(WS_HID + (size_t)T * DFF * 2 <= WS_GSCR && WS_IK + (size_t)T * 64 * 2 <= WS_GSCR, "d_ws map");
#endif
constexpr int CW_BAR = 4096;
constexpr int CW_Q = 16384;
constexpr int RING_OFF = 0, RING_BYTES = 131072;
constexpr int LDSCTL_OFF = RING_BYTES, MISC_OFF = LDSCTL_OFF + 320;
constexpr int LIST_OFF = RING_BYTES + 1024;
constexpr int SCANX_OFF = RING_BYTES + 6144;
constexpr int LDS_BYTES = 163840;
#define XB_TMO      128
#define XB_XCNT(j)  (256  + 64 * (j))
#define XB_XSUB(j)  (1280 + 64 * (j))
#define XB_XGEN(j)  (2304 + 64 * (j))
#define XB_TOP      3328
#define XB_TOPGEN   3392
#define XCD_BAR_WORDS 3456
#define XB_SPIN_CAP (1u << 18)

__device__ __forceinline__ unsigned xb_ld(unsigned* p)              { return __hip_atomic_load(p, __ATOMIC_RELAXED, __HIP_MEMORY_SCOPE_AGENT); }
__device__ __forceinline__ unsigned xb_add(unsigned* p, unsigned v) { return __hip_atomic_fetch_add(p, v, __ATOMIC_RELAXED, __HIP_MEMORY_SCOPE_AGENT); }
__device__ __forceinline__ unsigned xb_xcc_id() { return (unsigned)__builtin_amdgcn_s_getreg((3 << 11) | 20) & 0xFu; }
#define XB_SPIN(cond, bar) do { unsigned _sp = 0; while (cond) { __builtin_amdgcn_s_sleep(1); \
    if ((++_sp & 255u) == 0u) { if (xb_ld(&(bar)[XB_TMO])) break; if (_sp > XB_SPIN_CAP) { atomicAdd(&(bar)[XB_TMO], 1u); break; } } } } while (0)

struct XcdBarrier {
    unsigned* bar; unsigned x;
    volatile LAS unsigned* st;
};

__device__ __forceinline__ XcdBarrier xcd_barrier_post(unsigned* bar, volatile LAS unsigned* st) {
    XcdBarrier b; b.bar = bar; b.x = xb_xcc_id(); b.st = st;
    if (threadIdx.x == 0) (void)xb_add(&bar[XB_XCNT(b.x)], 1u);
    return b;
}
__device__ __forceinline__ void xcd_barrier_complete(unsigned* bar, unsigned x, unsigned& nloc, unsigned& nx) {
    const unsigned G = gridDim.x * gridDim.y * gridDim.z;
    unsigned sum, cnt, mine, sp = 0u;
    for (;;) {
        sum = 0u; cnt = 0u; mine = 0u;
#pragma unroll
        for (unsigned j = 0; j < 16; ++j) { const unsigned c = xb_ld(&bar[XB_XCNT(j)]); sum += c; cnt += (c > 0u) ? 1u : 0u; mine = (j == x) ? c : mine; }
        if (sum == G) break;
        __builtin_amdgcn_s_sleep(1);
        if ((++sp & 255u) == 0u) { if (xb_ld(&bar[XB_TMO])) break; if (sp > XB_SPIN_CAP) { atomicAdd(&bar[XB_TMO], 1u); break; } }
    }
    nloc = mine > 0u ? mine : 1u; nx = cnt > 0u ? cnt : 1u;
}

__device__ __forceinline__ void xcd_barrier(const XcdBarrier& b) {
    asm volatile("s_waitcnt vmcnt(0)" ::: "memory");
    __syncthreads();
    if (threadIdx.x == 0) {
        unsigned* bar = b.bar;
        __builtin_amdgcn_s_waitcnt(0);
        unsigned nloc = b.st[0], nx = b.st[1];
        if (nloc == 0u) { xcd_barrier_complete(bar, b.x, nloc, nx); b.st[0] = nloc; b.st[1] = nx; }
        const unsigned old = xb_add(&bar[XB_XSUB(b.x)], 1u);
        const unsigned gen = old / nloc;
        if (old + 1u == (gen + 1u) * nloc) {
            __builtin_amdgcn_fence(__ATOMIC_RELEASE, "agent");
            asm volatile("s_waitcnt vmcnt(0)" ::: "memory");
            const unsigned og = xb_add(&bar[XB_TOP], 1u);
            const unsigned tg = og / nx;
            if (og + 1u == (tg + 1u) * nx) xb_add(&bar[XB_TOPGEN], 1u);
            else XB_SPIN(xb_ld(&bar[XB_TOPGEN]) == tg, bar);
            __builtin_amdgcn_fence(__ATOMIC_ACQUIRE, "agent");
            xb_add(&bar[XB_XGEN(b.x)], 1u);
            asm volatile("s_waitcnt vmcnt(0)" ::: "memory");
        } else {
            XB_SPIN(xb_ld(&bar[XB_XGEN(b.x)]) == gen, bar);
            __builtin_amdgcn_fence(__ATOMIC_ACQUIRE, "agent");
            asm volatile("s_waitcnt vmcnt(0)" ::: "memory");
        }
    }
    __syncthreads();
}
__device__ __forceinline__ float wave_sum(float v) {
#pragma unroll
    for (int o = 1; o < 64; o <<= 1) v += __shfl_xor(v, o);
    return v;
}
__device__ __forceinline__ float wave_max(float v) {
#pragma unroll
    for (int o = 1; o < 64; o <<= 1) v = fmaxf(v, __shfl_xor(v, o));
    return v;
}
__device__ __forceinline__ int colmap(int mat, int n) {
    if (mat == 1) return n;
    if (mat == 3) return 3280 + n;
    const int tile = n >> 8, t = n & 255;
    if (mat == 0) return (t < 128 ? 0 : DFF) + 128 * tile + (t & 127);
    const int bj = t >> 7, wc = (t >> 5) & 3, i = t & 31, d = bj * 32 + i;
    if (tile < 2) return 0 + (4 * tile + wc) * 64 + d;
    if (tile < 4) return 512 + (4 * (tile - 2) + wc) * 64 + d;
    if (tile < 6) return 1024 + (4 * (tile - 4) + wc) * 64 + d;
    if (tile < 8) return 1544 + (4 * (tile - 6) + wc) * 64 + d;
    if (tile < 10) return 2184 + (4 * (tile - 8) + wc) * 64 + d;
    if (tile < 12) return 2768 + (2 * (tile - 10) + (wc >> 1)) * 128 + (wc & 1) * 64 + d;
    if (wc == 0) return 2056 + d;
    if (wc == 1) return 2120 + d;
    if (wc == 2) return 2696 + d;
    if (bj == 0 && i < 8) return 1536 + i;
    if (bj == 0 && i < 16) return 2760 + (i - 8);
    return -1;
}
__device__ __forceinline__ void transpose_item(int mat, const float* Wa, const float* Wb, int K, int Nsrc, const float* gain, bf16* WT, LAS float* scr, int item, int nblk, int lane) {
    const int kb = item / nblk, nb = item % nblk, k0 = 64 * kb, n0 = 32 * nb;
    int col = colmap(mat, n0 + (lane & 31)); const float* W = Wa;
    if (mat == 0 && col >= DFF) { W = Wb; col -= DFF; }
#pragma unroll 8
    for (int i = 0; i < 32; ++i) { const int kk = 2 * i + (lane >> 5); float v = 0.f; if (col >= 0) v = W[(size_t)(k0 + kk) * Nsrc + col]; if (gain) v *= gain[k0 + kk]; scr[kk * 33 + (lane & 31)] = v; }
    LDS_WAIT(); asm volatile("" ::: "memory");
    const int c = lane & 7;
#pragma unroll
    for (int j = 0; j < 4; ++j) { const int n = (lane >> 3) + 8 * j; const LAS float* s = scr + (8 * c) * 33 + n;
        v4u o; o.x = pk2(s[0 * 33], s[1 * 33]); o.y = pk2(s[2 * 33], s[3 * 33]); o.z = pk2(s[4 * 33], s[5 * 33]); o.w = pk2(s[6 * 33], s[7 * 33]);
        *(GAS v4u*)(WT + (size_t)(n0 + n) * K + k0 + 8 * c) = o; }
    LDS_WAIT(); asm volatile("" ::: "memory");
}
__device__ __forceinline__ void row_to_bf16_rstd(const float* xrow, bf16* orow, float* rstd_out, int lane) {
    const GAS f32x4* xr = (const GAS f32x4*)xrow + lane;
    f32x4 v[4]; float s = 0.f;
#pragma unroll
    for (int j = 0; j < 4; ++j) { v[j] = xr[64 * j]; s += (v[j].x * v[j].x + v[j].y * v[j].y) + (v[j].z * v[j].z + v[j].w * v[j].w); }
    const float rstd = 1.0f / sqrtf(wave_sum(s) * (1.f / 1024.f) + 1e-6f);
    GAS unsigned long long* o8 = (GAS unsigned long long*)orow + lane;
#pragma unroll
    for (int j = 0; j < 4; ++j) o8[64 * j] = (unsigned long long)pk2(v[j].x, v[j].y) | ((unsigned long long)pk2(v[j].z, v[j].w) << 32);
    if (lane == 0) *rstd_out = rstd;
}
__device__ __forceinline__ void rows4_to_bf16_rstd(const float* const (&xrow)[4], bf16* const (&orow)[4], float* const (&rout)[4], const bool (&ok)[4], int lane) {
    f32x4 v[4][4];
#pragma unroll
    for (int r = 0; r < 4; ++r) { const GAS f32x4* xr = (const GAS f32x4*)xrow[r] + lane;
#pragma unroll
        for (int j = 0; j < 4; ++j) v[r][j] = xr[64 * j]; }
#pragma unroll
    for (int r = 0; r < 4; ++r) { float s = 0.f;
#pragma unroll
        for (int j = 0; j < 4; ++j) s += (v[r][j].x * v[r][j].x + v[r][j].y * v[r][j].y) + (v[r][j].z * v[r][j].z + v[r][j].w * v[r][j].w);
        const float rstd = 1.0f / sqrtf(wave_sum(s) * (1.f / 1024.f) + 1e-6f);
        if (ok[r]) { GAS unsigned long long* o8 = (GAS unsigned long long*)orow[r] + lane;
#pragma unroll
            for (int j = 0; j < 4; ++j) o8[64 * j] = (unsigned long long)pk2(v[r][j].x, v[r][j].y) | ((unsigned long long)pk2(v[r][j].z, v[r][j].w) << 32);
            if (lane == 0) *rout[r] = rstd; } }
}
typedef float f32x16 __attribute__((ext_vector_type(16)));
typedef unsigned u32x2 __attribute__((ext_vector_type(2)));
__device__ __forceinline__ int crow(int r, int hi) { return (r & 3) + 8 * (r >> 2) + 4 * hi; }
__device__ __forceinline__ float bf2f(bf16 v) { return __uint_as_float((unsigned)v << 16); }
__device__ __forceinline__ unsigned cvtpk(float lo, float hi) { return pg8::cvt_pk_bf16(lo, hi); }
template <int HD, bool FOX, bool VT>
__device__ __forceinline__ void attn_wave_simple(const bf16x8 (&qr)[HD / 16], const bf16* Kp, int kpitch, const bf16* Vp, int vpitch, int tstart, int ntiles, int qlocal, const float* cb, bf16* Op, int opitch, int lane) {
    const int r32 = lane & 31, hi = lane >> 5;
    f32x16 o[HD / 32];
#pragma unroll
    for (int d0 = 0; d0 < HD / 32; ++d0)
#pragma unroll
        for (int r = 0; r < 16; ++r) o[d0][r] = 0.f;
    float m = -1e30f, l = 0.f;
    for (int t = tstart; t < ntiles; ++t) {
        const int kv0 = 32 * t;
        f32x16 p;
#pragma unroll
        for (int r = 0; r < 16; ++r) p[r] = 0.f;
        const bf16* kr = Kp + (size_t)(kv0 + r32) * kpitch + hi * 8;
#pragma unroll
        for (int ks = 0; ks < HD / 16; ++ks) { const bf16x8 kf = *(const bf16x8*)(kr + ks * 16); p = __builtin_amdgcn_mfma_f32_32x32x16_bf16(kf, qr[ks], p, 0, 0, 0); }
        if (FOX) {
#pragma unroll
            for (int g = 0; g < 4; ++g) { const f32x4 c4 = *(const f32x4*)(cb + kv0 + 8 * g + 4 * hi);
#pragma unroll
                for (int jj = 0; jj < 4; ++jj) p[4 * g + jj] -= L2E * c4[jj]; }
            if (t == ntiles - 1) {
#pragma unroll
                for (int r = 0; r < 16; ++r) if (kv0 + crow(r, hi) > qlocal) p[r] = -INFINITY;
            }
        }
        float mt = p[0];
#pragma unroll
        for (int r = 1; r < 16; ++r) mt = fmaxf(mt, p[r]);
        mt = fmaxf(mt, __shfl_xor(mt, 32));
        const float mn = fmaxf(m, mt); const float alpha = __builtin_amdgcn_exp2f(m - mn); m = mn;
        l *= alpha;
#pragma unroll
        for (int d0 = 0; d0 < HD / 32; ++d0)
#pragma unroll
            for (int r = 0; r < 16; ++r) o[d0][r] *= alpha;
        float ls = 0.f;
#pragma unroll
        for (int r = 0; r < 16; ++r) { p[r] = __builtin_amdgcn_exp2f(p[r] - mn); ls += p[r]; }
        l += ls;
        bf16x8 pa[2];
#pragma unroll
        for (int s = 0; s < 2; ++s) { v4u w; w.x = cvtpk(p[8 * s + 0], p[8 * s + 1]); w.y = cvtpk(p[8 * s + 2], p[8 * s + 3]); w.z = cvtpk(p[8 * s + 4], p[8 * s + 5]); w.w = cvtpk(p[8 * s + 6], p[8 * s + 7]); pa[s] = __builtin_bit_cast(bf16x8, w); }
#pragma unroll
        for (int d0 = 0; d0 < HD / 32; ++d0)
#pragma unroll
            for (int s = 0; s < 2; ++s) {
                bf16x8 vf;
                if (VT) {
                    const bf16* vp = Vp + (size_t)(d0 * 32 + r32) * vpitch + kv0 + 16 * s + 4 * hi;
                    const u32x2 lo = *(const u32x2*)vp, hi2 = *(const u32x2*)(vp + 8);
                    vf = __builtin_bit_cast(bf16x8, (v4u){lo.x, lo.y, hi2.x, hi2.y});
                } else {
#pragma unroll
                    for (int j = 0; j < 8; ++j) vf[j] = (short)Vp[(size_t)(kv0 + 16 * s + 8 * (j >> 2) + 4 * hi + (j & 3)) * vpitch + d0 * 32 + r32];
                }
                o[d0] = __builtin_amdgcn_mfma_f32_32x32x16_bf16(vf, pa[s], o[d0], 0, 0, 0);
            }
    }
    l += __shfl_xor(l, 32);
    const float inv = 1.0f / l;
    bf16* orow = Op + (size_t)r32 * opitch;
#pragma unroll
    for (int d0 = 0; d0 < HD / 32; ++d0)
#pragma unroll
        for (int g = 0; g < 4; ++g) { u32x2 w; w.x = cvtpk(o[d0][4 * g] * inv, o[d0][4 * g + 1] * inv); w.y = cvtpk(o[d0][4 * g + 2] * inv, o[d0][4 * g + 3] * inv);
            *(u32x2*)(orow + d0 * 32 + 8 * g + 4 * hi) = w; }
}
__device__ __forceinline__ void fox_unit(int bh, int qb, const bf16* FQ, const bf16* FK, const bf16* FV, const float* CUM, const int* T0, bf16* OA, int wave, int lane) {
    const int b = bh >> 3, h = bh & 7, r32 = lane & 31, hi = lane >> 5; const size_t rowbase = (size_t)b * SEQ; const int q0 = qb * 256 + wave * 32;
    const bf16* Qw = FQ + (rowbase + q0) * 512 + h * 64; bf16* Ow = OA + (rowbase + q0) * 512 + h * 64;
    bf16x8 qr[4];
#pragma unroll
    for (int ks = 0; ks < 4; ++ks) qr[ks] = *(const bf16x8*)(Qw + (size_t)r32 * 512 + ks * 16 + hi * 8);
    attn_wave_simple<64, true, false>(qr, FK + rowbase * 512 + h * 64, 512, FV + rowbase * 512 + h * 64, 512, T0[bh * 256 + q0 / 32], q0 / 32 + 1, q0 + r32, CUM + (size_t)bh * SEQ, Ow, 512, lane);
}
__device__ __forceinline__ void mem_unit(int rg, int head, bf16* MQ, const bf16* KMB, const bf16* VMB, const float* gq, int lane) {
    const int r32 = lane & 31, hi = lane >> 5; const int row0 = rg * 32; const int b = row0 / SEQ;
    bf16* Qw = MQ + (size_t)row0 * 512 + head * 128;
    bf16x8 raw[8]; float ss = 0.f;
#pragma unroll
    for (int ks = 0; ks < 8; ++ks) { raw[ks] = *(const bf16x8*)(Qw + (size_t)r32 * 512 + ks * 16 + hi * 8);
#pragma unroll
        for (int j = 0; j < 8; ++j) { const float f = bf2f((bf16)raw[ks][j]); ss += f * f; } }
    ss += __shfl_xor(ss, 32);
    const float rstd = __builtin_amdgcn_rsqf(ss * (1.0f / 128.0f) + 1e-6f) * C2_128;
    bf16x8 qr[8];
#pragma unroll
    for (int ks = 0; ks < 8; ++ks) { const f32x4 g0 = *(const f32x4*)(gq + ks * 16 + hi * 8), g1 = *(const f32x4*)(gq + ks * 16 + hi * 8 + 4); v4u w;
        w.x = cvtpk(bf2f((bf16)raw[ks][0]) * rstd * g0[0], bf2f((bf16)raw[ks][1]) * rstd * g0[1]); w.y = cvtpk(bf2f((bf16)raw[ks][2]) * rstd * g0[2], bf2f((bf16)raw[ks][3]) * rstd * g0[3]);
        w.z = cvtpk(bf2f((bf16)raw[ks][4]) * rstd * g1[0], bf2f((bf16)raw[ks][5]) * rstd * g1[1]); w.w = cvtpk(bf2f((bf16)raw[ks][6]) * rstd * g1[2], bf2f((bf16)raw[ks][7]) * rstd * g1[3]);
        qr[ks] = __builtin_bit_cast(bf16x8, w); }
    attn_wave_simple<128, false, true>(qr, KMB + (size_t)b * MEMLEN * 512 + head * 128, 512, VMB + (size_t)(b * 4 + head) * 128 * MEMLEN, MEMLEN, 0, MEMLEN / 32, 0, nullptr, Qw, 512, lane);
}
__device__ __forceinline__ void scan_unit(int bh, const float* LOGF, float* CUM, int* T0, const float* gq, const float* gk, LAS float* sx, LAS float* cl, int tid) {
    const int b = bh >> 3, h = bh & 7, lane = tid & 63, wave = tid >> 6;
    float v[16]; float run = 0.f;
#pragma unroll
    for (int i = 0; i < 16; ++i) v[i] = LOGF[((size_t)b * SEQ + 16 * tid + i) * 8 + h];
#pragma unroll
    for (int i = 0; i < 16; ++i) { run += v[i]; v[i] = run; }
    float tot = run;
#pragma unroll
    for (int off = 1; off < 64; off <<= 1) { const float nb = __shfl_up(tot, off); if (lane >= off) tot += nb; }
    if (lane == 63) sx[wave] = tot;
    __syncthreads();
    float woff = 0.f;
    for (int w = 0; w < wave; ++w) woff += sx[w];
    const float excl = tot - run + woff;
    float* dst = CUM + (size_t)bh * SEQ + 16 * tid;
#pragma unroll
    for (int i = 0; i < 16; i += 4) { const f32x4 o4 = (f32x4){v[i] + excl, v[i + 1] + excl, v[i + 2] + excl, v[i + 3] + excl}; *(f32x4*)(dst + i) = o4; *(LAS f32x4*)(cl + 16 * tid + i) = o4; }
    const float smax = 8.0f * wave_max(fabsf(gq[lane])) * wave_max(fabsf(gk[lane]));
    __syncthreads();
    if (tid < 256) { const float cq = cl[32 * tid]; const float lim = -(30.0f + 2.0f * smax);
        int lo = 0, hi = tid;
        while (lo < hi) { const int mid = (lo + hi) >> 1; if (cq - cl[32 * mid + 31] >= lim) hi = mid; else lo = mid + 1; }
        T0[bh * 256 + tid] = lo; }
    __syncthreads();
}
constexpr int D2_LST = RING_BYTES + 1024;
constexpr int D2_CNT = RING_BYTES + 3072;
constexpr int D2_CL = RING_BYTES + 4096;
typedef short v4i16_t __attribute__((ext_vector_type(4)));
typedef float f32x4d __attribute__((ext_vector_type(4)));
__device__ __forceinline__ unsigned sortable_u32(float f) { const unsigned u = __float_as_uint(f); return u ^ ((u >> 31) ? 0xFFFFFFFFu : 0x80000000u); }
__device__ __forceinline__ int lane_rank(unsigned long long mask) { return (int)__builtin_amdgcn_mbcnt_hi((unsigned)(mask >> 32), __builtin_amdgcn_mbcnt_lo((unsigned)mask, 0u)); }
__device__ __forceinline__ int bcount(bool p) { return (int)__popcll(__ballot(p)); }
__device__ __forceinline__ void select_full(const LAS unsigned* my, int npad, LAS unsigned short* lst, int lane) {
    unsigned thr = 0u;
    for (int bit = 31; bit >= 0; --bit) {
        const unsigned cand = thr | (1u << bit); int cnt = 0;
        for (int i0 = 0; i0 < npad; i0 += 256) { const int idx = i0 + 4 * lane; v4u v = (v4u){0u, 0u, 0u, 0u}; if (idx < npad) v = *(const LAS v4u*)(my + idx);
            cnt += bcount(v.x >= cand) + bcount(v.y >= cand) + bcount(v.z >= cand) + bcount(v.w >= cand); }
        if (cnt >= 256) thr = cand;
    }
    int cgt = 0;
    for (int i0 = 0; i0 < npad; i0 += 256) { const int idx = i0 + 4 * lane; v4u v = (v4u){0u, 0u, 0u, 0u}; if (idx < npad) v = *(const LAS v4u*)(my + idx);
        cgt += bcount(v.x > thr) + bcount(v.y > thr) + bcount(v.z > thr) + bcount(v.w > thr); }
    const int quota = 256 - cgt; int eqseen = 0, nsel = 0;
    for (int base = 0; base < npad; base += 64) { const int idx = base + lane; unsigned u = 0u; if (idx < npad) u = my[idx];
        const bool gt = u > thr, eq = (u == thr);
        const unsigned long long em = __ballot(eq); const int er = eqseen + lane_rank(em);
        const bool sel = gt || (eq && er < quota);
        const unsigned long long sm = __ballot(sel); const int pos = nsel + lane_rank(sm);
        if (sel && pos < 256) lst[pos] = (unsigned short)idx;
        nsel += __popcll(sm); eqseen += __popcll(em); }
}
template <int KMAX> __device__ __forceinline__ void select_cands(const unsigned (&uu)[16], const unsigned (&id)[16], LAS unsigned short* lst, int lane) {
    unsigned thr = 0u;
    for (int bit = 31; bit >= 0; --bit) {
        const unsigned cand = thr | (1u << bit); int cnt = 0;
#pragma unroll
        for (int k = 0; k < KMAX; ++k) cnt += bcount(uu[k] >= cand);
        if (cnt >= 256) { thr = cand; if (cnt == 256) break; }
    }
    int cgt = 0, ceq = 0;
#pragma unroll
    for (int k = 0; k < KMAX; ++k) { cgt += bcount(uu[k] > thr); ceq += bcount(uu[k] == thr); }
    const int quota = 256 - cgt; unsigned ilim = 0xFFFFu;
    if (ceq != quota) {
        unsigned I = 0u;
        for (int bit = 12; bit >= 0; --bit) { const unsigned cand = I | (1u << bit); int cnt = 0;
#pragma unroll
            for (int k = 0; k < KMAX; ++k) cnt += bcount(uu[k] == thr && id[k] < cand);
            if (cnt < quota) I = cand; }
        ilim = I;
    }
    int nsel = 0;
#pragma unroll
    for (int k = 0; k < KMAX; ++k) { const bool sel = (uu[k] > thr) || (uu[k] == thr && id[k] <= ilim);
        const unsigned long long sm = __ballot(sel); const int pos = nsel + lane_rank(sm);
        if (sel && pos < 256) lst[pos] = (unsigned short)id[k];
        nsel += __popcll(sm); }
}
__device__ __forceinline__ void dsa2_unit(int b, int qg, const bf16* IQ, const bf16* IK, const float* IW, const bf16* DQ, const bf16* DK, const bf16* DV, bf16* OB, LAS unsigned char* lds, int wave, int lane) {
    LAS unsigned* sc = (LAS unsigned*)lds;
    LAS unsigned short* LST = (LAS unsigned short*)(lds + D2_LST);
    LAS int* CNT = (LAS int*)(lds + D2_CNT);
    LAS unsigned short* CL = (LAS unsigned short*)(lds + D2_CL);
    const int q0 = 4 * qg, r32 = lane & 31, hi = lane >> 5; const size_t rowbase = (size_t)b * SEQ;
    const int ntile = (q0 + 3) / 32 + 1, npad = ntile * 32;
#ifndef REP_A
#define REP_A 1
#define REP_B1 1
#define REP_B2 1
#define REP_C 1
#endif
    for (int repa = 0; repa < REP_A; ++repa)
    {
        const int qi = 2 * ((r32 >> 2) & 1) + (r32 >> 4), hd = 4 * ((r32 >> 3) & 1) + (r32 & 3);
        bf16x8 aq[4];
#pragma unroll
        for (int ks = 0; ks < 4; ++ks) aq[ks] = *(const bf16x8*)(IQ + (rowbase + q0 + qi) * 512 + hd * 64 + ks * 16 + hi * 8);
        const float* w0p = IW + (rowbase + q0 + 2 * hi) * 8;
        const f32x4 w0a = *(const f32x4*)(w0p), w0b = *(const f32x4*)(w0p + 4), w1a = *(const f32x4*)(w0p + 8), w1b = *(const f32x4*)(w0p + 12);
        for (int t = wave; t < ntile; t += 32) {
            bf16x8 bk[4][4];
#pragma unroll
            for (int u = 0; u < 4; ++u) { const int tt = t + 8 * u; const bf16* kr = IK + (rowbase + 32 * (tt < ntile ? tt : t)) * 64 + lane * 8;
#pragma unroll
                for (int ks = 0; ks < 4; ++ks) bk[u][ks] = *(const bf16x8*)(kr + ks * 512); }
#pragma unroll
            for (int u = 0; u < 4; ++u) { const int tt = t + 8 * u;
                if (tt < ntile) {
                    const int key = 32 * tt + r32;
                    f32x16 a;
#pragma unroll
                    for (int r = 0; r < 16; ++r) a[r] = 0.f;
#pragma unroll
                    for (int ks = 0; ks < 4; ++ks) a = __builtin_amdgcn_mfma_f32_32x32x16_bf16(aq[ks], bk[u][ks], a, 0, 0, 0);
                    float s0 = 0.f, s1 = 0.f;
#pragma unroll
                    for (int j = 0; j < 4; ++j) { s0 += w0a[j] * fmaxf(a[j], 0.f); s1 += w1a[j] * fmaxf(a[8 + j], 0.f); }
#pragma unroll
                    for (int j = 0; j < 4; ++j) { s0 += w0b[j] * fmaxf(a[4 + j], 0.f); s1 += w1b[j] * fmaxf(a[12 + j], 0.f); }
                    sc[(2 * hi) * 8192 + key] = (key <= q0 + 2 * hi) ? sortable_u32(s0) : 0u;
                    sc[(2 * hi + 1) * 8192 + key] = (key <= q0 + 2 * hi + 1) ? sortable_u32(s1) : 0u;
                } }
        }
    }
    __syncthreads();
    const int qi = wave & 3, hf = wave >> 2, q = q0 + qi, n = q + 1;
    const LAS unsigned* my = sc + qi * 8192;
    for (int repb = 0; repb < REP_B1; ++repb)
    {
        int c = 0; bool ovf = false;
        if (n > 256) {
            unsigned pivot = 1u;
            if (n > 640) {
                unsigned s[8];
#pragma unroll
                for (int k = 0; k < 8; ++k) s[k] = my[(int)(((unsigned)(lane * 8 + k) * (unsigned)n) >> 9)];
                const int r = (256 * 512 * 7 / 4) / n + 8;
                unsigned t16 = 0u;
                for (int bit = 15; bit >= 0; --bit) { const unsigned cand = (t16 | (1u << bit)) << 16; int cnt = 0;
#pragma unroll
                    for (int k = 0; k < 8; ++k) cnt += bcount(s[k] >= cand);
                    if (cnt >= r) t16 |= (1u << bit); }
                pivot = t16 << 16; if (pivot == 0u) pivot = 1u;
            }
            const int half = ((npad + 511) >> 9) << 8; const int lo = hf * half; const int hiend = (lo + half < npad) ? lo + half : npad;
            LAS unsigned short* cl = CL + wave * 1024;
            for (int i0 = lo; i0 < hiend; i0 += 256) { const int idx = i0 + 4 * lane; v4u v = (v4u){0u, 0u, 0u, 0u}; if (idx < hiend) v = *(const LAS v4u*)(my + idx);
#pragma unroll
                for (int e = 0; e < 4; ++e) { const bool f = v[e] >= pivot; const unsigned long long m = __ballot(f); const int pos = c + lane_rank(m);
                    if (f) { if (pos < 1024) cl[pos] = (unsigned short)(idx + e); }
                    c += __popcll(m); } }
            if (c > 1024) ovf = true;
        }
        if (lane == 0) CNT[wave] = ovf ? -1 : c;
    }
    __syncthreads();
    for (int repb2 = 0; repb2 < REP_B2; ++repb2)
    if (wave < 4) {
        LAS unsigned short* lst = LST + wave * 256; int nsel;
        if (n <= 256) { for (int i = lane; i < n; i += 64) lst[i] = (unsigned short)i; nsel = n; }
        else {
            const int c0 = CNT[wave], c1 = CNT[wave + 4]; const int c = c0 + c1;
            if (c0 < 0 || c1 < 0 || c < 256 || c > 1024) select_full(my, npad, lst, lane);
            else {
                unsigned uu[16], id[16];
#pragma unroll
                for (int k = 0; k < 16; ++k) { const int j = k * 64 + lane; unsigned ix = 0u, u = 0u;
                    if (j < c) { ix = (j < c0) ? (unsigned)CL[wave * 1024 + j] : (unsigned)CL[(wave + 4) * 1024 + (j - c0)]; u = my[ix]; }
                    uu[k] = u; id[k] = ix; }
                if (c <= 512) select_cands<8>(uu, id, lst, lane); else select_cands<16>(uu, id, lst, lane);
            }
            nsel = 256;
        }
        if (lane == 0) CNT[8 + wave] = nsel;
    }
    __syncthreads();
    for (int repc = 0; repc < REP_C; ++repc)
    {
        const int nsel = CNT[8 + qi]; const int j0 = 128 * hf; int cntk = nsel - j0; cntk = cntk < 0 ? 0 : (cntk > 128 ? 128 : cntk);
        const LAS unsigned short* lst = LST + qi * 256;
        LAS unsigned char* tile = lds + wave * 16384;
        LAS float* tf = (LAS float*)tile;
        const int l15 = lane & 15, kq = lane >> 4;
        if (cntk == 0) {
#pragma unroll
            for (int i = 0; i < 8; ++i) tf[i * 64 + lane] = 0.f;
            if (lane < 8) { tf[512 + lane] = -INFINITY; tf[520 + lane] = 0.f; }
        } else {
#pragma unroll
            for (int it = 0; it < 16; ++it) { const int r = 8 * it + (lane >> 3), ch = lane & 7; int j = j0 + r; j = j < nsel ? j : nsel - 1;
                const int idxv = (int)lst[j]; const v4u v = *(const v4u*)(DV + (rowbase + idxv) * 64 + 8 * ch);
                *(LAS v4u*)(tile + r * 128 + ch * 16) = v; }
            bf16x8 qf[2];
#pragma unroll
            for (int ks = 0; ks < 2; ++ks) { v4u z = (v4u){0u, 0u, 0u, 0u}; if (l15 < 8) z = *(const v4u*)(DQ + (rowbase + q) * 512 + l15 * 64 + 32 * ks + 8 * kq); qf[ks] = __builtin_bit_cast(bf16x8, z); }
            f32x4d acc[8];
#pragma unroll
            for (int g = 0; g < 8; ++g) { int j = j0 + 16 * g + l15; j = j < nsel ? j : nsel - 1; const int idxk = (int)lst[j];
                const bf16* kp = DK + (rowbase + idxk) * 64 + 8 * kq;
                const bf16x8 k0 = *(const bf16x8*)(kp), k1 = *(const bf16x8*)(kp + 32);
                f32x4d a = (f32x4d){0.f, 0.f, 0.f, 0.f};
                a = __builtin_amdgcn_mfma_f32_16x16x32_bf16(k0, qf[0], a, 0, 0, 0); a = __builtin_amdgcn_mfma_f32_16x16x32_bf16(k1, qf[1], a, 0, 0, 0); acc[g] = a; }
            float mx = -INFINITY;
#pragma unroll
            for (int g = 0; g < 8; ++g)
#pragma unroll
                for (int e = 0; e < 4; ++e) { if (16 * g + 4 * kq + e >= cntk) acc[g][e] = -INFINITY; mx = fmaxf(mx, acc[g][e]); }
            mx = fmaxf(mx, __shfl_xor(mx, 16)); mx = fmaxf(mx, __shfl_xor(mx, 32));
            float ls = 0.f;
#pragma unroll
            for (int g = 0; g < 8; ++g)
#pragma unroll
                for (int e = 0; e < 4; ++e) { acc[g][e] = __builtin_amdgcn_exp2f(acc[g][e] - mx); ls += acc[g][e]; }
            ls += __shfl_xor(ls, 16); ls += __shfl_xor(ls, 32);
            bf16x8 pa[4];
#pragma unroll
            for (int t = 0; t < 4; ++t) { v4u w; w.x = cvtpk(acc[2 * t][0], acc[2 * t][1]); w.y = cvtpk(acc[2 * t][2], acc[2 * t][3]); w.z = cvtpk(acc[2 * t + 1][0], acc[2 * t + 1][1]); w.w = cvtpk(acc[2 * t + 1][2], acc[2 * t + 1][3]); pa[t] = __builtin_bit_cast(bf16x8, w); }
            f32x4d o[4];
            const int q_ = l15 >> 2, p_ = lane & 3;
#pragma unroll
            for (int cb = 0; cb < 4; ++cb) { f32x4d oc = (f32x4d){0.f, 0.f, 0.f, 0.f};
#pragma unroll
                for (int t = 0; t < 4; ++t) {
                    const LAS unsigned char* a1 = tile + (32 * t + 4 * kq + q_) * 128 + (16 * cb + 4 * p_) * 2;
                    const v4i16_t lo4 = __builtin_amdgcn_ds_read_tr16_b64_v4i16((LAS v4i16_t*)a1), hi4 = __builtin_amdgcn_ds_read_tr16_b64_v4i16((LAS v4i16_t*)(a1 + 16 * 128));
                    const bf16x8 vf = (bf16x8){lo4[0], lo4[1], lo4[2], lo4[3], hi4[0], hi4[1], hi4[2], hi4[3]};
                    oc = __builtin_amdgcn_mfma_f32_16x16x32_bf16(pa[t], vf, oc, 0, 0, 0); }
                o[cb] = oc; }
            if (kq < 2) {
#pragma unroll
                for (int cb = 0; cb < 4; ++cb)
#pragma unroll
                    for (int e = 0; e < 4; ++e) tf[(4 * kq + e) * 64 + 16 * cb + l15] = o[cb][e];
            }
            if (lane < 8) { tf[512 + lane] = mx; tf[520 + lane] = ls; }
        }
    }
    __syncthreads();
    if (wave < 4) {
        const LAS float* ta = (const LAS float*)(lds + wave * 16384); const LAS float* tb = (const LAS float*)(lds + (wave + 4) * 16384);
        const int h = lane >> 3, d0 = (lane & 7) * 8;
        const float ma = ta[512 + h], mb = tb[512 + h], la = ta[520 + h], lb = tb[520 + h];
        const float m = fmaxf(ma, mb), fa = __builtin_amdgcn_exp2f(ma - m), fb = __builtin_amdgcn_exp2f(mb - m);
        const float inv = 1.0f / (la * fa + lb * fb);
        const f32x4 a0 = *(const LAS f32x4*)(ta + h * 64 + d0), a1 = *(const LAS f32x4*)(ta + h * 64 + d0 + 4), b0 = *(const LAS f32x4*)(tb + h * 64 + d0), b1 = *(const LAS f32x4*)(tb + h * 64 + d0 + 4);
        const f32x4 r0 = (a0 * fa + b0 * fb) * inv, r1 = (a1 * fa + b1 * fb) * inv;
        v4u w; w.x = cvtpk(r0[0], r0[1]); w.y = cvtpk(r0[2], r0[3]); w.z = cvtpk(r1[0], r1[1]); w.w = cvtpk(r1[2], r1[3]);
        *(v4u*)(OB + (rowbase + q) * 512 + h * 64 + d0) = w;
    }
    __syncthreads();
}
constexpr int D3_RING = RING_BYTES + 1024;
constexpr int D3_LST = D3_RING + 16384;
constexpr int D3_CNT = D3_LST + 8192;
constexpr int D3_QW = D3_CNT + 512;
typedef unsigned long long u64d;
template <int KMAX> __device__ __forceinline__ void select_cands3(const unsigned (&uu)[16], const unsigned (&id)[16], LAS unsigned short* lst, int lane) { select_cands<KMAX>(uu, id, lst, lane); }
__device__ __forceinline__ void dsa3_unit(int b, int g16, const bf16* IQ, const bf16* IK, const float* IW, const bf16* DQ, const bf16* DK, const bf16* DV, bf16* OB, LAS unsigned char* lds, int wave, int lane_in) {
    int lane = lane_in; asm volatile("" : "+v"(lane));
    LAS u64d* LISTS = (LAS u64d*)lds;
    LAS unsigned short* LST = (LAS unsigned short*)(lds + D3_LST);
    LAS int* CNT = (LAS int*)(lds + D3_CNT);
    const int tid = wave * 64 + lane, r32 = lane & 31, hi = lane >> 5; const size_t rowbase = (size_t)b * SEQ;
    const int q0 = 16 * g16, ntile = (q0 + 15) / 32 + 1, nstep = (ntile + 1) >> 1;
    const int qgrp = wave & 3, par = wave >> 2;
    const int qA = q0 + 4 * qgrp + 2 * hi, qB = qA + 1;
    const int qi = 2 * ((r32 >> 2) & 1) + (r32 >> 4), hd = 4 * ((r32 >> 3) & 1) + (r32 & 3);
    bf16x8 aq[4];
#pragma unroll
    for (int ks = 0; ks < 4; ++ks) aq[ks] = *(const bf16x8*)(IQ + (rowbase + q0 + 4 * qgrp + qi) * 512 + hd * 64 + ks * 16 + hi * 8);
    const float* w0p = IW + (rowbase + qA) * 8;
    const f32x4 w0a = *(const f32x4*)(w0p), w0b = *(const f32x4*)(w0p + 4), w1a = *(const f32x4*)(w0p + 8), w1b = *(const f32x4*)(w0p + 12);
    f32x4 l0a, l0b, l1a, l1b;
#pragma unroll
    for (int j = 0; j < 4; ++j) { l0a[j] = w0a[j] >= 0.f ? INFINITY : -INFINITY; l0b[j] = w0b[j] >= 0.f ? INFINITY : -INFINITY; l1a[j] = w1a[j] >= 0.f ? INFINITY : -INFINITY; l1b[j] = w1b[j] >= 0.f ? INFINITY : -INFINITY; }
#define D3_SCORE(BK, S0, S1) do { f32x16 a_; _Pragma("unroll") for (int r = 0; r < 16; ++r) a_[r] = 0.f; \
        _Pragma("unroll") for (int ks = 0; ks < 4; ++ks) a_ = __builtin_amdgcn_mfma_f32_32x32x16_bf16(aq[ks], BK[ks], a_, 0, 0, 0); \
        S0 = 0.f; S1 = 0.f; \
        _Pragma("unroll") for (int j = 0; j < 4; ++j) { S0 += __builtin_amdgcn_fmed3f(w0a[j] * a_[j], 0.f, l0a[j]); S1 += __builtin_amdgcn_fmed3f(w1a[j] * a_[8 + j], 0.f, l1a[j]); } \
        _Pragma("unroll") for (int j = 0; j < 4; ++j) { S0 += __builtin_amdgcn_fmed3f(w0b[j] * a_[4 + j], 0.f, l0b[j]); S1 += __builtin_amdgcn_fmed3f(w1b[j] * a_[12 + j], 0.f, l1b[j]); } } while (0)
#ifndef REP_S
#define REP_S 1
#define REP_M 1
#define REP_B 1
#define REP_CD 1
#endif
    unsigned pivA = 1u, pivB = 1u;
    for (int reps = 0; reps < REP_S; ++reps)
    if (ntile > 16) {
#pragma unroll
        for (int k = 0; k < 4; ++k) { const int c = tid + 512 * k; const int ts = ((c >> 8) * ntile) >> 3;
            *(LAS v4u*)(lds + c * 16) = *(const v4u*)(IK + (rowbase + 32 * ts) * 64 + (c & 255) * 8); }
        __syncthreads();
        unsigned uA[8], uB[8];
#pragma unroll
        for (int i = 0; i < 8; ++i) { bf16x8 bk[4];
#pragma unroll
            for (int ks = 0; ks < 4; ++ks) bk[ks] = *(const LAS bf16x8*)(lds + i * 4096 + ks * 1024 + lane * 16);
            float s0, s1; D3_SCORE(bk, s0, s1); uA[i] = sortable_u32(s0); uB[i] = sortable_u32(s1); asm volatile("" ::: "memory"); }
        const int rA = (256 * 256 * 7 / 4) / (qA + 1) + 6, rB = (256 * 256 * 7 / 4) / (qB + 1) + 6;
        unsigned tA = 0u, tB = 0u;
        for (int bit = 15; bit >= 0; --bit) {
            const unsigned cA = (tA | (1u << bit)) << 16, cB = (tB | (1u << bit)) << 16; int nA = 0, nB = 0;
#pragma unroll
            for (int i = 0; i < 8; ++i) { const unsigned long long mA = __ballot(uA[i] >= cA), mB = __ballot(uB[i] >= cB);
                nA += hi ? __popc((unsigned)(mA >> 32)) : __popc((unsigned)mA); nB += hi ? __popc((unsigned)(mB >> 32)) : __popc((unsigned)mB); }
            if (nA >= rA) tA |= (1u << bit);
            if (nB >= rB) tB |= (1u << bit);
        }
        pivA = tA << 16; pivB = tB << 16; if (pivA == 0u) pivA = 1u; if (pivB == 0u) pivB = 1u;
        __syncthreads();
    }
    for (int repm = 0; repm < REP_M; ++repm)
    {
        const bf16* src0 = IK + rowbase * 64 + (size_t)(tid & 255) * 8;
#define D3_LOAD(k_) (*(const v4u*)(src0 + (size_t)32 * ((2 * (k_) + (tid >> 8)) < ntile ? (2 * (k_) + (tid >> 8)) : ntile - 1) * 64))
        v4u st0 = (v4u){0u, 0u, 0u, 0u}, st1 = st0, st2 = st0, st3 = st0;
        st0 = D3_LOAD(0); st1 = D3_LOAD(1); st2 = D3_LOAD(2); st3 = D3_LOAD(3);
        *(LAS v4u*)(lds + D3_RING + tid * 16) = st0;
        __syncthreads();
        int cntA = 0, cntB = 0;
        LAS u64d* lA = LISTS + ((4 * qgrp + 2 * hi) * 2 + par) * 512; LAS u64d* lB = lA + 1024;
        f32x16 acc;
#pragma unroll
        for (int r = 0; r < 16; ++r) acc[r] = 0.f;
#define D3_SUMS(S0, S1) do { S0 = 0.f; S1 = 0.f; \
            _Pragma("unroll") for (int j = 0; j < 4; ++j) { S0 += __builtin_amdgcn_fmed3f(w0a[j] * acc[j], 0.f, l0a[j]); S1 += __builtin_amdgcn_fmed3f(w1a[j] * acc[8 + j], 0.f, l1a[j]); } \
            _Pragma("unroll") for (int j = 0; j < 4; ++j) { S0 += __builtin_amdgcn_fmed3f(w0b[j] * acc[4 + j], 0.f, l0b[j]); S1 += __builtin_amdgcn_fmed3f(w1b[j] * acc[12 + j], 0.f, l1b[j]); } } while (0)
#define D3_FILTER(TP, S0, S1) do { const int key = 32 * (TP) + r32; const unsigned u0 = sortable_u32(S0), u1 = sortable_u32(S1); \
                { const bool ps = (key <= qA) && (u0 >= pivA); const unsigned long long m = __ballot(ps); const unsigned ml = (unsigned)m, mh = (unsigned)(m >> 32); \
                  const int pos = cntA + (int)__builtin_amdgcn_mbcnt_hi(mh, __builtin_amdgcn_mbcnt_lo(ml, 0u)) - (hi ? __popc(ml) : 0); \
                  if (ps && pos < 512) lA[pos] = ((u64d)(unsigned)key << 32) | u0; cntA += hi ? __popc(mh) : __popc(ml); } \
                { const bool ps = (key <= qB) && (u1 >= pivB); const unsigned long long m = __ballot(ps); const unsigned ml = (unsigned)m, mh = (unsigned)(m >> 32); \
                  const int pos = cntB + (int)__builtin_amdgcn_mbcnt_hi(mh, __builtin_amdgcn_mbcnt_lo(ml, 0u)) - (hi ? __popc(ml) : 0); \
                  if (ps && pos < 512) lB[pos] = ((u64d)(unsigned)key << 32) | u1; cntB += hi ? __popc(mh) : __popc(ml); } } while (0)
#define D3_STEP(k_, STNEXT, STFREE) do { \
            STFREE = D3_LOAD((k_) + 4); \
            const int tp_ = 2 * (k_) - 2 + par; \
            const LAS unsigned char* sb = lds + D3_RING + ((k_) & 1) * 8192 + par * 4096; bf16x8 bk[4]; \
            _Pragma("unroll") for (int ks = 0; ks < 4; ++ks) bk[ks] = *(const LAS bf16x8*)(sb + ks * 1024 + lane * 16); \
            __builtin_amdgcn_sched_barrier(0); \
            float s0, s1; D3_SUMS(s0, s1); asm volatile("" : "+v"(s0), "+v"(s1));     \
            __builtin_amdgcn_sched_barrier(0); \
            _Pragma("unroll") for (int r = 0; r < 16; ++r) acc[r] = 0.f; \
            _Pragma("unroll") for (int ks = 0; ks < 4; ++ks) acc = __builtin_amdgcn_mfma_f32_32x32x16_bf16(aq[ks], bk[ks], acc, 0, 0, 0); \
            __builtin_amdgcn_sched_barrier(0); \
            if (tp_ >= 0 && tp_ < ntile) D3_FILTER(tp_, s0, s1); \
            *(LAS v4u*)(lds + D3_RING + (((k_) + 1) & 1) * 8192 + tid * 16) = STNEXT; \
            asm volatile("s_waitcnt lgkmcnt(0)" ::: "memory"); __builtin_amdgcn_s_barrier(); asm volatile("" ::: "memory"); } while (0)
        int kend = 0;
        for (int k = 0; k < nstep; k += 4) {
            D3_STEP(k, st1, st0); D3_STEP(k + 1, st2, st1); D3_STEP(k + 2, st3, st2); D3_STEP(k + 3, st0, st3); kend = k + 4;
        }
        {   const int tp_ = 2 * kend - 2 + par; if (tp_ < ntile) { float s0, s1; D3_SUMS(s0, s1); D3_FILTER(tp_, s0, s1); } }
#undef D3_SUMS
#undef D3_FILTER
#undef D3_STEP
#undef D3_LOAD
        if (r32 == 0) { CNT[(4 * qgrp + 2 * hi) * 2 + par] = cntA; CNT[(4 * qgrp + 2 * hi + 1) * 2 + par] = cntB; }
        if (tid < 4) CNT[48 + tid] = 0;
    }
#undef D3_SCORE
    __syncthreads();
#if defined(DBG_D3_STAGE) && DBG_D3_STAGE == 1
    for (int grp = 0; grp < 4; ++grp) dsa2_unit(b, 4 * g16 + grp, IQ, IK, IW, DQ, DK, DV, OB, lds, wave, lane);
    return;
#endif
#pragma unroll 1
    for (int rr = 0; rr < 2 * REP_B; ++rr) {
        const int qx = wave + 8 * (rr & 1), q = q0 + qx, n = q + 1; LAS unsigned short* lst = LST + qx * 256; int nsel;
        if (n <= 256) { for (int i = lane; i < n; i += 64) lst[i] = (unsigned short)i; nsel = n; }
        else {
            const int c0 = CNT[2 * qx], c1 = CNT[2 * qx + 1]; const int c = c0 + c1;
#ifdef DBG_D3_ALLFAIL
            if (true) { if (lane == 0) CNT[48 + (qx >> 2)] = 1; nsel = 0; }
#else
            if (c0 > 512 || c1 > 512 || c < 256) { if (lane == 0) CNT[48 + (qx >> 2)] = 1; nsel = 0; }
#endif
            else {
                unsigned uu[16], id[16]; const LAS u64d* L0 = LISTS + (qx * 2) * 512; const LAS u64d* L1 = L0 + 512;
#pragma unroll
                for (int k = 0; k < 16; ++k) { const int j = k * 64 + lane; u64d e = 0ull; if (j < c) e = (j < c0) ? L0[j] : L1[j - c0]; uu[k] = (unsigned)e; id[k] = (unsigned)(e >> 32); }
                if (c <= 512) select_cands<8>(uu, id, lst, lane); else select_cands<16>(uu, id, lst, lane);
                nsel = 256;
            }
        }
        if (lane == 0) CNT[32 + qx] = nsel;
    }
    __syncthreads();
#pragma unroll 1
    for (int rr = 0; rr < 2; ++rr) {
        const int qx = wave + 8 * rr, q = q0 + qx; const int nsel = CNT[32 + qx];
        const LAS unsigned short* lst = LST + qx * 256;
        LAS unsigned char* tile = lds + wave * 16384; LAS float* tf = (LAS float*)tile;
        const int l15 = lane & 15, kq = lane >> 4, q_ = l15 >> 2, p_ = lane & 3;
        bf16x8 qf[2];
#pragma unroll
        for (int ks = 0; ks < 2; ++ks) { v4u z = (v4u){0u, 0u, 0u, 0u}; if (l15 < 8) z = *(const v4u*)(DQ + (rowbase + q) * 512 + l15 * 64 + 32 * ks + 8 * kq); qf[ks] = __builtin_bit_cast(bf16x8, z); }
        float mrun = -INFINITY, lrun = 0.f; f32x4d orun[4];
#pragma unroll
        for (int cb = 0; cb < 4; ++cb) orun[cb] = (f32x4d){0.f, 0.f, 0.f, 0.f};
#pragma unroll 1
        for (int hf = 0; hf < 2; ++hf) {
            const int j0 = 128 * hf; int cntk = nsel - j0; cntk = cntk > 128 ? 128 : cntk;
            if (cntk <= 0) break;
            int iv[16], ik[8];
#pragma unroll
            for (int it = 0; it < 16; ++it) { int j = j0 + 8 * it + (lane >> 3); j = j < nsel ? j : nsel - 1; iv[it] = (int)lst[j]; }
#pragma unroll
            for (int g = 0; g < 8; ++g) { int j = j0 + 16 * g + l15; j = j < nsel ? j : nsel - 1; ik[g] = (int)lst[j]; }
            asm volatile("s_waitcnt lgkmcnt(0)" ::: "memory");
#pragma unroll
            for (int it = 0; it < 16; ++it)
                __builtin_amdgcn_global_load_lds((const unsigned*)(DV + (rowbase + iv[it]) * 64 + 8 * (lane & 7)), (LAS unsigned*)(tile + it * 1024), 16, 0, 0);
            bf16x8 kk0[8], kk1[8];
#pragma unroll
            for (int g = 0; g < 8; ++g) { const bf16* kp = DK + (rowbase + ik[g]) * 64 + 8 * kq; kk0[g] = *(const bf16x8*)(kp); kk1[g] = *(const bf16x8*)(kp + 32); }
            asm volatile("" ::: "memory");
            f32x4d acc[8];
#pragma unroll
            for (int g = 0; g < 8; ++g) { f32x4d a = (f32x4d){0.f, 0.f, 0.f, 0.f};
                a = __builtin_amdgcn_mfma_f32_16x16x32_bf16(kk0[g], qf[0], a, 0, 0, 0); a = __builtin_amdgcn_mfma_f32_16x16x32_bf16(kk1[g], qf[1], a, 0, 0, 0); acc[g] = a; }
            float mx = -INFINITY;
#pragma unroll
            for (int g = 0; g < 8; ++g)
#pragma unroll
                for (int e = 0; e < 4; ++e) { if (16 * g + 4 * kq + e >= cntk) acc[g][e] = -INFINITY; mx = fmaxf(mx, acc[g][e]); }
            mx = fmaxf(mx, __shfl_xor(mx, 16)); mx = fmaxf(mx, __shfl_xor(mx, 32));
            const float mnew = fmaxf(mrun, mx), fold = __builtin_amdgcn_exp2f(mrun - mnew);
            float ls = 0.f;
#pragma unroll
            for (int g = 0; g < 8; ++g)
#pragma unroll
                for (int e = 0; e < 4; ++e) { acc[g][e] = __builtin_amdgcn_exp2f(acc[g][e] - mnew); ls += acc[g][e]; }
            ls += __shfl_xor(ls, 16); ls += __shfl_xor(ls, 32);
            lrun = lrun * fold + ls; mrun = mnew;
            float fo[4];
#pragma unroll
            for (int e = 0; e < 4; ++e) fo[e] = __shfl(fold, 4 * kq + e);
            asm volatile("s_waitcnt vmcnt(0)" ::: "memory");
            bf16x8 pa[4];
#pragma unroll
            for (int t = 0; t < 4; ++t) { v4u w; w.x = cvtpk(acc[2 * t][0], acc[2 * t][1]); w.y = cvtpk(acc[2 * t][2], acc[2 * t][3]); w.z = cvtpk(acc[2 * t + 1][0], acc[2 * t + 1][1]); w.w = cvtpk(acc[2 * t + 1][2], acc[2 * t + 1][3]); pa[t] = __builtin_bit_cast(bf16x8, w); }
#pragma unroll
            for (int cb = 0; cb < 4; ++cb) { f32x4d oc = orun[cb];
#pragma unroll
                for (int e = 0; e < 4; ++e) oc[e] *= fo[e];
#pragma unroll
                for (int t = 0; t < 4; ++t) {
                    const LAS unsigned char* a1 = tile + (32 * t + 4 * kq + q_) * 128 + (16 * cb + 4 * p_) * 2;
                    const v4i16_t lo4 = __builtin_amdgcn_ds_read_tr16_b64_v4i16((LAS v4i16_t*)a1), hi4 = __builtin_amdgcn_ds_read_tr16_b64_v4i16((LAS v4i16_t*)(a1 + 16 * 128));
                    const bf16x8 vf = (bf16x8){lo4[0], lo4[1], lo4[2], lo4[3], hi4[0], hi4[1], hi4[2], hi4[3]};
                    oc = __builtin_amdgcn_mfma_f32_16x16x32_bf16(pa[t], vf, oc, 0, 0, 0); }
                orun[cb] = oc; }
        }
        float li[4];
#pragma unroll
        for (int e = 0; e < 4; ++e) li[e] = 1.0f / __shfl(lrun, 4 * kq + e);
        if (kq < 2) {
#pragma unroll
            for (int cb = 0; cb < 4; ++cb)
#pragma unroll
                for (int e = 0; e < 4; ++e) tf[(4 * kq + e) * 64 + 16 * cb + l15] = orun[cb][e] * li[e];
        }
        { const int h = lane >> 3, d0 = (lane & 7) * 8;
          const f32x4 r0 = *(const LAS f32x4*)(tf + h * 64 + d0), r1 = *(const LAS f32x4*)(tf + h * 64 + d0 + 4);
          v4u w; w.x = cvtpk(r0[0], r0[1]); w.y = cvtpk(r0[2], r0[3]); w.z = cvtpk(r1[0], r1[1]); w.w = cvtpk(r1[2], r1[3]);
          *(v4u*)(OB + (rowbase + q) * 512 + h * 64 + d0) = w; }
    }
    __syncthreads();
    const int f0 = CNT[48], f1 = CNT[49], f2 = CNT[50], f3 = CNT[51];
    __syncthreads();
    const int fm = (f0 ? 1 : 0) | (f1 ? 2 : 0) | (f2 ? 4 : 0) | (f3 ? 8 : 0);
#pragma unroll 1
    for (int grp = 0; grp < 4; ++grp) if ((fm >> grp) & 1) dsa2_unit(b, 4 * g16 + grp, IQ, IK, IW, DQ, DK, DV, OB, lds, wave, lane);
}
__device__ __forceinline__ void fox_unit2(int bh, int qb, const bf16* FQ, const bf16* FK, const bf16* FV, const float* CUM, const int* T0, bf16* OA, LAS unsigned char* lds, int wave, int lane) {
    const int b = bh >> 3, h = bh & 7, r32 = lane & 31, hi = lane >> 5; const size_t rowbase = (size_t)b * SEQ; const int q0 = qb * 256 + wave * 32;
    const bf16* Qw = FQ + (rowbase + q0) * 512 + h * 64; bf16* Ow = OA + (rowbase + q0) * 512 + h * 64;
    const bf16* Kp = FK + rowbase * 512 + h * 64; const bf16* Vp = FV + rowbase * 512 + h * 64; const float* cb = CUM + (size_t)bh * SEQ;
    LAS unsigned char* wl = lds + wave * 16384;
    LAS float* bl = (LAS float*)(lds + RING_BYTES + 8192 + wave * 256);
    bf16x8 qr[4];
#pragma unroll
    for (int ks = 0; ks < 4; ++ks) qr[ks] = *(const bf16x8*)(Qw + (size_t)r32 * 512 + ks * 16 + hi * 8);
    const int tstart = T0[bh * 256 + q0 / 32], ntiles = q0 / 32 + 1, qlocal = q0 + r32;
    f32x16 o[2];
#pragma unroll
    for (int d0 = 0; d0 < 2; ++d0)
#pragma unroll
        for (int r = 0; r < 16; ++r) o[d0][r] = 0.f;
    float m = -1e30f, l = 0.f;
    const int lrow = lane >> 3, lch = lane & 7;
#define FOX_LOAD(KR, VR, BR, tt) do { _Pragma("unroll") for (int it = 0; it < 4; ++it) { const size_t ro = (size_t)(32 * (tt) + 8 * it + lrow) * 512 + lch * 8; KR[it] = *(const v4u*)(Kp + ro); VR[it] = *(const v4u*)(Vp + ro); } BR = cb[32 * (tt) + r32]; } while (0)
#define FOX_STORE(KR, VR, BR, bf) do { _Pragma("unroll") for (int it = 0; it < 4; ++it) { const int row = 8 * it + lrow; *(LAS v4u*)(wl + (bf) * 4096 + row * 128 + ((lch ^ (row & 7)) * 16)) = KR[it]; *(LAS v4u*)(wl + 8192 + (bf) * 4096 + row * 128 + lch * 16) = VR[it]; } if (lane < 32) bl[(bf) * 32 + lane] = -L2E * BR; } while (0)
    v4u krA[4], vrA[4], krB[4], vrB[4]; float brA = 0.f, brB = 0.f;
    const int kq = (lane >> 4) & 1, q_ = (lane & 15) >> 2, p_ = lane & 3;
    FOX_LOAD(krA, vrA, brA, tstart);
    if (tstart + 1 < ntiles) FOX_LOAD(krB, vrB, brB, tstart + 1);
    FOX_STORE(krA, vrA, brA, 0);
    auto compute = [&](int t, int buf) {
        const LAS unsigned char* kb = wl + buf * 4096; const LAS unsigned char* vb = wl + 8192 + buf * 4096; const LAS float* bb = bl + buf * 32;
        f32x16 p;
#pragma unroll
        for (int r = 0; r < 16; ++r) p[r] = 0.f;
#pragma unroll
        for (int ks = 0; ks < 4; ++ks) { const bf16x8 kf = *(const LAS bf16x8*)(kb + r32 * 128 + (((2 * ks + hi) ^ (r32 & 7)) * 16)); p = __builtin_amdgcn_mfma_f32_32x32x16_bf16(kf, qr[ks], p, 0, 0, 0); }
#pragma unroll
        for (int g = 0; g < 4; ++g) { const f32x4 c4 = *(const LAS f32x4*)(bb + 8 * g + 4 * hi);
#pragma unroll
            for (int jj = 0; jj < 4; ++jj) p[4 * g + jj] += c4[jj]; }
        if (t == ntiles - 1) {
#pragma unroll
            for (int r = 0; r < 16; ++r) if (32 * t + crow(r, hi) > qlocal) p[r] = -INFINITY;
        }
        float mt = p[0];
#pragma unroll
        for (int r = 1; r < 16; ++r) mt = fmaxf(mt, p[r]);
        mt = fmaxf(mt, __shfl_xor(mt, 32));
        const float mn = fmaxf(m, mt); const float alpha = __builtin_amdgcn_exp2f(m - mn); m = mn;
        l *= alpha;
#pragma unroll
        for (int d0 = 0; d0 < 2; ++d0)
#pragma unroll
            for (int r = 0; r < 16; ++r) o[d0][r] *= alpha;
        float ls = 0.f;
#pragma unroll
        for (int r = 0; r < 16; ++r) { p[r] = __builtin_amdgcn_exp2f(p[r] - mn); ls += p[r]; }
        l += ls;
        bf16x8 pa[2];
#pragma unroll
        for (int s2 = 0; s2 < 2; ++s2) { v4u w; w.x = cvtpk(p[8 * s2 + 0], p[8 * s2 + 1]); w.y = cvtpk(p[8 * s2 + 2], p[8 * s2 + 3]); w.z = cvtpk(p[8 * s2 + 4], p[8 * s2 + 5]); w.w = cvtpk(p[8 * s2 + 6], p[8 * s2 + 7]); pa[s2] = __builtin_bit_cast(bf16x8, w); }
#pragma unroll
        for (int d0 = 0; d0 < 2; ++d0)
#pragma unroll
            for (int s2 = 0; s2 < 2; ++s2) {
                const LAS unsigned char* a1 = vb + (16 * s2 + 4 * hi + q_) * 128 + (32 * d0 + 16 * kq + 4 * p_) * 2;
                const v4i16_t lo4 = __builtin_amdgcn_ds_read_tr16_b64_v4i16((LAS v4i16_t*)a1), hi4 = __builtin_amdgcn_ds_read_tr16_b64_v4i16((LAS v4i16_t*)(a1 + 8 * 128));
                const bf16x8 vf = (bf16x8){lo4[0], lo4[1], lo4[2], lo4[3], hi4[0], hi4[1], hi4[2], hi4[3]};
                o[d0] = __builtin_amdgcn_mfma_f32_32x32x16_bf16(vf, pa[s2], o[d0], 0, 0, 0);
            }
    };
    for (int t = tstart; t < ntiles; t += 2) {
        if (t + 2 < ntiles) FOX_LOAD(krA, vrA, brA, t + 2);
        compute(t, 0);
        if (t + 1 < ntiles) {
            FOX_STORE(krB, vrB, brB, 1);
            if (t + 3 < ntiles) FOX_LOAD(krB, vrB, brB, t + 3);
            compute(t + 1, 1);
            if (t + 2 < ntiles) FOX_STORE(krA, vrA, brA, 0);
        }
    }
#undef FOX_LOAD
#undef FOX_STORE
    l += __shfl_xor(l, 32);
    const float inv = 1.0f / l;
    bf16* orow = Ow + (size_t)r32 * 512;
#pragma unroll
    for (int d0 = 0; d0 < 2; ++d0)
#pragma unroll
        for (int g = 0; g < 4; ++g) { u32x2 w; w.x = cvtpk(o[d0][4 * g] * inv, o[d0][4 * g + 1] * inv); w.y = cvtpk(o[d0][4 * g + 2] * inv, o[d0][4 * g + 3] * inv);
            *(u32x2*)(orow + d0 * 32 + 8 * g + 4 * hi) = w; }
}
__device__ __forceinline__ void fox_unit4(int bh, int qb, const bf16* FQ, const bf16* FK, const bf16* FV, const float* CUM, const int* T0, const float* gq, const float* gk, bf16* OA, LAS unsigned char* lds, int wave, int lane) {
    const int b = bh >> 3, h = bh & 7, r32 = lane & 31, hi = lane >> 5; const size_t rowbase = (size_t)b * SEQ; const int q0 = qb * 256 + wave * 32;
    const bf16* Qw = FQ + (rowbase + q0) * 512 + h * 64; bf16* Ow = OA + (rowbase + q0) * 512 + h * 64;
    const bf16* Kp = FK + rowbase * 512 + h * 64; const bf16* Vp = FV + rowbase * 512 + h * 64; const float* cb = CUM + (size_t)bh * SEQ;
    LAS unsigned char* wl = lds + wave * 16384;
    LAS float* bl = (LAS float*)(lds + RING_BYTES + 8192 + wave * 256);
    bf16x8 qr[4];
#pragma unroll
    for (int ks = 0; ks < 4; ++ks) qr[ks] = *(const bf16x8*)(Qw + (size_t)r32 * 512 + ks * 16 + hi * 8);
    const int tstart = T0[bh * 256 + q0 / 32], tlast = q0 / 32, nseq = tlast - tstart + 1, qlocal = q0 + r32;
    const float stopc = (8.0f * wave_max(fabsf(gq[lane])) * wave_max(fabsf(gk[lane])) + 30.0f) * L2E;
    f32x16 o[2];
#pragma unroll
    for (int d0 = 0; d0 < 2; ++d0)
#pragma unroll
        for (int r = 0; r < 16; ++r) o[d0][r] = 0.f;
    float m = -1e30f, l = 0.f;
    const int lrow = lane >> 3, lch = lane & 7;
#define FOX_LOAD(KR, VR, BR, tt) do { _Pragma("unroll") for (int it = 0; it < 4; ++it) { const size_t ro = (size_t)(32 * (tt) + 8 * it + lrow) * 512 + lch * 8; KR[it] = *(const v4u*)(Kp + ro); VR[it] = *(const v4u*)(Vp + ro); } BR = cb[32 * (tt) + r32]; } while (0)
#define FOX_STORE(KR, VR, BR, bf) do { _Pragma("unroll") for (int it = 0; it < 4; ++it) { const int row = 8 * it + lrow; *(LAS v4u*)(wl + (bf) * 4096 + row * 128 + ((lch ^ (row & 7)) * 16)) = KR[it]; *(LAS v4u*)(wl + 8192 + (bf) * 4096 + row * 128 + lch * 16) = VR[it]; } if (lane < 32) bl[(bf) * 32 + lane] = -L2E * BR; } while (0)
    v4u krA[4], vrA[4], krB[4], vrB[4]; float brA = 0.f, brB = 0.f;
    const int kq = (lane >> 4) & 1, q_ = (lane & 15) >> 2, p_ = lane & 3;
    FOX_LOAD(krA, vrA, brA, tlast);
    if (1 < nseq) FOX_LOAD(krB, vrB, brB, tlast - 1);
    FOX_STORE(krA, vrA, brA, 0);
    auto compute = [&](int t, int buf) -> bool {
        const LAS unsigned char* kb = wl + buf * 4096; const LAS unsigned char* vb = wl + 8192 + buf * 4096; const LAS float* bb = bl + buf * 32;
        if (t != tlast) { const float bmax = bb[31]; if (__all(m > bmax + stopc)) return true; }
        f32x16 p;
#pragma unroll
        for (int r = 0; r < 16; ++r) p[r] = 0.f;
#pragma unroll
        for (int ks = 0; ks < 4; ++ks) { const bf16x8 kf = *(const LAS bf16x8*)(kb + r32 * 128 + (((2 * ks + hi) ^ (r32 & 7)) * 16)); p = __builtin_amdgcn_mfma_f32_32x32x16_bf16(kf, qr[ks], p, 0, 0, 0); }
#pragma unroll
        for (int g = 0; g < 4; ++g) { const f32x4 c4 = *(const LAS f32x4*)(bb + 8 * g + 4 * hi);
#pragma unroll
            for (int jj = 0; jj < 4; ++jj) p[4 * g + jj] += c4[jj]; }
        if (t == tlast) {
#pragma unroll
            for (int r = 0; r < 16; ++r) if (32 * t + crow(r, hi) > qlocal) p[r] = -INFINITY;
        }
        float mt = p[0];
#pragma unroll
        for (int r = 1; r < 16; ++r) mt = fmaxf(mt, p[r]);
        mt = fmaxf(mt, __shfl_xor(mt, 32));
        if (__any(mt > m)) {
            const float mn = fmaxf(m, mt); const float alpha = __builtin_amdgcn_exp2f(m - mn); m = mn;
            l *= alpha;
#pragma unroll
            for (int d0 = 0; d0 < 2; ++d0)
#pragma unroll
                for (int r = 0; r < 16; ++r) o[d0][r] *= alpha;
        }
        const float mn = m;
        float ls = 0.f;
#pragma unroll
        for (int r = 0; r < 16; ++r) { p[r] = __builtin_amdgcn_exp2f(p[r] - mn); ls += p[r]; }
        l += ls;
        bf16x8 pa[2];
#pragma unroll
        for (int s2 = 0; s2 < 2; ++s2) { v4u w; w.x = cvtpk(p[8 * s2 + 0], p[8 * s2 + 1]); w.y = cvtpk(p[8 * s2 + 2], p[8 * s2 + 3]); w.z = cvtpk(p[8 * s2 + 4], p[8 * s2 + 5]); w.w = cvtpk(p[8 * s2 + 6], p[8 * s2 + 7]); pa[s2] = __builtin_bit_cast(bf16x8, w); }
#pragma unroll
        for (int d0 = 0; d0 < 2; ++d0)
#pragma unroll
            for (int s2 = 0; s2 < 2; ++s2) {
                const LAS unsigned char* a1 = vb + (16 * s2 + 4 * hi + q_) * 128 + (32 * d0 + 16 * kq + 4 * p_) * 2;
                const v4i16_t lo4 = __builtin_amdgcn_ds_read_tr16_b64_v4i16((LAS v4i16_t*)a1), hi4 = __builtin_amdgcn_ds_read_tr16_b64_v4i16((LAS v4i16_t*)(a1 + 8 * 128));
                const bf16x8 vf = (bf16x8){lo4[0], lo4[1], lo4[2], lo4[3], hi4[0], hi4[1], hi4[2], hi4[3]};
                o[d0] = __builtin_amdgcn_mfma_f32_32x32x16_bf16(vf, pa[s2], o[d0], 0, 0, 0);
            }
        return false;
    };
    for (int i = 0; i < nseq; i += 2) {
        if (i + 2 < nseq) FOX_LOAD(krA, vrA, brA, tlast - (i + 2));
        if (compute(tlast - i, 0)) break;
        if (i + 1 < nseq) {
            FOX_STORE(krB, vrB, brB, 1);
            if (i + 3 < nseq) FOX_LOAD(krB, vrB, brB, tlast - (i + 3));
            if (compute(tlast - (i + 1), 1)) break;
            if (i + 2 < nseq) FOX_STORE(krA, vrA, brA, 0);
        }
    }
#undef FOX_LOAD
#undef FOX_STORE
    l += __shfl_xor(l, 32);
    const float inv = 1.0f / l;
    bf16* orow = Ow + (size_t)r32 * 512;
#pragma unroll
    for (int d0 = 0; d0 < 2; ++d0)
#pragma unroll
        for (int g = 0; g < 4; ++g) { u32x2 w; w.x = cvtpk(o[d0][4 * g] * inv, o[d0][4 * g + 1] * inv); w.y = cvtpk(o[d0][4 * g + 2] * inv, o[d0][4 * g + 3] * inv);
            *(u32x2*)(orow + d0 * 32 + 8 * g + 4 * hi) = w; }
}
#ifndef DBG_BRANCH_MASK
#define DBG_BRANCH_MASK 7
#endif
#ifndef DBG_NBR
#define DBG_NBR 3
#endif
#ifndef DBG_NOGATE
#define DBG_NOGATE 0
#endif
#ifndef DBG_NOBRANCH
#define DBG_NOBRANCH 0
#endif
#ifndef DBG_GATE_W
#define DBG_GATE_W WS_WGATE
#endif
#ifndef DBG_GATE_AS_BRANCH
#define DBG_GATE_AS_BRANCH 0
#endif
#ifndef REP_FOX
#define REP_FOX 1
#endif
#ifndef REP_DSA
#define REP_DSA 1
#endif
#ifndef REP_GEMM
#define REP_GEMM 1
#endif
#ifndef DBG_SUBST
#define DBG_SUBST 0
#endif
#ifndef P7SEL
#define P7SEL 3
#endif
#ifndef PHMASK
#define PHMASK 0xFFFF
#endif
struct Args { const void* in[24]; float* out; unsigned char* ws; };
#define CONVERT_GROUP(GRP, w_, nw_) do { \
    constexpr int I_GU = 16 * 176, I_D = 44 * 32, I_IN = 16 * 104, I_GT = 16 * 96, I_BR = 8 * 32, I_SQ = 16 * 32; \
    constexpr int NIT = (GRP) == 0 ? I_GU + I_SQ : (GRP) == 1 ? I_D + I_IN + I_GT + 3 * I_BR + I_SQ : I_GU + I_D; \
    LAS float* scr_ = (LAS float*)(L + RING_OFF + wave * 16384); \
    for (int it = (w_); it < NIT; it += (nw_)) { int r = it; \
        if ((GRP) == 0) { \
            if (r < I_GU) { transpose_item(0, ARG_IN(4), ARG_IN(5), 1024, DFF, ARG_IN(3), WSP(bf16, WS_WGU1), scr_, r, 176, lane); continue; } r -= I_GU; \
            transpose_item(1, ARG_IN(17), nullptr, 1024, 1024, ARG_IN(8), WSP(bf16, WS_WMKV), scr_, r, 32, lane); \
        } else if ((GRP) == 1) { \
            if (r < I_D) { transpose_item(1, ARG_IN(6), nullptr, DFF, 1024, nullptr, WSP(bf16, WS_WD1), scr_, r, 32, lane); continue; } r -= I_D; \
            if (r < I_IN) { transpose_item(2, ARG_IN(9), nullptr, 1024, DIN, ARG_IN(7), WSP(bf16, WS_WIN), scr_, r, 104, lane); continue; } r -= I_IN; \
            if (r < I_GT) { transpose_item(3, ARG_IN(9), nullptr, 1024, DIN, ARG_IN(7), WSP(bf16, WS_WGATE), scr_, r, 96, lane); continue; } r -= I_GT; \
            if (r < 3 * I_BR) { const int i = r / I_BR; transpose_item(1, ARG_IN(18) + (size_t)i * 512 * 1024, nullptr, 512, 1024, nullptr, WSP(bf16, WS_WBR) + (size_t)i * 1024 * 512, scr_, r % I_BR, 32, lane); continue; } r -= 3 * I_BR; \
            transpose_item(1, ARG_IN(19), nullptr, 1024, 1024, nullptr, WSP(bf16, WS_WOUT), scr_, r, 32, lane); \
        } else { \
            if (r < I_GU) { transpose_item(0, ARG_IN(21), ARG_IN(22), 1024, DFF, ARG_IN(20), WSP(bf16, WS_WGU2), scr_, r, 176, lane); continue; } r -= I_GU; \
            transpose_item(1, ARG_IN(23), nullptr, DFF, 1024, nullptr, WSP(bf16, WS_WD2), scr_, r, 32, lane); \
        } } } while (0)
__global__ void __launch_bounds__(NWAVES * 64, 2) fwd_mega(Args args) {
    extern __shared__ __attribute__((aligned(16))) unsigned char lds[];
    LAS unsigned char* L = (LAS unsigned char*)lds;
    volatile LAS unsigned* MISC = (volatile LAS unsigned*)(L + MISC_OFF);
    const int tid = threadIdx.x, lane = tid & 63, wave = __builtin_amdgcn_readfirstlane(tid >> 6);
    const int G = gridDim.x; const int bx = blockIdx.x; const int vcu = (G % 8 == 0) ? (bx % 8) * (G / 8) + bx / 8 : bx;
    const Args* ap = (const Args*)__builtin_amdgcn_kernarg_segment_ptr();
#define ARG_IN(k) ((const float*)ap->in[k])
#define WSP(type, off) ((type*)(ap->ws + (off)))
    gu32* ctl = (gu32*)(ap->ws + WS_CTL);
    for (int u = tid; u < (LDS_BYTES - LDSCTL_OFF) / 4; u += NWAVES * 64) ((LAS unsigned*)(L + LDSCTL_OFF))[u] = 0u;
    __syncthreads();
    XcdBarrier bar = xcd_barrier_post((unsigned*)(ctl + CW_BAR), MISC + 8);
#define GRID_BAR() xcd_barrier(bar)
    const int gw = vcu * NWAVES + wave, NGW = G * NWAVES;

#if (PHMASK >> 0) & 1
    {
        LAS float* scr = (LAS float*)(L + RING_OFF + wave * 16384);
        CONVERT_GROUP(0, gw, NGW);
        for (int m0 = gw; m0 < T + 512; m0 += 4 * NGW) {
            const float* xr[4]; bf16* orw[4]; float* ro[4]; bool ok[4];
#pragma unroll
            for (int r = 0; r < 4; ++r) { const int m = m0 + r * NGW; ok[r] = m < T + 512; const int mc = ok[r] ? m : gw;
                if (mc < T) { xr[r] = ARG_IN(0) + (size_t)mc * 1024; orw[r] = WSP(bf16, WS_HB) + (size_t)mc * 1024; ro[r] = WSP(float, WS_RSTDX) + mc; }
                else { xr[r] = ARG_IN(1) + (size_t)(mc - T) * 1024; orw[r] = WSP(bf16, WS_MEMB) + (size_t)(mc - T) * 1024; ro[r] = WSP(float, WS_RSTDM) + (mc - T); } }
            rows4_to_bf16_rstd(xr, orw, ro, ok, lane);
        }
        VM_WAIT(); __syncthreads();
        GRID_BAR();
    }
#endif
#if (PHMASK >> 1) & 1
    {
        if (bx >= G - 8) { pg8::Gemm g{WSP(bf16, WS_MEMB), WSP(bf16, WS_WMKV), 512, 1024, 1024}; pg8::StaticOrder S; S.init(512, 1024, G, bx - (G - 8));
        pg8::EpiMemKV E{WSP(float, WS_KVM), WSP(float, WS_RSTDM)};
        pg8::gemm_phase<pg8::EpiMemKV, pg8::StaticOrder, true, true>(L + RING_OFF, g, S, E); }
    }
#endif
#if (PHMASK >> 2) & 1
    {
        pg8::Gemm g{WSP(bf16, WS_HB), WSP(bf16, WS_WGU1), T, 2 * DFF, 1024}; pg8::StaticOrder S; S.init(T, 2 * DFF, G, bx);
        pg8::build_row_tab<0>(WSP(float, WS_RSTDX), S, (LAS float*)(L + RING_BYTES + 1024)); pg8::EpiSwiGLU<0> E{WSP(bf16, WS_HID), DFF, (LAS float*)(L + RING_BYTES + 1024)};
#pragma unroll 1
        for (int rep_ = 0; rep_ < REP_GEMM; ++rep_)
        pg8::gemm_phase<pg8::EpiSwiGLU<0>, pg8::StaticOrder, true, true>(L + RING_OFF, g, S, E);
        {
            const int nfull = (64 * 22) % G; const int nidle = (nfull == 0) ? G : G - nfull; const int first = G - nidle;
            if (bx >= first) { CONVERT_GROUP(1, (bx - first) * NWAVES + wave, nidle * NWAVES);
                for (int e = (bx - first) * NWAVES * 64 + tid; e < T * 32; e += nidle * NWAVES * 64) {
                    const int row = e >> 5, i = e & 31; const float inv_freq = powf(10000.0f, -(float)i * (1.0f / 32.0f));
                    const float ang = (float)((const int*)ap->in[2])[row] * inv_freq; float sn, cs; sincosf(ang, &sn, &cs); WSP(float, WS_COS)[e] = cs; WSP(float, WS_SIN)[e] = sn; } }
        }
        GRID_BAR();
    }
#endif
#if (PHMASK >> 3) & 1
    {
        pg8::Gemm g{WSP(bf16, WS_HID), WSP(bf16, WS_WD1), T, 1024, DFF}; pg8::StaticOrder S; S.init(T, 1024, G, bx);
        pg8::EpiResid2<true> E{ARG_IN(0), ap->out, WSP(bf16, WS_HB), WSP(float, WS_SSQ1), 0.5f};
#pragma unroll 1
        for (int rep_ = 0; rep_ < REP_GEMM; ++rep_)
        pg8::gemm_phase<pg8::EpiResid2<true>, pg8::StaticOrder, true, true>(L + RING_OFF, g, S, E);
        GRID_BAR();
    }
#endif
#if (PHMASK >> 4) & 1
    {
        pg8::Gemm g{WSP(bf16, WS_HB), WSP(bf16, WS_WIN), T, NPROJ, 1024}; pg8::StaticOrder S; S.init(T, NPROJ, G, bx);
        pg8::ProjOut PO{WSP(bf16, WS_FQ), WSP(bf16, WS_FK), WSP(bf16, WS_FV), WSP(bf16, WS_DQ), WSP(bf16, WS_IQ), WSP(bf16, WS_MQ), WSP(bf16, WS_DK), WSP(bf16, WS_DV), WSP(bf16, WS_IK), WSP(float, WS_LOGF), WSP(float, WS_IW), WSP(float, WS_COS), WSP(float, WS_SIN), ARG_IN(11), ARG_IN(12), ARG_IN(13), ARG_IN(14), ARG_IN(10)};
        pg8::build_row_tab<16>(WSP(float, WS_SSQ1), S, (LAS float*)(L + RING_BYTES + 1024)); pg8::EpiProj<16> E{PO, (LAS float*)(L + RING_BYTES + 1024), C2_64};
#pragma unroll 1
        for (int rep_ = 0; rep_ < REP_GEMM; ++rep_)
        pg8::gemm_phase<pg8::EpiProj<16>, pg8::StaticOrder, true, true>(L + RING_OFF, g, S, E);
        {
            const int nfull = (64 * 13) % G; const int nidle = (nfull == 0) ? G : G - nfull; const int first = G - nidle;
            if (bx >= first) { CONVERT_GROUP(2, (bx - first) * NWAVES + wave, nidle * NWAVES);
        for (int it = (bx - first) * NWAVES + wave; it < 2048; it += nidle * NWAVES) { const int row = it >> 2, h = it & 3;
                    const f32x2g kv = *(const f32x2g*)(WSP(float, WS_KVM) + (size_t)row * 1024 + h * 128 + 2 * lane); const f32x2g vv = *(const f32x2g*)(WSP(float, WS_KVM) + (size_t)row * 1024 + 512 + h * 128 + 2 * lane);
                    const float ss = wave_sum(kv.x * kv.x + kv.y * kv.y); const float rstd = 1.0f / sqrtf(ss * (1.0f / 128.0f) + 1e-6f);
                    const f32x2g gk = *(const f32x2g*)(ARG_IN(16) + 2 * lane);
                    *(unsigned*)(WSP(bf16, WS_KMB) + (size_t)row * 512 + h * 128 + 2 * lane) = pk2(kv.x * rstd * gk.x, kv.y * rstd * gk.y);
                    { const int bb = row >> 8, key = row & 255; bf16* vt = WSP(bf16, WS_VMB) + ((size_t)(bb * 4 + h) * 128 + 2 * lane) * MEMLEN + key; vt[0] = (bf16)f2bf(vv.x); vt[MEMLEN] = (bf16)f2bf(vv.y); } } }
        }
        GRID_BAR();
#if defined(DBG_DUMP_AFTER) && DBG_DUMP_AFTER == 4
        {
            const bf16* sa = WSP(bf16, DBG_DUMP_A); const bf16* sb = WSP(bf16, DBG_DUMP_B);
            for (size_t e = (size_t)vcu * 512 + tid; e < (size_t)T * 512; e += (size_t)G * 512) { const size_t row = e >> 9, c = e & 511;
                ap->out[row * 1024 + c] = bf2f(sa[row * DBG_PITCH + c]); ap->out[row * 1024 + 512 + c] = bf2f(sb[row * DBG_PITCH + c]); }
            return;
        }
#endif

    }
#endif
#if ((PHMASK >> 5) & 1) && !DBG_SUBST
    {
        for (int it = gw; it < 2048; it += NGW) mem_unit(it >> 2, it & 3, WSP(bf16, WS_MQ), WSP(bf16, WS_KMB), WSP(bf16, WS_VMB), ARG_IN(15), lane);
    }
#endif
#if ((PHMASK >> 6) & 1) && !DBG_SUBST
    {
        for (int rep_ = 0; rep_ < REP_FOX; ++rep_)
        for (int v = vcu; v < 256; v += G) { const int bh = v >> 4, s = v & 15;
            scan_unit(bh, WSP(float, WS_LOGF), WSP(float, WS_CUM), WSP(int, WS_T0), ARG_IN(11), ARG_IN(12), (LAS float*)(L + SCANX_OFF), (LAS float*)(L + RING_OFF), tid);
            asm volatile("s_waitcnt vmcnt(0)" ::: "memory"); __syncthreads();
            fox_unit4(bh, s, WSP(bf16, WS_FQ), WSP(bf16, WS_FK), WSP(bf16, WS_FV), WSP(float, WS_CUM), WSP(int, WS_T0), ARG_IN(11), ARG_IN(12), WSP(bf16, WS_OA), L, wave, lane); fox_unit4(bh, 31 - s, WSP(bf16, WS_FQ), WSP(bf16, WS_FK), WSP(bf16, WS_FV), WSP(float, WS_CUM), WSP(int, WS_T0), ARG_IN(11), ARG_IN(12), WSP(bf16, WS_OA), L, wave, lane); }
        __syncthreads();
        {
            gu32* qctr = ctl + CW_Q; LAS int* QW = (LAS int*)(L + D3_QW);
            const int pref = (vcu >> 5) & 1;
            unsigned raw = 0u; int cur;
            if (tid == 0) { unsigned u = __hip_atomic_fetch_add(qctr + 64 * pref, 1u, RLX_AGENT); int bsel = pref; if (u >= 512u) { bsel = pref ^ 1; u = __hip_atomic_fetch_add(qctr + 64 * bsel, 1u, RLX_AGENT); } QW[0] = (u < 512u) ? ((bsel << 16) | (int)u) : -1; }
            __syncthreads(); cur = QW[0]; __syncthreads();
            while (cur >= 0) {
                if (tid == 0) raw = __hip_atomic_fetch_add(qctr + 64 * pref, 1u, RLX_AGENT);
                dsa3_unit(cur >> 16, 511 - (cur & 0xffff), WSP(bf16, WS_IQ), WSP(bf16, WS_IK), WSP(float, WS_IW), WSP(bf16, WS_DQ), WSP(bf16, WS_DK), WSP(bf16, WS_DV), WSP(bf16, WS_OB), L, wave, lane);
                if (tid == 0) { unsigned u = raw; int bsel = pref; if (u >= 512u) { bsel = pref ^ 1; u = __hip_atomic_fetch_add(qctr + 64 * bsel, 1u, RLX_AGENT); } QW[0] = (u < 512u) ? ((bsel << 16) | (int)u) : -1; }
                __syncthreads(); cur = QW[0]; __syncthreads();
            }
        }
        GRID_BAR();
    }
#endif
#if (PHMASK >> 7) & 1
    {
        pg8::StaticOrder S; S.init(T, 1024, G, bx); pg8::build_row_tab<16>(WSP(float, WS_SSQ1), S, (LAS float*)(L + RING_BYTES + 1024));
#ifndef P7STREAM
#define P7STREAM 1
#endif
#if P7STREAM
        {   typedef pg8::P7Order<WS_HB, WS_WGATE, WS_OA, WS_OB, WS_MQ, WS_WBR> P7O; P7O O{S, (const char*)WSP(char, 0)};
            pg8::EpiP7 E{WSP(bf16, WS_GSCR), WSP(bf16, WS_MERGED), (LAS float*)(L + RING_BYTES + 1024)};
#ifndef REP_P7
#define REP_P7 1
#endif
#pragma unroll 1
            for (int rep7_ = 0; rep7_ < REP_P7; ++rep7_) pg8::gemm_stream<pg8::EpiP7, P7O>(L + RING_OFF, O, E); }
#pragma unroll 1
        for (int i = 0; i < 0; ++i) {
#else
#pragma unroll 1
        for (int rep_ = 0; rep_ < REP_GEMM; ++rep_)
#pragma unroll 1
        for (int i = 0; i < DBG_NBR; ++i) {
#endif
#if DBG_GATE_AS_BRANCH
            {   pg8::Gemm g{WSP(bf16, WS_HB), WSP(bf16, DBG_GATE_W), T, 1024, 1024}; pg8::EpiBranch E{WSP(bf16, WS_GSCR), WSP(bf16, WS_MERGED), true, 1.0f}; pg8::gemm_phase<pg8::EpiBranch, pg8::StaticOrder, true, true>(L + RING_OFF, g, S, E); }
#elif !DBG_NOGATE
            {   pg8::Gemm g{WSP(bf16, WS_HB), WSP(bf16, DBG_GATE_W) + (size_t)i * 1024 * 1024, T, 1024, 1024}; pg8::EpiGate<16> E{WSP(bf16, WS_GSCR), (LAS float*)(L + RING_BYTES + 1024)}; pg8::gemm_phase<pg8::EpiGate<16>, pg8::StaticOrder, true, true>(L + RING_OFF, g, S, E); }
#endif
#if !DBG_NOBRANCH
#if DBG_SUBST == 1
            {   const bf16* A = (i == 0) ? WSP(bf16, WS_FQ) : (i == 1) ? WSP(bf16, WS_DQ) : WSP(bf16, WS_IQ);
#elif DBG_SUBST == 2
            {   const bf16* A = (i == 0) ? WSP(bf16, WS_FK) : (i == 1) ? WSP(bf16, WS_FV) : WSP(bf16, WS_MQ);
#else
            {   const bf16* A = (i == 0) ? WSP(bf16, WS_OA) : (i == 1) ? WSP(bf16, WS_OB) : WSP(bf16, WS_MQ);
#endif
                pg8::Gemm g{A, WSP(bf16, WS_WBR) + (size_t)i * 1024 * 512, T, 1024, 512}; pg8::EpiBranch E{WSP(bf16, WS_GSCR), WSP(bf16, WS_MERGED), i == 0, ((DBG_BRANCH_MASK >> i) & 1) ? 1.0f : 0.0f}; pg8::gemm_phase<pg8::EpiBranch, pg8::StaticOrder, true, true>(L + RING_OFF, g, S, E); }
#endif
        }
        GRID_BAR();
#if defined(DBG_DUMP_AFTER) && DBG_DUMP_AFTER == 7
        {
            const bf16* sa = WSP(bf16, DBG_DUMP_A); const bf16* sb = WSP(bf16, DBG_DUMP_B);
            for (size_t e = (size_t)vcu * 512 + tid; e < (size_t)T * 512; e += (size_t)G * 512) { const size_t row = e >> 9, c = e & 511;
                ap->out[row * 1024 + c] = bf2f(sa[row * DBG_PITCH + c]); ap->out[row * 1024 + 512 + c] = bf2f(sb[row * DBG_PITCH + c]); }
            return;
        }
#endif

    }
#endif
#if (PHMASK >> 8) & 1
    {
        pg8::Gemm g{WSP(bf16, WS_MERGED), WSP(bf16, WS_WOUT), T, 1024, 1024}; pg8::StaticOrder S; S.init(T, 1024, G, bx);
        pg8::EpiResid2<true> E{ap->out, ap->out, WSP(bf16, WS_HB), WSP(float, WS_SSQ2), 1.0f};
        pg8::gemm_phase<pg8::EpiResid2<true>, pg8::StaticOrder, true, true>(L + RING_OFF, g, S, E);
        GRID_BAR();
    }
#endif
#if (PHMASK >> 9) & 1
    {
        pg8::Gemm g{WSP(bf16, WS_HB), WSP(bf16, WS_WGU2), T, 2 * DFF, 1024}; pg8::StaticOrder S; S.init(T, 2 * DFF, G, bx);
        pg8::build_row_tab<16>(WSP(float, WS_SSQ2), S, (LAS float*)(L + RING_BYTES + 1024)); pg8::EpiSwiGLU<16> E{WSP(bf16, WS_HID), DFF, (LAS float*)(L + RING_BYTES + 1024)};
#pragma unroll 1
        for (int rep_ = 0; rep_ < REP_GEMM; ++rep_)
        pg8::gemm_phase<pg8::EpiSwiGLU<16>, pg8::StaticOrder, true, true>(L + RING_OFF, g, S, E);
        GRID_BAR();
    }
#endif
#if (PHMASK >> 10) & 1
    {
        pg8::Gemm g{WSP(bf16, WS_HID), WSP(bf16, WS_WD2), T, 1024, DFF}; pg8::StaticOrder S; S.init(T, 1024, G, bx);
        pg8::EpiResid2<false> E{ap->out, ap->out, nullptr, nullptr, 0.5f};
        pg8::gemm_phase<pg8::EpiResid2<false>, pg8::StaticOrder, true, true>(L + RING_OFF, g, S, E);
    }
#endif
}

extern "C" void kernel_launch(void* const* d_in, const int* in_sizes, int n_in, void* d_out, int out_size, void* d_ws, size_t ws_size, hipStream_t stream) {
    static int grid = 0;
    if (grid == 0) {
        if (n_in != 24 || out_size != T * DM || ws_size < WS_END) { fprintf(stderr, "kernel_launch: unexpected problem (n_in %d, out %d, ws %zu)\n", n_in, out_size, ws_size); grid = -1; return; }
        int dev = 0, cus = 0, per_cu = 0;
        if (hipGetDevice(&dev) != hipSuccess || hipDeviceGetAttribute(&cus, hipDeviceAttributeMultiprocessorCount, dev) != hipSuccess) { grid = -1; return; }
        if (hipFuncSetAttribute((const void*)fwd_mega, hipFuncAttributeMaxDynamicSharedMemorySize, LDS_BYTES) != hipSuccess) { fprintf(stderr, "kernel_launch: hipFuncSetAttribute failed\n"); grid = -1; return; }
        if (hipOccupancyMaxActiveBlocksPerMultiprocessor(&per_cu, (const void*)fwd_mega, NWAVES * 64, LDS_BYTES) != hipSuccess || per_cu < 1) { fprintf(stderr, "kernel_launch: occupancy query says %d blocks per CU\n", per_cu); (void)hipGetLastError(); grid = -1; return; }
        grid = cus;
    }
    if (grid < 0) return;
    (void)hipMemsetAsync((char*)d_ws + WS_CTL, 0, CTL_ZERO_BYTES, stream);
    Args a{};
    for (int i = 0; i < 24; ++i) a.in[i] = d_in[i];
    a.out = (float*)d_out; a.ws = (unsigned char*)d_ws;
    hipLaunchKernelGGL(fwd_mega, dim3(grid), dim3(NWAVES * 64), LDS_BYTES, stream, a);
}
```

```cpp
#include <hip/hip_runtime.h>
#include <cstdio>
#include <cstdint>
namespace pg8 {
#define PG8_LAS __attribute__((address_space(3)))
typedef unsigned short bf16_t;
typedef short bf16x8 __attribute__((ext_vector_type(8)));
typedef float f32x4 __attribute__((ext_vector_type(4)));
typedef unsigned u32x4 __attribute__((ext_vector_type(4)));
constexpr int BM = 256, BK = 64, HALF = 128, HTB = HALF * BK * 2  , STAGE_BYTES = 8 * HTB, NXCD = 8, WGM = 8;

__host__ __device__ __forceinline__ int lds_byte(int r, int c) { const int st = (r >> 4) * 2 + (c >> 5), rr = r & 15, cc = c & 31, ob = rr * 64 + cc * 2; return st * 1024 + (ob ^ (((ob >> 9) & 1) << 5)); }
__host__ __device__ __forceinline__ void stage_rc(int b, int& R, int& C) { const int st = b / 1024, sb = b % 1024, swz = sb ^ (((sb >> 9) & 1) << 5); R = (st >> 1) * 16 + swz / 64; C = (st & 1) * 32 + (swz % 64) / 2; }
__host__ __device__ __forceinline__ int perm32(int rho) { const int n = rho >> 4, i = rho & 15; return 8 * (i >> 2) + 4 * n + (i & 3); }

struct Unit { int pm, pn; };
struct Gemm { const bf16_t* A; const bf16_t* Bt; int M, N, K; };

struct StaticOrder {
    int nM, nN, nwg, G, c;
    __host__ __device__ void init(int M, int N, int G_, int c_) { nM = M / BM; nN = N / BM; nwg = nM * nN; G = G_; c = c_; }
    __host__ __device__ bool next(int i, Unit& u) const {
        const long L = (long)i * G + c; if (L >= nwg) return false;
        int wgid = (int)L; { const int q = nwg / NXCD, r = nwg % NXCD, xcd = wgid % NXCD, off = wgid / NXCD; wgid = (xcd < r ? xcd * (q + 1) : r * (q + 1) + (xcd - r) * q) + off; }
        const int nig = WGM * nN, gid = wgid / nig, fm = gid * WGM, gsz = (nM - fm) < WGM ? (nM - fm) : WGM;
        u.pm = fm + ((wgid % nig) % gsz); u.pn = (wgid % nig) / gsz; return true;
    }
    __device__ __forceinline__ void a_ready(const Unit&) const {}
    __device__ __forceinline__ void done(const Unit&) const {}
};

typedef float f32x2cv __attribute__((ext_vector_type(2))); typedef __bf16 bf16x2cv __attribute__((ext_vector_type(2)));
__device__ __forceinline__ unsigned cvt_pk_bf16(float lo, float hi) { const f32x2cv v = {lo, hi}; const bf16x2cv b = __builtin_convertvector(v, bf16x2cv); return __builtin_bit_cast(unsigned, b); }
typedef float f32x2 __attribute__((ext_vector_type(2)));
template <class Epi, class Sched, bool ALIGN_EPI = false, bool SP2 = false>
__device__ __forceinline__ void gemm_phase(PG8_LAS unsigned char* lds, const Gemm g, const Sched& S, const Epi& E) {
    int tid_ = threadIdx.x; asm volatile("" : "+v"(tid_));
    const int tid = tid_, wid = __builtin_amdgcn_readfirstlane(tid >> 6), lane = tid & 63, wr = wid >> 2, wc = wid & 3, fr = lane & 15, fq = lane >> 4;
    const int K = g.K, nt = K / BK;
    unsigned voffA[2], voffB[2];
#pragma unroll
    for (int i = 0; i < 2; ++i) { int R, C; stage_rc(tid * 16 + i * 8192, R, C); const int Rb = Epi::PERM ? ((R & ~31) + perm32(R & 31)) : R;
        voffA[i] = (unsigned)(R * K + C) * 2u; voffB[i] = (unsigned)(Rb * K + C) * 2u; }
    const size_t kstep = (size_t)(BK * 2);
    const size_t hstep = (size_t)HALF * K * 2;
    const size_t tstep = 2 * hstep;
    const unsigned ldsw = (unsigned)wid * 1024u;
    const int aoff = lds_byte(wr * 64 + fr, fq * 8), boff = lds_byte(wc * 32 + fr, fq * 8);
#define PG8_SA(b, h) (((b) * 2 + (h)) * HTB)
#define PG8_SB(b, h) ((4 + (b) * 2 + (h)) * HTB)
#define PG8_STAGE(bufoff, gbase, voff) do { _Pragma("unroll") for (int _i = 0; _i < 2; ++_i) \
        __builtin_amdgcn_global_load_lds((const unsigned*)((const char*)(gbase) + (voff)[_i]), (PG8_LAS unsigned*)(lds + (bufoff) + ldsw + _i * 8192), 16, 0, 0); } while (0)
#define PG8_LDA(dst, b, h) do { _Pragma("unroll") for (int m = 0; m < 4; ++m) _Pragma("unroll") for (int k = 0; k < 2; ++k) dst[m][k] = *(const PG8_LAS bf16x8*)(lds + PG8_SA(b, h) + aoff + m * 2048 + k * 1024); } while (0)
#define PG8_LDB(dst, b, h) do { _Pragma("unroll") for (int n = 0; n < 2; ++n) _Pragma("unroll") for (int k = 0; k < 2; ++k) dst[n][k] = *(const PG8_LAS bf16x8*)(lds + PG8_SB(b, h) + boff + n * 2048 + k * 1024); } while (0)
#define PG8_MMA(ai, bj, At, Bt) do { __builtin_amdgcn_s_setprio(1); _Pragma("unroll") for (int m = 0; m < 4; ++m) _Pragma("unroll") for (int n = 0; n < 2; ++n) _Pragma("unroll") for (int k = 0; k < 2; ++k) \
        acc[ai][bj][m][n] = __builtin_amdgcn_mfma_f32_16x16x32_bf16(Bt[n][k], At[m][k], acc[ai][bj][m][n], 0, 0, 0); __builtin_amdgcn_s_setprio(0); } while (0)
#define PG8_WAIT_V(n) asm volatile("s_waitcnt vmcnt(" #n ")" ::: "memory")
#define PG8_WAIT_L(n) asm volatile("s_waitcnt lgkmcnt(" #n ")" ::: "memory")
#define PG8_BAR __builtin_amdgcn_s_barrier()
#define PG8_SCHED __builtin_amdgcn_sched_barrier(0)
    Unit cur, nxt; int ui = 0;
    if (!S.next(0, cur)) return;
    f32x4 acc[2][2][4][2];
#pragma unroll
    for (int a = 0; a < 2; ++a)
#pragma unroll
        for (int b = 0; b < 2; ++b)
#pragma unroll
            for (int m = 0; m < 4; ++m)
#pragma unroll
                for (int n = 0; n < 2; ++n) acc[a][b][m][n] = (f32x4){0.f, 0.f, 0.f, 0.f};
    bf16x8 At[4][2], B0[2][2], B1[2][2];
    const char* cA = (const char*)g.A + (size_t)cur.pm * tstep; const char* cB = (const char*)g.Bt + (size_t)cur.pn * tstep;
    S.a_ready(cur);
    if constexpr (SP2) {
        PG8_STAGE(PG8_SB(0, 0), cB, voffB); PG8_STAGE(PG8_SB(0, 1), cB + hstep, voffB); PG8_STAGE(PG8_SA(0, 0), cA, voffA); PG8_STAGE(PG8_SA(0, 1), cA + hstep, voffA);
        if (wr == 1) PG8_BAR;
        PG8_WAIT_V(2); PG8_BAR;
        PG8_STAGE(PG8_SB(1, 0), cB + kstep, voffB); PG8_STAGE(PG8_SA(1, 0), cA + kstep, voffA); PG8_STAGE(PG8_SB(1, 1), cB + hstep + kstep, voffB);
        PG8_WAIT_V(6); PG8_BAR;
    } else {
        PG8_STAGE(PG8_SB(0, 0), cB, voffB); PG8_STAGE(PG8_SA(0, 0), cA, voffA); PG8_STAGE(PG8_SB(0, 1), cB + hstep, voffB); PG8_STAGE(PG8_SA(0, 1), cA + hstep, voffA);
        if (wr == 1) PG8_BAR;
        PG8_WAIT_V(4); PG8_BAR;
        PG8_STAGE(PG8_SB(1, 0), cB + kstep, voffB); PG8_STAGE(PG8_SA(1, 0), cA + kstep, voffA); PG8_STAGE(PG8_SB(1, 1), cB + hstep + kstep, voffB);
        PG8_WAIT_V(6); PG8_BAR;
    }
    for (;;) {
        const bool has_next = S.next(ui + 1, nxt);
        const char* nA = has_next ? (const char*)g.A + (size_t)nxt.pm * tstep : cA; const char* nB = has_next ? (const char*)g.Bt + (size_t)nxt.pn * tstep : cB;
        for (int t = 0; t < nt; t += 2) {
            const bool last = (t == nt - 2);
            const char* a1 = cA + (size_t)(t + 1) * kstep;
            const char* a2 = last ? nA : cA + (size_t)(t + 2) * kstep; const char* b2 = last ? nB : cB + (size_t)(t + 2) * kstep;
            const char* a3 = a2 + kstep; const char* b3 = b2 + kstep;
            if (last && has_next) S.a_ready(nxt);
            if constexpr (SP2) {
            PG8_LDB(B0, 0, 0); PG8_LDB(B1, 0, 1); PG8_SCHED; PG8_LDA(At, 0, 0); PG8_STAGE(PG8_SA(1, 1), a1 + hstep, voffA);
            PG8_WAIT_V(8); PG8_WAIT_L(0); PG8_BAR; PG8_MMA(0, 0, At, B0); PG8_MMA(0, 1, At, B1); PG8_BAR; PG8_SCHED;
            PG8_LDA(At, 0, 1); PG8_STAGE(PG8_SB(0, 0), b2, voffB); PG8_STAGE(PG8_SB(0, 1), b2 + hstep, voffB); PG8_STAGE(PG8_SA(0, 0), a2, voffA);
            PG8_WAIT_V(8); PG8_WAIT_L(0); PG8_BAR; PG8_MMA(1, 0, At, B0); PG8_MMA(1, 1, At, B1); PG8_BAR; PG8_SCHED;
            PG8_LDB(B0, 1, 0); PG8_LDB(B1, 1, 1); PG8_SCHED; PG8_LDA(At, 1, 0); PG8_STAGE(PG8_SA(0, 1), a2 + hstep, voffA);
            PG8_WAIT_V(8); PG8_WAIT_L(0); PG8_BAR; PG8_MMA(0, 0, At, B0); PG8_MMA(0, 1, At, B1); PG8_BAR; PG8_SCHED;
            PG8_LDA(At, 1, 1); PG8_STAGE(PG8_SB(1, 0), b3, voffB); PG8_STAGE(PG8_SB(1, 1), b3 + hstep, voffB); PG8_STAGE(PG8_SA(1, 0), a3, voffA);
            PG8_WAIT_V(8); PG8_WAIT_L(0); PG8_BAR; PG8_MMA(1, 0, At, B0); PG8_MMA(1, 1, At, B1); PG8_BAR; PG8_SCHED;
            } else {
            PG8_LDB(B0, 0, 0); PG8_SCHED; PG8_LDA(At, 0, 0); PG8_STAGE(PG8_SA(1, 1), a1 + hstep, voffA);
            PG8_WAIT_L(8); PG8_BAR; PG8_WAIT_L(0); PG8_MMA(0, 0, At, B0); PG8_BAR; PG8_SCHED;
            PG8_LDB(B1, 0, 1); PG8_STAGE(PG8_SB(0, 0), b2, voffB);
            PG8_BAR; PG8_WAIT_L(0); PG8_MMA(0, 1, At, B1); PG8_BAR;
            PG8_LDA(At, 0, 1); PG8_STAGE(PG8_SA(0, 0), a2, voffA);
            PG8_BAR; PG8_WAIT_L(0); PG8_MMA(1, 0, At, B0); PG8_BAR; PG8_SCHED;
            PG8_STAGE(PG8_SB(0, 1), b2 + hstep, voffB);
            PG8_WAIT_V(6); PG8_BAR; PG8_MMA(1, 1, At, B1); PG8_BAR;
            PG8_LDB(B0, 1, 0); PG8_SCHED; PG8_LDA(At, 1, 0); PG8_STAGE(PG8_SA(0, 1), a2 + hstep, voffA);
            PG8_WAIT_L(8); PG8_BAR; PG8_WAIT_L(0); PG8_MMA(0, 0, At, B0); PG8_BAR; PG8_SCHED;
            PG8_LDB(B1, 1, 1); PG8_STAGE(PG8_SB(1, 0), b3, voffB);
            PG8_BAR; PG8_WAIT_L(0); PG8_MMA(0, 1, At, B1); PG8_BAR;
            PG8_LDA(At, 1, 1); PG8_STAGE(PG8_SA(1, 0), a3, voffA);
            PG8_BAR; PG8_WAIT_L(0); PG8_MMA(1, 0, At, B0); PG8_BAR; PG8_SCHED;
            PG8_STAGE(PG8_SB(1, 1), b3 + hstep, voffB);
            PG8_WAIT_V(6); PG8_BAR; PG8_MMA(1, 1, At, B1); PG8_BAR;
            }
        }
        if constexpr (ALIGN_EPI) { if (wr == 0) PG8_BAR; }
        if constexpr (!Epi::AFTER_DRAIN) { E(acc, cur, wr, wc, fr, fq); S.done(cur); }
        if (!has_next) break;
#pragma unroll
        for (int a = 0; a < 2; ++a)
#pragma unroll
            for (int b = 0; b < 2; ++b)
#pragma unroll
                for (int m = 0; m < 4; ++m)
#pragma unroll
                    for (int n = 0; n < 2; ++n) acc[a][b][m][n] = (f32x4){0.f, 0.f, 0.f, 0.f};
        cur = nxt; cA = nA; cB = nB; ++ui;
        if constexpr (ALIGN_EPI) { if (wr == 1) PG8_BAR; }
    }
    PG8_WAIT_V(0);
    if constexpr (!ALIGN_EPI) { if (wr == 0) PG8_BAR; }
    PG8_BAR;
    if constexpr (Epi::AFTER_DRAIN) { E.fused(acc, cur, wr, wc, fr, fq, lds, wid, lane); S.done(cur); }
#undef PG8_SA
#undef PG8_SB
#undef PG8_STAGE
#undef PG8_LDA
#undef PG8_LDB
#undef PG8_MMA
#undef PG8_WAIT_V
#undef PG8_WAIT_L
#undef PG8_BAR
#undef PG8_SCHED
}

struct UnitX { int pm, pn, kind, round; };
struct OpsX { const char* A; const char* Bt; int K; };
template <class Epi, class Sched>
__device__ __forceinline__ void gemm_stream(PG8_LAS unsigned char* lds, const Sched& S, const Epi& E) {
    int tid_ = threadIdx.x; asm volatile("" : "+v"(tid_));
    const int tid = tid_, wid = __builtin_amdgcn_readfirstlane(tid >> 6), lane = tid & 63, wr = wid >> 2, wc = wid & 3, fr = lane & 15, fq = lane >> 4;
    unsigned rA[2], rB[2], c2[2];
#pragma unroll
    for (int i = 0; i < 2; ++i) { int R, C; stage_rc(tid * 16 + i * 8192, R, C); rA[i] = (unsigned)R; rB[i] = (unsigned)((R & ~31) + perm32(R & 31)); c2[i] = (unsigned)C * 2u; }
    const size_t kstep = (size_t)(BK * 2);
    const unsigned ldsw = (unsigned)wid * 1024u;
    const int aoff = lds_byte(wr * 64 + fr, fq * 8), boff = lds_byte(wc * 32 + fr, fq * 8);
#define PG8_SA(b, h) (((b) * 2 + (h)) * HTB)
#define PG8_SB(b, h) ((4 + (b) * 2 + (h)) * HTB)
#define PGX_STAGE(bufoff, gbase, rr, pb) do { _Pragma("unroll") for (int _i = 0; _i < 2; ++_i) \
        __builtin_amdgcn_global_load_lds((const unsigned*)((const char*)(gbase) + ((rr)[_i] * (pb) + c2[_i])), (PG8_LAS unsigned*)(lds + (bufoff) + ldsw + _i * 8192), 16, 0, 0); } while (0)
#define PG8_LDA(dst, b, h) do { _Pragma("unroll") for (int m = 0; m < 4; ++m) _Pragma("unroll") for (int k = 0; k < 2; ++k) dst[m][k] = *(const PG8_LAS bf16x8*)(lds + PG8_SA(b, h) + aoff + m * 2048 + k * 1024); } while (0)
#define PG8_LDB(dst, b, h) do { _Pragma("unroll") for (int n = 0; n < 2; ++n) _Pragma("unroll") for (int k = 0; k < 2; ++k) dst[n][k] = *(const PG8_LAS bf16x8*)(lds + PG8_SB(b, h) + boff + n * 2048 + k * 1024); } while (0)
#define PG8_MMA(ai, bj, At, Bt) do { __builtin_amdgcn_s_setprio(1); _Pragma("unroll") for (int m = 0; m < 4; ++m) _Pragma("unroll") for (int n = 0; n < 2; ++n) _Pragma("unroll") for (int k = 0; k < 2; ++k) \
        acc[ai][bj][m][n] = __builtin_amdgcn_mfma_f32_16x16x32_bf16(Bt[n][k], At[m][k], acc[ai][bj][m][n], 0, 0, 0); __builtin_amdgcn_s_setprio(0); } while (0)
#define PG8_WAIT_V(n) asm volatile("s_waitcnt vmcnt(" #n ")" ::: "memory")
#define PG8_WAIT_L(n) asm volatile("s_waitcnt lgkmcnt(" #n ")" ::: "memory")
#define PG8_BAR __builtin_amdgcn_s_barrier()
#define PG8_SCHED __builtin_amdgcn_sched_barrier(0)
    UnitX cur, nxt; int ui = 0;
    if (!S.next(0, cur)) return;
    f32x4 acc[2][2][4][2];
#pragma unroll
    for (int a = 0; a < 2; ++a)
#pragma unroll
        for (int b = 0; b < 2; ++b)
#pragma unroll
            for (int m = 0; m < 4; ++m)
#pragma unroll
                for (int n = 0; n < 2; ++n) acc[a][b][m][n] = (f32x4){0.f, 0.f, 0.f, 0.f};
    bf16x8 At[4][2], B0[2][2], B1[2][2];
    OpsX oc = S.ops(cur);
    const char* cA = oc.A; const char* cB = oc.Bt; int Kc = oc.K;
    {   const unsigned pb = (unsigned)Kc * 2u; const size_t hstep = (size_t)HALF * pb;
        PGX_STAGE(PG8_SB(0, 0), cB, rB, pb); PGX_STAGE(PG8_SB(0, 1), cB + hstep, rB, pb); PGX_STAGE(PG8_SA(0, 0), cA, rA, pb); PGX_STAGE(PG8_SA(0, 1), cA + hstep, rA, pb);
        if (wr == 1) PG8_BAR;
        PG8_WAIT_V(2); PG8_BAR;
        PGX_STAGE(PG8_SB(1, 0), cB + kstep, rB, pb); PGX_STAGE(PG8_SA(1, 0), cA + kstep, rA, pb); PGX_STAGE(PG8_SB(1, 1), cB + hstep + kstep, rB, pb);
        PG8_WAIT_V(6); PG8_BAR; }
    for (;;) {
        const bool has_next = S.next(ui + 1, nxt);
        OpsX on = oc; if (has_next) on = S.ops(nxt);
        const char* nA = on.A; const char* nB = on.Bt; const int Kn = on.K;
        const int nt = Kc / BK; const unsigned pbc = (unsigned)Kc * 2u; const size_t hstep = (size_t)HALF * pbc;
        for (int t = 0; t < nt; t += 2) {
            const bool last = (t == nt - 2);
            const char* a1 = cA + (size_t)(t + 1) * kstep;
            const char* a2 = last ? nA : cA + (size_t)(t + 2) * kstep; const char* b2 = last ? nB : cB + (size_t)(t + 2) * kstep;
            const char* a3 = a2 + kstep; const char* b3 = b2 + kstep;
            const unsigned pb2 = last ? (unsigned)Kn * 2u : pbc; const size_t h2 = (size_t)HALF * pb2;
            PG8_LDB(B0, 0, 0); PG8_LDB(B1, 0, 1); PG8_SCHED; PG8_LDA(At, 0, 0); PGX_STAGE(PG8_SA(1, 1), a1 + hstep, rA, pbc);
            PG8_WAIT_V(8); PG8_WAIT_L(0); PG8_BAR; PG8_MMA(0, 0, At, B0); PG8_MMA(0, 1, At, B1); PG8_BAR; PG8_SCHED;
            PG8_LDA(At, 0, 1); PGX_STAGE(PG8_SB(0, 0), b2, rB, pb2); PGX_STAGE(PG8_SB(0, 1), b2 + h2, rB, pb2); PGX_STAGE(PG8_SA(0, 0), a2, rA, pb2);
            PG8_WAIT_V(8); PG8_WAIT_L(0); PG8_BAR; PG8_MMA(1, 0, At, B0); PG8_MMA(1, 1, At, B1); PG8_BAR; PG8_SCHED;
            PG8_LDB(B0, 1, 0); PG8_LDB(B1, 1, 1); PG8_SCHED; PG8_LDA(At, 1, 0); PGX_STAGE(PG8_SA(0, 1), a2 + h2, rA, pb2);
            PG8_WAIT_V(8); PG8_WAIT_L(0); PG8_BAR; PG8_MMA(0, 0, At, B0); PG8_MMA(0, 1, At, B1); PG8_BAR; PG8_SCHED;
            PG8_LDA(At, 1, 1); PGX_STAGE(PG8_SB(1, 0), b3, rB, pb2); PGX_STAGE(PG8_SB(1, 1), b3 + h2, rB, pb2); PGX_STAGE(PG8_SA(1, 0), a3, rA, pb2);
            PG8_WAIT_V(8); PG8_WAIT_L(0); PG8_BAR; PG8_MMA(1, 0, At, B0); PG8_MMA(1, 1, At, B1); PG8_BAR; PG8_SCHED;
        }
        if (wr == 0) PG8_BAR;
        E(acc, cur, wr, wc, fr, fq);
        if (!has_next) break;
#pragma unroll
        for (int a = 0; a < 2; ++a)
#pragma unroll
            for (int b = 0; b < 2; ++b)
#pragma unroll
                for (int m = 0; m < 4; ++m)
#pragma unroll
                    for (int n = 0; n < 2; ++n) acc[a][b][m][n] = (f32x4){0.f, 0.f, 0.f, 0.f};
        cur = nxt; oc = on; cA = nA; cB = nB; Kc = Kn; ++ui;
        if (wr == 1) PG8_BAR;
    }
    PG8_WAIT_V(0);
    PG8_BAR;
#undef PG8_SA
#undef PG8_SB
#undef PGX_STAGE
#undef PG8_LDA
#undef PG8_LDB
#undef PG8_MMA
#undef PG8_WAIT_V
#undef PG8_WAIT_L
#undef PG8_BAR
#undef PG8_SCHED
}
}
namespace pg8 {
constexpr int TOK = 16384;
constexpr float RMS_EPS = 1e-6f;
typedef float f32x2e __attribute__((ext_vector_type(2)));
template <int NP> __device__ __forceinline__ void row_scales(const float* src, int rowbase, int lane, int fr, float (&r)[2][4]) {
#pragma unroll
    for (int ai = 0; ai < 2; ++ai) {
        const int row = rowbase + 128 * ai + lane; float v;
        if (NP == 0) v = src[row];
        else { float s = 0.f;
#pragma unroll
            for (int p = 0; p < NP; ++p) s += src[(size_t)p * TOK + row];
            v = __builtin_amdgcn_rsqf(s * (1.0f / 1024.0f) + RMS_EPS); }
#pragma unroll
        for (int m = 0; m < 4; ++m) r[ai][m] = __shfl(v, 16 * m + fr);
    }
}
template <int NP, class Sched> __device__ __forceinline__ void build_row_tab(const float* src, const Sched& S, PG8_LAS float* tab) {
    Unit u;
    for (int i = 0; S.next(i, u); ++i)
        for (int r = (int)threadIdx.x; r < 256; r += 512) { const int row = u.pm * BM + r; float v;
            if (NP == 0) v = src[row];
            else { float s = 0.f;
#pragma unroll
                for (int p = 0; p < NP; ++p) s += src[(size_t)p * TOK + row];
                v = __builtin_amdgcn_rsqf(s * (1.0f / 1024.0f) + RMS_EPS); }
            tab[i * 256 + r] = v; }
    __syncthreads();
}
__device__ __forceinline__ void row_scales_tab(const PG8_LAS float* tab, int ui, int wr, int fr, float (&r)[2][4]) {
#pragma unroll
    for (int ai = 0; ai < 2; ++ai)
#pragma unroll
        for (int m = 0; m < 4; ++m) r[ai][m] = tab[ui * 256 + ai * 128 + wr * 64 + 16 * m + fr];
}
__device__ __forceinline__ float silu_f(float x) { return x * __builtin_amdgcn_rcpf(1.0f + __expf(-x)); }
__device__ __forceinline__ float sigmoid_f(float x) { return __builtin_amdgcn_rcpf(1.0f + __expf(-x)); }

template <int NP> struct EpiSwiGLU {
    static constexpr bool PERM = true, AFTER_DRAIN = false;
    bf16_t* H; int ldh; const PG8_LAS float* tab; mutable int ui = 0;
    __device__ __forceinline__ void operator()(const f32x4 (&acc)[2][2][4][2], const Unit& u, int wr, int wc, int fr0, int fq0) const {
        int fr = fr0, fq = fq0; asm volatile("" : "+v"(fr), "+v"(fq));
        float r[2][4]; row_scales_tab(tab, ui++, wr, fr, r);
        const int col0 = u.pn * 128 + wc * 32 + 8 * fq;
#pragma unroll
        for (int ai = 0; ai < 2; ++ai)
#pragma unroll
            for (int m = 0; m < 4; ++m) {
                const int row = u.pm * BM + ai * HALF + wr * 64 + m * 16 + fr; const float rr = r[ai][m];
                float o[8]; const float k1 = -1.44269504f * rr, rr2 = rr * rr;
#pragma unroll
                for (int n = 0; n < 2; ++n)
#pragma unroll
                    for (int j = 0; j < 4; j += 2) { const f32x2 g2 = (f32x2){acc[ai][0][m][n][j], acc[ai][0][m][n][j + 1]}, u2 = (f32x2){acc[ai][1][m][n][j], acc[ai][1][m][n][j + 1]};
                        const f32x2 t2 = g2 * k1; const f32x2 d2 = (f32x2){__builtin_amdgcn_exp2f(t2[0]), __builtin_amdgcn_exp2f(t2[1])} + 1.0f;
                        const f32x2 r2 = (f32x2){__builtin_amdgcn_rcpf(d2[0]), __builtin_amdgcn_rcpf(d2[1])} * rr2; const f32x2 o2 = (g2 * u2) * r2;
                        o[4 * n + j] = o2[0]; o[4 * n + j + 1] = o2[1]; }
                u32x4 w; w.x = cvt_pk_bf16(o[0], o[1]); w.y = cvt_pk_bf16(o[2], o[3]); w.z = cvt_pk_bf16(o[4], o[5]); w.w = cvt_pk_bf16(o[6], o[7]);
                *(u32x4*)(H + (size_t)row * ldh + col0) = w;
            }
    }
};
template <bool WRITE_HB> struct EpiResid {
    static constexpr bool PERM = true, AFTER_DRAIN = false;
    const float* base; float* out; bf16_t* hb; float* part; float sc;
    __device__ __forceinline__ void operator()(const f32x4 (&acc)[2][2][4][2], const Unit& u, int wr, int wc, int fr0, int fq0) const {
        int fr = fr0, fq = fq0; asm volatile("" : "+v"(fr), "+v"(fq));
        const int col0 = u.pn * BM + wc * 32 + 8 * fq;
#pragma unroll
        for (int ai = 0; ai < 2; ++ai)
#pragma unroll
            for (int m = 0; m < 4; ++m) {
                const int row = u.pm * BM + ai * HALF + wr * 64 + m * 16 + fr; float ss = 0.f;
#pragma unroll
                for (int bj = 0; bj < 2; ++bj) {
                    const size_t off = (size_t)row * 1024 + col0 + bj * HALF;
                    const f32x4 b0 = *(const f32x4*)(base + off), b1 = *(const f32x4*)(base + off + 4);
                    const f32x4 o0 = b0 + acc[ai][bj][m][0] * sc, o1 = b1 + acc[ai][bj][m][1] * sc;
                    *(f32x4*)(out + off) = o0; *(f32x4*)(out + off + 4) = o1;
                    if (WRITE_HB) {
                        ss += (o0[0] * o0[0] + o0[1] * o0[1]) + (o0[2] * o0[2] + o0[3] * o0[3]) + (o1[0] * o1[0] + o1[1] * o1[1]) + (o1[2] * o1[2] + o1[3] * o1[3]);
                        u32x4 w; w.x = cvt_pk_bf16(o0[0], o0[1]); w.y = cvt_pk_bf16(o0[2], o0[3]); w.z = cvt_pk_bf16(o1[0], o1[1]); w.w = cvt_pk_bf16(o1[2], o1[3]);
                        *(u32x4*)(hb + off) = w; }
                }
                if (WRITE_HB) { ss += __shfl_xor(ss, 16); ss += __shfl_xor(ss, 32); if (fq == 0) part[(size_t)(u.pn * 4 + wc) * TOK + row] = ss; }
                if (m == 3) asm volatile("" ::: "memory");
            }
    }
};
template <bool WRITE_HB> struct EpiResid2 {
    static constexpr bool PERM = true, AFTER_DRAIN = false;
    const float* base; float* out; bf16_t* hb; float* part; float sc;
    __device__ __forceinline__ void operator()(const f32x4 (&acc)[2][2][4][2], const Unit& u, int wr, int wc, int fr0, int fq0) const {
        int fr = fr0, fq = fq0; asm volatile("" : "+v"(fr), "+v"(fq));
        const int row0 = u.pm * BM + wr * 64 + fr; const size_t o00 = (size_t)row0 * 1024 + u.pn * BM + wc * 32 + 8 * fq;
        const float* bp = base + o00; float* op = out + o00; bf16_t* hp = hb + o00;
        f32x4 bq[2][8];
#define ER2_ISSUE(G, B) do { _Pragma("unroll") for (int c = 0; c < 8; ++c) { const int ai = (G) >> 1, m = 2 * ((G) & 1) + (c >> 2), bj = (c >> 1) & 1, n = c & 1; \
            bq[B][c] = *(const f32x4*)(bp + (size_t)(ai * 128 + m * 16) * 1024 + bj * 128 + 4 * n); } } while (0)
        ER2_ISSUE(0, 0);
#pragma unroll
        for (int G = 0; G < 4; ++G) {
            if (G + 1 < 4) { if ((G & 1) == 0) ER2_ISSUE(G + 1, 1); else ER2_ISSUE(G + 1, 0); }
            asm volatile("" ::: "memory");
#pragma unroll
            for (int mm = 0; mm < 2; ++mm) { const int ai = G >> 1, m = 2 * (G & 1) + mm; float ss = 0.f;
#pragma unroll
                for (int bj = 0; bj < 2; ++bj) { const size_t off = (size_t)(ai * 128 + m * 16) * 1024 + bj * 128;
                    const f32x4 o0 = bq[G & 1][mm * 4 + bj * 2] + acc[ai][bj][m][0] * sc, o1 = bq[G & 1][mm * 4 + bj * 2 + 1] + acc[ai][bj][m][1] * sc;
                    *(f32x4*)(op + off) = o0; *(f32x4*)(op + off + 4) = o1;
                    if (WRITE_HB) {
                        ss += (o0[0] * o0[0] + o0[1] * o0[1]) + (o0[2] * o0[2] + o0[3] * o0[3]) + (o1[0] * o1[0] + o1[1] * o1[1]) + (o1[2] * o1[2] + o1[3] * o1[3]);
                        u32x4 w; w.x = cvt_pk_bf16(o0[0], o0[1]); w.y = cvt_pk_bf16(o0[2], o0[3]); w.z = cvt_pk_bf16(o1[0], o1[1]); w.w = cvt_pk_bf16(o1[2], o1[3]);
                        *(u32x4*)(hp + off) = w; } }
                if (WRITE_HB) { ss += __shfl_xor(ss, 16); ss += __shfl_xor(ss, 32); if (fq == 0) part[(size_t)(u.pn * 4 + wc) * TOK + row0 + ai * 128 + m * 16] = ss; } }
            asm volatile("" ::: "memory");
        }
#undef ER2_ISSUE
    }
};
struct EpiMemKV {
    static constexpr bool PERM = true, AFTER_DRAIN = false;
    float* KV; const float* rs;
    __device__ __forceinline__ void operator()(const f32x4 (&acc)[2][2][4][2], const Unit& u, int wr, int wc, int fr0, int fq0) const {
        int fr = fr0, fq = fq0; asm volatile("" : "+v"(fr), "+v"(fq));
        float r[2][4]; row_scales<0>(rs, u.pm * BM + wr * 64, (int)(threadIdx.x & 63), fr, r);
        const int col0 = u.pn * BM + wc * 32 + 8 * fq;
#pragma unroll
        for (int ai = 0; ai < 2; ++ai)
#pragma unroll
            for (int m = 0; m < 4; ++m) { const int row = u.pm * BM + ai * HALF + wr * 64 + m * 16 + fr;
#pragma unroll
                for (int bj = 0; bj < 2; ++bj) { const size_t off = (size_t)row * 1024 + col0 + bj * HALF;
                    *(f32x4*)(KV + off) = acc[ai][bj][m][0] * r[ai][m]; *(f32x4*)(KV + off + 4) = acc[ai][bj][m][1] * r[ai][m]; } }
    }
};
template <int NP> struct EpiGate {
    static constexpr bool PERM = true, AFTER_DRAIN = false;
    bf16_t* scr; const PG8_LAS float* tab; mutable int ui = 0;
    __device__ __forceinline__ void operator()(const f32x4 (&acc)[2][2][4][2], const Unit& u, int wr, int wc, int fr0, int fq0) const {
        int fr = fr0, fq = fq0; asm volatile("" : "+v"(fr), "+v"(fq));
        float r[2][4];
#ifdef DBG_GATE_NOSCALE
        for (int a_ = 0; a_ < 2; ++a_) for (int m_ = 0; m_ < 4; ++m_) r[a_][m_] = 1.0f;
#else
        row_scales_tab(tab, ui++, wr, fr, r);
#endif
        bf16_t* t = scr + (size_t)(u.pm * 4 + u.pn) * 65536;
#pragma unroll
        for (int ai = 0; ai < 2; ++ai)
#pragma unroll
            for (int m = 0; m < 4; ++m) { const int lr = ai * HALF + wr * 64 + m * 16 + fr; const float rr = r[ai][m];
#pragma unroll
                for (int bj = 0; bj < 2; ++bj) { float o[8];
#pragma unroll
                    for (int n = 0; n < 2; ++n)
#pragma unroll
                        for (int j = 0; j < 4; ++j) o[4 * n + j] = sigmoid_f(acc[ai][bj][m][n][j] * rr);
                    u32x4 w; w.x = cvt_pk_bf16(o[0], o[1]); w.y = cvt_pk_bf16(o[2], o[3]); w.z = cvt_pk_bf16(o[4], o[5]); w.w = cvt_pk_bf16(o[6], o[7]);
                    *(u32x4*)(t + lr * 256 + bj * HALF + wc * 32 + 8 * fq) = w; } }
    }
};
__device__ __forceinline__ float bf_lo(unsigned w) { return __uint_as_float(w << 16); }
__device__ __forceinline__ float bf_hi(unsigned w) { return __uint_as_float(w & 0xffff0000u); }
struct EpiBranch {
    static constexpr bool PERM = true, AFTER_DRAIN = false;
    const bf16_t* scr; bf16_t* mg; bool first; float bscale;
    __device__ __forceinline__ void operator()(const f32x4 (&acc)[2][2][4][2], const Unit& u, int wr, int wc, int fr0, int fq0) const {
        int fr = fr0, fq = fq0; asm volatile("" : "+v"(fr), "+v"(fq));
        const bf16_t* t = scr + (size_t)(u.pm * 4 + u.pn) * 65536;
        __builtin_amdgcn_fence(__ATOMIC_ACQUIRE, "agent");
        asm volatile("s_waitcnt vmcnt(0)" ::: "memory");
#pragma unroll
        for (int ai = 0; ai < 2; ++ai)
#pragma unroll
            for (int m = 0; m < 4; ++m) { const int lr = ai * HALF + wr * 64 + m * 16 + fr; const int row = u.pm * BM + lr;
#pragma unroll
                for (int bj = 0; bj < 2; ++bj) { const int lc = bj * HALF + wc * 32 + 8 * fq;
#if defined(DBG_NOGATE) && DBG_NOGATE
                    const u32x4 g = (u32x4){0x3f803f80u, 0x3f803f80u, 0x3f803f80u, 0x3f803f80u};
#else
                    const u32x4 g = *(const u32x4*)(t + lr * 256 + lc);
#endif
                    bf16_t* mp = mg + (size_t)row * 1024 + u.pn * BM + lc;
                    float o[8];
                    o[0] = bf_lo(g.x) * acc[ai][bj][m][0][0]; o[1] = bf_hi(g.x) * acc[ai][bj][m][0][1]; o[2] = bf_lo(g.y) * acc[ai][bj][m][0][2]; o[3] = bf_hi(g.y) * acc[ai][bj][m][0][3];
                    o[4] = bf_lo(g.z) * acc[ai][bj][m][1][0]; o[5] = bf_hi(g.z) * acc[ai][bj][m][1][1]; o[6] = bf_lo(g.w) * acc[ai][bj][m][1][2]; o[7] = bf_hi(g.w) * acc[ai][bj][m][1][3];
#ifdef DBG_BRANCH_SIGMOID
#pragma unroll
                    for (int e = 0; e < 8; ++e) o[e] = DBG_NONLIN(o[e]);
#endif
#pragma unroll
                    for (int e = 0; e < 8; ++e) o[e] *= bscale;
                    if (!first) { const u32x4 p = *(const u32x4*)mp;
                        o[0] += bf_lo(p.x); o[1] += bf_hi(p.x); o[2] += bf_lo(p.y); o[3] += bf_hi(p.y); o[4] += bf_lo(p.z); o[5] += bf_hi(p.z); o[6] += bf_lo(p.w); o[7] += bf_hi(p.w); }
                    u32x4 w; w.x = cvt_pk_bf16(o[0], o[1]); w.y = cvt_pk_bf16(o[2], o[3]); w.z = cvt_pk_bf16(o[4], o[5]); w.w = cvt_pk_bf16(o[6], o[7]);
                    *(u32x4*)mp = w; }
                if (m & 1) asm volatile("" ::: "memory"); }
    }
};
template <bool FIRST> struct EpiBranch2 {
    const bf16_t* scr; bf16_t* mg;
    __device__ __forceinline__ void operator()(const f32x4 (&acc)[2][2][4][2], const Unit& u, int wr, int wc, int fr0, int fq0) const {
        int fr = fr0, fq = fq0; asm volatile("" : "+v"(fr), "+v"(fq));
        const bf16_t* t = scr + (size_t)(u.pm * 4 + u.pn) * 65536 + (wr * 64 + fr) * 256 + wc * 32 + 8 * fq;
        bf16_t* mp0 = mg + (size_t)(u.pm * BM + wr * 64 + fr) * 1024 + u.pn * BM + wc * 32 + 8 * fq;
        u32x4 gq[2][4], pq[2][4];
#define EB2_ISSUE(G, B) do { _Pragma("unroll") for (int c = 0; c < 4; ++c) { const int ai = (G) >> 1, m = 2 * ((G) & 1) + (c >> 1), bj = c & 1; \
            gq[B][c] = *(const u32x4*)(t + (ai * 128 + m * 16) * 256 + bj * 128); if (!FIRST) pq[B][c] = *(const u32x4*)(mp0 + (size_t)(ai * 128 + m * 16) * 1024 + bj * 128); } } while (0)
        EB2_ISSUE(0, 0);
#pragma unroll
        for (int G = 0; G < 4; ++G) {
            if (G + 1 < 4) { if ((G & 1) == 0) EB2_ISSUE(G + 1, 1); else EB2_ISSUE(G + 1, 0); }
            asm volatile("" ::: "memory");
#pragma unroll
            for (int c = 0; c < 4; ++c) { const int ai = G >> 1, m = 2 * (G & 1) + (c >> 1), bj = c & 1; const u32x4 g = gq[G & 1][c];
                float o[8];
                o[0] = bf_lo(g.x) * acc[ai][bj][m][0][0]; o[1] = bf_hi(g.x) * acc[ai][bj][m][0][1]; o[2] = bf_lo(g.y) * acc[ai][bj][m][0][2]; o[3] = bf_hi(g.y) * acc[ai][bj][m][0][3];
                o[4] = bf_lo(g.z) * acc[ai][bj][m][1][0]; o[5] = bf_hi(g.z) * acc[ai][bj][m][1][1]; o[6] = bf_lo(g.w) * acc[ai][bj][m][1][2]; o[7] = bf_hi(g.w) * acc[ai][bj][m][1][3];
                if (!FIRST) { const u32x4 p = pq[G & 1][c];
                    o[0] += bf_lo(p.x); o[1] += bf_hi(p.x); o[2] += bf_lo(p.y); o[3] += bf_hi(p.y); o[4] += bf_lo(p.z); o[5] += bf_hi(p.z); o[6] += bf_lo(p.w); o[7] += bf_hi(p.w); }
                u32x4 w; w.x = cvt_pk_bf16(o[0], o[1]); w.y = cvt_pk_bf16(o[2], o[3]); w.z = cvt_pk_bf16(o[4], o[5]); w.w = cvt_pk_bf16(o[6], o[7]);
                *(u32x4*)(mp0 + (size_t)(ai * 128 + m * 16) * 1024 + bj * 128) = w; }
            asm volatile("" ::: "memory");
        }
#undef EB2_ISSUE
    }
};
template <size_t O_HB, size_t O_WG, size_t O_A0, size_t O_A1, size_t O_A2, size_t O_WB> struct P7Order {
    StaticOrder T; const char* ws;
    __device__ __forceinline__ bool next(int i, UnitX& u) const { const int rd = i / 6; Unit t; if (!T.next(rd, t)) return false; u.pm = t.pm; u.pn = t.pn; u.kind = i - 6 * rd; u.round = rd; return true; }
    __device__ __forceinline__ OpsX ops(const UnitX& u) const { const int j = u.kind >> 1; OpsX o;
        if (u.kind & 1) { o.K = 512; o.A = ws + (j == 0 ? O_A0 : j == 1 ? O_A1 : O_A2) + (size_t)u.pm * (256 * 512 * 2); o.Bt = ws + O_WB + (size_t)j * (1024 * 512 * 2) + (size_t)u.pn * (256 * 512 * 2); }
        else { o.K = 1024; o.A = ws + O_HB + (size_t)u.pm * (256 * 1024 * 2); o.Bt = ws + O_WG + (size_t)j * (1024 * 1024 * 2) + (size_t)u.pn * (256 * 1024 * 2); }
        return o; }
};
struct EpiP7 {
    bf16_t* scr; bf16_t* mg; const PG8_LAS float* tab;
    __device__ __forceinline__ void operator()(const f32x4 (&acc)[2][2][4][2], const UnitX& u, int wr, int wc, int fr, int fq) const {
        const Unit uu{u.pm, u.pn};
        if (u.kind == 1) { const EpiBranch2<true> b{scr, mg}; b(acc, uu, wr, wc, fr, fq); }
        else if (u.kind & 1) { const EpiBranch2<false> b{scr, mg}; b(acc, uu, wr, wc, fr, fq); }
        else { const EpiGate<16> g{scr, tab, u.round}; g(acc, uu, wr, wc, fr, fq); }
    }
};
struct ProjOut { bf16_t *FQ, *FK, *FV, *DQ, *IQ, *MQ, *DK, *DV, *IK; float *LOGF, *IW; const float *cosT, *sinT, *g_fq, *g_fk, *g_dq, *g_dk, *b_forget; };
__device__ __forceinline__ float log_sigmoid_f(float z) { return z >= 0.f ? -log1pf(expf(-z)) : z - log1pf(expf(z)); }
template <int NP> struct EpiProj {
    static constexpr bool PERM = true, AFTER_DRAIN = false;
    ProjOut P; const PG8_LAS float* tab; float qscale; mutable int ui = 0;
    __device__ __forceinline__ void operator()(const f32x4 (&acc)[2][2][4][2], const Unit& u, int wr, int wc, int fr0, int fq0) const {
        int fr = fr0, fq = fq0; asm volatile("" : "+v"(fr), "+v"(fq));
        float r[2][4]; row_scales_tab(tab, ui++, wr, fr, r);
        const int pn = u.pn;
        bool do_norm = false, do_rope = false; const float* gain = nullptr; bf16_t* dst = nullptr; int pitch = 512, hoff = 0; float osc = 1.f;
        if (pn < 2)       { do_norm = true; gain = P.g_fq; dst = P.FQ; hoff = (4 * pn + wc) * 64; osc = qscale; }
        else if (pn < 4)  { do_norm = true; gain = P.g_fk; dst = P.FK; hoff = (4 * (pn - 2) + wc) * 64; }
        else if (pn < 6)  { dst = P.FV; hoff = (4 * (pn - 4) + wc) * 64; }
        else if (pn < 8)  { do_norm = true; do_rope = true; gain = P.g_dq; dst = P.DQ; hoff = (4 * (pn - 6) + wc) * 64; osc = qscale; }
        else if (pn < 10) { do_rope = true; dst = P.IQ; hoff = (4 * (pn - 8) + wc) * 64; }
        else if (pn < 12) { dst = P.MQ; hoff = (2 * (pn - 10) + (wc >> 1)) * 128 + (wc & 1) * 64; }
        else { pitch = 64;
            if (wc == 0)      { do_norm = true; do_rope = true; gain = P.g_dk; dst = P.DK; }
            else if (wc == 1) { dst = P.DV; }
            else if (wc == 2) { do_rope = true; dst = P.IK; }
            else dst = nullptr; }
        if (dst == nullptr) {
            if (fq < 2) {
#pragma unroll
                for (int ai = 0; ai < 2; ++ai)
#pragma unroll
                    for (int m = 0; m < 4; ++m) { const int row = u.pm * BM + ai * HALF + wr * 64 + m * 16 + fr; const float rr = r[ai][m];
                        f32x4 v0 = acc[ai][0][m][0] * rr, v1 = acc[ai][0][m][1] * rr;
                        if (fq == 0) {
                            const f32x4 b0 = *(const f32x4*)(P.b_forget), b1 = *(const f32x4*)(P.b_forget + 4);
#pragma unroll
                            for (int j = 0; j < 4; ++j) { v0[j] = log_sigmoid_f(v0[j] + b0[j]); v1[j] = log_sigmoid_f(v1[j] + b1[j]); }
                            *(f32x4*)(P.LOGF + (size_t)row * 8) = v0; *(f32x4*)(P.LOGF + (size_t)row * 8 + 4) = v1;
                        } else { const float c = 0.04419417382f; *(f32x4*)(P.IW + (size_t)row * 8) = v0 * c; *(f32x4*)(P.IW + (size_t)row * 8 + 4) = v1 * c; } }
            }
            return;
        }
        f32x4 gv[2][2];
        if (do_norm) {
#pragma unroll
            for (int bj = 0; bj < 2; ++bj)
#pragma unroll
                for (int n = 0; n < 2; ++n) gv[bj][n] = *(const f32x4*)(gain + bj * 32 + 8 * fq + 4 * n);
        }
#pragma unroll
        for (int ai = 0; ai < 2; ++ai)
#pragma unroll
            for (int m = 0; m < 4; ++m) {
                const int row = u.pm * BM + ai * HALF + wr * 64 + m * 16 + fr; const float rr = r[ai][m];
                f32x4 v[2][2];
#pragma unroll
                for (int bj = 0; bj < 2; ++bj)
#pragma unroll
                    for (int n = 0; n < 2; ++n) v[bj][n] = acc[ai][bj][m][n] * rr;
                if (do_norm) {
                    float ss = 0.f;
#pragma unroll
                    for (int bj = 0; bj < 2; ++bj)
#pragma unroll
                        for (int n = 0; n < 2; ++n) ss += (v[bj][n][0] * v[bj][n][0] + v[bj][n][1] * v[bj][n][1]) + (v[bj][n][2] * v[bj][n][2] + v[bj][n][3] * v[bj][n][3]);
                    ss += __shfl_xor(ss, 16); ss += __shfl_xor(ss, 32);
                    const float inv = __builtin_amdgcn_rsqf(ss * (1.0f / 64.0f) + RMS_EPS);
#pragma unroll
                    for (int bj = 0; bj < 2; ++bj)
#pragma unroll
                        for (int n = 0; n < 2; ++n) v[bj][n] = v[bj][n] * inv * gv[bj][n];
                }
                if (do_rope) {
#pragma unroll
                    for (int n = 0; n < 2; ++n) {
                        const f32x4 c = *(const f32x4*)(P.cosT + (size_t)row * 32 + 8 * fq + 4 * n), s = *(const f32x4*)(P.sinT + (size_t)row * 32 + 8 * fq + 4 * n);
                        const f32x4 x1 = v[0][n], x2 = v[1][n];
                        v[0][n] = x1 * c - x2 * s; v[1][n] = x2 * c + x1 * s; }
                }
#pragma unroll
                for (int bj = 0; bj < 2; ++bj) {
                    const f32x4 a = v[bj][0] * osc, b = v[bj][1] * osc;
                    u32x4 w; w.x = cvt_pk_bf16(a[0], a[1]); w.y = cvt_pk_bf16(a[2], a[3]); w.z = cvt_pk_bf16(b[0], b[1]); w.w = cvt_pk_bf16(b[2], b[3]);
                    if (pn == 12 && wc == 2) {
                        const int d = bj * 32 + 8 * fq; *(u32x4*)(dst + (size_t)(row >> 5) * 2048 + (d >> 4) * 512 + ((d >> 3) & 1) * 256 + (row & 31) * 8) = w;
                    } else *(u32x4*)(dst + (size_t)row * pitch + hoff + bj * 32 + 8 * fq) = w; }
            }
    }
};
}
#define GAS __attribute__((address_space(1)))
#define LAS __attribute__((address_space(3)))
typedef unsigned short bf16;
typedef unsigned v4u __attribute__((ext_vector_type(4)));
typedef float f32x4 __attribute__((ext_vector_type(4)));
typedef short bf16x8 __attribute__((ext_vector_type(8)));
typedef GAS unsigned gu32;
typedef GAS unsigned long long gu64;
#define RLX_AGENT __ATOMIC_RELAXED, __HIP_MEMORY_SCOPE_AGENT
#define LDS_WAIT() asm volatile("s_waitcnt lgkmcnt(0)" ::: "memory")
#define VM_WAIT() asm volatile("s_waitcnt vmcnt(0)" ::: "memory")
__device__ __forceinline__ unsigned long long rt() { return __builtin_amdgcn_s_memrealtime(); }
__device__ __forceinline__ unsigned f2bf(float f) { unsigned u = __builtin_bit_cast(unsigned, f); return (u + 0x7fffu + ((u >> 16) & 1u)) >> 16; }
__device__ __forceinline__ unsigned pk2(float lo, float hi) { return f2bf(lo) | (f2bf(hi) << 16); }
typedef float f32x2g __attribute__((ext_vector_type(2)));
__device__ __forceinline__ float bf_lo32(unsigned w) { return __uint_as_float(w << 16); }
__device__ __forceinline__ float bf_hi32(unsigned w) { return __uint_as_float(w & 0xffff0000u); }
constexpr int NWAVES = 8;
constexpr int BATCH = 2, SEQ = 8192, DM = 1024, T = BATCH * SEQ, DFF = 2816, MEMLEN = 256, BW = 512, DIN = 6352;
constexpr int NPROJ = 13 * 256, NGATE = 3072;
constexpr float L2E = 1.4426950408889634f;
constexpr float C2_64 = 0.125f * L2E;
constexpr float C2_128 = 0.08838834764831845f * L2E;
constexpr size_t MiB = 1u << 20;
constexpr size_t WS_CTL = 0, CTL_ZERO_BYTES = 128 * 1024;
constexpr size_t WS_RSTDX = 1 * MiB;
constexpr size_t WS_RSTDM = WS_RSTDX + 64 * 1024;
constexpr size_t WS_T0 = WS_RSTDM + 4096;
constexpr size_t WS_SSQ1 = 2 * MiB;
constexpr size_t WS_SSQ2 = 3 * MiB;
constexpr size_t WS_LOGF = 4 * MiB;
constexpr size_t WS_CUM = WS_LOGF + 512 * 1024;
constexpr size_t WS_IW = 5 * MiB;
constexpr size_t WS_COS = 6 * MiB, WS_SIN = 8 * MiB;
constexpr size_t WS_MEMB = 10 * MiB;
constexpr size_t WS_KVM = 11 * MiB;
constexpr size_t WS_KMB = 13 * MiB, WS_VMB = 14 * MiB;
constexpr size_t WS_WGU1 = 16 * MiB;
constexpr size_t WS_WD1 = 27 * MiB;
constexpr size_t WS_WIN = 33 * MiB;
constexpr size_t WS_WGATE = 40 * MiB;
constexpr size_t WS_WBR = 46 * MiB;
constexpr size_t WS_WOUT = 49 * MiB;
constexpr size_t WS_WGU2 = 51 * MiB;
constexpr size_t WS_WD2 = 62 * MiB;
constexpr size_t WS_WMKV = 68 * MiB;
constexpr size_t WS_HB = 70 * MiB;
constexpr size_t WS_ACT = 102 * MiB;
constexpr size_t WS_HID = WS_ACT;
constexpr size_t WS_FQ = WS_ACT, WS_FK = WS_ACT + 16 * MiB, WS_FV = WS_ACT + 32 * MiB, WS_DQ = WS_ACT + 48 * MiB, WS_IQ = WS_ACT + 64 * MiB, WS_MQ = WS_ACT + 80 * MiB;
constexpr size_t WS_DK = WS_ACT + 96 * MiB, WS_DV = WS_ACT + 98 * MiB, WS_IK = WS_ACT + 100 * MiB;
#if defined(DBG_SUBST) && DBG_SUBST == 2
constexpr size_t WS_MERGED = WS_DQ;
#else
constexpr size_t WS_MERGED = WS_FK;
#endif
#ifdef DBG_GSCR_AT
constexpr size_t WS_GSCR = DBG_GSCR_AT;
#else
constexpr size_t WS_GSCR = 204 * MiB;
#endif
constexpr size_t WS_OA = 236 * MiB;
constexpr size_t WS_OB = 16 * MiB;
constexpr size_t WS_END = 252 * MiB;
#ifndef DBG_GSCR_AT
static_assert(WS_HID + (size_t)T * DFF * 2 <= WS_GSCR && WS_IK + (size_t)T * 64 * 2 <= WS_GSCR, "d_ws map");
#endif
constexpr int CW_BAR = 4096;
constexpr int CW_Q = 16384;
constexpr int RING_OFF = 0, RING_BYTES = 131072;
constexpr int LDSCTL_OFF = RING_BYTES, MISC_OFF = LDSCTL_OFF + 320;
constexpr int LIST_OFF = RING_BYTES + 1024;
constexpr int SCANX_OFF = RING_BYTES + 6144;
constexpr int LDS_BYTES = 163840;
#define XB_TMO      128
#define XB_XCNT(j)  (256  + 64 * (j))
#define XB_XSUB(j)  (1280 + 64 * (j))
#define XB_XGEN(j)  (2304 + 64 * (j))
#define XB_TOP      3328
#define XB_TOPGEN   3392
#define XCD_BAR_WORDS 3456
#define XB_SPIN_CAP (1u << 18)

__device__ __forceinline__ unsigned xb_ld(unsigned* p)              { return __hip_atomic_load(p, __ATOMIC_RELAXED, __HIP_MEMORY_SCOPE_AGENT); }
__device__ __forceinline__ unsigned xb_add(unsigned* p, unsigned v) { return __hip_atomic_fetch_add(p, v, __ATOMIC_RELAXED, __HIP_MEMORY_SCOPE_AGENT); }
__device__ __forceinline__ unsigned xb_xcc_id() { return (unsigned)__builtin_amdgcn_s_getreg((3 << 11) | 20) & 0xFu; }
#define XB_SPIN(cond, bar) do { unsigned _sp = 0; while (cond) { __builtin_amdgcn_s_sleep(1); \
    if ((++_sp & 255u) == 0u) { if (xb_ld(&(bar)[XB_TMO])) break; if (_sp > XB_SPIN_CAP) { atomicAdd(&(bar)[XB_TMO], 1u); break; } } } } while (0)

struct XcdBarrier {
    unsigned* bar; unsigned x;
    volatile LAS unsigned* st;
};

__device__ __forceinline__ XcdBarrier xcd_barrier_post(unsigned* bar, volatile LAS unsigned* st) {
    XcdBarrier b; b.bar = bar; b.x = xb_xcc_id(); b.st = st;
    if (threadIdx.x == 0) (void)xb_add(&bar[XB_XCNT(b.x)], 1u);
    return b;
}
__device__ __forceinline__ void xcd_barrier_complete(unsigned* bar, unsigned x, unsigned& nloc, unsigned& nx) {
    const unsigned G = gridDim.x * gridDim.y * gridDim.z;
    unsigned sum, cnt, mine, sp = 0u;
    for (;;) {
        sum = 0u; cnt = 0u; mine = 0u;
#pragma unroll
        for (unsigned j = 0; j < 16; ++j) { const unsigned c = xb_ld(&bar[XB_XCNT(j)]); sum += c; cnt += (c > 0u) ? 1u : 0u; mine = (j == x) ? c : mine; }
        if (sum == G) break;
        __builtin_amdgcn_s_sleep(1);
        if ((++sp & 255u) == 0u) { if (xb_ld(&bar[XB_TMO])) break; if (sp > XB_SPIN_CAP) { atomicAdd(&bar[XB_TMO], 1u); break; } }
    }
    nloc = mine > 0u ? mine : 1u; nx = cnt > 0u ? cnt : 1u;
}

__device__ __forceinline__ void xcd_barrier(const XcdBarrier& b) {
    asm volatile("s_waitcnt vmcnt(0)" ::: "memory");
    __syncthreads();
    if (threadIdx.x == 0) {
        unsigned* bar = b.bar;
        __builtin_amdgcn_s_waitcnt(0);
        unsigned nloc = b.st[0], nx = b.st[1];
        if (nloc == 0u) { xcd_barrier_complete(bar, b.x, nloc, nx); b.st[0] = nloc; b.st[1] = nx; }
        const unsigned old = xb_add(&bar[XB_XSUB(b.x)], 1u);
        const unsigned gen = old / nloc;
        if (old + 1u == (gen + 1u) * nloc) {
            __builtin_amdgcn_fence(__ATOMIC_RELEASE, "agent");
            asm volatile("s_waitcnt vmcnt(0)" ::: "memory");
            const unsigned og = xb_add(&bar[XB_TOP], 1u);
            const unsigned tg = og / nx;
            if (og + 1u == (tg + 1u) * nx) xb_add(&bar[XB_TOPGEN], 1u);
            else XB_SPIN(xb_ld(&bar[XB_TOPGEN]) == tg, bar);
            __builtin_amdgcn_fence(__ATOMIC_ACQUIRE, "agent");
            xb_add(&bar[XB_XGEN(b.x)], 1u);
            asm volatile("s_waitcnt vmcnt(0)" ::: "memory");
        } else {
            XB_SPIN(xb_ld(&bar[XB_XGEN(b.x)]) == gen, bar);
            __builtin_amdgcn_fence(__ATOMIC_ACQUIRE, "agent");
            asm volatile("s_waitcnt vmcnt(0)" ::: "memory");
        }
    }
    __syncthreads();
}
__device__ __forceinline__ float wave_sum(float v) {
#pragma unroll
    for (int o = 1; o < 64; o <<= 1) v += __shfl_xor(v, o);
    return v;
}
__device__ __forceinline__ float wave_max(float v) {
#pragma unroll
    for (int o = 1; o < 64; o <<= 1) v = fmaxf(v, __shfl_xor(v, o));
    return v;
}
__device__ __forceinline__ int colmap(int mat, int n) {
    if (mat == 1) return n;
    if (mat == 3) return 3280 + n;
    const int tile = n >> 8, t = n & 255;
    if (mat == 0) return (t < 128 ? 0 : DFF) + 128 * tile + (t & 127);
    const int bj = t >> 7, wc = (t >> 5) & 3, i = t & 31, d = bj * 32 + i;
    if (tile < 2) return 0 + (4 * tile + wc) * 64 + d;
    if (tile < 4) return 512 + (4 * (tile - 2) + wc) * 64 + d;
    if (tile < 6) return 1024 + (4 * (tile - 4) + wc) * 64 + d;
    if (tile < 8) return 1544 + (4 * (tile - 6) + wc) * 64 + d;
    if (tile < 10) return 2184 + (4 * (tile - 8) + wc) * 64 + d;
    if (tile < 12) return 2768 + (2 * (tile - 10) + (wc >> 1)) * 128 + (wc & 1) * 64 + d;
    if (wc == 0) return 2056 + d;
    if (wc == 1) return 2120 + d;
    if (wc == 2) return 2696 + d;
    if (bj == 0 && i < 8) return 1536 + i;
    if (bj == 0 && i < 16) return 2760 + (i - 8);
    return -1;
}
__device__ __forceinline__ void transpose_item(int mat, const float* Wa, const float* Wb, int K, int Nsrc, const float* gain, bf16* WT, LAS float* scr, int item, int nblk, int lane) {
    const int kb = item / nblk, nb = item % nblk, k0 = 64 * kb, n0 = 32 * nb;
    int col = colmap(mat, n0 + (lane & 31)); const float* W = Wa;
    if (mat == 0 && col >= DFF) { W = Wb; col -= DFF; }
#pragma unroll 8
    for (int i = 0; i < 32; ++i) { const int kk = 2 * i + (lane >> 5); float v = 0.f; if (col >= 0) v = W[(size_t)(k0 + kk) * Nsrc + col]; if (gain) v *= gain[k0 + kk]; scr[kk * 33 + (lane & 31)] = v; }
    LDS_WAIT(); asm volatile("" ::: "memory");
    const int c = lane & 7;
#pragma unroll
    for (int j = 0; j < 4; ++j) { const int n = (lane >> 3) + 8 * j; const LAS float* s = scr + (8 * c) * 33 + n;
        v4u o; o.x = pk2(s[0 * 33], s[1 * 33]); o.y = pk2(s[2 * 33], s[3 * 33]); o.z = pk2(s[4 * 33], s[5 * 33]); o.w = pk2(s[6 * 33], s[7 * 33]);
        *(GAS v4u*)(WT + (size_t)(n0 + n) * K + k0 + 8 * c) = o; }
    LDS_WAIT(); asm volatile("" ::: "memory");
}
__device__ __forceinline__ void row_to_bf16_rstd(const float* xrow, bf16* orow, float* rstd_out, int lane) {
    const GAS f32x4* xr = (const GAS f32x4*)xrow + lane;
    f32x4 v[4]; float s = 0.f;
#pragma unroll
    for (int j = 0; j < 4; ++j) { v[j] = xr[64 * j]; s += (v[j].x * v[j].x + v[j].y * v[j].y) + (v[j].z * v[j].z + v[j].w * v[j].w); }
    const float rstd = 1.0f / sqrtf(wave_sum(s) * (1.f / 1024.f) + 1e-6f);
    GAS unsigned long long* o8 = (GAS unsigned long long*)orow + lane;
#pragma unroll
    for (int j = 0; j < 4; ++j) o8[64 * j] = (unsigned long long)pk2(v[j].x, v[j].y) | ((unsigned long long)pk2(v[j].z, v[j].w) << 32);
    if (lane == 0) *rstd_out = rstd;
}
__device__ __forceinline__ void rows4_to_bf16_rstd(const float* const (&xrow)[4], bf16* const (&orow)[4], float* const (&rout)[4], const bool (&ok)[4], int lane) {
    f32x4 v[4][4];
#pragma unroll
    for (int r = 0; r < 4; ++r) { const GAS f32x4* xr = (const GAS f32x4*)xrow[r] + lane;
#pragma unroll
        for (int j = 0; j < 4; ++j) v[r][j] = xr[64 * j]; }
#pragma unroll
    for (int r = 0; r < 4; ++r) { float s = 0.f;
#pragma unroll
        for (int j = 0; j < 4; ++j) s += (v[r][j].x * v[r][j].x + v[r][j].y * v[r][j].y) + (v[r][j].z * v[r][j].z + v[r][j].w * v[r][j].w);
        const float rstd = 1.0f / sqrtf(wave_sum(s) * (1.f / 1024.f) + 1e-6f);
        if (ok[r]) { GAS unsigned long long* o8 = (GAS unsigned long long*)orow[r] + lane;
#pragma unroll
            for (int j = 0; j < 4; ++j) o8[64 * j] = (unsigned long long)pk2(v[r][j].x, v[r][j].y) | ((unsigned long long)pk2(v[r][j].z, v[r][j].w) << 32);
            if (lane == 0) *rout[r] = rstd; } }
}
typedef float f32x16 __attribute__((ext_vector_type(16)));
typedef unsigned u32x2 __attribute__((ext_vector_type(2)));
__device__ __forceinline__ int crow(int r, int hi) { return (r & 3) + 8 * (r >> 2) + 4 * hi; }
__device__ __forceinline__ float bf2f(bf16 v) { return __uint_as_float((unsigned)v << 16); }
__device__ __forceinline__ unsigned cvtpk(float lo, float hi) { return pg8::cvt_pk_bf16(lo, hi); }
template <int HD, bool FOX, bool VT>
__device__ __forceinline__ void attn_wave_simple(const bf16x8 (&qr)[HD / 16], const bf16* Kp, int kpitch, const bf16* Vp, int vpitch, int tstart, int ntiles, int qlocal, const float* cb, bf16* Op, int opitch, int lane) {
    const int r32 = lane & 31, hi = lane >> 5;
    f32x16 o[HD / 32];
#pragma unroll
    for (int d0 = 0; d0 < HD / 32; ++d0)
#pragma unroll
        for (int r = 0; r < 16; ++r) o[d0][r] = 0.f;
    float m = -1e30f, l = 0.f;
    for (int t = tstart; t < ntiles; ++t) {
        const int kv0 = 32 * t;
        f32x16 p;
#pragma unroll
        for (int r = 0; r < 16; ++r) p[r] = 0.f;
        const bf16* kr = Kp + (size_t)(kv0 + r32) * kpitch + hi * 8;
#pragma unroll
        for (int ks = 0; ks < HD / 16; ++ks) { const bf16x8 kf = *(const bf16x8*)(kr + ks * 16); p = __builtin_amdgcn_mfma_f32_32x32x16_bf16(kf, qr[ks], p, 0, 0, 0); }
        if (FOX) {
#pragma unroll
            for (int g = 0; g < 4; ++g) { const f32x4 c4 = *(const f32x4*)(cb + kv0 + 8 * g + 4 * hi);
#pragma unroll
                for (int jj = 0; jj < 4; ++jj) p[4 * g + jj] -= L2E * c4[jj]; }
            if (t == ntiles - 1) {
#pragma unroll
                for (int r = 0; r < 16; ++r) if (kv0 + crow(r, hi) > qlocal) p[r] = -INFINITY;
            }
        }
        float mt = p[0];
#pragma unroll
        for (int r = 1; r < 16; ++r) mt = fmaxf(mt, p[r]);
        mt = fmaxf(mt, __shfl_xor(mt, 32));
        const float mn = fmaxf(m, mt); const float alpha = __builtin_amdgcn_exp2f(m - mn); m = mn;
        l *= alpha;
#pragma unroll
        for (int d0 = 0; d0 < HD / 32; ++d0)
#pragma unroll
            for (int r = 0; r < 16; ++r) o[d0][r] *= alpha;
        float ls = 0.f;
#pragma unroll
        for (int r = 0; r < 16; ++r) { p[r] = __builtin_amdgcn_exp2f(p[r] - mn); ls += p[r]; }
        l += ls;
        bf16x8 pa[2];
#pragma unroll
        for (int s = 0; s < 2; ++s) { v4u w; w.x = cvtpk(p[8 * s + 0], p[8 * s + 1]); w.y = cvtpk(p[8 * s + 2], p[8 * s + 3]); w.z = cvtpk(p[8 * s + 4], p[8 * s + 5]); w.w = cvtpk(p[8 * s + 6], p[8 * s + 7]); pa[s] = __builtin_bit_cast(bf16x8, w); }
#pragma unroll
        for (int d0 = 0; d0 < HD / 32; ++d0)
#pragma unroll
            for (int s = 0; s < 2; ++s) {
                bf16x8 vf;
                if (VT) {
                    const bf16* vp = Vp + (size_t)(d0 * 32 + r32) * vpitch + kv0 + 16 * s + 4 * hi;
                    const u32x2 lo = *(const u32x2*)vp, hi2 = *(const u32x2*)(vp + 8);
                    vf = __builtin_bit_cast(bf16x8, (v4u){lo.x, lo.y, hi2.x, hi2.y});
                } else {
#pragma unroll
                    for (int j = 0; j < 8; ++j) vf[j] = (short)Vp[(size_t)(kv0 + 16 * s + 8 * (j >> 2) + 4 * hi + (j & 3)) * vpitch + d0 * 32 + r32];
                }
                o[d0] = __builtin_amdgcn_mfma_f32_32x32x16_bf16(vf, pa[s], o[d0], 0, 0, 0);
            }
    }
    l += __shfl_xor(l, 32);
    const float inv = 1.0f / l;
    bf16* orow = Op + (size_t)r32 * opitch;
#pragma unroll
    for (int d0 = 0; d0 < HD / 32; ++d0)
#pragma unroll
        for (int g = 0; g < 4; ++g) { u32x2 w; w.x = cvtpk(o[d0][4 * g] * inv, o[d0][4 * g + 1] * inv); w.y = cvtpk(o[d0][4 * g + 2] * inv, o[d0][4 * g + 3] * inv);
            *(u32x2*)(orow + d0 * 32 + 8 * g + 4 * hi) = w; }
}
__device__ __forceinline__ void fox_unit(int bh, int qb, const bf16* FQ, const bf16* FK, const bf16* FV, const float* CUM, const int* T0, bf16* OA, int wave, int lane) {
    const int b = bh >> 3, h = bh & 7, r32 = lane & 31, hi = lane >> 5; const size_t rowbase = (size_t)b * SEQ; const int q0 = qb * 256 + wave * 32;
    const bf16* Qw = FQ + (rowbase + q0) * 512 + h * 64; bf16* Ow = OA + (rowbase + q0) * 512 + h * 64;
    bf16x8 qr[4];
#pragma unroll
    for (int ks = 0; ks < 4; ++ks) qr[ks] = *(const bf16x8*)(Qw + (size_t)r32 * 512 + ks * 16 + hi * 8);
    attn_wave_simple<64, true, false>(qr, FK + rowbase * 512 + h * 64, 512, FV + rowbase * 512 + h * 64, 512, T0[bh * 256 + q0 / 32], q0 / 32 + 1, q0 + r32, CUM + (size_t)bh * SEQ, Ow, 512, lane);
}
__device__ __forceinline__ void mem_unit(int rg, int head, bf16* MQ, const bf16* KMB, const bf16* VMB, const float* gq, int lane) {
    const int r32 = lane & 31, hi = lane >> 5; const int row0 = rg * 32; const int b = row0 / SEQ;
    bf16* Qw = MQ + (size_t)row0 * 512 + head * 128;
    bf16x8 raw[8]; float ss = 0.f;
#pragma unroll
    for (int ks = 0; ks < 8; ++ks) { raw[ks] = *(const bf16x8*)(Qw + (size_t)r32 * 512 + ks * 16 + hi * 8);
#pragma unroll
        for (int j = 0; j < 8; ++j) { const float f = bf2f((bf16)raw[ks][j]); ss += f * f; } }
    ss += __shfl_xor(ss, 32);
    const float rstd = __builtin_amdgcn_rsqf(ss * (1.0f / 128.0f) + 1e-6f) * C2_128;
    bf16x8 qr[8];
#pragma unroll
    for (int ks = 0; ks < 8; ++ks) { const f32x4 g0 = *(const f32x4*)(gq + ks * 16 + hi * 8), g1 = *(const f32x4*)(gq + ks * 16 + hi * 8 + 4); v4u w;
        w.x = cvtpk(bf2f((bf16)raw[ks][0]) * rstd * g0[0], bf2f((bf16)raw[ks][1]) * rstd * g0[1]); w.y = cvtpk(bf2f((bf16)raw[ks][2]) * rstd * g0[2], bf2f((bf16)raw[ks][3]) * rstd * g0[3]);
        w.z = cvtpk(bf2f((bf16)raw[ks][4]) * rstd * g1[0], bf2f((bf16)raw[ks][5]) * rstd * g1[1]); w.w = cvtpk(bf2f((bf16)raw[ks][6]) * rstd * g1[2], bf2f((bf16)raw[ks][7]) * rstd * g1[3]);
        qr[ks] = __builtin_bit_cast(bf16x8, w); }
    attn_wave_simple<128, false, true>(qr, KMB + (size_t)b * MEMLEN * 512 + head * 128, 512, VMB + (size_t)(b * 4 + head) * 128 * MEMLEN, MEMLEN, 0, MEMLEN / 32, 0, nullptr, Qw, 512, lane);
}
__device__ __forceinline__ void scan_unit(int bh, const float* LOGF, float* CUM, int* T0, const float* gq, const float* gk, LAS float* sx, LAS float* cl, int tid) {
    const int b = bh >> 3, h = bh & 7, lane = tid & 63, wave = tid >> 6;
    float v[16]; float run = 0.f;
#pragma unroll
    for (int i = 0; i < 16; ++i) v[i] = LOGF[((size_t)b * SEQ + 16 * tid + i) * 8 + h];
#pragma unroll
    for (int i = 0; i < 16; ++i) { run += v[i]; v[i] = run; }
    float tot = run;
#pragma unroll
    for (int off = 1; off < 64; off <<= 1) { const float nb = __shfl_up(tot, off); if (lane >= off) tot += nb; }
    if (lane == 63) sx[wave] = tot;
    __syncthreads();
    float woff = 0.f;
    for (int w = 0; w < wave; ++w) woff += sx[w];
    const float excl = tot - run + woff;
    float* dst = CUM + (size_t)bh * SEQ + 16 * tid;
#pragma unroll
    for (int i = 0; i < 16; i += 4) { const f32x4 o4 = (f32x4){v[i] + excl, v[i + 1] + excl, v[i + 2] + excl, v[i + 3] + excl}; *(f32x4*)(dst + i) = o4; *(LAS f32x4*)(cl + 16 * tid + i) = o4; }
    const float smax = 8.0f * wave_max(fabsf(gq[lane])) * wave_max(fabsf(gk[lane]));
    __syncthreads();
    if (tid < 256) { const float cq = cl[32 * tid]; const float lim = -(30.0f + 2.0f * smax);
        int lo = 0, hi = tid;
        while (lo < hi) { const int mid = (lo + hi) >> 1; if (cq - cl[32 * mid + 31] >= lim) hi = mid; else lo = mid + 1; }
        T0[bh * 256 + tid] = lo; }
    __syncthreads();
}
constexpr int D2_LST = RING_BYTES + 1024;
constexpr int D2_CNT = RING_BYTES + 3072;
constexpr int D2_CL = RING_BYTES + 4096;
typedef short v4i16_t __attribute__((ext_vector_type(4)));
typedef float f32x4d __attribute__((ext_vector_type(4)));
__device__ __forceinline__ unsigned sortable_u32(float f) { const unsigned u = __float_as_uint(f); return u ^ ((u >> 31) ? 0xFFFFFFFFu : 0x80000000u); }
__device__ __forceinline__ int lane_rank(unsigned long long mask) { return (int)__builtin_amdgcn_mbcnt_hi((unsigned)(mask >> 32), __builtin_amdgcn_mbcnt_lo((unsigned)mask, 0u)); }
__device__ __forceinline__ int bcount(bool p) { return (int)__popcll(__ballot(p)); }
__device__ __forceinline__ void select_full(const LAS unsigned* my, int npad, LAS unsigned short* lst, int lane) {
    unsigned thr = 0u;
    for (int bit = 31; bit >= 0; --bit) {
        const unsigned cand = thr | (1u << bit); int cnt = 0;
        for (int i0 = 0; i0 < npad; i0 += 256) { const int idx = i0 + 4 * lane; v4u v = (v4u){0u, 0u, 0u, 0u}; if (idx < npad) v = *(const LAS v4u*)(my + idx);
            cnt += bcount(v.x >= cand) + bcount(v.y >= cand) + bcount(v.z >= cand) + bcount(v.w >= cand); }
        if (cnt >= 256) thr = cand;
    }
    int cgt = 0;
    for (int i0 = 0; i0 < npad; i0 += 256) { const int idx = i0 + 4 * lane; v4u v = (v4u){0u, 0u, 0u, 0u}; if (idx < npad) v = *(const LAS v4u*)(my + idx);
        cgt += bcount(v.x > thr) + bcount(v.y > thr) + bcount(v.z > thr) + bcount(v.w > thr); }
    const int quota = 256 - cgt; int eqseen = 0, nsel = 0;
    for (int base = 0; base < npad; base += 64) { const int idx = base + lane; unsigned u = 0u; if (idx < npad) u = my[idx];
        const bool gt = u > thr, eq = (u == thr);
        const unsigned long long em = __ballot(eq); const int er = eqseen + lane_rank(em);
        const bool sel = gt || (eq && er < quota);
        const unsigned long long sm = __ballot(sel); const int pos = nsel + lane_rank(sm);
        if (sel && pos < 256) lst[pos] = (unsigned short)idx;
        nsel += __popcll(sm); eqseen += __popcll(em); }
}
template <int KMAX> __device__ __forceinline__ void select_cands(const unsigned (&uu)[16], const unsigned (&id)[16], LAS unsigned short* lst, int lane, unsigned lb = 0u) {
    unsigned thr = 0u;
    for (int bit = 31; bit >= 0; --bit) {
        if ((((thr ^ lb) >> bit) >> 1) == 0u && ((lb >> bit) & 1u)) { thr |= (1u << bit); continue; }
        const unsigned cand = thr | (1u << bit); int cnt = 0;
#pragma unroll
        for (int k = 0; k < KMAX; ++k) cnt += bcount(uu[k] >= cand);
        if (cnt >= 256) { thr = cand; if (cnt == 256) break; }
    }
    int cgt = 0, ceq = 0;
#pragma unroll
    for (int k = 0; k < KMAX; ++k) { cgt += bcount(uu[k] > thr); ceq += bcount(uu[k] == thr); }
    const int quota = 256 - cgt; unsigned ilim = 0xFFFFu;
    if (ceq != quota) {
        unsigned I = 0u;
        for (int bit = 12; bit >= 0; --bit) { const unsigned cand = I | (1u << bit); int cnt = 0;
#pragma unroll
            for (int k = 0; k < KMAX; ++k) cnt += bcount(uu[k] == thr && id[k] < cand);
            if (cnt < quota) I = cand; }
        ilim = I;
    }
    int nsel = 0;
#pragma unroll
    for (int k = 0; k < KMAX; ++k) { const bool sel = (uu[k] > thr) || (uu[k] == thr && id[k] <= ilim);
        const unsigned long long sm = __ballot(sel); const int pos = nsel + lane_rank(sm);
        if (sel && pos < 256) lst[pos] = (unsigned short)id[k];
        nsel += __popcll(sm); }
}
__device__ __forceinline__ void dsa2_unit(int b, int qg, const bf16* IQ, const bf16* IK, const float* IW, const bf16* DQ, const bf16* DK, const bf16* DV, bf16* OB, LAS unsigned char* lds, int wave, int lane) {
    LAS unsigned* sc = (LAS unsigned*)lds;
    LAS unsigned short* LST = (LAS unsigned short*)(lds + D2_LST);
    LAS int* CNT = (LAS int*)(lds + D2_CNT);
    LAS unsigned short* CL = (LAS unsigned short*)(lds + D2_CL);
    const int q0 = 4 * qg, r32 = lane & 31, hi = lane >> 5; const size_t rowbase = (size_t)b * SEQ;
    const int ntile = (q0 + 3) / 32 + 1, npad = ntile * 32;
#ifndef REP_A
#define REP_A 1
#define REP_B1 1
#define REP_B2 1
#define REP_C 1
#endif
    for (int repa = 0; repa < REP_A; ++repa)
    {
        const int qi = 2 * ((r32 >> 2) & 1) + (r32 >> 4), hd = 4 * ((r32 >> 3) & 1) + (r32 & 3);
        bf16x8 aq[4];
#pragma unroll
        for (int ks = 0; ks < 4; ++ks) aq[ks] = *(const bf16x8*)(IQ + (rowbase + q0 + qi) * 512 + hd * 64 + ks * 16 + hi * 8);
        const float* w0p = IW + (rowbase + q0 + 2 * hi) * 8;
        const f32x4 w0a = *(const f32x4*)(w0p), w0b = *(const f32x4*)(w0p + 4), w1a = *(const f32x4*)(w0p + 8), w1b = *(const f32x4*)(w0p + 12);
        for (int t = wave; t < ntile; t += 32) {
            bf16x8 bk[4][4];
#pragma unroll
            for (int u = 0; u < 4; ++u) { const int tt = t + 8 * u; const bf16* kr = IK + (rowbase + 32 * (tt < ntile ? tt : t)) * 64 + lane * 8;
#pragma unroll
                for (int ks = 0; ks < 4; ++ks) bk[u][ks] = *(const bf16x8*)(kr + ks * 512); }
#pragma unroll
            for (int u = 0; u < 4; ++u) { const int tt = t + 8 * u;
                if (tt < ntile) {
                    const int key = 32 * tt + r32;
                    f32x16 a;
#pragma unroll
                    for (int r = 0; r < 16; ++r) a[r] = 0.f;
#pragma unroll
                    for (int ks = 0; ks < 4; ++ks) a = __builtin_amdgcn_mfma_f32_32x32x16_bf16(aq[ks], bk[u][ks], a, 0, 0, 0);
                    float s0 = 0.f, s1 = 0.f;
#pragma unroll
                    for (int j = 0; j < 4; ++j) { s0 += w0a[j] * fmaxf(a[j], 0.f); s1 += w1a[j] * fmaxf(a[8 + j], 0.f); }
#pragma unroll
                    for (int j = 0; j < 4; ++j) { s0 += w0b[j] * fmaxf(a[4 + j], 0.f); s1 += w1b[j] * fmaxf(a[12 + j], 0.f); }
                    sc[(2 * hi) * 8192 + key] = (key <= q0 + 2 * hi) ? sortable_u32(s0) : 0u;
                    sc[(2 * hi + 1) * 8192 + key] = (key <= q0 + 2 * hi + 1) ? sortable_u32(s1) : 0u;
                } }
        }
    }
    __syncthreads();
    const int qi = wave & 3, hf = wave >> 2, q = q0 + qi, n = q + 1;
    const LAS unsigned* my = sc + qi * 8192;
    for (int repb = 0; repb < REP_B1; ++repb)
    {
        int c = 0; bool ovf = false;
        if (n > 256) {
            unsigned pivot = 1u;
            if (n > 640) {
                unsigned s[8];
#pragma unroll
                for (int k = 0; k < 8; ++k) s[k] = my[(int)(((unsigned)(lane * 8 + k) * (unsigned)n) >> 9)];
                const int r = (256 * 512 * 7 / 4) / n + 8;
                unsigned t16 = 0u;
                for (int bit = 15; bit >= 0; --bit) { const unsigned cand = (t16 | (1u << bit)) << 16; int cnt = 0;
#pragma unroll
                    for (int k = 0; k < 8; ++k) cnt += bcount(s[k] >= cand);
                    if (cnt >= r) t16 |= (1u << bit); }
                pivot = t16 << 16; if (pivot == 0u) pivot = 1u;
            }
            const int half = ((npad + 511) >> 9) << 8; const int lo = hf * half; const int hiend = (lo + half < npad) ? lo + half : npad;
            LAS unsigned short* cl = CL + wave * 1024;
            for (int i0 = lo; i0 < hiend; i0 += 256) { const int idx = i0 + 4 * lane; v4u v = (v4u){0u, 0u, 0u, 0u}; if (idx < hiend) v = *(const LAS v4u*)(my + idx);
#pragma unroll
                for (int e = 0; e < 4; ++e) { const bool f = v[e] >= pivot; const unsigned long long m = __ballot(f); const int pos = c + lane_rank(m);
                    if (f) { if (pos < 1024) cl[pos] = (unsigned short)(idx + e); }
                    c += __popcll(m); } }
            if (c > 1024) ovf = true;
        }
        if (lane == 0) CNT[wave] = ovf ? -1 : c;
    }
    __syncthreads();
    for (int repb2 = 0; repb2 < REP_B2; ++repb2)
    if (wave < 4) {
        LAS unsigned short* lst = LST + wave * 256; int nsel;
        if (n <= 256) { for (int i = lane; i < n; i += 64) lst[i] = (unsigned short)i; nsel = n; }
        else {
            const int c0 = CNT[wave], c1 = CNT[wave + 4]; const int c = c0 + c1;
            if (c0 < 0 || c1 < 0 || c < 256 || c > 1024) select_full(my, npad, lst, lane);
            else {
                unsigned uu[16], id[16];
#pragma unroll
                for (int k = 0; k < 16; ++k) { const int j = k * 64 + lane; unsigned ix = 0u, u = 0u;
                    if (j < c) { ix = (j < c0) ? (unsigned)CL[wave * 1024 + j] : (unsigned)CL[(wave + 4) * 1024 + (j - c0)]; u = my[ix]; }
                    uu[k] = u; id[k] = ix; }
                if (c <= 512) select_cands<8>(uu, id, lst, lane); else select_cands<16>(uu, id, lst, lane);
            }
            nsel = 256;
        }
        if (lane == 0) CNT[8 + wave] = nsel;
    }
    __syncthreads();
    for (int repc = 0; repc < REP_C; ++repc)
    {
        const int nsel = CNT[8 + qi]; const int j0 = 128 * hf; int cntk = nsel - j0; cntk = cntk < 0 ? 0 : (cntk > 128 ? 128 : cntk);
        const LAS unsigned short* lst = LST + qi * 256;
        LAS unsigned char* tile = lds + wave * 16384;
        LAS float* tf = (LAS float*)tile;
        const int l15 = lane & 15, kq = lane >> 4;
        if (cntk == 0) {
#pragma unroll
            for (int i = 0; i < 8; ++i) tf[i * 64 + lane] = 0.f;
            if (lane < 8) { tf[512 + lane] = -INFINITY; tf[520 + lane] = 0.f; }
        } else {
#pragma unroll
            for (int it = 0; it < 16; ++it) { const int r = 8 * it + (lane >> 3), ch = lane & 7; int j = j0 + r; j = j < nsel ? j : nsel - 1;
                const int idxv = (int)lst[j]; const v4u v = *(const v4u*)(DV + (rowbase + idxv) * 64 + 8 * ch);
                *(LAS v4u*)(tile + r * 128 + ch * 16) = v; }
            bf16x8 qf[2];
#pragma unroll
            for (int ks = 0; ks < 2; ++ks) { v4u z = (v4u){0u, 0u, 0u, 0u}; if (l15 < 8) z = *(const v4u*)(DQ + (rowbase + q) * 512 + l15 * 64 + 32 * ks + 8 * kq); qf[ks] = __builtin_bit_cast(bf16x8, z); }
            f32x4d acc[8];
#pragma unroll
            for (int g = 0; g < 8; ++g) { int j = j0 + 16 * g + l15; j = j < nsel ? j : nsel - 1; const int idxk = (int)lst[j];
                const bf16* kp = DK + (rowbase + idxk) * 64 + 8 * kq;
                const bf16x8 k0 = *(const bf16x8*)(kp), k1 = *(const bf16x8*)(kp + 32);
                f32x4d a = (f32x4d){0.f, 0.f, 0.f, 0.f};
                a = __builtin_amdgcn_mfma_f32_16x16x32_bf16(k0, qf[0], a, 0, 0, 0); a = __builtin_amdgcn_mfma_f32_16x16x32_bf16(k1, qf[1], a, 0, 0, 0); acc[g] = a; }
            float mx = -INFINITY;
#pragma unroll
            for (int g = 0; g < 8; ++g)
#pragma unroll
                for (int e = 0; e < 4; ++e) { if (16 * g + 4 * kq + e >= cntk) acc[g][e] = -INFINITY; mx = fmaxf(mx, acc[g][e]); }
            mx = fmaxf(mx, __shfl_xor(mx, 16)); mx = fmaxf(mx, __shfl_xor(mx, 32));
            float ls = 0.f;
#pragma unroll
            for (int g = 0; g < 8; ++g)
#pragma unroll
                for (int e = 0; e < 4; ++e) { acc[g][e] = __builtin_amdgcn_exp2f(acc[g][e] - mx); ls += acc[g][e]; }
            ls += __shfl_xor(ls, 16); ls += __shfl_xor(ls, 32);
            bf16x8 pa[4];
#pragma unroll
            for (int t = 0; t < 4; ++t) { v4u w; w.x = cvtpk(acc[2 * t][0], acc[2 * t][1]); w.y = cvtpk(acc[2 * t][2], acc[2 * t][3]); w.z = cvtpk(acc[2 * t + 1][0], acc[2 * t + 1][1]); w.w = cvtpk(acc[2 * t + 1][2], acc[2 * t + 1][3]); pa[t] = __builtin_bit_cast(bf16x8, w); }
            f32x4d o[4];
            const int q_ = l15 >> 2, p_ = lane & 3;
#pragma unroll
            for (int cb = 0; cb < 4; ++cb) { f32x4d oc = (f32x4d){0.f, 0.f, 0.f, 0.f};
#pragma unroll
                for (int t = 0; t < 4; ++t) {
                    const LAS unsigned char* a1 = tile + (32 * t + 4 * kq + q_) * 128 + (16 * cb + 4 * p_) * 2;
                    const v4i16_t lo4 = __builtin_amdgcn_ds_read_tr16_b64_v4i16((LAS v4i16_t*)a1), hi4 = __builtin_amdgcn_ds_read_tr16_b64_v4i16((LAS v4i16_t*)(a1 + 16 * 128));
                    const bf16x8 vf = (bf16x8){lo4[0], lo4[1], lo4[2], lo4[3], hi4[0], hi4[1], hi4[2], hi4[3]};
                    oc = __builtin_amdgcn_mfma_f32_16x16x32_bf16(pa[t], vf, oc, 0, 0, 0); }
                o[cb] = oc; }
            if (kq < 2) {
#pragma unroll
                for (int cb = 0; cb < 4; ++cb)
#pragma unroll
                    for (int e = 0; e < 4; ++e) tf[(4 * kq + e) * 64 + 16 * cb + l15] = o[cb][e];
            }
            if (lane < 8) { tf[512 + lane] = mx; tf[520 + lane] = ls; }
        }
    }
    __syncthreads();
    if (wave < 4) {
        const LAS float* ta = (const LAS float*)(lds + wave * 16384); const LAS float* tb = (const LAS float*)(lds + (wave + 4) * 16384);
        const int h = lane >> 3, d0 = (lane & 7) * 8;
        const float ma = ta[512 + h], mb = tb[512 + h], la = ta[520 + h], lb = tb[520 + h];
        const float m = fmaxf(ma, mb), fa = __builtin_amdgcn_exp2f(ma - m), fb = __builtin_amdgcn_exp2f(mb - m);
        const float inv = 1.0f / (la * fa + lb * fb);
        const f32x4 a0 = *(const LAS f32x4*)(ta + h * 64 + d0), a1 = *(const LAS f32x4*)(ta + h * 64 + d0 + 4), b0 = *(const LAS f32x4*)(tb + h * 64 + d0), b1 = *(const LAS f32x4*)(tb + h * 64 + d0 + 4);
        const f32x4 r0 = (a0 * fa + b0 * fb) * inv, r1 = (a1 * fa + b1 * fb) * inv;
        v4u w; w.x = cvtpk(r0[0], r0[1]); w.y = cvtpk(r0[2], r0[3]); w.z = cvtpk(r1[0], r1[1]); w.w = cvtpk(r1[2], r1[3]);
        *(v4u*)(OB + (rowbase + q) * 512 + h * 64 + d0) = w;
    }
    __syncthreads();
}
constexpr int D3_RING = RING_BYTES + 1024;
constexpr int D3_LST = D3_RING + 16384;
constexpr int D3_CNT = D3_LST + 8192;
constexpr int D3_QW = D3_CNT + 512;
typedef unsigned long long u64d;
template <int KMAX> __device__ __forceinline__ void select_cands3(const unsigned (&uu)[16], const unsigned (&id)[16], LAS unsigned short* lst, int lane) { select_cands<KMAX>(uu, id, lst, lane); }
__device__ __forceinline__ void dsa3_unit(int b, int g16, const bf16* IQ, const bf16* IK, const float* IW, const bf16* DQ, const bf16* DK, const bf16* DV, bf16* OB, LAS unsigned char* lds, int wave, int lane_in) {
    int lane = lane_in; asm volatile("" : "+v"(lane));
    LAS u64d* LISTS = (LAS u64d*)lds;
    LAS unsigned short* LST = (LAS unsigned short*)(lds + D3_LST);
    LAS int* CNT = (LAS int*)(lds + D3_CNT);
    const int tid = wave * 64 + lane, r32 = lane & 31, hi = lane >> 5; const size_t rowbase = (size_t)b * SEQ;
    const int q0 = 16 * g16, ntile = (q0 + 15) / 32 + 1, nstep = (ntile + 1) >> 1;
    const int qgrp = wave & 3, par = wave >> 2;
    const int qA = q0 + 4 * qgrp + 2 * hi, qB = qA + 1;
    const int qi = 2 * ((r32 >> 2) & 1) + (r32 >> 4), hd = 4 * ((r32 >> 3) & 1) + (r32 & 3);
    bf16x8 aq[4];
#pragma unroll
    for (int ks = 0; ks < 4; ++ks) aq[ks] = *(const bf16x8*)(IQ + (rowbase + q0 + 4 * qgrp + qi) * 512 + hd * 64 + ks * 16 + hi * 8);
    const float* w0p = IW + (rowbase + qA) * 8;
    const f32x4 w0a = *(const f32x4*)(w0p), w0b = *(const f32x4*)(w0p + 4), w1a = *(const f32x4*)(w0p + 8), w1b = *(const f32x4*)(w0p + 12);
    f32x4 l0a, l0b, l1a, l1b;
#pragma unroll
    for (int j = 0; j < 4; ++j) { l0a[j] = w0a[j] >= 0.f ? INFINITY : -INFINITY; l0b[j] = w0b[j] >= 0.f ? INFINITY : -INFINITY; l1a[j] = w1a[j] >= 0.f ? INFINITY : -INFINITY; l1b[j] = w1b[j] >= 0.f ? INFINITY : -INFINITY; }
#define D3_SCORE(BK, S0, S1) do { f32x16 a_; _Pragma("unroll") for (int r = 0; r < 16; ++r) a_[r] = 0.f; \
        _Pragma("unroll") for (int ks = 0; ks < 4; ++ks) a_ = __builtin_amdgcn_mfma_f32_32x32x16_bf16(aq[ks], BK[ks], a_, 0, 0, 0); \
        S0 = 0.f; S1 = 0.f; \
        _Pragma("unroll") for (int j = 0; j < 4; ++j) { S0 += __builtin_amdgcn_fmed3f(w0a[j] * a_[j], 0.f, l0a[j]); S1 += __builtin_amdgcn_fmed3f(w1a[j] * a_[8 + j], 0.f, l1a[j]); } \
        _Pragma("unroll") for (int j = 0; j < 4; ++j) { S0 += __builtin_amdgcn_fmed3f(w0b[j] * a_[4 + j], 0.f, l0b[j]); S1 += __builtin_amdgcn_fmed3f(w1b[j] * a_[12 + j], 0.f, l1b[j]); } } while (0)
#ifndef REP_S
#define REP_S 1
#define REP_M 1
#define REP_B 1
#define REP_CD 1
#endif
    unsigned pivA = 1u, pivB = 1u;
    if (ntile <= 16 && tid < 16) CNT[64 + tid] = 0;
    for (int reps = 0; reps < REP_S; ++reps)
    if (ntile > 16) {
#pragma unroll
        for (int k = 0; k < 4; ++k) { const int c = tid + 512 * k; const int ts = ((c >> 8) * ntile) >> 3;
            *(LAS v4u*)(lds + c * 16) = *(const v4u*)(IK + (rowbase + 32 * ts) * 64 + (c & 255) * 8); }
        __syncthreads();
        unsigned uA[8], uB[8];
#pragma unroll
        for (int i = 0; i < 8; ++i) { bf16x8 bk[4];
#pragma unroll
            for (int ks = 0; ks < 4; ++ks) bk[ks] = *(const LAS bf16x8*)(lds + i * 4096 + ks * 1024 + lane * 16);
            float s0, s1; D3_SCORE(bk, s0, s1); uA[i] = sortable_u32(s0); uB[i] = sortable_u32(s1); asm volatile("" ::: "memory"); }
        const int qs = q0 + 4 * qgrp + par;
        const int r0 = (256 * 256 * 7 / 4) / (qs + 1) + 6, r1 = (256 * 256 * 7 / 4) / (qs + 3) + 6;
        unsigned us[8];
#pragma unroll
        for (int i = 0; i < 8; ++i) us[i] = par ? uB[i] : uA[i];
        unsigned t0 = 0u, t1 = 0u;
        for (int bit = 15; bit >= 0; --bit) {
            const unsigned c = ((hi ? t1 : t0) | (1u << bit)) << 16; int n0 = 0, n1 = 0;
#pragma unroll
            for (int i = 0; i < 8; ++i) { const unsigned long long m = __builtin_amdgcn_ballot_w64(us[i] >= c); n0 += __popc((unsigned)m); n1 += __popc((unsigned)(m >> 32)); }
            if (n0 >= r0) t0 |= (1u << bit);
            if (n1 >= r1) t1 |= (1u << bit);
        }
        LAS unsigned* PV = (LAS unsigned*)(CNT + 64);
        if (lane == 0) { PV[4 * qgrp + par] = t0; PV[4 * qgrp + 2 + par] = t1; }
        __syncthreads();
        const unsigned tA = PV[4 * qgrp + 2 * hi], tB = PV[4 * qgrp + 2 * hi + 1];
        pivA = tA << 16; pivB = tB << 16; if (pivA == 0u) pivA = 1u; if (pivB == 0u) pivB = 1u;
        __syncthreads();
    }
    for (int repm = 0; repm < REP_M; ++repm)
    {
        const bf16* src0 = IK + rowbase * 64 + (size_t)(tid & 255) * 8;
#define D3_LOAD(k_) (*(const v4u*)(src0 + (size_t)32 * ((2 * (k_) + (tid >> 8)) < ntile ? (2 * (k_) + (tid >> 8)) : ntile - 1) * 64))
        v4u st0 = (v4u){0u, 0u, 0u, 0u}, st1 = st0, st2 = st0, st3 = st0;
        st0 = D3_LOAD(0); st1 = D3_LOAD(1); st2 = D3_LOAD(2); st3 = D3_LOAD(3);
        *(LAS v4u*)(lds + D3_RING + tid * 16) = st0;
        __syncthreads();
        int cntA = 0, cntB = 0;
        LAS u64d* lA = LISTS + ((4 * qgrp + 2 * hi) * 2 + par) * 512; LAS u64d* lB = lA + 1024;
        f32x16 acc;
#pragma unroll
        for (int r = 0; r < 16; ++r) acc[r] = 0.f;
#define D3_SUMS(S0, S1) do { S0 = 0.f; S1 = 0.f; \
            _Pragma("unroll") for (int j = 0; j < 4; ++j) { S0 += __builtin_amdgcn_fmed3f(w0a[j] * acc[j], 0.f, l0a[j]); S1 += __builtin_amdgcn_fmed3f(w1a[j] * acc[8 + j], 0.f, l1a[j]); } \
            _Pragma("unroll") for (int j = 0; j < 4; ++j) { S0 += __builtin_amdgcn_fmed3f(w0b[j] * acc[4 + j], 0.f, l0b[j]); S1 += __builtin_amdgcn_fmed3f(w1b[j] * acc[12 + j], 0.f, l1b[j]); } } while (0)
#define D3_FILTER(TP, S0, S1) do { const int key = 32 * (TP) + r32; const unsigned u0 = sortable_u32(S0), u1 = sortable_u32(S1); \
                { const bool ps = (key <= qA) && (u0 >= pivA); const unsigned long long m = __ballot(ps); const unsigned ml = (unsigned)m, mh = (unsigned)(m >> 32); \
                  const int pos = cntA + (int)__builtin_amdgcn_mbcnt_hi(mh, __builtin_amdgcn_mbcnt_lo(ml, 0u)) - (hi ? __popc(ml) : 0); \
                  if (ps && pos < 512) lA[pos] = ((u64d)(unsigned)key << 32) | u0; cntA += hi ? __popc(mh) : __popc(ml); } \
                { const bool ps = (key <= qB) && (u1 >= pivB); const unsigned long long m = __ballot(ps); const unsigned ml = (unsigned)m, mh = (unsigned)(m >> 32); \
                  const int pos = cntB + (int)__builtin_amdgcn_mbcnt_hi(mh, __builtin_amdgcn_mbcnt_lo(ml, 0u)) - (hi ? __popc(ml) : 0); \
                  if (ps && pos < 512) lB[pos] = ((u64d)(unsigned)key << 32) | u1; cntB += hi ? __popc(mh) : __popc(ml); } } while (0)
#define D3_STEP(k_, STNEXT, STFREE) do { \
            STFREE = D3_LOAD((k_) + 4); \
            const int tp_ = 2 * (k_) - 2 + par; \
            const LAS unsigned char* sb = lds + D3_RING + ((k_) & 1) * 8192 + par * 4096; bf16x8 bk[4]; \
            _Pragma("unroll") for (int ks = 0; ks < 4; ++ks) bk[ks] = *(const LAS bf16x8*)(sb + ks * 1024 + lane * 16); \
            __builtin_amdgcn_sched_barrier(0); \
            float s0, s1; D3_SUMS(s0, s1); asm volatile("" : "+v"(s0), "+v"(s1));     \
            __builtin_amdgcn_sched_barrier(0); \
            _Pragma("unroll") for (int r = 0; r < 16; ++r) acc[r] = 0.f; \
            _Pragma("unroll") for (int ks = 0; ks < 4; ++ks) acc = __builtin_amdgcn_mfma_f32_32x32x16_bf16(aq[ks], bk[ks], acc, 0, 0, 0); \
            __builtin_amdgcn_sched_barrier(0); \
            if (tp_ >= 0 && tp_ < ntile) D3_FILTER(tp_, s0, s1); \
            *(LAS v4u*)(lds + D3_RING + (((k_) + 1) & 1) * 8192 + tid * 16) = STNEXT; \
            asm volatile("s_waitcnt lgkmcnt(0)" ::: "memory"); __builtin_amdgcn_s_barrier(); asm volatile("" ::: "memory"); } while (0)
        int kend = 0;
        for (int k = 0; k < nstep; k += 4) {
            D3_STEP(k, st1, st0); D3_STEP(k + 1, st2, st1); D3_STEP(k + 2, st3, st2); D3_STEP(k + 3, st0, st3); kend = k + 4;
        }
        {   const int tp_ = 2 * kend - 2 + par; if (tp_ < ntile) { float s0, s1; D3_SUMS(s0, s1); D3_FILTER(tp_, s0, s1); } }
#undef D3_SUMS
#undef D3_FILTER
#undef D3_STEP
#undef D3_LOAD
        if (r32 == 0) { CNT[(4 * qgrp + 2 * hi) * 2 + par] = cntA; CNT[(4 * qgrp + 2 * hi + 1) * 2 + par] = cntB; }
        if (tid < 4) CNT[48 + tid] = 0;
    }
#undef D3_SCORE
    __syncthreads();
#if defined(DBG_D3_STAGE) && DBG_D3_STAGE == 1
    for (int grp = 0; grp < 4; ++grp) dsa2_unit(b, 4 * g16 + grp, IQ, IK, IW, DQ, DK, DV, OB, lds, wave, lane);
    return;
#endif
#pragma unroll 1
    for (int rr = 0; rr < 2 * REP_B; ++rr) {
        const int qx = wave + 8 * (rr & 1), q = q0 + qx, n = q + 1; LAS unsigned short* lst = LST + qx * 256; int nsel;
        if (n <= 256) { for (int i = lane; i < n; i += 64) lst[i] = (unsigned short)i; nsel = n; }
        else {
            const int c0 = CNT[2 * qx], c1 = CNT[2 * qx + 1]; const int c = c0 + c1;
#ifdef DBG_D3_ALLFAIL
            if (true) { if (lane == 0) CNT[48 + (qx >> 2)] = 1; nsel = 0; }
#else
            if (c0 > 512 || c1 > 512 || c < 256) { if (lane == 0) CNT[48 + (qx >> 2)] = 1; nsel = 0; }
#endif
            else {
                unsigned uu[16], id[16]; const LAS u64d* L0 = LISTS + (qx * 2) * 512; const LAS u64d* L1 = L0 + 512;
#pragma unroll
                for (int k = 0; k < 16; ++k) { const int j = k * 64 + lane, jj = j < c ? j : c - 1;
                    const u64d e = *((jj < c0) ? (L0 + jj) : (L1 + (jj - c0))); uu[k] = j < c ? (unsigned)e : 0u; id[k] = (unsigned)(e >> 32); }
                const unsigned lb = (unsigned)CNT[64 + qx] << 16;
                if (c <= 512) select_cands<8>(uu, id, lst, lane, lb); else if (c <= 640) select_cands<10>(uu, id, lst, lane, lb); else if (c <= 768) select_cands<12>(uu, id, lst, lane, lb); else select_cands<16>(uu, id, lst, lane, lb);
                nsel = 256;
            }
        }
        if (lane == 0) CNT[32 + qx] = nsel;
    }
    __syncthreads();
#pragma unroll 1
    for (int rr_ = 0; rr_ < 2 * REP_CD; ++rr_) { const int rr = rr_ & 1;
        const int qx = wave + 8 * rr, q = q0 + qx; const int nsel = CNT[32 + qx];
        const LAS unsigned short* lst = LST + qx * 256;
        LAS unsigned char* tile = lds + wave * 16384; LAS float* tf = (LAS float*)tile;
        const int l15 = lane & 15, kq = lane >> 4, q_ = l15 >> 2, p_ = lane & 3;
        bf16x8 qf[2];
#pragma unroll
        for (int ks = 0; ks < 2; ++ks) { v4u z = (v4u){0u, 0u, 0u, 0u}; if (l15 < 8) z = *(const v4u*)(DQ + (rowbase + q) * 512 + l15 * 64 + 32 * ks + 8 * kq); qf[ks] = __builtin_bit_cast(bf16x8, z); }
        float mrun = -INFINITY, lrun = 0.f; f32x4d orun[4];
#pragma unroll
        for (int cb = 0; cb < 4; ++cb) orun[cb] = (f32x4d){0.f, 0.f, 0.f, 0.f};
#pragma unroll 1
        for (int hf = 0; hf < 2; ++hf) {
            const int j0 = 128 * hf; int cntk = nsel - j0; cntk = cntk > 128 ? 128 : cntk;
            if (cntk <= 0) break;
            int iv[16], ik[8];
#pragma unroll
            for (int it = 0; it < 16; ++it) { int j = j0 + 8 * it + (lane >> 3); j = j < nsel ? j : nsel - 1; iv[it] = (int)lst[j]; }
#pragma unroll
            for (int g = 0; g < 8; ++g) { int j = j0 + 16 * g + l15; j = j < nsel ? j : nsel - 1; ik[g] = (int)lst[j]; }
            asm volatile("s_waitcnt lgkmcnt(0)" ::: "memory");
#pragma unroll
            for (int it = 0; it < 16; ++it)
                __builtin_amdgcn_global_load_lds((const unsigned*)(DV + (rowbase + iv[it]) * 64 + 8 * (lane & 7)), (LAS unsigned*)(tile + it * 1024), 16, 0, 0);
            bf16x8 kk0[8], kk1[8];
#pragma unroll
            for (int g = 0; g < 8; ++g) { const bf16* kp = DK + (rowbase + ik[g]) * 64 + 8 * kq; kk0[g] = *(const bf16x8*)(kp); kk1[g] = *(const bf16x8*)(kp + 32); }
            asm volatile("" ::: "memory");
            f32x4d acc[8];
#pragma unroll
            for (int g = 0; g < 8; ++g) { f32x4d a = (f32x4d){0.f, 0.f, 0.f, 0.f};
                a = __builtin_amdgcn_mfma_f32_16x16x32_bf16(kk0[g], qf[0], a, 0, 0, 0); a = __builtin_amdgcn_mfma_f32_16x16x32_bf16(kk1[g], qf[1], a, 0, 0, 0); acc[g] = a; }
            float mx = -INFINITY;
#pragma unroll
            for (int g = 0; g < 8; ++g)
#pragma unroll
                for (int e = 0; e < 4; ++e) { if (16 * g + 4 * kq + e >= cntk) acc[g][e] = -INFINITY; mx = fmaxf(mx, acc[g][e]); }
            mx = fmaxf(mx, __shfl_xor(mx, 16)); mx = fmaxf(mx, __shfl_xor(mx, 32));
            const float mnew = fmaxf(mrun, mx), fold = __builtin_amdgcn_exp2f(mrun - mnew);
            float ls = 0.f;
#pragma unroll
            for (int g = 0; g < 8; ++g)
#pragma unroll
                for (int e = 0; e < 4; ++e) { acc[g][e] = __builtin_amdgcn_exp2f(acc[g][e] - mnew); ls += acc[g][e]; }
            ls += __shfl_xor(ls, 16); ls += __shfl_xor(ls, 32);
            lrun = lrun * fold + ls; mrun = mnew;
            float fo[4];
#pragma unroll
            for (int e = 0; e < 4; ++e) fo[e] = __shfl(fold, 4 * kq + e);
            asm volatile("s_waitcnt vmcnt(0)" ::: "memory");
            bf16x8 pa[4];
#pragma unroll
            for (int t = 0; t < 4; ++t) { v4u w; w.x = cvtpk(acc[2 * t][0], acc[2 * t][1]); w.y = cvtpk(acc[2 * t][2], acc[2 * t][3]); w.z = cvtpk(acc[2 * t + 1][0], acc[2 * t + 1][1]); w.w = cvtpk(acc[2 * t + 1][2], acc[2 * t + 1][3]); pa[t] = __builtin_bit_cast(bf16x8, w); }
#pragma unroll
            for (int cb = 0; cb < 4; ++cb) { f32x4d oc = orun[cb];
#pragma unroll
                for (int e = 0; e < 4; ++e) oc[e] *= fo[e];
#pragma unroll
                for (int t = 0; t < 4; ++t) {
                    const LAS unsigned char* a1 = tile + (32 * t + 4 * kq + q_) * 128 + (16 * cb + 4 * p_) * 2;
                    const v4i16_t lo4 = __builtin_amdgcn_ds_read_tr16_b64_v4i16((LAS v4i16_t*)a1), hi4 = __builtin_amdgcn_ds_read_tr16_b64_v4i16((LAS v4i16_t*)(a1 + 16 * 128));
                    const bf16x8 vf = (bf16x8){lo4[0], lo4[1], lo4[2], lo4[3], hi4[0], hi4[1], hi4[2], hi4[3]};
                    oc = __builtin_amdgcn_mfma_f32_16x16x32_bf16(pa[t], vf, oc, 0, 0, 0); }
                orun[cb] = oc; }
        }
        float li[4];
#pragma unroll
        for (int e = 0; e < 4; ++e) li[e] = 1.0f / __shfl(lrun, 4 * kq + e);
        if (kq < 2) {
#pragma unroll
            for (int cb = 0; cb < 4; ++cb)
#pragma unroll
                for (int e = 0; e < 4; ++e) tf[(4 * kq + e) * 64 + 16 * cb + l15] = orun[cb][e] * li[e];
        }
        { const int h = lane >> 3, d0 = (lane & 7) * 8;
          const f32x4 r0 = *(const LAS f32x4*)(tf + h * 64 + d0), r1 = *(const LAS f32x4*)(tf + h * 64 + d0 + 4);
          v4u w; w.x = cvtpk(r0[0], r0[1]); w.y = cvtpk(r0[2], r0[3]); w.z = cvtpk(r1[0], r1[1]); w.w = cvtpk(r1[2], r1[3]);
          *(v4u*)(OB + (rowbase + q) * 512 + h * 64 + d0) = w; }
    }
    __syncthreads();
    const int f0 = CNT[48], f1 = CNT[49], f2 = CNT[50], f3 = CNT[51];
    __syncthreads();
    const int fm = (f0 ? 1 : 0) | (f1 ? 2 : 0) | (f2 ? 4 : 0) | (f3 ? 8 : 0);
#pragma unroll 1
    for (int grp = 0; grp < 4; ++grp) if ((fm >> grp) & 1) dsa2_unit(b, 4 * g16 + grp, IQ, IK, IW, DQ, DK, DV, OB, lds, wave, lane);
}
__device__ __forceinline__ void fox_unit2(int bh, int qb, const bf16* FQ, const bf16* FK, const bf16* FV, const float* CUM, const int* T0, bf16* OA, LAS unsigned char* lds, int wave, int lane) {
    const int b = bh >> 3, h = bh & 7, r32 = lane & 31, hi = lane >> 5; const size_t rowbase = (size_t)b * SEQ; const int q0 = qb * 256 + wave * 32;
    const bf16* Qw = FQ + (rowbase + q0) * 512 + h * 64; bf16* Ow = OA + (rowbase + q0) * 512 + h * 64;
    const bf16* Kp = FK + rowbase * 512 + h * 64; const bf16* Vp = FV + rowbase * 512 + h * 64; const float* cb = CUM + (size_t)bh * SEQ;
    LAS unsigned char* wl = lds + wave * 16384;
    LAS float* bl = (LAS float*)(lds + RING_BYTES + 8192 + wave * 256);
    bf16x8 qr[4];
#pragma unroll
    for (int ks = 0; ks < 4; ++ks) qr[ks] = *(const bf16x8*)(Qw + (size_t)r32 * 512 + ks * 16 + hi * 8);
    const int tstart = T0[bh * 256 + q0 / 32], ntiles = q0 / 32 + 1, qlocal = q0 + r32;
    f32x16 o[2];
#pragma unroll
    for (int d0 = 0; d0 < 2; ++d0)
#pragma unroll
        for (int r = 0; r < 16; ++r) o[d0][r] = 0.f;
    float m = -1e30f, l = 0.f;
    const int lrow = lane >> 3, lch = lane & 7;
#define FOX_LOAD(KR, VR, BR, tt) do { _Pragma("unroll") for (int it = 0; it < 4; ++it) { const size_t ro = (size_t)(32 * (tt) + 8 * it + lrow) * 512 + lch * 8; KR[it] = *(const v4u*)(Kp + ro); VR[it] = *(const v4u*)(Vp + ro); } BR = cb[32 * (tt) + r32]; } while (0)
#define FOX_STORE(KR, VR, BR, bf) do { _Pragma("unroll") for (int it = 0; it < 4; ++it) { const int row = 8 * it + lrow; *(LAS v4u*)(wl + (bf) * 4096 + row * 128 + ((lch ^ (row & 7)) * 16)) = KR[it]; *(LAS v4u*)(wl + 8192 + (bf) * 4096 + row * 128 + lch * 16) = VR[it]; } if (lane < 32) bl[(bf) * 32 + lane] = -L2E * BR; } while (0)
    v4u krA[4], vrA[4], krB[4], vrB[4]; float brA = 0.f, brB = 0.f;
    const int kq = (lane >> 4) & 1, q_ = (lane & 15) >> 2, p_ = lane & 3;
    FOX_LOAD(krA, vrA, brA, tstart);
    if (tstart + 1 < ntiles) FOX_LOAD(krB, vrB, brB, tstart + 1);
    FOX_STORE(krA, vrA, brA, 0);
    auto compute = [&](int t, int buf) {
        const LAS unsigned char* kb = wl + buf * 4096; const LAS unsigned char* vb = wl + 8192 + buf * 4096; const LAS float* bb = bl + buf * 32;
        f32x16 p;
#pragma unroll
        for (int r = 0; r < 16; ++r) p[r] = 0.f;
#pragma unroll
        for (int ks = 0; ks < 4; ++ks) { const bf16x8 kf = *(const LAS bf16x8*)(kb + r32 * 128 + (((2 * ks + hi) ^ (r32 & 7)) * 16)); p = __builtin_amdgcn_mfma_f32_32x32x16_bf16(kf, qr[ks], p, 0, 0, 0); }
#pragma unroll
        for (int g = 0; g < 4; ++g) { const f32x4 c4 = *(const LAS f32x4*)(bb + 8 * g + 4 * hi);
#pragma unroll
            for (int jj = 0; jj < 4; ++jj) p[4 * g + jj] += c4[jj]; }
        if (t == ntiles - 1) {
#pragma unroll
            for (int r = 0; r < 16; ++r) if (32 * t + crow(r, hi) > qlocal) p[r] = -INFINITY;
        }
        float mt = p[0];
#pragma unroll
        for (int r = 1; r < 16; ++r) mt = fmaxf(mt, p[r]);
        mt = fmaxf(mt, __shfl_xor(mt, 32));
        const float mn = fmaxf(m, mt); const float alpha = __builtin_amdgcn_exp2f(m - mn); m = mn;
        l *= alpha;
#pragma unroll
        for (int d0 = 0; d0 < 2; ++d0)
#pragma unroll
            for (int r = 0; r < 16; ++r) o[d0][r] *= alpha;
        float ls = 0.f;
#pragma unroll
        for (int r = 0; r < 16; ++r) { p[r] = __builtin_amdgcn_exp2f(p[r] - mn); ls += p[r]; }
        l += ls;
        bf16x8 pa[2];
#pragma unroll
        for (int s2 = 0; s2 < 2; ++s2) { v4u w; w.x = cvtpk(p[8 * s2 + 0], p[8 * s2 + 1]); w.y = cvtpk(p[8 * s2 + 2], p[8 * s2 + 3]); w.z = cvtpk(p[8 * s2 + 4], p[8 * s2 + 5]); w.w = cvtpk(p[8 * s2 + 6], p[8 * s2 + 7]); pa[s2] = __builtin_bit_cast(bf16x8, w); }
#pragma unroll
        for (int d0 = 0; d0 < 2; ++d0)
#pragma unroll
            for (int s2 = 0; s2 < 2; ++s2) {
                const LAS unsigned char* a1 = vb + (16 * s2 + 4 * hi + q_) * 128 + (32 * d0 + 16 * kq + 4 * p_) * 2;
                const v4i16_t lo4 = __builtin_amdgcn_ds_read_tr16_b64_v4i16((LAS v4i16_t*)a1), hi4 = __builtin_amdgcn_ds_read_tr16_b64_v4i16((LAS v4i16_t*)(a1 + 8 * 128));
                const bf16x8 vf = (bf16x8){lo4[0], lo4[1], lo4[2], lo4[3], hi4[0], hi4[1], hi4[2], hi4[3]};
                o[d0] = __builtin_amdgcn_mfma_f32_32x32x16_bf16(vf, pa[s2], o[d0], 0, 0, 0);
            }
    };
    for (int t = tstart; t < ntiles; t += 2) {
        if (t + 2 < ntiles) FOX_LOAD(krA, vrA, brA, t + 2);
        compute(t, 0);
        if (t + 1 < ntiles) {
            FOX_STORE(krB, vrB, brB, 1);
            if (t + 3 < ntiles) FOX_LOAD(krB, vrB, brB, t + 3);
            compute(t + 1, 1);
            if (t + 2 < ntiles) FOX_STORE(krA, vrA, brA, 0);
        }
    }
#undef FOX_LOAD
#undef FOX_STORE
    l += __shfl_xor(l, 32);
    const float inv = 1.0f / l;
    bf16* orow = Ow + (size_t)r32 * 512;
#pragma unroll
    for (int d0 = 0; d0 < 2; ++d0)
#pragma unroll
        for (int g = 0; g < 4; ++g) { u32x2 w; w.x = cvtpk(o[d0][4 * g] * inv, o[d0][4 * g + 1] * inv); w.y = cvtpk(o[d0][4 * g + 2] * inv, o[d0][4 * g + 3] * inv);
            *(u32x2*)(orow + d0 * 32 + 8 * g + 4 * hi) = w; }
}
__device__ __forceinline__ void fox_unit4(int bh, int qb, const bf16* FQ, const bf16* FK, const bf16* FV, const float* CUM, const int* T0, const float* gq, const float* gk, bf16* OA, LAS unsigned char* lds, int wave, int lane) {
    const int b = bh >> 3, h = bh & 7, r32 = lane & 31, hi = lane >> 5; const size_t rowbase = (size_t)b * SEQ; const int q0 = qb * 256 + wave * 32;
    const bf16* Qw = FQ + (rowbase + q0) * 512 + h * 64; bf16* Ow = OA + (rowbase + q0) * 512 + h * 64;
    const bf16* Kp = FK + rowbase * 512 + h * 64; const bf16* Vp = FV + rowbase * 512 + h * 64; const float* cb = CUM + (size_t)bh * SEQ;
    LAS unsigned char* wl = lds + wave * 16384;
    LAS float* bl = (LAS float*)(lds + RING_BYTES + 8192 + wave * 256);
    bf16x8 qr[4];
#pragma unroll
    for (int ks = 0; ks < 4; ++ks) qr[ks] = *(const bf16x8*)(Qw + (size_t)r32 * 512 + ks * 16 + hi * 8);
    const int tstart = T0[bh * 256 + q0 / 32], tlast = q0 / 32, nseq = tlast - tstart + 1, qlocal = q0 + r32;
    const float stopc = (8.0f * wave_max(fabsf(gq[lane])) * wave_max(fabsf(gk[lane])) + 30.0f) * L2E;
    f32x16 o[2];
#pragma unroll
    for (int d0 = 0; d0 < 2; ++d0)
#pragma unroll
        for (int r = 0; r < 16; ++r) o[d0][r] = 0.f;
    float m = -1e30f, l = 0.f;
    const int lrow = lane >> 3, lch = lane & 7;
#define FOX_LOAD(KR, VR, BR, tt) do { _Pragma("unroll") for (int it = 0; it < 4; ++it) { const size_t ro = (size_t)(32 * (tt) + 8 * it + lrow) * 512 + lch * 8; KR[it] = *(const v4u*)(Kp + ro); VR[it] = *(const v4u*)(Vp + ro); } BR = cb[32 * (tt) + r32]; } while (0)
#define FOX_STORE(KR, VR, BR, bf) do { _Pragma("unroll") for (int it = 0; it < 4; ++it) { const int row = 8 * it + lrow; *(LAS v4u*)(wl + (bf) * 4096 + row * 128 + ((lch ^ (row & 7)) * 16)) = KR[it]; *(LAS v4u*)(wl + 8192 + (bf) * 4096 + row * 128 + lch * 16) = VR[it]; } if (lane < 32) bl[(bf) * 32 + lane] = -L2E * BR; } while (0)
    v4u krA[4], vrA[4], krB[4], vrB[4]; float brA = 0.f, brB = 0.f;
    const int kq = (lane >> 4) & 1, q_ = (lane & 15) >> 2, p_ = lane & 3;
    FOX_LOAD(krA, vrA, brA, tlast);
    if (1 < nseq) FOX_LOAD(krB, vrB, brB, tlast - 1);
    FOX_STORE(krA, vrA, brA, 0);
    auto compute = [&](int t, int buf) -> bool {
        const LAS unsigned char* kb = wl + buf * 4096; const LAS unsigned char* vb = wl + 8192 + buf * 4096; const LAS float* bb = bl + buf * 32;
        if (t != tlast) { const float bmax = bb[31]; if (__all(m > bmax + stopc)) return true; }
        f32x16 p;
#pragma unroll
        for (int r = 0; r < 16; ++r) p[r] = 0.f;
#pragma unroll
        for (int ks = 0; ks < 4; ++ks) { const bf16x8 kf = *(const LAS bf16x8*)(kb + r32 * 128 + (((2 * ks + hi) ^ (r32 & 7)) * 16)); p = __builtin_amdgcn_mfma_f32_32x32x16_bf16(kf, qr[ks], p, 0, 0, 0); }
#pragma unroll
        for (int g = 0; g < 4; ++g) { const f32x4 c4 = *(const LAS f32x4*)(bb + 8 * g + 4 * hi);
#pragma unroll
            for (int jj = 0; jj < 4; ++jj) p[4 * g + jj] += c4[jj]; }
        if (t == tlast) {
#pragma unroll
            for (int r = 0; r < 16; ++r) if (32 * t + crow(r, hi) > qlocal) p[r] = -INFINITY;
        }
        float mt = p[0];
#pragma unroll
        for (int r = 1; r < 16; ++r) mt = fmaxf(mt, p[r]);
        mt = fmaxf(mt, __shfl_xor(mt, 32));
        if (__any(mt > m)) {
            const float mn = fmaxf(m, mt); const float alpha = __builtin_amdgcn_exp2f(m - mn); m = mn;
            l *= alpha;
#pragma unroll
            for (int d0 = 0; d0 < 2; ++d0)
#pragma unroll
                for (int r = 0; r < 16; ++r) o[d0][r] *= alpha;
        }
        const float mn = m;
        float ls = 0.f;
#pragma unroll
        for (int r = 0; r < 16; ++r) { p[r] = __builtin_amdgcn_exp2f(p[r] - mn); ls += p[r]; }
        l += ls;
        bf16x8 pa[2];
#pragma unroll
        for (int s2 = 0; s2 < 2; ++s2) { v4u w; w.x = cvtpk(p[8 * s2 + 0], p[8 * s2 + 1]); w.y = cvtpk(p[8 * s2 + 2], p[8 * s2 + 3]); w.z = cvtpk(p[8 * s2 + 4], p[8 * s2 + 5]); w.w = cvtpk(p[8 * s2 + 6], p[8 * s2 + 7]); pa[s2] = __builtin_bit_cast(bf16x8, w); }
#pragma unroll
        for (int d0 = 0; d0 < 2; ++d0)
#pragma unroll
            for (int s2 = 0; s2 < 2; ++s2) {
                const LAS unsigned char* a1 = vb + (16 * s2 + 4 * hi + q_) * 128 + (32 * d0 + 16 * kq + 4 * p_) * 2;
                const v4i16_t lo4 = __builtin_amdgcn_ds_read_tr16_b64_v4i16((LAS v4i16_t*)a1), hi4 = __builtin_amdgcn_ds_read_tr16_b64_v4i16((LAS v4i16_t*)(a1 + 8 * 128));
                const bf16x8 vf = (bf16x8){lo4[0], lo4[1], lo4[2], lo4[3], hi4[0], hi4[1], hi4[2], hi4[3]};
                o[d0] = __builtin_amdgcn_mfma_f32_32x32x16_bf16(vf, pa[s2], o[d0], 0, 0, 0);
            }
        return false;
    };
    for (int i = 0; i < nseq; i += 2) {
        if (i + 2 < nseq) FOX_LOAD(krA, vrA, brA, tlast - (i + 2));
        if (compute(tlast - i, 0)) break;
        if (i + 1 < nseq) {
            FOX_STORE(krB, vrB, brB, 1);
            if (i + 3 < nseq) FOX_LOAD(krB, vrB, brB, tlast - (i + 3));
            if (compute(tlast - (i + 1), 1)) break;
            if (i + 2 < nseq) FOX_STORE(krA, vrA, brA, 0);
        }
    }
#undef FOX_LOAD
#undef FOX_STORE
    l += __shfl_xor(l, 32);
    const float inv = 1.0f / l;
    bf16* orow = Ow + (size_t)r32 * 512;
#pragma unroll
    for (int d0 = 0; d0 < 2; ++d0)
#pragma unroll
        for (int g = 0; g < 4; ++g) { u32x2 w; w.x = cvtpk(o[d0][4 * g] * inv, o[d0][4 * g + 1] * inv); w.y = cvtpk(o[d0][4 * g + 2] * inv, o[d0][4 * g + 3] * inv);
            *(u32x2*)(orow + d0 * 32 + 8 * g + 4 * hi) = w; }
}
#ifndef DBG_BRANCH_MASK
#define DBG_BRANCH_MASK 7
#endif
#ifndef DBG_NBR
#define DBG_NBR 3
#endif
#ifndef DBG_NOGATE
#define DBG_NOGATE 0
#endif
#ifndef DBG_NOBRANCH
#define DBG_NOBRANCH 0
#endif
#ifndef DBG_GATE_W
#define DBG_GATE_W WS_WGATE
#endif
#ifndef DBG_GATE_AS_BRANCH
#define DBG_GATE_AS_BRANCH 0
#endif
#ifndef REP_FOX
#define REP_FOX 1
#endif
#ifndef REP_DSA
#define REP_DSA 1
#endif
#ifndef REP_GEMM
#define REP_GEMM 1
#endif
#ifndef DBG_SUBST
#define DBG_SUBST 0
#endif
#ifndef P7SEL
#define P7SEL 3
#endif
#ifndef PHMASK
#define PHMASK 0xFFFF
#endif
struct Args { const void* in[24]; float* out; unsigned char* ws; };
#define CONVERT_GROUP(GRP, w_, nw_) do { \
    constexpr int I_GU = 16 * 176, I_D = 44 * 32, I_IN = 16 * 104, I_GT = 16 * 96, I_BR = 8 * 32, I_SQ = 16 * 32; \
    constexpr int NIT = (GRP) == 0 ? I_GU + I_SQ : (GRP) == 1 ? I_D + I_IN + I_GT + 3 * I_BR + I_SQ : I_GU + I_D; \
    LAS float* scr_ = (LAS float*)(L + RING_OFF + wave * 16384); \
    for (int it = (w_); it < NIT; it += (nw_)) { int r = it; \
        if ((GRP) == 0) { \
            if (r < I_GU) { transpose_item(0, ARG_IN(4), ARG_IN(5), 1024, DFF, ARG_IN(3), WSP(bf16, WS_WGU1), scr_, r, 176, lane); continue; } r -= I_GU; \
            transpose_item(1, ARG_IN(17), nullptr, 1024, 1024, ARG_IN(8), WSP(bf16, WS_WMKV), scr_, r, 32, lane); \
        } else if ((GRP) == 1) { \
            if (r < I_D) { transpose_item(1, ARG_IN(6), nullptr, DFF, 1024, nullptr, WSP(bf16, WS_WD1), scr_, r, 32, lane); continue; } r -= I_D; \
            if (r < I_IN) { transpose_item(2, ARG_IN(9), nullptr, 1024, DIN, ARG_IN(7), WSP(bf16, WS_WIN), scr_, r, 104, lane); continue; } r -= I_IN; \
            if (r < I_GT) { transpose_item(3, ARG_IN(9), nullptr, 1024, DIN, ARG_IN(7), WSP(bf16, WS_WGATE), scr_, r, 96, lane); continue; } r -= I_GT; \
            if (r < 3 * I_BR) { const int i = r / I_BR; transpose_item(1, ARG_IN(18) + (size_t)i * 512 * 1024, nullptr, 512, 1024, nullptr, WSP(bf16, WS_WBR) + (size_t)i * 1024 * 512, scr_, r % I_BR, 32, lane); continue; } r -= 3 * I_BR; \
            transpose_item(1, ARG_IN(19), nullptr, 1024, 1024, nullptr, WSP(bf16, WS_WOUT), scr_, r, 32, lane); \
        } else { \
            if (r < I_GU) { transpose_item(0, ARG_IN(21), ARG_IN(22), 1024, DFF, ARG_IN(20), WSP(bf16, WS_WGU2), scr_, r, 176, lane); continue; } r -= I_GU; \
            transpose_item(1, ARG_IN(23), nullptr, DFF, 1024, nullptr, WSP(bf16, WS_WD2), scr_, r, 32, lane); \
        } } } while (0)
__global__ void __launch_bounds__(NWAVES * 64, 2) fwd_mega(Args args) {
    extern __shared__ __attribute__((aligned(16))) unsigned char lds[];
    LAS unsigned char* L = (LAS unsigned char*)lds;
    volatile LAS unsigned* MISC = (volatile LAS unsigned*)(L + MISC_OFF);
    const int tid = threadIdx.x, lane = tid & 63, wave = __builtin_amdgcn_readfirstlane(tid >> 6);
    const int G = gridDim.x; const int bx = blockIdx.x; const int vcu = (G % 8 == 0) ? (bx % 8) * (G / 8) + bx / 8 : bx;
    const Args* ap = (const Args*)__builtin_amdgcn_kernarg_segment_ptr();
#define ARG_IN(k) ((const float*)ap->in[k])
#define WSP(type, off) ((type*)(ap->ws + (off)))
    gu32* ctl = (gu32*)(ap->ws + WS_CTL);
    for (int u = tid; u < (LDS_BYTES - LDSCTL_OFF) / 4; u += NWAVES * 64) ((LAS unsigned*)(L + LDSCTL_OFF))[u] = 0u;
    __syncthreads();
    XcdBarrier bar = xcd_barrier_post((unsigned*)(ctl + CW_BAR), MISC + 8);
#define GRID_BAR() xcd_barrier(bar)
    const int gw = vcu * NWAVES + wave, NGW = G * NWAVES;

#if (PHMASK >> 0) & 1
    {
        LAS float* scr = (LAS float*)(L + RING_OFF + wave * 16384);
        CONVERT_GROUP(0, gw, NGW);
        for (int m0 = gw; m0 < T + 512; m0 += 4 * NGW) {
            const float* xr[4]; bf16* orw[4]; float* ro[4]; bool ok[4];
#pragma unroll
            for (int r = 0; r < 4; ++r) { const int m = m0 + r * NGW; ok[r] = m < T + 512; const int mc = ok[r] ? m : gw;
                if (mc < T) { xr[r] = ARG_IN(0) + (size_t)mc * 1024; orw[r] = WSP(bf16, WS_HB) + (size_t)mc * 1024; ro[r] = WSP(float, WS_RSTDX) + mc; }
                else { xr[r] = ARG_IN(1) + (size_t)(mc - T) * 1024; orw[r] = WSP(bf16, WS_MEMB) + (size_t)(mc - T) * 1024; ro[r] = WSP(float, WS_RSTDM) + (mc - T); } }
            rows4_to_bf16_rstd(xr, orw, ro, ok, lane);
        }
        VM_WAIT(); __syncthreads();
        GRID_BAR();
    }
#endif
#if (PHMASK >> 1) & 1
    {
        if (bx >= G - 8) { pg8::Gemm g{WSP(bf16, WS_MEMB), WSP(bf16, WS_WMKV), 512, 1024, 1024}; pg8::StaticOrder S; S.init(512, 1024, G, bx - (G - 8));
        pg8::EpiMemKV E{WSP(float, WS_KVM), WSP(float, WS_RSTDM)};
        pg8::gemm_phase<pg8::EpiMemKV, pg8::StaticOrder, true, true>(L + RING_OFF, g, S, E); }
    }
#endif
#if (PHMASK >> 2) & 1
    {
        pg8::Gemm g{WSP(bf16, WS_HB), WSP(bf16, WS_WGU1), T, 2 * DFF, 1024}; pg8::StaticOrder S; S.init(T, 2 * DFF, G, bx);
        pg8::build_row_tab<0>(WSP(float, WS_RSTDX), S, (LAS float*)(L + RING_BYTES + 1024)); pg8::EpiSwiGLU<0> E{WSP(bf16, WS_HID), DFF, (LAS float*)(L + RING_BYTES + 1024)};
#pragma unroll 1
        for (int rep_ = 0; rep_ < REP_GEMM; ++rep_)
        pg8::gemm_phase<pg8::EpiSwiGLU<0>, pg8::StaticOrder, true, true>(L + RING_OFF, g, S, E);
        {
            const int nfull = (64 * 22) % G; const int nidle = (nfull == 0) ? G : G - nfull; const int first = G - nidle;
            if (bx >= first) { CONVERT_GROUP(1, (bx - first) * NWAVES + wave, nidle * NWAVES);
                for (int e = (bx - first) * NWAVES * 64 + tid; e < T * 32; e += nidle * NWAVES * 64) {
                    const int row = e >> 5, i = e & 31; const float inv_freq = powf(10000.0f, -(float)i * (1.0f / 32.0f));
                    const float ang = (float)((const int*)ap->in[2])[row] * inv_freq; float sn, cs; sincosf(ang, &sn, &cs); WSP(float, WS_COS)[e] = cs; WSP(float, WS_SIN)[e] = sn; } }
        }
        GRID_BAR();
    }
#endif
#if (PHMASK >> 3) & 1
    {
        pg8::Gemm g{WSP(bf16, WS_HID), WSP(bf16, WS_WD1), T, 1024, DFF}; pg8::StaticOrder S; S.init(T, 1024, G, bx);
        pg8::EpiResid2<true> E{ARG_IN(0), ap->out, WSP(bf16, WS_HB), WSP(float, WS_SSQ1), 0.5f};
#pragma unroll 1
        for (int rep_ = 0; rep_ < REP_GEMM; ++rep_)
        pg8::gemm_phase<pg8::EpiResid2<true>, pg8::StaticOrder, true, true>(L + RING_OFF, g, S, E);
        GRID_BAR();
    }
#endif
#if (PHMASK >> 4) & 1
    {
        pg8::Gemm g{WSP(bf16, WS_HB), WSP(bf16, WS_WIN), T, NPROJ, 1024}; pg8::StaticOrder S; S.init(T, NPROJ, G, bx);
        pg8::ProjOut PO{WSP(bf16, WS_FQ), WSP(bf16, WS_FK), WSP(bf16, WS_FV), WSP(bf16, WS_DQ), WSP(bf16, WS_IQ), WSP(bf16, WS_MQ), WSP(bf16, WS_DK), WSP(bf16, WS_DV), WSP(bf16, WS_IK), WSP(float, WS_LOGF), WSP(float, WS_IW), WSP(float, WS_COS), WSP(float, WS_SIN), ARG_IN(11), ARG_IN(12), ARG_IN(13), ARG_IN(14), ARG_IN(10)};
        pg8::build_row_tab<16>(WSP(float, WS_SSQ1), S, (LAS float*)(L + RING_BYTES + 1024)); pg8::EpiProj<16> E{PO, (LAS float*)(L + RING_BYTES + 1024), C2_64};
#pragma unroll 1
        for (int rep_ = 0; rep_ < REP_GEMM; ++rep_)
        pg8::gemm_phase<pg8::EpiProj<16>, pg8::StaticOrder, true, true>(L + RING_OFF, g, S, E);
        {
            const int nfull = (64 * 13) % G; const int nidle = (nfull == 0) ? G : G - nfull; const int first = G - nidle;
            if (bx >= first) { CONVERT_GROUP(2, (bx - first) * NWAVES + wave, nidle * NWAVES);
        for (int it = (bx - first) * NWAVES + wave; it < 2048; it += nidle * NWAVES) { const int row = it >> 2, h = it & 3;
                    const f32x2g kv = *(const f32x2g*)(WSP(float, WS_KVM) + (size_t)row * 1024 + h * 128 + 2 * lane); const f32x2g vv = *(const f32x2g*)(WSP(float, WS_KVM) + (size_t)row * 1024 + 512 + h * 128 + 2 * lane);
                    const float ss = wave_sum(kv.x * kv.x + kv.y * kv.y); const float rstd = 1.0f / sqrtf(ss * (1.0f / 128.0f) + 1e-6f);
                    const f32x2g gk = *(const f32x2g*)(ARG_IN(16) + 2 * lane);
                    *(unsigned*)(WSP(bf16, WS_KMB) + (size_t)row * 512 + h * 128 + 2 * lane) = pk2(kv.x * rstd * gk.x, kv.y * rstd * gk.y);
                    { const int bb = row >> 8, key = row & 255; bf16* vt = WSP(bf16, WS_VMB) + ((size_t)(bb * 4 + h) * 128 + 2 * lane) * MEMLEN + key; vt[0] = (bf16)f2bf(vv.x); vt[MEMLEN] = (bf16)f2bf(vv.y); } } }
        }
        GRID_BAR();
#if defined(DBG_DUMP_AFTER) && DBG_DUMP_AFTER == 4
        {
            const bf16* sa = WSP(bf16, DBG_DUMP_A); const bf16* sb = WSP(bf16, DBG_DUMP_B);
            for (size_t e = (size_t)vcu * 512 + tid; e < (size_t)T * 512; e += (size_t)G * 512) { const size_t row = e >> 9, c = e & 511;
                ap->out[row * 1024 + c] = bf2f(sa[row * DBG_PITCH + c]); ap->out[row * 1024 + 512 + c] = bf2f(sb[row * DBG_PITCH + c]); }
            return;
        }
#endif

    }
#endif
#if ((PHMASK >> 5) & 1) && !DBG_SUBST
    {
        for (int it = gw; it < 2048; it += NGW) mem_unit(it >> 2, it & 3, WSP(bf16, WS_MQ), WSP(bf16, WS_KMB), WSP(bf16, WS_VMB), ARG_IN(15), lane);
    }
#endif
#if ((PHMASK >> 6) & 1) && !DBG_SUBST
    {
        for (int rep_ = 0; rep_ < REP_FOX; ++rep_)
        for (int v = vcu; v < 256; v += G) { const int bh = v >> 4, s = v & 15;
            scan_unit(bh, WSP(float, WS_LOGF), WSP(float, WS_CUM), WSP(int, WS_T0), ARG_IN(11), ARG_IN(12), (LAS float*)(L + SCANX_OFF), (LAS float*)(L + RING_OFF), tid);
            asm volatile("s_waitcnt vmcnt(0)" ::: "memory"); __syncthreads();
            fox_unit4(bh, s, WSP(bf16, WS_FQ), WSP(bf16, WS_FK), WSP(bf16, WS_FV), WSP(float, WS_CUM), WSP(int, WS_T0), ARG_IN(11), ARG_IN(12), WSP(bf16, WS_OA), L, wave, lane); fox_unit4(bh, 31 - s, WSP(bf16, WS_FQ), WSP(bf16, WS_FK), WSP(bf16, WS_FV), WSP(float, WS_CUM), WSP(int, WS_T0), ARG_IN(11), ARG_IN(12), WSP(bf16, WS_OA), L, wave, lane); }
        __syncthreads();
        {
            gu32* qctr = ctl + CW_Q; LAS int* QW = (LAS int*)(L + D3_QW);
            const int pref = (vcu >> 5) & 1;
            unsigned raw = 0u; int cur;
            if (tid == 0) { unsigned u = __hip_atomic_fetch_add(qctr + 64 * pref, 1u, RLX_AGENT); int bsel = pref; if (u >= 512u) { bsel = pref ^ 1; u = __hip_atomic_fetch_add(qctr + 64 * bsel, 1u, RLX_AGENT); } QW[0] = (u < 512u) ? ((bsel << 16) | (int)u) : -1; }
            __syncthreads(); cur = QW[0]; __syncthreads();
            while (cur >= 0) {
                if (tid == 0) raw = __hip_atomic_fetch_add(qctr + 64 * pref, 1u, RLX_AGENT);
                dsa3_unit(cur >> 16, 511 - (cur & 0xffff), WSP(bf16, WS_IQ), WSP(bf16, WS_IK), WSP(float, WS_IW), WSP(bf16, WS_DQ), WSP(bf16, WS_DK), WSP(bf16, WS_DV), WSP(bf16, WS_OB), L, wave, lane);
                if (tid == 0) { unsigned u = raw; int bsel = pref; if (u >= 512u) { bsel = pref ^ 1; u = __hip_atomic_fetch_add(qctr + 64 * bsel, 1u, RLX_AGENT); } QW[0] = (u < 512u) ? ((bsel << 16) | (int)u) : -1; }
                __syncthreads(); cur = QW[0]; __syncthreads();
            }
        }
        GRID_BAR();
    }
#endif
#if (PHMASK >> 7) & 1
    {
        pg8::StaticOrder S; S.init(T, 1024, G, bx); pg8::build_row_tab<16>(WSP(float, WS_SSQ1), S, (LAS float*)(L + RING_BYTES + 1024));
#ifndef P7STREAM
#define P7STREAM 1
#endif
#if P7STREAM
        {   typedef pg8::P7Order<WS_HB, WS_WGATE, WS_OA, WS_OB, WS_MQ, WS_WBR> P7O; P7O O{S, (const char*)WSP(char, 0)};
            pg8::EpiP7 E{WSP(bf16, WS_GSCR), WSP(bf16, WS_MERGED), (LAS float*)(L + RING_BYTES + 1024)};
#ifndef REP_P7
#define REP_P7 1
#endif
#pragma unroll 1
            for (int rep7_ = 0; rep7_ < REP_P7; ++rep7_) pg8::gemm_stream<pg8::EpiP7, P7O>(L + RING_OFF, O, E); }
#pragma unroll 1
        for (int i = 0; i < 0; ++i) {
#else
#pragma unroll 1
        for (int rep_ = 0; rep_ < REP_GEMM; ++rep_)
#pragma unroll 1
        for (int i = 0; i < DBG_NBR; ++i) {
#endif
#if DBG_GATE_AS_BRANCH
            {   pg8::Gemm g{WSP(bf16, WS_HB), WSP(bf16, DBG_GATE_W), T, 1024, 1024}; pg8::EpiBranch E{WSP(bf16, WS_GSCR), WSP(bf16, WS_MERGED), true, 1.0f}; pg8::gemm_phase<pg8::EpiBranch, pg8::StaticOrder, true, true>(L + RING_OFF, g, S, E); }
#elif !DBG_NOGATE
            {   pg8::Gemm g{WSP(bf16, WS_HB), WSP(bf16, DBG_GATE_W) + (size_t)i * 1024 * 1024, T, 1024, 1024}; pg8::EpiGate<16> E{WSP(bf16, WS_GSCR), (LAS float*)(L + RING_BYTES + 1024)}; pg8::gemm_phase<pg8::EpiGate<16>, pg8::StaticOrder, true, true>(L + RING_OFF, g, S, E); }
#endif
#if !DBG_NOBRANCH
#if DBG_SUBST == 1
            {   const bf16* A = (i == 0) ? WSP(bf16, WS_FQ) : (i == 1) ? WSP(bf16, WS_DQ) : WSP(bf16, WS_IQ);
#elif DBG_SUBST == 2
            {   const bf16* A = (i == 0) ? WSP(bf16, WS_FK) : (i == 1) ? WSP(bf16, WS_FV) : WSP(bf16, WS_MQ);
#else
            {   const bf16* A = (i == 0) ? WSP(bf16, WS_OA) : (i == 1) ? WSP(bf16, WS_OB) : WSP(bf16, WS_MQ);
#endif
                pg8::Gemm g{A, WSP(bf16, WS_WBR) + (size_t)i * 1024 * 512, T, 1024, 512}; pg8::EpiBranch E{WSP(bf16, WS_GSCR), WSP(bf16, WS_MERGED), i == 0, ((DBG_BRANCH_MASK >> i) & 1) ? 1.0f : 0.0f}; pg8::gemm_phase<pg8::EpiBranch, pg8::StaticOrder, true, true>(L + RING_OFF, g, S, E); }
#endif
        }
        GRID_BAR();
#if defined(DBG_DUMP_AFTER) && DBG_DUMP_AFTER == 7
        {
            const bf16* sa = WSP(bf16, DBG_DUMP_A); const bf16* sb = WSP(bf16, DBG_DUMP_B);
            for (size_t e = (size_t)vcu * 512 + tid; e < (size_t)T * 512; e += (size_t)G * 512) { const size_t row = e >> 9, c = e & 511;
                ap->out[row * 1024 + c] = bf2f(sa[row * DBG_PITCH + c]); ap->out[row * 1024 + 512 + c] = bf2f(sb[row * DBG_PITCH + c]); }
            return;
        }
#endif

    }
#endif
#if (PHMASK >> 8) & 1
    {
        pg8::Gemm g{WSP(bf16, WS_MERGED), WSP(bf16, WS_WOUT), T, 1024, 1024}; pg8::StaticOrder S; S.init(T, 1024, G, bx);
        pg8::EpiResid2<true> E{ap->out, ap->out, WSP(bf16, WS_HB), WSP(float, WS_SSQ2), 1.0f};
        pg8::gemm_phase<pg8::EpiResid2<true>, pg8::StaticOrder, true, true>(L + RING_OFF, g, S, E);
        GRID_BAR();
    }
#endif
#if (PHMASK >> 9) & 1
    {
        pg8::Gemm g{WSP(bf16, WS_HB), WSP(bf16, WS_WGU2), T, 2 * DFF, 1024}; pg8::StaticOrder S; S.init(T, 2 * DFF, G, bx);
        pg8::build_row_tab<16>(WSP(float, WS_SSQ2), S, (LAS float*)(L + RING_BYTES + 1024)); pg8::EpiSwiGLU<16> E{WSP(bf16, WS_HID), DFF, (LAS float*)(L + RING_BYTES + 1024)};
#pragma unroll 1
        for (int rep_ = 0; rep_ < REP_GEMM; ++rep_)
        pg8::gemm_phase<pg8::EpiSwiGLU<16>, pg8::StaticOrder, true, true>(L + RING_OFF, g, S, E);
        GRID_BAR();
    }
#endif
#if (PHMASK >> 10) & 1
    {
        pg8::Gemm g{WSP(bf16, WS_HID), WSP(bf16, WS_WD2), T, 1024, DFF}; pg8::StaticOrder S; S.init(T, 1024, G, bx);
        pg8::EpiResid2<false> E{ap->out, ap->out, nullptr, nullptr, 0.5f};
        pg8::gemm_phase<pg8::EpiResid2<false>, pg8::StaticOrder, true, true>(L + RING_OFF, g, S, E);
    }
#endif
}

extern "C" void kernel_launch(void* const* d_in, const int* in_sizes, int n_in, void* d_out, int out_size, void* d_ws, size_t ws_size, hipStream_t stream) {
    static int grid = 0;
    if (grid == 0) {
        if (n_in != 24 || out_size != T * DM || ws_size < WS_END) { fprintf(stderr, "kernel_launch: unexpected problem (n_in %d, out %d, ws %zu)\n", n_in, out_size, ws_size); grid = -1; return; }
        int dev = 0, cus = 0, per_cu = 0;
        if (hipGetDevice(&dev) != hipSuccess || hipDeviceGetAttribute(&cus, hipDeviceAttributeMultiprocessorCount, dev) != hipSuccess) { grid = -1; return; }
        if (hipFuncSetAttribute((const void*)fwd_mega, hipFuncAttributeMaxDynamicSharedMemorySize, LDS_BYTES) != hipSuccess) { fprintf(stderr, "kernel_launch: hipFuncSetAttribute failed\n"); grid = -1; return; }
        if (hipOccupancyMaxActiveBlocksPerMultiprocessor(&per_cu, (const void*)fwd_mega, NWAVES * 64, LDS_BYTES) != hipSuccess || per_cu < 1) { fprintf(stderr, "kernel_launch: occupancy query says %d blocks per CU\n", per_cu); (void)hipGetLastError(); grid = -1; return; }
        grid = cus;
    }
    if (grid < 0) return;
    (void)hipMemsetAsync((char*)d_ws + WS_CTL, 0, CTL_ZERO_BYTES, stream);
    Args a{};
    for (int i = 0; i < 24; ++i) a.in[i] = d_in[i];
    a.out = (float*)d_out; a.ws = (unsigned char*)d_ws;
    hipLaunchKernelGGL(fwd_mega, dim3(grid), dim3(NWAVES * 64), LDS_BYTES, stream, a);
}
```

```cpp
#include <hip/hip_runtime.h>
#include <cstdio>
#include <cstdint>
namespace pg8 {
#define PG8_LAS __attribute__((address_space(3)))
typedef unsigned short bf16_t;
typedef short bf16x8 __attribute__((ext_vector_type(8)));
typedef float f32x4 __attribute__((ext_vector_type(4)));
typedef unsigned u32x4 __attribute__((ext_vector_type(4)));
constexpr int BM = 256, BK = 64, HALF = 128, HTB = HALF * BK * 2  , STAGE_BYTES = 8 * HTB, NXCD = 8, WGM = 8;

__host__ __device__ __forceinline__ int lds_byte(int r, int c) { const int st = (r >> 4) * 2 + (c >> 5), rr = r & 15, cc = c & 31, ob = rr * 64 + cc * 2; return st * 1024 + (ob ^ (((ob >> 9) & 1) << 5)); }
__host__ __device__ __forceinline__ void stage_rc(int b, int& R, int& C) { const int st = b / 1024, sb = b % 1024, swz = sb ^ (((sb >> 9) & 1) << 5); R = (st >> 1) * 16 + swz / 64; C = (st & 1) * 32 + (swz % 64) / 2; }
__host__ __device__ __forceinline__ int perm32(int rho) { const int n = rho >> 4, i = rho & 15; return 8 * (i >> 2) + 4 * n + (i & 3); }

struct Unit { int pm, pn; };
struct Gemm { const bf16_t* A; const bf16_t* Bt; int M, N, K; };

struct StaticOrder {
    int nM, nN, nwg, G, c;
    __host__ __device__ void init(int M, int N, int G_, int c_) { nM = M / BM; nN = N / BM; nwg = nM * nN; G = G_; c = c_; }
    __host__ __device__ bool next(int i, Unit& u) const {
        const long L = (long)i * G + c; if (L >= nwg) return false;
        int wgid = (int)L; { const int q = nwg / NXCD, r = nwg % NXCD, xcd = wgid % NXCD, off = wgid / NXCD; wgid = (xcd < r ? xcd * (q + 1) : r * (q + 1) + (xcd - r) * q) + off; }
        const int nig = WGM * nN, gid = wgid / nig, fm = gid * WGM, gsz = (nM - fm) < WGM ? (nM - fm) : WGM;
        u.pm = fm + ((wgid % nig) % gsz); u.pn = (wgid % nig) / gsz; return true;
    }
    __device__ __forceinline__ void a_ready(const Unit&) const {}
    __device__ __forceinline__ void done(const Unit&) const {}
};

typedef float f32x2cv __attribute__((ext_vector_type(2))); typedef __bf16 bf16x2cv __attribute__((ext_vector_type(2)));
__device__ __forceinline__ unsigned cvt_pk_bf16(float lo, float hi) { const f32x2cv v = {lo, hi}; const bf16x2cv b = __builtin_convertvector(v, bf16x2cv); return __builtin_bit_cast(unsigned, b); }
typedef float f32x2 __attribute__((ext_vector_type(2)));
template <class Epi, class Sched, bool ALIGN_EPI = false, bool SP2 = false>
__device__ __forceinline__ void gemm_phase(PG8_LAS unsigned char* lds, const Gemm g, const Sched& S, const Epi& E) {
    int tid_ = threadIdx.x; asm volatile("" : "+v"(tid_));
    const int tid = tid_, wid = __builtin_amdgcn_readfirstlane(tid >> 6), lane = tid & 63, wr = wid >> 2, wc = wid & 3, fr = lane & 15, fq = lane >> 4;
    const int K = g.K, nt = K / BK;
    unsigned voffA[2], voffB[2];
#pragma unroll
    for (int i = 0; i < 2; ++i) { int R, C; stage_rc(tid * 16 + i * 8192, R, C); const int Rb = Epi::PERM ? ((R & ~31) + perm32(R & 31)) : R;
        voffA[i] = (unsigned)(R * K + C) * 2u; voffB[i] = (unsigned)(Rb * K + C) * 2u; }
    const size_t kstep = (size_t)(BK * 2);
    const size_t hstep = (size_t)HALF * K * 2;
    const size_t tstep = 2 * hstep;
    const unsigned ldsw = (unsigned)wid * 1024u;
    const int aoff = lds_byte(wr * 64 + fr, fq * 8), boff = lds_byte(wc * 32 + fr, fq * 8);
#define PG8_SA(b, h) (((b) * 2 + (h)) * HTB)
#define PG8_SB(b, h) ((4 + (b) * 2 + (h)) * HTB)
#define PG8_STAGE(bufoff, gbase, voff) do { _Pragma("unroll") for (int _i = 0; _i < 2; ++_i) \
        __builtin_amdgcn_global_load_lds((const unsigned*)((const char*)(gbase) + (voff)[_i]), (PG8_LAS unsigned*)(lds + (bufoff) + ldsw + _i * 8192), 16, 0, 0); } while (0)
#define PG8_LDA(dst, b, h) do { _Pragma("unroll") for (int m = 0; m < 4; ++m) _Pragma("unroll") for (int k = 0; k < 2; ++k) dst[m][k] = *(const PG8_LAS bf16x8*)(lds + PG8_SA(b, h) + aoff + m * 2048 + k * 1024); } while (0)
#define PG8_LDB(dst, b, h) do { _Pragma("unroll") for (int n = 0; n < 2; ++n) _Pragma("unroll") for (int k = 0; k < 2; ++k) dst[n][k] = *(const PG8_LAS bf16x8*)(lds + PG8_SB(b, h) + boff + n * 2048 + k * 1024); } while (0)
#define PG8_MMA(ai, bj, At, Bt) do { __builtin_amdgcn_s_setprio(1); _Pragma("unroll") for (int m = 0; m < 4; ++m) _Pragma("unroll") for (int n = 0; n < 2; ++n) _Pragma("unroll") for (int k = 0; k < 2; ++k) \
        acc[ai][bj][m][n] = __builtin_amdgcn_mfma_f32_16x16x32_bf16(Bt[n][k], At[m][k], acc[ai][bj][m][n], 0, 0, 0); __builtin_amdgcn_s_setprio(0); } while (0)
#define PG8_WAIT_V(n) asm volatile("s_waitcnt vmcnt(" #n ")" ::: "memory")
#define PG8_WAIT_L(n) asm volatile("s_waitcnt lgkmcnt(" #n ")" ::: "memory")
#define PG8_BAR __builtin_amdgcn_s_barrier()
#define PG8_SCHED __builtin_amdgcn_sched_barrier(0)
    Unit cur, nxt; int ui = 0;
    if (!S.next(0, cur)) return;
    f32x4 acc[2][2][4][2];
#pragma unroll
    for (int a = 0; a < 2; ++a)
#pragma unroll
        for (int b = 0; b < 2; ++b)
#pragma unroll
            for (int m = 0; m < 4; ++m)
#pragma unroll
                for (int n = 0; n < 2; ++n) acc[a][b][m][n] = (f32x4){0.f, 0.f, 0.f, 0.f};
    bf16x8 At[4][2], B0[2][2], B1[2][2];
    const char* cA = (const char*)g.A + (size_t)cur.pm * tstep; const char* cB = (const char*)g.Bt + (size_t)cur.pn * tstep;
    S.a_ready(cur);
    if constexpr (SP2) {
        PG8_STAGE(PG8_SB(0, 0), cB, voffB); PG8_STAGE(PG8_SB(0, 1), cB + hstep, voffB); PG8_STAGE(PG8_SA(0, 0), cA, voffA); PG8_STAGE(PG8_SA(0, 1), cA + hstep, voffA);
        if (wr == 1) PG8_BAR;
        PG8_WAIT_V(2); PG8_BAR;
        PG8_STAGE(PG8_SB(1, 0), cB + kstep, voffB); PG8_STAGE(PG8_SA(1, 0), cA + kstep, voffA); PG8_STAGE(PG8_SB(1, 1), cB + hstep + kstep, voffB);
        PG8_WAIT_V(6); PG8_BAR;
    } else {
        PG8_STAGE(PG8_SB(0, 0), cB, voffB); PG8_STAGE(PG8_SA(0, 0), cA, voffA); PG8_STAGE(PG8_SB(0, 1), cB + hstep, voffB); PG8_STAGE(PG8_SA(0, 1), cA + hstep, voffA);
        if (wr == 1) PG8_BAR;
        PG8_WAIT_V(4); PG8_BAR;
        PG8_STAGE(PG8_SB(1, 0), cB + kstep, voffB); PG8_STAGE(PG8_SA(1, 0), cA + kstep, voffA); PG8_STAGE(PG8_SB(1, 1), cB + hstep + kstep, voffB);
        PG8_WAIT_V(6); PG8_BAR;
    }
    for (;;) {
        const bool has_next = S.next(ui + 1, nxt);
        const char* nA = has_next ? (const char*)g.A + (size_t)nxt.pm * tstep : cA; const char* nB = has_next ? (const char*)g.Bt + (size_t)nxt.pn * tstep : cB;
        for (int t = 0; t < nt; t += 2) {
            const bool last = (t == nt - 2);
            const char* a1 = cA + (size_t)(t + 1) * kstep;
            const char* a2 = last ? nA : cA + (size_t)(t + 2) * kstep; const char* b2 = last ? nB : cB + (size_t)(t + 2) * kstep;
            const char* a3 = a2 + kstep; const char* b3 = b2 + kstep;
            if (last && has_next) S.a_ready(nxt);
            if constexpr (SP2) {
            PG8_LDB(B0, 0, 0); PG8_LDB(B1, 0, 1); PG8_SCHED; PG8_LDA(At, 0, 0); PG8_STAGE(PG8_SA(1, 1), a1 + hstep, voffA);
            PG8_WAIT_V(8); PG8_WAIT_L(0); PG8_BAR; PG8_MMA(0, 0, At, B0); PG8_MMA(0, 1, At, B1); PG8_BAR; PG8_SCHED;
            PG8_LDA(At, 0, 1); PG8_STAGE(PG8_SB(0, 0), b2, voffB); PG8_STAGE(PG8_SB(0, 1), b2 + hstep, voffB); PG8_STAGE(PG8_SA(0, 0), a2, voffA);
            PG8_WAIT_V(8); PG8_WAIT_L(0); PG8_BAR; PG8_MMA(1, 0, At, B0); PG8_MMA(1, 1, At, B1); PG8_BAR; PG8_SCHED;
            PG8_LDB(B0, 1, 0); PG8_LDB(B1, 1, 1); PG8_SCHED; PG8_LDA(At, 1, 0); PG8_STAGE(PG8_SA(0, 1), a2 + hstep, voffA);
            PG8_WAIT_V(8); PG8_WAIT_L(0); PG8_BAR; PG8_MMA(0, 0, At, B0); PG8_MMA(0, 1, At, B1); PG8_BAR; PG8_SCHED;
            PG8_LDA(At, 1, 1); PG8_STAGE(PG8_SB(1, 0), b3, voffB); PG8_STAGE(PG8_SB(1, 1), b3 + hstep, voffB); PG8_STAGE(PG8_SA(1, 0), a3, voffA);
            PG8_WAIT_V(8); PG8_WAIT_L(0); PG8_BAR; PG8_MMA(1, 0, At, B0); PG8_MMA(1, 1, At, B1); PG8_BAR; PG8_SCHED;
            } else {
            PG8_LDB(B0, 0, 0); PG8_SCHED; PG8_LDA(At, 0, 0); PG8_STAGE(PG8_SA(1, 1), a1 + hstep, voffA);
            PG8_WAIT_L(8); PG8_BAR; PG8_WAIT_L(0); PG8_MMA(0, 0, At, B0); PG8_BAR; PG8_SCHED;
            PG8_LDB(B1, 0, 1); PG8_STAGE(PG8_SB(0, 0), b2, voffB);
            PG8_BAR; PG8_WAIT_L(0); PG8_MMA(0, 1, At, B1); PG8_BAR;
            PG8_LDA(At, 0, 1); PG8_STAGE(PG8_SA(0, 0), a2, voffA);
            PG8_BAR; PG8_WAIT_L(0); PG8_MMA(1, 0, At, B0); PG8_BAR; PG8_SCHED;
            PG8_STAGE(PG8_SB(0, 1), b2 + hstep, voffB);
            PG8_WAIT_V(6); PG8_BAR; PG8_MMA(1, 1, At, B1); PG8_BAR;
            PG8_LDB(B0, 1, 0); PG8_SCHED; PG8_LDA(At, 1, 0); PG8_STAGE(PG8_SA(0, 1), a2 + hstep, voffA);
            PG8_WAIT_L(8); PG8_BAR; PG8_WAIT_L(0); PG8_MMA(0, 0, At, B0); PG8_BAR; PG8_SCHED;
            PG8_LDB(B1, 1, 1); PG8_STAGE(PG8_SB(1, 0), b3, voffB);
            PG8_BAR; PG8_WAIT_L(0); PG8_MMA(0, 1, At, B1); PG8_BAR;
            PG8_LDA(At, 1, 1); PG8_STAGE(PG8_SA(1, 0), a3, voffA);
            PG8_BAR; PG8_WAIT_L(0); PG8_MMA(1, 0, At, B0); PG8_BAR; PG8_SCHED;
            PG8_STAGE(PG8_SB(1, 1), b3 + hstep, voffB);
            PG8_WAIT_V(6); PG8_BAR; PG8_MMA(1, 1, At, B1); PG8_BAR;
            }
        }
        if constexpr (ALIGN_EPI) { if (wr == 0) PG8_BAR; }
        if constexpr (!Epi::AFTER_DRAIN) { E(acc, cur, wr, wc, fr, fq); S.done(cur); }
        if (!has_next) break;
#pragma unroll
        for (int a = 0; a < 2; ++a)
#pragma unroll
            for (int b = 0; b < 2; ++b)
#pragma unroll
                for (int m = 0; m < 4; ++m)
#pragma unroll
                    for (int n = 0; n < 2; ++n) acc[a][b][m][n] = (f32x4){0.f, 0.f, 0.f, 0.f};
        cur = nxt; cA = nA; cB = nB; ++ui;
        if constexpr (ALIGN_EPI) { if (wr == 1) PG8_BAR; }
    }
    PG8_WAIT_V(0);
    if constexpr (!ALIGN_EPI) { if (wr == 0) PG8_BAR; }
    PG8_BAR;
    if constexpr (Epi::AFTER_DRAIN) { E.fused(acc, cur, wr, wc, fr, fq, lds, wid, lane); S.done(cur); }
#undef PG8_SA
#undef PG8_SB
#undef PG8_STAGE
#undef PG8_LDA
#undef PG8_LDB
#undef PG8_MMA
#undef PG8_WAIT_V
#undef PG8_WAIT_L
#undef PG8_BAR
#undef PG8_SCHED
}

struct UnitX { int pm, pn, kind, round; };
struct OpsX { const char* A; const char* Bt; int K; };
template <class Epi, class Sched>
__device__ __forceinline__ void gemm_stream(PG8_LAS unsigned char* lds, const Sched& S, const Epi& E) {
    int tid_ = threadIdx.x; asm volatile("" : "+v"(tid_));
    const int tid = tid_, wid = __builtin_amdgcn_readfirstlane(tid >> 6), lane = tid & 63, wr = wid >> 2, wc = wid & 3, fr = lane & 15, fq = lane >> 4;
    unsigned rA[2], rB[2], c2[2];
#pragma unroll
    for (int i = 0; i < 2; ++i) { int R, C; stage_rc(tid * 16 + i * 8192, R, C); rA[i] = (unsigned)R; rB[i] = (unsigned)((R & ~31) + perm32(R & 31)); c2[i] = (unsigned)C * 2u; }
    const size_t kstep = (size_t)(BK * 2);
    const unsigned ldsw = (unsigned)wid * 1024u;
    const int aoff = lds_byte(wr * 64 + fr, fq * 8), boff = lds_byte(wc * 32 + fr, fq * 8);
#define PG8_SA(b, h) (((b) * 2 + (h)) * HTB)
#define PG8_SB(b, h) ((4 + (b) * 2 + (h)) * HTB)
#define PGX_STAGE(bufoff, gbase, rr, pb) do { _Pragma("unroll") for (int _i = 0; _i < 2; ++_i) \
        __builtin_amdgcn_global_load_lds((const unsigned*)((const char*)(gbase) + ((rr)[_i] * (pb) + c2[_i])), (PG8_LAS unsigned*)(lds + (bufoff) + ldsw + _i * 8192), 16, 0, 0); } while (0)
#define PG8_LDA(dst, b, h) do { _Pragma("unroll") for (int m = 0; m < 4; ++m) _Pragma("unroll") for (int k = 0; k < 2; ++k) dst[m][k] = *(const PG8_LAS bf16x8*)(lds + PG8_SA(b, h) + aoff + m * 2048 + k * 1024); } while (0)
#define PG8_LDB(dst, b, h) do { _Pragma("unroll") for (int n = 0; n < 2; ++n) _Pragma("unroll") for (int k = 0; k < 2; ++k) dst[n][k] = *(const PG8_LAS bf16x8*)(lds + PG8_SB(b, h) + boff + n * 2048 + k * 1024); } while (0)
#define PG8_MMA(ai, bj, At, Bt) do { __builtin_amdgcn_s_setprio(1); _Pragma("unroll") for (int m = 0; m < 4; ++m) _Pragma("unroll") for (int n = 0; n < 2; ++n) _Pragma("unroll") for (int k = 0; k < 2; ++k) \
        acc[ai][bj][m][n] = __builtin_amdgcn_mfma_f32_16x16x32_bf16(Bt[n][k], At[m][k], acc[ai][bj][m][n], 0, 0, 0); __builtin_amdgcn_s_setprio(0); } while (0)
#define PG8_WAIT_V(n) asm volatile("s_waitcnt vmcnt(" #n ")" ::: "memory")
#define PG8_WAIT_L(n) asm volatile("s_waitcnt lgkmcnt(" #n ")" ::: "memory")
#define PG8_BAR __builtin_amdgcn_s_barrier()
#define PG8_SCHED __builtin_amdgcn_sched_barrier(0)
    UnitX cur, nxt; int ui = 0;
    if (!S.next(0, cur)) return;
    f32x4 acc[2][2][4][2];
#pragma unroll
    for (int a = 0; a < 2; ++a)
#pragma unroll
        for (int b = 0; b < 2; ++b)
#pragma unroll
            for (int m = 0; m < 4; ++m)
#pragma unroll
                for (int n = 0; n < 2; ++n) acc[a][b][m][n] = (f32x4){0.f, 0.f, 0.f, 0.f};
    bf16x8 At[4][2], B0[2][2], B1[2][2];
    OpsX oc = S.ops(cur);
    const char* cA = oc.A; const char* cB = oc.Bt; int Kc = oc.K;
    {   const unsigned pb = (unsigned)Kc * 2u; const size_t hstep = (size_t)HALF * pb;
        PGX_STAGE(PG8_SB(0, 0), cB, rB, pb); PGX_STAGE(PG8_SB(0, 1), cB + hstep, rB, pb); PGX_STAGE(PG8_SA(0, 0), cA, rA, pb); PGX_STAGE(PG8_SA(0, 1), cA + hstep, rA, pb);
        if (wr == 1) PG8_BAR;
        PG8_WAIT_V(2); PG8_BAR;
        PGX_STAGE(PG8_SB(1, 0), cB + kstep, rB, pb); PGX_STAGE(PG8_SA(1, 0), cA + kstep, rA, pb); PGX_STAGE(PG8_SB(1, 1), cB + hstep + kstep, rB, pb);
        PG8_WAIT_V(6); PG8_BAR; }
    for (;;) {
        const bool has_next = S.next(ui + 1, nxt);
        OpsX on = oc; if (has_next) on = S.ops(nxt);
        const char* nA = on.A; const char* nB = on.Bt; const int Kn = on.K;
        const int nt = Kc / BK; const unsigned pbc = (unsigned)Kc * 2u; const size_t hstep = (size_t)HALF * pbc;
        for (int t = 0; t < nt; t += 2) {
            const bool last = (t == nt - 2);
            const char* a1 = cA + (size_t)(t + 1) * kstep;
            const char* a2 = last ? nA : cA + (size_t)(t + 2) * kstep; const char* b2 = last ? nB : cB + (size_t)(t + 2) * kstep;
            const char* a3 = a2 + kstep; const char* b3 = b2 + kstep;
            const unsigned pb2 = last ? (unsigned)Kn * 2u : pbc; const size_t h2 = (size_t)HALF * pb2;
            PG8_LDB(B0, 0, 0); PG8_LDB(B1, 0, 1); PG8_SCHED; PG8_LDA(At, 0, 0); PGX_STAGE(PG8_SA(1, 1), a1 + hstep, rA, pbc);
            PG8_WAIT_V(8); PG8_WAIT_L(0); PG8_BAR; PG8_MMA(0, 0, At, B0); PG8_MMA(0, 1, At, B1); PG8_BAR; PG8_SCHED;
            PG8_LDA(At, 0, 1); PGX_STAGE(PG8_SB(0, 0), b2, rB, pb2); PGX_STAGE(PG8_SB(0, 1), b2 + h2, rB, pb2); PGX_STAGE(PG8_SA(0, 0), a2, rA, pb2);
            PG8_WAIT_V(8); PG8_WAIT_L(0); PG8_BAR; PG8_MMA(1, 0, At, B0); PG8_MMA(1, 1, At, B1); PG8_BAR; PG8_SCHED;
            PG8_LDB(B0, 1, 0); PG8_LDB(B1, 1, 1); PG8_SCHED; PG8_LDA(At, 1, 0); PGX_STAGE(PG8_SA(0, 1), a2 + h2, rA, pb2);
            PG8_WAIT_V(8); PG8_WAIT_L(0); PG8_BAR; PG8_MMA(0, 0, At, B0); PG8_MMA(0, 1, At, B1); PG8_BAR; PG8_SCHED;
            PG8_LDA(At, 1, 1); PGX_STAGE(PG8_SB(1, 0), b3, rB, pb2); PGX_STAGE(PG8_SB(1, 1), b3 + h2, rB, pb2); PGX_STAGE(PG8_SA(1, 0), a3, rA, pb2);
            PG8_WAIT_V(8); PG8_WAIT_L(0); PG8_BAR; PG8_MMA(1, 0, At, B0); PG8_MMA(1, 1, At, B1); PG8_BAR; PG8_SCHED;
        }
        if (wr == 0) PG8_BAR;
        E(acc, cur, wr, wc, fr, fq);
        if (!has_next) break;
#pragma unroll
        for (int a = 0; a < 2; ++a)
#pragma unroll
            for (int b = 0; b < 2; ++b)
#pragma unroll
                for (int m = 0; m < 4; ++m)
#pragma unroll
                    for (int n = 0; n < 2; ++n) acc[a][b][m][n] = (f32x4){0.f, 0.f, 0.f, 0.f};
        cur = nxt; oc = on; cA = nA; cB = nB; Kc = Kn; ++ui;
        if (wr == 1) PG8_BAR;
    }
    PG8_WAIT_V(0);
    PG8_BAR;
#undef PG8_SA
#undef PG8_SB
#undef PGX_STAGE
#undef PG8_LDA
#undef PG8_LDB
#undef PG8_MMA
#undef PG8_WAIT_V
#undef PG8_WAIT_L
#undef PG8_BAR
#undef PG8_SCHED
}
}
namespace pg8 {
constexpr int TOK = 16384;
constexpr float RMS_EPS = 1e-6f;
typedef float f32x2e __attribute__((ext_vector_type(2)));
template <int NP> __device__ __forceinline__ void row_scales(const float* src, int rowbase, int lane, int fr, float (&r)[2][4]) {
#pragma unroll
    for (int ai = 0; ai < 2; ++ai) {
        const int row = rowbase + 128 * ai + lane; float v;
        if (NP == 0) v = src[row];
        else { float s = 0.f;
#pragma unroll
            for (int p = 0; p < NP; ++p) s += src[(size_t)p * TOK + row];
            v = __builtin_amdgcn_rsqf(s * (1.0f / 1024.0f) + RMS_EPS); }
#pragma unroll
        for (int m = 0; m < 4; ++m) r[ai][m] = __shfl(v, 16 * m + fr);
    }
}
template <int NP, class Sched> __device__ __forceinline__ void build_row_tab(const float* src, const Sched& S, PG8_LAS float* tab) {
    Unit u;
    for (int i = 0; S.next(i, u); ++i)
        for (int r = (int)threadIdx.x; r < 256; r += 512) { const int row = u.pm * BM + r; float v;
            if (NP == 0) v = src[row];
            else { float s = 0.f;
#pragma unroll
                for (int p = 0; p < NP; ++p) s += src[(size_t)p * TOK + row];
                v = __builtin_amdgcn_rsqf(s * (1.0f / 1024.0f) + RMS_EPS); }
            tab[i * 256 + r] = v; }
    __syncthreads();
}
__device__ __forceinline__ void row_scales_tab(const PG8_LAS float* tab, int ui, int wr, int fr, float (&r)[2][4]) {
#pragma unroll
    for (int ai = 0; ai < 2; ++ai)
#pragma unroll
        for (int m = 0; m < 4; ++m) r[ai][m] = tab[ui * 256 + ai * 128 + wr * 64 + 16 * m + fr];
}
__device__ __forceinline__ float silu_f(float x) { return x * __builtin_amdgcn_rcpf(1.0f + __expf(-x)); }
__device__ __forceinline__ float sigmoid_f(float x) { return __builtin_amdgcn_rcpf(1.0f + __expf(-x)); }

template <int NP> struct EpiSwiGLU {
    static constexpr bool PERM = true, AFTER_DRAIN = false;
    bf16_t* H; int ldh; const PG8_LAS float* tab; mutable int ui = 0;
    __device__ __forceinline__ void operator()(const f32x4 (&acc)[2][2][4][2], const Unit& u, int wr, int wc, int fr0, int fq0) const {
        int fr = fr0, fq = fq0; asm volatile("" : "+v"(fr), "+v"(fq));
        float r[2][4]; row_scales_tab(tab, ui++, wr, fr, r);
        const int col0 = u.pn * 128 + wc * 32 + 8 * fq;
#pragma unroll
        for (int ai = 0; ai < 2; ++ai)
#pragma unroll
            for (int m = 0; m < 4; ++m) {
                const int row = u.pm * BM + ai * HALF + wr * 64 + m * 16 + fr; const float rr = r[ai][m];
                float o[8]; const float k1 = -1.44269504f * rr, rr2 = rr * rr;
#pragma unroll
                for (int n = 0; n < 2; ++n)
#pragma unroll
                    for (int j = 0; j < 4; j += 2) { const f32x2 g2 = (f32x2){acc[ai][0][m][n][j], acc[ai][0][m][n][j + 1]}, u2 = (f32x2){acc[ai][1][m][n][j], acc[ai][1][m][n][j + 1]};
                        const f32x2 t2 = g2 * k1; const f32x2 d2 = (f32x2){__builtin_amdgcn_exp2f(t2[0]), __builtin_amdgcn_exp2f(t2[1])} + 1.0f;
                        const f32x2 r2 = (f32x2){__builtin_amdgcn_rcpf(d2[0]), __builtin_amdgcn_rcpf(d2[1])} * rr2; const f32x2 o2 = (g2 * u2) * r2;
                        o[4 * n + j] = o2[0]; o[4 * n + j + 1] = o2[1]; }
                u32x4 w; w.x = cvt_pk_bf16(o[0], o[1]); w.y = cvt_pk_bf16(o[2], o[3]); w.z = cvt_pk_bf16(o[4], o[5]); w.w = cvt_pk_bf16(o[6], o[7]);
                *(u32x4*)(H + (size_t)row * ldh + col0) = w;
            }
    }
};
template <bool WRITE_HB> struct EpiResid {
    static constexpr bool PERM = true, AFTER_DRAIN = false;
    const float* base; float* out; bf16_t* hb; float* part; float sc;
    __device__ __forceinline__ void operator()(const f32x4 (&acc)[2][2][4][2], const Unit& u, int wr, int wc, int fr0, int fq0) const {
        int fr = fr0, fq = fq0; asm volatile("" : "+v"(fr), "+v"(fq));
        const int col0 = u.pn * BM + wc * 32 + 8 * fq;
#pragma unroll
        for (int ai = 0; ai < 2; ++ai)
#pragma unroll
            for (int m = 0; m < 4; ++m) {
                const int row = u.pm * BM + ai * HALF + wr * 64 + m * 16 + fr; float ss = 0.f;
#pragma unroll
                for (int bj = 0; bj < 2; ++bj) {
                    const size_t off = (size_t)row * 1024 + col0 + bj * HALF;
                    const f32x4 b0 = *(const f32x4*)(base + off), b1 = *(const f32x4*)(base + off + 4);
                    const f32x4 o0 = b0 + acc[ai][bj][m][0] * sc, o1 = b1 + acc[ai][bj][m][1] * sc;
                    *(f32x4*)(out + off) = o0; *(f32x4*)(out + off + 4) = o1;
                    if (WRITE_HB) {
                        ss += (o0[0] * o0[0] + o0[1] * o0[1]) + (o0[2] * o0[2] + o0[3] * o0[3]) + (o1[0] * o1[0] + o1[1] * o1[1]) + (o1[2] * o1[2] + o1[3] * o1[3]);
                        u32x4 w; w.x = cvt_pk_bf16(o0[0], o0[1]); w.y = cvt_pk_bf16(o0[2], o0[3]); w.z = cvt_pk_bf16(o1[0], o1[1]); w.w = cvt_pk_bf16(o1[2], o1[3]);
                        *(u32x4*)(hb + off) = w; }
                }
                if (WRITE_HB) { ss += __shfl_xor(ss, 16); ss += __shfl_xor(ss, 32); if (fq == 0) part[(size_t)(u.pn * 4 + wc) * TOK + row] = ss; }
                if (m == 3) asm volatile("" ::: "memory");
            }
    }
};
template <bool WRITE_HB> struct EpiResid2 {
    static constexpr bool PERM = true, AFTER_DRAIN = false;
    const float* base; float* out; bf16_t* hb; float* part; float sc;
    __device__ __forceinline__ void operator()(const f32x4 (&acc)[2][2][4][2], const Unit& u, int wr, int wc, int fr0, int fq0) const {
        int fr = fr0, fq = fq0; asm volatile("" : "+v"(fr), "+v"(fq));
        const int row0 = u.pm * BM + wr * 64 + fr; const size_t o00 = (size_t)row0 * 1024 + u.pn * BM + wc * 32 + 8 * fq;
        const float* bp = base + o00; float* op = out + o00; bf16_t* hp = hb + o00;
        f32x4 bq[2][8];
#define ER2_ISSUE(G, B) do { _Pragma("unroll") for (int c = 0; c < 8; ++c) { const int ai = (G) >> 1, m = 2 * ((G) & 1) + (c >> 2), bj = (c >> 1) & 1, n = c & 1; \
            bq[B][c] = *(const f32x4*)(bp + (size_t)(ai * 128 + m * 16) * 1024 + bj * 128 + 4 * n); } } while (0)
        ER2_ISSUE(0, 0);
#pragma unroll
        for (int G = 0; G < 4; ++G) {
            if (G + 1 < 4) { if ((G & 1) == 0) ER2_ISSUE(G + 1, 1); else ER2_ISSUE(G + 1, 0); }
            asm volatile("" ::: "memory");
#pragma unroll
            for (int mm = 0; mm < 2; ++mm) { const int ai = G >> 1, m = 2 * (G & 1) + mm; float ss = 0.f;
#pragma unroll
                for (int bj = 0; bj < 2; ++bj) { const size_t off = (size_t)(ai * 128 + m * 16) * 1024 + bj * 128;
                    const f32x4 o0 = bq[G & 1][mm * 4 + bj * 2] + acc[ai][bj][m][0] * sc, o1 = bq[G & 1][mm * 4 + bj * 2 + 1] + acc[ai][bj][m][1] * sc;
                    *(f32x4*)(op + off) = o0; *(f32x4*)(op + off + 4) = o1;
                    if (WRITE_HB) {
                        ss += (o0[0] * o0[0] + o0[1] * o0[1]) + (o0[2] * o0[2] + o0[3] * o0[3]) + (o1[0] * o1[0] + o1[1] * o1[1]) + (o1[2] * o1[2] + o1[3] * o1[3]);
                        u32x4 w; w.x = cvt_pk_bf16(o0[0], o0[1]); w.y = cvt_pk_bf16(o0[2], o0[3]); w.z = cvt_pk_bf16(o1[0], o1[1]); w.w = cvt_pk_bf16(o1[2], o1[3]);
                        *(u32x4*)(hp + off) = w; } }
                if (WRITE_HB) { ss += __shfl_xor(ss, 16); ss += __shfl_xor(ss, 32); if (fq == 0) part[(size_t)(u.pn * 4 + wc) * TOK + row0 + ai * 128 + m * 16] = ss; } }
            asm volatile("" ::: "memory");
        }
#undef ER2_ISSUE
    }
};
struct EpiMemKV {
    static constexpr bool PERM = true, AFTER_DRAIN = false;
    float* KV; const float* rs;
    __device__ __forceinline__ void operator()(const f32x4 (&acc)[2][2][4][2], const Unit& u, int wr, int wc, int fr0, int fq0) const {
        int fr = fr0, fq = fq0; asm volatile("" : "+v"(fr), "+v"(fq));
        float r[2][4]; row_scales<0>(rs, u.pm * BM + wr * 64, (int)(threadIdx.x & 63), fr, r);
        const int col0 = u.pn * BM + wc * 32 + 8 * fq;
#pragma unroll
        for (int ai = 0; ai < 2; ++ai)
#pragma unroll
            for (int m = 0; m < 4; ++m) { const int row = u.pm * BM + ai * HALF + wr * 64 + m * 16 + fr;
#pragma unroll
                for (int bj = 0; bj < 2; ++bj) { const size_t off = (size_t)row * 1024 + col0 + bj * HALF;
                    *(f32x4*)(KV + off) = acc[ai][bj][m][0] * r[ai][m]; *(f32x4*)(KV + off + 4) = acc[ai][bj][m][1] * r[ai][m]; } }
    }
};
template <int NP> struct EpiGate {
    static constexpr bool PERM = true, AFTER_DRAIN = false;
    bf16_t* scr; const PG8_LAS float* tab; mutable int ui = 0;
    __device__ __forceinline__ void operator()(const f32x4 (&acc)[2][2][4][2], const Unit& u, int wr, int wc, int fr0, int fq0) const {
        int fr = fr0, fq = fq0; asm volatile("" : "+v"(fr), "+v"(fq));
        float r[2][4];
#ifdef DBG_GATE_NOSCALE
        for (int a_ = 0; a_ < 2; ++a_) for (int m_ = 0; m_ < 4; ++m_) r[a_][m_] = 1.0f;
#else
        row_scales_tab(tab, ui++, wr, fr, r);
#endif
        bf16_t* t = scr + (size_t)(u.pm * 4 + u.pn) * 65536;
#pragma unroll
        for (int ai = 0; ai < 2; ++ai)
#pragma unroll
            for (int m = 0; m < 4; ++m) { const int lr = ai * HALF + wr * 64 + m * 16 + fr; const float rr = r[ai][m];
#pragma unroll
                for (int bj = 0; bj < 2; ++bj) { float o[8];
#pragma unroll
                    for (int n = 0; n < 2; ++n)
#pragma unroll
                        for (int j = 0; j < 4; ++j) o[4 * n + j] = sigmoid_f(acc[ai][bj][m][n][j] * rr);
                    u32x4 w; w.x = cvt_pk_bf16(o[0], o[1]); w.y = cvt_pk_bf16(o[2], o[3]); w.z = cvt_pk_bf16(o[4], o[5]); w.w = cvt_pk_bf16(o[6], o[7]);
                    *(u32x4*)(t + lr * 256 + bj * HALF + wc * 32 + 8 * fq) = w; } }
    }
};
__device__ __forceinline__ float bf_lo(unsigned w) { return __uint_as_float(w << 16); }
__device__ __forceinline__ float bf_hi(unsigned w) { return __uint_as_float(w & 0xffff0000u); }
struct EpiBranch {
    static constexpr bool PERM = true, AFTER_DRAIN = false;
    const bf16_t* scr; bf16_t* mg; bool first; float bscale;
    __device__ __forceinline__ void operator()(const f32x4 (&acc)[2][2][4][2], const Unit& u, int wr, int wc, int fr0, int fq0) const {
        int fr = fr0, fq = fq0; asm volatile("" : "+v"(fr), "+v"(fq));
        const bf16_t* t = scr + (size_t)(u.pm * 4 + u.pn) * 65536;
        __builtin_amdgcn_fence(__ATOMIC_ACQUIRE, "agent");
        asm volatile("s_waitcnt vmcnt(0)" ::: "memory");
#pragma unroll
        for (int ai = 0; ai < 2; ++ai)
#pragma unroll
            for (int m = 0; m < 4; ++m) { const int lr = ai * HALF + wr * 64 + m * 16 + fr; const int row = u.pm * BM + lr;
#pragma unroll
                for (int bj = 0; bj < 2; ++bj) { const int lc = bj * HALF + wc * 32 + 8 * fq;
#if defined(DBG_NOGATE) && DBG_NOGATE
                    const u32x4 g = (u32x4){0x3f803f80u, 0x3f803f80u, 0x3f803f80u, 0x3f803f80u};
#else
                    const u32x4 g = *(const u32x4*)(t + lr * 256 + lc);
#endif
                    bf16_t* mp = mg + (size_t)row * 1024 + u.pn * BM + lc;
                    float o[8];
                    o[0] = bf_lo(g.x) * acc[ai][bj][m][0][0]; o[1] = bf_hi(g.x) * acc[ai][bj][m][0][1]; o[2] = bf_lo(g.y) * acc[ai][bj][m][0][2]; o[3] = bf_hi(g.y) * acc[ai][bj][m][0][3];
                    o[4] = bf_lo(g.z) * acc[ai][bj][m][1][0]; o[5] = bf_hi(g.z) * acc[ai][bj][m][1][1]; o[6] = bf_lo(g.w) * acc[ai][bj][m][1][2]; o[7] = bf_hi(g.w) * acc[ai][bj][m][1][3];
#ifdef DBG_BRANCH_SIGMOID
#pragma unroll
                    for (int e = 0; e < 8; ++e) o[e] = DBG_NONLIN(o[e]);
#endif
#pragma unroll
                    for (int e = 0; e < 8; ++e) o[e] *= bscale;
                    if (!first) { const u32x4 p = *(const u32x4*)mp;
                        o[0] += bf_lo(p.x); o[1] += bf_hi(p.x); o[2] += bf_lo(p.y); o[3] += bf_hi(p.y); o[4] += bf_lo(p.z); o[5] += bf_hi(p.z); o[6] += bf_lo(p.w); o[7] += bf_hi(p.w); }
                    u32x4 w; w.x = cvt_pk_bf16(o[0], o[1]); w.y = cvt_pk_bf16(o[2], o[3]); w.z = cvt_pk_bf16(o[4], o[5]); w.w = cvt_pk_bf16(o[6], o[7]);
                    *(u32x4*)mp = w; }
                if (m & 1) asm volatile("" ::: "memory"); }
    }
};
template <bool FIRST> struct EpiBranch2 {
    const bf16_t* scr; bf16_t* mg;
    __device__ __forceinline__ void operator()(const f32x4 (&acc)[2][2][4][2], const Unit& u, int wr, int wc, int fr0, int fq0) const {
        int fr = fr0, fq = fq0; asm volatile("" : "+v"(fr), "+v"(fq));
        const bf16_t* t = scr + (size_t)(u.pm * 4 + u.pn) * 65536 + (wr * 64 + fr) * 256 + wc * 32 + 8 * fq;
        bf16_t* mp0 = mg + (size_t)(u.pm * BM + wr * 64 + fr) * 1024 + u.pn * BM + wc * 32 + 8 * fq;
        u32x4 gq[2][4], pq[2][4];
#define EB2_ISSUE(G, B) do { _Pragma("unroll") for (int c = 0; c < 4; ++c) { const int ai = (G) >> 1, m = 2 * ((G) & 1) + (c >> 1), bj = c & 1; \
            gq[B][c] = *(const u32x4*)(t + (ai * 128 + m * 16) * 256 + bj * 128); if (!FIRST) pq[B][c] = *(const u32x4*)(mp0 + (size_t)(ai * 128 + m * 16) * 1024 + bj * 128); } } while (0)
        EB2_ISSUE(0, 0);
#pragma unroll
        for (int G = 0; G < 4; ++G) {
            if (G + 1 < 4) { if ((G & 1) == 0) EB2_ISSUE(G + 1, 1); else EB2_ISSUE(G + 1, 0); }
            asm volatile("" ::: "memory");
#pragma unroll
            for (int c = 0; c < 4; ++c) { const int ai = G >> 1, m = 2 * (G & 1) + (c >> 1), bj = c & 1; const u32x4 g = gq[G & 1][c];
                float o[8];
                o[0] = bf_lo(g.x) * acc[ai][bj][m][0][0]; o[1] = bf_hi(g.x) * acc[ai][bj][m][0][1]; o[2] = bf_lo(g.y) * acc[ai][bj][m][0][2]; o[3] = bf_hi(g.y) * acc[ai][bj][m][0][3];
                o[4] = bf_lo(g.z) * acc[ai][bj][m][1][0]; o[5] = bf_hi(g.z) * acc[ai][bj][m][1][1]; o[6] = bf_lo(g.w) * acc[ai][bj][m][1][2]; o[7] = bf_hi(g.w) * acc[ai][bj][m][1][3];
                if (!FIRST) { const u32x4 p = pq[G & 1][c];
                    o[0] += bf_lo(p.x); o[1] += bf_hi(p.x); o[2] += bf_lo(p.y); o[3] += bf_hi(p.y); o[4] += bf_lo(p.z); o[5] += bf_hi(p.z); o[6] += bf_lo(p.w); o[7] += bf_hi(p.w); }
                u32x4 w; w.x = cvt_pk_bf16(o[0], o[1]); w.y = cvt_pk_bf16(o[2], o[3]); w.z = cvt_pk_bf16(o[4], o[5]); w.w = cvt_pk_bf16(o[6], o[7]);
                *(u32x4*)(mp0 + (size_t)(ai * 128 + m * 16) * 1024 + bj * 128) = w; }
            asm volatile("" ::: "memory");
        }
#undef EB2_ISSUE
    }
};
template <size_t O_HB, size_t O_WG, size_t O_A0, size_t O_A1, size_t O_A2, size_t O_WB> struct P7Order {
    StaticOrder T; const char* ws;
    __device__ __forceinline__ bool next(int i, UnitX& u) const { const int rd = i / 6; Unit t; if (!T.next(rd, t)) return false; u.pm = t.pm; u.pn = t.pn; u.kind = i - 6 * rd; u.round = rd; return true; }
    __device__ __forceinline__ OpsX ops(const UnitX& u) const { const int j = u.kind >> 1; OpsX o;
        if (u.kind & 1) { o.K = 512; o.A = ws + (j == 0 ? O_A0 : j == 1 ? O_A1 : O_A2) + (size_t)u.pm * (256 * 512 * 2); o.Bt = ws + O_WB + (size_t)j * (1024 * 512 * 2) + (size_t)u.pn * (256 * 512 * 2); }
        else { o.K = 1024; o.A = ws + O_HB + (size_t)u.pm * (256 * 1024 * 2); o.Bt = ws + O_WG + (size_t)j * (1024 * 1024 * 2) + (size_t)u.pn * (256 * 1024 * 2); }
        return o; }
};
struct EpiP7 {
    bf16_t* scr; bf16_t* mg; const PG8_LAS float* tab;
    __device__ __forceinline__ void operator()(const f32x4 (&acc)[2][2][4][2], const UnitX& u, int wr, int wc, int fr, int fq) const {
        const Unit uu{u.pm, u.pn};
        if (u.kind == 1) { const EpiBranch2<true> b{scr, mg}; b(acc, uu, wr, wc, fr, fq); }
        else if (u.kind & 1) { const EpiBranch2<false> b{scr, mg}; b(acc, uu, wr, wc, fr, fq); }
        else { const EpiGate<16> g{scr, tab, u.round}; g(acc, uu, wr, wc, fr, fq); }
    }
};
struct ProjOut { bf16_t *FQ, *FK, *FV, *DQ, *IQ, *MQ, *DK, *DV, *IK; float *LOGF, *IW; const float *cosT, *sinT, *g_fq, *g_fk, *g_dq, *g_dk, *b_forget; };
__device__ __forceinline__ float log_sigmoid_f(float z) { return z >= 0.f ? -log1pf(expf(-z)) : z - log1pf(expf(z)); }
template <int NP> struct EpiProj {
    static constexpr bool PERM = true, AFTER_DRAIN = false;
    ProjOut P; const PG8_LAS float* tab; float qscale; mutable int ui = 0;
    __device__ __forceinline__ void operator()(const f32x4 (&acc)[2][2][4][2], const Unit& u, int wr, int wc, int fr0, int fq0) const {
        int fr = fr0, fq = fq0; asm volatile("" : "+v"(fr), "+v"(fq));
        float r[2][4]; row_scales_tab(tab, ui++, wr, fr, r);
        const int pn = u.pn;
        bool do_norm = false, do_rope = false; const float* gain = nullptr; bf16_t* dst = nullptr; int pitch = 512, hoff = 0; float osc = 1.f;
        if (pn < 2)       { do_norm = true; gain = P.g_fq; dst = P.FQ; hoff = (4 * pn + wc) * 64; osc = qscale; }
        else if (pn < 4)  { do_norm = true; gain = P.g_fk; dst = P.FK; hoff = (4 * (pn - 2) + wc) * 64; }
        else if (pn < 6)  { dst = P.FV; hoff = (4 * (pn - 4) + wc) * 64; }
        else if (pn < 8)  { do_norm = true; do_rope = true; gain = P.g_dq; dst = P.DQ; hoff = (4 * (pn - 6) + wc) * 64; osc = qscale; }
        else if (pn < 10) { do_rope = true; dst = P.IQ; hoff = (4 * (pn - 8) + wc) * 64; }
        else if (pn < 12) { dst = P.MQ; hoff = (2 * (pn - 10) + (wc >> 1)) * 128 + (wc & 1) * 64; }
        else { pitch = 64;
            if (wc == 0)      { do_norm = true; do_rope = true; gain = P.g_dk; dst = P.DK; }
            else if (wc == 1) { dst = P.DV; }
            else if (wc == 2) { do_rope = true; dst = P.IK; }
            else dst = nullptr; }
        if (dst == nullptr) {
            if (fq < 2) {
#pragma unroll
                for (int ai = 0; ai < 2; ++ai)
#pragma unroll
                    for (int m = 0; m < 4; ++m) { const int row = u.pm * BM + ai * HALF + wr * 64 + m * 16 + fr; const float rr = r[ai][m];
                        f32x4 v0 = acc[ai][0][m][0] * rr, v1 = acc[ai][0][m][1] * rr;
                        if (fq == 0) {
                            const f32x4 b0 = *(const f32x4*)(P.b_forget), b1 = *(const f32x4*)(P.b_forget + 4);
#pragma unroll
                            for (int j = 0; j < 4; ++j) { v0[j] = log_sigmoid_f(v0[j] + b0[j]); v1[j] = log_sigmoid_f(v1[j] + b1[j]); }
                            *(f32x4*)(P.LOGF + (size_t)row * 8) = v0; *(f32x4*)(P.LOGF + (size_t)row * 8 + 4) = v1;
                        } else { const float c = 0.04419417382f; *(f32x4*)(P.IW + (size_t)row * 8) = v0 * c; *(f32x4*)(P.IW + (size_t)row * 8 + 4) = v1 * c; } }
            }
            return;
        }
        const bool ikl = (pn == 12 && wc == 2);
        if (do_norm) { if (do_rope) body<true, true, false>(acc, u, r, gain, dst, pitch, hoff, osc, wr, fr, fq); else body<true, false, false>(acc, u, r, gain, dst, pitch, hoff, osc, wr, fr, fq); }
        else if (do_rope) { if (ikl) body<false, true, true>(acc, u, r, gain, dst, pitch, hoff, osc, wr, fr, fq); else body<false, true, false>(acc, u, r, gain, dst, pitch, hoff, osc, wr, fr, fq); }
        else body<false, false, false>(acc, u, r, gain, dst, pitch, hoff, osc, wr, fr, fq);
    }
    template <bool NORM, bool ROPE, bool IKL>
    __device__ __forceinline__ void body(const f32x4 (&acc)[2][2][4][2], const Unit& u, const float (&r)[2][4], const float* gain, bf16_t* dst, int pitch, int hoff, float osc, int wr, int fr, int fq) const {
        f32x4 gv[2][2];
        if (NORM) {
#pragma unroll
            for (int bj = 0; bj < 2; ++bj)
#pragma unroll
                for (int n = 0; n < 2; ++n) gv[bj][n] = *(const f32x4*)(gain + bj * 32 + 8 * fq + 4 * n);
        }
        f32x4 cq[2][4];
        const int rowb = u.pm * BM + wr * 64 + fr;
#define EP_ISSUE(I, B) do { const size_t ro_ = (size_t)(rowb + ((I) >> 2) * HALF + ((I) & 3) * 16) * 32 + 8 * fq; \
            cq[B][0] = *(const f32x4*)(P.cosT + ro_); cq[B][1] = *(const f32x4*)(P.cosT + ro_ + 4); cq[B][2] = *(const f32x4*)(P.sinT + ro_); cq[B][3] = *(const f32x4*)(P.sinT + ro_ + 4); } while (0)
        if (ROPE) EP_ISSUE(0, 0);
#pragma unroll
        for (int ai = 0; ai < 2; ++ai)
#pragma unroll
            for (int m = 0; m < 4; ++m) {
                const int row = u.pm * BM + ai * HALF + wr * 64 + m * 16 + fr; const float rr = r[ai][m];
                if (ROPE) { if (4 * ai + m + 1 < 8) { if (((4 * ai + m) & 1) == 0) EP_ISSUE(4 * ai + m + 1, 1); else EP_ISSUE(4 * ai + m + 1, 0); } asm volatile("" ::: "memory"); }
                f32x4 v[2][2];
#pragma unroll
                for (int bj = 0; bj < 2; ++bj)
#pragma unroll
                    for (int n = 0; n < 2; ++n) v[bj][n] = acc[ai][bj][m][n] * rr;
                if (NORM) {
                    float ss = 0.f;
#pragma unroll
                    for (int bj = 0; bj < 2; ++bj)
#pragma unroll
                        for (int n = 0; n < 2; ++n) ss += (v[bj][n][0] * v[bj][n][0] + v[bj][n][1] * v[bj][n][1]) + (v[bj][n][2] * v[bj][n][2] + v[bj][n][3] * v[bj][n][3]);
                    ss += __shfl_xor(ss, 16); ss += __shfl_xor(ss, 32);
                    const float inv = __builtin_amdgcn_rsqf(ss * (1.0f / 64.0f) + RMS_EPS);
#pragma unroll
                    for (int bj = 0; bj < 2; ++bj)
#pragma unroll
                        for (int n = 0; n < 2; ++n) v[bj][n] = v[bj][n] * inv * gv[bj][n];
                }
                if (ROPE) {
#pragma unroll
                    for (int n = 0; n < 2; ++n) {
                        const f32x4 c = cq[(4 * ai + m) & 1][n], s = cq[(4 * ai + m) & 1][2 + n];
                        const f32x4 x1 = v[0][n], x2 = v[1][n];
                        v[0][n] = x1 * c - x2 * s; v[1][n] = x2 * c + x1 * s; }
                }
#pragma unroll
                for (int bj = 0; bj < 2; ++bj) {
                    const f32x4 a = v[bj][0] * osc, b = v[bj][1] * osc;
                    u32x4 w; w.x = cvt_pk_bf16(a[0], a[1]); w.y = cvt_pk_bf16(a[2], a[3]); w.z = cvt_pk_bf16(b[0], b[1]); w.w = cvt_pk_bf16(b[2], b[3]);
                    if (IKL) {
                        const int d = bj * 32 + 8 * fq; *(u32x4*)(dst + (size_t)(row >> 5) * 2048 + (d >> 4) * 512 + ((d >> 3) & 1) * 256 + (row & 31) * 8) = w;
                    } else *(u32x4*)(dst + (size_t)row * pitch + hoff + bj * 32 + 8 * fq) = w; }
                if (ROPE) asm volatile("" ::: "memory");
            }
#undef EP_ISSUE
    }
};
}
#define GAS __attribute__((address_space(1)))
#define LAS __attribute__((address_space(3)))
typedef unsigned short bf16;
typedef unsigned v4u __attribute__((ext_vector_type(4)));
typedef float f32x4 __attribute__((ext_vector_type(4)));
typedef short bf16x8 __attribute__((ext_vector_type(8)));
typedef GAS unsigned gu32;
typedef GAS unsigned long long gu64;
#define RLX_AGENT __ATOMIC_RELAXED, __HIP_MEMORY_SCOPE_AGENT
#define LDS_WAIT() asm volatile("s_waitcnt lgkmcnt(0)" ::: "memory")
#define VM_WAIT() asm volatile("s_waitcnt vmcnt(0)" ::: "memory")
__device__ __forceinline__ unsigned long long rt() { return __builtin_amdgcn_s_memrealtime(); }
__device__ __forceinline__ unsigned f2bf(float f) { unsigned u = __builtin_bit_cast(unsigned, f); return (u + 0x7fffu + ((u >> 16) & 1u)) >> 16; }
__device__ __forceinline__ unsigned pk2(float lo, float hi) { return f2bf(lo) | (f2bf(hi) << 16); }
typedef float f32x2g __attribute__((ext_vector_type(2)));
__device__ __forceinline__ float bf_lo32(unsigned w) { return __uint_as_float(w << 16); }
__device__ __forceinline__ float bf_hi32(unsigned w) { return __uint_as_float(w & 0xffff0000u); }
constexpr int NWAVES = 8;
constexpr int BATCH = 2, SEQ = 8192, DM = 1024, T = BATCH * SEQ, DFF = 2816, MEMLEN = 256, BW = 512, DIN = 6352;
constexpr int NPROJ = 13 * 256, NGATE = 3072;
constexpr float L2E = 1.4426950408889634f;
constexpr float C2_64 = 0.125f * L2E;
constexpr float C2_128 = 0.08838834764831845f * L2E;
constexpr size_t MiB = 1u << 20;
constexpr size_t WS_CTL = 0, CTL_ZERO_BYTES = 128 * 1024;
constexpr size_t WS_RSTDX = 1 * MiB;
constexpr size_t WS_RSTDM = WS_RSTDX + 64 * 1024;
constexpr size_t WS_T0 = WS_RSTDM + 4096;
constexpr size_t WS_SSQ1 = 2 * MiB;
constexpr size_t WS_SSQ2 = 3 * MiB;
constexpr size_t WS_LOGF = 4 * MiB;
constexpr size_t WS_CUM = WS_LOGF + 512 * 1024;
constexpr size_t WS_IW = 5 * MiB;
constexpr size_t WS_COS = 6 * MiB, WS_SIN = 8 * MiB;
constexpr size_t WS_MEMB = 10 * MiB;
constexpr size_t WS_KVM = 11 * MiB;
constexpr size_t WS_KMB = 13 * MiB, WS_VMB = 14 * MiB;
constexpr size_t WS_WGU1 = 16 * MiB;
constexpr size_t WS_WD1 = 27 * MiB;
constexpr size_t WS_WIN = 33 * MiB;
constexpr size_t WS_WGATE = 40 * MiB;
constexpr size_t WS_WBR = 46 * MiB;
constexpr size_t WS_WOUT = 49 * MiB;
constexpr size_t WS_WGU2 = 51 * MiB;
constexpr size_t WS_WD2 = 62 * MiB;
constexpr size_t WS_WMKV = 68 * MiB;
constexpr size_t WS_HB = 70 * MiB;
constexpr size_t WS_ACT = 102 * MiB;
constexpr size_t WS_HID = WS_ACT;
constexpr size_t WS_FQ = WS_ACT, WS_FK = WS_ACT + 16 * MiB, WS_FV = WS_ACT + 32 * MiB, WS_DQ = WS_ACT + 48 * MiB, WS_IQ = WS_ACT + 64 * MiB, WS_MQ = WS_ACT + 80 * MiB;
constexpr size_t WS_DK = WS_ACT + 96 * MiB, WS_DV = WS_ACT + 98 * MiB, WS_IK = WS_ACT + 100 * MiB;
#if defined(DBG_SUBST) && DBG_SUBST == 2
constexpr size_t WS_MERGED = WS_DQ;
#else
constexpr size_t WS_MERGED = WS_FK;
#endif
#ifdef DBG_GSCR_AT
constexpr size_t WS_GSCR = DBG_GSCR_AT;
#else
constexpr size_t WS_GSCR = 204 * MiB;
#endif
constexpr size_t WS_OA = 236 * MiB;
constexpr size_t WS_OB = 16 * MiB;
constexpr size_t WS_END = 252 * MiB;
#ifndef DBG_GSCR_AT
static_assert(WS_HID + (size_t)T * DFF * 2 <= WS_GSCR && WS_IK + (size_t)T * 64 * 2 <= WS_GSCR, "d_ws map");
#endif
constexpr int CW_BAR = 4096;
constexpr int CW_Q = 16384;
constexpr int RING_OFF = 0, RING_BYTES = 131072;
constexpr int LDSCTL_OFF = RING_BYTES, MISC_OFF = LDSCTL_OFF + 320;
constexpr int LIST_OFF = RING_BYTES + 1024;
constexpr int SCANX_OFF = RING_BYTES + 6144;
constexpr int LDS_BYTES = 163840;
#define XB_TMO      128
#define XB_XCNT(j)  (256  + 64 * (j))
#define XB_XSUB(j)  (1280 + 64 * (j))
#define XB_XGEN(j)  (2304 + 64 * (j))
#define XB_TOP      3328
#define XB_TOPGEN   3392
#define XCD_BAR_WORDS 3456
#define XB_SPIN_CAP (1u << 18)

__device__ __forceinline__ unsigned xb_ld(unsigned* p)              { return __hip_atomic_load(p, __ATOMIC_RELAXED, __HIP_MEMORY_SCOPE_AGENT); }
__device__ __forceinline__ unsigned xb_add(unsigned* p, unsigned v) { return __hip_atomic_fetch_add(p, v, __ATOMIC_RELAXED, __HIP_MEMORY_SCOPE_AGENT); }
__device__ __forceinline__ unsigned xb_xcc_id() { return (unsigned)__builtin_amdgcn_s_getreg((3 << 11) | 20) & 0xFu; }
#define XB_SPIN(cond, bar) do { unsigned _sp = 0; while (cond) { __builtin_amdgcn_s_sleep(1); \
    if ((++_sp & 255u) == 0u) { if (xb_ld(&(bar)[XB_TMO])) break; if (_sp > XB_SPIN_CAP) { atomicAdd(&(bar)[XB_TMO], 1u); break; } } } } while (0)

struct XcdBarrier {
    unsigned* bar; unsigned x;
    volatile LAS unsigned* st;
};

__device__ __forceinline__ XcdBarrier xcd_barrier_post(unsigned* bar, volatile LAS unsigned* st) {
    XcdBarrier b; b.bar = bar; b.x = xb_xcc_id(); b.st = st;
    if (threadIdx.x == 0) (void)xb_add(&bar[XB_XCNT(b.x)], 1u);
    return b;
}
__device__ __forceinline__ void xcd_barrier_complete(unsigned* bar, unsigned x, unsigned& nloc, unsigned& nx) {
    const unsigned G = gridDim.x * gridDim.y * gridDim.z;
    unsigned sum, cnt, mine, sp = 0u;
    for (;;) {
        sum = 0u; cnt = 0u; mine = 0u;
#pragma unroll
        for (unsigned j = 0; j < 16; ++j) { const unsigned c = xb_ld(&bar[XB_XCNT(j)]); sum += c; cnt += (c > 0u) ? 1u : 0u; mine = (j == x) ? c : mine; }
        if (sum == G) break;
        __builtin_amdgcn_s_sleep(1);
        if ((++sp & 255u) == 0u) { if (xb_ld(&bar[XB_TMO])) break; if (sp > XB_SPIN_CAP) { atomicAdd(&bar[XB_TMO], 1u); break; } }
    }
    nloc = mine > 0u ? mine : 1u; nx = cnt > 0u ? cnt : 1u;
}

__device__ __forceinline__ void xcd_barrier(const XcdBarrier& b) {
    asm volatile("s_waitcnt vmcnt(0)" ::: "memory");
    __syncthreads();
    if (threadIdx.x == 0) {
        unsigned* bar = b.bar;
        __builtin_amdgcn_s_waitcnt(0);
        unsigned nloc = b.st[0], nx = b.st[1];
        if (nloc == 0u) { xcd_barrier_complete(bar, b.x, nloc, nx); b.st[0] = nloc; b.st[1] = nx; }
        const unsigned old = xb_add(&bar[XB_XSUB(b.x)], 1u);
        const unsigned gen = old / nloc;
        if (old + 1u == (gen + 1u) * nloc) {
            __builtin_amdgcn_fence(__ATOMIC_RELEASE, "agent");
            asm volatile("s_waitcnt vmcnt(0)" ::: "memory");
            const unsigned og = xb_add(&bar[XB_TOP], 1u);
            const unsigned tg = og / nx;
            if (og + 1u == (tg + 1u) * nx) xb_add(&bar[XB_TOPGEN], 1u);
            else XB_SPIN(xb_ld(&bar[XB_TOPGEN]) == tg, bar);
            __builtin_amdgcn_fence(__ATOMIC_ACQUIRE, "agent");
            xb_add(&bar[XB_XGEN(b.x)], 1u);
            asm volatile("s_waitcnt vmcnt(0)" ::: "memory");
        } else {
            XB_SPIN(xb_ld(&bar[XB_XGEN(b.x)]) == gen, bar);
            __builtin_amdgcn_fence(__ATOMIC_ACQUIRE, "agent");
            asm volatile("s_waitcnt vmcnt(0)" ::: "memory");
        }
    }
    __syncthreads();
}
__device__ __forceinline__ float wave_sum(float v) {
#pragma unroll
    for (int o = 1; o < 64; o <<= 1) v += __shfl_xor(v, o);
    return v;
}
__device__ __forceinline__ float wave_max(float v) {
#pragma unroll
    for (int o = 1; o < 64; o <<= 1) v = fmaxf(v, __shfl_xor(v, o));
    return v;
}
__device__ __forceinline__ int colmap(int mat, int n) {
    if (mat == 1) return n;
    if (mat == 3) return 3280 + n;
    const int tile = n >> 8, t = n & 255;
    if (mat == 0) return (t < 128 ? 0 : DFF) + 128 * tile + (t & 127);
    const int bj = t >> 7, wc = (t >> 5) & 3, i = t & 31, d = bj * 32 + i;
    if (tile < 2) return 0 + (4 * tile + wc) * 64 + d;
    if (tile < 4) return 512 + (4 * (tile - 2) + wc) * 64 + d;
    if (tile < 6) return 1024 + (4 * (tile - 4) + wc) * 64 + d;
    if (tile < 8) return 1544 + (4 * (tile - 6) + wc) * 64 + d;
    if (tile < 10) return 2184 + (4 * (tile - 8) + wc) * 64 + d;
    if (tile < 12) return 2768 + (2 * (tile - 10) + (wc >> 1)) * 128 + (wc & 1) * 64 + d;
    if (wc == 0) return 2056 + d;
    if (wc == 1) return 2120 + d;
    if (wc == 2) return 2696 + d;
    if (bj == 0 && i < 8) return 1536 + i;
    if (bj == 0 && i < 16) return 2760 + (i - 8);
    return -1;
}
__device__ __forceinline__ void transpose_item(int mat, const float* Wa, const float* Wb, int K, int Nsrc, const float* gain, bf16* WT, LAS float* scr, int item, int nblk, int lane) {
    const int kb = item / nblk, nb = item % nblk, k0 = 64 * kb, n0 = 32 * nb;
    int col = colmap(mat, n0 + (lane & 31)); const float* W = Wa;
    if (mat == 0 && col >= DFF) { W = Wb; col -= DFF; }
#pragma unroll 8
    for (int i = 0; i < 32; ++i) { const int kk = 2 * i + (lane >> 5); float v = 0.f; if (col >= 0) v = W[(size_t)(k0 + kk) * Nsrc + col]; if (gain) v *= gain[k0 + kk]; scr[kk * 33 + (lane & 31)] = v; }
    LDS_WAIT(); asm volatile("" ::: "memory");
    const int c = lane & 7;
#pragma unroll
    for (int j = 0; j < 4; ++j) { const int n = (lane >> 3) + 8 * j; const LAS float* s = scr + (8 * c) * 33 + n;
        v4u o; o.x = pk2(s[0 * 33], s[1 * 33]); o.y = pk2(s[2 * 33], s[3 * 33]); o.z = pk2(s[4 * 33], s[5 * 33]); o.w = pk2(s[6 * 33], s[7 * 33]);
        *(GAS v4u*)(WT + (size_t)(n0 + n) * K + k0 + 8 * c) = o; }
    LDS_WAIT(); asm volatile("" ::: "memory");
}
__device__ __forceinline__ void row_to_bf16_rstd(const float* xrow, bf16* orow, float* rstd_out, int lane) {
    const GAS f32x4* xr = (const GAS f32x4*)xrow + lane;
    f32x4 v[4]; float s = 0.f;
#pragma unroll
    for (int j = 0; j < 4; ++j) { v[j] = xr[64 * j]; s += (v[j].x * v[j].x + v[j].y * v[j].y) + (v[j].z * v[j].z + v[j].w * v[j].w); }
    const float rstd = 1.0f / sqrtf(wave_sum(s) * (1.f / 1024.f) + 1e-6f);
    GAS unsigned long long* o8 = (GAS unsigned long long*)orow + lane;
#pragma unroll
    for (int j = 0; j < 4; ++j) o8[64 * j] = (unsigned long long)pk2(v[j].x, v[j].y) | ((unsigned long long)pk2(v[j].z, v[j].w) << 32);
    if (lane == 0) *rstd_out = rstd;
}
__device__ __forceinline__ void rows4_to_bf16_rstd(const float* const (&xrow)[4], bf16* const (&orow)[4], float* const (&rout)[4], const bool (&ok)[4], int lane) {
    f32x4 v[4][4];
#pragma unroll
    for (int r = 0; r < 4; ++r) { const GAS f32x4* xr = (const GAS f32x4*)xrow[r] + lane;
#pragma unroll
        for (int j = 0; j < 4; ++j) v[r][j] = xr[64 * j]; }
#pragma unroll
    for (int r = 0; r < 4; ++r) { float s = 0.f;
#pragma unroll
        for (int j = 0; j < 4; ++j) s += (v[r][j].x * v[r][j].x + v[r][j].y * v[r][j].y) + (v[r][j].z * v[r][j].z + v[r][j].w * v[r][j].w);
        const float rstd = 1.0f / sqrtf(wave_sum(s) * (1.f / 1024.f) + 1e-6f);
        if (ok[r]) { GAS unsigned long long* o8 = (GAS unsigned long long*)orow[r] + lane;
#pragma unroll
            for (int j = 0; j < 4; ++j) o8[64 * j] = (unsigned long long)pk2(v[r][j].x, v[r][j].y) | ((unsigned long long)pk2(v[r][j].z, v[r][j].w) << 32);
            if (lane == 0) *rout[r] = rstd; } }
}
typedef float f32x16 __attribute__((ext_vector_type(16)));
typedef unsigned u32x2 __attribute__((ext_vector_type(2)));
__device__ __forceinline__ int crow(int r, int hi) { return (r & 3) + 8 * (r >> 2) + 4 * hi; }
__device__ __forceinline__ float bf2f(bf16 v) { return __uint_as_float((unsigned)v << 16); }
__device__ __forceinline__ unsigned cvtpk(float lo, float hi) { return pg8::cvt_pk_bf16(lo, hi); }
template <int HD, bool FOX, bool VT>
__device__ __forceinline__ void attn_wave_simple(const bf16x8 (&qr)[HD / 16], const bf16* Kp, int kpitch, const bf16* Vp, int vpitch, int tstart, int ntiles, int qlocal, const float* cb, bf16* Op, int opitch, int lane) {
    const int r32 = lane & 31, hi = lane >> 5;
    f32x16 o[HD / 32];
#pragma unroll
    for (int d0 = 0; d0 < HD / 32; ++d0)
#pragma unroll
        for (int r = 0; r < 16; ++r) o[d0][r] = 0.f;
    float m = -1e30f, l = 0.f;
    for (int t = tstart; t < ntiles; ++t) {
        const int kv0 = 32 * t;
        f32x16 p;
#pragma unroll
        for (int r = 0; r < 16; ++r) p[r] = 0.f;
        const bf16* kr = Kp + (size_t)(kv0 + r32) * kpitch + hi * 8;
#pragma unroll
        for (int ks = 0; ks < HD / 16; ++ks) { const bf16x8 kf = *(const bf16x8*)(kr + ks * 16); p = __builtin_amdgcn_mfma_f32_32x32x16_bf16(kf, qr[ks], p, 0, 0, 0); }
        if (FOX) {
#pragma unroll
            for (int g = 0; g < 4; ++g) { const f32x4 c4 = *(const f32x4*)(cb + kv0 + 8 * g + 4 * hi);
#pragma unroll
                for (int jj = 0; jj < 4; ++jj) p[4 * g + jj] -= L2E * c4[jj]; }
            if (t == ntiles - 1) {
#pragma unroll
                for (int r = 0; r < 16; ++r) if (kv0 + crow(r, hi) > qlocal) p[r] = -INFINITY;
            }
        }
        float mt = p[0];
#pragma unroll
        for (int r = 1; r < 16; ++r) mt = fmaxf(mt, p[r]);
        mt = fmaxf(mt, __shfl_xor(mt, 32));
        const float mn = fmaxf(m, mt); const float alpha = __builtin_amdgcn_exp2f(m - mn); m = mn;
        l *= alpha;
#pragma unroll
        for (int d0 = 0; d0 < HD / 32; ++d0)
#pragma unroll
            for (int r = 0; r < 16; ++r) o[d0][r] *= alpha;
        float ls = 0.f;
#pragma unroll
        for (int r = 0; r < 16; ++r) { p[r] = __builtin_amdgcn_exp2f(p[r] - mn); ls += p[r]; }
        l += ls;
        bf16x8 pa[2];
#pragma unroll
        for (int s = 0; s < 2; ++s) { v4u w; w.x = cvtpk(p[8 * s + 0], p[8 * s + 1]); w.y = cvtpk(p[8 * s + 2], p[8 * s + 3]); w.z = cvtpk(p[8 * s + 4], p[8 * s + 5]); w.w = cvtpk(p[8 * s + 6], p[8 * s + 7]); pa[s] = __builtin_bit_cast(bf16x8, w); }
#pragma unroll
        for (int d0 = 0; d0 < HD / 32; ++d0)
#pragma unroll
            for (int s = 0; s < 2; ++s) {
                bf16x8 vf;
                if (VT) {
                    const bf16* vp = Vp + (size_t)(d0 * 32 + r32) * vpitch + kv0 + 16 * s + 4 * hi;
                    const u32x2 lo = *(const u32x2*)vp, hi2 = *(const u32x2*)(vp + 8);
                    vf = __builtin_bit_cast(bf16x8, (v4u){lo.x, lo.y, hi2.x, hi2.y});
                } else {
#pragma unroll
                    for (int j = 0; j < 8; ++j) vf[j] = (short)Vp[(size_t)(kv0 + 16 * s + 8 * (j >> 2) + 4 * hi + (j & 3)) * vpitch + d0 * 32 + r32];
                }
                o[d0] = __builtin_amdgcn_mfma_f32_32x32x16_bf16(vf, pa[s], o[d0], 0, 0, 0);
            }
    }
    l += __shfl_xor(l, 32);
    const float inv = 1.0f / l;
    bf16* orow = Op + (size_t)r32 * opitch;
#pragma unroll
    for (int d0 = 0; d0 < HD / 32; ++d0)
#pragma unroll
        for (int g = 0; g < 4; ++g) { u32x2 w; w.x = cvtpk(o[d0][4 * g] * inv, o[d0][4 * g + 1] * inv); w.y = cvtpk(o[d0][4 * g + 2] * inv, o[d0][4 * g + 3] * inv);
            *(u32x2*)(orow + d0 * 32 + 8 * g + 4 * hi) = w; }
}
__device__ __forceinline__ void fox_unit(int bh, int qb, const bf16* FQ, const bf16* FK, const bf16* FV, const float* CUM, const int* T0, bf16* OA, int wave, int lane) {
    const int b = bh >> 3, h = bh & 7, r32 = lane & 31, hi = lane >> 5; const size_t rowbase = (size_t)b * SEQ; const int q0 = qb * 256 + wave * 32;
    const bf16* Qw = FQ + (rowbase + q0) * 512 + h * 64; bf16* Ow = OA + (rowbase + q0) * 512 + h * 64;
    bf16x8 qr[4];
#pragma unroll
    for (int ks = 0; ks < 4; ++ks) qr[ks] = *(const bf16x8*)(Qw + (size_t)r32 * 512 + ks * 16 + hi * 8);
    attn_wave_simple<64, true, false>(qr, FK + rowbase * 512 + h * 64, 512, FV + rowbase * 512 + h * 64, 512, T0[bh * 256 + q0 / 32], q0 / 32 + 1, q0 + r32, CUM + (size_t)bh * SEQ, Ow, 512, lane);
}
__device__ __forceinline__ void mem_unit(int rg, int head, bf16* MQ, const bf16* KMB, const bf16* VMB, const float* gq, int lane) {
    const int r32 = lane & 31, hi = lane >> 5; const int row0 = rg * 32; const int b = row0 / SEQ;
    bf16* Qw = MQ + (size_t)row0 * 512 + head * 128;
    bf16x8 raw[8]; float ss = 0.f;
#pragma unroll
    for (int ks = 0; ks < 8; ++ks) { raw[ks] = *(const bf16x8*)(Qw + (size_t)r32 * 512 + ks * 16 + hi * 8);
#pragma unroll
        for (int j = 0; j < 8; ++j) { const float f = bf2f((bf16)raw[ks][j]); ss += f * f; } }
    ss += __shfl_xor(ss, 32);
    const float rstd = __builtin_amdgcn_rsqf(ss * (1.0f / 128.0f) + 1e-6f) * C2_128;
    bf16x8 qr[8];
#pragma unroll
    for (int ks = 0; ks < 8; ++ks) { const f32x4 g0 = *(const f32x4*)(gq + ks * 16 + hi * 8), g1 = *(const f32x4*)(gq + ks * 16 + hi * 8 + 4); v4u w;
        w.x = cvtpk(bf2f((bf16)raw[ks][0]) * rstd * g0[0], bf2f((bf16)raw[ks][1]) * rstd * g0[1]); w.y = cvtpk(bf2f((bf16)raw[ks][2]) * rstd * g0[2], bf2f((bf16)raw[ks][3]) * rstd * g0[3]);
        w.z = cvtpk(bf2f((bf16)raw[ks][4]) * rstd * g1[0], bf2f((bf16)raw[ks][5]) * rstd * g1[1]); w.w = cvtpk(bf2f((bf16)raw[ks][6]) * rstd * g1[2], bf2f((bf16)raw[ks][7]) * rstd * g1[3]);
        qr[ks] = __builtin_bit_cast(bf16x8, w); }
    attn_wave_simple<128, false, true>(qr, KMB + (size_t)b * MEMLEN * 512 + head * 128, 512, VMB + (size_t)(b * 4 + head) * 128 * MEMLEN, MEMLEN, 0, MEMLEN / 32, 0, nullptr, Qw, 512, lane);
}
__device__ __forceinline__ void scan_unit(int bh, const float* LOGF, float* CUM, int* T0, const float* gq, const float* gk, LAS float* sx, LAS float* cl, int tid) {
    const int b = bh >> 3, h = bh & 7, lane = tid & 63, wave = tid >> 6;
    float v[16]; float run = 0.f;
#pragma unroll
    for (int i = 0; i < 16; ++i) v[i] = LOGF[((size_t)b * SEQ + 16 * tid + i) * 8 + h];
#pragma unroll
    for (int i = 0; i < 16; ++i) { run += v[i]; v[i] = run; }
    float tot = run;
#pragma unroll
    for (int off = 1; off < 64; off <<= 1) { const float nb = __shfl_up(tot, off); if (lane >= off) tot += nb; }
    if (lane == 63) sx[wave] = tot;
    __syncthreads();
    float woff = 0.f;
    for (int w = 0; w < wave; ++w) woff += sx[w];
    const float excl = tot - run + woff;
    float* dst = CUM + (size_t)bh * SEQ + 16 * tid;
#pragma unroll
    for (int i = 0; i < 16; i += 4) { const f32x4 o4 = (f32x4){v[i] + excl, v[i + 1] + excl, v[i + 2] + excl, v[i + 3] + excl}; *(f32x4*)(dst + i) = o4; *(LAS f32x4*)(cl + 16 * tid + i) = o4; }
    const float smax = 8.0f * wave_max(fabsf(gq[lane])) * wave_max(fabsf(gk[lane]));
    __syncthreads();
    if (tid < 256) { const float cq = cl[32 * tid]; const float lim = -(30.0f + 2.0f * smax);
        int lo = 0, hi = tid;
        while (lo < hi) { const int mid = (lo + hi) >> 1; if (cq - cl[32 * mid + 31] >= lim) hi = mid; else lo = mid + 1; }
        T0[bh * 256 + tid] = lo; }
    __syncthreads();
}
constexpr int D2_LST = RING_BYTES + 1024;
constexpr int D2_CNT = RING_BYTES + 3072;
constexpr int D2_CL = RING_BYTES + 4096;
typedef short v4i16_t __attribute__((ext_vector_type(4)));
typedef float f32x4d __attribute__((ext_vector_type(4)));
__device__ __forceinline__ unsigned sortable_u32(float f) { const unsigned u = __float_as_uint(f); return u ^ ((u >> 31) ? 0xFFFFFFFFu : 0x80000000u); }
__device__ __forceinline__ int lane_rank(unsigned long long mask) { return (int)__builtin_amdgcn_mbcnt_hi((unsigned)(mask >> 32), __builtin_amdgcn_mbcnt_lo((unsigned)mask, 0u)); }
__device__ __forceinline__ int bcount(bool p) { return (int)__popcll(__ballot(p)); }
__device__ __forceinline__ void select_full(const LAS unsigned* my, int npad, LAS unsigned short* lst, int lane) {
    unsigned thr = 0u;
    for (int bit = 31; bit >= 0; --bit) {
        const unsigned cand = thr | (1u << bit); int cnt = 0;
        for (int i0 = 0; i0 < npad; i0 += 256) { const int idx = i0 + 4 * lane; v4u v = (v4u){0u, 0u, 0u, 0u}; if (idx < npad) v = *(const LAS v4u*)(my + idx);
            cnt += bcount(v.x >= cand) + bcount(v.y >= cand) + bcount(v.z >= cand) + bcount(v.w >= cand); }
        if (cnt >= 256) thr = cand;
    }
    int cgt = 0;
    for (int i0 = 0; i0 < npad; i0 += 256) { const int idx = i0 + 4 * lane; v4u v = (v4u){0u, 0u, 0u, 0u}; if (idx < npad) v = *(const LAS v4u*)(my + idx);
        cgt += bcount(v.x > thr) + bcount(v.y > thr) + bcount(v.z > thr) + bcount(v.w > thr); }
    const int quota = 256 - cgt; int eqseen = 0, nsel = 0;
    for (int base = 0; base < npad; base += 64) { const int idx = base + lane; unsigned u = 0u; if (idx < npad) u = my[idx];
        const bool gt = u > thr, eq = (u == thr);
        const unsigned long long em = __ballot(eq); const int er = eqseen + lane_rank(em);
        const bool sel = gt || (eq && er < quota);
        const unsigned long long sm = __ballot(sel); const int pos = nsel + lane_rank(sm);
        if (sel && pos < 256) lst[pos] = (unsigned short)idx;
        nsel += __popcll(sm); eqseen += __popcll(em); }
}
template <int KMAX> __device__ __forceinline__ void select_cands(const unsigned (&uu)[16], const unsigned (&id)[16], LAS unsigned short* lst, int lane, unsigned lb = 0u) {
    unsigned thr = 0u;
    for (int bit = 31; bit >= 0; --bit) {
        if ((((thr ^ lb) >> bit) >> 1) == 0u && ((lb >> bit) & 1u)) { thr |= (1u << bit); continue; }
        const unsigned cand = thr | (1u << bit); int cnt = 0;
#pragma unroll
        for (int k = 0; k < KMAX; ++k) cnt += bcount(uu[k] >= cand);
        if (cnt >= 256) { thr = cand; if (cnt == 256) break; }
    }
    int cgt = 0, ceq = 0;
#pragma unroll
    for (int k = 0; k < KMAX; ++k) { cgt += bcount(uu[k] > thr); ceq += bcount(uu[k] == thr); }
    const int quota = 256 - cgt; unsigned ilim = 0xFFFFu;
    if (ceq != quota) {
        unsigned I = 0u;
        for (int bit = 12; bit >= 0; --bit) { const unsigned cand = I | (1u << bit); int cnt = 0;
#pragma unroll
            for (int k = 0; k < KMAX; ++k) cnt += bcount(uu[k] == thr && id[k] < cand);
            if (cnt < quota) I = cand; }
        ilim = I;
    }
    int nsel = 0;
#pragma unroll
    for (int k = 0; k < KMAX; ++k) { const bool sel = (uu[k] > thr) || (uu[k] == thr && id[k] <= ilim);
        const unsigned long long sm = __ballot(sel); const int pos = nsel + lane_rank(sm);
        if (sel && pos < 256) lst[pos] = (unsigned short)id[k];
        nsel += __popcll(sm); }
}
__device__ __forceinline__ void dsa2_unit(int b, int qg, const bf16* IQ, const bf16* IK, const float* IW, const bf16* DQ, const bf16* DK, const bf16* DV, bf16* OB, LAS unsigned char* lds, int wave, int lane) {
    LAS unsigned* sc = (LAS unsigned*)lds;
    LAS unsigned short* LST = (LAS unsigned short*)(lds + D2_LST);
    LAS int* CNT = (LAS int*)(lds + D2_CNT);
    LAS unsigned short* CL = (LAS unsigned short*)(lds + D2_CL);
    const int q0 = 4 * qg, r32 = lane & 31, hi = lane >> 5; const size_t rowbase = (size_t)b * SEQ;
    const int ntile = (q0 + 3) / 32 + 1, npad = ntile * 32;
#ifndef REP_A
#define REP_A 1
#define REP_B1 1
#define REP_B2 1
#define REP_C 1
#endif
    for (int repa = 0; repa < REP_A; ++repa)
    {
        const int qi = 2 * ((r32 >> 2) & 1) + (r32 >> 4), hd = 4 * ((r32 >> 3) & 1) + (r32 & 3);
        bf16x8 aq[4];
#pragma unroll
        for (int ks = 0; ks < 4; ++ks) aq[ks] = *(const bf16x8*)(IQ + (rowbase + q0 + qi) * 512 + hd * 64 + ks * 16 + hi * 8);
        const float* w0p = IW + (rowbase + q0 + 2 * hi) * 8;
        const f32x4 w0a = *(const f32x4*)(w0p), w0b = *(const f32x4*)(w0p + 4), w1a = *(const f32x4*)(w0p + 8), w1b = *(const f32x4*)(w0p + 12);
        for (int t = wave; t < ntile; t += 32) {
            bf16x8 bk[4][4];
#pragma unroll
            for (int u = 0; u < 4; ++u) { const int tt = t + 8 * u; const bf16* kr = IK + (rowbase + 32 * (tt < ntile ? tt : t)) * 64 + lane * 8;
#pragma unroll
                for (int ks = 0; ks < 4; ++ks) bk[u][ks] = *(const bf16x8*)(kr + ks * 512); }
#pragma unroll
            for (int u = 0; u < 4; ++u) { const int tt = t + 8 * u;
                if (tt < ntile) {
                    const int key = 32 * tt + r32;
                    f32x16 a;
#pragma unroll
                    for (int r = 0; r < 16; ++r) a[r] = 0.f;
#pragma unroll
                    for (int ks = 0; ks < 4; ++ks) a = __builtin_amdgcn_mfma_f32_32x32x16_bf16(aq[ks], bk[u][ks], a, 0, 0, 0);
                    float s0 = 0.f, s1 = 0.f;
#pragma unroll
                    for (int j = 0; j < 4; ++j) { s0 += w0a[j] * fmaxf(a[j], 0.f); s1 += w1a[j] * fmaxf(a[8 + j], 0.f); }
#pragma unroll
                    for (int j = 0; j < 4; ++j) { s0 += w0b[j] * fmaxf(a[4 + j], 0.f); s1 += w1b[j] * fmaxf(a[12 + j], 0.f); }
                    sc[(2 * hi) * 8192 + key] = (key <= q0 + 2 * hi) ? sortable_u32(s0) : 0u;
                    sc[(2 * hi + 1) * 8192 + key] = (key <= q0 + 2 * hi + 1) ? sortable_u32(s1) : 0u;
                } }
        }
    }
    __syncthreads();
    const int qi = wave & 3, hf = wave >> 2, q = q0 + qi, n = q + 1;
    const LAS unsigned* my = sc + qi * 8192;
    for (int repb = 0; repb < REP_B1; ++repb)
    {
        int c = 0; bool ovf = false;
        if (n > 256) {
            unsigned pivot = 1u;
            if (n > 640) {
                unsigned s[8];
#pragma unroll
                for (int k = 0; k < 8; ++k) s[k] = my[(int)(((unsigned)(lane * 8 + k) * (unsigned)n) >> 9)];
                const int r = (256 * 512 * 7 / 4) / n + 8;
                unsigned t16 = 0u;
                for (int bit = 15; bit >= 0; --bit) { const unsigned cand = (t16 | (1u << bit)) << 16; int cnt = 0;
#pragma unroll
                    for (int k = 0; k < 8; ++k) cnt += bcount(s[k] >= cand);
                    if (cnt >= r) t16 |= (1u << bit); }
                pivot = t16 << 16; if (pivot == 0u) pivot = 1u;
            }
            const int half = ((npad + 511) >> 9) << 8; const int lo = hf * half; const int hiend = (lo + half < npad) ? lo + half : npad;
            LAS unsigned short* cl = CL + wave * 1024;
            for (int i0 = lo; i0 < hiend; i0 += 256) { const int idx = i0 + 4 * lane; v4u v = (v4u){0u, 0u, 0u, 0u}; if (idx < hiend) v = *(const LAS v4u*)(my + idx);
#pragma unroll
                for (int e = 0; e < 4; ++e) { const bool f = v[e] >= pivot; const unsigned long long m = __ballot(f); const int pos = c + lane_rank(m);
                    if (f) { if (pos < 1024) cl[pos] = (unsigned short)(idx + e); }
                    c += __popcll(m); } }
            if (c > 1024) ovf = true;
        }
        if (lane == 0) CNT[wave] = ovf ? -1 : c;
    }
    __syncthreads();
    for (int repb2 = 0; repb2 < REP_B2; ++repb2)
    if (wave < 4) {
        LAS unsigned short* lst = LST + wave * 256; int nsel;
        if (n <= 256) { for (int i = lane; i < n; i += 64) lst[i] = (unsigned short)i; nsel = n; }
        else {
            const int c0 = CNT[wave], c1 = CNT[wave + 4]; const int c = c0 + c1;
            if (c0 < 0 || c1 < 0 || c < 256 || c > 1024) select_full(my, npad, lst, lane);
            else {
                unsigned uu[16], id[16];
#pragma unroll
                for (int k = 0; k < 16; ++k) { const int j = k * 64 + lane; unsigned ix = 0u, u = 0u;
                    if (j < c) { ix = (j < c0) ? (unsigned)CL[wave * 1024 + j] : (unsigned)CL[(wave + 4) * 1024 + (j - c0)]; u = my[ix]; }
                    uu[k] = u; id[k] = ix; }
                if (c <= 512) select_cands<8>(uu, id, lst, lane); else select_cands<16>(uu, id, lst, lane);
            }
            nsel = 256;
        }
        if (lane == 0) CNT[8 + wave] = nsel;
    }
    __syncthreads();
    for (int repc = 0; repc < REP_C; ++repc)
    {
        const int nsel = CNT[8 + qi]; const int j0 = 128 * hf; int cntk = nsel - j0; cntk = cntk < 0 ? 0 : (cntk > 128 ? 128 : cntk);
        const LAS unsigned short* lst = LST + qi * 256;
        LAS unsigned char* tile = lds + wave * 16384;
        LAS float* tf = (LAS float*)tile;
        const int l15 = lane & 15, kq = lane >> 4;
        if (cntk == 0) {
#pragma unroll
            for (int i = 0; i < 8; ++i) tf[i * 64 + lane] = 0.f;
            if (lane < 8) { tf[512 + lane] = -INFINITY; tf[520 + lane] = 0.f; }
        } else {
#pragma unroll
            for (int it = 0; it < 16; ++it) { const int r = 8 * it + (lane >> 3), ch = lane & 7; int j = j0 + r; j = j < nsel ? j : nsel - 1;
                const int idxv = (int)lst[j]; const v4u v = *(const v4u*)(DV + (rowbase + idxv) * 64 + 8 * ch);
                *(LAS v4u*)(tile + r * 128 + ch * 16) = v; }
            bf16x8 qf[2];
#pragma unroll
            for (int ks = 0; ks < 2; ++ks) { v4u z = (v4u){0u, 0u, 0u, 0u}; if (l15 < 8) z = *(const v4u*)(DQ + (rowbase + q) * 512 + l15 * 64 + 32 * ks + 8 * kq); qf[ks] = __builtin_bit_cast(bf16x8, z); }
            f32x4d acc[8];
#pragma unroll
            for (int g = 0; g < 8; ++g) { int j = j0 + 16 * g + l15; j = j < nsel ? j : nsel - 1; const int idxk = (int)lst[j];
                const bf16* kp = DK + (rowbase + idxk) * 64 + 8 * kq;
                const bf16x8 k0 = *(const bf16x8*)(kp), k1 = *(const bf16x8*)(kp + 32);
                f32x4d a = (f32x4d){0.f, 0.f, 0.f, 0.f};
                a = __builtin_amdgcn_mfma_f32_16x16x32_bf16(k0, qf[0], a, 0, 0, 0); a = __builtin_amdgcn_mfma_f32_16x16x32_bf16(k1, qf[1], a, 0, 0, 0); acc[g] = a; }
            float mx = -INFINITY;
#pragma unroll
            for (int g = 0; g < 8; ++g)
#pragma unroll
                for (int e = 0; e < 4; ++e) { if (16 * g + 4 * kq + e >= cntk) acc[g][e] = -INFINITY; mx = fmaxf(mx, acc[g][e]); }
            mx = fmaxf(mx, __shfl_xor(mx, 16)); mx = fmaxf(mx, __shfl_xor(mx, 32));
            float ls = 0.f;
#pragma unroll
            for (int g = 0; g < 8; ++g)
#pragma unroll
                for (int e = 0; e < 4; ++e) { acc[g][e] = __builtin_amdgcn_exp2f(acc[g][e] - mx); ls += acc[g][e]; }
            ls += __shfl_xor(ls, 16); ls += __shfl_xor(ls, 32);
            bf16x8 pa[4];
#pragma unroll
            for (int t = 0; t < 4; ++t) { v4u w; w.x = cvtpk(acc[2 * t][0], acc[2 * t][1]); w.y = cvtpk(acc[2 * t][2], acc[2 * t][3]); w.z = cvtpk(acc[2 * t + 1][0], acc[2 * t + 1][1]); w.w = cvtpk(acc[2 * t + 1][2], acc[2 * t + 1][3]); pa[t] = __builtin_bit_cast(bf16x8, w); }
            f32x4d o[4];
            const int q_ = l15 >> 2, p_ = lane & 3;
#pragma unroll
            for (int cb = 0; cb < 4; ++cb) { f32x4d oc = (f32x4d){0.f, 0.f, 0.f, 0.f};
#pragma unroll
                for (int t = 0; t < 4; ++t) {
                    const LAS unsigned char* a1 = tile + (32 * t + 4 * kq + q_) * 128 + (16 * cb + 4 * p_) * 2;
                    const v4i16_t lo4 = __builtin_amdgcn_ds_read_tr16_b64_v4i16((LAS v4i16_t*)a1), hi4 = __builtin_amdgcn_ds_read_tr16_b64_v4i16((LAS v4i16_t*)(a1 + 16 * 128));
                    const bf16x8 vf = (bf16x8){lo4[0], lo4[1], lo4[2], lo4[3], hi4[0], hi4[1], hi4[2], hi4[3]};
                    oc = __builtin_amdgcn_mfma_f32_16x16x32_bf16(pa[t], vf, oc, 0, 0, 0); }
                o[cb] = oc; }
            if (kq < 2) {
#pragma unroll
                for (int cb = 0; cb < 4; ++cb)
#pragma unroll
                    for (int e = 0; e < 4; ++e) tf[(4 * kq + e) * 64 + 16 * cb + l15] = o[cb][e];
            }
            if (lane < 8) { tf[512 + lane] = mx; tf[520 + lane] = ls; }
        }
    }
    __syncthreads();
    if (wave < 4) {
        const LAS float* ta = (const LAS float*)(lds + wave * 16384); const LAS float* tb = (const LAS float*)(lds + (wave + 4) * 16384);
        const int h = lane >> 3, d0 = (lane & 7) * 8;
        const float ma = ta[512 + h], mb = tb[512 + h], la = ta[520 + h], lb = tb[520 + h];
        const float m = fmaxf(ma, mb), fa = __builtin_amdgcn_exp2f(ma - m), fb = __builtin_amdgcn_exp2f(mb - m);
        const float inv = 1.0f / (la * fa + lb * fb);
        const f32x4 a0 = *(const LAS f32x4*)(ta + h * 64 + d0), a1 = *(const LAS f32x4*)(ta + h * 64 + d0 + 4), b0 = *(const LAS f32x4*)(tb + h * 64 + d0), b1 = *(const LAS f32x4*)(tb + h * 64 + d0 + 4);
        const f32x4 r0 = (a0 * fa + b0 * fb) * inv, r1 = (a1 * fa + b1 * fb) * inv;
        v4u w; w.x = cvtpk(r0[0], r0[1]); w.y = cvtpk(r0[2], r0[3]); w.z = cvtpk(r1[0], r1[1]); w.w = cvtpk(r1[2], r1[3]);
        *(v4u*)(OB + (rowbase + q) * 512 + h * 64 + d0) = w;
    }
    __syncthreads();
}
constexpr int D3_RING = RING_BYTES + 1024;
constexpr int D3_LST = D3_RING + 16384;
constexpr int D3_CNT = D3_LST + 8192;
constexpr int D3_QW = D3_CNT + 512;
typedef unsigned long long u64d;
template <int KMAX> __device__ __forceinline__ void select_cands3(const unsigned (&uu)[16], const unsigned (&id)[16], LAS unsigned short* lst, int lane) { select_cands<KMAX>(uu, id, lst, lane); }
__device__ __forceinline__ void dsa3_unit(int b, int g16, const bf16* IQ, const bf16* IK, const float* IW, const bf16* DQ, const bf16* DK, const bf16* DV, bf16* OB, LAS unsigned char* lds, int wave, int lane_in) {
    int lane = lane_in; asm volatile("" : "+v"(lane));
    LAS u64d* LISTS = (LAS u64d*)lds;
    LAS unsigned short* LST = (LAS unsigned short*)(lds + D3_LST);
    LAS int* CNT = (LAS int*)(lds + D3_CNT);
    const int tid = wave * 64 + lane, r32 = lane & 31, hi = lane >> 5; const size_t rowbase = (size_t)b * SEQ;
    const int q0 = 16 * g16, ntile = (q0 + 15) / 32 + 1, nstep = (ntile + 1) >> 1;
    const int qgrp = wave & 3, par = wave >> 2;
    const int qA = q0 + 4 * qgrp + 2 * hi, qB = qA + 1;
    const int qi = 2 * ((r32 >> 2) & 1) + (r32 >> 4), hd = 4 * ((r32 >> 3) & 1) + (r32 & 3);
    bf16x8 aq[4];
#pragma unroll
    for (int ks = 0; ks < 4; ++ks) aq[ks] = *(const bf16x8*)(IQ + (rowbase + q0 + 4 * qgrp + qi) * 512 + hd * 64 + ks * 16 + hi * 8);
    const float* w0p = IW + (rowbase + qA) * 8;
    const f32x4 w0a = *(const f32x4*)(w0p), w0b = *(const f32x4*)(w0p + 4), w1a = *(const f32x4*)(w0p + 8), w1b = *(const f32x4*)(w0p + 12);
    f32x4 l0a, l0b, l1a, l1b;
#pragma unroll
    for (int j = 0; j < 4; ++j) { l0a[j] = w0a[j] >= 0.f ? INFINITY : -INFINITY; l0b[j] = w0b[j] >= 0.f ? INFINITY : -INFINITY; l1a[j] = w1a[j] >= 0.f ? INFINITY : -INFINITY; l1b[j] = w1b[j] >= 0.f ? INFINITY : -INFINITY; }
#define D3_SCORE(BK, S0, S1) do { f32x16 a_; _Pragma("unroll") for (int r = 0; r < 16; ++r) a_[r] = 0.f; \
        _Pragma("unroll") for (int ks = 0; ks < 4; ++ks) a_ = __builtin_amdgcn_mfma_f32_32x32x16_bf16(aq[ks], BK[ks], a_, 0, 0, 0); \
        S0 = 0.f; S1 = 0.f; \
        _Pragma("unroll") for (int j = 0; j < 4; ++j) { S0 += __builtin_amdgcn_fmed3f(w0a[j] * a_[j], 0.f, l0a[j]); S1 += __builtin_amdgcn_fmed3f(w1a[j] * a_[8 + j], 0.f, l1a[j]); } \
        _Pragma("unroll") for (int j = 0; j < 4; ++j) { S0 += __builtin_amdgcn_fmed3f(w0b[j] * a_[4 + j], 0.f, l0b[j]); S1 += __builtin_amdgcn_fmed3f(w1b[j] * a_[12 + j], 0.f, l1b[j]); } } while (0)
#ifndef REP_S
#define REP_S 1
#define REP_M 1
#define REP_B 1
#define REP_CD 1
#endif
    unsigned pivA = 1u, pivB = 1u;
    if (ntile <= 16 && tid < 16) CNT[64 + tid] = 0;
    for (int reps = 0; reps < REP_S; ++reps)
    if (ntile > 16) {
#pragma unroll
        for (int k = 0; k < 4; ++k) { const int c = tid + 512 * k; const int ts = ((c >> 8) * ntile) >> 3;
            *(LAS v4u*)(lds + c * 16) = *(const v4u*)(IK + (rowbase + 32 * ts) * 64 + (c & 255) * 8); }
        __syncthreads();
        unsigned uA[8], uB[8];
#pragma unroll
        for (int i = 0; i < 8; ++i) { bf16x8 bk[4];
#pragma unroll
            for (int ks = 0; ks < 4; ++ks) bk[ks] = *(const LAS bf16x8*)(lds + i * 4096 + ks * 1024 + lane * 16);
            float s0, s1; D3_SCORE(bk, s0, s1); uA[i] = sortable_u32(s0); uB[i] = sortable_u32(s1); asm volatile("" ::: "memory"); }
        const int qs = q0 + 4 * qgrp + par;
        const int r0 = (256 * 256 * 7 / 4) / (qs + 1) + 6, r1 = (256 * 256 * 7 / 4) / (qs + 3) + 6;
        unsigned us[8];
#pragma unroll
        for (int i = 0; i < 8; ++i) us[i] = par ? uB[i] : uA[i];
        unsigned t0 = 0u, t1 = 0u;
        for (int bit = 15; bit >= 0; --bit) {
            const unsigned c = ((hi ? t1 : t0) | (1u << bit)) << 16; int n0 = 0, n1 = 0;
#pragma unroll
            for (int i = 0; i < 8; ++i) { const unsigned long long m = __builtin_amdgcn_ballot_w64(us[i] >= c); n0 += __popc((unsigned)m); n1 += __popc((unsigned)(m >> 32)); }
            if (n0 >= r0) t0 |= (1u << bit);
            if (n1 >= r1) t1 |= (1u << bit);
        }
        LAS unsigned* PV = (LAS unsigned*)(CNT + 64);
        if (lane == 0) { PV[4 * qgrp + par] = t0; PV[4 * qgrp + 2 + par] = t1; }
        __syncthreads();
        const unsigned tA = PV[4 * qgrp + 2 * hi], tB = PV[4 * qgrp + 2 * hi + 1];
        pivA = tA << 16; pivB = tB << 16; if (pivA == 0u) pivA = 1u; if (pivB == 0u) pivB = 1u;
        __syncthreads();
    }
    for (int repm = 0; repm < REP_M; ++repm)
    {
        const bf16* src0 = IK + rowbase * 64 + (size_t)(tid & 255) * 8;
#define D3_LOAD(k_) (*(const v4u*)(src0 + (size_t)32 * ((2 * (k_) + (tid >> 8)) < ntile ? (2 * (k_) + (tid >> 8)) : ntile - 1) * 64))
        v4u st0 = (v4u){0u, 0u, 0u, 0u}, st1 = st0, st2 = st0, st3 = st0;
        st0 = D3_LOAD(0); st1 = D3_LOAD(1); st2 = D3_LOAD(2); st3 = D3_LOAD(3);
        *(LAS v4u*)(lds + D3_RING + tid * 16) = st0;
        __syncthreads();
        int cntA = 0, cntB = 0;
        LAS u64d* lA = LISTS + ((4 * qgrp + 2 * hi) * 2 + par) * 512; LAS u64d* lB = lA + 1024;
        f32x16 acc;
#pragma unroll
        for (int r = 0; r < 16; ++r) acc[r] = 0.f;
#define D3_SUMS(S0, S1) do { S0 = 0.f; S1 = 0.f; \
            _Pragma("unroll") for (int j = 0; j < 4; ++j) { S0 += __builtin_amdgcn_fmed3f(w0a[j] * acc[j], 0.f, l0a[j]); S1 += __builtin_amdgcn_fmed3f(w1a[j] * acc[8 + j], 0.f, l1a[j]); } \
            _Pragma("unroll") for (int j = 0; j < 4; ++j) { S0 += __builtin_amdgcn_fmed3f(w0b[j] * acc[4 + j], 0.f, l0b[j]); S1 += __builtin_amdgcn_fmed3f(w1b[j] * acc[12 + j], 0.f, l1b[j]); } } while (0)
#define D3_FILTER(TP, S0, S1) do { const int key = 32 * (TP) + r32; const unsigned u0 = sortable_u32(S0), u1 = sortable_u32(S1); \
                { const bool ps = (key <= qA) && (u0 >= pivA); const unsigned long long m = __ballot(ps); const unsigned ml = (unsigned)m, mh = (unsigned)(m >> 32); \
                  const int pos = cntA + (int)__builtin_amdgcn_mbcnt_hi(mh, __builtin_amdgcn_mbcnt_lo(ml, 0u)) - (hi ? __popc(ml) : 0); \
                  if (ps && pos < 512) lA[pos] = ((u64d)(unsigned)key << 32) | u0; cntA += hi ? __popc(mh) : __popc(ml); } \
                { const bool ps = (key <= qB) && (u1 >= pivB); const unsigned long long m = __ballot(ps); const unsigned ml = (unsigned)m, mh = (unsigned)(m >> 32); \
                  const int pos = cntB + (int)__builtin_amdgcn_mbcnt_hi(mh, __builtin_amdgcn_mbcnt_lo(ml, 0u)) - (hi ? __popc(ml) : 0); \
                  if (ps && pos < 512) lB[pos] = ((u64d)(unsigned)key << 32) | u1; cntB += hi ? __popc(mh) : __popc(ml); } } while (0)
#define D3_STEP(k_, STNEXT, STFREE) do { \
            STFREE = D3_LOAD((k_) + 4); \
            const int tp_ = 2 * (k_) - 2 + par; \
            const LAS unsigned char* sb = lds + D3_RING + ((k_) & 1) * 8192 + par * 4096; bf16x8 bk[4]; \
            _Pragma("unroll") for (int ks = 0; ks < 4; ++ks) bk[ks] = *(const LAS bf16x8*)(sb + ks * 1024 + lane * 16); \
            __builtin_amdgcn_sched_barrier(0); \
            float s0, s1; D3_SUMS(s0, s1); asm volatile("" : "+v"(s0), "+v"(s1));     \
            __builtin_amdgcn_sched_barrier(0); \
            _Pragma("unroll") for (int r = 0; r < 16; ++r) acc[r] = 0.f; \
            _Pragma("unroll") for (int ks = 0; ks < 4; ++ks) acc = __builtin_amdgcn_mfma_f32_32x32x16_bf16(aq[ks], bk[ks], acc, 0, 0, 0); \
            __builtin_amdgcn_sched_barrier(0); \
            if (tp_ >= 0 && tp_ < ntile) D3_FILTER(tp_, s0, s1); \
            *(LAS v4u*)(lds + D3_RING + (((k_) + 1) & 1) * 8192 + tid * 16) = STNEXT; \
            asm volatile("s_waitcnt lgkmcnt(0)" ::: "memory"); __builtin_amdgcn_s_barrier(); asm volatile("" ::: "memory"); } while (0)
        int kend = 0;
        for (int k = 0; k < nstep; k += 4) {
            D3_STEP(k, st1, st0); D3_STEP(k + 1, st2, st1); D3_STEP(k + 2, st3, st2); D3_STEP(k + 3, st0, st3); kend = k + 4;
        }
        {   const int tp_ = 2 * kend - 2 + par; if (tp_ < ntile) { float s0, s1; D3_SUMS(s0, s1); D3_FILTER(tp_, s0, s1); } }
#undef D3_SUMS
#undef D3_FILTER
#undef D3_STEP
#undef D3_LOAD
        if (r32 == 0) { CNT[(4 * qgrp + 2 * hi) * 2 + par] = cntA; CNT[(4 * qgrp + 2 * hi + 1) * 2 + par] = cntB; }
        if (tid < 4) CNT[48 + tid] = 0;
    }
#undef D3_SCORE
    __syncthreads();
#if defined(DBG_D3_STAGE) && DBG_D3_STAGE == 1
    for (int grp = 0; grp < 4; ++grp) dsa2_unit(b, 4 * g16 + grp, IQ, IK, IW, DQ, DK, DV, OB, lds, wave, lane);
    return;
#endif
#pragma unroll 1
    for (int rr = 0; rr < 2 * REP_B; ++rr) {
        const int qx = wave + 8 * (rr & 1), q = q0 + qx, n = q + 1; LAS unsigned short* lst = LST + qx * 256; int nsel;
        if (n <= 256) { for (int i = lane; i < n; i += 64) lst[i] = (unsigned short)i; nsel = n; }
        else {
            const int c0 = CNT[2 * qx], c1 = CNT[2 * qx + 1]; const int c = c0 + c1;
#ifdef DBG_D3_ALLFAIL
            if (true) { if (lane == 0) CNT[48 + (qx >> 2)] = 1; nsel = 0; }
#else
            if (c0 > 512 || c1 > 512 || c < 256) { if (lane == 0) CNT[48 + (qx >> 2)] = 1; nsel = 0; }
#endif
            else {
                unsigned uu[16], id[16]; const LAS u64d* L0 = LISTS + (qx * 2) * 512; const LAS u64d* L1 = L0 + 512;
#pragma unroll
                for (int k = 0; k < 16; ++k) { const int j = k * 64 + lane, jj = j < c ? j : c - 1;
                    const u64d e = *((jj < c0) ? (L0 + jj) : (L1 + (jj - c0))); uu[k] = j < c ? (unsigned)e : 0u; id[k] = (unsigned)(e >> 32); }
                const unsigned lb = (unsigned)CNT[64 + qx] << 16;
                if (c <= 512) select_cands<8>(uu, id, lst, lane, lb); else if (c <= 640) select_cands<10>(uu, id, lst, lane, lb); else if (c <= 768) select_cands<12>(uu, id, lst, lane, lb); else select_cands<16>(uu, id, lst, lane, lb);
                nsel = 256;
            }
        }
        if (lane == 0) CNT[32 + qx] = nsel;
    }
    __syncthreads();
#pragma unroll 1
    for (int rr_ = 0; rr_ < 2 * REP_CD; ++rr_) { const int rr = rr_ & 1;
        const int qx = wave + 8 * rr, q = q0 + qx; const int nsel = CNT[32 + qx];
        const LAS unsigned short* lst = LST + qx * 256;
        LAS unsigned char* tile = lds + wave * 16384; LAS float* tf = (LAS float*)tile;
        const int l15 = lane & 15, kq = lane >> 4, q_ = l15 >> 2, p_ = lane & 3;
        bf16x8 qf[2];
#pragma unroll
        for (int ks = 0; ks < 2; ++ks) { v4u z = (v4u){0u, 0u, 0u, 0u}; if (l15 < 8) z = *(const v4u*)(DQ + (rowbase + q) * 512 + l15 * 64 + 32 * ks + 8 * kq); qf[ks] = __builtin_bit_cast(bf16x8, z); }
        float mrun = -INFINITY, lrun = 0.f; f32x4d orun[4];
#pragma unroll
        for (int cb = 0; cb < 4; ++cb) orun[cb] = (f32x4d){0.f, 0.f, 0.f, 0.f};
#pragma unroll 1
        for (int hf = 0; hf < 2; ++hf) {
            const int j0 = 128 * hf; int cntk = nsel - j0; cntk = cntk > 128 ? 128 : cntk;
            if (cntk <= 0) break;
            int iv[16], ik[8];
#pragma unroll
            for (int it = 0; it < 16; ++it) { int j = j0 + 8 * it + (lane >> 3); j = j < nsel ? j : nsel - 1; iv[it] = (int)lst[j]; }
#pragma unroll
            for (int g = 0; g < 8; ++g) { int j = j0 + 16 * g + l15; j = j < nsel ? j : nsel - 1; ik[g] = (int)lst[j]; }
            asm volatile("s_waitcnt lgkmcnt(0)" ::: "memory");
#pragma unroll
            for (int it = 0; it < 16; ++it)
                __builtin_amdgcn_global_load_lds((const unsigned*)(DV + (rowbase + iv[it]) * 64 + 8 * (lane & 7)), (LAS unsigned*)(tile + it * 1024), 16, 0, 0);
            bf16x8 kk0[8], kk1[8];
#pragma unroll
            for (int g = 0; g < 8; ++g) { const bf16* kp = DK + (rowbase + ik[g]) * 64 + 8 * kq; kk0[g] = *(const bf16x8*)(kp); kk1[g] = *(const bf16x8*)(kp + 32); }
            asm volatile("" ::: "memory");
            f32x4d acc[8];
#pragma unroll
            for (int g = 0; g < 8; ++g) { f32x4d a = (f32x4d){0.f, 0.f, 0.f, 0.f};
                a = __builtin_amdgcn_mfma_f32_16x16x32_bf16(kk0[g], qf[0], a, 0, 0, 0); a = __builtin_amdgcn_mfma_f32_16x16x32_bf16(kk1[g], qf[1], a, 0, 0, 0); acc[g] = a; }
            float mx = -INFINITY;
#pragma unroll
            for (int g = 0; g < 8; ++g)
#pragma unroll
                for (int e = 0; e < 4; ++e) { if (16 * g + 4 * kq + e >= cntk) acc[g][e] = -INFINITY; mx = fmaxf(mx, acc[g][e]); }
            mx = fmaxf(mx, __shfl_xor(mx, 16)); mx = fmaxf(mx, __shfl_xor(mx, 32));
            const float mnew = fmaxf(mrun, mx), fold = __builtin_amdgcn_exp2f(mrun - mnew);
            float ls = 0.f;
#pragma unroll
            for (int g = 0; g < 8; ++g)
#pragma unroll
                for (int e = 0; e < 4; ++e) { acc[g][e] = __builtin_amdgcn_exp2f(acc[g][e] - mnew); ls += acc[g][e]; }
            ls += __shfl_xor(ls, 16); ls += __shfl_xor(ls, 32);
            lrun = lrun * fold + ls; mrun = mnew;
            float fo[4];
#pragma unroll
            for (int e = 0; e < 4; ++e) fo[e] = __shfl(fold, 4 * kq + e);
            asm volatile("s_waitcnt vmcnt(0)" ::: "memory");
            bf16x8 pa[4];
#pragma unroll
            for (int t = 0; t < 4; ++t) { v4u w; w.x = cvtpk(acc[2 * t][0], acc[2 * t][1]); w.y = cvtpk(acc[2 * t][2], acc[2 * t][3]); w.z = cvtpk(acc[2 * t + 1][0], acc[2 * t + 1][1]); w.w = cvtpk(acc[2 * t + 1][2], acc[2 * t + 1][3]); pa[t] = __builtin_bit_cast(bf16x8, w); }
#pragma unroll
            for (int cb = 0; cb < 4; ++cb) { f32x4d oc = orun[cb];
#pragma unroll
                for (int e = 0; e < 4; ++e) oc[e] *= fo[e];
#pragma unroll
                for (int t = 0; t < 4; ++t) {
                    const LAS unsigned char* a1 = tile + (32 * t + 4 * kq + q_) * 128 + (16 * cb + 4 * p_) * 2;
                    const v4i16_t lo4 = __builtin_amdgcn_ds_read_tr16_b64_v4i16((LAS v4i16_t*)a1), hi4 = __builtin_amdgcn_ds_read_tr16_b64_v4i16((LAS v4i16_t*)(a1 + 16 * 128));
                    const bf16x8 vf = (bf16x8){lo4[0], lo4[1], lo4[2], lo4[3], hi4[0], hi4[1], hi4[2], hi4[3]};
                    oc = __builtin_amdgcn_mfma_f32_16x16x32_bf16(pa[t], vf, oc, 0, 0, 0); }
                orun[cb] = oc; }
        }
        float li[4];
#pragma unroll
        for (int e = 0; e < 4; ++e) li[e] = 1.0f / __shfl(lrun, 4 * kq + e);
        if (kq < 2) {
#pragma unroll
            for (int cb = 0; cb < 4; ++cb)
#pragma unroll
                for (int e = 0; e < 4; ++e) tf[(4 * kq + e) * 64 + 16 * cb + l15] = orun[cb][e] * li[e];
        }
        { const int h = lane >> 3, d0 = (lane & 7) * 8;
          const f32x4 r0 = *(const LAS f32x4*)(tf + h * 64 + d0), r1 = *(const LAS f32x4*)(tf + h * 64 + d0 + 4);
          v4u w; w.x = cvtpk(r0[0], r0[1]); w.y = cvtpk(r0[2], r0[3]); w.z = cvtpk(r1[0], r1[1]); w.w = cvtpk(r1[2], r1[3]);
          *(v4u*)(OB + (rowbase + q) * 512 + h * 64 + d0) = w; }
    }
    __syncthreads();
    const int f0 = CNT[48], f1 = CNT[49], f2 = CNT[50], f3 = CNT[51];
    __syncthreads();
    const int fm = (f0 ? 1 : 0) | (f1 ? 2 : 0) | (f2 ? 4 : 0) | (f3 ? 8 : 0);
#pragma unroll 1
    for (int grp = 0; grp < 4; ++grp) if ((fm >> grp) & 1) dsa2_unit(b, 4 * g16 + grp, IQ, IK, IW, DQ, DK, DV, OB, lds, wave, lane);
}
__device__ __forceinline__ void fox_unit2(int bh, int qb, const bf16* FQ, const bf16* FK, const bf16* FV, const float* CUM, const int* T0, bf16* OA, LAS unsigned char* lds, int wave, int lane) {
    const int b = bh >> 3, h = bh & 7, r32 = lane & 31, hi = lane >> 5; const size_t rowbase = (size_t)b * SEQ; const int q0 = qb * 256 + wave * 32;
    const bf16* Qw = FQ + (rowbase + q0) * 512 + h * 64; bf16* Ow = OA + (rowbase + q0) * 512 + h * 64;
    const bf16* Kp = FK + rowbase * 512 + h * 64; const bf16* Vp = FV + rowbase * 512 + h * 64; const float* cb = CUM + (size_t)bh * SEQ;
    LAS unsigned char* wl = lds + wave * 16384;
    LAS float* bl = (LAS float*)(lds + RING_BYTES + 8192 + wave * 256);
    bf16x8 qr[4];
#pragma unroll
    for (int ks = 0; ks < 4; ++ks) qr[ks] = *(const bf16x8*)(Qw + (size_t)r32 * 512 + ks * 16 + hi * 8);
    const int tstart = T0[bh * 256 + q0 / 32], ntiles = q0 / 32 + 1, qlocal = q0 + r32;
    f32x16 o[2];
#pragma unroll
    for (int d0 = 0; d0 < 2; ++d0)
#pragma unroll
        for (int r = 0; r < 16; ++r) o[d0][r] = 0.f;
    float m = -1e30f, l = 0.f;
    const int lrow = lane >> 3, lch = lane & 7;
#define FOX_LOAD(KR, VR, BR, tt) do { _Pragma("unroll") for (int it = 0; it < 4; ++it) { const size_t ro = (size_t)(32 * (tt) + 8 * it + lrow) * 512 + lch * 8; KR[it] = *(const v4u*)(Kp + ro); VR[it] = *(const v4u*)(Vp + ro); } BR = cb[32 * (tt) + r32]; } while (0)
#define FOX_STORE(KR, VR, BR, bf) do { _Pragma("unroll") for (int it = 0; it < 4; ++it) { const int row = 8 * it + lrow; *(LAS v4u*)(wl + (bf) * 4096 + row * 128 + ((lch ^ (row & 7)) * 16)) = KR[it]; *(LAS v4u*)(wl + 8192 + (bf) * 4096 + row * 128 + lch * 16) = VR[it]; } if (lane < 32) bl[(bf) * 32 + lane] = -L2E * BR; } while (0)
    v4u krA[4], vrA[4], krB[4], vrB[4]; float brA = 0.f, brB = 0.f;
    const int kq = (lane >> 4) & 1, q_ = (lane & 15) >> 2, p_ = lane & 3;
    FOX_LOAD(krA, vrA, brA, tstart);
    if (tstart + 1 < ntiles) FOX_LOAD(krB, vrB, brB, tstart + 1);
    FOX_STORE(krA, vrA, brA, 0);
    auto compute = [&](int t, int buf) {
        const LAS unsigned char* kb = wl + buf * 4096; const LAS unsigned char* vb = wl + 8192 + buf * 4096; const LAS float* bb = bl + buf * 32;
        f32x16 p;
#pragma unroll
        for (int r = 0; r < 16; ++r) p[r] = 0.f;
#pragma unroll
        for (int ks = 0; ks < 4; ++ks) { const bf16x8 kf = *(const LAS bf16x8*)(kb + r32 * 128 + (((2 * ks + hi) ^ (r32 & 7)) * 16)); p = __builtin_amdgcn_mfma_f32_32x32x16_bf16(kf, qr[ks], p, 0, 0, 0); }
#pragma unroll
        for (int g = 0; g < 4; ++g) { const f32x4 c4 = *(const LAS f32x4*)(bb + 8 * g + 4 * hi);
#pragma unroll
            for (int jj = 0; jj < 4; ++jj) p[4 * g + jj] += c4[jj]; }
        if (t == ntiles - 1) {
#pragma unroll
            for (int r = 0; r < 16; ++r) if (32 * t + crow(r, hi) > qlocal) p[r] = -INFINITY;
        }
        float mt = p[0];
#pragma unroll
        for (int r = 1; r < 16; ++r) mt = fmaxf(mt, p[r]);
        mt = fmaxf(mt, __shfl_xor(mt, 32));
        const float mn = fmaxf(m, mt); const float alpha = __builtin_amdgcn_exp2f(m - mn); m = mn;
        l *= alpha;
#pragma unroll
        for (int d0 = 0; d0 < 2; ++d0)
#pragma unroll
            for (int r = 0; r < 16; ++r) o[d0][r] *= alpha;
        float ls = 0.f;
#pragma unroll
        for (int r = 0; r < 16; ++r) { p[r] = __builtin_amdgcn_exp2f(p[r] - mn); ls += p[r]; }
        l += ls;
        bf16x8 pa[2];
#pragma unroll
        for (int s2 = 0; s2 < 2; ++s2) { v4u w; w.x = cvtpk(p[8 * s2 + 0], p[8 * s2 + 1]); w.y = cvtpk(p[8 * s2 + 2], p[8 * s2 + 3]); w.z = cvtpk(p[8 * s2 + 4], p[8 * s2 + 5]); w.w = cvtpk(p[8 * s2 + 6], p[8 * s2 + 7]); pa[s2] = __builtin_bit_cast(bf16x8, w); }
#pragma unroll
        for (int d0 = 0; d0 < 2; ++d0)
#pragma unroll
            for (int s2 = 0; s2 < 2; ++s2) {
                const LAS unsigned char* a1 = vb + (16 * s2 + 4 * hi + q_) * 128 + (32 * d0 + 16 * kq + 4 * p_) * 2;
                const v4i16_t lo4 = __builtin_amdgcn_ds_read_tr16_b64_v4i16((LAS v4i16_t*)a1), hi4 = __builtin_amdgcn_ds_read_tr16_b64_v4i16((LAS v4i16_t*)(a1 + 8 * 128));
                const bf16x8 vf = (bf16x8){lo4[0], lo4[1], lo4[2], lo4[3], hi4[0], hi4[1], hi4[2], hi4[3]};
                o[d0] = __builtin_amdgcn_mfma_f32_32x32x16_bf16(vf, pa[s2], o[d0], 0, 0, 0);
            }
    };
    for (int t = tstart; t < ntiles; t += 2) {
        if (t + 2 < ntiles) FOX_LOAD(krA, vrA, brA, t + 2);
        compute(t, 0);
        if (t + 1 < ntiles) {
            FOX_STORE(krB, vrB, brB, 1);
            if (t + 3 < ntiles) FOX_LOAD(krB, vrB, brB, t + 3);
            compute(t + 1, 1);
            if (t + 2 < ntiles) FOX_STORE(krA, vrA, brA, 0);
        }
    }
#undef FOX_LOAD
#undef FOX_STORE
    l += __shfl_xor(l, 32);
    const float inv = 1.0f / l;
    bf16* orow = Ow + (size_t)r32 * 512;
#pragma unroll
    for (int d0 = 0; d0 < 2; ++d0)
#pragma unroll
        for (int g = 0; g < 4; ++g) { u32x2 w; w.x = cvtpk(o[d0][4 * g] * inv, o[d0][4 * g + 1] * inv); w.y = cvtpk(o[d0][4 * g + 2] * inv, o[d0][4 * g + 3] * inv);
            *(u32x2*)(orow + d0 * 32 + 8 * g + 4 * hi) = w; }
}
__device__ __forceinline__ void fox_unit4(int bh, int qb, const bf16* FQ, const bf16* FK, const bf16* FV, const float* CUM, const int* T0, const float* gq, const float* gk, bf16* OA, LAS unsigned char* lds, int wave, int lane) {
    const int b = bh >> 3, h = bh & 7, r32 = lane & 31, hi = lane >> 5; const size_t rowbase = (size_t)b * SEQ; const int q0 = qb * 256 + wave * 32;
    const bf16* Qw = FQ + (rowbase + q0) * 512 + h * 64; bf16* Ow = OA + (rowbase + q0) * 512 + h * 64;
    const bf16* Kp = FK + rowbase * 512 + h * 64; const bf16* Vp = FV + rowbase * 512 + h * 64; const float* cb = CUM + (size_t)bh * SEQ;
    LAS unsigned char* wl = lds + wave * 16384;
    LAS float* bl = (LAS float*)(lds + RING_BYTES + 8192 + wave * 256);
    bf16x8 qr[4];
#pragma unroll
    for (int ks = 0; ks < 4; ++ks) qr[ks] = *(const bf16x8*)(Qw + (size_t)r32 * 512 + ks * 16 + hi * 8);
    const int tstart = T0[bh * 256 + q0 / 32], tlast = q0 / 32, nseq = tlast - tstart + 1, qlocal = q0 + r32;
    const float stopc = (8.0f * wave_max(fabsf(gq[lane])) * wave_max(fabsf(gk[lane])) + 30.0f) * L2E;
    f32x16 o[2];
#pragma unroll
    for (int d0 = 0; d0 < 2; ++d0)
#pragma unroll
        for (int r = 0; r < 16; ++r) o[d0][r] = 0.f;
    float m = -1e30f, l = 0.f;
    const int lrow = lane >> 3, lch = lane & 7;
#define FOX_LOAD(KR, VR, BR, tt) do { _Pragma("unroll") for (int it = 0; it < 4; ++it) { const size_t ro = (size_t)(32 * (tt) + 8 * it + lrow) * 512 + lch * 8; KR[it] = *(const v4u*)(Kp + ro); VR[it] = *(const v4u*)(Vp + ro); } BR = cb[32 * (tt) + r32]; } while (0)
#define FOX_STORE(KR, VR, BR, bf) do { _Pragma("unroll") for (int it = 0; it < 4; ++it) { const int row = 8 * it + lrow; *(LAS v4u*)(wl + (bf) * 4096 + row * 128 + ((lch ^ (row & 7)) * 16)) = KR[it]; *(LAS v4u*)(wl + 8192 + (bf) * 4096 + row * 128 + lch * 16) = VR[it]; } if (lane < 32) bl[(bf) * 32 + lane] = -L2E * BR; } while (0)
    v4u krA[4], vrA[4], krB[4], vrB[4]; float brA = 0.f, brB = 0.f;
    const int kq = (lane >> 4) & 1, q_ = (lane & 15) >> 2, p_ = lane & 3;
    FOX_LOAD(krA, vrA, brA, tlast);
    if (1 < nseq) FOX_LOAD(krB, vrB, brB, tlast - 1);
    FOX_STORE(krA, vrA, brA, 0);
    auto compute = [&](int t, int buf) -> bool {
        const LAS unsigned char* kb = wl + buf * 4096; const LAS unsigned char* vb = wl + 8192 + buf * 4096; const LAS float* bb = bl + buf * 32;
        if (t != tlast) { const float bmax = bb[31]; if (__all(m > bmax + stopc)) return true; }
        f32x16 p;
#pragma unroll
        for (int r = 0; r < 16; ++r) p[r] = 0.f;
#pragma unroll
        for (int ks = 0; ks < 4; ++ks) { const bf16x8 kf = *(const LAS bf16x8*)(kb + r32 * 128 + (((2 * ks + hi) ^ (r32 & 7)) * 16)); p = __builtin_amdgcn_mfma_f32_32x32x16_bf16(kf, qr[ks], p, 0, 0, 0); }
#pragma unroll
        for (int g = 0; g < 4; ++g) { const f32x4 c4 = *(const LAS f32x4*)(bb + 8 * g + 4 * hi);
#pragma unroll
            for (int jj = 0; jj < 4; ++jj) p[4 * g + jj] += c4[jj]; }
        if (t == tlast) {
#pragma unroll
            for (int r = 0; r < 16; ++r) if (32 * t + crow(r, hi) > qlocal) p[r] = -INFINITY;
        }
        float mt = p[0];
#pragma unroll
        for (int r = 1; r < 16; ++r) mt = fmaxf(mt, p[r]);
        mt = fmaxf(mt, __shfl_xor(mt, 32));
        if (__any(mt > m)) {
            const float mn = fmaxf(m, mt); const float alpha = __builtin_amdgcn_exp2f(m - mn); m = mn;
            l *= alpha;
#pragma unroll
            for (int d0 = 0; d0 < 2; ++d0)
#pragma unroll
                for (int r = 0; r < 16; ++r) o[d0][r] *= alpha;
        }
        const float mn = m;
        float ls = 0.f;
#pragma unroll
        for (int r = 0; r < 16; ++r) { p[r] = __builtin_amdgcn_exp2f(p[r] - mn); ls += p[r]; }
        l += ls;
        bf16x8 pa[2];
#pragma unroll
        for (int s2 = 0; s2 < 2; ++s2) { v4u w; w.x = cvtpk(p[8 * s2 + 0], p[8 * s2 + 1]); w.y = cvtpk(p[8 * s2 + 2], p[8 * s2 + 3]); w.z = cvtpk(p[8 * s2 + 4], p[8 * s2 + 5]); w.w = cvtpk(p[8 * s2 + 6], p[8 * s2 + 7]); pa[s2] = __builtin_bit_cast(bf16x8, w); }
#pragma unroll
        for (int d0 = 0; d0 < 2; ++d0)
#pragma unroll
            for (int s2 = 0; s2 < 2; ++s2) {
                const LAS unsigned char* a1 = vb + (16 * s2 + 4 * hi + q_) * 128 + (32 * d0 + 16 * kq + 4 * p_) * 2;
                const v4i16_t lo4 = __builtin_amdgcn_ds_read_tr16_b64_v4i16((LAS v4i16_t*)a1), hi4 = __builtin_amdgcn_ds_read_tr16_b64_v4i16((LAS v4i16_t*)(a1 + 8 * 128));
                const bf16x8 vf = (bf16x8){lo4[0], lo4[1], lo4[2], lo4[3], hi4[0], hi4[1], hi4[2], hi4[3]};
                o[d0] = __builtin_amdgcn_mfma_f32_32x32x16_bf16(vf, pa[s2], o[d0], 0, 0, 0);
            }
        return false;
    };
    for (int i = 0; i < nseq; i += 2) {
        if (i + 2 < nseq) FOX_LOAD(krA, vrA, brA, tlast - (i + 2));
        if (compute(tlast - i, 0)) break;
        if (i + 1 < nseq) {
            FOX_STORE(krB, vrB, brB, 1);
            if (i + 3 < nseq) FOX_LOAD(krB, vrB, brB, tlast - (i + 3));
            if (compute(tlast - (i + 1), 1)) break;
            if (i + 2 < nseq) FOX_STORE(krA, vrA, brA, 0);
        }
    }
#undef FOX_LOAD
#undef FOX_STORE
    l += __shfl_xor(l, 32);
    const float inv = 1.0f / l;
    bf16* orow = Ow + (size_t)r32 * 512;
#pragma unroll
    for (int d0 = 0; d0 < 2; ++d0)
#pragma unroll
        for (int g = 0; g < 4; ++g) { u32x2 w; w.x = cvtpk(o[d0][4 * g] * inv, o[d0][4 * g + 1] * inv); w.y = cvtpk(o[d0][4 * g + 2] * inv, o[d0][4 * g + 3] * inv);
            *(u32x2*)(orow + d0 * 32 + 8 * g + 4 * hi) = w; }
}
#ifndef DBG_BRANCH_MASK
#define DBG_BRANCH_MASK 7
#endif
#ifndef DBG_NBR
#define DBG_NBR 3
#endif
#ifndef DBG_NOGATE
#define DBG_NOGATE 0
#endif
#ifndef DBG_NOBRANCH
#define DBG_NOBRANCH 0
#endif
#ifndef DBG_GATE_W
#define DBG_GATE_W WS_WGATE
#endif
#ifndef DBG_GATE_AS_BRANCH
#define DBG_GATE_AS_BRANCH 0
#endif
#ifndef REP_FOX
#define REP_FOX 1
#endif
#ifndef REP_DSA
#define REP_DSA 1
#endif
#ifndef REP_GEMM
#define REP_GEMM 1
#endif
#ifndef DBG_SUBST
#define DBG_SUBST 0
#endif
#ifndef P7SEL
#define P7SEL 3
#endif
#ifndef PHMASK
#define PHMASK 0xFFFF
#endif
struct Args { const void* in[24]; float* out; unsigned char* ws; };
#define CONVERT_GROUP(GRP, w_, nw_) do { \
    constexpr int I_GU = 16 * 176, I_D = 44 * 32, I_IN = 16 * 104, I_GT = 16 * 96, I_BR = 8 * 32, I_SQ = 16 * 32; \
    constexpr int NIT = (GRP) == 0 ? I_GU + I_SQ : (GRP) == 1 ? I_D + I_IN + I_GT + 3 * I_BR + I_SQ : I_GU + I_D; \
    LAS float* scr_ = (LAS float*)(L + RING_OFF + wave * 16384); \
    for (int it = (w_); it < NIT; it += (nw_)) { int r = it; \
        if ((GRP) == 0) { \
            if (r < I_GU) { transpose_item(0, ARG_IN(4), ARG_IN(5), 1024, DFF, ARG_IN(3), WSP(bf16, WS_WGU1), scr_, r, 176, lane); continue; } r -= I_GU; \
            transpose_item(1, ARG_IN(17), nullptr, 1024, 1024, ARG_IN(8), WSP(bf16, WS_WMKV), scr_, r, 32, lane); \
        } else if ((GRP) == 1) { \
            if (r < I_D) { transpose_item(1, ARG_IN(6), nullptr, DFF, 1024, nullptr, WSP(bf16, WS_WD1), scr_, r, 32, lane); continue; } r -= I_D; \
            if (r < I_IN) { transpose_item(2, ARG_IN(9), nullptr, 1024, DIN, ARG_IN(7), WSP(bf16, WS_WIN), scr_, r, 104, lane); continue; } r -= I_IN; \
            if (r < I_GT) { transpose_item(3, ARG_IN(9), nullptr, 1024, DIN, ARG_IN(7), WSP(bf16, WS_WGATE), scr_, r, 96, lane); continue; } r -= I_GT; \
            if (r < 3 * I_BR) { const int i = r / I_BR; transpose_item(1, ARG_IN(18) + (size_t)i * 512 * 1024, nullptr, 512, 1024, nullptr, WSP(bf16, WS_WBR) + (size_t)i * 1024 * 512, scr_, r % I_BR, 32, lane); continue; } r -= 3 * I_BR; \
            transpose_item(1, ARG_IN(19), nullptr, 1024, 1024, nullptr, WSP(bf16, WS_WOUT), scr_, r, 32, lane); \
        } else { \
            if (r < I_GU) { transpose_item(0, ARG_IN(21), ARG_IN(22), 1024, DFF, ARG_IN(20), WSP(bf16, WS_WGU2), scr_, r, 176, lane); continue; } r -= I_GU; \
            transpose_item(1, ARG_IN(23), nullptr, DFF, 1024, nullptr, WSP(bf16, WS_WD2), scr_, r, 32, lane); \
        } } } while (0)
__global__ void __launch_bounds__(NWAVES * 64, 2) fwd_mega(Args args) {
    extern __shared__ __attribute__((aligned(16))) unsigned char lds[];
    LAS unsigned char* L = (LAS unsigned char*)lds;
    volatile LAS unsigned* MISC = (volatile LAS unsigned*)(L + MISC_OFF);
    const int tid = threadIdx.x, lane = tid & 63, wave = __builtin_amdgcn_readfirstlane(tid >> 6);
    const int G = gridDim.x; const int bx = blockIdx.x; const int vcu = (G % 8 == 0) ? (bx % 8) * (G / 8) + bx / 8 : bx;
    const Args* ap = (const Args*)__builtin_amdgcn_kernarg_segment_ptr();
#define ARG_IN(k) ((const float*)ap->in[k])
#define WSP(type, off) ((type*)(ap->ws + (off)))
    gu32* ctl = (gu32*)(ap->ws + WS_CTL);
    for (int u = tid; u < (LDS_BYTES - LDSCTL_OFF) / 4; u += NWAVES * 64) ((LAS unsigned*)(L + LDSCTL_OFF))[u] = 0u;
    __syncthreads();
    XcdBarrier bar = xcd_barrier_post((unsigned*)(ctl + CW_BAR), MISC + 8);
#define GRID_BAR() xcd_barrier(bar)
    const int gw = vcu * NWAVES + wave, NGW = G * NWAVES;

#if (PHMASK >> 0) & 1
    {
        LAS float* scr = (LAS float*)(L + RING_OFF + wave * 16384);
        CONVERT_GROUP(0, gw, NGW);
        for (int m0 = gw; m0 < T + 512; m0 += 4 * NGW) {
            const float* xr[4]; bf16* orw[4]; float* ro[4]; bool ok[4];
#pragma unroll
            for (int r = 0; r < 4; ++r) { const int m = m0 + r * NGW; ok[r] = m < T + 512; const int mc = ok[r] ? m : gw;
                if (mc < T) { xr[r] = ARG_IN(0) + (size_t)mc * 1024; orw[r] = WSP(bf16, WS_HB) + (size_t)mc * 1024; ro[r] = WSP(float, WS_RSTDX) + mc; }
                else { xr[r] = ARG_IN(1) + (size_t)(mc - T) * 1024; orw[r] = WSP(bf16, WS_MEMB) + (size_t)(mc - T) * 1024; ro[r] = WSP(float, WS_RSTDM) + (mc - T); } }
            rows4_to_bf16_rstd(xr, orw, ro, ok, lane);
        }
        VM_WAIT(); __syncthreads();
        GRID_BAR();
    }
#endif
#if (PHMASK >> 1) & 1
    {
        if (bx >= G - 8) { pg8::Gemm g{WSP(bf16, WS_MEMB), WSP(bf16, WS_WMKV), 512, 1024, 1024}; pg8::StaticOrder S; S.init(512, 1024, G, bx - (G - 8));
        pg8::EpiMemKV E{WSP(float, WS_KVM), WSP(float, WS_RSTDM)};
        pg8::gemm_phase<pg8::EpiMemKV, pg8::StaticOrder, true, true>(L + RING_OFF, g, S, E); }
    }
#endif
#if (PHMASK >> 2) & 1
    {
        pg8::Gemm g{WSP(bf16, WS_HB), WSP(bf16, WS_WGU1), T, 2 * DFF, 1024}; pg8::StaticOrder S; S.init(T, 2 * DFF, G, bx);
        pg8::build_row_tab<0>(WSP(float, WS_RSTDX), S, (LAS float*)(L + RING_BYTES + 1024)); pg8::EpiSwiGLU<0> E{WSP(bf16, WS_HID), DFF, (LAS float*)(L + RING_BYTES + 1024)};
#pragma unroll 1
        for (int rep_ = 0; rep_ < REP_GEMM; ++rep_)
        pg8::gemm_phase<pg8::EpiSwiGLU<0>, pg8::StaticOrder, true, true>(L + RING_OFF, g, S, E);
        {
            const int nfull = (64 * 22) % G; const int nidle = (nfull == 0) ? G : G - nfull; const int first = G - nidle;
            if (bx >= first) { CONVERT_GROUP(1, (bx - first) * NWAVES + wave, nidle * NWAVES);
                for (int e = (bx - first) * NWAVES * 64 + tid; e < T * 32; e += nidle * NWAVES * 64) {
                    const int row = e >> 5, i = e & 31; const float inv_freq = powf(10000.0f, -(float)i * (1.0f / 32.0f));
                    const float ang = (float)((const int*)ap->in[2])[row] * inv_freq; float sn, cs; sincosf(ang, &sn, &cs); WSP(float, WS_COS)[e] = cs; WSP(float, WS_SIN)[e] = sn; } }
        }
        GRID_BAR();
    }
#endif
#if (PHMASK >> 3) & 1
    {
        pg8::Gemm g{WSP(bf16, WS_HID), WSP(bf16, WS_WD1), T, 1024, DFF}; pg8::StaticOrder S; S.init(T, 1024, G, bx);
        pg8::EpiResid2<true> E{ARG_IN(0), ap->out, WSP(bf16, WS_HB), WSP(float, WS_SSQ1), 0.5f};
#pragma unroll 1
        for (int rep_ = 0; rep_ < REP_GEMM; ++rep_)
        pg8::gemm_phase<pg8::EpiResid2<true>, pg8::StaticOrder, true, true>(L + RING_OFF, g, S, E);
        GRID_BAR();
    }
#endif
#if (PHMASK >> 4) & 1
    {
        pg8::Gemm g{WSP(bf16, WS_HB), WSP(bf16, WS_WIN), T, NPROJ, 1024}; pg8::StaticOrder S; S.init(T, NPROJ, G, bx);
        pg8::ProjOut PO{WSP(bf16, WS_FQ), WSP(bf16, WS_FK), WSP(bf16, WS_FV), WSP(bf16, WS_DQ), WSP(bf16, WS_IQ), WSP(bf16, WS_MQ), WSP(bf16, WS_DK), WSP(bf16, WS_DV), WSP(bf16, WS_IK), WSP(float, WS_LOGF), WSP(float, WS_IW), WSP(float, WS_COS), WSP(float, WS_SIN), ARG_IN(11), ARG_IN(12), ARG_IN(13), ARG_IN(14), ARG_IN(10)};
        pg8::build_row_tab<16>(WSP(float, WS_SSQ1), S, (LAS float*)(L + RING_BYTES + 1024)); pg8::EpiProj<16> E{PO, (LAS float*)(L + RING_BYTES + 1024), C2_64};
#pragma unroll 1
        for (int rep_ = 0; rep_ < REP_GEMM; ++rep_)
        pg8::gemm_phase<pg8::EpiProj<16>, pg8::StaticOrder, true, true>(L + RING_OFF, g, S, E);
        {
            const int nfull = (64 * 13) % G; const int nidle = (nfull == 0) ? G : G - nfull; const int first = G - nidle;
            if (bx >= first) { CONVERT_GROUP(2, (bx - first) * NWAVES + wave, nidle * NWAVES);
        for (int it = (bx - first) * NWAVES + wave; it < 2048; it += nidle * NWAVES) { const int row = it >> 2, h = it & 3;
                    const f32x2g kv = *(const f32x2g*)(WSP(float, WS_KVM) + (size_t)row * 1024 + h * 128 + 2 * lane); const f32x2g vv = *(const f32x2g*)(WSP(float, WS_KVM) + (size_t)row * 1024 + 512 + h * 128 + 2 * lane);
                    const float ss = wave_sum(kv.x * kv.x + kv.y * kv.y); const float rstd = 1.0f / sqrtf(ss * (1.0f / 128.0f) + 1e-6f);
                    const f32x2g gk = *(const f32x2g*)(ARG_IN(16) + 2 * lane);
                    *(unsigned*)(WSP(bf16, WS_KMB) + (size_t)row * 512 + h * 128 + 2 * lane) = pk2(kv.x * rstd * gk.x, kv.y * rstd * gk.y);
                    { const int bb = row >> 8, key = row & 255; bf16* vt = WSP(bf16, WS_VMB) + ((size_t)(bb * 4 + h) * 128 + 2 * lane) * MEMLEN + key; vt[0] = (bf16)f2bf(vv.x); vt[MEMLEN] = (bf16)f2bf(vv.y); } } }
        }
        GRID_BAR();
#if defined(DBG_DUMP_AFTER) && DBG_DUMP_AFTER == 4
        {
            const bf16* sa = WSP(bf16, DBG_DUMP_A); const bf16* sb = WSP(bf16, DBG_DUMP_B);
            for (size_t e = (size_t)vcu * 512 + tid; e < (size_t)T * 512; e += (size_t)G * 512) { const size_t row = e >> 9, c = e & 511;
                ap->out[row * 1024 + c] = bf2f(sa[row * DBG_PITCH + c]); ap->out[row * 1024 + 512 + c] = bf2f(sb[row * DBG_PITCH + c]); }
            return;
        }
#endif

    }
#endif
#if ((PHMASK >> 5) & 1) && !DBG_SUBST
    {
        for (int it = gw; it < 2048; it += NGW) mem_unit(it >> 2, it & 3, WSP(bf16, WS_MQ), WSP(bf16, WS_KMB), WSP(bf16, WS_VMB), ARG_IN(15), lane);
    }
#endif
#if ((PHMASK >> 6) & 1) && !DBG_SUBST
    {
        for (int rep_ = 0; rep_ < REP_FOX; ++rep_)
        for (int v = vcu; v < 256; v += G) { const int bh = v >> 4, s = v & 15;
            scan_unit(bh, WSP(float, WS_LOGF), WSP(float, WS_CUM), WSP(int, WS_T0), ARG_IN(11), ARG_IN(12), (LAS float*)(L + SCANX_OFF), (LAS float*)(L + RING_OFF), tid);
            asm volatile("s_waitcnt vmcnt(0)" ::: "memory"); __syncthreads();
            fox_unit4(bh, s, WSP(bf16, WS_FQ), WSP(bf16, WS_FK), WSP(bf16, WS_FV), WSP(float, WS_CUM), WSP(int, WS_T0), ARG_IN(11), ARG_IN(12), WSP(bf16, WS_OA), L, wave, lane); fox_unit4(bh, 31 - s, WSP(bf16, WS_FQ), WSP(bf16, WS_FK), WSP(bf16, WS_FV), WSP(float, WS_CUM), WSP(int, WS_T0), ARG_IN(11), ARG_IN(12), WSP(bf16, WS_OA), L, wave, lane); }
        __syncthreads();
        {
            gu32* qctr = ctl + CW_Q; LAS int* QW = (LAS int*)(L + D3_QW);
            const int pref = (vcu >> 5) & 1;
            unsigned raw = 0u; int cur;
            if (tid == 0) { unsigned u = __hip_atomic_fetch_add(qctr + 64 * pref, 1u, RLX_AGENT); int bsel = pref; if (u >= 512u) { bsel = pref ^ 1; u = __hip_atomic_fetch_add(qctr + 64 * bsel, 1u, RLX_AGENT); } QW[0] = (u < 512u) ? ((bsel << 16) | (int)u) : -1; }
            __syncthreads(); cur = QW[0]; __syncthreads();
            while (cur >= 0) {
                if (tid == 0) raw = __hip_atomic_fetch_add(qctr + 64 * pref, 1u, RLX_AGENT);
                dsa3_unit(cur >> 16, 511 - (cur & 0xffff), WSP(bf16, WS_IQ), WSP(bf16, WS_IK), WSP(float, WS_IW), WSP(bf16, WS_DQ), WSP(bf16, WS_DK), WSP(bf16, WS_DV), WSP(bf16, WS_OB), L, wave, lane);
                if (tid == 0) { unsigned u = raw; int bsel = pref; if (u >= 512u) { bsel = pref ^ 1; u = __hip_atomic_fetch_add(qctr + 64 * bsel, 1u, RLX_AGENT); } QW[0] = (u < 512u) ? ((bsel << 16) | (int)u) : -1; }
                __syncthreads(); cur = QW[0]; __syncthreads();
            }
        }
        GRID_BAR();
    }
#endif
#if (PHMASK >> 7) & 1
    {
        pg8::StaticOrder S; S.init(T, 1024, G, bx); pg8::build_row_tab<16>(WSP(float, WS_SSQ1), S, (LAS float*)(L + RING_BYTES + 1024));
#ifndef P7STREAM
#define P7STREAM 1
#endif
#if P7STREAM
        {   typedef pg8::P7Order<WS_HB, WS_WGATE, WS_OA, WS_OB, WS_MQ, WS_WBR> P7O; P7O O{S, (const char*)WSP(char, 0)};
            pg8::EpiP7 E{WSP(bf16, WS_GSCR), WSP(bf16, WS_MERGED), (LAS float*)(L + RING_BYTES + 1024)};
#ifndef REP_P7
#define REP_P7 1
#endif
#pragma unroll 1
            for (int rep7_ = 0; rep7_ < REP_P7; ++rep7_) pg8::gemm_stream<pg8::EpiP7, P7O>(L + RING_OFF, O, E); }
#pragma unroll 1
        for (int i = 0; i < 0; ++i) {
#else
#pragma unroll 1
        for (int rep_ = 0; rep_ < REP_GEMM; ++rep_)
#pragma unroll 1
        for (int i = 0; i < DBG_NBR; ++i) {
#endif
#if DBG_GATE_AS_BRANCH
            {   pg8::Gemm g{WSP(bf16, WS_HB), WSP(bf16, DBG_GATE_W), T, 1024, 1024}; pg8::EpiBranch E{WSP(bf16, WS_GSCR), WSP(bf16, WS_MERGED), true, 1.0f}; pg8::gemm_phase<pg8::EpiBranch, pg8::StaticOrder, true, true>(L + RING_OFF, g, S, E); }
#elif !DBG_NOGATE
            {   pg8::Gemm g{WSP(bf16, WS_HB), WSP(bf16, DBG_GATE_W) + (size_t)i * 1024 * 1024, T, 1024, 1024}; pg8::EpiGate<16> E{WSP(bf16, WS_GSCR), (LAS float*)(L + RING_BYTES + 1024)}; pg8::gemm_phase<pg8::EpiGate<16>, pg8::StaticOrder, true, true>(L + RING_OFF, g, S, E); }
#endif
#if !DBG_NOBRANCH
#if DBG_SUBST == 1
            {   const bf16* A = (i == 0) ? WSP(bf16, WS_FQ) : (i == 1) ? WSP(bf16, WS_DQ) : WSP(bf16, WS_IQ);
#elif DBG_SUBST == 2
            {   const bf16* A = (i == 0) ? WSP(bf16, WS_FK) : (i == 1) ? WSP(bf16, WS_FV) : WSP(bf16, WS_MQ);
#else
            {   const bf16* A = (i == 0) ? WSP(bf16, WS_OA) : (i == 1) ? WSP(bf16, WS_OB) : WSP(bf16, WS_MQ);
#endif
                pg8::Gemm g{A, WSP(bf16, WS_WBR) + (size_t)i * 1024 * 512, T, 1024, 512}; pg8::EpiBranch E{WSP(bf16, WS_GSCR), WSP(bf16, WS_MERGED), i == 0, ((DBG_BRANCH_MASK >> i) & 1) ? 1.0f : 0.0f}; pg8::gemm_phase<pg8::EpiBranch, pg8::StaticOrder, true, true>(L + RING_OFF, g, S, E); }
#endif
        }
        GRID_BAR();
#if defined(DBG_DUMP_AFTER) && DBG_DUMP_AFTER == 7
        {
            const bf16* sa = WSP(bf16, DBG_DUMP_A); const bf16* sb = WSP(bf16, DBG_DUMP_B);
            for (size_t e = (size_t)vcu * 512 + tid; e < (size_t)T * 512; e += (size_t)G * 512) { const size_t row = e >> 9, c = e & 511;
                ap->out[row * 1024 + c] = bf2f(sa[row * DBG_PITCH + c]); ap->out[row * 1024 + 512 + c] = bf2f(sb[row * DBG_PITCH + c]); }
            return;
        }
#endif

    }
#endif
#if (PHMASK >> 8) & 1
    {
        pg8::Gemm g{WSP(bf16, WS_MERGED), WSP(bf16, WS_WOUT), T, 1024, 1024}; pg8::StaticOrder S; S.init(T, 1024, G, bx);
        pg8::EpiResid2<true> E{ap->out, ap->out, WSP(bf16, WS_HB), WSP(float, WS_SSQ2), 1.0f};
        pg8::gemm_phase<pg8::EpiResid2<true>, pg8::StaticOrder, true, true>(L + RING_OFF, g, S, E);
        GRID_BAR();
    }
#endif
#if (PHMASK >> 9) & 1
    {
        pg8::Gemm g{WSP(bf16, WS_HB), WSP(bf16, WS_WGU2), T, 2 * DFF, 1024}; pg8::StaticOrder S; S.init(T, 2 * DFF, G, bx);
        pg8::build_row_tab<16>(WSP(float, WS_SSQ2), S, (LAS float*)(L + RING_BYTES + 1024)); pg8::EpiSwiGLU<16> E{WSP(bf16, WS_HID), DFF, (LAS float*)(L + RING_BYTES + 1024)};
#pragma unroll 1
        for (int rep_ = 0; rep_ < REP_GEMM; ++rep_)
        pg8::gemm_phase<pg8::EpiSwiGLU<16>, pg8::StaticOrder, true, true>(L + RING_OFF, g, S, E);
        GRID_BAR();
    }
#endif
#if (PHMASK >> 10) & 1
    {
        pg8::Gemm g{WSP(bf16, WS_HID), WSP(bf16, WS_WD2), T, 1024, DFF}; pg8::StaticOrder S; S.init(T, 1024, G, bx);
        pg8::EpiResid2<false> E{ap->out, ap->out, nullptr, nullptr, 0.5f};
        pg8::gemm_phase<pg8::EpiResid2<false>, pg8::StaticOrder, true, true>(L + RING_OFF, g, S, E);
    }
#endif
}

extern "C" void kernel_launch(void* const* d_in, const int* in_sizes, int n_in, void* d_out, int out_size, void* d_ws, size_t ws_size, hipStream_t stream) {
    static int grid = 0;
    if (grid == 0) {
        if (n_in != 24 || out_size != T * DM || ws_size < WS_END) { fprintf(stderr, "kernel_launch: unexpected problem (n_in %d, out %d, ws %zu)\n", n_in, out_size, ws_size); grid = -1; return; }
        int dev = 0, cus = 0, per_cu = 0;
        if (hipGetDevice(&dev) != hipSuccess || hipDeviceGetAttribute(&cus, hipDeviceAttributeMultiprocessorCount, dev) != hipSuccess) { grid = -1; return; }
        if (hipFuncSetAttribute((const void*)fwd_mega, hipFuncAttributeMaxDynamicSharedMemorySize, LDS_BYTES) != hipSuccess) { fprintf(stderr, "kernel_launch: hipFuncSetAttribute failed\n"); grid = -1; return; }
        if (hipOccupancyMaxActiveBlocksPerMultiprocessor(&per_cu, (const void*)fwd_mega, NWAVES * 64, LDS_BYTES) != hipSuccess || per_cu < 1) { fprintf(stderr, "kernel_launch: occupancy query says %d blocks per CU\n", per_cu); (void)hipGetLastError(); grid = -1; return; }
        grid = cus;
    }
    if (grid < 0) return;
    (void)hipMemsetAsync((char*)d_ws + WS_CTL, 0, CTL_ZERO_BYTES, stream);
    Args a{};
    for (int i = 0; i < 24; ++i) a.in[i] = d_in[i];
    a.out = (float*)d_out; a.ws = (unsigned char*)d_ws;
    hipLaunchKernelGGL(fwd_mega, dim3(grid), dim3(NWAVES * 64), LDS_BYTES, stream, a);
}
```

```cpp
#include <hip/hip_runtime.h>
#include <cstdio>
#include <cstdint>
namespace pg8 {
#define PG8_LAS __attribute__((address_space(3)))
typedef unsigned short bf16_t;
typedef short bf16x8 __attribute__((ext_vector_type(8)));
typedef float f32x4 __attribute__((ext_vector_type(4)));
typedef unsigned u32x4 __attribute__((ext_vector_type(4)));
constexpr int BM = 256, BK = 64, HALF = 128, HTB = HALF * BK * 2  , STAGE_BYTES = 8 * HTB, NXCD = 8, WGM = 8;

__host__ __device__ __forceinline__ int lds_byte(int r, int c) { const int st = (r >> 4) * 2 + (c >> 5), rr = r & 15, cc = c & 31, ob = rr * 64 + cc * 2; return st * 1024 + (ob ^ (((ob >> 9) & 1) << 5)); }
__host__ __device__ __forceinline__ void stage_rc(int b, int& R, int& C) { const int st = b / 1024, sb = b % 1024, swz = sb ^ (((sb >> 9) & 1) << 5); R = (st >> 1) * 16 + swz / 64; C = (st & 1) * 32 + (swz % 64) / 2; }
__host__ __device__ __forceinline__ int perm32(int rho) { const int n = rho >> 4, i = rho & 15; return 8 * (i >> 2) + 4 * n + (i & 3); }

struct Unit { int pm, pn; };
struct Gemm { const bf16_t* A; const bf16_t* Bt; int M, N, K; };

struct StaticOrder {
    int nM, nN, nwg, G, c;
    __host__ __device__ void init(int M, int N, int G_, int c_) { nM = M / BM; nN = N / BM; nwg = nM * nN; G = G_; c = c_; }
    __host__ __device__ bool next(int i, Unit& u) const {
        const long L = (long)i * G + c; if (L >= nwg) return false;
        int wgid = (int)L; { const int q = nwg / NXCD, r = nwg % NXCD, xcd = wgid % NXCD, off = wgid / NXCD; wgid = (xcd < r ? xcd * (q + 1) : r * (q + 1) + (xcd - r) * q) + off; }
        const int nig = WGM * nN, gid = wgid / nig, fm = gid * WGM, gsz = (nM - fm) < WGM ? (nM - fm) : WGM;
        u.pm = fm + ((wgid % nig) % gsz); u.pn = (wgid % nig) / gsz; return true;
    }
    __device__ __forceinline__ void a_ready(const Unit&) const {}
    __device__ __forceinline__ void done(const Unit&) const {}
};

typedef float f32x2cv __attribute__((ext_vector_type(2))); typedef __bf16 bf16x2cv __attribute__((ext_vector_type(2)));
__device__ __forceinline__ unsigned cvt_pk_bf16(float lo, float hi) { const f32x2cv v = {lo, hi}; const bf16x2cv b = __builtin_convertvector(v, bf16x2cv); return __builtin_bit_cast(unsigned, b); }
typedef float f32x2 __attribute__((ext_vector_type(2)));
template <class Epi, class Sched, bool ALIGN_EPI = false, bool SP2 = false>
__device__ __forceinline__ void gemm_phase(PG8_LAS unsigned char* lds, const Gemm g, const Sched& S, const Epi& E) {
    int tid_ = threadIdx.x; asm volatile("" : "+v"(tid_));
    const int tid = tid_, wid = __builtin_amdgcn_readfirstlane(tid >> 6), lane = tid & 63, wr = wid >> 2, wc = wid & 3, fr = lane & 15, fq = lane >> 4;
    const int K = g.K, nt = K / BK;
    unsigned voffA[2], voffB[2];
#pragma unroll
    for (int i = 0; i < 2; ++i) { int R, C; stage_rc(tid * 16 + i * 8192, R, C); const int Rb = Epi::PERM ? ((R & ~31) + perm32(R & 31)) : R;
        voffA[i] = (unsigned)(R * K + C) * 2u; voffB[i] = (unsigned)(Rb * K + C) * 2u; }
    const size_t kstep = (size_t)(BK * 2);
    const size_t hstep = (size_t)HALF * K * 2;
    const size_t tstep = 2 * hstep;
    const unsigned ldsw = (unsigned)wid * 1024u;
    const int aoff = lds_byte(wr * 64 + fr, fq * 8), boff = lds_byte(wc * 32 + fr, fq * 8);
#define PG8_SA(b, h) (((b) * 2 + (h)) * HTB)
#define PG8_SB(b, h) ((4 + (b) * 2 + (h)) * HTB)
#define PG8_STAGE(bufoff, gbase, voff) do { _Pragma("unroll") for (int _i = 0; _i < 2; ++_i) \
        __builtin_amdgcn_global_load_lds((const unsigned*)((const char*)(gbase) + (voff)[_i]), (PG8_LAS unsigned*)(lds + (bufoff) + ldsw + _i * 8192), 16, 0, 0); } while (0)
#define PG8_LDA(dst, b, h) do { _Pragma("unroll") for (int m = 0; m < 4; ++m) _Pragma("unroll") for (int k = 0; k < 2; ++k) dst[m][k] = *(const PG8_LAS bf16x8*)(lds + PG8_SA(b, h) + aoff + m * 2048 + k * 1024); } while (0)
#define PG8_LDB(dst, b, h) do { _Pragma("unroll") for (int n = 0; n < 2; ++n) _Pragma("unroll") for (int k = 0; k < 2; ++k) dst[n][k] = *(const PG8_LAS bf16x8*)(lds + PG8_SB(b, h) + boff + n * 2048 + k * 1024); } while (0)
#define PG8_MMA(ai, bj, At, Bt) do { __builtin_amdgcn_s_setprio(1); _Pragma("unroll") for (int m = 0; m < 4; ++m) _Pragma("unroll") for (int n = 0; n < 2; ++n) _Pragma("unroll") for (int k = 0; k < 2; ++k) \
        acc[ai][bj][m][n] = __builtin_amdgcn_mfma_f32_16x16x32_bf16(Bt[n][k], At[m][k], acc[ai][bj][m][n], 0, 0, 0); __builtin_amdgcn_s_setprio(0); } while (0)
#define PG8_WAIT_V(n) asm volatile("s_waitcnt vmcnt(" #n ")" ::: "memory")
#define PG8_WAIT_L(n) asm volatile("s_waitcnt lgkmcnt(" #n ")" ::: "memory")
#define PG8_BAR __builtin_amdgcn_s_barrier()
#define PG8_SCHED __builtin_amdgcn_sched_barrier(0)
    Unit cur, nxt; int ui = 0;
    if (!S.next(0, cur)) return;
    f32x4 acc[2][2][4][2];
#pragma unroll
    for (int a = 0; a < 2; ++a)
#pragma unroll
        for (int b = 0; b < 2; ++b)
#pragma unroll
            for (int m = 0; m < 4; ++m)
#pragma unroll
                for (int n = 0; n < 2; ++n) acc[a][b][m][n] = (f32x4){0.f, 0.f, 0.f, 0.f};
    bf16x8 At[4][2], B0[2][2], B1[2][2];
    const char* cA = (const char*)g.A + (size_t)cur.pm * tstep; const char* cB = (const char*)g.Bt + (size_t)cur.pn * tstep;
    S.a_ready(cur);
    if constexpr (SP2) {
        PG8_STAGE(PG8_SB(0, 0), cB, voffB); PG8_STAGE(PG8_SB(0, 1), cB + hstep, voffB); PG8_STAGE(PG8_SA(0, 0), cA, voffA); PG8_STAGE(PG8_SA(0, 1), cA + hstep, voffA);
        if (wr == 1) PG8_BAR;
        PG8_WAIT_V(2); PG8_BAR;
        PG8_STAGE(PG8_SB(1, 0), cB + kstep, voffB); PG8_STAGE(PG8_SA(1, 0), cA + kstep, voffA); PG8_STAGE(PG8_SB(1, 1), cB + hstep + kstep, voffB);
        PG8_WAIT_V(6); PG8_BAR;
    } else {
        PG8_STAGE(PG8_SB(0, 0), cB, voffB); PG8_STAGE(PG8_SA(0, 0), cA, voffA); PG8_STAGE(PG8_SB(0, 1), cB + hstep, voffB); PG8_STAGE(PG8_SA(0, 1), cA + hstep, voffA);
        if (wr == 1) PG8_BAR;
        PG8_WAIT_V(4); PG8_BAR;
        PG8_STAGE(PG8_SB(1, 0), cB + kstep, voffB); PG8_STAGE(PG8_SA(1, 0), cA + kstep, voffA); PG8_STAGE(PG8_SB(1, 1), cB + hstep + kstep, voffB);
        PG8_WAIT_V(6); PG8_BAR;
    }
    for (;;) {
        const bool has_next = S.next(ui + 1, nxt);
        const char* nA = has_next ? (const char*)g.A + (size_t)nxt.pm * tstep : cA; const char* nB = has_next ? (const char*)g.Bt + (size_t)nxt.pn * tstep : cB;
        for (int t = 0; t < nt; t += 2) {
            const bool last = (t == nt - 2);
            const char* a1 = cA + (size_t)(t + 1) * kstep;
            const char* a2 = last ? nA : cA + (size_t)(t + 2) * kstep; const char* b2 = last ? nB : cB + (size_t)(t + 2) * kstep;
            const char* a3 = a2 + kstep; const char* b3 = b2 + kstep;
            if (last && has_next) S.a_ready(nxt);
            if constexpr (SP2) {
            PG8_LDB(B0, 0, 0); PG8_LDB(B1, 0, 1); PG8_SCHED; PG8_LDA(At, 0, 0); PG8_STAGE(PG8_SA(1, 1), a1 + hstep, voffA);
            PG8_WAIT_V(8); PG8_WAIT_L(0); PG8_BAR; PG8_MMA(0, 0, At, B0); PG8_MMA(0, 1, At, B1); PG8_BAR; PG8_SCHED;
            PG8_LDA(At, 0, 1); PG8_STAGE(PG8_SB(0, 0), b2, voffB); PG8_STAGE(PG8_SB(0, 1), b2 + hstep, voffB); PG8_STAGE(PG8_SA(0, 0), a2, voffA);
            PG8_WAIT_V(8); PG8_WAIT_L(0); PG8_BAR; PG8_MMA(1, 0, At, B0); PG8_MMA(1, 1, At, B1); PG8_BAR; PG8_SCHED;
            PG8_LDB(B0, 1, 0); PG8_LDB(B1, 1, 1); PG8_SCHED; PG8_LDA(At, 1, 0); PG8_STAGE(PG8_SA(0, 1), a2 + hstep, voffA);
            PG8_WAIT_V(8); PG8_WAIT_L(0); PG8_BAR; PG8_MMA(0, 0, At, B0); PG8_MMA(0, 1, At, B1); PG8_BAR; PG8_SCHED;
            PG8_LDA(At, 1, 1); PG8_STAGE(PG8_SB(1, 0), b3, voffB); PG8_STAGE(PG8_SB(1, 1), b3 + hstep, voffB); PG8_STAGE(PG8_SA(1, 0), a3, voffA);
            PG8_WAIT_V(8); PG8_WAIT_L(0); PG8_BAR; PG8_MMA(1, 0, At, B0); PG8_MMA(1, 1, At, B1); PG8_BAR; PG8_SCHED;
            } else {
            PG8_LDB(B0, 0, 0); PG8_SCHED; PG8_LDA(At, 0, 0); PG8_STAGE(PG8_SA(1, 1), a1 + hstep, voffA);
            PG8_WAIT_L(8); PG8_BAR; PG8_WAIT_L(0); PG8_MMA(0, 0, At, B0); PG8_BAR; PG8_SCHED;
            PG8_LDB(B1, 0, 1); PG8_STAGE(PG8_SB(0, 0), b2, voffB);
            PG8_BAR; PG8_WAIT_L(0); PG8_MMA(0, 1, At, B1); PG8_BAR;
            PG8_LDA(At, 0, 1); PG8_STAGE(PG8_SA(0, 0), a2, voffA);
            PG8_BAR; PG8_WAIT_L(0); PG8_MMA(1, 0, At, B0); PG8_BAR; PG8_SCHED;
            PG8_STAGE(PG8_SB(0, 1), b2 + hstep, voffB);
            PG8_WAIT_V(6); PG8_BAR; PG8_MMA(1, 1, At, B1); PG8_BAR;
            PG8_LDB(B0, 1, 0); PG8_SCHED; PG8_LDA(At, 1, 0); PG8_STAGE(PG8_SA(0, 1), a2 + hstep, voffA);
            PG8_WAIT_L(8); PG8_BAR; PG8_WAIT_L(0); PG8_MMA(0, 0, At, B0); PG8_BAR; PG8_SCHED;
            PG8_LDB(B1, 1, 1); PG8_STAGE(PG8_SB(1, 0), b3, voffB);
            PG8_BAR; PG8_WAIT_L(0); PG8_MMA(0, 1, At, B1); PG8_BAR;
            PG8_LDA(At, 1, 1); PG8_STAGE(PG8_SA(1, 0), a3, voffA);
            PG8_BAR; PG8_WAIT_L(0); PG8_MMA(1, 0, At, B0); PG8_BAR; PG8_SCHED;
            PG8_STAGE(PG8_SB(1, 1), b3 + hstep, voffB);
            PG8_WAIT_V(6); PG8_BAR; PG8_MMA(1, 1, At, B1); PG8_BAR;
            }
        }
        if constexpr (ALIGN_EPI) { if (wr == 0) PG8_BAR; }
        if constexpr (!Epi::AFTER_DRAIN) { E(acc, cur, wr, wc, fr, fq); S.done(cur); }
        if (!has_next) break;
#pragma unroll
        for (int a = 0; a < 2; ++a)
#pragma unroll
            for (int b = 0; b < 2; ++b)
#pragma unroll
                for (int m = 0; m < 4; ++m)
#pragma unroll
                    for (int n = 0; n < 2; ++n) acc[a][b][m][n] = (f32x4){0.f, 0.f, 0.f, 0.f};
        cur = nxt; cA = nA; cB = nB; ++ui;
        if constexpr (ALIGN_EPI) { if (wr == 1) PG8_BAR; }
    }
    PG8_WAIT_V(0);
    if constexpr (!ALIGN_EPI) { if (wr == 0) PG8_BAR; }
    PG8_BAR;
    if constexpr (Epi::AFTER_DRAIN) { E.fused(acc, cur, wr, wc, fr, fq, lds, wid, lane); S.done(cur); }
#undef PG8_SA
#undef PG8_SB
#undef PG8_STAGE
#undef PG8_LDA
#undef PG8_LDB
#undef PG8_MMA
#undef PG8_WAIT_V
#undef PG8_WAIT_L
#undef PG8_BAR
#undef PG8_SCHED
}

struct UnitX { int pm, pn, kind, round; };
struct OpsX { const char* A; const char* Bt; int K; };
template <class Epi, class Sched>
__device__ __forceinline__ void gemm_stream(PG8_LAS unsigned char* lds, const Sched& S, const Epi& E) {
    int tid_ = threadIdx.x; asm volatile("" : "+v"(tid_));
    const int tid = tid_, wid = __builtin_amdgcn_readfirstlane(tid >> 6), lane = tid & 63, wr = wid >> 2, wc = wid & 3, fr = lane & 15, fq = lane >> 4;
    unsigned rA[2], rB[2], c2[2];
#pragma unroll
    for (int i = 0; i < 2; ++i) { int R, C; stage_rc(tid * 16 + i * 8192, R, C); rA[i] = (unsigned)R; rB[i] = (unsigned)((R & ~31) + perm32(R & 31)); c2[i] = (unsigned)C * 2u; }
    const size_t kstep = (size_t)(BK * 2);
    const unsigned ldsw = (unsigned)wid * 1024u;
    const int aoff = lds_byte(wr * 64 + fr, fq * 8), boff = lds_byte(wc * 32 + fr, fq * 8);
#define PG8_SA(b, h) (((b) * 2 + (h)) * HTB)
#define PG8_SB(b, h) ((4 + (b) * 2 + (h)) * HTB)
#define PGX_STAGE(bufoff, gbase, rr, pb) do { _Pragma("unroll") for (int _i = 0; _i < 2; ++_i) \
        __builtin_amdgcn_global_load_lds((const unsigned*)((const char*)(gbase) + ((rr)[_i] * (pb) + c2[_i])), (PG8_LAS unsigned*)(lds + (bufoff) + ldsw + _i * 8192), 16, 0, 0); } while (0)
#define PG8_LDA(dst, b, h) do { _Pragma("unroll") for (int m = 0; m < 4; ++m) _Pragma("unroll") for (int k = 0; k < 2; ++k) dst[m][k] = *(const PG8_LAS bf16x8*)(lds + PG8_SA(b, h) + aoff + m * 2048 + k * 1024); } while (0)
#define PG8_LDB(dst, b, h) do { _Pragma("unroll") for (int n = 0; n < 2; ++n) _Pragma("unroll") for (int k = 0; k < 2; ++k) dst[n][k] = *(const PG8_LAS bf16x8*)(lds + PG8_SB(b, h) + boff + n * 2048 + k * 1024); } while (0)
#define PG8_MMA(ai, bj, At, Bt) do { __builtin_amdgcn_s_setprio(1); _Pragma("unroll") for (int m = 0; m < 4; ++m) _Pragma("unroll") for (int n = 0; n < 2; ++n) _Pragma("unroll") for (int k = 0; k < 2; ++k) \
        acc[ai][bj][m][n] = __builtin_amdgcn_mfma_f32_16x16x32_bf16(Bt[n][k], At[m][k], acc[ai][bj][m][n], 0, 0, 0); __builtin_amdgcn_s_setprio(0); } while (0)
#define PG8_WAIT_V(n) asm volatile("s_waitcnt vmcnt(" #n ")" ::: "memory")
#define PG8_WAIT_L(n) asm volatile("s_waitcnt lgkmcnt(" #n ")" ::: "memory")
#define PG8_BAR __builtin_amdgcn_s_barrier()
#define PG8_SCHED __builtin_amdgcn_sched_barrier(0)
    UnitX cur, nxt; int ui = 0;
    if (!S.next(0, cur)) return;
    f32x4 acc[2][2][4][2];
#pragma unroll
    for (int a = 0; a < 2; ++a)
#pragma unroll
        for (int b = 0; b < 2; ++b)
#pragma unroll
            for (int m = 0; m < 4; ++m)
#pragma unroll
                for (int n = 0; n < 2; ++n) acc[a][b][m][n] = (f32x4){0.f, 0.f, 0.f, 0.f};
    bf16x8 At[4][2], B0[2][2], B1[2][2];
    OpsX oc = S.ops(cur);
    const char* cA = oc.A; const char* cB = oc.Bt; int Kc = oc.K;
    {   const unsigned pb = (unsigned)Kc * 2u; const size_t hstep = (size_t)HALF * pb;
        PGX_STAGE(PG8_SB(0, 0), cB, rB, pb); PGX_STAGE(PG8_SB(0, 1), cB + hstep, rB, pb); PGX_STAGE(PG8_SA(0, 0), cA, rA, pb); PGX_STAGE(PG8_SA(0, 1), cA + hstep, rA, pb);
        if (wr == 1) PG8_BAR;
        PG8_WAIT_V(2); PG8_BAR;
        PGX_STAGE(PG8_SB(1, 0), cB + kstep, rB, pb); PGX_STAGE(PG8_SA(1, 0), cA + kstep, rA, pb); PGX_STAGE(PG8_SB(1, 1), cB + hstep + kstep, rB, pb);
        PG8_WAIT_V(6); PG8_BAR; }
    for (;;) {
        const bool has_next = S.next(ui + 1, nxt);
        OpsX on = oc; if (has_next) on = S.ops(nxt);
        const char* nA = on.A; const char* nB = on.Bt; const int Kn = on.K;
        const int nt = Kc / BK; const unsigned pbc = (unsigned)Kc * 2u; const size_t hstep = (size_t)HALF * pbc;
        for (int t = 0; t < nt; t += 2) {
            const bool last = (t == nt - 2);
            const char* a1 = cA + (size_t)(t + 1) * kstep;
            const char* a2 = last ? nA : cA + (size_t)(t + 2) * kstep; const char* b2 = last ? nB : cB + (size_t)(t + 2) * kstep;
            const char* a3 = a2 + kstep; const char* b3 = b2 + kstep;
            const unsigned pb2 = last ? (unsigned)Kn * 2u : pbc; const size_t h2 = (size_t)HALF * pb2;
            PG8_LDB(B0, 0, 0); PG8_LDB(B1, 0, 1); PG8_SCHED; PG8_LDA(At, 0, 0); PGX_STAGE(PG8_SA(1, 1), a1 + hstep, rA, pbc);
            PG8_WAIT_V(8); PG8_WAIT_L(0); PG8_BAR; PG8_MMA(0, 0, At, B0); PG8_MMA(0, 1, At, B1); PG8_BAR; PG8_SCHED;
            PG8_LDA(At, 0, 1); PGX_STAGE(PG8_SB(0, 0), b2, rB, pb2); PGX_STAGE(PG8_SB(0, 1), b2 + h2, rB, pb2); PGX_STAGE(PG8_SA(0, 0), a2, rA, pb2);
            PG8_WAIT_V(8); PG8_WAIT_L(0); PG8_BAR; PG8_MMA(1, 0, At, B0); PG8_MMA(1, 1, At, B1); PG8_BAR; PG8_SCHED;
            PG8_LDB(B0, 1, 0); PG8_LDB(B1, 1, 1); PG8_SCHED; PG8_LDA(At, 1, 0); PGX_STAGE(PG8_SA(0, 1), a2 + h2, rA, pb2);
            PG8_WAIT_V(8); PG8_WAIT_L(0); PG8_BAR; PG8_MMA(0, 0, At, B0); PG8_MMA(0, 1, At, B1); PG8_BAR; PG8_SCHED;
            PG8_LDA(At, 1, 1); PGX_STAGE(PG8_SB(1, 0), b3, rB, pb2); PGX_STAGE(PG8_SB(1, 1), b3 + h2, rB, pb2); PGX_STAGE(PG8_SA(1, 0), a3, rA, pb2);
            PG8_WAIT_V(8); PG8_WAIT_L(0); PG8_BAR; PG8_MMA(1, 0, At, B0); PG8_MMA(1, 1, At, B1); PG8_BAR; PG8_SCHED;
        }
        if (wr == 0) PG8_BAR;
        E(acc, cur, wr, wc, fr, fq);
        if (!has_next) break;
#pragma unroll
        for (int a = 0; a < 2; ++a)
#pragma unroll
            for (int b = 0; b < 2; ++b)
#pragma unroll
                for (int m = 0; m < 4; ++m)
#pragma unroll
                    for (int n = 0; n < 2; ++n) acc[a][b][m][n] = (f32x4){0.f, 0.f, 0.f, 0.f};
        cur = nxt; oc = on; cA = nA; cB = nB; Kc = Kn; ++ui;
        if (wr == 1) PG8_BAR;
    }
    PG8_WAIT_V(0);
    PG8_BAR;
#undef PG8_SA
#undef PG8_SB
#undef PGX_STAGE
#undef PG8_LDA
#undef PG8_LDB
#undef PG8_MMA
#undef PG8_WAIT_V
#undef PG8_WAIT_L
#undef PG8_BAR
#undef PG8_SCHED
}
}
namespace pg8 {
constexpr int TOK = 16384;
constexpr float RMS_EPS = 1e-6f;
typedef float f32x2e __attribute__((ext_vector_type(2)));
template <int NP> __device__ __forceinline__ void row_scales(const float* src, int rowbase, int lane, int fr, float (&r)[2][4]) {
#pragma unroll
    for (int ai = 0; ai < 2; ++ai) {
        const int row = rowbase + 128 * ai + lane; float v;
        if (NP == 0) v = src[row];
        else { float s = 0.f;
#pragma unroll
            for (int p = 0; p < NP; ++p) s += src[(size_t)p * TOK + row];
            v = __builtin_amdgcn_rsqf(s * (1.0f / 1024.0f) + RMS_EPS); }
#pragma unroll
        for (int m = 0; m < 4; ++m) r[ai][m] = __shfl(v, 16 * m + fr);
    }
}
template <int NP, class Sched> __device__ __forceinline__ void build_row_tab(const float* src, const Sched& S, PG8_LAS float* tab) {
    Unit u;
    for (int i = 0; S.next(i, u); ++i)
        for (int r = (int)threadIdx.x; r < 256; r += 512) { const int row = u.pm * BM + r; float v;
            if (NP == 0) v = src[row];
            else { float s = 0.f;
#pragma unroll
                for (int p = 0; p < NP; ++p) s += src[(size_t)p * TOK + row];
                v = __builtin_amdgcn_rsqf(s * (1.0f / 1024.0f) + RMS_EPS); }
            tab[i * 256 + r] = v; }
    __syncthreads();
}
__device__ __forceinline__ void row_scales_tab(const PG8_LAS float* tab, int ui, int wr, int fr, float (&r)[2][4]) {
#pragma unroll
    for (int ai = 0; ai < 2; ++ai)
#pragma unroll
        for (int m = 0; m < 4; ++m) r[ai][m] = tab[ui * 256 + ai * 128 + wr * 64 + 16 * m + fr];
}
__device__ __forceinline__ float silu_f(float x) { return x * __builtin_amdgcn_rcpf(1.0f + __expf(-x)); }
__device__ __forceinline__ float sigmoid_f(float x) { return __builtin_amdgcn_rcpf(1.0f + __expf(-x)); }

template <int NP> struct EpiSwiGLU {
    static constexpr bool PERM = true, AFTER_DRAIN = false;
    bf16_t* H; int ldh; const PG8_LAS float* tab; mutable int ui = 0;
    __device__ __forceinline__ void operator()(const f32x4 (&acc)[2][2][4][2], const Unit& u, int wr, int wc, int fr0, int fq0) const {
        int fr = fr0, fq = fq0; asm volatile("" : "+v"(fr), "+v"(fq));
        float r[2][4]; row_scales_tab(tab, ui++, wr, fr, r);
        const int col0 = u.pn * 128 + wc * 32 + 8 * fq;
#pragma unroll
        for (int ai = 0; ai < 2; ++ai)
#pragma unroll
            for (int m = 0; m < 4; ++m) {
                const int row = u.pm * BM + ai * HALF + wr * 64 + m * 16 + fr; const float rr = r[ai][m];
                float o[8]; const float k1 = -1.44269504f * rr, rr2 = rr * rr;
#pragma unroll
                for (int n = 0; n < 2; ++n)
#pragma unroll
                    for (int j = 0; j < 4; j += 2) { const f32x2 g2 = (f32x2){acc[ai][0][m][n][j], acc[ai][0][m][n][j + 1]}, u2 = (f32x2){acc[ai][1][m][n][j], acc[ai][1][m][n][j + 1]};
                        const f32x2 t2 = g2 * k1; const f32x2 d2 = (f32x2){__builtin_amdgcn_exp2f(t2[0]), __builtin_amdgcn_exp2f(t2[1])} + 1.0f;
                        const f32x2 r2 = (f32x2){__builtin_amdgcn_rcpf(d2[0]), __builtin_amdgcn_rcpf(d2[1])} * rr2; const f32x2 o2 = (g2 * u2) * r2;
                        o[4 * n + j] = o2[0]; o[4 * n + j + 1] = o2[1]; }
                u32x4 w; w.x = cvt_pk_bf16(o[0], o[1]); w.y = cvt_pk_bf16(o[2], o[3]); w.z = cvt_pk_bf16(o[4], o[5]); w.w = cvt_pk_bf16(o[6], o[7]);
                *(u32x4*)(H + (size_t)row * ldh + col0) = w;
            }
    }
};
template <bool WRITE_HB> struct EpiResid {
    static constexpr bool PERM = true, AFTER_DRAIN = false;
    const float* base; float* out; bf16_t* hb; float* part; float sc;
    __device__ __forceinline__ void operator()(const f32x4 (&acc)[2][2][4][2], const Unit& u, int wr, int wc, int fr0, int fq0) const {
        int fr = fr0, fq = fq0; asm volatile("" : "+v"(fr), "+v"(fq));
        const int col0 = u.pn * BM + wc * 32 + 8 * fq;
#pragma unroll
        for (int ai = 0; ai < 2; ++ai)
#pragma unroll
            for (int m = 0; m < 4; ++m) {
                const int row = u.pm * BM + ai * HALF + wr * 64 + m * 16 + fr; float ss = 0.f;
#pragma unroll
                for (int bj = 0; bj < 2; ++bj) {
                    const size_t off = (size_t)row * 1024 + col0 + bj * HALF;
                    const f32x4 b0 = *(const f32x4*)(base + off), b1 = *(const f32x4*)(base + off + 4);
                    const f32x4 o0 = b0 + acc[ai][bj][m][0] * sc, o1 = b1 + acc[ai][bj][m][1] * sc;
                    *(f32x4*)(out + off) = o0; *(f32x4*)(out + off + 4) = o1;
                    if (WRITE_HB) {
                        ss += (o0[0] * o0[0] + o0[1] * o0[1]) + (o0[2] * o0[2] + o0[3] * o0[3]) + (o1[0] * o1[0] + o1[1] * o1[1]) + (o1[2] * o1[2] + o1[3] * o1[3]);
                        u32x4 w; w.x = cvt_pk_bf16(o0[0], o0[1]); w.y = cvt_pk_bf16(o0[2], o0[3]); w.z = cvt_pk_bf16(o1[0], o1[1]); w.w = cvt_pk_bf16(o1[2], o1[3]);
                        *(u32x4*)(hb + off) = w; }
                }
                if (WRITE_HB) { ss += __shfl_xor(ss, 16); ss += __shfl_xor(ss, 32); if (fq == 0) part[(size_t)(u.pn * 4 + wc) * TOK + row] = ss; }
                if (m == 3) asm volatile("" ::: "memory");
            }
    }
};
template <bool WRITE_HB> struct EpiResid2 {
    static constexpr bool PERM = true, AFTER_DRAIN = false;
    const float* base; float* out; bf16_t* hb; float* part; float sc;
    __device__ __forceinline__ void operator()(const f32x4 (&acc)[2][2][4][2], const Unit& u, int wr, int wc, int fr0, int fq0) const {
        int fr = fr0, fq = fq0; asm volatile("" : "+v"(fr), "+v"(fq));
        const int row0 = u.pm * BM + wr * 64 + fr; const size_t o00 = (size_t)row0 * 1024 + u.pn * BM + wc * 32 + 8 * fq;
        const float* bp = base + o00; float* op = out + o00; bf16_t* hp = hb + o00;
        f32x4 bq[2][8];
#define ER2_ISSUE(G, B) do { _Pragma("unroll") for (int c = 0; c < 8; ++c) { const int ai = (G) >> 1, m = 2 * ((G) & 1) + (c >> 2), bj = (c >> 1) & 1, n = c & 1; \
            bq[B][c] = *(const f32x4*)(bp + (size_t)(ai * 128 + m * 16) * 1024 + bj * 128 + 4 * n); } } while (0)
        ER2_ISSUE(0, 0);
#pragma unroll
        for (int G = 0; G < 4; ++G) {
            if (G + 1 < 4) { if ((G & 1) == 0) ER2_ISSUE(G + 1, 1); else ER2_ISSUE(G + 1, 0); }
            asm volatile("" ::: "memory");
#pragma unroll
            for (int mm = 0; mm < 2; ++mm) { const int ai = G >> 1, m = 2 * (G & 1) + mm; float ss = 0.f;
#pragma unroll
                for (int bj = 0; bj < 2; ++bj) { const size_t off = (size_t)(ai * 128 + m * 16) * 1024 + bj * 128;
                    const f32x4 o0 = bq[G & 1][mm * 4 + bj * 2] + acc[ai][bj][m][0] * sc, o1 = bq[G & 1][mm * 4 + bj * 2 + 1] + acc[ai][bj][m][1] * sc;
                    *(f32x4*)(op + off) = o0; *(f32x4*)(op + off + 4) = o1;
                    if (WRITE_HB) {
                        ss += (o0[0] * o0[0] + o0[1] * o0[1]) + (o0[2] * o0[2] + o0[3] * o0[3]) + (o1[0] * o1[0] + o1[1] * o1[1]) + (o1[2] * o1[2] + o1[3] * o1[3]);
                        u32x4 w; w.x = cvt_pk_bf16(o0[0], o0[1]); w.y = cvt_pk_bf16(o0[2], o0[3]); w.z = cvt_pk_bf16(o1[0], o1[1]); w.w = cvt_pk_bf16(o1[2], o1[3]);
                        *(u32x4*)(hp + off) = w; } }
                if (WRITE_HB) { ss += __shfl_xor(ss, 16); ss += __shfl_xor(ss, 32); if (fq == 0) part[(size_t)(u.pn * 4 + wc) * TOK + row0 + ai * 128 + m * 16] = ss; } }
            asm volatile("" ::: "memory");
        }
#undef ER2_ISSUE
    }
};
struct EpiMemKV {
    static constexpr bool PERM = true, AFTER_DRAIN = false;
    float* KV; const float* rs;
    __device__ __forceinline__ void operator()(const f32x4 (&acc)[2][2][4][2], const Unit& u, int wr, int wc, int fr0, int fq0) const {
        int fr = fr0, fq = fq0; asm volatile("" : "+v"(fr), "+v"(fq));
        float r[2][4]; row_scales<0>(rs, u.pm * BM + wr * 64, (int)(threadIdx.x & 63), fr, r);
        const int col0 = u.pn * BM + wc * 32 + 8 * fq;
#pragma unroll
        for (int ai = 0; ai < 2; ++ai)
#pragma unroll
            for (int m = 0; m < 4; ++m) { const int row = u.pm * BM + ai * HALF + wr * 64 + m * 16 + fr;
#pragma unroll
                for (int bj = 0; bj < 2; ++bj) { const size_t off = (size_t)row * 1024 + col0 + bj * HALF;
                    *(f32x4*)(KV + off) = acc[ai][bj][m][0] * r[ai][m]; *(f32x4*)(KV + off + 4) = acc[ai][bj][m][1] * r[ai][m]; } }
    }
};
template <int NP> struct EpiGate {
    static constexpr bool PERM = true, AFTER_DRAIN = false;
    bf16_t* scr; const PG8_LAS float* tab; mutable int ui = 0;
    __device__ __forceinline__ void operator()(const f32x4 (&acc)[2][2][4][2], const Unit& u, int wr, int wc, int fr0, int fq0) const {
        int fr = fr0, fq = fq0; asm volatile("" : "+v"(fr), "+v"(fq));
        float r[2][4];
#ifdef DBG_GATE_NOSCALE
        for (int a_ = 0; a_ < 2; ++a_) for (int m_ = 0; m_ < 4; ++m_) r[a_][m_] = 1.0f;
#else
        row_scales_tab(tab, ui++, wr, fr, r);
#endif
        bf16_t* t = scr + (size_t)(u.pm * 4 + u.pn) * 65536;
#pragma unroll
        for (int ai = 0; ai < 2; ++ai)
#pragma unroll
            for (int m = 0; m < 4; ++m) { const int lr = ai * HALF + wr * 64 + m * 16 + fr; const float rr = r[ai][m];
#pragma unroll
                for (int bj = 0; bj < 2; ++bj) { float o[8];
#pragma unroll
                    for (int n = 0; n < 2; ++n)
#pragma unroll
                        for (int j = 0; j < 4; ++j) o[4 * n + j] = sigmoid_f(acc[ai][bj][m][n][j] * rr);
                    u32x4 w; w.x = cvt_pk_bf16(o[0], o[1]); w.y = cvt_pk_bf16(o[2], o[3]); w.z = cvt_pk_bf16(o[4], o[5]); w.w = cvt_pk_bf16(o[6], o[7]);
                    *(u32x4*)(t + lr * 256 + bj * HALF + wc * 32 + 8 * fq) = w; } }
    }
};
__device__ __forceinline__ float bf_lo(unsigned w) { return __uint_as_float(w << 16); }
__device__ __forceinline__ float bf_hi(unsigned w) { return __uint_as_float(w & 0xffff0000u); }
struct EpiBranch {
    static constexpr bool PERM = true, AFTER_DRAIN = false;
    const bf16_t* scr; bf16_t* mg; bool first; float bscale;
    __device__ __forceinline__ void operator()(const f32x4 (&acc)[2][2][4][2], const Unit& u, int wr, int wc, int fr0, int fq0) const {
        int fr = fr0, fq = fq0; asm volatile("" : "+v"(fr), "+v"(fq));
        const bf16_t* t = scr + (size_t)(u.pm * 4 + u.pn) * 65536;
        __builtin_amdgcn_fence(__ATOMIC_ACQUIRE, "agent");
        asm volatile("s_waitcnt vmcnt(0)" ::: "memory");
#pragma unroll
        for (int ai = 0; ai < 2; ++ai)
#pragma unroll
            for (int m = 0; m < 4; ++m) { const int lr = ai * HALF + wr * 64 + m * 16 + fr; const int row = u.pm * BM + lr;
#pragma unroll
                for (int bj = 0; bj < 2; ++bj) { const int lc = bj * HALF + wc * 32 + 8 * fq;
#if defined(DBG_NOGATE) && DBG_NOGATE
                    const u32x4 g = (u32x4){0x3f803f80u, 0x3f803f80u, 0x3f803f80u, 0x3f803f80u};
#else
                    const u32x4 g = *(const u32x4*)(t + lr * 256 + lc);
#endif
                    bf16_t* mp = mg + (size_t)row * 1024 + u.pn * BM + lc;
                    float o[8];
                    o[0] = bf_lo(g.x) * acc[ai][bj][m][0][0]; o[1] = bf_hi(g.x) * acc[ai][bj][m][0][1]; o[2] = bf_lo(g.y) * acc[ai][bj][m][0][2]; o[3] = bf_hi(g.y) * acc[ai][bj][m][0][3];
                    o[4] = bf_lo(g.z) * acc[ai][bj][m][1][0]; o[5] = bf_hi(g.z) * acc[ai][bj][m][1][1]; o[6] = bf_lo(g.w) * acc[ai][bj][m][1][2]; o[7] = bf_hi(g.w) * acc[ai][bj][m][1][3];
#ifdef DBG_BRANCH_SIGMOID
#pragma unroll
                    for (int e = 0; e < 8; ++e) o[e] = DBG_NONLIN(o[e]);
#endif
#pragma unroll
                    for (int e = 0; e < 8; ++e) o[e] *= bscale;
                    if (!first) { const u32x4 p = *(const u32x4*)mp;
                        o[0] += bf_lo(p.x); o[1] += bf_hi(p.x); o[2] += bf_lo(p.y); o[3] += bf_hi(p.y); o[4] += bf_lo(p.z); o[5] += bf_hi(p.z); o[6] += bf_lo(p.w); o[7] += bf_hi(p.w); }
                    u32x4 w; w.x = cvt_pk_bf16(o[0], o[1]); w.y = cvt_pk_bf16(o[2], o[3]); w.z = cvt_pk_bf16(o[4], o[5]); w.w = cvt_pk_bf16(o[6], o[7]);
                    *(u32x4*)mp = w; }
                if (m & 1) asm volatile("" ::: "memory"); }
    }
};
template <bool FIRST> struct EpiBranch2 {
    const bf16_t* scr; bf16_t* mg;
    __device__ __forceinline__ void operator()(const f32x4 (&acc)[2][2][4][2], const Unit& u, int wr, int wc, int fr0, int fq0) const {
        int fr = fr0, fq = fq0; asm volatile("" : "+v"(fr), "+v"(fq));
        const bf16_t* t = scr + (size_t)(u.pm * 4 + u.pn) * 65536 + (wr * 64 + fr) * 256 + wc * 32 + 8 * fq;
        bf16_t* mp0 = mg + (size_t)(u.pm * BM + wr * 64 + fr) * 1024 + u.pn * BM + wc * 32 + 8 * fq;
        u32x4 gq[2][4], pq[2][4];
#define EB2_ISSUE(G, B) do { _Pragma("unroll") for (int c = 0; c < 4; ++c) { const int ai = (G) >> 1, m = 2 * ((G) & 1) + (c >> 1), bj = c & 1; \
            gq[B][c] = *(const u32x4*)(t + (ai * 128 + m * 16) * 256 + bj * 128); if (!FIRST) pq[B][c] = *(const u32x4*)(mp0 + (size_t)(ai * 128 + m * 16) * 1024 + bj * 128); } } while (0)
        EB2_ISSUE(0, 0);
#pragma unroll
        for (int G = 0; G < 4; ++G) {
            if (G + 1 < 4) { if ((G & 1) == 0) EB2_ISSUE(G + 1, 1); else EB2_ISSUE(G + 1, 0); }
            asm volatile("" ::: "memory");
#pragma unroll
            for (int c = 0; c < 4; ++c) { const int ai = G >> 1, m = 2 * (G & 1) + (c >> 1), bj = c & 1; const u32x4 g = gq[G & 1][c];
                float o[8];
                o[0] = bf_lo(g.x) * acc[ai][bj][m][0][0]; o[1] = bf_hi(g.x) * acc[ai][bj][m][0][1]; o[2] = bf_lo(g.y) * acc[ai][bj][m][0][2]; o[3] = bf_hi(g.y) * acc[ai][bj][m][0][3];
                o[4] = bf_lo(g.z) * acc[ai][bj][m][1][0]; o[5] = bf_hi(g.z) * acc[ai][bj][m][1][1]; o[6] = bf_lo(g.w) * acc[ai][bj][m][1][2]; o[7] = bf_hi(g.w) * acc[ai][bj][m][1][3];
                if (!FIRST) { const u32x4 p = pq[G & 1][c];
                    o[0] += bf_lo(p.x); o[1] += bf_hi(p.x); o[2] += bf_lo(p.y); o[3] += bf_hi(p.y); o[4] += bf_lo(p.z); o[5] += bf_hi(p.z); o[6] += bf_lo(p.w); o[7] += bf_hi(p.w); }
                u32x4 w; w.x = cvt_pk_bf16(o[0], o[1]); w.y = cvt_pk_bf16(o[2], o[3]); w.z = cvt_pk_bf16(o[4], o[5]); w.w = cvt_pk_bf16(o[6], o[7]);
                *(u32x4*)(mp0 + (size_t)(ai * 128 + m * 16) * 1024 + bj * 128) = w; }
            asm volatile("" ::: "memory");
        }
#undef EB2_ISSUE
    }
};
template <size_t O_HB, size_t O_WG, size_t O_A0, size_t O_A1, size_t O_A2, size_t O_WB> struct P7Order {
    StaticOrder T; const char* ws;
    __device__ __forceinline__ bool next(int i, UnitX& u) const { const int rd = i / 6; Unit t; if (!T.next(rd, t)) return false; u.pm = t.pm; u.pn = t.pn; u.kind = i - 6 * rd; u.round = rd; return true; }
    __device__ __forceinline__ OpsX ops(const UnitX& u) const { const int j = u.kind >> 1; OpsX o;
        if (u.kind & 1) { o.K = 512; o.A = ws + (j == 0 ? O_A0 : j == 1 ? O_A1 : O_A2) + (size_t)u.pm * (256 * 512 * 2); o.Bt = ws + O_WB + (size_t)j * (1024 * 512 * 2) + (size_t)u.pn * (256 * 512 * 2); }
        else { o.K = 1024; o.A = ws + O_HB + (size_t)u.pm * (256 * 1024 * 2); o.Bt = ws + O_WG + (size_t)j * (1024 * 1024 * 2) + (size_t)u.pn * (256 * 1024 * 2); }
        return o; }
};
struct EpiP7 {
    bf16_t* scr; bf16_t* mg; const PG8_LAS float* tab;
    __device__ __forceinline__ void operator()(const f32x4 (&acc)[2][2][4][2], const UnitX& u, int wr, int wc, int fr, int fq) const {
        const Unit uu{u.pm, u.pn};
        if (u.kind == 1) { const EpiBranch2<true> b{scr, mg}; b(acc, uu, wr, wc, fr, fq); }
        else if (u.kind & 1) { const EpiBranch2<false> b{scr, mg}; b(acc, uu, wr, wc, fr, fq); }
        else { const EpiGate<16> g{scr, tab, u.round}; g(acc, uu, wr, wc, fr, fq); }
    }
};
struct ProjOut { bf16_t *FQ, *FK, *FV, *DQ, *IQ, *MQ, *DK, *DV, *IK; float *LOGF, *IW; const float *cosT, *sinT, *g_fq, *g_fk, *g_dq, *g_dk, *b_forget; };
__device__ __forceinline__ float log_sigmoid_f(float z) { return z >= 0.f ? -log1pf(expf(-z)) : z - log1pf(expf(z)); }
template <int NP> struct EpiProj {
    static constexpr bool PERM = true, AFTER_DRAIN = false;
    ProjOut P; const PG8_LAS float* tab; float qscale; mutable int ui = 0;
    __device__ __forceinline__ void operator()(const f32x4 (&acc)[2][2][4][2], const Unit& u, int wr, int wc, int fr0, int fq0) const {
        int fr = fr0, fq = fq0; asm volatile("" : "+v"(fr), "+v"(fq));
        float r[2][4]; row_scales_tab(tab, ui++, wr, fr, r);
        const int pn = u.pn;
        bool do_norm = false, do_rope = false; const float* gain = nullptr; bf16_t* dst = nullptr; int pitch = 512, hoff = 0; float osc = 1.f;
        if (pn < 2)       { do_norm = true; gain = P.g_fq; dst = P.FQ; hoff = (4 * pn + wc) * 64; osc = qscale; }
        else if (pn < 4)  { do_norm = true; gain = P.g_fk; dst = P.FK; hoff = (4 * (pn - 2) + wc) * 64; }
        else if (pn < 6)  { dst = P.FV; hoff = (4 * (pn - 4) + wc) * 64; }
        else if (pn < 8)  { do_norm = true; do_rope = true; gain = P.g_dq; dst = P.DQ; hoff = (4 * (pn - 6) + wc) * 64; osc = qscale; }
        else if (pn < 10) { do_rope = true; dst = P.IQ; hoff = (4 * (pn - 8) + wc) * 64; }
        else if (pn < 12) { dst = P.MQ; hoff = (2 * (pn - 10) + (wc >> 1)) * 128 + (wc & 1) * 64; }
        else { pitch = 64;
            if (wc == 0)      { do_norm = true; do_rope = true; gain = P.g_dk; dst = P.DK; }
            else if (wc == 1) { dst = P.DV; }
            else if (wc == 2) { do_rope = true; dst = P.IK; }
            else dst = nullptr; }
        if (dst == nullptr) {
            if (fq < 2) {
#pragma unroll
                for (int ai = 0; ai < 2; ++ai)
#pragma unroll
                    for (int m = 0; m < 4; ++m) { const int row = u.pm * BM + ai * HALF + wr * 64 + m * 16 + fr; const float rr = r[ai][m];
                        f32x4 v0 = acc[ai][0][m][0] * rr, v1 = acc[ai][0][m][1] * rr;
                        if (fq == 0) {
                            const f32x4 b0 = *(const f32x4*)(P.b_forget), b1 = *(const f32x4*)(P.b_forget + 4);
#pragma unroll
                            for (int j = 0; j < 4; ++j) { v0[j] = log_sigmoid_f(v0[j] + b0[j]); v1[j] = log_sigmoid_f(v1[j] + b1[j]); }
                            *(f32x4*)(P.LOGF + (size_t)row * 8) = v0; *(f32x4*)(P.LOGF + (size_t)row * 8 + 4) = v1;
                        } else { const float c = 0.04419417382f; *(f32x4*)(P.IW + (size_t)row * 8) = v0 * c; *(f32x4*)(P.IW + (size_t)row * 8 + 4) = v1 * c; } }
            }
            return;
        }
        const bool ikl = (pn == 12 && wc == 2);
        if (do_norm) { if (do_rope) body<true, true, false>(acc, u, r, gain, dst, pitch, hoff, osc, wr, fr, fq); else body<true, false, false>(acc, u, r, gain, dst, pitch, hoff, osc, wr, fr, fq); }
        else if (do_rope) { if (ikl) body<false, true, true>(acc, u, r, gain, dst, pitch, hoff, osc, wr, fr, fq); else body<false, true, false>(acc, u, r, gain, dst, pitch, hoff, osc, wr, fr, fq); }
        else body<false, false, false>(acc, u, r, gain, dst, pitch, hoff, osc, wr, fr, fq);
    }
    template <bool NORM, bool ROPE, bool IKL>
    __device__ __forceinline__ void body(const f32x4 (&acc)[2][2][4][2], const Unit& u, const float (&r)[2][4], const float* gain, bf16_t* dst, int pitch, int hoff, float osc, int wr, int fr, int fq) const {
        f32x4 gv[2][2];
        if (NORM) {
#pragma unroll
            for (int bj = 0; bj < 2; ++bj)
#pragma unroll
                for (int n = 0; n < 2; ++n) gv[bj][n] = *(const f32x4*)(gain + bj * 32 + 8 * fq + 4 * n);
        }
        f32x4 cq[2][4];
        const int rowb = u.pm * BM + wr * 64 + fr;
#define EP_ISSUE(I, B) do { const size_t ro_ = (size_t)(rowb + ((I) >> 2) * HALF + ((I) & 3) * 16) * 32 + 8 * fq; \
            cq[B][0] = *(const f32x4*)(P.cosT + ro_); cq[B][1] = *(const f32x4*)(P.cosT + ro_ + 4); cq[B][2] = *(const f32x4*)(P.sinT + ro_); cq[B][3] = *(const f32x4*)(P.sinT + ro_ + 4); } while (0)
        if (ROPE) EP_ISSUE(0, 0);
#pragma unroll
        for (int ai = 0; ai < 2; ++ai)
#pragma unroll
            for (int m = 0; m < 4; ++m) {
                const int row = u.pm * BM + ai * HALF + wr * 64 + m * 16 + fr; const float rr = r[ai][m];
                if (ROPE) { if (4 * ai + m + 1 < 8) { if (((4 * ai + m) & 1) == 0) EP_ISSUE(4 * ai + m + 1, 1); else EP_ISSUE(4 * ai + m + 1, 0); } asm volatile("" ::: "memory"); }
                f32x4 v[2][2];
#pragma unroll
                for (int bj = 0; bj < 2; ++bj)
#pragma unroll
                    for (int n = 0; n < 2; ++n) v[bj][n] = acc[ai][bj][m][n] * rr;
                if (NORM) {
                    float ss = 0.f;
#pragma unroll
                    for (int bj = 0; bj < 2; ++bj)
#pragma unroll
                        for (int n = 0; n < 2; ++n) ss += (v[bj][n][0] * v[bj][n][0] + v[bj][n][1] * v[bj][n][1]) + (v[bj][n][2] * v[bj][n][2] + v[bj][n][3] * v[bj][n][3]);
                    ss += __shfl_xor(ss, 16); ss += __shfl_xor(ss, 32);
                    const float inv = __builtin_amdgcn_rsqf(ss * (1.0f / 64.0f) + RMS_EPS);
#pragma unroll
                    for (int bj = 0; bj < 2; ++bj)
#pragma unroll
                        for (int n = 0; n < 2; ++n) v[bj][n] = v[bj][n] * inv * gv[bj][n];
                }
                if (ROPE) {
#pragma unroll
                    for (int n = 0; n < 2; ++n) {
                        const f32x4 c = cq[(4 * ai + m) & 1][n], s = cq[(4 * ai + m) & 1][2 + n];
                        const f32x4 x1 = v[0][n], x2 = v[1][n];
                        v[0][n] = x1 * c - x2 * s; v[1][n] = x2 * c + x1 * s; }
                }
#pragma unroll
                for (int bj = 0; bj < 2; ++bj) {
                    const f32x4 a = v[bj][0] * osc, b = v[bj][1] * osc;
                    u32x4 w; w.x = cvt_pk_bf16(a[0], a[1]); w.y = cvt_pk_bf16(a[2], a[3]); w.z = cvt_pk_bf16(b[0], b[1]); w.w = cvt_pk_bf16(b[2], b[3]);
                    if (IKL) {
                        const int d = bj * 32 + 8 * fq; *(u32x4*)(dst + (size_t)(row >> 5) * 2048 + (d >> 4) * 512 + ((d >> 3) & 1) * 256 + (row & 31) * 8) = w;
                    } else *(u32x4*)(dst + (size_t)row * pitch + hoff + bj * 32 + 8 * fq) = w; }
                if (ROPE) asm volatile("" ::: "memory");
            }
#undef EP_ISSUE
    }
};
}
#define GAS __attribute__((address_space(1)))
#define LAS __attribute__((address_space(3)))
typedef unsigned short bf16;
typedef unsigned v4u __attribute__((ext_vector_type(4)));
typedef float f32x4 __attribute__((ext_vector_type(4)));
typedef short bf16x8 __attribute__((ext_vector_type(8)));
typedef GAS unsigned gu32;
typedef GAS unsigned long long gu64;
#define RLX_AGENT __ATOMIC_RELAXED, __HIP_MEMORY_SCOPE_AGENT
#define LDS_WAIT() asm volatile("s_waitcnt lgkmcnt(0)" ::: "memory")
#define VM_WAIT() asm volatile("s_waitcnt vmcnt(0)" ::: "memory")
__device__ __forceinline__ unsigned long long rt() { return __builtin_amdgcn_s_memrealtime(); }
__device__ __forceinline__ unsigned f2bf(float f) { unsigned u = __builtin_bit_cast(unsigned, f); return (u + 0x7fffu + ((u >> 16) & 1u)) >> 16; }
__device__ __forceinline__ unsigned pk2(float lo, float hi) { return f2bf(lo) | (f2bf(hi) << 16); }
typedef float f32x2g __attribute__((ext_vector_type(2)));
__device__ __forceinline__ float bf_lo32(unsigned w) { return __uint_as_float(w << 16); }
__device__ __forceinline__ float bf_hi32(unsigned w) { return __uint_as_float(w & 0xffff0000u); }
constexpr int NWAVES = 8;
constexpr int BATCH = 2, SEQ = 8192, DM = 1024, T = BATCH * SEQ, DFF = 2816, MEMLEN = 256, BW = 512, DIN = 6352;
constexpr int NPROJ = 13 * 256, NGATE = 3072;
constexpr float L2E = 1.4426950408889634f;
constexpr float C2_64 = 0.125f * L2E;
constexpr float C2_128 = 0.08838834764831845f * L2E;
constexpr size_t MiB = 1u << 20;
constexpr size_t WS_CTL = 0, CTL_ZERO_BYTES = 128 * 1024;
constexpr size_t WS_RSTDX = 1 * MiB;
constexpr size_t WS_RSTDM = WS_RSTDX + 64 * 1024;
constexpr size_t WS_T0 = WS_RSTDM + 4096;
constexpr size_t WS_SSQ1 = 2 * MiB;
constexpr size_t WS_SSQ2 = 3 * MiB;
constexpr size_t WS_LOGF = 4 * MiB;
constexpr size_t WS_CUM = WS_LOGF + 512 * 1024;
constexpr size_t WS_IW = 5 * MiB;
constexpr size_t WS_COS = 6 * MiB, WS_SIN = 8 * MiB;
constexpr size_t WS_MEMB = 10 * MiB;
constexpr size_t WS_KVM = 11 * MiB;
constexpr size_t WS_KMB = 13 * MiB, WS_VMB = 14 * MiB;
constexpr size_t WS_WGU1 = 16 * MiB;
constexpr size_t WS_WD1 = 27 * MiB;
constexpr size_t WS_WIN = 33 * MiB;
constexpr size_t WS_WGATE = 40 * MiB;
constexpr size_t WS_WBR = 46 * MiB;
constexpr size_t WS_WOUT = 49 * MiB;
constexpr size_t WS_WGU2 = 51 * MiB;
constexpr size_t WS_WD2 = 62 * MiB;
constexpr size_t WS_WMKV = 68 * MiB;
constexpr size_t WS_HB = 70 * MiB;
constexpr size_t WS_ACT = 102 * MiB;
constexpr size_t WS_HID = WS_ACT;
constexpr size_t WS_FQ = WS_ACT, WS_FK = WS_ACT + 16 * MiB, WS_FV = WS_ACT + 32 * MiB, WS_DQ = WS_ACT + 48 * MiB, WS_IQ = WS_ACT + 64 * MiB, WS_MQ = WS_ACT + 80 * MiB;
constexpr size_t WS_DK = WS_ACT + 96 * MiB, WS_DV = WS_ACT + 98 * MiB, WS_IK = WS_ACT + 100 * MiB;
#if defined(DBG_SUBST) && DBG_SUBST == 2
constexpr size_t WS_MERGED = WS_DQ;
#else
constexpr size_t WS_MERGED = WS_FK;
#endif
#ifdef DBG_GSCR_AT
constexpr size_t WS_GSCR = DBG_GSCR_AT;
#else
constexpr size_t WS_GSCR = 204 * MiB;
#endif
constexpr size_t WS_OA = 236 * MiB;
constexpr size_t WS_OB = 16 * MiB;
constexpr size_t WS_END = 252 * MiB;
#ifndef DBG_GSCR_AT
static_assert(WS_HID + (size_t)T * DFF * 2 <= WS_GSCR && WS_IK + (size_t)T * 64 * 2 <= WS_GSCR, "d_ws map");
#endif
constexpr int CW_BAR = 4096;
constexpr int CW_Q = 16384;
constexpr int RING_OFF = 0, RING_BYTES = 131072;
constexpr int LDSCTL_OFF = RING_BYTES, MISC_OFF = LDSCTL_OFF + 320;
constexpr int LIST_OFF = RING_BYTES + 1024;
constexpr int SCANX_OFF = RING_BYTES + 6144;
constexpr int LDS_BYTES = 163840;
#define XB_TMO      128
#define XB_XCNT(j)  (256  + 64 * (j))
#define XB_XSUB(j)  (1280 + 64 * (j))
#define XB_XGEN(j)  (2304 + 64 * (j))
#define XB_TOP      3328
#define XB_TOPGEN   3392
#define XCD_BAR_WORDS 3456
#define XB_SPIN_CAP (1u << 18)

__device__ __forceinline__ unsigned xb_ld(unsigned* p)              { return __hip_atomic_load(p, __ATOMIC_RELAXED, __HIP_MEMORY_SCOPE_AGENT); }
__device__ __forceinline__ unsigned xb_add(unsigned* p, unsigned v) { return __hip_atomic_fetch_add(p, v, __ATOMIC_RELAXED, __HIP_MEMORY_SCOPE_AGENT); }
__device__ __forceinline__ unsigned xb_xcc_id() { return (unsigned)__builtin_amdgcn_s_getreg((3 << 11) | 20) & 0xFu; }
#define XB_SPIN(cond, bar) do { unsigned _sp = 0; while (cond) { __builtin_amdgcn_s_sleep(1); \
    if ((++_sp & 255u) == 0u) { if (xb_ld(&(bar)[XB_TMO])) break; if (_sp > XB_SPIN_CAP) { atomicAdd(&(bar)[XB_TMO], 1u); break; } } } } while (0)

struct XcdBarrier {
    unsigned* bar; unsigned x;
    volatile LAS unsigned* st;
};

__device__ __forceinline__ XcdBarrier xcd_barrier_post(unsigned* bar, volatile LAS unsigned* st) {
    XcdBarrier b; b.bar = bar; b.x = xb_xcc_id(); b.st = st;
    if (threadIdx.x == 0) (void)xb_add(&bar[XB_XCNT(b.x)], 1u);
    return b;
}
__device__ __forceinline__ void xcd_barrier_complete(unsigned* bar, unsigned x, unsigned& nloc, unsigned& nx) {
    const unsigned G = gridDim.x * gridDim.y * gridDim.z;
    unsigned sum, cnt, mine, sp = 0u;
    for (;;) {
        sum = 0u; cnt = 0u; mine = 0u;
#pragma unroll
        for (unsigned j = 0; j < 16; ++j) { const unsigned c = xb_ld(&bar[XB_XCNT(j)]); sum += c; cnt += (c > 0u) ? 1u : 0u; mine = (j == x) ? c : mine; }
        if (sum == G) break;
        __builtin_amdgcn_s_sleep(1);
        if ((++sp & 255u) == 0u) { if (xb_ld(&bar[XB_TMO])) break; if (sp > XB_SPIN_CAP) { atomicAdd(&bar[XB_TMO], 1u); break; } }
    }
    nloc = mine > 0u ? mine : 1u; nx = cnt > 0u ? cnt : 1u;
}

__device__ __forceinline__ void xcd_barrier(const XcdBarrier& b) {
    asm volatile("s_waitcnt vmcnt(0)" ::: "memory");
    __syncthreads();
    if (threadIdx.x == 0) {
        unsigned* bar = b.bar;
        __builtin_amdgcn_s_waitcnt(0);
        unsigned nloc = b.st[0], nx = b.st[1];
        if (nloc == 0u) { xcd_barrier_complete(bar, b.x, nloc, nx); b.st[0] = nloc; b.st[1] = nx; }
        const unsigned old = xb_add(&bar[XB_XSUB(b.x)], 1u);
        const unsigned gen = old / nloc;
        if (old + 1u == (gen + 1u) * nloc) {
            __builtin_amdgcn_fence(__ATOMIC_RELEASE, "agent");
            asm volatile("s_waitcnt vmcnt(0)" ::: "memory");
            const unsigned og = xb_add(&bar[XB_TOP], 1u);
            const unsigned tg = og / nx;
            if (og + 1u == (tg + 1u) * nx) xb_add(&bar[XB_TOPGEN], 1u);
            else XB_SPIN(xb_ld(&bar[XB_TOPGEN]) == tg, bar);
            __builtin_amdgcn_fence(__ATOMIC_ACQUIRE, "agent");
            xb_add(&bar[XB_XGEN(b.x)], 1u);
            asm volatile("s_waitcnt vmcnt(0)" ::: "memory");
        } else {
            XB_SPIN(xb_ld(&bar[XB_XGEN(b.x)]) == gen, bar);
            __builtin_amdgcn_fence(__ATOMIC_ACQUIRE, "agent");
            asm volatile("s_waitcnt vmcnt(0)" ::: "memory");
        }
    }
    __syncthreads();
}
__device__ __forceinline__ float wave_sum(float v) {
#pragma unroll
    for (int o = 1; o < 64; o <<= 1) v += __shfl_xor(v, o);
    return v;
}
__device__ __forceinline__ float wave_max(float v) {
#pragma unroll
    for (int o = 1; o < 64; o <<= 1) v = fmaxf(v, __shfl_xor(v, o));
    return v;
}
__device__ __forceinline__ int colmap(int mat, int n) {
    if (mat == 1) return n;
    if (mat == 3) return 3280 + n;
    const int tile = n >> 8, t = n & 255;
    if (mat == 0) return (t < 128 ? 0 : DFF) + 128 * tile + (t & 127);
    const int bj = t >> 7, wc = (t >> 5) & 3, i = t & 31, d = bj * 32 + i;
    if (tile < 2) return 0 + (4 * tile + wc) * 64 + d;
    if (tile < 4) return 512 + (4 * (tile - 2) + wc) * 64 + d;
    if (tile < 6) return 1024 + (4 * (tile - 4) + wc) * 64 + d;
    if (tile < 8) return 1544 + (4 * (tile - 6) + wc) * 64 + d;
    if (tile < 10) return 2184 + (4 * (tile - 8) + wc) * 64 + d;
    if (tile < 12) return 2768 + (2 * (tile - 10) + (wc >> 1)) * 128 + (wc & 1) * 64 + d;
    if (wc == 0) return 2056 + d;
    if (wc == 1) return 2120 + d;
    if (wc == 2) return 2696 + d;
    if (bj == 0 && i < 8) return 1536 + i;
    if (bj == 0 && i < 16) return 2760 + (i - 8);
    return -1;
}
template <bool GAIN> __device__ __forceinline__ void transpose_item(int mat, const float* Wa, const float* Wb, int K, int Nsrc, const float* gain, bf16* WT, LAS float* scr, int item, int nblk, int lane) {
    const int kb = item / nblk, nb = item % nblk, k0 = 64 * kb, n0 = 32 * nb;
    int col = colmap(mat, n0 + (lane & 31)); const float* W = Wa;
    if (mat == 0 && col >= DFF) { W = Wb; col -= DFF; }
    const bool okc = col >= 0; const float* wp = W + (size_t)(k0 + (lane >> 5)) * Nsrc + (okc ? col : 0); const float* gp = gain + k0 + (lane >> 5);
    float v[32];
#pragma unroll
    for (int i = 0; i < 32; ++i) v[i] = wp[(size_t)(2 * i) * Nsrc];
    if (GAIN) {
#pragma unroll
        for (int i = 0; i < 32; ++i) v[i] *= gp[2 * i]; }
#pragma unroll
    for (int i = 0; i < 32; ++i) scr[(2 * i + (lane >> 5)) * 33 + (lane & 31)] = okc ? v[i] : 0.f;
    LDS_WAIT(); asm volatile("" ::: "memory");
    const int c = lane & 7;
#pragma unroll
    for (int j = 0; j < 4; ++j) { const int n = (lane >> 3) + 8 * j; const LAS float* s = scr + (8 * c) * 33 + n;
        v4u o; o.x = pk2(s[0 * 33], s[1 * 33]); o.y = pk2(s[2 * 33], s[3 * 33]); o.z = pk2(s[4 * 33], s[5 * 33]); o.w = pk2(s[6 * 33], s[7 * 33]);
        *(GAS v4u*)(WT + (size_t)(n0 + n) * K + k0 + 8 * c) = o; }
    LDS_WAIT(); asm volatile("" ::: "memory");
}
__device__ __forceinline__ void row_to_bf16_rstd(const float* xrow, bf16* orow, float* rstd_out, int lane) {
    const GAS f32x4* xr = (const GAS f32x4*)xrow + lane;
    f32x4 v[4]; float s = 0.f;
#pragma unroll
    for (int j = 0; j < 4; ++j) { v[j] = xr[64 * j]; s += (v[j].x * v[j].x + v[j].y * v[j].y) + (v[j].z * v[j].z + v[j].w * v[j].w); }
    const float rstd = 1.0f / sqrtf(wave_sum(s) * (1.f / 1024.f) + 1e-6f);
    GAS unsigned long long* o8 = (GAS unsigned long long*)orow + lane;
#pragma unroll
    for (int j = 0; j < 4; ++j) o8[64 * j] = (unsigned long long)pk2(v[j].x, v[j].y) | ((unsigned long long)pk2(v[j].z, v[j].w) << 32);
    if (lane == 0) *rstd_out = rstd;
}
__device__ __forceinline__ void rows4_to_bf16_rstd(const float* const (&xrow)[4], bf16* const (&orow)[4], float* const (&rout)[4], const bool (&ok)[4], int lane) {
    f32x4 v[4][4];
#pragma unroll
    for (int r = 0; r < 4; ++r) { const GAS f32x4* xr = (const GAS f32x4*)xrow[r] + lane;
#pragma unroll
        for (int j = 0; j < 4; ++j) v[r][j] = xr[64 * j]; }
#pragma unroll
    for (int r = 0; r < 4; ++r) { float s = 0.f;
#pragma unroll
        for (int j = 0; j < 4; ++j) s += (v[r][j].x * v[r][j].x + v[r][j].y * v[r][j].y) + (v[r][j].z * v[r][j].z + v[r][j].w * v[r][j].w);
        const float rstd = 1.0f / sqrtf(wave_sum(s) * (1.f / 1024.f) + 1e-6f);
        if (ok[r]) { GAS unsigned long long* o8 = (GAS unsigned long long*)orow[r] + lane;
#pragma unroll
            for (int j = 0; j < 4; ++j) o8[64 * j] = (unsigned long long)pk2(v[r][j].x, v[r][j].y) | ((unsigned long long)pk2(v[r][j].z, v[r][j].w) << 32);
            if (lane == 0) *rout[r] = rstd; } }
}
typedef float f32x16 __attribute__((ext_vector_type(16)));
typedef unsigned u32x2 __attribute__((ext_vector_type(2)));
__device__ __forceinline__ int crow(int r, int hi) { return (r & 3) + 8 * (r >> 2) + 4 * hi; }
__device__ __forceinline__ float bf2f(bf16 v) { return __uint_as_float((unsigned)v << 16); }
__device__ __forceinline__ unsigned cvtpk(float lo, float hi) { return pg8::cvt_pk_bf16(lo, hi); }
template <int HD, bool FOX, bool VT>
__device__ __forceinline__ void attn_wave_simple(const bf16x8 (&qr)[HD / 16], const bf16* Kp, int kpitch, const bf16* Vp, int vpitch, int tstart, int ntiles, int qlocal, const float* cb, bf16* Op, int opitch, int lane) {
    const int r32 = lane & 31, hi = lane >> 5;
    f32x16 o[HD / 32];
#pragma unroll
    for (int d0 = 0; d0 < HD / 32; ++d0)
#pragma unroll
        for (int r = 0; r < 16; ++r) o[d0][r] = 0.f;
    float m = -1e30f, l = 0.f;
    for (int t = tstart; t < ntiles; ++t) {
        const int kv0 = 32 * t;
        f32x16 p;
#pragma unroll
        for (int r = 0; r < 16; ++r) p[r] = 0.f;
        const bf16* kr = Kp + (size_t)(kv0 + r32) * kpitch + hi * 8;
#pragma unroll
        for (int ks = 0; ks < HD / 16; ++ks) { const bf16x8 kf = *(const bf16x8*)(kr + ks * 16); p = __builtin_amdgcn_mfma_f32_32x32x16_bf16(kf, qr[ks], p, 0, 0, 0); }
        if (FOX) {
#pragma unroll
            for (int g = 0; g < 4; ++g) { const f32x4 c4 = *(const f32x4*)(cb + kv0 + 8 * g + 4 * hi);
#pragma unroll
                for (int jj = 0; jj < 4; ++jj) p[4 * g + jj] -= L2E * c4[jj]; }
            if (t == ntiles - 1) {
#pragma unroll
                for (int r = 0; r < 16; ++r) if (kv0 + crow(r, hi) > qlocal) p[r] = -INFINITY;
            }
        }
        float mt = p[0];
#pragma unroll
        for (int r = 1; r < 16; ++r) mt = fmaxf(mt, p[r]);
        mt = fmaxf(mt, __shfl_xor(mt, 32));
        const float mn = fmaxf(m, mt); const float alpha = __builtin_amdgcn_exp2f(m - mn); m = mn;
        l *= alpha;
#pragma unroll
        for (int d0 = 0; d0 < HD / 32; ++d0)
#pragma unroll
            for (int r = 0; r < 16; ++r) o[d0][r] *= alpha;
        float ls = 0.f;
#pragma unroll
        for (int r = 0; r < 16; ++r) { p[r] = __builtin_amdgcn_exp2f(p[r] - mn); ls += p[r]; }
        l += ls;
        bf16x8 pa[2];
#pragma unroll
        for (int s = 0; s < 2; ++s) { v4u w; w.x = cvtpk(p[8 * s + 0], p[8 * s + 1]); w.y = cvtpk(p[8 * s + 2], p[8 * s + 3]); w.z = cvtpk(p[8 * s + 4], p[8 * s + 5]); w.w = cvtpk(p[8 * s + 6], p[8 * s + 7]); pa[s] = __builtin_bit_cast(bf16x8, w); }
#pragma unroll
        for (int d0 = 0; d0 < HD / 32; ++d0)
#pragma unroll
            for (int s = 0; s < 2; ++s) {
                bf16x8 vf;
                if (VT) {
                    const bf16* vp = Vp + (size_t)(d0 * 32 + r32) * vpitch + kv0 + 16 * s + 4 * hi;
                    const u32x2 lo = *(const u32x2*)vp, hi2 = *(const u32x2*)(vp + 8);
                    vf = __builtin_bit_cast(bf16x8, (v4u){lo.x, lo.y, hi2.x, hi2.y});
                } else {
#pragma unroll
                    for (int j = 0; j < 8; ++j) vf[j] = (short)Vp[(size_t)(kv0 + 16 * s + 8 * (j >> 2) + 4 * hi + (j & 3)) * vpitch + d0 * 32 + r32];
                }
                o[d0] = __builtin_amdgcn_mfma_f32_32x32x16_bf16(vf, pa[s], o[d0], 0, 0, 0);
            }
    }
    l += __shfl_xor(l, 32);
    const float inv = 1.0f / l;
    bf16* orow = Op + (size_t)r32 * opitch;
#pragma unroll
    for (int d0 = 0; d0 < HD / 32; ++d0)
#pragma unroll
        for (int g = 0; g < 4; ++g) { u32x2 w; w.x = cvtpk(o[d0][4 * g] * inv, o[d0][4 * g + 1] * inv); w.y = cvtpk(o[d0][4 * g + 2] * inv, o[d0][4 * g + 3] * inv);
            *(u32x2*)(orow + d0 * 32 + 8 * g + 4 * hi) = w; }
}
__device__ __forceinline__ void fox_unit(int bh, int qb, const bf16* FQ, const bf16* FK, const bf16* FV, const float* CUM, const int* T0, bf16* OA, int wave, int lane) {
    const int b = bh >> 3, h = bh & 7, r32 = lane & 31, hi = lane >> 5; const size_t rowbase = (size_t)b * SEQ; const int q0 = qb * 256 + wave * 32;
    const bf16* Qw = FQ + (rowbase + q0) * 512 + h * 64; bf16* Ow = OA + (rowbase + q0) * 512 + h * 64;
    bf16x8 qr[4];
#pragma unroll
    for (int ks = 0; ks < 4; ++ks) qr[ks] = *(const bf16x8*)(Qw + (size_t)r32 * 512 + ks * 16 + hi * 8);
    attn_wave_simple<64, true, false>(qr, FK + rowbase * 512 + h * 64, 512, FV + rowbase * 512 + h * 64, 512, T0[bh * 256 + q0 / 32], q0 / 32 + 1, q0 + r32, CUM + (size_t)bh * SEQ, Ow, 512, lane);
}
__device__ __forceinline__ void mem_unit(int rg, int head, bf16* MQ, const bf16* KMB, const bf16* VMB, const float* gq, int lane) {
    const int r32 = lane & 31, hi = lane >> 5; const int row0 = rg * 32; const int b = row0 / SEQ;
    bf16* Qw = MQ + (size_t)row0 * 512 + head * 128;
    bf16x8 raw[8]; float ss = 0.f;
#pragma unroll
    for (int ks = 0; ks < 8; ++ks) { raw[ks] = *(const bf16x8*)(Qw + (size_t)r32 * 512 + ks * 16 + hi * 8);
#pragma unroll
        for (int j = 0; j < 8; ++j) { const float f = bf2f((bf16)raw[ks][j]); ss += f * f; } }
    ss += __shfl_xor(ss, 32);
    const float rstd = __builtin_amdgcn_rsqf(ss * (1.0f / 128.0f) + 1e-6f) * C2_128;
    bf16x8 qr[8];
#pragma unroll
    for (int ks = 0; ks < 8; ++ks) { const f32x4 g0 = *(const f32x4*)(gq + ks * 16 + hi * 8), g1 = *(const f32x4*)(gq + ks * 16 + hi * 8 + 4); v4u w;
        w.x = cvtpk(bf2f((bf16)raw[ks][0]) * rstd * g0[0], bf2f((bf16)raw[ks][1]) * rstd * g0[1]); w.y = cvtpk(bf2f((bf16)raw[ks][2]) * rstd * g0[2], bf2f((bf16)raw[ks][3]) * rstd * g0[3]);
        w.z = cvtpk(bf2f((bf16)raw[ks][4]) * rstd * g1[0], bf2f((bf16)raw[ks][5]) * rstd * g1[1]); w.w = cvtpk(bf2f((bf16)raw[ks][6]) * rstd * g1[2], bf2f((bf16)raw[ks][7]) * rstd * g1[3]);
        qr[ks] = __builtin_bit_cast(bf16x8, w); }
    attn_wave_simple<128, false, true>(qr, KMB + (size_t)b * MEMLEN * 512 + head * 128, 512, VMB + (size_t)(b * 4 + head) * 128 * MEMLEN, MEMLEN, 0, MEMLEN / 32, 0, nullptr, Qw, 512, lane);
}
__device__ __forceinline__ void scan_unit(int bh, const float* LOGF, float* CUM, int* T0, const float* gq, const float* gk, LAS float* sx, LAS float* cl, int tid) {
    const int b = bh >> 3, h = bh & 7, lane = tid & 63, wave = tid >> 6;
    float v[16]; float run = 0.f;
#pragma unroll
    for (int i = 0; i < 16; ++i) v[i] = LOGF[((size_t)b * SEQ + 16 * tid + i) * 8 + h];
#pragma unroll
    for (int i = 0; i < 16; ++i) { run += v[i]; v[i] = run; }
    float tot = run;
#pragma unroll
    for (int off = 1; off < 64; off <<= 1) { const float nb = __shfl_up(tot, off); if (lane >= off) tot += nb; }
    if (lane == 63) sx[wave] = tot;
    __syncthreads();
    float woff = 0.f;
    for (int w = 0; w < wave; ++w) woff += sx[w];
    const float excl = tot - run + woff;
    float* dst = CUM + (size_t)bh * SEQ + 16 * tid;
#pragma unroll
    for (int i = 0; i < 16; i += 4) { const f32x4 o4 = (f32x4){v[i] + excl, v[i + 1] + excl, v[i + 2] + excl, v[i + 3] + excl}; *(f32x4*)(dst + i) = o4; *(LAS f32x4*)(cl + 16 * tid + i) = o4; }
    const float smax = 8.0f * wave_max(fabsf(gq[lane])) * wave_max(fabsf(gk[lane]));
    __syncthreads();
    if (tid < 256) { const float cq = cl[32 * tid]; const float lim = -(30.0f + 2.0f * smax);
        int lo = 0, hi = tid;
        while (lo < hi) { const int mid = (lo + hi) >> 1; if (cq - cl[32 * mid + 31] >= lim) hi = mid; else lo = mid + 1; }
        T0[bh * 256 + tid] = lo; }
    __syncthreads();
}
constexpr int D2_LST = RING_BYTES + 1024;
constexpr int D2_CNT = RING_BYTES + 3072;
constexpr int D2_CL = RING_BYTES + 4096;
typedef short v4i16_t __attribute__((ext_vector_type(4)));
typedef float f32x4d __attribute__((ext_vector_type(4)));
__device__ __forceinline__ unsigned sortable_u32(float f) { const unsigned u = __float_as_uint(f); return u ^ ((u >> 31) ? 0xFFFFFFFFu : 0x80000000u); }
__device__ __forceinline__ int lane_rank(unsigned long long mask) { return (int)__builtin_amdgcn_mbcnt_hi((unsigned)(mask >> 32), __builtin_amdgcn_mbcnt_lo((unsigned)mask, 0u)); }
__device__ __forceinline__ int bcount(bool p) { return (int)__popcll(__ballot(p)); }
__device__ __forceinline__ void select_full(const LAS unsigned* my, int npad, LAS unsigned short* lst, int lane) {
    unsigned thr = 0u;
    for (int bit = 31; bit >= 0; --bit) {
        const unsigned cand = thr | (1u << bit); int cnt = 0;
        for (int i0 = 0; i0 < npad; i0 += 256) { const int idx = i0 + 4 * lane; v4u v = (v4u){0u, 0u, 0u, 0u}; if (idx < npad) v = *(const LAS v4u*)(my + idx);
            cnt += bcount(v.x >= cand) + bcount(v.y >= cand) + bcount(v.z >= cand) + bcount(v.w >= cand); }
        if (cnt >= 256) thr = cand;
    }
    int cgt = 0;
    for (int i0 = 0; i0 < npad; i0 += 256) { const int idx = i0 + 4 * lane; v4u v = (v4u){0u, 0u, 0u, 0u}; if (idx < npad) v = *(const LAS v4u*)(my + idx);
        cgt += bcount(v.x > thr) + bcount(v.y > thr) + bcount(v.z > thr) + bcount(v.w > thr); }
    const int quota = 256 - cgt; int eqseen = 0, nsel = 0;
    for (int base = 0; base < npad; base += 64) { const int idx = base + lane; unsigned u = 0u; if (idx < npad) u = my[idx];
        const bool gt = u > thr, eq = (u == thr);
        const unsigned long long em = __ballot(eq); const int er = eqseen + lane_rank(em);
        const bool sel = gt || (eq && er < quota);
        const unsigned long long sm = __ballot(sel); const int pos = nsel + lane_rank(sm);
        if (sel && pos < 256) lst[pos] = (unsigned short)idx;
        nsel += __popcll(sm); eqseen += __popcll(em); }
}
template <int KMAX> __device__ __forceinline__ void select_cands(const unsigned (&uu)[16], const unsigned (&id)[16], LAS unsigned short* lst, int lane, unsigned lb = 0u) {
    unsigned thr = 0u;
    for (int bit = 31; bit >= 0; --bit) {
        if ((((thr ^ lb) >> bit) >> 1) == 0u && ((lb >> bit) & 1u)) { thr |= (1u << bit); continue; }
        const unsigned cand = thr | (1u << bit); int cnt = 0;
#pragma unroll
        for (int k = 0; k < KMAX; ++k) cnt += bcount(uu[k] >= cand);
        if (cnt >= 256) { thr = cand; if (cnt == 256) break; }
    }
    int cgt = 0, ceq = 0;
#pragma unroll
    for (int k = 0; k < KMAX; ++k) { cgt += bcount(uu[k] > thr); ceq += bcount(uu[k] == thr); }
    const int quota = 256 - cgt; unsigned ilim = 0xFFFFu;
    if (ceq != quota) {
        unsigned I = 0u;
        for (int bit = 12; bit >= 0; --bit) { const unsigned cand = I | (1u << bit); int cnt = 0;
#pragma unroll
            for (int k = 0; k < KMAX; ++k) cnt += bcount(uu[k] == thr && id[k] < cand);
            if (cnt < quota) I = cand; }
        ilim = I;
    }
    int nsel = 0;
#pragma unroll
    for (int k = 0; k < KMAX; ++k) { const bool sel = (uu[k] > thr) || (uu[k] == thr && id[k] <= ilim);
        const unsigned long long sm = __ballot(sel); const int pos = nsel + lane_rank(sm);
        if (sel && pos < 256) lst[pos] = (unsigned short)id[k];
        nsel += __popcll(sm); }
}
__device__ __forceinline__ void dsa2_unit(int b, int qg, const bf16* IQ, const bf16* IK, const float* IW, const bf16* DQ, const bf16* DK, const bf16* DV, bf16* OB, LAS unsigned char* lds, int wave, int lane) {
    LAS unsigned* sc = (LAS unsigned*)lds;
    LAS unsigned short* LST = (LAS unsigned short*)(lds + D2_LST);
    LAS int* CNT = (LAS int*)(lds + D2_CNT);
    LAS unsigned short* CL = (LAS unsigned short*)(lds + D2_CL);
    const int q0 = 4 * qg, r32 = lane & 31, hi = lane >> 5; const size_t rowbase = (size_t)b * SEQ;
    const int ntile = (q0 + 3) / 32 + 1, npad = ntile * 32;
#ifndef REP_A
#define REP_A 1
#define REP_B1 1
#define REP_B2 1
#define REP_C 1
#endif
    for (int repa = 0; repa < REP_A; ++repa)
    {
        const int qi = 2 * ((r32 >> 2) & 1) + (r32 >> 4), hd = 4 * ((r32 >> 3) & 1) + (r32 & 3);
        bf16x8 aq[4];
#pragma unroll
        for (int ks = 0; ks < 4; ++ks) aq[ks] = *(const bf16x8*)(IQ + (rowbase + q0 + qi) * 512 + hd * 64 + ks * 16 + hi * 8);
        const float* w0p = IW + (rowbase + q0 + 2 * hi) * 8;
        const f32x4 w0a = *(const f32x4*)(w0p), w0b = *(const f32x4*)(w0p + 4), w1a = *(const f32x4*)(w0p + 8), w1b = *(const f32x4*)(w0p + 12);
        for (int t = wave; t < ntile; t += 32) {
            bf16x8 bk[4][4];
#pragma unroll
            for (int u = 0; u < 4; ++u) { const int tt = t + 8 * u; const bf16* kr = IK + (rowbase + 32 * (tt < ntile ? tt : t)) * 64 + lane * 8;
#pragma unroll
                for (int ks = 0; ks < 4; ++ks) bk[u][ks] = *(const bf16x8*)(kr + ks * 512); }
#pragma unroll
            for (int u = 0; u < 4; ++u) { const int tt = t + 8 * u;
                if (tt < ntile) {
                    const int key = 32 * tt + r32;
                    f32x16 a;
#pragma unroll
                    for (int r = 0; r < 16; ++r) a[r] = 0.f;
#pragma unroll
                    for (int ks = 0; ks < 4; ++ks) a = __builtin_amdgcn_mfma_f32_32x32x16_bf16(aq[ks], bk[u][ks], a, 0, 0, 0);
                    float s0 = 0.f, s1 = 0.f;
#pragma unroll
                    for (int j = 0; j < 4; ++j) { s0 += w0a[j] * fmaxf(a[j], 0.f); s1 += w1a[j] * fmaxf(a[8 + j], 0.f); }
#pragma unroll
                    for (int j = 0; j < 4; ++j) { s0 += w0b[j] * fmaxf(a[4 + j], 0.f); s1 += w1b[j] * fmaxf(a[12 + j], 0.f); }
                    sc[(2 * hi) * 8192 + key] = (key <= q0 + 2 * hi) ? sortable_u32(s0) : 0u;
                    sc[(2 * hi + 1) * 8192 + key] = (key <= q0 + 2 * hi + 1) ? sortable_u32(s1) : 0u;
                } }
        }
    }
    __syncthreads();
    const int qi = wave & 3, hf = wave >> 2, q = q0 + qi, n = q + 1;
    const LAS unsigned* my = sc + qi * 8192;
    for (int repb = 0; repb < REP_B1; ++repb)
    {
        int c = 0; bool ovf = false;
        if (n > 256) {
            unsigned pivot = 1u;
            if (n > 640) {
                unsigned s[8];
#pragma unroll
                for (int k = 0; k < 8; ++k) s[k] = my[(int)(((unsigned)(lane * 8 + k) * (unsigned)n) >> 9)];
                const int r = (256 * 512 * 7 / 4) / n + 8;
                unsigned t16 = 0u;
                for (int bit = 15; bit >= 0; --bit) { const unsigned cand = (t16 | (1u << bit)) << 16; int cnt = 0;
#pragma unroll
                    for (int k = 0; k < 8; ++k) cnt += bcount(s[k] >= cand);
                    if (cnt >= r) t16 |= (1u << bit); }
                pivot = t16 << 16; if (pivot == 0u) pivot = 1u;
            }
            const int half = ((npad + 511) >> 9) << 8; const int lo = hf * half; const int hiend = (lo + half < npad) ? lo + half : npad;
            LAS unsigned short* cl = CL + wave * 1024;
            for (int i0 = lo; i0 < hiend; i0 += 256) { const int idx = i0 + 4 * lane; v4u v = (v4u){0u, 0u, 0u, 0u}; if (idx < hiend) v = *(const LAS v4u*)(my + idx);
#pragma unroll
                for (int e = 0; e < 4; ++e) { const bool f = v[e] >= pivot; const unsigned long long m = __ballot(f); const int pos = c + lane_rank(m);
                    if (f) { if (pos < 1024) cl[pos] = (unsigned short)(idx + e); }
                    c += __popcll(m); } }
            if (c > 1024) ovf = true;
        }
        if (lane == 0) CNT[wave] = ovf ? -1 : c;
    }
    __syncthreads();
    for (int repb2 = 0; repb2 < REP_B2; ++repb2)
    if (wave < 4) {
        LAS unsigned short* lst = LST + wave * 256; int nsel;
        if (n <= 256) { for (int i = lane; i < n; i += 64) lst[i] = (unsigned short)i; nsel = n; }
        else {
            const int c0 = CNT[wave], c1 = CNT[wave + 4]; const int c = c0 + c1;
            if (c0 < 0 || c1 < 0 || c < 256 || c > 1024) select_full(my, npad, lst, lane);
            else {
                unsigned uu[16], id[16];
#pragma unroll
                for (int k = 0; k < 16; ++k) { const int j = k * 64 + lane; unsigned ix = 0u, u = 0u;
                    if (j < c) { ix = (j < c0) ? (unsigned)CL[wave * 1024 + j] : (unsigned)CL[(wave + 4) * 1024 + (j - c0)]; u = my[ix]; }
                    uu[k] = u; id[k] = ix; }
                if (c <= 512) select_cands<8>(uu, id, lst, lane); else select_cands<16>(uu, id, lst, lane);
            }
            nsel = 256;
        }
        if (lane == 0) CNT[8 + wave] = nsel;
    }
    __syncthreads();
    for (int repc = 0; repc < REP_C; ++repc)
    {
        const int nsel = CNT[8 + qi]; const int j0 = 128 * hf; int cntk = nsel - j0; cntk = cntk < 0 ? 0 : (cntk > 128 ? 128 : cntk);
        const LAS unsigned short* lst = LST + qi * 256;
        LAS unsigned char* tile = lds + wave * 16384;
        LAS float* tf = (LAS float*)tile;
        const int l15 = lane & 15, kq = lane >> 4;
        if (cntk == 0) {
#pragma unroll
            for (int i = 0; i < 8; ++i) tf[i * 64 + lane] = 0.f;
            if (lane < 8) { tf[512 + lane] = -INFINITY; tf[520 + lane] = 0.f; }
        } else {
#pragma unroll
            for (int it = 0; it < 16; ++it) { const int r = 8 * it + (lane >> 3), ch = lane & 7; int j = j0 + r; j = j < nsel ? j : nsel - 1;
                const int idxv = (int)lst[j]; const v4u v = *(const v4u*)(DV + (rowbase + idxv) * 64 + 8 * ch);
                *(LAS v4u*)(tile + r * 128 + ch * 16) = v; }
            bf16x8 qf[2];
#pragma unroll
            for (int ks = 0; ks < 2; ++ks) { v4u z = (v4u){0u, 0u, 0u, 0u}; if (l15 < 8) z = *(const v4u*)(DQ + (rowbase + q) * 512 + l15 * 64 + 32 * ks + 8 * kq); qf[ks] = __builtin_bit_cast(bf16x8, z); }
            f32x4d acc[8];
#pragma unroll
            for (int g = 0; g < 8; ++g) { int j = j0 + 16 * g + l15; j = j < nsel ? j : nsel - 1; const int idxk = (int)lst[j];
                const bf16* kp = DK + (rowbase + idxk) * 64 + 8 * kq;
                const bf16x8 k0 = *(const bf16x8*)(kp), k1 = *(const bf16x8*)(kp + 32);
                f32x4d a = (f32x4d){0.f, 0.f, 0.f, 0.f};
                a = __builtin_amdgcn_mfma_f32_16x16x32_bf16(k0, qf[0], a, 0, 0, 0); a = __builtin_amdgcn_mfma_f32_16x16x32_bf16(k1, qf[1], a, 0, 0, 0); acc[g] = a; }
            float mx = -INFINITY;
#pragma unroll
            for (int g = 0; g < 8; ++g)
#pragma unroll
                for (int e = 0; e < 4; ++e) { if (16 * g + 4 * kq + e >= cntk) acc[g][e] = -INFINITY; mx = fmaxf(mx, acc[g][e]); }
            mx = fmaxf(mx, __shfl_xor(mx, 16)); mx = fmaxf(mx, __shfl_xor(mx, 32));
            float ls = 0.f;
#pragma unroll
            for (int g = 0; g < 8; ++g)
#pragma unroll
                for (int e = 0; e < 4; ++e) { acc[g][e] = __builtin_amdgcn_exp2f(acc[g][e] - mx); ls += acc[g][e]; }
            ls += __shfl_xor(ls, 16); ls += __shfl_xor(ls, 32);
            bf16x8 pa[4];
#pragma unroll
            for (int t = 0; t < 4; ++t) { v4u w; w.x = cvtpk(acc[2 * t][0], acc[2 * t][1]); w.y = cvtpk(acc[2 * t][2], acc[2 * t][3]); w.z = cvtpk(acc[2 * t + 1][0], acc[2 * t + 1][1]); w.w = cvtpk(acc[2 * t + 1][2], acc[2 * t + 1][3]); pa[t] = __builtin_bit_cast(bf16x8, w); }
            f32x4d o[4];
            const int q_ = l15 >> 2, p_ = lane & 3;
#pragma unroll
            for (int cb = 0; cb < 4; ++cb) { f32x4d oc = (f32x4d){0.f, 0.f, 0.f, 0.f};
#pragma unroll
                for (int t = 0; t < 4; ++t) {
                    const LAS unsigned char* a1 = tile + (32 * t + 4 * kq + q_) * 128 + (16 * cb + 4 * p_) * 2;
                    const v4i16_t lo4 = __builtin_amdgcn_ds_read_tr16_b64_v4i16((LAS v4i16_t*)a1), hi4 = __builtin_amdgcn_ds_read_tr16_b64_v4i16((LAS v4i16_t*)(a1 + 16 * 128));
                    const bf16x8 vf = (bf16x8){lo4[0], lo4[1], lo4[2], lo4[3], hi4[0], hi4[1], hi4[2], hi4[3]};
                    oc = __builtin_amdgcn_mfma_f32_16x16x32_bf16(pa[t], vf, oc, 0, 0, 0); }
                o[cb] = oc; }
            if (kq < 2) {
#pragma unroll
                for (int cb = 0; cb < 4; ++cb)
#pragma unroll
                    for (int e = 0; e < 4; ++e) tf[(4 * kq + e) * 64 + 16 * cb + l15] = o[cb][e];
            }
            if (lane < 8) { tf[512 + lane] = mx; tf[520 + lane] = ls; }
        }
    }
    __syncthreads();
    if (wave < 4) {
        const LAS float* ta = (const LAS float*)(lds + wave * 16384); const LAS float* tb = (const LAS float*)(lds + (wave + 4) * 16384);
        const int h = lane >> 3, d0 = (lane & 7) * 8;
        const float ma = ta[512 + h], mb = tb[512 + h], la = ta[520 + h], lb = tb[520 + h];
        const float m = fmaxf(ma, mb), fa = __builtin_amdgcn_exp2f(ma - m), fb = __builtin_amdgcn_exp2f(mb - m);
        const float inv = 1.0f / (la * fa + lb * fb);
        const f32x4 a0 = *(const LAS f32x4*)(ta + h * 64 + d0), a1 = *(const LAS f32x4*)(ta + h * 64 + d0 + 4), b0 = *(const LAS f32x4*)(tb + h * 64 + d0), b1 = *(const LAS f32x4*)(tb + h * 64 + d0 + 4);
        const f32x4 r0 = (a0 * fa + b0 * fb) * inv, r1 = (a1 * fa + b1 * fb) * inv;
        v4u w; w.x = cvtpk(r0[0], r0[1]); w.y = cvtpk(r0[2], r0[3]); w.z = cvtpk(r1[0], r1[1]); w.w = cvtpk(r1[2], r1[3]);
        *(v4u*)(OB + (rowbase + q) * 512 + h * 64 + d0) = w;
    }
    __syncthreads();
}
constexpr int D3_RING = RING_BYTES + 1024;
constexpr int D3_LST = D3_RING + 16384;
constexpr int D3_CNT = D3_LST + 8192;
constexpr int D3_QW = D3_CNT + 512;
typedef unsigned long long u64d;
template <int KMAX> __device__ __forceinline__ void select_cands3(const unsigned (&uu)[16], const unsigned (&id)[16], LAS unsigned short* lst, int lane) { select_cands<KMAX>(uu, id, lst, lane); }
__device__ __forceinline__ void dsa3_unit(int b, int g16, const bf16* IQ, const bf16* IK, const float* IW, const bf16* DQ, const bf16* DK, const bf16* DV, bf16* OB, LAS unsigned char* lds, int wave, int lane_in) {
    int lane = lane_in; asm volatile("" : "+v"(lane));
    LAS u64d* LISTS = (LAS u64d*)lds;
    LAS unsigned short* LST = (LAS unsigned short*)(lds + D3_LST);
    LAS int* CNT = (LAS int*)(lds + D3_CNT);
    const int tid = wave * 64 + lane, r32 = lane & 31, hi = lane >> 5; const size_t rowbase = (size_t)b * SEQ;
    const int q0 = 16 * g16, ntile = (q0 + 15) / 32 + 1, nstep = (ntile + 1) >> 1;
    const int qgrp = wave & 3, par = wave >> 2;
    const int qA = q0 + 4 * qgrp + 2 * hi, qB = qA + 1;
    const int qi = 2 * ((r32 >> 2) & 1) + (r32 >> 4), hd = 4 * ((r32 >> 3) & 1) + (r32 & 3);
    bf16x8 aq[4];
#pragma unroll
    for (int ks = 0; ks < 4; ++ks) aq[ks] = *(const bf16x8*)(IQ + (rowbase + q0 + 4 * qgrp + qi) * 512 + hd * 64 + ks * 16 + hi * 8);
    const float* w0p = IW + (rowbase + qA) * 8;
    const f32x4 w0a = *(const f32x4*)(w0p), w0b = *(const f32x4*)(w0p + 4), w1a = *(const f32x4*)(w0p + 8), w1b = *(const f32x4*)(w0p + 12);
    f32x4 l0a, l0b, l1a, l1b;
#pragma unroll
    for (int j = 0; j < 4; ++j) { l0a[j] = w0a[j] >= 0.f ? INFINITY : -INFINITY; l0b[j] = w0b[j] >= 0.f ? INFINITY : -INFINITY; l1a[j] = w1a[j] >= 0.f ? INFINITY : -INFINITY; l1b[j] = w1b[j] >= 0.f ? INFINITY : -INFINITY; }
#define D3_SCORE(BK, S0, S1) do { f32x16 a_; _Pragma("unroll") for (int r = 0; r < 16; ++r) a_[r] = 0.f; \
        _Pragma("unroll") for (int ks = 0; ks < 4; ++ks) a_ = __builtin_amdgcn_mfma_f32_32x32x16_bf16(aq[ks], BK[ks], a_, 0, 0, 0); \
        S0 = 0.f; S1 = 0.f; \
        _Pragma("unroll") for (int j = 0; j < 4; ++j) { S0 += __builtin_amdgcn_fmed3f(w0a[j] * a_[j], 0.f, l0a[j]); S1 += __builtin_amdgcn_fmed3f(w1a[j] * a_[8 + j], 0.f, l1a[j]); } \
        _Pragma("unroll") for (int j = 0; j < 4; ++j) { S0 += __builtin_amdgcn_fmed3f(w0b[j] * a_[4 + j], 0.f, l0b[j]); S1 += __builtin_amdgcn_fmed3f(w1b[j] * a_[12 + j], 0.f, l1b[j]); } } while (0)
#ifndef REP_S
#define REP_S 1
#define REP_M 1
#define REP_B 1
#define REP_CD 1
#endif
    unsigned pivA = 1u, pivB = 1u;
    if (ntile <= 16 && tid < 16) CNT[64 + tid] = 0;
    for (int reps = 0; reps < REP_S; ++reps)
    if (ntile > 16) {
#pragma unroll
        for (int k = 0; k < 4; ++k) { const int c = tid + 512 * k; const int ts = ((c >> 8) * ntile) >> 3;
            *(LAS v4u*)(lds + c * 16) = *(const v4u*)(IK + (rowbase + 32 * ts) * 64 + (c & 255) * 8); }
        __syncthreads();
        unsigned uA[8], uB[8];
#pragma unroll
        for (int i = 0; i < 8; ++i) { bf16x8 bk[4];
#pragma unroll
            for (int ks = 0; ks < 4; ++ks) bk[ks] = *(const LAS bf16x8*)(lds + i * 4096 + ks * 1024 + lane * 16);
            float s0, s1; D3_SCORE(bk, s0, s1); uA[i] = sortable_u32(s0); uB[i] = sortable_u32(s1); asm volatile("" ::: "memory"); }
        const int qs = q0 + 4 * qgrp + par;
        const int r0 = (256 * 256 * 7 / 4) / (qs + 1) + 6, r1 = (256 * 256 * 7 / 4) / (qs + 3) + 6;
        unsigned us[8];
#pragma unroll
        for (int i = 0; i < 8; ++i) us[i] = par ? uB[i] : uA[i];
        unsigned t0 = 0u, t1 = 0u;
        for (int bit = 15; bit >= 0; --bit) {
            const unsigned c = ((hi ? t1 : t0) | (1u << bit)) << 16; int n0 = 0, n1 = 0;
#pragma unroll
            for (int i = 0; i < 8; ++i) { const unsigned long long m = __builtin_amdgcn_ballot_w64(us[i] >= c); n0 += __popc((unsigned)m); n1 += __popc((unsigned)(m >> 32)); }
            if (n0 >= r0) t0 |= (1u << bit);
            if (n1 >= r1) t1 |= (1u << bit);
        }
        LAS unsigned* PV = (LAS unsigned*)(CNT + 64);
        if (lane == 0) { PV[4 * qgrp + par] = t0; PV[4 * qgrp + 2 + par] = t1; }
        __syncthreads();
        const unsigned tA = PV[4 * qgrp + 2 * hi], tB = PV[4 * qgrp + 2 * hi + 1];
        pivA = tA << 16; pivB = tB << 16; if (pivA == 0u) pivA = 1u; if (pivB == 0u) pivB = 1u;
        __syncthreads();
    }
    for (int repm = 0; repm < REP_M; ++repm)
    {
        const bf16* src0 = IK + rowbase * 64 + (size_t)(tid & 255) * 8;
#define D3_LOAD(k_) (*(const v4u*)(src0 + (size_t)32 * ((2 * (k_) + (tid >> 8)) < ntile ? (2 * (k_) + (tid >> 8)) : ntile - 1) * 64))
        v4u st0 = (v4u){0u, 0u, 0u, 0u}, st1 = st0, st2 = st0, st3 = st0;
        st0 = D3_LOAD(0); st1 = D3_LOAD(1); st2 = D3_LOAD(2); st3 = D3_LOAD(3);
        *(LAS v4u*)(lds + D3_RING + tid * 16) = st0;
        __syncthreads();
        int cntA = 0, cntB = 0;
        LAS u64d* lA = LISTS + ((4 * qgrp + 2 * hi) * 2 + par) * 512; LAS u64d* lB = lA + 1024;
        f32x16 acc;
#pragma unroll
        for (int r = 0; r < 16; ++r) acc[r] = 0.f;
#define D3_SUMS(S0, S1) do { S0 = 0.f; S1 = 0.f; \
            _Pragma("unroll") for (int j = 0; j < 4; ++j) { S0 += __builtin_amdgcn_fmed3f(w0a[j] * acc[j], 0.f, l0a[j]); S1 += __builtin_amdgcn_fmed3f(w1a[j] * acc[8 + j], 0.f, l1a[j]); } \
            _Pragma("unroll") for (int j = 0; j < 4; ++j) { S0 += __builtin_amdgcn_fmed3f(w0b[j] * acc[4 + j], 0.f, l0b[j]); S1 += __builtin_amdgcn_fmed3f(w1b[j] * acc[12 + j], 0.f, l1b[j]); } } while (0)
#define D3_FILTER(TP, S0, S1) do { const int key = 32 * (TP) + r32; const unsigned u0 = sortable_u32(S0), u1 = sortable_u32(S1); \
                { const bool ps = (key <= qA) && (u0 >= pivA); const unsigned long long m = __ballot(ps); const unsigned ml = (unsigned)m, mh = (unsigned)(m >> 32); \
                  const int pos = cntA + (int)__builtin_amdgcn_mbcnt_hi(mh, __builtin_amdgcn_mbcnt_lo(ml, 0u)) - (hi ? __popc(ml) : 0); \
                  if (ps && pos < 512) lA[pos] = ((u64d)(unsigned)key << 32) | u0; cntA += hi ? __popc(mh) : __popc(ml); } \
                { const bool ps = (key <= qB) && (u1 >= pivB); const unsigned long long m = __ballot(ps); const unsigned ml = (unsigned)m, mh = (unsigned)(m >> 32); \
                  const int pos = cntB + (int)__builtin_amdgcn_mbcnt_hi(mh, __builtin_amdgcn_mbcnt_lo(ml, 0u)) - (hi ? __popc(ml) : 0); \
                  if (ps && pos < 512) lB[pos] = ((u64d)(unsigned)key << 32) | u1; cntB += hi ? __popc(mh) : __popc(ml); } } while (0)
#define D3_STEP(k_, STNEXT, STFREE) do { \
            STFREE = D3_LOAD((k_) + 4); \
            const int tp_ = 2 * (k_) - 2 + par; \
            const LAS unsigned char* sb = lds + D3_RING + ((k_) & 1) * 8192 + par * 4096; bf16x8 bk[4]; \
            _Pragma("unroll") for (int ks = 0; ks < 4; ++ks) bk[ks] = *(const LAS bf16x8*)(sb + ks * 1024 + lane * 16); \
            __builtin_amdgcn_sched_barrier(0); \
            float s0, s1; D3_SUMS(s0, s1); asm volatile("" : "+v"(s0), "+v"(s1));     \
            __builtin_amdgcn_sched_barrier(0); \
            _Pragma("unroll") for (int r = 0; r < 16; ++r) acc[r] = 0.f; \
            _Pragma("unroll") for (int ks = 0; ks < 4; ++ks) acc = __builtin_amdgcn_mfma_f32_32x32x16_bf16(aq[ks], bk[ks], acc, 0, 0, 0); \
            __builtin_amdgcn_sched_barrier(0); \
            if (tp_ >= 0 && tp_ < ntile) D3_FILTER(tp_, s0, s1); \
            *(LAS v4u*)(lds + D3_RING + (((k_) + 1) & 1) * 8192 + tid * 16) = STNEXT; \
            asm volatile("s_waitcnt lgkmcnt(0)" ::: "memory"); __builtin_amdgcn_s_barrier(); asm volatile("" ::: "memory"); } while (0)
        int kend = 0;
        for (int k = 0; k < nstep; k += 4) {
            D3_STEP(k, st1, st0); D3_STEP(k + 1, st2, st1); D3_STEP(k + 2, st3, st2); D3_STEP(k + 3, st0, st3); kend = k + 4;
        }
        {   const int tp_ = 2 * kend - 2 + par; if (tp_ < ntile) { float s0, s1; D3_SUMS(s0, s1); D3_FILTER(tp_, s0, s1); } }
#undef D3_SUMS
#undef D3_FILTER
#undef D3_STEP
#undef D3_LOAD
        if (r32 == 0) { CNT[(4 * qgrp + 2 * hi) * 2 + par] = cntA; CNT[(4 * qgrp + 2 * hi + 1) * 2 + par] = cntB; }
        if (tid < 4) CNT[48 + tid] = 0;
    }
#undef D3_SCORE
    __syncthreads();
#if defined(DBG_D3_STAGE) && DBG_D3_STAGE == 1
    for (int grp = 0; grp < 4; ++grp) dsa2_unit(b, 4 * g16 + grp, IQ, IK, IW, DQ, DK, DV, OB, lds, wave, lane);
    return;
#endif
#pragma unroll 1
    for (int rr = 0; rr < 2 * REP_B; ++rr) {
        const int qx = wave + 8 * (rr & 1), q = q0 + qx, n = q + 1; LAS unsigned short* lst = LST + qx * 256; int nsel;
        if (n <= 256) { for (int i = lane; i < n; i += 64) lst[i] = (unsigned short)i; nsel = n; }
        else {
            const int c0 = CNT[2 * qx], c1 = CNT[2 * qx + 1]; const int c = c0 + c1;
#ifdef DBG_D3_ALLFAIL
            if (true) { if (lane == 0) CNT[48 + (qx >> 2)] = 1; nsel = 0; }
#else
            if (c0 > 512 || c1 > 512 || c < 256) { if (lane == 0) CNT[48 + (qx >> 2)] = 1; nsel = 0; }
#endif
            else {
                unsigned uu[16], id[16]; const LAS u64d* L0 = LISTS + (qx * 2) * 512; const LAS u64d* L1 = L0 + 512;
#pragma unroll
                for (int k = 0; k < 16; ++k) { const int j = k * 64 + lane, jj = j < c ? j : c - 1;
                    const u64d e = *((jj < c0) ? (L0 + jj) : (L1 + (jj - c0))); uu[k] = j < c ? (unsigned)e : 0u; id[k] = (unsigned)(e >> 32); }
                const unsigned lb = (unsigned)CNT[64 + qx] << 16;
                if (c <= 512) select_cands<8>(uu, id, lst, lane, lb); else if (c <= 640) select_cands<10>(uu, id, lst, lane, lb); else if (c <= 768) select_cands<12>(uu, id, lst, lane, lb); else select_cands<16>(uu, id, lst, lane, lb);
                nsel = 256;
            }
        }
        if (lane == 0) CNT[32 + qx] = nsel;
    }
    __syncthreads();
#pragma unroll 1
    for (int rr_ = 0; rr_ < 2 * REP_CD; ++rr_) { const int rr = rr_ & 1;
        const int qx = wave + 8 * rr, q = q0 + qx; const int nsel = CNT[32 + qx];
        const LAS unsigned short* lst = LST + qx * 256;
        LAS unsigned char* tile = lds + wave * 16384; LAS float* tf = (LAS float*)tile;
        const int l15 = lane & 15, kq = lane >> 4, q_ = l15 >> 2, p_ = lane & 3;
        bf16x8 qf[2];
#pragma unroll
        for (int ks = 0; ks < 2; ++ks) { v4u z = (v4u){0u, 0u, 0u, 0u}; if (l15 < 8) z = *(const v4u*)(DQ + (rowbase + q) * 512 + l15 * 64 + 32 * ks + 8 * kq); qf[ks] = __builtin_bit_cast(bf16x8, z); }
        float mrun = -INFINITY, lrun = 0.f; f32x4d orun[4];
#pragma unroll
        for (int cb = 0; cb < 4; ++cb) orun[cb] = (f32x4d){0.f, 0.f, 0.f, 0.f};
#pragma unroll 1
        for (int hf = 0; hf < 2; ++hf) {
            const int j0 = 128 * hf; int cntk = nsel - j0; cntk = cntk > 128 ? 128 : cntk;
            if (cntk <= 0) break;
            int iv[16], ik[8];
#pragma unroll
            for (int it = 0; it < 16; ++it) { int j = j0 + 8 * it + (lane >> 3); j = j < nsel ? j : nsel - 1; iv[it] = (int)lst[j]; }
#pragma unroll
            for (int g = 0; g < 8; ++g) { int j = j0 + 16 * g + l15; j = j < nsel ? j : nsel - 1; ik[g] = (int)lst[j]; }
            asm volatile("s_waitcnt lgkmcnt(0)" ::: "memory");
#pragma unroll
            for (int it = 0; it < 16; ++it)
                __builtin_amdgcn_global_load_lds((const unsigned*)(DV + (rowbase + iv[it]) * 64 + 8 * (lane & 7)), (LAS unsigned*)(tile + it * 1024), 16, 0, 0);
            bf16x8 kk0[8], kk1[8];
#pragma unroll
            for (int g = 0; g < 8; ++g) { const bf16* kp = DK + (rowbase + ik[g]) * 64 + 8 * kq; kk0[g] = *(const bf16x8*)(kp); kk1[g] = *(const bf16x8*)(kp + 32); }
            asm volatile("" ::: "memory");
            f32x4d acc[8];
#pragma unroll
            for (int g = 0; g < 8; ++g) { f32x4d a = (f32x4d){0.f, 0.f, 0.f, 0.f};
                a = __builtin_amdgcn_mfma_f32_16x16x32_bf16(kk0[g], qf[0], a, 0, 0, 0); a = __builtin_amdgcn_mfma_f32_16x16x32_bf16(kk1[g], qf[1], a, 0, 0, 0); acc[g] = a; }
            float mx = -INFINITY;
#pragma unroll
            for (int g = 0; g < 8; ++g)
#pragma unroll
                for (int e = 0; e < 4; ++e) { if (16 * g + 4 * kq + e >= cntk) acc[g][e] = -INFINITY; mx = fmaxf(mx, acc[g][e]); }
            mx = fmaxf(mx, __shfl_xor(mx, 16)); mx = fmaxf(mx, __shfl_xor(mx, 32));
            const float mnew = fmaxf(mrun, mx), fold = __builtin_amdgcn_exp2f(mrun - mnew);
            float ls = 0.f;
#pragma unroll
            for (int g = 0; g < 8; ++g)
#pragma unroll
                for (int e = 0; e < 4; ++e) { acc[g][e] = __builtin_amdgcn_exp2f(acc[g][e] - mnew); ls += acc[g][e]; }
            ls += __shfl_xor(ls, 16); ls += __shfl_xor(ls, 32);
            lrun = lrun * fold + ls; mrun = mnew;
            float fo[4];
#pragma unroll
            for (int e = 0; e < 4; ++e) fo[e] = __shfl(fold, 4 * kq + e);
            asm volatile("s_waitcnt vmcnt(0)" ::: "memory");
            bf16x8 pa[4];
#pragma unroll
            for (int t = 0; t < 4; ++t) { v4u w; w.x = cvtpk(acc[2 * t][0], acc[2 * t][1]); w.y = cvtpk(acc[2 * t][2], acc[2 * t][3]); w.z = cvtpk(acc[2 * t + 1][0], acc[2 * t + 1][1]); w.w = cvtpk(acc[2 * t + 1][2], acc[2 * t + 1][3]); pa[t] = __builtin_bit_cast(bf16x8, w); }
#pragma unroll
            for (int cb = 0; cb < 4; ++cb) { f32x4d oc = orun[cb];
#pragma unroll
                for (int e = 0; e < 4; ++e) oc[e] *= fo[e];
#pragma unroll
                for (int t = 0; t < 4; ++t) {
                    const LAS unsigned char* a1 = tile + (32 * t + 4 * kq + q_) * 128 + (16 * cb + 4 * p_) * 2;
                    const v4i16_t lo4 = __builtin_amdgcn_ds_read_tr16_b64_v4i16((LAS v4i16_t*)a1), hi4 = __builtin_amdgcn_ds_read_tr16_b64_v4i16((LAS v4i16_t*)(a1 + 16 * 128));
                    const bf16x8 vf = (bf16x8){lo4[0], lo4[1], lo4[2], lo4[3], hi4[0], hi4[1], hi4[2], hi4[3]};
                    oc = __builtin_amdgcn_mfma_f32_16x16x32_bf16(pa[t], vf, oc, 0, 0, 0); }
                orun[cb] = oc; }
        }
        float li[4];
#pragma unroll
        for (int e = 0; e < 4; ++e) li[e] = 1.0f / __shfl(lrun, 4 * kq + e);
        if (kq < 2) {
#pragma unroll
            for (int cb = 0; cb < 4; ++cb)
#pragma unroll
                for (int e = 0; e < 4; ++e) tf[(4 * kq + e) * 64 + 16 * cb + l15] = orun[cb][e] * li[e];
        }
        { const int h = lane >> 3, d0 = (lane & 7) * 8;
          const f32x4 r0 = *(const LAS f32x4*)(tf + h * 64 + d0), r1 = *(const LAS f32x4*)(tf + h * 64 + d0 + 4);
          v4u w; w.x = cvtpk(r0[0], r0[1]); w.y = cvtpk(r0[2], r0[3]); w.z = cvtpk(r1[0], r1[1]); w.w = cvtpk(r1[2], r1[3]);
          *(v4u*)(OB + (rowbase + q) * 512 + h * 64 + d0) = w; }
    }
    __syncthreads();
    const int f0 = CNT[48], f1 = CNT[49], f2 = CNT[50], f3 = CNT[51];
    __syncthreads();
    const int fm = (f0 ? 1 : 0) | (f1 ? 2 : 0) | (f2 ? 4 : 0) | (f3 ? 8 : 0);
#pragma unroll 1
    for (int grp = 0; grp < 4; ++grp) if ((fm >> grp) & 1) dsa2_unit(b, 4 * g16 + grp, IQ, IK, IW, DQ, DK, DV, OB, lds, wave, lane);
}
__device__ __forceinline__ void fox_unit2(int bh, int qb, const bf16* FQ, const bf16* FK, const bf16* FV, const float* CUM, const int* T0, bf16* OA, LAS unsigned char* lds, int wave, int lane) {
    const int b = bh >> 3, h = bh & 7, r32 = lane & 31, hi = lane >> 5; const size_t rowbase = (size_t)b * SEQ; const int q0 = qb * 256 + wave * 32;
    const bf16* Qw = FQ + (rowbase + q0) * 512 + h * 64; bf16* Ow = OA + (rowbase + q0) * 512 + h * 64;
    const bf16* Kp = FK + rowbase * 512 + h * 64; const bf16* Vp = FV + rowbase * 512 + h * 64; const float* cb = CUM + (size_t)bh * SEQ;
    LAS unsigned char* wl = lds + wave * 16384;
    LAS float* bl = (LAS float*)(lds + RING_BYTES + 8192 + wave * 256);
    bf16x8 qr[4];
#pragma unroll
    for (int ks = 0; ks < 4; ++ks) qr[ks] = *(const bf16x8*)(Qw + (size_t)r32 * 512 + ks * 16 + hi * 8);
    const int tstart = T0[bh * 256 + q0 / 32], ntiles = q0 / 32 + 1, qlocal = q0 + r32;
    f32x16 o[2];
#pragma unroll
    for (int d0 = 0; d0 < 2; ++d0)
#pragma unroll
        for (int r = 0; r < 16; ++r) o[d0][r] = 0.f;
    float m = -1e30f, l = 0.f;
    const int lrow = lane >> 3, lch = lane & 7;
#define FOX_LOAD(KR, VR, BR, tt) do { _Pragma("unroll") for (int it = 0; it < 4; ++it) { const size_t ro = (size_t)(32 * (tt) + 8 * it + lrow) * 512 + lch * 8; KR[it] = *(const v4u*)(Kp + ro); VR[it] = *(const v4u*)(Vp + ro); } BR = cb[32 * (tt) + r32]; } while (0)
#define FOX_STORE(KR, VR, BR, bf) do { _Pragma("unroll") for (int it = 0; it < 4; ++it) { const int row = 8 * it + lrow; *(LAS v4u*)(wl + (bf) * 4096 + row * 128 + ((lch ^ (row & 7)) * 16)) = KR[it]; *(LAS v4u*)(wl + 8192 + (bf) * 4096 + row * 128 + lch * 16) = VR[it]; } if (lane < 32) bl[(bf) * 32 + lane] = -L2E * BR; } while (0)
    v4u krA[4], vrA[4], krB[4], vrB[4]; float brA = 0.f, brB = 0.f;
    const int kq = (lane >> 4) & 1, q_ = (lane & 15) >> 2, p_ = lane & 3;
    FOX_LOAD(krA, vrA, brA, tstart);
    if (tstart + 1 < ntiles) FOX_LOAD(krB, vrB, brB, tstart + 1);
    FOX_STORE(krA, vrA, brA, 0);
    auto compute = [&](int t, int buf) {
        const LAS unsigned char* kb = wl + buf * 4096; const LAS unsigned char* vb = wl + 8192 + buf * 4096; const LAS float* bb = bl + buf * 32;
        f32x16 p;
#pragma unroll
        for (int r = 0; r < 16; ++r) p[r] = 0.f;
#pragma unroll
        for (int ks = 0; ks < 4; ++ks) { const bf16x8 kf = *(const LAS bf16x8*)(kb + r32 * 128 + (((2 * ks + hi) ^ (r32 & 7)) * 16)); p = __builtin_amdgcn_mfma_f32_32x32x16_bf16(kf, qr[ks], p, 0, 0, 0); }
#pragma unroll
        for (int g = 0; g < 4; ++g) { const f32x4 c4 = *(const LAS f32x4*)(bb + 8 * g + 4 * hi);
#pragma unroll
            for (int jj = 0; jj < 4; ++jj) p[4 * g + jj] += c4[jj]; }
        if (t == ntiles - 1) {
#pragma unroll
            for (int r = 0; r < 16; ++r) if (32 * t + crow(r, hi) > qlocal) p[r] = -INFINITY;
        }
        float mt = p[0];
#pragma unroll
        for (int r = 1; r < 16; ++r) mt = fmaxf(mt, p[r]);
        mt = fmaxf(mt, __shfl_xor(mt, 32));
        const float mn = fmaxf(m, mt); const float alpha = __builtin_amdgcn_exp2f(m - mn); m = mn;
        l *= alpha;
#pragma unroll
        for (int d0 = 0; d0 < 2; ++d0)
#pragma unroll
            for (int r = 0; r < 16; ++r) o[d0][r] *= alpha;
        float ls = 0.f;
#pragma unroll
        for (int r = 0; r < 16; ++r) { p[r] = __builtin_amdgcn_exp2f(p[r] - mn); ls += p[r]; }
        l += ls;
        bf16x8 pa[2];
#pragma unroll
        for (int s2 = 0; s2 < 2; ++s2) { v4u w; w.x = cvtpk(p[8 * s2 + 0], p[8 * s2 + 1]); w.y = cvtpk(p[8 * s2 + 2], p[8 * s2 + 3]); w.z = cvtpk(p[8 * s2 + 4], p[8 * s2 + 5]); w.w = cvtpk(p[8 * s2 + 6], p[8 * s2 + 7]); pa[s2] = __builtin_bit_cast(bf16x8, w); }
#pragma unroll
        for (int d0 = 0; d0 < 2; ++d0)
#pragma unroll
            for (int s2 = 0; s2 < 2; ++s2) {
                const LAS unsigned char* a1 = vb + (16 * s2 + 4 * hi + q_) * 128 + (32 * d0 + 16 * kq + 4 * p_) * 2;
                const v4i16_t lo4 = __builtin_amdgcn_ds_read_tr16_b64_v4i16((LAS v4i16_t*)a1), hi4 = __builtin_amdgcn_ds_read_tr16_b64_v4i16((LAS v4i16_t*)(a1 + 8 * 128));
                const bf16x8 vf = (bf16x8){lo4[0], lo4[1], lo4[2], lo4[3], hi4[0], hi4[1], hi4[2], hi4[3]};
                o[d0] = __builtin_amdgcn_mfma_f32_32x32x16_bf16(vf, pa[s2], o[d0], 0, 0, 0);
            }
    };
    for (int t = tstart; t < ntiles; t += 2) {
        if (t + 2 < ntiles) FOX_LOAD(krA, vrA, brA, t + 2);
        compute(t, 0);
        if (t + 1 < ntiles) {
            FOX_STORE(krB, vrB, brB, 1);
            if (t + 3 < ntiles) FOX_LOAD(krB, vrB, brB, t + 3);
            compute(t + 1, 1);
            if (t + 2 < ntiles) FOX_STORE(krA, vrA, brA, 0);
        }
    }
#undef FOX_LOAD
#undef FOX_STORE
    l += __shfl_xor(l, 32);
    const float inv = 1.0f / l;
    bf16* orow = Ow + (size_t)r32 * 512;
#pragma unroll
    for (int d0 = 0; d0 < 2; ++d0)
#pragma unroll
        for (int g = 0; g < 4; ++g) { u32x2 w; w.x = cvtpk(o[d0][4 * g] * inv, o[d0][4 * g + 1] * inv); w.y = cvtpk(o[d0][4 * g + 2] * inv, o[d0][4 * g + 3] * inv);
            *(u32x2*)(orow + d0 * 32 + 8 * g + 4 * hi) = w; }
}
__device__ __forceinline__ void fox_unit4(int bh, int qb, const bf16* FQ, const bf16* FK, const bf16* FV, const float* CUM, const int* T0, const float* gq, const float* gk, bf16* OA, LAS unsigned char* lds, int wave, int lane) {
    const int b = bh >> 3, h = bh & 7, r32 = lane & 31, hi = lane >> 5; const size_t rowbase = (size_t)b * SEQ; const int q0 = qb * 256 + wave * 32;
    const bf16* Qw = FQ + (rowbase + q0) * 512 + h * 64; bf16* Ow = OA + (rowbase + q0) * 512 + h * 64;
    const bf16* Kp = FK + rowbase * 512 + h * 64; const bf16* Vp = FV + rowbase * 512 + h * 64; const float* cb = CUM + (size_t)bh * SEQ;
    LAS unsigned char* wl = lds + wave * 16384;
    LAS float* bl = (LAS float*)(lds + RING_BYTES + 8192 + wave * 256);
    bf16x8 qr[4];
#pragma unroll
    for (int ks = 0; ks < 4; ++ks) qr[ks] = *(const bf16x8*)(Qw + (size_t)r32 * 512 + ks * 16 + hi * 8);
    const int tstart = T0[bh * 256 + q0 / 32], tlast = q0 / 32, nseq = tlast - tstart + 1, qlocal = q0 + r32;
    const float stopc = (8.0f * wave_max(fabsf(gq[lane])) * wave_max(fabsf(gk[lane])) + 30.0f) * L2E;
    f32x16 o[2];
#pragma unroll
    for (int d0 = 0; d0 < 2; ++d0)
#pragma unroll
        for (int r = 0; r < 16; ++r) o[d0][r] = 0.f;
    float m = -1e30f, l = 0.f;
    const int lrow = lane >> 3, lch = lane & 7;
#define FOX_LOAD(KR, VR, BR, tt) do { _Pragma("unroll") for (int it = 0; it < 4; ++it) { const size_t ro = (size_t)(32 * (tt) + 8 * it + lrow) * 512 + lch * 8; KR[it] = *(const v4u*)(Kp + ro); VR[it] = *(const v4u*)(Vp + ro); } BR = cb[32 * (tt) + r32]; } while (0)
#define FOX_STORE(KR, VR, BR, bf) do { _Pragma("unroll") for (int it = 0; it < 4; ++it) { const int row = 8 * it + lrow; *(LAS v4u*)(wl + (bf) * 4096 + row * 128 + ((lch ^ (row & 7)) * 16)) = KR[it]; *(LAS v4u*)(wl + 8192 + (bf) * 4096 + row * 128 + lch * 16) = VR[it]; } if (lane < 32) bl[(bf) * 32 + lane] = -L2E * BR; } while (0)
    v4u krA[4], vrA[4], krB[4], vrB[4]; float brA = 0.f, brB = 0.f;
    const int kq = (lane >> 4) & 1, q_ = (lane & 15) >> 2, p_ = lane & 3;
    FOX_LOAD(krA, vrA, brA, tlast);
    if (1 < nseq) FOX_LOAD(krB, vrB, brB, tlast - 1);
    FOX_STORE(krA, vrA, brA, 0);
    auto compute = [&](int t, int buf) -> bool {
        const LAS unsigned char* kb = wl + buf * 4096; const LAS unsigned char* vb = wl + 8192 + buf * 4096; const LAS float* bb = bl + buf * 32;
        if (t != tlast) { const float bmax = bb[31]; if (__all(m > bmax + stopc)) return true; }
        f32x16 p;
#pragma unroll
        for (int r = 0; r < 16; ++r) p[r] = 0.f;
#pragma unroll
        for (int ks = 0; ks < 4; ++ks) { const bf16x8 kf = *(const LAS bf16x8*)(kb + r32 * 128 + (((2 * ks + hi) ^ (r32 & 7)) * 16)); p = __builtin_amdgcn_mfma_f32_32x32x16_bf16(kf, qr[ks], p, 0, 0, 0); }
#pragma unroll
        for (int g = 0; g < 4; ++g) { const f32x4 c4 = *(const LAS f32x4*)(bb + 8 * g + 4 * hi);
#pragma unroll
            for (int jj = 0; jj < 4; ++jj) p[4 * g + jj] += c4[jj]; }
        if (t == tlast) {
#pragma unroll
            for (int r = 0; r < 16; ++r) if (32 * t + crow(r, hi) > qlocal) p[r] = -INFINITY;
        }
        float mt = p[0];
#pragma unroll
        for (int r = 1; r < 16; ++r) mt = fmaxf(mt, p[r]);
        mt = fmaxf(mt, __shfl_xor(mt, 32));
        if (__any(mt > m)) {
            const float mn = fmaxf(m, mt); const float alpha = __builtin_amdgcn_exp2f(m - mn); m = mn;
            l *= alpha;
#pragma unroll
            for (int d0 = 0; d0 < 2; ++d0)
#pragma unroll
                for (int r = 0; r < 16; ++r) o[d0][r] *= alpha;
        }
        const float mn = m;
        float ls = 0.f;
#pragma unroll
        for (int r = 0; r < 16; ++r) { p[r] = __builtin_amdgcn_exp2f(p[r] - mn); ls += p[r]; }
        l += ls;
        bf16x8 pa[2];
#pragma unroll
        for (int s2 = 0; s2 < 2; ++s2) { v4u w; w.x = cvtpk(p[8 * s2 + 0], p[8 * s2 + 1]); w.y = cvtpk(p[8 * s2 + 2], p[8 * s2 + 3]); w.z = cvtpk(p[8 * s2 + 4], p[8 * s2 + 5]); w.w = cvtpk(p[8 * s2 + 6], p[8 * s2 + 7]); pa[s2] = __builtin_bit_cast(bf16x8, w); }
#pragma unroll
        for (int d0 = 0; d0 < 2; ++d0)
#pragma unroll
            for (int s2 = 0; s2 < 2; ++s2) {
                const LAS unsigned char* a1 = vb + (16 * s2 + 4 * hi + q_) * 128 + (32 * d0 + 16 * kq + 4 * p_) * 2;
                const v4i16_t lo4 = __builtin_amdgcn_ds_read_tr16_b64_v4i16((LAS v4i16_t*)a1), hi4 = __builtin_amdgcn_ds_read_tr16_b64_v4i16((LAS v4i16_t*)(a1 + 8 * 128));
                const bf16x8 vf = (bf16x8){lo4[0], lo4[1], lo4[2], lo4[3], hi4[0], hi4[1], hi4[2], hi4[3]};
                o[d0] = __builtin_amdgcn_mfma_f32_32x32x16_bf16(vf, pa[s2], o[d0], 0, 0, 0);
            }
        return false;
    };
    for (int i = 0; i < nseq; i += 2) {
        if (i + 2 < nseq) FOX_LOAD(krA, vrA, brA, tlast - (i + 2));
        if (compute(tlast - i, 0)) break;
        if (i + 1 < nseq) {
            FOX_STORE(krB, vrB, brB, 1);
            if (i + 3 < nseq) FOX_LOAD(krB, vrB, brB, tlast - (i + 3));
            if (compute(tlast - (i + 1), 1)) break;
            if (i + 2 < nseq) FOX_STORE(krA, vrA, brA, 0);
        }
    }
#undef FOX_LOAD
#undef FOX_STORE
    l += __shfl_xor(l, 32);
    const float inv = 1.0f / l;
    bf16* orow = Ow + (size_t)r32 * 512;
#pragma unroll
    for (int d0 = 0; d0 < 2; ++d0)
#pragma unroll
        for (int g = 0; g < 4; ++g) { u32x2 w; w.x = cvtpk(o[d0][4 * g] * inv, o[d0][4 * g + 1] * inv); w.y = cvtpk(o[d0][4 * g + 2] * inv, o[d0][4 * g + 3] * inv);
            *(u32x2*)(orow + d0 * 32 + 8 * g + 4 * hi) = w; }
}
#ifndef DBG_BRANCH_MASK
#define DBG_BRANCH_MASK 7
#endif
#ifndef DBG_NBR
#define DBG_NBR 3
#endif
#ifndef DBG_NOGATE
#define DBG_NOGATE 0
#endif
#ifndef DBG_NOBRANCH
#define DBG_NOBRANCH 0
#endif
#ifndef DBG_GATE_W
#define DBG_GATE_W WS_WGATE
#endif
#ifndef DBG_GATE_AS_BRANCH
#define DBG_GATE_AS_BRANCH 0
#endif
#ifndef REP_FOX
#define REP_FOX 1
#endif
#ifndef REP_DSA
#define REP_DSA 1
#endif
#ifndef REP_GEMM
#define REP_GEMM 1
#endif
#ifndef DBG_SUBST
#define DBG_SUBST 0
#endif
#ifndef P7SEL
#define P7SEL 3
#endif
#ifndef PHMASK
#define PHMASK 0xFFFF
#endif
struct Args { const void* in[24]; float* out; unsigned char* ws; };
#define CONVERT_GROUP(GRP, w_, nw_) do { \
    constexpr int I_GU = 16 * 176, I_D = 44 * 32, I_IN = 16 * 104, I_GT = 16 * 96, I_BR = 8 * 32, I_SQ = 16 * 32; \
    constexpr int NIT = (GRP) == 0 ? I_GU + I_SQ : (GRP) == 1 ? I_D + I_IN + I_GT + 3 * I_BR + I_SQ : I_GU + I_D; \
    LAS float* scr_ = (LAS float*)(L + RING_OFF + wave * 16384); \
    for (int it = (w_); it < NIT; it += (nw_)) { int r = it; \
        if ((GRP) == 0) { \
            if (r < I_GU) { transpose_item<true>(0, ARG_IN(4), ARG_IN(5), 1024, DFF, ARG_IN(3), WSP(bf16, WS_WGU1), scr_, r, 176, lane); continue; } r -= I_GU; \
            transpose_item<true>(1, ARG_IN(17), nullptr, 1024, 1024, ARG_IN(8), WSP(bf16, WS_WMKV), scr_, r, 32, lane); \
        } else if ((GRP) == 1) { \
            if (r < I_D) { transpose_item<false>(1, ARG_IN(6), nullptr, DFF, 1024, nullptr, WSP(bf16, WS_WD1), scr_, r, 32, lane); continue; } r -= I_D; \
            if (r < I_IN) { transpose_item<true>(2, ARG_IN(9), nullptr, 1024, DIN, ARG_IN(7), WSP(bf16, WS_WIN), scr_, r, 104, lane); continue; } r -= I_IN; \
            if (r < I_GT) { transpose_item<true>(3, ARG_IN(9), nullptr, 1024, DIN, ARG_IN(7), WSP(bf16, WS_WGATE), scr_, r, 96, lane); continue; } r -= I_GT; \
            if (r < 3 * I_BR) { const int i = r / I_BR; transpose_item<false>(1, ARG_IN(18) + (size_t)i * 512 * 1024, nullptr, 512, 1024, nullptr, WSP(bf16, WS_WBR) + (size_t)i * 1024 * 512, scr_, r % I_BR, 32, lane); continue; } r -= 3 * I_BR; \
            transpose_item<false>(1, ARG_IN(19), nullptr, 1024, 1024, nullptr, WSP(bf16, WS_WOUT), scr_, r, 32, lane); \
        } else { \
            if (r < I_GU) { transpose_item<true>(0, ARG_IN(21), ARG_IN(22), 1024, DFF, ARG_IN(20), WSP(bf16, WS_WGU2), scr_, r, 176, lane); continue; } r -= I_GU; \
            transpose_item<false>(1, ARG_IN(23), nullptr, DFF, 1024, nullptr, WSP(bf16, WS_WD2), scr_, r, 32, lane); \
        } } } while (0)
__global__ void __launch_bounds__(NWAVES * 64, 2) fwd_mega(Args args) {
    extern __shared__ __attribute__((aligned(16))) unsigned char lds[];
    LAS unsigned char* L = (LAS unsigned char*)lds;
    volatile LAS unsigned* MISC = (volatile LAS unsigned*)(L + MISC_OFF);
    const int tid = threadIdx.x, lane = tid & 63, wave = __builtin_amdgcn_readfirstlane(tid >> 6);
    const int G = gridDim.x; const int bx = blockIdx.x; const int vcu = (G % 8 == 0) ? (bx % 8) * (G / 8) + bx / 8 : bx;
    const Args* ap = (const Args*)__builtin_amdgcn_kernarg_segment_ptr();
#define ARG_IN(k) ((const float*)ap->in[k])
#define WSP(type, off) ((type*)(ap->ws + (off)))
    gu32* ctl = (gu32*)(ap->ws + WS_CTL);
    for (int u = tid; u < (LDS_BYTES - LDSCTL_OFF) / 4; u += NWAVES * 64) ((LAS unsigned*)(L + LDSCTL_OFF))[u] = 0u;
    __syncthreads();
    XcdBarrier bar = xcd_barrier_post((unsigned*)(ctl + CW_BAR), MISC + 8);
#define GRID_BAR() xcd_barrier(bar)
    const int gw = vcu * NWAVES + wave, NGW = G * NWAVES;

#if (PHMASK >> 0) & 1
    {
        LAS float* scr = (LAS float*)(L + RING_OFF + wave * 16384);
        CONVERT_GROUP(0, gw, NGW);
        for (int m0 = gw; m0 < T + 512; m0 += 4 * NGW) {
            const float* xr[4]; bf16* orw[4]; float* ro[4]; bool ok[4];
#pragma unroll
            for (int r = 0; r < 4; ++r) { const int m = m0 + r * NGW; ok[r] = m < T + 512; const int mc = ok[r] ? m : gw;
                if (mc < T) { xr[r] = ARG_IN(0) + (size_t)mc * 1024; orw[r] = WSP(bf16, WS_HB) + (size_t)mc * 1024; ro[r] = WSP(float, WS_RSTDX) + mc; }
                else { xr[r] = ARG_IN(1) + (size_t)(mc - T) * 1024; orw[r] = WSP(bf16, WS_MEMB) + (size_t)(mc - T) * 1024; ro[r] = WSP(float, WS_RSTDM) + (mc - T); } }
            rows4_to_bf16_rstd(xr, orw, ro, ok, lane);
        }
        VM_WAIT(); __syncthreads();
        GRID_BAR();
    }
#endif
#if (PHMASK >> 1) & 1
    {
        if (bx >= G - 8) { pg8::Gemm g{WSP(bf16, WS_MEMB), WSP(bf16, WS_WMKV), 512, 1024, 1024}; pg8::StaticOrder S; S.init(512, 1024, G, bx - (G - 8));
        pg8::EpiMemKV E{WSP(float, WS_KVM), WSP(float, WS_RSTDM)};
        pg8::gemm_phase<pg8::EpiMemKV, pg8::StaticOrder, true, true>(L + RING_OFF, g, S, E); }
    }
#endif
#if (PHMASK >> 2) & 1
    {
        pg8::Gemm g{WSP(bf16, WS_HB), WSP(bf16, WS_WGU1), T, 2 * DFF, 1024}; pg8::StaticOrder S; S.init(T, 2 * DFF, G, bx);
        pg8::build_row_tab<0>(WSP(float, WS_RSTDX), S, (LAS float*)(L + RING_BYTES + 1024)); pg8::EpiSwiGLU<0> E{WSP(bf16, WS_HID), DFF, (LAS float*)(L + RING_BYTES + 1024)};
#pragma unroll 1
        for (int rep_ = 0; rep_ < REP_GEMM; ++rep_)
        pg8::gemm_phase<pg8::EpiSwiGLU<0>, pg8::StaticOrder, true, true>(L + RING_OFF, g, S, E);
        {
            const int nfull = (64 * 22) % G; const int nidle = (nfull == 0) ? G : G - nfull; const int first = G - nidle;
            if (bx >= first) { CONVERT_GROUP(1, (bx - first) * NWAVES + wave, nidle * NWAVES);
                for (int e = (bx - first) * NWAVES * 64 + tid; e < T * 32; e += nidle * NWAVES * 64) {
                    const int row = e >> 5, i = e & 31; const float inv_freq = powf(10000.0f, -(float)i * (1.0f / 32.0f));
                    const float ang = (float)((const int*)ap->in[2])[row] * inv_freq; float sn, cs; sincosf(ang, &sn, &cs); WSP(float, WS_COS)[e] = cs; WSP(float, WS_SIN)[e] = sn; } }
        }
        GRID_BAR();
    }
#endif
#if (PHMASK >> 3) & 1
    {
        pg8::Gemm g{WSP(bf16, WS_HID), WSP(bf16, WS_WD1), T, 1024, DFF}; pg8::StaticOrder S; S.init(T, 1024, G, bx);
        pg8::EpiResid2<true> E{ARG_IN(0), ap->out, WSP(bf16, WS_HB), WSP(float, WS_SSQ1), 0.5f};
#pragma unroll 1
        for (int rep_ = 0; rep_ < REP_GEMM; ++rep_)
        pg8::gemm_phase<pg8::EpiResid2<true>, pg8::StaticOrder, true, true>(L + RING_OFF, g, S, E);
        GRID_BAR();
    }
#endif
#if (PHMASK >> 4) & 1
    {
        pg8::Gemm g{WSP(bf16, WS_HB), WSP(bf16, WS_WIN), T, NPROJ, 1024}; pg8::StaticOrder S; S.init(T, NPROJ, G, bx);
        pg8::ProjOut PO{WSP(bf16, WS_FQ), WSP(bf16, WS_FK), WSP(bf16, WS_FV), WSP(bf16, WS_DQ), WSP(bf16, WS_IQ), WSP(bf16, WS_MQ), WSP(bf16, WS_DK), WSP(bf16, WS_DV), WSP(bf16, WS_IK), WSP(float, WS_LOGF), WSP(float, WS_IW), WSP(float, WS_COS), WSP(float, WS_SIN), ARG_IN(11), ARG_IN(12), ARG_IN(13), ARG_IN(14), ARG_IN(10)};
        pg8::build_row_tab<16>(WSP(float, WS_SSQ1), S, (LAS float*)(L + RING_BYTES + 1024)); pg8::EpiProj<16> E{PO, (LAS float*)(L + RING_BYTES + 1024), C2_64};
#pragma unroll 1
        for (int rep_ = 0; rep_ < REP_GEMM; ++rep_)
        pg8::gemm_phase<pg8::EpiProj<16>, pg8::StaticOrder, true, true>(L + RING_OFF, g, S, E);
        {
            const int nfull = (64 * 13) % G; const int nidle = (nfull == 0) ? G : G - nfull; const int first = G - nidle;
            if (bx >= first) { CONVERT_GROUP(2, (bx - first) * NWAVES + wave, nidle * NWAVES);
        for (int it = (bx - first) * NWAVES + wave; it < 2048; it += nidle * NWAVES) { const int row = it >> 2, h = it & 3;
                    const f32x2g kv = *(const f32x2g*)(WSP(float, WS_KVM) + (size_t)row * 1024 + h * 128 + 2 * lane); const f32x2g vv = *(const f32x2g*)(WSP(float, WS_KVM) + (size_t)row * 1024 + 512 + h * 128 + 2 * lane);
                    const float ss = wave_sum(kv.x * kv.x + kv.y * kv.y); const float rstd = 1.0f / sqrtf(ss * (1.0f / 128.0f) + 1e-6f);
                    const f32x2g gk = *(const f32x2g*)(ARG_IN(16) + 2 * lane);
                    *(unsigned*)(WSP(bf16, WS_KMB) + (size_t)row * 512 + h * 128 + 2 * lane) = pk2(kv.x * rstd * gk.x, kv.y * rstd * gk.y);
                    { const int bb = row >> 8, key = row & 255; bf16* vt = WSP(bf16, WS_VMB) + ((size_t)(bb * 4 + h) * 128 + 2 * lane) * MEMLEN + key; vt[0] = (bf16)f2bf(vv.x); vt[MEMLEN] = (bf16)f2bf(vv.y); } } }
        }
        GRID_BAR();
#if defined(DBG_DUMP_AFTER) && DBG_DUMP_AFTER == 4
        {
            const bf16* sa = WSP(bf16, DBG_DUMP_A); const bf16* sb = WSP(bf16, DBG_DUMP_B);
            for (size_t e = (size_t)vcu * 512 + tid; e < (size_t)T * 512; e += (size_t)G * 512) { const size_t row = e >> 9, c = e & 511;
                ap->out[row * 1024 + c] = bf2f(sa[row * DBG_PITCH + c]); ap->out[row * 1024 + 512 + c] = bf2f(sb[row * DBG_PITCH + c]); }
            return;
        }
#endif

    }
#endif
#if ((PHMASK >> 5) & 1) && !DBG_SUBST
    {
        for (int it = gw; it < 2048; it += NGW) mem_unit(it >> 2, it & 3, WSP(bf16, WS_MQ), WSP(bf16, WS_KMB), WSP(bf16, WS_VMB), ARG_IN(15), lane);
    }
#endif
#if ((PHMASK >> 6) & 1) && !DBG_SUBST
    {
        for (int rep_ = 0; rep_ < REP_FOX; ++rep_)
        for (int v = vcu; v < 256; v += G) { const int bh = v >> 4, s = v & 15;
            scan_unit(bh, WSP(float, WS_LOGF), WSP(float, WS_CUM), WSP(int, WS_T0), ARG_IN(11), ARG_IN(12), (LAS float*)(L + SCANX_OFF), (LAS float*)(L + RING_OFF), tid);
            asm volatile("s_waitcnt vmcnt(0)" ::: "memory"); __syncthreads();
            fox_unit4(bh, s, WSP(bf16, WS_FQ), WSP(bf16, WS_FK), WSP(bf16, WS_FV), WSP(float, WS_CUM), WSP(int, WS_T0), ARG_IN(11), ARG_IN(12), WSP(bf16, WS_OA), L, wave, lane); fox_unit4(bh, 31 - s, WSP(bf16, WS_FQ), WSP(bf16, WS_FK), WSP(bf16, WS_FV), WSP(float, WS_CUM), WSP(int, WS_T0), ARG_IN(11), ARG_IN(12), WSP(bf16, WS_OA), L, wave, lane); }
        __syncthreads();
        {
            gu32* qctr = ctl + CW_Q; LAS int* QW = (LAS int*)(L + D3_QW);
            const int pref = (vcu >> 5) & 1;
            unsigned raw = 0u; int cur;
            if (tid == 0) { unsigned u = __hip_atomic_fetch_add(qctr + 64 * pref, 1u, RLX_AGENT); int bsel = pref; if (u >= 512u) { bsel = pref ^ 1; u = __hip_atomic_fetch_add(qctr + 64 * bsel, 1u, RLX_AGENT); } QW[0] = (u < 512u) ? ((bsel << 16) | (int)u) : -1; }
            __syncthreads(); cur = QW[0]; __syncthreads();
            while (cur >= 0) {
                if (tid == 0) raw = __hip_atomic_fetch_add(qctr + 64 * pref, 1u, RLX_AGENT);
                dsa3_unit(cur >> 16, 511 - (cur & 0xffff), WSP(bf16, WS_IQ), WSP(bf16, WS_IK), WSP(float, WS_IW), WSP(bf16, WS_DQ), WSP(bf16, WS_DK), WSP(bf16, WS_DV), WSP(bf16, WS_OB), L, wave, lane);
                if (tid == 0) { unsigned u = raw; int bsel = pref; if (u >= 512u) { bsel = pref ^ 1; u = __hip_atomic_fetch_add(qctr + 64 * bsel, 1u, RLX_AGENT); } QW[0] = (u < 512u) ? ((bsel << 16) | (int)u) : -1; }
                __syncthreads(); cur = QW[0]; __syncthreads();
            }
        }
        GRID_BAR();
    }
#endif
#if (PHMASK >> 7) & 1
    {
        pg8::StaticOrder S; S.init(T, 1024, G, bx); pg8::build_row_tab<16>(WSP(float, WS_SSQ1), S, (LAS float*)(L + RING_BYTES + 1024));
#ifndef P7STREAM
#define P7STREAM 1
#endif
#if P7STREAM
        {   typedef pg8::P7Order<WS_HB, WS_WGATE, WS_OA, WS_OB, WS_MQ, WS_WBR> P7O; P7O O{S, (const char*)WSP(char, 0)};
            pg8::EpiP7 E{WSP(bf16, WS_GSCR), WSP(bf16, WS_MERGED), (LAS float*)(L + RING_BYTES + 1024)};
#ifndef REP_P7
#define REP_P7 1
#endif
#pragma unroll 1
            for (int rep7_ = 0; rep7_ < REP_P7; ++rep7_) pg8::gemm_stream<pg8::EpiP7, P7O>(L + RING_OFF, O, E); }
#pragma unroll 1
        for (int i = 0; i < 0; ++i) {
#else
#pragma unroll 1
        for (int rep_ = 0; rep_ < REP_GEMM; ++rep_)
#pragma unroll 1
        for (int i = 0; i < DBG_NBR; ++i) {
#endif
#if DBG_GATE_AS_BRANCH
            {   pg8::Gemm g{WSP(bf16, WS_HB), WSP(bf16, DBG_GATE_W), T, 1024, 1024}; pg8::EpiBranch E{WSP(bf16, WS_GSCR), WSP(bf16, WS_MERGED), true, 1.0f}; pg8::gemm_phase<pg8::EpiBranch, pg8::StaticOrder, true, true>(L + RING_OFF, g, S, E); }
#elif !DBG_NOGATE
            {   pg8::Gemm g{WSP(bf16, WS_HB), WSP(bf16, DBG_GATE_W) + (size_t)i * 1024 * 1024, T, 1024, 1024}; pg8::EpiGate<16> E{WSP(bf16, WS_GSCR), (LAS float*)(L + RING_BYTES + 1024)}; pg8::gemm_phase<pg8::EpiGate<16>, pg8::StaticOrder, true, true>(L + RING_OFF, g, S, E); }
#endif
#if !DBG_NOBRANCH
#if DBG_SUBST == 1
            {   const bf16* A = (i == 0) ? WSP(bf16, WS_FQ) : (i == 1) ? WSP(bf16, WS_DQ) : WSP(bf16, WS_IQ);
#elif DBG_SUBST == 2
            {   const bf16* A = (i == 0) ? WSP(bf16, WS_FK) : (i == 1) ? WSP(bf16, WS_FV) : WSP(bf16, WS_MQ);
#else
            {   const bf16* A = (i == 0) ? WSP(bf16, WS_OA) : (i == 1) ? WSP(bf16, WS_OB) : WSP(bf16, WS_MQ);
#endif
                pg8::Gemm g{A, WSP(bf16, WS_WBR) + (size_t)i * 1024 * 512, T, 1024, 512}; pg8::EpiBranch E{WSP(bf16, WS_GSCR), WSP(bf16, WS_MERGED), i == 0, ((DBG_BRANCH_MASK >> i) & 1) ? 1.0f : 0.0f}; pg8::gemm_phase<pg8::EpiBranch, pg8::StaticOrder, true, true>(L + RING_OFF, g, S, E); }
#endif
        }
        GRID_BAR();
#if defined(DBG_DUMP_AFTER) && DBG_DUMP_AFTER == 7
        {
            const bf16* sa = WSP(bf16, DBG_DUMP_A); const bf16* sb = WSP(bf16, DBG_DUMP_B);
            for (size_t e = (size_t)vcu * 512 + tid; e < (size_t)T * 512; e += (size_t)G * 512) { const size_t row = e >> 9, c = e & 511;
                ap->out[row * 1024 + c] = bf2f(sa[row * DBG_PITCH + c]); ap->out[row * 1024 + 512 + c] = bf2f(sb[row * DBG_PITCH + c]); }
            return;
        }
#endif

    }
#endif
#if (PHMASK >> 8) & 1
    {
        pg8::Gemm g{WSP(bf16, WS_MERGED), WSP(bf16, WS_WOUT), T, 1024, 1024}; pg8::StaticOrder S; S.init(T, 1024, G, bx);
        pg8::EpiResid2<true> E{ap->out, ap->out, WSP(bf16, WS_HB), WSP(float, WS_SSQ2), 1.0f};
        pg8::gemm_phase<pg8::EpiResid2<true>, pg8::StaticOrder, true, true>(L + RING_OFF, g, S, E);
        GRID_BAR();
    }
#endif
#if (PHMASK >> 9) & 1
    {
        pg8::Gemm g{WSP(bf16, WS_HB), WSP(bf16, WS_WGU2), T, 2 * DFF, 1024}; pg8::StaticOrder S; S.init(T, 2 * DFF, G, bx);
        pg8::build_row_tab<16>(WSP(float, WS_SSQ2), S, (LAS float*)(L + RING_BYTES + 1024)); pg8::EpiSwiGLU<16> E{WSP(bf16, WS_HID), DFF, (LAS float*)(L + RING_BYTES + 1024)};
#pragma unroll 1
        for (int rep_ = 0; rep_ < REP_GEMM; ++rep_)
        pg8::gemm_phase<pg8::EpiSwiGLU<16>, pg8::StaticOrder, true, true>(L + RING_OFF, g, S, E);
        GRID_BAR();
    }
#endif
#if (PHMASK >> 10) & 1
    {
        pg8::Gemm g{WSP(bf16, WS_HID), WSP(bf16, WS_WD2), T, 1024, DFF}; pg8::StaticOrder S; S.init(T, 1024, G, bx);
        pg8::EpiResid2<false> E{ap->out, ap->out, nullptr, nullptr, 0.5f};
        pg8::gemm_phase<pg8::EpiResid2<false>, pg8::StaticOrder, true, true>(L + RING_OFF, g, S, E);
    }
#endif
}

extern "C" void kernel_launch(void* const* d_in, const int* in_sizes, int n_in, void* d_out, int out_size, void* d_ws, size_t ws_size, hipStream_t stream) {
    static int grid = 0;
    if (grid == 0) {
        if (n_in != 24 || out_size != T * DM || ws_size < WS_END) { fprintf(stderr, "kernel_launch: unexpected problem (n_in %d, out %d, ws %zu)\n", n_in, out_size, ws_size); grid = -1; return; }
        int dev = 0, cus = 0, per_cu = 0;
        if (hipGetDevice(&dev) != hipSuccess || hipDeviceGetAttribute(&cus, hipDeviceAttributeMultiprocessorCount, dev) != hipSuccess) { grid = -1; return; }
        if (hipFuncSetAttribute((const void*)fwd_mega, hipFuncAttributeMaxDynamicSharedMemorySize, LDS_BYTES) != hipSuccess) { fprintf(stderr, "kernel_launch: hipFuncSetAttribute failed\n"); grid = -1; return; }
        if (hipOccupancyMaxActiveBlocksPerMultiprocessor(&per_cu, (const void*)fwd_mega, NWAVES * 64, LDS_BYTES) != hipSuccess || per_cu < 1) { fprintf(stderr, "kernel_launch: occupancy query says %d blocks per CU\n", per_cu); (void)hipGetLastError(); grid = -1; return; }
        grid = cus;
    }
    if (grid < 0) return;
    (void)hipMemsetAsync((char*)d_ws + WS_CTL, 0, CTL_ZERO_BYTES, stream);
    Args a{};
    for (int i = 0; i < 24; ++i) a.in[i] = d_in[i];
    a.out = (float*)d_out; a.ws = (unsigned char*)d_ws;
    hipLaunchKernelGGL(fwd_mega, dim3(grid), dim3(NWAVES * 64), LDS_BYTES, stream, a);
}
```

```cpp
#include <hip/hip_runtime.h>
#include <cstdio>
#include <cstdint>
namespace pg8 {
#define PG8_LAS __attribute__((address_space(3)))
typedef unsigned short bf16_t;
typedef short bf16x8 __attribute__((ext_vector_type(8)));
typedef float f32x4 __attribute__((ext_vector_type(4)));
typedef unsigned u32x4 __attribute__((ext_vector_type(4)));
constexpr int BM = 256, BK = 64, HALF = 128, HTB = HALF * BK * 2  , STAGE_BYTES = 8 * HTB, NXCD = 8, WGM = 8;

__host__ __device__ __forceinline__ int lds_byte(int r, int c) { const int st = (r >> 4) * 2 + (c >> 5), rr = r & 15, cc = c & 31, ob = rr * 64 + cc * 2; return st * 1024 + (ob ^ (((ob >> 9) & 1) << 5)); }
__host__ __device__ __forceinline__ void stage_rc(int b, int& R, int& C) { const int st = b / 1024, sb = b % 1024, swz = sb ^ (((sb >> 9) & 1) << 5); R = (st >> 1) * 16 + swz / 64; C = (st & 1) * 32 + (swz % 64) / 2; }
__host__ __device__ __forceinline__ int perm32(int rho) { const int n = rho >> 4, i = rho & 15; return 8 * (i >> 2) + 4 * n + (i & 3); }

struct Unit { int pm, pn; };
struct Gemm { const bf16_t* A; const bf16_t* Bt; int M, N, K; };

struct StaticOrder {
    int nM, nN, nwg, G, c;
    __host__ __device__ void init(int M, int N, int G_, int c_) { nM = M / BM; nN = N / BM; nwg = nM * nN; G = G_; c = c_; }
    __host__ __device__ bool next(int i, Unit& u) const {
        const long L = (long)i * G + c; if (L >= nwg) return false;
        int wgid = (int)L; { const int q = nwg / NXCD, r = nwg % NXCD, xcd = wgid % NXCD, off = wgid / NXCD; wgid = (xcd < r ? xcd * (q + 1) : r * (q + 1) + (xcd - r) * q) + off; }
        const int nig = WGM * nN, gid = wgid / nig, fm = gid * WGM, gsz = (nM - fm) < WGM ? (nM - fm) : WGM;
        u.pm = fm + ((wgid % nig) % gsz); u.pn = (wgid % nig) / gsz; return true;
    }
    __device__ __forceinline__ void a_ready(const Unit&) const {}
    __device__ __forceinline__ void done(const Unit&) const {}
};

typedef float f32x2cv __attribute__((ext_vector_type(2))); typedef __bf16 bf16x2cv __attribute__((ext_vector_type(2)));
__device__ __forceinline__ unsigned cvt_pk_bf16(float lo, float hi) { const f32x2cv v = {lo, hi}; const bf16x2cv b = __builtin_convertvector(v, bf16x2cv); return __builtin_bit_cast(unsigned, b); }
typedef float f32x2 __attribute__((ext_vector_type(2)));
template <class Epi, class Sched, bool ALIGN_EPI = false, bool SP2 = false>
__device__ __forceinline__ void gemm_phase(PG8_LAS unsigned char* lds, const Gemm g, const Sched& S, const Epi& E) {
    int tid_ = threadIdx.x; asm volatile("" : "+v"(tid_));
    const int tid = tid_, wid = __builtin_amdgcn_readfirstlane(tid >> 6), lane = tid & 63, wr = wid >> 2, wc = wid & 3, fr = lane & 15, fq = lane >> 4;
    const int K = g.K, nt = K / BK;
    unsigned voffA[2], voffB[2];
#pragma unroll
    for (int i = 0; i < 2; ++i) { int R, C; stage_rc(tid * 16 + i * 8192, R, C); const int Rb = Epi::PERM ? ((R & ~31) + perm32(R & 31)) : R;
        voffA[i] = (unsigned)(R * K + C) * 2u; voffB[i] = (unsigned)(Rb * K + C) * 2u; }
    const size_t kstep = (size_t)(BK * 2);
    const size_t hstep = (size_t)HALF * K * 2;
    const size_t tstep = 2 * hstep;
    const unsigned ldsw = (unsigned)wid * 1024u;
    const int aoff = lds_byte(wr * 64 + fr, fq * 8), boff = lds_byte(wc * 32 + fr, fq * 8);
#define PG8_SA(b, h) (((b) * 2 + (h)) * HTB)
#define PG8_SB(b, h) ((4 + (b) * 2 + (h)) * HTB)
#define PG8_STAGE(bufoff, gbase, voff) do { _Pragma("unroll") for (int _i = 0; _i < 2; ++_i) \
        __builtin_amdgcn_global_load_lds((const unsigned*)((const char*)(gbase) + (voff)[_i]), (PG8_LAS unsigned*)(lds + (bufoff) + ldsw + _i * 8192), 16, 0, 0); } while (0)
#define PG8_LDA(dst, b, h) do { _Pragma("unroll") for (int m = 0; m < 4; ++m) _Pragma("unroll") for (int k = 0; k < 2; ++k) dst[m][k] = *(const PG8_LAS bf16x8*)(lds + PG8_SA(b, h) + aoff + m * 2048 + k * 1024); } while (0)
#define PG8_LDB(dst, b, h) do { _Pragma("unroll") for (int n = 0; n < 2; ++n) _Pragma("unroll") for (int k = 0; k < 2; ++k) dst[n][k] = *(const PG8_LAS bf16x8*)(lds + PG8_SB(b, h) + boff + n * 2048 + k * 1024); } while (0)
#define PG8_MMA(ai, bj, At, Bt) do { __builtin_amdgcn_s_setprio(1); _Pragma("unroll") for (int m = 0; m < 4; ++m) _Pragma("unroll") for (int n = 0; n < 2; ++n) _Pragma("unroll") for (int k = 0; k < 2; ++k) \
        acc[ai][bj][m][n] = __builtin_amdgcn_mfma_f32_16x16x32_bf16(Bt[n][k], At[m][k], acc[ai][bj][m][n], 0, 0, 0); __builtin_amdgcn_s_setprio(0); } while (0)
#define PG8_WAIT_V(n) asm volatile("s_waitcnt vmcnt(" #n ")" ::: "memory")
#define PG8_WAIT_L(n) asm volatile("s_waitcnt lgkmcnt(" #n ")" ::: "memory")
#define PG8_BAR __builtin_amdgcn_s_barrier()
#define PG8_SCHED __builtin_amdgcn_sched_barrier(0)
    Unit cur, nxt; int ui = 0;
    if (!S.next(0, cur)) return;
    f32x4 acc[2][2][4][2];
#pragma unroll
    for (int a = 0; a < 2; ++a)
#pragma unroll
        for (int b = 0; b < 2; ++b)
#pragma unroll
            for (int m = 0; m < 4; ++m)
#pragma unroll
                for (int n = 0; n < 2; ++n) acc[a][b][m][n] = (f32x4){0.f, 0.f, 0.f, 0.f};
    bf16x8 At[4][2], B0[2][2], B1[2][2];
    const char* cA = (const char*)g.A + (size_t)cur.pm * tstep; const char* cB = (const char*)g.Bt + (size_t)cur.pn * tstep;
    S.a_ready(cur);
    if constexpr (SP2) {
        PG8_STAGE(PG8_SB(0, 0), cB, voffB); PG8_STAGE(PG8_SB(0, 1), cB + hstep, voffB); PG8_STAGE(PG8_SA(0, 0), cA, voffA); PG8_STAGE(PG8_SA(0, 1), cA + hstep, voffA);
        if (wr == 1) PG8_BAR;
        PG8_WAIT_V(2); PG8_BAR;
        PG8_STAGE(PG8_SB(1, 0), cB + kstep, voffB); PG8_STAGE(PG8_SA(1, 0), cA + kstep, voffA); PG8_STAGE(PG8_SB(1, 1), cB + hstep + kstep, voffB);
        PG8_WAIT_V(6); PG8_BAR;
    } else {
        PG8_STAGE(PG8_SB(0, 0), cB, voffB); PG8_STAGE(PG8_SA(0, 0), cA, voffA); PG8_STAGE(PG8_SB(0, 1), cB + hstep, voffB); PG8_STAGE(PG8_SA(0, 1), cA + hstep, voffA);
        if (wr == 1) PG8_BAR;
        PG8_WAIT_V(4); PG8_BAR;
        PG8_STAGE(PG8_SB(1, 0), cB + kstep, voffB); PG8_STAGE(PG8_SA(1, 0), cA + kstep, voffA); PG8_STAGE(PG8_SB(1, 1), cB + hstep + kstep, voffB);
        PG8_WAIT_V(6); PG8_BAR;
    }
    for (;;) {
        const bool has_next = S.next(ui + 1, nxt);
        const char* nA = has_next ? (const char*)g.A + (size_t)nxt.pm * tstep : cA; const char* nB = has_next ? (const char*)g.Bt + (size_t)nxt.pn * tstep : cB;
        for (int t = 0; t < nt; t += 2) {
            const bool last = (t == nt - 2);
            const char* a1 = cA + (size_t)(t + 1) * kstep;
            const char* a2 = last ? nA : cA + (size_t)(t + 2) * kstep; const char* b2 = last ? nB : cB + (size_t)(t + 2) * kstep;
            const char* a3 = a2 + kstep; const char* b3 = b2 + kstep;
            if (last && has_next) S.a_ready(nxt);
            if constexpr (SP2) {
            PG8_LDB(B0, 0, 0); PG8_LDB(B1, 0, 1); PG8_SCHED; PG8_LDA(At, 0, 0); PG8_STAGE(PG8_SA(1, 1), a1 + hstep, voffA);
            PG8_WAIT_V(8); PG8_WAIT_L(0); PG8_BAR; PG8_MMA(0, 0, At, B0); PG8_MMA(0, 1, At, B1); PG8_BAR; PG8_SCHED;
            PG8_LDA(At, 0, 1); PG8_STAGE(PG8_SB(0, 0), b2, voffB); PG8_STAGE(PG8_SB(0, 1), b2 + hstep, voffB); PG8_STAGE(PG8_SA(0, 0), a2, voffA);
            PG8_WAIT_V(8); PG8_WAIT_L(0); PG8_BAR; PG8_MMA(1, 0, At, B0); PG8_MMA(1, 1, At, B1); PG8_BAR; PG8_SCHED;
            PG8_LDB(B0, 1, 0); PG8_LDB(B1, 1, 1); PG8_SCHED; PG8_LDA(At, 1, 0); PG8_STAGE(PG8_SA(0, 1), a2 + hstep, voffA);
            PG8_WAIT_V(8); PG8_WAIT_L(0); PG8_BAR; PG8_MMA(0, 0, At, B0); PG8_MMA(0, 1, At, B1); PG8_BAR; PG8_SCHED;
            PG8_LDA(At, 1, 1); PG8_STAGE(PG8_SB(1, 0), b3, voffB); PG8_STAGE(PG8_SB(1, 1), b3 + hstep, voffB); PG8_STAGE(PG8_SA(1, 0), a3, voffA);
            PG8_WAIT_V(8); PG8_WAIT_L(0); PG8_BAR; PG8_MMA(1, 0, At, B0); PG8_MMA(1, 1, At, B1); PG8_BAR; PG8_SCHED;
            } else {
            PG8_LDB(B0, 0, 0); PG8_SCHED; PG8_LDA(At, 0, 0); PG8_STAGE(PG8_SA(1, 1), a1 + hstep, voffA);
            PG8_WAIT_L(8); PG8_BAR; PG8_WAIT_L(0); PG8_MMA(0, 0, At, B0); PG8_BAR; PG8_SCHED;
            PG8_LDB(B1, 0, 1); PG8_STAGE(PG8_SB(0, 0), b2, voffB);
            PG8_BAR; PG8_WAIT_L(0); PG8_MMA(0, 1, At, B1); PG8_BAR;
            PG8_LDA(At, 0, 1); PG8_STAGE(PG8_SA(0, 0), a2, voffA);
            PG8_BAR; PG8_WAIT_L(0); PG8_MMA(1, 0, At, B0); PG8_BAR; PG8_SCHED;
            PG8_STAGE(PG8_SB(0, 1), b2 + hstep, voffB);
            PG8_WAIT_V(6); PG8_BAR; PG8_MMA(1, 1, At, B1); PG8_BAR;
            PG8_LDB(B0, 1, 0); PG8_SCHED; PG8_LDA(At, 1, 0); PG8_STAGE(PG8_SA(0, 1), a2 + hstep, voffA);
            PG8_WAIT_L(8); PG8_BAR; PG8_WAIT_L(0); PG8_MMA(0, 0, At, B0); PG8_BAR; PG8_SCHED;
            PG8_LDB(B1, 1, 1); PG8_STAGE(PG8_SB(1, 0), b3, voffB);
            PG8_BAR; PG8_WAIT_L(0); PG8_MMA(0, 1, At, B1); PG8_BAR;
            PG8_LDA(At, 1, 1); PG8_STAGE(PG8_SA(1, 0), a3, voffA);
            PG8_BAR; PG8_WAIT_L(0); PG8_MMA(1, 0, At, B0); PG8_BAR; PG8_SCHED;
            PG8_STAGE(PG8_SB(1, 1), b3 + hstep, voffB);
            PG8_WAIT_V(6); PG8_BAR; PG8_MMA(1, 1, At, B1); PG8_BAR;
            }
        }
        if constexpr (ALIGN_EPI) { if (wr == 0) PG8_BAR; }
        if constexpr (!Epi::AFTER_DRAIN) { E(acc, cur, wr, wc, fr, fq); S.done(cur); }
        if (!has_next) break;
#pragma unroll
        for (int a = 0; a < 2; ++a)
#pragma unroll
            for (int b = 0; b < 2; ++b)
#pragma unroll
                for (int m = 0; m < 4; ++m)
#pragma unroll
                    for (int n = 0; n < 2; ++n) acc[a][b][m][n] = (f32x4){0.f, 0.f, 0.f, 0.f};
        cur = nxt; cA = nA; cB = nB; ++ui;
        if constexpr (ALIGN_EPI) { if (wr == 1) PG8_BAR; }
    }
    PG8_WAIT_V(0);
    if constexpr (!ALIGN_EPI) { if (wr == 0) PG8_BAR; }
    PG8_BAR;
    if constexpr (Epi::AFTER_DRAIN) { E.fused(acc, cur, wr, wc, fr, fq, lds, wid, lane); S.done(cur); }
#undef PG8_SA
#undef PG8_SB
#undef PG8_STAGE
#undef PG8_LDA
#undef PG8_LDB
#undef PG8_MMA
#undef PG8_WAIT_V
#undef PG8_WAIT_L
#undef PG8_BAR
#undef PG8_SCHED
}

struct UnitX { int pm, pn, kind, round; };
struct OpsX { const char* A; const char* Bt; int K; };
template <class Epi, class Sched>
__device__ __forceinline__ void gemm_stream(PG8_LAS unsigned char* lds, const Sched& S, const Epi& E) {
    int tid_ = threadIdx.x; asm volatile("" : "+v"(tid_));
    const int tid = tid_, wid = __builtin_amdgcn_readfirstlane(tid >> 6), lane = tid & 63, wr = wid >> 2, wc = wid & 3, fr = lane & 15, fq = lane >> 4;
    unsigned rA[2], rB[2], c2[2];
#pragma unroll
    for (int i = 0; i < 2; ++i) { int R, C; stage_rc(tid * 16 + i * 8192, R, C); rA[i] = (unsigned)R; rB[i] = (unsigned)((R & ~31) + perm32(R & 31)); c2[i] = (unsigned)C * 2u; }
    const size_t kstep = (size_t)(BK * 2);
    const unsigned ldsw = (unsigned)wid * 1024u;
    const int aoff = lds_byte(wr * 64 + fr, fq * 8), boff = lds_byte(wc * 32 + fr, fq * 8);
#define PG8_SA(b, h) (((b) * 2 + (h)) * HTB)
#define PG8_SB(b, h) ((4 + (b) * 2 + (h)) * HTB)
#define PGX_STAGE(bufoff, gbase, rr, pb) do { _Pragma("unroll") for (int _i = 0; _i < 2; ++_i) \
        __builtin_amdgcn_global_load_lds((const unsigned*)((const char*)(gbase) + ((rr)[_i] * (pb) + c2[_i])), (PG8_LAS unsigned*)(lds + (bufoff) + ldsw + _i * 8192), 16, 0, 0); } while (0)
#define PG8_LDA(dst, b, h) do { _Pragma("unroll") for (int m = 0; m < 4; ++m) _Pragma("unroll") for (int k = 0; k < 2; ++k) dst[m][k] = *(const PG8_LAS bf16x8*)(lds + PG8_SA(b, h) + aoff + m * 2048 + k * 1024); } while (0)
#define PG8_LDB(dst, b, h) do { _Pragma("unroll") for (int n = 0; n < 2; ++n) _Pragma("unroll") for (int k = 0; k < 2; ++k) dst[n][k] = *(const PG8_LAS bf16x8*)(lds + PG8_SB(b, h) + boff + n * 2048 + k * 1024); } while (0)
#define PG8_MMA(ai, bj, At, Bt) do { __builtin_amdgcn_s_setprio(1); _Pragma("unroll") for (int m = 0; m < 4; ++m) _Pragma("unroll") for (int n = 0; n < 2; ++n) _Pragma("unroll") for (int k = 0; k < 2; ++k) \
        acc[ai][bj][m][n] = __builtin_amdgcn_mfma_f32_16x16x32_bf16(Bt[n][k], At[m][k], acc[ai][bj][m][n], 0, 0, 0); __builtin_amdgcn_s_setprio(0); } while (0)
#define PG8_WAIT_V(n) asm volatile("s_waitcnt vmcnt(" #n ")" ::: "memory")
#define PG8_WAIT_L(n) asm volatile("s_waitcnt lgkmcnt(" #n ")" ::: "memory")
#define PG8_BAR __builtin_amdgcn_s_barrier()
#define PG8_SCHED __builtin_amdgcn_sched_barrier(0)
    UnitX cur, nxt; int ui = 0;
    if (!S.next(0, cur)) return;
    f32x4 acc[2][2][4][2];
#pragma unroll
    for (int a = 0; a < 2; ++a)
#pragma unroll
        for (int b = 0; b < 2; ++b)
#pragma unroll
            for (int m = 0; m < 4; ++m)
#pragma unroll
                for (int n = 0; n < 2; ++n) acc[a][b][m][n] = (f32x4){0.f, 0.f, 0.f, 0.f};
    bf16x8 At[4][2], B0[2][2], B1[2][2];
    OpsX oc = S.ops(cur);
    const char* cA = oc.A; const char* cB = oc.Bt; int Kc = oc.K;
    {   const unsigned pb = (unsigned)Kc * 2u; const size_t hstep = (size_t)HALF * pb;
        PGX_STAGE(PG8_SB(0, 0), cB, rB, pb); PGX_STAGE(PG8_SB(0, 1), cB + hstep, rB, pb); PGX_STAGE(PG8_SA(0, 0), cA, rA, pb); PGX_STAGE(PG8_SA(0, 1), cA + hstep, rA, pb);
        if (wr == 1) PG8_BAR;
        PG8_WAIT_V(2); PG8_BAR;
        PGX_STAGE(PG8_SB(1, 0), cB + kstep, rB, pb); PGX_STAGE(PG8_SA(1, 0), cA + kstep, rA, pb); PGX_STAGE(PG8_SB(1, 1), cB + hstep + kstep, rB, pb);
        PG8_WAIT_V(6); PG8_BAR; }
    for (;;) {
        const bool has_next = S.next(ui + 1, nxt);
        OpsX on = oc; if (has_next) on = S.ops(nxt);
        const char* nA = on.A; const char* nB = on.Bt; const int Kn = on.K;
        const int nt = Kc / BK; const unsigned pbc = (unsigned)Kc * 2u; const size_t hstep = (size_t)HALF * pbc;
        for (int t = 0; t < nt; t += 2) {
            const bool last = (t == nt - 2);
            const char* a1 = cA + (size_t)(t + 1) * kstep;
            const char* a2 = last ? nA : cA + (size_t)(t + 2) * kstep; const char* b2 = last ? nB : cB + (size_t)(t + 2) * kstep;
            const char* a3 = a2 + kstep; const char* b3 = b2 + kstep;
            const unsigned pb2 = last ? (unsigned)Kn * 2u : pbc; const size_t h2 = (size_t)HALF * pb2;
            PG8_LDB(B0, 0, 0); PG8_LDB(B1, 0, 1); PG8_SCHED; PG8_LDA(At, 0, 0); PGX_STAGE(PG8_SA(1, 1), a1 + hstep, rA, pbc);
            PG8_WAIT_V(8); PG8_WAIT_L(0); PG8_BAR; PG8_MMA(0, 0, At, B0); PG8_MMA(0, 1, At, B1); PG8_BAR; PG8_SCHED;
            PG8_LDA(At, 0, 1); PGX_STAGE(PG8_SB(0, 0), b2, rB, pb2); PGX_STAGE(PG8_SB(0, 1), b2 + h2, rB, pb2); PGX_STAGE(PG8_SA(0, 0), a2, rA, pb2);
            PG8_WAIT_V(8); PG8_WAIT_L(0); PG8_BAR; PG8_MMA(1, 0, At, B0); PG8_MMA(1, 1, At, B1); PG8_BAR; PG8_SCHED;
            PG8_LDB(B0, 1, 0); PG8_LDB(B1, 1, 1); PG8_SCHED; PG8_LDA(At, 1, 0); PGX_STAGE(PG8_SA(0, 1), a2 + h2, rA, pb2);
            PG8_WAIT_V(8); PG8_WAIT_L(0); PG8_BAR; PG8_MMA(0, 0, At, B0); PG8_MMA(0, 1, At, B1); PG8_BAR; PG8_SCHED;
            PG8_LDA(At, 1, 1); PGX_STAGE(PG8_SB(1, 0), b3, rB, pb2); PGX_STAGE(PG8_SB(1, 1), b3 + h2, rB, pb2); PGX_STAGE(PG8_SA(1, 0), a3, rA, pb2);
            PG8_WAIT_V(8); PG8_WAIT_L(0); PG8_BAR; PG8_MMA(1, 0, At, B0); PG8_MMA(1, 1, At, B1); PG8_BAR; PG8_SCHED;
        }
        if (wr == 0) PG8_BAR;
        E(acc, cur, wr, wc, fr, fq);
        if (!has_next) break;
#pragma unroll
        for (int a = 0; a < 2; ++a)
#pragma unroll
            for (int b = 0; b < 2; ++b)
#pragma unroll
                for (int m = 0; m < 4; ++m)
#pragma unroll
                    for (int n = 0; n < 2; ++n) acc[a][b][m][n] = (f32x4){0.f, 0.f, 0.f, 0.f};
        cur = nxt; oc = on; cA = nA; cB = nB; Kc = Kn; ++ui;
        if (wr == 1) PG8_BAR;
    }
    PG8_WAIT_V(0);
    PG8_BAR;
#undef PG8_SA
#undef PG8_SB
#undef PGX_STAGE
#undef PG8_LDA
#undef PG8_LDB
#undef PG8_MMA
#undef PG8_WAIT_V
#undef PG8_WAIT_L
#undef PG8_BAR
#undef PG8_SCHED
}
}
namespace pg8 {
constexpr int TOK = 16384;
constexpr float RMS_EPS = 1e-6f;
typedef float f32x2e __attribute__((ext_vector_type(2)));
template <int NP> __device__ __forceinline__ void row_scales(const float* src, int rowbase, int lane, int fr, float (&r)[2][4]) {
#pragma unroll
    for (int ai = 0; ai < 2; ++ai) {
        const int row = rowbase + 128 * ai + lane; float v;
        if (NP == 0) v = src[row];
        else { float s = 0.f;
#pragma unroll
            for (int p = 0; p < NP; ++p) s += src[(size_t)p * TOK + row];
            v = __builtin_amdgcn_rsqf(s * (1.0f / 1024.0f) + RMS_EPS); }
#pragma unroll
        for (int m = 0; m < 4; ++m) r[ai][m] = __shfl(v, 16 * m + fr);
    }
}
template <int NP, class Sched> __device__ __forceinline__ void build_row_tab(const float* src, const Sched& S, PG8_LAS float* tab) {
    Unit u;
    for (int i = 0; S.next(i, u); ++i)
        for (int r = (int)threadIdx.x; r < 256; r += 512) { const int row = u.pm * BM + r; float v;
            if (NP == 0) v = src[row];
            else { float s = 0.f;
#pragma unroll
                for (int p = 0; p < NP; ++p) s += src[(size_t)p * TOK + row];
                v = __builtin_amdgcn_rsqf(s * (1.0f / 1024.0f) + RMS_EPS); }
            tab[i * 256 + r] = v; }
    __syncthreads();
}
__device__ __forceinline__ void row_scales_tab(const PG8_LAS float* tab, int ui, int wr, int fr, float (&r)[2][4]) {
#pragma unroll
    for (int ai = 0; ai < 2; ++ai)
#pragma unroll
        for (int m = 0; m < 4; ++m) r[ai][m] = tab[ui * 256 + ai * 128 + wr * 64 + 16 * m + fr];
}
__device__ __forceinline__ float silu_f(float x) { return x * __builtin_amdgcn_rcpf(1.0f + __expf(-x)); }
__device__ __forceinline__ float sigmoid_f(float x) { return __builtin_amdgcn_rcpf(1.0f + __expf(-x)); }

template <int NP> struct EpiSwiGLU {
    static constexpr bool PERM = true, AFTER_DRAIN = false;
    bf16_t* H; int ldh; const PG8_LAS float* tab; mutable int ui = 0;
    __device__ __forceinline__ void operator()(const f32x4 (&acc)[2][2][4][2], const Unit& u, int wr, int wc, int fr0, int fq0) const {
        int fr = fr0, fq = fq0; asm volatile("" : "+v"(fr), "+v"(fq));
        float r[2][4]; row_scales_tab(tab, ui++, wr, fr, r);
        const int col0 = u.pn * 128 + wc * 32 + 8 * fq;
#pragma unroll
        for (int ai = 0; ai < 2; ++ai)
#pragma unroll
            for (int m = 0; m < 4; ++m) {
                const int row = u.pm * BM + ai * HALF + wr * 64 + m * 16 + fr; const float rr = r[ai][m];
                float o[8]; const float k1 = -1.44269504f * rr, rr2 = rr * rr;
#pragma unroll
                for (int n = 0; n < 2; ++n)
#pragma unroll
                    for (int j = 0; j < 4; j += 2) { const f32x2 g2 = (f32x2){acc[ai][0][m][n][j], acc[ai][0][m][n][j + 1]}, u2 = (f32x2){acc[ai][1][m][n][j], acc[ai][1][m][n][j + 1]};
                        const f32x2 t2 = g2 * k1; const f32x2 d2 = (f32x2){__builtin_amdgcn_exp2f(t2[0]), __builtin_amdgcn_exp2f(t2[1])} + 1.0f;
                        const f32x2 r2 = (f32x2){__builtin_amdgcn_rcpf(d2[0]), __builtin_amdgcn_rcpf(d2[1])} * rr2; const f32x2 o2 = (g2 * u2) * r2;
                        o[4 * n + j] = o2[0]; o[4 * n + j + 1] = o2[1]; }
                u32x4 w; w.x = cvt_pk_bf16(o[0], o[1]); w.y = cvt_pk_bf16(o[2], o[3]); w.z = cvt_pk_bf16(o[4], o[5]); w.w = cvt_pk_bf16(o[6], o[7]);
                *(u32x4*)(H + (size_t)row * ldh + col0) = w;
            }
    }
};
template <bool WRITE_HB> struct EpiResid {
    static constexpr bool PERM = true, AFTER_DRAIN = false;
    const float* base; float* out; bf16_t* hb; float* part; float sc;
    __device__ __forceinline__ void operator()(const f32x4 (&acc)[2][2][4][2], const Unit& u, int wr, int wc, int fr0, int fq0) const {
        int fr = fr0, fq = fq0; asm volatile("" : "+v"(fr), "+v"(fq));
        const int col0 = u.pn * BM + wc * 32 + 8 * fq;
#pragma unroll
        for (int ai = 0; ai < 2; ++ai)
#pragma unroll
            for (int m = 0; m < 4; ++m) {
                const int row = u.pm * BM + ai * HALF + wr * 64 + m * 16 + fr; float ss = 0.f;
#pragma unroll
                for (int bj = 0; bj < 2; ++bj) {
                    const size_t off = (size_t)row * 1024 + col0 + bj * HALF;
                    const f32x4 b0 = *(const f32x4*)(base + off), b1 = *(const f32x4*)(base + off + 4);
                    const f32x4 o0 = b0 + acc[ai][bj][m][0] * sc, o1 = b1 + acc[ai][bj][m][1] * sc;
                    *(f32x4*)(out + off) = o0; *(f32x4*)(out + off + 4) = o1;
                    if (WRITE_HB) {
                        ss += (o0[0] * o0[0] + o0[1] * o0[1]) + (o0[2] * o0[2] + o0[3] * o0[3]) + (o1[0] * o1[0] + o1[1] * o1[1]) + (o1[2] * o1[2] + o1[3] * o1[3]);
                        u32x4 w; w.x = cvt_pk_bf16(o0[0], o0[1]); w.y = cvt_pk_bf16(o0[2], o0[3]); w.z = cvt_pk_bf16(o1[0], o1[1]); w.w = cvt_pk_bf16(o1[2], o1[3]);
                        *(u32x4*)(hb + off) = w; }
                }
                if (WRITE_HB) { ss += __shfl_xor(ss, 16); ss += __shfl_xor(ss, 32); if (fq == 0) part[(size_t)(u.pn * 4 + wc) * TOK + row] = ss; }
                if (m == 3) asm volatile("" ::: "memory");
            }
    }
};
template <bool WRITE_HB> struct EpiResid2 {
    static constexpr bool PERM = true, AFTER_DRAIN = false;
    const float* base; float* out; bf16_t* hb; float* part; float sc;
    __device__ __forceinline__ void operator()(const f32x4 (&acc)[2][2][4][2], const Unit& u, int wr, int wc, int fr0, int fq0) const {
        int fr = fr0, fq = fq0; asm volatile("" : "+v"(fr), "+v"(fq));
        const int row0 = u.pm * BM + wr * 64 + fr; const size_t o00 = (size_t)row0 * 1024 + u.pn * BM + wc * 32 + 8 * fq;
        const float* bp = base + o00; float* op = out + o00; bf16_t* hp = hb + o00;
        f32x4 bq[2][8];
#define ER2_ISSUE(G, B) do { _Pragma("unroll") for (int c = 0; c < 8; ++c) { const int ai = (G) >> 1, m = 2 * ((G) & 1) + (c >> 2), bj = (c >> 1) & 1, n = c & 1; \
            bq[B][c] = *(const f32x4*)(bp + (size_t)(ai * 128 + m * 16) * 1024 + bj * 128 + 4 * n); } } while (0)
        ER2_ISSUE(0, 0);
#pragma unroll
        for (int G = 0; G < 4; ++G) {
            if (G + 1 < 4) { if ((G & 1) == 0) ER2_ISSUE(G + 1, 1); else ER2_ISSUE(G + 1, 0); }
            asm volatile("" ::: "memory");
#pragma unroll
            for (int mm = 0; mm < 2; ++mm) { const int ai = G >> 1, m = 2 * (G & 1) + mm; float ss = 0.f;
#pragma unroll
                for (int bj = 0; bj < 2; ++bj) { const size_t off = (size_t)(ai * 128 + m * 16) * 1024 + bj * 128;
                    const f32x4 o0 = bq[G & 1][mm * 4 + bj * 2] + acc[ai][bj][m][0] * sc, o1 = bq[G & 1][mm * 4 + bj * 2 + 1] + acc[ai][bj][m][1] * sc;
                    *(f32x4*)(op + off) = o0; *(f32x4*)(op + off + 4) = o1;
                    if (WRITE_HB) {
                        ss += (o0[0] * o0[0] + o0[1] * o0[1]) + (o0[2] * o0[2] + o0[3] * o0[3]) + (o1[0] * o1[0] + o1[1] * o1[1]) + (o1[2] * o1[2] + o1[3] * o1[3]);
                        u32x4 w; w.x = cvt_pk_bf16(o0[0], o0[1]); w.y = cvt_pk_bf16(o0[2], o0[3]); w.z = cvt_pk_bf16(o1[0], o1[1]); w.w = cvt_pk_bf16(o1[2], o1[3]);
                        *(u32x4*)(hp + off) = w; } }
                if (WRITE_HB) { ss += __shfl_xor(ss, 16); ss += __shfl_xor(ss, 32); if (fq == 0) part[(size_t)(u.pn * 4 + wc) * TOK + row0 + ai * 128 + m * 16] = ss; } }
            asm volatile("" ::: "memory");
        }
#undef ER2_ISSUE
    }
};
struct EpiMemKV {
    static constexpr bool PERM = true, AFTER_DRAIN = false;
    float* KV; const float* rs;
    __device__ __forceinline__ void operator()(const f32x4 (&acc)[2][2][4][2], const Unit& u, int wr, int wc, int fr0, int fq0) const {
        int fr = fr0, fq = fq0; asm volatile("" : "+v"(fr), "+v"(fq));
        float r[2][4]; row_scales<0>(rs, u.pm * BM + wr * 64, (int)(threadIdx.x & 63), fr, r);
        const int col0 = u.pn * BM + wc * 32 + 8 * fq;
#pragma unroll
        for (int ai = 0; ai < 2; ++ai)
#pragma unroll
            for (int m = 0; m < 4; ++m) { const int row = u.pm * BM + ai * HALF + wr * 64 + m * 16 + fr;
#pragma unroll
                for (int bj = 0; bj < 2; ++bj) { const size_t off = (size_t)row * 1024 + col0 + bj * HALF;
                    *(f32x4*)(KV + off) = acc[ai][bj][m][0] * r[ai][m]; *(f32x4*)(KV + off + 4) = acc[ai][bj][m][1] * r[ai][m]; } }
    }
};
template <int NP> struct EpiGate {
    static constexpr bool PERM = true, AFTER_DRAIN = false;
    bf16_t* scr; const PG8_LAS float* tab; mutable int ui = 0;
    __device__ __forceinline__ void operator()(const f32x4 (&acc)[2][2][4][2], const Unit& u, int wr, int wc, int fr0, int fq0) const {
        int fr = fr0, fq = fq0; asm volatile("" : "+v"(fr), "+v"(fq));
        float r[2][4];
#ifdef DBG_GATE_NOSCALE
        for (int a_ = 0; a_ < 2; ++a_) for (int m_ = 0; m_ < 4; ++m_) r[a_][m_] = 1.0f;
#else
        row_scales_tab(tab, ui++, wr, fr, r);
#endif
        bf16_t* t = scr + (size_t)(u.pm * 4 + u.pn) * 65536;
#pragma unroll
        for (int ai = 0; ai < 2; ++ai)
#pragma unroll
            for (int m = 0; m < 4; ++m) { const int lr = ai * HALF + wr * 64 + m * 16 + fr; const float rr = r[ai][m];
#pragma unroll
                for (int bj = 0; bj < 2; ++bj) { float o[8];
#pragma unroll
                    for (int n = 0; n < 2; ++n)
#pragma unroll
                        for (int j = 0; j < 4; ++j) o[4 * n + j] = sigmoid_f(acc[ai][bj][m][n][j] * rr);
                    u32x4 w; w.x = cvt_pk_bf16(o[0], o[1]); w.y = cvt_pk_bf16(o[2], o[3]); w.z = cvt_pk_bf16(o[4], o[5]); w.w = cvt_pk_bf16(o[6], o[7]);
                    *(u32x4*)(t + lr * 256 + bj * HALF + wc * 32 + 8 * fq) = w; } }
    }
};
__device__ __forceinline__ float bf_lo(unsigned w) { return __uint_as_float(w << 16); }
__device__ __forceinline__ float bf_hi(unsigned w) { return __uint_as_float(w & 0xffff0000u); }
struct EpiBranch {
    static constexpr bool PERM = true, AFTER_DRAIN = false;
    const bf16_t* scr; bf16_t* mg; bool first; float bscale;
    __device__ __forceinline__ void operator()(const f32x4 (&acc)[2][2][4][2], const Unit& u, int wr, int wc, int fr0, int fq0) const {
        int fr = fr0, fq = fq0; asm volatile("" : "+v"(fr), "+v"(fq));
        const bf16_t* t = scr + (size_t)(u.pm * 4 + u.pn) * 65536;
        __builtin_amdgcn_fence(__ATOMIC_ACQUIRE, "agent");
        asm volatile("s_waitcnt vmcnt(0)" ::: "memory");
#pragma unroll
        for (int ai = 0; ai < 2; ++ai)
#pragma unroll
            for (int m = 0; m < 4; ++m) { const int lr = ai * HALF + wr * 64 + m * 16 + fr; const int row = u.pm * BM + lr;
#pragma unroll
                for (int bj = 0; bj < 2; ++bj) { const int lc = bj * HALF + wc * 32 + 8 * fq;
#if defined(DBG_NOGATE) && DBG_NOGATE
                    const u32x4 g = (u32x4){0x3f803f80u, 0x3f803f80u, 0x3f803f80u, 0x3f803f80u};
#else
                    const u32x4 g = *(const u32x4*)(t + lr * 256 + lc);
#endif
                    bf16_t* mp = mg + (size_t)row * 1024 + u.pn * BM + lc;
                    float o[8];
                    o[0] = bf_lo(g.x) * acc[ai][bj][m][0][0]; o[1] = bf_hi(g.x) * acc[ai][bj][m][0][1]; o[2] = bf_lo(g.y) * acc[ai][bj][m][0][2]; o[3] = bf_hi(g.y) * acc[ai][bj][m][0][3];
                    o[4] = bf_lo(g.z) * acc[ai][bj][m][1][0]; o[5] = bf_hi(g.z) * acc[ai][bj][m][1][1]; o[6] = bf_lo(g.w) * acc[ai][bj][m][1][2]; o[7] = bf_hi(g.w) * acc[ai][bj][m][1][3];
#ifdef DBG_BRANCH_SIGMOID
#pragma unroll
                    for (int e = 0; e < 8; ++e) o[e] = DBG_NONLIN(o[e]);
#endif
#pragma unroll
                    for (int e = 0; e < 8; ++e) o[e] *= bscale;
                    if (!first) { const u32x4 p = *(const u32x4*)mp;
                        o[0] += bf_lo(p.x); o[1] += bf_hi(p.x); o[2] += bf_lo(p.y); o[3] += bf_hi(p.y); o[4] += bf_lo(p.z); o[5] += bf_hi(p.z); o[6] += bf_lo(p.w); o[7] += bf_hi(p.w); }
                    u32x4 w; w.x = cvt_pk_bf16(o[0], o[1]); w.y = cvt_pk_bf16(o[2], o[3]); w.z = cvt_pk_bf16(o[4], o[5]); w.w = cvt_pk_bf16(o[6], o[7]);
                    *(u32x4*)mp = w; }
                if (m & 1) asm volatile("" ::: "memory"); }
    }
};
template <bool FIRST> struct EpiBranch2 {
    const bf16_t* scr; bf16_t* mg;
    __device__ __forceinline__ void operator()(const f32x4 (&acc)[2][2][4][2], const Unit& u, int wr, int wc, int fr0, int fq0) const {
        int fr = fr0, fq = fq0; asm volatile("" : "+v"(fr), "+v"(fq));
        const bf16_t* t = scr + (size_t)(u.pm * 4 + u.pn) * 65536 + (wr * 64 + fr) * 256 + wc * 32 + 8 * fq;
        bf16_t* mp0 = mg + (size_t)(u.pm * BM + wr * 64 + fr) * 1024 + u.pn * BM + wc * 32 + 8 * fq;
        u32x4 gq[2][4], pq[2][4];
#define EB2_ISSUE(G, B) do { _Pragma("unroll") for (int c = 0; c < 4; ++c) { const int ai = (G) >> 1, m = 2 * ((G) & 1) + (c >> 1), bj = c & 1; \
            gq[B][c] = *(const u32x4*)(t + (ai * 128 + m * 16) * 256 + bj * 128); if (!FIRST) pq[B][c] = *(const u32x4*)(mp0 + (size_t)(ai * 128 + m * 16) * 1024 + bj * 128); } } while (0)
        EB2_ISSUE(0, 0);
#pragma unroll
        for (int G = 0; G < 4; ++G) {
            if (G + 1 < 4) { if ((G & 1) == 0) EB2_ISSUE(G + 1, 1); else EB2_ISSUE(G + 1, 0); }
            asm volatile("" ::: "memory");
#pragma unroll
            for (int c = 0; c < 4; ++c) { const int ai = G >> 1, m = 2 * (G & 1) + (c >> 1), bj = c & 1; const u32x4 g = gq[G & 1][c];
                float o[8];
                o[0] = bf_lo(g.x) * acc[ai][bj][m][0][0]; o[1] = bf_hi(g.x) * acc[ai][bj][m][0][1]; o[2] = bf_lo(g.y) * acc[ai][bj][m][0][2]; o[3] = bf_hi(g.y) * acc[ai][bj][m][0][3];
                o[4] = bf_lo(g.z) * acc[ai][bj][m][1][0]; o[5] = bf_hi(g.z) * acc[ai][bj][m][1][1]; o[6] = bf_lo(g.w) * acc[ai][bj][m][1][2]; o[7] = bf_hi(g.w) * acc[ai][bj][m][1][3];
                if (!FIRST) { const u32x4 p = pq[G & 1][c];
                    o[0] += bf_lo(p.x); o[1] += bf_hi(p.x); o[2] += bf_lo(p.y); o[3] += bf_hi(p.y); o[4] += bf_lo(p.z); o[5] += bf_hi(p.z); o[6] += bf_lo(p.w); o[7] += bf_hi(p.w); }
                u32x4 w; w.x = cvt_pk_bf16(o[0], o[1]); w.y = cvt_pk_bf16(o[2], o[3]); w.z = cvt_pk_bf16(o[4], o[5]); w.w = cvt_pk_bf16(o[6], o[7]);
                *(u32x4*)(mp0 + (size_t)(ai * 128 + m * 16) * 1024 + bj * 128) = w; }
            asm volatile("" ::: "memory");
        }
#undef EB2_ISSUE
    }
};
template <size_t O_HB, size_t O_WG, size_t O_A0, size_t O_A1, size_t O_A2, size_t O_WB> struct P7Order {
    StaticOrder T; const char* ws;
    __device__ __forceinline__ bool next(int i, UnitX& u) const { const int rd = i / 6; Unit t; if (!T.next(rd, t)) return false; u.pm = t.pm; u.pn = t.pn; u.kind = i - 6 * rd; u.round = rd; return true; }
    __device__ __forceinline__ OpsX ops(const UnitX& u) const { const int j = u.kind >> 1; OpsX o;
        if (u.kind & 1) { o.K = 512; o.A = ws + (j == 0 ? O_A0 : j == 1 ? O_A1 : O_A2) + (size_t)u.pm * (256 * 512 * 2); o.Bt = ws + O_WB + (size_t)j * (1024 * 512 * 2) + (size_t)u.pn * (256 * 512 * 2); }
        else { o.K = 1024; o.A = ws + O_HB + (size_t)u.pm * (256 * 1024 * 2); o.Bt = ws + O_WG + (size_t)j * (1024 * 1024 * 2) + (size_t)u.pn * (256 * 1024 * 2); }
        return o; }
};
struct EpiP7 {
    bf16_t* scr; bf16_t* mg; const PG8_LAS float* tab;
    __device__ __forceinline__ void operator()(const f32x4 (&acc)[2][2][4][2], const UnitX& u, int wr, int wc, int fr, int fq) const {
        const Unit uu{u.pm, u.pn};
        if (u.kind == 1) { const EpiBranch2<true> b{scr, mg}; b(acc, uu, wr, wc, fr, fq); }
        else if (u.kind & 1) { const EpiBranch2<false> b{scr, mg}; b(acc, uu, wr, wc, fr, fq); }
        else { const EpiGate<16> g{scr, tab, u.round}; g(acc, uu, wr, wc, fr, fq); }
    }
};
struct ProjOut { bf16_t *FQ, *FK, *FV, *DQ, *IQ, *MQ, *DK, *DV, *IK; float *LOGF, *IW; const float *cosT, *sinT, *g_fq, *g_fk, *g_dq, *g_dk, *b_forget; };
__device__ __forceinline__ float log_sigmoid_f(float z) { return z >= 0.f ? -log1pf(expf(-z)) : z - log1pf(expf(z)); }
template <int NP> struct EpiProj {
    static constexpr bool PERM = true, AFTER_DRAIN = false;
    ProjOut P; const PG8_LAS float* tab; float qscale; mutable int ui = 0;
    __device__ __forceinline__ void operator()(const f32x4 (&acc)[2][2][4][2], const Unit& u, int wr, int wc, int fr0, int fq0) const {
        int fr = fr0, fq = fq0; asm volatile("" : "+v"(fr), "+v"(fq));
        float r[2][4]; row_scales_tab(tab, ui++, wr, fr, r);
        const int pn = u.pn;
        bool do_norm = false, do_rope = false; const float* gain = nullptr; bf16_t* dst = nullptr; int pitch = 512, hoff = 0; float osc = 1.f;
        if (pn < 2)       { do_norm = true; gain = P.g_fq; dst = P.FQ; hoff = (4 * pn + wc) * 64; osc = qscale; }
        else if (pn < 4)  { do_norm = true; gain = P.g_fk; dst = P.FK; hoff = (4 * (pn - 2) + wc) * 64; }
        else if (pn < 6)  { dst = P.FV; hoff = (4 * (pn - 4) + wc) * 64; }
        else if (pn < 8)  { do_norm = true; do_rope = true; gain = P.g_dq; dst = P.DQ; hoff = (4 * (pn - 6) + wc) * 64; osc = qscale; }
        else if (pn < 10) { do_rope = true; dst = P.IQ; hoff = (4 * (pn - 8) + wc) * 64; }
        else if (pn < 12) { dst = P.MQ; hoff = (2 * (pn - 10) + (wc >> 1)) * 128 + (wc & 1) * 64; }
        else { pitch = 64;
            if (wc == 0)      { do_norm = true; do_rope = true; gain = P.g_dk; dst = P.DK; }
            else if (wc == 1) { dst = P.DV; }
            else if (wc == 2) { do_rope = true; dst = P.IK; }
            else dst = nullptr; }
        if (dst == nullptr) {
            if (fq < 2) {
#pragma unroll
                for (int ai = 0; ai < 2; ++ai)
#pragma unroll
                    for (int m = 0; m < 4; ++m) { const int row = u.pm * BM + ai * HALF + wr * 64 + m * 16 + fr; const float rr = r[ai][m];
                        f32x4 v0 = acc[ai][0][m][0] * rr, v1 = acc[ai][0][m][1] * rr;
                        if (fq == 0) {
                            const f32x4 b0 = *(const f32x4*)(P.b_forget), b1 = *(const f32x4*)(P.b_forget + 4);
#pragma unroll
                            for (int j = 0; j < 4; ++j) { v0[j] = log_sigmoid_f(v0[j] + b0[j]); v1[j] = log_sigmoid_f(v1[j] + b1[j]); }
                            *(f32x4*)(P.LOGF + (size_t)row * 8) = v0; *(f32x4*)(P.LOGF + (size_t)row * 8 + 4) = v1;
                        } else { const float c = 0.04419417382f; *(f32x4*)(P.IW + (size_t)row * 8) = v0 * c; *(f32x4*)(P.IW + (size_t)row * 8 + 4) = v1 * c; } }
            }
            return;
        }
        const bool ikl = (pn == 12 && wc == 2);
        if (do_norm) { if (do_rope) body<true, true, false>(acc, u, r, gain, dst, pitch, hoff, osc, wr, fr, fq); else body<true, false, false>(acc, u, r, gain, dst, pitch, hoff, osc, wr, fr, fq); }
        else if (do_rope) { if (ikl) body<false, true, true>(acc, u, r, gain, dst, pitch, hoff, osc, wr, fr, fq); else body<false, true, false>(acc, u, r, gain, dst, pitch, hoff, osc, wr, fr, fq); }
        else body<false, false, false>(acc, u, r, gain, dst, pitch, hoff, osc, wr, fr, fq);
    }
    template <bool NORM, bool ROPE, bool IKL>
    __device__ __forceinline__ void body(const f32x4 (&acc)[2][2][4][2], const Unit& u, const float (&r)[2][4], const float* gain, bf16_t* dst, int pitch, int hoff, float osc, int wr, int fr, int fq) const {
        f32x4 gv[2][2];
        if (NORM) {
#pragma unroll
            for (int bj = 0; bj < 2; ++bj)
#pragma unroll
                for (int n = 0; n < 2; ++n) gv[bj][n] = *(const f32x4*)(gain + bj * 32 + 8 * fq + 4 * n);
        }
        f32x4 cq[2][4];
        const int rowb = u.pm * BM + wr * 64 + fr;
#define EP_ISSUE(I, B) do { const size_t ro_ = (size_t)(rowb + ((I) >> 2) * HALF + ((I) & 3) * 16) * 32 + 8 * fq; \
            cq[B][0] = *(const f32x4*)(P.cosT + ro_); cq[B][1] = *(const f32x4*)(P.cosT + ro_ + 4); cq[B][2] = *(const f32x4*)(P.sinT + ro_); cq[B][3] = *(const f32x4*)(P.sinT + ro_ + 4); } while (0)
        if (ROPE) EP_ISSUE(0, 0);
#pragma unroll
        for (int ai = 0; ai < 2; ++ai)
#pragma unroll
            for (int m = 0; m < 4; ++m) {
                const int row = u.pm * BM + ai * HALF + wr * 64 + m * 16 + fr; const float rr = r[ai][m];
                if (ROPE) { if (4 * ai + m + 1 < 8) { if (((4 * ai + m) & 1) == 0) EP_ISSUE(4 * ai + m + 1, 1); else EP_ISSUE(4 * ai + m + 1, 0); } asm volatile("" ::: "memory"); }
                f32x4 v[2][2];
#pragma unroll
                for (int bj = 0; bj < 2; ++bj)
#pragma unroll
                    for (int n = 0; n < 2; ++n) v[bj][n] = acc[ai][bj][m][n] * rr;
                if (NORM) {
                    float ss = 0.f;
#pragma unroll
                    for (int bj = 0; bj < 2; ++bj)
#pragma unroll
                        for (int n = 0; n < 2; ++n) ss += (v[bj][n][0] * v[bj][n][0] + v[bj][n][1] * v[bj][n][1]) + (v[bj][n][2] * v[bj][n][2] + v[bj][n][3] * v[bj][n][3]);
                    ss += __shfl_xor(ss, 16); ss += __shfl_xor(ss, 32);
                    const float inv = __builtin_amdgcn_rsqf(ss * (1.0f / 64.0f) + RMS_EPS);
#pragma unroll
                    for (int bj = 0; bj < 2; ++bj)
#pragma unroll
                        for (int n = 0; n < 2; ++n) v[bj][n] = v[bj][n] * inv * gv[bj][n];
                }
                if (ROPE) {
#pragma unroll
                    for (int n = 0; n < 2; ++n) {
                        const f32x4 c = cq[(4 * ai + m) & 1][n], s = cq[(4 * ai + m) & 1][2 + n];
                        const f32x4 x1 = v[0][n], x2 = v[1][n];
                        v[0][n] = x1 * c - x2 * s; v[1][n] = x2 * c + x1 * s; }
                }
#pragma unroll
                for (int bj = 0; bj < 2; ++bj) {
                    const f32x4 a = v[bj][0] * osc, b = v[bj][1] * osc;
                    u32x4 w; w.x = cvt_pk_bf16(a[0], a[1]); w.y = cvt_pk_bf16(a[2], a[3]); w.z = cvt_pk_bf16(b[0], b[1]); w.w = cvt_pk_bf16(b[2], b[3]);
                    if (IKL) {
                        const int d = bj * 32 + 8 * fq; *(u32x4*)(dst + (size_t)(row >> 5) * 2048 + (d >> 4) * 512 + ((d >> 3) & 1) * 256 + (row & 31) * 8) = w;
                    } else *(u32x4*)(dst + (size_t)row * pitch + hoff + bj * 32 + 8 * fq) = w; }
                if (ROPE) asm volatile("" ::: "memory");
            }
#undef EP_ISSUE
    }
};
}
#define GAS __attribute__((address_space(1)))
#define LAS __attribute__((address_space(3)))
typedef unsigned short bf16;
typedef unsigned v4u __attribute__((ext_vector_type(4)));
typedef float f32x4 __attribute__((ext_vector_type(4)));
typedef short bf16x8 __attribute__((ext_vector_type(8)));
typedef GAS unsigned gu32;
typedef GAS unsigned long long gu64;
#define RLX_AGENT __ATOMIC_RELAXED, __HIP_MEMORY_SCOPE_AGENT
#define LDS_WAIT() asm volatile("s_waitcnt lgkmcnt(0)" ::: "memory")
#define VM_WAIT() asm volatile("s_waitcnt vmcnt(0)" ::: "memory")
__device__ __forceinline__ unsigned long long rt() { return __builtin_amdgcn_s_memrealtime(); }
__device__ __forceinline__ unsigned f2bf(float f) { unsigned u = __builtin_bit_cast(unsigned, f); return (u + 0x7fffu + ((u >> 16) & 1u)) >> 16; }
__device__ __forceinline__ unsigned pk2(float lo, float hi) { return f2bf(lo) | (f2bf(hi) << 16); }
typedef float f32x2g __attribute__((ext_vector_type(2)));
__device__ __forceinline__ float bf_lo32(unsigned w) { return __uint_as_float(w << 16); }
__device__ __forceinline__ float bf_hi32(unsigned w) { return __uint_as_float(w & 0xffff0000u); }
constexpr int NWAVES = 8;
constexpr int BATCH = 2, SEQ = 8192, DM = 1024, T = BATCH * SEQ, DFF = 2816, MEMLEN = 256, BW = 512, DIN = 6352;
constexpr int NPROJ = 13 * 256, NGATE = 3072;
constexpr float L2E = 1.4426950408889634f;
constexpr float C2_64 = 0.125f * L2E;
constexpr float C2_128 = 0.08838834764831845f * L2E;
constexpr size_t MiB = 1u << 20;
constexpr size_t WS_CTL = 0, CTL_ZERO_BYTES = 128 * 1024;
constexpr size_t WS_RSTDX = 1 * MiB;
constexpr size_t WS_RSTDM = WS_RSTDX + 64 * 1024;
constexpr size_t WS_T0 = WS_RSTDM + 4096;
constexpr size_t WS_SSQ1 = 2 * MiB;
constexpr size_t WS_SSQ2 = 3 * MiB;
constexpr size_t WS_LOGF = 4 * MiB;
constexpr size_t WS_CUM = WS_LOGF + 512 * 1024;
constexpr size_t WS_IW = 5 * MiB;
constexpr size_t WS_COS = 6 * MiB, WS_SIN = 8 * MiB;
constexpr size_t WS_MEMB = 10 * MiB;
constexpr size_t WS_KVM = 11 * MiB;
constexpr size_t WS_KMB = 13 * MiB, WS_VMB = 14 * MiB;
constexpr size_t WS_WGU1 = 16 * MiB;
constexpr size_t WS_WD1 = 27 * MiB;
constexpr size_t WS_WIN = 33 * MiB;
constexpr size_t WS_WGATE = 40 * MiB;
constexpr size_t WS_WBR = 46 * MiB;
constexpr size_t WS_WOUT = 49 * MiB;
constexpr size_t WS_WGU2 = 51 * MiB;
constexpr size_t WS_WD2 = 62 * MiB;
constexpr size_t WS_WMKV = 68 * MiB;
constexpr size_t WS_HB = 70 * MiB;
constexpr size_t WS_ACT = 102 * MiB;
constexpr size_t WS_HID = WS_ACT;
constexpr size_t WS_FQ = WS_ACT, WS_FK = WS_ACT + 16 * MiB, WS_FV = WS_ACT + 32 * MiB, WS_DQ = WS_ACT + 48 * MiB, WS_IQ = WS_ACT + 64 * MiB, WS_MQ = WS_ACT + 80 * MiB;
constexpr size_t WS_DK = WS_ACT + 96 * MiB, WS_DV = WS_ACT + 98 * MiB, WS_IK = WS_ACT + 100 * MiB;
#if defined(DBG_SUBST) && DBG_SUBST == 2
constexpr size_t WS_MERGED = WS_DQ;
#else
constexpr size_t WS_MERGED = WS_FK;
#endif
#ifdef DBG_GSCR_AT
constexpr size_t WS_GSCR = DBG_GSCR_AT;
#else
constexpr size_t WS_GSCR = 204 * MiB;
#endif
constexpr size_t WS_OA = 236 * MiB;
constexpr size_t WS_OB = 16 * MiB;
constexpr size_t WS_END = 252 * MiB;
#ifndef DBG_GSCR_AT
static_assert(WS_HID + (size_t)T * DFF * 2 <= WS_GSCR && WS_IK + (size_t)T * 64 * 2 <= WS_GSCR, "d_ws map");
#endif
constexpr int CW_BAR = 4096;
constexpr int CW_Q = 16384;
constexpr int RING_OFF = 0, RING_BYTES = 131072;
constexpr int LDSCTL_OFF = RING_BYTES, MISC_OFF = LDSCTL_OFF + 320;
constexpr int LIST_OFF = RING_BYTES + 1024;
constexpr int SCANX_OFF = RING_BYTES + 6144;
constexpr int LDS_BYTES = 163840;
#define XB_TMO      128
#define XB_XCNT(j)  (256  + 64 * (j))
#define XB_XSUB(j)  (1280 + 64 * (j))
#define XB_XGEN(j)  (2304 + 64 * (j))
#define XB_TOP      3328
#define XB_TOPGEN   3392
#define XCD_BAR_WORDS 3456
#define XB_SPIN_CAP (1u << 18)

__device__ __forceinline__ unsigned xb_ld(unsigned* p)              { return __hip_atomic_load(p, __ATOMIC_RELAXED, __HIP_MEMORY_SCOPE_AGENT); }
__device__ __forceinline__ unsigned xb_add(unsigned* p, unsigned v) { return __hip_atomic_fetch_add(p, v, __ATOMIC_RELAXED, __HIP_MEMORY_SCOPE_AGENT); }
__device__ __forceinline__ unsigned xb_xcc_id() { return (unsigned)__builtin_amdgcn_s_getreg((3 << 11) | 20) & 0xFu; }
#define XB_SPIN(cond, bar) do { unsigned _sp = 0; while (cond) { __builtin_amdgcn_s_sleep(1); \
    if ((++_sp & 255u) == 0u) { if (xb_ld(&(bar)[XB_TMO])) break; if (_sp > XB_SPIN_CAP) { atomicAdd(&(bar)[XB_TMO], 1u); break; } } } } while (0)

struct XcdBarrier {
    unsigned* bar; unsigned x;
    volatile LAS unsigned* st;
};

__device__ __forceinline__ XcdBarrier xcd_barrier_post(unsigned* bar, volatile LAS unsigned* st) {
    XcdBarrier b; b.bar = bar; b.x = xb_xcc_id(); b.st = st;
    if (threadIdx.x == 0) (void)xb_add(&bar[XB_XCNT(b.x)], 1u);
    return b;
}
__device__ __forceinline__ void xcd_barrier_complete(unsigned* bar, unsigned x, unsigned& nloc, unsigned& nx) {
    const unsigned G = gridDim.x * gridDim.y * gridDim.z;
    unsigned sum, cnt, mine, sp = 0u;
    for (;;) {
        sum = 0u; cnt = 0u; mine = 0u;
#pragma unroll
        for (unsigned j = 0; j < 16; ++j) { const unsigned c = xb_ld(&bar[XB_XCNT(j)]); sum += c; cnt += (c > 0u) ? 1u : 0u; mine = (j == x) ? c : mine; }
        if (sum == G) break;
        __builtin_amdgcn_s_sleep(1);
        if ((++sp & 255u) == 0u) { if (xb_ld(&bar[XB_TMO])) break; if (sp > XB_SPIN_CAP) { atomicAdd(&bar[XB_TMO], 1u); break; } }
    }
    nloc = mine > 0u ? mine : 1u; nx = cnt > 0u ? cnt : 1u;
}

__device__ __forceinline__ void xcd_barrier(const XcdBarrier& b) {
    asm volatile("s_waitcnt vmcnt(0)" ::: "memory");
    __syncthreads();
    if (threadIdx.x == 0) {
        unsigned* bar = b.bar;
        __builtin_amdgcn_s_waitcnt(0);
        unsigned nloc = b.st[0], nx = b.st[1];
        if (nloc == 0u) { xcd_barrier_complete(bar, b.x, nloc, nx); b.st[0] = nloc; b.st[1] = nx; }
        const unsigned old = xb_add(&bar[XB_XSUB(b.x)], 1u);
        const unsigned gen = old / nloc;
        if (old + 1u == (gen + 1u) * nloc) {
            __builtin_amdgcn_fence(__ATOMIC_RELEASE, "agent");
            asm volatile("s_waitcnt vmcnt(0)" ::: "memory");
            const unsigned og = xb_add(&bar[XB_TOP], 1u);
            const unsigned tg = og / nx;
            if (og + 1u == (tg + 1u) * nx) xb_add(&bar[XB_TOPGEN], 1u);
            else XB_SPIN(xb_ld(&bar[XB_TOPGEN]) == tg, bar);
            __builtin_amdgcn_fence(__ATOMIC_ACQUIRE, "agent");
            xb_add(&bar[XB_XGEN(b.x)], 1u);
            asm volatile("s_waitcnt vmcnt(0)" ::: "memory");
        } else {
            XB_SPIN(xb_ld(&bar[XB_XGEN(b.x)]) == gen, bar);
            __builtin_amdgcn_fence(__ATOMIC_ACQUIRE, "agent");
            asm volatile("s_waitcnt vmcnt(0)" ::: "memory");
        }
    }
    __syncthreads();
}
__device__ __forceinline__ float wave_sum(float v) {
#pragma unroll
    for (int o = 1; o < 64; o <<= 1) v += __shfl_xor(v, o);
    return v;
}
__device__ __forceinline__ float wave_max(float v) {
#pragma unroll
    for (int o = 1; o < 64; o <<= 1) v = fmaxf(v, __shfl_xor(v, o));
    return v;
}
__device__ __forceinline__ int colmap(int mat, int n) {
    if (mat == 1) return n;
    if (mat == 3) return 3280 + n;
    const int tile = n >> 8, t = n & 255;
    if (mat == 0) return (t < 128 ? 0 : DFF) + 128 * tile + (t & 127);
    const int bj = t >> 7, wc = (t >> 5) & 3, i = t & 31, d = bj * 32 + i;
    if (tile < 2) return 0 + (4 * tile + wc) * 64 + d;
    if (tile < 4) return 512 + (4 * (tile - 2) + wc) * 64 + d;
    if (tile < 6) return 1024 + (4 * (tile - 4) + wc) * 64 + d;
    if (tile < 8) return 1544 + (4 * (tile - 6) + wc) * 64 + d;
    if (tile < 10) return 2184 + (4 * (tile - 8) + wc) * 64 + d;
    if (tile < 12) return 2768 + (2 * (tile - 10) + (wc >> 1)) * 128 + (wc & 1) * 64 + d;
    if (wc == 0) return 2056 + d;
    if (wc == 1) return 2120 + d;
    if (wc == 2) return 2696 + d;
    if (bj == 0 && i < 8) return 1536 + i;
    if (bj == 0 && i < 16) return 2760 + (i - 8);
    return -1;
}
template <bool GAIN> __device__ __forceinline__ void transpose_item(int mat, const float* Wa, const float* Wb, int K, int Nsrc, const float* gain, bf16* WT, LAS float* scr, int item, int nblk, int lane) {
    const int kb = item / nblk, nb = item % nblk, k0 = 64 * kb, n0 = 32 * nb;
    int col = colmap(mat, n0 + (lane & 31)); const float* W = Wa;
    if (mat == 0 && col >= DFF) { W = Wb; col -= DFF; }
    const bool okc = col >= 0; const float* wp = W + (size_t)(k0 + (lane >> 5)) * Nsrc + (okc ? col : 0); const float* gp = gain + k0 + (lane >> 5);
    float v[32];
#pragma unroll
    for (int i = 0; i < 32; ++i) v[i] = wp[(size_t)(2 * i) * Nsrc];
    if (GAIN) {
#pragma unroll
        for (int i = 0; i < 32; ++i) v[i] *= gp[2 * i]; }
#pragma unroll
    for (int i = 0; i < 32; ++i) scr[(2 * i + (lane >> 5)) * 33 + (lane & 31)] = okc ? v[i] : 0.f;
    LDS_WAIT(); asm volatile("" ::: "memory");
    const int c = lane & 7;
#pragma unroll
    for (int j = 0; j < 4; ++j) { const int n = (lane >> 3) + 8 * j; const LAS float* s = scr + (8 * c) * 33 + n;
        v4u o; o.x = pk2(s[0 * 33], s[1 * 33]); o.y = pk2(s[2 * 33], s[3 * 33]); o.z = pk2(s[4 * 33], s[5 * 33]); o.w = pk2(s[6 * 33], s[7 * 33]);
        *(GAS v4u*)(WT + (size_t)(n0 + n) * K + k0 + 8 * c) = o; }
    LDS_WAIT(); asm volatile("" ::: "memory");
}
__device__ __forceinline__ void row_to_bf16_rstd(const float* xrow, bf16* orow, float* rstd_out, int lane) {
    const GAS f32x4* xr = (const GAS f32x4*)xrow + lane;
    f32x4 v[4]; float s = 0.f;
#pragma unroll
    for (int j = 0; j < 4; ++j) { v[j] = xr[64 * j]; s += (v[j].x * v[j].x + v[j].y * v[j].y) + (v[j].z * v[j].z + v[j].w * v[j].w); }
    const float rstd = 1.0f / sqrtf(wave_sum(s) * (1.f / 1024.f) + 1e-6f);
    GAS unsigned long long* o8 = (GAS unsigned long long*)orow + lane;
#pragma unroll
    for (int j = 0; j < 4; ++j) o8[64 * j] = (unsigned long long)pk2(v[j].x, v[j].y) | ((unsigned long long)pk2(v[j].z, v[j].w) << 32);
    if (lane == 0) *rstd_out = rstd;
}
__device__ __forceinline__ void rows4_to_bf16_rstd(const float* const (&xrow)[4], bf16* const (&orow)[4], float* const (&rout)[4], const bool (&ok)[4], int lane) {
    f32x4 v[4][4];
#pragma unroll
    for (int r = 0; r < 4; ++r) { const GAS f32x4* xr = (const GAS f32x4*)xrow[r] + lane;
#pragma unroll
        for (int j = 0; j < 4; ++j) v[r][j] = xr[64 * j]; }
#pragma unroll
    for (int r = 0; r < 4; ++r) { float s = 0.f;
#pragma unroll
        for (int j = 0; j < 4; ++j) s += (v[r][j].x * v[r][j].x + v[r][j].y * v[r][j].y) + (v[r][j].z * v[r][j].z + v[r][j].w * v[r][j].w);
        const float rstd = 1.0f / sqrtf(wave_sum(s) * (1.f / 1024.f) + 1e-6f);
        if (ok[r]) { GAS unsigned long long* o8 = (GAS unsigned long long*)orow[r] + lane;
#pragma unroll
            for (int j = 0; j < 4; ++j) o8[64 * j] = (unsigned long long)pk2(v[r][j].x, v[r][j].y) | ((unsigned long long)pk2(v[r][j].z, v[r][j].w) << 32);
            if (lane == 0) *rout[r] = rstd; } }
}
typedef float f32x16 __attribute__((ext_vector_type(16)));
typedef unsigned u32x2 __attribute__((ext_vector_type(2)));
__device__ __forceinline__ int crow(int r, int hi) { return (r & 3) + 8 * (r >> 2) + 4 * hi; }
__device__ __forceinline__ float bf2f(bf16 v) { return __uint_as_float((unsigned)v << 16); }
__device__ __forceinline__ unsigned cvtpk(float lo, float hi) { return pg8::cvt_pk_bf16(lo, hi); }
template <int HD, bool FOX, bool VT>
__device__ __forceinline__ void attn_wave_simple(const bf16x8 (&qr)[HD / 16], const bf16* Kp, int kpitch, const bf16* Vp, int vpitch, int tstart, int ntiles, int qlocal, const float* cb, bf16* Op, int opitch, int lane) {
    const int r32 = lane & 31, hi = lane >> 5;
    f32x16 o[HD / 32];
#pragma unroll
    for (int d0 = 0; d0 < HD / 32; ++d0)
#pragma unroll
        for (int r = 0; r < 16; ++r) o[d0][r] = 0.f;
    float m = -1e30f, l = 0.f;
    for (int t = tstart; t < ntiles; ++t) {
        const int kv0 = 32 * t;
        f32x16 p;
#pragma unroll
        for (int r = 0; r < 16; ++r) p[r] = 0.f;
        const bf16* kr = Kp + (size_t)(kv0 + r32) * kpitch + hi * 8;
#pragma unroll
        for (int ks = 0; ks < HD / 16; ++ks) { const bf16x8 kf = *(const bf16x8*)(kr + ks * 16); p = __builtin_amdgcn_mfma_f32_32x32x16_bf16(kf, qr[ks], p, 0, 0, 0); }
        if (FOX) {
#pragma unroll
            for (int g = 0; g < 4; ++g) { const f32x4 c4 = *(const f32x4*)(cb + kv0 + 8 * g + 4 * hi);
#pragma unroll
                for (int jj = 0; jj < 4; ++jj) p[4 * g + jj] -= L2E * c4[jj]; }
            if (t == ntiles - 1) {
#pragma unroll
                for (int r = 0; r < 16; ++r) if (kv0 + crow(r, hi) > qlocal) p[r] = -INFINITY;
            }
        }
        float mt = p[0];
#pragma unroll
        for (int r = 1; r < 16; ++r) mt = fmaxf(mt, p[r]);
        mt = fmaxf(mt, __shfl_xor(mt, 32));
        const float mn = fmaxf(m, mt); const float alpha = __builtin_amdgcn_exp2f(m - mn); m = mn;
        l *= alpha;
#pragma unroll
        for (int d0 = 0; d0 < HD / 32; ++d0)
#pragma unroll
            for (int r = 0; r < 16; ++r) o[d0][r] *= alpha;
        float ls = 0.f;
#pragma unroll
        for (int r = 0; r < 16; ++r) { p[r] = __builtin_amdgcn_exp2f(p[r] - mn); ls += p[r]; }
        l += ls;
        bf16x8 pa[2];
#pragma unroll
        for (int s = 0; s < 2; ++s) { v4u w; w.x = cvtpk(p[8 * s + 0], p[8 * s + 1]); w.y = cvtpk(p[8 * s + 2], p[8 * s + 3]); w.z = cvtpk(p[8 * s + 4], p[8 * s + 5]); w.w = cvtpk(p[8 * s + 6], p[8 * s + 7]); pa[s] = __builtin_bit_cast(bf16x8, w); }
#pragma unroll
        for (int d0 = 0; d0 < HD / 32; ++d0)
#pragma unroll
            for (int s = 0; s < 2; ++s) {
                bf16x8 vf;
                if (VT) {
                    const bf16* vp = Vp + (size_t)(d0 * 32 + r32) * vpitch + kv0 + 16 * s + 4 * hi;
                    const u32x2 lo = *(const u32x2*)vp, hi2 = *(const u32x2*)(vp + 8);
                    vf = __builtin_bit_cast(bf16x8, (v4u){lo.x, lo.y, hi2.x, hi2.y});
                } else {
#pragma unroll
                    for (int j = 0; j < 8; ++j) vf[j] = (short)Vp[(size_t)(kv0 + 16 * s + 8 * (j >> 2) + 4 * hi + (j & 3)) * vpitch + d0 * 32 + r32];
                }
                o[d0] = __builtin_amdgcn_mfma_f32_32x32x16_bf16(vf, pa[s], o[d0], 0, 0, 0);
            }
    }
    l += __shfl_xor(l, 32);
    const float inv = 1.0f / l;
    bf16* orow = Op + (size_t)r32 * opitch;
#pragma unroll
    for (int d0 = 0; d0 < HD / 32; ++d0)
#pragma unroll
        for (int g = 0; g < 4; ++g) { u32x2 w; w.x = cvtpk(o[d0][4 * g] * inv, o[d0][4 * g + 1] * inv); w.y = cvtpk(o[d0][4 * g + 2] * inv, o[d0][4 * g + 3] * inv);
            *(u32x2*)(orow + d0 * 32 + 8 * g + 4 * hi) = w; }
}
__device__ __forceinline__ void fox_unit(int bh, int qb, const bf16* FQ, const bf16* FK, const bf16* FV, const float* CUM, const int* T0, bf16* OA, int wave, int lane) {
    const int b = bh >> 3, h = bh & 7, r32 = lane & 31, hi = lane >> 5; const size_t rowbase = (size_t)b * SEQ; const int q0 = qb * 256 + wave * 32;
    const bf16* Qw = FQ + (rowbase + q0) * 512 + h * 64; bf16* Ow = OA + (rowbase + q0) * 512 + h * 64;
    bf16x8 qr[4];
#pragma unroll
    for (int ks = 0; ks < 4; ++ks) qr[ks] = *(const bf16x8*)(Qw + (size_t)r32 * 512 + ks * 16 + hi * 8);
    attn_wave_simple<64, true, false>(qr, FK + rowbase * 512 + h * 64, 512, FV + rowbase * 512 + h * 64, 512, T0[bh * 256 + q0 / 32], q0 / 32 + 1, q0 + r32, CUM + (size_t)bh * SEQ, Ow, 512, lane);
}
__device__ __forceinline__ void mem_unit(int rg, int head, bf16* MQ, const bf16* KMB, const bf16* VMB, const float* gq, int lane) {
    const int r32 = lane & 31, hi = lane >> 5; const int row0 = rg * 32; const int b = row0 / SEQ;
    bf16* Qw = MQ + (size_t)row0 * 512 + head * 128;
    bf16x8 raw[8]; float ss = 0.f;
#pragma unroll
    for (int ks = 0; ks < 8; ++ks) { raw[ks] = *(const bf16x8*)(Qw + (size_t)r32 * 512 + ks * 16 + hi * 8);
#pragma unroll
        for (int j = 0; j < 8; ++j) { const float f = bf2f((bf16)raw[ks][j]); ss += f * f; } }
    ss += __shfl_xor(ss, 32);
    const float rstd = __builtin_amdgcn_rsqf(ss * (1.0f / 128.0f) + 1e-6f) * C2_128;
    bf16x8 qr[8];
#pragma unroll
    for (int ks = 0; ks < 8; ++ks) { const f32x4 g0 = *(const f32x4*)(gq + ks * 16 + hi * 8), g1 = *(const f32x4*)(gq + ks * 16 + hi * 8 + 4); v4u w;
        w.x = cvtpk(bf2f((bf16)raw[ks][0]) * rstd * g0[0], bf2f((bf16)raw[ks][1]) * rstd * g0[1]); w.y = cvtpk(bf2f((bf16)raw[ks][2]) * rstd * g0[2], bf2f((bf16)raw[ks][3]) * rstd * g0[3]);
        w.z = cvtpk(bf2f((bf16)raw[ks][4]) * rstd * g1[0], bf2f((bf16)raw[ks][5]) * rstd * g1[1]); w.w = cvtpk(bf2f((bf16)raw[ks][6]) * rstd * g1[2], bf2f((bf16)raw[ks][7]) * rstd * g1[3]);
        qr[ks] = __builtin_bit_cast(bf16x8, w); }
    attn_wave_simple<128, false, true>(qr, KMB + (size_t)b * MEMLEN * 512 + head * 128, 512, VMB + (size_t)(b * 4 + head) * 128 * MEMLEN, MEMLEN, 0, MEMLEN / 32, 0, nullptr, Qw, 512, lane);
}
__device__ __forceinline__ void scan_unit(int bh, const float* LOGF, float* CUM, int* T0, const float* gq, const float* gk, LAS float* sx, LAS float* cl, int tid) {
    const int b = bh >> 3, h = bh & 7, lane = tid & 63, wave = tid >> 6;
    float v[16]; float run = 0.f;
#pragma unroll
    for (int i = 0; i < 16; ++i) v[i] = LOGF[((size_t)b * SEQ + 16 * tid + i) * 8 + h];
#pragma unroll
    for (int i = 0; i < 16; ++i) { run += v[i]; v[i] = run; }
    float tot = run;
#pragma unroll
    for (int off = 1; off < 64; off <<= 1) { const float nb = __shfl_up(tot, off); if (lane >= off) tot += nb; }
    if (lane == 63) sx[wave] = tot;
    __syncthreads();
    float woff = 0.f;
    for (int w = 0; w < wave; ++w) woff += sx[w];
    const float excl = tot - run + woff;
    float* dst = CUM + (size_t)bh * SEQ + 16 * tid;
#pragma unroll
    for (int i = 0; i < 16; i += 4) { const f32x4 o4 = (f32x4){v[i] + excl, v[i + 1] + excl, v[i + 2] + excl, v[i + 3] + excl}; *(f32x4*)(dst + i) = o4; *(LAS f32x4*)(cl + 16 * tid + i) = o4; }
    const float smax = 8.0f * wave_max(fabsf(gq[lane])) * wave_max(fabsf(gk[lane]));
    __syncthreads();
    if (tid < 256) { const float cq = cl[32 * tid]; const float lim = -(30.0f + 2.0f * smax);
        int lo = 0, hi = tid;
        while (lo < hi) { const int mid = (lo + hi) >> 1; if (cq - cl[32 * mid + 31] >= lim) hi = mid; else lo = mid + 1; }
        T0[bh * 256 + tid] = lo; }
    __syncthreads();
}
constexpr int D2_LST = RING_BYTES + 1024;
constexpr int D2_CNT = RING_BYTES + 3072;
constexpr int D2_CL = RING_BYTES + 4096;
typedef short v4i16_t __attribute__((ext_vector_type(4)));
typedef float f32x4d __attribute__((ext_vector_type(4)));
__device__ __forceinline__ unsigned sortable_u32(float f) { const unsigned u = __float_as_uint(f); return u ^ ((u >> 31) ? 0xFFFFFFFFu : 0x80000000u); }
__device__ __forceinline__ int lane_rank(unsigned long long mask) { return (int)__builtin_amdgcn_mbcnt_hi((unsigned)(mask >> 32), __builtin_amdgcn_mbcnt_lo((unsigned)mask, 0u)); }
__device__ __forceinline__ int bcount(bool p) { return (int)__popcll(__ballot(p)); }
__device__ __forceinline__ void select_full(const LAS unsigned* my, int npad, LAS unsigned short* lst, int lane) {
    unsigned thr = 0u;
    for (int bit = 31; bit >= 0; --bit) {
        const unsigned cand = thr | (1u << bit); int cnt = 0;
        for (int i0 = 0; i0 < npad; i0 += 256) { const int idx = i0 + 4 * lane; v4u v = (v4u){0u, 0u, 0u, 0u}; if (idx < npad) v = *(const LAS v4u*)(my + idx);
            cnt += bcount(v.x >= cand) + bcount(v.y >= cand) + bcount(v.z >= cand) + bcount(v.w >= cand); }
        if (cnt >= 256) thr = cand;
    }
    int cgt = 0;
    for (int i0 = 0; i0 < npad; i0 += 256) { const int idx = i0 + 4 * lane; v4u v = (v4u){0u, 0u, 0u, 0u}; if (idx < npad) v = *(const LAS v4u*)(my + idx);
        cgt += bcount(v.x > thr) + bcount(v.y > thr) + bcount(v.z > thr) + bcount(v.w > thr); }
    const int quota = 256 - cgt; int eqseen = 0, nsel = 0;
    for (int base = 0; base < npad; base += 64) { const int idx = base + lane; unsigned u = 0u; if (idx < npad) u = my[idx];
        const bool gt = u > thr, eq = (u == thr);
        const unsigned long long em = __ballot(eq); const int er = eqseen + lane_rank(em);
        const bool sel = gt || (eq && er < quota);
        const unsigned long long sm = __ballot(sel); const int pos = nsel + lane_rank(sm);
        if (sel && pos < 256) lst[pos] = (unsigned short)idx;
        nsel += __popcll(sm); eqseen += __popcll(em); }
}
template <int KMAX> __device__ __forceinline__ void select_cands(const unsigned (&uu)[16], const unsigned (&id)[16], LAS unsigned short* lst, int lane, unsigned lb = 0u) {
    unsigned thr = 0u;
    for (int bit = 31; bit >= 0; --bit) {
        if ((((thr ^ lb) >> bit) >> 1) == 0u && ((lb >> bit) & 1u)) { thr |= (1u << bit); continue; }
        const unsigned cand = thr | (1u << bit); int cnt = 0;
#pragma unroll
        for (int k = 0; k < KMAX; ++k) cnt += bcount(uu[k] >= cand);
        if (cnt >= 256) { thr = cand; if (cnt == 256) break; }
    }
    int cgt = 0, ceq = 0;
#pragma unroll
    for (int k = 0; k < KMAX; ++k) { cgt += bcount(uu[k] > thr); ceq += bcount(uu[k] == thr); }
    const int quota = 256 - cgt; unsigned ilim = 0xFFFFu;
    if (ceq != quota) {
        unsigned I = 0u;
        for (int bit = 12; bit >= 0; --bit) { const unsigned cand = I | (1u << bit); int cnt = 0;
#pragma unroll
            for (int k = 0; k < KMAX; ++k) cnt += bcount(uu[k] == thr && id[k] < cand);
            if (cnt < quota) I = cand; }
        ilim = I;
    }
    int nsel = 0;
#pragma unroll
    for (int k = 0; k < KMAX; ++k) { const bool sel = (uu[k] > thr) || (uu[k] == thr && id[k] <= ilim);
        const unsigned long long sm = __ballot(sel); const int pos = nsel + lane_rank(sm);
        if (sel && pos < 256) lst[pos] = (unsigned short)id[k];
        nsel += __popcll(sm); }
}
__device__ __forceinline__ void dsa2_unit(int b, int qg, const bf16* IQ, const bf16* IK, const float* IW, const bf16* DQ, const bf16* DK, const bf16* DV, bf16* OB, LAS unsigned char* lds, int wave, int lane) {
    LAS unsigned* sc = (LAS unsigned*)lds;
    LAS unsigned short* LST = (LAS unsigned short*)(lds + D2_LST);
    LAS int* CNT = (LAS int*)(lds + D2_CNT);
    LAS unsigned short* CL = (LAS unsigned short*)(lds + D2_CL);
    const int q0 = 4 * qg, r32 = lane & 31, hi = lane >> 5; const size_t rowbase = (size_t)b * SEQ;
    const int ntile = (q0 + 3) / 32 + 1, npad = ntile * 32;
#ifndef REP_A
#define REP_A 1
#define REP_B1 1
#define REP_B2 1
#define REP_C 1
#endif
    for (int repa = 0; repa < REP_A; ++repa)
    {
        const int qi = 2 * ((r32 >> 2) & 1) + (r32 >> 4), hd = 4 * ((r32 >> 3) & 1) + (r32 & 3);
        bf16x8 aq[4];
#pragma unroll
        for (int ks = 0; ks < 4; ++ks) aq[ks] = *(const bf16x8*)(IQ + (rowbase + q0 + qi) * 512 + hd * 64 + ks * 16 + hi * 8);
        const float* w0p = IW + (rowbase + q0 + 2 * hi) * 8;
        const f32x4 w0a = *(const f32x4*)(w0p), w0b = *(const f32x4*)(w0p + 4), w1a = *(const f32x4*)(w0p + 8), w1b = *(const f32x4*)(w0p + 12);
        for (int t = wave; t < ntile; t += 32) {
            bf16x8 bk[4][4];
#pragma unroll
            for (int u = 0; u < 4; ++u) { const int tt = t + 8 * u; const bf16* kr = IK + (rowbase + 32 * (tt < ntile ? tt : t)) * 64 + lane * 8;
#pragma unroll
                for (int ks = 0; ks < 4; ++ks) bk[u][ks] = *(const bf16x8*)(kr + ks * 512); }
#pragma unroll
            for (int u = 0; u < 4; ++u) { const int tt = t + 8 * u;
                if (tt < ntile) {
                    const int key = 32 * tt + r32;
                    f32x16 a;
#pragma unroll
                    for (int r = 0; r < 16; ++r) a[r] = 0.f;
#pragma unroll
                    for (int ks = 0; ks < 4; ++ks) a = __builtin_amdgcn_mfma_f32_32x32x16_bf16(aq[ks], bk[u][ks], a, 0, 0, 0);
                    float s0 = 0.f, s1 = 0.f;
#pragma unroll
                    for (int j = 0; j < 4; ++j) { s0 += w0a[j] * fmaxf(a[j], 0.f); s1 += w1a[j] * fmaxf(a[8 + j], 0.f); }
#pragma unroll
                    for (int j = 0; j < 4; ++j) { s0 += w0b[j] * fmaxf(a[4 + j], 0.f); s1 += w1b[j] * fmaxf(a[12 + j], 0.f); }
                    sc[(2 * hi) * 8192 + key] = (key <= q0 + 2 * hi) ? sortable_u32(s0) : 0u;
                    sc[(2 * hi + 1) * 8192 + key] = (key <= q0 + 2 * hi + 1) ? sortable_u32(s1) : 0u;
                } }
        }
    }
    __syncthreads();
    const int qi = wave & 3, hf = wave >> 2, q = q0 + qi, n = q + 1;
    const LAS unsigned* my = sc + qi * 8192;
    for (int repb = 0; repb < REP_B1; ++repb)
    {
        int c = 0; bool ovf = false;
        if (n > 256) {
            unsigned pivot = 1u;
            if (n > 640) {
                unsigned s[8];
#pragma unroll
                for (int k = 0; k < 8; ++k) s[k] = my[(int)(((unsigned)(lane * 8 + k) * (unsigned)n) >> 9)];
                const int r = (256 * 512 * 7 / 4) / n + 8;
                unsigned t16 = 0u;
                for (int bit = 15; bit >= 0; --bit) { const unsigned cand = (t16 | (1u << bit)) << 16; int cnt = 0;
#pragma unroll
                    for (int k = 0; k < 8; ++k) cnt += bcount(s[k] >= cand);
                    if (cnt >= r) t16 |= (1u << bit); }
                pivot = t16 << 16; if (pivot == 0u) pivot = 1u;
            }
            const int half = ((npad + 511) >> 9) << 8; const int lo = hf * half; const int hiend = (lo + half < npad) ? lo + half : npad;
            LAS unsigned short* cl = CL + wave * 1024;
            for (int i0 = lo; i0 < hiend; i0 += 256) { const int idx = i0 + 4 * lane; v4u v = (v4u){0u, 0u, 0u, 0u}; if (idx < hiend) v = *(const LAS v4u*)(my + idx);
#pragma unroll
                for (int e = 0; e < 4; ++e) { const bool f = v[e] >= pivot; const unsigned long long m = __ballot(f); const int pos = c + lane_rank(m);
                    if (f) { if (pos < 1024) cl[pos] = (unsigned short)(idx + e); }
                    c += __popcll(m); } }
            if (c > 1024) ovf = true;
        }
        if (lane == 0) CNT[wave] = ovf ? -1 : c;
    }
    __syncthreads();
    for (int repb2 = 0; repb2 < REP_B2; ++repb2)
    if (wave < 4) {
        LAS unsigned short* lst = LST + wave * 256; int nsel;
        if (n <= 256) { for (int i = lane; i < n; i += 64) lst[i] = (unsigned short)i; nsel = n; }
        else {
            const int c0 = CNT[wave], c1 = CNT[wave + 4]; const int c = c0 + c1;
            if (c0 < 0 || c1 < 0 || c < 256 || c > 1024) select_full(my, npad, lst, lane);
            else {
                unsigned uu[16], id[16];
#pragma unroll
                for (int k = 0; k < 16; ++k) { const int j = k * 64 + lane; unsigned ix = 0u, u = 0u;
                    if (j < c) { ix = (j < c0) ? (unsigned)CL[wave * 1024 + j] : (unsigned)CL[(wave + 4) * 1024 + (j - c0)]; u = my[ix]; }
                    uu[k] = u; id[k] = ix; }
                if (c <= 512) select_cands<8>(uu, id, lst, lane); else select_cands<16>(uu, id, lst, lane);
            }
            nsel = 256;
        }
        if (lane == 0) CNT[8 + wave] = nsel;
    }
    __syncthreads();
    for (int repc = 0; repc < REP_C; ++repc)
    {
        const int nsel = CNT[8 + qi]; const int j0 = 128 * hf; int cntk = nsel - j0; cntk = cntk < 0 ? 0 : (cntk > 128 ? 128 : cntk);
        const LAS unsigned short* lst = LST + qi * 256;
        LAS unsigned char* tile = lds + wave * 16384;
        LAS float* tf = (LAS float*)tile;
        const int l15 = lane & 15, kq = lane >> 4;
        if (cntk == 0) {
#pragma unroll
            for (int i = 0; i < 8; ++i) tf[i * 64 + lane] = 0.f;
            if (lane < 8) { tf[512 + lane] = -INFINITY; tf[520 + lane] = 0.f; }
        } else {
#pragma unroll
            for (int it = 0; it < 16; ++it) { const int r = 8 * it + (lane >> 3), ch = lane & 7; int j = j0 + r; j = j < nsel ? j : nsel - 1;
                const int idxv = (int)lst[j]; const v4u v = *(const v4u*)(DV + (rowbase + idxv) * 64 + 8 * ch);
                *(LAS v4u*)(tile + r * 128 + ch * 16) = v; }
            bf16x8 qf[2];
#pragma unroll
            for (int ks = 0; ks < 2; ++ks) { v4u z = (v4u){0u, 0u, 0u, 0u}; if (l15 < 8) z = *(const v4u*)(DQ + (rowbase + q) * 512 + l15 * 64 + 32 * ks + 8 * kq); qf[ks] = __builtin_bit_cast(bf16x8, z); }
            f32x4d acc[8];
#pragma unroll
            for (int g = 0; g < 8; ++g) { int j = j0 + 16 * g + l15; j = j < nsel ? j : nsel - 1; const int idxk = (int)lst[j];
                const bf16* kp = DK + (rowbase + idxk) * 64 + 8 * kq;
                const bf16x8 k0 = *(const bf16x8*)(kp), k1 = *(const bf16x8*)(kp + 32);
                f32x4d a = (f32x4d){0.f, 0.f, 0.f, 0.f};
                a = __builtin_amdgcn_mfma_f32_16x16x32_bf16(k0, qf[0], a, 0, 0, 0); a = __builtin_amdgcn_mfma_f32_16x16x32_bf16(k1, qf[1], a, 0, 0, 0); acc[g] = a; }
            float mx = -INFINITY;
#pragma unroll
            for (int g = 0; g < 8; ++g)
#pragma unroll
                for (int e = 0; e < 4; ++e) { if (16 * g + 4 * kq + e >= cntk) acc[g][e] = -INFINITY; mx = fmaxf(mx, acc[g][e]); }
            mx = fmaxf(mx, __shfl_xor(mx, 16)); mx = fmaxf(mx, __shfl_xor(mx, 32));
            float ls = 0.f;
#pragma unroll
            for (int g = 0; g < 8; ++g)
#pragma unroll
                for (int e = 0; e < 4; ++e) { acc[g][e] = __builtin_amdgcn_exp2f(acc[g][e] - mx); ls += acc[g][e]; }
            ls += __shfl_xor(ls, 16); ls += __shfl_xor(ls, 32);
            bf16x8 pa[4];
#pragma unroll
            for (int t = 0; t < 4; ++t) { v4u w; w.x = cvtpk(acc[2 * t][0], acc[2 * t][1]); w.y = cvtpk(acc[2 * t][2], acc[2 * t][3]); w.z = cvtpk(acc[2 * t + 1][0], acc[2 * t + 1][1]); w.w = cvtpk(acc[2 * t + 1][2], acc[2 * t + 1][3]); pa[t] = __builtin_bit_cast(bf16x8, w); }
            f32x4d o[4];
            const int q_ = l15 >> 2, p_ = lane & 3;
#pragma unroll
            for (int cb = 0; cb < 4; ++cb) { f32x4d oc = (f32x4d){0.f, 0.f, 0.f, 0.f};
#pragma unroll
                for (int t = 0; t < 4; ++t) {
                    const LAS unsigned char* a1 = tile + (32 * t + 4 * kq + q_) * 128 + (16 * cb + 4 * p_) * 2;
                    const v4i16_t lo4 = __builtin_amdgcn_ds_read_tr16_b64_v4i16((LAS v4i16_t*)a1), hi4 = __builtin_amdgcn_ds_read_tr16_b64_v4i16((LAS v4i16_t*)(a1 + 16 * 128));
                    const bf16x8 vf = (bf16x8){lo4[0], lo4[1], lo4[2], lo4[3], hi4[0], hi4[1], hi4[2], hi4[3]};
                    oc = __builtin_amdgcn_mfma_f32_16x16x32_bf16(pa[t], vf, oc, 0, 0, 0); }
                o[cb] = oc; }
            if (kq < 2) {
#pragma unroll
                for (int cb = 0; cb < 4; ++cb)
#pragma unroll
                    for (int e = 0; e < 4; ++e) tf[(4 * kq + e) * 64 + 16 * cb + l15] = o[cb][e];
            }
            if (lane < 8) { tf[512 + lane] = mx; tf[520 + lane] = ls; }
        }
    }
    __syncthreads();
    if (wave < 4) {
        const LAS float* ta = (const LAS float*)(lds + wave * 16384); const LAS float* tb = (const LAS float*)(lds + (wave + 4) * 16384);
        const int h = lane >> 3, d0 = (lane & 7) * 8;
        const float ma = ta[512 + h], mb = tb[512 + h], la = ta[520 + h], lb = tb[520 + h];
        const float m = fmaxf(ma, mb), fa = __builtin_amdgcn_exp2f(ma - m), fb = __builtin_amdgcn_exp2f(mb - m);
        const float inv = 1.0f / (la * fa + lb * fb);
        const f32x4 a0 = *(const LAS f32x4*)(ta + h * 64 + d0), a1 = *(const LAS f32x4*)(ta + h * 64 + d0 + 4), b0 = *(const LAS f32x4*)(tb + h * 64 + d0), b1 = *(const LAS f32x4*)(tb + h * 64 + d0 + 4);
        const f32x4 r0 = (a0 * fa + b0 * fb) * inv, r1 = (a1 * fa + b1 * fb) * inv;
        v4u w; w.x = cvtpk(r0[0], r0[1]); w.y = cvtpk(r0[2], r0[3]); w.z = cvtpk(r1[0], r1[1]); w.w = cvtpk(r1[2], r1[3]);
        *(v4u*)(OB + (rowbase + q) * 512 + h * 64 + d0) = w;
    }
    __syncthreads();
}
constexpr int D3_RING = RING_BYTES + 1024;
constexpr int D3_LST = D3_RING + 16384;
constexpr int D3_CNT = D3_LST + 8192;
constexpr int D3_QW = D3_CNT + 512;
typedef unsigned long long u64d;
template <int KMAX> __device__ __forceinline__ void select_cands3(const unsigned (&uu)[16], const unsigned (&id)[16], LAS unsigned short* lst, int lane) { select_cands<KMAX>(uu, id, lst, lane); }
__device__ __forceinline__ void dsa3_unit(int b, int g16, const bf16* IQ, const bf16* IK, const float* IW, const bf16* DQ, const bf16* DK, const bf16* DV, bf16* OB, LAS unsigned char* lds, int wave, int lane_in) {
    int lane = lane_in; asm volatile("" : "+v"(lane));
    LAS u64d* LISTS = (LAS u64d*)lds;
    LAS unsigned short* LST = (LAS unsigned short*)(lds + D3_LST);
    LAS int* CNT = (LAS int*)(lds + D3_CNT);
    const int tid = wave * 64 + lane, r32 = lane & 31, hi = lane >> 5; const size_t rowbase = (size_t)b * SEQ;
    const int q0 = 16 * g16, ntile = (q0 + 15) / 32 + 1, nstep = (ntile + 1) >> 1;
    const int qgrp = wave & 3, par = wave >> 2;
    const int qA = q0 + 4 * qgrp + 2 * hi, qB = qA + 1;
    const int qi = 2 * ((r32 >> 2) & 1) + (r32 >> 4), hd = 4 * ((r32 >> 3) & 1) + (r32 & 3);
    bf16x8 aq[4];
#pragma unroll
    for (int ks = 0; ks < 4; ++ks) aq[ks] = *(const bf16x8*)(IQ + (rowbase + q0 + 4 * qgrp + qi) * 512 + hd * 64 + ks * 16 + hi * 8);
    const float* w0p = IW + (rowbase + qA) * 8;
    const f32x4 w0a = *(const f32x4*)(w0p), w0b = *(const f32x4*)(w0p + 4), w1a = *(const f32x4*)(w0p + 8), w1b = *(const f32x4*)(w0p + 12);
    f32x4 l0a, l0b, l1a, l1b;
#pragma unroll
    for (int j = 0; j < 4; ++j) { l0a[j] = w0a[j] >= 0.f ? INFINITY : -INFINITY; l0b[j] = w0b[j] >= 0.f ? INFINITY : -INFINITY; l1a[j] = w1a[j] >= 0.f ? INFINITY : -INFINITY; l1b[j] = w1b[j] >= 0.f ? INFINITY : -INFINITY; }
#define D3_SCORE(BK, S0, S1) do { f32x16 a_; _Pragma("unroll") for (int r = 0; r < 16; ++r) a_[r] = 0.f; \
        _Pragma("unroll") for (int ks = 0; ks < 4; ++ks) a_ = __builtin_amdgcn_mfma_f32_32x32x16_bf16(aq[ks], BK[ks], a_, 0, 0, 0); \
        S0 = 0.f; S1 = 0.f; \
        _Pragma("unroll") for (int j = 0; j < 4; ++j) { S0 += __builtin_amdgcn_fmed3f(w0a[j] * a_[j], 0.f, l0a[j]); S1 += __builtin_amdgcn_fmed3f(w1a[j] * a_[8 + j], 0.f, l1a[j]); } \
        _Pragma("unroll") for (int j = 0; j < 4; ++j) { S0 += __builtin_amdgcn_fmed3f(w0b[j] * a_[4 + j], 0.f, l0b[j]); S1 += __builtin_amdgcn_fmed3f(w1b[j] * a_[12 + j], 0.f, l1b[j]); } } while (0)
#ifndef REP_S
#define REP_S 1
#define REP_M 1
#define REP_B 1
#define REP_CD 1
#endif
    unsigned pivA = 1u, pivB = 1u;
    if (ntile <= 16 && tid < 16) CNT[64 + tid] = 0;
    for (int reps = 0; reps < REP_S; ++reps)
    if (ntile > 16) {
#pragma unroll
        for (int k = 0; k < 4; ++k) { const int c = tid + 512 * k; const int ts = ((c >> 8) * ntile) >> 3;
            *(LAS v4u*)(lds + c * 16) = *(const v4u*)(IK + (rowbase + 32 * ts) * 64 + (c & 255) * 8); }
        __syncthreads();
        unsigned uA[8], uB[8];
#pragma unroll
        for (int i = 0; i < 8; ++i) { bf16x8 bk[4];
#pragma unroll
            for (int ks = 0; ks < 4; ++ks) bk[ks] = *(const LAS bf16x8*)(lds + i * 4096 + ks * 1024 + lane * 16);
            float s0, s1; D3_SCORE(bk, s0, s1); uA[i] = sortable_u32(s0); uB[i] = sortable_u32(s1); asm volatile("" ::: "memory"); }
        const int qs = q0 + 4 * qgrp + par;
        const int r0 = (256 * 256 * 7 / 4) / (qs + 1) + 6, r1 = (256 * 256 * 7 / 4) / (qs + 3) + 6;
        unsigned us[8];
#pragma unroll
        for (int i = 0; i < 8; ++i) us[i] = par ? uB[i] : uA[i];
        unsigned t0 = 0u, t1 = 0u;
        for (int bit = 15; bit >= 0; --bit) {
            const unsigned c = ((hi ? t1 : t0) | (1u << bit)) << 16; int n0 = 0, n1 = 0;
#pragma unroll
            for (int i = 0; i < 8; ++i) { const unsigned long long m = __builtin_amdgcn_ballot_w64(us[i] >= c); n0 += __popc((unsigned)m); n1 += __popc((unsigned)(m >> 32)); }
            if (n0 >= r0) t0 |= (1u << bit);
            if (n1 >= r1) t1 |= (1u << bit);
        }
        LAS unsigned* PV = (LAS unsigned*)(CNT + 64);
        if (lane == 0) { PV[4 * qgrp + par] = t0; PV[4 * qgrp + 2 + par] = t1; }
        __syncthreads();
        const unsigned tA = PV[4 * qgrp + 2 * hi], tB = PV[4 * qgrp + 2 * hi + 1];
        pivA = tA << 16; pivB = tB << 16; if (pivA == 0u) pivA = 1u; if (pivB == 0u) pivB = 1u;
        __syncthreads();
    }
    for (int repm = 0; repm < REP_M; ++repm)
    {
        const bf16* src0 = IK + rowbase * 64 + (size_t)(tid & 255) * 8;
#define D3_LOAD(k_) (*(const v4u*)(src0 + (size_t)32 * ((2 * (k_) + (tid >> 8)) < ntile ? (2 * (k_) + (tid >> 8)) : ntile - 1) * 64))
        v4u st0 = (v4u){0u, 0u, 0u, 0u}, st1 = st0, st2 = st0, st3 = st0;
        st0 = D3_LOAD(0); st1 = D3_LOAD(1); st2 = D3_LOAD(2); st3 = D3_LOAD(3);
        *(LAS v4u*)(lds + D3_RING + tid * 16) = st0;
        __syncthreads();
        int cntA = 0, cntB = 0;
        LAS u64d* lA = LISTS + ((4 * qgrp + 2 * hi) * 2 + par) * 512; LAS u64d* lB = lA + 1024;
        LAS u64d* dmy = (LAS u64d*)(lds + D3_QW + 64) + lane;
        f32x16 acc;
#pragma unroll
        for (int r = 0; r < 16; ++r) acc[r] = 0.f;
#define D3_SUMS(S0, S1) do { S0 = 0.f; S1 = 0.f; \
            _Pragma("unroll") for (int j = 0; j < 4; ++j) { S0 += __builtin_amdgcn_fmed3f(w0a[j] * acc[j], 0.f, l0a[j]); S1 += __builtin_amdgcn_fmed3f(w1a[j] * acc[8 + j], 0.f, l1a[j]); } \
            _Pragma("unroll") for (int j = 0; j < 4; ++j) { S0 += __builtin_amdgcn_fmed3f(w0b[j] * acc[4 + j], 0.f, l0b[j]); S1 += __builtin_amdgcn_fmed3f(w1b[j] * acc[12 + j], 0.f, l1b[j]); } } while (0)
#define D3_FILTER(TP, S0, S1) do { const int key = 32 * (TP) + r32; const unsigned u0 = sortable_u32(S0), u1 = sortable_u32(S1);     \
                const bool psa = (key <= qA) && (u0 >= pivA), psb = (key <= qB) && (u1 >= pivB); \
                const unsigned long long ma = __ballot(psa), mb = __ballot(psb); const unsigned mla = (unsigned)ma, mha = (unsigned)(ma >> 32), mlb = (unsigned)mb, mhb = (unsigned)(mb >> 32); \
                const int posa = cntA + (int)__builtin_amdgcn_mbcnt_hi(mha, __builtin_amdgcn_mbcnt_lo(mla, 0u)) - (hi ? __popc(mla) : 0); \
                const int posb = cntB + (int)__builtin_amdgcn_mbcnt_hi(mhb, __builtin_amdgcn_mbcnt_lo(mlb, 0u)) - (hi ? __popc(mlb) : 0); \
                LAS u64d* wa_ = (psa && posa < 512) ? lA + posa : dmy; LAS u64d* wb_ = (psb && posb < 512) ? lB + posb : dmy; \
                *wa_ = ((u64d)(unsigned)key << 32) | u0; *wb_ = ((u64d)(unsigned)key << 32) | u1; \
                cntA += hi ? __popc(mha) : __popc(mla); cntB += hi ? __popc(mhb) : __popc(mlb); } while (0)
#define D3_STEP(k_, STNEXT, STFREE) do { \
            STFREE = D3_LOAD((k_) + 4); \
            const int tp_ = 2 * (k_) - 2 + par; \
            const LAS unsigned char* sb = lds + D3_RING + ((k_) & 1) * 8192 + par * 4096; bf16x8 bk[4]; \
            _Pragma("unroll") for (int ks = 0; ks < 4; ++ks) bk[ks] = *(const LAS bf16x8*)(sb + ks * 1024 + lane * 16); \
            __builtin_amdgcn_sched_barrier(0); \
            float s0, s1; D3_SUMS(s0, s1); asm volatile("" : "+v"(s0), "+v"(s1));     \
            __builtin_amdgcn_sched_barrier(0); \
            _Pragma("unroll") for (int r = 0; r < 16; ++r) acc[r] = 0.f; \
            _Pragma("unroll") for (int ks = 0; ks < 4; ++ks) acc = __builtin_amdgcn_mfma_f32_32x32x16_bf16(aq[ks], bk[ks], acc, 0, 0, 0); \
            __builtin_amdgcn_sched_barrier(0); \
            if (tp_ >= 0 && tp_ < ntile) D3_FILTER(tp_, s0, s1); \
            *(LAS v4u*)(lds + D3_RING + (((k_) + 1) & 1) * 8192 + tid * 16) = STNEXT; \
            asm volatile("s_waitcnt lgkmcnt(0)" ::: "memory"); __builtin_amdgcn_s_barrier(); asm volatile("" ::: "memory"); } while (0)
        int kend = 0;
        for (int k = 0; k < nstep; k += 4) {
            D3_STEP(k, st1, st0); D3_STEP(k + 1, st2, st1); D3_STEP(k + 2, st3, st2); D3_STEP(k + 3, st0, st3); kend = k + 4;
        }
        {   const int tp_ = 2 * kend - 2 + par; if (tp_ < ntile) { float s0, s1; D3_SUMS(s0, s1); D3_FILTER(tp_, s0, s1); } }
#undef D3_SUMS
#undef D3_FILTER
#undef D3_STEP
#undef D3_LOAD
        if (r32 == 0) { CNT[(4 * qgrp + 2 * hi) * 2 + par] = cntA; CNT[(4 * qgrp + 2 * hi + 1) * 2 + par] = cntB; }
        if (tid < 4) CNT[48 + tid] = 0;
    }
#undef D3_SCORE
    __syncthreads();
#if defined(DBG_D3_STAGE) && DBG_D3_STAGE == 1
    for (int grp = 0; grp < 4; ++grp) dsa2_unit(b, 4 * g16 + grp, IQ, IK, IW, DQ, DK, DV, OB, lds, wave, lane);
    return;
#endif
#pragma unroll 1
    for (int rr = 0; rr < 2 * REP_B; ++rr) {
        const int qx = wave + 8 * (rr & 1), q = q0 + qx, n = q + 1; LAS unsigned short* lst = LST + qx * 256; int nsel;
        if (n <= 256) { for (int i = lane; i < n; i += 64) lst[i] = (unsigned short)i; nsel = n; }
        else {
            const int c0 = CNT[2 * qx], c1 = CNT[2 * qx + 1]; const int c = c0 + c1;
#ifdef DBG_D3_ALLFAIL
            if (true) { if (lane == 0) CNT[48 + (qx >> 2)] = 1; nsel = 0; }
#else
            if (c0 > 512 || c1 > 512 || c < 256) { if (lane == 0) CNT[48 + (qx >> 2)] = 1; nsel = 0; }
#endif
            else {
                unsigned uu[16], id[16]; const LAS u64d* L0 = LISTS + (qx * 2) * 512; const LAS u64d* L1 = L0 + 512;
#pragma unroll
                for (int k = 0; k < 16; ++k) { const int j = k * 64 + lane, jj = j < c ? j : c - 1;
                    const u64d e = *((jj < c0) ? (L0 + jj) : (L1 + (jj - c0))); uu[k] = j < c ? (unsigned)e : 0u; id[k] = (unsigned)(e >> 32); }
                const unsigned lb = (unsigned)CNT[64 + qx] << 16;
                if (c <= 512) select_cands<8>(uu, id, lst, lane, lb); else if (c <= 640) select_cands<10>(uu, id, lst, lane, lb); else if (c <= 768) select_cands<12>(uu, id, lst, lane, lb); else select_cands<16>(uu, id, lst, lane, lb);
                nsel = 256;
            }
        }
        if (lane == 0) CNT[32 + qx] = nsel;
    }
    __syncthreads();
#pragma unroll 1
    for (int rr_ = 0; rr_ < 2 * REP_CD; ++rr_) { const int rr = rr_ & 1;
        const int qx = wave + 8 * rr, q = q0 + qx; const int nsel = CNT[32 + qx];
        const LAS unsigned short* lst = LST + qx * 256;
        LAS unsigned char* tile = lds + wave * 16384; LAS float* tf = (LAS float*)tile;
        const int l15 = lane & 15, kq = lane >> 4, q_ = l15 >> 2, p_ = lane & 3;
        bf16x8 qf[2];
#pragma unroll
        for (int ks = 0; ks < 2; ++ks) { v4u z = (v4u){0u, 0u, 0u, 0u}; if (l15 < 8) z = *(const v4u*)(DQ + (rowbase + q) * 512 + l15 * 64 + 32 * ks + 8 * kq); qf[ks] = __builtin_bit_cast(bf16x8, z); }
        float mrun = -INFINITY, lrun = 0.f; f32x4d orun[4];
#pragma unroll
        for (int cb = 0; cb < 4; ++cb) orun[cb] = (f32x4d){0.f, 0.f, 0.f, 0.f};
#pragma unroll 1
        for (int hf = 0; hf < 2; ++hf) {
            const int j0 = 128 * hf; int cntk = nsel - j0; cntk = cntk > 128 ? 128 : cntk;
            if (cntk <= 0) break;
            int iv[16], ik[8];
#pragma unroll
            for (int it = 0; it < 16; ++it) { int j = j0 + 8 * it + (lane >> 3); j = j < nsel ? j : nsel - 1; iv[it] = (int)lst[j]; }
#pragma unroll
            for (int g = 0; g < 8; ++g) { int j = j0 + 16 * g + l15; j = j < nsel ? j : nsel - 1; ik[g] = (int)lst[j]; }
            asm volatile("s_waitcnt lgkmcnt(0)" ::: "memory");
#pragma unroll
            for (int it = 0; it < 16; ++it)
                __builtin_amdgcn_global_load_lds((const unsigned*)(DV + (rowbase + iv[it]) * 64 + 8 * (lane & 7)), (LAS unsigned*)(tile + it * 1024), 16, 0, 0);
            bf16x8 kk0[8], kk1[8];
#pragma unroll
            for (int g = 0; g < 8; ++g) { const bf16* kp = DK + (rowbase + ik[g]) * 64 + 8 * kq; kk0[g] = *(const bf16x8*)(kp); kk1[g] = *(const bf16x8*)(kp + 32); }
            asm volatile("" ::: "memory");
            f32x4d acc[8];
#pragma unroll
            for (int g = 0; g < 8; ++g) { f32x4d a = (f32x4d){0.f, 0.f, 0.f, 0.f};
                a = __builtin_amdgcn_mfma_f32_16x16x32_bf16(kk0[g], qf[0], a, 0, 0, 0); a = __builtin_amdgcn_mfma_f32_16x16x32_bf16(kk1[g], qf[1], a, 0, 0, 0); acc[g] = a; }
            float mx = -INFINITY;
#pragma unroll
            for (int g = 0; g < 8; ++g)
#pragma unroll
                for (int e = 0; e < 4; ++e) { if (16 * g + 4 * kq + e >= cntk) acc[g][e] = -INFINITY; mx = fmaxf(mx, acc[g][e]); }
            mx = fmaxf(mx, __shfl_xor(mx, 16)); mx = fmaxf(mx, __shfl_xor(mx, 32));
            const float mnew = fmaxf(mrun, mx), fold = __builtin_amdgcn_exp2f(mrun - mnew);
            float ls = 0.f;
#pragma unroll
            for (int g = 0; g < 8; ++g)
#pragma unroll
                for (int e = 0; e < 4; ++e) { acc[g][e] = __builtin_amdgcn_exp2f(acc[g][e] - mnew); ls += acc[g][e]; }
            ls += __shfl_xor(ls, 16); ls += __shfl_xor(ls, 32);
            lrun = lrun * fold + ls; mrun = mnew;
            float fo[4];
#pragma unroll
            for (int e = 0; e < 4; ++e) fo[e] = __shfl(fold, 4 * kq + e);
            asm volatile("s_waitcnt vmcnt(0)" ::: "memory");
            bf16x8 pa[4];
#pragma unroll
            for (int t = 0; t < 4; ++t) { v4u w; w.x = cvtpk(acc[2 * t][0], acc[2 * t][1]); w.y = cvtpk(acc[2 * t][2], acc[2 * t][3]); w.z = cvtpk(acc[2 * t + 1][0], acc[2 * t + 1][1]); w.w = cvtpk(acc[2 * t + 1][2], acc[2 * t + 1][3]); pa[t] = __builtin_bit_cast(bf16x8, w); }
#pragma unroll
            for (int cb = 0; cb < 4; ++cb) { f32x4d oc = orun[cb];
#pragma unroll
                for (int e = 0; e < 4; ++e) oc[e] *= fo[e];
#pragma unroll
                for (int t = 0; t < 4; ++t) {
                    const LAS unsigned char* a1 = tile + (32 * t + 4 * kq + q_) * 128 + (16 * cb + 4 * p_) * 2;
                    const v4i16_t lo4 = __builtin_amdgcn_ds_read_tr16_b64_v4i16((LAS v4i16_t*)a1), hi4 = __builtin_amdgcn_ds_read_tr16_b64_v4i16((LAS v4i16_t*)(a1 + 16 * 128));
                    const bf16x8 vf = (bf16x8){lo4[0], lo4[1], lo4[2], lo4[3], hi4[0], hi4[1], hi4[2], hi4[3]};
                    oc = __builtin_amdgcn_mfma_f32_16x16x32_bf16(pa[t], vf, oc, 0, 0, 0); }
                orun[cb] = oc; }
        }
        float li[4];
#pragma unroll
        for (int e = 0; e < 4; ++e) li[e] = 1.0f / __shfl(lrun, 4 * kq + e);
        if (kq < 2) {
#pragma unroll
            for (int cb = 0; cb < 4; ++cb)
#pragma unroll
                for (int e = 0; e < 4; ++e) tf[(4 * kq + e) * 64 + 16 * cb + l15] = orun[cb][e] * li[e];
        }
        { const int h = lane >> 3, d0 = (lane & 7) * 8;
          const f32x4 r0 = *(const LAS f32x4*)(tf + h * 64 + d0), r1 = *(const LAS f32x4*)(tf + h * 64 + d0 + 4);
          v4u w; w.x = cvtpk(r0[0], r0[1]); w.y = cvtpk(r0[2], r0[3]); w.z = cvtpk(r1[0], r1[1]); w.w = cvtpk(r1[2], r1[3]);
          *(v4u*)(OB + (rowbase + q) * 512 + h * 64 + d0) = w; }
    }
    __syncthreads();
    const int f0 = CNT[48], f1 = CNT[49], f2 = CNT[50], f3 = CNT[51];
    __syncthreads();
    const int fm = (f0 ? 1 : 0) | (f1 ? 2 : 0) | (f2 ? 4 : 0) | (f3 ? 8 : 0);
#pragma unroll 1
    for (int grp = 0; grp < 4; ++grp) if ((fm >> grp) & 1) dsa2_unit(b, 4 * g16 + grp, IQ, IK, IW, DQ, DK, DV, OB, lds, wave, lane);
}
__device__ __forceinline__ void fox_unit2(int bh, int qb, const bf16* FQ, const bf16* FK, const bf16* FV, const float* CUM, const int* T0, bf16* OA, LAS unsigned char* lds, int wave, int lane) {
    const int b = bh >> 3, h = bh & 7, r32 = lane & 31, hi = lane >> 5; const size_t rowbase = (size_t)b * SEQ; const int q0 = qb * 256 + wave * 32;
    const bf16* Qw = FQ + (rowbase + q0) * 512 + h * 64; bf16* Ow = OA + (rowbase + q0) * 512 + h * 64;
    const bf16* Kp = FK + rowbase * 512 + h * 64; const bf16* Vp = FV + rowbase * 512 + h * 64; const float* cb = CUM + (size_t)bh * SEQ;
    LAS unsigned char* wl = lds + wave * 16384;
    LAS float* bl = (LAS float*)(lds + RING_BYTES + 8192 + wave * 256);
    bf16x8 qr[4];
#pragma unroll
    for (int ks = 0; ks < 4; ++ks) qr[ks] = *(const bf16x8*)(Qw + (size_t)r32 * 512 + ks * 16 + hi * 8);
    const int tstart = T0[bh * 256 + q0 / 32], ntiles = q0 / 32 + 1, qlocal = q0 + r32;
    f32x16 o[2];
#pragma unroll
    for (int d0 = 0; d0 < 2; ++d0)
#pragma unroll
        for (int r = 0; r < 16; ++r) o[d0][r] = 0.f;
    float m = -1e30f, l = 0.f;
    const int lrow = lane >> 3, lch = lane & 7;
#define FOX_LOAD(KR, VR, BR, tt) do { _Pragma("unroll") for (int it = 0; it < 4; ++it) { const size_t ro = (size_t)(32 * (tt) + 8 * it + lrow) * 512 + lch * 8; KR[it] = *(const v4u*)(Kp + ro); VR[it] = *(const v4u*)(Vp + ro); } BR = cb[32 * (tt) + r32]; } while (0)
#define FOX_STORE(KR, VR, BR, bf) do { _Pragma("unroll") for (int it = 0; it < 4; ++it) { const int row = 8 * it + lrow; *(LAS v4u*)(wl + (bf) * 4096 + row * 128 + ((lch ^ (row & 7)) * 16)) = KR[it]; *(LAS v4u*)(wl + 8192 + (bf) * 4096 + row * 128 + lch * 16) = VR[it]; } if (lane < 32) bl[(bf) * 32 + lane] = -L2E * BR; } while (0)
    v4u krA[4], vrA[4], krB[4], vrB[4]; float brA = 0.f, brB = 0.f;
    const int kq = (lane >> 4) & 1, q_ = (lane & 15) >> 2, p_ = lane & 3;
    FOX_LOAD(krA, vrA, brA, tstart);
    if (tstart + 1 < ntiles) FOX_LOAD(krB, vrB, brB, tstart + 1);
    FOX_STORE(krA, vrA, brA, 0);
    auto compute = [&](int t, int buf) {
        const LAS unsigned char* kb = wl + buf * 4096; const LAS unsigned char* vb = wl + 8192 + buf * 4096; const LAS float* bb = bl + buf * 32;
        f32x16 p;
#pragma unroll
        for (int r = 0; r < 16; ++r) p[r] = 0.f;
#pragma unroll
        for (int ks = 0; ks < 4; ++ks) { const bf16x8 kf = *(const LAS bf16x8*)(kb + r32 * 128 + (((2 * ks + hi) ^ (r32 & 7)) * 16)); p = __builtin_amdgcn_mfma_f32_32x32x16_bf16(kf, qr[ks], p, 0, 0, 0); }
#pragma unroll
        for (int g = 0; g < 4; ++g) { const f32x4 c4 = *(const LAS f32x4*)(bb + 8 * g + 4 * hi);
#pragma unroll
            for (int jj = 0; jj < 4; ++jj) p[4 * g + jj] += c4[jj]; }
        if (t == ntiles - 1) {
#pragma unroll
            for (int r = 0; r < 16; ++r) if (32 * t + crow(r, hi) > qlocal) p[r] = -INFINITY;
        }
        float mt = p[0];
#pragma unroll
        for (int r = 1; r < 16; ++r) mt = fmaxf(mt, p[r]);
        mt = fmaxf(mt, __shfl_xor(mt, 32));
        const float mn = fmaxf(m, mt); const float alpha = __builtin_amdgcn_exp2f(m - mn); m = mn;
        l *= alpha;
#pragma unroll
        for (int d0 = 0; d0 < 2; ++d0)
#pragma unroll
            for (int r = 0; r < 16; ++r) o[d0][r] *= alpha;
        float ls = 0.f;
#pragma unroll
        for (int r = 0; r < 16; ++r) { p[r] = __builtin_amdgcn_exp2f(p[r] - mn); ls += p[r]; }
        l += ls;
        bf16x8 pa[2];
#pragma unroll
        for (int s2 = 0; s2 < 2; ++s2) { v4u w; w.x = cvtpk(p[8 * s2 + 0], p[8 * s2 + 1]); w.y = cvtpk(p[8 * s2 + 2], p[8 * s2 + 3]); w.z = cvtpk(p[8 * s2 + 4], p[8 * s2 + 5]); w.w = cvtpk(p[8 * s2 + 6], p[8 * s2 + 7]); pa[s2] = __builtin_bit_cast(bf16x8, w); }
#pragma unroll
        for (int d0 = 0; d0 < 2; ++d0)
#pragma unroll
            for (int s2 = 0; s2 < 2; ++s2) {
                const LAS unsigned char* a1 = vb + (16 * s2 + 4 * hi + q_) * 128 + (32 * d0 + 16 * kq + 4 * p_) * 2;
                const v4i16_t lo4 = __builtin_amdgcn_ds_read_tr16_b64_v4i16((LAS v4i16_t*)a1), hi4 = __builtin_amdgcn_ds_read_tr16_b64_v4i16((LAS v4i16_t*)(a1 + 8 * 128));
                const bf16x8 vf = (bf16x8){lo4[0], lo4[1], lo4[2], lo4[3], hi4[0], hi4[1], hi4[2], hi4[3]};
                o[d0] = __builtin_amdgcn_mfma_f32_32x32x16_bf16(vf, pa[s2], o[d0], 0, 0, 0);
            }
    };
    for (int t = tstart; t < ntiles; t += 2) {
        if (t + 2 < ntiles) FOX_LOAD(krA, vrA, brA, t + 2);
        compute(t, 0);
        if (t + 1 < ntiles) {
            FOX_STORE(krB, vrB, brB, 1);
            if (t + 3 < ntiles) FOX_LOAD(krB, vrB, brB, t + 3);
            compute(t + 1, 1);
            if (t + 2 < ntiles) FOX_STORE(krA, vrA, brA, 0);
        }
    }
#undef FOX_LOAD
#undef FOX_STORE
    l += __shfl_xor(l, 32);
    const float inv = 1.0f / l;
    bf16* orow = Ow + (size_t)r32 * 512;
#pragma unroll
    for (int d0 = 0; d0 < 2; ++d0)
#pragma unroll
        for (int g = 0; g < 4; ++g) { u32x2 w; w.x = cvtpk(o[d0][4 * g] * inv, o[d0][4 * g + 1] * inv); w.y = cvtpk(o[d0][4 * g + 2] * inv, o[d0][4 * g + 3] * inv);
            *(u32x2*)(orow + d0 * 32 + 8 * g + 4 * hi) = w; }
}
__device__ __forceinline__ void fox_unit4(int bh, int qb, const bf16* FQ, const bf16* FK, const bf16* FV, const float* CUM, const int* T0, const float* gq, const float* gk, bf16* OA, LAS unsigned char* lds, int wave, int lane) {
    const int b = bh >> 3, h = bh & 7, r32 = lane & 31, hi = lane >> 5; const size_t rowbase = (size_t)b * SEQ; const int q0 = qb * 256 + wave * 32;
    const bf16* Qw = FQ + (rowbase + q0) * 512 + h * 64; bf16* Ow = OA + (rowbase + q0) * 512 + h * 64;
    const bf16* Kp = FK + rowbase * 512 + h * 64; const bf16* Vp = FV + rowbase * 512 + h * 64; const float* cb = CUM + (size_t)bh * SEQ;
    LAS unsigned char* wl = lds + wave * 16384;
    LAS float* bl = (LAS float*)(lds + RING_BYTES + 8192 + wave * 256);
    bf16x8 qr[4];
#pragma unroll
    for (int ks = 0; ks < 4; ++ks) qr[ks] = *(const bf16x8*)(Qw + (size_t)r32 * 512 + ks * 16 + hi * 8);
    const int tstart = T0[bh * 256 + q0 / 32], tlast = q0 / 32, nseq = tlast - tstart + 1, qlocal = q0 + r32;
    const float stopc = (8.0f * wave_max(fabsf(gq[lane])) * wave_max(fabsf(gk[lane])) + 30.0f) * L2E;
    f32x16 o[2];
#pragma unroll
    for (int d0 = 0; d0 < 2; ++d0)
#pragma unroll
        for (int r = 0; r < 16; ++r) o[d0][r] = 0.f;
    float m = -1e30f, l = 0.f;
    const int lrow = lane >> 3, lch = lane & 7;
#define FOX_LOAD(KR, VR, BR, tt) do { _Pragma("unroll") for (int it = 0; it < 4; ++it) { const size_t ro = (size_t)(32 * (tt) + 8 * it + lrow) * 512 + lch * 8; KR[it] = *(const v4u*)(Kp + ro); VR[it] = *(const v4u*)(Vp + ro); } BR = cb[32 * (tt) + r32]; } while (0)
#define FOX_STORE(KR, VR, BR, bf) do { _Pragma("unroll") for (int it = 0; it < 4; ++it) { const int row = 8 * it + lrow; *(LAS v4u*)(wl + (bf) * 4096 + row * 128 + ((lch ^ (row & 7)) * 16)) = KR[it]; *(LAS v4u*)(wl + 8192 + (bf) * 4096 + row * 128 + lch * 16) = VR[it]; } if (lane < 32) bl[(bf) * 32 + lane] = -L2E * BR; } while (0)
    v4u krA[4], vrA[4], krB[4], vrB[4]; float brA = 0.f, brB = 0.f;
    const int kq = (lane >> 4) & 1, q_ = (lane & 15) >> 2, p_ = lane & 3;
    FOX_LOAD(krA, vrA, brA, tlast);
    if (1 < nseq) FOX_LOAD(krB, vrB, brB, tlast - 1);
    FOX_STORE(krA, vrA, brA, 0);
    auto compute = [&](int t, int buf) -> bool {
        const LAS unsigned char* kb = wl + buf * 4096; const LAS unsigned char* vb = wl + 8192 + buf * 4096; const LAS float* bb = bl + buf * 32;
        if (t != tlast) { const float bmax = bb[31]; if (__all(m > bmax + stopc)) return true; }
        f32x16 p;
#pragma unroll
        for (int r = 0; r < 16; ++r) p[r] = 0.f;
#pragma unroll
        for (int ks = 0; ks < 4; ++ks) { const bf16x8 kf = *(const LAS bf16x8*)(kb + r32 * 128 + (((2 * ks + hi) ^ (r32 & 7)) * 16)); p = __builtin_amdgcn_mfma_f32_32x32x16_bf16(kf, qr[ks], p, 0, 0, 0); }
#pragma unroll
        for (int g = 0; g < 4; ++g) { const f32x4 c4 = *(const LAS f32x4*)(bb + 8 * g + 4 * hi);
#pragma unroll
            for (int jj = 0; jj < 4; ++jj) p[4 * g + jj] += c4[jj]; }
        if (t == tlast) {
#pragma unroll
            for (int r = 0; r < 16; ++r) if (32 * t + crow(r, hi) > qlocal) p[r] = -INFINITY;
        }
        float mt = p[0];
#pragma unroll
        for (int r = 1; r < 16; ++r) mt = fmaxf(mt, p[r]);
        mt = fmaxf(mt, __shfl_xor(mt, 32));
        if (__any(mt > m)) {
            const float mn = fmaxf(m, mt); const float alpha = __builtin_amdgcn_exp2f(m - mn); m = mn;
            l *= alpha;
#pragma unroll
            for (int d0 = 0; d0 < 2; ++d0)
#pragma unroll
                for (int r = 0; r < 16; ++r) o[d0][r] *= alpha;
        }
        const float mn = m;
        float ls = 0.f;
#pragma unroll
        for (int r = 0; r < 16; ++r) { p[r] = __builtin_amdgcn_exp2f(p[r] - mn); ls += p[r]; }
        l += ls;
        bf16x8 pa[2];
#pragma unroll
        for (int s2 = 0; s2 < 2; ++s2) { v4u w; w.x = cvtpk(p[8 * s2 + 0], p[8 * s2 + 1]); w.y = cvtpk(p[8 * s2 + 2], p[8 * s2 + 3]); w.z = cvtpk(p[8 * s2 + 4], p[8 * s2 + 5]); w.w = cvtpk(p[8 * s2 + 6], p[8 * s2 + 7]); pa[s2] = __builtin_bit_cast(bf16x8, w); }
#pragma unroll
        for (int d0 = 0; d0 < 2; ++d0)
#pragma unroll
            for (int s2 = 0; s2 < 2; ++s2) {
                const LAS unsigned char* a1 = vb + (16 * s2 + 4 * hi + q_) * 128 + (32 * d0 + 16 * kq + 4 * p_) * 2;
                const v4i16_t lo4 = __builtin_amdgcn_ds_read_tr16_b64_v4i16((LAS v4i16_t*)a1), hi4 = __builtin_amdgcn_ds_read_tr16_b64_v4i16((LAS v4i16_t*)(a1 + 8 * 128));
                const bf16x8 vf = (bf16x8){lo4[0], lo4[1], lo4[2], lo4[3], hi4[0], hi4[1], hi4[2], hi4[3]};
                o[d0] = __builtin_amdgcn_mfma_f32_32x32x16_bf16(vf, pa[s2], o[d0], 0, 0, 0);
            }
        return false;
    };
    for (int i = 0; i < nseq; i += 2) {
        if (i + 2 < nseq) FOX_LOAD(krA, vrA, brA, tlast - (i + 2));
        if (compute(tlast - i, 0)) break;
        if (i + 1 < nseq) {
            FOX_STORE(krB, vrB, brB, 1);
            if (i + 3 < nseq) FOX_LOAD(krB, vrB, brB, tlast - (i + 3));
            if (compute(tlast - (i + 1), 1)) break;
            if (i + 2 < nseq) FOX_STORE(krA, vrA, brA, 0);
        }
    }
#undef FOX_LOAD
#undef FOX_STORE
    l += __shfl_xor(l, 32);
    const float inv = 1.0f / l;
    bf16* orow = Ow + (size_t)r32 * 512;
#pragma unroll
    for (int d0 = 0; d0 < 2; ++d0)
#pragma unroll
        for (int g = 0; g < 4; ++g) { u32x2 w; w.x = cvtpk(o[d0][4 * g] * inv, o[d0][4 * g + 1] * inv); w.y = cvtpk(o[d0][4 * g + 2] * inv, o[d0][4 * g + 3] * inv);
            *(u32x2*)(orow + d0 * 32 + 8 * g + 4 * hi) = w; }
}
#ifndef DBG_BRANCH_MASK
#define DBG_BRANCH_MASK 7
#endif
#ifndef DBG_NBR
#define DBG_NBR 3
#endif
#ifndef DBG_NOGATE
#define DBG_NOGATE 0
#endif
#ifndef DBG_NOBRANCH
#define DBG_NOBRANCH 0
#endif
#ifndef DBG_GATE_W
#define DBG_GATE_W WS_WGATE
#endif
#ifndef DBG_GATE_AS_BRANCH
#define DBG_GATE_AS_BRANCH 0
#endif
#ifndef REP_FOX
#define REP_FOX 1
#endif
#ifndef REP_DSA
#define REP_DSA 1
#endif
#ifndef REP_GEMM
#define REP_GEMM 1
#endif
#ifndef DBG_SUBST
#define DBG_SUBST 0
#endif
#ifndef P7SEL
#define P7SEL 3
#endif
#ifndef PHMASK
#define PHMASK 0xFFFF
#endif
struct Args { const void* in[24]; float* out; unsigned char* ws; };
#define CONVERT_GROUP(GRP, w_, nw_) do { \
    constexpr int I_GU = 16 * 176, I_D = 44 * 32, I_IN = 16 * 104, I_GT = 16 * 96, I_BR = 8 * 32, I_SQ = 16 * 32; \
    constexpr int NIT = (GRP) == 0 ? I_GU + I_SQ : (GRP) == 1 ? I_D + I_IN + I_GT + 3 * I_BR + I_SQ : I_GU + I_D; \
    LAS float* scr_ = (LAS float*)(L + RING_OFF + wave * 16384); \
    for (int it = (w_); it < NIT; it += (nw_)) { int r = it; \
        if ((GRP) == 0) { \
            if (r < I_GU) { transpose_item<true>(0, ARG_IN(4), ARG_IN(5), 1024, DFF, ARG_IN(3), WSP(bf16, WS_WGU1), scr_, r, 176, lane); continue; } r -= I_GU; \
            transpose_item<true>(1, ARG_IN(17), nullptr, 1024, 1024, ARG_IN(8), WSP(bf16, WS_WMKV), scr_, r, 32, lane); \
        } else if ((GRP) == 1) { \
            if (r < I_D) { transpose_item<false>(1, ARG_IN(6), nullptr, DFF, 1024, nullptr, WSP(bf16, WS_WD1), scr_, r, 32, lane); continue; } r -= I_D; \
            if (r < I_IN) { transpose_item<true>(2, ARG_IN(9), nullptr, 1024, DIN, ARG_IN(7), WSP(bf16, WS_WIN), scr_, r, 104, lane); continue; } r -= I_IN; \
            if (r < I_GT) { transpose_item<true>(3, ARG_IN(9), nullptr, 1024, DIN, ARG_IN(7), WSP(bf16, WS_WGATE), scr_, r, 96, lane); continue; } r -= I_GT; \
            if (r < 3 * I_BR) { const int i = r / I_BR; transpose_item<false>(1, ARG_IN(18) + (size_t)i * 512 * 1024, nullptr, 512, 1024, nullptr, WSP(bf16, WS_WBR) + (size_t)i * 1024 * 512, scr_, r % I_BR, 32, lane); continue; } r -= 3 * I_BR; \
            transpose_item<false>(1, ARG_IN(19), nullptr, 1024, 1024, nullptr, WSP(bf16, WS_WOUT), scr_, r, 32, lane); \
        } else { \
            if (r < I_GU) { transpose_item<true>(0, ARG_IN(21), ARG_IN(22), 1024, DFF, ARG_IN(20), WSP(bf16, WS_WGU2), scr_, r, 176, lane); continue; } r -= I_GU; \
            transpose_item<false>(1, ARG_IN(23), nullptr, DFF, 1024, nullptr, WSP(bf16, WS_WD2), scr_, r, 32, lane); \
        } } } while (0)
__global__ void __launch_bounds__(NWAVES * 64, 2) fwd_mega(Args args) {
    extern __shared__ __attribute__((aligned(16))) unsigned char lds[];
    LAS unsigned char* L = (LAS unsigned char*)lds;
    volatile LAS unsigned* MISC = (volatile LAS unsigned*)(L + MISC_OFF);
    const int tid = threadIdx.x, lane = tid & 63, wave = __builtin_amdgcn_readfirstlane(tid >> 6);
    const int G = gridDim.x; const int bx = blockIdx.x; const int vcu = (G % 8 == 0) ? (bx % 8) * (G / 8) + bx / 8 : bx;
    const Args* ap = (const Args*)__builtin_amdgcn_kernarg_segment_ptr();
#define ARG_IN(k) ((const float*)ap->in[k])
#define WSP(type, off) ((type*)(ap->ws + (off)))
    gu32* ctl = (gu32*)(ap->ws + WS_CTL);
    for (int u = tid; u < (LDS_BYTES - LDSCTL_OFF) / 4; u += NWAVES * 64) ((LAS unsigned*)(L + LDSCTL_OFF))[u] = 0u;
    __syncthreads();
    XcdBarrier bar = xcd_barrier_post((unsigned*)(ctl + CW_BAR), MISC + 8);
#define GRID_BAR() xcd_barrier(bar)
    const int gw = vcu * NWAVES + wave, NGW = G * NWAVES;

#if (PHMASK >> 0) & 1
    {
        LAS float* scr = (LAS float*)(L + RING_OFF + wave * 16384);
        CONVERT_GROUP(0, gw, NGW);
        for (int m0 = gw; m0 < T + 512; m0 += 4 * NGW) {
            const float* xr[4]; bf16* orw[4]; float* ro[4]; bool ok[4];
#pragma unroll
            for (int r = 0; r < 4; ++r) { const int m = m0 + r * NGW; ok[r] = m < T + 512; const int mc = ok[r] ? m : gw;
                if (mc < T) { xr[r] = ARG_IN(0) + (size_t)mc * 1024; orw[r] = WSP(bf16, WS_HB) + (size_t)mc * 1024; ro[r] = WSP(float, WS_RSTDX) + mc; }
                else { xr[r] = ARG_IN(1) + (size_t)(mc - T) * 1024; orw[r] = WSP(bf16, WS_MEMB) + (size_t)(mc - T) * 1024; ro[r] = WSP(float, WS_RSTDM) + (mc - T); } }
            rows4_to_bf16_rstd(xr, orw, ro, ok, lane);
        }
        VM_WAIT(); __syncthreads();
        GRID_BAR();
    }
#endif
#if (PHMASK >> 1) & 1
    {
        if (bx >= G - 8) { pg8::Gemm g{WSP(bf16, WS_MEMB), WSP(bf16, WS_WMKV), 512, 1024, 1024}; pg8::StaticOrder S; S.init(512, 1024, G, bx - (G - 8));
        pg8::EpiMemKV E{WSP(float, WS_KVM), WSP(float, WS_RSTDM)};
        pg8::gemm_phase<pg8::EpiMemKV, pg8::StaticOrder, true, true>(L + RING_OFF, g, S, E); }
    }
#endif
#if (PHMASK >> 2) & 1
    {
        pg8::Gemm g{WSP(bf16, WS_HB), WSP(bf16, WS_WGU1), T, 2 * DFF, 1024}; pg8::StaticOrder S; S.init(T, 2 * DFF, G, bx);
        pg8::build_row_tab<0>(WSP(float, WS_RSTDX), S, (LAS float*)(L + RING_BYTES + 1024)); pg8::EpiSwiGLU<0> E{WSP(bf16, WS_HID), DFF, (LAS float*)(L + RING_BYTES + 1024)};
#pragma unroll 1
        for (int rep_ = 0; rep_ < REP_GEMM; ++rep_)
        pg8::gemm_phase<pg8::EpiSwiGLU<0>, pg8::StaticOrder, true, true>(L + RING_OFF, g, S, E);
        {
            const int nfull = (64 * 22) % G; const int nidle = (nfull == 0) ? G : G - nfull; const int first = G - nidle;
            if (bx >= first) { CONVERT_GROUP(1, (bx - first) * NWAVES + wave, nidle * NWAVES);
                for (int e = (bx - first) * NWAVES * 64 + tid; e < T * 32; e += nidle * NWAVES * 64) {
                    const int row = e >> 5, i = e & 31; const float inv_freq = powf(10000.0f, -(float)i * (1.0f / 32.0f));
                    const float ang = (float)((const int*)ap->in[2])[row] * inv_freq; float sn, cs; sincosf(ang, &sn, &cs); WSP(float, WS_COS)[e] = cs; WSP(float, WS_SIN)[e] = sn; } }
        }
        GRID_BAR();
    }
#endif
#if (PHMASK >> 3) & 1
    {
        pg8::Gemm g{WSP(bf16, WS_HID), WSP(bf16, WS_WD1), T, 1024, DFF}; pg8::StaticOrder S; S.init(T, 1024, G, bx);
        pg8::EpiResid2<true> E{ARG_IN(0), ap->out, WSP(bf16, WS_HB), WSP(float, WS_SSQ1), 0.5f};
#pragma unroll 1
        for (int rep_ = 0; rep_ < REP_GEMM; ++rep_)
        pg8::gemm_phase<pg8::EpiResid2<true>, pg8::StaticOrder, true, true>(L + RING_OFF, g, S, E);
        GRID_BAR();
    }
#endif
#if (PHMASK >> 4) & 1
    {
        pg8::Gemm g{WSP(bf16, WS_HB), WSP(bf16, WS_WIN), T, NPROJ, 1024}; pg8::StaticOrder S; S.init(T, NPROJ, G, bx);
        pg8::ProjOut PO{WSP(bf16, WS_FQ), WSP(bf16, WS_FK), WSP(bf16, WS_FV), WSP(bf16, WS_DQ), WSP(bf16, WS_IQ), WSP(bf16, WS_MQ), WSP(bf16, WS_DK), WSP(bf16, WS_DV), WSP(bf16, WS_IK), WSP(float, WS_LOGF), WSP(float, WS_IW), WSP(float, WS_COS), WSP(float, WS_SIN), ARG_IN(11), ARG_IN(12), ARG_IN(13), ARG_IN(14), ARG_IN(10)};
        pg8::build_row_tab<16>(WSP(float, WS_SSQ1), S, (LAS float*)(L + RING_BYTES + 1024)); pg8::EpiProj<16> E{PO, (LAS float*)(L + RING_BYTES + 1024), C2_64};
#pragma unroll 1
        for (int rep_ = 0; rep_ < REP_GEMM; ++rep_)
        pg8::gemm_phase<pg8::EpiProj<16>, pg8::StaticOrder, true, true>(L + RING_OFF, g, S, E);
        {
            const int nfull = (64 * 13) % G; const int nidle = (nfull == 0) ? G : G - nfull; const int first = G - nidle;
            if (bx >= first) { CONVERT_GROUP(2, (bx - first) * NWAVES + wave, nidle * NWAVES);
        for (int it = (bx - first) * NWAVES + wave; it < 2048; it += nidle * NWAVES) { const int row = it >> 2, h = it & 3;
                    const f32x2g kv = *(const f32x2g*)(WSP(float, WS_KVM) + (size_t)row * 1024 + h * 128 + 2 * lane); const f32x2g vv = *(const f32x2g*)(WSP(float, WS_KVM) + (size_t)row * 1024 + 512 + h * 128 + 2 * lane);
                    const float ss = wave_sum(kv.x * kv.x + kv.y * kv.y); const float rstd = 1.0f / sqrtf(ss * (1.0f / 128.0f) + 1e-6f);
                    const f32x2g gk = *(const f32x2g*)(ARG_IN(16) + 2 * lane);
                    *(unsigned*)(WSP(bf16, WS_KMB) + (size_t)row * 512 + h * 128 + 2 * lane) = pk2(kv.x * rstd * gk.x, kv.y * rstd * gk.y);
                    { const int bb = row >> 8, key = row & 255; bf16* vt = WSP(bf16, WS_VMB) + ((size_t)(bb * 4 + h) * 128 + 2 * lane) * MEMLEN + key; vt[0] = (bf16)f2bf(vv.x); vt[MEMLEN] = (bf16)f2bf(vv.y); } } }
        }
        GRID_BAR();
#if defined(DBG_DUMP_AFTER) && DBG_DUMP_AFTER == 4
        {
            const bf16* sa = WSP(bf16, DBG_DUMP_A); const bf16* sb = WSP(bf16, DBG_DUMP_B);
            for (size_t e = (size_t)vcu * 512 + tid; e < (size_t)T * 512; e += (size_t)G * 512) { const size_t row = e >> 9, c = e & 511;
                ap->out[row * 1024 + c] = bf2f(sa[row * DBG_PITCH + c]); ap->out[row * 1024 + 512 + c] = bf2f(sb[row * DBG_PITCH + c]); }
            return;
        }
#endif

    }
#endif
#if ((PHMASK >> 5) & 1) && !DBG_SUBST
    {
        for (int it = gw; it < 2048; it += NGW) mem_unit(it >> 2, it & 3, WSP(bf16, WS_MQ), WSP(bf16, WS_KMB), WSP(bf16, WS_VMB), ARG_IN(15), lane);
    }
#endif
#if ((PHMASK >> 6) & 1) && !DBG_SUBST
    {
        for (int rep_ = 0; rep_ < REP_FOX; ++rep_)
        for (int v = vcu; v < 256; v += G) { const int bh = v >> 4, s = v & 15;
            scan_unit(bh, WSP(float, WS_LOGF), WSP(float, WS_CUM), WSP(int, WS_T0), ARG_IN(11), ARG_IN(12), (LAS float*)(L + SCANX_OFF), (LAS float*)(L + RING_OFF), tid);
            asm volatile("s_waitcnt vmcnt(0)" ::: "memory"); __syncthreads();
            fox_unit4(bh, s, WSP(bf16, WS_FQ), WSP(bf16, WS_FK), WSP(bf16, WS_FV), WSP(float, WS_CUM), WSP(int, WS_T0), ARG_IN(11), ARG_IN(12), WSP(bf16, WS_OA), L, wave, lane); fox_unit4(bh, 31 - s, WSP(bf16, WS_FQ), WSP(bf16, WS_FK), WSP(bf16, WS_FV), WSP(float, WS_CUM), WSP(int, WS_T0), ARG_IN(11), ARG_IN(12), WSP(bf16, WS_OA), L, wave, lane); }
        __syncthreads();
        {
            gu32* qctr = ctl + CW_Q; LAS int* QW = (LAS int*)(L + D3_QW);
            const int pref = (vcu >> 5) & 1;
            unsigned raw = 0u; int cur;
            if (tid == 0) { unsigned u = __hip_atomic_fetch_add(qctr + 64 * pref, 1u, RLX_AGENT); int bsel = pref; if (u >= 512u) { bsel = pref ^ 1; u = __hip_atomic_fetch_add(qctr + 64 * bsel, 1u, RLX_AGENT); } QW[0] = (u < 512u) ? ((bsel << 16) | (int)u) : -1; }
            __syncthreads(); cur = QW[0]; __syncthreads();
            while (cur >= 0) {
                if (tid == 0) raw = __hip_atomic_fetch_add(qctr + 64 * pref, 1u, RLX_AGENT);
                dsa3_unit(cur >> 16, 511 - (cur & 0xffff), WSP(bf16, WS_IQ), WSP(bf16, WS_IK), WSP(float, WS_IW), WSP(bf16, WS_DQ), WSP(bf16, WS_DK), WSP(bf16, WS_DV), WSP(bf16, WS_OB), L, wave, lane);
                if (tid == 0) { unsigned u = raw; int bsel = pref; if (u >= 512u) { bsel = pref ^ 1; u = __hip_atomic_fetch_add(qctr + 64 * bsel, 1u, RLX_AGENT); } QW[0] = (u < 512u) ? ((bsel << 16) | (int)u) : -1; }
                __syncthreads(); cur = QW[0]; __syncthreads();
            }
        }
        GRID_BAR();
    }
#endif
#if (PHMASK >> 7) & 1
    {
        pg8::StaticOrder S; S.init(T, 1024, G, bx); pg8::build_row_tab<16>(WSP(float, WS_SSQ1), S, (LAS float*)(L + RING_BYTES + 1024));
#ifndef P7STREAM
#define P7STREAM 1
#endif
#if P7STREAM
        {   typedef pg8::P7Order<WS_HB, WS_WGATE, WS_OA, WS_OB, WS_MQ, WS_WBR> P7O; P7O O{S, (const char*)WSP(char, 0)};
            pg8::EpiP7 E{WSP(bf16, WS_GSCR), WSP(bf16, WS_MERGED), (LAS float*)(L + RING_BYTES + 1024)};
#ifndef REP_P7
#define REP_P7 1
#endif
#pragma unroll 1
            for (int rep7_ = 0; rep7_ < REP_P7; ++rep7_) pg8::gemm_stream<pg8::EpiP7, P7O>(L + RING_OFF, O, E); }
#pragma unroll 1
        for (int i = 0; i < 0; ++i) {
#else
#pragma unroll 1
        for (int rep_ = 0; rep_ < REP_GEMM; ++rep_)
#pragma unroll 1
        for (int i = 0; i < DBG_NBR; ++i) {
#endif
#if DBG_GATE_AS_BRANCH
            {   pg8::Gemm g{WSP(bf16, WS_HB), WSP(bf16, DBG_GATE_W), T, 1024, 1024}; pg8::EpiBranch E{WSP(bf16, WS_GSCR), WSP(bf16, WS_MERGED), true, 1.0f}; pg8::gemm_phase<pg8::EpiBranch, pg8::StaticOrder, true, true>(L + RING_OFF, g, S, E); }
#elif !DBG_NOGATE
            {   pg8::Gemm g{WSP(bf16, WS_HB), WSP(bf16, DBG_GATE_W) + (size_t)i * 1024 * 1024, T, 1024, 1024}; pg8::EpiGate<16> E{WSP(bf16, WS_GSCR), (LAS float*)(L + RING_BYTES + 1024)}; pg8::gemm_phase<pg8::EpiGate<16>, pg8::StaticOrder, true, true>(L + RING_OFF, g, S, E); }
#endif
#if !DBG_NOBRANCH
#if DBG_SUBST == 1
            {   const bf16* A = (i == 0) ? WSP(bf16, WS_FQ) : (i == 1) ? WSP(bf16, WS_DQ) : WSP(bf16, WS_IQ);
#elif DBG_SUBST == 2
            {   const bf16* A = (i == 0) ? WSP(bf16, WS_FK) : (i == 1) ? WSP(bf16, WS_FV) : WSP(bf16, WS_MQ);
#else
            {   const bf16* A = (i == 0) ? WSP(bf16, WS_OA) : (i == 1) ? WSP(bf16, WS_OB) : WSP(bf16, WS_MQ);
#endif
                pg8::Gemm g{A, WSP(bf16, WS_WBR) + (size_t)i * 1024 * 512, T, 1024, 512}; pg8::EpiBranch E{WSP(bf16, WS_GSCR), WSP(bf16, WS_MERGED), i == 0, ((DBG_BRANCH_MASK >> i) & 1) ? 1.0f : 0.0f}; pg8::gemm_phase<pg8::EpiBranch, pg8::StaticOrder, true, true>(L + RING_OFF, g, S, E); }
#endif
        }
        GRID_BAR();
#if defined(DBG_DUMP_AFTER) && DBG_DUMP_AFTER == 7
        {
            const bf16* sa = WSP(bf16, DBG_DUMP_A); const bf16* sb = WSP(bf16, DBG_DUMP_B);
            for (size_t e = (size_t)vcu * 512 + tid; e < (size_t)T * 512; e += (size_t)G * 512) { const size_t row = e >> 9, c = e & 511;
                ap->out[row * 1024 + c] = bf2f(sa[row * DBG_PITCH + c]); ap->out[row * 1024 + 512 + c] = bf2f(sb[row * DBG_PITCH + c]); }
            return;
        }
#endif

    }
#endif
#if (PHMASK >> 8) & 1
    {
        pg8::Gemm g{WSP(bf16, WS_MERGED), WSP(bf16, WS_WOUT), T, 1024, 1024}; pg8::StaticOrder S; S.init(T, 1024, G, bx);
        pg8::EpiResid2<true> E{ap->out, ap->out, WSP(bf16, WS_HB), WSP(float, WS_SSQ2), 1.0f};
        pg8::gemm_phase<pg8::EpiResid2<true>, pg8::StaticOrder, true, true>(L + RING_OFF, g, S, E);
        GRID_BAR();
    }
#endif
#if (PHMASK >> 9) & 1
    {
        pg8::Gemm g{WSP(bf16, WS_HB), WSP(bf16, WS_WGU2), T, 2 * DFF, 1024}; pg8::StaticOrder S; S.init(T, 2 * DFF, G, bx);
        pg8::build_row_tab<16>(WSP(float, WS_SSQ2), S, (LAS float*)(L + RING_BYTES + 1024)); pg8::EpiSwiGLU<16> E{WSP(bf16, WS_HID), DFF, (LAS float*)(L + RING_BYTES + 1024)};
#pragma unroll 1
        for (int rep_ = 0; rep_ < REP_GEMM; ++rep_)
        pg8::gemm_phase<pg8::EpiSwiGLU<16>, pg8::StaticOrder, true, true>(L + RING_OFF, g, S, E);
        GRID_BAR();
    }
#endif
#if (PHMASK >> 10) & 1
    {
        pg8::Gemm g{WSP(bf16, WS_HID), WSP(bf16, WS_WD2), T, 1024, DFF}; pg8::StaticOrder S; S.init(T, 1024, G, bx);
        pg8::EpiResid2<false> E{ap->out, ap->out, nullptr, nullptr, 0.5f};
        pg8::gemm_phase<pg8::EpiResid2<false>, pg8::StaticOrder, true, true>(L + RING_OFF, g, S, E);
    }
#endif
}

extern "C" void kernel_launch(void* const* d_in, const int* in_sizes, int n_in, void* d_out, int out_size, void* d_ws, size_t ws_size, hipStream_t stream) {
    static int grid = 0;
    if (grid == 0) {
        if (n_in != 24 || out_size != T * DM || ws_size < WS_END) { fprintf(stderr, "kernel_launch: unexpected problem (n_in %d, out %d, ws %zu)\n", n_in, out_size, ws_size); grid = -1; return; }
        int dev = 0, cus = 0, per_cu = 0;
        if (hipGetDevice(&dev) != hipSuccess || hipDeviceGetAttribute(&cus, hipDeviceAttributeMultiprocessorCount, dev) != hipSuccess) { grid = -1; return; }
        if (hipFuncSetAttribute((const void*)fwd_mega, hipFuncAttributeMaxDynamicSharedMemorySize, LDS_BYTES) != hipSuccess) { fprintf(stderr, "kernel_launch: hipFuncSetAttribute failed\n"); grid = -1; return; }
        if (hipOccupancyMaxActiveBlocksPerMultiprocessor(&per_cu, (const void*)fwd_mega, NWAVES * 64, LDS_BYTES) != hipSuccess || per_cu < 1) { fprintf(stderr, "kernel_launch: occupancy query says %d blocks per CU\n", per_cu); (void)hipGetLastError(); grid = -1; return; }
        grid = cus;
    }
    if (grid < 0) return;
    (void)hipMemsetAsync((char*)d_ws + WS_CTL, 0, CTL_ZERO_BYTES, stream);
    Args a{};
    for (int i = 0; i < 24; ++i) a.in[i] = d_in[i];
    a.out = (float*)d_out; a.ws = (unsigned char*)d_ws;
    hipLaunchKernelGGL(fwd_mega, dim3(grid), dim3(NWAVES * 64), LDS_BYTES, stream, a);
}
```

```cpp
#include <hip/hip_runtime.h>
#include <cstdio>
#include <cstdint>
namespace pg8 {
#define PG8_LAS __attribute__((address_space(3)))
typedef unsigned short bf16_t;
typedef short bf16x8 __attribute__((ext_vector_type(8)));
typedef float f32x4 __attribute__((ext_vector_type(4)));
typedef unsigned u32x4 __attribute__((ext_vector_type(4)));
constexpr int BM = 256, BK = 64, HALF = 128, HTB = HALF * BK * 2  , STAGE_BYTES = 8 * HTB, NXCD = 8, WGM = 8;

__host__ __device__ __forceinline__ int lds_byte(int r, int c) { const int st = (r >> 4) * 2 + (c >> 5), rr = r & 15, cc = c & 31, ob = rr * 64 + cc * 2; return st * 1024 + (ob ^ (((ob >> 9) & 1) << 5)); }
__host__ __device__ __forceinline__ void stage_rc(int b, int& R, int& C) { const int st = b / 1024, sb = b % 1024, swz = sb ^ (((sb >> 9) & 1) << 5); R = (st >> 1) * 16 + swz / 64; C = (st & 1) * 32 + (swz % 64) / 2; }
__host__ __device__ __forceinline__ int perm32(int rho) { const int n = rho >> 4, i = rho & 15; return 8 * (i >> 2) + 4 * n + (i & 3); }

struct Unit { int pm, pn; };
struct Gemm { const bf16_t* A; const bf16_t* Bt; int M, N, K; };

struct StaticOrder {
    int nM, nN, nwg, G, c;
    __host__ __device__ void init(int M, int N, int G_, int c_) { nM = M / BM; nN = N / BM; nwg = nM * nN; G = G_; c = c_; }
    __host__ __device__ bool next(int i, Unit& u) const {
        const long L = (long)i * G + c; if (L >= nwg) return false;
        int wgid = (int)L; { const int q = nwg / NXCD, r = nwg % NXCD, xcd = wgid % NXCD, off = wgid / NXCD; wgid = (xcd < r ? xcd * (q + 1) : r * (q + 1) + (xcd - r) * q) + off; }
        const int nig = WGM * nN, gid = wgid / nig, fm = gid * WGM, gsz = (nM - fm) < WGM ? (nM - fm) : WGM;
        u.pm = fm + ((wgid % nig) % gsz); u.pn = (wgid % nig) / gsz; return true;
    }
    __device__ __forceinline__ void a_ready(const Unit&) const {}
    __device__ __forceinline__ void done(const Unit&) const {}
};

typedef float f32x2cv __attribute__((ext_vector_type(2))); typedef __bf16 bf16x2cv __attribute__((ext_vector_type(2)));
__device__ __forceinline__ unsigned cvt_pk_bf16(float lo, float hi) { const f32x2cv v = {lo, hi}; const bf16x2cv b = __builtin_convertvector(v, bf16x2cv); return __builtin_bit_cast(unsigned, b); }
typedef float f32x2 __attribute__((ext_vector_type(2)));
template <class Epi, class Sched, bool ALIGN_EPI = false, bool SP2 = false>
__device__ __forceinline__ void gemm_phase(PG8_LAS unsigned char* lds, const Gemm g, const Sched& S, const Epi& E) {
    int tid_ = threadIdx.x; asm volatile("" : "+v"(tid_));
    const int tid = tid_, wid = __builtin_amdgcn_readfirstlane(tid >> 6), lane = tid & 63, wr = wid >> 2, wc = wid & 3, fr = lane & 15, fq = lane >> 4;
    const int K = g.K, nt = K / BK;
    unsigned voffA[2], voffB[2];
#pragma unroll
    for (int i = 0; i < 2; ++i) { int R, C; stage_rc(tid * 16 + i * 8192, R, C); const int Rb = Epi::PERM ? ((R & ~31) + perm32(R & 31)) : R;
        voffA[i] = (unsigned)(R * K + C) * 2u; voffB[i] = (unsigned)(Rb * K + C) * 2u; }
    const size_t kstep = (size_t)(BK * 2);
    const size_t hstep = (size_t)HALF * K * 2;
    const size_t tstep = 2 * hstep;
    const unsigned ldsw = (unsigned)wid * 1024u;
    const int aoff = lds_byte(wr * 64 + fr, fq * 8), boff = lds_byte(wc * 32 + fr, fq * 8);
#define PG8_SA(b, h) (((b) * 2 + (h)) * HTB)
#define PG8_SB(b, h) ((4 + (b) * 2 + (h)) * HTB)
#define PG8_STAGE(bufoff, gbase, voff) do { _Pragma("unroll") for (int _i = 0; _i < 2; ++_i) \
        __builtin_amdgcn_global_load_lds((const unsigned*)((const char*)(gbase) + (voff)[_i]), (PG8_LAS unsigned*)(lds + (bufoff) + ldsw + _i * 8192), 16, 0, 0); } while (0)
#define PG8_LDA(dst, b, h) do { _Pragma("unroll") for (int m = 0; m < 4; ++m) _Pragma("unroll") for (int k = 0; k < 2; ++k) dst[m][k] = *(const PG8_LAS bf16x8*)(lds + PG8_SA(b, h) + aoff + m * 2048 + k * 1024); } while (0)
#define PG8_LDB(dst, b, h) do { _Pragma("unroll") for (int n = 0; n < 2; ++n) _Pragma("unroll") for (int k = 0; k < 2; ++k) dst[n][k] = *(const PG8_LAS bf16x8*)(lds + PG8_SB(b, h) + boff + n * 2048 + k * 1024); } while (0)
#define PG8_MMA(ai, bj, At, Bt) do { __builtin_amdgcn_s_setprio(1); _Pragma("unroll") for (int m = 0; m < 4; ++m) _Pragma("unroll") for (int n = 0; n < 2; ++n) _Pragma("unroll") for (int k = 0; k < 2; ++k) \
        acc[ai][bj][m][n] = __builtin_amdgcn_mfma_f32_16x16x32_bf16(Bt[n][k], At[m][k], acc[ai][bj][m][n], 0, 0, 0); __builtin_amdgcn_s_setprio(0); } while (0)
#define PG8_WAIT_V(n) asm volatile("s_waitcnt vmcnt(" #n ")" ::: "memory")
#define PG8_WAIT_L(n) asm volatile("s_waitcnt lgkmcnt(" #n ")" ::: "memory")
#define PG8_BAR __builtin_amdgcn_s_barrier()
#define PG8_SCHED __builtin_amdgcn_sched_barrier(0)
    Unit cur, nxt; int ui = 0;
    if (!S.next(0, cur)) return;
    f32x4 acc[2][2][4][2];
#pragma unroll
    for (int a = 0; a < 2; ++a)
#pragma unroll
        for (int b = 0; b < 2; ++b)
#pragma unroll
            for (int m = 0; m < 4; ++m)
#pragma unroll
                for (int n = 0; n < 2; ++n) acc[a][b][m][n] = (f32x4){0.f, 0.f, 0.f, 0.f};
    bf16x8 At[4][2], B0[2][2], B1[2][2];
    const char* cA = (const char*)g.A + (size_t)cur.pm * tstep; const char* cB = (const char*)g.Bt + (size_t)cur.pn * tstep;
    S.a_ready(cur);
    if constexpr (SP2) {
        PG8_STAGE(PG8_SB(0, 0), cB, voffB); PG8_STAGE(PG8_SB(0, 1), cB + hstep, voffB); PG8_STAGE(PG8_SA(0, 0), cA, voffA); PG8_STAGE(PG8_SA(0, 1), cA + hstep, voffA);
        if (wr == 1) PG8_BAR;
        PG8_WAIT_V(2); PG8_BAR;
        PG8_STAGE(PG8_SB(1, 0), cB + kstep, voffB); PG8_STAGE(PG8_SA(1, 0), cA + kstep, voffA); PG8_STAGE(PG8_SB(1, 1), cB + hstep + kstep, voffB);
        PG8_WAIT_V(6); PG8_BAR;
    } else {
        PG8_STAGE(PG8_SB(0, 0), cB, voffB); PG8_STAGE(PG8_SA(0, 0), cA, voffA); PG8_STAGE(PG8_SB(0, 1), cB + hstep, voffB); PG8_STAGE(PG8_SA(0, 1), cA + hstep, voffA);
        if (wr == 1) PG8_BAR;
        PG8_WAIT_V(4); PG8_BAR;
        PG8_STAGE(PG8_SB(1, 0), cB + kstep, voffB); PG8_STAGE(PG8_SA(1, 0), cA + kstep, voffA); PG8_STAGE(PG8_SB(1, 1), cB + hstep + kstep, voffB);
        PG8_WAIT_V(6); PG8_BAR;
    }
    for (;;) {
        const bool has_next = S.next(ui + 1, nxt);
        const char* nA = has_next ? (const char*)g.A + (size_t)nxt.pm * tstep : cA; const char* nB = has_next ? (const char*)g.Bt + (size_t)nxt.pn * tstep : cB;
        for (int t = 0; t < nt; t += 2) {
            const bool last = (t == nt - 2);
            const char* a1 = cA + (size_t)(t + 1) * kstep;
            const char* a2 = last ? nA : cA + (size_t)(t + 2) * kstep; const char* b2 = last ? nB : cB + (size_t)(t + 2) * kstep;
            const char* a3 = a2 + kstep; const char* b3 = b2 + kstep;
            if (last && has_next) S.a_ready(nxt);
            if constexpr (SP2) {
            PG8_LDB(B0, 0, 0); PG8_LDB(B1, 0, 1); PG8_SCHED; PG8_LDA(At, 0, 0); PG8_STAGE(PG8_SA(1, 1), a1 + hstep, voffA);
            PG8_WAIT_V(8); PG8_WAIT_L(0); PG8_BAR; PG8_MMA(0, 0, At, B0); PG8_MMA(0, 1, At, B1); PG8_BAR; PG8_SCHED;
            PG8_LDA(At, 0, 1); PG8_STAGE(PG8_SB(0, 0), b2, voffB); PG8_STAGE(PG8_SB(0, 1), b2 + hstep, voffB); PG8_STAGE(PG8_SA(0, 0), a2, voffA);
            PG8_WAIT_V(8); PG8_WAIT_L(0); PG8_BAR; PG8_MMA(1, 0, At, B0); PG8_MMA(1, 1, At, B1); PG8_BAR; PG8_SCHED;
            PG8_LDB(B0, 1, 0); PG8_LDB(B1, 1, 1); PG8_SCHED; PG8_LDA(At, 1, 0); PG8_STAGE(PG8_SA(0, 1), a2 + hstep, voffA);
            PG8_WAIT_V(8); PG8_WAIT_L(0); PG8_BAR; PG8_MMA(0, 0, At, B0); PG8_MMA(0, 1, At, B1); PG8_BAR; PG8_SCHED;
            PG8_LDA(At, 1, 1); PG8_STAGE(PG8_SB(1, 0), b3, voffB); PG8_STAGE(PG8_SB(1, 1), b3 + hstep, voffB); PG8_STAGE(PG8_SA(1, 0), a3, voffA);
            PG8_WAIT_V(8); PG8_WAIT_L(0); PG8_BAR; PG8_MMA(1, 0, At, B0); PG8_MMA(1, 1, At, B1); PG8_BAR; PG8_SCHED;
            } else {
            PG8_LDB(B0, 0, 0); PG8_SCHED; PG8_LDA(At, 0, 0); PG8_STAGE(PG8_SA(1, 1), a1 + hstep, voffA);
            PG8_WAIT_L(8); PG8_BAR; PG8_WAIT_L(0); PG8_MMA(0, 0, At, B0); PG8_BAR; PG8_SCHED;
            PG8_LDB(B1, 0, 1); PG8_STAGE(PG8_SB(0, 0), b2, voffB);
            PG8_BAR; PG8_WAIT_L(0); PG8_MMA(0, 1, At, B1); PG8_BAR;
            PG8_LDA(At, 0, 1); PG8_STAGE(PG8_SA(0, 0), a2, voffA);
            PG8_BAR; PG8_WAIT_L(0); PG8_MMA(1, 0, At, B0); PG8_BAR; PG8_SCHED;
            PG8_STAGE(PG8_SB(0, 1), b2 + hstep, voffB);
            PG8_WAIT_V(6); PG8_BAR; PG8_MMA(1, 1, At, B1); PG8_BAR;
            PG8_LDB(B0, 1, 0); PG8_SCHED; PG8_LDA(At, 1, 0); PG8_STAGE(PG8_SA(0, 1), a2 + hstep, voffA);
            PG8_WAIT_L(8); PG8_BAR; PG8_WAIT_L(0); PG8_MMA(0, 0, At, B0); PG8_BAR; PG8_SCHED;
            PG8_LDB(B1, 1, 1); PG8_STAGE(PG8_SB(1, 0), b3, voffB);
            PG8_BAR; PG8_WAIT_L(0); PG8_MMA(0, 1, At, B1); PG8_BAR;
            PG8_LDA(At, 1, 1); PG8_STAGE(PG8_SA(1, 0), a3, voffA);
            PG8_BAR; PG8_WAIT_L(0); PG8_MMA(1, 0, At, B0); PG8_BAR; PG8_SCHED;
            PG8_STAGE(PG8_SB(1, 1), b3 + hstep, voffB);
            PG8_WAIT_V(6); PG8_BAR; PG8_MMA(1, 1, At, B1); PG8_BAR;
            }
        }
        if constexpr (ALIGN_EPI) { if (wr == 0) PG8_BAR; }
        if constexpr (!Epi::AFTER_DRAIN) { E(acc, cur, wr, wc, fr, fq); S.done(cur); }
        if (!has_next) break;
#pragma unroll
        for (int a = 0; a < 2; ++a)
#pragma unroll
            for (int b = 0; b < 2; ++b)
#pragma unroll
                for (int m = 0; m < 4; ++m)
#pragma unroll
                    for (int n = 0; n < 2; ++n) acc[a][b][m][n] = (f32x4){0.f, 0.f, 0.f, 0.f};
        cur = nxt; cA = nA; cB = nB; ++ui;
        if constexpr (ALIGN_EPI) { if (wr == 1) PG8_BAR; }
    }
    PG8_WAIT_V(0);
    if constexpr (!ALIGN_EPI) { if (wr == 0) PG8_BAR; }
    PG8_BAR;
    if constexpr (Epi::AFTER_DRAIN) { E.fused(acc, cur, wr, wc, fr, fq, lds, wid, lane); S.done(cur); }
#undef PG8_SA
#undef PG8_SB
#undef PG8_STAGE
#undef PG8_LDA
#undef PG8_LDB
#undef PG8_MMA
#undef PG8_WAIT_V
#undef PG8_WAIT_L
#undef PG8_BAR
#undef PG8_SCHED
}

struct UnitX { int pm, pn, kind, round; };
struct OpsX { const char* A; const char* Bt; int K; };
template <class Epi, class Sched>
__device__ __forceinline__ void gemm_stream(PG8_LAS unsigned char* lds, const Sched& S, const Epi& E) {
    int tid_ = threadIdx.x; asm volatile("" : "+v"(tid_));
    const int tid = tid_, wid = __builtin_amdgcn_readfirstlane(tid >> 6), lane = tid & 63, wr = wid >> 2, wc = wid & 3, fr = lane & 15, fq = lane >> 4;
    unsigned rA[2], rB[2], c2[2];
#pragma unroll
    for (int i = 0; i < 2; ++i) { int R, C; stage_rc(tid * 16 + i * 8192, R, C); rA[i] = (unsigned)R; rB[i] = (unsigned)((R & ~31) + perm32(R & 31)); c2[i] = (unsigned)C * 2u; }
    const size_t kstep = (size_t)(BK * 2);
    const unsigned ldsw = (unsigned)wid * 1024u;
    const int aoff = lds_byte(wr * 64 + fr, fq * 8), boff = lds_byte(wc * 32 + fr, fq * 8);
#define PG8_SA(b, h) (((b) * 2 + (h)) * HTB)
#define PG8_SB(b, h) ((4 + (b) * 2 + (h)) * HTB)
#define PGX_STAGE(bufoff, gbase, rr, pb) do { _Pragma("unroll") for (int _i = 0; _i < 2; ++_i) \
        __builtin_amdgcn_global_load_lds((const unsigned*)((const char*)(gbase) + ((rr)[_i] * (pb) + c2[_i])), (PG8_LAS unsigned*)(lds + (bufoff) + ldsw + _i * 8192), 16, 0, 0); } while (0)
#define PG8_LDA(dst, b, h) do { _Pragma("unroll") for (int m = 0; m < 4; ++m) _Pragma("unroll") for (int k = 0; k < 2; ++k) dst[m][k] = *(const PG8_LAS bf16x8*)(lds + PG8_SA(b, h) + aoff + m * 2048 + k * 1024); } while (0)
#define PG8_LDB(dst, b, h) do { _Pragma("unroll") for (int n = 0; n < 2; ++n) _Pragma("unroll") for (int k = 0; k < 2; ++k) dst[n][k] = *(const PG8_LAS bf16x8*)(lds + PG8_SB(b, h) + boff + n * 2048 + k * 1024); } while (0)
#define PG8_MMA(ai, bj, At, Bt) do { __builtin_amdgcn_s_setprio(1); _Pragma("unroll") for (int m = 0; m < 4; ++m) _Pragma("unroll") for (int n = 0; n < 2; ++n) _Pragma("unroll") for (int k = 0; k < 2; ++k) \
        acc[ai][bj][m][n] = __builtin_amdgcn_mfma_f32_16x16x32_bf16(Bt[n][k], At[m][k], acc[ai][bj][m][n], 0, 0, 0); __builtin_amdgcn_s_setprio(0); } while (0)
#define PG8_WAIT_V(n) asm volatile("s_waitcnt vmcnt(" #n ")" ::: "memory")
#define PG8_WAIT_L(n) asm volatile("s_waitcnt lgkmcnt(" #n ")" ::: "memory")
#define PG8_BAR __builtin_amdgcn_s_barrier()
#define PG8_SCHED __builtin_amdgcn_sched_barrier(0)
    UnitX cur, nxt; int ui = 0;
    if (!S.next(0, cur)) return;
    f32x4 acc[2][2][4][2];
#pragma unroll
    for (int a = 0; a < 2; ++a)
#pragma unroll
        for (int b = 0; b < 2; ++b)
#pragma unroll
            for (int m = 0; m < 4; ++m)
#pragma unroll
                for (int n = 0; n < 2; ++n) acc[a][b][m][n] = (f32x4){0.f, 0.f, 0.f, 0.f};
    bf16x8 At[4][2], B0[2][2], B1[2][2];
    OpsX oc = S.ops(cur);
    const char* cA = oc.A; const char* cB = oc.Bt; int Kc = oc.K;
    {   const unsigned pb = (unsigned)Kc * 2u; const size_t hstep = (size_t)HALF * pb;
        PGX_STAGE(PG8_SB(0, 0), cB, rB, pb); PGX_STAGE(PG8_SB(0, 1), cB + hstep, rB, pb); PGX_STAGE(PG8_SA(0, 0), cA, rA, pb); PGX_STAGE(PG8_SA(0, 1), cA + hstep, rA, pb);
        if (wr == 1) PG8_BAR;
        PG8_WAIT_V(2); PG8_BAR;
        PGX_STAGE(PG8_SB(1, 0), cB + kstep, rB, pb); PGX_STAGE(PG8_SA(1, 0), cA + kstep, rA, pb); PGX_STAGE(PG8_SB(1, 1), cB + hstep + kstep, rB, pb);
        PG8_WAIT_V(6); PG8_BAR; }
    for (;;) {
        const bool has_next = S.next(ui + 1, nxt);
        OpsX on = oc; if (has_next) on = S.ops(nxt);
        const char* nA = on.A; const char* nB = on.Bt; const int Kn = on.K;
        const int nt = Kc / BK; const unsigned pbc = (unsigned)Kc * 2u; const size_t hstep = (size_t)HALF * pbc;
        for (int t = 0; t < nt; t += 2) {
            const bool last = (t == nt - 2);
            const char* a1 = cA + (size_t)(t + 1) * kstep;
            const char* a2 = last ? nA : cA + (size_t)(t + 2) * kstep; const char* b2 = last ? nB : cB + (size_t)(t + 2) * kstep;
            const char* a3 = a2 + kstep; const char* b3 = b2 + kstep;
            const unsigned pb2 = last ? (unsigned)Kn * 2u : pbc; const size_t h2 = (size_t)HALF * pb2;
            PG8_LDB(B0, 0, 0); PG8_LDB(B1, 0, 1); PG8_SCHED; PG8_LDA(At, 0, 0); PGX_STAGE(PG8_SA(1, 1), a1 + hstep, rA, pbc);
            PG8_WAIT_V(8); PG8_WAIT_L(0); PG8_BAR; PG8_MMA(0, 0, At, B0); PG8_MMA(0, 1, At, B1); PG8_BAR; PG8_SCHED;
            PG8_LDA(At, 0, 1); PGX_STAGE(PG8_SB(0, 0), b2, rB, pb2); PGX_STAGE(PG8_SB(0, 1), b2 + h2, rB, pb2); PGX_STAGE(PG8_SA(0, 0), a2, rA, pb2);
            PG8_WAIT_V(8); PG8_WAIT_L(0); PG8_BAR; PG8_MMA(1, 0, At, B0); PG8_MMA(1, 1, At, B1); PG8_BAR; PG8_SCHED;
            PG8_LDB(B0, 1, 0); PG8_LDB(B1, 1, 1); PG8_SCHED; PG8_LDA(At, 1, 0); PGX_STAGE(PG8_SA(0, 1), a2 + h2, rA, pb2);
            PG8_WAIT_V(8); PG8_WAIT_L(0); PG8_BAR; PG8_MMA(0, 0, At, B0); PG8_MMA(0, 1, At, B1); PG8_BAR; PG8_SCHED;
            PG8_LDA(At, 1, 1); PGX_STAGE(PG8_SB(1, 0), b3, rB, pb2); PGX_STAGE(PG8_SB(1, 1), b3 + h2, rB, pb2); PGX_STAGE(PG8_SA(1, 0), a3, rA, pb2);
            PG8_WAIT_V(8); PG8_WAIT_L(0); PG8_BAR; PG8_MMA(1, 0, At, B0); PG8_MMA(1, 1, At, B1); PG8_BAR; PG8_SCHED;
        }
        if (wr == 0) PG8_BAR;
        E(acc, cur, wr, wc, fr, fq);
        if (!has_next) break;
#pragma unroll
        for (int a = 0; a < 2; ++a)
#pragma unroll
            for (int b = 0; b < 2; ++b)
#pragma unroll
                for (int m = 0; m < 4; ++m)
#pragma unroll
                    for (int n = 0; n < 2; ++n) acc[a][b][m][n] = (f32x4){0.f, 0.f, 0.f, 0.f};
        cur = nxt; oc = on; cA = nA; cB = nB; Kc = Kn; ++ui;
        if (wr == 1) PG8_BAR;
    }
    PG8_WAIT_V(0);
    PG8_BAR;
#undef PG8_SA
#undef PG8_SB
#undef PGX_STAGE
#undef PG8_LDA
#undef PG8_LDB
#undef PG8_MMA
#undef PG8_WAIT_V
#undef PG8_WAIT_L
#undef PG8_BAR
#undef PG8_SCHED
}
}
namespace pg8 {
constexpr int TOK = 16384;
constexpr float RMS_EPS = 1e-6f;
typedef float f32x2e __attribute__((ext_vector_type(2)));
template <int NP> __device__ __forceinline__ void row_scales(const float* src, int rowbase, int lane, int fr, float (&r)[2][4]) {
#pragma unroll
    for (int ai = 0; ai < 2; ++ai) {
        const int row = rowbase + 128 * ai + lane; float v;
        if (NP == 0) v = src[row];
        else { float s = 0.f;
#pragma unroll
            for (int p = 0; p < NP; ++p) s += src[(size_t)p * TOK + row];
            v = __builtin_amdgcn_rsqf(s * (1.0f / 1024.0f) + RMS_EPS); }
#pragma unroll
        for (int m = 0; m < 4; ++m) r[ai][m] = __shfl(v, 16 * m + fr);
    }
}
template <int NP, class Sched> __device__ __forceinline__ void build_row_tab(const float* src, const Sched& S, PG8_LAS float* tab) {
    Unit u;
    for (int i = 0; S.next(i, u); ++i)
        for (int r = (int)threadIdx.x; r < 256; r += 512) { const int row = u.pm * BM + r; float v;
            if (NP == 0) v = src[row];
            else { float s = 0.f;
#pragma unroll
                for (int p = 0; p < NP; ++p) s += src[(size_t)p * TOK + row];
                v = __builtin_amdgcn_rsqf(s * (1.0f / 1024.0f) + RMS_EPS); }
            tab[i * 256 + r] = v; }
    __syncthreads();
}
__device__ __forceinline__ void row_scales_tab(const PG8_LAS float* tab, int ui, int wr, int fr, float (&r)[2][4]) {
#pragma unroll
    for (int ai = 0; ai < 2; ++ai)
#pragma unroll
        for (int m = 0; m < 4; ++m) r[ai][m] = tab[ui * 256 + ai * 128 + wr * 64 + 16 * m + fr];
}
__device__ __forceinline__ float silu_f(float x) { return x * __builtin_amdgcn_rcpf(1.0f + __expf(-x)); }
__device__ __forceinline__ float sigmoid_f(float x) { return __builtin_amdgcn_rcpf(1.0f + __expf(-x)); }

template <int NP> struct EpiSwiGLU {
    static constexpr bool PERM = true, AFTER_DRAIN = false;
    bf16_t* H; int ldh; const PG8_LAS float* tab; mutable int ui = 0;
    __device__ __forceinline__ void operator()(const f32x4 (&acc)[2][2][4][2], const Unit& u, int wr, int wc, int fr0, int fq0) const {
        int fr = fr0, fq = fq0; asm volatile("" : "+v"(fr), "+v"(fq));
        float r[2][4]; row_scales_tab(tab, ui++, wr, fr, r);
        const int col0 = u.pn * 128 + wc * 32 + 8 * fq;
#pragma unroll
        for (int ai = 0; ai < 2; ++ai)
#pragma unroll
            for (int m = 0; m < 4; ++m) {
                const int row = u.pm * BM + ai * HALF + wr * 64 + m * 16 + fr; const float rr = r[ai][m];
                float o[8]; const float k1 = -1.44269504f * rr, rr2 = rr * rr;
#pragma unroll
                for (int n = 0; n < 2; ++n)
#pragma unroll
                    for (int j = 0; j < 4; j += 2) { const f32x2 g2 = (f32x2){acc[ai][0][m][n][j], acc[ai][0][m][n][j + 1]}, u2 = (f32x2){acc[ai][1][m][n][j], acc[ai][1][m][n][j + 1]};
                        const f32x2 t2 = g2 * k1; const f32x2 d2 = (f32x2){__builtin_amdgcn_exp2f(t2[0]), __builtin_amdgcn_exp2f(t2[1])} + 1.0f;
                        const f32x2 r2 = (f32x2){__builtin_amdgcn_rcpf(d2[0]), __builtin_amdgcn_rcpf(d2[1])} * rr2; const f32x2 o2 = (g2 * u2) * r2;
                        o[4 * n + j] = o2[0]; o[4 * n + j + 1] = o2[1]; }
                u32x4 w; w.x = cvt_pk_bf16(o[0], o[1]); w.y = cvt_pk_bf16(o[2], o[3]); w.z = cvt_pk_bf16(o[4], o[5]); w.w = cvt_pk_bf16(o[6], o[7]);
                *(u32x4*)(H + (size_t)row * ldh + col0) = w;
            }
    }
};
template <bool WRITE_HB> struct EpiResid {
    static constexpr bool PERM = true, AFTER_DRAIN = false;
    const float* base; float* out; bf16_t* hb; float* part; float sc;
    __device__ __forceinline__ void operator()(const f32x4 (&acc)[2][2][4][2], const Unit& u, int wr, int wc, int fr0, int fq0) const {
        int fr = fr0, fq = fq0; asm volatile("" : "+v"(fr), "+v"(fq));
        const int col0 = u.pn * BM + wc * 32 + 8 * fq;
#pragma unroll
        for (int ai = 0; ai < 2; ++ai)
#pragma unroll
            for (int m = 0; m < 4; ++m) {
                const int row = u.pm * BM + ai * HALF + wr * 64 + m * 16 + fr; float ss = 0.f;
#pragma unroll
                for (int bj = 0; bj < 2; ++bj) {
                    const size_t off = (size_t)row * 1024 + col0 + bj * HALF;
                    const f32x4 b0 = *(const f32x4*)(base + off), b1 = *(const f32x4*)(base + off + 4);
                    const f32x4 o0 = b0 + acc[ai][bj][m][0] * sc, o1 = b1 + acc[ai][bj][m][1] * sc;
                    *(f32x4*)(out + off) = o0; *(f32x4*)(out + off + 4) = o1;
                    if (WRITE_HB) {
                        ss += (o0[0] * o0[0] + o0[1] * o0[1]) + (o0[2] * o0[2] + o0[3] * o0[3]) + (o1[0] * o1[0] + o1[1] * o1[1]) + (o1[2] * o1[2] + o1[3] * o1[3]);
                        u32x4 w; w.x = cvt_pk_bf16(o0[0], o0[1]); w.y = cvt_pk_bf16(o0[2], o0[3]); w.z = cvt_pk_bf16(o1[0], o1[1]); w.w = cvt_pk_bf16(o1[2], o1[3]);
                        *(u32x4*)(hb + off) = w; }
                }
                if (WRITE_HB) { ss += __shfl_xor(ss, 16); ss += __shfl_xor(ss, 32); if (fq == 0) part[(size_t)(u.pn * 4 + wc) * TOK + row] = ss; }
                if (m == 3) asm volatile("" ::: "memory");
            }
    }
};
template <bool WRITE_HB> struct EpiResid2 {
    static constexpr bool PERM = true, AFTER_DRAIN = false;
    const float* base; float* out; bf16_t* hb; float* part; float sc;
    __device__ __forceinline__ void operator()(const f32x4 (&acc)[2][2][4][2], const Unit& u, int wr, int wc, int fr0, int fq0) const {
        int fr = fr0, fq = fq0; asm volatile("" : "+v"(fr), "+v"(fq));
        const int row0 = u.pm * BM + wr * 64 + fr; const size_t o00 = (size_t)row0 * 1024 + u.pn * BM + wc * 32 + 8 * fq;
        const float* bp = base + o00; float* op = out + o00; bf16_t* hp = hb + o00;
        f32x4 bq[2][8];
#define ER2_ISSUE(G, B) do { _Pragma("unroll") for (int c = 0; c < 8; ++c) { const int ai = (G) >> 1, m = 2 * ((G) & 1) + (c >> 2), bj = (c >> 1) & 1, n = c & 1; \
            bq[B][c] = *(const f32x4*)(bp + (size_t)(ai * 128 + m * 16) * 1024 + bj * 128 + 4 * n); } } while (0)
        ER2_ISSUE(0, 0);
#pragma unroll
        for (int G = 0; G < 4; ++G) {
            if (G + 1 < 4) { if ((G & 1) == 0) ER2_ISSUE(G + 1, 1); else ER2_ISSUE(G + 1, 0); }
            asm volatile("" ::: "memory");
#pragma unroll
            for (int mm = 0; mm < 2; ++mm) { const int ai = G >> 1, m = 2 * (G & 1) + mm; float ss = 0.f;
#pragma unroll
                for (int bj = 0; bj < 2; ++bj) { const size_t off = (size_t)(ai * 128 + m * 16) * 1024 + bj * 128;
                    const f32x4 o0 = bq[G & 1][mm * 4 + bj * 2] + acc[ai][bj][m][0] * sc, o1 = bq[G & 1][mm * 4 + bj * 2 + 1] + acc[ai][bj][m][1] * sc;
                    *(f32x4*)(op + off) = o0; *(f32x4*)(op + off + 4) = o1;
                    if (WRITE_HB) {
                        ss += (o0[0] * o0[0] + o0[1] * o0[1]) + (o0[2] * o0[2] + o0[3] * o0[3]) + (o1[0] * o1[0] + o1[1] * o1[1]) + (o1[2] * o1[2] + o1[3] * o1[3]);
                        u32x4 w; w.x = cvt_pk_bf16(o0[0], o0[1]); w.y = cvt_pk_bf16(o0[2], o0[3]); w.z = cvt_pk_bf16(o1[0], o1[1]); w.w = cvt_pk_bf16(o1[2], o1[3]);
                        *(u32x4*)(hp + off) = w; } }
                if (WRITE_HB) { ss += __shfl_xor(ss, 16); ss += __shfl_xor(ss, 32); if (fq == 0) part[(size_t)(u.pn * 4 + wc) * TOK + row0 + ai * 128 + m * 16] = ss; } }
            asm volatile("" ::: "memory");
        }
#undef ER2_ISSUE
    }
};
struct EpiMemKV {
    static constexpr bool PERM = true, AFTER_DRAIN = false;
    float* KV; const float* rs;
    __device__ __forceinline__ void operator()(const f32x4 (&acc)[2][2][4][2], const Unit& u, int wr, int wc, int fr0, int fq0) const {
        int fr = fr0, fq = fq0; asm volatile("" : "+v"(fr), "+v"(fq));
        float r[2][4]; row_scales<0>(rs, u.pm * BM + wr * 64, (int)(threadIdx.x & 63), fr, r);
        const int col0 = u.pn * BM + wc * 32 + 8 * fq;
#pragma unroll
        for (int ai = 0; ai < 2; ++ai)
#pragma unroll
            for (int m = 0; m < 4; ++m) { const int row = u.pm * BM + ai * HALF + wr * 64 + m * 16 + fr;
#pragma unroll
                for (int bj = 0; bj < 2; ++bj) { const size_t off = (size_t)row * 1024 + col0 + bj * HALF;
                    *(f32x4*)(KV + off) = acc[ai][bj][m][0] * r[ai][m]; *(f32x4*)(KV + off + 4) = acc[ai][bj][m][1] * r[ai][m]; } }
    }
};
template <int NP> struct EpiGate {
    static constexpr bool PERM = true, AFTER_DRAIN = false;
    bf16_t* scr; const PG8_LAS float* tab; mutable int ui = 0;
    __device__ __forceinline__ void operator()(const f32x4 (&acc)[2][2][4][2], const Unit& u, int wr, int wc, int fr0, int fq0) const {
        int fr = fr0, fq = fq0; asm volatile("" : "+v"(fr), "+v"(fq));
        float r[2][4];
#ifdef DBG_GATE_NOSCALE
        for (int a_ = 0; a_ < 2; ++a_) for (int m_ = 0; m_ < 4; ++m_) r[a_][m_] = 1.0f;
#else
        row_scales_tab(tab, ui++, wr, fr, r);
#endif
        bf16_t* t = scr + (size_t)(u.pm * 4 + u.pn) * 65536;
#pragma unroll
        for (int ai = 0; ai < 2; ++ai)
#pragma unroll
            for (int m = 0; m < 4; ++m) { const int lr = ai * HALF + wr * 64 + m * 16 + fr; const float rr = r[ai][m];
#pragma unroll
                for (int bj = 0; bj < 2; ++bj) { float o[8];
#pragma unroll
                    for (int n = 0; n < 2; ++n)
#pragma unroll
                        for (int j = 0; j < 4; ++j) o[4 * n + j] = sigmoid_f(acc[ai][bj][m][n][j] * rr);
                    u32x4 w; w.x = cvt_pk_bf16(o[0], o[1]); w.y = cvt_pk_bf16(o[2], o[3]); w.z = cvt_pk_bf16(o[4], o[5]); w.w = cvt_pk_bf16(o[6], o[7]);
                    *(u32x4*)(t + lr * 256 + bj * HALF + wc * 32 + 8 * fq) = w; } }
    }
};
__device__ __forceinline__ float bf_lo(unsigned w) { return __uint_as_float(w << 16); }
__device__ __forceinline__ float bf_hi(unsigned w) { return __uint_as_float(w & 0xffff0000u); }
struct EpiBranch {
    static constexpr bool PERM = true, AFTER_DRAIN = false;
    const bf16_t* scr; bf16_t* mg; bool first; float bscale;
    __device__ __forceinline__ void operator()(const f32x4 (&acc)[2][2][4][2], const Unit& u, int wr, int wc, int fr0, int fq0) const {
        int fr = fr0, fq = fq0; asm volatile("" : "+v"(fr), "+v"(fq));
        const bf16_t* t = scr + (size_t)(u.pm * 4 + u.pn) * 65536;
        __builtin_amdgcn_fence(__ATOMIC_ACQUIRE, "agent");
        asm volatile("s_waitcnt vmcnt(0)" ::: "memory");
#pragma unroll
        for (int ai = 0; ai < 2; ++ai)
#pragma unroll
            for (int m = 0; m < 4; ++m) { const int lr = ai * HALF + wr * 64 + m * 16 + fr; const int row = u.pm * BM + lr;
#pragma unroll
                for (int bj = 0; bj < 2; ++bj) { const int lc = bj * HALF + wc * 32 + 8 * fq;
#if defined(DBG_NOGATE) && DBG_NOGATE
                    const u32x4 g = (u32x4){0x3f803f80u, 0x3f803f80u, 0x3f803f80u, 0x3f803f80u};
#else
                    const u32x4 g = *(const u32x4*)(t + lr * 256 + lc);
#endif
                    bf16_t* mp = mg + (size_t)row * 1024 + u.pn * BM + lc;
                    float o[8];
                    o[0] = bf_lo(g.x) * acc[ai][bj][m][0][0]; o[1] = bf_hi(g.x) * acc[ai][bj][m][0][1]; o[2] = bf_lo(g.y) * acc[ai][bj][m][0][2]; o[3] = bf_hi(g.y) * acc[ai][bj][m][0][3];
                    o[4] = bf_lo(g.z) * acc[ai][bj][m][1][0]; o[5] = bf_hi(g.z) * acc[ai][bj][m][1][1]; o[6] = bf_lo(g.w) * acc[ai][bj][m][1][2]; o[7] = bf_hi(g.w) * acc[ai][bj][m][1][3];
#ifdef DBG_BRANCH_SIGMOID
#pragma unroll
                    for (int e = 0; e < 8; ++e) o[e] = DBG_NONLIN(o[e]);
#endif
#pragma unroll
                    for (int e = 0; e < 8; ++e) o[e] *= bscale;
                    if (!first) { const u32x4 p = *(const u32x4*)mp;
                        o[0] += bf_lo(p.x); o[1] += bf_hi(p.x); o[2] += bf_lo(p.y); o[3] += bf_hi(p.y); o[4] += bf_lo(p.z); o[5] += bf_hi(p.z); o[6] += bf_lo(p.w); o[7] += bf_hi(p.w); }
                    u32x4 w; w.x = cvt_pk_bf16(o[0], o[1]); w.y = cvt_pk_bf16(o[2], o[3]); w.z = cvt_pk_bf16(o[4], o[5]); w.w = cvt_pk_bf16(o[6], o[7]);
                    *(u32x4*)mp = w; }
                if (m & 1) asm volatile("" ::: "memory"); }
    }
};
template <bool FIRST> struct EpiBranch2 {
    const bf16_t* scr; bf16_t* mg;
    __device__ __forceinline__ void operator()(const f32x4 (&acc)[2][2][4][2], const Unit& u, int wr, int wc, int fr0, int fq0) const {
        int fr = fr0, fq = fq0; asm volatile("" : "+v"(fr), "+v"(fq));
        const bf16_t* t = scr + (size_t)(u.pm * 4 + u.pn) * 65536 + (wr * 64 + fr) * 256 + wc * 32 + 8 * fq;
        bf16_t* mp0 = mg + (size_t)(u.pm * BM + wr * 64 + fr) * 1024 + u.pn * BM + wc * 32 + 8 * fq;
        u32x4 gq[2][4], pq[2][4];
#define EB2_ISSUE(G, B) do { _Pragma("unroll") for (int c = 0; c < 4; ++c) { const int ai = (G) >> 1, m = 2 * ((G) & 1) + (c >> 1), bj = c & 1; \
            gq[B][c] = *(const u32x4*)(t + (ai * 128 + m * 16) * 256 + bj * 128); if (!FIRST) pq[B][c] = *(const u32x4*)(mp0 + (size_t)(ai * 128 + m * 16) * 1024 + bj * 128); } } while (0)
        EB2_ISSUE(0, 0);
#pragma unroll
        for (int G = 0; G < 4; ++G) {
            if (G + 1 < 4) { if ((G & 1) == 0) EB2_ISSUE(G + 1, 1); else EB2_ISSUE(G + 1, 0); }
            asm volatile("" ::: "memory");
#pragma unroll
            for (int c = 0; c < 4; ++c) { const int ai = G >> 1, m = 2 * (G & 1) + (c >> 1), bj = c & 1; const u32x4 g = gq[G & 1][c];
                float o[8];
                o[0] = bf_lo(g.x) * acc[ai][bj][m][0][0]; o[1] = bf_hi(g.x) * acc[ai][bj][m][0][1]; o[2] = bf_lo(g.y) * acc[ai][bj][m][0][2]; o[3] = bf_hi(g.y) * acc[ai][bj][m][0][3];
                o[4] = bf_lo(g.z) * acc[ai][bj][m][1][0]; o[5] = bf_hi(g.z) * acc[ai][bj][m][1][1]; o[6] = bf_lo(g.w) * acc[ai][bj][m][1][2]; o[7] = bf_hi(g.w) * acc[ai][bj][m][1][3];
                if (!FIRST) { const u32x4 p = pq[G & 1][c];
                    o[0] += bf_lo(p.x); o[1] += bf_hi(p.x); o[2] += bf_lo(p.y); o[3] += bf_hi(p.y); o[4] += bf_lo(p.z); o[5] += bf_hi(p.z); o[6] += bf_lo(p.w); o[7] += bf_hi(p.w); }
                u32x4 w; w.x = cvt_pk_bf16(o[0], o[1]); w.y = cvt_pk_bf16(o[2], o[3]); w.z = cvt_pk_bf16(o[4], o[5]); w.w = cvt_pk_bf16(o[6], o[7]);
                *(u32x4*)(mp0 + (size_t)(ai * 128 + m * 16) * 1024 + bj * 128) = w; }
            asm volatile("" ::: "memory");
        }
#undef EB2_ISSUE
    }
};
template <size_t O_HB, size_t O_WG, size_t O_A0, size_t O_A1, size_t O_A2, size_t O_WB> struct P7Order {
    StaticOrder T; const char* ws;
    __device__ __forceinline__ bool next(int i, UnitX& u) const { const int rd = i / 6; Unit t; if (!T.next(rd, t)) return false; u.pm = t.pm; u.pn = t.pn; u.kind = i - 6 * rd; u.round = rd; return true; }
    __device__ __forceinline__ OpsX ops(const UnitX& u) const { const int j = u.kind >> 1; OpsX o;
        if (u.kind & 1) { o.K = 512; o.A = ws + (j == 0 ? O_A0 : j == 1 ? O_A1 : O_A2) + (size_t)u.pm * (256 * 512 * 2); o.Bt = ws + O_WB + (size_t)j * (1024 * 512 * 2) + (size_t)u.pn * (256 * 512 * 2); }
        else { o.K = 1024; o.A = ws + O_HB + (size_t)u.pm * (256 * 1024 * 2); o.Bt = ws + O_WG + (size_t)j * (1024 * 1024 * 2) + (size_t)u.pn * (256 * 1024 * 2); }
        return o; }
};
struct EpiP7 {
    bf16_t* scr; bf16_t* mg; const PG8_LAS float* tab;
    __device__ __forceinline__ void operator()(const f32x4 (&acc)[2][2][4][2], const UnitX& u, int wr, int wc, int fr, int fq) const {
        const Unit uu{u.pm, u.pn};
        if (u.kind == 1) { const EpiBranch2<true> b{scr, mg}; b(acc, uu, wr, wc, fr, fq); }
        else if (u.kind & 1) { const EpiBranch2<false> b{scr, mg}; b(acc, uu, wr, wc, fr, fq); }
        else { const EpiGate<16> g{scr, tab, u.round}; g(acc, uu, wr, wc, fr, fq); }
    }
};
struct ProjOut { bf16_t *FQ, *FK, *FV, *DQ, *IQ, *MQ, *DK, *DV, *IK; float *LOGF, *IW; const float *cosT, *sinT, *g_fq, *g_fk, *g_dq, *g_dk, *b_forget; };
__device__ __forceinline__ float log_sigmoid_f(float z) { return z >= 0.f ? -log1pf(expf(-z)) : z - log1pf(expf(z)); }
template <int NP> struct EpiProj {
    static constexpr bool PERM = true, AFTER_DRAIN = false;
    ProjOut P; const PG8_LAS float* tab; float qscale; mutable int ui = 0;
    __device__ __forceinline__ void operator()(const f32x4 (&acc)[2][2][4][2], const Unit& u, int wr, int wc, int fr0, int fq0) const {
        int fr = fr0, fq = fq0; asm volatile("" : "+v"(fr), "+v"(fq));
        float r[2][4]; row_scales_tab(tab, ui++, wr, fr, r);
        const int pn = u.pn;
        bool do_norm = false, do_rope = false; const float* gain = nullptr; bf16_t* dst = nullptr; int pitch = 512, hoff = 0; float osc = 1.f;
        if (pn < 2)       { do_norm = true; gain = P.g_fq; dst = P.FQ; hoff = (4 * pn + wc) * 64; osc = qscale; }
        else if (pn < 4)  { do_norm = true; gain = P.g_fk; dst = P.FK; hoff = (4 * (pn - 2) + wc) * 64; }
        else if (pn < 6)  { dst = P.FV; hoff = (4 * (pn - 4) + wc) * 64; }
        else if (pn < 8)  { do_norm = true; do_rope = true; gain = P.g_dq; dst = P.DQ; hoff = (4 * (pn - 6) + wc) * 64; osc = qscale; }
        else if (pn < 10) { do_rope = true; dst = P.IQ; hoff = (4 * (pn - 8) + wc) * 64; }
        else if (pn < 12) { dst = P.MQ; hoff = (2 * (pn - 10) + (wc >> 1)) * 128 + (wc & 1) * 64; }
        else { pitch = 64;
            if (wc == 0)      { do_norm = true; do_rope = true; gain = P.g_dk; dst = P.DK; }
            else if (wc == 1) { dst = P.DV; }
            else if (wc == 2) { do_rope = true; dst = P.IK; }
            else dst = nullptr; }
        if (dst == nullptr) {
            if (fq < 2) {
#pragma unroll
                for (int ai = 0; ai < 2; ++ai)
#pragma unroll
                    for (int m = 0; m < 4; ++m) { const int row = u.pm * BM + ai * HALF + wr * 64 + m * 16 + fr; const float rr = r[ai][m];
                        f32x4 v0 = acc[ai][0][m][0] * rr, v1 = acc[ai][0][m][1] * rr;
                        if (fq == 0) {
                            const f32x4 b0 = *(const f32x4*)(P.b_forget), b1 = *(const f32x4*)(P.b_forget + 4);
#pragma unroll
                            for (int j = 0; j < 4; ++j) { v0[j] = log_sigmoid_f(v0[j] + b0[j]); v1[j] = log_sigmoid_f(v1[j] + b1[j]); }
                            *(f32x4*)(P.LOGF + (size_t)row * 8) = v0; *(f32x4*)(P.LOGF + (size_t)row * 8 + 4) = v1;
                        } else { const float c = 0.04419417382f; *(f32x4*)(P.IW + (size_t)row * 8) = v0 * c; *(f32x4*)(P.IW + (size_t)row * 8 + 4) = v1 * c; } }
            }
            return;
        }
        const bool ikl = (pn == 12 && wc == 2);
        if (do_norm) { if (do_rope) body<true, true, false>(acc, u, r, gain, dst, pitch, hoff, osc, wr, fr, fq); else body<true, false, false>(acc, u, r, gain, dst, pitch, hoff, osc, wr, fr, fq); }
        else if (do_rope) { if (ikl) body<false, true, true>(acc, u, r, gain, dst, pitch, hoff, osc, wr, fr, fq); else body<false, true, false>(acc, u, r, gain, dst, pitch, hoff, osc, wr, fr, fq); }
        else body<false, false, false>(acc, u, r, gain, dst, pitch, hoff, osc, wr, fr, fq);
    }
    template <bool NORM, bool ROPE, bool IKL>
    __device__ __forceinline__ void body(const f32x4 (&acc)[2][2][4][2], const Unit& u, const float (&r)[2][4], const float* gain, bf16_t* dst, int pitch, int hoff, float osc, int wr, int fr, int fq) const {
        f32x4 gv[2][2];
        if (NORM) {
#pragma unroll
            for (int bj = 0; bj < 2; ++bj)
#pragma unroll
                for (int n = 0; n < 2; ++n) gv[bj][n] = *(const f32x4*)(gain + bj * 32 + 8 * fq + 4 * n);
        }
        f32x4 cq[2][4];
        const int rowb = u.pm * BM + wr * 64 + fr;
#define EP_ISSUE(I, B) do { const size_t ro_ = (size_t)(rowb + ((I) >> 2) * HALF + ((I) & 3) * 16) * 32 + 8 * fq; \
            cq[B][0] = *(const f32x4*)(P.cosT + ro_); cq[B][1] = *(const f32x4*)(P.cosT + ro_ + 4); cq[B][2] = *(const f32x4*)(P.sinT + ro_); cq[B][3] = *(const f32x4*)(P.sinT + ro_ + 4); } while (0)
        if (ROPE) EP_ISSUE(0, 0);
#pragma unroll
        for (int ai = 0; ai < 2; ++ai)
#pragma unroll
            for (int m = 0; m < 4; ++m) {
                const int row = u.pm * BM + ai * HALF + wr * 64 + m * 16 + fr; const float rr = r[ai][m];
                if (ROPE) { if (4 * ai + m + 1 < 8) { if (((4 * ai + m) & 1) == 0) EP_ISSUE(4 * ai + m + 1, 1); else EP_ISSUE(4 * ai + m + 1, 0); } asm volatile("" ::: "memory"); }
                f32x4 v[2][2];
#pragma unroll
                for (int bj = 0; bj < 2; ++bj)
#pragma unroll
                    for (int n = 0; n < 2; ++n) v[bj][n] = acc[ai][bj][m][n] * rr;
                if (NORM) {
                    float ss = 0.f;
#pragma unroll
                    for (int bj = 0; bj < 2; ++bj)
#pragma unroll
                        for (int n = 0; n < 2; ++n) ss += (v[bj][n][0] * v[bj][n][0] + v[bj][n][1] * v[bj][n][1]) + (v[bj][n][2] * v[bj][n][2] + v[bj][n][3] * v[bj][n][3]);
                    ss += __shfl_xor(ss, 16); ss += __shfl_xor(ss, 32);
                    const float inv = __builtin_amdgcn_rsqf(ss * (1.0f / 64.0f) + RMS_EPS);
#pragma unroll
                    for (int bj = 0; bj < 2; ++bj)
#pragma unroll
                        for (int n = 0; n < 2; ++n) v[bj][n] = v[bj][n] * inv * gv[bj][n];
                }
                if (ROPE) {
#pragma unroll
                    for (int n = 0; n < 2; ++n) {
                        const f32x4 c = cq[(4 * ai + m) & 1][n], s = cq[(4 * ai + m) & 1][2 + n];
                        const f32x4 x1 = v[0][n], x2 = v[1][n];
                        v[0][n] = x1 * c - x2 * s; v[1][n] = x2 * c + x1 * s; }
                }
#pragma unroll
                for (int bj = 0; bj < 2; ++bj) {
                    const f32x4 a = v[bj][0] * osc, b = v[bj][1] * osc;
                    u32x4 w; w.x = cvt_pk_bf16(a[0], a[1]); w.y = cvt_pk_bf16(a[2], a[3]); w.z = cvt_pk_bf16(b[0], b[1]); w.w = cvt_pk_bf16(b[2], b[3]);
                    if (IKL) {
                        const int d = bj * 32 + 8 * fq; *(u32x4*)(dst + (size_t)(row >> 5) * 2048 + (d >> 4) * 512 + ((d >> 3) & 1) * 256 + (row & 31) * 8) = w;
                    } else *(u32x4*)(dst + (size_t)row * pitch + hoff + bj * 32 + 8 * fq) = w; }
                if (ROPE) asm volatile("" ::: "memory");
            }
#undef EP_ISSUE
    }
};
}
#define GAS __attribute__((address_space(1)))
#define LAS __attribute__((address_space(3)))
typedef unsigned short bf16;
typedef unsigned v4u __attribute__((ext_vector_type(4)));
typedef float f32x4 __attribute__((ext_vector_type(4)));
typedef short bf16x8 __attribute__((ext_vector_type(8)));
typedef GAS unsigned gu32;
typedef GAS unsigned long long gu64;
#define RLX_AGENT __ATOMIC_RELAXED, __HIP_MEMORY_SCOPE_AGENT
#define LDS_WAIT() asm volatile("s_waitcnt lgkmcnt(0)" ::: "memory")
#define VM_WAIT() asm volatile("s_waitcnt vmcnt(0)" ::: "memory")
__device__ __forceinline__ unsigned long long rt() { return __builtin_amdgcn_s_memrealtime(); }
__device__ __forceinline__ unsigned f2bf(float f) { unsigned u = __builtin_bit_cast(unsigned, f); return (u + 0x7fffu + ((u >> 16) & 1u)) >> 16; }
__device__ __forceinline__ unsigned pk2(float lo, float hi) { return f2bf(lo) | (f2bf(hi) << 16); }
typedef float f32x2g __attribute__((ext_vector_type(2)));
__device__ __forceinline__ float bf_lo32(unsigned w) { return __uint_as_float(w << 16); }
__device__ __forceinline__ float bf_hi32(unsigned w) { return __uint_as_float(w & 0xffff0000u); }
constexpr int NWAVES = 8;
constexpr int BATCH = 2, SEQ = 8192, DM = 1024, T = BATCH * SEQ, DFF = 2816, MEMLEN = 256, BW = 512, DIN = 6352;
constexpr int NPROJ = 13 * 256, NGATE = 3072;
constexpr float L2E = 1.4426950408889634f;
constexpr float C2_64 = 0.125f * L2E;
constexpr float C2_128 = 0.08838834764831845f * L2E;
constexpr size_t MiB = 1u << 20;
constexpr size_t WS_CTL = 0, CTL_ZERO_BYTES = 128 * 1024;
constexpr size_t WS_RSTDX = 1 * MiB;
constexpr size_t WS_RSTDM = WS_RSTDX + 64 * 1024;
constexpr size_t WS_T0 = WS_RSTDM + 4096;
constexpr size_t WS_SSQ1 = 2 * MiB;
constexpr size_t WS_SSQ2 = 3 * MiB;
constexpr size_t WS_LOGF = 4 * MiB;
constexpr size_t WS_CUM = WS_LOGF + 512 * 1024;
constexpr size_t WS_IW = 5 * MiB;
constexpr size_t WS_COS = 6 * MiB, WS_SIN = 8 * MiB;
constexpr size_t WS_MEMB = 10 * MiB;
constexpr size_t WS_KVM = 11 * MiB;
constexpr size_t WS_KMB = 13 * MiB, WS_VMB = 14 * MiB;
constexpr size_t WS_WGU1 = 16 * MiB;
constexpr size_t WS_WD1 = 27 * MiB;
constexpr size_t WS_WIN = 33 * MiB;
constexpr size_t WS_WGATE = 40 * MiB;
constexpr size_t WS_WBR = 46 * MiB;
constexpr size_t WS_WOUT = 49 * MiB;
constexpr size_t WS_WGU2 = 51 * MiB;
constexpr size_t WS_WD2 = 62 * MiB;
constexpr size_t WS_WMKV = 68 * MiB;
constexpr size_t WS_HB = 70 * MiB;
constexpr size_t WS_ACT = 102 * MiB;
constexpr size_t WS_HID = WS_ACT;
constexpr size_t WS_FQ = WS_ACT, WS_FK = WS_ACT + 16 * MiB, WS_FV = WS_ACT + 32 * MiB, WS_DQ = WS_ACT + 48 * MiB, WS_IQ = WS_ACT + 64 * MiB, WS_MQ = WS_ACT + 80 * MiB;
constexpr size_t WS_DK = WS_ACT + 96 * MiB, WS_DV = WS_ACT + 98 * MiB, WS_IK = WS_ACT + 100 * MiB;
#if defined(DBG_SUBST) && DBG_SUBST == 2
constexpr size_t WS_MERGED = WS_DQ;
#else
constexpr size_t WS_MERGED = WS_FK;
#endif
#ifdef DBG_GSCR_AT
constexpr size_t WS_GSCR = DBG_GSCR_AT;
#else
constexpr size_t WS_GSCR = 204 * MiB;
#endif
constexpr size_t WS_OA = 236 * MiB;
constexpr size_t WS_OB = 16 * MiB;
constexpr size_t WS_END = 252 * MiB;
#ifndef DBG_GSCR_AT
static_assert(WS_HID + (size_t)T * DFF * 2 <= WS_GSCR && WS_IK + (size_t)T * 64 * 2 <= WS_GSCR, "d_ws map");
#endif
constexpr int CW_BAR = 4096;
constexpr int CW_Q = 16384;
constexpr int RING_OFF = 0, RING_BYTES = 131072;
constexpr int LDSCTL_OFF = RING_BYTES, MISC_OFF = LDSCTL_OFF + 320;
constexpr int LIST_OFF = RING_BYTES + 1024;
constexpr int SCANX_OFF = RING_BYTES + 6144;
constexpr int LDS_BYTES = 163840;
#define XB_TMO      128
#define XB_XCNT(j)  (256  + 64 * (j))
#define XB_XSUB(j)  (1280 + 64 * (j))
#define XB_XGEN(j)  (2304 + 64 * (j))
#define XB_TOP      3328
#define XB_TOPGEN   3392
#define XCD_BAR_WORDS 3456
#define XB_SPIN_CAP (1u << 18)

__device__ __forceinline__ unsigned xb_ld(unsigned* p)              { return __hip_atomic_load(p, __ATOMIC_RELAXED, __HIP_MEMORY_SCOPE_AGENT); }
__device__ __forceinline__ unsigned xb_add(unsigned* p, unsigned v) { return __hip_atomic_fetch_add(p, v, __ATOMIC_RELAXED, __HIP_MEMORY_SCOPE_AGENT); }
__device__ __forceinline__ unsigned xb_xcc_id() { return (unsigned)__builtin_amdgcn_s_getreg((3 << 11) | 20) & 0xFu; }
#define XB_SPIN(cond, bar) do { unsigned _sp = 0; while (cond) { __builtin_amdgcn_s_sleep(1); \
    if ((++_sp & 255u) == 0u) { if (xb_ld(&(bar)[XB_TMO])) break; if (_sp > XB_SPIN_CAP) { atomicAdd(&(bar)[XB_TMO], 1u); break; } } } } while (0)

struct XcdBarrier {
    unsigned* bar; unsigned x;
    volatile LAS unsigned* st;
};

__device__ __forceinline__ XcdBarrier xcd_barrier_post(unsigned* bar, volatile LAS unsigned* st) {
    XcdBarrier b; b.bar = bar; b.x = xb_xcc_id(); b.st = st;
    if (threadIdx.x == 0) (void)xb_add(&bar[XB_XCNT(b.x)], 1u);
    return b;
}
__device__ __forceinline__ void xcd_barrier_complete(unsigned* bar, unsigned x, unsigned& nloc, unsigned& nx) {
    const unsigned G = gridDim.x * gridDim.y * gridDim.z;
    unsigned sum, cnt, mine, sp = 0u;
    for (;;) {
        sum = 0u; cnt = 0u; mine = 0u;
#pragma unroll
        for (unsigned j = 0; j < 16; ++j) { const unsigned c = xb_ld(&bar[XB_XCNT(j)]); sum += c; cnt += (c > 0u) ? 1u : 0u; mine = (j == x) ? c : mine; }
        if (sum == G) break;
        __builtin_amdgcn_s_sleep(1);
        if ((++sp & 255u) == 0u) { if (xb_ld(&bar[XB_TMO])) break; if (sp > XB_SPIN_CAP) { atomicAdd(&bar[XB_TMO], 1u); break; } }
    }
    nloc = mine > 0u ? mine : 1u; nx = cnt > 0u ? cnt : 1u;
}

__device__ __forceinline__ void xcd_barrier(const XcdBarrier& b) {
    asm volatile("s_waitcnt vmcnt(0)" ::: "memory");
    __syncthreads();
    if (threadIdx.x == 0) {
        unsigned* bar = b.bar;
        __builtin_amdgcn_s_waitcnt(0);
        unsigned nloc = b.st[0], nx = b.st[1];
        if (nloc == 0u) { xcd_barrier_complete(bar, b.x, nloc, nx); b.st[0] = nloc; b.st[1] = nx; }
        const unsigned old = xb_add(&bar[XB_XSUB(b.x)], 1u);
        const unsigned gen = old / nloc;
        if (old + 1u == (gen + 1u) * nloc) {
            __builtin_amdgcn_fence(__ATOMIC_RELEASE, "agent");
            asm volatile("s_waitcnt vmcnt(0)" ::: "memory");
            const unsigned og = xb_add(&bar[XB_TOP], 1u);
            const unsigned tg = og / nx;
            if (og + 1u == (tg + 1u) * nx) xb_add(&bar[XB_TOPGEN], 1u);
            else XB_SPIN(xb_ld(&bar[XB_TOPGEN]) == tg, bar);
            __builtin_amdgcn_fence(__ATOMIC_ACQUIRE, "agent");
            xb_add(&bar[XB_XGEN(b.x)], 1u);
            asm volatile("s_waitcnt vmcnt(0)" ::: "memory");
        } else {
            XB_SPIN(xb_ld(&bar[XB_XGEN(b.x)]) == gen, bar);
            __builtin_amdgcn_fence(__ATOMIC_ACQUIRE, "agent");
            asm volatile("s_waitcnt vmcnt(0)" ::: "memory");
        }
    }
    __syncthreads();
}
__device__ __forceinline__ float wave_sum(float v) {
#pragma unroll
    for (int o = 1; o < 64; o <<= 1) v += __shfl_xor(v, o);
    return v;
}
__device__ __forceinline__ float wave_max(float v) {
#pragma unroll
    for (int o = 1; o < 64; o <<= 1) v = fmaxf(v, __shfl_xor(v, o));
    return v;
}
__device__ __forceinline__ int colmap(int mat, int n) {
    if (mat == 1) return n;
    if (mat == 3) return 3280 + n;
    const int tile = n >> 8, t = n & 255;
    if (mat == 0) return (t < 128 ? 0 : DFF) + 128 * tile + (t & 127);
    const int bj = t >> 7, wc = (t >> 5) & 3, i = t & 31, d = bj * 32 + i;
    if (tile < 2) return 0 + (4 * tile + wc) * 64 + d;
    if (tile < 4) return 512 + (4 * (tile - 2) + wc) * 64 + d;
    if (tile < 6) return 1024 + (4 * (tile - 4) + wc) * 64 + d;
    if (tile < 8) return 1544 + (4 * (tile - 6) + wc) * 64 + d;
    if (tile < 10) return 2184 + (4 * (tile - 8) + wc) * 64 + d;
    if (tile < 12) return 2768 + (2 * (tile - 10) + (wc >> 1)) * 128 + (wc & 1) * 64 + d;
    if (wc == 0) return 2056 + d;
    if (wc == 1) return 2120 + d;
    if (wc == 2) return 2696 + d;
    if (bj == 0 && i < 8) return 1536 + i;
    if (bj == 0 && i < 16) return 2760 + (i - 8);
    return -1;
}
template <bool GAIN> __device__ __forceinline__ void transpose_item(int mat, const float* Wa, const float* Wb, int K, int Nsrc, const float* gain, bf16* WT, LAS float* scr, int item, int nblk, int lane) {
    const int kb = item / nblk, nb = item % nblk, k0 = 64 * kb, n0 = 32 * nb;
    int col = colmap(mat, n0 + (lane & 31)); const float* W = Wa;
    if (mat == 0 && col >= DFF) { W = Wb; col -= DFF; }
    const bool okc = col >= 0; const float* wp = W + (size_t)(k0 + (lane >> 5)) * Nsrc + (okc ? col : 0); const float* gp = gain + k0 + (lane >> 5);
    float v[32];
#pragma unroll
    for (int i = 0; i < 32; ++i) v[i] = wp[(size_t)(2 * i) * Nsrc];
    if (GAIN) {
#pragma unroll
        for (int i = 0; i < 32; ++i) v[i] *= gp[2 * i]; }
#pragma unroll
    for (int i = 0; i < 32; ++i) scr[(2 * i + (lane >> 5)) * 33 + (lane & 31)] = okc ? v[i] : 0.f;
    LDS_WAIT(); asm volatile("" ::: "memory");
    const int c = lane & 7;
#pragma unroll
    for (int j = 0; j < 4; ++j) { const int n = (lane >> 3) + 8 * j; const LAS float* s = scr + (8 * c) * 33 + n;
        v4u o; o.x = pk2(s[0 * 33], s[1 * 33]); o.y = pk2(s[2 * 33], s[3 * 33]); o.z = pk2(s[4 * 33], s[5 * 33]); o.w = pk2(s[6 * 33], s[7 * 33]);
        *(GAS v4u*)(WT + (size_t)(n0 + n) * K + k0 + 8 * c) = o; }
    LDS_WAIT(); asm volatile("" ::: "memory");
}
__device__ __forceinline__ void row_to_bf16_rstd(const float* xrow, bf16* orow, float* rstd_out, int lane) {
    const GAS f32x4* xr = (const GAS f32x4*)xrow + lane;
    f32x4 v[4]; float s = 0.f;
#pragma unroll
    for (int j = 0; j < 4; ++j) { v[j] = xr[64 * j]; s += (v[j].x * v[j].x + v[j].y * v[j].y) + (v[j].z * v[j].z + v[j].w * v[j].w); }
    const float rstd = 1.0f / sqrtf(wave_sum(s) * (1.f / 1024.f) + 1e-6f);
    GAS unsigned long long* o8 = (GAS unsigned long long*)orow + lane;
#pragma unroll
    for (int j = 0; j < 4; ++j) o8[64 * j] = (unsigned long long)pk2(v[j].x, v[j].y) | ((unsigned long long)pk2(v[j].z, v[j].w) << 32);
    if (lane == 0) *rstd_out = rstd;
}
__device__ __forceinline__ void rows4_to_bf16_rstd(const float* const (&xrow)[4], bf16* const (&orow)[4], float* const (&rout)[4], const bool (&ok)[4], int lane) {
    f32x4 v[4][4];
#pragma unroll
    for (int r = 0; r < 4; ++r) { const GAS f32x4* xr = (const GAS f32x4*)xrow[r] + lane;
#pragma unroll
        for (int j = 0; j < 4; ++j) v[r][j] = xr[64 * j]; }
#pragma unroll
    for (int r = 0; r < 4; ++r) { float s = 0.f;
#pragma unroll
        for (int j = 0; j < 4; ++j) s += (v[r][j].x * v[r][j].x + v[r][j].y * v[r][j].y) + (v[r][j].z * v[r][j].z + v[r][j].w * v[r][j].w);
        const float rstd = 1.0f / sqrtf(wave_sum(s) * (1.f / 1024.f) + 1e-6f);
        if (ok[r]) { GAS unsigned long long* o8 = (GAS unsigned long long*)orow[r] + lane;
#pragma unroll
            for (int j = 0; j < 4; ++j) o8[64 * j] = (unsigned long long)pk2(v[r][j].x, v[r][j].y) | ((unsigned long long)pk2(v[r][j].z, v[r][j].w) << 32);
            if (lane == 0) *rout[r] = rstd; } }
}
typedef float f32x16 __attribute__((ext_vector_type(16)));
typedef unsigned u32x2 __attribute__((ext_vector_type(2)));
__device__ __forceinline__ int crow(int r, int hi) { return (r & 3) + 8 * (r >> 2) + 4 * hi; }
__device__ __forceinline__ float bf2f(bf16 v) { return __uint_as_float((unsigned)v << 16); }
__device__ __forceinline__ unsigned cvtpk(float lo, float hi) { return pg8::cvt_pk_bf16(lo, hi); }
template <int HD, bool FOX, bool VT>
__device__ __forceinline__ void attn_wave_simple(const bf16x8 (&qr)[HD / 16], const bf16* Kp, int kpitch, const bf16* Vp, int vpitch, int tstart, int ntiles, int qlocal, const float* cb, bf16* Op, int opitch, int lane) {
    const int r32 = lane & 31, hi = lane >> 5;
    f32x16 o[HD / 32];
#pragma unroll
    for (int d0 = 0; d0 < HD / 32; ++d0)
#pragma unroll
        for (int r = 0; r < 16; ++r) o[d0][r] = 0.f;
    float m = -1e30f, l = 0.f;
    for (int t = tstart; t < ntiles; ++t) {
        const int kv0 = 32 * t;
        f32x16 p;
#pragma unroll
        for (int r = 0; r < 16; ++r) p[r] = 0.f;
        const bf16* kr = Kp + (size_t)(kv0 + r32) * kpitch + hi * 8;
#pragma unroll
        for (int ks = 0; ks < HD / 16; ++ks) { const bf16x8 kf = *(const bf16x8*)(kr + ks * 16); p = __builtin_amdgcn_mfma_f32_32x32x16_bf16(kf, qr[ks], p, 0, 0, 0); }
        if (FOX) {
#pragma unroll
            for (int g = 0; g < 4; ++g) { const f32x4 c4 = *(const f32x4*)(cb + kv0 + 8 * g + 4 * hi);
#pragma unroll
                for (int jj = 0; jj < 4; ++jj) p[4 * g + jj] -= L2E * c4[jj]; }
            if (t == ntiles - 1) {
#pragma unroll
                for (int r = 0; r < 16; ++r) if (kv0 + crow(r, hi) > qlocal) p[r] = -INFINITY;
            }
        }
        float mt = p[0];
#pragma unroll
        for (int r = 1; r < 16; ++r) mt = fmaxf(mt, p[r]);
        mt = fmaxf(mt, __shfl_xor(mt, 32));
        const float mn = fmaxf(m, mt); const float alpha = __builtin_amdgcn_exp2f(m - mn); m = mn;
        l *= alpha;
#pragma unroll
        for (int d0 = 0; d0 < HD / 32; ++d0)
#pragma unroll
            for (int r = 0; r < 16; ++r) o[d0][r] *= alpha;
        float ls = 0.f;
#pragma unroll
        for (int r = 0; r < 16; ++r) { p[r] = __builtin_amdgcn_exp2f(p[r] - mn); ls += p[r]; }
        l += ls;
        bf16x8 pa[2];
#pragma unroll
        for (int s = 0; s < 2; ++s) { v4u w; w.x = cvtpk(p[8 * s + 0], p[8 * s + 1]); w.y = cvtpk(p[8 * s + 2], p[8 * s + 3]); w.z = cvtpk(p[8 * s + 4], p[8 * s + 5]); w.w = cvtpk(p[8 * s + 6], p[8 * s + 7]); pa[s] = __builtin_bit_cast(bf16x8, w); }
#pragma unroll
        for (int d0 = 0; d0 < HD / 32; ++d0)
#pragma unroll
            for (int s = 0; s < 2; ++s) {
                bf16x8 vf;
                if (VT) {
                    const bf16* vp = Vp + (size_t)(d0 * 32 + r32) * vpitch + kv0 + 16 * s + 4 * hi;
                    const u32x2 lo = *(const u32x2*)vp, hi2 = *(const u32x2*)(vp + 8);
                    vf = __builtin_bit_cast(bf16x8, (v4u){lo.x, lo.y, hi2.x, hi2.y});
                } else {
#pragma unroll
                    for (int j = 0; j < 8; ++j) vf[j] = (short)Vp[(size_t)(kv0 + 16 * s + 8 * (j >> 2) + 4 * hi + (j & 3)) * vpitch + d0 * 32 + r32];
                }
                o[d0] = __builtin_amdgcn_mfma_f32_32x32x16_bf16(vf, pa[s], o[d0], 0, 0, 0);
            }
    }
    l += __shfl_xor(l, 32);
    const float inv = 1.0f / l;
    bf16* orow = Op + (size_t)r32 * opitch;
#pragma unroll
    for (int d0 = 0; d0 < HD / 32; ++d0)
#pragma unroll
        for (int g = 0; g < 4; ++g) { u32x2 w; w.x = cvtpk(o[d0][4 * g] * inv, o[d0][4 * g + 1] * inv); w.y = cvtpk(o[d0][4 * g + 2] * inv, o[d0][4 * g + 3] * inv);
            *(u32x2*)(orow + d0 * 32 + 8 * g + 4 * hi) = w; }
}
__device__ __forceinline__ void fox_unit(int bh, int qb, const bf16* FQ, const bf16* FK, const bf16* FV, const float* CUM, const int* T0, bf16* OA, int wave, int lane) {
    const int b = bh >> 3, h = bh & 7, r32 = lane & 31, hi = lane >> 5; const size_t rowbase = (size_t)b * SEQ; const int q0 = qb * 256 + wave * 32;
    const bf16* Qw = FQ + (rowbase + q0) * 512 + h * 64; bf16* Ow = OA + (rowbase + q0) * 512 + h * 64;
    bf16x8 qr[4];
#pragma unroll
    for (int ks = 0; ks < 4; ++ks) qr[ks] = *(const bf16x8*)(Qw + (size_t)r32 * 512 + ks * 16 + hi * 8);
    attn_wave_simple<64, true, false>(qr, FK + rowbase * 512 + h * 64, 512, FV + rowbase * 512 + h * 64, 512, T0[bh * 256 + q0 / 32], q0 / 32 + 1, q0 + r32, CUM + (size_t)bh * SEQ, Ow, 512, lane);
}
__device__ __forceinline__ void mem_unit(int rg, int head, bf16* MQ, const bf16* KMB, const bf16* VMB, const float* gq, int lane) {
    const int r32 = lane & 31, hi = lane >> 5; const int row0 = rg * 32; const int b = row0 / SEQ;
    bf16* Qw = MQ + (size_t)row0 * 512 + head * 128;
    bf16x8 raw[8]; float ss = 0.f;
#pragma unroll
    for (int ks = 0; ks < 8; ++ks) { raw[ks] = *(const bf16x8*)(Qw + (size_t)r32 * 512 + ks * 16 + hi * 8);
#pragma unroll
        for (int j = 0; j < 8; ++j) { const float f = bf2f((bf16)raw[ks][j]); ss += f * f; } }
    ss += __shfl_xor(ss, 32);
    const float rstd = __builtin_amdgcn_rsqf(ss * (1.0f / 128.0f) + 1e-6f) * C2_128;
    bf16x8 qr[8];
#pragma unroll
    for (int ks = 0; ks < 8; ++ks) { const f32x4 g0 = *(const f32x4*)(gq + ks * 16 + hi * 8), g1 = *(const f32x4*)(gq + ks * 16 + hi * 8 + 4); v4u w;
        w.x = cvtpk(bf2f((bf16)raw[ks][0]) * rstd * g0[0], bf2f((bf16)raw[ks][1]) * rstd * g0[1]); w.y = cvtpk(bf2f((bf16)raw[ks][2]) * rstd * g0[2], bf2f((bf16)raw[ks][3]) * rstd * g0[3]);
        w.z = cvtpk(bf2f((bf16)raw[ks][4]) * rstd * g1[0], bf2f((bf16)raw[ks][5]) * rstd * g1[1]); w.w = cvtpk(bf2f((bf16)raw[ks][6]) * rstd * g1[2], bf2f((bf16)raw[ks][7]) * rstd * g1[3]);
        qr[ks] = __builtin_bit_cast(bf16x8, w); }
    attn_wave_simple<128, false, true>(qr, KMB + (size_t)b * MEMLEN * 512 + head * 128, 512, VMB + (size_t)(b * 4 + head) * 128 * MEMLEN, MEMLEN, 0, MEMLEN / 32, 0, nullptr, Qw, 512, lane);
}
typedef short v4i16_t __attribute__((ext_vector_type(4)));
__device__ __forceinline__ void mem_block(int u, bf16* MQ, const bf16* KMB, const bf16* VNB, const float* gq, LAS unsigned char* lds, int wave, int lane, int tid) {
    const int head = u & 3, rg = (u >> 2) * 8 + wave, row0 = rg * 32, b = row0 / SEQ;
    const int r32 = lane & 31, hi = lane >> 5;
    {   const bf16* ks_ = KMB + (size_t)b * MEMLEN * 512 + head * 128; const bf16* vs_ = VNB + (size_t)b * MEMLEN * 512 + head * 128;
#pragma unroll
        for (int i = 0; i < 8; ++i) { const int e = tid + 512 * i, key = e >> 4, c = e & 15;
            const v4u kv = *(const v4u*)(ks_ + (size_t)key * 512 + c * 8), vv = *(const v4u*)(vs_ + (size_t)key * 512 + c * 8);
            *(LAS v4u*)(lds + key * 256 + ((c ^ (key & 7)) * 16)) = kv; *(LAS v4u*)(lds + 65536 + key * 256 + c * 16) = vv; } }
    bf16* Qw = MQ + (size_t)row0 * 512 + head * 128;
    bf16x8 raw[8]; float ss = 0.f;
#pragma unroll
    for (int ks = 0; ks < 8; ++ks) { raw[ks] = *(const bf16x8*)(Qw + (size_t)r32 * 512 + ks * 16 + hi * 8);
#pragma unroll
        for (int j = 0; j < 8; ++j) { const float f = bf2f((bf16)raw[ks][j]); ss += f * f; } }
    ss += __shfl_xor(ss, 32);
    const float rstd = __builtin_amdgcn_rsqf(ss * (1.0f / 128.0f) + 1e-6f) * C2_128;
    bf16x8 qr[8];
#pragma unroll
    for (int ks = 0; ks < 8; ++ks) { const f32x4 g0 = *(const f32x4*)(gq + ks * 16 + hi * 8), g1 = *(const f32x4*)(gq + ks * 16 + hi * 8 + 4); v4u w;
        w.x = cvtpk(bf2f((bf16)raw[ks][0]) * rstd * g0[0], bf2f((bf16)raw[ks][1]) * rstd * g0[1]); w.y = cvtpk(bf2f((bf16)raw[ks][2]) * rstd * g0[2], bf2f((bf16)raw[ks][3]) * rstd * g0[3]);
        w.z = cvtpk(bf2f((bf16)raw[ks][4]) * rstd * g1[0], bf2f((bf16)raw[ks][5]) * rstd * g1[1]); w.w = cvtpk(bf2f((bf16)raw[ks][6]) * rstd * g1[2], bf2f((bf16)raw[ks][7]) * rstd * g1[3]);
        qr[ks] = __builtin_bit_cast(bf16x8, w); }
    __syncthreads();
    f32x16 o[4];
#pragma unroll
    for (int d0 = 0; d0 < 4; ++d0)
#pragma unroll
        for (int r = 0; r < 16; ++r) o[d0][r] = 0.f;
    float m = -1e30f, l = 0.f;
    const int kq = (lane >> 4) & 1, q_ = (lane & 15) >> 2, p_ = lane & 3;
#pragma unroll 1
    for (int t = 0; t < MEMLEN / 32; ++t) {
        const LAS unsigned char* kb = lds + (32 * t) * 256; const LAS unsigned char* vb = lds + 65536 + (32 * t) * 256;
        f32x16 p;
#pragma unroll
        for (int r = 0; r < 16; ++r) p[r] = 0.f;
#pragma unroll
        for (int ks = 0; ks < 8; ++ks) { const bf16x8 kf = *(const LAS bf16x8*)(kb + r32 * 256 + (((2 * ks + hi) ^ (r32 & 7)) * 16)); p = __builtin_amdgcn_mfma_f32_32x32x16_bf16(kf, qr[ks], p, 0, 0, 0); }
        float mt = p[0];
#pragma unroll
        for (int r = 1; r < 16; ++r) mt = fmaxf(mt, p[r]);
        mt = fmaxf(mt, __shfl_xor(mt, 32));
        if (__any(mt > m)) { const float mn_ = fmaxf(m, mt); const float alpha = __builtin_amdgcn_exp2f(m - mn_); m = mn_; l *= alpha;
#pragma unroll
            for (int d0 = 0; d0 < 4; ++d0)
#pragma unroll
                for (int r = 0; r < 16; ++r) o[d0][r] *= alpha; }
        const float mn = m; float ls = 0.f;
#pragma unroll
        for (int r = 0; r < 16; ++r) { p[r] = __builtin_amdgcn_exp2f(p[r] - mn); ls += p[r]; }
        l += ls;
        bf16x8 pa[2];
#pragma unroll
        for (int s2 = 0; s2 < 2; ++s2) { v4u w; w.x = cvtpk(p[8 * s2 + 0], p[8 * s2 + 1]); w.y = cvtpk(p[8 * s2 + 2], p[8 * s2 + 3]); w.z = cvtpk(p[8 * s2 + 4], p[8 * s2 + 5]); w.w = cvtpk(p[8 * s2 + 6], p[8 * s2 + 7]); pa[s2] = __builtin_bit_cast(bf16x8, w); }
#pragma unroll
        for (int d0 = 0; d0 < 4; ++d0)
#pragma unroll
            for (int s2 = 0; s2 < 2; ++s2) {
                const LAS unsigned char* a1 = vb + (16 * s2 + 4 * hi + q_) * 256 + (32 * d0 + 16 * kq + 4 * p_) * 2;
                const v4i16_t lo4 = __builtin_amdgcn_ds_read_tr16_b64_v4i16((LAS v4i16_t*)a1), hi4 = __builtin_amdgcn_ds_read_tr16_b64_v4i16((LAS v4i16_t*)(a1 + 8 * 256));
                const bf16x8 vf = (bf16x8){lo4[0], lo4[1], lo4[2], lo4[3], hi4[0], hi4[1], hi4[2], hi4[3]};
                o[d0] = __builtin_amdgcn_mfma_f32_32x32x16_bf16(vf, pa[s2], o[d0], 0, 0, 0); }
    }
    l += __shfl_xor(l, 32);
    const float inv = 1.0f / l;
    bf16* orow = Qw + (size_t)r32 * 512;
#pragma unroll
    for (int d0 = 0; d0 < 4; ++d0)
#pragma unroll
        for (int g = 0; g < 4; ++g) { u32x2 w; w.x = cvtpk(o[d0][4 * g] * inv, o[d0][4 * g + 1] * inv); w.y = cvtpk(o[d0][4 * g + 2] * inv, o[d0][4 * g + 3] * inv);
            *(u32x2*)(orow + d0 * 32 + 8 * g + 4 * hi) = w; }
    __syncthreads();
}
__device__ __forceinline__ void scan_unit(int bh, const float* LOGF, float* CUM, int* T0, const float* gq, const float* gk, LAS float* sx, LAS float* cl, int tid) {
    const int b = bh >> 3, h = bh & 7, lane = tid & 63, wave = tid >> 6;
    float v[16]; float run = 0.f;
#pragma unroll
    for (int i = 0; i < 16; ++i) v[i] = LOGF[((size_t)b * SEQ + 16 * tid + i) * 8 + h];
#pragma unroll
    for (int i = 0; i < 16; ++i) { run += v[i]; v[i] = run; }
    float tot = run;
#pragma unroll
    for (int off = 1; off < 64; off <<= 1) { const float nb = __shfl_up(tot, off); if (lane >= off) tot += nb; }
    if (lane == 63) sx[wave] = tot;
    __syncthreads();
    float woff = 0.f;
    for (int w = 0; w < wave; ++w) woff += sx[w];
    const float excl = tot - run + woff;
    float* dst = CUM + (size_t)bh * SEQ + 16 * tid;
#pragma unroll
    for (int i = 0; i < 16; i += 4) { const f32x4 o4 = (f32x4){v[i] + excl, v[i + 1] + excl, v[i + 2] + excl, v[i + 3] + excl}; *(f32x4*)(dst + i) = o4; *(LAS f32x4*)(cl + 16 * tid + i) = o4; }
    const float smax = 8.0f * wave_max(fabsf(gq[lane])) * wave_max(fabsf(gk[lane]));
    __syncthreads();
    if (tid < 256) { const float cq = cl[32 * tid]; const float lim = -(30.0f + 2.0f * smax);
        int lo = 0, hi = tid;
        while (lo < hi) { const int mid = (lo + hi) >> 1; if (cq - cl[32 * mid + 31] >= lim) hi = mid; else lo = mid + 1; }
        T0[bh * 256 + tid] = lo; }
    __syncthreads();
}
constexpr int D2_LST = RING_BYTES + 1024;
constexpr int D2_CNT = RING_BYTES + 3072;
constexpr int D2_CL = RING_BYTES + 4096;
typedef float f32x4d __attribute__((ext_vector_type(4)));
__device__ __forceinline__ unsigned sortable_u32(float f) { const unsigned u = __float_as_uint(f); return u ^ ((u >> 31) ? 0xFFFFFFFFu : 0x80000000u); }
__device__ __forceinline__ int lane_rank(unsigned long long mask) { return (int)__builtin_amdgcn_mbcnt_hi((unsigned)(mask >> 32), __builtin_amdgcn_mbcnt_lo((unsigned)mask, 0u)); }
__device__ __forceinline__ int bcount(bool p) { return (int)__popcll(__ballot(p)); }
__device__ __forceinline__ void select_full(const LAS unsigned* my, int npad, LAS unsigned short* lst, int lane) {
    unsigned thr = 0u;
    for (int bit = 31; bit >= 0; --bit) {
        const unsigned cand = thr | (1u << bit); int cnt = 0;
        for (int i0 = 0; i0 < npad; i0 += 256) { const int idx = i0 + 4 * lane; v4u v = (v4u){0u, 0u, 0u, 0u}; if (idx < npad) v = *(const LAS v4u*)(my + idx);
            cnt += bcount(v.x >= cand) + bcount(v.y >= cand) + bcount(v.z >= cand) + bcount(v.w >= cand); }
        if (cnt >= 256) thr = cand;
    }
    int cgt = 0;
    for (int i0 = 0; i0 < npad; i0 += 256) { const int idx = i0 + 4 * lane; v4u v = (v4u){0u, 0u, 0u, 0u}; if (idx < npad) v = *(const LAS v4u*)(my + idx);
        cgt += bcount(v.x > thr) + bcount(v.y > thr) + bcount(v.z > thr) + bcount(v.w > thr); }
    const int quota = 256 - cgt; int eqseen = 0, nsel = 0;
    for (int base = 0; base < npad; base += 64) { const int idx = base + lane; unsigned u = 0u; if (idx < npad) u = my[idx];
        const bool gt = u > thr, eq = (u == thr);
        const unsigned long long em = __ballot(eq); const int er = eqseen + lane_rank(em);
        const bool sel = gt || (eq && er < quota);
        const unsigned long long sm = __ballot(sel); const int pos = nsel + lane_rank(sm);
        if (sel && pos < 256) lst[pos] = (unsigned short)idx;
        nsel += __popcll(sm); eqseen += __popcll(em); }
}
template <int KMAX> __device__ __forceinline__ void select_cands(const unsigned (&uu)[16], const unsigned (&id)[16], LAS unsigned short* lst, int lane, unsigned lb = 0u) {
    unsigned thr = 0u;
    for (int bit = 31; bit >= 0; --bit) {
        if ((((thr ^ lb) >> bit) >> 1) == 0u && ((lb >> bit) & 1u)) { thr |= (1u << bit); continue; }
        const unsigned cand = thr | (1u << bit); int cnt = 0;
#pragma unroll
        for (int k = 0; k < KMAX; ++k) cnt += bcount(uu[k] >= cand);
        if (cnt >= 256) { thr = cand; if (cnt == 256) break; }
    }
    int cgt = 0, ceq = 0;
#pragma unroll
    for (int k = 0; k < KMAX; ++k) { cgt += bcount(uu[k] > thr); ceq += bcount(uu[k] == thr); }
    const int quota = 256 - cgt; unsigned ilim = 0xFFFFu;
    if (ceq != quota) {
        unsigned I = 0u;
        for (int bit = 12; bit >= 0; --bit) { const unsigned cand = I | (1u << bit); int cnt = 0;
#pragma unroll
            for (int k = 0; k < KMAX; ++k) cnt += bcount(uu[k] == thr && id[k] < cand);
            if (cnt < quota) I = cand; }
        ilim = I;
    }
    int nsel = 0;
#pragma unroll
    for (int k = 0; k < KMAX; ++k) { const bool sel = (uu[k] > thr) || (uu[k] == thr && id[k] <= ilim);
        const unsigned long long sm = __ballot(sel); const int pos = nsel + lane_rank(sm);
        if (sel && pos < 256) lst[pos] = (unsigned short)id[k];
        nsel += __popcll(sm); }
}
__device__ __forceinline__ void dsa2_unit(int b, int qg, const bf16* IQ, const bf16* IK, const float* IW, const bf16* DQ, const bf16* DK, const bf16* DV, bf16* OB, LAS unsigned char* lds, int wave, int lane) {
    LAS unsigned* sc = (LAS unsigned*)lds;
    LAS unsigned short* LST = (LAS unsigned short*)(lds + D2_LST);
    LAS int* CNT = (LAS int*)(lds + D2_CNT);
    LAS unsigned short* CL = (LAS unsigned short*)(lds + D2_CL);
    const int q0 = 4 * qg, r32 = lane & 31, hi = lane >> 5; const size_t rowbase = (size_t)b * SEQ;
    const int ntile = (q0 + 3) / 32 + 1, npad = ntile * 32;
#ifndef REP_A
#define REP_A 1
#define REP_B1 1
#define REP_B2 1
#define REP_C 1
#endif
    for (int repa = 0; repa < REP_A; ++repa)
    {
        const int qi = 2 * ((r32 >> 2) & 1) + (r32 >> 4), hd = 4 * ((r32 >> 3) & 1) + (r32 & 3);
        bf16x8 aq[4];
#pragma unroll
        for (int ks = 0; ks < 4; ++ks) aq[ks] = *(const bf16x8*)(IQ + (rowbase + q0 + qi) * 512 + hd * 64 + ks * 16 + hi * 8);
        const float* w0p = IW + (rowbase + q0 + 2 * hi) * 8;
        const f32x4 w0a = *(const f32x4*)(w0p), w0b = *(const f32x4*)(w0p + 4), w1a = *(const f32x4*)(w0p + 8), w1b = *(const f32x4*)(w0p + 12);
        for (int t = wave; t < ntile; t += 32) {
            bf16x8 bk[4][4];
#pragma unroll
            for (int u = 0; u < 4; ++u) { const int tt = t + 8 * u; const bf16* kr = IK + (rowbase + 32 * (tt < ntile ? tt : t)) * 64 + lane * 8;
#pragma unroll
                for (int ks = 0; ks < 4; ++ks) bk[u][ks] = *(const bf16x8*)(kr + ks * 512); }
#pragma unroll
            for (int u = 0; u < 4; ++u) { const int tt = t + 8 * u;
                if (tt < ntile) {
                    const int key = 32 * tt + r32;
                    f32x16 a;
#pragma unroll
                    for (int r = 0; r < 16; ++r) a[r] = 0.f;
#pragma unroll
                    for (int ks = 0; ks < 4; ++ks) a = __builtin_amdgcn_mfma_f32_32x32x16_bf16(aq[ks], bk[u][ks], a, 0, 0, 0);
                    float s0 = 0.f, s1 = 0.f;
#pragma unroll
                    for (int j = 0; j < 4; ++j) { s0 += w0a[j] * fmaxf(a[j], 0.f); s1 += w1a[j] * fmaxf(a[8 + j], 0.f); }
#pragma unroll
                    for (int j = 0; j < 4; ++j) { s0 += w0b[j] * fmaxf(a[4 + j], 0.f); s1 += w1b[j] * fmaxf(a[12 + j], 0.f); }
                    sc[(2 * hi) * 8192 + key] = (key <= q0 + 2 * hi) ? sortable_u32(s0) : 0u;
                    sc[(2 * hi + 1) * 8192 + key] = (key <= q0 + 2 * hi + 1) ? sortable_u32(s1) : 0u;
                } }
        }
    }
    __syncthreads();
    const int qi = wave & 3, hf = wave >> 2, q = q0 + qi, n = q + 1;
    const LAS unsigned* my = sc + qi * 8192;
    for (int repb = 0; repb < REP_B1; ++repb)
    {
        int c = 0; bool ovf = false;
        if (n > 256) {
            unsigned pivot = 1u;
            if (n > 640) {
                unsigned s[8];
#pragma unroll
                for (int k = 0; k < 8; ++k) s[k] = my[(int)(((unsigned)(lane * 8 + k) * (unsigned)n) >> 9)];
                const int r = (256 * 512 * 7 / 4) / n + 8;
                unsigned t16 = 0u;
                for (int bit = 15; bit >= 0; --bit) { const unsigned cand = (t16 | (1u << bit)) << 16; int cnt = 0;
#pragma unroll
                    for (int k = 0; k < 8; ++k) cnt += bcount(s[k] >= cand);
                    if (cnt >= r) t16 |= (1u << bit); }
                pivot = t16 << 16; if (pivot == 0u) pivot = 1u;
            }
            const int half = ((npad + 511) >> 9) << 8; const int lo = hf * half; const int hiend = (lo + half < npad) ? lo + half : npad;
            LAS unsigned short* cl = CL + wave * 1024;
            for (int i0 = lo; i0 < hiend; i0 += 256) { const int idx = i0 + 4 * lane; v4u v = (v4u){0u, 0u, 0u, 0u}; if (idx < hiend) v = *(const LAS v4u*)(my + idx);
#pragma unroll
                for (int e = 0; e < 4; ++e) { const bool f = v[e] >= pivot; const unsigned long long m = __ballot(f); const int pos = c + lane_rank(m);
                    if (f) { if (pos < 1024) cl[pos] = (unsigned short)(idx + e); }
                    c += __popcll(m); } }
            if (c > 1024) ovf = true;
        }
        if (lane == 0) CNT[wave] = ovf ? -1 : c;
    }
    __syncthreads();
    for (int repb2 = 0; repb2 < REP_B2; ++repb2)
    if (wave < 4) {
        LAS unsigned short* lst = LST + wave * 256; int nsel;
        if (n <= 256) { for (int i = lane; i < n; i += 64) lst[i] = (unsigned short)i; nsel = n; }
        else {
            const int c0 = CNT[wave], c1 = CNT[wave + 4]; const int c = c0 + c1;
            if (c0 < 0 || c1 < 0 || c < 256 || c > 1024) select_full(my, npad, lst, lane);
            else {
                unsigned uu[16], id[16];
#pragma unroll
                for (int k = 0; k < 16; ++k) { const int j = k * 64 + lane; unsigned ix = 0u, u = 0u;
                    if (j < c) { ix = (j < c0) ? (unsigned)CL[wave * 1024 + j] : (unsigned)CL[(wave + 4) * 1024 + (j - c0)]; u = my[ix]; }
                    uu[k] = u; id[k] = ix; }
                if (c <= 512) select_cands<8>(uu, id, lst, lane); else select_cands<16>(uu, id, lst, lane);
            }
            nsel = 256;
        }
        if (lane == 0) CNT[8 + wave] = nsel;
    }
    __syncthreads();
    for (int repc = 0; repc < REP_C; ++repc)
    {
        const int nsel = CNT[8 + qi]; const int j0 = 128 * hf; int cntk = nsel - j0; cntk = cntk < 0 ? 0 : (cntk > 128 ? 128 : cntk);
        const LAS unsigned short* lst = LST + qi * 256;
        LAS unsigned char* tile = lds + wave * 16384;
        LAS float* tf = (LAS float*)tile;
        const int l15 = lane & 15, kq = lane >> 4;
        if (cntk == 0) {
#pragma unroll
            for (int i = 0; i < 8; ++i) tf[i * 64 + lane] = 0.f;
            if (lane < 8) { tf[512 + lane] = -INFINITY; tf[520 + lane] = 0.f; }
        } else {
#pragma unroll
            for (int it = 0; it < 16; ++it) { const int r = 8 * it + (lane >> 3), ch = lane & 7; int j = j0 + r; j = j < nsel ? j : nsel - 1;
                const int idxv = (int)lst[j]; const v4u v = *(const v4u*)(DV + (rowbase + idxv) * 64 + 8 * ch);
                *(LAS v4u*)(tile + r * 128 + ch * 16) = v; }
            bf16x8 qf[2];
#pragma unroll
            for (int ks = 0; ks < 2; ++ks) { v4u z = (v4u){0u, 0u, 0u, 0u}; if (l15 < 8) z = *(const v4u*)(DQ + (rowbase + q) * 512 + l15 * 64 + 32 * ks + 8 * kq); qf[ks] = __builtin_bit_cast(bf16x8, z); }
            f32x4d acc[8];
#pragma unroll
            for (int g = 0; g < 8; ++g) { int j = j0 + 16 * g + l15; j = j < nsel ? j : nsel - 1; const int idxk = (int)lst[j];
                const bf16* kp = DK + (rowbase + idxk) * 64 + 8 * kq;
                const bf16x8 k0 = *(const bf16x8*)(kp), k1 = *(const bf16x8*)(kp + 32);
                f32x4d a = (f32x4d){0.f, 0.f, 0.f, 0.f};
                a = __builtin_amdgcn_mfma_f32_16x16x32_bf16(k0, qf[0], a, 0, 0, 0); a = __builtin_amdgcn_mfma_f32_16x16x32_bf16(k1, qf[1], a, 0, 0, 0); acc[g] = a; }
            float mx = -INFINITY;
#pragma unroll
            for (int g = 0; g < 8; ++g)
#pragma unroll
                for (int e = 0; e < 4; ++e) { if (16 * g + 4 * kq + e >= cntk) acc[g][e] = -INFINITY; mx = fmaxf(mx, acc[g][e]); }
            mx = fmaxf(mx, __shfl_xor(mx, 16)); mx = fmaxf(mx, __shfl_xor(mx, 32));
            float ls = 0.f;
#pragma unroll
            for (int g = 0; g < 8; ++g)
#pragma unroll
                for (int e = 0; e < 4; ++e) { acc[g][e] = __builtin_amdgcn_exp2f(acc[g][e] - mx); ls += acc[g][e]; }
            ls += __shfl_xor(ls, 16); ls += __shfl_xor(ls, 32);
            bf16x8 pa[4];
#pragma unroll
            for (int t = 0; t < 4; ++t) { v4u w; w.x = cvtpk(acc[2 * t][0], acc[2 * t][1]); w.y = cvtpk(acc[2 * t][2], acc[2 * t][3]); w.z = cvtpk(acc[2 * t + 1][0], acc[2 * t + 1][1]); w.w = cvtpk(acc[2 * t + 1][2], acc[2 * t + 1][3]); pa[t] = __builtin_bit_cast(bf16x8, w); }
            f32x4d o[4];
            const int q_ = l15 >> 2, p_ = lane & 3;
#pragma unroll
            for (int cb = 0; cb < 4; ++cb) { f32x4d oc = (f32x4d){0.f, 0.f, 0.f, 0.f};
#pragma unroll
                for (int t = 0; t < 4; ++t) {
                    const LAS unsigned char* a1 = tile + (32 * t + 4 * kq + q_) * 128 + (16 * cb + 4 * p_) * 2;
                    const v4i16_t lo4 = __builtin_amdgcn_ds_read_tr16_b64_v4i16((LAS v4i16_t*)a1), hi4 = __builtin_amdgcn_ds_read_tr16_b64_v4i16((LAS v4i16_t*)(a1 + 16 * 128));
                    const bf16x8 vf = (bf16x8){lo4[0], lo4[1], lo4[2], lo4[3], hi4[0], hi4[1], hi4[2], hi4[3]};
                    oc = __builtin_amdgcn_mfma_f32_16x16x32_bf16(pa[t], vf, oc, 0, 0, 0); }
                o[cb] = oc; }
            if (kq < 2) {
#pragma unroll
                for (int cb = 0; cb < 4; ++cb)
#pragma unroll
                    for (int e = 0; e < 4; ++e) tf[(4 * kq + e) * 64 + 16 * cb + l15] = o[cb][e];
            }
            if (lane < 8) { tf[512 + lane] = mx; tf[520 + lane] = ls; }
        }
    }
    __syncthreads();
    if (wave < 4) {
        const LAS float* ta = (const LAS float*)(lds + wave * 16384); const LAS float* tb = (const LAS float*)(lds + (wave + 4) * 16384);
        const int h = lane >> 3, d0 = (lane & 7) * 8;
        const float ma = ta[512 + h], mb = tb[512 + h], la = ta[520 + h], lb = tb[520 + h];
        const float m = fmaxf(ma, mb), fa = __builtin_amdgcn_exp2f(ma - m), fb = __builtin_amdgcn_exp2f(mb - m);
        const float inv = 1.0f / (la * fa + lb * fb);
        const f32x4 a0 = *(const LAS f32x4*)(ta + h * 64 + d0), a1 = *(const LAS f32x4*)(ta + h * 64 + d0 + 4), b0 = *(const LAS f32x4*)(tb + h * 64 + d0), b1 = *(const LAS f32x4*)(tb + h * 64 + d0 + 4);
        const f32x4 r0 = (a0 * fa + b0 * fb) * inv, r1 = (a1 * fa + b1 * fb) * inv;
        v4u w; w.x = cvtpk(r0[0], r0[1]); w.y = cvtpk(r0[2], r0[3]); w.z = cvtpk(r1[0], r1[1]); w.w = cvtpk(r1[2], r1[3]);
        *(v4u*)(OB + (rowbase + q) * 512 + h * 64 + d0) = w;
    }
    __syncthreads();
}
constexpr int D3_RING = RING_BYTES + 1024;
constexpr int D3_LST = D3_RING + 16384;
constexpr int D3_CNT = D3_LST + 8192;
constexpr int D3_QW = D3_CNT + 512;
typedef unsigned long long u64d;
template <int KMAX> __device__ __forceinline__ void select_cands3(const unsigned (&uu)[16], const unsigned (&id)[16], LAS unsigned short* lst, int lane) { select_cands<KMAX>(uu, id, lst, lane); }
__device__ __forceinline__ void dsa3_unit(int b, int g16, const bf16* IQ, const bf16* IK, const float* IW, const bf16* DQ, const bf16* DK, const bf16* DV, bf16* OB, LAS unsigned char* lds, int wave, int lane_in) {
    int lane = lane_in; asm volatile("" : "+v"(lane));
    LAS u64d* LISTS = (LAS u64d*)lds;
    LAS unsigned short* LST = (LAS unsigned short*)(lds + D3_LST);
    LAS int* CNT = (LAS int*)(lds + D3_CNT);
    const int tid = wave * 64 + lane, r32 = lane & 31, hi = lane >> 5; const size_t rowbase = (size_t)b * SEQ;
    const int q0 = 16 * g16, ntile = (q0 + 15) / 32 + 1, nstep = (ntile + 1) >> 1;
    const int qgrp = wave & 3, par = wave >> 2;
    const int qA = q0 + 4 * qgrp + 2 * hi, qB = qA + 1;
    const int qi = 2 * ((r32 >> 2) & 1) + (r32 >> 4), hd = 4 * ((r32 >> 3) & 1) + (r32 & 3);
    bf16x8 aq[4];
#pragma unroll
    for (int ks = 0; ks < 4; ++ks) aq[ks] = *(const bf16x8*)(IQ + (rowbase + q0 + 4 * qgrp + qi) * 512 + hd * 64 + ks * 16 + hi * 8);
    const float* w0p = IW + (rowbase + qA) * 8;
    const f32x4 w0a = *(const f32x4*)(w0p), w0b = *(const f32x4*)(w0p + 4), w1a = *(const f32x4*)(w0p + 8), w1b = *(const f32x4*)(w0p + 12);
    f32x4 l0a, l0b, l1a, l1b;
#pragma unroll
    for (int j = 0; j < 4; ++j) { l0a[j] = w0a[j] >= 0.f ? INFINITY : -INFINITY; l0b[j] = w0b[j] >= 0.f ? INFINITY : -INFINITY; l1a[j] = w1a[j] >= 0.f ? INFINITY : -INFINITY; l1b[j] = w1b[j] >= 0.f ? INFINITY : -INFINITY; }
#define D3_SCORE(BK, S0, S1) do { f32x16 a_; _Pragma("unroll") for (int r = 0; r < 16; ++r) a_[r] = 0.f; \
        _Pragma("unroll") for (int ks = 0; ks < 4; ++ks) a_ = __builtin_amdgcn_mfma_f32_32x32x16_bf16(aq[ks], BK[ks], a_, 0, 0, 0); \
        S0 = 0.f; S1 = 0.f; \
        _Pragma("unroll") for (int j = 0; j < 4; ++j) { S0 += __builtin_amdgcn_fmed3f(w0a[j] * a_[j], 0.f, l0a[j]); S1 += __builtin_amdgcn_fmed3f(w1a[j] * a_[8 + j], 0.f, l1a[j]); } \
        _Pragma("unroll") for (int j = 0; j < 4; ++j) { S0 += __builtin_amdgcn_fmed3f(w0b[j] * a_[4 + j], 0.f, l0b[j]); S1 += __builtin_amdgcn_fmed3f(w1b[j] * a_[12 + j], 0.f, l1b[j]); } } while (0)
#ifndef REP_S
#define REP_S 1
#define REP_M 1
#define REP_B 1
#define REP_CD 1
#endif
    unsigned pivA = 1u, pivB = 1u;
    if (ntile <= 16 && tid < 16) CNT[64 + tid] = 0;
    for (int reps = 0; reps < REP_S; ++reps)
    if (ntile > 16) {
#pragma unroll
        for (int k = 0; k < 4; ++k) { const int c = tid + 512 * k; const int ts = ((c >> 8) * ntile) >> 3;
            *(LAS v4u*)(lds + c * 16) = *(const v4u*)(IK + (rowbase + 32 * ts) * 64 + (c & 255) * 8); }
        __syncthreads();
        unsigned uA[8], uB[8];
#pragma unroll
        for (int i = 0; i < 8; ++i) { bf16x8 bk[4];
#pragma unroll
            for (int ks = 0; ks < 4; ++ks) bk[ks] = *(const LAS bf16x8*)(lds + i * 4096 + ks * 1024 + lane * 16);
            float s0, s1; D3_SCORE(bk, s0, s1); uA[i] = sortable_u32(s0); uB[i] = sortable_u32(s1); asm volatile("" ::: "memory"); }
        const int qs = q0 + 4 * qgrp + par;
        const int r0 = (256 * 256 * 7 / 4) / (qs + 1) + 6, r1 = (256 * 256 * 7 / 4) / (qs + 3) + 6;
        unsigned us[8];
#pragma unroll
        for (int i = 0; i < 8; ++i) us[i] = par ? uB[i] : uA[i];
        unsigned t0 = 0u, t1 = 0u;
        for (int bit = 15; bit >= 0; --bit) {
            const unsigned c = ((hi ? t1 : t0) | (1u << bit)) << 16; int n0 = 0, n1 = 0;
#pragma unroll
            for (int i = 0; i < 8; ++i) { const unsigned long long m = __builtin_amdgcn_ballot_w64(us[i] >= c); n0 += __popc((unsigned)m); n1 += __popc((unsigned)(m >> 32)); }
            if (n0 >= r0) t0 |= (1u << bit);
            if (n1 >= r1) t1 |= (1u << bit);
        }
        LAS unsigned* PV = (LAS unsigned*)(CNT + 64);
        if (lane == 0) { PV[4 * qgrp + par] = t0; PV[4 * qgrp + 2 + par] = t1; }
        __syncthreads();
        const unsigned tA = PV[4 * qgrp + 2 * hi], tB = PV[4 * qgrp + 2 * hi + 1];
        pivA = tA << 16; pivB = tB << 16; if (pivA == 0u) pivA = 1u; if (pivB == 0u) pivB = 1u;
        __syncthreads();
    }
    for (int repm = 0; repm < REP_M; ++repm)
    {
        const bf16* src0 = IK + rowbase * 64 + (size_t)(tid & 255) * 8;
#define D3_LOAD(k_) (*(const v4u*)(src0 + (size_t)32 * ((2 * (k_) + (tid >> 8)) < ntile ? (2 * (k_) + (tid >> 8)) : ntile - 1) * 64))
        v4u st0 = (v4u){0u, 0u, 0u, 0u}, st1 = st0, st2 = st0, st3 = st0;
        st0 = D3_LOAD(0); st1 = D3_LOAD(1); st2 = D3_LOAD(2); st3 = D3_LOAD(3);
        *(LAS v4u*)(lds + D3_RING + tid * 16) = st0;
        __syncthreads();
        int cntA = 0, cntB = 0;
        LAS u64d* lA = LISTS + ((4 * qgrp + 2 * hi) * 2 + par) * 512; LAS u64d* lB = lA + 1024;
        LAS u64d* dmy = (LAS u64d*)(lds + D3_QW + 64) + lane;
        f32x16 acc;
#pragma unroll
        for (int r = 0; r < 16; ++r) acc[r] = 0.f;
#define D3_SUMS(S0, S1) do { S0 = 0.f; S1 = 0.f; \
            _Pragma("unroll") for (int j = 0; j < 4; ++j) { S0 += __builtin_amdgcn_fmed3f(w0a[j] * acc[j], 0.f, l0a[j]); S1 += __builtin_amdgcn_fmed3f(w1a[j] * acc[8 + j], 0.f, l1a[j]); } \
            _Pragma("unroll") for (int j = 0; j < 4; ++j) { S0 += __builtin_amdgcn_fmed3f(w0b[j] * acc[4 + j], 0.f, l0b[j]); S1 += __builtin_amdgcn_fmed3f(w1b[j] * acc[12 + j], 0.f, l1b[j]); } } while (0)
#define D3_FILTER(TP, S0, S1) do { const int key = 32 * (TP) + r32; const unsigned u0 = sortable_u32(S0), u1 = sortable_u32(S1);     \
                const bool psa = (key <= qA) && (u0 >= pivA), psb = (key <= qB) && (u1 >= pivB); \
                const unsigned long long ma = __ballot(psa), mb = __ballot(psb); const unsigned mla = (unsigned)ma, mha = (unsigned)(ma >> 32), mlb = (unsigned)mb, mhb = (unsigned)(mb >> 32); \
                const int posa = cntA + (int)__builtin_amdgcn_mbcnt_hi(mha, __builtin_amdgcn_mbcnt_lo(mla, 0u)) - (hi ? __popc(mla) : 0); \
                const int posb = cntB + (int)__builtin_amdgcn_mbcnt_hi(mhb, __builtin_amdgcn_mbcnt_lo(mlb, 0u)) - (hi ? __popc(mlb) : 0); \
                LAS u64d* wa_ = (psa && posa < 512) ? lA + posa : dmy; LAS u64d* wb_ = (psb && posb < 512) ? lB + posb : dmy; \
                *wa_ = ((u64d)(unsigned)key << 32) | u0; *wb_ = ((u64d)(unsigned)key << 32) | u1; \
                cntA += hi ? __popc(mha) : __popc(mla); cntB += hi ? __popc(mhb) : __popc(mlb); } while (0)
#define D3_STEP(k_, STNEXT, STFREE) do { \
            STFREE = D3_LOAD((k_) + 4); \
            const int tp_ = 2 * (k_) - 2 + par; \
            const LAS unsigned char* sb = lds + D3_RING + ((k_) & 1) * 8192 + par * 4096; bf16x8 bk[4]; \
            _Pragma("unroll") for (int ks = 0; ks < 4; ++ks) bk[ks] = *(const LAS bf16x8*)(sb + ks * 1024 + lane * 16); \
            __builtin_amdgcn_sched_barrier(0); \
            float s0, s1; D3_SUMS(s0, s1); asm volatile("" : "+v"(s0), "+v"(s1));     \
            __builtin_amdgcn_sched_barrier(0); \
            _Pragma("unroll") for (int r = 0; r < 16; ++r) acc[r] = 0.f; \
            _Pragma("unroll") for (int ks = 0; ks < 4; ++ks) acc = __builtin_amdgcn_mfma_f32_32x32x16_bf16(aq[ks], bk[ks], acc, 0, 0, 0); \
            __builtin_amdgcn_sched_barrier(0); \
            if (tp_ >= 0 && tp_ < ntile) D3_FILTER(tp_, s0, s1); \
            *(LAS v4u*)(lds + D3_RING + (((k_) + 1) & 1) * 8192 + tid * 16) = STNEXT; \
            asm volatile("s_waitcnt lgkmcnt(0)" ::: "memory"); __builtin_amdgcn_s_barrier(); asm volatile("" ::: "memory"); } while (0)
        int kend = 0;
        for (int k = 0; k < nstep; k += 4) {
            D3_STEP(k, st1, st0); D3_STEP(k + 1, st2, st1); D3_STEP(k + 2, st3, st2); D3_STEP(k + 3, st0, st3); kend = k + 4;
        }
        {   const int tp_ = 2 * kend - 2 + par; if (tp_ < ntile) { float s0, s1; D3_SUMS(s0, s1); D3_FILTER(tp_, s0, s1); } }
#undef D3_SUMS
#undef D3_FILTER
#undef D3_STEP
#undef D3_LOAD
        if (r32 == 0) { CNT[(4 * qgrp + 2 * hi) * 2 + par] = cntA; CNT[(4 * qgrp + 2 * hi + 1) * 2 + par] = cntB; }
        if (tid < 4) CNT[48 + tid] = 0;
    }
#undef D3_SCORE
    __syncthreads();
#if defined(DBG_D3_STAGE) && DBG_D3_STAGE == 1
    for (int grp = 0; grp < 4; ++grp) dsa2_unit(b, 4 * g16 + grp, IQ, IK, IW, DQ, DK, DV, OB, lds, wave, lane);
    return;
#endif
#pragma unroll 1
    for (int rr = 0; rr < 2 * REP_B; ++rr) {
        const int qx = wave + 8 * (rr & 1), q = q0 + qx, n = q + 1; LAS unsigned short* lst = LST + qx * 256; int nsel;
        if (n <= 256) { for (int i = lane; i < n; i += 64) lst[i] = (unsigned short)i; nsel = n; }
        else {
            const int c0 = CNT[2 * qx], c1 = CNT[2 * qx + 1]; const int c = c0 + c1;
#ifdef DBG_D3_ALLFAIL
            if (true) { if (lane == 0) CNT[48 + (qx >> 2)] = 1; nsel = 0; }
#else
            if (c0 > 512 || c1 > 512 || c < 256) { if (lane == 0) CNT[48 + (qx >> 2)] = 1; nsel = 0; }
#endif
            else {
                unsigned uu[16], id[16]; const LAS u64d* L0 = LISTS + (qx * 2) * 512; const LAS u64d* L1 = L0 + 512;
#pragma unroll
                for (int k = 0; k < 16; ++k) { const int j = k * 64 + lane, jj = j < c ? j : c - 1;
                    const u64d e = *((jj < c0) ? (L0 + jj) : (L1 + (jj - c0))); uu[k] = j < c ? (unsigned)e : 0u; id[k] = (unsigned)(e >> 32); }
                const unsigned lb = (unsigned)CNT[64 + qx] << 16;
                if (c <= 512) select_cands<8>(uu, id, lst, lane, lb); else if (c <= 640) select_cands<10>(uu, id, lst, lane, lb); else if (c <= 768) select_cands<12>(uu, id, lst, lane, lb); else select_cands<16>(uu, id, lst, lane, lb);
                nsel = 256;
            }
        }
        if (lane == 0) CNT[32 + qx] = nsel;
    }
    __syncthreads();
#pragma unroll 1
    for (int rr_ = 0; rr_ < 2 * REP_CD; ++rr_) { const int rr = rr_ & 1;
        const int qx = wave + 8 * rr, q = q0 + qx; const int nsel = CNT[32 + qx];
        const LAS unsigned short* lst = LST + qx * 256;
        LAS unsigned char* tile = lds + wave * 16384; LAS float* tf = (LAS float*)tile;
        const int l15 = lane & 15, kq = lane >> 4, q_ = l15 >> 2, p_ = lane & 3;
        bf16x8 qf[2];
#pragma unroll
        for (int ks = 0; ks < 2; ++ks) { v4u z = (v4u){0u, 0u, 0u, 0u}; if (l15 < 8) z = *(const v4u*)(DQ + (rowbase + q) * 512 + l15 * 64 + 32 * ks + 8 * kq); qf[ks] = __builtin_bit_cast(bf16x8, z); }
        float mrun = -INFINITY, lrun = 0.f; f32x4d orun[4];
#pragma unroll
        for (int cb = 0; cb < 4; ++cb) orun[cb] = (f32x4d){0.f, 0.f, 0.f, 0.f};
#pragma unroll 1
        for (int hf = 0; hf < 2; ++hf) {
            const int j0 = 128 * hf; int cntk = nsel - j0; cntk = cntk > 128 ? 128 : cntk;
            if (cntk <= 0) break;
            int iv[16], ik[8];
#pragma unroll
            for (int it = 0; it < 16; ++it) { int j = j0 + 8 * it + (lane >> 3); j = j < nsel ? j : nsel - 1; iv[it] = (int)lst[j]; }
#pragma unroll
            for (int g = 0; g < 8; ++g) { int j = j0 + 16 * g + l15; j = j < nsel ? j : nsel - 1; ik[g] = (int)lst[j]; }
            asm volatile("s_waitcnt lgkmcnt(0)" ::: "memory");
#pragma unroll
            for (int it = 0; it < 16; ++it)
                __builtin_amdgcn_global_load_lds((const unsigned*)(DV + (rowbase + iv[it]) * 64 + 8 * (lane & 7)), (LAS unsigned*)(tile + it * 1024), 16, 0, 0);
            bf16x8 kk0[8], kk1[8];
#pragma unroll
            for (int g = 0; g < 8; ++g) { const bf16* kp = DK + (rowbase + ik[g]) * 64 + 8 * kq; kk0[g] = *(const bf16x8*)(kp); kk1[g] = *(const bf16x8*)(kp + 32); }
            asm volatile("" ::: "memory");
            f32x4d acc[8];
#pragma unroll
            for (int g = 0; g < 8; ++g) { f32x4d a = (f32x4d){0.f, 0.f, 0.f, 0.f};
                a = __builtin_amdgcn_mfma_f32_16x16x32_bf16(kk0[g], qf[0], a, 0, 0, 0); a = __builtin_amdgcn_mfma_f32_16x16x32_bf16(kk1[g], qf[1], a, 0, 0, 0); acc[g] = a; }
            float mx = -INFINITY;
#pragma unroll
            for (int g = 0; g < 8; ++g)
#pragma unroll
                for (int e = 0; e < 4; ++e) { if (16 * g + 4 * kq + e >= cntk) acc[g][e] = -INFINITY; mx = fmaxf(mx, acc[g][e]); }
            mx = fmaxf(mx, __shfl_xor(mx, 16)); mx = fmaxf(mx, __shfl_xor(mx, 32));
            const float mnew = fmaxf(mrun, mx), fold = __builtin_amdgcn_exp2f(mrun - mnew);
            float ls = 0.f;
#pragma unroll
            for (int g = 0; g < 8; ++g)
#pragma unroll
                for (int e = 0; e < 4; ++e) { acc[g][e] = __builtin_amdgcn_exp2f(acc[g][e] - mnew); ls += acc[g][e]; }
            ls += __shfl_xor(ls, 16); ls += __shfl_xor(ls, 32);
            lrun = lrun * fold + ls; mrun = mnew;
            float fo[4];
#pragma unroll
            for (int e = 0; e < 4; ++e) fo[e] = __shfl(fold, 4 * kq + e);
            asm volatile("s_waitcnt vmcnt(0)" ::: "memory");
            bf16x8 pa[4];
#pragma unroll
            for (int t = 0; t < 4; ++t) { v4u w; w.x = cvtpk(acc[2 * t][0], acc[2 * t][1]); w.y = cvtpk(acc[2 * t][2], acc[2 * t][3]); w.z = cvtpk(acc[2 * t + 1][0], acc[2 * t + 1][1]); w.w = cvtpk(acc[2 * t + 1][2], acc[2 * t + 1][3]); pa[t] = __builtin_bit_cast(bf16x8, w); }
#pragma unroll
            for (int cb = 0; cb < 4; ++cb) { f32x4d oc = orun[cb];
#pragma unroll
                for (int e = 0; e < 4; ++e) oc[e] *= fo[e];
#pragma unroll
                for (int t = 0; t < 4; ++t) {
                    const LAS unsigned char* a1 = tile + (32 * t + 4 * kq + q_) * 128 + (16 * cb + 4 * p_) * 2;
                    const v4i16_t lo4 = __builtin_amdgcn_ds_read_tr16_b64_v4i16((LAS v4i16_t*)a1), hi4 = __builtin_amdgcn_ds_read_tr16_b64_v4i16((LAS v4i16_t*)(a1 + 16 * 128));
                    const bf16x8 vf = (bf16x8){lo4[0], lo4[1], lo4[2], lo4[3], hi4[0], hi4[1], hi4[2], hi4[3]};
                    oc = __builtin_amdgcn_mfma_f32_16x16x32_bf16(pa[t], vf, oc, 0, 0, 0); }
                orun[cb] = oc; }
        }
        float li[4];
#pragma unroll
        for (int e = 0; e < 4; ++e) li[e] = 1.0f / __shfl(lrun, 4 * kq + e);
        if (kq < 2) {
#pragma unroll
            for (int cb = 0; cb < 4; ++cb)
#pragma unroll
                for (int e = 0; e < 4; ++e) tf[(4 * kq + e) * 64 + 16 * cb + l15] = orun[cb][e] * li[e];
        }
        { const int h = lane >> 3, d0 = (lane & 7) * 8;
          const f32x4 r0 = *(const LAS f32x4*)(tf + h * 64 + d0), r1 = *(const LAS f32x4*)(tf + h * 64 + d0 + 4);
          v4u w; w.x = cvtpk(r0[0], r0[1]); w.y = cvtpk(r0[2], r0[3]); w.z = cvtpk(r1[0], r1[1]); w.w = cvtpk(r1[2], r1[3]);
          *(v4u*)(OB + (rowbase + q) * 512 + h * 64 + d0) = w; }
    }
    __syncthreads();
    const int f0 = CNT[48], f1 = CNT[49], f2 = CNT[50], f3 = CNT[51];
    __syncthreads();
    const int fm = (f0 ? 1 : 0) | (f1 ? 2 : 0) | (f2 ? 4 : 0) | (f3 ? 8 : 0);
#pragma unroll 1
    for (int grp = 0; grp < 4; ++grp) if ((fm >> grp) & 1) dsa2_unit(b, 4 * g16 + grp, IQ, IK, IW, DQ, DK, DV, OB, lds, wave, lane);
}
__device__ __forceinline__ void fox_unit2(int bh, int qb, const bf16* FQ, const bf16* FK, const bf16* FV, const float* CUM, const int* T0, bf16* OA, LAS unsigned char* lds, int wave, int lane) {
    const int b = bh >> 3, h = bh & 7, r32 = lane & 31, hi = lane >> 5; const size_t rowbase = (size_t)b * SEQ; const int q0 = qb * 256 + wave * 32;
    const bf16* Qw = FQ + (rowbase + q0) * 512 + h * 64; bf16* Ow = OA + (rowbase + q0) * 512 + h * 64;
    const bf16* Kp = FK + rowbase * 512 + h * 64; const bf16* Vp = FV + rowbase * 512 + h * 64; const float* cb = CUM + (size_t)bh * SEQ;
    LAS unsigned char* wl = lds + wave * 16384;
    LAS float* bl = (LAS float*)(lds + RING_BYTES + 8192 + wave * 256);
    bf16x8 qr[4];
#pragma unroll
    for (int ks = 0; ks < 4; ++ks) qr[ks] = *(const bf16x8*)(Qw + (size_t)r32 * 512 + ks * 16 + hi * 8);
    const int tstart = T0[bh * 256 + q0 / 32], ntiles = q0 / 32 + 1, qlocal = q0 + r32;
    f32x16 o[2];
#pragma unroll
    for (int d0 = 0; d0 < 2; ++d0)
#pragma unroll
        for (int r = 0; r < 16; ++r) o[d0][r] = 0.f;
    float m = -1e30f, l = 0.f;
    const int lrow = lane >> 3, lch = lane & 7;
#define FOX_LOAD(KR, VR, BR, tt) do { _Pragma("unroll") for (int it = 0; it < 4; ++it) { const size_t ro = (size_t)(32 * (tt) + 8 * it + lrow) * 512 + lch * 8; KR[it] = *(const v4u*)(Kp + ro); VR[it] = *(const v4u*)(Vp + ro); } BR = cb[32 * (tt) + r32]; } while (0)
#define FOX_STORE(KR, VR, BR, bf) do { _Pragma("unroll") for (int it = 0; it < 4; ++it) { const int row = 8 * it + lrow; *(LAS v4u*)(wl + (bf) * 4096 + row * 128 + ((lch ^ (row & 7)) * 16)) = KR[it]; *(LAS v4u*)(wl + 8192 + (bf) * 4096 + row * 128 + lch * 16) = VR[it]; } if (lane < 32) bl[(bf) * 32 + lane] = -L2E * BR; } while (0)
    v4u krA[4], vrA[4], krB[4], vrB[4]; float brA = 0.f, brB = 0.f;
    const int kq = (lane >> 4) & 1, q_ = (lane & 15) >> 2, p_ = lane & 3;
    FOX_LOAD(krA, vrA, brA, tstart);
    if (tstart + 1 < ntiles) FOX_LOAD(krB, vrB, brB, tstart + 1);
    FOX_STORE(krA, vrA, brA, 0);
    auto compute = [&](int t, int buf) {
        const LAS unsigned char* kb = wl + buf * 4096; const LAS unsigned char* vb = wl + 8192 + buf * 4096; const LAS float* bb = bl + buf * 32;
        f32x16 p;
#pragma unroll
        for (int r = 0; r < 16; ++r) p[r] = 0.f;
#pragma unroll
        for (int ks = 0; ks < 4; ++ks) { const bf16x8 kf = *(const LAS bf16x8*)(kb + r32 * 128 + (((2 * ks + hi) ^ (r32 & 7)) * 16)); p = __builtin_amdgcn_mfma_f32_32x32x16_bf16(kf, qr[ks], p, 0, 0, 0); }
#pragma unroll
        for (int g = 0; g < 4; ++g) { const f32x4 c4 = *(const LAS f32x4*)(bb + 8 * g + 4 * hi);
#pragma unroll
            for (int jj = 0; jj < 4; ++jj) p[4 * g + jj] += c4[jj]; }
        if (t == ntiles - 1) {
#pragma unroll
            for (int r = 0; r < 16; ++r) if (32 * t + crow(r, hi) > qlocal) p[r] = -INFINITY;
        }
        float mt = p[0];
#pragma unroll
        for (int r = 1; r < 16; ++r) mt = fmaxf(mt, p[r]);
        mt = fmaxf(mt, __shfl_xor(mt, 32));
        const float mn = fmaxf(m, mt); const float alpha = __builtin_amdgcn_exp2f(m - mn); m = mn;
        l *= alpha;
#pragma unroll
        for (int d0 = 0; d0 < 2; ++d0)
#pragma unroll
            for (int r = 0; r < 16; ++r) o[d0][r] *= alpha;
        float ls = 0.f;
#pragma unroll
        for (int r = 0; r < 16; ++r) { p[r] = __builtin_amdgcn_exp2f(p[r] - mn); ls += p[r]; }
        l += ls;
        bf16x8 pa[2];
#pragma unroll
        for (int s2 = 0; s2 < 2; ++s2) { v4u w; w.x = cvtpk(p[8 * s2 + 0], p[8 * s2 + 1]); w.y = cvtpk(p[8 * s2 + 2], p[8 * s2 + 3]); w.z = cvtpk(p[8 * s2 + 4], p[8 * s2 + 5]); w.w = cvtpk(p[8 * s2 + 6], p[8 * s2 + 7]); pa[s2] = __builtin_bit_cast(bf16x8, w); }
#pragma unroll
        for (int d0 = 0; d0 < 2; ++d0)
#pragma unroll
            for (int s2 = 0; s2 < 2; ++s2) {
                const LAS unsigned char* a1 = vb + (16 * s2 + 4 * hi + q_) * 128 + (32 * d0 + 16 * kq + 4 * p_) * 2;
                const v4i16_t lo4 = __builtin_amdgcn_ds_read_tr16_b64_v4i16((LAS v4i16_t*)a1), hi4 = __builtin_amdgcn_ds_read_tr16_b64_v4i16((LAS v4i16_t*)(a1 + 8 * 128));
                const bf16x8 vf = (bf16x8){lo4[0], lo4[1], lo4[2], lo4[3], hi4[0], hi4[1], hi4[2], hi4[3]};
                o[d0] = __builtin_amdgcn_mfma_f32_32x32x16_bf16(vf, pa[s2], o[d0], 0, 0, 0);
            }
    };
    for (int t = tstart; t < ntiles; t += 2) {
        if (t + 2 < ntiles) FOX_LOAD(krA, vrA, brA, t + 2);
        compute(t, 0);
        if (t + 1 < ntiles) {
            FOX_STORE(krB, vrB, brB, 1);
            if (t + 3 < ntiles) FOX_LOAD(krB, vrB, brB, t + 3);
            compute(t + 1, 1);
            if (t + 2 < ntiles) FOX_STORE(krA, vrA, brA, 0);
        }
    }
#undef FOX_LOAD
#undef FOX_STORE
    l += __shfl_xor(l, 32);
    const float inv = 1.0f / l;
    bf16* orow = Ow + (size_t)r32 * 512;
#pragma unroll
    for (int d0 = 0; d0 < 2; ++d0)
#pragma unroll
        for (int g = 0; g < 4; ++g) { u32x2 w; w.x = cvtpk(o[d0][4 * g] * inv, o[d0][4 * g + 1] * inv); w.y = cvtpk(o[d0][4 * g + 2] * inv, o[d0][4 * g + 3] * inv);
            *(u32x2*)(orow + d0 * 32 + 8 * g + 4 * hi) = w; }
}
__device__ __forceinline__ void fox_unit4(int bh, int qb, const bf16* FQ, const bf16* FK, const bf16* FV, const float* CUM, const int* T0, const float* gq, const float* gk, bf16* OA, LAS unsigned char* lds, int wave, int lane) {
    const int b = bh >> 3, h = bh & 7, r32 = lane & 31, hi = lane >> 5; const size_t rowbase = (size_t)b * SEQ; const int q0 = qb * 256 + wave * 32;
    const bf16* Qw = FQ + (rowbase + q0) * 512 + h * 64; bf16* Ow = OA + (rowbase + q0) * 512 + h * 64;
    const bf16* Kp = FK + rowbase * 512 + h * 64; const bf16* Vp = FV + rowbase * 512 + h * 64; const float* cb = CUM + (size_t)bh * SEQ;
    LAS unsigned char* wl = lds + wave * 16384;
    LAS float* bl = (LAS float*)(lds + RING_BYTES + 8192 + wave * 256);
    bf16x8 qr[4];
#pragma unroll
    for (int ks = 0; ks < 4; ++ks) qr[ks] = *(const bf16x8*)(Qw + (size_t)r32 * 512 + ks * 16 + hi * 8);
    const int tstart = T0[bh * 256 + q0 / 32], tlast = q0 / 32, nseq = tlast - tstart + 1, qlocal = q0 + r32;
    const float stopc = (8.0f * wave_max(fabsf(gq[lane])) * wave_max(fabsf(gk[lane])) + 30.0f) * L2E;
    f32x16 o[2];
#pragma unroll
    for (int d0 = 0; d0 < 2; ++d0)
#pragma unroll
        for (int r = 0; r < 16; ++r) o[d0][r] = 0.f;
    float m = -1e30f, l = 0.f;
    const int lrow = lane >> 3, lch = lane & 7;
#define FOX_LOAD(KR, VR, BR, tt) do { _Pragma("unroll") for (int it = 0; it < 4; ++it) { const size_t ro = (size_t)(32 * (tt) + 8 * it + lrow) * 512 + lch * 8; KR[it] = *(const v4u*)(Kp + ro); VR[it] = *(const v4u*)(Vp + ro); } BR = cb[32 * (tt) + r32]; } while (0)
#define FOX_STORE(KR, VR, BR, bf) do { _Pragma("unroll") for (int it = 0; it < 4; ++it) { const int row = 8 * it + lrow; *(LAS v4u*)(wl + (bf) * 4096 + row * 128 + ((lch ^ (row & 7)) * 16)) = KR[it]; *(LAS v4u*)(wl + 8192 + (bf) * 4096 + row * 128 + lch * 16) = VR[it]; } if (lane < 32) bl[(bf) * 32 + lane] = -L2E * BR; } while (0)
    v4u krA[4], vrA[4], krB[4], vrB[4]; float brA = 0.f, brB = 0.f;
    const int kq = (lane >> 4) & 1, q_ = (lane & 15) >> 2, p_ = lane & 3;
    FOX_LOAD(krA, vrA, brA, tlast);
    if (1 < nseq) FOX_LOAD(krB, vrB, brB, tlast - 1);
    FOX_STORE(krA, vrA, brA, 0);
    auto compute = [&](int t, int buf) -> bool {
        const LAS unsigned char* kb = wl + buf * 4096; const LAS unsigned char* vb = wl + 8192 + buf * 4096; const LAS float* bb = bl + buf * 32;
        if (t != tlast) { const float bmax = bb[31]; if (__all(m > bmax + stopc)) return true; }
        f32x16 p;
#pragma unroll
        for (int r = 0; r < 16; ++r) p[r] = 0.f;
#pragma unroll
        for (int ks = 0; ks < 4; ++ks) { const bf16x8 kf = *(const LAS bf16x8*)(kb + r32 * 128 + (((2 * ks + hi) ^ (r32 & 7)) * 16)); p = __builtin_amdgcn_mfma_f32_32x32x16_bf16(kf, qr[ks], p, 0, 0, 0); }
#pragma unroll
        for (int g = 0; g < 4; ++g) { const f32x4 c4 = *(const LAS f32x4*)(bb + 8 * g + 4 * hi);
#pragma unroll
            for (int jj = 0; jj < 4; ++jj) p[4 * g + jj] += c4[jj]; }
        if (t == tlast) {
#pragma unroll
            for (int r = 0; r < 16; ++r) if (32 * t + crow(r, hi) > qlocal) p[r] = -INFINITY;
        }
        float mt = p[0];
#pragma unroll
        for (int r = 1; r < 16; ++r) mt = fmaxf(mt, p[r]);
        mt = fmaxf(mt, __shfl_xor(mt, 32));
        if (__any(mt > m)) {
            const float mn = fmaxf(m, mt); const float alpha = __builtin_amdgcn_exp2f(m - mn); m = mn;
            l *= alpha;
#pragma unroll
            for (int d0 = 0; d0 < 2; ++d0)
#pragma unroll
                for (int r = 0; r < 16; ++r) o[d0][r] *= alpha;
        }
        const float mn = m;
        float ls = 0.f;
#pragma unroll
        for (int r = 0; r < 16; ++r) { p[r] = __builtin_amdgcn_exp2f(p[r] - mn); ls += p[r]; }
        l += ls;
        bf16x8 pa[2];
#pragma unroll
        for (int s2 = 0; s2 < 2; ++s2) { v4u w; w.x = cvtpk(p[8 * s2 + 0], p[8 * s2 + 1]); w.y = cvtpk(p[8 * s2 + 2], p[8 * s2 + 3]); w.z = cvtpk(p[8 * s2 + 4], p[8 * s2 + 5]); w.w = cvtpk(p[8 * s2 + 6], p[8 * s2 + 7]); pa[s2] = __builtin_bit_cast(bf16x8, w); }
#pragma unroll
        for (int d0 = 0; d0 < 2; ++d0)
#pragma unroll
            for (int s2 = 0; s2 < 2; ++s2) {
                const LAS unsigned char* a1 = vb + (16 * s2 + 4 * hi + q_) * 128 + (32 * d0 + 16 * kq + 4 * p_) * 2;
                const v4i16_t lo4 = __builtin_amdgcn_ds_read_tr16_b64_v4i16((LAS v4i16_t*)a1), hi4 = __builtin_amdgcn_ds_read_tr16_b64_v4i16((LAS v4i16_t*)(a1 + 8 * 128));
                const bf16x8 vf = (bf16x8){lo4[0], lo4[1], lo4[2], lo4[3], hi4[0], hi4[1], hi4[2], hi4[3]};
                o[d0] = __builtin_amdgcn_mfma_f32_32x32x16_bf16(vf, pa[s2], o[d0], 0, 0, 0);
            }
        return false;
    };
    for (int i = 0; i < nseq; i += 2) {
        if (i + 2 < nseq) FOX_LOAD(krA, vrA, brA, tlast - (i + 2));
        if (compute(tlast - i, 0)) break;
        if (i + 1 < nseq) {
            FOX_STORE(krB, vrB, brB, 1);
            if (i + 3 < nseq) FOX_LOAD(krB, vrB, brB, tlast - (i + 3));
            if (compute(tlast - (i + 1), 1)) break;
            if (i + 2 < nseq) FOX_STORE(krA, vrA, brA, 0);
        }
    }
#undef FOX_LOAD
#undef FOX_STORE
    l += __shfl_xor(l, 32);
    const float inv = 1.0f / l;
    bf16* orow = Ow + (size_t)r32 * 512;
#pragma unroll
    for (int d0 = 0; d0 < 2; ++d0)
#pragma unroll
        for (int g = 0; g < 4; ++g) { u32x2 w; w.x = cvtpk(o[d0][4 * g] * inv, o[d0][4 * g + 1] * inv); w.y = cvtpk(o[d0][4 * g + 2] * inv, o[d0][4 * g + 3] * inv);
            *(u32x2*)(orow + d0 * 32 + 8 * g + 4 * hi) = w; }
}
#ifndef DBG_BRANCH_MASK
#define DBG_BRANCH_MASK 7
#endif
#ifndef DBG_NBR
#define DBG_NBR 3
#endif
#ifndef DBG_NOGATE
#define DBG_NOGATE 0
#endif
#ifndef DBG_NOBRANCH
#define DBG_NOBRANCH 0
#endif
#ifndef DBG_GATE_W
#define DBG_GATE_W WS_WGATE
#endif
#ifndef DBG_GATE_AS_BRANCH
#define DBG_GATE_AS_BRANCH 0
#endif
#ifndef REP_FOX
#define REP_FOX 1
#endif
#ifndef REP_DSA
#define REP_DSA 1
#endif
#ifndef REP_GEMM
#define REP_GEMM 1
#endif
#ifndef DBG_SUBST
#define DBG_SUBST 0
#endif
#ifndef P7SEL
#define P7SEL 3
#endif
#ifndef PHMASK
#define PHMASK 0xFFFF
#endif
struct Args { const void* in[24]; float* out; unsigned char* ws; };
#define CONVERT_GROUP(GRP, w_, nw_) do { \
    constexpr int I_GU = 16 * 176, I_D = 44 * 32, I_IN = 16 * 104, I_GT = 16 * 96, I_BR = 8 * 32, I_SQ = 16 * 32; \
    constexpr int NIT = (GRP) == 0 ? I_GU + I_SQ : (GRP) == 1 ? I_D + I_IN + I_GT + 3 * I_BR + I_SQ : I_GU + I_D; \
    LAS float* scr_ = (LAS float*)(L + RING_OFF + wave * 16384); \
    for (int it = (w_); it < NIT; it += (nw_)) { int r = it; \
        if ((GRP) == 0) { \
            if (r < I_GU) { transpose_item<true>(0, ARG_IN(4), ARG_IN(5), 1024, DFF, ARG_IN(3), WSP(bf16, WS_WGU1), scr_, r, 176, lane); continue; } r -= I_GU; \
            transpose_item<true>(1, ARG_IN(17), nullptr, 1024, 1024, ARG_IN(8), WSP(bf16, WS_WMKV), scr_, r, 32, lane); \
        } else if ((GRP) == 1) { \
            if (r < I_D) { transpose_item<false>(1, ARG_IN(6), nullptr, DFF, 1024, nullptr, WSP(bf16, WS_WD1), scr_, r, 32, lane); continue; } r -= I_D; \
            if (r < I_IN) { transpose_item<true>(2, ARG_IN(9), nullptr, 1024, DIN, ARG_IN(7), WSP(bf16, WS_WIN), scr_, r, 104, lane); continue; } r -= I_IN; \
            if (r < I_GT) { transpose_item<true>(3, ARG_IN(9), nullptr, 1024, DIN, ARG_IN(7), WSP(bf16, WS_WGATE), scr_, r, 96, lane); continue; } r -= I_GT; \
            if (r < 3 * I_BR) { const int i = r / I_BR; transpose_item<false>(1, ARG_IN(18) + (size_t)i * 512 * 1024, nullptr, 512, 1024, nullptr, WSP(bf16, WS_WBR) + (size_t)i * 1024 * 512, scr_, r % I_BR, 32, lane); continue; } r -= 3 * I_BR; \
            transpose_item<false>(1, ARG_IN(19), nullptr, 1024, 1024, nullptr, WSP(bf16, WS_WOUT), scr_, r, 32, lane); \
        } else { \
            if (r < I_GU) { transpose_item<true>(0, ARG_IN(21), ARG_IN(22), 1024, DFF, ARG_IN(20), WSP(bf16, WS_WGU2), scr_, r, 176, lane); continue; } r -= I_GU; \
            transpose_item<false>(1, ARG_IN(23), nullptr, DFF, 1024, nullptr, WSP(bf16, WS_WD2), scr_, r, 32, lane); \
        } } } while (0)
__global__ void __launch_bounds__(NWAVES * 64, 2) fwd_mega(Args args) {
    extern __shared__ __attribute__((aligned(16))) unsigned char lds[];
    LAS unsigned char* L = (LAS unsigned char*)lds;
    volatile LAS unsigned* MISC = (volatile LAS unsigned*)(L + MISC_OFF);
    const int tid = threadIdx.x, lane = tid & 63, wave = __builtin_amdgcn_readfirstlane(tid >> 6);
    const int G = gridDim.x; const int bx = blockIdx.x; const int vcu = (G % 8 == 0) ? (bx % 8) * (G / 8) + bx / 8 : bx;
    const Args* ap = (const Args*)__builtin_amdgcn_kernarg_segment_ptr();
#define ARG_IN(k) ((const float*)ap->in[k])
#define WSP(type, off) ((type*)(ap->ws + (off)))
    gu32* ctl = (gu32*)(ap->ws + WS_CTL);
    for (int u = tid; u < (LDS_BYTES - LDSCTL_OFF) / 4; u += NWAVES * 64) ((LAS unsigned*)(L + LDSCTL_OFF))[u] = 0u;
    __syncthreads();
    XcdBarrier bar = xcd_barrier_post((unsigned*)(ctl + CW_BAR), MISC + 8);
#define GRID_BAR() xcd_barrier(bar)
    const int gw = vcu * NWAVES + wave, NGW = G * NWAVES;

#if (PHMASK >> 0) & 1
    {
        LAS float* scr = (LAS float*)(L + RING_OFF + wave * 16384);
        CONVERT_GROUP(0, gw, NGW);
        for (int m0 = gw; m0 < T + 512; m0 += 4 * NGW) {
            const float* xr[4]; bf16* orw[4]; float* ro[4]; bool ok[4];
#pragma unroll
            for (int r = 0; r < 4; ++r) { const int m = m0 + r * NGW; ok[r] = m < T + 512; const int mc = ok[r] ? m : gw;
                if (mc < T) { xr[r] = ARG_IN(0) + (size_t)mc * 1024; orw[r] = WSP(bf16, WS_HB) + (size_t)mc * 1024; ro[r] = WSP(float, WS_RSTDX) + mc; }
                else { xr[r] = ARG_IN(1) + (size_t)(mc - T) * 1024; orw[r] = WSP(bf16, WS_MEMB) + (size_t)(mc - T) * 1024; ro[r] = WSP(float, WS_RSTDM) + (mc - T); } }
            rows4_to_bf16_rstd(xr, orw, ro, ok, lane);
        }
        VM_WAIT(); __syncthreads();
        GRID_BAR();
    }
#endif
#if (PHMASK >> 1) & 1
    {
        if (bx >= G - 8) { pg8::Gemm g{WSP(bf16, WS_MEMB), WSP(bf16, WS_WMKV), 512, 1024, 1024}; pg8::StaticOrder S; S.init(512, 1024, G, bx - (G - 8));
        pg8::EpiMemKV E{WSP(float, WS_KVM), WSP(float, WS_RSTDM)};
        pg8::gemm_phase<pg8::EpiMemKV, pg8::StaticOrder, true, true>(L + RING_OFF, g, S, E); }
    }
#endif
#if (PHMASK >> 2) & 1
    {
        pg8::Gemm g{WSP(bf16, WS_HB), WSP(bf16, WS_WGU1), T, 2 * DFF, 1024}; pg8::StaticOrder S; S.init(T, 2 * DFF, G, bx);
        pg8::build_row_tab<0>(WSP(float, WS_RSTDX), S, (LAS float*)(L + RING_BYTES + 1024)); pg8::EpiSwiGLU<0> E{WSP(bf16, WS_HID), DFF, (LAS float*)(L + RING_BYTES + 1024)};
#pragma unroll 1
        for (int rep_ = 0; rep_ < REP_GEMM; ++rep_)
        pg8::gemm_phase<pg8::EpiSwiGLU<0>, pg8::StaticOrder, true, true>(L + RING_OFF, g, S, E);
        {
            const int nfull = (64 * 22) % G; const int nidle = (nfull == 0) ? G : G - nfull; const int first = G - nidle;
            if (bx >= first) { CONVERT_GROUP(1, (bx - first) * NWAVES + wave, nidle * NWAVES);
                for (int e = (bx - first) * NWAVES * 64 + tid; e < T * 32; e += nidle * NWAVES * 64) {
                    const int row = e >> 5, i = e & 31; const float inv_freq = powf(10000.0f, -(float)i * (1.0f / 32.0f));
                    const float ang = (float)((const int*)ap->in[2])[row] * inv_freq; float sn, cs; sincosf(ang, &sn, &cs); WSP(float, WS_COS)[e] = cs; WSP(float, WS_SIN)[e] = sn; } }
        }
        GRID_BAR();
    }
#endif
#if (PHMASK >> 3) & 1
    {
        pg8::Gemm g{WSP(bf16, WS_HID), WSP(bf16, WS_WD1), T, 1024, DFF}; pg8::StaticOrder S; S.init(T, 1024, G, bx);
        pg8::EpiResid2<true> E{ARG_IN(0), ap->out, WSP(bf16, WS_HB), WSP(float, WS_SSQ1), 0.5f};
#pragma unroll 1
        for (int rep_ = 0; rep_ < REP_GEMM; ++rep_)
        pg8::gemm_phase<pg8::EpiResid2<true>, pg8::StaticOrder, true, true>(L + RING_OFF, g, S, E);
        GRID_BAR();
    }
#endif
#if (PHMASK >> 4) & 1
    {
        pg8::Gemm g{WSP(bf16, WS_HB), WSP(bf16, WS_WIN), T, NPROJ, 1024}; pg8::StaticOrder S; S.init(T, NPROJ, G, bx);
        pg8::ProjOut PO{WSP(bf16, WS_FQ), WSP(bf16, WS_FK), WSP(bf16, WS_FV), WSP(bf16, WS_DQ), WSP(bf16, WS_IQ), WSP(bf16, WS_MQ), WSP(bf16, WS_DK), WSP(bf16, WS_DV), WSP(bf16, WS_IK), WSP(float, WS_LOGF), WSP(float, WS_IW), WSP(float, WS_COS), WSP(float, WS_SIN), ARG_IN(11), ARG_IN(12), ARG_IN(13), ARG_IN(14), ARG_IN(10)};
        pg8::build_row_tab<16>(WSP(float, WS_SSQ1), S, (LAS float*)(L + RING_BYTES + 1024)); pg8::EpiProj<16> E{PO, (LAS float*)(L + RING_BYTES + 1024), C2_64};
#pragma unroll 1
        for (int rep_ = 0; rep_ < REP_GEMM; ++rep_)
        pg8::gemm_phase<pg8::EpiProj<16>, pg8::StaticOrder, true, true>(L + RING_OFF, g, S, E);
        {
            const int nfull = (64 * 13) % G; const int nidle = (nfull == 0) ? G : G - nfull; const int first = G - nidle;
            if (bx >= first) { CONVERT_GROUP(2, (bx - first) * NWAVES + wave, nidle * NWAVES);
        for (int it = (bx - first) * NWAVES + wave; it < 2048; it += nidle * NWAVES) { const int row = it >> 2, h = it & 3;
                    const f32x2g kv = *(const f32x2g*)(WSP(float, WS_KVM) + (size_t)row * 1024 + h * 128 + 2 * lane); const f32x2g vv = *(const f32x2g*)(WSP(float, WS_KVM) + (size_t)row * 1024 + 512 + h * 128 + 2 * lane);
                    const float ss = wave_sum(kv.x * kv.x + kv.y * kv.y); const float rstd = 1.0f / sqrtf(ss * (1.0f / 128.0f) + 1e-6f);
                    const f32x2g gk = *(const f32x2g*)(ARG_IN(16) + 2 * lane);
                    *(unsigned*)(WSP(bf16, WS_KMB) + (size_t)row * 512 + h * 128 + 2 * lane) = pk2(kv.x * rstd * gk.x, kv.y * rstd * gk.y);
                    *(unsigned*)(WSP(bf16, WS_VMB) + (size_t)row * 512 + h * 128 + 2 * lane) = pk2(vv.x, vv.y); } }
        }
        GRID_BAR();
#if defined(DBG_DUMP_AFTER) && DBG_DUMP_AFTER == 4
        {
            const bf16* sa = WSP(bf16, DBG_DUMP_A); const bf16* sb = WSP(bf16, DBG_DUMP_B);
            for (size_t e = (size_t)vcu * 512 + tid; e < (size_t)T * 512; e += (size_t)G * 512) { const size_t row = e >> 9, c = e & 511;
                ap->out[row * 1024 + c] = bf2f(sa[row * DBG_PITCH + c]); ap->out[row * 1024 + 512 + c] = bf2f(sb[row * DBG_PITCH + c]); }
            return;
        }
#endif

    }
#endif
#if ((PHMASK >> 5) & 1) && !DBG_SUBST
    {
        for (int u = vcu; u < 256; u += G) mem_block(u, WSP(bf16, WS_MQ), WSP(bf16, WS_KMB), WSP(bf16, WS_VMB), ARG_IN(15), L, wave, lane, tid);
    }
#endif
#if ((PHMASK >> 6) & 1) && !DBG_SUBST
    {
        for (int rep_ = 0; rep_ < REP_FOX; ++rep_)
        for (int v = vcu; v < 256; v += G) { const int bh = v >> 4, s = v & 15;
            scan_unit(bh, WSP(float, WS_LOGF), WSP(float, WS_CUM), WSP(int, WS_T0), ARG_IN(11), ARG_IN(12), (LAS float*)(L + SCANX_OFF), (LAS float*)(L + RING_OFF), tid);
            asm volatile("s_waitcnt vmcnt(0)" ::: "memory"); __syncthreads();
            fox_unit4(bh, s, WSP(bf16, WS_FQ), WSP(bf16, WS_FK), WSP(bf16, WS_FV), WSP(float, WS_CUM), WSP(int, WS_T0), ARG_IN(11), ARG_IN(12), WSP(bf16, WS_OA), L, wave, lane); fox_unit4(bh, 31 - s, WSP(bf16, WS_FQ), WSP(bf16, WS_FK), WSP(bf16, WS_FV), WSP(float, WS_CUM), WSP(int, WS_T0), ARG_IN(11), ARG_IN(12), WSP(bf16, WS_OA), L, wave, lane); }
        __syncthreads();
        {
            gu32* qctr = ctl + CW_Q; LAS int* QW = (LAS int*)(L + D3_QW);
            const int pref = (vcu >> 5) & 1;
            unsigned raw = 0u; int cur;
            if (tid == 0) { unsigned u = __hip_atomic_fetch_add(qctr + 64 * pref, 1u, RLX_AGENT); int bsel = pref; if (u >= 512u) { bsel = pref ^ 1; u = __hip_atomic_fetch_add(qctr + 64 * bsel, 1u, RLX_AGENT); } QW[0] = (u < 512u) ? ((bsel << 16) | (int)u) : -1; }
            __syncthreads(); cur = QW[0]; __syncthreads();
            while (cur >= 0) {
                if (tid == 0) raw = __hip_atomic_fetch_add(qctr + 64 * pref, 1u, RLX_AGENT);
                dsa3_unit(cur >> 16, 511 - (cur & 0xffff), WSP(bf16, WS_IQ), WSP(bf16, WS_IK), WSP(float, WS_IW), WSP(bf16, WS_DQ), WSP(bf16, WS_DK), WSP(bf16, WS_DV), WSP(bf16, WS_OB), L, wave, lane);
                if (tid == 0) { unsigned u = raw; int bsel = pref; if (u >= 512u) { bsel = pref ^ 1; u = __hip_atomic_fetch_add(qctr + 64 * bsel, 1u, RLX_AGENT); } QW[0] = (u < 512u) ? ((bsel << 16) | (int)u) : -1; }
                __syncthreads(); cur = QW[0]; __syncthreads();
            }
        }
        GRID_BAR();
    }
#endif
#if (PHMASK >> 7) & 1
    {
        pg8::StaticOrder S; S.init(T, 1024, G, bx); pg8::build_row_tab<16>(WSP(float, WS_SSQ1), S, (LAS float*)(L + RING_BYTES + 1024));
#ifndef P7STREAM
#define P7STREAM 1
#endif
#if P7STREAM
        {   typedef pg8::P7Order<WS_HB, WS_WGATE, WS_OA, WS_OB, WS_MQ, WS_WBR> P7O; P7O O{S, (const char*)WSP(char, 0)};
            pg8::EpiP7 E{WSP(bf16, WS_GSCR), WSP(bf16, WS_MERGED), (LAS float*)(L + RING_BYTES + 1024)};
#ifndef REP_P7
#define REP_P7 1
#endif
#pragma unroll 1
            for (int rep7_ = 0; rep7_ < REP_P7; ++rep7_) pg8::gemm_stream<pg8::EpiP7, P7O>(L + RING_OFF, O, E); }
#pragma unroll 1
        for (int i = 0; i < 0; ++i) {
#else
#pragma unroll 1
        for (int rep_ = 0; rep_ < REP_GEMM; ++rep_)
#pragma unroll 1
        for (int i = 0; i < DBG_NBR; ++i) {
#endif
#if DBG_GATE_AS_BRANCH
            {   pg8::Gemm g{WSP(bf16, WS_HB), WSP(bf16, DBG_GATE_W), T, 1024, 1024}; pg8::EpiBranch E{WSP(bf16, WS_GSCR), WSP(bf16, WS_MERGED), true, 1.0f}; pg8::gemm_phase<pg8::EpiBranch, pg8::StaticOrder, true, true>(L + RING_OFF, g, S, E); }
#elif !DBG_NOGATE
            {   pg8::Gemm g{WSP(bf16, WS_HB), WSP(bf16, DBG_GATE_W) + (size_t)i * 1024 * 1024, T, 1024, 1024}; pg8::EpiGate<16> E{WSP(bf16, WS_GSCR), (LAS float*)(L + RING_BYTES + 1024)}; pg8::gemm_phase<pg8::EpiGate<16>, pg8::StaticOrder, true, true>(L + RING_OFF, g, S, E); }
#endif
#if !DBG_NOBRANCH
#if DBG_SUBST == 1
            {   const bf16* A = (i == 0) ? WSP(bf16, WS_FQ) : (i == 1) ? WSP(bf16, WS_DQ) : WSP(bf16, WS_IQ);
#elif DBG_SUBST == 2
            {   const bf16* A = (i == 0) ? WSP(bf16, WS_FK) : (i == 1) ? WSP(bf16, WS_FV) : WSP(bf16, WS_MQ);
#else
            {   const bf16* A = (i == 0) ? WSP(bf16, WS_OA) : (i == 1) ? WSP(bf16, WS_OB) : WSP(bf16, WS_MQ);
#endif
                pg8::Gemm g{A, WSP(bf16, WS_WBR) + (size_t)i * 1024 * 512, T, 1024, 512}; pg8::EpiBranch E{WSP(bf16, WS_GSCR), WSP(bf16, WS_MERGED), i == 0, ((DBG_BRANCH_MASK >> i) & 1) ? 1.0f : 0.0f}; pg8::gemm_phase<pg8::EpiBranch, pg8::StaticOrder, true, true>(L + RING_OFF, g, S, E); }
#endif
        }
        GRID_BAR();
#if defined(DBG_DUMP_AFTER) && DBG_DUMP_AFTER == 7
        {
            const bf16* sa = WSP(bf16, DBG_DUMP_A); const bf16* sb = WSP(bf16, DBG_DUMP_B);
            for (size_t e = (size_t)vcu * 512 + tid; e < (size_t)T * 512; e += (size_t)G * 512) { const size_t row = e >> 9, c = e & 511;
                ap->out[row * 1024 + c] = bf2f(sa[row * DBG_PITCH + c]); ap->out[row * 1024 + 512 + c] = bf2f(sb[row * DBG_PITCH + c]); }
            return;
        }
#endif

    }
#endif
#if (PHMASK >> 8) & 1
    {
        pg8::Gemm g{WSP(bf16, WS_MERGED), WSP(bf16, WS_WOUT), T, 1024, 1024}; pg8::StaticOrder S; S.init(T, 1024, G, bx);
        pg8::EpiResid2<true> E{ap->out, ap->out, WSP(bf16, WS_HB), WSP(float, WS_SSQ2), 1.0f};
        pg8::gemm_phase<pg8::EpiResid2<true>, pg8::StaticOrder, true, true>(L + RING_OFF, g, S, E);
        GRID_BAR();
    }
#endif
#if (PHMASK >> 9) & 1
    {
        pg8::Gemm g{WSP(bf16, WS_HB), WSP(bf16, WS_WGU2), T, 2 * DFF, 1024}; pg8::StaticOrder S; S.init(T, 2 * DFF, G, bx);
        pg8::build_row_tab<16>(WSP(float, WS_SSQ2), S, (LAS float*)(L + RING_BYTES + 1024)); pg8::EpiSwiGLU<16> E{WSP(bf16, WS_HID), DFF, (LAS float*)(L + RING_BYTES + 1024)};
#pragma unroll 1
        for (int rep_ = 0; rep_ < REP_GEMM; ++rep_)
        pg8::gemm_phase<pg8::EpiSwiGLU<16>, pg8::StaticOrder, true, true>(L + RING_OFF, g, S, E);
        GRID_BAR();
    }
#endif
#if (PHMASK >> 10) & 1
    {
        pg8::Gemm g{WSP(bf16, WS_HID), WSP(bf16, WS_WD2), T, 1024, DFF}; pg8::StaticOrder S; S.init(T, 1024, G, bx);
        pg8::EpiResid2<false> E{ap->out, ap->out, nullptr, nullptr, 0.5f};
        pg8::gemm_phase<pg8::EpiResid2<false>, pg8::StaticOrder, true, true>(L + RING_OFF, g, S, E);
    }
#endif
}

extern "C" void kernel_launch(void* const* d_in, const int* in_sizes, int n_in, void* d_out, int out_size, void* d_ws, size_t ws_size, hipStream_t stream) {
    static int grid = 0;
    if (grid == 0) {
        if (n_in != 24 || out_size != T * DM || ws_size < WS_END) { fprintf(stderr, "kernel_launch: unexpected problem (n_in %d, out %d, ws %zu)\n", n_in, out_size, ws_size); grid = -1; return; }
        int dev = 0, cus = 0, per_cu = 0;
        if (hipGetDevice(&dev) != hipSuccess || hipDeviceGetAttribute(&cus, hipDeviceAttributeMultiprocessorCount, dev) != hipSuccess) { grid = -1; return; }
        if (hipFuncSetAttribute((const void*)fwd_mega, hipFuncAttributeMaxDynamicSharedMemorySize, LDS_BYTES) != hipSuccess) { fprintf(stderr, "kernel_launch: hipFuncSetAttribute failed\n"); grid = -1; return; }
        if (hipOccupancyMaxActiveBlocksPerMultiprocessor(&per_cu, (const void*)fwd_mega, NWAVES * 64, LDS_BYTES) != hipSuccess || per_cu < 1) { fprintf(stderr, "kernel_launch: occupancy query says %d blocks per CU\n", per_cu); (void)hipGetLastError(); grid = -1; return; }
        grid = cus;
    }
    if (grid < 0) return;
    (void)hipMemsetAsync((char*)d_ws + WS_CTL, 0, CTL_ZERO_BYTES, stream);
    Args a{};
    for (int i = 0; i < 24; ++i) a.in[i] = d_in[i];
    a.out = (float*)d_out; a.ws = (unsigned char*)d_ws;
    hipLaunchKernelGGL(fwd_mega, dim3(grid), dim3(NWAVES * 64), LDS_BYTES, stream, a);
}
```

```cpp
#include <hip/hip_runtime.h>
#include <cstdio>
#include <cstdint>
namespace pg8 {
#define PG8_LAS __attribute__((address_space(3)))
typedef unsigned short bf16_t;
typedef short bf16x8 __attribute__((ext_vector_type(8)));
typedef float f32x4 __attribute__((ext_vector_type(4)));
typedef unsigned u32x4 __attribute__((ext_vector_type(4)));
constexpr int BM = 256, BK = 64, HALF = 128, HTB = HALF * BK * 2  , STAGE_BYTES = 8 * HTB, NXCD = 8, WGM = 8;

__host__ __device__ __forceinline__ int lds_byte(int r, int c) { const int st = (r >> 4) * 2 + (c >> 5), rr = r & 15, cc = c & 31, ob = rr * 64 + cc * 2; return st * 1024 + (ob ^ (((ob >> 9) & 1) << 5)); }
__host__ __device__ __forceinline__ void stage_rc(int b, int& R, int& C) { const int st = b / 1024, sb = b % 1024, swz = sb ^ (((sb >> 9) & 1) << 5); R = (st >> 1) * 16 + swz / 64; C = (st & 1) * 32 + (swz % 64) / 2; }
__host__ __device__ __forceinline__ int perm32(int rho) { const int n = rho >> 4, i = rho & 15; return 8 * (i >> 2) + 4 * n + (i & 3); }

struct Unit { int pm, pn; };
struct Gemm { const bf16_t* A; const bf16_t* Bt; int M, N, K; };

struct StaticOrder {
    int nM, nN, nwg, G, c;
    __host__ __device__ void init(int M, int N, int G_, int c_) { nM = M / BM; nN = N / BM; nwg = nM * nN; G = G_; c = c_; }
    __host__ __device__ bool next(int i, Unit& u) const {
        const long L = (long)i * G + c; if (L >= nwg) return false;
        int wgid = (int)L; { const int q = nwg / NXCD, r = nwg % NXCD, xcd = wgid % NXCD, off = wgid / NXCD; wgid = (xcd < r ? xcd * (q + 1) : r * (q + 1) + (xcd - r) * q) + off; }
        const int nig = WGM * nN, gid = wgid / nig, fm = gid * WGM, gsz = (nM - fm) < WGM ? (nM - fm) : WGM;
        u.pm = fm + ((wgid % nig) % gsz); u.pn = (wgid % nig) / gsz; return true;
    }
    __device__ __forceinline__ void a_ready(const Unit&) const {}
    __device__ __forceinline__ void done(const Unit&) const {}
};

typedef float f32x2cv __attribute__((ext_vector_type(2))); typedef __bf16 bf16x2cv __attribute__((ext_vector_type(2)));
__device__ __forceinline__ unsigned cvt_pk_bf16(float lo, float hi) { const f32x2cv v = {lo, hi}; const bf16x2cv b = __builtin_convertvector(v, bf16x2cv); return __builtin_bit_cast(unsigned, b); }
typedef float f32x2 __attribute__((ext_vector_type(2)));
template <class Epi, class Sched, bool ALIGN_EPI = false, bool SP2 = false>
__device__ __forceinline__ void gemm_phase(PG8_LAS unsigned char* lds, const Gemm g, const Sched& S, const Epi& E) {
    int tid_ = threadIdx.x; asm volatile("" : "+v"(tid_));
    const int tid = tid_, wid = __builtin_amdgcn_readfirstlane(tid >> 6), lane = tid & 63, wr = wid >> 2, wc = wid & 3, fr = lane & 15, fq = lane >> 4;
    const int K = g.K, nt = K / BK;
    unsigned voffA[2], voffB[2];
#pragma unroll
    for (int i = 0; i < 2; ++i) { int R, C; stage_rc(tid * 16 + i * 8192, R, C); const int Rb = Epi::PERM ? ((R & ~31) + perm32(R & 31)) : R;
        voffA[i] = (unsigned)(R * K + C) * 2u; voffB[i] = (unsigned)(Rb * K + C) * 2u; }
    const size_t kstep = (size_t)(BK * 2);
    const size_t hstep = (size_t)HALF * K * 2;
    const size_t tstep = 2 * hstep;
    const unsigned ldsw = (unsigned)wid * 1024u;
    const int aoff = lds_byte(wr * 64 + fr, fq * 8), boff = lds_byte(wc * 32 + fr, fq * 8);
#define PG8_SA(b, h) (((b) * 2 + (h)) * HTB)
#define PG8_SB(b, h) ((4 + (b) * 2 + (h)) * HTB)
#define PG8_STAGE(bufoff, gbase, voff) do { _Pragma("unroll") for (int _i = 0; _i < 2; ++_i) \
        __builtin_amdgcn_global_load_lds((const unsigned*)((const char*)(gbase) + (voff)[_i]), (PG8_LAS unsigned*)(lds + (bufoff) + ldsw + _i * 8192), 16, 0, 0); } while (0)
#define PG8_LDA(dst, b, h) do { _Pragma("unroll") for (int m = 0; m < 4; ++m) _Pragma("unroll") for (int k = 0; k < 2; ++k) dst[m][k] = *(const PG8_LAS bf16x8*)(lds + PG8_SA(b, h) + aoff + m * 2048 + k * 1024); } while (0)
#define PG8_LDB(dst, b, h) do { _Pragma("unroll") for (int n = 0; n < 2; ++n) _Pragma("unroll") for (int k = 0; k < 2; ++k) dst[n][k] = *(const PG8_LAS bf16x8*)(lds + PG8_SB(b, h) + boff + n * 2048 + k * 1024); } while (0)
#define PG8_MMA(ai, bj, At, Bt) do { __builtin_amdgcn_s_setprio(1); _Pragma("unroll") for (int m = 0; m < 4; ++m) _Pragma("unroll") for (int n = 0; n < 2; ++n) _Pragma("unroll") for (int k = 0; k < 2; ++k) \
        acc[ai][bj][m][n] = __builtin_amdgcn_mfma_f32_16x16x32_bf16(Bt[n][k], At[m][k], acc[ai][bj][m][n], 0, 0, 0); __builtin_amdgcn_s_setprio(0); } while (0)
#define PG8_WAIT_V(n) asm volatile("s_waitcnt vmcnt(" #n ")" ::: "memory")
#define PG8_WAIT_L(n) asm volatile("s_waitcnt lgkmcnt(" #n ")" ::: "memory")
#define PG8_BAR __builtin_amdgcn_s_barrier()
#define PG8_SCHED __builtin_amdgcn_sched_barrier(0)
    Unit cur, nxt; int ui = 0;
    if (!S.next(0, cur)) return;
    f32x4 acc[2][2][4][2];
#pragma unroll
    for (int a = 0; a < 2; ++a)
#pragma unroll
        for (int b = 0; b < 2; ++b)
#pragma unroll
            for (int m = 0; m < 4; ++m)
#pragma unroll
                for (int n = 0; n < 2; ++n) acc[a][b][m][n] = (f32x4){0.f, 0.f, 0.f, 0.f};
    bf16x8 At[4][2], B0[2][2], B1[2][2];
    const char* cA = (const char*)g.A + (size_t)cur.pm * tstep; const char* cB = (const char*)g.Bt + (size_t)cur.pn * tstep;
    S.a_ready(cur);
    if constexpr (SP2) {
        PG8_STAGE(PG8_SB(0, 0), cB, voffB); PG8_STAGE(PG8_SB(0, 1), cB + hstep, voffB); PG8_STAGE(PG8_SA(0, 0), cA, voffA); PG8_STAGE(PG8_SA(0, 1), cA + hstep, voffA);
        if (wr == 1) PG8_BAR;
        PG8_WAIT_V(2); PG8_BAR;
        PG8_STAGE(PG8_SB(1, 0), cB + kstep, voffB); PG8_STAGE(PG8_SA(1, 0), cA + kstep, voffA); PG8_STAGE(PG8_SB(1, 1), cB + hstep + kstep, voffB);
        PG8_WAIT_V(6); PG8_BAR;
    } else {
        PG8_STAGE(PG8_SB(0, 0), cB, voffB); PG8_STAGE(PG8_SA(0, 0), cA, voffA); PG8_STAGE(PG8_SB(0, 1), cB + hstep, voffB); PG8_STAGE(PG8_SA(0, 1), cA + hstep, voffA);
        if (wr == 1) PG8_BAR;
        PG8_WAIT_V(4); PG8_BAR;
        PG8_STAGE(PG8_SB(1, 0), cB + kstep, voffB); PG8_STAGE(PG8_SA(1, 0), cA + kstep, voffA); PG8_STAGE(PG8_SB(1, 1), cB + hstep + kstep, voffB);
        PG8_WAIT_V(6); PG8_BAR;
    }
    for (;;) {
        const bool has_next = S.next(ui + 1, nxt);
        const char* nA = has_next ? (const char*)g.A + (size_t)nxt.pm * tstep : cA; const char* nB = has_next ? (const char*)g.Bt + (size_t)nxt.pn * tstep : cB;
        for (int t = 0; t < nt; t += 2) {
            const bool last = (t == nt - 2);
            const char* a1 = cA + (size_t)(t + 1) * kstep;
            const char* a2 = last ? nA : cA + (size_t)(t + 2) * kstep; const char* b2 = last ? nB : cB + (size_t)(t + 2) * kstep;
            const char* a3 = a2 + kstep; const char* b3 = b2 + kstep;
            if (last && has_next) S.a_ready(nxt);
            if constexpr (SP2) {
            PG8_LDB(B0, 0, 0); PG8_LDB(B1, 0, 1); PG8_SCHED; PG8_LDA(At, 0, 0); PG8_STAGE(PG8_SA(1, 1), a1 + hstep, voffA);
            PG8_WAIT_V(8); PG8_WAIT_L(0); PG8_BAR; PG8_MMA(0, 0, At, B0); PG8_MMA(0, 1, At, B1); PG8_BAR; PG8_SCHED;
            PG8_LDA(At, 0, 1); PG8_STAGE(PG8_SB(0, 0), b2, voffB); PG8_STAGE(PG8_SB(0, 1), b2 + hstep, voffB); PG8_STAGE(PG8_SA(0, 0), a2, voffA);
            PG8_WAIT_V(8); PG8_WAIT_L(0); PG8_BAR; PG8_MMA(1, 0, At, B0); PG8_MMA(1, 1, At, B1); PG8_BAR; PG8_SCHED;
            PG8_LDB(B0, 1, 0); PG8_LDB(B1, 1, 1); PG8_SCHED; PG8_LDA(At, 1, 0); PG8_STAGE(PG8_SA(0, 1), a2 + hstep, voffA);
            PG8_WAIT_V(8); PG8_WAIT_L(0); PG8_BAR; PG8_MMA(0, 0, At, B0); PG8_MMA(0, 1, At, B1); PG8_BAR; PG8_SCHED;
            PG8_LDA(At, 1, 1); PG8_STAGE(PG8_SB(1, 0), b3, voffB); PG8_STAGE(PG8_SB(1, 1), b3 + hstep, voffB); PG8_STAGE(PG8_SA(1, 0), a3, voffA);
            PG8_WAIT_V(8); PG8_WAIT_L(0); PG8_BAR; PG8_MMA(1, 0, At, B0); PG8_MMA(1, 1, At, B1); PG8_BAR; PG8_SCHED;
            } else {
            PG8_LDB(B0, 0, 0); PG8_SCHED; PG8_LDA(At, 0, 0); PG8_STAGE(PG8_SA(1, 1), a1 + hstep, voffA);
            PG8_WAIT_L(8); PG8_BAR; PG8_WAIT_L(0); PG8_MMA(0, 0, At, B0); PG8_BAR; PG8_SCHED;
            PG8_LDB(B1, 0, 1); PG8_STAGE(PG8_SB(0, 0), b2, voffB);
            PG8_BAR; PG8_WAIT_L(0); PG8_MMA(0, 1, At, B1); PG8_BAR;
            PG8_LDA(At, 0, 1); PG8_STAGE(PG8_SA(0, 0), a2, voffA);
            PG8_BAR; PG8_WAIT_L(0); PG8_MMA(1, 0, At, B0); PG8_BAR; PG8_SCHED;
            PG8_STAGE(PG8_SB(0, 1), b2 + hstep, voffB);
            PG8_WAIT_V(6); PG8_BAR; PG8_MMA(1, 1, At, B1); PG8_BAR;
            PG8_LDB(B0, 1, 0); PG8_SCHED; PG8_LDA(At, 1, 0); PG8_STAGE(PG8_SA(0, 1), a2 + hstep, voffA);
            PG8_WAIT_L(8); PG8_BAR; PG8_WAIT_L(0); PG8_MMA(0, 0, At, B0); PG8_BAR; PG8_SCHED;
            PG8_LDB(B1, 1, 1); PG8_STAGE(PG8_SB(1, 0), b3, voffB);
            PG8_BAR; PG8_WAIT_L(0); PG8_MMA(0, 1, At, B1); PG8_BAR;
            PG8_LDA(At, 1, 1); PG8_STAGE(PG8_SA(1, 0), a3, voffA);
            PG8_BAR; PG8_WAIT_L(0); PG8_MMA(1, 0, At, B0); PG8_BAR; PG8_SCHED;
            PG8_STAGE(PG8_SB(1, 1), b3 + hstep, voffB);
            PG8_WAIT_V(6); PG8_BAR; PG8_MMA(1, 1, At, B1); PG8_BAR;
            }
        }
        if constexpr (ALIGN_EPI) { if (wr == 0) PG8_BAR; }
        if constexpr (!Epi::AFTER_DRAIN) { E(acc, cur, wr, wc, fr, fq); S.done(cur); }
        if (!has_next) break;
#pragma unroll
        for (int a = 0; a < 2; ++a)
#pragma unroll
            for (int b = 0; b < 2; ++b)
#pragma unroll
                for (int m = 0; m < 4; ++m)
#pragma unroll
                    for (int n = 0; n < 2; ++n) acc[a][b][m][n] = (f32x4){0.f, 0.f, 0.f, 0.f};
        cur = nxt; cA = nA; cB = nB; ++ui;
        if constexpr (ALIGN_EPI) { if (wr == 1) PG8_BAR; }
    }
    PG8_WAIT_V(0);
    if constexpr (!ALIGN_EPI) { if (wr == 0) PG8_BAR; }
    PG8_BAR;
    if constexpr (Epi::AFTER_DRAIN) { E.fused(acc, cur, wr, wc, fr, fq, lds, wid, lane); S.done(cur); }
#undef PG8_SA
#undef PG8_SB
#undef PG8_STAGE
#undef PG8_LDA
#undef PG8_LDB
#undef PG8_MMA
#undef PG8_WAIT_V
#undef PG8_WAIT_L
#undef PG8_BAR
#undef PG8_SCHED
}

struct UnitX { int pm, pn, kind, round; };
struct OpsX { const char* A; const char* Bt; int K; };
template <class Epi, class Sched>
__device__ __forceinline__ void gemm_stream(PG8_LAS unsigned char* lds, const Sched& S, const Epi& E) {
    int tid_ = threadIdx.x; asm volatile("" : "+v"(tid_));
    const int tid = tid_, wid = __builtin_amdgcn_readfirstlane(tid >> 6), lane = tid & 63, wr = wid >> 2, wc = wid & 3, fr = lane & 15, fq = lane >> 4;
    unsigned rA[2], rB[2], c2[2];
#pragma unroll
    for (int i = 0; i < 2; ++i) { int R, C; stage_rc(tid * 16 + i * 8192, R, C); rA[i] = (unsigned)R; rB[i] = (unsigned)((R & ~31) + perm32(R & 31)); c2[i] = (unsigned)C * 2u; }
    const size_t kstep = (size_t)(BK * 2);
    const unsigned ldsw = (unsigned)wid * 1024u;
    const int aoff = lds_byte(wr * 64 + fr, fq * 8), boff = lds_byte(wc * 32 + fr, fq * 8);
#define PG8_SA(b, h) (((b) * 2 + (h)) * HTB)
#define PG8_SB(b, h) ((4 + (b) * 2 + (h)) * HTB)
#define PGX_STAGE(bufoff, gbase, rr, pb) do { _Pragma("unroll") for (int _i = 0; _i < 2; ++_i) \
        __builtin_amdgcn_global_load_lds((const unsigned*)((const char*)(gbase) + ((rr)[_i] * (pb) + c2[_i])), (PG8_LAS unsigned*)(lds + (bufoff) + ldsw + _i * 8192), 16, 0, 0); } while (0)
#define PG8_LDA(dst, b, h) do { _Pragma("unroll") for (int m = 0; m < 4; ++m) _Pragma("unroll") for (int k = 0; k < 2; ++k) dst[m][k] = *(const PG8_LAS bf16x8*)(lds + PG8_SA(b, h) + aoff + m * 2048 + k * 1024); } while (0)
#define PG8_LDB(dst, b, h) do { _Pragma("unroll") for (int n = 0; n < 2; ++n) _Pragma("unroll") for (int k = 0; k < 2; ++k) dst[n][k] = *(const PG8_LAS bf16x8*)(lds + PG8_SB(b, h) + boff + n * 2048 + k * 1024); } while (0)
#define PG8_MMA(ai, bj, At, Bt) do { __builtin_amdgcn_s_setprio(1); _Pragma("unroll") for (int m = 0; m < 4; ++m) _Pragma("unroll") for (int n = 0; n < 2; ++n) _Pragma("unroll") for (int k = 0; k < 2; ++k) \
        acc[ai][bj][m][n] = __builtin_amdgcn_mfma_f32_16x16x32_bf16(Bt[n][k], At[m][k], acc[ai][bj][m][n], 0, 0, 0); __builtin_amdgcn_s_setprio(0); } while (0)
#define PG8_WAIT_V(n) asm volatile("s_waitcnt vmcnt(" #n ")" ::: "memory")
#define PG8_WAIT_L(n) asm volatile("s_waitcnt lgkmcnt(" #n ")" ::: "memory")
#define PG8_BAR __builtin_amdgcn_s_barrier()
#define PG8_SCHED __builtin_amdgcn_sched_barrier(0)
    UnitX cur, nxt; int ui = 0;
    if (!S.next(0, cur)) return;
    f32x4 acc[2][2][4][2];
#pragma unroll
    for (int a = 0; a < 2; ++a)
#pragma unroll
        for (int b = 0; b < 2; ++b)
#pragma unroll
            for (int m = 0; m < 4; ++m)
#pragma unroll
                for (int n = 0; n < 2; ++n) acc[a][b][m][n] = (f32x4){0.f, 0.f, 0.f, 0.f};
    bf16x8 At[4][2], B0[2][2], B1[2][2];
    OpsX oc = S.ops(cur);
    const char* cA = oc.A; const char* cB = oc.Bt; int Kc = oc.K;
    {   const unsigned pb = (unsigned)Kc * 2u; const size_t hstep = (size_t)HALF * pb;
        PGX_STAGE(PG8_SB(0, 0), cB, rB, pb); PGX_STAGE(PG8_SB(0, 1), cB + hstep, rB, pb); PGX_STAGE(PG8_SA(0, 0), cA, rA, pb); PGX_STAGE(PG8_SA(0, 1), cA + hstep, rA, pb);
        if (wr == 1) PG8_BAR;
        PG8_WAIT_V(2); PG8_BAR;
        PGX_STAGE(PG8_SB(1, 0), cB + kstep, rB, pb); PGX_STAGE(PG8_SA(1, 0), cA + kstep, rA, pb); PGX_STAGE(PG8_SB(1, 1), cB + hstep + kstep, rB, pb);
        PG8_WAIT_V(6); PG8_BAR; }
    for (;;) {
        const bool has_next = S.next(ui + 1, nxt);
        OpsX on = oc; if (has_next) on = S.ops(nxt);
        const char* nA = on.A; const char* nB = on.Bt; const int Kn = on.K;
        const int nt = Kc / BK; const unsigned pbc = (unsigned)Kc * 2u; const size_t hstep = (size_t)HALF * pbc;
        for (int t = 0; t < nt; t += 2) {
            const bool last = (t == nt - 2);
            const char* a1 = cA + (size_t)(t + 1) * kstep;
            const char* a2 = last ? nA : cA + (size_t)(t + 2) * kstep; const char* b2 = last ? nB : cB + (size_t)(t + 2) * kstep;
            const char* a3 = a2 + kstep; const char* b3 = b2 + kstep;
            const unsigned pb2 = last ? (unsigned)Kn * 2u : pbc; const size_t h2 = (size_t)HALF * pb2;
            PG8_LDB(B0, 0, 0); PG8_LDB(B1, 0, 1); PG8_SCHED; PG8_LDA(At, 0, 0); PGX_STAGE(PG8_SA(1, 1), a1 + hstep, rA, pbc);
            PG8_WAIT_V(8); PG8_WAIT_L(0); PG8_BAR; PG8_MMA(0, 0, At, B0); PG8_MMA(0, 1, At, B1); PG8_BAR; PG8_SCHED;
            PG8_LDA(At, 0, 1); PGX_STAGE(PG8_SB(0, 0), b2, rB, pb2); PGX_STAGE(PG8_SB(0, 1), b2 + h2, rB, pb2); PGX_STAGE(PG8_SA(0, 0), a2, rA, pb2);
            PG8_WAIT_V(8); PG8_WAIT_L(0); PG8_BAR; PG8_MMA(1, 0, At, B0); PG8_MMA(1, 1, At, B1); PG8_BAR; PG8_SCHED;
            PG8_LDB(B0, 1, 0); PG8_LDB(B1, 1, 1); PG8_SCHED; PG8_LDA(At, 1, 0); PGX_STAGE(PG8_SA(0, 1), a2 + h2, rA, pb2);
            PG8_WAIT_V(8); PG8_WAIT_L(0); PG8_BAR; PG8_MMA(0, 0, At, B0); PG8_MMA(0, 1, At, B1); PG8_BAR; PG8_SCHED;
            PG8_LDA(At, 1, 1); PGX_STAGE(PG8_SB(1, 0), b3, rB, pb2); PGX_STAGE(PG8_SB(1, 1), b3 + h2, rB, pb2); PGX_STAGE(PG8_SA(1, 0), a3, rA, pb2);
            PG8_WAIT_V(8); PG8_WAIT_L(0); PG8_BAR; PG8_MMA(1, 0, At, B0); PG8_MMA(1, 1, At, B1); PG8_BAR; PG8_SCHED;
        }
        if (wr == 0) PG8_BAR;
        E(acc, cur, wr, wc, fr, fq);
        if (!has_next) break;
#pragma unroll
        for (int a = 0; a < 2; ++a)
#pragma unroll
            for (int b = 0; b < 2; ++b)
#pragma unroll
                for (int m = 0; m < 4; ++m)
#pragma unroll
                    for (int n = 0; n < 2; ++n) acc[a][b][m][n] = (f32x4){0.f, 0.f, 0.f, 0.f};
        cur = nxt; oc = on; cA = nA; cB = nB; Kc = Kn; ++ui;
        if (wr == 1) PG8_BAR;
    }
    PG8_WAIT_V(0);
    PG8_BAR;
#undef PG8_SA
#undef PG8_SB
#undef PGX_STAGE
#undef PG8_LDA
#undef PG8_LDB
#undef PG8_MMA
#undef PG8_WAIT_V
#undef PG8_WAIT_L
#undef PG8_BAR
#undef PG8_SCHED
}
}
namespace pg8 {
constexpr int TOK = 16384;
constexpr float RMS_EPS = 1e-6f;
typedef float f32x2e __attribute__((ext_vector_type(2)));
template <int NP> __device__ __forceinline__ void row_scales(const float* src, int rowbase, int lane, int fr, float (&r)[2][4]) {
#pragma unroll
    for (int ai = 0; ai < 2; ++ai) {
        const int row = rowbase + 128 * ai + lane; float v;
        if (NP == 0) v = src[row];
        else { float s = 0.f;
#pragma unroll
            for (int p = 0; p < NP; ++p) s += src[(size_t)p * TOK + row];
            v = __builtin_amdgcn_rsqf(s * (1.0f / 1024.0f) + RMS_EPS); }
#pragma unroll
        for (int m = 0; m < 4; ++m) r[ai][m] = __shfl(v, 16 * m + fr);
    }
}
template <int NP, class Sched> __device__ __forceinline__ void build_row_tab(const float* src, const Sched& S, PG8_LAS float* tab) {
    Unit u;
    for (int i = 0; S.next(i, u); ++i)
        for (int r = (int)threadIdx.x; r < 256; r += 512) { const int row = u.pm * BM + r; float v;
            if (NP == 0) v = src[row];
            else { float s = 0.f;
#pragma unroll
                for (int p = 0; p < NP; ++p) s += src[(size_t)p * TOK + row];
                v = __builtin_amdgcn_rsqf(s * (1.0f / 1024.0f) + RMS_EPS); }
            tab[i * 256 + r] = v; }
    __syncthreads();
}
__device__ __forceinline__ void row_scales_tab(const PG8_LAS float* tab, int ui, int wr, int fr, float (&r)[2][4]) {
#pragma unroll
    for (int ai = 0; ai < 2; ++ai)
#pragma unroll
        for (int m = 0; m < 4; ++m) r[ai][m] = tab[ui * 256 + ai * 128 + wr * 64 + 16 * m + fr];
}
__device__ __forceinline__ float silu_f(float x) { return x * __builtin_amdgcn_rcpf(1.0f + __expf(-x)); }
__device__ __forceinline__ float sigmoid_f(float x) { return __builtin_amdgcn_rcpf(1.0f + __expf(-x)); }

template <int NP> struct EpiSwiGLU {
    static constexpr bool PERM = true, AFTER_DRAIN = false;
    bf16_t* H; int ldh; const PG8_LAS float* tab; mutable int ui = 0;
    __device__ __forceinline__ void operator()(const f32x4 (&acc)[2][2][4][2], const Unit& u, int wr, int wc, int fr0, int fq0) const {
        int fr = fr0, fq = fq0; asm volatile("" : "+v"(fr), "+v"(fq));
        float r[2][4]; row_scales_tab(tab, ui++, wr, fr, r);
        const int col0 = u.pn * 128 + wc * 32 + 8 * fq;
#pragma unroll
        for (int ai = 0; ai < 2; ++ai)
#pragma unroll
            for (int m = 0; m < 4; ++m) {
                const int row = u.pm * BM + ai * HALF + wr * 64 + m * 16 + fr; const float rr = r[ai][m];
                float o[8]; const float k1 = -1.44269504f * rr, rr2 = rr * rr;
#pragma unroll
                for (int n = 0; n < 2; ++n)
#pragma unroll
                    for (int j = 0; j < 4; j += 2) { const f32x2 g2 = (f32x2){acc[ai][0][m][n][j], acc[ai][0][m][n][j + 1]}, u2 = (f32x2){acc[ai][1][m][n][j], acc[ai][1][m][n][j + 1]};
                        const f32x2 t2 = g2 * k1; const f32x2 d2 = (f32x2){__builtin_amdgcn_exp2f(t2[0]), __builtin_amdgcn_exp2f(t2[1])} + 1.0f;
                        const f32x2 r2 = (f32x2){__builtin_amdgcn_rcpf(d2[0]), __builtin_amdgcn_rcpf(d2[1])} * rr2; const f32x2 o2 = (g2 * u2) * r2;
                        o[4 * n + j] = o2[0]; o[4 * n + j + 1] = o2[1]; }
                u32x4 w; w.x = cvt_pk_bf16(o[0], o[1]); w.y = cvt_pk_bf16(o[2], o[3]); w.z = cvt_pk_bf16(o[4], o[5]); w.w = cvt_pk_bf16(o[6], o[7]);
                *(u32x4*)(H + (size_t)row * ldh + col0) = w;
            }
    }
};
template <bool WRITE_HB> struct EpiResid {
    static constexpr bool PERM = true, AFTER_DRAIN = false;
    const float* base; float* out; bf16_t* hb; float* part; float sc;
    __device__ __forceinline__ void operator()(const f32x4 (&acc)[2][2][4][2], const Unit& u, int wr, int wc, int fr0, int fq0) const {
        int fr = fr0, fq = fq0; asm volatile("" : "+v"(fr), "+v"(fq));
        const int col0 = u.pn * BM + wc * 32 + 8 * fq;
#pragma unroll
        for (int ai = 0; ai < 2; ++ai)
#pragma unroll
            for (int m = 0; m < 4; ++m) {
                const int row = u.pm * BM + ai * HALF + wr * 64 + m * 16 + fr; float ss = 0.f;
#pragma unroll
                for (int bj = 0; bj < 2; ++bj) {
                    const size_t off = (size_t)row * 1024 + col0 + bj * HALF;
                    const f32x4 b0 = *(const f32x4*)(base + off), b1 = *(const f32x4*)(base + off + 4);
                    const f32x4 o0 = b0 + acc[ai][bj][m][0] * sc, o1 = b1 + acc[ai][bj][m][1] * sc;
                    *(f32x4*)(out + off) = o0; *(f32x4*)(out + off + 4) = o1;
                    if (WRITE_HB) {
                        ss += (o0[0] * o0[0] + o0[1] * o0[1]) + (o0[2] * o0[2] + o0[3] * o0[3]) + (o1[0] * o1[0] + o1[1] * o1[1]) + (o1[2] * o1[2] + o1[3] * o1[3]);
                        u32x4 w; w.x = cvt_pk_bf16(o0[0], o0[1]); w.y = cvt_pk_bf16(o0[2], o0[3]); w.z = cvt_pk_bf16(o1[0], o1[1]); w.w = cvt_pk_bf16(o1[2], o1[3]);
                        *(u32x4*)(hb + off) = w; }
                }
                if (WRITE_HB) { ss += __shfl_xor(ss, 16); ss += __shfl_xor(ss, 32); if (fq == 0) part[(size_t)(u.pn * 4 + wc) * TOK + row] = ss; }
                if (m == 3) asm volatile("" ::: "memory");
            }
    }
};
template <bool WRITE_HB> struct EpiResid2 {
    static constexpr bool PERM = true, AFTER_DRAIN = false;
    const float* base; float* out; bf16_t* hb; float* part; float sc;
    __device__ __forceinline__ void operator()(const f32x4 (&acc)[2][2][4][2], const Unit& u, int wr, int wc, int fr0, int fq0) const {
        int fr = fr0, fq = fq0; asm volatile("" : "+v"(fr), "+v"(fq));
        const int row0 = u.pm * BM + wr * 64 + fr; const size_t o00 = (size_t)row0 * 1024 + u.pn * BM + wc * 32 + 8 * fq;
        const float* bp = base + o00; float* op = out + o00; bf16_t* hp = hb + o00;
        f32x4 bq[2][8];
#define ER2_ISSUE(G, B) do { _Pragma("unroll") for (int c = 0; c < 8; ++c) { const int ai = (G) >> 1, m = 2 * ((G) & 1) + (c >> 2), bj = (c >> 1) & 1, n = c & 1; \
            bq[B][c] = *(const f32x4*)(bp + (size_t)(ai * 128 + m * 16) * 1024 + bj * 128 + 4 * n); } } while (0)
        ER2_ISSUE(0, 0);
#pragma unroll
        for (int G = 0; G < 4; ++G) {
            if (G + 1 < 4) { if ((G & 1) == 0) ER2_ISSUE(G + 1, 1); else ER2_ISSUE(G + 1, 0); }
            asm volatile("" ::: "memory");
#pragma unroll
            for (int mm = 0; mm < 2; ++mm) { const int ai = G >> 1, m = 2 * (G & 1) + mm; float ss = 0.f;
#pragma unroll
                for (int bj = 0; bj < 2; ++bj) { const size_t off = (size_t)(ai * 128 + m * 16) * 1024 + bj * 128;
                    const f32x4 o0 = bq[G & 1][mm * 4 + bj * 2] + acc[ai][bj][m][0] * sc, o1 = bq[G & 1][mm * 4 + bj * 2 + 1] + acc[ai][bj][m][1] * sc;
                    *(f32x4*)(op + off) = o0; *(f32x4*)(op + off + 4) = o1;
                    if (WRITE_HB) {
                        ss += (o0[0] * o0[0] + o0[1] * o0[1]) + (o0[2] * o0[2] + o0[3] * o0[3]) + (o1[0] * o1[0] + o1[1] * o1[1]) + (o1[2] * o1[2] + o1[3] * o1[3]);
                        u32x4 w; w.x = cvt_pk_bf16(o0[0], o0[1]); w.y = cvt_pk_bf16(o0[2], o0[3]); w.z = cvt_pk_bf16(o1[0], o1[1]); w.w = cvt_pk_bf16(o1[2], o1[3]);
                        *(u32x4*)(hp + off) = w; } }
                if (WRITE_HB) { ss += __shfl_xor(ss, 16); ss += __shfl_xor(ss, 32); if (fq == 0) part[(size_t)(u.pn * 4 + wc) * TOK + row0 + ai * 128 + m * 16] = ss; } }
            asm volatile("" ::: "memory");
        }
#undef ER2_ISSUE
    }
};
struct EpiMemKV {
    static constexpr bool PERM = true, AFTER_DRAIN = false;
    float* KV; const float* rs;
    __device__ __forceinline__ void operator()(const f32x4 (&acc)[2][2][4][2], const Unit& u, int wr, int wc, int fr0, int fq0) const {
        int fr = fr0, fq = fq0; asm volatile("" : "+v"(fr), "+v"(fq));
        float r[2][4]; row_scales<0>(rs, u.pm * BM + wr * 64, (int)(threadIdx.x & 63), fr, r);
        const int col0 = u.pn * BM + wc * 32 + 8 * fq;
#pragma unroll
        for (int ai = 0; ai < 2; ++ai)
#pragma unroll
            for (int m = 0; m < 4; ++m) { const int row = u.pm * BM + ai * HALF + wr * 64 + m * 16 + fr;
#pragma unroll
                for (int bj = 0; bj < 2; ++bj) { const size_t off = (size_t)row * 1024 + col0 + bj * HALF;
                    *(f32x4*)(KV + off) = acc[ai][bj][m][0] * r[ai][m]; *(f32x4*)(KV + off + 4) = acc[ai][bj][m][1] * r[ai][m]; } }
    }
};
template <int NP> struct EpiGate {
    static constexpr bool PERM = true, AFTER_DRAIN = false;
    bf16_t* scr; const PG8_LAS float* tab; mutable int ui = 0;
    __device__ __forceinline__ void operator()(const f32x4 (&acc)[2][2][4][2], const Unit& u, int wr, int wc, int fr0, int fq0) const {
        int fr = fr0, fq = fq0; asm volatile("" : "+v"(fr), "+v"(fq));
        float r[2][4];
#ifdef DBG_GATE_NOSCALE
        for (int a_ = 0; a_ < 2; ++a_) for (int m_ = 0; m_ < 4; ++m_) r[a_][m_] = 1.0f;
#else
        row_scales_tab(tab, ui++, wr, fr, r);
#endif
        bf16_t* t = scr + (size_t)(u.pm * 4 + u.pn) * 65536;
#pragma unroll
        for (int ai = 0; ai < 2; ++ai)
#pragma unroll
            for (int m = 0; m < 4; ++m) { const int lr = ai * HALF + wr * 64 + m * 16 + fr; const float rr = r[ai][m];
#pragma unroll
                for (int bj = 0; bj < 2; ++bj) { float o[8];
#pragma unroll
                    for (int n = 0; n < 2; ++n)
#pragma unroll
                        for (int j = 0; j < 4; ++j) o[4 * n + j] = sigmoid_f(acc[ai][bj][m][n][j] * rr);
                    u32x4 w; w.x = cvt_pk_bf16(o[0], o[1]); w.y = cvt_pk_bf16(o[2], o[3]); w.z = cvt_pk_bf16(o[4], o[5]); w.w = cvt_pk_bf16(o[6], o[7]);
                    *(u32x4*)(t + lr * 256 + bj * HALF + wc * 32 + 8 * fq) = w; } }
    }
};
__device__ __forceinline__ float bf_lo(unsigned w) { return __uint_as_float(w << 16); }
__device__ __forceinline__ float bf_hi(unsigned w) { return __uint_as_float(w & 0xffff0000u); }
struct EpiBranch {
    static constexpr bool PERM = true, AFTER_DRAIN = false;
    const bf16_t* scr; bf16_t* mg; bool first; float bscale;
    __device__ __forceinline__ void operator()(const f32x4 (&acc)[2][2][4][2], const Unit& u, int wr, int wc, int fr0, int fq0) const {
        int fr = fr0, fq = fq0; asm volatile("" : "+v"(fr), "+v"(fq));
        const bf16_t* t = scr + (size_t)(u.pm * 4 + u.pn) * 65536;
        __builtin_amdgcn_fence(__ATOMIC_ACQUIRE, "agent");
        asm volatile("s_waitcnt vmcnt(0)" ::: "memory");
#pragma unroll
        for (int ai = 0; ai < 2; ++ai)
#pragma unroll
            for (int m = 0; m < 4; ++m) { const int lr = ai * HALF + wr * 64 + m * 16 + fr; const int row = u.pm * BM + lr;
#pragma unroll
                for (int bj = 0; bj < 2; ++bj) { const int lc = bj * HALF + wc * 32 + 8 * fq;
#if defined(DBG_NOGATE) && DBG_NOGATE
                    const u32x4 g = (u32x4){0x3f803f80u, 0x3f803f80u, 0x3f803f80u, 0x3f803f80u};
#else
                    const u32x4 g = *(const u32x4*)(t + lr * 256 + lc);
#endif
                    bf16_t* mp = mg + (size_t)row * 1024 + u.pn * BM + lc;
                    float o[8];
                    o[0] = bf_lo(g.x) * acc[ai][bj][m][0][0]; o[1] = bf_hi(g.x) * acc[ai][bj][m][0][1]; o[2] = bf_lo(g.y) * acc[ai][bj][m][0][2]; o[3] = bf_hi(g.y) * acc[ai][bj][m][0][3];
                    o[4] = bf_lo(g.z) * acc[ai][bj][m][1][0]; o[5] = bf_hi(g.z) * acc[ai][bj][m][1][1]; o[6] = bf_lo(g.w) * acc[ai][bj][m][1][2]; o[7] = bf_hi(g.w) * acc[ai][bj][m][1][3];
#ifdef DBG_BRANCH_SIGMOID
#pragma unroll
                    for (int e = 0; e < 8; ++e) o[e] = DBG_NONLIN(o[e]);
#endif
#pragma unroll
                    for (int e = 0; e < 8; ++e) o[e] *= bscale;
                    if (!first) { const u32x4 p = *(const u32x4*)mp;
                        o[0] += bf_lo(p.x); o[1] += bf_hi(p.x); o[2] += bf_lo(p.y); o[3] += bf_hi(p.y); o[4] += bf_lo(p.z); o[5] += bf_hi(p.z); o[6] += bf_lo(p.w); o[7] += bf_hi(p.w); }
                    u32x4 w; w.x = cvt_pk_bf16(o[0], o[1]); w.y = cvt_pk_bf16(o[2], o[3]); w.z = cvt_pk_bf16(o[4], o[5]); w.w = cvt_pk_bf16(o[6], o[7]);
                    *(u32x4*)mp = w; }
                if (m & 1) asm volatile("" ::: "memory"); }
    }
};
template <bool FIRST> struct EpiBranch2 {
    const bf16_t* scr; bf16_t* mg;
    __device__ __forceinline__ void operator()(const f32x4 (&acc)[2][2][4][2], const Unit& u, int wr, int wc, int fr0, int fq0) const {
        int fr = fr0, fq = fq0; asm volatile("" : "+v"(fr), "+v"(fq));
        const bf16_t* t = scr + (size_t)(u.pm * 4 + u.pn) * 65536 + (wr * 64 + fr) * 256 + wc * 32 + 8 * fq;
        bf16_t* mp0 = mg + (size_t)(u.pm * BM + wr * 64 + fr) * 1024 + u.pn * BM + wc * 32 + 8 * fq;
        u32x4 gq[2][4], pq[2][4];
#define EB2_ISSUE(G, B) do { _Pragma("unroll") for (int c = 0; c < 4; ++c) { const int ai = (G) >> 1, m = 2 * ((G) & 1) + (c >> 1), bj = c & 1; \
            gq[B][c] = *(const u32x4*)(t + (ai * 128 + m * 16) * 256 + bj * 128); if (!FIRST) pq[B][c] = *(const u32x4*)(mp0 + (size_t)(ai * 128 + m * 16) * 1024 + bj * 128); } } while (0)
        EB2_ISSUE(0, 0);
#pragma unroll
        for (int G = 0; G < 4; ++G) {
            if (G + 1 < 4) { if ((G & 1) == 0) EB2_ISSUE(G + 1, 1); else EB2_ISSUE(G + 1, 0); }
            asm volatile("" ::: "memory");
#pragma unroll
            for (int c = 0; c < 4; ++c) { const int ai = G >> 1, m = 2 * (G & 1) + (c >> 1), bj = c & 1; const u32x4 g = gq[G & 1][c];
                float o[8];
                o[0] = bf_lo(g.x) * acc[ai][bj][m][0][0]; o[1] = bf_hi(g.x) * acc[ai][bj][m][0][1]; o[2] = bf_lo(g.y) * acc[ai][bj][m][0][2]; o[3] = bf_hi(g.y) * acc[ai][bj][m][0][3];
                o[4] = bf_lo(g.z) * acc[ai][bj][m][1][0]; o[5] = bf_hi(g.z) * acc[ai][bj][m][1][1]; o[6] = bf_lo(g.w) * acc[ai][bj][m][1][2]; o[7] = bf_hi(g.w) * acc[ai][bj][m][1][3];
                if (!FIRST) { const u32x4 p = pq[G & 1][c];
                    o[0] += bf_lo(p.x); o[1] += bf_hi(p.x); o[2] += bf_lo(p.y); o[3] += bf_hi(p.y); o[4] += bf_lo(p.z); o[5] += bf_hi(p.z); o[6] += bf_lo(p.w); o[7] += bf_hi(p.w); }
                u32x4 w; w.x = cvt_pk_bf16(o[0], o[1]); w.y = cvt_pk_bf16(o[2], o[3]); w.z = cvt_pk_bf16(o[4], o[5]); w.w = cvt_pk_bf16(o[6], o[7]);
                *(u32x4*)(mp0 + (size_t)(ai * 128 + m * 16) * 1024 + bj * 128) = w; }
            asm volatile("" ::: "memory");
        }
#undef EB2_ISSUE
    }
};
template <size_t O_HB, size_t O_WG, size_t O_A0, size_t O_A1, size_t O_A2, size_t O_WB> struct P7Order {
    StaticOrder T; const char* ws;
    __device__ __forceinline__ bool next(int i, UnitX& u) const { const int rd = i / 6; Unit t; if (!T.next(rd, t)) return false; u.pm = t.pm; u.pn = t.pn; u.kind = i - 6 * rd; u.round = rd; return true; }
    __device__ __forceinline__ OpsX ops(const UnitX& u) const { const int j = u.kind >> 1; OpsX o;
        if (u.kind & 1) { o.K = 512; o.A = ws + (j == 0 ? O_A0 : j == 1 ? O_A1 : O_A2) + (size_t)u.pm * (256 * 512 * 2); o.Bt = ws + O_WB + (size_t)j * (1024 * 512 * 2) + (size_t)u.pn * (256 * 512 * 2); }
        else { o.K = 1024; o.A = ws + O_HB + (size_t)u.pm * (256 * 1024 * 2); o.Bt = ws + O_WG + (size_t)j * (1024 * 1024 * 2) + (size_t)u.pn * (256 * 1024 * 2); }
        return o; }
};
struct EpiP7 {
    bf16_t* scr; bf16_t* mg; const PG8_LAS float* tab;
    __device__ __forceinline__ void operator()(const f32x4 (&acc)[2][2][4][2], const UnitX& u, int wr, int wc, int fr, int fq) const {
        const Unit uu{u.pm, u.pn};
        if (u.kind == 1) { const EpiBranch2<true> b{scr, mg}; b(acc, uu, wr, wc, fr, fq); }
        else if (u.kind & 1) { const EpiBranch2<false> b{scr, mg}; b(acc, uu, wr, wc, fr, fq); }
        else { const EpiGate<16> g{scr, tab, u.round}; g(acc, uu, wr, wc, fr, fq); }
    }
};
struct ProjOut { bf16_t *FQ, *FK, *FV, *DQ, *IQ, *MQ, *DK, *DV, *IK; float *LOGF, *IW; const float *cosT, *sinT, *g_fq, *g_fk, *g_dq, *g_dk, *b_forget; };
__device__ __forceinline__ float log_sigmoid_f(float z) { return z >= 0.f ? -log1pf(expf(-z)) : z - log1pf(expf(z)); }
template <int NP> struct EpiProj {
    static constexpr bool PERM = true, AFTER_DRAIN = false;
    ProjOut P; const PG8_LAS float* tab; float qscale; mutable int ui = 0;
    __device__ __forceinline__ void operator()(const f32x4 (&acc)[2][2][4][2], const Unit& u, int wr, int wc, int fr0, int fq0) const {
        int fr = fr0, fq = fq0; asm volatile("" : "+v"(fr), "+v"(fq));
        float r[2][4]; row_scales_tab(tab, ui++, wr, fr, r);
        const int pn = u.pn;
        bool do_norm = false, do_rope = false; const float* gain = nullptr; bf16_t* dst = nullptr; int pitch = 512, hoff = 0; float osc = 1.f;
        if (pn < 2)       { do_norm = true; gain = P.g_fq; dst = P.FQ; hoff = (4 * pn + wc) * 64; osc = qscale; }
        else if (pn < 4)  { do_norm = true; gain = P.g_fk; dst = P.FK; hoff = (4 * (pn - 2) + wc) * 64; }
        else if (pn < 6)  { dst = P.FV; hoff = (4 * (pn - 4) + wc) * 64; }
        else if (pn < 8)  { do_norm = true; do_rope = true; gain = P.g_dq; dst = P.DQ; hoff = (4 * (pn - 6) + wc) * 64; osc = qscale; }
        else if (pn < 10) { do_rope = true; dst = P.IQ; hoff = (4 * (pn - 8) + wc) * 64; }
        else if (pn < 12) { dst = P.MQ; hoff = (2 * (pn - 10) + (wc >> 1)) * 128 + (wc & 1) * 64; }
        else { pitch = 64;
            if (wc == 0)      { do_norm = true; do_rope = true; gain = P.g_dk; dst = P.DK; }
            else if (wc == 1) { dst = P.DV; }
            else if (wc == 2) { do_rope = true; dst = P.IK; }
            else dst = nullptr; }
        if (dst == nullptr) {
            if (fq < 2) {
#pragma unroll
                for (int ai = 0; ai < 2; ++ai)
#pragma unroll
                    for (int m = 0; m < 4; ++m) { const int row = u.pm * BM + ai * HALF + wr * 64 + m * 16 + fr; const float rr = r[ai][m];
                        f32x4 v0 = acc[ai][0][m][0] * rr, v1 = acc[ai][0][m][1] * rr;
                        if (fq == 0) {
                            const f32x4 b0 = *(const f32x4*)(P.b_forget), b1 = *(const f32x4*)(P.b_forget + 4);
#pragma unroll
                            for (int j = 0; j < 4; ++j) { v0[j] = log_sigmoid_f(v0[j] + b0[j]); v1[j] = log_sigmoid_f(v1[j] + b1[j]); }
                            *(f32x4*)(P.LOGF + (size_t)row * 8) = v0; *(f32x4*)(P.LOGF + (size_t)row * 8 + 4) = v1;
                        } else { const float c = 0.04419417382f; *(f32x4*)(P.IW + (size_t)row * 8) = v0 * c; *(f32x4*)(P.IW + (size_t)row * 8 + 4) = v1 * c; } }
            }
            return;
        }
        const bool ikl = (pn == 12 && wc == 2);
        if (do_norm) { if (do_rope) body<true, true, false>(acc, u, r, gain, dst, pitch, hoff, osc, wr, fr, fq); else body<true, false, false>(acc, u, r, gain, dst, pitch, hoff, osc, wr, fr, fq); }
        else if (do_rope) { if (ikl) body<false, true, true>(acc, u, r, gain, dst, pitch, hoff, osc, wr, fr, fq); else body<false, true, false>(acc, u, r, gain, dst, pitch, hoff, osc, wr, fr, fq); }
        else body<false, false, false>(acc, u, r, gain, dst, pitch, hoff, osc, wr, fr, fq);
    }
    template <bool NORM, bool ROPE, bool IKL>
    __device__ __forceinline__ void body(const f32x4 (&acc)[2][2][4][2], const Unit& u, const float (&r)[2][4], const float* gain, bf16_t* dst, int pitch, int hoff, float osc, int wr, int fr, int fq) const {
        f32x4 gv[2][2];
        if (NORM) {
#pragma unroll
            for (int bj = 0; bj < 2; ++bj)
#pragma unroll
                for (int n = 0; n < 2; ++n) gv[bj][n] = *(const f32x4*)(gain + bj * 32 + 8 * fq + 4 * n);
        }
        f32x4 cq[2][4];
        const int rowb = u.pm * BM + wr * 64 + fr;
#define EP_ISSUE(I, B) do { const size_t ro_ = (size_t)(rowb + ((I) >> 2) * HALF + ((I) & 3) * 16) * 32 + 8 * fq; \
            cq[B][0] = *(const f32x4*)(P.cosT + ro_); cq[B][1] = *(const f32x4*)(P.cosT + ro_ + 4); cq[B][2] = *(const f32x4*)(P.sinT + ro_); cq[B][3] = *(const f32x4*)(P.sinT + ro_ + 4); } while (0)
        if (ROPE) EP_ISSUE(0, 0);
#pragma unroll
        for (int ai = 0; ai < 2; ++ai)
#pragma unroll
            for (int m = 0; m < 4; ++m) {
                const int row = u.pm * BM + ai * HALF + wr * 64 + m * 16 + fr; const float rr = r[ai][m];
                if (ROPE) { if (4 * ai + m + 1 < 8) { if (((4 * ai + m) & 1) == 0) EP_ISSUE(4 * ai + m + 1, 1); else EP_ISSUE(4 * ai + m + 1, 0); } asm volatile("" ::: "memory"); }
                f32x4 v[2][2];
#pragma unroll
                for (int bj = 0; bj < 2; ++bj)
#pragma unroll
                    for (int n = 0; n < 2; ++n) v[bj][n] = acc[ai][bj][m][n] * rr;
                if (NORM) {
                    float ss = 0.f;
#pragma unroll
                    for (int bj = 0; bj < 2; ++bj)
#pragma unroll
                        for (int n = 0; n < 2; ++n) ss += (v[bj][n][0] * v[bj][n][0] + v[bj][n][1] * v[bj][n][1]) + (v[bj][n][2] * v[bj][n][2] + v[bj][n][3] * v[bj][n][3]);
                    ss += __shfl_xor(ss, 16); ss += __shfl_xor(ss, 32);
                    const float inv = __builtin_amdgcn_rsqf(ss * (1.0f / 64.0f) + RMS_EPS);
#pragma unroll
                    for (int bj = 0; bj < 2; ++bj)
#pragma unroll
                        for (int n = 0; n < 2; ++n) v[bj][n] = v[bj][n] * inv * gv[bj][n];
                }
                if (ROPE) {
#pragma unroll
                    for (int n = 0; n < 2; ++n) {
                        const f32x4 c = cq[(4 * ai + m) & 1][n], s = cq[(4 * ai + m) & 1][2 + n];
                        const f32x4 x1 = v[0][n], x2 = v[1][n];
                        v[0][n] = x1 * c - x2 * s; v[1][n] = x2 * c + x1 * s; }
                }
#pragma unroll
                for (int bj = 0; bj < 2; ++bj) {
                    const f32x4 a = v[bj][0] * osc, b = v[bj][1] * osc;
                    u32x4 w; w.x = cvt_pk_bf16(a[0], a[1]); w.y = cvt_pk_bf16(a[2], a[3]); w.z = cvt_pk_bf16(b[0], b[1]); w.w = cvt_pk_bf16(b[2], b[3]);
                    if (IKL) {
                        const int d = bj * 32 + 8 * fq; *(u32x4*)(dst + (size_t)(row >> 5) * 2048 + (d >> 4) * 512 + ((d >> 3) & 1) * 256 + (row & 31) * 8) = w;
                    } else *(u32x4*)(dst + (size_t)row * pitch + hoff + bj * 32 + 8 * fq) = w; }
                if (ROPE) asm volatile("" ::: "memory");
            }
#undef EP_ISSUE
    }
};
}
#define GAS __attribute__((address_space(1)))
#define LAS __attribute__((address_space(3)))
typedef unsigned short bf16;
typedef unsigned v4u __attribute__((ext_vector_type(4)));
typedef float f32x4 __attribute__((ext_vector_type(4)));
typedef short bf16x8 __attribute__((ext_vector_type(8)));
typedef GAS unsigned gu32;
typedef GAS unsigned long long gu64;
#define RLX_AGENT __ATOMIC_RELAXED, __HIP_MEMORY_SCOPE_AGENT
#define LDS_WAIT() asm volatile("s_waitcnt lgkmcnt(0)" ::: "memory")
#define VM_WAIT() asm volatile("s_waitcnt vmcnt(0)" ::: "memory")
__device__ __forceinline__ unsigned long long rt() { return __builtin_amdgcn_s_memrealtime(); }
__device__ __forceinline__ unsigned f2bf(float f) { unsigned u = __builtin_bit_cast(unsigned, f); return (u + 0x7fffu + ((u >> 16) & 1u)) >> 16; }
__device__ __forceinline__ unsigned pk2(float lo, float hi) { return f2bf(lo) | (f2bf(hi) << 16); }
typedef float f32x2g __attribute__((ext_vector_type(2)));
__device__ __forceinline__ float bf_lo32(unsigned w) { return __uint_as_float(w << 16); }
__device__ __forceinline__ float bf_hi32(unsigned w) { return __uint_as_float(w & 0xffff0000u); }
constexpr int NWAVES = 8;
constexpr int BATCH = 2, SEQ = 8192, DM = 1024, T = BATCH * SEQ, DFF = 2816, MEMLEN = 256, BW = 512, DIN = 6352;
constexpr int NPROJ = 13 * 256, NGATE = 3072;
constexpr float L2E = 1.4426950408889634f;
constexpr float C2_64 = 0.125f * L2E;
constexpr float C2_128 = 0.08838834764831845f * L2E;
constexpr size_t MiB = 1u << 20;
constexpr size_t WS_CTL = 0, CTL_ZERO_BYTES = 128 * 1024;
constexpr size_t WS_RSTDX = 1 * MiB;
constexpr size_t WS_RSTDM = WS_RSTDX + 64 * 1024;
constexpr size_t WS_T0 = WS_RSTDM + 4096;
constexpr size_t WS_SSQ1 = 2 * MiB;
constexpr size_t WS_SSQ2 = 3 * MiB;
constexpr size_t WS_LOGF = 4 * MiB;
constexpr size_t WS_CUM = WS_LOGF + 512 * 1024;
constexpr size_t WS_IW = 5 * MiB;
constexpr size_t WS_COS = 6 * MiB, WS_SIN = 8 * MiB;
constexpr size_t WS_MEMB = 10 * MiB;
constexpr size_t WS_KVM = 11 * MiB;
constexpr size_t WS_KMB = 13 * MiB, WS_VMB = 14 * MiB;
constexpr size_t WS_WGU1 = 16 * MiB;
constexpr size_t WS_WD1 = 27 * MiB;
constexpr size_t WS_WIN = 33 * MiB;
constexpr size_t WS_WGATE = 40 * MiB;
constexpr size_t WS_WBR = 46 * MiB;
constexpr size_t WS_WOUT = 49 * MiB;
constexpr size_t WS_WGU2 = 51 * MiB;
constexpr size_t WS_WD2 = 62 * MiB;
constexpr size_t WS_WMKV = 68 * MiB;
constexpr size_t WS_HB = 70 * MiB;
constexpr size_t WS_ACT = 102 * MiB;
constexpr size_t WS_HID = WS_ACT;
constexpr size_t WS_FQ = WS_ACT, WS_FK = WS_ACT + 16 * MiB, WS_FV = WS_ACT + 32 * MiB, WS_DQ = WS_ACT + 48 * MiB, WS_IQ = WS_ACT + 64 * MiB, WS_MQ = WS_ACT + 80 * MiB;
constexpr size_t WS_DK = WS_ACT + 96 * MiB, WS_DV = WS_ACT + 98 * MiB, WS_IK = WS_ACT + 100 * MiB;
#if defined(DBG_SUBST) && DBG_SUBST == 2
constexpr size_t WS_MERGED = WS_DQ;
#else
constexpr size_t WS_MERGED = WS_FK;
#endif
#ifdef DBG_GSCR_AT
constexpr size_t WS_GSCR = DBG_GSCR_AT;
#else
constexpr size_t WS_GSCR = 204 * MiB;
#endif
constexpr size_t WS_OA = 236 * MiB;
constexpr size_t WS_OB = 16 * MiB;
constexpr size_t WS_END = 252 * MiB;
#ifndef DBG_GSCR_AT
static_assert(WS_HID + (size_t)T * DFF * 2 <= WS_GSCR && WS_IK + (size_t)T * 64 * 2 <= WS_GSCR, "d_ws map");
#endif
constexpr int CW_BAR = 4096;
constexpr int CW_Q = 16384;
constexpr int RING_OFF = 0, RING_BYTES = 131072;
constexpr int LDSCTL_OFF = RING_BYTES, MISC_OFF = LDSCTL_OFF + 320;
constexpr int LIST_OFF = RING_BYTES + 1024;
constexpr int SCANX_OFF = RING_BYTES + 6144;
constexpr int LDS_BYTES = 163840;
#define XB_TMO      128
#define XB_XCNT(j)  (256  + 64 * (j))
#define XB_XSUB(j)  (1280 + 64 * (j))
#define XB_XGEN(j)  (2304 + 64 * (j))
#define XB_TOP      3328
#define XB_TOPGEN   3392
#define XCD_BAR_WORDS 3456
#define XB_SPIN_CAP (1u << 18)

__device__ __forceinline__ unsigned xb_ld(unsigned* p)              { return __hip_atomic_load(p, __ATOMIC_RELAXED, __HIP_MEMORY_SCOPE_AGENT); }
__device__ __forceinline__ unsigned xb_add(unsigned* p, unsigned v) { return __hip_atomic_fetch_add(p, v, __ATOMIC_RELAXED, __HIP_MEMORY_SCOPE_AGENT); }
__device__ __forceinline__ unsigned xb_xcc_id() { return (unsigned)__builtin_amdgcn_s_getreg((3 << 11) | 20) & 0xFu; }
#define XB_SPIN(cond, bar) do { unsigned _sp = 0; while (cond) { __builtin_amdgcn_s_sleep(1); \
    if ((++_sp & 255u) == 0u) { if (xb_ld(&(bar)[XB_TMO])) break; if (_sp > XB_SPIN_CAP) { atomicAdd(&(bar)[XB_TMO], 1u); break; } } } } while (0)

struct XcdBarrier {
    unsigned* bar; unsigned x;
    volatile LAS unsigned* st;
};

__device__ __forceinline__ XcdBarrier xcd_barrier_post(unsigned* bar, volatile LAS unsigned* st) {
    XcdBarrier b; b.bar = bar; b.x = xb_xcc_id(); b.st = st;
    if (threadIdx.x == 0) (void)xb_add(&bar[XB_XCNT(b.x)], 1u);
    return b;
}
__device__ __forceinline__ void xcd_barrier_complete(unsigned* bar, unsigned x, unsigned& nloc, unsigned& nx) {
    const unsigned G = gridDim.x * gridDim.y * gridDim.z;
    unsigned sum, cnt, mine, sp = 0u;
    for (;;) {
        sum = 0u; cnt = 0u; mine = 0u;
#pragma unroll
        for (unsigned j = 0; j < 16; ++j) { const unsigned c = xb_ld(&bar[XB_XCNT(j)]); sum += c; cnt += (c > 0u) ? 1u : 0u; mine = (j == x) ? c : mine; }
        if (sum == G) break;
        __builtin_amdgcn_s_sleep(1);
        if ((++sp & 255u) == 0u) { if (xb_ld(&bar[XB_TMO])) break; if (sp > XB_SPIN_CAP) { atomicAdd(&bar[XB_TMO], 1u); break; } }
    }
    nloc = mine > 0u ? mine : 1u; nx = cnt > 0u ? cnt : 1u;
}

__device__ __forceinline__ void xcd_barrier(const XcdBarrier& b) {
    asm volatile("s_waitcnt vmcnt(0)" ::: "memory");
    __syncthreads();
    if (threadIdx.x == 0) {
        unsigned* bar = b.bar;
        __builtin_amdgcn_s_waitcnt(0);
        unsigned nloc = b.st[0], nx = b.st[1];
        if (nloc == 0u) { xcd_barrier_complete(bar, b.x, nloc, nx); b.st[0] = nloc; b.st[1] = nx; }
        const unsigned old = xb_add(&bar[XB_XSUB(b.x)], 1u);
        const unsigned gen = old / nloc;
        if (old + 1u == (gen + 1u) * nloc) {
            __builtin_amdgcn_fence(__ATOMIC_RELEASE, "agent");
            asm volatile("s_waitcnt vmcnt(0)" ::: "memory");
            const unsigned og = xb_add(&bar[XB_TOP], 1u);
            const unsigned tg = og / nx;
            if (og + 1u == (tg + 1u) * nx) xb_add(&bar[XB_TOPGEN], 1u);
            else XB_SPIN(xb_ld(&bar[XB_TOPGEN]) == tg, bar);
            __builtin_amdgcn_fence(__ATOMIC_ACQUIRE, "agent");
            xb_add(&bar[XB_XGEN(b.x)], 1u);
            asm volatile("s_waitcnt vmcnt(0)" ::: "memory");
        } else {
            XB_SPIN(xb_ld(&bar[XB_XGEN(b.x)]) == gen, bar);
            __builtin_amdgcn_fence(__ATOMIC_ACQUIRE, "agent");
            asm volatile("s_waitcnt vmcnt(0)" ::: "memory");
        }
    }
    __syncthreads();
}
__device__ __forceinline__ float wave_sum(float v) {
#pragma unroll
    for (int o = 1; o < 64; o <<= 1) v += __shfl_xor(v, o);
    return v;
}
__device__ __forceinline__ float wave_max(float v) {
#pragma unroll
    for (int o = 1; o < 64; o <<= 1) v = fmaxf(v, __shfl_xor(v, o));
    return v;
}
__device__ __forceinline__ int colmap(int mat, int n) {
    if (mat == 1) return n;
    if (mat == 3) return 3280 + n;
    const int tile = n >> 8, t = n & 255;
    if (mat == 0) return (t < 128 ? 0 : DFF) + 128 * tile + (t & 127);
    const int bj = t >> 7, wc = (t >> 5) & 3, i = t & 31, d = bj * 32 + i;
    if (tile < 2) return 0 + (4 * tile + wc) * 64 + d;
    if (tile < 4) return 512 + (4 * (tile - 2) + wc) * 64 + d;
    if (tile < 6) return 1024 + (4 * (tile - 4) + wc) * 64 + d;
    if (tile < 8) return 1544 + (4 * (tile - 6) + wc) * 64 + d;
    if (tile < 10) return 2184 + (4 * (tile - 8) + wc) * 64 + d;
    if (tile < 12) return 2768 + (2 * (tile - 10) + (wc >> 1)) * 128 + (wc & 1) * 64 + d;
    if (wc == 0) return 2056 + d;
    if (wc == 1) return 2120 + d;
    if (wc == 2) return 2696 + d;
    if (bj == 0 && i < 8) return 1536 + i;
    if (bj == 0 && i < 16) return 2760 + (i - 8);
    return -1;
}
template <bool GAIN> __device__ __forceinline__ void transpose_item(int mat, const float* Wa, const float* Wb, int K, int Nsrc, const float* gain, bf16* WT, LAS float* scr, int item, int nblk, int lane) {
    const int kb = item / nblk, nb = item % nblk, k0 = 64 * kb, n0 = 32 * nb;
    int col = colmap(mat, n0 + (lane & 31)); const float* W = Wa;
    if (mat == 0 && col >= DFF) { W = Wb; col -= DFF; }
    const bool okc = col >= 0; const float* wp = W + (size_t)(k0 + (lane >> 5)) * Nsrc + (okc ? col : 0); const float* gp = gain + k0 + (lane >> 5);
    float v[32];
#pragma unroll
    for (int i = 0; i < 32; ++i) v[i] = wp[(size_t)(2 * i) * Nsrc];
    if (GAIN) {
#pragma unroll
        for (int i = 0; i < 32; ++i) v[i] *= gp[2 * i]; }
#pragma unroll
    for (int i = 0; i < 32; ++i) scr[(2 * i + (lane >> 5)) * 33 + (lane & 31)] = okc ? v[i] : 0.f;
    LDS_WAIT(); asm volatile("" ::: "memory");
    const int c = lane & 7;
#pragma unroll
    for (int j = 0; j < 4; ++j) { const int n = (lane >> 3) + 8 * j; const LAS float* s = scr + (8 * c) * 33 + n;
        v4u o; o.x = pk2(s[0 * 33], s[1 * 33]); o.y = pk2(s[2 * 33], s[3 * 33]); o.z = pk2(s[4 * 33], s[5 * 33]); o.w = pk2(s[6 * 33], s[7 * 33]);
        *(GAS v4u*)(WT + (size_t)(n0 + n) * K + k0 + 8 * c) = o; }
    LDS_WAIT(); asm volatile("" ::: "memory");
}
__device__ __forceinline__ void row_to_bf16_rstd(const float* xrow, bf16* orow, float* rstd_out, int lane) {
    const GAS f32x4* xr = (const GAS f32x4*)xrow + lane;
    f32x4 v[4]; float s = 0.f;
#pragma unroll
    for (int j = 0; j < 4; ++j) { v[j] = xr[64 * j]; s += (v[j].x * v[j].x + v[j].y * v[j].y) + (v[j].z * v[j].z + v[j].w * v[j].w); }
    const float rstd = 1.0f / sqrtf(wave_sum(s) * (1.f / 1024.f) + 1e-6f);
    GAS unsigned long long* o8 = (GAS unsigned long long*)orow + lane;
#pragma unroll
    for (int j = 0; j < 4; ++j) o8[64 * j] = (unsigned long long)pk2(v[j].x, v[j].y) | ((unsigned long long)pk2(v[j].z, v[j].w) << 32);
    if (lane == 0) *rstd_out = rstd;
}
__device__ __forceinline__ void rows4_to_bf16_rstd(const float* const (&xrow)[4], bf16* const (&orow)[4], float* const (&rout)[4], const bool (&ok)[4], int lane) {
    f32x4 v[4][4];
#pragma unroll
    for (int r = 0; r < 4; ++r) { const GAS f32x4* xr = (const GAS f32x4*)xrow[r] + lane;
#pragma unroll
        for (int j = 0; j < 4; ++j) v[r][j] = xr[64 * j]; }
#pragma unroll
    for (int r = 0; r < 4; ++r) { float s = 0.f;
#pragma unroll
        for (int j = 0; j < 4; ++j) s += (v[r][j].x * v[r][j].x + v[r][j].y * v[r][j].y) + (v[r][j].z * v[r][j].z + v[r][j].w * v[r][j].w);
        const float rstd = 1.0f / sqrtf(wave_sum(s) * (1.f / 1024.f) + 1e-6f);
        if (ok[r]) { GAS unsigned long long* o8 = (GAS unsigned long long*)orow[r] + lane;
#pragma unroll
            for (int j = 0; j < 4; ++j) o8[64 * j] = (unsigned long long)pk2(v[r][j].x, v[r][j].y) | ((unsigned long long)pk2(v[r][j].z, v[r][j].w) << 32);
            if (lane == 0) *rout[r] = rstd; } }
}
typedef float f32x16 __attribute__((ext_vector_type(16)));
typedef unsigned u32x2 __attribute__((ext_vector_type(2)));
__device__ __forceinline__ int crow(int r, int hi) { return (r & 3) + 8 * (r >> 2) + 4 * hi; }
__device__ __forceinline__ float bf2f(bf16 v) { return __uint_as_float((unsigned)v << 16); }
__device__ __forceinline__ unsigned cvtpk(float lo, float hi) { return pg8::cvt_pk_bf16(lo, hi); }
template <int HD, bool FOX, bool VT>
__device__ __forceinline__ void attn_wave_simple(const bf16x8 (&qr)[HD / 16], const bf16* Kp, int kpitch, const bf16* Vp, int vpitch, int tstart, int ntiles, int qlocal, const float* cb, bf16* Op, int opitch, int lane) {
    const int r32 = lane & 31, hi = lane >> 5;
    f32x16 o[HD / 32];
#pragma unroll
    for (int d0 = 0; d0 < HD / 32; ++d0)
#pragma unroll
        for (int r = 0; r < 16; ++r) o[d0][r] = 0.f;
    float m = -1e30f, l = 0.f;
    for (int t = tstart; t < ntiles; ++t) {
        const int kv0 = 32 * t;
        f32x16 p;
#pragma unroll
        for (int r = 0; r < 16; ++r) p[r] = 0.f;
        const bf16* kr = Kp + (size_t)(kv0 + r32) * kpitch + hi * 8;
#pragma unroll
        for (int ks = 0; ks < HD / 16; ++ks) { const bf16x8 kf = *(const bf16x8*)(kr + ks * 16); p = __builtin_amdgcn_mfma_f32_32x32x16_bf16(kf, qr[ks], p, 0, 0, 0); }
        if (FOX) {
#pragma unroll
            for (int g = 0; g < 4; ++g) { const f32x4 c4 = *(const f32x4*)(cb + kv0 + 8 * g + 4 * hi);
#pragma unroll
                for (int jj = 0; jj < 4; ++jj) p[4 * g + jj] -= L2E * c4[jj]; }
            if (t == ntiles - 1) {
#pragma unroll
                for (int r = 0; r < 16; ++r) if (kv0 + crow(r, hi) > qlocal) p[r] = -INFINITY;
            }
        }
        float mt = p[0];
#pragma unroll
        for (int r = 1; r < 16; ++r) mt = fmaxf(mt, p[r]);
        mt = fmaxf(mt, __shfl_xor(mt, 32));
        const float mn = fmaxf(m, mt); const float alpha = __builtin_amdgcn_exp2f(m - mn); m = mn;
        l *= alpha;
#pragma unroll
        for (int d0 = 0; d0 < HD / 32; ++d0)
#pragma unroll
            for (int r = 0; r < 16; ++r) o[d0][r] *= alpha;
        float ls = 0.f;
#pragma unroll
        for (int r = 0; r < 16; ++r) { p[r] = __builtin_amdgcn_exp2f(p[r] - mn); ls += p[r]; }
        l += ls;
        bf16x8 pa[2];
#pragma unroll
        for (int s = 0; s < 2; ++s) { v4u w; w.x = cvtpk(p[8 * s + 0], p[8 * s + 1]); w.y = cvtpk(p[8 * s + 2], p[8 * s + 3]); w.z = cvtpk(p[8 * s + 4], p[8 * s + 5]); w.w = cvtpk(p[8 * s + 6], p[8 * s + 7]); pa[s] = __builtin_bit_cast(bf16x8, w); }
#pragma unroll
        for (int d0 = 0; d0 < HD / 32; ++d0)
#pragma unroll
            for (int s = 0; s < 2; ++s) {
                bf16x8 vf;
                if (VT) {
                    const bf16* vp = Vp + (size_t)(d0 * 32 + r32) * vpitch + kv0 + 16 * s + 4 * hi;
                    const u32x2 lo = *(const u32x2*)vp, hi2 = *(const u32x2*)(vp + 8);
                    vf = __builtin_bit_cast(bf16x8, (v4u){lo.x, lo.y, hi2.x, hi2.y});
                } else {
#pragma unroll
                    for (int j = 0; j < 8; ++j) vf[j] = (short)Vp[(size_t)(kv0 + 16 * s + 8 * (j >> 2) + 4 * hi + (j & 3)) * vpitch + d0 * 32 + r32];
                }
                o[d0] = __builtin_amdgcn_mfma_f32_32x32x16_bf16(vf, pa[s], o[d0], 0, 0, 0);
            }
    }
    l += __shfl_xor(l, 32);
    const float inv = 1.0f / l;
    bf16* orow = Op + (size_t)r32 * opitch;
#pragma unroll
    for (int d0 = 0; d0 < HD / 32; ++d0)
#pragma unroll
        for (int g = 0; g < 4; ++g) { u32x2 w; w.x = cvtpk(o[d0][4 * g] * inv, o[d0][4 * g + 1] * inv); w.y = cvtpk(o[d0][4 * g + 2] * inv, o[d0][4 * g + 3] * inv);
            *(u32x2*)(orow + d0 * 32 + 8 * g + 4 * hi) = w; }
}
__device__ __forceinline__ void fox_unit(int bh, int qb, const bf16* FQ, const bf16* FK, const bf16* FV, const float* CUM, const int* T0, bf16* OA, int wave, int lane) {
    const int b = bh >> 3, h = bh & 7, r32 = lane & 31, hi = lane >> 5; const size_t rowbase = (size_t)b * SEQ; const int q0 = qb * 256 + wave * 32;
    const bf16* Qw = FQ + (rowbase + q0) * 512 + h * 64; bf16* Ow = OA + (rowbase + q0) * 512 + h * 64;
    bf16x8 qr[4];
#pragma unroll
    for (int ks = 0; ks < 4; ++ks) qr[ks] = *(const bf16x8*)(Qw + (size_t)r32 * 512 + ks * 16 + hi * 8);
    attn_wave_simple<64, true, false>(qr, FK + rowbase * 512 + h * 64, 512, FV + rowbase * 512 + h * 64, 512, T0[bh * 256 + q0 / 32], q0 / 32 + 1, q0 + r32, CUM + (size_t)bh * SEQ, Ow, 512, lane);
}
__device__ __forceinline__ void mem_unit(int rg, int head, bf16* MQ, const bf16* KMB, const bf16* VMB, const float* gq, int lane) {
    const int r32 = lane & 31, hi = lane >> 5; const int row0 = rg * 32; const int b = row0 / SEQ;
    bf16* Qw = MQ + (size_t)row0 * 512 + head * 128;
    bf16x8 raw[8]; float ss = 0.f;
#pragma unroll
    for (int ks = 0; ks < 8; ++ks) { raw[ks] = *(const bf16x8*)(Qw + (size_t)r32 * 512 + ks * 16 + hi * 8);
#pragma unroll
        for (int j = 0; j < 8; ++j) { const float f = bf2f((bf16)raw[ks][j]); ss += f * f; } }
    ss += __shfl_xor(ss, 32);
    const float rstd = __builtin_amdgcn_rsqf(ss * (1.0f / 128.0f) + 1e-6f) * C2_128;
    bf16x8 qr[8];
#pragma unroll
    for (int ks = 0; ks < 8; ++ks) { const f32x4 g0 = *(const f32x4*)(gq + ks * 16 + hi * 8), g1 = *(const f32x4*)(gq + ks * 16 + hi * 8 + 4); v4u w;
        w.x = cvtpk(bf2f((bf16)raw[ks][0]) * rstd * g0[0], bf2f((bf16)raw[ks][1]) * rstd * g0[1]); w.y = cvtpk(bf2f((bf16)raw[ks][2]) * rstd * g0[2], bf2f((bf16)raw[ks][3]) * rstd * g0[3]);
        w.z = cvtpk(bf2f((bf16)raw[ks][4]) * rstd * g1[0], bf2f((bf16)raw[ks][5]) * rstd * g1[1]); w.w = cvtpk(bf2f((bf16)raw[ks][6]) * rstd * g1[2], bf2f((bf16)raw[ks][7]) * rstd * g1[3]);
        qr[ks] = __builtin_bit_cast(bf16x8, w); }
    attn_wave_simple<128, false, true>(qr, KMB + (size_t)b * MEMLEN * 512 + head * 128, 512, VMB + (size_t)(b * 4 + head) * 128 * MEMLEN, MEMLEN, 0, MEMLEN / 32, 0, nullptr, Qw, 512, lane);
}
typedef short v4i16_t __attribute__((ext_vector_type(4)));
__device__ __forceinline__ void mem_block(int u, bf16* MQ, const bf16* KMB, const bf16* VNB, const float* gq, LAS unsigned char* lds, int wave, int lane, int tid) {
    const int head = u & 3, rg = (u >> 2) * 8 + wave, row0 = rg * 32, b = row0 / SEQ;
    const int r32 = lane & 31, hi = lane >> 5;
    {   const bf16* ks_ = KMB + (size_t)b * MEMLEN * 512 + head * 128; const bf16* vs_ = VNB + (size_t)b * MEMLEN * 512 + head * 128;
#pragma unroll
        for (int i = 0; i < 8; ++i) { const int e = tid + 512 * i, key = e >> 4, c = e & 15;
            const v4u kv = *(const v4u*)(ks_ + (size_t)key * 512 + c * 8), vv = *(const v4u*)(vs_ + (size_t)key * 512 + c * 8);
            *(LAS v4u*)(lds + key * 256 + ((c ^ (key & 7)) * 16)) = kv; *(LAS v4u*)(lds + 65536 + key * 256 + c * 16) = vv; } }
    bf16* Qw = MQ + (size_t)row0 * 512 + head * 128;
    bf16x8 raw[8]; float ss = 0.f;
#pragma unroll
    for (int ks = 0; ks < 8; ++ks) { raw[ks] = *(const bf16x8*)(Qw + (size_t)r32 * 512 + ks * 16 + hi * 8);
#pragma unroll
        for (int j = 0; j < 8; ++j) { const float f = bf2f((bf16)raw[ks][j]); ss += f * f; } }
    ss += __shfl_xor(ss, 32);
    const float rstd = __builtin_amdgcn_rsqf(ss * (1.0f / 128.0f) + 1e-6f) * C2_128;
    bf16x8 qr[8];
#pragma unroll
    for (int ks = 0; ks < 8; ++ks) { const f32x4 g0 = *(const f32x4*)(gq + ks * 16 + hi * 8), g1 = *(const f32x4*)(gq + ks * 16 + hi * 8 + 4); v4u w;
        w.x = cvtpk(bf2f((bf16)raw[ks][0]) * rstd * g0[0], bf2f((bf16)raw[ks][1]) * rstd * g0[1]); w.y = cvtpk(bf2f((bf16)raw[ks][2]) * rstd * g0[2], bf2f((bf16)raw[ks][3]) * rstd * g0[3]);
        w.z = cvtpk(bf2f((bf16)raw[ks][4]) * rstd * g1[0], bf2f((bf16)raw[ks][5]) * rstd * g1[1]); w.w = cvtpk(bf2f((bf16)raw[ks][6]) * rstd * g1[2], bf2f((bf16)raw[ks][7]) * rstd * g1[3]);
        qr[ks] = __builtin_bit_cast(bf16x8, w); }
    __syncthreads();
    f32x16 o[4];
#pragma unroll
    for (int d0 = 0; d0 < 4; ++d0)
#pragma unroll
        for (int r = 0; r < 16; ++r) o[d0][r] = 0.f;
    float m = -1e30f, l = 0.f;
    const int kq = (lane >> 4) & 1, q_ = (lane & 15) >> 2, p_ = lane & 3;
#pragma unroll 1
    for (int t = 0; t < MEMLEN / 32; ++t) {
        const LAS unsigned char* kb = lds + (32 * t) * 256; const LAS unsigned char* vb = lds + 65536 + (32 * t) * 256;
        f32x16 p;
#pragma unroll
        for (int r = 0; r < 16; ++r) p[r] = 0.f;
#pragma unroll
        for (int ks = 0; ks < 8; ++ks) { const bf16x8 kf = *(const LAS bf16x8*)(kb + r32 * 256 + (((2 * ks + hi) ^ (r32 & 7)) * 16)); p = __builtin_amdgcn_mfma_f32_32x32x16_bf16(kf, qr[ks], p, 0, 0, 0); }
        float mt = p[0];
#pragma unroll
        for (int r = 1; r < 16; ++r) mt = fmaxf(mt, p[r]);
        mt = fmaxf(mt, __shfl_xor(mt, 32));
        if (__any(mt > m)) { const float mn_ = fmaxf(m, mt); const float alpha = __builtin_amdgcn_exp2f(m - mn_); m = mn_; l *= alpha;
#pragma unroll
            for (int d0 = 0; d0 < 4; ++d0)
#pragma unroll
                for (int r = 0; r < 16; ++r) o[d0][r] *= alpha; }
        const float mn = m; float ls = 0.f;
#pragma unroll
        for (int r = 0; r < 16; ++r) { p[r] = __builtin_amdgcn_exp2f(p[r] - mn); ls += p[r]; }
        l += ls;
        bf16x8 pa[2];
#pragma unroll
        for (int s2 = 0; s2 < 2; ++s2) { v4u w; w.x = cvtpk(p[8 * s2 + 0], p[8 * s2 + 1]); w.y = cvtpk(p[8 * s2 + 2], p[8 * s2 + 3]); w.z = cvtpk(p[8 * s2 + 4], p[8 * s2 + 5]); w.w = cvtpk(p[8 * s2 + 6], p[8 * s2 + 7]); pa[s2] = __builtin_bit_cast(bf16x8, w); }
#pragma unroll
        for (int d0 = 0; d0 < 4; ++d0)
#pragma unroll
            for (int s2 = 0; s2 < 2; ++s2) {
                const LAS unsigned char* a1 = vb + (16 * s2 + 4 * hi + q_) * 256 + (32 * d0 + 16 * kq + 4 * p_) * 2;
                const v4i16_t lo4 = __builtin_amdgcn_ds_read_tr16_b64_v4i16((LAS v4i16_t*)a1), hi4 = __builtin_amdgcn_ds_read_tr16_b64_v4i16((LAS v4i16_t*)(a1 + 8 * 256));
                const bf16x8 vf = (bf16x8){lo4[0], lo4[1], lo4[2], lo4[3], hi4[0], hi4[1], hi4[2], hi4[3]};
                o[d0] = __builtin_amdgcn_mfma_f32_32x32x16_bf16(vf, pa[s2], o[d0], 0, 0, 0); }
    }
    l += __shfl_xor(l, 32);
    const float inv = 1.0f / l;
    bf16* orow = Qw + (size_t)r32 * 512;
#pragma unroll
    for (int d0 = 0; d0 < 4; ++d0)
#pragma unroll
        for (int g = 0; g < 4; ++g) { u32x2 w; w.x = cvtpk(o[d0][4 * g] * inv, o[d0][4 * g + 1] * inv); w.y = cvtpk(o[d0][4 * g + 2] * inv, o[d0][4 * g + 3] * inv);
            *(u32x2*)(orow + d0 * 32 + 8 * g + 4 * hi) = w; }
    __syncthreads();
}
__device__ __forceinline__ void scan_unit(int bh, const float* LOGF, float* CUM, int* T0, const float* gq, const float* gk, LAS float* sx, LAS float* cl, int tid) {
    const int b = bh >> 3, h = bh & 7, lane = tid & 63, wave = tid >> 6;
    float v[16]; float run = 0.f;
#pragma unroll
    for (int i = 0; i < 16; ++i) v[i] = LOGF[((size_t)b * SEQ + 16 * tid + i) * 8 + h];
#pragma unroll
    for (int i = 0; i < 16; ++i) { run += v[i]; v[i] = run; }
    float tot = run;
#pragma unroll
    for (int off = 1; off < 64; off <<= 1) { const float nb = __shfl_up(tot, off); if (lane >= off) tot += nb; }
    if (lane == 63) sx[wave] = tot;
    __syncthreads();
    float woff = 0.f;
    for (int w = 0; w < wave; ++w) woff += sx[w];
    const float excl = tot - run + woff;
    float* dst = CUM + (size_t)bh * SEQ + 16 * tid;
#pragma unroll
    for (int i = 0; i < 16; i += 4) { const f32x4 o4 = (f32x4){v[i] + excl, v[i + 1] + excl, v[i + 2] + excl, v[i + 3] + excl}; *(f32x4*)(dst + i) = o4; *(LAS f32x4*)(cl + 16 * tid + i) = o4; }
    const float smax = 8.0f * wave_max(fabsf(gq[lane])) * wave_max(fabsf(gk[lane]));
    __syncthreads();
    if (tid < 256) { const float cq = cl[32 * tid]; const float lim = -(30.0f + 2.0f * smax);
        int lo = 0, hi = tid;
        while (lo < hi) { const int mid = (lo + hi) >> 1; if (cq - cl[32 * mid + 31] >= lim) hi = mid; else lo = mid + 1; }
        T0[bh * 256 + tid] = lo; }
    __syncthreads();
}
constexpr int D2_LST = RING_BYTES + 1024;
constexpr int D2_CNT = RING_BYTES + 3072;
constexpr int D2_CL = RING_BYTES + 4096;
typedef float f32x4d __attribute__((ext_vector_type(4)));
__device__ __forceinline__ unsigned sortable_u32(float f) { const unsigned u = __float_as_uint(f); return u ^ ((u >> 31) ? 0xFFFFFFFFu : 0x80000000u); }
__device__ __forceinline__ int lane_rank(unsigned long long mask) { return (int)__builtin_amdgcn_mbcnt_hi((unsigned)(mask >> 32), __builtin_amdgcn_mbcnt_lo((unsigned)mask, 0u)); }
__device__ __forceinline__ int bcount(bool p) { return (int)__popcll(__ballot(p)); }
__device__ __forceinline__ void select_full(const LAS unsigned* my, int npad, LAS unsigned short* lst, int lane) {
    unsigned thr = 0u;
    for (int bit = 31; bit >= 0; --bit) {
        const unsigned cand = thr | (1u << bit); int cnt = 0;
        for (int i0 = 0; i0 < npad; i0 += 256) { const int idx = i0 + 4 * lane; v4u v = (v4u){0u, 0u, 0u, 0u}; if (idx < npad) v = *(const LAS v4u*)(my + idx);
            cnt += bcount(v.x >= cand) + bcount(v.y >= cand) + bcount(v.z >= cand) + bcount(v.w >= cand); }
        if (cnt >= 256) thr = cand;
    }
    int cgt = 0;
    for (int i0 = 0; i0 < npad; i0 += 256) { const int idx = i0 + 4 * lane; v4u v = (v4u){0u, 0u, 0u, 0u}; if (idx < npad) v = *(const LAS v4u*)(my + idx);
        cgt += bcount(v.x > thr) + bcount(v.y > thr) + bcount(v.z > thr) + bcount(v.w > thr); }
    const int quota = 256 - cgt; int eqseen = 0, nsel = 0;
    for (int base = 0; base < npad; base += 64) { const int idx = base + lane; unsigned u = 0u; if (idx < npad) u = my[idx];
        const bool gt = u > thr, eq = (u == thr);
        const unsigned long long em = __ballot(eq); const int er = eqseen + lane_rank(em);
        const bool sel = gt || (eq && er < quota);
        const unsigned long long sm = __ballot(sel); const int pos = nsel + lane_rank(sm);
        if (sel && pos < 256) lst[pos] = (unsigned short)idx;
        nsel += __popcll(sm); eqseen += __popcll(em); }
}
template <int KMAX> __device__ __forceinline__ void select_cands(const unsigned (&uu)[16], const unsigned (&id)[16], LAS unsigned short* lst, int lane, unsigned lb = 0u) {
    unsigned thr = 0u;
    for (int bit = 31; bit >= 0; --bit) {
        if ((((thr ^ lb) >> bit) >> 1) == 0u && ((lb >> bit) & 1u)) { thr |= (1u << bit); continue; }
        const unsigned cand = thr | (1u << bit); int cnt = 0;
#pragma unroll
        for (int k = 0; k < KMAX; ++k) cnt += bcount(uu[k] >= cand);
        if (cnt >= 256) { thr = cand; if (cnt == 256) break; }
    }
    int cgt = 0, ceq = 0;
#pragma unroll
    for (int k = 0; k < KMAX; ++k) { cgt += bcount(uu[k] > thr); ceq += bcount(uu[k] == thr); }
    const int quota = 256 - cgt; unsigned ilim = 0xFFFFu;
    if (ceq != quota) {
        unsigned I = 0u;
        for (int bit = 12; bit >= 0; --bit) { const unsigned cand = I | (1u << bit); int cnt = 0;
#pragma unroll
            for (int k = 0; k < KMAX; ++k) cnt += bcount(uu[k] == thr && id[k] < cand);
            if (cnt < quota) I = cand; }
        ilim = I;
    }
    int nsel = 0;
#pragma unroll
    for (int k = 0; k < KMAX; ++k) { const bool sel = (uu[k] > thr) || (uu[k] == thr && id[k] <= ilim);
        const unsigned long long sm = __ballot(sel); const int pos = nsel + lane_rank(sm);
        if (sel && pos < 256) lst[pos] = (unsigned short)id[k];
        nsel += __popcll(sm); }
}
__device__ __forceinline__ void dsa2_unit(int b, int qg, const bf16* IQ, const bf16* IK, const float* IW, const bf16* DQ, const bf16* DK, const bf16* DV, bf16* OB, LAS unsigned char* lds, int wave, int lane) {
    LAS unsigned* sc = (LAS unsigned*)lds;
    LAS unsigned short* LST = (LAS unsigned short*)(lds + D2_LST);
    LAS int* CNT = (LAS int*)(lds + D2_CNT);
    LAS unsigned short* CL = (LAS unsigned short*)(lds + D2_CL);
    const int q0 = 4 * qg, r32 = lane & 31, hi = lane >> 5; const size_t rowbase = (size_t)b * SEQ;
    const int ntile = (q0 + 3) / 32 + 1, npad = ntile * 32;
#ifndef REP_A
#define REP_A 1
#define REP_B1 1
#define REP_B2 1
#define REP_C 1
#endif
    for (int repa = 0; repa < REP_A; ++repa)
    {
        const int qi = 2 * ((r32 >> 2) & 1) + (r32 >> 4), hd = 4 * ((r32 >> 3) & 1) + (r32 & 3);
        bf16x8 aq[4];
#pragma unroll
        for (int ks = 0; ks < 4; ++ks) aq[ks] = *(const bf16x8*)(IQ + (rowbase + q0 + qi) * 512 + hd * 64 + ks * 16 + hi * 8);
        const float* w0p = IW + (rowbase + q0 + 2 * hi) * 8;
        const f32x4 w0a = *(const f32x4*)(w0p), w0b = *(const f32x4*)(w0p + 4), w1a = *(const f32x4*)(w0p + 8), w1b = *(const f32x4*)(w0p + 12);
        for (int t = wave; t < ntile; t += 32) {
            bf16x8 bk[4][4];
#pragma unroll
            for (int u = 0; u < 4; ++u) { const int tt = t + 8 * u; const bf16* kr = IK + (rowbase + 32 * (tt < ntile ? tt : t)) * 64 + lane * 8;
#pragma unroll
                for (int ks = 0; ks < 4; ++ks) bk[u][ks] = *(const bf16x8*)(kr + ks * 512); }
#pragma unroll
            for (int u = 0; u < 4; ++u) { const int tt = t + 8 * u;
                if (tt < ntile) {
                    const int key = 32 * tt + r32;
                    f32x16 a;
#pragma unroll
                    for (int r = 0; r < 16; ++r) a[r] = 0.f;
#pragma unroll
                    for (int ks = 0; ks < 4; ++ks) a = __builtin_amdgcn_mfma_f32_32x32x16_bf16(aq[ks], bk[u][ks], a, 0, 0, 0);
                    float s0 = 0.f, s1 = 0.f;
#pragma unroll
                    for (int j = 0; j < 4; ++j) { s0 += w0a[j] * fmaxf(a[j], 0.f); s1 += w1a[j] * fmaxf(a[8 + j], 0.f); }
#pragma unroll
                    for (int j = 0; j < 4; ++j) { s0 += w0b[j] * fmaxf(a[4 + j], 0.f); s1 += w1b[j] * fmaxf(a[12 + j], 0.f); }
                    sc[(2 * hi) * 8192 + key] = (key <= q0 + 2 * hi) ? sortable_u32(s0) : 0u;
                    sc[(2 * hi + 1) * 8192 + key] = (key <= q0 + 2 * hi + 1) ? sortable_u32(s1) : 0u;
                } }
        }
    }
    __syncthreads();
    const int qi = wave & 3, hf = wave >> 2, q = q0 + qi, n = q + 1;
    const LAS unsigned* my = sc + qi * 8192;
    for (int repb = 0; repb < REP_B1; ++repb)
    {
        int c = 0; bool ovf = false;
        if (n > 256) {
            unsigned pivot = 1u;
            if (n > 640) {
                unsigned s[8];
#pragma unroll
                for (int k = 0; k < 8; ++k) s[k] = my[(int)(((unsigned)(lane * 8 + k) * (unsigned)n) >> 9)];
                const int r = (256 * 512 * 7 / 4) / n + 8;
                unsigned t16 = 0u;
                for (int bit = 15; bit >= 0; --bit) { const unsigned cand = (t16 | (1u << bit)) << 16; int cnt = 0;
#pragma unroll
                    for (int k = 0; k < 8; ++k) cnt += bcount(s[k] >= cand);
                    if (cnt >= r) t16 |= (1u << bit); }
                pivot = t16 << 16; if (pivot == 0u) pivot = 1u;
            }
            const int half = ((npad + 511) >> 9) << 8; const int lo = hf * half; const int hiend = (lo + half < npad) ? lo + half : npad;
            LAS unsigned short* cl = CL + wave * 1024;
            for (int i0 = lo; i0 < hiend; i0 += 256) { const int idx = i0 + 4 * lane; v4u v = (v4u){0u, 0u, 0u, 0u}; if (idx < hiend) v = *(const LAS v4u*)(my + idx);
#pragma unroll
                for (int e = 0; e < 4; ++e) { const bool f = v[e] >= pivot; const unsigned long long m = __ballot(f); const int pos = c + lane_rank(m);
                    if (f) { if (pos < 1024) cl[pos] = (unsigned short)(idx + e); }
                    c += __popcll(m); } }
            if (c > 1024) ovf = true;
        }
        if (lane == 0) CNT[wave] = ovf ? -1 : c;
    }
    __syncthreads();
    for (int repb2 = 0; repb2 < REP_B2; ++repb2)
    if (wave < 4) {
        LAS unsigned short* lst = LST + wave * 256; int nsel;
        if (n <= 256) { for (int i = lane; i < n; i += 64) lst[i] = (unsigned short)i; nsel = n; }
        else {
            const int c0 = CNT[wave], c1 = CNT[wave + 4]; const int c = c0 + c1;
            if (c0 < 0 || c1 < 0 || c < 256 || c > 1024) select_full(my, npad, lst, lane);
            else {
                unsigned uu[16], id[16];
#pragma unroll
                for (int k = 0; k < 16; ++k) { const int j = k * 64 + lane; unsigned ix = 0u, u = 0u;
                    if (j < c) { ix = (j < c0) ? (unsigned)CL[wave * 1024 + j] : (unsigned)CL[(wave + 4) * 1024 + (j - c0)]; u = my[ix]; }
                    uu[k] = u; id[k] = ix; }
                if (c <= 512) select_cands<8>(uu, id, lst, lane); else select_cands<16>(uu, id, lst, lane);
            }
            nsel = 256;
        }
        if (lane == 0) CNT[8 + wave] = nsel;
    }
    __syncthreads();
    for (int repc = 0; repc < REP_C; ++repc)
    {
        const int nsel = CNT[8 + qi]; const int j0 = 128 * hf; int cntk = nsel - j0; cntk = cntk < 0 ? 0 : (cntk > 128 ? 128 : cntk);
        const LAS unsigned short* lst = LST + qi * 256;
        LAS unsigned char* tile = lds + wave * 16384;
        LAS float* tf = (LAS float*)tile;
        const int l15 = lane & 15, kq = lane >> 4;
        if (cntk == 0) {
#pragma unroll
            for (int i = 0; i < 8; ++i) tf[i * 64 + lane] = 0.f;
            if (lane < 8) { tf[512 + lane] = -INFINITY; tf[520 + lane] = 0.f; }
        } else {
#pragma unroll
            for (int it = 0; it < 16; ++it) { const int r = 8 * it + (lane >> 3), ch = lane & 7; int j = j0 + r; j = j < nsel ? j : nsel - 1;
                const int idxv = (int)lst[j]; const v4u v = *(const v4u*)(DV + (rowbase + idxv) * 64 + 8 * ch);
                *(LAS v4u*)(tile + r * 128 + ch * 16) = v; }
            bf16x8 qf[2];
#pragma unroll
            for (int ks = 0; ks < 2; ++ks) { v4u z = (v4u){0u, 0u, 0u, 0u}; if (l15 < 8) z = *(const v4u*)(DQ + (rowbase + q) * 512 + l15 * 64 + 32 * ks + 8 * kq); qf[ks] = __builtin_bit_cast(bf16x8, z); }
            f32x4d acc[8];
#pragma unroll
            for (int g = 0; g < 8; ++g) { int j = j0 + 16 * g + l15; j = j < nsel ? j : nsel - 1; const int idxk = (int)lst[j];
                const bf16* kp = DK + (rowbase + idxk) * 64 + 8 * kq;
                const bf16x8 k0 = *(const bf16x8*)(kp), k1 = *(const bf16x8*)(kp + 32);
                f32x4d a = (f32x4d){0.f, 0.f, 0.f, 0.f};
                a = __builtin_amdgcn_mfma_f32_16x16x32_bf16(k0, qf[0], a, 0, 0, 0); a = __builtin_amdgcn_mfma_f32_16x16x32_bf16(k1, qf[1], a, 0, 0, 0); acc[g] = a; }
            float mx = -INFINITY;
#pragma unroll
            for (int g = 0; g < 8; ++g)
#pragma unroll
                for (int e = 0; e < 4; ++e) { if (16 * g + 4 * kq + e >= cntk) acc[g][e] = -INFINITY; mx = fmaxf(mx, acc[g][e]); }
            mx = fmaxf(mx, __shfl_xor(mx, 16)); mx = fmaxf(mx, __shfl_xor(mx, 32));
            float ls = 0.f;
#pragma unroll
            for (int g = 0; g < 8; ++g)
#pragma unroll
                for (int e = 0; e < 4; ++e) { acc[g][e] = __builtin_amdgcn_exp2f(acc[g][e] - mx); ls += acc[g][e]; }
            ls += __shfl_xor(ls, 16); ls += __shfl_xor(ls, 32);
            bf16x8 pa[4];
#pragma unroll
            for (int t = 0; t < 4; ++t) { v4u w; w.x = cvtpk(acc[2 * t][0], acc[2 * t][1]); w.y = cvtpk(acc[2 * t][2], acc[2 * t][3]); w.z = cvtpk(acc[2 * t + 1][0], acc[2 * t + 1][1]); w.w = cvtpk(acc[2 * t + 1][2], acc[2 * t + 1][3]); pa[t] = __builtin_bit_cast(bf16x8, w); }
            f32x4d o[4];
            const int q_ = l15 >> 2, p_ = lane & 3;
#pragma unroll
            for (int cb = 0; cb < 4; ++cb) { f32x4d oc = (f32x4d){0.f, 0.f, 0.f, 0.f};
#pragma unroll
                for (int t = 0; t < 4; ++t) {
                    const LAS unsigned char* a1 = tile + (32 * t + 4 * kq + q_) * 128 + (16 * cb + 4 * p_) * 2;
                    const v4i16_t lo4 = __builtin_amdgcn_ds_read_tr16_b64_v4i16((LAS v4i16_t*)a1), hi4 = __builtin_amdgcn_ds_read_tr16_b64_v4i16((LAS v4i16_t*)(a1 + 16 * 128));
                    const bf16x8 vf = (bf16x8){lo4[0], lo4[1], lo4[2], lo4[3], hi4[0], hi4[1], hi4[2], hi4[3]};
                    oc = __builtin_amdgcn_mfma_f32_16x16x32_bf16(pa[t], vf, oc, 0, 0, 0); }
                o[cb] = oc; }
            if (kq < 2) {
#pragma unroll
                for (int cb = 0; cb < 4; ++cb)
#pragma unroll
                    for (int e = 0; e < 4; ++e) tf[(4 * kq + e) * 64 + 16 * cb + l15] = o[cb][e];
            }
            if (lane < 8) { tf[512 + lane] = mx; tf[520 + lane] = ls; }
        }
    }
    __syncthreads();
    if (wave < 4) {
        const LAS float* ta = (const LAS float*)(lds + wave * 16384); const LAS float* tb = (const LAS float*)(lds + (wave + 4) * 16384);
        const int h = lane >> 3, d0 = (lane & 7) * 8;
        const float ma = ta[512 + h], mb = tb[512 + h], la = ta[520 + h], lb = tb[520 + h];
        const float m = fmaxf(ma, mb), fa = __builtin_amdgcn_exp2f(ma - m), fb = __builtin_amdgcn_exp2f(mb - m);
        const float inv = 1.0f / (la * fa + lb * fb);
        const f32x4 a0 = *(const LAS f32x4*)(ta + h * 64 + d0), a1 = *(const LAS f32x4*)(ta + h * 64 + d0 + 4), b0 = *(const LAS f32x4*)(tb + h * 64 + d0), b1 = *(const LAS f32x4*)(tb + h * 64 + d0 + 4);
        const f32x4 r0 = (a0 * fa + b0 * fb) * inv, r1 = (a1 * fa + b1 * fb) * inv;
        v4u w; w.x = cvtpk(r0[0], r0[1]); w.y = cvtpk(r0[2], r0[3]); w.z = cvtpk(r1[0], r1[1]); w.w = cvtpk(r1[2], r1[3]);
        *(v4u*)(OB + (rowbase + q) * 512 + h * 64 + d0) = w;
    }
    __syncthreads();
}
constexpr int D3_RING = RING_BYTES + 1024;
constexpr int D3_LST = D3_RING + 16384;
constexpr int D3_CNT = D3_LST + 8192;
constexpr int D3_QW = D3_CNT + 512;
typedef unsigned long long u64d;
template <int KMAX> __device__ __forceinline__ void select_cands3(const unsigned (&uu)[16], const unsigned (&id)[16], LAS unsigned short* lst, int lane) { select_cands<KMAX>(uu, id, lst, lane); }
__device__ __forceinline__ void dsa3_unit(int b, int g16, const bf16* IQ, const bf16* IK, const float* IW, const bf16* DQ, const bf16* DK, const bf16* DV, bf16* OB, LAS unsigned char* lds, int wave, int lane_in) {
    int lane = lane_in; asm volatile("" : "+v"(lane));
    LAS u64d* LISTS = (LAS u64d*)lds;
    LAS unsigned short* LST = (LAS unsigned short*)(lds + D3_LST);
    LAS int* CNT = (LAS int*)(lds + D3_CNT);
    const int tid = wave * 64 + lane, r32 = lane & 31, hi = lane >> 5; const size_t rowbase = (size_t)b * SEQ;
    const int q0 = 16 * g16, ntile = (q0 + 15) / 32 + 1, nstep = (ntile + 1) >> 1;
    const int qgrp = wave & 3, par = wave >> 2;
    const int qA = q0 + 4 * qgrp + 2 * hi, qB = qA + 1;
    const int qi = 2 * ((r32 >> 2) & 1) + (r32 >> 4), hd = 4 * ((r32 >> 3) & 1) + (r32 & 3);
    bf16x8 aq[4];
#pragma unroll
    for (int ks = 0; ks < 4; ++ks) aq[ks] = *(const bf16x8*)(IQ + (rowbase + q0 + 4 * qgrp + qi) * 512 + hd * 64 + ks * 16 + hi * 8);
    const float* w0p = IW + (rowbase + qA) * 8;
    const f32x4 w0a = *(const f32x4*)(w0p), w0b = *(const f32x4*)(w0p + 4), w1a = *(const f32x4*)(w0p + 8), w1b = *(const f32x4*)(w0p + 12);
    f32x4 l0a, l0b, l1a, l1b;
#pragma unroll
    for (int j = 0; j < 4; ++j) { l0a[j] = w0a[j] >= 0.f ? INFINITY : -INFINITY; l0b[j] = w0b[j] >= 0.f ? INFINITY : -INFINITY; l1a[j] = w1a[j] >= 0.f ? INFINITY : -INFINITY; l1b[j] = w1b[j] >= 0.f ? INFINITY : -INFINITY; }
#define D3_SCORE(BK, S0, S1) do { f32x16 a_; _Pragma("unroll") for (int r = 0; r < 16; ++r) a_[r] = 0.f; \
        _Pragma("unroll") for (int ks = 0; ks < 4; ++ks) a_ = __builtin_amdgcn_mfma_f32_32x32x16_bf16(aq[ks], BK[ks], a_, 0, 0, 0); \
        S0 = 0.f; S1 = 0.f; \
        _Pragma("unroll") for (int j = 0; j < 4; ++j) { S0 += __builtin_amdgcn_fmed3f(w0a[j] * a_[j], 0.f, l0a[j]); S1 += __builtin_amdgcn_fmed3f(w1a[j] * a_[8 + j], 0.f, l1a[j]); } \
        _Pragma("unroll") for (int j = 0; j < 4; ++j) { S0 += __builtin_amdgcn_fmed3f(w0b[j] * a_[4 + j], 0.f, l0b[j]); S1 += __builtin_amdgcn_fmed3f(w1b[j] * a_[12 + j], 0.f, l1b[j]); } } while (0)
#ifndef REP_S
#define REP_S 1
#define REP_M 1
#define REP_B 1
#define REP_CD 1
#endif
    unsigned pivA = 1u, pivB = 1u;
    if (ntile <= 16 && tid < 16) CNT[64 + tid] = 0;
    for (int reps = 0; reps < REP_S; ++reps)
    if (ntile > 16) {
#pragma unroll
        for (int k = 0; k < 4; ++k) { const int c = tid + 512 * k; const int ts = ((c >> 8) * ntile) >> 3;
            *(LAS v4u*)(lds + c * 16) = *(const v4u*)(IK + (rowbase + 32 * ts) * 64 + (c & 255) * 8); }
        __syncthreads();
        unsigned uA[8], uB[8];
#pragma unroll
        for (int i = 0; i < 8; ++i) { bf16x8 bk[4];
#pragma unroll
            for (int ks = 0; ks < 4; ++ks) bk[ks] = *(const LAS bf16x8*)(lds + i * 4096 + ks * 1024 + lane * 16);
            float s0, s1; D3_SCORE(bk, s0, s1); uA[i] = sortable_u32(s0); uB[i] = sortable_u32(s1); asm volatile("" ::: "memory"); }
        const int qs = q0 + 4 * qgrp + par;
        const int r0 = (256 * 256 * 7 / 4) / (qs + 1) + 6, r1 = (256 * 256 * 7 / 4) / (qs + 3) + 6;
        unsigned us[8];
#pragma unroll
        for (int i = 0; i < 8; ++i) us[i] = par ? uB[i] : uA[i];
        unsigned t0 = 0u, t1 = 0u;
        for (int bit = 15; bit >= 0; --bit) {
            const unsigned c = ((hi ? t1 : t0) | (1u << bit)) << 16; int n0 = 0, n1 = 0;
#pragma unroll
            for (int i = 0; i < 8; ++i) { const unsigned long long m = __builtin_amdgcn_ballot_w64(us[i] >= c); n0 += __popc((unsigned)m); n1 += __popc((unsigned)(m >> 32)); }
            if (n0 >= r0) t0 |= (1u << bit);
            if (n1 >= r1) t1 |= (1u << bit);
        }
        LAS unsigned* PV = (LAS unsigned*)(CNT + 64);
        if (lane == 0) { PV[4 * qgrp + par] = t0; PV[4 * qgrp + 2 + par] = t1; }
        __syncthreads();
        const unsigned tA = PV[4 * qgrp + 2 * hi], tB = PV[4 * qgrp + 2 * hi + 1];
        pivA = tA << 16; pivB = tB << 16; if (pivA == 0u) pivA = 1u; if (pivB == 0u) pivB = 1u;
        __syncthreads();
    }
    for (int repm = 0; repm < REP_M; ++repm)
    {
        const bf16* src0 = IK + rowbase * 64 + (size_t)(tid & 255) * 8;
#define D3_LOAD(k_) (*(const v4u*)(src0 + (size_t)32 * ((2 * (k_) + (tid >> 8)) < ntile ? (2 * (k_) + (tid >> 8)) : ntile - 1) * 64))
        v4u st0 = (v4u){0u, 0u, 0u, 0u}, st1 = st0, st2 = st0, st3 = st0;
        st0 = D3_LOAD(0); st1 = D3_LOAD(1); st2 = D3_LOAD(2); st3 = D3_LOAD(3);
        *(LAS v4u*)(lds + D3_RING + tid * 16) = st0;
        __syncthreads();
        int cntA = 0, cntB = 0;
        LAS u64d* lA = LISTS + ((4 * qgrp + 2 * hi) * 2 + par) * 512; LAS u64d* lB = lA + 1024;
        LAS u64d* dmy = (LAS u64d*)(lds + D3_QW + 64) + lane;
        f32x16 acc;
#pragma unroll
        for (int r = 0; r < 16; ++r) acc[r] = 0.f;
#define D3_SUMS(S0, S1) do { S0 = 0.f; S1 = 0.f; \
            _Pragma("unroll") for (int j = 0; j < 4; ++j) { S0 += __builtin_amdgcn_fmed3f(w0a[j] * acc[j], 0.f, l0a[j]); S1 += __builtin_amdgcn_fmed3f(w1a[j] * acc[8 + j], 0.f, l1a[j]); } \
            _Pragma("unroll") for (int j = 0; j < 4; ++j) { S0 += __builtin_amdgcn_fmed3f(w0b[j] * acc[4 + j], 0.f, l0b[j]); S1 += __builtin_amdgcn_fmed3f(w1b[j] * acc[12 + j], 0.f, l1b[j]); } } while (0)
#define D3_FILTER(TP, S0, S1) do { const int key = 32 * (TP) + r32; const unsigned u0 = sortable_u32(S0), u1 = sortable_u32(S1);     \
                const bool psa = (key <= qA) && (u0 >= pivA), psb = (key <= qB) && (u1 >= pivB); \
                const unsigned long long ma = __ballot(psa), mb = __ballot(psb); const unsigned mla = (unsigned)ma, mha = (unsigned)(ma >> 32), mlb = (unsigned)mb, mhb = (unsigned)(mb >> 32); \
                const int posa = cntA + (int)__builtin_amdgcn_mbcnt_hi(mha, __builtin_amdgcn_mbcnt_lo(mla, 0u)) - (hi ? __popc(mla) : 0); \
                const int posb = cntB + (int)__builtin_amdgcn_mbcnt_hi(mhb, __builtin_amdgcn_mbcnt_lo(mlb, 0u)) - (hi ? __popc(mlb) : 0); \
                LAS u64d* wa_ = (psa && posa < 512) ? lA + posa : dmy; LAS u64d* wb_ = (psb && posb < 512) ? lB + posb : dmy; \
                *wa_ = ((u64d)(unsigned)key << 32) | u0; *wb_ = ((u64d)(unsigned)key << 32) | u1; \
                cntA += hi ? __popc(mha) : __popc(mla); cntB += hi ? __popc(mhb) : __popc(mlb); } while (0)
#define D3_STEP(k_, STNEXT, STFREE) do { \
            STFREE = D3_LOAD((k_) + 4); \
            const int tp_ = 2 * (k_) - 2 + par; \
            const LAS unsigned char* sb = lds + D3_RING + ((k_) & 1) * 8192 + par * 4096; bf16x8 bk[4]; \
            _Pragma("unroll") for (int ks = 0; ks < 4; ++ks) bk[ks] = *(const LAS bf16x8*)(sb + ks * 1024 + lane * 16); \
            __builtin_amdgcn_sched_barrier(0); \
            float s0, s1; D3_SUMS(s0, s1); asm volatile("" : "+v"(s0), "+v"(s1));     \
            __builtin_amdgcn_sched_barrier(0); \
            _Pragma("unroll") for (int r = 0; r < 16; ++r) acc[r] = 0.f; \
            _Pragma("unroll") for (int ks = 0; ks < 4; ++ks) acc = __builtin_amdgcn_mfma_f32_32x32x16_bf16(aq[ks], bk[ks], acc, 0, 0, 0); \
            __builtin_amdgcn_sched_barrier(0); \
            if (tp_ >= 0 && tp_ < ntile) D3_FILTER(tp_, s0, s1); \
            *(LAS v4u*)(lds + D3_RING + (((k_) + 1) & 1) * 8192 + tid * 16) = STNEXT; \
            asm volatile("s_waitcnt lgkmcnt(0)" ::: "memory"); __builtin_amdgcn_s_barrier(); asm volatile("" ::: "memory"); } while (0)
        int kend = 0;
        for (int k = 0; k < nstep; k += 4) {
            D3_STEP(k, st1, st0); D3_STEP(k + 1, st2, st1); D3_STEP(k + 2, st3, st2); D3_STEP(k + 3, st0, st3); kend = k + 4;
        }
        {   const int tp_ = 2 * kend - 2 + par; if (tp_ < ntile) { float s0, s1; D3_SUMS(s0, s1); D3_FILTER(tp_, s0, s1); } }
#undef D3_SUMS
#undef D3_FILTER
#undef D3_STEP
#undef D3_LOAD
        if (r32 == 0) { CNT[(4 * qgrp + 2 * hi) * 2 + par] = cntA; CNT[(4 * qgrp + 2 * hi + 1) * 2 + par] = cntB; }
        if (tid < 4) CNT[48 + tid] = 0;
    }
#undef D3_SCORE
    __syncthreads();
#if defined(DBG_D3_STAGE) && DBG_D3_STAGE == 1
    for (int grp = 0; grp < 4; ++grp) dsa2_unit(b, 4 * g16 + grp, IQ, IK, IW, DQ, DK, DV, OB, lds, wave, lane);
    return;
#endif
#pragma unroll 1
    for (int rr = 0; rr < 2 * REP_B; ++rr) {
        const int qx = wave + 8 * (rr & 1), q = q0 + qx, n = q + 1; LAS unsigned short* lst = LST + qx * 256; int nsel;
        if (n <= 256) { for (int i = lane; i < n; i += 64) lst[i] = (unsigned short)i; nsel = n; }
        else {
            const int c0 = CNT[2 * qx], c1 = CNT[2 * qx + 1]; const int c = c0 + c1;
#ifdef DBG_D3_ALLFAIL
            if (true) { if (lane == 0) CNT[48 + (qx >> 2)] = 1; nsel = 0; }
#else
            if (c0 > 512 || c1 > 512 || c < 256) { if (lane == 0) CNT[48 + (qx >> 2)] = 1; nsel = 0; }
#endif
            else {
                unsigned uu[16], id[16]; const LAS u64d* L0 = LISTS + (qx * 2) * 512; const LAS u64d* L1 = L0 + 512;
#pragma unroll
                for (int k = 0; k < 16; ++k) { const int j = k * 64 + lane, jj = j < c ? j : c - 1;
                    const u64d e = *((jj < c0) ? (L0 + jj) : (L1 + (jj - c0))); uu[k] = j < c ? (unsigned)e : 0u; id[k] = (unsigned)(e >> 32); }
                const unsigned lb = (unsigned)CNT[64 + qx] << 16;
                if (c <= 512) select_cands<8>(uu, id, lst, lane, lb); else if (c <= 640) select_cands<10>(uu, id, lst, lane, lb); else if (c <= 768) select_cands<12>(uu, id, lst, lane, lb); else select_cands<16>(uu, id, lst, lane, lb);
                nsel = 256;
            }
        }
        if (lane == 0) CNT[32 + qx] = nsel;
    }
    __syncthreads();
#pragma unroll 1
    for (int rr_ = 0; rr_ < 2 * REP_CD; ++rr_) { const int rr = rr_ & 1;
        const int qx = wave + 8 * rr, q = q0 + qx; const int nsel = CNT[32 + qx];
        const LAS unsigned short* lst = LST + qx * 256;
        LAS unsigned char* tile = lds + wave * 16384; LAS float* tf = (LAS float*)tile;
        const int l15 = lane & 15, kq = lane >> 4, q_ = l15 >> 2, p_ = lane & 3;
        bf16x8 qf[2];
#pragma unroll
        for (int ks = 0; ks < 2; ++ks) { v4u z = (v4u){0u, 0u, 0u, 0u}; if (l15 < 8) z = *(const v4u*)(DQ + (rowbase + q) * 512 + l15 * 64 + 32 * ks + 8 * kq); qf[ks] = __builtin_bit_cast(bf16x8, z); }
        float mrun = -INFINITY, lrun = 0.f; f32x4d orun[4];
#pragma unroll
        for (int cb = 0; cb < 4; ++cb) orun[cb] = (f32x4d){0.f, 0.f, 0.f, 0.f};
#pragma unroll 1
        for (int hf = 0; hf < 2; ++hf) {
            const int j0 = 128 * hf; int cntk = nsel - j0; cntk = cntk > 128 ? 128 : cntk;
            if (cntk <= 0) break;
            int iv[16], ik[8];
#pragma unroll
            for (int it = 0; it < 16; ++it) { int j = j0 + 8 * it + (lane >> 3); j = j < nsel ? j : nsel - 1; iv[it] = (int)lst[j]; }
#pragma unroll
            for (int g = 0; g < 8; ++g) { int j = j0 + 16 * g + l15; j = j < nsel ? j : nsel - 1; ik[g] = (int)lst[j]; }
            asm volatile("s_waitcnt lgkmcnt(0)" ::: "memory");
#pragma unroll
            for (int it = 0; it < 16; ++it)
                __builtin_amdgcn_global_load_lds((const unsigned*)(DV + (rowbase + iv[it]) * 64 + 8 * (lane & 7)), (LAS unsigned*)(tile + it * 1024), 16, 0, 0);
            bf16x8 kk0[8], kk1[8];
#pragma unroll
            for (int g = 0; g < 8; ++g) { const bf16* kp = DK + (rowbase + ik[g]) * 64 + 8 * kq; kk0[g] = *(const bf16x8*)(kp); kk1[g] = *(const bf16x8*)(kp + 32); }
            asm volatile("" ::: "memory");
            f32x4d acc[8];
#pragma unroll
            for (int g = 0; g < 8; ++g) { f32x4d a = (f32x4d){0.f, 0.f, 0.f, 0.f};
                a = __builtin_amdgcn_mfma_f32_16x16x32_bf16(kk0[g], qf[0], a, 0, 0, 0); a = __builtin_amdgcn_mfma_f32_16x16x32_bf16(kk1[g], qf[1], a, 0, 0, 0); acc[g] = a; }
            float mx = -INFINITY;
#pragma unroll
            for (int g = 0; g < 8; ++g)
#pragma unroll
                for (int e = 0; e < 4; ++e) { if (16 * g + 4 * kq + e >= cntk) acc[g][e] = -INFINITY; mx = fmaxf(mx, acc[g][e]); }
            mx = fmaxf(mx, __shfl_xor(mx, 16)); mx = fmaxf(mx, __shfl_xor(mx, 32));
            const float mnew = fmaxf(mrun, mx), fold = __builtin_amdgcn_exp2f(mrun - mnew);
            float ls = 0.f;
#pragma unroll
            for (int g = 0; g < 8; ++g)
#pragma unroll
                for (int e = 0; e < 4; ++e) { acc[g][e] = __builtin_amdgcn_exp2f(acc[g][e] - mnew); ls += acc[g][e]; }
            ls += __shfl_xor(ls, 16); ls += __shfl_xor(ls, 32);
            lrun = lrun * fold + ls; mrun = mnew;
            float fo[4];
#pragma unroll
            for (int e = 0; e < 4; ++e) fo[e] = __shfl(fold, 4 * kq + e);
            asm volatile("s_waitcnt vmcnt(0)" ::: "memory");
            bf16x8 pa[4];
#pragma unroll
            for (int t = 0; t < 4; ++t) { v4u w; w.x = cvtpk(acc[2 * t][0], acc[2 * t][1]); w.y = cvtpk(acc[2 * t][2], acc[2 * t][3]); w.z = cvtpk(acc[2 * t + 1][0], acc[2 * t + 1][1]); w.w = cvtpk(acc[2 * t + 1][2], acc[2 * t + 1][3]); pa[t] = __builtin_bit_cast(bf16x8, w); }
#pragma unroll
            for (int cb = 0; cb < 4; ++cb) { f32x4d oc = orun[cb];
#pragma unroll
                for (int e = 0; e < 4; ++e) oc[e] *= fo[e];
#pragma unroll
                for (int t = 0; t < 4; ++t) {
                    const LAS unsigned char* a1 = tile + (32 * t + 4 * kq + q_) * 128 + (16 * cb + 4 * p_) * 2;
                    const v4i16_t lo4 = __builtin_amdgcn_ds_read_tr16_b64_v4i16((LAS v4i16_t*)a1), hi4 = __builtin_amdgcn_ds_read_tr16_b64_v4i16((LAS v4i16_t*)(a1 + 16 * 128));
                    const bf16x8 vf = (bf16x8){lo4[0], lo4[1], lo4[2], lo4[3], hi4[0], hi4[1], hi4[2], hi4[3]};
                    oc = __builtin_amdgcn_mfma_f32_16x16x32_bf16(pa[t], vf, oc, 0, 0, 0); }
                orun[cb] = oc; }
        }
        float li[4];
#pragma unroll
        for (int e = 0; e < 4; ++e) li[e] = 1.0f / __shfl(lrun, 4 * kq + e);
        if (kq < 2) {
#pragma unroll
            for (int cb = 0; cb < 4; ++cb)
#pragma unroll
                for (int e = 0; e < 4; ++e) tf[(4 * kq + e) * 64 + 16 * cb + l15] = orun[cb][e] * li[e];
        }
        { const int h = lane >> 3, d0 = (lane & 7) * 8;
          const f32x4 r0 = *(const LAS f32x4*)(tf + h * 64 + d0), r1 = *(const LAS f32x4*)(tf + h * 64 + d0 + 4);
          v4u w; w.x = cvtpk(r0[0], r0[1]); w.y = cvtpk(r0[2], r0[3]); w.z = cvtpk(r1[0], r1[1]); w.w = cvtpk(r1[2], r1[3]);
          *(v4u*)(OB + (rowbase + q) * 512 + h * 64 + d0) = w; }
    }
    __syncthreads();
    const int f0 = CNT[48], f1 = CNT[49], f2 = CNT[50], f3 = CNT[51];
    __syncthreads();
    const int fm = (f0 ? 1 : 0) | (f1 ? 2 : 0) | (f2 ? 4 : 0) | (f3 ? 8 : 0);
#pragma unroll 1
    for (int grp = 0; grp < 4; ++grp) if ((fm >> grp) & 1) dsa2_unit(b, 4 * g16 + grp, IQ, IK, IW, DQ, DK, DV, OB, lds, wave, lane);
}
__device__ __forceinline__ void fox_unit2(int bh, int qb, const bf16* FQ, const bf16* FK, const bf16* FV, const float* CUM, const int* T0, bf16* OA, LAS unsigned char* lds, int wave, int lane) {
    const int b = bh >> 3, h = bh & 7, r32 = lane & 31, hi = lane >> 5; const size_t rowbase = (size_t)b * SEQ; const int q0 = qb * 256 + wave * 32;
    const bf16* Qw = FQ + (rowbase + q0) * 512 + h * 64; bf16* Ow = OA + (rowbase + q0) * 512 + h * 64;
    const bf16* Kp = FK + rowbase * 512 + h * 64; const bf16* Vp = FV + rowbase * 512 + h * 64; const float* cb = CUM + (size_t)bh * SEQ;
    LAS unsigned char* wl = lds + wave * 16384;
    LAS float* bl = (LAS float*)(lds + RING_BYTES + 8192 + wave * 256);
    bf16x8 qr[4];
#pragma unroll
    for (int ks = 0; ks < 4; ++ks) qr[ks] = *(const bf16x8*)(Qw + (size_t)r32 * 512 + ks * 16 + hi * 8);
    const int tstart = T0[bh * 256 + q0 / 32], ntiles = q0 / 32 + 1, qlocal = q0 + r32;
    f32x16 o[2];
#pragma unroll
    for (int d0 = 0; d0 < 2; ++d0)
#pragma unroll
        for (int r = 0; r < 16; ++r) o[d0][r] = 0.f;
    float m = -1e30f, l = 0.f;
    const int lrow = lane >> 3, lch = lane & 7;
#define FOX_LOAD(KR, VR, BR, tt) do { _Pragma("unroll") for (int it = 0; it < 4; ++it) { const size_t ro = (size_t)(32 * (tt) + 8 * it + lrow) * 512 + lch * 8; KR[it] = *(const v4u*)(Kp + ro); VR[it] = *(const v4u*)(Vp + ro); } BR = cb[32 * (tt) + r32]; } while (0)
#define FOX_STORE(KR, VR, BR, bf) do { _Pragma("unroll") for (int it = 0; it < 4; ++it) { const int row = 8 * it + lrow; *(LAS v4u*)(wl + (bf) * 4096 + row * 128 + ((lch ^ (row & 7)) * 16)) = KR[it]; *(LAS v4u*)(wl + 8192 + (bf) * 4096 + row * 128 + lch * 16) = VR[it]; } if (lane < 32) bl[(bf) * 32 + lane] = -L2E * BR; } while (0)
    v4u krA[4], vrA[4], krB[4], vrB[4]; float brA = 0.f, brB = 0.f;
    const int kq = (lane >> 4) & 1, q_ = (lane & 15) >> 2, p_ = lane & 3;
    FOX_LOAD(krA, vrA, brA, tstart);
    if (tstart + 1 < ntiles) FOX_LOAD(krB, vrB, brB, tstart + 1);
    FOX_STORE(krA, vrA, brA, 0);
    auto compute = [&](int t, int buf) {
        const LAS unsigned char* kb = wl + buf * 4096; const LAS unsigned char* vb = wl + 8192 + buf * 4096; const LAS float* bb = bl + buf * 32;
        f32x16 p;
#pragma unroll
        for (int r = 0; r < 16; ++r) p[r] = 0.f;
#pragma unroll
        for (int ks = 0; ks < 4; ++ks) { const bf16x8 kf = *(const LAS bf16x8*)(kb + r32 * 128 + (((2 * ks + hi) ^ (r32 & 7)) * 16)); p = __builtin_amdgcn_mfma_f32_32x32x16_bf16(kf, qr[ks], p, 0, 0, 0); }
#pragma unroll
        for (int g = 0; g < 4; ++g) { const f32x4 c4 = *(const LAS f32x4*)(bb + 8 * g + 4 * hi);
#pragma unroll
            for (int jj = 0; jj < 4; ++jj) p[4 * g + jj] += c4[jj]; }
        if (t == ntiles - 1) {
#pragma unroll
            for (int r = 0; r < 16; ++r) if (32 * t + crow(r, hi) > qlocal) p[r] = -INFINITY;
        }
        float mt = p[0];
#pragma unroll
        for (int r = 1; r < 16; ++r) mt = fmaxf(mt, p[r]);
        mt = fmaxf(mt, __shfl_xor(mt, 32));
        const float mn = fmaxf(m, mt); const float alpha = __builtin_amdgcn_exp2f(m - mn); m = mn;
        l *= alpha;
#pragma unroll
        for (int d0 = 0; d0 < 2; ++d0)
#pragma unroll
            for (int r = 0; r < 16; ++r) o[d0][r] *= alpha;
        float ls = 0.f;
#pragma unroll
        for (int r = 0; r < 16; ++r) { p[r] = __builtin_amdgcn_exp2f(p[r] - mn); ls += p[r]; }
        l += ls;
        bf16x8 pa[2];
#pragma unroll
        for (int s2 = 0; s2 < 2; ++s2) { v4u w; w.x = cvtpk(p[8 * s2 + 0], p[8 * s2 + 1]); w.y = cvtpk(p[8 * s2 + 2], p[8 * s2 + 3]); w.z = cvtpk(p[8 * s2 + 4], p[8 * s2 + 5]); w.w = cvtpk(p[8 * s2 + 6], p[8 * s2 + 7]); pa[s2] = __builtin_bit_cast(bf16x8, w); }
#pragma unroll
        for (int d0 = 0; d0 < 2; ++d0)
#pragma unroll
            for (int s2 = 0; s2 < 2; ++s2) {
                const LAS unsigned char* a1 = vb + (16 * s2 + 4 * hi + q_) * 128 + (32 * d0 + 16 * kq + 4 * p_) * 2;
                const v4i16_t lo4 = __builtin_amdgcn_ds_read_tr16_b64_v4i16((LAS v4i16_t*)a1), hi4 = __builtin_amdgcn_ds_read_tr16_b64_v4i16((LAS v4i16_t*)(a1 + 8 * 128));
                const bf16x8 vf = (bf16x8){lo4[0], lo4[1], lo4[2], lo4[3], hi4[0], hi4[1], hi4[2], hi4[3]};
                o[d0] = __builtin_amdgcn_mfma_f32_32x32x16_bf16(vf, pa[s2], o[d0], 0, 0, 0);
            }
    };
    for (int t = tstart; t < ntiles; t += 2) {
        if (t + 2 < ntiles) FOX_LOAD(krA, vrA, brA, t + 2);
        compute(t, 0);
        if (t + 1 < ntiles) {
            FOX_STORE(krB, vrB, brB, 1);
            if (t + 3 < ntiles) FOX_LOAD(krB, vrB, brB, t + 3);
            compute(t + 1, 1);
            if (t + 2 < ntiles) FOX_STORE(krA, vrA, brA, 0);
        }
    }
#undef FOX_LOAD
#undef FOX_STORE
    l += __shfl_xor(l, 32);
    const float inv = 1.0f / l;
    bf16* orow = Ow + (size_t)r32 * 512;
#pragma unroll
    for (int d0 = 0; d0 < 2; ++d0)
#pragma unroll
        for (int g = 0; g < 4; ++g) { u32x2 w; w.x = cvtpk(o[d0][4 * g] * inv, o[d0][4 * g + 1] * inv); w.y = cvtpk(o[d0][4 * g + 2] * inv, o[d0][4 * g + 3] * inv);
            *(u32x2*)(orow + d0 * 32 + 8 * g + 4 * hi) = w; }
}
__device__ __forceinline__ void fox_unit4(int bh, int qb, const bf16* FQ, const bf16* FK, const bf16* FV, const float* CUM, const int* T0, const float* gq, const float* gk, bf16* OA, LAS unsigned char* lds, int wave, int lane) {
    const int b = bh >> 3, h = bh & 7, r32 = lane & 31, hi = lane >> 5; const size_t rowbase = (size_t)b * SEQ; const int q0 = qb * 256 + wave * 32;
    const bf16* Qw = FQ + (rowbase + q0) * 512 + h * 64; bf16* Ow = OA + (rowbase + q0) * 512 + h * 64;
    const bf16* Kp = FK + rowbase * 512 + h * 64; const bf16* Vp = FV + rowbase * 512 + h * 64; const float* cb = CUM + (size_t)bh * SEQ;
    LAS unsigned char* wl = lds + wave * 16384;
    LAS float* bl = (LAS float*)(lds + RING_BYTES + 8192 + wave * 256);
    bf16x8 qr[4];
#pragma unroll
    for (int ks = 0; ks < 4; ++ks) qr[ks] = *(const bf16x8*)(Qw + (size_t)r32 * 512 + ks * 16 + hi * 8);
    const int tstart = T0[bh * 256 + q0 / 32], tlast = q0 / 32, nseq = tlast - tstart + 1, qlocal = q0 + r32;
    const float stopc = (8.0f * wave_max(fabsf(gq[lane])) * wave_max(fabsf(gk[lane])) + 30.0f) * L2E;
    f32x16 o[2];
#pragma unroll
    for (int d0 = 0; d0 < 2; ++d0)
#pragma unroll
        for (int r = 0; r < 16; ++r) o[d0][r] = 0.f;
    float m = -1e30f, l = 0.f;
    const int lrow = lane >> 3, lch = lane & 7;
#define FOX_LOAD(KR, VR, BR, tt) do { _Pragma("unroll") for (int it = 0; it < 4; ++it) { const size_t ro = (size_t)(32 * (tt) + 8 * it + lrow) * 512 + lch * 8; KR[it] = *(const v4u*)(Kp + ro); VR[it] = *(const v4u*)(Vp + ro); } BR = cb[32 * (tt) + r32]; } while (0)
#define FOX_STORE(KR, VR, BR, bf) do { _Pragma("unroll") for (int it = 0; it < 4; ++it) { const int row = 8 * it + lrow; *(LAS v4u*)(wl + (bf) * 4096 + row * 128 + ((lch ^ (row & 7)) * 16)) = KR[it]; *(LAS v4u*)(wl + 8192 + (bf) * 4096 + row * 128 + lch * 16) = VR[it]; } if (lane < 32) bl[(bf) * 32 + lane] = -L2E * BR; } while (0)
    v4u krA[4], vrA[4], krB[4], vrB[4]; float brA = 0.f, brB = 0.f;
    const int kq = (lane >> 4) & 1, q_ = (lane & 15) >> 2, p_ = lane & 3;
    FOX_LOAD(krA, vrA, brA, tlast);
    if (1 < nseq) FOX_LOAD(krB, vrB, brB, tlast - 1);
    FOX_STORE(krA, vrA, brA, 0);
    auto compute = [&](int t, int buf) -> bool {
        const LAS unsigned char* kb = wl + buf * 4096; const LAS unsigned char* vb = wl + 8192 + buf * 4096; const LAS float* bb = bl + buf * 32;
        if (t != tlast) { const float bmax = bb[31]; if (__all(m > bmax + stopc)) return true; }
        f32x16 p;
#pragma unroll
        for (int r = 0; r < 16; ++r) p[r] = 0.f;
#pragma unroll
        for (int ks = 0; ks < 4; ++ks) { const bf16x8 kf = *(const LAS bf16x8*)(kb + r32 * 128 + (((2 * ks + hi) ^ (r32 & 7)) * 16)); p = __builtin_amdgcn_mfma_f32_32x32x16_bf16(kf, qr[ks], p, 0, 0, 0); }
#pragma unroll
        for (int g = 0; g < 4; ++g) { const f32x4 c4 = *(const LAS f32x4*)(bb + 8 * g + 4 * hi);
#pragma unroll
            for (int jj = 0; jj < 4; ++jj) p[4 * g + jj] += c4[jj]; }
        if (t == tlast) {
#pragma unroll
            for (int r = 0; r < 16; ++r) if (32 * t + crow(r, hi) > qlocal) p[r] = -INFINITY;
        }
        float mt = p[0];
#pragma unroll
        for (int r = 1; r < 16; ++r) mt = fmaxf(mt, p[r]);
        mt = fmaxf(mt, __shfl_xor(mt, 32));
        if (__any(mt > m)) {
            const float mn = fmaxf(m, mt); const float alpha = __builtin_amdgcn_exp2f(m - mn); m = mn;
            l *= alpha;
#pragma unroll
            for (int d0 = 0; d0 < 2; ++d0)
#pragma unroll
                for (int r = 0; r < 16; ++r) o[d0][r] *= alpha;
        }
        const float mn = m;
        float ls = 0.f;
#pragma unroll
        for (int r = 0; r < 16; ++r) { p[r] = __builtin_amdgcn_exp2f(p[r] - mn); ls += p[r]; }
        l += ls;
        bf16x8 pa[2];
#pragma unroll
        for (int s2 = 0; s2 < 2; ++s2) { v4u w; w.x = cvtpk(p[8 * s2 + 0], p[8 * s2 + 1]); w.y = cvtpk(p[8 * s2 + 2], p[8 * s2 + 3]); w.z = cvtpk(p[8 * s2 + 4], p[8 * s2 + 5]); w.w = cvtpk(p[8 * s2 + 6], p[8 * s2 + 7]); pa[s2] = __builtin_bit_cast(bf16x8, w); }
#pragma unroll
        for (int d0 = 0; d0 < 2; ++d0)
#pragma unroll
            for (int s2 = 0; s2 < 2; ++s2) {
                const LAS unsigned char* a1 = vb + (16 * s2 + 4 * hi + q_) * 128 + (32 * d0 + 16 * kq + 4 * p_) * 2;
                const v4i16_t lo4 = __builtin_amdgcn_ds_read_tr16_b64_v4i16((LAS v4i16_t*)a1), hi4 = __builtin_amdgcn_ds_read_tr16_b64_v4i16((LAS v4i16_t*)(a1 + 8 * 128));
                const bf16x8 vf = (bf16x8){lo4[0], lo4[1], lo4[2], lo4[3], hi4[0], hi4[1], hi4[2], hi4[3]};
                o[d0] = __builtin_amdgcn_mfma_f32_32x32x16_bf16(vf, pa[s2], o[d0], 0, 0, 0);
            }
        return false;
    };
    for (int i = 0; i < nseq; i += 2) {
        if (i + 2 < nseq) FOX_LOAD(krA, vrA, brA, tlast - (i + 2));
        if (compute(tlast - i, 0)) break;
        if (i + 1 < nseq) {
            FOX_STORE(krB, vrB, brB, 1);
            if (i + 3 < nseq) FOX_LOAD(krB, vrB, brB, tlast - (i + 3));
            if (compute(tlast - (i + 1), 1)) break;
            if (i + 2 < nseq) FOX_STORE(krA, vrA, brA, 0);
        }
    }
#undef FOX_LOAD
#undef FOX_STORE
    l += __shfl_xor(l, 32);
    const float inv = 1.0f / l;
    bf16* orow = Ow + (size_t)r32 * 512;
#pragma unroll
    for (int d0 = 0; d0 < 2; ++d0)
#pragma unroll
        for (int g = 0; g < 4; ++g) { u32x2 w; w.x = cvtpk(o[d0][4 * g] * inv, o[d0][4 * g + 1] * inv); w.y = cvtpk(o[d0][4 * g + 2] * inv, o[d0][4 * g + 3] * inv);
            *(u32x2*)(orow + d0 * 32 + 8 * g + 4 * hi) = w; }
}
#ifndef DBG_BRANCH_MASK
#define DBG_BRANCH_MASK 7
#endif
#ifndef DBG_NBR
#define DBG_NBR 3
#endif
#ifndef DBG_NOGATE
#define DBG_NOGATE 0
#endif
#ifndef DBG_NOBRANCH
#define DBG_NOBRANCH 0
#endif
#ifndef DBG_GATE_W
#define DBG_GATE_W WS_WGATE
#endif
#ifndef DBG_GATE_AS_BRANCH
#define DBG_GATE_AS_BRANCH 0
#endif
#ifndef REP_FOX
#define REP_FOX 1
#endif
#ifndef REP_DSA
#define REP_DSA 1
#endif
#ifndef REP_GEMM
#define REP_GEMM 1
#endif
#ifndef DBG_SUBST
#define DBG_SUBST 0
#endif
#ifndef P7SEL
#define P7SEL 3
#endif
#ifndef PHMASK
#define PHMASK 0xFFFF
#endif
struct Args { const void* in[24]; float* out; unsigned char* ws; };
#define CONVERT_GROUP(GRP, w_, nw_) do { \
    constexpr int I_GU = 16 * 176, I_D = 44 * 32, I_IN = 16 * 104, I_GT = 16 * 96, I_BR = 8 * 32, I_SQ = 16 * 32; \
    constexpr int NIT = (GRP) == 0 ? I_GU + I_SQ : (GRP) == 1 ? I_D + I_IN + I_GT + 3 * I_BR + I_SQ : I_GU + I_D; \
    LAS float* scr_ = (LAS float*)(L + RING_OFF + wave * 16384); \
    for (int it = (w_); it < NIT; it += (nw_)) { int r = it; \
        if ((GRP) == 0) { \
            if (r < I_GU) { transpose_item<true>(0, ARG_IN(4), ARG_IN(5), 1024, DFF, ARG_IN(3), WSP(bf16, WS_WGU1), scr_, r, 176, lane); continue; } r -= I_GU; \
            transpose_item<true>(1, ARG_IN(17), nullptr, 1024, 1024, ARG_IN(8), WSP(bf16, WS_WMKV), scr_, r, 32, lane); \
        } else if ((GRP) == 1) { \
            if (r < I_D) { transpose_item<false>(1, ARG_IN(6), nullptr, DFF, 1024, nullptr, WSP(bf16, WS_WD1), scr_, r, 32, lane); continue; } r -= I_D; \
            if (r < I_IN) { transpose_item<true>(2, ARG_IN(9), nullptr, 1024, DIN, ARG_IN(7), WSP(bf16, WS_WIN), scr_, r, 104, lane); continue; } r -= I_IN; \
            if (r < I_GT) { transpose_item<true>(3, ARG_IN(9), nullptr, 1024, DIN, ARG_IN(7), WSP(bf16, WS_WGATE), scr_, r, 96, lane); continue; } r -= I_GT; \
            if (r < 3 * I_BR) { const int i = r / I_BR; transpose_item<false>(1, ARG_IN(18) + (size_t)i * 512 * 1024, nullptr, 512, 1024, nullptr, WSP(bf16, WS_WBR) + (size_t)i * 1024 * 512, scr_, r % I_BR, 32, lane); continue; } r -= 3 * I_BR; \
            transpose_item<false>(1, ARG_IN(19), nullptr, 1024, 1024, nullptr, WSP(bf16, WS_WOUT), scr_, r, 32, lane); \
        } else { \
            if (r < I_GU) { transpose_item<true>(0, ARG_IN(21), ARG_IN(22), 1024, DFF, ARG_IN(20), WSP(bf16, WS_WGU2), scr_, r, 176, lane); continue; } r -= I_GU; \
            transpose_item<false>(1, ARG_IN(23), nullptr, DFF, 1024, nullptr, WSP(bf16, WS_WD2), scr_, r, 32, lane); \
        } } } while (0)
__global__ void __launch_bounds__(NWAVES * 64, 2) fwd_mega(Args args) {
    extern __shared__ __attribute__((aligned(16))) unsigned char lds[];
    LAS unsigned char* L = (LAS unsigned char*)lds;
    volatile LAS unsigned* MISC = (volatile LAS unsigned*)(L + MISC_OFF);
    const int tid = threadIdx.x, lane = tid & 63, wave = __builtin_amdgcn_readfirstlane(tid >> 6);
    const int G = gridDim.x; const int bx = blockIdx.x; const int vcu = (G % 8 == 0) ? (bx % 8) * (G / 8) + bx / 8 : bx;
    const Args* ap = (const Args*)__builtin_amdgcn_kernarg_segment_ptr();
#define ARG_IN(k) ((const float*)ap->in[k])
#define WSP(type, off) ((type*)(ap->ws + (off)))
    gu32* ctl = (gu32*)(ap->ws + WS_CTL);
    for (int u = tid; u < (LDS_BYTES - LDSCTL_OFF) / 4; u += NWAVES * 64) ((LAS unsigned*)(L + LDSCTL_OFF))[u] = 0u;
    __syncthreads();
    XcdBarrier bar = xcd_barrier_post((unsigned*)(ctl + CW_BAR), MISC + 8);
#define GRID_BAR() xcd_barrier(bar)
    const int gw = vcu * NWAVES + wave, NGW = G * NWAVES;

#if (PHMASK >> 0) & 1
    {
        LAS float* scr = (LAS float*)(L + RING_OFF + wave * 16384);
        CONVERT_GROUP(0, gw, NGW);
        for (int m0 = gw; m0 < T + 512; m0 += 4 * NGW) {
            const float* xr[4]; bf16* orw[4]; float* ro[4]; bool ok[4];
#pragma unroll
            for (int r = 0; r < 4; ++r) { const int m = m0 + r * NGW; ok[r] = m < T + 512; const int mc = ok[r] ? m : gw;
                if (mc < T) { xr[r] = ARG_IN(0) + (size_t)mc * 1024; orw[r] = WSP(bf16, WS_HB) + (size_t)mc * 1024; ro[r] = WSP(float, WS_RSTDX) + mc; }
                else { xr[r] = ARG_IN(1) + (size_t)(mc - T) * 1024; orw[r] = WSP(bf16, WS_MEMB) + (size_t)(mc - T) * 1024; ro[r] = WSP(float, WS_RSTDM) + (mc - T); } }
            rows4_to_bf16_rstd(xr, orw, ro, ok, lane);
        }
        VM_WAIT(); __syncthreads();
        GRID_BAR();
    }
#endif
#if (PHMASK >> 1) & 1
    {
        if (bx >= G - 8) { pg8::Gemm g{WSP(bf16, WS_MEMB), WSP(bf16, WS_WMKV), 512, 1024, 1024}; pg8::StaticOrder S; S.init(512, 1024, G, bx - (G - 8));
        pg8::EpiMemKV E{WSP(float, WS_KVM), WSP(float, WS_RSTDM)};
        pg8::gemm_phase<pg8::EpiMemKV, pg8::StaticOrder, true, true>(L + RING_OFF, g, S, E); }
    }
#endif
#if (PHMASK >> 2) & 1
    {
        pg8::Gemm g{WSP(bf16, WS_HB), WSP(bf16, WS_WGU1), T, 2 * DFF, 1024}; pg8::StaticOrder S; S.init(T, 2 * DFF, G, bx);
        pg8::build_row_tab<0>(WSP(float, WS_RSTDX), S, (LAS float*)(L + RING_BYTES + 1024)); pg8::EpiSwiGLU<0> E{WSP(bf16, WS_HID), DFF, (LAS float*)(L + RING_BYTES + 1024)};
#pragma unroll 1
        for (int rep_ = 0; rep_ < REP_GEMM; ++rep_)
        pg8::gemm_phase<pg8::EpiSwiGLU<0>, pg8::StaticOrder, true, true>(L + RING_OFF, g, S, E);
        {
            const int nfull = (64 * 22) % G; const int nidle = (nfull == 0) ? G : G - nfull; const int first = G - nidle;
            const int nconv = nidle > 8 ? nidle - 8 : nidle; const bool conv = (bx >= first) && (bx - first < nconv);
            if (conv) { CONVERT_GROUP(1, (bx - first) * NWAVES + wave, nconv * NWAVES);
                for (int e = (bx - first) * NWAVES * 64 + tid; e < T * 32; e += nconv * NWAVES * 64) {
                    const int row = e >> 5, i = e & 31; const float inv_freq = powf(10000.0f, -(float)i * (1.0f / 32.0f));
                    const float ang = (float)((const int*)ap->in[2])[row] * inv_freq; float sn, cs; sincosf(ang, &sn, &cs); WSP(float, WS_COS)[e] = cs; WSP(float, WS_SIN)[e] = sn; } }
        }
        GRID_BAR();
    }
#endif
#if (PHMASK >> 3) & 1
    {
        pg8::Gemm g{WSP(bf16, WS_HID), WSP(bf16, WS_WD1), T, 1024, DFF}; pg8::StaticOrder S; S.init(T, 1024, G, bx);
        pg8::EpiResid2<true> E{ARG_IN(0), ap->out, WSP(bf16, WS_HB), WSP(float, WS_SSQ1), 0.5f};
#pragma unroll 1
        for (int rep_ = 0; rep_ < REP_GEMM; ++rep_)
        pg8::gemm_phase<pg8::EpiResid2<true>, pg8::StaticOrder, true, true>(L + RING_OFF, g, S, E);
        GRID_BAR();
    }
#endif
#if (PHMASK >> 4) & 1
    {
        pg8::Gemm g{WSP(bf16, WS_HB), WSP(bf16, WS_WIN), T, NPROJ, 1024}; pg8::StaticOrder S; S.init(T, NPROJ, G, bx);
        pg8::ProjOut PO{WSP(bf16, WS_FQ), WSP(bf16, WS_FK), WSP(bf16, WS_FV), WSP(bf16, WS_DQ), WSP(bf16, WS_IQ), WSP(bf16, WS_MQ), WSP(bf16, WS_DK), WSP(bf16, WS_DV), WSP(bf16, WS_IK), WSP(float, WS_LOGF), WSP(float, WS_IW), WSP(float, WS_COS), WSP(float, WS_SIN), ARG_IN(11), ARG_IN(12), ARG_IN(13), ARG_IN(14), ARG_IN(10)};
        pg8::build_row_tab<16>(WSP(float, WS_SSQ1), S, (LAS float*)(L + RING_BYTES + 1024)); pg8::EpiProj<16> E{PO, (LAS float*)(L + RING_BYTES + 1024), C2_64};
#pragma unroll 1
        for (int rep_ = 0; rep_ < REP_GEMM; ++rep_)
        pg8::gemm_phase<pg8::EpiProj<16>, pg8::StaticOrder, true, true>(L + RING_OFF, g, S, E);
        {
            const int nfull = (64 * 13) % G; const int nidle = (nfull == 0) ? G : G - nfull; const int first = G - nidle;
            if (bx >= first) { CONVERT_GROUP(2, (bx - first) * NWAVES + wave, nidle * NWAVES);
        for (int it = (bx - first) * NWAVES + wave; it < 2048; it += nidle * NWAVES) { const int row = it >> 2, h = it & 3;
                    const f32x2g kv = *(const f32x2g*)(WSP(float, WS_KVM) + (size_t)row * 1024 + h * 128 + 2 * lane); const f32x2g vv = *(const f32x2g*)(WSP(float, WS_KVM) + (size_t)row * 1024 + 512 + h * 128 + 2 * lane);
                    const float ss = wave_sum(kv.x * kv.x + kv.y * kv.y); const float rstd = 1.0f / sqrtf(ss * (1.0f / 128.0f) + 1e-6f);
                    const f32x2g gk = *(const f32x2g*)(ARG_IN(16) + 2 * lane);
                    *(unsigned*)(WSP(bf16, WS_KMB) + (size_t)row * 512 + h * 128 + 2 * lane) = pk2(kv.x * rstd * gk.x, kv.y * rstd * gk.y);
                    *(unsigned*)(WSP(bf16, WS_VMB) + (size_t)row * 512 + h * 128 + 2 * lane) = pk2(vv.x, vv.y); } }
        }
        GRID_BAR();
#if defined(DBG_DUMP_AFTER) && DBG_DUMP_AFTER == 4
        {
            const bf16* sa = WSP(bf16, DBG_DUMP_A); const bf16* sb = WSP(bf16, DBG_DUMP_B);
            for (size_t e = (size_t)vcu * 512 + tid; e < (size_t)T * 512; e += (size_t)G * 512) { const size_t row = e >> 9, c = e & 511;
                ap->out[row * 1024 + c] = bf2f(sa[row * DBG_PITCH + c]); ap->out[row * 1024 + 512 + c] = bf2f(sb[row * DBG_PITCH + c]); }
            return;
        }
#endif

    }
#endif
#if ((PHMASK >> 5) & 1) && !DBG_SUBST
    {
        for (int u = vcu; u < 256; u += G) mem_block(u, WSP(bf16, WS_MQ), WSP(bf16, WS_KMB), WSP(bf16, WS_VMB), ARG_IN(15), L, wave, lane, tid);
    }
#endif
#if ((PHMASK >> 6) & 1) && !DBG_SUBST
    {
        for (int rep_ = 0; rep_ < REP_FOX; ++rep_)
        for (int v = vcu; v < 256; v += G) { const int bh = v >> 4, s = v & 15;
            scan_unit(bh, WSP(float, WS_LOGF), WSP(float, WS_CUM), WSP(int, WS_T0), ARG_IN(11), ARG_IN(12), (LAS float*)(L + SCANX_OFF), (LAS float*)(L + RING_OFF), tid);
            asm volatile("s_waitcnt vmcnt(0)" ::: "memory"); __syncthreads();
            fox_unit4(bh, s, WSP(bf16, WS_FQ), WSP(bf16, WS_FK), WSP(bf16, WS_FV), WSP(float, WS_CUM), WSP(int, WS_T0), ARG_IN(11), ARG_IN(12), WSP(bf16, WS_OA), L, wave, lane); fox_unit4(bh, 31 - s, WSP(bf16, WS_FQ), WSP(bf16, WS_FK), WSP(bf16, WS_FV), WSP(float, WS_CUM), WSP(int, WS_T0), ARG_IN(11), ARG_IN(12), WSP(bf16, WS_OA), L, wave, lane); }
        __syncthreads();
        {
            gu32* qctr = ctl + CW_Q; LAS int* QW = (LAS int*)(L + D3_QW);
            const int pref = (vcu >> 5) & 1;
            unsigned raw = 0u; int cur;
            if (tid == 0) { unsigned u = __hip_atomic_fetch_add(qctr + 64 * pref, 1u, RLX_AGENT); int bsel = pref; if (u >= 512u) { bsel = pref ^ 1; u = __hip_atomic_fetch_add(qctr + 64 * bsel, 1u, RLX_AGENT); } QW[0] = (u < 512u) ? ((bsel << 16) | (int)u) : -1; }
            __syncthreads(); cur = QW[0]; __syncthreads();
            while (cur >= 0) {
                if (tid == 0) raw = __hip_atomic_fetch_add(qctr + 64 * pref, 1u, RLX_AGENT);
                dsa3_unit(cur >> 16, 511 - (cur & 0xffff), WSP(bf16, WS_IQ), WSP(bf16, WS_IK), WSP(float, WS_IW), WSP(bf16, WS_DQ), WSP(bf16, WS_DK), WSP(bf16, WS_DV), WSP(bf16, WS_OB), L, wave, lane);
                if (tid == 0) { unsigned u = raw; int bsel = pref; if (u >= 512u) { bsel = pref ^ 1; u = __hip_atomic_fetch_add(qctr + 64 * bsel, 1u, RLX_AGENT); } QW[0] = (u < 512u) ? ((bsel << 16) | (int)u) : -1; }
                __syncthreads(); cur = QW[0]; __syncthreads();
            }
        }
        GRID_BAR();
    }
#endif
#if (PHMASK >> 7) & 1
    {
        pg8::StaticOrder S; S.init(T, 1024, G, bx); pg8::build_row_tab<16>(WSP(float, WS_SSQ1), S, (LAS float*)(L + RING_BYTES + 1024));
#ifndef P7STREAM
#define P7STREAM 1
#endif
#if P7STREAM
        {   typedef pg8::P7Order<WS_HB, WS_WGATE, WS_OA, WS_OB, WS_MQ, WS_WBR> P7O; P7O O{S, (const char*)WSP(char, 0)};
            pg8::EpiP7 E{WSP(bf16, WS_GSCR), WSP(bf16, WS_MERGED), (LAS float*)(L + RING_BYTES + 1024)};
#ifndef REP_P7
#define REP_P7 1
#endif
#pragma unroll 1
            for (int rep7_ = 0; rep7_ < REP_P7; ++rep7_) pg8::gemm_stream<pg8::EpiP7, P7O>(L + RING_OFF, O, E); }
#pragma unroll 1
        for (int i = 0; i < 0; ++i) {
#else
#pragma unroll 1
        for (int rep_ = 0; rep_ < REP_GEMM; ++rep_)
#pragma unroll 1
        for (int i = 0; i < DBG_NBR; ++i) {
#endif
#if DBG_GATE_AS_BRANCH
            {   pg8::Gemm g{WSP(bf16, WS_HB), WSP(bf16, DBG_GATE_W), T, 1024, 1024}; pg8::EpiBranch E{WSP(bf16, WS_GSCR), WSP(bf16, WS_MERGED), true, 1.0f}; pg8::gemm_phase<pg8::EpiBranch, pg8::StaticOrder, true, true>(L + RING_OFF, g, S, E); }
#elif !DBG_NOGATE
            {   pg8::Gemm g{WSP(bf16, WS_HB), WSP(bf16, DBG_GATE_W) + (size_t)i * 1024 * 1024, T, 1024, 1024}; pg8::EpiGate<16> E{WSP(bf16, WS_GSCR), (LAS float*)(L + RING_BYTES + 1024)}; pg8::gemm_phase<pg8::EpiGate<16>, pg8::StaticOrder, true, true>(L + RING_OFF, g, S, E); }
#endif
#if !DBG_NOBRANCH
#if DBG_SUBST == 1
            {   const bf16* A = (i == 0) ? WSP(bf16, WS_FQ) : (i == 1) ? WSP(bf16, WS_DQ) : WSP(bf16, WS_IQ);
#elif DBG_SUBST == 2
            {   const bf16* A = (i == 0) ? WSP(bf16, WS_FK) : (i == 1) ? WSP(bf16, WS_FV) : WSP(bf16, WS_MQ);
#else
            {   const bf16* A = (i == 0) ? WSP(bf16, WS_OA) : (i == 1) ? WSP(bf16, WS_OB) : WSP(bf16, WS_MQ);
#endif
                pg8::Gemm g{A, WSP(bf16, WS_WBR) + (size_t)i * 1024 * 512, T, 1024, 512}; pg8::EpiBranch E{WSP(bf16, WS_GSCR), WSP(bf16, WS_MERGED), i == 0, ((DBG_BRANCH_MASK >> i) & 1) ? 1.0f : 0.0f}; pg8::gemm_phase<pg8::EpiBranch, pg8::StaticOrder, true, true>(L + RING_OFF, g, S, E); }
#endif
        }
        GRID_BAR();
#if defined(DBG_DUMP_AFTER) && DBG_DUMP_AFTER == 7
        {
            const bf16* sa = WSP(bf16, DBG_DUMP_A); const bf16* sb = WSP(bf16, DBG_DUMP_B);
            for (size_t e = (size_t)vcu * 512 + tid; e < (size_t)T * 512; e += (size_t)G * 512) { const size_t row = e >> 9, c = e & 511;
                ap->out[row * 1024 + c] = bf2f(sa[row * DBG_PITCH + c]); ap->out[row * 1024 + 512 + c] = bf2f(sb[row * DBG_PITCH + c]); }
            return;
        }
#endif

    }
#endif
#if (PHMASK >> 8) & 1
    {
        pg8::Gemm g{WSP(bf16, WS_MERGED), WSP(bf16, WS_WOUT), T, 1024, 1024}; pg8::StaticOrder S; S.init(T, 1024, G, bx);
        pg8::EpiResid2<true> E{ap->out, ap->out, WSP(bf16, WS_HB), WSP(float, WS_SSQ2), 1.0f};
        pg8::gemm_phase<pg8::EpiResid2<true>, pg8::StaticOrder, true, true>(L + RING_OFF, g, S, E);
        GRID_BAR();
    }
#endif
#if (PHMASK >> 9) & 1
    {
        pg8::Gemm g{WSP(bf16, WS_HB), WSP(bf16, WS_WGU2), T, 2 * DFF, 1024}; pg8::StaticOrder S; S.init(T, 2 * DFF, G, bx);
        pg8::build_row_tab<16>(WSP(float, WS_SSQ2), S, (LAS float*)(L + RING_BYTES + 1024)); pg8::EpiSwiGLU<16> E{WSP(bf16, WS_HID), DFF, (LAS float*)(L + RING_BYTES + 1024)};
#pragma unroll 1
        for (int rep_ = 0; rep_ < REP_GEMM; ++rep_)
        pg8::gemm_phase<pg8::EpiSwiGLU<16>, pg8::StaticOrder, true, true>(L + RING_OFF, g, S, E);
        GRID_BAR();
    }
#endif
#if (PHMASK >> 10) & 1
    {
        pg8::Gemm g{WSP(bf16, WS_HID), WSP(bf16, WS_WD2), T, 1024, DFF}; pg8::StaticOrder S; S.init(T, 1024, G, bx);
        pg8::EpiResid2<false> E{ap->out, ap->out, nullptr, nullptr, 0.5f};
        pg8::gemm_phase<pg8::EpiResid2<false>, pg8::StaticOrder, true, true>(L + RING_OFF, g, S, E);
    }
#endif
}

extern "C" void kernel_launch(void* const* d_in, const int* in_sizes, int n_in, void* d_out, int out_size, void* d_ws, size_t ws_size, hipStream_t stream) {
    static int grid = 0;
    if (grid == 0) {
        if (n_in != 24 || out_size != T * DM || ws_size < WS_END) { fprintf(stderr, "kernel_launch: unexpected problem (n_in %d, out %d, ws %zu)\n", n_in, out_size, ws_size); grid = -1; return; }
        int dev = 0, cus = 0, per_cu = 0;
        if (hipGetDevice(&dev) != hipSuccess || hipDeviceGetAttribute(&cus, hipDeviceAttributeMultiprocessorCount, dev) != hipSuccess) { grid = -1; return; }
        if (hipFuncSetAttribute((const void*)fwd_mega, hipFuncAttributeMaxDynamicSharedMemorySize, LDS_BYTES) != hipSuccess) { fprintf(stderr, "kernel_launch: hipFuncSetAttribute failed\n"); grid = -1; return; }
        if (hipOccupancyMaxActiveBlocksPerMultiprocessor(&per_cu, (const void*)fwd_mega, NWAVES * 64, LDS_BYTES) != hipSuccess || per_cu < 1) { fprintf(stderr, "kernel_launch: occupancy query says %d blocks per CU\n", per_cu); (void)hipGetLastError(); grid = -1; return; }
        grid = cus;
    }
    if (grid < 0) return;
    (void)hipMemsetAsync((char*)d_ws + WS_CTL, 0, CTL_ZERO_BYTES, stream);
    Args a{};
    for (int i = 0; i < 24; ++i) a.in[i] = d_in[i];
    a.out = (float*)d_out; a.ws = (unsigned char*)d_ws;
    hipLaunchKernelGGL(fwd_mega, dim3(grid), dim3(NWAVES * 64), LDS_BYTES, stream, a);
}
```

```cpp
#include <hip/hip_runtime.h>
#include <cstdio>
#include <cstdint>
namespace pg8 {
#define PG8_LAS __attribute__((address_space(3)))
typedef unsigned short bf16_t;
typedef short bf16x8 __attribute__((ext_vector_type(8)));
typedef float f32x4 __attribute__((ext_vector_type(4)));
typedef unsigned u32x4 __attribute__((ext_vector_type(4)));
constexpr int BM = 256, BK = 64, HALF = 128, HTB = HALF * BK * 2  , STAGE_BYTES = 8 * HTB, NXCD = 8, WGM = 8;

__host__ __device__ __forceinline__ int lds_byte(int r, int c) { const int st = (r >> 4) * 2 + (c >> 5), rr = r & 15, cc = c & 31, ob = rr * 64 + cc * 2; return st * 1024 + (ob ^ (((ob >> 9) & 1) << 5)); }
__host__ __device__ __forceinline__ void stage_rc(int b, int& R, int& C) { const int st = b / 1024, sb = b % 1024, swz = sb ^ (((sb >> 9) & 1) << 5); R = (st >> 1) * 16 + swz / 64; C = (st & 1) * 32 + (swz % 64) / 2; }
__host__ __device__ __forceinline__ int perm32(int rho) { const int n = rho >> 4, i = rho & 15; return 8 * (i >> 2) + 4 * n + (i & 3); }

struct Unit { int pm, pn; };
struct Gemm { const bf16_t* A; const bf16_t* Bt; int M, N, K; };

struct StaticOrder {
    int nM, nN, nwg, G, c;
    __host__ __device__ void init(int M, int N, int G_, int c_) { nM = M / BM; nN = N / BM; nwg = nM * nN; G = G_; c = c_; }
    __host__ __device__ bool next(int i, Unit& u) const {
        const long L = (long)i * G + c; if (L >= nwg) return false;
        int wgid = (int)L; { const int q = nwg / NXCD, r = nwg % NXCD, xcd = wgid % NXCD, off = wgid / NXCD; wgid = (xcd < r ? xcd * (q + 1) : r * (q + 1) + (xcd - r) * q) + off; }
        const int nig = WGM * nN, gid = wgid / nig, fm = gid * WGM, gsz = (nM - fm) < WGM ? (nM - fm) : WGM;
        u.pm = fm + ((wgid % nig) % gsz); u.pn = (wgid % nig) / gsz; return true;
    }
    __device__ __forceinline__ void a_ready(const Unit&) const {}
    __device__ __forceinline__ void done(const Unit&) const {}
};

typedef float f32x2cv __attribute__((ext_vector_type(2))); typedef __bf16 bf16x2cv __attribute__((ext_vector_type(2)));
__device__ __forceinline__ unsigned cvt_pk_bf16(float lo, float hi) { const f32x2cv v = {lo, hi}; const bf16x2cv b = __builtin_convertvector(v, bf16x2cv); return __builtin_bit_cast(unsigned, b); }
typedef float f32x2 __attribute__((ext_vector_type(2)));
template <class Epi, class Sched, bool ALIGN_EPI = false, bool SP2 = false>
__device__ __forceinline__ void gemm_phase(PG8_LAS unsigned char* lds, const Gemm g, const Sched& S, const Epi& E) {
    int tid_ = threadIdx.x; asm volatile("" : "+v"(tid_));
    const int tid = tid_, wid = __builtin_amdgcn_readfirstlane(tid >> 6), lane = tid & 63, wr = wid >> 2, wc = wid & 3, fr = lane & 15, fq = lane >> 4;
    const int K = g.K, nt = K / BK;
    unsigned voffA[2], voffB[2];
#pragma unroll
    for (int i = 0; i < 2; ++i) { int R, C; stage_rc(tid * 16 + i * 8192, R, C); const int Rb = Epi::PERM ? ((R & ~31) + perm32(R & 31)) : R;
        voffA[i] = (unsigned)(R * K + C) * 2u; voffB[i] = (unsigned)(Rb * K + C) * 2u; }
    const size_t kstep = (size_t)(BK * 2);
    const size_t hstep = (size_t)HALF * K * 2;
    const size_t tstep = 2 * hstep;
    const unsigned ldsw = (unsigned)wid * 1024u;
    const int aoff = lds_byte(wr * 64 + fr, fq * 8), boff = lds_byte(wc * 32 + fr, fq * 8);
#define PG8_SA(b, h) (((b) * 2 + (h)) * HTB)
#define PG8_SB(b, h) ((4 + (b) * 2 + (h)) * HTB)
#define PG8_STAGE(bufoff, gbase, voff) do { _Pragma("unroll") for (int _i = 0; _i < 2; ++_i) \
        __builtin_amdgcn_global_load_lds((const unsigned*)((const char*)(gbase) + (voff)[_i]), (PG8_LAS unsigned*)(lds + (bufoff) + ldsw + _i * 8192), 16, 0, 0); } while (0)
#define PG8_LDA(dst, b, h) do { _Pragma("unroll") for (int m = 0; m < 4; ++m) _Pragma("unroll") for (int k = 0; k < 2; ++k) dst[m][k] = *(const PG8_LAS bf16x8*)(lds + PG8_SA(b, h) + aoff + m * 2048 + k * 1024); } while (0)
#define PG8_LDB(dst, b, h) do { _Pragma("unroll") for (int n = 0; n < 2; ++n) _Pragma("unroll") for (int k = 0; k < 2; ++k) dst[n][k] = *(const PG8_LAS bf16x8*)(lds + PG8_SB(b, h) + boff + n * 2048 + k * 1024); } while (0)
#define PG8_MMA(ai, bj, At, Bt) do { __builtin_amdgcn_s_setprio(1); _Pragma("unroll") for (int m = 0; m < 4; ++m) _Pragma("unroll") for (int n = 0; n < 2; ++n) _Pragma("unroll") for (int k = 0; k < 2; ++k) \
        acc[ai][bj][m][n] = __builtin_amdgcn_mfma_f32_16x16x32_bf16(Bt[n][k], At[m][k], acc[ai][bj][m][n], 0, 0, 0); __builtin_amdgcn_s_setprio(0); } while (0)
#define PG8_WAIT_V(n) asm volatile("s_waitcnt vmcnt(" #n ")" ::: "memory")
#define PG8_WAIT_L(n) asm volatile("s_waitcnt lgkmcnt(" #n ")" ::: "memory")
#define PG8_BAR __builtin_amdgcn_s_barrier()
#define PG8_SCHED __builtin_amdgcn_sched_barrier(0)
    Unit cur, nxt; int ui = 0;
    if (!S.next(0, cur)) return;
    f32x4 acc[2][2][4][2];
#pragma unroll
    for (int a = 0; a < 2; ++a)
#pragma unroll
        for (int b = 0; b < 2; ++b)
#pragma unroll
            for (int m = 0; m < 4; ++m)
#pragma unroll
                for (int n = 0; n < 2; ++n) acc[a][b][m][n] = (f32x4){0.f, 0.f, 0.f, 0.f};
    bf16x8 At[4][2], B0[2][2], B1[2][2];
    const char* cA = (const char*)g.A + (size_t)cur.pm * tstep; const char* cB = (const char*)g.Bt + (size_t)cur.pn * tstep;
    S.a_ready(cur);
    if constexpr (SP2) {
        PG8_STAGE(PG8_SB(0, 0), cB, voffB); PG8_STAGE(PG8_SB(0, 1), cB + hstep, voffB); PG8_STAGE(PG8_SA(0, 0), cA, voffA); PG8_STAGE(PG8_SA(0, 1), cA + hstep, voffA);
        if (wr == 1) PG8_BAR;
        PG8_WAIT_V(2); PG8_BAR;
        PG8_STAGE(PG8_SB(1, 0), cB + kstep, voffB); PG8_STAGE(PG8_SA(1, 0), cA + kstep, voffA); PG8_STAGE(PG8_SB(1, 1), cB + hstep + kstep, voffB);
        PG8_WAIT_V(6); PG8_BAR;
    } else {
        PG8_STAGE(PG8_SB(0, 0), cB, voffB); PG8_STAGE(PG8_SA(0, 0), cA, voffA); PG8_STAGE(PG8_SB(0, 1), cB + hstep, voffB); PG8_STAGE(PG8_SA(0, 1), cA + hstep, voffA);
        if (wr == 1) PG8_BAR;
        PG8_WAIT_V(4); PG8_BAR;
        PG8_STAGE(PG8_SB(1, 0), cB + kstep, voffB); PG8_STAGE(PG8_SA(1, 0), cA + kstep, voffA); PG8_STAGE(PG8_SB(1, 1), cB + hstep + kstep, voffB);
        PG8_WAIT_V(6); PG8_BAR;
    }
    for (;;) {
        const bool has_next = S.next(ui + 1, nxt);
        const char* nA = has_next ? (const char*)g.A + (size_t)nxt.pm * tstep : cA; const char* nB = has_next ? (const char*)g.Bt + (size_t)nxt.pn * tstep : cB;
        for (int t = 0; t < nt; t += 2) {
            const bool last = (t == nt - 2);
            const char* a1 = cA + (size_t)(t + 1) * kstep;
            const char* a2 = last ? nA : cA + (size_t)(t + 2) * kstep; const char* b2 = last ? nB : cB + (size_t)(t + 2) * kstep;
            const char* a3 = a2 + kstep; const char* b3 = b2 + kstep;
            if (last && has_next) S.a_ready(nxt);
            if constexpr (SP2) {
            PG8_LDB(B0, 0, 0); PG8_LDB(B1, 0, 1); PG8_SCHED; PG8_LDA(At, 0, 0); PG8_STAGE(PG8_SA(1, 1), a1 + hstep, voffA);
            PG8_WAIT_V(8); PG8_WAIT_L(0); PG8_BAR; PG8_MMA(0, 0, At, B0); PG8_MMA(0, 1, At, B1); PG8_BAR; PG8_SCHED;
            PG8_LDA(At, 0, 1); PG8_STAGE(PG8_SB(0, 0), b2, voffB); PG8_STAGE(PG8_SB(0, 1), b2 + hstep, voffB); PG8_STAGE(PG8_SA(0, 0), a2, voffA);
            PG8_WAIT_V(8); PG8_WAIT_L(0); PG8_BAR; PG8_MMA(1, 0, At, B0); PG8_MMA(1, 1, At, B1); PG8_BAR; PG8_SCHED;
            PG8_LDB(B0, 1, 0); PG8_LDB(B1, 1, 1); PG8_SCHED; PG8_LDA(At, 1, 0); PG8_STAGE(PG8_SA(0, 1), a2 + hstep, voffA);
            PG8_WAIT_V(8); PG8_WAIT_L(0); PG8_BAR; PG8_MMA(0, 0, At, B0); PG8_MMA(0, 1, At, B1); PG8_BAR; PG8_SCHED;
            PG8_LDA(At, 1, 1); PG8_STAGE(PG8_SB(1, 0), b3, voffB); PG8_STAGE(PG8_SB(1, 1), b3 + hstep, voffB); PG8_STAGE(PG8_SA(1, 0), a3, voffA);
            PG8_WAIT_V(8); PG8_WAIT_L(0); PG8_BAR; PG8_MMA(1, 0, At, B0); PG8_MMA(1, 1, At, B1); PG8_BAR; PG8_SCHED;
            } else {
            PG8_LDB(B0, 0, 0); PG8_SCHED; PG8_LDA(At, 0, 0); PG8_STAGE(PG8_SA(1, 1), a1 + hstep, voffA);
            PG8_WAIT_L(8); PG8_BAR; PG8_WAIT_L(0); PG8_MMA(0, 0, At, B0); PG8_BAR; PG8_SCHED;
            PG8_LDB(B1, 0, 1); PG8_STAGE(PG8_SB(0, 0), b2, voffB);
            PG8_BAR; PG8_WAIT_L(0); PG8_MMA(0, 1, At, B1); PG8_BAR;
            PG8_LDA(At, 0, 1); PG8_STAGE(PG8_SA(0, 0), a2, voffA);
            PG8_BAR; PG8_WAIT_L(0); PG8_MMA(1, 0, At, B0); PG8_BAR; PG8_SCHED;
            PG8_STAGE(PG8_SB(0, 1), b2 + hstep, voffB);
            PG8_WAIT_V(6); PG8_BAR; PG8_MMA(1, 1, At, B1); PG8_BAR;
            PG8_LDB(B0, 1, 0); PG8_SCHED; PG8_LDA(At, 1, 0); PG8_STAGE(PG8_SA(0, 1), a2 + hstep, voffA);
            PG8_WAIT_L(8); PG8_BAR; PG8_WAIT_L(0); PG8_MMA(0, 0, At, B0); PG8_BAR; PG8_SCHED;
            PG8_LDB(B1, 1, 1); PG8_STAGE(PG8_SB(1, 0), b3, voffB);
            PG8_BAR; PG8_WAIT_L(0); PG8_MMA(0, 1, At, B1); PG8_BAR;
            PG8_LDA(At, 1, 1); PG8_STAGE(PG8_SA(1, 0), a3, voffA);
            PG8_BAR; PG8_WAIT_L(0); PG8_MMA(1, 0, At, B0); PG8_BAR; PG8_SCHED;
            PG8_STAGE(PG8_SB(1, 1), b3 + hstep, voffB);
            PG8_WAIT_V(6); PG8_BAR; PG8_MMA(1, 1, At, B1); PG8_BAR;
            }
        }
        if constexpr (ALIGN_EPI) { if (wr == 0) PG8_BAR; }
        if constexpr (!Epi::AFTER_DRAIN) { E(acc, cur, wr, wc, fr, fq); S.done(cur); }
        if (!has_next) break;
#pragma unroll
        for (int a = 0; a < 2; ++a)
#pragma unroll
            for (int b = 0; b < 2; ++b)
#pragma unroll
                for (int m = 0; m < 4; ++m)
#pragma unroll
                    for (int n = 0; n < 2; ++n) acc[a][b][m][n] = (f32x4){0.f, 0.f, 0.f, 0.f};
        cur = nxt; cA = nA; cB = nB; ++ui;
        if constexpr (ALIGN_EPI) { if (wr == 1) PG8_BAR; }
    }
    PG8_WAIT_V(0);
    if constexpr (!ALIGN_EPI) { if (wr == 0) PG8_BAR; }
    PG8_BAR;
    if constexpr (Epi::AFTER_DRAIN) { E.fused(acc, cur, wr, wc, fr, fq, lds, wid, lane); S.done(cur); }
#undef PG8_SA
#undef PG8_SB
#undef PG8_STAGE
#undef PG8_LDA
#undef PG8_LDB
#undef PG8_MMA
#undef PG8_WAIT_V
#undef PG8_WAIT_L
#undef PG8_BAR
#undef PG8_SCHED
}

struct UnitX { int pm, pn, kind, round; };
struct OpsX { const char* A; const char* Bt; int K; };
template <class Epi, class Sched>
__device__ __forceinline__ void gemm_stream(PG8_LAS unsigned char* lds, const Sched& S, const Epi& E) {
    int tid_ = threadIdx.x; asm volatile("" : "+v"(tid_));
    const int tid = tid_, wid = __builtin_amdgcn_readfirstlane(tid >> 6), lane = tid & 63, wr = wid >> 2, wc = wid & 3, fr = lane & 15, fq = lane >> 4;
    unsigned rA[2], rB[2], c2[2];
#pragma unroll
    for (int i = 0; i < 2; ++i) { int R, C; stage_rc(tid * 16 + i * 8192, R, C); rA[i] = (unsigned)R; rB[i] = (unsigned)((R & ~31) + perm32(R & 31)); c2[i] = (unsigned)C * 2u; }
    const size_t kstep = (size_t)(BK * 2);
    const unsigned ldsw = (unsigned)wid * 1024u;
    const int aoff = lds_byte(wr * 64 + fr, fq * 8), boff = lds_byte(wc * 32 + fr, fq * 8);
#define PG8_SA(b, h) (((b) * 2 + (h)) * HTB)
#define PG8_SB(b, h) ((4 + (b) * 2 + (h)) * HTB)
#define PGX_STAGE(bufoff, gbase, rr, pb) do { _Pragma("unroll") for (int _i = 0; _i < 2; ++_i) \
        __builtin_amdgcn_global_load_lds((const unsigned*)((const char*)(gbase) + ((rr)[_i] * (pb) + c2[_i])), (PG8_LAS unsigned*)(lds + (bufoff) + ldsw + _i * 8192), 16, 0, 0); } while (0)
#define PG8_LDA(dst, b, h) do { _Pragma("unroll") for (int m = 0; m < 4; ++m) _Pragma("unroll") for (int k = 0; k < 2; ++k) dst[m][k] = *(const PG8_LAS bf16x8*)(lds + PG8_SA(b, h) + aoff + m * 2048 + k * 1024); } while (0)
#define PG8_LDB(dst, b, h) do { _Pragma("unroll") for (int n = 0; n < 2; ++n) _Pragma("unroll") for (int k = 0; k < 2; ++k) dst[n][k] = *(const PG8_LAS bf16x8*)(lds + PG8_SB(b, h) + boff + n * 2048 + k * 1024); } while (0)
#define PG8_MMA(ai, bj, At, Bt) do { __builtin_amdgcn_s_setprio(1); _Pragma("unroll") for (int m = 0; m < 4; ++m) _Pragma("unroll") for (int n = 0; n < 2; ++n) _Pragma("unroll") for (int k = 0; k < 2; ++k) \
        acc[ai][bj][m][n] = __builtin_amdgcn_mfma_f32_16x16x32_bf16(Bt[n][k], At[m][k], acc[ai][bj][m][n], 0, 0, 0); __builtin_amdgcn_s_setprio(0); } while (0)
#define PG8_WAIT_V(n) asm volatile("s_waitcnt vmcnt(" #n ")" ::: "memory")
#define PG8_WAIT_L(n) asm volatile("s_waitcnt lgkmcnt(" #n ")" ::: "memory")
#define PG8_BAR __builtin_amdgcn_s_barrier()
#define PG8_SCHED __builtin_amdgcn_sched_barrier(0)
    UnitX cur, nxt; int ui = 0;
    if (!S.next(0, cur)) return;
    f32x4 acc[2][2][4][2];
#pragma unroll
    for (int a = 0; a < 2; ++a)
#pragma unroll
        for (int b = 0; b < 2; ++b)
#pragma unroll
            for (int m = 0; m < 4; ++m)
#pragma unroll
                for (int n = 0; n < 2; ++n) acc[a][b][m][n] = (f32x4){0.f, 0.f, 0.f, 0.f};
    bf16x8 At[4][2], B0[2][2], B1[2][2];
    OpsX oc = S.ops(cur);
    const char* cA = oc.A; const char* cB = oc.Bt; int Kc = oc.K;
    {   const unsigned pb = (unsigned)Kc * 2u; const size_t hstep = (size_t)HALF * pb;
        PGX_STAGE(PG8_SB(0, 0), cB, rB, pb); PGX_STAGE(PG8_SB(0, 1), cB + hstep, rB, pb); PGX_STAGE(PG8_SA(0, 0), cA, rA, pb); PGX_STAGE(PG8_SA(0, 1), cA + hstep, rA, pb);
        if (wr == 1) PG8_BAR;
        PG8_WAIT_V(2); PG8_BAR;
        PGX_STAGE(PG8_SB(1, 0), cB + kstep, rB, pb); PGX_STAGE(PG8_SA(1, 0), cA + kstep, rA, pb); PGX_STAGE(PG8_SB(1, 1), cB + hstep + kstep, rB, pb);
        PG8_WAIT_V(6); PG8_BAR; }
    for (;;) {
        const bool has_next = S.next(ui + 1, nxt);
        OpsX on = oc; if (has_next) on = S.ops(nxt);
        const char* nA = on.A; const char* nB = on.Bt; const int Kn = on.K;
        const int nt = Kc / BK; const unsigned pbc = (unsigned)Kc * 2u; const size_t hstep = (size_t)HALF * pbc;
        for (int t = 0; t < nt; t += 2) {
            const bool last = (t == nt - 2);
            const char* a1 = cA + (size_t)(t + 1) * kstep;
            const char* a2 = last ? nA : cA + (size_t)(t + 2) * kstep; const char* b2 = last ? nB : cB + (size_t)(t + 2) * kstep;
            const char* a3 = a2 + kstep; const char* b3 = b2 + kstep;
            const unsigned pb2 = last ? (unsigned)Kn * 2u : pbc; const size_t h2 = (size_t)HALF * pb2;
            PG8_LDB(B0, 0, 0); PG8_LDB(B1, 0, 1); PG8_SCHED; PG8_LDA(At, 0, 0); PGX_STAGE(PG8_SA(1, 1), a1 + hstep, rA, pbc);
            PG8_WAIT_V(8); PG8_WAIT_L(0); PG8_BAR; PG8_MMA(0, 0, At, B0); PG8_MMA(0, 1, At, B1); PG8_BAR; PG8_SCHED;
            PG8_LDA(At, 0, 1); PGX_STAGE(PG8_SB(0, 0), b2, rB, pb2); PGX_STAGE(PG8_SB(0, 1), b2 + h2, rB, pb2); PGX_STAGE(PG8_SA(0, 0), a2, rA, pb2);
            PG8_WAIT_V(8); PG8_WAIT_L(0); PG8_BAR; PG8_MMA(1, 0, At, B0); PG8_MMA(1, 1, At, B1); PG8_BAR; PG8_SCHED;
            PG8_LDB(B0, 1, 0); PG8_LDB(B1, 1, 1); PG8_SCHED; PG8_LDA(At, 1, 0); PGX_STAGE(PG8_SA(0, 1), a2 + h2, rA, pb2);
            PG8_WAIT_V(8); PG8_WAIT_L(0); PG8_BAR; PG8_MMA(0, 0, At, B0); PG8_MMA(0, 1, At, B1); PG8_BAR; PG8_SCHED;
            PG8_LDA(At, 1, 1); PGX_STAGE(PG8_SB(1, 0), b3, rB, pb2); PGX_STAGE(PG8_SB(1, 1), b3 + h2, rB, pb2); PGX_STAGE(PG8_SA(1, 0), a3, rA, pb2);
            PG8_WAIT_V(8); PG8_WAIT_L(0); PG8_BAR; PG8_MMA(1, 0, At, B0); PG8_MMA(1, 1, At, B1); PG8_BAR; PG8_SCHED;
        }
        if (wr == 0) PG8_BAR;
        E(acc, cur, wr, wc, fr, fq);
        if (!has_next) break;
#pragma unroll
        for (int a = 0; a < 2; ++a)
#pragma unroll
            for (int b = 0; b < 2; ++b)
#pragma unroll
                for (int m = 0; m < 4; ++m)
#pragma unroll
                    for (int n = 0; n < 2; ++n) acc[a][b][m][n] = (f32x4){0.f, 0.f, 0.f, 0.f};
        cur = nxt; oc = on; cA = nA; cB = nB; Kc = Kn; ++ui;
        if (wr == 1) PG8_BAR;
    }
    PG8_WAIT_V(0);
    PG8_BAR;
#undef PG8_SA
#undef PG8_SB
#undef PGX_STAGE
#undef PG8_LDA
#undef PG8_LDB
#undef PG8_MMA
#undef PG8_WAIT_V
#undef PG8_WAIT_L
#undef PG8_BAR
#undef PG8_SCHED
}
}
namespace pg8 {
constexpr int TOK = 16384;
constexpr float RMS_EPS = 1e-6f;
typedef float f32x2e __attribute__((ext_vector_type(2)));
template <int NP> __device__ __forceinline__ void row_scales(const float* src, int rowbase, int lane, int fr, float (&r)[2][4]) {
#pragma unroll
    for (int ai = 0; ai < 2; ++ai) {
        const int row = rowbase + 128 * ai + lane; float v;
        if (NP == 0) v = src[row];
        else { float s = 0.f;
#pragma unroll
            for (int p = 0; p < NP; ++p) s += src[(size_t)p * TOK + row];
            v = __builtin_amdgcn_rsqf(s * (1.0f / 1024.0f) + RMS_EPS); }
#pragma unroll
        for (int m = 0; m < 4; ++m) r[ai][m] = __shfl(v, 16 * m + fr);
    }
}
template <int NP, class Sched> __device__ __forceinline__ void build_row_tab(const float* src, const Sched& S, PG8_LAS float* tab) {
    Unit u;
    for (int i = 0; S.next(i, u); ++i)
        for (int r = (int)threadIdx.x; r < 256; r += 512) { const int row = u.pm * BM + r; float v;
            if (NP == 0) v = src[row];
            else { float s = 0.f;
#pragma unroll
                for (int p = 0; p < NP; ++p) s += src[(size_t)p * TOK + row];
                v = __builtin_amdgcn_rsqf(s * (1.0f / 1024.0f) + RMS_EPS); }
            tab[i * 256 + r] = v; }
    __syncthreads();
}
__device__ __forceinline__ void row_scales_tab(const PG8_LAS float* tab, int ui, int wr, int fr, float (&r)[2][4]) {
#pragma unroll
    for (int ai = 0; ai < 2; ++ai)
#pragma unroll
        for (int m = 0; m < 4; ++m) r[ai][m] = tab[ui * 256 + ai * 128 + wr * 64 + 16 * m + fr];
}
__device__ __forceinline__ float silu_f(float x) { return x * __builtin_amdgcn_rcpf(1.0f + __expf(-x)); }
__device__ __forceinline__ float sigmoid_f(float x) { return __builtin_amdgcn_rcpf(1.0f + __expf(-x)); }

template <int NP> struct EpiSwiGLU {
    static constexpr bool PERM = true, AFTER_DRAIN = false;
    bf16_t* H; int ldh; const PG8_LAS float* tab; mutable int ui = 0;
    __device__ __forceinline__ void operator()(const f32x4 (&acc)[2][2][4][2], const Unit& u, int wr, int wc, int fr0, int fq0) const {
        int fr = fr0, fq = fq0; asm volatile("" : "+v"(fr), "+v"(fq));
        float r[2][4]; row_scales_tab(tab, ui++, wr, fr, r);
        const int col0 = u.pn * 128 + wc * 32 + 8 * fq;
#pragma unroll
        for (int ai = 0; ai < 2; ++ai)
#pragma unroll
            for (int m = 0; m < 4; ++m) {
                const int row = u.pm * BM + ai * HALF + wr * 64 + m * 16 + fr; const float rr = r[ai][m];
                float o[8]; const float k1 = -1.44269504f * rr, rr2 = rr * rr;
#pragma unroll
                for (int n = 0; n < 2; ++n)
#pragma unroll
                    for (int j = 0; j < 4; j += 2) { const f32x2 g2 = (f32x2){acc[ai][0][m][n][j], acc[ai][0][m][n][j + 1]}, u2 = (f32x2){acc[ai][1][m][n][j], acc[ai][1][m][n][j + 1]};
                        const f32x2 t2 = g2 * k1; const f32x2 d2 = (f32x2){__builtin_amdgcn_exp2f(t2[0]), __builtin_amdgcn_exp2f(t2[1])} + 1.0f;
                        const f32x2 r2 = (f32x2){__builtin_amdgcn_rcpf(d2[0]), __builtin_amdgcn_rcpf(d2[1])} * rr2; const f32x2 o2 = (g2 * u2) * r2;
                        o[4 * n + j] = o2[0]; o[4 * n + j + 1] = o2[1]; }
                u32x4 w; w.x = cvt_pk_bf16(o[0], o[1]); w.y = cvt_pk_bf16(o[2], o[3]); w.z = cvt_pk_bf16(o[4], o[5]); w.w = cvt_pk_bf16(o[6], o[7]);
                *(u32x4*)(H + (size_t)row * ldh + col0) = w;
            }
    }
};
template <bool WRITE_HB> struct EpiResid {
    static constexpr bool PERM = true, AFTER_DRAIN = false;
    const float* base; float* out; bf16_t* hb; float* part; float sc;
    __device__ __forceinline__ void operator()(const f32x4 (&acc)[2][2][4][2], const Unit& u, int wr, int wc, int fr0, int fq0) const {
        int fr = fr0, fq = fq0; asm volatile("" : "+v"(fr), "+v"(fq));
        const int col0 = u.pn * BM + wc * 32 + 8 * fq;
#pragma unroll
        for (int ai = 0; ai < 2; ++ai)
#pragma unroll
            for (int m = 0; m < 4; ++m) {
                const int row = u.pm * BM + ai * HALF + wr * 64 + m * 16 + fr; float ss = 0.f;
#pragma unroll
                for (int bj = 0; bj < 2; ++bj) {
                    const size_t off = (size_t)row * 1024 + col0 + bj * HALF;
                    const f32x4 b0 = *(const f32x4*)(base + off), b1 = *(const f32x4*)(base + off + 4);
                    const f32x4 o0 = b0 + acc[ai][bj][m][0] * sc, o1 = b1 + acc[ai][bj][m][1] * sc;
                    *(f32x4*)(out + off) = o0; *(f32x4*)(out + off + 4) = o1;
                    if (WRITE_HB) {
                        ss += (o0[0] * o0[0] + o0[1] * o0[1]) + (o0[2] * o0[2] + o0[3] * o0[3]) + (o1[0] * o1[0] + o1[1] * o1[1]) + (o1[2] * o1[2] + o1[3] * o1[3]);
                        u32x4 w; w.x = cvt_pk_bf16(o0[0], o0[1]); w.y = cvt_pk_bf16(o0[2], o0[3]); w.z = cvt_pk_bf16(o1[0], o1[1]); w.w = cvt_pk_bf16(o1[2], o1[3]);
                        *(u32x4*)(hb + off) = w; }
                }
                if (WRITE_HB) { ss += __shfl_xor(ss, 16); ss += __shfl_xor(ss, 32); if (fq == 0) part[(size_t)(u.pn * 4 + wc) * TOK + row] = ss; }
                if (m == 3) asm volatile("" ::: "memory");
            }
    }
};
template <bool WRITE_HB> struct EpiResid2 {
    static constexpr bool PERM = true, AFTER_DRAIN = false;
    const float* base; float* out; bf16_t* hb; float* part; float sc;
    __device__ __forceinline__ void operator()(const f32x4 (&acc)[2][2][4][2], const Unit& u, int wr, int wc, int fr0, int fq0) const {
        int fr = fr0, fq = fq0; asm volatile("" : "+v"(fr), "+v"(fq));
        const int row0 = u.pm * BM + wr * 64 + fr; const size_t o00 = (size_t)row0 * 1024 + u.pn * BM + wc * 32 + 8 * fq;
        const float* bp = base + o00; float* op = out + o00; bf16_t* hp = hb + o00;
        f32x4 bq[2][8];
#define ER2_ISSUE(G, B) do { _Pragma("unroll") for (int c = 0; c < 8; ++c) { const int ai = (G) >> 1, m = 2 * ((G) & 1) + (c >> 2), bj = (c >> 1) & 1, n = c & 1; \
            bq[B][c] = *(const f32x4*)(bp + (size_t)(ai * 128 + m * 16) * 1024 + bj * 128 + 4 * n); } } while (0)
        ER2_ISSUE(0, 0);
#pragma unroll
        for (int G = 0; G < 4; ++G) {
            if (G + 1 < 4) { if ((G & 1) == 0) ER2_ISSUE(G + 1, 1); else ER2_ISSUE(G + 1, 0); }
            asm volatile("" ::: "memory");
#pragma unroll
            for (int mm = 0; mm < 2; ++mm) { const int ai = G >> 1, m = 2 * (G & 1) + mm; float ss = 0.f;
#pragma unroll
                for (int bj = 0; bj < 2; ++bj) { const size_t off = (size_t)(ai * 128 + m * 16) * 1024 + bj * 128;
                    const f32x4 o0 = bq[G & 1][mm * 4 + bj * 2] + acc[ai][bj][m][0] * sc, o1 = bq[G & 1][mm * 4 + bj * 2 + 1] + acc[ai][bj][m][1] * sc;
                    *(f32x4*)(op + off) = o0; *(f32x4*)(op + off + 4) = o1;
                    if (WRITE_HB) {
                        ss += (o0[0] * o0[0] + o0[1] * o0[1]) + (o0[2] * o0[2] + o0[3] * o0[3]) + (o1[0] * o1[0] + o1[1] * o1[1]) + (o1[2] * o1[2] + o1[3] * o1[3]);
                        u32x4 w; w.x = cvt_pk_bf16(o0[0], o0[1]); w.y = cvt_pk_bf16(o0[2], o0[3]); w.z = cvt_pk_bf16(o1[0], o1[1]); w.w = cvt_pk_bf16(o1[2], o1[3]);
                        *(u32x4*)(hp + off) = w; } }
                if (WRITE_HB) { ss += __shfl_xor(ss, 16); ss += __shfl_xor(ss, 32); if (fq == 0) part[(size_t)(u.pn * 4 + wc) * TOK + row0 + ai * 128 + m * 16] = ss; } }
            asm volatile("" ::: "memory");
        }
#undef ER2_ISSUE
    }
};
__device__ __forceinline__ float bf_lo(unsigned w) { return __uint_as_float(w << 16); }
__device__ __forceinline__ float bf_hi(unsigned w) { return __uint_as_float(w & 0xffff0000u); }
template <int MODE> struct EpiResid3 {
    static constexpr bool PERM = true, AFTER_DRAIN = false;
    static constexpr int NS = 0;
    const float* basef; float* out; bf16_t* hb; float* part; float sc;
    __device__ __forceinline__ void operator()(const f32x4 (&acc)[2][2][4][2], const Unit& u, int wr, int wc, int fr0, int fq0) const {
        int fr = fr0, fq = fq0; asm volatile("" : "+v"(fr), "+v"(fq));
        const int row0 = u.pm * BM + wr * 64 + fr; const size_t o00 = (size_t)row0 * 1024 + u.pn * BM + wc * 32 + 8 * fq;
        const float* bp = basef + o00; float* op = out + o00; bf16_t* hp = hb + o00;
        f32x4 bq[2][8]; u32x4 hq[2][4];
#define ER3_ISSUE(G, B) do { if (MODE == 0) { _Pragma("unroll") for (int c = 0; c < 8; ++c) { const int ai = (G) >> 1, m = 2 * ((G) & 1) + (c >> 2), bj = (c >> 1) & 1, n = c & 1; \
                bq[B][c] = *(const f32x4*)(bp + (size_t)(ai * 128 + m * 16) * 1024 + bj * 128 + 4 * n); } } \
            else { _Pragma("unroll") for (int c = 0; c < 4; ++c) { const int ai = (G) >> 1, m = 2 * ((G) & 1) + (c >> 1), bj = c & 1; hq[B][c] = *(const u32x4*)(hp + (size_t)(ai * 128 + m * 16) * 1024 + bj * 128); } } } while (0)
        ER3_ISSUE(0, 0);
#pragma unroll
        for (int G = 0; G < 4; ++G) {
            if (G + 1 < 4) { if ((G & 1) == 0) ER3_ISSUE(G + 1, 1); else ER3_ISSUE(G + 1, 0); }
            asm volatile("" ::: "memory");
#pragma unroll
            for (int mm = 0; mm < 2; ++mm) { const int ai = G >> 1, m = 2 * (G & 1) + mm; float ss = 0.f;
#pragma unroll
                for (int bj = 0; bj < 2; ++bj) { const size_t off = (size_t)(ai * 128 + m * 16) * 1024 + bj * 128;
                    f32x4 b0, b1;
                    if (MODE == 0) { b0 = bq[G & 1][mm * 4 + bj * 2]; b1 = bq[G & 1][mm * 4 + bj * 2 + 1]; }
                    else { const u32x4 h = hq[G & 1][mm * 2 + bj]; b0 = (f32x4){bf_lo(h.x), bf_hi(h.x), bf_lo(h.y), bf_hi(h.y)}; b1 = (f32x4){bf_lo(h.z), bf_hi(h.z), bf_lo(h.w), bf_hi(h.w)}; }
                    const f32x4 o0 = b0 + acc[ai][bj][m][0] * sc, o1 = b1 + acc[ai][bj][m][1] * sc;
                    if (MODE == 2) { *(f32x4*)(op + off) = o0; *(f32x4*)(op + off + 4) = o1; }
                    else {
                        ss += (o0[0] * o0[0] + o0[1] * o0[1]) + (o0[2] * o0[2] + o0[3] * o0[3]) + (o1[0] * o1[0] + o1[1] * o1[1]) + (o1[2] * o1[2] + o1[3] * o1[3]);
                        u32x4 w; w.x = cvt_pk_bf16(o0[0], o0[1]); w.y = cvt_pk_bf16(o0[2], o0[3]); w.z = cvt_pk_bf16(o1[0], o1[1]); w.w = cvt_pk_bf16(o1[2], o1[3]);
                        *(u32x4*)(hp + off) = w; } }
                if (MODE != 2) { ss += __shfl_xor(ss, 16); ss += __shfl_xor(ss, 32); if (fq == 0) part[(size_t)(u.pn * 4 + wc) * TOK + row0 + ai * 128 + m * 16] = ss; } }
            asm volatile("" ::: "memory");
        }
#undef ER3_ISSUE
    }
};
struct EpiMemKV {
    static constexpr bool PERM = true, AFTER_DRAIN = false;
    float* KV; const float* rs;
    __device__ __forceinline__ void operator()(const f32x4 (&acc)[2][2][4][2], const Unit& u, int wr, int wc, int fr0, int fq0) const {
        int fr = fr0, fq = fq0; asm volatile("" : "+v"(fr), "+v"(fq));
        float r[2][4]; row_scales<0>(rs, u.pm * BM + wr * 64, (int)(threadIdx.x & 63), fr, r);
        const int col0 = u.pn * BM + wc * 32 + 8 * fq;
#pragma unroll
        for (int ai = 0; ai < 2; ++ai)
#pragma unroll
            for (int m = 0; m < 4; ++m) { const int row = u.pm * BM + ai * HALF + wr * 64 + m * 16 + fr;
#pragma unroll
                for (int bj = 0; bj < 2; ++bj) { const size_t off = (size_t)row * 1024 + col0 + bj * HALF;
                    *(f32x4*)(KV + off) = acc[ai][bj][m][0] * r[ai][m]; *(f32x4*)(KV + off + 4) = acc[ai][bj][m][1] * r[ai][m]; } }
    }
};
template <int NP> struct EpiGate {
    static constexpr bool PERM = true, AFTER_DRAIN = false;
    bf16_t* scr; const PG8_LAS float* tab; mutable int ui = 0;
    __device__ __forceinline__ void operator()(const f32x4 (&acc)[2][2][4][2], const Unit& u, int wr, int wc, int fr0, int fq0) const {
        int fr = fr0, fq = fq0; asm volatile("" : "+v"(fr), "+v"(fq));
        float r[2][4];
#ifdef DBG_GATE_NOSCALE
        for (int a_ = 0; a_ < 2; ++a_) for (int m_ = 0; m_ < 4; ++m_) r[a_][m_] = 1.0f;
#else
        row_scales_tab(tab, ui++, wr, fr, r);
#endif
        bf16_t* t = scr + (size_t)(u.pm * 4 + u.pn) * 65536;
#pragma unroll
        for (int ai = 0; ai < 2; ++ai)
#pragma unroll
            for (int m = 0; m < 4; ++m) { const int lr = ai * HALF + wr * 64 + m * 16 + fr; const float rr = r[ai][m];
#pragma unroll
                for (int bj = 0; bj < 2; ++bj) { float o[8];
#pragma unroll
                    for (int n = 0; n < 2; ++n)
#pragma unroll
                        for (int j = 0; j < 4; ++j) o[4 * n + j] = sigmoid_f(acc[ai][bj][m][n][j] * rr);
                    u32x4 w; w.x = cvt_pk_bf16(o[0], o[1]); w.y = cvt_pk_bf16(o[2], o[3]); w.z = cvt_pk_bf16(o[4], o[5]); w.w = cvt_pk_bf16(o[6], o[7]);
                    *(u32x4*)(t + lr * 256 + bj * HALF + wc * 32 + 8 * fq) = w; } }
    }
};
struct EpiBranch {
    static constexpr bool PERM = true, AFTER_DRAIN = false;
    const bf16_t* scr; bf16_t* mg; bool first; float bscale;
    __device__ __forceinline__ void operator()(const f32x4 (&acc)[2][2][4][2], const Unit& u, int wr, int wc, int fr0, int fq0) const {
        int fr = fr0, fq = fq0; asm volatile("" : "+v"(fr), "+v"(fq));
        const bf16_t* t = scr + (size_t)(u.pm * 4 + u.pn) * 65536;
        __builtin_amdgcn_fence(__ATOMIC_ACQUIRE, "agent");
        asm volatile("s_waitcnt vmcnt(0)" ::: "memory");
#pragma unroll
        for (int ai = 0; ai < 2; ++ai)
#pragma unroll
            for (int m = 0; m < 4; ++m) { const int lr = ai * HALF + wr * 64 + m * 16 + fr; const int row = u.pm * BM + lr;
#pragma unroll
                for (int bj = 0; bj < 2; ++bj) { const int lc = bj * HALF + wc * 32 + 8 * fq;
#if defined(DBG_NOGATE) && DBG_NOGATE
                    const u32x4 g = (u32x4){0x3f803f80u, 0x3f803f80u, 0x3f803f80u, 0x3f803f80u};
#else
                    const u32x4 g = *(const u32x4*)(t + lr * 256 + lc);
#endif
                    bf16_t* mp = mg + (size_t)row * 1024 + u.pn * BM + lc;
                    float o[8];
                    o[0] = bf_lo(g.x) * acc[ai][bj][m][0][0]; o[1] = bf_hi(g.x) * acc[ai][bj][m][0][1]; o[2] = bf_lo(g.y) * acc[ai][bj][m][0][2]; o[3] = bf_hi(g.y) * acc[ai][bj][m][0][3];
                    o[4] = bf_lo(g.z) * acc[ai][bj][m][1][0]; o[5] = bf_hi(g.z) * acc[ai][bj][m][1][1]; o[6] = bf_lo(g.w) * acc[ai][bj][m][1][2]; o[7] = bf_hi(g.w) * acc[ai][bj][m][1][3];
#ifdef DBG_BRANCH_SIGMOID
#pragma unroll
                    for (int e = 0; e < 8; ++e) o[e] = DBG_NONLIN(o[e]);
#endif
#pragma unroll
                    for (int e = 0; e < 8; ++e) o[e] *= bscale;
                    if (!first) { const u32x4 p = *(const u32x4*)mp;
                        o[0] += bf_lo(p.x); o[1] += bf_hi(p.x); o[2] += bf_lo(p.y); o[3] += bf_hi(p.y); o[4] += bf_lo(p.z); o[5] += bf_hi(p.z); o[6] += bf_lo(p.w); o[7] += bf_hi(p.w); }
                    u32x4 w; w.x = cvt_pk_bf16(o[0], o[1]); w.y = cvt_pk_bf16(o[2], o[3]); w.z = cvt_pk_bf16(o[4], o[5]); w.w = cvt_pk_bf16(o[6], o[7]);
                    *(u32x4*)mp = w; }
                if (m & 1) asm volatile("" ::: "memory"); }
    }
};
template <bool FIRST> struct EpiBranch2 {
    const bf16_t* scr; bf16_t* mg;
    __device__ __forceinline__ void operator()(const f32x4 (&acc)[2][2][4][2], const Unit& u, int wr, int wc, int fr0, int fq0) const {
        int fr = fr0, fq = fq0; asm volatile("" : "+v"(fr), "+v"(fq));
        const bf16_t* t = scr + (size_t)(u.pm * 4 + u.pn) * 65536 + (wr * 64 + fr) * 256 + wc * 32 + 8 * fq;
        bf16_t* mp0 = mg + (size_t)(u.pm * BM + wr * 64 + fr) * 1024 + u.pn * BM + wc * 32 + 8 * fq;
        u32x4 gq[2][4], pq[2][4];
#define EB2_ISSUE(G, B) do { _Pragma("unroll") for (int c = 0; c < 4; ++c) { const int ai = (G) >> 1, m = 2 * ((G) & 1) + (c >> 1), bj = c & 1; \
            gq[B][c] = *(const u32x4*)(t + (ai * 128 + m * 16) * 256 + bj * 128); if (!FIRST) pq[B][c] = *(const u32x4*)(mp0 + (size_t)(ai * 128 + m * 16) * 1024 + bj * 128); } } while (0)
        EB2_ISSUE(0, 0);
#pragma unroll
        for (int G = 0; G < 4; ++G) {
            if (G + 1 < 4) { if ((G & 1) == 0) EB2_ISSUE(G + 1, 1); else EB2_ISSUE(G + 1, 0); }
            asm volatile("" ::: "memory");
#pragma unroll
            for (int c = 0; c < 4; ++c) { const int ai = G >> 1, m = 2 * (G & 1) + (c >> 1), bj = c & 1; const u32x4 g = gq[G & 1][c];
                float o[8];
                o[0] = bf_lo(g.x) * acc[ai][bj][m][0][0]; o[1] = bf_hi(g.x) * acc[ai][bj][m][0][1]; o[2] = bf_lo(g.y) * acc[ai][bj][m][0][2]; o[3] = bf_hi(g.y) * acc[ai][bj][m][0][3];
                o[4] = bf_lo(g.z) * acc[ai][bj][m][1][0]; o[5] = bf_hi(g.z) * acc[ai][bj][m][1][1]; o[6] = bf_lo(g.w) * acc[ai][bj][m][1][2]; o[7] = bf_hi(g.w) * acc[ai][bj][m][1][3];
                if (!FIRST) { const u32x4 p = pq[G & 1][c];
                    o[0] += bf_lo(p.x); o[1] += bf_hi(p.x); o[2] += bf_lo(p.y); o[3] += bf_hi(p.y); o[4] += bf_lo(p.z); o[5] += bf_hi(p.z); o[6] += bf_lo(p.w); o[7] += bf_hi(p.w); }
                u32x4 w; w.x = cvt_pk_bf16(o[0], o[1]); w.y = cvt_pk_bf16(o[2], o[3]); w.z = cvt_pk_bf16(o[4], o[5]); w.w = cvt_pk_bf16(o[6], o[7]);
                *(u32x4*)(mp0 + (size_t)(ai * 128 + m * 16) * 1024 + bj * 128) = w; }
            asm volatile("" ::: "memory");
        }
#undef EB2_ISSUE
    }
};
template <size_t O_HB, size_t O_WG, size_t O_A0, size_t O_A1, size_t O_A2, size_t O_WB> struct P7Order {
    StaticOrder T; const char* ws;
    __device__ __forceinline__ bool next(int i, UnitX& u) const { const int rd = i / 6; Unit t; if (!T.next(rd, t)) return false; u.pm = t.pm; u.pn = t.pn; u.kind = i - 6 * rd; u.round = rd; return true; }
    __device__ __forceinline__ OpsX ops(const UnitX& u) const { const int j = u.kind >> 1; OpsX o;
        if (u.kind & 1) { o.K = 512; o.A = ws + (j == 0 ? O_A0 : j == 1 ? O_A1 : O_A2) + (size_t)u.pm * (256 * 512 * 2); o.Bt = ws + O_WB + (size_t)j * (1024 * 512 * 2) + (size_t)u.pn * (256 * 512 * 2); }
        else { o.K = 1024; o.A = ws + O_HB + (size_t)u.pm * (256 * 1024 * 2); o.Bt = ws + O_WG + (size_t)j * (1024 * 1024 * 2) + (size_t)u.pn * (256 * 1024 * 2); }
        return o; }
};
struct EpiP7 {
    bf16_t* scr; bf16_t* mg; const PG8_LAS float* tab;
    __device__ __forceinline__ void operator()(const f32x4 (&acc)[2][2][4][2], const UnitX& u, int wr, int wc, int fr, int fq) const {
        const Unit uu{u.pm, u.pn};
        if (u.kind == 1) { const EpiBranch2<true> b{scr, mg}; b(acc, uu, wr, wc, fr, fq); }
        else if (u.kind & 1) { const EpiBranch2<false> b{scr, mg}; b(acc, uu, wr, wc, fr, fq); }
        else { const EpiGate<16> g{scr, tab, u.round}; g(acc, uu, wr, wc, fr, fq); }
    }
};
struct ProjOut { bf16_t *FQ, *FK, *FV, *DQ, *IQ, *MQ, *DK, *DV, *IK; float *LOGF, *IW; const float *cosT, *sinT, *g_fq, *g_fk, *g_dq, *g_dk, *b_forget; };
__device__ __forceinline__ float log_sigmoid_f(float z) { return z >= 0.f ? -log1pf(expf(-z)) : z - log1pf(expf(z)); }
template <int NP> struct EpiProj {
    static constexpr bool PERM = true, AFTER_DRAIN = false;
    ProjOut P; const PG8_LAS float* tab; float qscale; mutable int ui = 0;
    __device__ __forceinline__ void operator()(const f32x4 (&acc)[2][2][4][2], const Unit& u, int wr, int wc, int fr0, int fq0) const {
        int fr = fr0, fq = fq0; asm volatile("" : "+v"(fr), "+v"(fq));
        float r[2][4]; row_scales_tab(tab, ui++, wr, fr, r);
        const int pn = u.pn;
        bool do_norm = false, do_rope = false; const float* gain = nullptr; bf16_t* dst = nullptr; int pitch = 512, hoff = 0; float osc = 1.f;
        if (pn < 2)       { do_norm = true; gain = P.g_fq; dst = P.FQ; hoff = (4 * pn + wc) * 64; osc = qscale; }
        else if (pn < 4)  { do_norm = true; gain = P.g_fk; dst = P.FK; hoff = (4 * (pn - 2) + wc) * 64; }
        else if (pn < 6)  { dst = P.FV; hoff = (4 * (pn - 4) + wc) * 64; }
        else if (pn < 8)  { do_norm = true; do_rope = true; gain = P.g_dq; dst = P.DQ; hoff = (4 * (pn - 6) + wc) * 64; osc = qscale; }
        else if (pn < 10) { do_rope = true; dst = P.IQ; hoff = (4 * (pn - 8) + wc) * 64; }
        else if (pn < 12) { dst = P.MQ; hoff = (2 * (pn - 10) + (wc >> 1)) * 128 + (wc & 1) * 64; }
        else { pitch = 64;
            if (wc == 0)      { do_norm = true; do_rope = true; gain = P.g_dk; dst = P.DK; }
            else if (wc == 1) { dst = P.DV; }
            else if (wc == 2) { do_rope = true; dst = P.IK; }
            else dst = nullptr; }
        if (dst == nullptr) {
            if (fq < 2) {
#pragma unroll
                for (int ai = 0; ai < 2; ++ai)
#pragma unroll
                    for (int m = 0; m < 4; ++m) { const int row = u.pm * BM + ai * HALF + wr * 64 + m * 16 + fr; const float rr = r[ai][m];
                        f32x4 v0 = acc[ai][0][m][0] * rr, v1 = acc[ai][0][m][1] * rr;
                        if (fq == 0) {
                            const f32x4 b0 = *(const f32x4*)(P.b_forget), b1 = *(const f32x4*)(P.b_forget + 4);
#pragma unroll
                            for (int j = 0; j < 4; ++j) { v0[j] = log_sigmoid_f(v0[j] + b0[j]); v1[j] = log_sigmoid_f(v1[j] + b1[j]); }
                            *(f32x4*)(P.LOGF + (size_t)row * 8) = v0; *(f32x4*)(P.LOGF + (size_t)row * 8 + 4) = v1;
                        } else { const float c = 0.04419417382f; *(f32x4*)(P.IW + (size_t)row * 8) = v0 * c; *(f32x4*)(P.IW + (size_t)row * 8 + 4) = v1 * c; } }
            }
            return;
        }
        const bool ikl = (pn == 12 && wc == 2);
        if (do_norm) { if (do_rope) body<true, true, false>(acc, u, r, gain, dst, pitch, hoff, osc, wr, fr, fq); else body<true, false, false>(acc, u, r, gain, dst, pitch, hoff, osc, wr, fr, fq); }
        else if (do_rope) { if (ikl) body<false, true, true>(acc, u, r, gain, dst, pitch, hoff, osc, wr, fr, fq); else body<false, true, false>(acc, u, r, gain, dst, pitch, hoff, osc, wr, fr, fq); }
        else body<false, false, false>(acc, u, r, gain, dst, pitch, hoff, osc, wr, fr, fq);
    }
    template <bool NORM, bool ROPE, bool IKL>
    __device__ __forceinline__ void body(const f32x4 (&acc)[2][2][4][2], const Unit& u, const float (&r)[2][4], const float* gain, bf16_t* dst, int pitch, int hoff, float osc, int wr, int fr, int fq) const {
        f32x4 gv[2][2];
        if (NORM) {
#pragma unroll
            for (int bj = 0; bj < 2; ++bj)
#pragma unroll
                for (int n = 0; n < 2; ++n) gv[bj][n] = *(const f32x4*)(gain + bj * 32 + 8 * fq + 4 * n);
        }
        f32x4 cq[2][4];
        const int rowb = u.pm * BM + wr * 64 + fr;
#define EP_ISSUE(I, B) do { const size_t ro_ = (size_t)(rowb + ((I) >> 2) * HALF + ((I) & 3) * 16) * 32 + 8 * fq; \
            cq[B][0] = *(const f32x4*)(P.cosT + ro_); cq[B][1] = *(const f32x4*)(P.cosT + ro_ + 4); cq[B][2] = *(const f32x4*)(P.sinT + ro_); cq[B][3] = *(const f32x4*)(P.sinT + ro_ + 4); } while (0)
        if (ROPE) EP_ISSUE(0, 0);
#pragma unroll
        for (int ai = 0; ai < 2; ++ai)
#pragma unroll
            for (int m = 0; m < 4; ++m) {
                const int row = u.pm * BM + ai * HALF + wr * 64 + m * 16 + fr; const float rr = r[ai][m];
                if (ROPE) { if (4 * ai + m + 1 < 8) { if (((4 * ai + m) & 1) == 0) EP_ISSUE(4 * ai + m + 1, 1); else EP_ISSUE(4 * ai + m + 1, 0); } asm volatile("" ::: "memory"); }
                f32x4 v[2][2];
#pragma unroll
                for (int bj = 0; bj < 2; ++bj)
#pragma unroll
                    for (int n = 0; n < 2; ++n) v[bj][n] = acc[ai][bj][m][n] * rr;
                if (NORM) {
                    float ss = 0.f;
#pragma unroll
                    for (int bj = 0; bj < 2; ++bj)
#pragma unroll
                        for (int n = 0; n < 2; ++n) ss += (v[bj][n][0] * v[bj][n][0] + v[bj][n][1] * v[bj][n][1]) + (v[bj][n][2] * v[bj][n][2] + v[bj][n][3] * v[bj][n][3]);
                    ss += __shfl_xor(ss, 16); ss += __shfl_xor(ss, 32);
                    const float inv = __builtin_amdgcn_rsqf(ss * (1.0f / 64.0f) + RMS_EPS);
#pragma unroll
                    for (int bj = 0; bj < 2; ++bj)
#pragma unroll
                        for (int n = 0; n < 2; ++n) v[bj][n] = v[bj][n] * inv * gv[bj][n];
                }
                if (ROPE) {
#pragma unroll
                    for (int n = 0; n < 2; ++n) {
                        const f32x4 c = cq[(4 * ai + m) & 1][n], s = cq[(4 * ai + m) & 1][2 + n];
                        const f32x4 x1 = v[0][n], x2 = v[1][n];
                        v[0][n] = x1 * c - x2 * s; v[1][n] = x2 * c + x1 * s; }
                }
#pragma unroll
                for (int bj = 0; bj < 2; ++bj) {
                    const f32x4 a = v[bj][0] * osc, b = v[bj][1] * osc;
                    u32x4 w; w.x = cvt_pk_bf16(a[0], a[1]); w.y = cvt_pk_bf16(a[2], a[3]); w.z = cvt_pk_bf16(b[0], b[1]); w.w = cvt_pk_bf16(b[2], b[3]);
                    if (IKL) {
                        const int d = bj * 32 + 8 * fq; *(u32x4*)(dst + (size_t)(row >> 5) * 2048 + (d >> 4) * 512 + ((d >> 3) & 1) * 256 + (row & 31) * 8) = w;
                    } else *(u32x4*)(dst + (size_t)row * pitch + hoff + bj * 32 + 8 * fq) = w; }
                if (ROPE) asm volatile("" ::: "memory");
            }
#undef EP_ISSUE
    }
};
}
#define GAS __attribute__((address_space(1)))
#define LAS __attribute__((address_space(3)))
typedef unsigned short bf16;
typedef unsigned v4u __attribute__((ext_vector_type(4)));
typedef float f32x4 __attribute__((ext_vector_type(4)));
typedef short bf16x8 __attribute__((ext_vector_type(8)));
typedef GAS unsigned gu32;
typedef GAS unsigned long long gu64;
#define RLX_AGENT __ATOMIC_RELAXED, __HIP_MEMORY_SCOPE_AGENT
#define LDS_WAIT() asm volatile("s_waitcnt lgkmcnt(0)" ::: "memory")
#define VM_WAIT() asm volatile("s_waitcnt vmcnt(0)" ::: "memory")
__device__ __forceinline__ unsigned long long rt() { return __builtin_amdgcn_s_memrealtime(); }
__device__ __forceinline__ unsigned f2bf(float f) { unsigned u = __builtin_bit_cast(unsigned, f); return (u + 0x7fffu + ((u >> 16) & 1u)) >> 16; }
__device__ __forceinline__ unsigned pk2(float lo, float hi) { return f2bf(lo) | (f2bf(hi) << 16); }
typedef float f32x2g __attribute__((ext_vector_type(2)));
__device__ __forceinline__ float bf_lo32(unsigned w) { return __uint_as_float(w << 16); }
__device__ __forceinline__ float bf_hi32(unsigned w) { return __uint_as_float(w & 0xffff0000u); }
constexpr int NWAVES = 8;
constexpr int BATCH = 2, SEQ = 8192, DM = 1024, T = BATCH * SEQ, DFF = 2816, MEMLEN = 256, BW = 512, DIN = 6352;
constexpr int NPROJ = 13 * 256, NGATE = 3072;
constexpr float L2E = 1.4426950408889634f;
constexpr float C2_64 = 0.125f * L2E;
constexpr float C2_128 = 0.08838834764831845f * L2E;
constexpr size_t MiB = 1u << 20;
constexpr size_t WS_CTL = 0, CTL_ZERO_BYTES = 128 * 1024;
constexpr size_t WS_RSTDX = 1 * MiB;
constexpr size_t WS_RSTDM = WS_RSTDX + 64 * 1024;
constexpr size_t WS_T0 = WS_RSTDM + 4096;
constexpr size_t WS_SSQ1 = 2 * MiB;
constexpr size_t WS_SSQ2 = 3 * MiB;
constexpr size_t WS_LOGF = 4 * MiB;
constexpr size_t WS_CUM = WS_LOGF + 512 * 1024;
constexpr size_t WS_IW = 5 * MiB;
constexpr size_t WS_COS = 6 * MiB, WS_SIN = 8 * MiB;
constexpr size_t WS_MEMB = 10 * MiB;
constexpr size_t WS_KVM = 11 * MiB;
constexpr size_t WS_KMB = 13 * MiB, WS_VMB = 14 * MiB;
constexpr size_t WS_WGU1 = 16 * MiB;
constexpr size_t WS_WD1 = 27 * MiB;
constexpr size_t WS_WIN = 33 * MiB;
constexpr size_t WS_WGATE = 40 * MiB;
constexpr size_t WS_WBR = 46 * MiB;
constexpr size_t WS_WOUT = 49 * MiB;
constexpr size_t WS_WGU2 = 51 * MiB;
constexpr size_t WS_WD2 = 62 * MiB;
constexpr size_t WS_WMKV = 68 * MiB;
constexpr size_t WS_HB = 70 * MiB;
constexpr size_t WS_ACT = 102 * MiB;
constexpr size_t WS_HID = WS_ACT;
constexpr size_t WS_FQ = WS_ACT, WS_FK = WS_ACT + 16 * MiB, WS_FV = WS_ACT + 32 * MiB, WS_DQ = WS_ACT + 48 * MiB, WS_IQ = WS_ACT + 64 * MiB, WS_MQ = WS_ACT + 80 * MiB;
constexpr size_t WS_DK = WS_ACT + 96 * MiB, WS_DV = WS_ACT + 98 * MiB, WS_IK = WS_ACT + 100 * MiB;
#if defined(DBG_SUBST) && DBG_SUBST == 2
constexpr size_t WS_MERGED = WS_DQ;
#else
constexpr size_t WS_MERGED = WS_FK;
#endif
#ifdef DBG_GSCR_AT
constexpr size_t WS_GSCR = DBG_GSCR_AT;
#else
constexpr size_t WS_GSCR = 204 * MiB;
#endif
constexpr size_t WS_OA = 236 * MiB;
constexpr size_t WS_OB = 16 * MiB;
constexpr size_t WS_END = 252 * MiB;
#ifndef DBG_GSCR_AT
static_assert(WS_HID + (size_t)T * DFF * 2 <= WS_GSCR && WS_IK + (size_t)T * 64 * 2 <= WS_GSCR, "d_ws map");
#endif
constexpr int CW_BAR = 4096;
constexpr int CW_Q = 16384;
constexpr int RING_OFF = 0, RING_BYTES = 131072;
constexpr int LDSCTL_OFF = RING_BYTES, MISC_OFF = LDSCTL_OFF + 320;
constexpr int LIST_OFF = RING_BYTES + 1024;
constexpr int SCANX_OFF = RING_BYTES + 6144;
constexpr int LDS_BYTES = 163840;
#define XB_TMO      128
#define XB_XCNT(j)  (256  + 64 * (j))
#define XB_XSUB(j)  (1280 + 64 * (j))
#define XB_XGEN(j)  (2304 + 64 * (j))
#define XB_TOP      3328
#define XB_TOPGEN   3392
#define XCD_BAR_WORDS 3456
#define XB_SPIN_CAP (1u << 18)

__device__ __forceinline__ unsigned xb_ld(unsigned* p)              { return __hip_atomic_load(p, __ATOMIC_RELAXED, __HIP_MEMORY_SCOPE_AGENT); }
__device__ __forceinline__ unsigned xb_add(unsigned* p, unsigned v) { return __hip_atomic_fetch_add(p, v, __ATOMIC_RELAXED, __HIP_MEMORY_SCOPE_AGENT); }
__device__ __forceinline__ unsigned xb_xcc_id() { return (unsigned)__builtin_amdgcn_s_getreg((3 << 11) | 20) & 0xFu; }
#define XB_SPIN(cond, bar) do { unsigned _sp = 0; while (cond) { __builtin_amdgcn_s_sleep(1); \
    if ((++_sp & 255u) == 0u) { if (xb_ld(&(bar)[XB_TMO])) break; if (_sp > XB_SPIN_CAP) { atomicAdd(&(bar)[XB_TMO], 1u); break; } } } } while (0)

struct XcdBarrier {
    unsigned* bar; unsigned x;
    volatile LAS unsigned* st;
};

__device__ __forceinline__ XcdBarrier xcd_barrier_post(unsigned* bar, volatile LAS unsigned* st) {
    XcdBarrier b; b.bar = bar; b.x = xb_xcc_id(); b.st = st;
    if (threadIdx.x == 0) (void)xb_add(&bar[XB_XCNT(b.x)], 1u);
    return b;
}
__device__ __forceinline__ void xcd_barrier_complete(unsigned* bar, unsigned x, unsigned& nloc, unsigned& nx) {
    const unsigned G = gridDim.x * gridDim.y * gridDim.z;
    unsigned sum, cnt, mine, sp = 0u;
    for (;;) {
        sum = 0u; cnt = 0u; mine = 0u;
#pragma unroll
        for (unsigned j = 0; j < 16; ++j) { const unsigned c = xb_ld(&bar[XB_XCNT(j)]); sum += c; cnt += (c > 0u) ? 1u : 0u; mine = (j == x) ? c : mine; }
        if (sum == G) break;
        __builtin_amdgcn_s_sleep(1);
        if ((++sp & 255u) == 0u) { if (xb_ld(&bar[XB_TMO])) break; if (sp > XB_SPIN_CAP) { atomicAdd(&bar[XB_TMO], 1u); break; } }
    }
    nloc = mine > 0u ? mine : 1u; nx = cnt > 0u ? cnt : 1u;
}

__device__ __forceinline__ void xcd_barrier(const XcdBarrier& b) {
    asm volatile("s_waitcnt vmcnt(0)" ::: "memory");
    __syncthreads();
    if (threadIdx.x == 0) {
        unsigned* bar = b.bar;
        __builtin_amdgcn_s_waitcnt(0);
        unsigned nloc = b.st[0], nx = b.st[1];
        if (nloc == 0u) { xcd_barrier_complete(bar, b.x, nloc, nx); b.st[0] = nloc; b.st[1] = nx; }
        const unsigned old = xb_add(&bar[XB_XSUB(b.x)], 1u);
        const unsigned gen = old / nloc;
        if (old + 1u == (gen + 1u) * nloc) {
            __builtin_amdgcn_fence(__ATOMIC_RELEASE, "agent");
            asm volatile("s_waitcnt vmcnt(0)" ::: "memory");
            const unsigned og = xb_add(&bar[XB_TOP], 1u);
            const unsigned tg = og / nx;
            if (og + 1u == (tg + 1u) * nx) xb_add(&bar[XB_TOPGEN], 1u);
            else XB_SPIN(xb_ld(&bar[XB_TOPGEN]) == tg, bar);
            __builtin_amdgcn_fence(__ATOMIC_ACQUIRE, "agent");
            xb_add(&bar[XB_XGEN(b.x)], 1u);
            asm volatile("s_waitcnt vmcnt(0)" ::: "memory");
        } else {
            XB_SPIN(xb_ld(&bar[XB_XGEN(b.x)]) == gen, bar);
            __builtin_amdgcn_fence(__ATOMIC_ACQUIRE, "agent");
            asm volatile("s_waitcnt vmcnt(0)" ::: "memory");
        }
    }
    __syncthreads();
}
__device__ __forceinline__ float wave_sum(float v) {
#pragma unroll
    for (int o = 1; o < 64; o <<= 1) v += __shfl_xor(v, o);
    return v;
}
__device__ __forceinline__ float wave_max(float v) {
#pragma unroll
    for (int o = 1; o < 64; o <<= 1) v = fmaxf(v, __shfl_xor(v, o));
    return v;
}
__device__ __forceinline__ int colmap(int mat, int n) {
    if (mat == 1) return n;
    if (mat == 3) return 3280 + n;
    const int tile = n >> 8, t = n & 255;
    if (mat == 0) return (t < 128 ? 0 : DFF) + 128 * tile + (t & 127);
    const int bj = t >> 7, wc = (t >> 5) & 3, i = t & 31, d = bj * 32 + i;
    if (tile < 2) return 0 + (4 * tile + wc) * 64 + d;
    if (tile < 4) return 512 + (4 * (tile - 2) + wc) * 64 + d;
    if (tile < 6) return 1024 + (4 * (tile - 4) + wc) * 64 + d;
    if (tile < 8) return 1544 + (4 * (tile - 6) + wc) * 64 + d;
    if (tile < 10) return 2184 + (4 * (tile - 8) + wc) * 64 + d;
    if (tile < 12) return 2768 + (2 * (tile - 10) + (wc >> 1)) * 128 + (wc & 1) * 64 + d;
    if (wc == 0) return 2056 + d;
    if (wc == 1) return 2120 + d;
    if (wc == 2) return 2696 + d;
    if (bj == 0 && i < 8) return 1536 + i;
    if (bj == 0 && i < 16) return 2760 + (i - 8);
    return -1;
}
template <bool GAIN> __device__ __forceinline__ void transpose_item(int mat, const float* Wa, const float* Wb, int K, int Nsrc, const float* gain, bf16* WT, LAS float* scr, int item, int nblk, int lane) {
    const int kb = item / nblk, nb = item % nblk, k0 = 64 * kb, n0 = 32 * nb;
    int col = colmap(mat, n0 + (lane & 31)); const float* W = Wa;
    if (mat == 0 && col >= DFF) { W = Wb; col -= DFF; }
    const bool okc = col >= 0; const float* wp = W + (size_t)(k0 + (lane >> 5)) * Nsrc + (okc ? col : 0); const float* gp = gain + k0 + (lane >> 5);
    float v[32];
#pragma unroll
    for (int i = 0; i < 32; ++i) v[i] = wp[(size_t)(2 * i) * Nsrc];
    if (GAIN) {
#pragma unroll
        for (int i = 0; i < 32; ++i) v[i] *= gp[2 * i]; }
#pragma unroll
    for (int i = 0; i < 32; ++i) scr[(2 * i + (lane >> 5)) * 33 + (lane & 31)] = okc ? v[i] : 0.f;
    LDS_WAIT(); asm volatile("" ::: "memory");
    const int c = lane & 7;
#pragma unroll
    for (int j = 0; j < 4; ++j) { const int n = (lane >> 3) + 8 * j; const LAS float* s = scr + (8 * c) * 33 + n;
        v4u o; o.x = pk2(s[0 * 33], s[1 * 33]); o.y = pk2(s[2 * 33], s[3 * 33]); o.z = pk2(s[4 * 33], s[5 * 33]); o.w = pk2(s[6 * 33], s[7 * 33]);
        *(GAS v4u*)(WT + (size_t)(n0 + n) * K + k0 + 8 * c) = o; }
    LDS_WAIT(); asm volatile("" ::: "memory");
}
__device__ __forceinline__ void row_to_bf16_rstd(const float* xrow, bf16* orow, float* rstd_out, int lane) {
    const GAS f32x4* xr = (const GAS f32x4*)xrow + lane;
    f32x4 v[4]; float s = 0.f;
#pragma unroll
    for (int j = 0; j < 4; ++j) { v[j] = xr[64 * j]; s += (v[j].x * v[j].x + v[j].y * v[j].y) + (v[j].z * v[j].z + v[j].w * v[j].w); }
    const float rstd = 1.0f / sqrtf(wave_sum(s) * (1.f / 1024.f) + 1e-6f);
    GAS unsigned long long* o8 = (GAS unsigned long long*)orow + lane;
#pragma unroll
    for (int j = 0; j < 4; ++j) o8[64 * j] = (unsigned long long)pk2(v[j].x, v[j].y) | ((unsigned long long)pk2(v[j].z, v[j].w) << 32);
    if (lane == 0) *rstd_out = rstd;
}
__device__ __forceinline__ void rows4_to_bf16_rstd(const float* const (&xrow)[4], bf16* const (&orow)[4], float* const (&rout)[4], const bool (&ok)[4], int lane) {
    f32x4 v[4][4];
#pragma unroll
    for (int r = 0; r < 4; ++r) { const GAS f32x4* xr = (const GAS f32x4*)xrow[r] + lane;
#pragma unroll
        for (int j = 0; j < 4; ++j) v[r][j] = xr[64 * j]; }
#pragma unroll
    for (int r = 0; r < 4; ++r) { float s = 0.f;
#pragma unroll
        for (int j = 0; j < 4; ++j) s += (v[r][j].x * v[r][j].x + v[r][j].y * v[r][j].y) + (v[r][j].z * v[r][j].z + v[r][j].w * v[r][j].w);
        const float rstd = 1.0f / sqrtf(wave_sum(s) * (1.f / 1024.f) + 1e-6f);
        if (ok[r]) { GAS unsigned long long* o8 = (GAS unsigned long long*)orow[r] + lane;
#pragma unroll
            for (int j = 0; j < 4; ++j) o8[64 * j] = (unsigned long long)pk2(v[r][j].x, v[r][j].y) | ((unsigned long long)pk2(v[r][j].z, v[r][j].w) << 32);
            if (lane == 0) *rout[r] = rstd; } }
}
typedef float f32x16 __attribute__((ext_vector_type(16)));
typedef unsigned u32x2 __attribute__((ext_vector_type(2)));
__device__ __forceinline__ int crow(int r, int hi) { return (r & 3) + 8 * (r >> 2) + 4 * hi; }
__device__ __forceinline__ float bf2f(bf16 v) { return __uint_as_float((unsigned)v << 16); }
__device__ __forceinline__ unsigned cvtpk(float lo, float hi) { return pg8::cvt_pk_bf16(lo, hi); }
template <int HD, bool FOX, bool VT>
__device__ __forceinline__ void attn_wave_simple(const bf16x8 (&qr)[HD / 16], const bf16* Kp, int kpitch, const bf16* Vp, int vpitch, int tstart, int ntiles, int qlocal, const float* cb, bf16* Op, int opitch, int lane) {
    const int r32 = lane & 31, hi = lane >> 5;
    f32x16 o[HD / 32];
#pragma unroll
    for (int d0 = 0; d0 < HD / 32; ++d0)
#pragma unroll
        for (int r = 0; r < 16; ++r) o[d0][r] = 0.f;
    float m = -1e30f, l = 0.f;
    for (int t = tstart; t < ntiles; ++t) {
        const int kv0 = 32 * t;
        f32x16 p;
#pragma unroll
        for (int r = 0; r < 16; ++r) p[r] = 0.f;
        const bf16* kr = Kp + (size_t)(kv0 + r32) * kpitch + hi * 8;
#pragma unroll
        for (int ks = 0; ks < HD / 16; ++ks) { const bf16x8 kf = *(const bf16x8*)(kr + ks * 16); p = __builtin_amdgcn_mfma_f32_32x32x16_bf16(kf, qr[ks], p, 0, 0, 0); }
        if (FOX) {
#pragma unroll
            for (int g = 0; g < 4; ++g) { const f32x4 c4 = *(const f32x4*)(cb + kv0 + 8 * g + 4 * hi);
#pragma unroll
                for (int jj = 0; jj < 4; ++jj) p[4 * g + jj] -= L2E * c4[jj]; }
            if (t == ntiles - 1) {
#pragma unroll
                for (int r = 0; r < 16; ++r) if (kv0 + crow(r, hi) > qlocal) p[r] = -INFINITY;
            }
        }
        float mt = p[0];
#pragma unroll
        for (int r = 1; r < 16; ++r) mt = fmaxf(mt, p[r]);
        mt = fmaxf(mt, __shfl_xor(mt, 32));
        const float mn = fmaxf(m, mt); const float alpha = __builtin_amdgcn_exp2f(m - mn); m = mn;
        l *= alpha;
#pragma unroll
        for (int d0 = 0; d0 < HD / 32; ++d0)
#pragma unroll
            for (int r = 0; r < 16; ++r) o[d0][r] *= alpha;
        float ls = 0.f;
#pragma unroll
        for (int r = 0; r < 16; ++r) { p[r] = __builtin_amdgcn_exp2f(p[r] - mn); ls += p[r]; }
        l += ls;
        bf16x8 pa[2];
#pragma unroll
        for (int s = 0; s < 2; ++s) { v4u w; w.x = cvtpk(p[8 * s + 0], p[8 * s + 1]); w.y = cvtpk(p[8 * s + 2], p[8 * s + 3]); w.z = cvtpk(p[8 * s + 4], p[8 * s + 5]); w.w = cvtpk(p[8 * s + 6], p[8 * s + 7]); pa[s] = __builtin_bit_cast(bf16x8, w); }
#pragma unroll
        for (int d0 = 0; d0 < HD / 32; ++d0)
#pragma unroll
            for (int s = 0; s < 2; ++s) {
                bf16x8 vf;
                if (VT) {
                    const bf16* vp = Vp + (size_t)(d0 * 32 + r32) * vpitch + kv0 + 16 * s + 4 * hi;
                    const u32x2 lo = *(const u32x2*)vp, hi2 = *(const u32x2*)(vp + 8);
                    vf = __builtin_bit_cast(bf16x8, (v4u){lo.x, lo.y, hi2.x, hi2.y});
                } else {
#pragma unroll
                    for (int j = 0; j < 8; ++j) vf[j] = (short)Vp[(size_t)(kv0 + 16 * s + 8 * (j >> 2) + 4 * hi + (j & 3)) * vpitch + d0 * 32 + r32];
                }
                o[d0] = __builtin_amdgcn_mfma_f32_32x32x16_bf16(vf, pa[s], o[d0], 0, 0, 0);
            }
    }
    l += __shfl_xor(l, 32);
    const float inv = 1.0f / l;
    bf16* orow = Op + (size_t)r32 * opitch;
#pragma unroll
    for (int d0 = 0; d0 < HD / 32; ++d0)
#pragma unroll
        for (int g = 0; g < 4; ++g) { u32x2 w; w.x = cvtpk(o[d0][4 * g] * inv, o[d0][4 * g + 1] * inv); w.y = cvtpk(o[d0][4 * g + 2] * inv, o[d0][4 * g + 3] * inv);
            *(u32x2*)(orow + d0 * 32 + 8 * g + 4 * hi) = w; }
}
__device__ __forceinline__ void fox_unit(int bh, int qb, const bf16* FQ, const bf16* FK, const bf16* FV, const float* CUM, const int* T0, bf16* OA, int wave, int lane) {
    const int b = bh >> 3, h = bh & 7, r32 = lane & 31, hi = lane >> 5; const size_t rowbase = (size_t)b * SEQ; const int q0 = qb * 256 + wave * 32;
    const bf16* Qw = FQ + (rowbase + q0) * 512 + h * 64; bf16* Ow = OA + (rowbase + q0) * 512 + h * 64;
    bf16x8 qr[4];
#pragma unroll
    for (int ks = 0; ks < 4; ++ks) qr[ks] = *(const bf16x8*)(Qw + (size_t)r32 * 512 + ks * 16 + hi * 8);
    attn_wave_simple<64, true, false>(qr, FK + rowbase * 512 + h * 64, 512, FV + rowbase * 512 + h * 64, 512, T0[bh * 256 + q0 / 32], q0 / 32 + 1, q0 + r32, CUM + (size_t)bh * SEQ, Ow, 512, lane);
}
__device__ __forceinline__ void mem_unit(int rg, int head, bf16* MQ, const bf16* KMB, const bf16* VMB, const float* gq, int lane) {
    const int r32 = lane & 31, hi = lane >> 5; const int row0 = rg * 32; const int b = row0 / SEQ;
    bf16* Qw = MQ + (size_t)row0 * 512 + head * 128;
    bf16x8 raw[8]; float ss = 0.f;
#pragma unroll
    for (int ks = 0; ks < 8; ++ks) { raw[ks] = *(const bf16x8*)(Qw + (size_t)r32 * 512 + ks * 16 + hi * 8);
#pragma unroll
        for (int j = 0; j < 8; ++j) { const float f = bf2f((bf16)raw[ks][j]); ss += f * f; } }
    ss += __shfl_xor(ss, 32);
    const float rstd = __builtin_amdgcn_rsqf(ss * (1.0f / 128.0f) + 1e-6f) * C2_128;
    bf16x8 qr[8];
#pragma unroll
    for (int ks = 0; ks < 8; ++ks) { const f32x4 g0 = *(const f32x4*)(gq + ks * 16 + hi * 8), g1 = *(const f32x4*)(gq + ks * 16 + hi * 8 + 4); v4u w;
        w.x = cvtpk(bf2f((bf16)raw[ks][0]) * rstd * g0[0], bf2f((bf16)raw[ks][1]) * rstd * g0[1]); w.y = cvtpk(bf2f((bf16)raw[ks][2]) * rstd * g0[2], bf2f((bf16)raw[ks][3]) * rstd * g0[3]);
        w.z = cvtpk(bf2f((bf16)raw[ks][4]) * rstd * g1[0], bf2f((bf16)raw[ks][5]) * rstd * g1[1]); w.w = cvtpk(bf2f((bf16)raw[ks][6]) * rstd * g1[2], bf2f((bf16)raw[ks][7]) * rstd * g1[3]);
        qr[ks] = __builtin_bit_cast(bf16x8, w); }
    attn_wave_simple<128, false, true>(qr, KMB + (size_t)b * MEMLEN * 512 + head * 128, 512, VMB + (size_t)(b * 4 + head) * 128 * MEMLEN, MEMLEN, 0, MEMLEN / 32, 0, nullptr, Qw, 512, lane);
}
typedef short v4i16_t __attribute__((ext_vector_type(4)));
__device__ __forceinline__ void mem_block(int u, bf16* MQ, const bf16* KMB, const bf16* VNB, const float* gq, LAS unsigned char* lds, int wave, int lane, int tid) {
    const int head = u & 3, rg = (u >> 2) * 8 + wave, row0 = rg * 32, b = row0 / SEQ;
    const int r32 = lane & 31, hi = lane >> 5;
    {   const bf16* ks_ = KMB + (size_t)b * MEMLEN * 512 + head * 128; const bf16* vs_ = VNB + (size_t)b * MEMLEN * 512 + head * 128;
#pragma unroll
        for (int i = 0; i < 8; ++i) { const int e = tid + 512 * i, key = e >> 4, c = e & 15;
            const v4u kv = *(const v4u*)(ks_ + (size_t)key * 512 + c * 8), vv = *(const v4u*)(vs_ + (size_t)key * 512 + c * 8);
            *(LAS v4u*)(lds + key * 256 + ((c ^ (key & 7)) * 16)) = kv; *(LAS v4u*)(lds + 65536 + key * 256 + c * 16) = vv; } }
    bf16* Qw = MQ + (size_t)row0 * 512 + head * 128;
    bf16x8 raw[8]; float ss = 0.f;
#pragma unroll
    for (int ks = 0; ks < 8; ++ks) { raw[ks] = *(const bf16x8*)(Qw + (size_t)r32 * 512 + ks * 16 + hi * 8);
#pragma unroll
        for (int j = 0; j < 8; ++j) { const float f = bf2f((bf16)raw[ks][j]); ss += f * f; } }
    ss += __shfl_xor(ss, 32);
    const float rstd = __builtin_amdgcn_rsqf(ss * (1.0f / 128.0f) + 1e-6f) * C2_128;
    bf16x8 qr[8];
#pragma unroll
    for (int ks = 0; ks < 8; ++ks) { const f32x4 g0 = *(const f32x4*)(gq + ks * 16 + hi * 8), g1 = *(const f32x4*)(gq + ks * 16 + hi * 8 + 4); v4u w;
        w.x = cvtpk(bf2f((bf16)raw[ks][0]) * rstd * g0[0], bf2f((bf16)raw[ks][1]) * rstd * g0[1]); w.y = cvtpk(bf2f((bf16)raw[ks][2]) * rstd * g0[2], bf2f((bf16)raw[ks][3]) * rstd * g0[3]);
        w.z = cvtpk(bf2f((bf16)raw[ks][4]) * rstd * g1[0], bf2f((bf16)raw[ks][5]) * rstd * g1[1]); w.w = cvtpk(bf2f((bf16)raw[ks][6]) * rstd * g1[2], bf2f((bf16)raw[ks][7]) * rstd * g1[3]);
        qr[ks] = __builtin_bit_cast(bf16x8, w); }
    __syncthreads();
    f32x16 o[4];
#pragma unroll
    for (int d0 = 0; d0 < 4; ++d0)
#pragma unroll
        for (int r = 0; r < 16; ++r) o[d0][r] = 0.f;
    float m = -1e30f, l = 0.f;
    const int kq = (lane >> 4) & 1, q_ = (lane & 15) >> 2, p_ = lane & 3;
#pragma unroll 1
    for (int t = 0; t < MEMLEN / 32; ++t) {
        const LAS unsigned char* kb = lds + (32 * t) * 256; const LAS unsigned char* vb = lds + 65536 + (32 * t) * 256;
        f32x16 p;
#pragma unroll
        for (int r = 0; r < 16; ++r) p[r] = 0.f;
#pragma unroll
        for (int ks = 0; ks < 8; ++ks) { const bf16x8 kf = *(const LAS bf16x8*)(kb + r32 * 256 + (((2 * ks + hi) ^ (r32 & 7)) * 16)); p = __builtin_amdgcn_mfma_f32_32x32x16_bf16(kf, qr[ks], p, 0, 0, 0); }
        float mt = p[0];
#pragma unroll
        for (int r = 1; r < 16; ++r) mt = fmaxf(mt, p[r]);
        mt = fmaxf(mt, __shfl_xor(mt, 32));
        if (__any(mt > m)) { const float mn_ = fmaxf(m, mt); const float alpha = __builtin_amdgcn_exp2f(m - mn_); m = mn_; l *= alpha;
#pragma unroll
            for (int d0 = 0; d0 < 4; ++d0)
#pragma unroll
                for (int r = 0; r < 16; ++r) o[d0][r] *= alpha; }
        const float mn = m; float ls = 0.f;
#pragma unroll
        for (int r = 0; r < 16; ++r) { p[r] = __builtin_amdgcn_exp2f(p[r] - mn); ls += p[r]; }
        l += ls;
        bf16x8 pa[2];
#pragma unroll
        for (int s2 = 0; s2 < 2; ++s2) { v4u w; w.x = cvtpk(p[8 * s2 + 0], p[8 * s2 + 1]); w.y = cvtpk(p[8 * s2 + 2], p[8 * s2 + 3]); w.z = cvtpk(p[8 * s2 + 4], p[8 * s2 + 5]); w.w = cvtpk(p[8 * s2 + 6], p[8 * s2 + 7]); pa[s2] = __builtin_bit_cast(bf16x8, w); }
#pragma unroll
        for (int d0 = 0; d0 < 4; ++d0)
#pragma unroll
            for (int s2 = 0; s2 < 2; ++s2) {
                const LAS unsigned char* a1 = vb + (16 * s2 + 4 * hi + q_) * 256 + (32 * d0 + 16 * kq + 4 * p_) * 2;
                const v4i16_t lo4 = __builtin_amdgcn_ds_read_tr16_b64_v4i16((LAS v4i16_t*)a1), hi4 = __builtin_amdgcn_ds_read_tr16_b64_v4i16((LAS v4i16_t*)(a1 + 8 * 256));
                const bf16x8 vf = (bf16x8){lo4[0], lo4[1], lo4[2], lo4[3], hi4[0], hi4[1], hi4[2], hi4[3]};
                o[d0] = __builtin_amdgcn_mfma_f32_32x32x16_bf16(vf, pa[s2], o[d0], 0, 0, 0); }
    }
    l += __shfl_xor(l, 32);
    const float inv = 1.0f / l;
    bf16* orow = Qw + (size_t)r32 * 512;
#pragma unroll
    for (int d0 = 0; d0 < 4; ++d0)
#pragma unroll
        for (int g = 0; g < 4; ++g) { u32x2 w; w.x = cvtpk(o[d0][4 * g] * inv, o[d0][4 * g + 1] * inv); w.y = cvtpk(o[d0][4 * g + 2] * inv, o[d0][4 * g + 3] * inv);
            *(u32x2*)(orow + d0 * 32 + 8 * g + 4 * hi) = w; }
    __syncthreads();
}
__device__ __forceinline__ void scan_unit(int bh, const float* LOGF, float* CUM, int* T0, const float* gq, const float* gk, LAS float* sx, LAS float* cl, int tid) {
    const int b = bh >> 3, h = bh & 7, lane = tid & 63, wave = tid >> 6;
    float v[16]; float run = 0.f;
#pragma unroll
    for (int i = 0; i < 16; ++i) v[i] = LOGF[((size_t)b * SEQ + 16 * tid + i) * 8 + h];
#pragma unroll
    for (int i = 0; i < 16; ++i) { run += v[i]; v[i] = run; }
    float tot = run;
#pragma unroll
    for (int off = 1; off < 64; off <<= 1) { const float nb = __shfl_up(tot, off); if (lane >= off) tot += nb; }
    if (lane == 63) sx[wave] = tot;
    __syncthreads();
    float woff = 0.f;
    for (int w = 0; w < wave; ++w) woff += sx[w];
    const float excl = tot - run + woff;
    float* dst = CUM + (size_t)bh * SEQ + 16 * tid;
#pragma unroll
    for (int i = 0; i < 16; i += 4) { const f32x4 o4 = (f32x4){v[i] + excl, v[i + 1] + excl, v[i + 2] + excl, v[i + 3] + excl}; *(f32x4*)(dst + i) = o4; *(LAS f32x4*)(cl + 16 * tid + i) = o4; }
    const float smax = 8.0f * wave_max(fabsf(gq[lane])) * wave_max(fabsf(gk[lane]));
    __syncthreads();
    if (tid < 256) { const float cq = cl[32 * tid]; const float lim = -(30.0f + 2.0f * smax);
        int lo = 0, hi = tid;
        while (lo < hi) { const int mid = (lo + hi) >> 1; if (cq - cl[32 * mid + 31] >= lim) hi = mid; else lo = mid + 1; }
        T0[bh * 256 + tid] = lo; }
    __syncthreads();
}
constexpr int D2_LST = RING_BYTES + 1024;
constexpr int D2_CNT = RING_BYTES + 3072;
constexpr int D2_CL = RING_BYTES + 4096;
typedef float f32x4d __attribute__((ext_vector_type(4)));
__device__ __forceinline__ unsigned sortable_u32(float f) { const unsigned u = __float_as_uint(f); return u ^ ((u >> 31) ? 0xFFFFFFFFu : 0x80000000u); }
__device__ __forceinline__ int lane_rank(unsigned long long mask) { return (int)__builtin_amdgcn_mbcnt_hi((unsigned)(mask >> 32), __builtin_amdgcn_mbcnt_lo((unsigned)mask, 0u)); }
__device__ __forceinline__ int bcount(bool p) { return (int)__popcll(__ballot(p)); }
__device__ __forceinline__ void select_full(const LAS unsigned* my, int npad, LAS unsigned short* lst, int lane) {
    unsigned thr = 0u;
    for (int bit = 31; bit >= 0; --bit) {
        const unsigned cand = thr | (1u << bit); int cnt = 0;
        for (int i0 = 0; i0 < npad; i0 += 256) { const int idx = i0 + 4 * lane; v4u v = (v4u){0u, 0u, 0u, 0u}; if (idx < npad) v = *(const LAS v4u*)(my + idx);
            cnt += bcount(v.x >= cand) + bcount(v.y >= cand) + bcount(v.z >= cand) + bcount(v.w >= cand); }
        if (cnt >= 256) thr = cand;
    }
    int cgt = 0;
    for (int i0 = 0; i0 < npad; i0 += 256) { const int idx = i0 + 4 * lane; v4u v = (v4u){0u, 0u, 0u, 0u}; if (idx < npad) v = *(const LAS v4u*)(my + idx);
        cgt += bcount(v.x > thr) + bcount(v.y > thr) + bcount(v.z > thr) + bcount(v.w > thr); }
    const int quota = 256 - cgt; int eqseen = 0, nsel = 0;
    for (int base = 0; base < npad; base += 64) { const int idx = base + lane; unsigned u = 0u; if (idx < npad) u = my[idx];
        const bool gt = u > thr, eq = (u == thr);
        const unsigned long long em = __ballot(eq); const int er = eqseen + lane_rank(em);
        const bool sel = gt || (eq && er < quota);
        const unsigned long long sm = __ballot(sel); const int pos = nsel + lane_rank(sm);
        if (sel && pos < 256) lst[pos] = (unsigned short)idx;
        nsel += __popcll(sm); eqseen += __popcll(em); }
}
template <int KMAX> __device__ __forceinline__ void select_cands(const unsigned (&uu)[16], const unsigned (&id)[16], LAS unsigned short* lst, int lane, unsigned lb = 0u) {
    unsigned thr = 0u;
    for (int bit = 31; bit >= 0; --bit) {
        if ((((thr ^ lb) >> bit) >> 1) == 0u && ((lb >> bit) & 1u)) { thr |= (1u << bit); continue; }
        const unsigned cand = thr | (1u << bit); int cnt = 0;
#pragma unroll
        for (int k = 0; k < KMAX; ++k) cnt += bcount(uu[k] >= cand);
        if (cnt >= 256) { thr = cand; if (cnt == 256) break; }
    }
    int cgt = 0, ceq = 0;
#pragma unroll
    for (int k = 0; k < KMAX; ++k) { cgt += bcount(uu[k] > thr); ceq += bcount(uu[k] == thr); }
    const int quota = 256 - cgt; unsigned ilim = 0xFFFFu;
    if (ceq != quota) {
        unsigned I = 0u;
        for (int bit = 12; bit >= 0; --bit) { const unsigned cand = I | (1u << bit); int cnt = 0;
#pragma unroll
            for (int k = 0; k < KMAX; ++k) cnt += bcount(uu[k] == thr && id[k] < cand);
            if (cnt < quota) I = cand; }
        ilim = I;
    }
    int nsel = 0;
#pragma unroll
    for (int k = 0; k < KMAX; ++k) { const bool sel = (uu[k] > thr) || (uu[k] == thr && id[k] <= ilim);
        const unsigned long long sm = __ballot(sel); const int pos = nsel + lane_rank(sm);
        if (sel && pos < 256) lst[pos] = (unsigned short)id[k];
        nsel += __popcll(sm); }
}
__device__ __forceinline__ void dsa2_unit(int b, int qg, const bf16* IQ, const bf16* IK, const float* IW, const bf16* DQ, const bf16* DK, const bf16* DV, bf16* OB, LAS unsigned char* lds, int wave, int lane) {
    LAS unsigned* sc = (LAS unsigned*)lds;
    LAS unsigned short* LST = (LAS unsigned short*)(lds + D2_LST);
    LAS int* CNT = (LAS int*)(lds + D2_CNT);
    LAS unsigned short* CL = (LAS unsigned short*)(lds + D2_CL);
    const int q0 = 4 * qg, r32 = lane & 31, hi = lane >> 5; const size_t rowbase = (size_t)b * SEQ;
    const int ntile = (q0 + 3) / 32 + 1, npad = ntile * 32;
#ifndef REP_A
#define REP_A 1
#define REP_B1 1
#define REP_B2 1
#define REP_C 1
#endif
    for (int repa = 0; repa < REP_A; ++repa)
    {
        const int qi = 2 * ((r32 >> 2) & 1) + (r32 >> 4), hd = 4 * ((r32 >> 3) & 1) + (r32 & 3);
        bf16x8 aq[4];
#pragma unroll
        for (int ks = 0; ks < 4; ++ks) aq[ks] = *(const bf16x8*)(IQ + (rowbase + q0 + qi) * 512 + hd * 64 + ks * 16 + hi * 8);
        const float* w0p = IW + (rowbase + q0 + 2 * hi) * 8;
        const f32x4 w0a = *(const f32x4*)(w0p), w0b = *(const f32x4*)(w0p + 4), w1a = *(const f32x4*)(w0p + 8), w1b = *(const f32x4*)(w0p + 12);
        for (int t = wave; t < ntile; t += 32) {
            bf16x8 bk[4][4];
#pragma unroll
            for (int u = 0; u < 4; ++u) { const int tt = t + 8 * u; const bf16* kr = IK + (rowbase + 32 * (tt < ntile ? tt : t)) * 64 + lane * 8;
#pragma unroll
                for (int ks = 0; ks < 4; ++ks) bk[u][ks] = *(const bf16x8*)(kr + ks * 512); }
#pragma unroll
            for (int u = 0; u < 4; ++u) { const int tt = t + 8 * u;
                if (tt < ntile) {
                    const int key = 32 * tt + r32;
                    f32x16 a;
#pragma unroll
                    for (int r = 0; r < 16; ++r) a[r] = 0.f;
#pragma unroll
                    for (int ks = 0; ks < 4; ++ks) a = __builtin_amdgcn_mfma_f32_32x32x16_bf16(aq[ks], bk[u][ks], a, 0, 0, 0);
                    float s0 = 0.f, s1 = 0.f;
#pragma unroll
                    for (int j = 0; j < 4; ++j) { s0 += w0a[j] * fmaxf(a[j], 0.f); s1 += w1a[j] * fmaxf(a[8 + j], 0.f); }
#pragma unroll
                    for (int j = 0; j < 4; ++j) { s0 += w0b[j] * fmaxf(a[4 + j], 0.f); s1 += w1b[j] * fmaxf(a[12 + j], 0.f); }
                    sc[(2 * hi) * 8192 + key] = (key <= q0 + 2 * hi) ? sortable_u32(s0) : 0u;
                    sc[(2 * hi + 1) * 8192 + key] = (key <= q0 + 2 * hi + 1) ? sortable_u32(s1) : 0u;
                } }
        }
    }
    __syncthreads();
    const int qi = wave & 3, hf = wave >> 2, q = q0 + qi, n = q + 1;
    const LAS unsigned* my = sc + qi * 8192;
    for (int repb = 0; repb < REP_B1; ++repb)
    {
        int c = 0; bool ovf = false;
        if (n > 256) {
            unsigned pivot = 1u;
            if (n > 640) {
                unsigned s[8];
#pragma unroll
                for (int k = 0; k < 8; ++k) s[k] = my[(int)(((unsigned)(lane * 8 + k) * (unsigned)n) >> 9)];
                const int r = (256 * 512 * 7 / 4) / n + 8;
                unsigned t16 = 0u;
                for (int bit = 15; bit >= 0; --bit) { const unsigned cand = (t16 | (1u << bit)) << 16; int cnt = 0;
#pragma unroll
                    for (int k = 0; k < 8; ++k) cnt += bcount(s[k] >= cand);
                    if (cnt >= r) t16 |= (1u << bit); }
                pivot = t16 << 16; if (pivot == 0u) pivot = 1u;
            }
            const int half = ((npad + 511) >> 9) << 8; const int lo = hf * half; const int hiend = (lo + half < npad) ? lo + half : npad;
            LAS unsigned short* cl = CL + wave * 1024;
            for (int i0 = lo; i0 < hiend; i0 += 256) { const int idx = i0 + 4 * lane; v4u v = (v4u){0u, 0u, 0u, 0u}; if (idx < hiend) v = *(const LAS v4u*)(my + idx);
#pragma unroll
                for (int e = 0; e < 4; ++e) { const bool f = v[e] >= pivot; const unsigned long long m = __ballot(f); const int pos = c + lane_rank(m);
                    if (f) { if (pos < 1024) cl[pos] = (unsigned short)(idx + e); }
                    c += __popcll(m); } }
            if (c > 1024) ovf = true;
        }
        if (lane == 0) CNT[wave] = ovf ? -1 : c;
    }
    __syncthreads();
    for (int repb2 = 0; repb2 < REP_B2; ++repb2)
    if (wave < 4) {
        LAS unsigned short* lst = LST + wave * 256; int nsel;
        if (n <= 256) { for (int i = lane; i < n; i += 64) lst[i] = (unsigned short)i; nsel = n; }
        else {
            const int c0 = CNT[wave], c1 = CNT[wave + 4]; const int c = c0 + c1;
            if (c0 < 0 || c1 < 0 || c < 256 || c > 1024) select_full(my, npad, lst, lane);
            else {
                unsigned uu[16], id[16];
#pragma unroll
                for (int k = 0; k < 16; ++k) { const int j = k * 64 + lane; unsigned ix = 0u, u = 0u;
                    if (j < c) { ix = (j < c0) ? (unsigned)CL[wave * 1024 + j] : (unsigned)CL[(wave + 4) * 1024 + (j - c0)]; u = my[ix]; }
                    uu[k] = u; id[k] = ix; }
                if (c <= 512) select_cands<8>(uu, id, lst, lane); else select_cands<16>(uu, id, lst, lane);
            }
            nsel = 256;
        }
        if (lane == 0) CNT[8 + wave] = nsel;
    }
    __syncthreads();
    for (int repc = 0; repc < REP_C; ++repc)
    {
        const int nsel = CNT[8 + qi]; const int j0 = 128 * hf; int cntk = nsel - j0; cntk = cntk < 0 ? 0 : (cntk > 128 ? 128 : cntk);
        const LAS unsigned short* lst = LST + qi * 256;
        LAS unsigned char* tile = lds + wave * 16384;
        LAS float* tf = (LAS float*)tile;
        const int l15 = lane & 15, kq = lane >> 4;
        if (cntk == 0) {
#pragma unroll
            for (int i = 0; i < 8; ++i) tf[i * 64 + lane] = 0.f;
            if (lane < 8) { tf[512 + lane] = -INFINITY; tf[520 + lane] = 0.f; }
        } else {
#pragma unroll
            for (int it = 0; it < 16; ++it) { const int r = 8 * it + (lane >> 3), ch = lane & 7; int j = j0 + r; j = j < nsel ? j : nsel - 1;
                const int idxv = (int)lst[j]; const v4u v = *(const v4u*)(DV + (rowbase + idxv) * 64 + 8 * ch);
                *(LAS v4u*)(tile + r * 128 + ch * 16) = v; }
            bf16x8 qf[2];
#pragma unroll
            for (int ks = 0; ks < 2; ++ks) { v4u z = (v4u){0u, 0u, 0u, 0u}; if (l15 < 8) z = *(const v4u*)(DQ + (rowbase + q) * 512 + l15 * 64 + 32 * ks + 8 * kq); qf[ks] = __builtin_bit_cast(bf16x8, z); }
            f32x4d acc[8];
#pragma unroll
            for (int g = 0; g < 8; ++g) { int j = j0 + 16 * g + l15; j = j < nsel ? j : nsel - 1; const int idxk = (int)lst[j];
                const bf16* kp = DK + (rowbase + idxk) * 64 + 8 * kq;
                const bf16x8 k0 = *(const bf16x8*)(kp), k1 = *(const bf16x8*)(kp + 32);
                f32x4d a = (f32x4d){0.f, 0.f, 0.f, 0.f};
                a = __builtin_amdgcn_mfma_f32_16x16x32_bf16(k0, qf[0], a, 0, 0, 0); a = __builtin_amdgcn_mfma_f32_16x16x32_bf16(k1, qf[1], a, 0, 0, 0); acc[g] = a; }
            float mx = -INFINITY;
#pragma unroll
            for (int g = 0; g < 8; ++g)
#pragma unroll
                for (int e = 0; e < 4; ++e) { if (16 * g + 4 * kq + e >= cntk) acc[g][e] = -INFINITY; mx = fmaxf(mx, acc[g][e]); }
            mx = fmaxf(mx, __shfl_xor(mx, 16)); mx = fmaxf(mx, __shfl_xor(mx, 32));
            float ls = 0.f;
#pragma unroll
            for (int g = 0; g < 8; ++g)
#pragma unroll
                for (int e = 0; e < 4; ++e) { acc[g][e] = __builtin_amdgcn_exp2f(acc[g][e] - mx); ls += acc[g][e]; }
            ls += __shfl_xor(ls, 16); ls += __shfl_xor(ls, 32);
            bf16x8 pa[4];
#pragma unroll
            for (int t = 0; t < 4; ++t) { v4u w; w.x = cvtpk(acc[2 * t][0], acc[2 * t][1]); w.y = cvtpk(acc[2 * t][2], acc[2 * t][3]); w.z = cvtpk(acc[2 * t + 1][0], acc[2 * t + 1][1]); w.w = cvtpk(acc[2 * t + 1][2], acc[2 * t + 1][3]); pa[t] = __builtin_bit_cast(bf16x8, w); }
            f32x4d o[4];
            const int q_ = l15 >> 2, p_ = lane & 3;
#pragma unroll
            for (int cb = 0; cb < 4; ++cb) { f32x4d oc = (f32x4d){0.f, 0.f, 0.f, 0.f};
#pragma unroll
                for (int t = 0; t < 4; ++t) {
                    const LAS unsigned char* a1 = tile + (32 * t + 4 * kq + q_) * 128 + (16 * cb + 4 * p_) * 2;
                    const v4i16_t lo4 = __builtin_amdgcn_ds_read_tr16_b64_v4i16((LAS v4i16_t*)a1), hi4 = __builtin_amdgcn_ds_read_tr16_b64_v4i16((LAS v4i16_t*)(a1 + 16 * 128));
                    const bf16x8 vf = (bf16x8){lo4[0], lo4[1], lo4[2], lo4[3], hi4[0], hi4[1], hi4[2], hi4[3]};
                    oc = __builtin_amdgcn_mfma_f32_16x16x32_bf16(pa[t], vf, oc, 0, 0, 0); }
                o[cb] = oc; }
            if (kq < 2) {
#pragma unroll
                for (int cb = 0; cb < 4; ++cb)
#pragma unroll
                    for (int e = 0; e < 4; ++e) tf[(4 * kq + e) * 64 + 16 * cb + l15] = o[cb][e];
            }
            if (lane < 8) { tf[512 + lane] = mx; tf[520 + lane] = ls; }
        }
    }
    __syncthreads();
    if (wave < 4) {
        const LAS float* ta = (const LAS float*)(lds + wave * 16384); const LAS float* tb = (const LAS float*)(lds + (wave + 4) * 16384);
        const int h = lane >> 3, d0 = (lane & 7) * 8;
        const float ma = ta[512 + h], mb = tb[512 + h], la = ta[520 + h], lb = tb[520 + h];
        const float m = fmaxf(ma, mb), fa = __builtin_amdgcn_exp2f(ma - m), fb = __builtin_amdgcn_exp2f(mb - m);
        const float inv = 1.0f / (la * fa + lb * fb);
        const f32x4 a0 = *(const LAS f32x4*)(ta + h * 64 + d0), a1 = *(const LAS f32x4*)(ta + h * 64 + d0 + 4), b0 = *(const LAS f32x4*)(tb + h * 64 + d0), b1 = *(const LAS f32x4*)(tb + h * 64 + d0 + 4);
        const f32x4 r0 = (a0 * fa + b0 * fb) * inv, r1 = (a1 * fa + b1 * fb) * inv;
        v4u w; w.x = cvtpk(r0[0], r0[1]); w.y = cvtpk(r0[2], r0[3]); w.z = cvtpk(r1[0], r1[1]); w.w = cvtpk(r1[2], r1[3]);
        *(v4u*)(OB + (rowbase + q) * 512 + h * 64 + d0) = w;
    }
    __syncthreads();
}
constexpr int D3_RING = RING_BYTES + 1024;
constexpr int D3_LST = D3_RING + 16384;
constexpr int D3_CNT = D3_LST + 8192;
constexpr int D3_QW = D3_CNT + 512;
typedef unsigned long long u64d;
template <int KMAX> __device__ __forceinline__ void select_cands3(const unsigned (&uu)[16], const unsigned (&id)[16], LAS unsigned short* lst, int lane) { select_cands<KMAX>(uu, id, lst, lane); }
__device__ __forceinline__ void dsa3_unit(int b, int g16, const bf16* IQ, const bf16* IK, const float* IW, const bf16* DQ, const bf16* DK, const bf16* DV, bf16* OB, LAS unsigned char* lds, int wave, int lane_in) {
    int lane = lane_in; asm volatile("" : "+v"(lane));
    LAS u64d* LISTS = (LAS u64d*)lds;
    LAS unsigned short* LST = (LAS unsigned short*)(lds + D3_LST);
    LAS int* CNT = (LAS int*)(lds + D3_CNT);
    const int tid = wave * 64 + lane, r32 = lane & 31, hi = lane >> 5; const size_t rowbase = (size_t)b * SEQ;
    const int q0 = 16 * g16, ntile = (q0 + 15) / 32 + 1, nstep = (ntile + 1) >> 1;
    const int qgrp = wave & 3, par = wave >> 2;
    const int qA = q0 + 4 * qgrp + 2 * hi, qB = qA + 1;
    const int qi = 2 * ((r32 >> 2) & 1) + (r32 >> 4), hd = 4 * ((r32 >> 3) & 1) + (r32 & 3);
    bf16x8 aq[4];
#pragma unroll
    for (int ks = 0; ks < 4; ++ks) aq[ks] = *(const bf16x8*)(IQ + (rowbase + q0 + 4 * qgrp + qi) * 512 + hd * 64 + ks * 16 + hi * 8);
    const float* w0p = IW + (rowbase + qA) * 8;
    const f32x4 w0a = *(const f32x4*)(w0p), w0b = *(const f32x4*)(w0p + 4), w1a = *(const f32x4*)(w0p + 8), w1b = *(const f32x4*)(w0p + 12);
    f32x4 l0a, l0b, l1a, l1b;
#pragma unroll
    for (int j = 0; j < 4; ++j) { l0a[j] = w0a[j] >= 0.f ? INFINITY : -INFINITY; l0b[j] = w0b[j] >= 0.f ? INFINITY : -INFINITY; l1a[j] = w1a[j] >= 0.f ? INFINITY : -INFINITY; l1b[j] = w1b[j] >= 0.f ? INFINITY : -INFINITY; }
#define D3_SCORE(BK, S0, S1) do { f32x16 a_; _Pragma("unroll") for (int r = 0; r < 16; ++r) a_[r] = 0.f; \
        _Pragma("unroll") for (int ks = 0; ks < 4; ++ks) a_ = __builtin_amdgcn_mfma_f32_32x32x16_bf16(aq[ks], BK[ks], a_, 0, 0, 0); \
        S0 = 0.f; S1 = 0.f; \
        _Pragma("unroll") for (int j = 0; j < 4; ++j) { S0 += __builtin_amdgcn_fmed3f(w0a[j] * a_[j], 0.f, l0a[j]); S1 += __builtin_amdgcn_fmed3f(w1a[j] * a_[8 + j], 0.f, l1a[j]); } \
        _Pragma("unroll") for (int j = 0; j < 4; ++j) { S0 += __builtin_amdgcn_fmed3f(w0b[j] * a_[4 + j], 0.f, l0b[j]); S1 += __builtin_amdgcn_fmed3f(w1b[j] * a_[12 + j], 0.f, l1b[j]); } } while (0)
#ifndef REP_S
#define REP_S 1
#define REP_M 1
#define REP_B 1
#define REP_CD 1
#endif
    unsigned pivA = 1u, pivB = 1u;
    if (ntile <= 16 && tid < 16) CNT[64 + tid] = 0;
    for (int reps = 0; reps < REP_S; ++reps)
    if (ntile > 16) {
#pragma unroll
        for (int k = 0; k < 4; ++k) { const int c = tid + 512 * k; const int ts = ((c >> 8) * ntile) >> 3;
            *(LAS v4u*)(lds + c * 16) = *(const v4u*)(IK + (rowbase + 32 * ts) * 64 + (c & 255) * 8); }
        __syncthreads();
        unsigned uA[8], uB[8];
#pragma unroll
        for (int i = 0; i < 8; ++i) { bf16x8 bk[4];
#pragma unroll
            for (int ks = 0; ks < 4; ++ks) bk[ks] = *(const LAS bf16x8*)(lds + i * 4096 + ks * 1024 + lane * 16);
            float s0, s1; D3_SCORE(bk, s0, s1); uA[i] = sortable_u32(s0); uB[i] = sortable_u32(s1); asm volatile("" ::: "memory"); }
        const int qs = q0 + 4 * qgrp + par;
        const int r0 = (256 * 256 * 7 / 4) / (qs + 1) + 6, r1 = (256 * 256 * 7 / 4) / (qs + 3) + 6;
        unsigned us[8];
#pragma unroll
        for (int i = 0; i < 8; ++i) us[i] = par ? uB[i] : uA[i];
        unsigned t0 = 0u, t1 = 0u;
        for (int bit = 15; bit >= 0; --bit) {
            const unsigned c = ((hi ? t1 : t0) | (1u << bit)) << 16; int n0 = 0, n1 = 0;
#pragma unroll
            for (int i = 0; i < 8; ++i) { const unsigned long long m = __builtin_amdgcn_ballot_w64(us[i] >= c); n0 += __popc((unsigned)m); n1 += __popc((unsigned)(m >> 32)); }
            if (n0 >= r0) t0 |= (1u << bit);
            if (n1 >= r1) t1 |= (1u << bit);
        }
        LAS unsigned* PV = (LAS unsigned*)(CNT + 64);
        if (lane == 0) { PV[4 * qgrp + par] = t0; PV[4 * qgrp + 2 + par] = t1; }
        __syncthreads();
        const unsigned tA = PV[4 * qgrp + 2 * hi], tB = PV[4 * qgrp + 2 * hi + 1];
        pivA = tA << 16; pivB = tB << 16; if (pivA == 0u) pivA = 1u; if (pivB == 0u) pivB = 1u;
        __syncthreads();
    }
    for (int repm = 0; repm < REP_M; ++repm)
    {
        const bf16* src0 = IK + rowbase * 64 + (size_t)(tid & 255) * 8;
#define D3_LOAD(k_) (*(const v4u*)(src0 + (size_t)32 * ((2 * (k_) + (tid >> 8)) < ntile ? (2 * (k_) + (tid >> 8)) : ntile - 1) * 64))
        v4u st0 = (v4u){0u, 0u, 0u, 0u}, st1 = st0, st2 = st0, st3 = st0;
        st0 = D3_LOAD(0); st1 = D3_LOAD(1); st2 = D3_LOAD(2); st3 = D3_LOAD(3);
        *(LAS v4u*)(lds + D3_RING + tid * 16) = st0;
        __syncthreads();
        int cntA = 0, cntB = 0;
        LAS u64d* lA = LISTS + ((4 * qgrp + 2 * hi) * 2 + par) * 512; LAS u64d* lB = lA + 1024;
        LAS u64d* dmy = (LAS u64d*)(lds + D3_QW + 64) + lane;
        f32x16 acc;
#pragma unroll
        for (int r = 0; r < 16; ++r) acc[r] = 0.f;
#define D3_SUMS(S0, S1) do { S0 = 0.f; S1 = 0.f; \
            _Pragma("unroll") for (int j = 0; j < 4; ++j) { S0 += __builtin_amdgcn_fmed3f(w0a[j] * acc[j], 0.f, l0a[j]); S1 += __builtin_amdgcn_fmed3f(w1a[j] * acc[8 + j], 0.f, l1a[j]); } \
            _Pragma("unroll") for (int j = 0; j < 4; ++j) { S0 += __builtin_amdgcn_fmed3f(w0b[j] * acc[4 + j], 0.f, l0b[j]); S1 += __builtin_amdgcn_fmed3f(w1b[j] * acc[12 + j], 0.f, l1b[j]); } } while (0)
#define D3_FILTER(TP, S0, S1) do { const int key = 32 * (TP) + r32; const unsigned u0 = sortable_u32(S0), u1 = sortable_u32(S1);     \
                const bool psa = (key <= qA) && (u0 >= pivA), psb = (key <= qB) && (u1 >= pivB); \
                const unsigned long long ma = __ballot(psa), mb = __ballot(psb); const unsigned mla = (unsigned)ma, mha = (unsigned)(ma >> 32), mlb = (unsigned)mb, mhb = (unsigned)(mb >> 32); \
                const int posa = cntA + (int)__builtin_amdgcn_mbcnt_hi(mha, __builtin_amdgcn_mbcnt_lo(mla, 0u)) - (hi ? __popc(mla) : 0); \
                const int posb = cntB + (int)__builtin_amdgcn_mbcnt_hi(mhb, __builtin_amdgcn_mbcnt_lo(mlb, 0u)) - (hi ? __popc(mlb) : 0); \
                LAS u64d* wa_ = (psa && posa < 512) ? lA + posa : dmy; LAS u64d* wb_ = (psb && posb < 512) ? lB + posb : dmy; \
                *wa_ = ((u64d)(unsigned)key << 32) | u0; *wb_ = ((u64d)(unsigned)key << 32) | u1; \
                cntA += hi ? __popc(mha) : __popc(mla); cntB += hi ? __popc(mhb) : __popc(mlb); } while (0)
#define D3_STEP(k_, STNEXT, STFREE) do { \
            STFREE = D3_LOAD((k_) + 4); \
            const int tp_ = 2 * (k_) - 2 + par; \
            const LAS unsigned char* sb = lds + D3_RING + ((k_) & 1) * 8192 + par * 4096; bf16x8 bk[4]; \
            _Pragma("unroll") for (int ks = 0; ks < 4; ++ks) bk[ks] = *(const LAS bf16x8*)(sb + ks * 1024 + lane * 16); \
            __builtin_amdgcn_sched_barrier(0); \
            float s0, s1; D3_SUMS(s0, s1); asm volatile("" : "+v"(s0), "+v"(s1));     \
            __builtin_amdgcn_sched_barrier(0); \
            _Pragma("unroll") for (int r = 0; r < 16; ++r) acc[r] = 0.f; \
            _Pragma("unroll") for (int ks = 0; ks < 4; ++ks) acc = __builtin_amdgcn_mfma_f32_32x32x16_bf16(aq[ks], bk[ks], acc, 0, 0, 0); \
            __builtin_amdgcn_sched_barrier(0); \
            if (tp_ >= 0 && tp_ < ntile) D3_FILTER(tp_, s0, s1); \
            *(LAS v4u*)(lds + D3_RING + (((k_) + 1) & 1) * 8192 + tid * 16) = STNEXT; \
            asm volatile("s_waitcnt lgkmcnt(0)" ::: "memory"); __builtin_amdgcn_s_barrier(); asm volatile("" ::: "memory"); } while (0)
        int kend = 0;
        for (int k = 0; k < nstep; k += 4) {
            D3_STEP(k, st1, st0); D3_STEP(k + 1, st2, st1); D3_STEP(k + 2, st3, st2); D3_STEP(k + 3, st0, st3); kend = k + 4;
        }
        {   const int tp_ = 2 * kend - 2 + par; if (tp_ < ntile) { float s0, s1; D3_SUMS(s0, s1); D3_FILTER(tp_, s0, s1); } }
#undef D3_SUMS
#undef D3_FILTER
#undef D3_STEP
#undef D3_LOAD
        if (r32 == 0) { CNT[(4 * qgrp + 2 * hi) * 2 + par] = cntA; CNT[(4 * qgrp + 2 * hi + 1) * 2 + par] = cntB; }
        if (tid < 4) CNT[48 + tid] = 0;
    }
#undef D3_SCORE
    __syncthreads();
#if defined(DBG_D3_STAGE) && DBG_D3_STAGE == 1
    for (int grp = 0; grp < 4; ++grp) dsa2_unit(b, 4 * g16 + grp, IQ, IK, IW, DQ, DK, DV, OB, lds, wave, lane);
    return;
#endif
#pragma unroll 1
    for (int rr = 0; rr < 2 * REP_B; ++rr) {
        const int qx = wave + 8 * (rr & 1), q = q0 + qx, n = q + 1; LAS unsigned short* lst = LST + qx * 256; int nsel;
        if (n <= 256) { for (int i = lane; i < n; i += 64) lst[i] = (unsigned short)i; nsel = n; }
        else {
            const int c0 = CNT[2 * qx], c1 = CNT[2 * qx + 1]; const int c = c0 + c1;
#ifdef DBG_D3_ALLFAIL
            if (true) { if (lane == 0) CNT[48 + (qx >> 2)] = 1; nsel = 0; }
#else
            if (c0 > 512 || c1 > 512 || c < 256) { if (lane == 0) CNT[48 + (qx >> 2)] = 1; nsel = 0; }
#endif
            else {
                unsigned uu[16], id[16]; const LAS u64d* L0 = LISTS + (qx * 2) * 512; const LAS u64d* L1 = L0 + 512;
#pragma unroll
                for (int k = 0; k < 16; ++k) { const int j = k * 64 + lane, jj = j < c ? j : c - 1;
                    const u64d e = *((jj < c0) ? (L0 + jj) : (L1 + (jj - c0))); uu[k] = j < c ? (unsigned)e : 0u; id[k] = (unsigned)(e >> 32); }
                const unsigned lb = (unsigned)CNT[64 + qx] << 16;
                if (c <= 512) select_cands<8>(uu, id, lst, lane, lb); else if (c <= 640) select_cands<10>(uu, id, lst, lane, lb); else if (c <= 768) select_cands<12>(uu, id, lst, lane, lb); else select_cands<16>(uu, id, lst, lane, lb);
                nsel = 256;
            }
        }
        if (lane == 0) CNT[32 + qx] = nsel;
    }
    __syncthreads();
#pragma unroll 1
    for (int rr_ = 0; rr_ < 2 * REP_CD; ++rr_) { const int rr = rr_ & 1;
        const int qx = wave + 8 * rr, q = q0 + qx; const int nsel = CNT[32 + qx];
        const LAS unsigned short* lst = LST + qx * 256;
        LAS unsigned char* tile = lds + wave * 16384; LAS float* tf = (LAS float*)tile;
        const int l15 = lane & 15, kq = lane >> 4, q_ = l15 >> 2, p_ = lane & 3;
        bf16x8 qf[2];
#pragma unroll
        for (int ks = 0; ks < 2; ++ks) { v4u z = (v4u){0u, 0u, 0u, 0u}; if (l15 < 8) z = *(const v4u*)(DQ + (rowbase + q) * 512 + l15 * 64 + 32 * ks + 8 * kq); qf[ks] = __builtin_bit_cast(bf16x8, z); }
        float mrun = -INFINITY, lrun = 0.f; f32x4d orun[4];
#pragma unroll
        for (int cb = 0; cb < 4; ++cb) orun[cb] = (f32x4d){0.f, 0.f, 0.f, 0.f};
#pragma unroll 1
        for (int hf = 0; hf < 2; ++hf) {
            const int j0 = 128 * hf; int cntk = nsel - j0; cntk = cntk > 128 ? 128 : cntk;
            if (cntk <= 0) break;
            int iv[16], ik[8];
#pragma unroll
            for (int it = 0; it < 16; ++it) { int j = j0 + 8 * it + (lane >> 3); j = j < nsel ? j : nsel - 1; iv[it] = (int)lst[j]; }
#pragma unroll
            for (int g = 0; g < 8; ++g) { int j = j0 + 16 * g + l15; j = j < nsel ? j : nsel - 1; ik[g] = (int)lst[j]; }
            asm volatile("s_waitcnt lgkmcnt(0)" ::: "memory");
#pragma unroll
            for (int it = 0; it < 16; ++it)
                __builtin_amdgcn_global_load_lds((const unsigned*)(DV + (rowbase + iv[it]) * 64 + 8 * (lane & 7)), (LAS unsigned*)(tile + it * 1024), 16, 0, 0);
            bf16x8 kk0[8], kk1[8];
#pragma unroll
            for (int g = 0; g < 8; ++g) { const bf16* kp = DK + (rowbase + ik[g]) * 64 + 8 * kq; kk0[g] = *(const bf16x8*)(kp); kk1[g] = *(const bf16x8*)(kp + 32); }
            asm volatile("" ::: "memory");
            f32x4d acc[8];
#pragma unroll
            for (int g = 0; g < 8; ++g) { f32x4d a = (f32x4d){0.f, 0.f, 0.f, 0.f};
                a = __builtin_amdgcn_mfma_f32_16x16x32_bf16(kk0[g], qf[0], a, 0, 0, 0); a = __builtin_amdgcn_mfma_f32_16x16x32_bf16(kk1[g], qf[1], a, 0, 0, 0); acc[g] = a; }
            float mx = -INFINITY;
#pragma unroll
            for (int g = 0; g < 8; ++g)
#pragma unroll
                for (int e = 0; e < 4; ++e) { if (16 * g + 4 * kq + e >= cntk) acc[g][e] = -INFINITY; mx = fmaxf(mx, acc[g][e]); }
            mx = fmaxf(mx, __shfl_xor(mx, 16)); mx = fmaxf(mx, __shfl_xor(mx, 32));
            const float mnew = fmaxf(mrun, mx), fold = __builtin_amdgcn_exp2f(mrun - mnew);
            float ls = 0.f;
#pragma unroll
            for (int g = 0; g < 8; ++g)
#pragma unroll
                for (int e = 0; e < 4; ++e) { acc[g][e] = __builtin_amdgcn_exp2f(acc[g][e] - mnew); ls += acc[g][e]; }
            ls += __shfl_xor(ls, 16); ls += __shfl_xor(ls, 32);
            lrun = lrun * fold + ls; mrun = mnew;
            float fo[4];
#pragma unroll
            for (int e = 0; e < 4; ++e) fo[e] = __shfl(fold, 4 * kq + e);
            asm volatile("s_waitcnt vmcnt(0)" ::: "memory");
            bf16x8 pa[4];
#pragma unroll
            for (int t = 0; t < 4; ++t) { v4u w; w.x = cvtpk(acc[2 * t][0], acc[2 * t][1]); w.y = cvtpk(acc[2 * t][2], acc[2 * t][3]); w.z = cvtpk(acc[2 * t + 1][0], acc[2 * t + 1][1]); w.w = cvtpk(acc[2 * t + 1][2], acc[2 * t + 1][3]); pa[t] = __builtin_bit_cast(bf16x8, w); }
#pragma unroll
            for (int cb = 0; cb < 4; ++cb) { f32x4d oc = orun[cb];
#pragma unroll
                for (int e = 0; e < 4; ++e) oc[e] *= fo[e];
#pragma unroll
                for (int t = 0; t < 4; ++t) {
                    const LAS unsigned char* a1 = tile + (32 * t + 4 * kq + q_) * 128 + (16 * cb + 4 * p_) * 2;
                    const v4i16_t lo4 = __builtin_amdgcn_ds_read_tr16_b64_v4i16((LAS v4i16_t*)a1), hi4 = __builtin_amdgcn_ds_read_tr16_b64_v4i16((LAS v4i16_t*)(a1 + 16 * 128));
                    const bf16x8 vf = (bf16x8){lo4[0], lo4[1], lo4[2], lo4[3], hi4[0], hi4[1], hi4[2], hi4[3]};
                    oc = __builtin_amdgcn_mfma_f32_16x16x32_bf16(pa[t], vf, oc, 0, 0, 0); }
                orun[cb] = oc; }
        }
        float li[4];
#pragma unroll
        for (int e = 0; e < 4; ++e) li[e] = 1.0f / __shfl(lrun, 4 * kq + e);
        if (kq < 2) {
#pragma unroll
            for (int cb = 0; cb < 4; ++cb)
#pragma unroll
                for (int e = 0; e < 4; ++e) tf[(4 * kq + e) * 64 + 16 * cb + l15] = orun[cb][e] * li[e];
        }
        { const int h = lane >> 3, d0 = (lane & 7) * 8;
          const f32x4 r0 = *(const LAS f32x4*)(tf + h * 64 + d0), r1 = *(const LAS f32x4*)(tf + h * 64 + d0 + 4);
          v4u w; w.x = cvtpk(r0[0], r0[1]); w.y = cvtpk(r0[2], r0[3]); w.z = cvtpk(r1[0], r1[1]); w.w = cvtpk(r1[2], r1[3]);
          *(v4u*)(OB + (rowbase + q) * 512 + h * 64 + d0) = w; }
    }
    __syncthreads();
    const int f0 = CNT[48], f1 = CNT[49], f2 = CNT[50], f3 = CNT[51];
    __syncthreads();
    const int fm = (f0 ? 1 : 0) | (f1 ? 2 : 0) | (f2 ? 4 : 0) | (f3 ? 8 : 0);
#pragma unroll 1
    for (int grp = 0; grp < 4; ++grp) if ((fm >> grp) & 1) dsa2_unit(b, 4 * g16 + grp, IQ, IK, IW, DQ, DK, DV, OB, lds, wave, lane);
}
__device__ __forceinline__ void fox_unit2(int bh, int qb, const bf16* FQ, const bf16* FK, const bf16* FV, const float* CUM, const int* T0, bf16* OA, LAS unsigned char* lds, int wave, int lane) {
    const int b = bh >> 3, h = bh & 7, r32 = lane & 31, hi = lane >> 5; const size_t rowbase = (size_t)b * SEQ; const int q0 = qb * 256 + wave * 32;
    const bf16* Qw = FQ + (rowbase + q0) * 512 + h * 64; bf16* Ow = OA + (rowbase + q0) * 512 + h * 64;
    const bf16* Kp = FK + rowbase * 512 + h * 64; const bf16* Vp = FV + rowbase * 512 + h * 64; const float* cb = CUM + (size_t)bh * SEQ;
    LAS unsigned char* wl = lds + wave * 16384;
    LAS float* bl = (LAS float*)(lds + RING_BYTES + 8192 + wave * 256);
    bf16x8 qr[4];
#pragma unroll
    for (int ks = 0; ks < 4; ++ks) qr[ks] = *(const bf16x8*)(Qw + (size_t)r32 * 512 + ks * 16 + hi * 8);
    const int tstart = T0[bh * 256 + q0 / 32], ntiles = q0 / 32 + 1, qlocal = q0 + r32;
    f32x16 o[2];
#pragma unroll
    for (int d0 = 0; d0 < 2; ++d0)
#pragma unroll
        for (int r = 0; r < 16; ++r) o[d0][r] = 0.f;
    float m = -1e30f, l = 0.f;
    const int lrow = lane >> 3, lch = lane & 7;
#define FOX_LOAD(KR, VR, BR, tt) do { _Pragma("unroll") for (int it = 0; it < 4; ++it) { const size_t ro = (size_t)(32 * (tt) + 8 * it + lrow) * 512 + lch * 8; KR[it] = *(const v4u*)(Kp + ro); VR[it] = *(const v4u*)(Vp + ro); } BR = cb[32 * (tt) + r32]; } while (0)
#define FOX_STORE(KR, VR, BR, bf) do { _Pragma("unroll") for (int it = 0; it < 4; ++it) { const int row = 8 * it + lrow; *(LAS v4u*)(wl + (bf) * 4096 + row * 128 + ((lch ^ (row & 7)) * 16)) = KR[it]; *(LAS v4u*)(wl + 8192 + (bf) * 4096 + row * 128 + lch * 16) = VR[it]; } if (lane < 32) bl[(bf) * 32 + lane] = -L2E * BR; } while (0)
    v4u krA[4], vrA[4], krB[4], vrB[4]; float brA = 0.f, brB = 0.f;
    const int kq = (lane >> 4) & 1, q_ = (lane & 15) >> 2, p_ = lane & 3;
    FOX_LOAD(krA, vrA, brA, tstart);
    if (tstart + 1 < ntiles) FOX_LOAD(krB, vrB, brB, tstart + 1);
    FOX_STORE(krA, vrA, brA, 0);
    auto compute = [&](int t, int buf) {
        const LAS unsigned char* kb = wl + buf * 4096; const LAS unsigned char* vb = wl + 8192 + buf * 4096; const LAS float* bb = bl + buf * 32;
        f32x16 p;
#pragma unroll
        for (int r = 0; r < 16; ++r) p[r] = 0.f;
#pragma unroll
        for (int ks = 0; ks < 4; ++ks) { const bf16x8 kf = *(const LAS bf16x8*)(kb + r32 * 128 + (((2 * ks + hi) ^ (r32 & 7)) * 16)); p = __builtin_amdgcn_mfma_f32_32x32x16_bf16(kf, qr[ks], p, 0, 0, 0); }
#pragma unroll
        for (int g = 0; g < 4; ++g) { const f32x4 c4 = *(const LAS f32x4*)(bb + 8 * g + 4 * hi);
#pragma unroll
            for (int jj = 0; jj < 4; ++jj) p[4 * g + jj] += c4[jj]; }
        if (t == ntiles - 1) {
#pragma unroll
            for (int r = 0; r < 16; ++r) if (32 * t + crow(r, hi) > qlocal) p[r] = -INFINITY;
        }
        float mt = p[0];
#pragma unroll
        for (int r = 1; r < 16; ++r) mt = fmaxf(mt, p[r]);
        mt = fmaxf(mt, __shfl_xor(mt, 32));
        const float mn = fmaxf(m, mt); const float alpha = __builtin_amdgcn_exp2f(m - mn); m = mn;
        l *= alpha;
#pragma unroll
        for (int d0 = 0; d0 < 2; ++d0)
#pragma unroll
            for (int r = 0; r < 16; ++r) o[d0][r] *= alpha;
        float ls = 0.f;
#pragma unroll
        for (int r = 0; r < 16; ++r) { p[r] = __builtin_amdgcn_exp2f(p[r] - mn); ls += p[r]; }
        l += ls;
        bf16x8 pa[2];
#pragma unroll
        for (int s2 = 0; s2 < 2; ++s2) { v4u w; w.x = cvtpk(p[8 * s2 + 0], p[8 * s2 + 1]); w.y = cvtpk(p[8 * s2 + 2], p[8 * s2 + 3]); w.z = cvtpk(p[8 * s2 + 4], p[8 * s2 + 5]); w.w = cvtpk(p[8 * s2 + 6], p[8 * s2 + 7]); pa[s2] = __builtin_bit_cast(bf16x8, w); }
#pragma unroll
        for (int d0 = 0; d0 < 2; ++d0)
#pragma unroll
            for (int s2 = 0; s2 < 2; ++s2) {
                const LAS unsigned char* a1 = vb + (16 * s2 + 4 * hi + q_) * 128 + (32 * d0 + 16 * kq + 4 * p_) * 2;
                const v4i16_t lo4 = __builtin_amdgcn_ds_read_tr16_b64_v4i16((LAS v4i16_t*)a1), hi4 = __builtin_amdgcn_ds_read_tr16_b64_v4i16((LAS v4i16_t*)(a1 + 8 * 128));
                const bf16x8 vf = (bf16x8){lo4[0], lo4[1], lo4[2], lo4[3], hi4[0], hi4[1], hi4[2], hi4[3]};
                o[d0] = __builtin_amdgcn_mfma_f32_32x32x16_bf16(vf, pa[s2], o[d0], 0, 0, 0);
            }
    };
    for (int t = tstart; t < ntiles; t += 2) {
        if (t + 2 < ntiles) FOX_LOAD(krA, vrA, brA, t + 2);
        compute(t, 0);
        if (t + 1 < ntiles) {
            FOX_STORE(krB, vrB, brB, 1);
            if (t + 3 < ntiles) FOX_LOAD(krB, vrB, brB, t + 3);
            compute(t + 1, 1);
            if (t + 2 < ntiles) FOX_STORE(krA, vrA, brA, 0);
        }
    }
#undef FOX_LOAD
#undef FOX_STORE
    l += __shfl_xor(l, 32);
    const float inv = 1.0f / l;
    bf16* orow = Ow + (size_t)r32 * 512;
#pragma unroll
    for (int d0 = 0; d0 < 2; ++d0)
#pragma unroll
        for (int g = 0; g < 4; ++g) { u32x2 w; w.x = cvtpk(o[d0][4 * g] * inv, o[d0][4 * g + 1] * inv); w.y = cvtpk(o[d0][4 * g + 2] * inv, o[d0][4 * g + 3] * inv);
            *(u32x2*)(orow + d0 * 32 + 8 * g + 4 * hi) = w; }
}
__device__ __forceinline__ void fox_unit4(int bh, int qb, const bf16* FQ, const bf16* FK, const bf16* FV, const float* CUM, const int* T0, const float* gq, const float* gk, bf16* OA, LAS unsigned char* lds, int wave, int lane) {
    const int b = bh >> 3, h = bh & 7, r32 = lane & 31, hi = lane >> 5; const size_t rowbase = (size_t)b * SEQ; const int q0 = qb * 256 + wave * 32;
    const bf16* Qw = FQ + (rowbase + q0) * 512 + h * 64; bf16* Ow = OA + (rowbase + q0) * 512 + h * 64;
    const bf16* Kp = FK + rowbase * 512 + h * 64; const bf16* Vp = FV + rowbase * 512 + h * 64; const float* cb = CUM + (size_t)bh * SEQ;
    LAS unsigned char* wl = lds + wave * 16384;
    LAS float* bl = (LAS float*)(lds + RING_BYTES + 8192 + wave * 256);
    bf16x8 qr[4];
#pragma unroll
    for (int ks = 0; ks < 4; ++ks) qr[ks] = *(const bf16x8*)(Qw + (size_t)r32 * 512 + ks * 16 + hi * 8);
    const int tstart = T0[bh * 256 + q0 / 32], tlast = q0 / 32, nseq = tlast - tstart + 1, qlocal = q0 + r32;
    const float stopc = (8.0f * wave_max(fabsf(gq[lane])) * wave_max(fabsf(gk[lane])) + 30.0f) * L2E;
    f32x16 o[2];
#pragma unroll
    for (int d0 = 0; d0 < 2; ++d0)
#pragma unroll
        for (int r = 0; r < 16; ++r) o[d0][r] = 0.f;
    float m = -1e30f, l = 0.f;
    const int lrow = lane >> 3, lch = lane & 7;
#define FOX_LOAD(KR, VR, BR, tt) do { _Pragma("unroll") for (int it = 0; it < 4; ++it) { const size_t ro = (size_t)(32 * (tt) + 8 * it + lrow) * 512 + lch * 8; KR[it] = *(const v4u*)(Kp + ro); VR[it] = *(const v4u*)(Vp + ro); } BR = cb[32 * (tt) + r32]; } while (0)
#define FOX_STORE(KR, VR, BR, bf) do { _Pragma("unroll") for (int it = 0; it < 4; ++it) { const int row = 8 * it + lrow; *(LAS v4u*)(wl + (bf) * 4096 + row * 128 + ((lch ^ (row & 7)) * 16)) = KR[it]; *(LAS v4u*)(wl + 8192 + (bf) * 4096 + row * 128 + lch * 16) = VR[it]; } if (lane < 32) bl[(bf) * 32 + lane] = -L2E * BR; } while (0)
    v4u krA[4], vrA[4], krB[4], vrB[4]; float brA = 0.f, brB = 0.f;
    const int kq = (lane >> 4) & 1, q_ = (lane & 15) >> 2, p_ = lane & 3;
    FOX_LOAD(krA, vrA, brA, tlast);
    if (1 < nseq) FOX_LOAD(krB, vrB, brB, tlast - 1);
    FOX_STORE(krA, vrA, brA, 0);
    auto compute = [&](int t, int buf) -> bool {
        const LAS unsigned char* kb = wl + buf * 4096; const LAS unsigned char* vb = wl + 8192 + buf * 4096; const LAS float* bb = bl + buf * 32;
        if (t != tlast) { const float bmax = bb[31]; if (__all(m > bmax + stopc)) return true; }
        f32x16 p;
#pragma unroll
        for (int r = 0; r < 16; ++r) p[r] = 0.f;
#pragma unroll
        for (int ks = 0; ks < 4; ++ks) { const bf16x8 kf = *(const LAS bf16x8*)(kb + r32 * 128 + (((2 * ks + hi) ^ (r32 & 7)) * 16)); p = __builtin_amdgcn_mfma_f32_32x32x16_bf16(kf, qr[ks], p, 0, 0, 0); }
#pragma unroll
        for (int g = 0; g < 4; ++g) { const f32x4 c4 = *(const LAS f32x4*)(bb + 8 * g + 4 * hi);
#pragma unroll
            for (int jj = 0; jj < 4; ++jj) p[4 * g + jj] += c4[jj]; }
        if (t == tlast) {
#pragma unroll
            for (int r = 0; r < 16; ++r) if (32 * t + crow(r, hi) > qlocal) p[r] = -INFINITY;
        }
        float mt = p[0];
#pragma unroll
        for (int r = 1; r < 16; ++r) mt = fmaxf(mt, p[r]);
        mt = fmaxf(mt, __shfl_xor(mt, 32));
        if (__any(mt > m)) {
            const float mn = fmaxf(m, mt); const float alpha = __builtin_amdgcn_exp2f(m - mn); m = mn;
            l *= alpha;
#pragma unroll
            for (int d0 = 0; d0 < 2; ++d0)
#pragma unroll
                for (int r = 0; r < 16; ++r) o[d0][r] *= alpha;
        }
        const float mn = m;
        float ls = 0.f;
#pragma unroll
        for (int r = 0; r < 16; ++r) { p[r] = __builtin_amdgcn_exp2f(p[r] - mn); ls += p[r]; }
        l += ls;
        bf16x8 pa[2];
#pragma unroll
        for (int s2 = 0; s2 < 2; ++s2) { v4u w; w.x = cvtpk(p[8 * s2 + 0], p[8 * s2 + 1]); w.y = cvtpk(p[8 * s2 + 2], p[8 * s2 + 3]); w.z = cvtpk(p[8 * s2 + 4], p[8 * s2 + 5]); w.w = cvtpk(p[8 * s2 + 6], p[8 * s2 + 7]); pa[s2] = __builtin_bit_cast(bf16x8, w); }
#pragma unroll
        for (int d0 = 0; d0 < 2; ++d0)
#pragma unroll
            for (int s2 = 0; s2 < 2; ++s2) {
                const LAS unsigned char* a1 = vb + (16 * s2 + 4 * hi + q_) * 128 + (32 * d0 + 16 * kq + 4 * p_) * 2;
                const v4i16_t lo4 = __builtin_amdgcn_ds_read_tr16_b64_v4i16((LAS v4i16_t*)a1), hi4 = __builtin_amdgcn_ds_read_tr16_b64_v4i16((LAS v4i16_t*)(a1 + 8 * 128));
                const bf16x8 vf = (bf16x8){lo4[0], lo4[1], lo4[2], lo4[3], hi4[0], hi4[1], hi4[2], hi4[3]};
                o[d0] = __builtin_amdgcn_mfma_f32_32x32x16_bf16(vf, pa[s2], o[d0], 0, 0, 0);
            }
        return false;
    };
    for (int i = 0; i < nseq; i += 2) {
        if (i + 2 < nseq) FOX_LOAD(krA, vrA, brA, tlast - (i + 2));
        if (compute(tlast - i, 0)) break;
        if (i + 1 < nseq) {
            FOX_STORE(krB, vrB, brB, 1);
            if (i + 3 < nseq) FOX_LOAD(krB, vrB, brB, tlast - (i + 3));
            if (compute(tlast - (i + 1), 1)) break;
            if (i + 2 < nseq) FOX_STORE(krA, vrA, brA, 0);
        }
    }
#undef FOX_LOAD
#undef FOX_STORE
    l += __shfl_xor(l, 32);
    const float inv = 1.0f / l;
    bf16* orow = Ow + (size_t)r32 * 512;
#pragma unroll
    for (int d0 = 0; d0 < 2; ++d0)
#pragma unroll
        for (int g = 0; g < 4; ++g) { u32x2 w; w.x = cvtpk(o[d0][4 * g] * inv, o[d0][4 * g + 1] * inv); w.y = cvtpk(o[d0][4 * g + 2] * inv, o[d0][4 * g + 3] * inv);
            *(u32x2*)(orow + d0 * 32 + 8 * g + 4 * hi) = w; }
}
#ifndef DBG_BRANCH_MASK
#define DBG_BRANCH_MASK 7
#endif
#ifndef DBG_NBR
#define DBG_NBR 3
#endif
#ifndef DBG_NOGATE
#define DBG_NOGATE 0
#endif
#ifndef DBG_NOBRANCH
#define DBG_NOBRANCH 0
#endif
#ifndef DBG_GATE_W
#define DBG_GATE_W WS_WGATE
#endif
#ifndef DBG_GATE_AS_BRANCH
#define DBG_GATE_AS_BRANCH 0
#endif
#ifndef REP_FOX
#define REP_FOX 1
#endif
#ifndef REP_DSA
#define REP_DSA 1
#endif
#ifndef REP_GEMM
#define REP_GEMM 1
#endif
#ifndef DBG_SUBST
#define DBG_SUBST 0
#endif
#ifndef P7SEL
#define P7SEL 3
#endif
#ifndef PHMASK
#define PHMASK 0xFFFF
#endif
struct Args { const void* in[24]; float* out; unsigned char* ws; };
#define CONVERT_GROUP(GRP, w_, nw_) do { \
    constexpr int I_GU = 16 * 176, I_D = 44 * 32, I_IN = 16 * 104, I_GT = 16 * 96, I_BR = 8 * 32, I_SQ = 16 * 32; \
    constexpr int NIT = (GRP) == 0 ? I_GU + I_SQ : (GRP) == 1 ? I_D + I_IN + I_GT + 3 * I_BR + I_SQ : I_GU + I_D; \
    LAS float* scr_ = (LAS float*)(L + RING_OFF + wave * 16384); \
    for (int it = (w_); it < NIT; it += (nw_)) { int r = it; \
        if ((GRP) == 0) { \
            if (r < I_GU) { transpose_item<true>(0, ARG_IN(4), ARG_IN(5), 1024, DFF, ARG_IN(3), WSP(bf16, WS_WGU1), scr_, r, 176, lane); continue; } r -= I_GU; \
            transpose_item<true>(1, ARG_IN(17), nullptr, 1024, 1024, ARG_IN(8), WSP(bf16, WS_WMKV), scr_, r, 32, lane); \
        } else if ((GRP) == 1) { \
            if (r < I_D) { transpose_item<false>(1, ARG_IN(6), nullptr, DFF, 1024, nullptr, WSP(bf16, WS_WD1), scr_, r, 32, lane); continue; } r -= I_D; \
            if (r < I_IN) { transpose_item<true>(2, ARG_IN(9), nullptr, 1024, DIN, ARG_IN(7), WSP(bf16, WS_WIN), scr_, r, 104, lane); continue; } r -= I_IN; \
            if (r < I_GT) { transpose_item<true>(3, ARG_IN(9), nullptr, 1024, DIN, ARG_IN(7), WSP(bf16, WS_WGATE), scr_, r, 96, lane); continue; } r -= I_GT; \
            if (r < 3 * I_BR) { const int i = r / I_BR; transpose_item<false>(1, ARG_IN(18) + (size_t)i * 512 * 1024, nullptr, 512, 1024, nullptr, WSP(bf16, WS_WBR) + (size_t)i * 1024 * 512, scr_, r % I_BR, 32, lane); continue; } r -= 3 * I_BR; \
            transpose_item<false>(1, ARG_IN(19), nullptr, 1024, 1024, nullptr, WSP(bf16, WS_WOUT), scr_, r, 32, lane); \
        } else { \
            if (r < I_GU) { transpose_item<true>(0, ARG_IN(21), ARG_IN(22), 1024, DFF, ARG_IN(20), WSP(bf16, WS_WGU2), scr_, r, 176, lane); continue; } r -= I_GU; \
            transpose_item<false>(1, ARG_IN(23), nullptr, DFF, 1024, nullptr, WSP(bf16, WS_WD2), scr_, r, 32, lane); \
        } } } while (0)
__global__ void __launch_bounds__(NWAVES * 64, 2) fwd_mega(Args args) {
    extern __shared__ __attribute__((aligned(16))) unsigned char lds[];
    LAS unsigned char* L = (LAS unsigned char*)lds;
    volatile LAS unsigned* MISC = (volatile LAS unsigned*)(L + MISC_OFF);
    const int tid = threadIdx.x, lane = tid & 63, wave = __builtin_amdgcn_readfirstlane(tid >> 6);
    const int G = gridDim.x; const int bx = blockIdx.x; const int vcu = (G % 8 == 0) ? (bx % 8) * (G / 8) + bx / 8 : bx;
    const Args* ap = (const Args*)__builtin_amdgcn_kernarg_segment_ptr();
#define ARG_IN(k) ((const float*)ap->in[k])
#define WSP(type, off) ((type*)(ap->ws + (off)))
    gu32* ctl = (gu32*)(ap->ws + WS_CTL);
    for (int u = tid; u < (LDS_BYTES - LDSCTL_OFF) / 4; u += NWAVES * 64) ((LAS unsigned*)(L + LDSCTL_OFF))[u] = 0u;
    __syncthreads();
    XcdBarrier bar = xcd_barrier_post((unsigned*)(ctl + CW_BAR), MISC + 8);
#define GRID_BAR() xcd_barrier(bar)
    const int gw = vcu * NWAVES + wave, NGW = G * NWAVES;

#if (PHMASK >> 0) & 1
    {
        LAS float* scr = (LAS float*)(L + RING_OFF + wave * 16384);
        CONVERT_GROUP(0, gw, NGW);
        for (int m0 = gw; m0 < T + 512; m0 += 4 * NGW) {
            const float* xr[4]; bf16* orw[4]; float* ro[4]; bool ok[4];
#pragma unroll
            for (int r = 0; r < 4; ++r) { const int m = m0 + r * NGW; ok[r] = m < T + 512; const int mc = ok[r] ? m : gw;
                if (mc < T) { xr[r] = ARG_IN(0) + (size_t)mc * 1024; orw[r] = WSP(bf16, WS_HB) + (size_t)mc * 1024; ro[r] = WSP(float, WS_RSTDX) + mc; }
                else { xr[r] = ARG_IN(1) + (size_t)(mc - T) * 1024; orw[r] = WSP(bf16, WS_MEMB) + (size_t)(mc - T) * 1024; ro[r] = WSP(float, WS_RSTDM) + (mc - T); } }
            rows4_to_bf16_rstd(xr, orw, ro, ok, lane);
        }
        VM_WAIT(); __syncthreads();
        GRID_BAR();
    }
#endif
#if (PHMASK >> 1) & 1
    {
        if (bx >= G - 8) { pg8::Gemm g{WSP(bf16, WS_MEMB), WSP(bf16, WS_WMKV), 512, 1024, 1024}; pg8::StaticOrder S; S.init(512, 1024, G, bx - (G - 8));
        pg8::EpiMemKV E{WSP(float, WS_KVM), WSP(float, WS_RSTDM)};
        pg8::gemm_phase<pg8::EpiMemKV, pg8::StaticOrder, true, true>(L + RING_OFF, g, S, E); }
    }
#endif
#if (PHMASK >> 2) & 1
    {
        pg8::Gemm g{WSP(bf16, WS_HB), WSP(bf16, WS_WGU1), T, 2 * DFF, 1024}; pg8::StaticOrder S; S.init(T, 2 * DFF, G, bx);
        pg8::build_row_tab<0>(WSP(float, WS_RSTDX), S, (LAS float*)(L + RING_BYTES + 1024)); pg8::EpiSwiGLU<0> E{WSP(bf16, WS_HID), DFF, (LAS float*)(L + RING_BYTES + 1024)};
#pragma unroll 1
        for (int rep_ = 0; rep_ < REP_GEMM; ++rep_)
        pg8::gemm_phase<pg8::EpiSwiGLU<0>, pg8::StaticOrder, true, true>(L + RING_OFF, g, S, E);
        {
            const int nfull = (64 * 22) % G; const int nidle = (nfull == 0) ? G : G - nfull; const int first = G - nidle;
            const int nconv = nidle > 8 ? nidle - 8 : nidle; const bool conv = (bx >= first) && (bx - first < nconv);
            if (conv) { CONVERT_GROUP(1, (bx - first) * NWAVES + wave, nconv * NWAVES);
                for (int e = (bx - first) * NWAVES * 64 + tid; e < T * 32; e += nconv * NWAVES * 64) {
                    const int row = e >> 5, i = e & 31; const float inv_freq = powf(10000.0f, -(float)i * (1.0f / 32.0f));
                    const float ang = (float)((const int*)ap->in[2])[row] * inv_freq; float sn, cs; sincosf(ang, &sn, &cs); WSP(float, WS_COS)[e] = cs; WSP(float, WS_SIN)[e] = sn; } }
        }
        GRID_BAR();
    }
#endif
#if (PHMASK >> 3) & 1
    {
        pg8::Gemm g{WSP(bf16, WS_HID), WSP(bf16, WS_WD1), T, 1024, DFF}; pg8::StaticOrder S; S.init(T, 1024, G, bx);
        pg8::EpiResid3<0> E{ARG_IN(0), nullptr, WSP(bf16, WS_HB), WSP(float, WS_SSQ1), 0.5f};
#pragma unroll 1
        for (int rep_ = 0; rep_ < REP_GEMM; ++rep_)
        pg8::gemm_phase<pg8::EpiResid3<0>, pg8::StaticOrder, true, true>(L + RING_OFF, g, S, E);
        GRID_BAR();
    }
#endif
#if (PHMASK >> 4) & 1
    {
        pg8::Gemm g{WSP(bf16, WS_HB), WSP(bf16, WS_WIN), T, NPROJ, 1024}; pg8::StaticOrder S; S.init(T, NPROJ, G, bx);
        pg8::ProjOut PO{WSP(bf16, WS_FQ), WSP(bf16, WS_FK), WSP(bf16, WS_FV), WSP(bf16, WS_DQ), WSP(bf16, WS_IQ), WSP(bf16, WS_MQ), WSP(bf16, WS_DK), WSP(bf16, WS_DV), WSP(bf16, WS_IK), WSP(float, WS_LOGF), WSP(float, WS_IW), WSP(float, WS_COS), WSP(float, WS_SIN), ARG_IN(11), ARG_IN(12), ARG_IN(13), ARG_IN(14), ARG_IN(10)};
        pg8::build_row_tab<16>(WSP(float, WS_SSQ1), S, (LAS float*)(L + RING_BYTES + 1024)); pg8::EpiProj<16> E{PO, (LAS float*)(L + RING_BYTES + 1024), C2_64};
#pragma unroll 1
        for (int rep_ = 0; rep_ < REP_GEMM; ++rep_)
        pg8::gemm_phase<pg8::EpiProj<16>, pg8::StaticOrder, true, true>(L + RING_OFF, g, S, E);
        {
            const int nfull = (64 * 13) % G; const int nidle = (nfull == 0) ? G : G - nfull; const int first = G - nidle;
            if (bx >= first) { CONVERT_GROUP(2, (bx - first) * NWAVES + wave, nidle * NWAVES);
        for (int it = (bx - first) * NWAVES + wave; it < 2048; it += nidle * NWAVES) { const int row = it >> 2, h = it & 3;
                    const f32x2g kv = *(const f32x2g*)(WSP(float, WS_KVM) + (size_t)row * 1024 + h * 128 + 2 * lane); const f32x2g vv = *(const f32x2g*)(WSP(float, WS_KVM) + (size_t)row * 1024 + 512 + h * 128 + 2 * lane);
                    const float ss = wave_sum(kv.x * kv.x + kv.y * kv.y); const float rstd = 1.0f / sqrtf(ss * (1.0f / 128.0f) + 1e-6f);
                    const f32x2g gk = *(const f32x2g*)(ARG_IN(16) + 2 * lane);
                    *(unsigned*)(WSP(bf16, WS_KMB) + (size_t)row * 512 + h * 128 + 2 * lane) = pk2(kv.x * rstd * gk.x, kv.y * rstd * gk.y);
                    *(unsigned*)(WSP(bf16, WS_VMB) + (size_t)row * 512 + h * 128 + 2 * lane) = pk2(vv.x, vv.y); } }
        }
        GRID_BAR();
#if defined(DBG_DUMP_AFTER) && DBG_DUMP_AFTER == 4
        {
            const bf16* sa = WSP(bf16, DBG_DUMP_A); const bf16* sb = WSP(bf16, DBG_DUMP_B);
            for (size_t e = (size_t)vcu * 512 + tid; e < (size_t)T * 512; e += (size_t)G * 512) { const size_t row = e >> 9, c = e & 511;
                ap->out[row * 1024 + c] = bf2f(sa[row * DBG_PITCH + c]); ap->out[row * 1024 + 512 + c] = bf2f(sb[row * DBG_PITCH + c]); }
            return;
        }
#endif

    }
#endif
#if ((PHMASK >> 5) & 1) && !DBG_SUBST
    {
        for (int u = vcu; u < 256; u += G) mem_block(u, WSP(bf16, WS_MQ), WSP(bf16, WS_KMB), WSP(bf16, WS_VMB), ARG_IN(15), L, wave, lane, tid);
    }
#endif
#if ((PHMASK >> 6) & 1) && !DBG_SUBST
    {
        for (int rep_ = 0; rep_ < REP_FOX; ++rep_)
        for (int v = vcu; v < 256; v += G) { const int bh = v >> 4, s = v & 15;
            scan_unit(bh, WSP(float, WS_LOGF), WSP(float, WS_CUM), WSP(int, WS_T0), ARG_IN(11), ARG_IN(12), (LAS float*)(L + SCANX_OFF), (LAS float*)(L + RING_OFF), tid);
            asm volatile("s_waitcnt vmcnt(0)" ::: "memory"); __syncthreads();
            fox_unit4(bh, s, WSP(bf16, WS_FQ), WSP(bf16, WS_FK), WSP(bf16, WS_FV), WSP(float, WS_CUM), WSP(int, WS_T0), ARG_IN(11), ARG_IN(12), WSP(bf16, WS_OA), L, wave, lane); fox_unit4(bh, 31 - s, WSP(bf16, WS_FQ), WSP(bf16, WS_FK), WSP(bf16, WS_FV), WSP(float, WS_CUM), WSP(int, WS_T0), ARG_IN(11), ARG_IN(12), WSP(bf16, WS_OA), L, wave, lane); }
        __syncthreads();
        {
            gu32* qctr = ctl + CW_Q; LAS int* QW = (LAS int*)(L + D3_QW);
            const int pref = (vcu >> 5) & 1;
            unsigned raw = 0u; int cur;
            if (tid == 0) { unsigned u = __hip_atomic_fetch_add(qctr + 64 * pref, 1u, RLX_AGENT); int bsel = pref; if (u >= 512u) { bsel = pref ^ 1; u = __hip_atomic_fetch_add(qctr + 64 * bsel, 1u, RLX_AGENT); } QW[0] = (u < 512u) ? ((bsel << 16) | (int)u) : -1; }
            __syncthreads(); cur = QW[0]; __syncthreads();
            while (cur >= 0) {
                if (tid == 0) raw = __hip_atomic_fetch_add(qctr + 64 * pref, 1u, RLX_AGENT);
                dsa3_unit(cur >> 16, 511 - (cur & 0xffff), WSP(bf16, WS_IQ), WSP(bf16, WS_IK), WSP(float, WS_IW), WSP(bf16, WS_DQ), WSP(bf16, WS_DK), WSP(bf16, WS_DV), WSP(bf16, WS_OB), L, wave, lane);
                if (tid == 0) { unsigned u = raw; int bsel = pref; if (u >= 512u) { bsel = pref ^ 1; u = __hip_atomic_fetch_add(qctr + 64 * bsel, 1u, RLX_AGENT); } QW[0] = (u < 512u) ? ((bsel << 16) | (int)u) : -1; }
                __syncthreads(); cur = QW[0]; __syncthreads();
            }
        }
        GRID_BAR();
    }
#endif
#if (PHMASK >> 7) & 1
    {
        pg8::StaticOrder S; S.init(T, 1024, G, bx); pg8::build_row_tab<16>(WSP(float, WS_SSQ1), S, (LAS float*)(L + RING_BYTES + 1024));
#ifndef P7STREAM
#define P7STREAM 1
#endif
#if P7STREAM
        {   typedef pg8::P7Order<WS_HB, WS_WGATE, WS_OA, WS_OB, WS_MQ, WS_WBR> P7O; P7O O{S, (const char*)WSP(char, 0)};
            pg8::EpiP7 E{WSP(bf16, WS_GSCR), WSP(bf16, WS_MERGED), (LAS float*)(L + RING_BYTES + 1024)};
#ifndef REP_P7
#define REP_P7 1
#endif
#pragma unroll 1
            for (int rep7_ = 0; rep7_ < REP_P7; ++rep7_) pg8::gemm_stream<pg8::EpiP7, P7O>(L + RING_OFF, O, E); }
#pragma unroll 1
        for (int i = 0; i < 0; ++i) {
#else
#pragma unroll 1
        for (int rep_ = 0; rep_ < REP_GEMM; ++rep_)
#pragma unroll 1
        for (int i = 0; i < DBG_NBR; ++i) {
#endif
#if DBG_GATE_AS_BRANCH
            {   pg8::Gemm g{WSP(bf16, WS_HB), WSP(bf16, DBG_GATE_W), T, 1024, 1024}; pg8::EpiBranch E{WSP(bf16, WS_GSCR), WSP(bf16, WS_MERGED), true, 1.0f}; pg8::gemm_phase<pg8::EpiBranch, pg8::StaticOrder, true, true>(L + RING_OFF, g, S, E); }
#elif !DBG_NOGATE
            {   pg8::Gemm g{WSP(bf16, WS_HB), WSP(bf16, DBG_GATE_W) + (size_t)i * 1024 * 1024, T, 1024, 1024}; pg8::EpiGate<16> E{WSP(bf16, WS_GSCR), (LAS float*)(L + RING_BYTES + 1024)}; pg8::gemm_phase<pg8::EpiGate<16>, pg8::StaticOrder, true, true>(L + RING_OFF, g, S, E); }
#endif
#if !DBG_NOBRANCH
#if DBG_SUBST == 1
            {   const bf16* A = (i == 0) ? WSP(bf16, WS_FQ) : (i == 1) ? WSP(bf16, WS_DQ) : WSP(bf16, WS_IQ);
#elif DBG_SUBST == 2
            {   const bf16* A = (i == 0) ? WSP(bf16, WS_FK) : (i == 1) ? WSP(bf16, WS_FV) : WSP(bf16, WS_MQ);
#else
            {   const bf16* A = (i == 0) ? WSP(bf16, WS_OA) : (i == 1) ? WSP(bf16, WS_OB) : WSP(bf16, WS_MQ);
#endif
                pg8::Gemm g{A, WSP(bf16, WS_WBR) + (size_t)i * 1024 * 512, T, 1024, 512}; pg8::EpiBranch E{WSP(bf16, WS_GSCR), WSP(bf16, WS_MERGED), i == 0, ((DBG_BRANCH_MASK >> i) & 1) ? 1.0f : 0.0f}; pg8::gemm_phase<pg8::EpiBranch, pg8::StaticOrder, true, true>(L + RING_OFF, g, S, E); }
#endif
        }
        GRID_BAR();
#if defined(DBG_DUMP_AFTER) && DBG_DUMP_AFTER == 7
        {
            const bf16* sa = WSP(bf16, DBG_DUMP_A); const bf16* sb = WSP(bf16, DBG_DUMP_B);
            for (size_t e = (size_t)vcu * 512 + tid; e < (size_t)T * 512; e += (size_t)G * 512) { const size_t row = e >> 9, c = e & 511;
                ap->out[row * 1024 + c] = bf2f(sa[row * DBG_PITCH + c]); ap->out[row * 1024 + 512 + c] = bf2f(sb[row * DBG_PITCH + c]); }
            return;
        }
#endif

    }
#endif
#if (PHMASK >> 8) & 1
    {
        pg8::Gemm g{WSP(bf16, WS_MERGED), WSP(bf16, WS_WOUT), T, 1024, 1024}; pg8::StaticOrder S; S.init(T, 1024, G, bx);
        pg8::EpiResid3<1> E{nullptr, nullptr, WSP(bf16, WS_HB), WSP(float, WS_SSQ2), 1.0f};
        pg8::gemm_phase<pg8::EpiResid3<1>, pg8::StaticOrder, true, true>(L + RING_OFF, g, S, E);
        GRID_BAR();
    }
#endif
#if (PHMASK >> 9) & 1
    {
        pg8::Gemm g{WSP(bf16, WS_HB), WSP(bf16, WS_WGU2), T, 2 * DFF, 1024}; pg8::StaticOrder S; S.init(T, 2 * DFF, G, bx);
        pg8::build_row_tab<16>(WSP(float, WS_SSQ2), S, (LAS float*)(L + RING_BYTES + 1024)); pg8::EpiSwiGLU<16> E{WSP(bf16, WS_HID), DFF, (LAS float*)(L + RING_BYTES + 1024)};
#pragma unroll 1
        for (int rep_ = 0; rep_ < REP_GEMM; ++rep_)
        pg8::gemm_phase<pg8::EpiSwiGLU<16>, pg8::StaticOrder, true, true>(L + RING_OFF, g, S, E);
        GRID_BAR();
    }
#endif
#if (PHMASK >> 10) & 1
    {
        pg8::Gemm g{WSP(bf16, WS_HID), WSP(bf16, WS_WD2), T, 1024, DFF}; pg8::StaticOrder S; S.init(T, 1024, G, bx);
        pg8::EpiResid3<2> E{nullptr, ap->out, WSP(bf16, WS_HB), nullptr, 0.5f};
        pg8::gemm_phase<pg8::EpiResid3<2>, pg8::StaticOrder, true, true>(L + RING_OFF, g, S, E);
    }
#endif
}

extern "C" void kernel_launch(void* const* d_in, const int* in_sizes, int n_in, void* d_out, int out_size, void* d_ws, size_t ws_size, hipStream_t stream) {
    static int grid = 0;
    if (grid == 0) {
        if (n_in != 24 || out_size != T * DM || ws_size < WS_END) { fprintf(stderr, "kernel_launch: unexpected problem (n_in %d, out %d, ws %zu)\n", n_in, out_size, ws_size); grid = -1; return; }
        int dev = 0, cus = 0, per_cu = 0;
        if (hipGetDevice(&dev) != hipSuccess || hipDeviceGetAttribute(&cus, hipDeviceAttributeMultiprocessorCount, dev) != hipSuccess) { grid = -1; return; }
        if (hipFuncSetAttribute((const void*)fwd_mega, hipFuncAttributeMaxDynamicSharedMemorySize, LDS_BYTES) != hipSuccess) { fprintf(stderr, "kernel_launch: hipFuncSetAttribute failed\n"); grid = -1; return; }
        if (hipOccupancyMaxActiveBlocksPerMultiprocessor(&per_cu, (const void*)fwd_mega, NWAVES * 64, LDS_BYTES) != hipSuccess || per_cu < 1) { fprintf(stderr, "kernel_launch: occupancy query says %d blocks per CU\n", per_cu); (void)hipGetLastError(); grid = -1; return; }
        grid = cus;
    }
    if (grid < 0) return;
    (void)hipMemsetAsync((char*)d_ws + WS_CTL, 0, CTL_ZERO_BYTES, stream);
    Args a{};
    for (int i = 0; i < 24; ++i) a.in[i] = d_in[i];
    a.out = (float*)d_out; a.ws = (unsigned char*)d_ws;
    hipLaunchKernelGGL(fwd_mega, dim3(grid), dim3(NWAVES * 64), LDS_BYTES, stream, a);
}
```

```cpp
#include <hip/hip_runtime.h>
#include <cstdio>
#include <cstdint>
namespace pg8 {
#define PG8_LAS __attribute__((address_space(3)))
typedef unsigned short bf16_t;
typedef short bf16x8 __attribute__((ext_vector_type(8)));
typedef float f32x4 __attribute__((ext_vector_type(4)));
typedef unsigned u32x4 __attribute__((ext_vector_type(4)));
constexpr int BM = 256, BK = 64, HALF = 128, HTB = HALF * BK * 2  , STAGE_BYTES = 8 * HTB, NXCD = 8, WGM = 8;

__host__ __device__ __forceinline__ int lds_byte(int r, int c) { const int st = (r >> 4) * 2 + (c >> 5), rr = r & 15, cc = c & 31, ob = rr * 64 + cc * 2; return st * 1024 + (ob ^ (((ob >> 9) & 1) << 5)); }
__host__ __device__ __forceinline__ void stage_rc(int b, int& R, int& C) { const int st = b / 1024, sb = b % 1024, swz = sb ^ (((sb >> 9) & 1) << 5); R = (st >> 1) * 16 + swz / 64; C = (st & 1) * 32 + (swz % 64) / 2; }
__host__ __device__ __forceinline__ int perm32(int rho) { const int n = rho >> 4, i = rho & 15; return 8 * (i >> 2) + 4 * n + (i & 3); }

struct Unit { int pm, pn; };
struct Gemm { const bf16_t* A; const bf16_t* Bt; int M, N, K; };

struct StaticOrder {
    int nM, nN, nwg, G, c;
    __host__ __device__ void init(int M, int N, int G_, int c_) { nM = M / BM; nN = N / BM; nwg = nM * nN; G = G_; c = c_; }
    __host__ __device__ bool next(int i, Unit& u) const {
        const long L = (long)i * G + c; if (L >= nwg) return false;
        int wgid = (int)L; { const int q = nwg / NXCD, r = nwg % NXCD, xcd = wgid % NXCD, off = wgid / NXCD; wgid = (xcd < r ? xcd * (q + 1) : r * (q + 1) + (xcd - r) * q) + off; }
        const int nig = WGM * nN, gid = wgid / nig, fm = gid * WGM, gsz = (nM - fm) < WGM ? (nM - fm) : WGM;
        u.pm = fm + ((wgid % nig) % gsz); u.pn = (wgid % nig) / gsz; return true;
    }
    __device__ __forceinline__ void a_ready(const Unit&) const {}
    __device__ __forceinline__ void done(const Unit&) const {}
};

typedef float f32x2cv __attribute__((ext_vector_type(2))); typedef __bf16 bf16x2cv __attribute__((ext_vector_type(2)));
__device__ __forceinline__ unsigned cvt_pk_bf16(float lo, float hi) { const f32x2cv v = {lo, hi}; const bf16x2cv b = __builtin_convertvector(v, bf16x2cv); return __builtin_bit_cast(unsigned, b); }
typedef float f32x2 __attribute__((ext_vector_type(2)));
template <class Epi, class Sched, bool ALIGN_EPI = false, bool SP2 = false>
__device__ __forceinline__ void gemm_phase(PG8_LAS unsigned char* lds, const Gemm g, const Sched& S, const Epi& E) {
    int tid_ = threadIdx.x; asm volatile("" : "+v"(tid_));
    const int tid = tid_, wid = __builtin_amdgcn_readfirstlane(tid >> 6), lane = tid & 63, wr = wid >> 2, wc = wid & 3, fr = lane & 15, fq = lane >> 4;
    const int K = g.K, nt = K / BK;
    unsigned voffA[2], voffB[2];
#pragma unroll
    for (int i = 0; i < 2; ++i) { int R, C; stage_rc(tid * 16 + i * 8192, R, C); const int Rb = Epi::PERM ? ((R & ~31) + perm32(R & 31)) : R;
        voffA[i] = (unsigned)(R * K + C) * 2u; voffB[i] = (unsigned)(Rb * K + C) * 2u; }
    const size_t kstep = (size_t)(BK * 2);
    const size_t hstep = (size_t)HALF * K * 2;
    const size_t tstep = 2 * hstep;
    const unsigned ldsw = (unsigned)wid * 1024u;
    const int aoff = lds_byte(wr * 64 + fr, fq * 8), boff = lds_byte(wc * 32 + fr, fq * 8);
#define PG8_SA(b, h) (((b) * 2 + (h)) * HTB)
#define PG8_SB(b, h) ((4 + (b) * 2 + (h)) * HTB)
#define PG8_STAGE(bufoff, gbase, voff) do { _Pragma("unroll") for (int _i = 0; _i < 2; ++_i) \
        __builtin_amdgcn_global_load_lds((const unsigned*)((const char*)(gbase) + (voff)[_i]), (PG8_LAS unsigned*)(lds + (bufoff) + ldsw + _i * 8192), 16, 0, 0); } while (0)
#define PG8_LDA(dst, b, h) do { _Pragma("unroll") for (int m = 0; m < 4; ++m) _Pragma("unroll") for (int k = 0; k < 2; ++k) dst[m][k] = *(const PG8_LAS bf16x8*)(lds + PG8_SA(b, h) + aoff + m * 2048 + k * 1024); } while (0)
#define PG8_LDB(dst, b, h) do { _Pragma("unroll") for (int n = 0; n < 2; ++n) _Pragma("unroll") for (int k = 0; k < 2; ++k) dst[n][k] = *(const PG8_LAS bf16x8*)(lds + PG8_SB(b, h) + boff + n * 2048 + k * 1024); } while (0)
#define PG8_MMA(ai, bj, At, Bt) do { __builtin_amdgcn_s_setprio(1); _Pragma("unroll") for (int m = 0; m < 4; ++m) _Pragma("unroll") for (int n = 0; n < 2; ++n) _Pragma("unroll") for (int k = 0; k < 2; ++k) \
        acc[ai][bj][m][n] = __builtin_amdgcn_mfma_f32_16x16x32_bf16(Bt[n][k], At[m][k], acc[ai][bj][m][n], 0, 0, 0); __builtin_amdgcn_s_setprio(0); } while (0)
#define PG8_WAIT_V(n) asm volatile("s_waitcnt vmcnt(" #n ")" ::: "memory")
#define PG8_WAIT_L(n) asm volatile("s_waitcnt lgkmcnt(" #n ")" ::: "memory")
#define PG8_BAR __builtin_amdgcn_s_barrier()
#define PG8_SCHED __builtin_amdgcn_sched_barrier(0)
    Unit cur, nxt; int ui = 0;
    if (!S.next(0, cur)) return;
    f32x4 acc[2][2][4][2];
#pragma unroll
    for (int a = 0; a < 2; ++a)
#pragma unroll
        for (int b = 0; b < 2; ++b)
#pragma unroll
            for (int m = 0; m < 4; ++m)
#pragma unroll
                for (int n = 0; n < 2; ++n) acc[a][b][m][n] = (f32x4){0.f, 0.f, 0.f, 0.f};
    bf16x8 At[4][2], B0[2][2], B1[2][2];
    const char* cA = (const char*)g.A + (size_t)cur.pm * tstep; const char* cB = (const char*)g.Bt + (size_t)cur.pn * tstep;
    S.a_ready(cur);
    if constexpr (SP2) {
        PG8_STAGE(PG8_SB(0, 0), cB, voffB); PG8_STAGE(PG8_SB(0, 1), cB + hstep, voffB); PG8_STAGE(PG8_SA(0, 0), cA, voffA); PG8_STAGE(PG8_SA(0, 1), cA + hstep, voffA);
        if (wr == 1) PG8_BAR;
        PG8_WAIT_V(2); PG8_BAR;
        PG8_STAGE(PG8_SB(1, 0), cB + kstep, voffB); PG8_STAGE(PG8_SA(1, 0), cA + kstep, voffA); PG8_STAGE(PG8_SB(1, 1), cB + hstep + kstep, voffB);
        PG8_WAIT_V(6); PG8_BAR;
    } else {
        PG8_STAGE(PG8_SB(0, 0), cB, voffB); PG8_STAGE(PG8_SA(0, 0), cA, voffA); PG8_STAGE(PG8_SB(0, 1), cB + hstep, voffB); PG8_STAGE(PG8_SA(0, 1), cA + hstep, voffA);
        if (wr == 1) PG8_BAR;
        PG8_WAIT_V(4); PG8_BAR;
        PG8_STAGE(PG8_SB(1, 0), cB + kstep, voffB); PG8_STAGE(PG8_SA(1, 0), cA + kstep, voffA); PG8_STAGE(PG8_SB(1, 1), cB + hstep + kstep, voffB);
        PG8_WAIT_V(6); PG8_BAR;
    }
    for (;;) {
        const bool has_next = S.next(ui + 1, nxt);
        const char* nA = has_next ? (const char*)g.A + (size_t)nxt.pm * tstep : cA; const char* nB = has_next ? (const char*)g.Bt + (size_t)nxt.pn * tstep : cB;
        for (int t = 0; t < nt; t += 2) {
            const bool last = (t == nt - 2);
            const char* a1 = cA + (size_t)(t + 1) * kstep;
            const char* a2 = last ? nA : cA + (size_t)(t + 2) * kstep; const char* b2 = last ? nB : cB + (size_t)(t + 2) * kstep;
            const char* a3 = a2 + kstep; const char* b3 = b2 + kstep;
            if (last && has_next) S.a_ready(nxt);
            if constexpr (SP2) {
            PG8_LDB(B0, 0, 0); PG8_LDB(B1, 0, 1); PG8_SCHED; PG8_LDA(At, 0, 0); PG8_STAGE(PG8_SA(1, 1), a1 + hstep, voffA);
            PG8_WAIT_V(8); PG8_WAIT_L(0); PG8_BAR; PG8_MMA(0, 0, At, B0); PG8_MMA(0, 1, At, B1); PG8_BAR; PG8_SCHED;
            PG8_LDA(At, 0, 1); PG8_STAGE(PG8_SB(0, 0), b2, voffB); PG8_STAGE(PG8_SB(0, 1), b2 + hstep, voffB); PG8_STAGE(PG8_SA(0, 0), a2, voffA);
            PG8_WAIT_V(8); PG8_WAIT_L(0); PG8_BAR; PG8_MMA(1, 0, At, B0); PG8_MMA(1, 1, At, B1); PG8_BAR; PG8_SCHED;
            PG8_LDB(B0, 1, 0); PG8_LDB(B1, 1, 1); PG8_SCHED; PG8_LDA(At, 1, 0); PG8_STAGE(PG8_SA(0, 1), a2 + hstep, voffA);
            PG8_WAIT_V(8); PG8_WAIT_L(0); PG8_BAR; PG8_MMA(0, 0, At, B0); PG8_MMA(0, 1, At, B1); PG8_BAR; PG8_SCHED;
            PG8_LDA(At, 1, 1); PG8_STAGE(PG8_SB(1, 0), b3, voffB); PG8_STAGE(PG8_SB(1, 1), b3 + hstep, voffB); PG8_STAGE(PG8_SA(1, 0), a3, voffA);
            PG8_WAIT_V(8); PG8_WAIT_L(0); PG8_BAR; PG8_MMA(1, 0, At, B0); PG8_MMA(1, 1, At, B1); PG8_BAR; PG8_SCHED;
            } else {
            PG8_LDB(B0, 0, 0); PG8_SCHED; PG8_LDA(At, 0, 0); PG8_STAGE(PG8_SA(1, 1), a1 + hstep, voffA);
            PG8_WAIT_L(8); PG8_BAR; PG8_WAIT_L(0); PG8_MMA(0, 0, At, B0); PG8_BAR; PG8_SCHED;
            PG8_LDB(B1, 0, 1); PG8_STAGE(PG8_SB(0, 0), b2, voffB);
            PG8_BAR; PG8_WAIT_L(0); PG8_MMA(0, 1, At, B1); PG8_BAR;
            PG8_LDA(At, 0, 1); PG8_STAGE(PG8_SA(0, 0), a2, voffA);
            PG8_BAR; PG8_WAIT_L(0); PG8_MMA(1, 0, At, B0); PG8_BAR; PG8_SCHED;
            PG8_STAGE(PG8_SB(0, 1), b2 + hstep, voffB);
            PG8_WAIT_V(6); PG8_BAR; PG8_MMA(1, 1, At, B1); PG8_BAR;
            PG8_LDB(B0, 1, 0); PG8_SCHED; PG8_LDA(At, 1, 0); PG8_STAGE(PG8_SA(0, 1), a2 + hstep, voffA);
            PG8_WAIT_L(8); PG8_BAR; PG8_WAIT_L(0); PG8_MMA(0, 0, At, B0); PG8_BAR; PG8_SCHED;
            PG8_LDB(B1, 1, 1); PG8_STAGE(PG8_SB(1, 0), b3, voffB);
            PG8_BAR; PG8_WAIT_L(0); PG8_MMA(0, 1, At, B1); PG8_BAR;
            PG8_LDA(At, 1, 1); PG8_STAGE(PG8_SA(1, 0), a3, voffA);
            PG8_BAR; PG8_WAIT_L(0); PG8_MMA(1, 0, At, B0); PG8_BAR; PG8_SCHED;
            PG8_STAGE(PG8_SB(1, 1), b3 + hstep, voffB);
            PG8_WAIT_V(6); PG8_BAR; PG8_MMA(1, 1, At, B1); PG8_BAR;
            }
        }
        if constexpr (ALIGN_EPI) { if (wr == 0) PG8_BAR; }
        if constexpr (!Epi::AFTER_DRAIN) { E(acc, cur, wr, wc, fr, fq); S.done(cur); }
        if (!has_next) break;
#pragma unroll
        for (int a = 0; a < 2; ++a)
#pragma unroll
            for (int b = 0; b < 2; ++b)
#pragma unroll
                for (int m = 0; m < 4; ++m)
#pragma unroll
                    for (int n = 0; n < 2; ++n) acc[a][b][m][n] = (f32x4){0.f, 0.f, 0.f, 0.f};
        cur = nxt; cA = nA; cB = nB; ++ui;
        if constexpr (ALIGN_EPI) { if (wr == 1) PG8_BAR; }
    }
    PG8_WAIT_V(0);
    if constexpr (!ALIGN_EPI) { if (wr == 0) PG8_BAR; }
    PG8_BAR;
    if constexpr (Epi::AFTER_DRAIN) { E.fused(acc, cur, wr, wc, fr, fq, lds, wid, lane); S.done(cur); }
#undef PG8_SA
#undef PG8_SB
#undef PG8_STAGE
#undef PG8_LDA
#undef PG8_LDB
#undef PG8_MMA
#undef PG8_WAIT_V
#undef PG8_WAIT_L
#undef PG8_BAR
#undef PG8_SCHED
}

struct UnitX { int pm, pn, kind, round; };
struct OpsX { const char* A; const char* Bt; int K; };
template <class Epi, class Sched>
__device__ __forceinline__ void gemm_stream(PG8_LAS unsigned char* lds, const Sched& S, const Epi& E) {
    int tid_ = threadIdx.x; asm volatile("" : "+v"(tid_));
    const int tid = tid_, wid = __builtin_amdgcn_readfirstlane(tid >> 6), lane = tid & 63, wr = wid >> 2, wc = wid & 3, fr = lane & 15, fq = lane >> 4;
    unsigned rA[2], rB[2], c2[2];
#pragma unroll
    for (int i = 0; i < 2; ++i) { int R, C; stage_rc(tid * 16 + i * 8192, R, C); rA[i] = (unsigned)R; rB[i] = (unsigned)((R & ~31) + perm32(R & 31)); c2[i] = (unsigned)C * 2u; }
    const size_t kstep = (size_t)(BK * 2);
    const unsigned ldsw = (unsigned)wid * 1024u;
    const int aoff = lds_byte(wr * 64 + fr, fq * 8), boff = lds_byte(wc * 32 + fr, fq * 8);
#define PG8_SA(b, h) (((b) * 2 + (h)) * HTB)
#define PG8_SB(b, h) ((4 + (b) * 2 + (h)) * HTB)
#define PGX_STAGE(bufoff, gbase, rr, pb) do { _Pragma("unroll") for (int _i = 0; _i < 2; ++_i) \
        __builtin_amdgcn_global_load_lds((const unsigned*)((const char*)(gbase) + ((rr)[_i] * (pb) + c2[_i])), (PG8_LAS unsigned*)(lds + (bufoff) + ldsw + _i * 8192), 16, 0, 0); } while (0)
#define PG8_LDA(dst, b, h) do { _Pragma("unroll") for (int m = 0; m < 4; ++m) _Pragma("unroll") for (int k = 0; k < 2; ++k) dst[m][k] = *(const PG8_LAS bf16x8*)(lds + PG8_SA(b, h) + aoff + m * 2048 + k * 1024); } while (0)
#define PG8_LDB(dst, b, h) do { _Pragma("unroll") for (int n = 0; n < 2; ++n) _Pragma("unroll") for (int k = 0; k < 2; ++k) dst[n][k] = *(const PG8_LAS bf16x8*)(lds + PG8_SB(b, h) + boff + n * 2048 + k * 1024); } while (0)
#define PG8_MMA(ai, bj, At, Bt) do { __builtin_amdgcn_s_setprio(1); _Pragma("unroll") for (int m = 0; m < 4; ++m) _Pragma("unroll") for (int n = 0; n < 2; ++n) _Pragma("unroll") for (int k = 0; k < 2; ++k) \
        acc[ai][bj][m][n] = __builtin_amdgcn_mfma_f32_16x16x32_bf16(Bt[n][k], At[m][k], acc[ai][bj][m][n], 0, 0, 0); __builtin_amdgcn_s_setprio(0); } while (0)
#define PG8_WAIT_V(n) asm volatile("s_waitcnt vmcnt(" #n ")" ::: "memory")
#define PG8_WAIT_L(n) asm volatile("s_waitcnt lgkmcnt(" #n ")" ::: "memory")
#define PG8_BAR __builtin_amdgcn_s_barrier()
#define PG8_SCHED __builtin_amdgcn_sched_barrier(0)
    UnitX cur, nxt; int ui = 0;
    if (!S.next(0, cur)) return;
    f32x4 acc[2][2][4][2];
#pragma unroll
    for (int a = 0; a < 2; ++a)
#pragma unroll
        for (int b = 0; b < 2; ++b)
#pragma unroll
            for (int m = 0; m < 4; ++m)
#pragma unroll
                for (int n = 0; n < 2; ++n) acc[a][b][m][n] = (f32x4){0.f, 0.f, 0.f, 0.f};
    bf16x8 At[4][2], B0[2][2], B1[2][2];
    OpsX oc = S.ops(cur);
    const char* cA = oc.A; const char* cB = oc.Bt; int Kc = oc.K;
    {   const unsigned pb = (unsigned)Kc * 2u; const size_t hstep = (size_t)HALF * pb;
        PGX_STAGE(PG8_SB(0, 0), cB, rB, pb); PGX_STAGE(PG8_SB(0, 1), cB + hstep, rB, pb); PGX_STAGE(PG8_SA(0, 0), cA, rA, pb); PGX_STAGE(PG8_SA(0, 1), cA + hstep, rA, pb);
        if (wr == 1) PG8_BAR;
        PG8_WAIT_V(2); PG8_BAR;
        PGX_STAGE(PG8_SB(1, 0), cB + kstep, rB, pb); PGX_STAGE(PG8_SA(1, 0), cA + kstep, rA, pb); PGX_STAGE(PG8_SB(1, 1), cB + hstep + kstep, rB, pb);
        PG8_WAIT_V(6); PG8_BAR; }
    for (;;) {
        const bool has_next = S.next(ui + 1, nxt);
        OpsX on = oc; if (has_next) on = S.ops(nxt);
        const char* nA = on.A; const char* nB = on.Bt; const int Kn = on.K;
        const int nt = Kc / BK; const unsigned pbc = (unsigned)Kc * 2u; const size_t hstep = (size_t)HALF * pbc;
        for (int t = 0; t < nt; t += 2) {
            const bool last = (t == nt - 2);
            const char* a1 = cA + (size_t)(t + 1) * kstep;
            const char* a2 = last ? nA : cA + (size_t)(t + 2) * kstep; const char* b2 = last ? nB : cB + (size_t)(t + 2) * kstep;
            const char* a3 = a2 + kstep; const char* b3 = b2 + kstep;
            const unsigned pb2 = last ? (unsigned)Kn * 2u : pbc; const size_t h2 = (size_t)HALF * pb2;
            PG8_LDB(B0, 0, 0); PG8_LDB(B1, 0, 1); PG8_SCHED; PG8_LDA(At, 0, 0); PGX_STAGE(PG8_SA(1, 1), a1 + hstep, rA, pbc);
            PG8_WAIT_V(8); PG8_WAIT_L(0); PG8_BAR; PG8_MMA(0, 0, At, B0); PG8_MMA(0, 1, At, B1); PG8_BAR; PG8_SCHED;
            PG8_LDA(At, 0, 1); PGX_STAGE(PG8_SB(0, 0), b2, rB, pb2); PGX_STAGE(PG8_SB(0, 1), b2 + h2, rB, pb2); PGX_STAGE(PG8_SA(0, 0), a2, rA, pb2);
            PG8_WAIT_V(8); PG8_WAIT_L(0); PG8_BAR; PG8_MMA(1, 0, At, B0); PG8_MMA(1, 1, At, B1); PG8_BAR; PG8_SCHED;
            PG8_LDB(B0, 1, 0); PG8_LDB(B1, 1, 1); PG8_SCHED; PG8_LDA(At, 1, 0); PGX_STAGE(PG8_SA(0, 1), a2 + h2, rA, pb2);
            PG8_WAIT_V(8); PG8_WAIT_L(0); PG8_BAR; PG8_MMA(0, 0, At, B0); PG8_MMA(0, 1, At, B1); PG8_BAR; PG8_SCHED;
            PG8_LDA(At, 1, 1); PGX_STAGE(PG8_SB(1, 0), b3, rB, pb2); PGX_STAGE(PG8_SB(1, 1), b3 + h2, rB, pb2); PGX_STAGE(PG8_SA(1, 0), a3, rA, pb2);
            PG8_WAIT_V(8); PG8_WAIT_L(0); PG8_BAR; PG8_MMA(1, 0, At, B0); PG8_MMA(1, 1, At, B1); PG8_BAR; PG8_SCHED;
        }
        if (wr == 0) PG8_BAR;
        E(acc, cur, wr, wc, fr, fq);
        if (!has_next) break;
#pragma unroll
        for (int a = 0; a < 2; ++a)
#pragma unroll
            for (int b = 0; b < 2; ++b)
#pragma unroll
                for (int m = 0; m < 4; ++m)
#pragma unroll
                    for (int n = 0; n < 2; ++n) acc[a][b][m][n] = (f32x4){0.f, 0.f, 0.f, 0.f};
        cur = nxt; oc = on; cA = nA; cB = nB; Kc = Kn; ++ui;
        if (wr == 1) PG8_BAR;
    }
    PG8_WAIT_V(0);
    PG8_BAR;
#undef PG8_SA
#undef PG8_SB
#undef PGX_STAGE
#undef PG8_LDA
#undef PG8_LDB
#undef PG8_MMA
#undef PG8_WAIT_V
#undef PG8_WAIT_L
#undef PG8_BAR
#undef PG8_SCHED
}
}
namespace pg8 {
constexpr int TOK = 16384;
constexpr float RMS_EPS = 1e-6f;
typedef float f32x2e __attribute__((ext_vector_type(2)));
template <int NP> __device__ __forceinline__ void row_scales(const float* src, int rowbase, int lane, int fr, float (&r)[2][4]) {
#pragma unroll
    for (int ai = 0; ai < 2; ++ai) {
        const int row = rowbase + 128 * ai + lane; float v;
        if (NP == 0) v = src[row];
        else { float s = 0.f;
#pragma unroll
            for (int p = 0; p < NP; ++p) s += src[(size_t)p * TOK + row];
            v = __builtin_amdgcn_rsqf(s * (1.0f / 1024.0f) + RMS_EPS); }
#pragma unroll
        for (int m = 0; m < 4; ++m) r[ai][m] = __shfl(v, 16 * m + fr);
    }
}
template <int NP, class Sched> __device__ __forceinline__ void build_row_tab(const float* src, const Sched& S, PG8_LAS float* tab) {
    Unit u;
    for (int i = 0; S.next(i, u); ++i)
        for (int r = (int)threadIdx.x; r < 256; r += 512) { const int row = u.pm * BM + r; float v;
            if (NP == 0) v = src[row];
            else { float s = 0.f;
#pragma unroll
                for (int p = 0; p < NP; ++p) s += src[(size_t)p * TOK + row];
                v = __builtin_amdgcn_rsqf(s * (1.0f / 1024.0f) + RMS_EPS); }
            tab[i * 256 + r] = v; }
    __syncthreads();
}
__device__ __forceinline__ void row_scales_tab(const PG8_LAS float* tab, int ui, int wr, int fr, float (&r)[2][4]) {
#pragma unroll
    for (int ai = 0; ai < 2; ++ai)
#pragma unroll
        for (int m = 0; m < 4; ++m) r[ai][m] = tab[ui * 256 + ai * 128 + wr * 64 + 16 * m + fr];
}
__device__ __forceinline__ float silu_f(float x) { return x * __builtin_amdgcn_rcpf(1.0f + __expf(-x)); }
__device__ __forceinline__ float sigmoid_f(float x) { return __builtin_amdgcn_rcpf(1.0f + __expf(-x)); }

template <int NP> struct EpiSwiGLU {
    static constexpr bool PERM = true, AFTER_DRAIN = false;
    bf16_t* H; int ldh; const PG8_LAS float* tab; mutable int ui = 0;
    __device__ __forceinline__ void operator()(const f32x4 (&acc)[2][2][4][2], const Unit& u, int wr, int wc, int fr0, int fq0) const {
        int fr = fr0, fq = fq0; asm volatile("" : "+v"(fr), "+v"(fq));
        float r[2][4]; row_scales_tab(tab, ui++, wr, fr, r);
        const int col0 = u.pn * 128 + wc * 32 + 8 * fq;
#pragma unroll
        for (int ai = 0; ai < 2; ++ai)
#pragma unroll
            for (int m = 0; m < 4; ++m) {
                const int row = u.pm * BM + ai * HALF + wr * 64 + m * 16 + fr; const float rr = r[ai][m];
                float o[8]; const float k1 = -1.44269504f * rr, rr2 = rr * rr;
#pragma unroll
                for (int n = 0; n < 2; ++n)
#pragma unroll
                    for (int j = 0; j < 4; j += 2) { const f32x2 g2 = (f32x2){acc[ai][0][m][n][j], acc[ai][0][m][n][j + 1]}, u2 = (f32x2){acc[ai][1][m][n][j], acc[ai][1][m][n][j + 1]};
                        const f32x2 t2 = g2 * k1; const f32x2 d2 = (f32x2){__builtin_amdgcn_exp2f(t2[0]), __builtin_amdgcn_exp2f(t2[1])} + 1.0f;
                        const f32x2 r2 = (f32x2){__builtin_amdgcn_rcpf(d2[0]), __builtin_amdgcn_rcpf(d2[1])} * rr2; const f32x2 o2 = (g2 * u2) * r2;
                        o[4 * n + j] = o2[0]; o[4 * n + j + 1] = o2[1]; }
                u32x4 w; w.x = cvt_pk_bf16(o[0], o[1]); w.y = cvt_pk_bf16(o[2], o[3]); w.z = cvt_pk_bf16(o[4], o[5]); w.w = cvt_pk_bf16(o[6], o[7]);
                *(u32x4*)(H + (size_t)row * ldh + col0) = w;
            }
    }
};
template <bool WRITE_HB> struct EpiResid {
    static constexpr bool PERM = true, AFTER_DRAIN = false;
    const float* base; float* out; bf16_t* hb; float* part; float sc;
    __device__ __forceinline__ void operator()(const f32x4 (&acc)[2][2][4][2], const Unit& u, int wr, int wc, int fr0, int fq0) const {
        int fr = fr0, fq = fq0; asm volatile("" : "+v"(fr), "+v"(fq));
        const int col0 = u.pn * BM + wc * 32 + 8 * fq;
#pragma unroll
        for (int ai = 0; ai < 2; ++ai)
#pragma unroll
            for (int m = 0; m < 4; ++m) {
                const int row = u.pm * BM + ai * HALF + wr * 64 + m * 16 + fr; float ss = 0.f;
#pragma unroll
                for (int bj = 0; bj < 2; ++bj) {
                    const size_t off = (size_t)row * 1024 + col0 + bj * HALF;
                    const f32x4 b0 = *(const f32x4*)(base + off), b1 = *(const f32x4*)(base + off + 4);
                    const f32x4 o0 = b0 + acc[ai][bj][m][0] * sc, o1 = b1 + acc[ai][bj][m][1] * sc;
                    *(f32x4*)(out + off) = o0; *(f32x4*)(out + off + 4) = o1;
                    if (WRITE_HB) {
                        ss += (o0[0] * o0[0] + o0[1] * o0[1]) + (o0[2] * o0[2] + o0[3] * o0[3]) + (o1[0] * o1[0] + o1[1] * o1[1]) + (o1[2] * o1[2] + o1[3] * o1[3]);
                        u32x4 w; w.x = cvt_pk_bf16(o0[0], o0[1]); w.y = cvt_pk_bf16(o0[2], o0[3]); w.z = cvt_pk_bf16(o1[0], o1[1]); w.w = cvt_pk_bf16(o1[2], o1[3]);
                        *(u32x4*)(hb + off) = w; }
                }
                if (WRITE_HB) { ss += __shfl_xor(ss, 16); ss += __shfl_xor(ss, 32); if (fq == 0) part[(size_t)(u.pn * 4 + wc) * TOK + row] = ss; }
                if (m == 3) asm volatile("" ::: "memory");
            }
    }
};
template <bool WRITE_HB> struct EpiResid2 {
    static constexpr bool PERM = true, AFTER_DRAIN = false;
    const float* base; float* out; bf16_t* hb; float* part; float sc;
    __device__ __forceinline__ void operator()(const f32x4 (&acc)[2][2][4][2], const Unit& u, int wr, int wc, int fr0, int fq0) const {
        int fr = fr0, fq = fq0; asm volatile("" : "+v"(fr), "+v"(fq));
        const int row0 = u.pm * BM + wr * 64 + fr; const size_t o00 = (size_t)row0 * 1024 + u.pn * BM + wc * 32 + 8 * fq;
        const float* bp = base + o00; float* op = out + o00; bf16_t* hp = hb + o00;
        f32x4 bq[2][8];
#define ER2_ISSUE(G, B) do { _Pragma("unroll") for (int c = 0; c < 8; ++c) { const int ai = (G) >> 1, m = 2 * ((G) & 1) + (c >> 2), bj = (c >> 1) & 1, n = c & 1; \
            bq[B][c] = *(const f32x4*)(bp + (size_t)(ai * 128 + m * 16) * 1024 + bj * 128 + 4 * n); } } while (0)
        ER2_ISSUE(0, 0);
#pragma unroll
        for (int G = 0; G < 4; ++G) {
            if (G + 1 < 4) { if ((G & 1) == 0) ER2_ISSUE(G + 1, 1); else ER2_ISSUE(G + 1, 0); }
            asm volatile("" ::: "memory");
#pragma unroll
            for (int mm = 0; mm < 2; ++mm) { const int ai = G >> 1, m = 2 * (G & 1) + mm; float ss = 0.f;
#pragma unroll
                for (int bj = 0; bj < 2; ++bj) { const size_t off = (size_t)(ai * 128 + m * 16) * 1024 + bj * 128;
                    const f32x4 o0 = bq[G & 1][mm * 4 + bj * 2] + acc[ai][bj][m][0] * sc, o1 = bq[G & 1][mm * 4 + bj * 2 + 1] + acc[ai][bj][m][1] * sc;
                    *(f32x4*)(op + off) = o0; *(f32x4*)(op + off + 4) = o1;
                    if (WRITE_HB) {
                        ss += (o0[0] * o0[0] + o0[1] * o0[1]) + (o0[2] * o0[2] + o0[3] * o0[3]) + (o1[0] * o1[0] + o1[1] * o1[1]) + (o1[2] * o1[2] + o1[3] * o1[3]);
                        u32x4 w; w.x = cvt_pk_bf16(o0[0], o0[1]); w.y = cvt_pk_bf16(o0[2], o0[3]); w.z = cvt_pk_bf16(o1[0], o1[1]); w.w = cvt_pk_bf16(o1[2], o1[3]);
                        *(u32x4*)(hp + off) = w; } }
                if (WRITE_HB) { ss += __shfl_xor(ss, 16); ss += __shfl_xor(ss, 32); if (fq == 0) part[(size_t)(u.pn * 4 + wc) * TOK + row0 + ai * 128 + m * 16] = ss; } }
            asm volatile("" ::: "memory");
        }
#undef ER2_ISSUE
    }
};
__device__ __forceinline__ float bf_lo(unsigned w) { return __uint_as_float(w << 16); }
__device__ __forceinline__ float bf_hi(unsigned w) { return __uint_as_float(w & 0xffff0000u); }
template <int MODE> struct EpiResid3 {
    static constexpr bool PERM = true, AFTER_DRAIN = false;
    static constexpr int NS = 0;
    const float* basef; float* out; bf16_t* hb; float* part; float sc;
    __device__ __forceinline__ void operator()(const f32x4 (&acc)[2][2][4][2], const Unit& u, int wr, int wc, int fr0, int fq0) const {
        int fr = fr0, fq = fq0; asm volatile("" : "+v"(fr), "+v"(fq));
        const int row0 = u.pm * BM + wr * 64 + fr; const size_t o00 = (size_t)row0 * 1024 + u.pn * BM + wc * 32 + 8 * fq;
        const float* bp = basef + o00; float* op = out + o00; bf16_t* hp = hb + o00;
        f32x4 bq[2][8]; u32x4 hq[2][4];
#define ER3_ISSUE(G, B) do { if (MODE == 0) { _Pragma("unroll") for (int c = 0; c < 8; ++c) { const int ai = (G) >> 1, m = 2 * ((G) & 1) + (c >> 2), bj = (c >> 1) & 1, n = c & 1; \
                bq[B][c] = *(const f32x4*)(bp + (size_t)(ai * 128 + m * 16) * 1024 + bj * 128 + 4 * n); } } \
            else { _Pragma("unroll") for (int c = 0; c < 4; ++c) { const int ai = (G) >> 1, m = 2 * ((G) & 1) + (c >> 1), bj = c & 1; hq[B][c] = *(const u32x4*)(hp + (size_t)(ai * 128 + m * 16) * 1024 + bj * 128); } } } while (0)
        ER3_ISSUE(0, 0);
#pragma unroll
        for (int G = 0; G < 4; ++G) {
            if (G + 1 < 4) { if ((G & 1) == 0) ER3_ISSUE(G + 1, 1); else ER3_ISSUE(G + 1, 0); }
            asm volatile("" ::: "memory");
#pragma unroll
            for (int mm = 0; mm < 2; ++mm) { const int ai = G >> 1, m = 2 * (G & 1) + mm; float ss = 0.f;
#pragma unroll
                for (int bj = 0; bj < 2; ++bj) { const size_t off = (size_t)(ai * 128 + m * 16) * 1024 + bj * 128;
                    f32x4 b0, b1;
                    if (MODE == 0) { b0 = bq[G & 1][mm * 4 + bj * 2]; b1 = bq[G & 1][mm * 4 + bj * 2 + 1]; }
                    else { const u32x4 h = hq[G & 1][mm * 2 + bj]; b0 = (f32x4){bf_lo(h.x), bf_hi(h.x), bf_lo(h.y), bf_hi(h.y)}; b1 = (f32x4){bf_lo(h.z), bf_hi(h.z), bf_lo(h.w), bf_hi(h.w)}; }
                    const f32x4 o0 = b0 + acc[ai][bj][m][0] * sc, o1 = b1 + acc[ai][bj][m][1] * sc;
                    if (MODE == 2) { *(f32x4*)(op + off) = o0; *(f32x4*)(op + off + 4) = o1; }
                    else {
                        ss += (o0[0] * o0[0] + o0[1] * o0[1]) + (o0[2] * o0[2] + o0[3] * o0[3]) + (o1[0] * o1[0] + o1[1] * o1[1]) + (o1[2] * o1[2] + o1[3] * o1[3]);
                        u32x4 w; w.x = cvt_pk_bf16(o0[0], o0[1]); w.y = cvt_pk_bf16(o0[2], o0[3]); w.z = cvt_pk_bf16(o1[0], o1[1]); w.w = cvt_pk_bf16(o1[2], o1[3]);
                        *(u32x4*)(hp + off) = w; } }
                if (MODE != 2) { ss += __shfl_xor(ss, 16); ss += __shfl_xor(ss, 32); if (fq == 0) part[(size_t)(u.pn * 4 + wc) * TOK + row0 + ai * 128 + m * 16] = ss; } }
            asm volatile("" ::: "memory");
        }
#undef ER3_ISSUE
    }
};
struct EpiMemKV {
    static constexpr bool PERM = true, AFTER_DRAIN = false;
    float* KV; const float* rs;
    __device__ __forceinline__ void operator()(const f32x4 (&acc)[2][2][4][2], const Unit& u, int wr, int wc, int fr0, int fq0) const {
        int fr = fr0, fq = fq0; asm volatile("" : "+v"(fr), "+v"(fq));
        float r[2][4]; row_scales<0>(rs, u.pm * BM + wr * 64, (int)(threadIdx.x & 63), fr, r);
        const int col0 = u.pn * BM + wc * 32 + 8 * fq;
#pragma unroll
        for (int ai = 0; ai < 2; ++ai)
#pragma unroll
            for (int m = 0; m < 4; ++m) { const int row = u.pm * BM + ai * HALF + wr * 64 + m * 16 + fr;
#pragma unroll
                for (int bj = 0; bj < 2; ++bj) { const size_t off = (size_t)row * 1024 + col0 + bj * HALF;
                    *(f32x4*)(KV + off) = acc[ai][bj][m][0] * r[ai][m]; *(f32x4*)(KV + off + 4) = acc[ai][bj][m][1] * r[ai][m]; } }
    }
};
template <int NP> struct EpiGate {
    static constexpr bool PERM = true, AFTER_DRAIN = false;
    bf16_t* scr; const PG8_LAS float* tab; mutable int ui = 0;
    __device__ __forceinline__ void operator()(const f32x4 (&acc)[2][2][4][2], const Unit& u, int wr, int wc, int fr0, int fq0) const {
        int fr = fr0, fq = fq0; asm volatile("" : "+v"(fr), "+v"(fq));
        float r[2][4];
#ifdef DBG_GATE_NOSCALE
        for (int a_ = 0; a_ < 2; ++a_) for (int m_ = 0; m_ < 4; ++m_) r[a_][m_] = 1.0f;
#else
        row_scales_tab(tab, ui++, wr, fr, r);
#endif
        bf16_t* t = scr + (size_t)(u.pm * 4 + u.pn) * 65536;
#pragma unroll
        for (int ai = 0; ai < 2; ++ai)
#pragma unroll
            for (int m = 0; m < 4; ++m) { const int lr = ai * HALF + wr * 64 + m * 16 + fr; const float rr = r[ai][m];
#pragma unroll
                for (int bj = 0; bj < 2; ++bj) { float o[8];
#pragma unroll
                    for (int n = 0; n < 2; ++n)
#pragma unroll
                        for (int j = 0; j < 4; ++j) o[4 * n + j] = sigmoid_f(acc[ai][bj][m][n][j] * rr);
                    u32x4 w; w.x = cvt_pk_bf16(o[0], o[1]); w.y = cvt_pk_bf16(o[2], o[3]); w.z = cvt_pk_bf16(o[4], o[5]); w.w = cvt_pk_bf16(o[6], o[7]);
                    *(u32x4*)(t + lr * 256 + bj * HALF + wc * 32 + 8 * fq) = w; } }
    }
};
struct EpiBranch {
    static constexpr bool PERM = true, AFTER_DRAIN = false;
    const bf16_t* scr; bf16_t* mg; bool first; float bscale;
    __device__ __forceinline__ void operator()(const f32x4 (&acc)[2][2][4][2], const Unit& u, int wr, int wc, int fr0, int fq0) const {
        int fr = fr0, fq = fq0; asm volatile("" : "+v"(fr), "+v"(fq));
        const bf16_t* t = scr + (size_t)(u.pm * 4 + u.pn) * 65536;
        __builtin_amdgcn_fence(__ATOMIC_ACQUIRE, "agent");
        asm volatile("s_waitcnt vmcnt(0)" ::: "memory");
#pragma unroll
        for (int ai = 0; ai < 2; ++ai)
#pragma unroll
            for (int m = 0; m < 4; ++m) { const int lr = ai * HALF + wr * 64 + m * 16 + fr; const int row = u.pm * BM + lr;
#pragma unroll
                for (int bj = 0; bj < 2; ++bj) { const int lc = bj * HALF + wc * 32 + 8 * fq;
#if defined(DBG_NOGATE) && DBG_NOGATE
                    const u32x4 g = (u32x4){0x3f803f80u, 0x3f803f80u, 0x3f803f80u, 0x3f803f80u};
#else
                    const u32x4 g = *(const u32x4*)(t + lr * 256 + lc);
#endif
                    bf16_t* mp = mg + (size_t)row * 1024 + u.pn * BM + lc;
                    float o[8];
                    o[0] = bf_lo(g.x) * acc[ai][bj][m][0][0]; o[1] = bf_hi(g.x) * acc[ai][bj][m][0][1]; o[2] = bf_lo(g.y) * acc[ai][bj][m][0][2]; o[3] = bf_hi(g.y) * acc[ai][bj][m][0][3];
                    o[4] = bf_lo(g.z) * acc[ai][bj][m][1][0]; o[5] = bf_hi(g.z) * acc[ai][bj][m][1][1]; o[6] = bf_lo(g.w) * acc[ai][bj][m][1][2]; o[7] = bf_hi(g.w) * acc[ai][bj][m][1][3];
#ifdef DBG_BRANCH_SIGMOID
#pragma unroll
                    for (int e = 0; e < 8; ++e) o[e] = DBG_NONLIN(o[e]);
#endif
#pragma unroll
                    for (int e = 0; e < 8; ++e) o[e] *= bscale;
                    if (!first) { const u32x4 p = *(const u32x4*)mp;
                        o[0] += bf_lo(p.x); o[1] += bf_hi(p.x); o[2] += bf_lo(p.y); o[3] += bf_hi(p.y); o[4] += bf_lo(p.z); o[5] += bf_hi(p.z); o[6] += bf_lo(p.w); o[7] += bf_hi(p.w); }
                    u32x4 w; w.x = cvt_pk_bf16(o[0], o[1]); w.y = cvt_pk_bf16(o[2], o[3]); w.z = cvt_pk_bf16(o[4], o[5]); w.w = cvt_pk_bf16(o[6], o[7]);
                    *(u32x4*)mp = w; }
                if (m & 1) asm volatile("" ::: "memory"); }
    }
};
template <bool FIRST> struct EpiBranch2 {
    const bf16_t* scr; bf16_t* mg;
    __device__ __forceinline__ void operator()(const f32x4 (&acc)[2][2][4][2], const Unit& u, int wr, int wc, int fr0, int fq0) const {
        int fr = fr0, fq = fq0; asm volatile("" : "+v"(fr), "+v"(fq));
        const bf16_t* t = scr + (size_t)(u.pm * 4 + u.pn) * 65536 + (wr * 64 + fr) * 256 + wc * 32 + 8 * fq;
        bf16_t* mp0 = mg + (size_t)(u.pm * BM + wr * 64 + fr) * 1024 + u.pn * BM + wc * 32 + 8 * fq;
        u32x4 gq[2][4], pq[2][4];
#define EB2_ISSUE(G, B) do { _Pragma("unroll") for (int c = 0; c < 4; ++c) { const int ai = (G) >> 1, m = 2 * ((G) & 1) + (c >> 1), bj = c & 1; \
            gq[B][c] = *(const u32x4*)(t + (ai * 128 + m * 16) * 256 + bj * 128); if (!FIRST) pq[B][c] = *(const u32x4*)(mp0 + (size_t)(ai * 128 + m * 16) * 1024 + bj * 128); } } while (0)
        EB2_ISSUE(0, 0);
#pragma unroll
        for (int G = 0; G < 4; ++G) {
            if (G + 1 < 4) { if ((G & 1) == 0) EB2_ISSUE(G + 1, 1); else EB2_ISSUE(G + 1, 0); }
            asm volatile("" ::: "memory");
#pragma unroll
            for (int c = 0; c < 4; ++c) { const int ai = G >> 1, m = 2 * (G & 1) + (c >> 1), bj = c & 1; const u32x4 g = gq[G & 1][c];
                float o[8];
                o[0] = bf_lo(g.x) * acc[ai][bj][m][0][0]; o[1] = bf_hi(g.x) * acc[ai][bj][m][0][1]; o[2] = bf_lo(g.y) * acc[ai][bj][m][0][2]; o[3] = bf_hi(g.y) * acc[ai][bj][m][0][3];
                o[4] = bf_lo(g.z) * acc[ai][bj][m][1][0]; o[5] = bf_hi(g.z) * acc[ai][bj][m][1][1]; o[6] = bf_lo(g.w) * acc[ai][bj][m][1][2]; o[7] = bf_hi(g.w) * acc[ai][bj][m][1][3];
                if (!FIRST) { const u32x4 p = pq[G & 1][c];
                    o[0] += bf_lo(p.x); o[1] += bf_hi(p.x); o[2] += bf_lo(p.y); o[3] += bf_hi(p.y); o[4] += bf_lo(p.z); o[5] += bf_hi(p.z); o[6] += bf_lo(p.w); o[7] += bf_hi(p.w); }
                u32x4 w; w.x = cvt_pk_bf16(o[0], o[1]); w.y = cvt_pk_bf16(o[2], o[3]); w.z = cvt_pk_bf16(o[4], o[5]); w.w = cvt_pk_bf16(o[6], o[7]);
                *(u32x4*)(mp0 + (size_t)(ai * 128 + m * 16) * 1024 + bj * 128) = w; }
            asm volatile("" ::: "memory");
        }
#undef EB2_ISSUE
    }
};
template <size_t O_HB, size_t O_WG, size_t O_A0, size_t O_A1, size_t O_A2, size_t O_WB> struct P7Order {
    StaticOrder T; const char* ws;
    __device__ __forceinline__ bool next(int i, UnitX& u) const { const int rd = i / 6; Unit t; if (!T.next(rd, t)) return false; u.pm = t.pm; u.pn = t.pn; u.kind = i - 6 * rd; u.round = rd; return true; }
    __device__ __forceinline__ OpsX ops(const UnitX& u) const { const int j = u.kind >> 1; OpsX o;
        if (u.kind & 1) { o.K = 512; o.A = ws + (j == 0 ? O_A0 : j == 1 ? O_A1 : O_A2) + (size_t)u.pm * (256 * 512 * 2); o.Bt = ws + O_WB + (size_t)j * (1024 * 512 * 2) + (size_t)u.pn * (256 * 512 * 2); }
        else { o.K = 1024; o.A = ws + O_HB + (size_t)u.pm * (256 * 1024 * 2); o.Bt = ws + O_WG + (size_t)j * (1024 * 1024 * 2) + (size_t)u.pn * (256 * 1024 * 2); }
        return o; }
};
struct EpiP7 {
    bf16_t* scr; bf16_t* mg; const PG8_LAS float* tab;
    __device__ __forceinline__ void operator()(const f32x4 (&acc)[2][2][4][2], const UnitX& u, int wr, int wc, int fr, int fq) const {
        const Unit uu{u.pm, u.pn};
        if (u.kind == 1) { const EpiBranch2<true> b{scr, mg}; b(acc, uu, wr, wc, fr, fq); }
        else if (u.kind & 1) { const EpiBranch2<false> b{scr, mg}; b(acc, uu, wr, wc, fr, fq); }
        else { const EpiGate<16> g{scr, tab, u.round}; g(acc, uu, wr, wc, fr, fq); }
    }
};
struct ProjOut { bf16_t *FQ, *FK, *FV, *DQ, *IQ, *MQ, *DK, *DV, *IK; float *LOGF, *IW; const float *cosT, *sinT, *g_fq, *g_fk, *g_dq, *g_dk, *b_forget; };
__device__ __forceinline__ float log_sigmoid_f(float z) { return z >= 0.f ? -log1pf(expf(-z)) : z - log1pf(expf(z)); }
template <int NP> struct EpiProj {
    static constexpr bool PERM = true, AFTER_DRAIN = false;
    ProjOut P; const PG8_LAS float* tab; float qscale; mutable int ui = 0;
    __device__ __forceinline__ void operator()(const f32x4 (&acc)[2][2][4][2], const Unit& u, int wr, int wc, int fr0, int fq0) const {
        int fr = fr0, fq = fq0; asm volatile("" : "+v"(fr), "+v"(fq));
        float r[2][4]; row_scales_tab(tab, ui++, wr, fr, r);
        const int pn = u.pn;
        bool do_norm = false, do_rope = false; const float* gain = nullptr; bf16_t* dst = nullptr; int pitch = 512, hoff = 0; float osc = 1.f;
        if (pn < 2)       { do_norm = true; gain = P.g_fq; dst = P.FQ; hoff = (4 * pn + wc) * 64; osc = qscale; }
        else if (pn < 4)  { do_norm = true; gain = P.g_fk; dst = P.FK; hoff = (4 * (pn - 2) + wc) * 64; }
        else if (pn < 6)  { dst = P.FV; hoff = (4 * (pn - 4) + wc) * 64; }
        else if (pn < 8)  { do_norm = true; do_rope = true; gain = P.g_dq; dst = P.DQ; hoff = (4 * (pn - 6) + wc) * 64; osc = qscale; }
        else if (pn < 10) { do_rope = true; dst = P.IQ; hoff = (4 * (pn - 8) + wc) * 64; }
        else if (pn < 12) { dst = P.MQ; hoff = (2 * (pn - 10) + (wc >> 1)) * 128 + (wc & 1) * 64; }
        else { pitch = 64;
            if (wc == 0)      { do_norm = true; do_rope = true; gain = P.g_dk; dst = P.DK; }
            else if (wc == 1) { dst = P.DV; }
            else if (wc == 2) { do_rope = true; dst = P.IK; }
            else dst = nullptr; }
        if (dst == nullptr) {
            if (fq < 2) {
#pragma unroll
                for (int ai = 0; ai < 2; ++ai)
#pragma unroll
                    for (int m = 0; m < 4; ++m) { const int row = u.pm * BM + ai * HALF + wr * 64 + m * 16 + fr; const float rr = r[ai][m];
                        f32x4 v0 = acc[ai][0][m][0] * rr, v1 = acc[ai][0][m][1] * rr;
                        if (fq == 0) {
                            const f32x4 b0 = *(const f32x4*)(P.b_forget), b1 = *(const f32x4*)(P.b_forget + 4);
#pragma unroll
                            for (int j = 0; j < 4; ++j) { v0[j] = log_sigmoid_f(v0[j] + b0[j]); v1[j] = log_sigmoid_f(v1[j] + b1[j]); }
                            *(f32x4*)(P.LOGF + (size_t)row * 8) = v0; *(f32x4*)(P.LOGF + (size_t)row * 8 + 4) = v1;
                        } else { const float c = 0.04419417382f; *(f32x4*)(P.IW + (size_t)row * 8) = v0 * c; *(f32x4*)(P.IW + (size_t)row * 8 + 4) = v1 * c; } }
            }
            return;
        }
        const bool ikl = (pn == 12 && wc == 2);
        if (do_norm) { if (do_rope) body<true, true, false>(acc, u, r, gain, dst, pitch, hoff, osc, wr, fr, fq); else body<true, false, false>(acc, u, r, gain, dst, pitch, hoff, osc, wr, fr, fq); }
        else if (do_rope) { if (ikl) body<false, true, true>(acc, u, r, gain, dst, pitch, hoff, osc, wr, fr, fq); else body<false, true, false>(acc, u, r, gain, dst, pitch, hoff, osc, wr, fr, fq); }
        else body<false, false, false>(acc, u, r, gain, dst, pitch, hoff, osc, wr, fr, fq);
    }
    template <bool NORM, bool ROPE, bool IKL>
    __device__ __forceinline__ void body(const f32x4 (&acc)[2][2][4][2], const Unit& u, const float (&r)[2][4], const float* gain, bf16_t* dst, int pitch, int hoff, float osc, int wr, int fr, int fq) const {
        f32x4 gv[2][2];
        if (NORM) {
#pragma unroll
            for (int bj = 0; bj < 2; ++bj)
#pragma unroll
                for (int n = 0; n < 2; ++n) gv[bj][n] = *(const f32x4*)(gain + bj * 32 + 8 * fq + 4 * n);
        }
        f32x4 cq[2][4];
        const int rowb = u.pm * BM + wr * 64 + fr;
#define EP_ISSUE(I, B) do { const size_t ro_ = (size_t)(rowb + ((I) >> 2) * HALF + ((I) & 3) * 16) * 32 + 8 * fq; \
            cq[B][0] = *(const f32x4*)(P.cosT + ro_); cq[B][1] = *(const f32x4*)(P.cosT + ro_ + 4); cq[B][2] = *(const f32x4*)(P.sinT + ro_); cq[B][3] = *(const f32x4*)(P.sinT + ro_ + 4); } while (0)
        if (ROPE) EP_ISSUE(0, 0);
#pragma unroll
        for (int ai = 0; ai < 2; ++ai)
#pragma unroll
            for (int m = 0; m < 4; ++m) {
                const int row = u.pm * BM + ai * HALF + wr * 64 + m * 16 + fr; const float rr = r[ai][m];
                if (ROPE) { if (4 * ai + m + 1 < 8) { if (((4 * ai + m) & 1) == 0) EP_ISSUE(4 * ai + m + 1, 1); else EP_ISSUE(4 * ai + m + 1, 0); } asm volatile("" ::: "memory"); }
                f32x4 v[2][2];
#pragma unroll
                for (int bj = 0; bj < 2; ++bj)
#pragma unroll
                    for (int n = 0; n < 2; ++n) v[bj][n] = acc[ai][bj][m][n] * rr;
                if (NORM) {
                    float ss = 0.f;
#pragma unroll
                    for (int bj = 0; bj < 2; ++bj)
#pragma unroll
                        for (int n = 0; n < 2; ++n) ss += (v[bj][n][0] * v[bj][n][0] + v[bj][n][1] * v[bj][n][1]) + (v[bj][n][2] * v[bj][n][2] + v[bj][n][3] * v[bj][n][3]);
                    ss += __shfl_xor(ss, 16); ss += __shfl_xor(ss, 32);
                    const float inv = __builtin_amdgcn_rsqf(ss * (1.0f / 64.0f) + RMS_EPS);
#pragma unroll
                    for (int bj = 0; bj < 2; ++bj)
#pragma unroll
                        for (int n = 0; n < 2; ++n) v[bj][n] = v[bj][n] * inv * gv[bj][n];
                }
                if (ROPE) {
#pragma unroll
                    for (int n = 0; n < 2; ++n) {
                        const f32x4 c = cq[(4 * ai + m) & 1][n], s = cq[(4 * ai + m) & 1][2 + n];
                        const f32x4 x1 = v[0][n], x2 = v[1][n];
                        v[0][n] = x1 * c - x2 * s; v[1][n] = x2 * c + x1 * s; }
                }
#pragma unroll
                for (int bj = 0; bj < 2; ++bj) {
                    const f32x4 a = v[bj][0] * osc, b = v[bj][1] * osc;
                    u32x4 w; w.x = cvt_pk_bf16(a[0], a[1]); w.y = cvt_pk_bf16(a[2], a[3]); w.z = cvt_pk_bf16(b[0], b[1]); w.w = cvt_pk_bf16(b[2], b[3]);
                    if (IKL) {
                        const int d = bj * 32 + 8 * fq; *(u32x4*)(dst + (size_t)(row >> 5) * 2048 + (d >> 4) * 512 + ((d >> 3) & 1) * 256 + (row & 31) * 8) = w;
                    } else *(u32x4*)(dst + (size_t)row * pitch + hoff + bj * 32 + 8 * fq) = w; }
                if (ROPE) asm volatile("" ::: "memory");
            }
#undef EP_ISSUE
    }
};
}
#define GAS __attribute__((address_space(1)))
#define LAS __attribute__((address_space(3)))
typedef unsigned short bf16;
typedef unsigned v4u __attribute__((ext_vector_type(4)));
typedef float f32x4 __attribute__((ext_vector_type(4)));
typedef short bf16x8 __attribute__((ext_vector_type(8)));
typedef GAS unsigned gu32;
typedef GAS unsigned long long gu64;
#define RLX_AGENT __ATOMIC_RELAXED, __HIP_MEMORY_SCOPE_AGENT
#define LDS_WAIT() asm volatile("s_waitcnt lgkmcnt(0)" ::: "memory")
#define VM_WAIT() asm volatile("s_waitcnt vmcnt(0)" ::: "memory")
__device__ __forceinline__ unsigned long long rt() { return __builtin_amdgcn_s_memrealtime(); }
__device__ __forceinline__ unsigned f2bf(float f) { unsigned u = __builtin_bit_cast(unsigned, f); return (u + 0x7fffu + ((u >> 16) & 1u)) >> 16; }
__device__ __forceinline__ unsigned pk2(float lo, float hi) { return f2bf(lo) | (f2bf(hi) << 16); }
typedef float f32x2g __attribute__((ext_vector_type(2)));
__device__ __forceinline__ float bf_lo32(unsigned w) { return __uint_as_float(w << 16); }
__device__ __forceinline__ float bf_hi32(unsigned w) { return __uint_as_float(w & 0xffff0000u); }
constexpr int NWAVES = 8;
constexpr int BATCH = 2, SEQ = 8192, DM = 1024, T = BATCH * SEQ, DFF = 2816, MEMLEN = 256, BW = 512, DIN = 6352;
constexpr int NPROJ = 13 * 256, NGATE = 3072;
constexpr float L2E = 1.4426950408889634f;
constexpr float C2_64 = 0.125f * L2E;
constexpr float C2_128 = 0.08838834764831845f * L2E;
constexpr size_t MiB = 1u << 20;
constexpr size_t WS_CTL = 0, CTL_ZERO_BYTES = 128 * 1024;
constexpr size_t WS_RSTDX = 1 * MiB;
constexpr size_t WS_RSTDM = WS_RSTDX + 64 * 1024;
constexpr size_t WS_T0 = WS_RSTDM + 4096;
constexpr size_t WS_SSQ1 = 2 * MiB;
constexpr size_t WS_SSQ2 = 3 * MiB;
constexpr size_t WS_LOGF = 4 * MiB;
constexpr size_t WS_CUM = WS_LOGF + 512 * 1024;
constexpr size_t WS_IW = 5 * MiB;
constexpr size_t WS_COS = 6 * MiB, WS_SIN = 8 * MiB;
constexpr size_t WS_MEMB = 10 * MiB;
constexpr size_t WS_KVM = 11 * MiB;
constexpr size_t WS_KMB = 13 * MiB, WS_VMB = 14 * MiB;
constexpr size_t WS_WGU1 = 16 * MiB;
constexpr size_t WS_WD1 = 27 * MiB;
constexpr size_t WS_WIN = 33 * MiB;
constexpr size_t WS_WGATE = 40 * MiB;
constexpr size_t WS_WBR = 46 * MiB;
constexpr size_t WS_WOUT = 49 * MiB;
constexpr size_t WS_WGU2 = 51 * MiB;
constexpr size_t WS_WD2 = 62 * MiB;
constexpr size_t WS_WMKV = 68 * MiB;
constexpr size_t WS_HB = 70 * MiB;
constexpr size_t WS_ACT = 102 * MiB;
constexpr size_t WS_HID = WS_ACT;
constexpr size_t WS_FQ = WS_ACT, WS_FK = WS_ACT + 16 * MiB, WS_FV = WS_ACT + 32 * MiB, WS_DQ = WS_ACT + 48 * MiB, WS_IQ = WS_ACT + 64 * MiB, WS_MQ = WS_ACT + 80 * MiB;
constexpr size_t WS_DK = WS_ACT + 96 * MiB, WS_DV = WS_ACT + 98 * MiB, WS_IK = WS_ACT + 100 * MiB;
#if defined(DBG_SUBST) && DBG_SUBST == 2
constexpr size_t WS_MERGED = WS_DQ;
#else
constexpr size_t WS_MERGED = WS_FK;
#endif
#ifdef DBG_GSCR_AT
constexpr size_t WS_GSCR = DBG_GSCR_AT;
#else
constexpr size_t WS_GSCR = 204 * MiB;
#endif
constexpr size_t WS_OA = 236 * MiB;
constexpr size_t WS_OB = 16 * MiB;
constexpr size_t WS_END = 252 * MiB;
#ifndef DBG_GSCR_AT
static_assert(WS_HID + (size_t)T * DFF * 2 <= WS_GSCR && WS_IK + (size_t)T * 64 * 2 <= WS_GSCR, "d_ws map");
#endif
constexpr int CW_BAR = 4096;
constexpr int CW_Q = 16384;
constexpr int RING_OFF = 0, RING_BYTES = 131072;
constexpr int LDSCTL_OFF = RING_BYTES, MISC_OFF = LDSCTL_OFF + 320;
constexpr int LIST_OFF = RING_BYTES + 1024;
constexpr int SCANX_OFF = RING_BYTES + 6144;
constexpr int LDS_BYTES = 163840;
#define XB_TMO      128
#define XB_XCNT(j)  (256  + 64 * (j))
#define XB_XSUB(j)  (1280 + 64 * (j))
#define XB_XGEN(j)  (2304 + 64 * (j))
#define XB_TOP      3328
#define XB_TOPGEN   3392
#define XCD_BAR_WORDS 3456
#define XB_SPIN_CAP (1u << 18)

__device__ __forceinline__ unsigned xb_ld(unsigned* p)              { return __hip_atomic_load(p, __ATOMIC_RELAXED, __HIP_MEMORY_SCOPE_AGENT); }
__device__ __forceinline__ unsigned xb_add(unsigned* p, unsigned v) { return __hip_atomic_fetch_add(p, v, __ATOMIC_RELAXED, __HIP_MEMORY_SCOPE_AGENT); }
__device__ __forceinline__ unsigned xb_xcc_id() { return (unsigned)__builtin_amdgcn_s_getreg((3 << 11) | 20) & 0xFu; }
#define XB_SPIN(cond, bar) do { unsigned _sp = 0; while (cond) { __builtin_amdgcn_s_sleep(1); \
    if ((++_sp & 255u) == 0u) { if (xb_ld(&(bar)[XB_TMO])) break; if (_sp > XB_SPIN_CAP) { atomicAdd(&(bar)[XB_TMO], 1u); break; } } } } while (0)

struct XcdBarrier {
    unsigned* bar; unsigned x;
    volatile LAS unsigned* st;
};

__device__ __forceinline__ XcdBarrier xcd_barrier_post(unsigned* bar, volatile LAS unsigned* st) {
    XcdBarrier b; b.bar = bar; b.x = xb_xcc_id(); b.st = st;
    if (threadIdx.x == 0) (void)xb_add(&bar[XB_XCNT(b.x)], 1u);
    return b;
}
__device__ __forceinline__ void xcd_barrier_complete(unsigned* bar, unsigned x, unsigned& nloc, unsigned& nx) {
    const unsigned G = gridDim.x * gridDim.y * gridDim.z;
    unsigned sum, cnt, mine, sp = 0u;
    for (;;) {
        sum = 0u; cnt = 0u; mine = 0u;
#pragma unroll
        for (unsigned j = 0; j < 16; ++j) { const unsigned c = xb_ld(&bar[XB_XCNT(j)]); sum += c; cnt += (c > 0u) ? 1u : 0u; mine = (j == x) ? c : mine; }
        if (sum == G) break;
        __builtin_amdgcn_s_sleep(1);
        if ((++sp & 255u) == 0u) { if (xb_ld(&bar[XB_TMO])) break; if (sp > XB_SPIN_CAP) { atomicAdd(&bar[XB_TMO], 1u); break; } }
    }
    nloc = mine > 0u ? mine : 1u; nx = cnt > 0u ? cnt : 1u;
}

__device__ __forceinline__ void xcd_barrier(const XcdBarrier& b) {
    asm volatile("s_waitcnt vmcnt(0)" ::: "memory");
    __syncthreads();
    if (threadIdx.x == 0) {
        unsigned* bar = b.bar;
        __builtin_amdgcn_s_waitcnt(0);
        unsigned nloc = b.st[0], nx = b.st[1];
        if (nloc == 0u) { xcd_barrier_complete(bar, b.x, nloc, nx); b.st[0] = nloc; b.st[1] = nx; }
        const unsigned old = xb_add(&bar[XB_XSUB(b.x)], 1u);
        const unsigned gen = old / nloc;
        if (old + 1u == (gen + 1u) * nloc) {
            __builtin_amdgcn_fence(__ATOMIC_RELEASE, "agent");
            asm volatile("s_waitcnt vmcnt(0)" ::: "memory");
            const unsigned og = xb_add(&bar[XB_TOP], 1u);
            const unsigned tg = og / nx;
            if (og + 1u == (tg + 1u) * nx) xb_add(&bar[XB_TOPGEN], 1u);
            else XB_SPIN(xb_ld(&bar[XB_TOPGEN]) == tg, bar);
            __builtin_amdgcn_fence(__ATOMIC_ACQUIRE, "agent");
            xb_add(&bar[XB_XGEN(b.x)], 1u);
            asm volatile("s_waitcnt vmcnt(0)" ::: "memory");
        } else {
            XB_SPIN(xb_ld(&bar[XB_XGEN(b.x)]) == gen, bar);
            __builtin_amdgcn_fence(__ATOMIC_ACQUIRE, "agent");
            asm volatile("s_waitcnt vmcnt(0)" ::: "memory");
        }
    }
    __syncthreads();
}
__device__ __forceinline__ float wave_sum(float v) {
#pragma unroll
    for (int o = 1; o < 64; o <<= 1) v += __shfl_xor(v, o);
    return v;
}
__device__ __forceinline__ float wave_max(float v) {
#pragma unroll
    for (int o = 1; o < 64; o <<= 1) v = fmaxf(v, __shfl_xor(v, o));
    return v;
}
__device__ __forceinline__ int colmap(int mat, int n) {
    if (mat == 1) return n;
    if (mat == 3) return 3280 + n;
    const int tile = n >> 8, t = n & 255;
    if (mat == 0) return (t < 128 ? 0 : DFF) + 128 * tile + (t & 127);
    const int bj = t >> 7, wc = (t >> 5) & 3, i = t & 31, d = bj * 32 + i;
    if (tile < 2) return 0 + (4 * tile + wc) * 64 + d;
    if (tile < 4) return 512 + (4 * (tile - 2) + wc) * 64 + d;
    if (tile < 6) return 1024 + (4 * (tile - 4) + wc) * 64 + d;
    if (tile < 8) return 1544 + (4 * (tile - 6) + wc) * 64 + d;
    if (tile < 10) return 2184 + (4 * (tile - 8) + wc) * 64 + d;
    if (tile < 12) return 2768 + (2 * (tile - 10) + (wc >> 1)) * 128 + (wc & 1) * 64 + d;
    if (wc == 0) return 2056 + d;
    if (wc == 1) return 2120 + d;
    if (wc == 2) return 2696 + d;
    if (bj == 0 && i < 8) return 1536 + i;
    if (bj == 0 && i < 16) return 2760 + (i - 8);
    return -1;
}
template <bool GAIN> __device__ __forceinline__ void transpose_item(int mat, const float* Wa, const float* Wb, int K, int Nsrc, const float* gain, bf16* WT, LAS float* scr, int item, int nblk, int lane) {
    const int kb = item / nblk, nb = item % nblk, k0 = 64 * kb, n0 = 32 * nb;
    int col = colmap(mat, n0 + (lane & 31)); const float* W = Wa;
    if (mat == 0 && col >= DFF) { W = Wb; col -= DFF; }
    const bool okc = col >= 0; const float* wp = W + (size_t)(k0 + (lane >> 5)) * Nsrc + (okc ? col : 0); const float* gp = gain + k0 + (lane >> 5);
    float v[32];
#pragma unroll
    for (int i = 0; i < 32; ++i) v[i] = wp[(size_t)(2 * i) * Nsrc];
    if (GAIN) {
#pragma unroll
        for (int i = 0; i < 32; ++i) v[i] *= gp[2 * i]; }
#pragma unroll
    for (int i = 0; i < 32; ++i) scr[(2 * i + (lane >> 5)) * 33 + (lane & 31)] = okc ? v[i] : 0.f;
    LDS_WAIT(); asm volatile("" ::: "memory");
    const int c = lane & 7;
#pragma unroll
    for (int j = 0; j < 4; ++j) { const int n = (lane >> 3) + 8 * j; const LAS float* s = scr + (8 * c) * 33 + n;
        v4u o; o.x = pk2(s[0 * 33], s[1 * 33]); o.y = pk2(s[2 * 33], s[3 * 33]); o.z = pk2(s[4 * 33], s[5 * 33]); o.w = pk2(s[6 * 33], s[7 * 33]);
        *(GAS v4u*)(WT + (size_t)(n0 + n) * K + k0 + 8 * c) = o; }
    LDS_WAIT(); asm volatile("" ::: "memory");
}
__device__ __forceinline__ void row_to_bf16_rstd(const float* xrow, bf16* orow, float* rstd_out, int lane) {
    const GAS f32x4* xr = (const GAS f32x4*)xrow + lane;
    f32x4 v[4]; float s = 0.f;
#pragma unroll
    for (int j = 0; j < 4; ++j) { v[j] = xr[64 * j]; s += (v[j].x * v[j].x + v[j].y * v[j].y) + (v[j].z * v[j].z + v[j].w * v[j].w); }
    const float rstd = 1.0f / sqrtf(wave_sum(s) * (1.f / 1024.f) + 1e-6f);
    GAS unsigned long long* o8 = (GAS unsigned long long*)orow + lane;
#pragma unroll
    for (int j = 0; j < 4; ++j) o8[64 * j] = (unsigned long long)pk2(v[j].x, v[j].y) | ((unsigned long long)pk2(v[j].z, v[j].w) << 32);
    if (lane == 0) *rstd_out = rstd;
}
__device__ __forceinline__ void rows4_to_bf16_rstd(const float* const (&xrow)[4], bf16* const (&orow)[4], float* const (&rout)[4], const bool (&ok)[4], int lane) {
    f32x4 v[4][4];
#pragma unroll
    for (int r = 0; r < 4; ++r) { const GAS f32x4* xr = (const GAS f32x4*)xrow[r] + lane;
#pragma unroll
        for (int j = 0; j < 4; ++j) v[r][j] = xr[64 * j]; }
#pragma unroll
    for (int r = 0; r < 4; ++r) { float s = 0.f;
#pragma unroll
        for (int j = 0; j < 4; ++j) s += (v[r][j].x * v[r][j].x + v[r][j].y * v[r][j].y) + (v[r][j].z * v[r][j].z + v[r][j].w * v[r][j].w);
        const float rstd = 1.0f / sqrtf(wave_sum(s) * (1.f / 1024.f) + 1e-6f);
        if (ok[r]) { GAS unsigned long long* o8 = (GAS unsigned long long*)orow[r] + lane;
#pragma unroll
            for (int j = 0; j < 4; ++j) o8[64 * j] = (unsigned long long)pk2(v[r][j].x, v[r][j].y) | ((unsigned long long)pk2(v[r][j].z, v[r][j].w) << 32);
            if (lane == 0) *rout[r] = rstd; } }
}
typedef float f32x16 __attribute__((ext_vector_type(16)));
typedef unsigned u32x2 __attribute__((ext_vector_type(2)));
__device__ __forceinline__ int crow(int r, int hi) { return (r & 3) + 8 * (r >> 2) + 4 * hi; }
__device__ __forceinline__ float bf2f(bf16 v) { return __uint_as_float((unsigned)v << 16); }
__device__ __forceinline__ unsigned cvtpk(float lo, float hi) { return pg8::cvt_pk_bf16(lo, hi); }
template <int HD, bool FOX, bool VT>
__device__ __forceinline__ void attn_wave_simple(const bf16x8 (&qr)[HD / 16], const bf16* Kp, int kpitch, const bf16* Vp, int vpitch, int tstart, int ntiles, int qlocal, const float* cb, bf16* Op, int opitch, int lane) {
    const int r32 = lane & 31, hi = lane >> 5;
    f32x16 o[HD / 32];
#pragma unroll
    for (int d0 = 0; d0 < HD / 32; ++d0)
#pragma unroll
        for (int r = 0; r < 16; ++r) o[d0][r] = 0.f;
    float m = -1e30f, l = 0.f;
    for (int t = tstart; t < ntiles; ++t) {
        const int kv0 = 32 * t;
        f32x16 p;
#pragma unroll
        for (int r = 0; r < 16; ++r) p[r] = 0.f;
        const bf16* kr = Kp + (size_t)(kv0 + r32) * kpitch + hi * 8;
#pragma unroll
        for (int ks = 0; ks < HD / 16; ++ks) { const bf16x8 kf = *(const bf16x8*)(kr + ks * 16); p = __builtin_amdgcn_mfma_f32_32x32x16_bf16(kf, qr[ks], p, 0, 0, 0); }
        if (FOX) {
#pragma unroll
            for (int g = 0; g < 4; ++g) { const f32x4 c4 = *(const f32x4*)(cb + kv0 + 8 * g + 4 * hi);
#pragma unroll
                for (int jj = 0; jj < 4; ++jj) p[4 * g + jj] -= L2E * c4[jj]; }
            if (t == ntiles - 1) {
#pragma unroll
                for (int r = 0; r < 16; ++r) if (kv0 + crow(r, hi) > qlocal) p[r] = -INFINITY;
            }
        }
        float mt = p[0];
#pragma unroll
        for (int r = 1; r < 16; ++r) mt = fmaxf(mt, p[r]);
        mt = fmaxf(mt, __shfl_xor(mt, 32));
        const float mn = fmaxf(m, mt); const float alpha = __builtin_amdgcn_exp2f(m - mn); m = mn;
        l *= alpha;
#pragma unroll
        for (int d0 = 0; d0 < HD / 32; ++d0)
#pragma unroll
            for (int r = 0; r < 16; ++r) o[d0][r] *= alpha;
        float ls = 0.f;
#pragma unroll
        for (int r = 0; r < 16; ++r) { p[r] = __builtin_amdgcn_exp2f(p[r] - mn); ls += p[r]; }
        l += ls;
        bf16x8 pa[2];
#pragma unroll
        for (int s = 0; s < 2; ++s) { v4u w; w.x = cvtpk(p[8 * s + 0], p[8 * s + 1]); w.y = cvtpk(p[8 * s + 2], p[8 * s + 3]); w.z = cvtpk(p[8 * s + 4], p[8 * s + 5]); w.w = cvtpk(p[8 * s + 6], p[8 * s + 7]); pa[s] = __builtin_bit_cast(bf16x8, w); }
#pragma unroll
        for (int d0 = 0; d0 < HD / 32; ++d0)
#pragma unroll
            for (int s = 0; s < 2; ++s) {
                bf16x8 vf;
                if (VT) {
                    const bf16* vp = Vp + (size_t)(d0 * 32 + r32) * vpitch + kv0 + 16 * s + 4 * hi;
                    const u32x2 lo = *(const u32x2*)vp, hi2 = *(const u32x2*)(vp + 8);
                    vf = __builtin_bit_cast(bf16x8, (v4u){lo.x, lo.y, hi2.x, hi2.y});
                } else {
#pragma unroll
                    for (int j = 0; j < 8; ++j) vf[j] = (short)Vp[(size_t)(kv0 + 16 * s + 8 * (j >> 2) + 4 * hi + (j & 3)) * vpitch + d0 * 32 + r32];
                }
                o[d0] = __builtin_amdgcn_mfma_f32_32x32x16_bf16(vf, pa[s], o[d0], 0, 0, 0);
            }
    }
    l += __shfl_xor(l, 32);
    const float inv = 1.0f / l;
    bf16* orow = Op + (size_t)r32 * opitch;
#pragma unroll
    for (int d0 = 0; d0 < HD / 32; ++d0)
#pragma unroll
        for (int g = 0; g < 4; ++g) { u32x2 w; w.x = cvtpk(o[d0][4 * g] * inv, o[d0][4 * g + 1] * inv); w.y = cvtpk(o[d0][4 * g + 2] * inv, o[d0][4 * g + 3] * inv);
            *(u32x2*)(orow + d0 * 32 + 8 * g + 4 * hi) = w; }
}
__device__ __forceinline__ void fox_unit(int bh, int qb, const bf16* FQ, const bf16* FK, const bf16* FV, const float* CUM, const int* T0, bf16* OA, int wave, int lane) {
    const int b = bh >> 3, h = bh & 7, r32 = lane & 31, hi = lane >> 5; const size_t rowbase = (size_t)b * SEQ; const int q0 = qb * 256 + wave * 32;
    const bf16* Qw = FQ + (rowbase + q0) * 512 + h * 64; bf16* Ow = OA + (rowbase + q0) * 512 + h * 64;
    bf16x8 qr[4];
#pragma unroll
    for (int ks = 0; ks < 4; ++ks) qr[ks] = *(const bf16x8*)(Qw + (size_t)r32 * 512 + ks * 16 + hi * 8);
    attn_wave_simple<64, true, false>(qr, FK + rowbase * 512 + h * 64, 512, FV + rowbase * 512 + h * 64, 512, T0[bh * 256 + q0 / 32], q0 / 32 + 1, q0 + r32, CUM + (size_t)bh * SEQ, Ow, 512, lane);
}
__device__ __forceinline__ void mem_unit(int rg, int head, bf16* MQ, const bf16* KMB, const bf16* VMB, const float* gq, int lane) {
    const int r32 = lane & 31, hi = lane >> 5; const int row0 = rg * 32; const int b = row0 / SEQ;
    bf16* Qw = MQ + (size_t)row0 * 512 + head * 128;
    bf16x8 raw[8]; float ss = 0.f;
#pragma unroll
    for (int ks = 0; ks < 8; ++ks) { raw[ks] = *(const bf16x8*)(Qw + (size_t)r32 * 512 + ks * 16 + hi * 8);
#pragma unroll
        for (int j = 0; j < 8; ++j) { const float f = bf2f((bf16)raw[ks][j]); ss += f * f; } }
    ss += __shfl_xor(ss, 32);
    const float rstd = __builtin_amdgcn_rsqf(ss * (1.0f / 128.0f) + 1e-6f) * C2_128;
    bf16x8 qr[8];
#pragma unroll
    for (int ks = 0; ks < 8; ++ks) { const f32x4 g0 = *(const f32x4*)(gq + ks * 16 + hi * 8), g1 = *(const f32x4*)(gq + ks * 16 + hi * 8 + 4); v4u w;
        w.x = cvtpk(bf2f((bf16)raw[ks][0]) * rstd * g0[0], bf2f((bf16)raw[ks][1]) * rstd * g0[1]); w.y = cvtpk(bf2f((bf16)raw[ks][2]) * rstd * g0[2], bf2f((bf16)raw[ks][3]) * rstd * g0[3]);
        w.z = cvtpk(bf2f((bf16)raw[ks][4]) * rstd * g1[0], bf2f((bf16)raw[ks][5]) * rstd * g1[1]); w.w = cvtpk(bf2f((bf16)raw[ks][6]) * rstd * g1[2], bf2f((bf16)raw[ks][7]) * rstd * g1[3]);
        qr[ks] = __builtin_bit_cast(bf16x8, w); }
    attn_wave_simple<128, false, true>(qr, KMB + (size_t)b * MEMLEN * 512 + head * 128, 512, VMB + (size_t)(b * 4 + head) * 128 * MEMLEN, MEMLEN, 0, MEMLEN / 32, 0, nullptr, Qw, 512, lane);
}
typedef short v4i16_t __attribute__((ext_vector_type(4)));
__device__ __forceinline__ void mem_block(int u, bf16* MQ, const bf16* KMB, const bf16* VNB, const float* gq, LAS unsigned char* lds, int wave, int lane, int tid) {
    const int head = u & 3, rg = (u >> 2) * 8 + wave, row0 = rg * 32, b = row0 / SEQ;
    const int r32 = lane & 31, hi = lane >> 5;
    {   const bf16* ks_ = KMB + (size_t)b * MEMLEN * 512 + head * 128; const bf16* vs_ = VNB + (size_t)b * MEMLEN * 512 + head * 128;
#pragma unroll
        for (int i = 0; i < 8; ++i) { const int e = tid + 512 * i, key = e >> 4, c = e & 15;
            const v4u kv = *(const v4u*)(ks_ + (size_t)key * 512 + c * 8), vv = *(const v4u*)(vs_ + (size_t)key * 512 + c * 8);
            *(LAS v4u*)(lds + key * 256 + ((c ^ (key & 7)) * 16)) = kv; *(LAS v4u*)(lds + 65536 + key * 256 + c * 16) = vv; } }
    bf16* Qw = MQ + (size_t)row0 * 512 + head * 128;
    bf16x8 raw[8]; float ss = 0.f;
#pragma unroll
    for (int ks = 0; ks < 8; ++ks) { raw[ks] = *(const bf16x8*)(Qw + (size_t)r32 * 512 + ks * 16 + hi * 8);
#pragma unroll
        for (int j = 0; j < 8; ++j) { const float f = bf2f((bf16)raw[ks][j]); ss += f * f; } }
    ss += __shfl_xor(ss, 32);
    const float rstd = __builtin_amdgcn_rsqf(ss * (1.0f / 128.0f) + 1e-6f) * C2_128;
    bf16x8 qr[8];
#pragma unroll
    for (int ks = 0; ks < 8; ++ks) { const f32x4 g0 = *(const f32x4*)(gq + ks * 16 + hi * 8), g1 = *(const f32x4*)(gq + ks * 16 + hi * 8 + 4); v4u w;
        w.x = cvtpk(bf2f((bf16)raw[ks][0]) * rstd * g0[0], bf2f((bf16)raw[ks][1]) * rstd * g0[1]); w.y = cvtpk(bf2f((bf16)raw[ks][2]) * rstd * g0[2], bf2f((bf16)raw[ks][3]) * rstd * g0[3]);
        w.z = cvtpk(bf2f((bf16)raw[ks][4]) * rstd * g1[0], bf2f((bf16)raw[ks][5]) * rstd * g1[1]); w.w = cvtpk(bf2f((bf16)raw[ks][6]) * rstd * g1[2], bf2f((bf16)raw[ks][7]) * rstd * g1[3]);
        qr[ks] = __builtin_bit_cast(bf16x8, w); }
    __syncthreads();
    f32x16 o[4];
#pragma unroll
    for (int d0 = 0; d0 < 4; ++d0)
#pragma unroll
        for (int r = 0; r < 16; ++r) o[d0][r] = 0.f;
    float m = -1e30f, l = 0.f;
    const int kq = (lane >> 4) & 1, q_ = (lane & 15) >> 2, p_ = lane & 3;
#pragma unroll 1
    for (int t = 0; t < MEMLEN / 32; ++t) {
        const LAS unsigned char* kb = lds + (32 * t) * 256; const LAS unsigned char* vb = lds + 65536 + (32 * t) * 256;
        f32x16 p;
#pragma unroll
        for (int r = 0; r < 16; ++r) p[r] = 0.f;
#pragma unroll
        for (int ks = 0; ks < 8; ++ks) { const bf16x8 kf = *(const LAS bf16x8*)(kb + r32 * 256 + (((2 * ks + hi) ^ (r32 & 7)) * 16)); p = __builtin_amdgcn_mfma_f32_32x32x16_bf16(kf, qr[ks], p, 0, 0, 0); }
        float mt = p[0];
#pragma unroll
        for (int r = 1; r < 16; ++r) mt = fmaxf(mt, p[r]);
        mt = fmaxf(mt, __shfl_xor(mt, 32));
        if (__any(mt > m)) { const float mn_ = fmaxf(m, mt); const float alpha = __builtin_amdgcn_exp2f(m - mn_); m = mn_; l *= alpha;
#pragma unroll
            for (int d0 = 0; d0 < 4; ++d0)
#pragma unroll
                for (int r = 0; r < 16; ++r) o[d0][r] *= alpha; }
        const float mn = m; float ls = 0.f;
#pragma unroll
        for (int r = 0; r < 16; ++r) { p[r] = __builtin_amdgcn_exp2f(p[r] - mn); ls += p[r]; }
        l += ls;
        bf16x8 pa[2];
#pragma unroll
        for (int s2 = 0; s2 < 2; ++s2) { v4u w; w.x = cvtpk(p[8 * s2 + 0], p[8 * s2 + 1]); w.y = cvtpk(p[8 * s2 + 2], p[8 * s2 + 3]); w.z = cvtpk(p[8 * s2 + 4], p[8 * s2 + 5]); w.w = cvtpk(p[8 * s2 + 6], p[8 * s2 + 7]); pa[s2] = __builtin_bit_cast(bf16x8, w); }
#pragma unroll
        for (int d0 = 0; d0 < 4; ++d0)
#pragma unroll
            for (int s2 = 0; s2 < 2; ++s2) {
                const LAS unsigned char* a1 = vb + (16 * s2 + 4 * hi + q_) * 256 + (32 * d0 + 16 * kq + 4 * p_) * 2;
                const v4i16_t lo4 = __builtin_amdgcn_ds_read_tr16_b64_v4i16((LAS v4i16_t*)a1), hi4 = __builtin_amdgcn_ds_read_tr16_b64_v4i16((LAS v4i16_t*)(a1 + 8 * 256));
                const bf16x8 vf = (bf16x8){lo4[0], lo4[1], lo4[2], lo4[3], hi4[0], hi4[1], hi4[2], hi4[3]};
                o[d0] = __builtin_amdgcn_mfma_f32_32x32x16_bf16(vf, pa[s2], o[d0], 0, 0, 0); }
    }
    l += __shfl_xor(l, 32);
    const float inv = 1.0f / l;
    bf16* orow = Qw + (size_t)r32 * 512;
#pragma unroll
    for (int d0 = 0; d0 < 4; ++d0)
#pragma unroll
        for (int g = 0; g < 4; ++g) { u32x2 w; w.x = cvtpk(o[d0][4 * g] * inv, o[d0][4 * g + 1] * inv); w.y = cvtpk(o[d0][4 * g + 2] * inv, o[d0][4 * g + 3] * inv);
            *(u32x2*)(orow + d0 * 32 + 8 * g + 4 * hi) = w; }
    __syncthreads();
}
__device__ __forceinline__ void scan_unit(int bh, const float* LOGF, float* CUM, int* T0, const float* gq, const float* gk, LAS float* sx, LAS float* cl, int tid) {
    const int b = bh >> 3, h = bh & 7, lane = tid & 63, wave = tid >> 6;
    float v[16]; float run = 0.f;
#pragma unroll
    for (int i = 0; i < 16; ++i) v[i] = LOGF[((size_t)b * SEQ + 16 * tid + i) * 8 + h];
#pragma unroll
    for (int i = 0; i < 16; ++i) { run += v[i]; v[i] = run; }
    float tot = run;
#pragma unroll
    for (int off = 1; off < 64; off <<= 1) { const float nb = __shfl_up(tot, off); if (lane >= off) tot += nb; }
    if (lane == 63) sx[wave] = tot;
    __syncthreads();
    float woff = 0.f;
    for (int w = 0; w < wave; ++w) woff += sx[w];
    const float excl = tot - run + woff;
    float* dst = CUM + (size_t)bh * SEQ + 16 * tid;
#pragma unroll
    for (int i = 0; i < 16; i += 4) { const f32x4 o4 = (f32x4){v[i] + excl, v[i + 1] + excl, v[i + 2] + excl, v[i + 3] + excl}; *(f32x4*)(dst + i) = o4; *(LAS f32x4*)(cl + 16 * tid + i) = o4; }
    const float smax = 8.0f * wave_max(fabsf(gq[lane])) * wave_max(fabsf(gk[lane]));
    __syncthreads();
    if (tid < 256) { const float cq = cl[32 * tid]; const float lim = -(30.0f + 2.0f * smax);
        int lo = 0, hi = tid;
        while (lo < hi) { const int mid = (lo + hi) >> 1; if (cq - cl[32 * mid + 31] >= lim) hi = mid; else lo = mid + 1; }
        T0[bh * 256 + tid] = lo; }
    __syncthreads();
}
constexpr int D2_LST = RING_BYTES + 1024;
constexpr int D2_CNT = RING_BYTES + 3072;
constexpr int D2_CL = RING_BYTES + 4096;
typedef float f32x4d __attribute__((ext_vector_type(4)));
__device__ __forceinline__ unsigned sortable_u32(float f) { const unsigned u = __float_as_uint(f); return u ^ ((u >> 31) ? 0xFFFFFFFFu : 0x80000000u); }
__device__ __forceinline__ int lane_rank(unsigned long long mask) { return (int)__builtin_amdgcn_mbcnt_hi((unsigned)(mask >> 32), __builtin_amdgcn_mbcnt_lo((unsigned)mask, 0u)); }
__device__ __forceinline__ int bcount(bool p) { return (int)__popcll(__ballot(p)); }
__device__ __forceinline__ void select_full(const LAS unsigned* my, int npad, LAS unsigned short* lst, int lane) {
    unsigned thr = 0u;
    for (int bit = 31; bit >= 0; --bit) {
        const unsigned cand = thr | (1u << bit); int cnt = 0;
        for (int i0 = 0; i0 < npad; i0 += 256) { const int idx = i0 + 4 * lane; v4u v = (v4u){0u, 0u, 0u, 0u}; if (idx < npad) v = *(const LAS v4u*)(my + idx);
            cnt += bcount(v.x >= cand) + bcount(v.y >= cand) + bcount(v.z >= cand) + bcount(v.w >= cand); }
        if (cnt >= 256) thr = cand;
    }
    int cgt = 0;
    for (int i0 = 0; i0 < npad; i0 += 256) { const int idx = i0 + 4 * lane; v4u v = (v4u){0u, 0u, 0u, 0u}; if (idx < npad) v = *(const LAS v4u*)(my + idx);
        cgt += bcount(v.x > thr) + bcount(v.y > thr) + bcount(v.z > thr) + bcount(v.w > thr); }
    const int quota = 256 - cgt; int eqseen = 0, nsel = 0;
    for (int base = 0; base < npad; base += 64) { const int idx = base + lane; unsigned u = 0u; if (idx < npad) u = my[idx];
        const bool gt = u > thr, eq = (u == thr);
        const unsigned long long em = __ballot(eq); const int er = eqseen + lane_rank(em);
        const bool sel = gt || (eq && er < quota);
        const unsigned long long sm = __ballot(sel); const int pos = nsel + lane_rank(sm);
        if (sel && pos < 256) lst[pos] = (unsigned short)idx;
        nsel += __popcll(sm); eqseen += __popcll(em); }
}
template <int KMAX> __device__ __forceinline__ void select_cands(const unsigned (&uu)[16], const unsigned (&id)[16], LAS unsigned short* lst, int lane, unsigned lb = 0u) {
    unsigned thr = 0u;
    for (int bit = 31; bit >= 0; --bit) {
        if ((((thr ^ lb) >> bit) >> 1) == 0u && ((lb >> bit) & 1u)) { thr |= (1u << bit); continue; }
        const unsigned cand = thr | (1u << bit); int cnt = 0;
#pragma unroll
        for (int k = 0; k < KMAX; ++k) cnt += bcount(uu[k] >= cand);
        if (cnt >= 256) { thr = cand; if (cnt == 256) break; }
    }
    int cgt = 0, ceq = 0;
#pragma unroll
    for (int k = 0; k < KMAX; ++k) { cgt += bcount(uu[k] > thr); ceq += bcount(uu[k] == thr); }
    const int quota = 256 - cgt; unsigned ilim = 0xFFFFu;
    if (ceq != quota) {
        unsigned I = 0u;
        for (int bit = 12; bit >= 0; --bit) { const unsigned cand = I | (1u << bit); int cnt = 0;
#pragma unroll
            for (int k = 0; k < KMAX; ++k) cnt += bcount(uu[k] == thr && id[k] < cand);
            if (cnt < quota) I = cand; }
        ilim = I;
    }
    int nsel = 0;
#pragma unroll
    for (int k = 0; k < KMAX; ++k) { const bool sel = (uu[k] > thr) || (uu[k] == thr && id[k] <= ilim);
        const unsigned long long sm = __ballot(sel); const int pos = nsel + lane_rank(sm);
        if (sel && pos < 256) lst[pos] = (unsigned short)id[k];
        nsel += __popcll(sm); }
}
__device__ __forceinline__ void dsa2_unit(int b, int qg, const bf16* IQ, const bf16* IK, const float* IW, const bf16* DQ, const bf16* DK, const bf16* DV, bf16* OB, LAS unsigned char* lds, int wave, int lane) {
    LAS unsigned* sc = (LAS unsigned*)lds;
    LAS unsigned short* LST = (LAS unsigned short*)(lds + D2_LST);
    LAS int* CNT = (LAS int*)(lds + D2_CNT);
    LAS unsigned short* CL = (LAS unsigned short*)(lds + D2_CL);
    const int q0 = 4 * qg, r32 = lane & 31, hi = lane >> 5; const size_t rowbase = (size_t)b * SEQ;
    const int ntile = (q0 + 3) / 32 + 1, npad = ntile * 32;
#ifndef REP_A
#define REP_A 1
#define REP_B1 1
#define REP_B2 1
#define REP_C 1
#endif
    for (int repa = 0; repa < REP_A; ++repa)
    {
        const int qi = 2 * ((r32 >> 2) & 1) + (r32 >> 4), hd = 4 * ((r32 >> 3) & 1) + (r32 & 3);
        bf16x8 aq[4];
#pragma unroll
        for (int ks = 0; ks < 4; ++ks) aq[ks] = *(const bf16x8*)(IQ + (rowbase + q0 + qi) * 512 + hd * 64 + ks * 16 + hi * 8);
        const float* w0p = IW + (rowbase + q0 + 2 * hi) * 8;
        const f32x4 w0a = *(const f32x4*)(w0p), w0b = *(const f32x4*)(w0p + 4), w1a = *(const f32x4*)(w0p + 8), w1b = *(const f32x4*)(w0p + 12);
        for (int t = wave; t < ntile; t += 32) {
            bf16x8 bk[4][4];
#pragma unroll
            for (int u = 0; u < 4; ++u) { const int tt = t + 8 * u; const bf16* kr = IK + (rowbase + 32 * (tt < ntile ? tt : t)) * 64 + lane * 8;
#pragma unroll
                for (int ks = 0; ks < 4; ++ks) bk[u][ks] = *(const bf16x8*)(kr + ks * 512); }
#pragma unroll
            for (int u = 0; u < 4; ++u) { const int tt = t + 8 * u;
                if (tt < ntile) {
                    const int key = 32 * tt + r32;
                    f32x16 a;
#pragma unroll
                    for (int r = 0; r < 16; ++r) a[r] = 0.f;
#pragma unroll
                    for (int ks = 0; ks < 4; ++ks) a = __builtin_amdgcn_mfma_f32_32x32x16_bf16(aq[ks], bk[u][ks], a, 0, 0, 0);
                    float s0 = 0.f, s1 = 0.f;
#pragma unroll
                    for (int j = 0; j < 4; ++j) { s0 += w0a[j] * fmaxf(a[j], 0.f); s1 += w1a[j] * fmaxf(a[8 + j], 0.f); }
#pragma unroll
                    for (int j = 0; j < 4; ++j) { s0 += w0b[j] * fmaxf(a[4 + j], 0.f); s1 += w1b[j] * fmaxf(a[12 + j], 0.f); }
                    sc[(2 * hi) * 8192 + key] = (key <= q0 + 2 * hi) ? sortable_u32(s0) : 0u;
                    sc[(2 * hi + 1) * 8192 + key] = (key <= q0 + 2 * hi + 1) ? sortable_u32(s1) : 0u;
                } }
        }
    }
    __syncthreads();
    const int qi = wave & 3, hf = wave >> 2, q = q0 + qi, n = q + 1;
    const LAS unsigned* my = sc + qi * 8192;
    for (int repb = 0; repb < REP_B1; ++repb)
    {
        int c = 0; bool ovf = false;
        if (n > 256) {
            unsigned pivot = 1u;
            if (n > 640) {
                unsigned s[8];
#pragma unroll
                for (int k = 0; k < 8; ++k) s[k] = my[(int)(((unsigned)(lane * 8 + k) * (unsigned)n) >> 9)];
                const int r = (256 * 512 * 7 / 4) / n + 8;
                unsigned t16 = 0u;
                for (int bit = 15; bit >= 0; --bit) { const unsigned cand = (t16 | (1u << bit)) << 16; int cnt = 0;
#pragma unroll
                    for (int k = 0; k < 8; ++k) cnt += bcount(s[k] >= cand);
                    if (cnt >= r) t16 |= (1u << bit); }
                pivot = t16 << 16; if (pivot == 0u) pivot = 1u;
            }
            const int half = ((npad + 511) >> 9) << 8; const int lo = hf * half; const int hiend = (lo + half < npad) ? lo + half : npad;
            LAS unsigned short* cl = CL + wave * 1024;
            for (int i0 = lo; i0 < hiend; i0 += 256) { const int idx = i0 + 4 * lane; v4u v = (v4u){0u, 0u, 0u, 0u}; if (idx < hiend) v = *(const LAS v4u*)(my + idx);
#pragma unroll
                for (int e = 0; e < 4; ++e) { const bool f = v[e] >= pivot; const unsigned long long m = __ballot(f); const int pos = c + lane_rank(m);
                    if (f) { if (pos < 1024) cl[pos] = (unsigned short)(idx + e); }
                    c += __popcll(m); } }
            if (c > 1024) ovf = true;
        }
        if (lane == 0) CNT[wave] = ovf ? -1 : c;
    }
    __syncthreads();
    for (int repb2 = 0; repb2 < REP_B2; ++repb2)
    if (wave < 4) {
        LAS unsigned short* lst = LST + wave * 256; int nsel;
        if (n <= 256) { for (int i = lane; i < n; i += 64) lst[i] = (unsigned short)i; nsel = n; }
        else {
            const int c0 = CNT[wave], c1 = CNT[wave + 4]; const int c = c0 + c1;
            if (c0 < 0 || c1 < 0 || c < 256 || c > 1024) select_full(my, npad, lst, lane);
            else {
                unsigned uu[16], id[16];
#pragma unroll
                for (int k = 0; k < 16; ++k) { const int j = k * 64 + lane; unsigned ix = 0u, u = 0u;
                    if (j < c) { ix = (j < c0) ? (unsigned)CL[wave * 1024 + j] : (unsigned)CL[(wave + 4) * 1024 + (j - c0)]; u = my[ix]; }
                    uu[k] = u; id[k] = ix; }
                if (c <= 512) select_cands<8>(uu, id, lst, lane); else select_cands<16>(uu, id, lst, lane);
            }
            nsel = 256;
        }
        if (lane == 0) CNT[8 + wave] = nsel;
    }
    __syncthreads();
    for (int repc = 0; repc < REP_C; ++repc)
    {
        const int nsel = CNT[8 + qi]; const int j0 = 128 * hf; int cntk = nsel - j0; cntk = cntk < 0 ? 0 : (cntk > 128 ? 128 : cntk);
        const LAS unsigned short* lst = LST + qi * 256;
        LAS unsigned char* tile = lds + wave * 16384;
        LAS float* tf = (LAS float*)tile;
        const int l15 = lane & 15, kq = lane >> 4;
        if (cntk == 0) {
#pragma unroll
            for (int i = 0; i < 8; ++i) tf[i * 64 + lane] = 0.f;
            if (lane < 8) { tf[512 + lane] = -INFINITY; tf[520 + lane] = 0.f; }
        } else {
#pragma unroll
            for (int it = 0; it < 16; ++it) { const int r = 8 * it + (lane >> 3), ch = lane & 7; int j = j0 + r; j = j < nsel ? j : nsel - 1;
                const int idxv = (int)lst[j]; const v4u v = *(const v4u*)(DV + (rowbase + idxv) * 64 + 8 * ch);
                *(LAS v4u*)(tile + r * 128 + ch * 16) = v; }
            bf16x8 qf[2];
#pragma unroll
            for (int ks = 0; ks < 2; ++ks) { v4u z = (v4u){0u, 0u, 0u, 0u}; if (l15 < 8) z = *(const v4u*)(DQ + (rowbase + q) * 512 + l15 * 64 + 32 * ks + 8 * kq); qf[ks] = __builtin_bit_cast(bf16x8, z); }
            f32x4d acc[8];
#pragma unroll
            for (int g = 0; g < 8; ++g) { int j = j0 + 16 * g + l15; j = j < nsel ? j : nsel - 1; const int idxk = (int)lst[j];
                const bf16* kp = DK + (rowbase + idxk) * 64 + 8 * kq;
                const bf16x8 k0 = *(const bf16x8*)(kp), k1 = *(const bf16x8*)(kp + 32);
                f32x4d a = (f32x4d){0.f, 0.f, 0.f, 0.f};
                a = __builtin_amdgcn_mfma_f32_16x16x32_bf16(k0, qf[0], a, 0, 0, 0); a = __builtin_amdgcn_mfma_f32_16x16x32_bf16(k1, qf[1], a, 0, 0, 0); acc[g] = a; }
            float mx = -INFINITY;
#pragma unroll
            for (int g = 0; g < 8; ++g)
#pragma unroll
                for (int e = 0; e < 4; ++e) { if (16 * g + 4 * kq + e >= cntk) acc[g][e] = -INFINITY; mx = fmaxf(mx, acc[g][e]); }
            mx = fmaxf(mx, __shfl_xor(mx, 16)); mx = fmaxf(mx, __shfl_xor(mx, 32));
            float ls = 0.f;
#pragma unroll
            for (int g = 0; g < 8; ++g)
#pragma unroll
                for (int e = 0; e < 4; ++e) { acc[g][e] = __builtin_amdgcn_exp2f(acc[g][e] - mx); ls += acc[g][e]; }
            ls += __shfl_xor(ls, 16); ls += __shfl_xor(ls, 32);
            bf16x8 pa[4];
#pragma unroll
            for (int t = 0; t < 4; ++t) { v4u w; w.x = cvtpk(acc[2 * t][0], acc[2 * t][1]); w.y = cvtpk(acc[2 * t][2], acc[2 * t][3]); w.z = cvtpk(acc[2 * t + 1][0], acc[2 * t + 1][1]); w.w = cvtpk(acc[2 * t + 1][2], acc[2 * t + 1][3]); pa[t] = __builtin_bit_cast(bf16x8, w); }
            f32x4d o[4];
            const int q_ = l15 >> 2, p_ = lane & 3;
#pragma unroll
            for (int cb = 0; cb < 4; ++cb) { f32x4d oc = (f32x4d){0.f, 0.f, 0.f, 0.f};
#pragma unroll
                for (int t = 0; t < 4; ++t) {
                    const LAS unsigned char* a1 = tile + (32 * t + 4 * kq + q_) * 128 + (16 * cb + 4 * p_) * 2;
                    const v4i16_t lo4 = __builtin_amdgcn_ds_read_tr16_b64_v4i16((LAS v4i16_t*)a1), hi4 = __builtin_amdgcn_ds_read_tr16_b64_v4i16((LAS v4i16_t*)(a1 + 16 * 128));
                    const bf16x8 vf = (bf16x8){lo4[0], lo4[1], lo4[2], lo4[3], hi4[0], hi4[1], hi4[2], hi4[3]};
                    oc = __builtin_amdgcn_mfma_f32_16x16x32_bf16(pa[t], vf, oc, 0, 0, 0); }
                o[cb] = oc; }
            if (kq < 2) {
#pragma unroll
                for (int cb = 0; cb < 4; ++cb)
#pragma unroll
                    for (int e = 0; e < 4; ++e) tf[(4 * kq + e) * 64 + 16 * cb + l15] = o[cb][e];
            }
            if (lane < 8) { tf[512 + lane] = mx; tf[520 + lane] = ls; }
        }
    }
    __syncthreads();
    if (wave < 4) {
        const LAS float* ta = (const LAS float*)(lds + wave * 16384); const LAS float* tb = (const LAS float*)(lds + (wave + 4) * 16384);
        const int h = lane >> 3, d0 = (lane & 7) * 8;
        const float ma = ta[512 + h], mb = tb[512 + h], la = ta[520 + h], lb = tb[520 + h];
        const float m = fmaxf(ma, mb), fa = __builtin_amdgcn_exp2f(ma - m), fb = __builtin_amdgcn_exp2f(mb - m);
        const float inv = 1.0f / (la * fa + lb * fb);
        const f32x4 a0 = *(const LAS f32x4*)(ta + h * 64 + d0), a1 = *(const LAS f32x4*)(ta + h * 64 + d0 + 4), b0 = *(const LAS f32x4*)(tb + h * 64 + d0), b1 = *(const LAS f32x4*)(tb + h * 64 + d0 + 4);
        const f32x4 r0 = (a0 * fa + b0 * fb) * inv, r1 = (a1 * fa + b1 * fb) * inv;
        v4u w; w.x = cvtpk(r0[0], r0[1]); w.y = cvtpk(r0[2], r0[3]); w.z = cvtpk(r1[0], r1[1]); w.w = cvtpk(r1[2], r1[3]);
        *(v4u*)(OB + (rowbase + q) * 512 + h * 64 + d0) = w;
    }
    __syncthreads();
}
constexpr int D3_RING = RING_BYTES + 1024;
constexpr int D3_LST = D3_RING + 16384;
constexpr int D3_CNT = D3_LST + 8192;
constexpr int D3_QW = D3_CNT + 512;
typedef unsigned long long u64d;
template <int KMAX> __device__ __forceinline__ void select_cands3(const unsigned (&uu)[16], const unsigned (&id)[16], LAS unsigned short* lst, int lane) { select_cands<KMAX>(uu, id, lst, lane); }
__device__ __forceinline__ void dsa3_unit(int b, int g16, const bf16* IQ, const bf16* IK, const float* IW, const bf16* DQ, const bf16* DK, const bf16* DV, bf16* OB, LAS unsigned char* lds, int wave, int lane_in) {
    int lane = lane_in; asm volatile("" : "+v"(lane));
    LAS u64d* LISTS = (LAS u64d*)lds;
    LAS unsigned short* LST = (LAS unsigned short*)(lds + D3_LST);
    LAS int* CNT = (LAS int*)(lds + D3_CNT);
    const int tid = wave * 64 + lane, r32 = lane & 31, hi = lane >> 5; const size_t rowbase = (size_t)b * SEQ;
    const int q0 = 16 * g16, ntile = (q0 + 15) / 32 + 1, nstep = (ntile + 1) >> 1;
    const int qgrp = wave & 3, par = wave >> 2;
    const int qA = q0 + 4 * qgrp + 2 * hi, qB = qA + 1;
    const int qi = 2 * ((r32 >> 2) & 1) + (r32 >> 4), hd = 4 * ((r32 >> 3) & 1) + (r32 & 3);
    bf16x8 aq[4];
#pragma unroll
    for (int ks = 0; ks < 4; ++ks) aq[ks] = *(const bf16x8*)(IQ + (rowbase + q0 + 4 * qgrp + qi) * 512 + hd * 64 + ks * 16 + hi * 8);
    const float* w0p = IW + (rowbase + qA) * 8;
    const f32x4 w0a = *(const f32x4*)(w0p), w0b = *(const f32x4*)(w0p + 4), w1a = *(const f32x4*)(w0p + 8), w1b = *(const f32x4*)(w0p + 12);
    f32x4 l0a, l0b, l1a, l1b;
#pragma unroll
    for (int j = 0; j < 4; ++j) { l0a[j] = w0a[j] >= 0.f ? INFINITY : -INFINITY; l0b[j] = w0b[j] >= 0.f ? INFINITY : -INFINITY; l1a[j] = w1a[j] >= 0.f ? INFINITY : -INFINITY; l1b[j] = w1b[j] >= 0.f ? INFINITY : -INFINITY; }
#define D3_SCORE(BK, S0, S1) do { f32x16 a_; _Pragma("unroll") for (int r = 0; r < 16; ++r) a_[r] = 0.f; \
        _Pragma("unroll") for (int ks = 0; ks < 4; ++ks) a_ = __builtin_amdgcn_mfma_f32_32x32x16_bf16(aq[ks], BK[ks], a_, 0, 0, 0); \
        S0 = 0.f; S1 = 0.f; \
        _Pragma("unroll") for (int j = 0; j < 4; ++j) { S0 += __builtin_amdgcn_fmed3f(w0a[j] * a_[j], 0.f, l0a[j]); S1 += __builtin_amdgcn_fmed3f(w1a[j] * a_[8 + j], 0.f, l1a[j]); } \
        _Pragma("unroll") for (int j = 0; j < 4; ++j) { S0 += __builtin_amdgcn_fmed3f(w0b[j] * a_[4 + j], 0.f, l0b[j]); S1 += __builtin_amdgcn_fmed3f(w1b[j] * a_[12 + j], 0.f, l1b[j]); } } while (0)
#ifndef REP_S
#define REP_S 1
#define REP_M 1
#define REP_B 1
#define REP_CD 1
#endif
    unsigned pivA = 1u, pivB = 1u;
    if (ntile <= 16 && tid < 16) CNT[64 + tid] = 0;
    for (int reps = 0; reps < REP_S; ++reps)
    if (ntile > 16) {
#pragma unroll
        for (int k = 0; k < 4; ++k) { const int c = tid + 512 * k; const int ts = ((c >> 8) * ntile) >> 3;
            *(LAS v4u*)(lds + c * 16) = *(const v4u*)(IK + (rowbase + 32 * ts) * 64 + (c & 255) * 8); }
        __syncthreads();
        unsigned uA[8], uB[8];
#pragma unroll
        for (int i = 0; i < 8; ++i) { bf16x8 bk[4];
#pragma unroll
            for (int ks = 0; ks < 4; ++ks) bk[ks] = *(const LAS bf16x8*)(lds + i * 4096 + ks * 1024 + lane * 16);
            float s0, s1; D3_SCORE(bk, s0, s1); uA[i] = sortable_u32(s0); uB[i] = sortable_u32(s1); asm volatile("" ::: "memory"); }
        const int qs = q0 + 4 * qgrp + par;
        const int r0 = (256 * 256 * 7 / 4) / (qs + 1) + 6, r1 = (256 * 256 * 7 / 4) / (qs + 3) + 6;
        unsigned us[8];
#pragma unroll
        for (int i = 0; i < 8; ++i) us[i] = par ? uB[i] : uA[i];
        unsigned t0 = 0u, t1 = 0u;
        for (int bit = 15; bit >= 0; --bit) {
            const unsigned c = ((hi ? t1 : t0) | (1u << bit)) << 16; int n0 = 0, n1 = 0;
#pragma unroll
            for (int i = 0; i < 8; ++i) { const unsigned long long m = __builtin_amdgcn_ballot_w64(us[i] >= c); n0 += __popc((unsigned)m); n1 += __popc((unsigned)(m >> 32)); }
            if (n0 >= r0) t0 |= (1u << bit);
            if (n1 >= r1) t1 |= (1u << bit);
        }
        LAS unsigned* PV = (LAS unsigned*)(CNT + 64);
        if (lane == 0) { PV[4 * qgrp + par] = t0; PV[4 * qgrp + 2 + par] = t1; }
        __syncthreads();
        const unsigned tA = PV[4 * qgrp + 2 * hi], tB = PV[4 * qgrp + 2 * hi + 1];
        pivA = tA << 16; pivB = tB << 16; if (pivA == 0u) pivA = 1u; if (pivB == 0u) pivB = 1u;
        __syncthreads();
    }
    for (int repm = 0; repm < REP_M; ++repm)
    {
        const bf16* src0 = IK + rowbase * 64 + (size_t)(tid & 255) * 8;
#define D3_LOAD(k_) (*(const v4u*)(src0 + (size_t)32 * ((2 * (k_) + (tid >> 8)) < ntile ? (2 * (k_) + (tid >> 8)) : ntile - 1) * 64))
        v4u st0 = (v4u){0u, 0u, 0u, 0u}, st1 = st0, st2 = st0, st3 = st0;
        st0 = D3_LOAD(0); st1 = D3_LOAD(1); st2 = D3_LOAD(2); st3 = D3_LOAD(3);
        *(LAS v4u*)(lds + D3_RING + tid * 16) = st0;
        __syncthreads();
        int cntA = 0, cntB = 0;
        LAS u64d* lA = LISTS + ((4 * qgrp + 2 * hi) * 2 + par) * 512; LAS u64d* lB = lA + 1024;
        LAS u64d* dmy = (LAS u64d*)(lds + D3_QW + 64) + lane;
        f32x16 acc;
#pragma unroll
        for (int r = 0; r < 16; ++r) acc[r] = 0.f;
#define D3_SUMS(S0, S1) do { S0 = 0.f; S1 = 0.f; \
            _Pragma("unroll") for (int j = 0; j < 4; ++j) { S0 += __builtin_amdgcn_fmed3f(w0a[j] * acc[j], 0.f, l0a[j]); S1 += __builtin_amdgcn_fmed3f(w1a[j] * acc[8 + j], 0.f, l1a[j]); } \
            _Pragma("unroll") for (int j = 0; j < 4; ++j) { S0 += __builtin_amdgcn_fmed3f(w0b[j] * acc[4 + j], 0.f, l0b[j]); S1 += __builtin_amdgcn_fmed3f(w1b[j] * acc[12 + j], 0.f, l1b[j]); } } while (0)
#define D3_FILTER(TP, S0, S1) do { const int key = 32 * (TP) + r32; const unsigned u0 = sortable_u32(S0), u1 = sortable_u32(S1);     \
                const bool psa = (key <= qA) && (u0 >= pivA), psb = (key <= qB) && (u1 >= pivB); \
                const unsigned long long ma = __ballot(psa), mb = __ballot(psb); const unsigned mla = (unsigned)ma, mha = (unsigned)(ma >> 32), mlb = (unsigned)mb, mhb = (unsigned)(mb >> 32); \
                const int posa = cntA + (int)__builtin_amdgcn_mbcnt_hi(mha, __builtin_amdgcn_mbcnt_lo(mla, 0u)) - (hi ? __popc(mla) : 0); \
                const int posb = cntB + (int)__builtin_amdgcn_mbcnt_hi(mhb, __builtin_amdgcn_mbcnt_lo(mlb, 0u)) - (hi ? __popc(mlb) : 0); \
                LAS u64d* wa_ = (psa && posa < 512) ? lA + posa : dmy; LAS u64d* wb_ = (psb && posb < 512) ? lB + posb : dmy; \
                *wa_ = ((u64d)(unsigned)key << 32) | u0; *wb_ = ((u64d)(unsigned)key << 32) | u1; \
                cntA += hi ? __popc(mha) : __popc(mla); cntB += hi ? __popc(mhb) : __popc(mlb); } while (0)
#define D3_STEP(k_, STNEXT, STFREE) do { \
            STFREE = D3_LOAD((k_) + 4); \
            const int tp_ = 2 * (k_) - 2 + par; \
            const LAS unsigned char* sb = lds + D3_RING + ((k_) & 1) * 8192 + par * 4096; bf16x8 bk[4]; \
            _Pragma("unroll") for (int ks = 0; ks < 4; ++ks) bk[ks] = *(const LAS bf16x8*)(sb + ks * 1024 + lane * 16); \
            __builtin_amdgcn_sched_barrier(0); \
            float s0, s1; D3_SUMS(s0, s1); asm volatile("" : "+v"(s0), "+v"(s1));     \
            __builtin_amdgcn_sched_barrier(0); \
            _Pragma("unroll") for (int r = 0; r < 16; ++r) acc[r] = 0.f; \
            _Pragma("unroll") for (int ks = 0; ks < 4; ++ks) acc = __builtin_amdgcn_mfma_f32_32x32x16_bf16(aq[ks], bk[ks], acc, 0, 0, 0); \
            __builtin_amdgcn_sched_barrier(0); \
            if (tp_ >= 0 && tp_ < ntile) D3_FILTER(tp_, s0, s1); \
            *(LAS v4u*)(lds + D3_RING + (((k_) + 1) & 1) * 8192 + tid * 16) = STNEXT; \
            asm volatile("s_waitcnt lgkmcnt(0)" ::: "memory"); __builtin_amdgcn_s_barrier(); asm volatile("" ::: "memory"); } while (0)
        int kend = 0;
        for (int k = 0; k < nstep; k += 4) {
            D3_STEP(k, st1, st0); D3_STEP(k + 1, st2, st1); D3_STEP(k + 2, st3, st2); D3_STEP(k + 3, st0, st3); kend = k + 4;
        }
        {   const int tp_ = 2 * kend - 2 + par; if (tp_ < ntile) { float s0, s1; D3_SUMS(s0, s1); D3_FILTER(tp_, s0, s1); } }
#undef D3_SUMS
#undef D3_FILTER
#undef D3_STEP
#undef D3_LOAD
        if (r32 == 0) { CNT[(4 * qgrp + 2 * hi) * 2 + par] = cntA; CNT[(4 * qgrp + 2 * hi + 1) * 2 + par] = cntB; }
        if (tid < 4) CNT[48 + tid] = 0;
    }
#undef D3_SCORE
    __syncthreads();
#if defined(DBG_D3_STAGE) && DBG_D3_STAGE == 1
    for (int grp = 0; grp < 4; ++grp) dsa2_unit(b, 4 * g16 + grp, IQ, IK, IW, DQ, DK, DV, OB, lds, wave, lane);
    return;
#endif
#pragma unroll 1
    for (int rr = 0; rr < 2 * REP_B; ++rr) {
        const int qx = wave + 8 * (rr & 1), q = q0 + qx, n = q + 1; LAS unsigned short* lst = LST + qx * 256; int nsel;
        if (n <= 256) { for (int i = lane; i < n; i += 64) lst[i] = (unsigned short)i; nsel = n; }
        else {
            const int c0 = CNT[2 * qx], c1 = CNT[2 * qx + 1]; const int c = c0 + c1;
#ifdef DBG_D3_ALLFAIL
            if (true) { if (lane == 0) CNT[48 + (qx >> 2)] = 1; nsel = 0; }
#else
            if (c0 > 512 || c1 > 512 || c < 256) { if (lane == 0) CNT[48 + (qx >> 2)] = 1; nsel = 0; }
#endif
            else {
                unsigned uu[16], id[16]; const LAS u64d* L0 = LISTS + (qx * 2) * 512; const LAS u64d* L1 = L0 + 512;
#pragma unroll
                for (int k = 0; k < 16; ++k) { const int j = k * 64 + lane, jj = j < c ? j : c - 1;
                    const u64d e = *((jj < c0) ? (L0 + jj) : (L1 + (jj - c0))); uu[k] = j < c ? (unsigned)e : 0u; id[k] = (unsigned)(e >> 32); }
                const unsigned lb = (unsigned)CNT[64 + qx] << 16;
                if (c <= 512) select_cands<8>(uu, id, lst, lane, lb); else if (c <= 640) select_cands<10>(uu, id, lst, lane, lb); else if (c <= 768) select_cands<12>(uu, id, lst, lane, lb); else select_cands<16>(uu, id, lst, lane, lb);
                nsel = 256;
            }
        }
        if (lane == 0) CNT[32 + qx] = nsel;
    }
    __syncthreads();
#pragma unroll 1
    for (int rr_ = 0; rr_ < 2 * REP_CD; ++rr_) { const int rr = rr_ & 1;
        const int qx = wave + 8 * rr, q = q0 + qx; const int nsel = CNT[32 + qx];
        const LAS unsigned short* lst = LST + qx * 256;
        LAS unsigned char* tile = lds + wave * 16384; LAS float* tf = (LAS float*)tile;
        const int l15 = lane & 15, kq = lane >> 4, q_ = l15 >> 2, p_ = lane & 3;
        bf16x8 qf[2];
#pragma unroll
        for (int ks = 0; ks < 2; ++ks) { v4u z = (v4u){0u, 0u, 0u, 0u}; if (l15 < 8) z = *(const v4u*)(DQ + (rowbase + q) * 512 + l15 * 64 + 32 * ks + 8 * kq); qf[ks] = __builtin_bit_cast(bf16x8, z); }
        float mrun = -INFINITY, lrun = 0.f; f32x4d orun[4];
#pragma unroll
        for (int cb = 0; cb < 4; ++cb) orun[cb] = (f32x4d){0.f, 0.f, 0.f, 0.f};
#pragma unroll 1
        for (int hf = 0; hf < 2; ++hf) {
            const int j0 = 128 * hf; int cntk = nsel - j0; cntk = cntk > 128 ? 128 : cntk;
            if (cntk <= 0) break;
            int iv[16], ik[8];
#pragma unroll
            for (int it = 0; it < 16; ++it) { int j = j0 + 8 * it + (lane >> 3); j = j < nsel ? j : nsel - 1; iv[it] = (int)lst[j]; }
#pragma unroll
            for (int g = 0; g < 8; ++g) { int j = j0 + 16 * g + l15; j = j < nsel ? j : nsel - 1; ik[g] = (int)lst[j]; }
            asm volatile("s_waitcnt lgkmcnt(0)" ::: "memory");
#pragma unroll
            for (int it = 0; it < 16; ++it)
                __builtin_amdgcn_global_load_lds((const unsigned*)(DV + (rowbase + iv[it]) * 64 + 8 * (lane & 7)), (LAS unsigned*)(tile + it * 1024), 16, 0, 0);
            bf16x8 kk0[8], kk1[8];
#pragma unroll
            for (int g = 0; g < 8; ++g) { const bf16* kp = DK + (rowbase + ik[g]) * 64 + 8 * kq; kk0[g] = *(const bf16x8*)(kp); kk1[g] = *(const bf16x8*)(kp + 32); }
            asm volatile("" ::: "memory");
            f32x4d acc[8];
#pragma unroll
            for (int g = 0; g < 8; ++g) { f32x4d a = (f32x4d){0.f, 0.f, 0.f, 0.f};
                a = __builtin_amdgcn_mfma_f32_16x16x32_bf16(kk0[g], qf[0], a, 0, 0, 0); a = __builtin_amdgcn_mfma_f32_16x16x32_bf16(kk1[g], qf[1], a, 0, 0, 0); acc[g] = a; }
            float mx = -INFINITY;
#pragma unroll
            for (int g = 0; g < 8; ++g)
#pragma unroll
                for (int e = 0; e < 4; ++e) { if (16 * g + 4 * kq + e >= cntk) acc[g][e] = -INFINITY; mx = fmaxf(mx, acc[g][e]); }
            mx = fmaxf(mx, __shfl_xor(mx, 16)); mx = fmaxf(mx, __shfl_xor(mx, 32));
            const float mnew = fmaxf(mrun, mx), fold = __builtin_amdgcn_exp2f(mrun - mnew);
            float ls = 0.f;
#pragma unroll
            for (int g = 0; g < 8; ++g)
#pragma unroll
                for (int e = 0; e < 4; ++e) { acc[g][e] = __builtin_amdgcn_exp2f(acc[g][e] - mnew); ls += acc[g][e]; }
            ls += __shfl_xor(ls, 16); ls += __shfl_xor(ls, 32);
            lrun = lrun * fold + ls; mrun = mnew;
            float fo[4];
#pragma unroll
            for (int e = 0; e < 4; ++e) fo[e] = __shfl(fold, 4 * kq + e);
            asm volatile("s_waitcnt vmcnt(0)" ::: "memory");
            bf16x8 pa[4];
#pragma unroll
            for (int t = 0; t < 4; ++t) { v4u w; w.x = cvtpk(acc[2 * t][0], acc[2 * t][1]); w.y = cvtpk(acc[2 * t][2], acc[2 * t][3]); w.z = cvtpk(acc[2 * t + 1][0], acc[2 * t + 1][1]); w.w = cvtpk(acc[2 * t + 1][2], acc[2 * t + 1][3]); pa[t] = __builtin_bit_cast(bf16x8, w); }
#pragma unroll
            for (int cb = 0; cb < 4; ++cb) { f32x4d oc = orun[cb];
#pragma unroll
                for (int e = 0; e < 4; ++e) oc[e] *= fo[e];
#pragma unroll
                for (int t = 0; t < 4; ++t) {
                    const LAS unsigned char* a1 = tile + (32 * t + 4 * kq + q_) * 128 + (16 * cb + 4 * p_) * 2;
                    const v4i16_t lo4 = __builtin_amdgcn_ds_read_tr16_b64_v4i16((LAS v4i16_t*)a1), hi4 = __builtin_amdgcn_ds_read_tr16_b64_v4i16((LAS v4i16_t*)(a1 + 16 * 128));
                    const bf16x8 vf = (bf16x8){lo4[0], lo4[1], lo4[2], lo4[3], hi4[0], hi4[1], hi4[2], hi4[3]};
                    oc = __builtin_amdgcn_mfma_f32_16x16x32_bf16(pa[t], vf, oc, 0, 0, 0); }
                orun[cb] = oc; }
        }
        float li[4];
#pragma unroll
        for (int e = 0; e < 4; ++e) li[e] = 1.0f / __shfl(lrun, 4 * kq + e);
        if (kq < 2) {
#pragma unroll
            for (int cb = 0; cb < 4; ++cb)
#pragma unroll
                for (int e = 0; e < 4; ++e) tf[(4 * kq + e) * 64 + 16 * cb + l15] = orun[cb][e] * li[e];
        }
        { const int h = lane >> 3, d0 = (lane & 7) * 8;
          const f32x4 r0 = *(const LAS f32x4*)(tf + h * 64 + d0), r1 = *(const LAS f32x4*)(tf + h * 64 + d0 + 4);
          v4u w; w.x = cvtpk(r0[0], r0[1]); w.y = cvtpk(r0[2], r0[3]); w.z = cvtpk(r1[0], r1[1]); w.w = cvtpk(r1[2], r1[3]);
          *(v4u*)(OB + (rowbase + q) * 512 + h * 64 + d0) = w; }
    }
    __syncthreads();
    const int f0 = CNT[48], f1 = CNT[49], f2 = CNT[50], f3 = CNT[51];
    __syncthreads();
    const int fm = (f0 ? 1 : 0) | (f1 ? 2 : 0) | (f2 ? 4 : 0) | (f3 ? 8 : 0);
#pragma unroll 1
    for (int grp = 0; grp < 4; ++grp) if ((fm >> grp) & 1) dsa2_unit(b, 4 * g16 + grp, IQ, IK, IW, DQ, DK, DV, OB, lds, wave, lane);
}
__device__ __forceinline__ void fox_unit2(int bh, int qb, const bf16* FQ, const bf16* FK, const bf16* FV, const float* CUM, const int* T0, bf16* OA, LAS unsigned char* lds, int wave, int lane) {
    const int b = bh >> 3, h = bh & 7, r32 = lane & 31, hi = lane >> 5; const size_t rowbase = (size_t)b * SEQ; const int q0 = qb * 256 + wave * 32;
    const bf16* Qw = FQ + (rowbase + q0) * 512 + h * 64; bf16* Ow = OA + (rowbase + q0) * 512 + h * 64;
    const bf16* Kp = FK + rowbase * 512 + h * 64; const bf16* Vp = FV + rowbase * 512 + h * 64; const float* cb = CUM + (size_t)bh * SEQ;
    LAS unsigned char* wl = lds + wave * 16384;
    LAS float* bl = (LAS float*)(lds + RING_BYTES + 8192 + wave * 256);
    bf16x8 qr[4];
#pragma unroll
    for (int ks = 0; ks < 4; ++ks) qr[ks] = *(const bf16x8*)(Qw + (size_t)r32 * 512 + ks * 16 + hi * 8);
    const int tstart = T0[bh * 256 + q0 / 32], ntiles = q0 / 32 + 1, qlocal = q0 + r32;
    f32x16 o[2];
#pragma unroll
    for (int d0 = 0; d0 < 2; ++d0)
#pragma unroll
        for (int r = 0; r < 16; ++r) o[d0][r] = 0.f;
    float m = -1e30f, l = 0.f;
    const int lrow = lane >> 3, lch = lane & 7;
#define FOX_LOAD(KR, VR, BR, tt) do { _Pragma("unroll") for (int it = 0; it < 4; ++it) { const size_t ro = (size_t)(32 * (tt) + 8 * it + lrow) * 512 + lch * 8; KR[it] = *(const v4u*)(Kp + ro); VR[it] = *(const v4u*)(Vp + ro); } BR = cb[32 * (tt) + r32]; } while (0)
#define FOX_STORE(KR, VR, BR, bf) do { _Pragma("unroll") for (int it = 0; it < 4; ++it) { const int row = 8 * it + lrow; *(LAS v4u*)(wl + (bf) * 4096 + row * 128 + ((lch ^ (row & 7)) * 16)) = KR[it]; *(LAS v4u*)(wl + 8192 + (bf) * 4096 + row * 128 + lch * 16) = VR[it]; } if (lane < 32) bl[(bf) * 32 + lane] = -L2E * BR; } while (0)
    v4u krA[4], vrA[4], krB[4], vrB[4]; float brA = 0.f, brB = 0.f;
    const int kq = (lane >> 4) & 1, q_ = (lane & 15) >> 2, p_ = lane & 3;
    FOX_LOAD(krA, vrA, brA, tstart);
    if (tstart + 1 < ntiles) FOX_LOAD(krB, vrB, brB, tstart + 1);
    FOX_STORE(krA, vrA, brA, 0);
    auto compute = [&](int t, int buf) {
        const LAS unsigned char* kb = wl + buf * 4096; const LAS unsigned char* vb = wl + 8192 + buf * 4096; const LAS float* bb = bl + buf * 32;
        f32x16 p;
#pragma unroll
        for (int r = 0; r < 16; ++r) p[r] = 0.f;
#pragma unroll
        for (int ks = 0; ks < 4; ++ks) { const bf16x8 kf = *(const LAS bf16x8*)(kb + r32 * 128 + (((2 * ks + hi) ^ (r32 & 7)) * 16)); p = __builtin_amdgcn_mfma_f32_32x32x16_bf16(kf, qr[ks], p, 0, 0, 0); }
#pragma unroll
        for (int g = 0; g < 4; ++g) { const f32x4 c4 = *(const LAS f32x4*)(bb + 8 * g + 4 * hi);
#pragma unroll
            for (int jj = 0; jj < 4; ++jj) p[4 * g + jj] += c4[jj]; }
        if (t == ntiles - 1) {
#pragma unroll
            for (int r = 0; r < 16; ++r) if (32 * t + crow(r, hi) > qlocal) p[r] = -INFINITY;
        }
        float mt = p[0];
#pragma unroll
        for (int r = 1; r < 16; ++r) mt = fmaxf(mt, p[r]);
        mt = fmaxf(mt, __shfl_xor(mt, 32));
        const float mn = fmaxf(m, mt); const float alpha = __builtin_amdgcn_exp2f(m - mn); m = mn;
        l *= alpha;
#pragma unroll
        for (int d0 = 0; d0 < 2; ++d0)
#pragma unroll
            for (int r = 0; r < 16; ++r) o[d0][r] *= alpha;
        float ls = 0.f;
#pragma unroll
        for (int r = 0; r < 16; ++r) { p[r] = __builtin_amdgcn_exp2f(p[r] - mn); ls += p[r]; }
        l += ls;
        bf16x8 pa[2];
#pragma unroll
        for (int s2 = 0; s2 < 2; ++s2) { v4u w; w.x = cvtpk(p[8 * s2 + 0], p[8 * s2 + 1]); w.y = cvtpk(p[8 * s2 + 2], p[8 * s2 + 3]); w.z = cvtpk(p[8 * s2 + 4], p[8 * s2 + 5]); w.w = cvtpk(p[8 * s2 + 6], p[8 * s2 + 7]); pa[s2] = __builtin_bit_cast(bf16x8, w); }
#pragma unroll
        for (int d0 = 0; d0 < 2; ++d0)
#pragma unroll
            for (int s2 = 0; s2 < 2; ++s2) {
                const LAS unsigned char* a1 = vb + (16 * s2 + 4 * hi + q_) * 128 + (32 * d0 + 16 * kq + 4 * p_) * 2;
                const v4i16_t lo4 = __builtin_amdgcn_ds_read_tr16_b64_v4i16((LAS v4i16_t*)a1), hi4 = __builtin_amdgcn_ds_read_tr16_b64_v4i16((LAS v4i16_t*)(a1 + 8 * 128));
                const bf16x8 vf = (bf16x8){lo4[0], lo4[1], lo4[2], lo4[3], hi4[0], hi4[1], hi4[2], hi4[3]};
                o[d0] = __builtin_amdgcn_mfma_f32_32x32x16_bf16(vf, pa[s2], o[d0], 0, 0, 0);
            }
    };
    for (int t = tstart; t < ntiles; t += 2) {
        if (t + 2 < ntiles) FOX_LOAD(krA, vrA, brA, t + 2);
        compute(t, 0);
        if (t + 1 < ntiles) {
            FOX_STORE(krB, vrB, brB, 1);
            if (t + 3 < ntiles) FOX_LOAD(krB, vrB, brB, t + 3);
            compute(t + 1, 1);
            if (t + 2 < ntiles) FOX_STORE(krA, vrA, brA, 0);
        }
    }
#undef FOX_LOAD
#undef FOX_STORE
    l += __shfl_xor(l, 32);
    const float inv = 1.0f / l;
    bf16* orow = Ow + (size_t)r32 * 512;
#pragma unroll
    for (int d0 = 0; d0 < 2; ++d0)
#pragma unroll
        for (int g = 0; g < 4; ++g) { u32x2 w; w.x = cvtpk(o[d0][4 * g] * inv, o[d0][4 * g + 1] * inv); w.y = cvtpk(o[d0][4 * g + 2] * inv, o[d0][4 * g + 3] * inv);
            *(u32x2*)(orow + d0 * 32 + 8 * g + 4 * hi) = w; }
}
__device__ __forceinline__ void fox_unit4(int bh, int qb, const bf16* FQ, const bf16* FK, const bf16* FV, const float* CUM, const int* T0, const float* gq, const float* gk, bf16* OA, LAS unsigned char* lds, int wave, int lane) {
    const int b = bh >> 3, h = bh & 7, r32 = lane & 31, hi = lane >> 5; const size_t rowbase = (size_t)b * SEQ; const int q0 = qb * 256 + wave * 32;
    const bf16* Qw = FQ + (rowbase + q0) * 512 + h * 64; bf16* Ow = OA + (rowbase + q0) * 512 + h * 64;
    const bf16* Kp = FK + rowbase * 512 + h * 64; const bf16* Vp = FV + rowbase * 512 + h * 64; const float* cb = CUM + (size_t)bh * SEQ;
    LAS unsigned char* wl = lds + wave * 16384;
    LAS float* bl = (LAS float*)(lds + RING_BYTES + 8192 + wave * 256);
    bf16x8 qr[4];
#pragma unroll
    for (int ks = 0; ks < 4; ++ks) qr[ks] = *(const bf16x8*)(Qw + (size_t)r32 * 512 + ks * 16 + hi * 8);
    const int tstart = T0[bh * 256 + q0 / 32], tlast = q0 / 32, nseq = tlast - tstart + 1, qlocal = q0 + r32;
    const float stopc = (8.0f * wave_max(fabsf(gq[lane])) * wave_max(fabsf(gk[lane])) + 30.0f) * L2E;
    f32x16 o[2];
#pragma unroll
    for (int d0 = 0; d0 < 2; ++d0)
#pragma unroll
        for (int r = 0; r < 16; ++r) o[d0][r] = 0.f;
    float m = -1e30f, l = 0.f;
    const int lrow = lane >> 3, lch = lane & 7;
#define FOX_LOAD(KR, VR, BR, tt) do { _Pragma("unroll") for (int it = 0; it < 4; ++it) { const size_t ro = (size_t)(32 * (tt) + 8 * it + lrow) * 512 + lch * 8; KR[it] = *(const v4u*)(Kp + ro); VR[it] = *(const v4u*)(Vp + ro); } BR = cb[32 * (tt) + r32]; } while (0)
#define FOX_STORE(KR, VR, BR, bf) do { _Pragma("unroll") for (int it = 0; it < 4; ++it) { const int row = 8 * it + lrow; *(LAS v4u*)(wl + (bf) * 4096 + row * 128 + ((lch ^ (row & 7)) * 16)) = KR[it]; *(LAS v4u*)(wl + 8192 + (bf) * 4096 + row * 128 + lch * 16) = VR[it]; } if (lane < 32) bl[(bf) * 32 + lane] = -L2E * BR; } while (0)
    v4u krA[4], vrA[4], krB[4], vrB[4]; float brA = 0.f, brB = 0.f;
    const int kq = (lane >> 4) & 1, q_ = (lane & 15) >> 2, p_ = lane & 3;
    FOX_LOAD(krA, vrA, brA, tlast);
    if (1 < nseq) FOX_LOAD(krB, vrB, brB, tlast - 1);
    FOX_STORE(krA, vrA, brA, 0);
    auto compute = [&](int t, int buf) -> bool {
        const LAS unsigned char* kb = wl + buf * 4096; const LAS unsigned char* vb = wl + 8192 + buf * 4096; const LAS float* bb = bl + buf * 32;
        if (t != tlast) { const float bmax = bb[31]; if (__all(m > bmax + stopc)) return true; }
        f32x16 p;
#pragma unroll
        for (int r = 0; r < 16; ++r) p[r] = 0.f;
#pragma unroll
        for (int ks = 0; ks < 4; ++ks) { const bf16x8 kf = *(const LAS bf16x8*)(kb + r32 * 128 + (((2 * ks + hi) ^ (r32 & 7)) * 16)); p = __builtin_amdgcn_mfma_f32_32x32x16_bf16(kf, qr[ks], p, 0, 0, 0); }
#pragma unroll
        for (int g = 0; g < 4; ++g) { const f32x4 c4 = *(const LAS f32x4*)(bb + 8 * g + 4 * hi);
#pragma unroll
            for (int jj = 0; jj < 4; ++jj) p[4 * g + jj] += c4[jj]; }
        if (t == tlast) {
#pragma unroll
            for (int r = 0; r < 16; ++r) if (32 * t + crow(r, hi) > qlocal) p[r] = -INFINITY;
        }
        float mt = p[0];
#pragma unroll
        for (int r = 1; r < 16; ++r) mt = fmaxf(mt, p[r]);
        mt = fmaxf(mt, __shfl_xor(mt, 32));
        if (__any(mt > m)) {
            const float mn = fmaxf(m, mt); const float alpha = __builtin_amdgcn_exp2f(m - mn); m = mn;
            l *= alpha;
#pragma unroll
            for (int d0 = 0; d0 < 2; ++d0)
#pragma unroll
                for (int r = 0; r < 16; ++r) o[d0][r] *= alpha;
        }
        const float mn = m;
        float ls = 0.f;
#pragma unroll
        for (int r = 0; r < 16; ++r) { p[r] = __builtin_amdgcn_exp2f(p[r] - mn); ls += p[r]; }
        l += ls;
        bf16x8 pa[2];
#pragma unroll
        for (int s2 = 0; s2 < 2; ++s2) { v4u w; w.x = cvtpk(p[8 * s2 + 0], p[8 * s2 + 1]); w.y = cvtpk(p[8 * s2 + 2], p[8 * s2 + 3]); w.z = cvtpk(p[8 * s2 + 4], p[8 * s2 + 5]); w.w = cvtpk(p[8 * s2 + 6], p[8 * s2 + 7]); pa[s2] = __builtin_bit_cast(bf16x8, w); }
#pragma unroll
        for (int d0 = 0; d0 < 2; ++d0)
#pragma unroll
            for (int s2 = 0; s2 < 2; ++s2) {
                const LAS unsigned char* a1 = vb + (16 * s2 + 4 * hi + q_) * 128 + (32 * d0 + 16 * kq + 4 * p_) * 2;
                const v4i16_t lo4 = __builtin_amdgcn_ds_read_tr16_b64_v4i16((LAS v4i16_t*)a1), hi4 = __builtin_amdgcn_ds_read_tr16_b64_v4i16((LAS v4i16_t*)(a1 + 8 * 128));
                const bf16x8 vf = (bf16x8){lo4[0], lo4[1], lo4[2], lo4[3], hi4[0], hi4[1], hi4[2], hi4[3]};
                o[d0] = __builtin_amdgcn_mfma_f32_32x32x16_bf16(vf, pa[s2], o[d0], 0, 0, 0);
            }
        return false;
    };
    for (int i = 0; i < nseq; i += 2) {
        if (i + 2 < nseq) FOX_LOAD(krA, vrA, brA, tlast - (i + 2));
        if (compute(tlast - i, 0)) break;
        if (i + 1 < nseq) {
            FOX_STORE(krB, vrB, brB, 1);
            if (i + 3 < nseq) FOX_LOAD(krB, vrB, brB, tlast - (i + 3));
            if (compute(tlast - (i + 1), 1)) break;
            if (i + 2 < nseq) FOX_STORE(krA, vrA, brA, 0);
        }
    }
#undef FOX_LOAD
#undef FOX_STORE
    l += __shfl_xor(l, 32);
    const float inv = 1.0f / l;
    bf16* orow = Ow + (size_t)r32 * 512;
#pragma unroll
    for (int d0 = 0; d0 < 2; ++d0)
#pragma unroll
        for (int g = 0; g < 4; ++g) { u32x2 w; w.x = cvtpk(o[d0][4 * g] * inv, o[d0][4 * g + 1] * inv); w.y = cvtpk(o[d0][4 * g + 2] * inv, o[d0][4 * g + 3] * inv);
            *(u32x2*)(orow + d0 * 32 + 8 * g + 4 * hi) = w; }
}
#ifndef DBG_BRANCH_MASK
#define DBG_BRANCH_MASK 7
#endif
#ifndef DBG_NBR
#define DBG_NBR 3
#endif
#ifndef DBG_NOGATE
#define DBG_NOGATE 0
#endif
#ifndef DBG_NOBRANCH
#define DBG_NOBRANCH 0
#endif
#ifndef DBG_GATE_W
#define DBG_GATE_W WS_WGATE
#endif
#ifndef DBG_GATE_AS_BRANCH
#define DBG_GATE_AS_BRANCH 0
#endif
#ifndef REP_FOX
#define REP_FOX 1
#endif
#ifndef REP_DSA
#define REP_DSA 1
#endif
#ifndef REP_GEMM
#define REP_GEMM 1
#endif
#ifndef DBG_SUBST
#define DBG_SUBST 0
#endif
#ifndef P7SEL
#define P7SEL 3
#endif
#ifndef PHMASK
#define PHMASK 0xFFFF
#endif
struct Args { const void* in[24]; float* out; unsigned char* ws; };
#define CONVERT_GROUP(GRP, w_, nw_) do { \
    constexpr int I_GU = 16 * 176, I_D = 44 * 32, I_IN = 16 * 104, I_GT = 16 * 96, I_BR = 8 * 32, I_SQ = 16 * 32; \
    constexpr int NIT = (GRP) == 0 ? I_GU + I_SQ : (GRP) == 1 ? I_D + I_IN + I_GT + 3 * I_BR + I_SQ : I_GU + I_D; \
    LAS float* scr_ = (LAS float*)(L + RING_OFF + wave * 16384); \
    for (int it = (w_); it < NIT; it += (nw_)) { int r = it; \
        if ((GRP) == 0) { \
            if (r < I_GU) { transpose_item<true>(0, ARG_IN(4), ARG_IN(5), 1024, DFF, ARG_IN(3), WSP(bf16, WS_WGU1), scr_, r, 176, lane); continue; } r -= I_GU; \
            transpose_item<true>(1, ARG_IN(17), nullptr, 1024, 1024, ARG_IN(8), WSP(bf16, WS_WMKV), scr_, r, 32, lane); \
        } else if ((GRP) == 1) { \
            if (r < I_D) { transpose_item<false>(1, ARG_IN(6), nullptr, DFF, 1024, nullptr, WSP(bf16, WS_WD1), scr_, r, 32, lane); continue; } r -= I_D; \
            if (r < I_IN) { transpose_item<true>(2, ARG_IN(9), nullptr, 1024, DIN, ARG_IN(7), WSP(bf16, WS_WIN), scr_, r, 104, lane); continue; } r -= I_IN; \
            if (r < I_GT) { transpose_item<true>(3, ARG_IN(9), nullptr, 1024, DIN, ARG_IN(7), WSP(bf16, WS_WGATE), scr_, r, 96, lane); continue; } r -= I_GT; \
            if (r < 3 * I_BR) { const int i = r / I_BR; transpose_item<false>(1, ARG_IN(18) + (size_t)i * 512 * 1024, nullptr, 512, 1024, nullptr, WSP(bf16, WS_WBR) + (size_t)i * 1024 * 512, scr_, r % I_BR, 32, lane); continue; } r -= 3 * I_BR; \
            transpose_item<false>(1, ARG_IN(19), nullptr, 1024, 1024, nullptr, WSP(bf16, WS_WOUT), scr_, r, 32, lane); \
        } else { \
            if (r < I_GU) { transpose_item<true>(0, ARG_IN(21), ARG_IN(22), 1024, DFF, ARG_IN(20), WSP(bf16, WS_WGU2), scr_, r, 176, lane); continue; } r -= I_GU; \
            transpose_item<false>(1, ARG_IN(23), nullptr, DFF, 1024, nullptr, WSP(bf16, WS_WD2), scr_, r, 32, lane); \
        } } } while (0)
__global__ void __launch_bounds__(NWAVES * 64, 2) fwd_mega(Args args) {
    extern __shared__ __attribute__((aligned(16))) unsigned char lds[];
    LAS unsigned char* L = (LAS unsigned char*)lds;
    volatile LAS unsigned* MISC = (volatile LAS unsigned*)(L + MISC_OFF);
    const int tid = threadIdx.x, lane = tid & 63, wave = __builtin_amdgcn_readfirstlane(tid >> 6);
    const int G = gridDim.x; const int bx = blockIdx.x; const int vcu = (G % 8 == 0) ? (bx % 8) * (G / 8) + bx / 8 : bx;
    const Args* ap = (const Args*)__builtin_amdgcn_kernarg_segment_ptr();
#define ARG_IN(k) ((const float*)ap->in[k])
#define WSP(type, off) ((type*)(ap->ws + (off)))
    gu32* ctl = (gu32*)(ap->ws + WS_CTL);
    for (int u = tid; u < (LDS_BYTES - LDSCTL_OFF) / 4; u += NWAVES * 64) ((LAS unsigned*)(L + LDSCTL_OFF))[u] = 0u;
    __syncthreads();
    XcdBarrier bar = xcd_barrier_post((unsigned*)(ctl + CW_BAR), MISC + 8);
#define GRID_BAR() xcd_barrier(bar)
    const int gw = vcu * NWAVES + wave, NGW = G * NWAVES;

#if (PHMASK >> 0) & 1
    {
        LAS float* scr = (LAS float*)(L + RING_OFF + wave * 16384);
        CONVERT_GROUP(0, gw, NGW);
        for (int m0 = gw; m0 < T + 512; m0 += 4 * NGW) {
            const float* xr[4]; bf16* orw[4]; float* ro[4]; bool ok[4];
#pragma unroll
            for (int r = 0; r < 4; ++r) { const int m = m0 + r * NGW; ok[r] = m < T + 512; const int mc = ok[r] ? m : gw;
                if (mc < T) { xr[r] = ARG_IN(0) + (size_t)mc * 1024; orw[r] = WSP(bf16, WS_HB) + (size_t)mc * 1024; ro[r] = WSP(float, WS_RSTDX) + mc; }
                else { xr[r] = ARG_IN(1) + (size_t)(mc - T) * 1024; orw[r] = WSP(bf16, WS_MEMB) + (size_t)(mc - T) * 1024; ro[r] = WSP(float, WS_RSTDM) + (mc - T); } }
            rows4_to_bf16_rstd(xr, orw, ro, ok, lane);
        }
        VM_WAIT(); __syncthreads();
        GRID_BAR();
    }
#endif
#if (PHMASK >> 1) & 1
    {
        if (bx >= G - 8) { pg8::Gemm g{WSP(bf16, WS_MEMB), WSP(bf16, WS_WMKV), 512, 1024, 1024}; pg8::StaticOrder S; S.init(512, 1024, G, bx - (G - 8));
        pg8::EpiMemKV E{WSP(float, WS_KVM), WSP(float, WS_RSTDM)};
        pg8::gemm_phase<pg8::EpiMemKV, pg8::StaticOrder, true, true>(L + RING_OFF, g, S, E); }
    }
#endif
#if (PHMASK >> 2) & 1
    {
        pg8::Gemm g{WSP(bf16, WS_HB), WSP(bf16, WS_WGU1), T, 2 * DFF, 1024}; pg8::StaticOrder S; S.init(T, 2 * DFF, G, bx);
        pg8::build_row_tab<0>(WSP(float, WS_RSTDX), S, (LAS float*)(L + RING_BYTES + 1024)); pg8::EpiSwiGLU<0> E{WSP(bf16, WS_HID), DFF, (LAS float*)(L + RING_BYTES + 1024)};
#pragma unroll 1
        for (int rep_ = 0; rep_ < REP_GEMM; ++rep_)
        pg8::gemm_phase<pg8::EpiSwiGLU<0>, pg8::StaticOrder, true, true>(L + RING_OFF, g, S, E);
        {
            const int nfull = (64 * 22) % G; const int nidle = (nfull == 0) ? G : G - nfull; const int first = G - nidle;
            const int nconv = nidle > 8 ? nidle - 8 : nidle; const bool conv = (bx >= first) && (bx - first < nconv);
            if (conv) { CONVERT_GROUP(1, (bx - first) * NWAVES + wave, nconv * NWAVES);
                for (int e = (bx - first) * NWAVES * 64 + tid; e < T * 32; e += nconv * NWAVES * 64) {
                    const int row = e >> 5, i = e & 31; const float inv_freq = powf(10000.0f, -(float)i * (1.0f / 32.0f));
                    const float ang = (float)((const int*)ap->in[2])[row] * inv_freq; float sn, cs; sincosf(ang, &sn, &cs); WSP(float, WS_COS)[e] = cs; WSP(float, WS_SIN)[e] = sn; } }
        }
        GRID_BAR();
    }
#endif
#if (PHMASK >> 3) & 1
    {
        pg8::Gemm g{WSP(bf16, WS_HID), WSP(bf16, WS_WD1), T, 1024, DFF}; pg8::StaticOrder S; S.init(T, 1024, G, bx);
        pg8::EpiResid3<1> E{nullptr, nullptr, WSP(bf16, WS_HB), WSP(float, WS_SSQ1), 0.5f};
#pragma unroll 1
        for (int rep_ = 0; rep_ < REP_GEMM; ++rep_)
        pg8::gemm_phase<pg8::EpiResid3<1>, pg8::StaticOrder, true, true>(L + RING_OFF, g, S, E);
        GRID_BAR();
    }
#endif
#if (PHMASK >> 4) & 1
    {
        pg8::Gemm g{WSP(bf16, WS_HB), WSP(bf16, WS_WIN), T, NPROJ, 1024}; pg8::StaticOrder S; S.init(T, NPROJ, G, bx);
        pg8::ProjOut PO{WSP(bf16, WS_FQ), WSP(bf16, WS_FK), WSP(bf16, WS_FV), WSP(bf16, WS_DQ), WSP(bf16, WS_IQ), WSP(bf16, WS_MQ), WSP(bf16, WS_DK), WSP(bf16, WS_DV), WSP(bf16, WS_IK), WSP(float, WS_LOGF), WSP(float, WS_IW), WSP(float, WS_COS), WSP(float, WS_SIN), ARG_IN(11), ARG_IN(12), ARG_IN(13), ARG_IN(14), ARG_IN(10)};
        pg8::build_row_tab<16>(WSP(float, WS_SSQ1), S, (LAS float*)(L + RING_BYTES + 1024)); pg8::EpiProj<16> E{PO, (LAS float*)(L + RING_BYTES + 1024), C2_64};
#pragma unroll 1
        for (int rep_ = 0; rep_ < REP_GEMM; ++rep_)
        pg8::gemm_phase<pg8::EpiProj<16>, pg8::StaticOrder, true, true>(L + RING_OFF, g, S, E);
        {
            const int nfull = (64 * 13) % G; const int nidle = (nfull == 0) ? G : G - nfull; const int first = G - nidle;
            if (bx >= first) { CONVERT_GROUP(2, (bx - first) * NWAVES + wave, nidle * NWAVES);
        int lt_ = tid; asm volatile("" : "+v"(lt_)); const int lane = lt_ & 63;
        for (int it = (bx - first) * NWAVES + wave; it < 2048; it += nidle * NWAVES) { const int row = it >> 2, h = it & 3;
                    const f32x2g kv = *(const f32x2g*)(WSP(float, WS_KVM) + (size_t)row * 1024 + h * 128 + 2 * lane); const f32x2g vv = *(const f32x2g*)(WSP(float, WS_KVM) + (size_t)row * 1024 + 512 + h * 128 + 2 * lane);
                    const float ss = wave_sum(kv.x * kv.x + kv.y * kv.y); const float rstd = 1.0f / sqrtf(ss * (1.0f / 128.0f) + 1e-6f);
                    const f32x2g gk = *(const f32x2g*)(ARG_IN(16) + 2 * lane);
                    *(unsigned*)(WSP(bf16, WS_KMB) + (size_t)row * 512 + h * 128 + 2 * lane) = pk2(kv.x * rstd * gk.x, kv.y * rstd * gk.y);
                    *(unsigned*)(WSP(bf16, WS_VMB) + (size_t)row * 512 + h * 128 + 2 * lane) = pk2(vv.x, vv.y); } }
        }
        GRID_BAR();
#if defined(DBG_DUMP_AFTER) && DBG_DUMP_AFTER == 4
        {
            const bf16* sa = WSP(bf16, DBG_DUMP_A); const bf16* sb = WSP(bf16, DBG_DUMP_B);
            for (size_t e = (size_t)vcu * 512 + tid; e < (size_t)T * 512; e += (size_t)G * 512) { const size_t row = e >> 9, c = e & 511;
                ap->out[row * 1024 + c] = bf2f(sa[row * DBG_PITCH + c]); ap->out[row * 1024 + 512 + c] = bf2f(sb[row * DBG_PITCH + c]); }
            return;
        }
#endif

    }
#endif
#if ((PHMASK >> 5) & 1) && !DBG_SUBST
    {
        int lt_ = tid; asm volatile("" : "+v"(lt_)); const int lane = lt_ & 63;
        for (int u = vcu; u < 256; u += G) mem_block(u, WSP(bf16, WS_MQ), WSP(bf16, WS_KMB), WSP(bf16, WS_VMB), ARG_IN(15), L, wave, lane, tid);
    }
#endif
#if ((PHMASK >> 6) & 1) && !DBG_SUBST
    {
        int lt_ = tid; asm volatile("" : "+v"(lt_)); const int lane = lt_ & 63;
        for (int rep_ = 0; rep_ < REP_FOX; ++rep_)
        for (int v = vcu; v < 256; v += G) { const int bh = v >> 4, s = v & 15;
            scan_unit(bh, WSP(float, WS_LOGF), WSP(float, WS_CUM), WSP(int, WS_T0), ARG_IN(11), ARG_IN(12), (LAS float*)(L + SCANX_OFF), (LAS float*)(L + RING_OFF), tid);
            asm volatile("s_waitcnt vmcnt(0)" ::: "memory"); __syncthreads();
            fox_unit4(bh, s, WSP(bf16, WS_FQ), WSP(bf16, WS_FK), WSP(bf16, WS_FV), WSP(float, WS_CUM), WSP(int, WS_T0), ARG_IN(11), ARG_IN(12), WSP(bf16, WS_OA), L, wave, lane); fox_unit4(bh, 31 - s, WSP(bf16, WS_FQ), WSP(bf16, WS_FK), WSP(bf16, WS_FV), WSP(float, WS_CUM), WSP(int, WS_T0), ARG_IN(11), ARG_IN(12), WSP(bf16, WS_OA), L, wave, lane); }
        __syncthreads();
        {
            gu32* qctr = ctl + CW_Q; LAS int* QW = (LAS int*)(L + D3_QW);
            const int pref = (vcu >> 5) & 1;
            unsigned raw = 0u; int cur;
            if (tid == 0) { unsigned u = __hip_atomic_fetch_add(qctr + 64 * pref, 1u, RLX_AGENT); int bsel = pref; if (u >= 512u) { bsel = pref ^ 1; u = __hip_atomic_fetch_add(qctr + 64 * bsel, 1u, RLX_AGENT); } QW[0] = (u < 512u) ? ((bsel << 16) | (int)u) : -1; }
            __syncthreads(); cur = QW[0]; __syncthreads();
            while (cur >= 0) {
                if (tid == 0) raw = __hip_atomic_fetch_add(qctr + 64 * pref, 1u, RLX_AGENT);
                dsa3_unit(cur >> 16, 511 - (cur & 0xffff), WSP(bf16, WS_IQ), WSP(bf16, WS_IK), WSP(float, WS_IW), WSP(bf16, WS_DQ), WSP(bf16, WS_DK), WSP(bf16, WS_DV), WSP(bf16, WS_OB), L, wave, lane);
                if (tid == 0) { unsigned u = raw; int bsel = pref; if (u >= 512u) { bsel = pref ^ 1; u = __hip_atomic_fetch_add(qctr + 64 * bsel, 1u, RLX_AGENT); } QW[0] = (u < 512u) ? ((bsel << 16) | (int)u) : -1; }
                __syncthreads(); cur = QW[0]; __syncthreads();
            }
        }
        GRID_BAR();
    }
#endif
#if (PHMASK >> 7) & 1
    {
        pg8::StaticOrder S; S.init(T, 1024, G, bx); pg8::build_row_tab<16>(WSP(float, WS_SSQ1), S, (LAS float*)(L + RING_BYTES + 1024));
#ifndef P7STREAM
#define P7STREAM 1
#endif
#if P7STREAM
        {   typedef pg8::P7Order<WS_HB, WS_WGATE, WS_OA, WS_OB, WS_MQ, WS_WBR> P7O; P7O O{S, (const char*)WSP(char, 0)};
            pg8::EpiP7 E{WSP(bf16, WS_GSCR), WSP(bf16, WS_MERGED), (LAS float*)(L + RING_BYTES + 1024)};
#ifndef REP_P7
#define REP_P7 1
#endif
#pragma unroll 1
            for (int rep7_ = 0; rep7_ < REP_P7; ++rep7_) pg8::gemm_stream<pg8::EpiP7, P7O>(L + RING_OFF, O, E); }
#pragma unroll 1
        for (int i = 0; i < 0; ++i) {
#else
#pragma unroll 1
        for (int rep_ = 0; rep_ < REP_GEMM; ++rep_)
#pragma unroll 1
        for (int i = 0; i < DBG_NBR; ++i) {
#endif
#if DBG_GATE_AS_BRANCH
            {   pg8::Gemm g{WSP(bf16, WS_HB), WSP(bf16, DBG_GATE_W), T, 1024, 1024}; pg8::EpiBranch E{WSP(bf16, WS_GSCR), WSP(bf16, WS_MERGED), true, 1.0f}; pg8::gemm_phase<pg8::EpiBranch, pg8::StaticOrder, true, true>(L + RING_OFF, g, S, E); }
#elif !DBG_NOGATE
            {   pg8::Gemm g{WSP(bf16, WS_HB), WSP(bf16, DBG_GATE_W) + (size_t)i * 1024 * 1024, T, 1024, 1024}; pg8::EpiGate<16> E{WSP(bf16, WS_GSCR), (LAS float*)(L + RING_BYTES + 1024)}; pg8::gemm_phase<pg8::EpiGate<16>, pg8::StaticOrder, true, true>(L + RING_OFF, g, S, E); }
#endif
#if !DBG_NOBRANCH
#if DBG_SUBST == 1
            {   const bf16* A = (i == 0) ? WSP(bf16, WS_FQ) : (i == 1) ? WSP(bf16, WS_DQ) : WSP(bf16, WS_IQ);
#elif DBG_SUBST == 2
            {   const bf16* A = (i == 0) ? WSP(bf16, WS_FK) : (i == 1) ? WSP(bf16, WS_FV) : WSP(bf16, WS_MQ);
#else
            {   const bf16* A = (i == 0) ? WSP(bf16, WS_OA) : (i == 1) ? WSP(bf16, WS_OB) : WSP(bf16, WS_MQ);
#endif
                pg8::Gemm g{A, WSP(bf16, WS_WBR) + (size_t)i * 1024 * 512, T, 1024, 512}; pg8::EpiBranch E{WSP(bf16, WS_GSCR), WSP(bf16, WS_MERGED), i == 0, ((DBG_BRANCH_MASK >> i) & 1) ? 1.0f : 0.0f}; pg8::gemm_phase<pg8::EpiBranch, pg8::StaticOrder, true, true>(L + RING_OFF, g, S, E); }
#endif
        }
        GRID_BAR();
#if defined(DBG_DUMP_AFTER) && DBG_DUMP_AFTER == 7
        {
            const bf16* sa = WSP(bf16, DBG_DUMP_A); const bf16* sb = WSP(bf16, DBG_DUMP_B);
            for (size_t e = (size_t)vcu * 512 + tid; e < (size_t)T * 512; e += (size_t)G * 512) { const size_t row = e >> 9, c = e & 511;
                ap->out[row * 1024 + c] = bf2f(sa[row * DBG_PITCH + c]); ap->out[row * 1024 + 512 + c] = bf2f(sb[row * DBG_PITCH + c]); }
            return;
        }
#endif

    }
#endif
#if (PHMASK >> 8) & 1
    {
        pg8::Gemm g{WSP(bf16, WS_MERGED), WSP(bf16, WS_WOUT), T, 1024, 1024}; pg8::StaticOrder S; S.init(T, 1024, G, bx);
        pg8::EpiResid3<1> E{nullptr, nullptr, WSP(bf16, WS_HB), WSP(float, WS_SSQ2), 1.0f};
        pg8::gemm_phase<pg8::EpiResid3<1>, pg8::StaticOrder, true, true>(L + RING_OFF, g, S, E);
        GRID_BAR();
    }
#endif
#if (PHMASK >> 9) & 1
    {
        pg8::Gemm g{WSP(bf16, WS_HB), WSP(bf16, WS_WGU2), T, 2 * DFF, 1024}; pg8::StaticOrder S; S.init(T, 2 * DFF, G, bx);
        pg8::build_row_tab<16>(WSP(float, WS_SSQ2), S, (LAS float*)(L + RING_BYTES + 1024)); pg8::EpiSwiGLU<16> E{WSP(bf16, WS_HID), DFF, (LAS float*)(L + RING_BYTES + 1024)};
#pragma unroll 1
        for (int rep_ = 0; rep_ < REP_GEMM; ++rep_)
        pg8::gemm_phase<pg8::EpiSwiGLU<16>, pg8::StaticOrder, true, true>(L + RING_OFF, g, S, E);
        GRID_BAR();
    }
#endif
#if (PHMASK >> 10) & 1
    {
        pg8::Gemm g{WSP(bf16, WS_HID), WSP(bf16, WS_WD2), T, 1024, DFF}; pg8::StaticOrder S; S.init(T, 1024, G, bx);
        pg8::EpiResid3<2> E{nullptr, ap->out, WSP(bf16, WS_HB), nullptr, 0.5f};
        pg8::gemm_phase<pg8::EpiResid3<2>, pg8::StaticOrder, true, true>(L + RING_OFF, g, S, E);
    }
#endif
}

extern "C" void kernel_launch(void* const* d_in, const int* in_sizes, int n_in, void* d_out, int out_size, void* d_ws, size_t ws_size, hipStream_t stream) {
    static int grid = 0;
    if (grid == 0) {
        if (n_in != 24 || out_size != T * DM || ws_size < WS_END) { fprintf(stderr, "kernel_launch: unexpected problem (n_in %d, out %d, ws %zu)\n", n_in, out_size, ws_size); grid = -1; return; }
        int dev = 0, cus = 0, per_cu = 0;
        if (hipGetDevice(&dev) != hipSuccess || hipDeviceGetAttribute(&cus, hipDeviceAttributeMultiprocessorCount, dev) != hipSuccess) { grid = -1; return; }
        if (hipFuncSetAttribute((const void*)fwd_mega, hipFuncAttributeMaxDynamicSharedMemorySize, LDS_BYTES) != hipSuccess) { fprintf(stderr, "kernel_launch: hipFuncSetAttribute failed\n"); grid = -1; return; }
        if (hipOccupancyMaxActiveBlocksPerMultiprocessor(&per_cu, (const void*)fwd_mega, NWAVES * 64, LDS_BYTES) != hipSuccess || per_cu < 1) { fprintf(stderr, "kernel_launch: occupancy query says %d blocks per CU\n", per_cu); (void)hipGetLastError(); grid = -1; return; }
        grid = cus;
    }
    if (grid < 0) return;
    (void)hipMemsetAsync((char*)d_ws + WS_CTL, 0, CTL_ZERO_BYTES, stream);
    Args a{};
    for (int i = 0; i < 24; ++i) a.in[i] = d_in[i];
    a.out = (float*)d_out; a.ws = (unsigned char*)d_ws;
    hipLaunchKernelGGL(fwd_mega, dim3(grid), dim3(NWAVES * 64), LDS_BYTES, stream, a);
}
```

```cpp
#include <hip/hip_runtime.h>
#include <cstdio>
#include <cstdint>
namespace pg8 {
#define PG8_LAS __attribute__((address_space(3)))
typedef unsigned short bf16_t;
typedef short bf16x8 __attribute__((ext_vector_type(8)));
typedef float f32x4 __attribute__((ext_vector_type(4)));
typedef unsigned u32x4 __attribute__((ext_vector_type(4)));
constexpr int BM = 256, BK = 64, HALF = 128, HTB = HALF * BK * 2  , STAGE_BYTES = 8 * HTB, NXCD = 8, WGM = 8;

__host__ __device__ __forceinline__ int lds_byte(int r, int c) { const int st = (r >> 4) * 2 + (c >> 5), rr = r & 15, cc = c & 31, ob = rr * 64 + cc * 2; return st * 1024 + (ob ^ (((ob >> 9) & 1) << 5)); }
__host__ __device__ __forceinline__ void stage_rc(int b, int& R, int& C) { const int st = b / 1024, sb = b % 1024, swz = sb ^ (((sb >> 9) & 1) << 5); R = (st >> 1) * 16 + swz / 64; C = (st & 1) * 32 + (swz % 64) / 2; }
__host__ __device__ __forceinline__ int perm32(int rho) { const int n = rho >> 4, i = rho & 15; return 8 * (i >> 2) + 4 * n + (i & 3); }

struct Unit { int pm, pn; };
struct Gemm { const bf16_t* A; const bf16_t* Bt; int M, N, K; };

struct StaticOrder {
    int nM, nN, nwg, G, c;
    __host__ __device__ void init(int M, int N, int G_, int c_) { nM = M / BM; nN = N / BM; nwg = nM * nN; G = G_; c = c_; }
    __host__ __device__ bool next(int i, Unit& u) const {
        const long L = (long)i * G + c; if (L >= nwg) return false;
        int wgid = (int)L; { const int q = nwg / NXCD, r = nwg % NXCD, xcd = wgid % NXCD, off = wgid / NXCD; wgid = (xcd < r ? xcd * (q + 1) : r * (q + 1) + (xcd - r) * q) + off; }
        const int nig = WGM * nN, gid = wgid / nig, fm = gid * WGM, gsz = (nM - fm) < WGM ? (nM - fm) : WGM;
        u.pm = fm + ((wgid % nig) % gsz); u.pn = (wgid % nig) / gsz; return true;
    }
    __device__ __forceinline__ void a_ready(const Unit&) const {}
    __device__ __forceinline__ void done(const Unit&) const {}
};

typedef float f32x2cv __attribute__((ext_vector_type(2))); typedef __bf16 bf16x2cv __attribute__((ext_vector_type(2)));
__device__ __forceinline__ unsigned cvt_pk_bf16(float lo, float hi) { const f32x2cv v = {lo, hi}; const bf16x2cv b = __builtin_convertvector(v, bf16x2cv); return __builtin_bit_cast(unsigned, b); }
typedef float f32x2 __attribute__((ext_vector_type(2)));
template <class Epi, class Sched, bool ALIGN_EPI = false, bool SP2 = false>
__device__ __forceinline__ void gemm_phase(PG8_LAS unsigned char* lds, const Gemm g, const Sched& S, const Epi& E) {
    int tid_ = threadIdx.x; asm volatile("" : "+v"(tid_));
    const int tid = tid_, wid = __builtin_amdgcn_readfirstlane(tid >> 6), lane = tid & 63, wr = wid >> 2, wc = wid & 3, fr = lane & 15, fq = lane >> 4;
    const int K = g.K, nt = K / BK;
    unsigned voffA[2], voffB[2];
#pragma unroll
    for (int i = 0; i < 2; ++i) { int R, C; stage_rc(tid * 16 + i * 8192, R, C); const int Rb = Epi::PERM ? ((R & ~31) + perm32(R & 31)) : R;
        voffA[i] = (unsigned)(R * K + C) * 2u; voffB[i] = (unsigned)(Rb * K + C) * 2u; }
    const size_t kstep = (size_t)(BK * 2);
    const size_t hstep = (size_t)HALF * K * 2;
    const size_t tstep = 2 * hstep;
    const unsigned ldsw = (unsigned)wid * 1024u;
    const int aoff = lds_byte(wr * 64 + fr, fq * 8), boff = lds_byte(wc * 32 + fr, fq * 8);
#define PG8_SA(b, h) (((b) * 2 + (h)) * HTB)
#define PG8_SB(b, h) ((4 + (b) * 2 + (h)) * HTB)
#define PG8_STAGE(bufoff, gbase, voff) do { _Pragma("unroll") for (int _i = 0; _i < 2; ++_i) \
        __builtin_amdgcn_global_load_lds((const unsigned*)((const char*)(gbase) + (voff)[_i]), (PG8_LAS unsigned*)(lds + (bufoff) + ldsw + _i * 8192), 16, 0, 0); } while (0)
#define PG8_LDA(dst, b, h) do { _Pragma("unroll") for (int m = 0; m < 4; ++m) _Pragma("unroll") for (int k = 0; k < 2; ++k) dst[m][k] = *(const PG8_LAS bf16x8*)(lds + PG8_SA(b, h) + aoff + m * 2048 + k * 1024); } while (0)
#define PG8_LDB(dst, b, h) do { _Pragma("unroll") for (int n = 0; n < 2; ++n) _Pragma("unroll") for (int k = 0; k < 2; ++k) dst[n][k] = *(const PG8_LAS bf16x8*)(lds + PG8_SB(b, h) + boff + n * 2048 + k * 1024); } while (0)
#define PG8_MMA(ai, bj, At, Bt) do { __builtin_amdgcn_s_setprio(1); _Pragma("unroll") for (int m = 0; m < 4; ++m) _Pragma("unroll") for (int n = 0; n < 2; ++n) _Pragma("unroll") for (int k = 0; k < 2; ++k) \
        acc[ai][bj][m][n] = __builtin_amdgcn_mfma_f32_16x16x32_bf16(Bt[n][k], At[m][k], acc[ai][bj][m][n], 0, 0, 0); __builtin_amdgcn_s_setprio(0); } while (0)
#define PG8_WAIT_V(n) asm volatile("s_waitcnt vmcnt(" #n ")" ::: "memory")
#define PG8_WAIT_L(n) asm volatile("s_waitcnt lgkmcnt(" #n ")" ::: "memory")
#define PG8_BAR __builtin_amdgcn_s_barrier()
#define PG8_SCHED __builtin_amdgcn_sched_barrier(0)
    Unit cur, nxt; int ui = 0;
    if (!S.next(0, cur)) return;
    f32x4 acc[2][2][4][2];
#pragma unroll
    for (int a = 0; a < 2; ++a)
#pragma unroll
        for (int b = 0; b < 2; ++b)
#pragma unroll
            for (int m = 0; m < 4; ++m)
#pragma unroll
                for (int n = 0; n < 2; ++n) acc[a][b][m][n] = (f32x4){0.f, 0.f, 0.f, 0.f};
    bf16x8 At[4][2], B0[2][2], B1[2][2];
    const char* cA = (const char*)g.A + (size_t)cur.pm * tstep; const char* cB = (const char*)g.Bt + (size_t)cur.pn * tstep;
    S.a_ready(cur);
    if constexpr (SP2) {
        PG8_STAGE(PG8_SB(0, 0), cB, voffB); PG8_STAGE(PG8_SB(0, 1), cB + hstep, voffB); PG8_STAGE(PG8_SA(0, 0), cA, voffA); PG8_STAGE(PG8_SA(0, 1), cA + hstep, voffA);
        if (wr == 1) PG8_BAR;
        PG8_WAIT_V(2); PG8_BAR;
        PG8_STAGE(PG8_SB(1, 0), cB + kstep, voffB); PG8_STAGE(PG8_SA(1, 0), cA + kstep, voffA); PG8_STAGE(PG8_SB(1, 1), cB + hstep + kstep, voffB);
        PG8_WAIT_V(6); PG8_BAR;
    } else {
        PG8_STAGE(PG8_SB(0, 0), cB, voffB); PG8_STAGE(PG8_SA(0, 0), cA, voffA); PG8_STAGE(PG8_SB(0, 1), cB + hstep, voffB); PG8_STAGE(PG8_SA(0, 1), cA + hstep, voffA);
        if (wr == 1) PG8_BAR;
        PG8_WAIT_V(4); PG8_BAR;
        PG8_STAGE(PG8_SB(1, 0), cB + kstep, voffB); PG8_STAGE(PG8_SA(1, 0), cA + kstep, voffA); PG8_STAGE(PG8_SB(1, 1), cB + hstep + kstep, voffB);
        PG8_WAIT_V(6); PG8_BAR;
    }
    for (;;) {
        const bool has_next = S.next(ui + 1, nxt);
        const char* nA = has_next ? (const char*)g.A + (size_t)nxt.pm * tstep : cA; const char* nB = has_next ? (const char*)g.Bt + (size_t)nxt.pn * tstep : cB;
        for (int t = 0; t < nt; t += 2) {
            const bool last = (t == nt - 2);
            const char* a1 = cA + (size_t)(t + 1) * kstep;
            const char* a2 = last ? nA : cA + (size_t)(t + 2) * kstep; const char* b2 = last ? nB : cB + (size_t)(t + 2) * kstep;
            const char* a3 = a2 + kstep; const char* b3 = b2 + kstep;
            if (last && has_next) S.a_ready(nxt);
            if constexpr (SP2) {
            PG8_LDB(B0, 0, 0); PG8_LDB(B1, 0, 1); PG8_SCHED; PG8_LDA(At, 0, 0); PG8_STAGE(PG8_SA(1, 1), a1 + hstep, voffA);
            PG8_WAIT_V(8); PG8_WAIT_L(0); PG8_BAR; PG8_MMA(0, 0, At, B0); PG8_MMA(0, 1, At, B1); PG8_BAR; PG8_SCHED;
            PG8_LDA(At, 0, 1); PG8_STAGE(PG8_SB(0, 0), b2, voffB); PG8_STAGE(PG8_SB(0, 1), b2 + hstep, voffB); PG8_STAGE(PG8_SA(0, 0), a2, voffA);
            PG8_WAIT_V(8); PG8_WAIT_L(0); PG8_BAR; PG8_MMA(1, 0, At, B0); PG8_MMA(1, 1, At, B1); PG8_BAR; PG8_SCHED;
            PG8_LDB(B0, 1, 0); PG8_LDB(B1, 1, 1); PG8_SCHED; PG8_LDA(At, 1, 0); PG8_STAGE(PG8_SA(0, 1), a2 + hstep, voffA);
            PG8_WAIT_V(8); PG8_WAIT_L(0); PG8_BAR; PG8_MMA(0, 0, At, B0); PG8_MMA(0, 1, At, B1); PG8_BAR; PG8_SCHED;
            PG8_LDA(At, 1, 1); PG8_STAGE(PG8_SB(1, 0), b3, voffB); PG8_STAGE(PG8_SB(1, 1), b3 + hstep, voffB); PG8_STAGE(PG8_SA(1, 0), a3, voffA);
            PG8_WAIT_V(8); PG8_WAIT_L(0); PG8_BAR; PG8_MMA(1, 0, At, B0); PG8_MMA(1, 1, At, B1); PG8_BAR; PG8_SCHED;
            } else {
            PG8_LDB(B0, 0, 0); PG8_SCHED; PG8_LDA(At, 0, 0); PG8_STAGE(PG8_SA(1, 1), a1 + hstep, voffA);
            PG8_WAIT_L(8); PG8_BAR; PG8_WAIT_L(0); PG8_MMA(0, 0, At, B0); PG8_BAR; PG8_SCHED;
            PG8_LDB(B1, 0, 1); PG8_STAGE(PG8_SB(0, 0), b2, voffB);
            PG8_BAR; PG8_WAIT_L(0); PG8_MMA(0, 1, At, B1); PG8_BAR;
            PG8_LDA(At, 0, 1); PG8_STAGE(PG8_SA(0, 0), a2, voffA);
            PG8_BAR; PG8_WAIT_L(0); PG8_MMA(1, 0, At, B0); PG8_BAR; PG8_SCHED;
            PG8_STAGE(PG8_SB(0, 1), b2 + hstep, voffB);
            PG8_WAIT_V(6); PG8_BAR; PG8_MMA(1, 1, At, B1); PG8_BAR;
            PG8_LDB(B0, 1, 0); PG8_SCHED; PG8_LDA(At, 1, 0); PG8_STAGE(PG8_SA(0, 1), a2 + hstep, voffA);
            PG8_WAIT_L(8); PG8_BAR; PG8_WAIT_L(0); PG8_MMA(0, 0, At, B0); PG8_BAR; PG8_SCHED;
            PG8_LDB(B1, 1, 1); PG8_STAGE(PG8_SB(1, 0), b3, voffB);
            PG8_BAR; PG8_WAIT_L(0); PG8_MMA(0, 1, At, B1); PG8_BAR;
            PG8_LDA(At, 1, 1); PG8_STAGE(PG8_SA(1, 0), a3, voffA);
            PG8_BAR; PG8_WAIT_L(0); PG8_MMA(1, 0, At, B0); PG8_BAR; PG8_SCHED;
            PG8_STAGE(PG8_SB(1, 1), b3 + hstep, voffB);
            PG8_WAIT_V(6); PG8_BAR; PG8_MMA(1, 1, At, B1); PG8_BAR;
            }
        }
        if constexpr (ALIGN_EPI) { if (wr == 0) PG8_BAR; }
        if constexpr (!Epi::AFTER_DRAIN) { E(acc, cur, wr, wc, fr, fq); S.done(cur); }
        if (!has_next) break;
#pragma unroll
        for (int a = 0; a < 2; ++a)
#pragma unroll
            for (int b = 0; b < 2; ++b)
#pragma unroll
                for (int m = 0; m < 4; ++m)
#pragma unroll
                    for (int n = 0; n < 2; ++n) acc[a][b][m][n] = (f32x4){0.f, 0.f, 0.f, 0.f};
        cur = nxt; cA = nA; cB = nB; ++ui;
        if constexpr (ALIGN_EPI) { if (wr == 1) PG8_BAR; }
    }
    PG8_WAIT_V(0);
    if constexpr (!ALIGN_EPI) { if (wr == 0) PG8_BAR; }
    PG8_BAR;
    if constexpr (Epi::AFTER_DRAIN) { E.fused(acc, cur, wr, wc, fr, fq, lds, wid, lane); S.done(cur); }
#undef PG8_SA
#undef PG8_SB
#undef PG8_STAGE
#undef PG8_LDA
#undef PG8_LDB
#undef PG8_MMA
#undef PG8_WAIT_V
#undef PG8_WAIT_L
#undef PG8_BAR
#undef PG8_SCHED
}

struct UnitX { int pm, pn, kind, round; };
struct OpsX { const char* A; const char* Bt; int K; };
template <class Epi, class Sched>
__device__ __forceinline__ void gemm_stream(PG8_LAS unsigned char* lds, const Sched& S, const Epi& E) {
    int tid_ = threadIdx.x; asm volatile("" : "+v"(tid_));
    const int tid = tid_, wid = __builtin_amdgcn_readfirstlane(tid >> 6), lane = tid & 63, wr = wid >> 2, wc = wid & 3, fr = lane & 15, fq = lane >> 4;
    unsigned rA[2], rB[2], c2[2];
#pragma unroll
    for (int i = 0; i < 2; ++i) { int R, C; stage_rc(tid * 16 + i * 8192, R, C); rA[i] = (unsigned)R; rB[i] = (unsigned)((R & ~31) + perm32(R & 31)); c2[i] = (unsigned)C * 2u; }
    const size_t kstep = (size_t)(BK * 2);
    const unsigned ldsw = (unsigned)wid * 1024u;
    const int aoff = lds_byte(wr * 64 + fr, fq * 8), boff = lds_byte(wc * 32 + fr, fq * 8);
#define PG8_SA(b, h) (((b) * 2 + (h)) * HTB)
#define PG8_SB(b, h) ((4 + (b) * 2 + (h)) * HTB)
#define PGX_STAGE(bufoff, gbase, rr, pb) do { _Pragma("unroll") for (int _i = 0; _i < 2; ++_i) \
        __builtin_amdgcn_global_load_lds((const unsigned*)((const char*)(gbase) + ((rr)[_i] * (pb) + c2[_i])), (PG8_LAS unsigned*)(lds + (bufoff) + ldsw + _i * 8192), 16, 0, 0); } while (0)
#define PG8_LDA(dst, b, h) do { _Pragma("unroll") for (int m = 0; m < 4; ++m) _Pragma("unroll") for (int k = 0; k < 2; ++k) dst[m][k] = *(const PG8_LAS bf16x8*)(lds + PG8_SA(b, h) + aoff + m * 2048 + k * 1024); } while (0)
#define PG8_LDB(dst, b, h) do { _Pragma("unroll") for (int n = 0; n < 2; ++n) _Pragma("unroll") for (int k = 0; k < 2; ++k) dst[n][k] = *(const PG8_LAS bf16x8*)(lds + PG8_SB(b, h) + boff + n * 2048 + k * 1024); } while (0)
#define PG8_MMA(ai, bj, At, Bt) do { __builtin_amdgcn_s_setprio(1); _Pragma("unroll") for (int m = 0; m < 4; ++m) _Pragma("unroll") for (int n = 0; n < 2; ++n) _Pragma("unroll") for (int k = 0; k < 2; ++k) \
        acc[ai][bj][m][n] = __builtin_amdgcn_mfma_f32_16x16x32_bf16(Bt[n][k], At[m][k], acc[ai][bj][m][n], 0, 0, 0); __builtin_amdgcn_s_setprio(0); } while (0)
#define PG8_WAIT_V(n) asm volatile("s_waitcnt vmcnt(" #n ")" ::: "memory")
#define PG8_WAIT_L(n) asm volatile("s_waitcnt lgkmcnt(" #n ")" ::: "memory")
#define PG8_BAR __builtin_amdgcn_s_barrier()
#define PG8_SCHED __builtin_amdgcn_sched_barrier(0)
    UnitX cur, nxt; int ui = 0;
    if (!S.next(0, cur)) return;
    f32x4 acc[2][2][4][2];
#pragma unroll
    for (int a = 0; a < 2; ++a)
#pragma unroll
        for (int b = 0; b < 2; ++b)
#pragma unroll
            for (int m = 0; m < 4; ++m)
#pragma unroll
                for (int n = 0; n < 2; ++n) acc[a][b][m][n] = (f32x4){0.f, 0.f, 0.f, 0.f};
    bf16x8 At[4][2], B0[2][2], B1[2][2];
    OpsX oc = S.ops(cur);
    const char* cA = oc.A; const char* cB = oc.Bt; int Kc = oc.K;
    {   const unsigned pb = (unsigned)Kc * 2u; const size_t hstep = (size_t)HALF * pb;
        PGX_STAGE(PG8_SB(0, 0), cB, rB, pb); PGX_STAGE(PG8_SB(0, 1), cB + hstep, rB, pb); PGX_STAGE(PG8_SA(0, 0), cA, rA, pb); PGX_STAGE(PG8_SA(0, 1), cA + hstep, rA, pb);
        if (wr == 1) PG8_BAR;
        PG8_WAIT_V(2); PG8_BAR;
        PGX_STAGE(PG8_SB(1, 0), cB + kstep, rB, pb); PGX_STAGE(PG8_SA(1, 0), cA + kstep, rA, pb); PGX_STAGE(PG8_SB(1, 1), cB + hstep + kstep, rB, pb);
        PG8_WAIT_V(6); PG8_BAR; }
    for (;;) {
        const bool has_next = S.next(ui + 1, nxt);
        OpsX on = oc; if (has_next) on = S.ops(nxt);
        const char* nA = on.A; const char* nB = on.Bt; const int Kn = on.K;
        const int nt = Kc / BK; const unsigned pbc = (unsigned)Kc * 2u; const size_t hstep = (size_t)HALF * pbc;
        for (int t = 0; t < nt; t += 2) {
            const bool last = (t == nt - 2);
            const char* a1 = cA + (size_t)(t + 1) * kstep;
            const char* a2 = last ? nA : cA + (size_t)(t + 2) * kstep; const char* b2 = last ? nB : cB + (size_t)(t + 2) * kstep;
            const char* a3 = a2 + kstep; const char* b3 = b2 + kstep;
            const unsigned pb2 = last ? (unsigned)Kn * 2u : pbc; const size_t h2 = (size_t)HALF * pb2;
            PG8_LDB(B0, 0, 0); PG8_LDB(B1, 0, 1); PG8_SCHED; PG8_LDA(At, 0, 0); PGX_STAGE(PG8_SA(1, 1), a1 + hstep, rA, pbc);
            PG8_WAIT_V(8); PG8_WAIT_L(0); PG8_BAR; PG8_MMA(0, 0, At, B0); PG8_MMA(0, 1, At, B1); PG8_BAR; PG8_SCHED;
            PG8_LDA(At, 0, 1); PGX_STAGE(PG8_SB(0, 0), b2, rB, pb2); PGX_STAGE(PG8_SB(0, 1), b2 + h2, rB, pb2); PGX_STAGE(PG8_SA(0, 0), a2, rA, pb2);
            PG8_WAIT_V(8); PG8_WAIT_L(0); PG8_BAR; PG8_MMA(1, 0, At, B0); PG8_MMA(1, 1, At, B1); PG8_BAR; PG8_SCHED;
            PG8_LDB(B0, 1, 0); PG8_LDB(B1, 1, 1); PG8_SCHED; PG8_LDA(At, 1, 0); PGX_STAGE(PG8_SA(0, 1), a2 + h2, rA, pb2);
            PG8_WAIT_V(8); PG8_WAIT_L(0); PG8_BAR; PG8_MMA(0, 0, At, B0); PG8_MMA(0, 1, At, B1); PG8_BAR; PG8_SCHED;
            PG8_LDA(At, 1, 1); PGX_STAGE(PG8_SB(1, 0), b3, rB, pb2); PGX_STAGE(PG8_SB(1, 1), b3 + h2, rB, pb2); PGX_STAGE(PG8_SA(1, 0), a3, rA, pb2);
            PG8_WAIT_V(8); PG8_WAIT_L(0); PG8_BAR; PG8_MMA(1, 0, At, B0); PG8_MMA(1, 1, At, B1); PG8_BAR; PG8_SCHED;
        }
        if (wr == 0) PG8_BAR;
        E(acc, cur, wr, wc, fr, fq);
        if (!has_next) break;
#pragma unroll
        for (int a = 0; a < 2; ++a)
#pragma unroll
            for (int b = 0; b < 2; ++b)
#pragma unroll
                for (int m = 0; m < 4; ++m)
#pragma unroll
                    for (int n = 0; n < 2; ++n) acc[a][b][m][n] = (f32x4){0.f, 0.f, 0.f, 0.f};
        cur = nxt; oc = on; cA = nA; cB = nB; Kc = Kn; ++ui;
        if (wr == 1) PG8_BAR;
    }
    PG8_WAIT_V(0);
    PG8_BAR;
#undef PG8_SA
#undef PG8_SB
#undef PGX_STAGE
#undef PG8_LDA
#undef PG8_LDB
#undef PG8_MMA
#undef PG8_WAIT_V
#undef PG8_WAIT_L
#undef PG8_BAR
#undef PG8_SCHED
}
}
namespace pg8 {
constexpr int TOK = 16384;
constexpr float RMS_EPS = 1e-6f;
typedef float f32x2e __attribute__((ext_vector_type(2)));
template <int NP> __device__ __forceinline__ void row_scales(const float* src, int rowbase, int lane, int fr, float (&r)[2][4]) {
#pragma unroll
    for (int ai = 0; ai < 2; ++ai) {
        const int row = rowbase + 128 * ai + lane; float v;
        if (NP == 0) v = src[row];
        else { float s = 0.f;
#pragma unroll
            for (int p = 0; p < NP; ++p) s += src[(size_t)p * TOK + row];
            v = __builtin_amdgcn_rsqf(s * (1.0f / 1024.0f) + RMS_EPS); }
#pragma unroll
        for (int m = 0; m < 4; ++m) r[ai][m] = __shfl(v, 16 * m + fr);
    }
}
template <int NP, class Sched> __device__ __forceinline__ void build_row_tab(const float* src, const Sched& S, PG8_LAS float* tab) {
    Unit u;
    for (int i = 0; S.next(i, u); ++i)
        for (int r = (int)threadIdx.x; r < 256; r += 512) { const int row = u.pm * BM + r; float v;
            if (NP == 0) v = src[row];
            else { float s = 0.f;
#pragma unroll
                for (int p = 0; p < NP; ++p) s += src[(size_t)p * TOK + row];
                v = __builtin_amdgcn_rsqf(s * (1.0f / 1024.0f) + RMS_EPS); }
            tab[i * 256 + r] = v; }
    __syncthreads();
}
__device__ __forceinline__ void row_scales_tab(const PG8_LAS float* tab, int ui, int wr, int fr, float (&r)[2][4]) {
#pragma unroll
    for (int ai = 0; ai < 2; ++ai)
#pragma unroll
        for (int m = 0; m < 4; ++m) r[ai][m] = tab[ui * 256 + ai * 128 + wr * 64 + 16 * m + fr];
}
__device__ __forceinline__ float silu_f(float x) { return x * __builtin_amdgcn_rcpf(1.0f + __expf(-x)); }
__device__ __forceinline__ float sigmoid_f(float x) { return __builtin_amdgcn_rcpf(1.0f + __expf(-x)); }

template <int NP> struct EpiSwiGLU {
    static constexpr bool PERM = true, AFTER_DRAIN = false;
    bf16_t* H; int ldh; const PG8_LAS float* tab; mutable int ui = 0;
    __device__ __forceinline__ void operator()(const f32x4 (&acc)[2][2][4][2], const Unit& u, int wr, int wc, int fr0, int fq0) const {
        int fr = fr0, fq = fq0; asm volatile("" : "+v"(fr), "+v"(fq));
        float r[2][4]; row_scales_tab(tab, ui++, wr, fr, r);
        const int col0 = u.pn * 128 + wc * 32 + 8 * fq;
#pragma unroll
        for (int ai = 0; ai < 2; ++ai)
#pragma unroll
            for (int m = 0; m < 4; ++m) {
                const int row = u.pm * BM + ai * HALF + wr * 64 + m * 16 + fr; const float rr = r[ai][m];
                float o[8]; const float k1 = -1.44269504f * rr, rr2 = rr * rr;
#pragma unroll
                for (int n = 0; n < 2; ++n)
#pragma unroll
                    for (int j = 0; j < 4; j += 2) { const f32x2 g2 = (f32x2){acc[ai][0][m][n][j], acc[ai][0][m][n][j + 1]}, u2 = (f32x2){acc[ai][1][m][n][j], acc[ai][1][m][n][j + 1]};
                        const f32x2 t2 = g2 * k1; const f32x2 d2 = (f32x2){__builtin_amdgcn_exp2f(t2[0]), __builtin_amdgcn_exp2f(t2[1])} + 1.0f;
                        const f32x2 r2 = (f32x2){__builtin_amdgcn_rcpf(d2[0]), __builtin_amdgcn_rcpf(d2[1])} * rr2; const f32x2 o2 = (g2 * u2) * r2;
                        o[4 * n + j] = o2[0]; o[4 * n + j + 1] = o2[1]; }
                u32x4 w; w.x = cvt_pk_bf16(o[0], o[1]); w.y = cvt_pk_bf16(o[2], o[3]); w.z = cvt_pk_bf16(o[4], o[5]); w.w = cvt_pk_bf16(o[6], o[7]);
                *(u32x4*)(H + (size_t)row * ldh + col0) = w;
            }
    }
};
template <bool WRITE_HB> struct EpiResid {
    static constexpr bool PERM = true, AFTER_DRAIN = false;
    const float* base; float* out; bf16_t* hb; float* part; float sc;
    __device__ __forceinline__ void operator()(const f32x4 (&acc)[2][2][4][2], const Unit& u, int wr, int wc, int fr0, int fq0) const {
        int fr = fr0, fq = fq0; asm volatile("" : "+v"(fr), "+v"(fq));
        const int col0 = u.pn * BM + wc * 32 + 8 * fq;
#pragma unroll
        for (int ai = 0; ai < 2; ++ai)
#pragma unroll
            for (int m = 0; m < 4; ++m) {
                const int row = u.pm * BM + ai * HALF + wr * 64 + m * 16 + fr; float ss = 0.f;
#pragma unroll
                for (int bj = 0; bj < 2; ++bj) {
                    const size_t off = (size_t)row * 1024 + col0 + bj * HALF;
                    const f32x4 b0 = *(const f32x4*)(base + off), b1 = *(const f32x4*)(base + off + 4);
                    const f32x4 o0 = b0 + acc[ai][bj][m][0] * sc, o1 = b1 + acc[ai][bj][m][1] * sc;
                    *(f32x4*)(out + off) = o0; *(f32x4*)(out + off + 4) = o1;
                    if (WRITE_HB) {
                        ss += (o0[0] * o0[0] + o0[1] * o0[1]) + (o0[2] * o0[2] + o0[3] * o0[3]) + (o1[0] * o1[0] + o1[1] * o1[1]) + (o1[2] * o1[2] + o1[3] * o1[3]);
                        u32x4 w; w.x = cvt_pk_bf16(o0[0], o0[1]); w.y = cvt_pk_bf16(o0[2], o0[3]); w.z = cvt_pk_bf16(o1[0], o1[1]); w.w = cvt_pk_bf16(o1[2], o1[3]);
                        *(u32x4*)(hb + off) = w; }
                }
                if (WRITE_HB) { ss += __shfl_xor(ss, 16); ss += __shfl_xor(ss, 32); if (fq == 0) part[(size_t)(u.pn * 4 + wc) * TOK + row] = ss; }
                if (m == 3) asm volatile("" ::: "memory");
            }
    }
};
template <bool WRITE_HB> struct EpiResid2 {
    static constexpr bool PERM = true, AFTER_DRAIN = false;
    const float* base; float* out; bf16_t* hb; float* part; float sc;
    __device__ __forceinline__ void operator()(const f32x4 (&acc)[2][2][4][2], const Unit& u, int wr, int wc, int fr0, int fq0) const {
        int fr = fr0, fq = fq0; asm volatile("" : "+v"(fr), "+v"(fq));
        const int row0 = u.pm * BM + wr * 64 + fr; const size_t o00 = (size_t)row0 * 1024 + u.pn * BM + wc * 32 + 8 * fq;
        const float* bp = base + o00; float* op = out + o00; bf16_t* hp = hb + o00;
        f32x4 bq[2][8];
#define ER2_ISSUE(G, B) do { _Pragma("unroll") for (int c = 0; c < 8; ++c) { const int ai = (G) >> 1, m = 2 * ((G) & 1) + (c >> 2), bj = (c >> 1) & 1, n = c & 1; \
            bq[B][c] = *(const f32x4*)(bp + (size_t)(ai * 128 + m * 16) * 1024 + bj * 128 + 4 * n); } } while (0)
        ER2_ISSUE(0, 0);
#pragma unroll
        for (int G = 0; G < 4; ++G) {
            if (G + 1 < 4) { if ((G & 1) == 0) ER2_ISSUE(G + 1, 1); else ER2_ISSUE(G + 1, 0); }
            asm volatile("" ::: "memory");
#pragma unroll
            for (int mm = 0; mm < 2; ++mm) { const int ai = G >> 1, m = 2 * (G & 1) + mm; float ss = 0.f;
#pragma unroll
                for (int bj = 0; bj < 2; ++bj) { const size_t off = (size_t)(ai * 128 + m * 16) * 1024 + bj * 128;
                    const f32x4 o0 = bq[G & 1][mm * 4 + bj * 2] + acc[ai][bj][m][0] * sc, o1 = bq[G & 1][mm * 4 + bj * 2 + 1] + acc[ai][bj][m][1] * sc;
                    *(f32x4*)(op + off) = o0; *(f32x4*)(op + off + 4) = o1;
                    if (WRITE_HB) {
                        ss += (o0[0] * o0[0] + o0[1] * o0[1]) + (o0[2] * o0[2] + o0[3] * o0[3]) + (o1[0] * o1[0] + o1[1] * o1[1]) + (o1[2] * o1[2] + o1[3] * o1[3]);
                        u32x4 w; w.x = cvt_pk_bf16(o0[0], o0[1]); w.y = cvt_pk_bf16(o0[2], o0[3]); w.z = cvt_pk_bf16(o1[0], o1[1]); w.w = cvt_pk_bf16(o1[2], o1[3]);
                        *(u32x4*)(hp + off) = w; } }
                if (WRITE_HB) { ss += __shfl_xor(ss, 16); ss += __shfl_xor(ss, 32); if (fq == 0) part[(size_t)(u.pn * 4 + wc) * TOK + row0 + ai * 128 + m * 16] = ss; } }
            asm volatile("" ::: "memory");
        }
#undef ER2_ISSUE
    }
};
__device__ __forceinline__ float bf_lo(unsigned w) { return __uint_as_float(w << 16); }
__device__ __forceinline__ float bf_hi(unsigned w) { return __uint_as_float(w & 0xffff0000u); }
template <int MODE> struct EpiResid3 {
    static constexpr bool PERM = true, AFTER_DRAIN = false;
    static constexpr int NS = 0;
    const float* basef; float* out; bf16_t* hb; float* part; float sc;
    __device__ __forceinline__ void operator()(const f32x4 (&acc)[2][2][4][2], const Unit& u, int wr, int wc, int fr0, int fq0) const {
        int fr = fr0, fq = fq0; asm volatile("" : "+v"(fr), "+v"(fq));
        const int row0 = u.pm * BM + wr * 64 + fr; const size_t o00 = (size_t)row0 * 1024 + u.pn * BM + wc * 32 + 8 * fq;
        const float* bp = basef + o00; float* op = out + o00; bf16_t* hp = hb + o00;
        f32x4 bq[2][8]; u32x4 hq[2][4];
#define ER3_ISSUE(G, B) do { if (MODE == 0) { _Pragma("unroll") for (int c = 0; c < 8; ++c) { const int ai = (G) >> 1, m = 2 * ((G) & 1) + (c >> 2), bj = (c >> 1) & 1, n = c & 1; \
                bq[B][c] = *(const f32x4*)(bp + (size_t)(ai * 128 + m * 16) * 1024 + bj * 128 + 4 * n); } } \
            else { _Pragma("unroll") for (int c = 0; c < 4; ++c) { const int ai = (G) >> 1, m = 2 * ((G) & 1) + (c >> 1), bj = c & 1; hq[B][c] = *(const u32x4*)(hp + (size_t)(ai * 128 + m * 16) * 1024 + bj * 128); } } } while (0)
        ER3_ISSUE(0, 0);
#pragma unroll
        for (int G = 0; G < 4; ++G) {
            if (G + 1 < 4) { if ((G & 1) == 0) ER3_ISSUE(G + 1, 1); else ER3_ISSUE(G + 1, 0); }
            asm volatile("" ::: "memory");
#pragma unroll
            for (int mm = 0; mm < 2; ++mm) { const int ai = G >> 1, m = 2 * (G & 1) + mm; float ss = 0.f;
#pragma unroll
                for (int bj = 0; bj < 2; ++bj) { const size_t off = (size_t)(ai * 128 + m * 16) * 1024 + bj * 128;
                    f32x4 b0, b1;
                    if (MODE == 0) { b0 = bq[G & 1][mm * 4 + bj * 2]; b1 = bq[G & 1][mm * 4 + bj * 2 + 1]; }
                    else { const u32x4 h = hq[G & 1][mm * 2 + bj]; b0 = (f32x4){bf_lo(h.x), bf_hi(h.x), bf_lo(h.y), bf_hi(h.y)}; b1 = (f32x4){bf_lo(h.z), bf_hi(h.z), bf_lo(h.w), bf_hi(h.w)}; }
                    const f32x4 o0 = b0 + acc[ai][bj][m][0] * sc, o1 = b1 + acc[ai][bj][m][1] * sc;
                    if (MODE == 2) { *(f32x4*)(op + off) = o0; *(f32x4*)(op + off + 4) = o1; }
                    else {
                        ss += (o0[0] * o0[0] + o0[1] * o0[1]) + (o0[2] * o0[2] + o0[3] * o0[3]) + (o1[0] * o1[0] + o1[1] * o1[1]) + (o1[2] * o1[2] + o1[3] * o1[3]);
                        u32x4 w; w.x = cvt_pk_bf16(o0[0], o0[1]); w.y = cvt_pk_bf16(o0[2], o0[3]); w.z = cvt_pk_bf16(o1[0], o1[1]); w.w = cvt_pk_bf16(o1[2], o1[3]);
                        *(u32x4*)(hp + off) = w; } }
                if (MODE != 2) { ss += __shfl_xor(ss, 16); ss += __shfl_xor(ss, 32); if (fq == 0) part[(size_t)(u.pn * 4 + wc) * TOK + row0 + ai * 128 + m * 16] = ss; } }
            asm volatile("" ::: "memory");
        }
#undef ER3_ISSUE
    }
};
struct EpiMemKV {
    static constexpr bool PERM = true, AFTER_DRAIN = false;
    float* KV; const float* rs;
    __device__ __forceinline__ void operator()(const f32x4 (&acc)[2][2][4][2], const Unit& u, int wr, int wc, int fr0, int fq0) const {
        int fr = fr0, fq = fq0; asm volatile("" : "+v"(fr), "+v"(fq));
        float r[2][4]; row_scales<0>(rs, u.pm * BM + wr * 64, (int)(threadIdx.x & 63), fr, r);
        const int col0 = u.pn * BM + wc * 32 + 8 * fq;
#pragma unroll
        for (int ai = 0; ai < 2; ++ai)
#pragma unroll
            for (int m = 0; m < 4; ++m) { const int row = u.pm * BM + ai * HALF + wr * 64 + m * 16 + fr;
#pragma unroll
                for (int bj = 0; bj < 2; ++bj) { const size_t off = (size_t)row * 1024 + col0 + bj * HALF;
                    *(f32x4*)(KV + off) = acc[ai][bj][m][0] * r[ai][m]; *(f32x4*)(KV + off + 4) = acc[ai][bj][m][1] * r[ai][m]; } }
    }
};
template <int NP> struct EpiGate {
    static constexpr bool PERM = true, AFTER_DRAIN = false;
    bf16_t* scr; const PG8_LAS float* tab; mutable int ui = 0;
    __device__ __forceinline__ void operator()(const f32x4 (&acc)[2][2][4][2], const Unit& u, int wr, int wc, int fr0, int fq0) const {
        int fr = fr0, fq = fq0; asm volatile("" : "+v"(fr), "+v"(fq));
        float r[2][4];
#ifdef DBG_GATE_NOSCALE
        for (int a_ = 0; a_ < 2; ++a_) for (int m_ = 0; m_ < 4; ++m_) r[a_][m_] = 1.0f;
#else
        row_scales_tab(tab, ui++, wr, fr, r);
#endif
        bf16_t* t = scr + (size_t)(u.pm * 4 + u.pn) * 65536;
#pragma unroll
        for (int ai = 0; ai < 2; ++ai)
#pragma unroll
            for (int m = 0; m < 4; ++m) { const int lr = ai * HALF + wr * 64 + m * 16 + fr; const float rr = r[ai][m];
#pragma unroll
                for (int bj = 0; bj < 2; ++bj) { float o[8];
#pragma unroll
                    for (int n = 0; n < 2; ++n)
#pragma unroll
                        for (int j = 0; j < 4; ++j) o[4 * n + j] = sigmoid_f(acc[ai][bj][m][n][j] * rr);
                    u32x4 w; w.x = cvt_pk_bf16(o[0], o[1]); w.y = cvt_pk_bf16(o[2], o[3]); w.z = cvt_pk_bf16(o[4], o[5]); w.w = cvt_pk_bf16(o[6], o[7]);
                    *(u32x4*)(t + lr * 256 + bj * HALF + wc * 32 + 8 * fq) = w; } }
    }
};
struct EpiBranch {
    static constexpr bool PERM = true, AFTER_DRAIN = false;
    const bf16_t* scr; bf16_t* mg; bool first; float bscale;
    __device__ __forceinline__ void operator()(const f32x4 (&acc)[2][2][4][2], const Unit& u, int wr, int wc, int fr0, int fq0) const {
        int fr = fr0, fq = fq0; asm volatile("" : "+v"(fr), "+v"(fq));
        const bf16_t* t = scr + (size_t)(u.pm * 4 + u.pn) * 65536;
        __builtin_amdgcn_fence(__ATOMIC_ACQUIRE, "agent");
        asm volatile("s_waitcnt vmcnt(0)" ::: "memory");
#pragma unroll
        for (int ai = 0; ai < 2; ++ai)
#pragma unroll
            for (int m = 0; m < 4; ++m) { const int lr = ai * HALF + wr * 64 + m * 16 + fr; const int row = u.pm * BM + lr;
#pragma unroll
                for (int bj = 0; bj < 2; ++bj) { const int lc = bj * HALF + wc * 32 + 8 * fq;
#if defined(DBG_NOGATE) && DBG_NOGATE
                    const u32x4 g = (u32x4){0x3f803f80u, 0x3f803f80u, 0x3f803f80u, 0x3f803f80u};
#else
                    const u32x4 g = *(const u32x4*)(t + lr * 256 + lc);
#endif
                    bf16_t* mp = mg + (size_t)row * 1024 + u.pn * BM + lc;
                    float o[8];
                    o[0] = bf_lo(g.x) * acc[ai][bj][m][0][0]; o[1] = bf_hi(g.x) * acc[ai][bj][m][0][1]; o[2] = bf_lo(g.y) * acc[ai][bj][m][0][2]; o[3] = bf_hi(g.y) * acc[ai][bj][m][0][3];
                    o[4] = bf_lo(g.z) * acc[ai][bj][m][1][0]; o[5] = bf_hi(g.z) * acc[ai][bj][m][1][1]; o[6] = bf_lo(g.w) * acc[ai][bj][m][1][2]; o[7] = bf_hi(g.w) * acc[ai][bj][m][1][3];
#ifdef DBG_BRANCH_SIGMOID
#pragma unroll
                    for (int e = 0; e < 8; ++e) o[e] = DBG_NONLIN(o[e]);
#endif
#pragma unroll
                    for (int e = 0; e < 8; ++e) o[e] *= bscale;
                    if (!first) { const u32x4 p = *(const u32x4*)mp;
                        o[0] += bf_lo(p.x); o[1] += bf_hi(p.x); o[2] += bf_lo(p.y); o[3] += bf_hi(p.y); o[4] += bf_lo(p.z); o[5] += bf_hi(p.z); o[6] += bf_lo(p.w); o[7] += bf_hi(p.w); }
                    u32x4 w; w.x = cvt_pk_bf16(o[0], o[1]); w.y = cvt_pk_bf16(o[2], o[3]); w.z = cvt_pk_bf16(o[4], o[5]); w.w = cvt_pk_bf16(o[6], o[7]);
                    *(u32x4*)mp = w; }
                if (m & 1) asm volatile("" ::: "memory"); }
    }
};
template <bool FIRST> struct EpiBranch2 {
    const bf16_t* scr; bf16_t* mg;
    __device__ __forceinline__ void operator()(const f32x4 (&acc)[2][2][4][2], const Unit& u, int wr, int wc, int fr0, int fq0) const {
        int fr = fr0, fq = fq0; asm volatile("" : "+v"(fr), "+v"(fq));
        const bf16_t* t = scr + (size_t)(u.pm * 4 + u.pn) * 65536 + (wr * 64 + fr) * 256 + wc * 32 + 8 * fq;
        bf16_t* mp0 = mg + (size_t)(u.pm * BM + wr * 64 + fr) * 1024 + u.pn * BM + wc * 32 + 8 * fq;
        u32x4 gq[2][4], pq[2][4];
#define EB2_ISSUE(G, B) do { _Pragma("unroll") for (int c = 0; c < 4; ++c) { const int ai = (G) >> 1, m = 2 * ((G) & 1) + (c >> 1), bj = c & 1; \
            gq[B][c] = *(const u32x4*)(t + (ai * 128 + m * 16) * 256 + bj * 128); if (!FIRST) pq[B][c] = *(const u32x4*)(mp0 + (size_t)(ai * 128 + m * 16) * 1024 + bj * 128); } } while (0)
        EB2_ISSUE(0, 0);
#pragma unroll
        for (int G = 0; G < 4; ++G) {
            if (G + 1 < 4) { if ((G & 1) == 0) EB2_ISSUE(G + 1, 1); else EB2_ISSUE(G + 1, 0); }
            asm volatile("" ::: "memory");
#pragma unroll
            for (int c = 0; c < 4; ++c) { const int ai = G >> 1, m = 2 * (G & 1) + (c >> 1), bj = c & 1; const u32x4 g = gq[G & 1][c];
                float o[8];
                o[0] = bf_lo(g.x) * acc[ai][bj][m][0][0]; o[1] = bf_hi(g.x) * acc[ai][bj][m][0][1]; o[2] = bf_lo(g.y) * acc[ai][bj][m][0][2]; o[3] = bf_hi(g.y) * acc[ai][bj][m][0][3];
                o[4] = bf_lo(g.z) * acc[ai][bj][m][1][0]; o[5] = bf_hi(g.z) * acc[ai][bj][m][1][1]; o[6] = bf_lo(g.w) * acc[ai][bj][m][1][2]; o[7] = bf_hi(g.w) * acc[ai][bj][m][1][3];
                if (!FIRST) { const u32x4 p = pq[G & 1][c];
                    o[0] += bf_lo(p.x); o[1] += bf_hi(p.x); o[2] += bf_lo(p.y); o[3] += bf_hi(p.y); o[4] += bf_lo(p.z); o[5] += bf_hi(p.z); o[6] += bf_lo(p.w); o[7] += bf_hi(p.w); }
                u32x4 w; w.x = cvt_pk_bf16(o[0], o[1]); w.y = cvt_pk_bf16(o[2], o[3]); w.z = cvt_pk_bf16(o[4], o[5]); w.w = cvt_pk_bf16(o[6], o[7]);
                *(u32x4*)(mp0 + (size_t)(ai * 128 + m * 16) * 1024 + bj * 128) = w; }
            asm volatile("" ::: "memory");
        }
#undef EB2_ISSUE
    }
};
template <size_t O_HB, size_t O_WG, size_t O_A0, size_t O_A1, size_t O_A2, size_t O_WB> struct P7Order {
    StaticOrder T; const char* ws;
    __device__ __forceinline__ bool next(int i, UnitX& u) const { const int rd = i / 6; Unit t; if (!T.next(rd, t)) return false; u.pm = t.pm; u.pn = t.pn; u.kind = i - 6 * rd; u.round = rd; return true; }
    __device__ __forceinline__ OpsX ops(const UnitX& u) const { const int j = u.kind >> 1; OpsX o;
        if (u.kind & 1) { o.K = 512; o.A = ws + (j == 0 ? O_A0 : j == 1 ? O_A1 : O_A2) + (size_t)u.pm * (256 * 512 * 2); o.Bt = ws + O_WB + (size_t)j * (1024 * 512 * 2) + (size_t)u.pn * (256 * 512 * 2); }
        else { o.K = 1024; o.A = ws + O_HB + (size_t)u.pm * (256 * 1024 * 2); o.Bt = ws + O_WG + (size_t)j * (1024 * 1024 * 2) + (size_t)u.pn * (256 * 1024 * 2); }
        return o; }
};
struct EpiP7 {
    bf16_t* scr; bf16_t* mg; const PG8_LAS float* tab;
    __device__ __forceinline__ void operator()(const f32x4 (&acc)[2][2][4][2], const UnitX& u, int wr, int wc, int fr, int fq) const {
        const Unit uu{u.pm, u.pn};
        if (u.kind == 1) { const EpiBranch2<true> b{scr, mg}; b(acc, uu, wr, wc, fr, fq); }
        else if (u.kind & 1) { const EpiBranch2<false> b{scr, mg}; b(acc, uu, wr, wc, fr, fq); }
        else { const EpiGate<16> g{scr, tab, u.round}; g(acc, uu, wr, wc, fr, fq); }
    }
};
struct ProjOut { bf16_t *FQ, *FK, *FV, *DQ, *IQ, *MQ, *DK, *DV, *IK; float *LOGF, *IW; const float *cosT, *sinT, *g_fq, *g_fk, *g_dq, *g_dk, *b_forget; };
__device__ __forceinline__ float log_sigmoid_f(float z) { return z >= 0.f ? -log1pf(expf(-z)) : z - log1pf(expf(z)); }
template <int NP> struct EpiProj {
    static constexpr bool PERM = true, AFTER_DRAIN = false;
    ProjOut P; const PG8_LAS float* tab; float qscale; mutable int ui = 0;
    __device__ __forceinline__ void operator()(const f32x4 (&acc)[2][2][4][2], const Unit& u, int wr, int wc, int fr0, int fq0) const {
        int fr = fr0, fq = fq0; asm volatile("" : "+v"(fr), "+v"(fq));
        float r[2][4]; row_scales_tab(tab, ui++, wr, fr, r);
        const int pn = u.pn;
        bool do_norm = false, do_rope = false; const float* gain = nullptr; bf16_t* dst = nullptr; int pitch = 512, hoff = 0; float osc = 1.f;
        if (pn < 2)       { do_norm = true; gain = P.g_fq; dst = P.FQ; hoff = (4 * pn + wc) * 64; osc = qscale; }
        else if (pn < 4)  { do_norm = true; gain = P.g_fk; dst = P.FK; hoff = (4 * (pn - 2) + wc) * 64; }
        else if (pn < 6)  { dst = P.FV; hoff = (4 * (pn - 4) + wc) * 64; }
        else if (pn < 8)  { do_norm = true; do_rope = true; gain = P.g_dq; dst = P.DQ; hoff = (4 * (pn - 6) + wc) * 64; osc = qscale; }
        else if (pn < 10) { do_rope = true; dst = P.IQ; hoff = (4 * (pn - 8) + wc) * 64; }
        else if (pn < 12) { dst = P.MQ; hoff = (2 * (pn - 10) + (wc >> 1)) * 128 + (wc & 1) * 64; }
        else { pitch = 64;
            if (wc == 0)      { do_norm = true; do_rope = true; gain = P.g_dk; dst = P.DK; }
            else if (wc == 1) { dst = P.DV; }
            else if (wc == 2) { do_rope = true; dst = P.IK; }
            else dst = nullptr; }
        if (dst == nullptr) {
            if (fq < 2) {
#pragma unroll
                for (int ai = 0; ai < 2; ++ai)
#pragma unroll
                    for (int m = 0; m < 4; ++m) { const int row = u.pm * BM + ai * HALF + wr * 64 + m * 16 + fr; const float rr = r[ai][m];
                        f32x4 v0 = acc[ai][0][m][0] * rr, v1 = acc[ai][0][m][1] * rr;
                        if (fq == 0) {
                            const f32x4 b0 = *(const f32x4*)(P.b_forget), b1 = *(const f32x4*)(P.b_forget + 4);
#pragma unroll
                            for (int j = 0; j < 4; ++j) { v0[j] = log_sigmoid_f(v0[j] + b0[j]); v1[j] = log_sigmoid_f(v1[j] + b1[j]); }
                            *(f32x4*)(P.LOGF + (size_t)row * 8) = v0; *(f32x4*)(P.LOGF + (size_t)row * 8 + 4) = v1;
                        } else { const float c = 0.04419417382f; *(f32x4*)(P.IW + (size_t)row * 8) = v0 * c; *(f32x4*)(P.IW + (size_t)row * 8 + 4) = v1 * c; } }
            }
            return;
        }
        const bool ikl = (pn == 12 && wc == 2);
        if (do_norm) { if (do_rope) body<true, true, false>(acc, u, r, gain, dst, pitch, hoff, osc, wr, fr, fq); else body<true, false, false>(acc, u, r, gain, dst, pitch, hoff, osc, wr, fr, fq); }
        else if (do_rope) { if (ikl) body<false, true, true>(acc, u, r, gain, dst, pitch, hoff, osc, wr, fr, fq); else body<false, true, false>(acc, u, r, gain, dst, pitch, hoff, osc, wr, fr, fq); }
        else body<false, false, false>(acc, u, r, gain, dst, pitch, hoff, osc, wr, fr, fq);
    }
    template <bool NORM, bool ROPE, bool IKL>
    __device__ __forceinline__ void body(const f32x4 (&acc)[2][2][4][2], const Unit& u, const float (&r)[2][4], const float* gain, bf16_t* dst, int pitch, int hoff, float osc, int wr, int fr, int fq) const {
        f32x4 gv[2][2];
        if (NORM) {
#pragma unroll
            for (int bj = 0; bj < 2; ++bj)
#pragma unroll
                for (int n = 0; n < 2; ++n) gv[bj][n] = *(const f32x4*)(gain + bj * 32 + 8 * fq + 4 * n);
        }
        f32x4 cq[2][4];
        const int rowb = u.pm * BM + wr * 64 + fr;
#define EP_ISSUE(I, B) do { const size_t ro_ = (size_t)(rowb + ((I) >> 2) * HALF + ((I) & 3) * 16) * 32 + 8 * fq; \
            cq[B][0] = *(const f32x4*)(P.cosT + ro_); cq[B][1] = *(const f32x4*)(P.cosT + ro_ + 4); cq[B][2] = *(const f32x4*)(P.sinT + ro_); cq[B][3] = *(const f32x4*)(P.sinT + ro_ + 4); } while (0)
        if (ROPE) EP_ISSUE(0, 0);
#pragma unroll
        for (int ai = 0; ai < 2; ++ai)
#pragma unroll
            for (int m = 0; m < 4; ++m) {
                const int row = u.pm * BM + ai * HALF + wr * 64 + m * 16 + fr; const float rr = r[ai][m];
                if (ROPE) { if (4 * ai + m + 1 < 8) { if (((4 * ai + m) & 1) == 0) EP_ISSUE(4 * ai + m + 1, 1); else EP_ISSUE(4 * ai + m + 1, 0); } asm volatile("" ::: "memory"); }
                f32x4 v[2][2];
#pragma unroll
                for (int bj = 0; bj < 2; ++bj)
#pragma unroll
                    for (int n = 0; n < 2; ++n) v[bj][n] = acc[ai][bj][m][n] * rr;
                if (NORM) {
                    float ss = 0.f;
#pragma unroll
                    for (int bj = 0; bj < 2; ++bj)
#pragma unroll
                        for (int n = 0; n < 2; ++n) ss += (v[bj][n][0] * v[bj][n][0] + v[bj][n][1] * v[bj][n][1]) + (v[bj][n][2] * v[bj][n][2] + v[bj][n][3] * v[bj][n][3]);
                    ss += __shfl_xor(ss, 16); ss += __shfl_xor(ss, 32);
                    const float inv = __builtin_amdgcn_rsqf(ss * (1.0f / 64.0f) + RMS_EPS);
#pragma unroll
                    for (int bj = 0; bj < 2; ++bj)
#pragma unroll
                        for (int n = 0; n < 2; ++n) v[bj][n] = v[bj][n] * inv * gv[bj][n];
                }
                if (ROPE) {
#pragma unroll
                    for (int n = 0; n < 2; ++n) {
                        const f32x4 c = cq[(4 * ai + m) & 1][n], s = cq[(4 * ai + m) & 1][2 + n];
                        const f32x4 x1 = v[0][n], x2 = v[1][n];
                        v[0][n] = x1 * c - x2 * s; v[1][n] = x2 * c + x1 * s; }
                }
#pragma unroll
                for (int bj = 0; bj < 2; ++bj) {
                    const f32x4 a = v[bj][0] * osc, b = v[bj][1] * osc;
                    u32x4 w; w.x = cvt_pk_bf16(a[0], a[1]); w.y = cvt_pk_bf16(a[2], a[3]); w.z = cvt_pk_bf16(b[0], b[1]); w.w = cvt_pk_bf16(b[2], b[3]);
                    if (IKL) {
                        const int d = bj * 32 + 8 * fq; *(u32x4*)(dst + (size_t)(row >> 5) * 2048 + (d >> 4) * 512 + ((d >> 3) & 1) * 256 + (row & 31) * 8) = w;
                    } else *(u32x4*)(dst + (size_t)row * pitch + hoff + bj * 32 + 8 * fq) = w; }
                if (ROPE) asm volatile("" ::: "memory");
            }
#undef EP_ISSUE
    }
};
}
#define GAS __attribute__((address_space(1)))
#define LAS __attribute__((address_space(3)))
typedef unsigned short bf16;
typedef unsigned v4u __attribute__((ext_vector_type(4)));
typedef float f32x4 __attribute__((ext_vector_type(4)));
typedef short bf16x8 __attribute__((ext_vector_type(8)));
typedef GAS unsigned gu32;
typedef GAS unsigned long long gu64;
#define RLX_AGENT __ATOMIC_RELAXED, __HIP_MEMORY_SCOPE_AGENT
#define LDS_WAIT() asm volatile("s_waitcnt lgkmcnt(0)" ::: "memory")
#define VM_WAIT() asm volatile("s_waitcnt vmcnt(0)" ::: "memory")
__device__ __forceinline__ unsigned long long rt() { return __builtin_amdgcn_s_memrealtime(); }
__device__ __forceinline__ unsigned f2bf(float f) { unsigned u = __builtin_bit_cast(unsigned, f); return (u + 0x7fffu + ((u >> 16) & 1u)) >> 16; }
__device__ __forceinline__ unsigned pk2(float lo, float hi) { return f2bf(lo) | (f2bf(hi) << 16); }
typedef float f32x2g __attribute__((ext_vector_type(2)));
__device__ __forceinline__ float bf_lo32(unsigned w) { return __uint_as_float(w << 16); }
__device__ __forceinline__ float bf_hi32(unsigned w) { return __uint_as_float(w & 0xffff0000u); }
constexpr int NWAVES = 8;
constexpr int BATCH = 2, SEQ = 8192, DM = 1024, T = BATCH * SEQ, DFF = 2816, MEMLEN = 256, BW = 512, DIN = 6352;
constexpr int NPROJ = 13 * 256, NGATE = 3072;
constexpr float L2E = 1.4426950408889634f;
constexpr float C2_64 = 0.125f * L2E;
constexpr float C2_128 = 0.08838834764831845f * L2E;
constexpr size_t MiB = 1u << 20;
constexpr size_t WS_CTL = 0, CTL_ZERO_BYTES = 128 * 1024;
constexpr size_t WS_RSTDX = 1 * MiB;
constexpr size_t WS_RSTDM = WS_RSTDX + 64 * 1024;
constexpr size_t WS_T0 = WS_RSTDM + 4096;
constexpr size_t WS_SSQ1 = 2 * MiB;
constexpr size_t WS_SSQ2 = 3 * MiB;
constexpr size_t WS_LOGF = 4 * MiB;
constexpr size_t WS_CUM = WS_LOGF + 512 * 1024;
constexpr size_t WS_IW = 5 * MiB;
constexpr size_t WS_COS = 6 * MiB, WS_SIN = 8 * MiB;
constexpr size_t WS_MEMB = 10 * MiB;
constexpr size_t WS_KVM = 11 * MiB;
constexpr size_t WS_KMB = 13 * MiB, WS_VMB = 14 * MiB;
constexpr size_t WS_WGU1 = 16 * MiB;
constexpr size_t WS_WD1 = 27 * MiB;
constexpr size_t WS_WIN = 33 * MiB;
constexpr size_t WS_WGATE = 40 * MiB;
constexpr size_t WS_WBR = 46 * MiB;
constexpr size_t WS_WOUT = 49 * MiB;
constexpr size_t WS_WGU2 = 51 * MiB;
constexpr size_t WS_WD2 = 62 * MiB;
constexpr size_t WS_WMKV = 68 * MiB;
constexpr size_t WS_HB = 70 * MiB;
constexpr size_t WS_ACT = 102 * MiB;
constexpr size_t WS_HID = WS_ACT;
constexpr size_t WS_FQ = WS_ACT, WS_FK = WS_ACT + 16 * MiB, WS_FV = WS_ACT + 32 * MiB, WS_DQ = WS_ACT + 48 * MiB, WS_IQ = WS_ACT + 64 * MiB, WS_MQ = WS_ACT + 80 * MiB;
constexpr size_t WS_DK = WS_ACT + 96 * MiB, WS_DV = WS_ACT + 98 * MiB, WS_IK = WS_ACT + 100 * MiB;
#if defined(DBG_SUBST) && DBG_SUBST == 2
constexpr size_t WS_MERGED = WS_DQ;
#else
constexpr size_t WS_MERGED = WS_FK;
#endif
#ifdef DBG_GSCR_AT
constexpr size_t WS_GSCR = DBG_GSCR_AT;
#else
constexpr size_t WS_GSCR = 204 * MiB;
#endif
constexpr size_t WS_OA = 236 * MiB;
constexpr size_t WS_OB = 16 * MiB;
constexpr size_t WS_END = 252 * MiB;
#ifndef DBG_GSCR_AT
static_assert(WS_HID + (size_t)T * DFF * 2 <= WS_GSCR && WS_IK + (size_t)T * 64 * 2 <= WS_GSCR, "d_ws map");
#endif
constexpr int CW_BAR = 4096;
constexpr int CW_Q = 16384;
constexpr int RING_OFF = 0, RING_BYTES = 131072;
constexpr int LDSCTL_OFF = RING_BYTES, MISC_OFF = LDSCTL_OFF + 320;
constexpr int LIST_OFF = RING_BYTES + 1024;
constexpr int SCANX_OFF = RING_BYTES + 6144;
constexpr int LDS_BYTES = 163840;
#define XB_TMO      128
#define XB_XCNT(j)  (256  + 64 * (j))
#define XB_XSUB(j)  (1280 + 64 * (j))
#define XB_XGEN(j)  (2304 + 64 * (j))
#define XB_TOP      3328
#define XB_TOPGEN   3392
#define XCD_BAR_WORDS 3456
#define XB_SPIN_CAP (1u << 18)

__device__ __forceinline__ unsigned xb_ld(unsigned* p)              { return __hip_atomic_load(p, __ATOMIC_RELAXED, __HIP_MEMORY_SCOPE_AGENT); }
__device__ __forceinline__ unsigned xb_add(unsigned* p, unsigned v) { return __hip_atomic_fetch_add(p, v, __ATOMIC_RELAXED, __HIP_MEMORY_SCOPE_AGENT); }
__device__ __forceinline__ unsigned xb_xcc_id() { return (unsigned)__builtin_amdgcn_s_getreg((3 << 11) | 20) & 0xFu; }
#define XB_SPIN(cond, bar) do { unsigned _sp = 0; while (cond) { __builtin_amdgcn_s_sleep(1); \
    if ((++_sp & 255u) == 0u) { if (xb_ld(&(bar)[XB_TMO])) break; if (_sp > XB_SPIN_CAP) { atomicAdd(&(bar)[XB_TMO], 1u); break; } } } } while (0)

struct XcdBarrier {
    unsigned* bar; unsigned x;
    volatile LAS unsigned* st;
};

__device__ __forceinline__ XcdBarrier xcd_barrier_post(unsigned* bar, volatile LAS unsigned* st) {
    XcdBarrier b; b.bar = bar; b.x = xb_xcc_id(); b.st = st;
    if (threadIdx.x == 0) (void)xb_add(&bar[XB_XCNT(b.x)], 1u);
    return b;
}
__device__ __forceinline__ void xcd_barrier_complete(unsigned* bar, unsigned x, unsigned& nloc, unsigned& nx) {
    const unsigned G = gridDim.x * gridDim.y * gridDim.z;
    unsigned sum, cnt, mine, sp = 0u;
    for (;;) {
        sum = 0u; cnt = 0u; mine = 0u;
#pragma unroll
        for (unsigned j = 0; j < 16; ++j) { const unsigned c = xb_ld(&bar[XB_XCNT(j)]); sum += c; cnt += (c > 0u) ? 1u : 0u; mine = (j == x) ? c : mine; }
        if (sum == G) break;
        __builtin_amdgcn_s_sleep(1);
        if ((++sp & 255u) == 0u) { if (xb_ld(&bar[XB_TMO])) break; if (sp > XB_SPIN_CAP) { atomicAdd(&bar[XB_TMO], 1u); break; } }
    }
    nloc = mine > 0u ? mine : 1u; nx = cnt > 0u ? cnt : 1u;
}

__device__ __forceinline__ void xcd_barrier(const XcdBarrier& b) {
    asm volatile("s_waitcnt vmcnt(0)" ::: "memory");
    __syncthreads();
    if (threadIdx.x == 0) {
        unsigned* bar = b.bar;
        __builtin_amdgcn_s_waitcnt(0);
        unsigned nloc = b.st[0], nx = b.st[1];
        if (nloc == 0u) { xcd_barrier_complete(bar, b.x, nloc, nx); b.st[0] = nloc; b.st[1] = nx; }
        const unsigned old = xb_add(&bar[XB_XSUB(b.x)], 1u);
        const unsigned gen = old / nloc;
        if (old + 1u == (gen + 1u) * nloc) {
            __builtin_amdgcn_fence(__ATOMIC_RELEASE, "agent");
            asm volatile("s_waitcnt vmcnt(0)" ::: "memory");
            const unsigned og = xb_add(&bar[XB_TOP], 1u);
            const unsigned tg = og / nx;
            if (og + 1u == (tg + 1u) * nx) xb_add(&bar[XB_TOPGEN], 1u);
            else XB_SPIN(xb_ld(&bar[XB_TOPGEN]) == tg, bar);
            __builtin_amdgcn_fence(__ATOMIC_ACQUIRE, "agent");
            xb_add(&bar[XB_XGEN(b.x)], 1u);
            asm volatile("s_waitcnt vmcnt(0)" ::: "memory");
        } else {
            XB_SPIN(xb_ld(&bar[XB_XGEN(b.x)]) == gen, bar);
            __builtin_amdgcn_fence(__ATOMIC_ACQUIRE, "agent");
            asm volatile("s_waitcnt vmcnt(0)" ::: "memory");
        }
    }
    __syncthreads();
}
__device__ __forceinline__ float wave_sum(float v) {
#pragma unroll
    for (int o = 1; o < 64; o <<= 1) v += __shfl_xor(v, o);
    return v;
}
__device__ __forceinline__ float wave_max(float v) {
#pragma unroll
    for (int o = 1; o < 64; o <<= 1) v = fmaxf(v, __shfl_xor(v, o));
    return v;
}
__device__ __forceinline__ int colmap(int mat, int n) {
    if (mat == 1) return n;
    if (mat == 3) return 3280 + n;
    const int tile = n >> 8, t = n & 255;
    if (mat == 0) return (t < 128 ? 0 : DFF) + 128 * tile + (t & 127);
    const int bj = t >> 7, wc = (t >> 5) & 3, i = t & 31, d = bj * 32 + i;
    if (tile < 2) return 0 + (4 * tile + wc) * 64 + d;
    if (tile < 4) return 512 + (4 * (tile - 2) + wc) * 64 + d;
    if (tile < 6) return 1024 + (4 * (tile - 4) + wc) * 64 + d;
    if (tile < 8) return 1544 + (4 * (tile - 6) + wc) * 64 + d;
    if (tile < 10) return 2184 + (4 * (tile - 8) + wc) * 64 + d;
    if (tile < 12) return 2768 + (2 * (tile - 10) + (wc >> 1)) * 128 + (wc & 1) * 64 + d;
    if (wc == 0) return 2056 + d;
    if (wc == 1) return 2120 + d;
    if (wc == 2) return 2696 + d;
    if (bj == 0 && i < 8) return 1536 + i;
    if (bj == 0 && i < 16) return 2760 + (i - 8);
    return -1;
}
template <bool GAIN> __device__ __forceinline__ void transpose_item(int mat, const float* Wa, const float* Wb, int K, int Nsrc, const float* gain, bf16* WT, LAS float* scr, int item, int nblk, int lane) {
    const int kb = item / nblk, nb = item % nblk, k0 = 64 * kb, n0 = 32 * nb;
    int col = colmap(mat, n0 + (lane & 31)); const float* W = Wa;
    if (mat == 0 && col >= DFF) { W = Wb; col -= DFF; }
    const bool okc = col >= 0; const float* wp = W + (size_t)(k0 + (lane >> 5)) * Nsrc + (okc ? col : 0); const float* gp = gain + k0 + (lane >> 5);
    float v[32];
#pragma unroll
    for (int i = 0; i < 32; ++i) v[i] = wp[(size_t)(2 * i) * Nsrc];
    if (GAIN) {
#pragma unroll
        for (int i = 0; i < 32; ++i) v[i] *= gp[2 * i]; }
#pragma unroll
    for (int i = 0; i < 32; ++i) scr[(2 * i + (lane >> 5)) * 33 + (lane & 31)] = okc ? v[i] : 0.f;
    LDS_WAIT(); asm volatile("" ::: "memory");
    const int c = lane & 7;
#pragma unroll
    for (int j = 0; j < 4; ++j) { const int n = (lane >> 3) + 8 * j; const LAS float* s = scr + (8 * c) * 33 + n;
        v4u o; o.x = pk2(s[0 * 33], s[1 * 33]); o.y = pk2(s[2 * 33], s[3 * 33]); o.z = pk2(s[4 * 33], s[5 * 33]); o.w = pk2(s[6 * 33], s[7 * 33]);
        *(GAS v4u*)(WT + (size_t)(n0 + n) * K + k0 + 8 * c) = o; }
    LDS_WAIT(); asm volatile("" ::: "memory");
}
__device__ __forceinline__ void row_to_bf16_rstd(const float* xrow, bf16* orow, float* rstd_out, int lane) {
    const GAS f32x4* xr = (const GAS f32x4*)xrow + lane;
    f32x4 v[4]; float s = 0.f;
#pragma unroll
    for (int j = 0; j < 4; ++j) { v[j] = xr[64 * j]; s += (v[j].x * v[j].x + v[j].y * v[j].y) + (v[j].z * v[j].z + v[j].w * v[j].w); }
    const float rstd = 1.0f / sqrtf(wave_sum(s) * (1.f / 1024.f) + 1e-6f);
    GAS unsigned long long* o8 = (GAS unsigned long long*)orow + lane;
#pragma unroll
    for (int j = 0; j < 4; ++j) o8[64 * j] = (unsigned long long)pk2(v[j].x, v[j].y) | ((unsigned long long)pk2(v[j].z, v[j].w) << 32);
    if (lane == 0) *rstd_out = rstd;
}
__device__ __forceinline__ void rows4_to_bf16_rstd(const float* const (&xrow)[4], bf16* const (&orow)[4], float* const (&rout)[4], const bool (&ok)[4], int lane) {
    f32x4 v[4][4];
#pragma unroll
    for (int r = 0; r < 4; ++r) { const GAS f32x4* xr = (const GAS f32x4*)xrow[r] + lane;
#pragma unroll
        for (int j = 0; j < 4; ++j) v[r][j] = xr[64 * j]; }
#pragma unroll
    for (int r = 0; r < 4; ++r) { float s = 0.f;
#pragma unroll
        for (int j = 0; j < 4; ++j) s += (v[r][j].x * v[r][j].x + v[r][j].y * v[r][j].y) + (v[r][j].z * v[r][j].z + v[r][j].w * v[r][j].w);
        const float rstd = 1.0f / sqrtf(wave_sum(s) * (1.f / 1024.f) + 1e-6f);
        if (ok[r]) { GAS unsigned long long* o8 = (GAS unsigned long long*)orow[r] + lane;
#pragma unroll
            for (int j = 0; j < 4; ++j) o8[64 * j] = (unsigned long long)pk2(v[r][j].x, v[r][j].y) | ((unsigned long long)pk2(v[r][j].z, v[r][j].w) << 32);
            if (lane == 0) *rout[r] = rstd; } }
}
typedef float f32x16 __attribute__((ext_vector_type(16)));
typedef unsigned u32x2 __attribute__((ext_vector_type(2)));
__device__ __forceinline__ int crow(int r, int hi) { return (r & 3) + 8 * (r >> 2) + 4 * hi; }
__device__ __forceinline__ float bf2f(bf16 v) { return __uint_as_float((unsigned)v << 16); }
__device__ __forceinline__ unsigned cvtpk(float lo, float hi) { return pg8::cvt_pk_bf16(lo, hi); }
template <int HD, bool FOX, bool VT>
__device__ __forceinline__ void attn_wave_simple(const bf16x8 (&qr)[HD / 16], const bf16* Kp, int kpitch, const bf16* Vp, int vpitch, int tstart, int ntiles, int qlocal, const float* cb, bf16* Op, int opitch, int lane) {
    const int r32 = lane & 31, hi = lane >> 5;
    f32x16 o[HD / 32];
#pragma unroll
    for (int d0 = 0; d0 < HD / 32; ++d0)
#pragma unroll
        for (int r = 0; r < 16; ++r) o[d0][r] = 0.f;
    float m = -1e30f, l = 0.f;
    for (int t = tstart; t < ntiles; ++t) {
        const int kv0 = 32 * t;
        f32x16 p;
#pragma unroll
        for (int r = 0; r < 16; ++r) p[r] = 0.f;
        const bf16* kr = Kp + (size_t)(kv0 + r32) * kpitch + hi * 8;
#pragma unroll
        for (int ks = 0; ks < HD / 16; ++ks) { const bf16x8 kf = *(const bf16x8*)(kr + ks * 16); p = __builtin_amdgcn_mfma_f32_32x32x16_bf16(kf, qr[ks], p, 0, 0, 0); }
        if (FOX) {
#pragma unroll
            for (int g = 0; g < 4; ++g) { const f32x4 c4 = *(const f32x4*)(cb + kv0 + 8 * g + 4 * hi);
#pragma unroll
                for (int jj = 0; jj < 4; ++jj) p[4 * g + jj] -= L2E * c4[jj]; }
            if (t == ntiles - 1) {
#pragma unroll
                for (int r = 0; r < 16; ++r) if (kv0 + crow(r, hi) > qlocal) p[r] = -INFINITY;
            }
        }
        float mt = p[0];
#pragma unroll
        for (int r = 1; r < 16; ++r) mt = fmaxf(mt, p[r]);
        mt = fmaxf(mt, __shfl_xor(mt, 32));
        const float mn = fmaxf(m, mt); const float alpha = __builtin_amdgcn_exp2f(m - mn); m = mn;
        l *= alpha;
#pragma unroll
        for (int d0 = 0; d0 < HD / 32; ++d0)
#pragma unroll
            for (int r = 0; r < 16; ++r) o[d0][r] *= alpha;
        float ls = 0.f;
#pragma unroll
        for (int r = 0; r < 16; ++r) { p[r] = __builtin_amdgcn_exp2f(p[r] - mn); ls += p[r]; }
        l += ls;
        bf16x8 pa[2];
#pragma unroll
        for (int s = 0; s < 2; ++s) { v4u w; w.x = cvtpk(p[8 * s + 0], p[8 * s + 1]); w.y = cvtpk(p[8 * s + 2], p[8 * s + 3]); w.z = cvtpk(p[8 * s + 4], p[8 * s + 5]); w.w = cvtpk(p[8 * s + 6], p[8 * s + 7]); pa[s] = __builtin_bit_cast(bf16x8, w); }
#pragma unroll
        for (int d0 = 0; d0 < HD / 32; ++d0)
#pragma unroll
            for (int s = 0; s < 2; ++s) {
                bf16x8 vf;
                if (VT) {
                    const bf16* vp = Vp + (size_t)(d0 * 32 + r32) * vpitch + kv0 + 16 * s + 4 * hi;
                    const u32x2 lo = *(const u32x2*)vp, hi2 = *(const u32x2*)(vp + 8);
                    vf = __builtin_bit_cast(bf16x8, (v4u){lo.x, lo.y, hi2.x, hi2.y});
                } else {
#pragma unroll
                    for (int j = 0; j < 8; ++j) vf[j] = (short)Vp[(size_t)(kv0 + 16 * s + 8 * (j >> 2) + 4 * hi + (j & 3)) * vpitch + d0 * 32 + r32];
                }
                o[d0] = __builtin_amdgcn_mfma_f32_32x32x16_bf16(vf, pa[s], o[d0], 0, 0, 0);
            }
    }
    l += __shfl_xor(l, 32);
    const float inv = 1.0f / l;
    bf16* orow = Op + (size_t)r32 * opitch;
#pragma unroll
    for (int d0 = 0; d0 < HD / 32; ++d0)
#pragma unroll
        for (int g = 0; g < 4; ++g) { u32x2 w; w.x = cvtpk(o[d0][4 * g] * inv, o[d0][4 * g + 1] * inv); w.y = cvtpk(o[d0][4 * g + 2] * inv, o[d0][4 * g + 3] * inv);
            *(u32x2*)(orow + d0 * 32 + 8 * g + 4 * hi) = w; }
}
__device__ __forceinline__ void fox_unit(int bh, int qb, const bf16* FQ, const bf16* FK, const bf16* FV, const float* CUM, const int* T0, bf16* OA, int wave, int lane) {
    const int b = bh >> 3, h = bh & 7, r32 = lane & 31, hi = lane >> 5; const size_t rowbase = (size_t)b * SEQ; const int q0 = qb * 256 + wave * 32;
    const bf16* Qw = FQ + (rowbase + q0) * 512 + h * 64; bf16* Ow = OA + (rowbase + q0) * 512 + h * 64;
    bf16x8 qr[4];
#pragma unroll
    for (int ks = 0; ks < 4; ++ks) qr[ks] = *(const bf16x8*)(Qw + (size_t)r32 * 512 + ks * 16 + hi * 8);
    attn_wave_simple<64, true, false>(qr, FK + rowbase * 512 + h * 64, 512, FV + rowbase * 512 + h * 64, 512, T0[bh * 256 + q0 / 32], q0 / 32 + 1, q0 + r32, CUM + (size_t)bh * SEQ, Ow, 512, lane);
}
__device__ __forceinline__ void mem_unit(int rg, int head, bf16* MQ, const bf16* KMB, const bf16* VMB, const float* gq, int lane) {
    const int r32 = lane & 31, hi = lane >> 5; const int row0 = rg * 32; const int b = row0 / SEQ;
    bf16* Qw = MQ + (size_t)row0 * 512 + head * 128;
    bf16x8 raw[8]; float ss = 0.f;
#pragma unroll
    for (int ks = 0; ks < 8; ++ks) { raw[ks] = *(const bf16x8*)(Qw + (size_t)r32 * 512 + ks * 16 + hi * 8);
#pragma unroll
        for (int j = 0; j < 8; ++j) { const float f = bf2f((bf16)raw[ks][j]); ss += f * f; } }
    ss += __shfl_xor(ss, 32);
    const float rstd = __builtin_amdgcn_rsqf(ss * (1.0f / 128.0f) + 1e-6f) * C2_128;
    bf16x8 qr[8];
#pragma unroll
    for (int ks = 0; ks < 8; ++ks) { const f32x4 g0 = *(const f32x4*)(gq + ks * 16 + hi * 8), g1 = *(const f32x4*)(gq + ks * 16 + hi * 8 + 4); v4u w;
        w.x = cvtpk(bf2f((bf16)raw[ks][0]) * rstd * g0[0], bf2f((bf16)raw[ks][1]) * rstd * g0[1]); w.y = cvtpk(bf2f((bf16)raw[ks][2]) * rstd * g0[2], bf2f((bf16)raw[ks][3]) * rstd * g0[3]);
        w.z = cvtpk(bf2f((bf16)raw[ks][4]) * rstd * g1[0], bf2f((bf16)raw[ks][5]) * rstd * g1[1]); w.w = cvtpk(bf2f((bf16)raw[ks][6]) * rstd * g1[2], bf2f((bf16)raw[ks][7]) * rstd * g1[3]);
        qr[ks] = __builtin_bit_cast(bf16x8, w); }
    attn_wave_simple<128, false, true>(qr, KMB + (size_t)b * MEMLEN * 512 + head * 128, 512, VMB + (size_t)(b * 4 + head) * 128 * MEMLEN, MEMLEN, 0, MEMLEN / 32, 0, nullptr, Qw, 512, lane);
}
typedef short v4i16_t __attribute__((ext_vector_type(4)));
__device__ __forceinline__ void fox_block(int bh, int qb, const bf16* FQ, const bf16* FK, const bf16* FV, const float* CUM, const int* T0, const float* gq, const float* gk, bf16* OA, LAS unsigned char* lds, int wave, int lane, int tid) {
    const int b = bh >> 3, h = bh & 7, r32 = lane & 31, hi = lane >> 5; const size_t rowbase = (size_t)b * SEQ; const int q0 = qb * 256 + wave * 32;
    const bf16* Qw = FQ + (rowbase + q0) * 512 + h * 64; bf16* Ow = OA + (rowbase + q0) * 512 + h * 64;
    const bf16* Kp = FK + rowbase * 512 + h * 64; const bf16* Vp = FV + rowbase * 512 + h * 64; const float* cb = CUM + (size_t)bh * SEQ;
    LAS float* bl = (LAS float*)(lds + 32768);
    LAS int* flg = (LAS int*)(lds + 32768 + 512);
    bf16x8 qr[4];
#pragma unroll
    for (int ks = 0; ks < 4; ++ks) qr[ks] = *(const bf16x8*)(Qw + (size_t)r32 * 512 + ks * 16 + hi * 8);
    const int tlast = q0 / 32, tstart = T0[bh * 256 + tlast], qlocal = q0 + r32;
    int Tlo = tstart;
#pragma unroll
    for (int w8 = 0; w8 < 8; ++w8) { const int tv = T0[bh * 256 + qb * 8 + w8]; Tlo = tv < Tlo ? tv : Tlo; }
    const int Thi = qb * 8 + 7, nwalk = (Thi - Tlo + 2) >> 1;
    const float stopc = (8.0f * wave_max(fabsf(gq[lane])) * wave_max(fabsf(gk[lane])) + 30.0f) * L2E;
    f32x16 o[2];
#pragma unroll
    for (int d0 = 0; d0 < 2; ++d0)
#pragma unroll
        for (int r = 0; r < 16; ++r) o[d0][r] = 0.f;
    float m = -1e30f, l = 0.f; bool gone = false;
    const int kq = (lane >> 4) & 1, q_ = (lane & 15) >> 2, p_ = lane & 3;
    if (lane == 0) flg[wave] = 0;
    const int lrow = (tid & 255) >> 3, lch = tid & 7; const bf16* src = (tid < 256 ? Kp : Vp) + (size_t)lrow * 512 + lch * 8;
    const unsigned ldso = (tid < 256) ? (unsigned)(lrow * 128 + ((lch ^ (lrow & 7)) * 16)) : (unsigned)(4096 + lrow * 128 + lch * 16);
#define FB_TA(i_) (Thi - 2 * ((i_) < nwalk ? (i_) : nwalk - 1))
#define FB_LOAD(SA, SB, SC, i_) do { const int ta_ = FB_TA(i_), tb_ = ta_ > 0 ? ta_ - 1 : 0; SA = *(const v4u*)(src + (size_t)(32 * ta_) * 512); SB = *(const v4u*)(src + (size_t)(32 * tb_) * 512); SC = cb[32 * ((tid & 32) ? tb_ : ta_) + (tid & 31)]; } while (0)
#define FB_PUT(SLOT, SA, SB, SC) do { *(LAS v4u*)(lds + (SLOT) * 16384 + ldso) = SA; *(LAS v4u*)(lds + (SLOT) * 16384 + 8192 + ldso) = SB; if (tid < 64) bl[(SLOT) * 64 + tid] = -L2E * SC; } while (0)
    v4u sa0, sa1, sa2, sa3, sb0, sb1, sb2, sb3; float sc0, sc1, sc2, sc3;
    FB_LOAD(sa0, sb0, sc0, 0); FB_LOAD(sa1, sb1, sc1, 1); FB_LOAD(sa2, sb2, sc2, 2); FB_LOAD(sa3, sb3, sc3, 3);
    FB_PUT(0, sa0, sb0, sc0);
    __syncthreads();
    auto compute1 = [&](int t, int slot, int half) {
        const LAS unsigned char* kb = lds + slot * 16384 + half * 8192; const LAS unsigned char* vb = kb + 4096; const LAS float* bb = bl + slot * 64 + half * 32;
        if (t != tlast) { const float bmax = bb[31]; if (__all(m > bmax + stopc)) { gone = true; return; } }
        f32x16 p;
#pragma unroll
        for (int r = 0; r < 16; ++r) p[r] = 0.f;
#pragma unroll
        for (int ks = 0; ks < 4; ++ks) { const bf16x8 kf = *(const LAS bf16x8*)(kb + r32 * 128 + (((2 * ks + hi) ^ (r32 & 7)) * 16)); p = __builtin_amdgcn_mfma_f32_32x32x16_bf16(kf, qr[ks], p, 0, 0, 0); }
#pragma unroll
        for (int g = 0; g < 4; ++g) { const f32x4 c4 = *(const LAS f32x4*)(bb + 8 * g + 4 * hi);
#pragma unroll
            for (int jj = 0; jj < 4; ++jj) p[4 * g + jj] += c4[jj]; }
        if (t == tlast) {
#pragma unroll
            for (int r = 0; r < 16; ++r) if (32 * t + crow(r, hi) > qlocal) p[r] = -INFINITY;
        }
        float mt = p[0];
#pragma unroll
        for (int r = 1; r < 16; ++r) mt = fmaxf(mt, p[r]);
        mt = fmaxf(mt, __shfl_xor(mt, 32));
        if (__any(mt > m)) {
            const float mn_ = fmaxf(m, mt); const float alpha = __builtin_amdgcn_exp2f(m - mn_); m = mn_;
            l *= alpha;
#pragma unroll
            for (int d0 = 0; d0 < 2; ++d0)
#pragma unroll
                for (int r = 0; r < 16; ++r) o[d0][r] *= alpha;
        }
        const float mn = m;
        float ls = 0.f;
#pragma unroll
        for (int r = 0; r < 16; ++r) { p[r] = __builtin_amdgcn_exp2f(p[r] - mn); ls += p[r]; }
        l += ls;
        bf16x8 pa[2];
#pragma unroll
        for (int s2 = 0; s2 < 2; ++s2) { v4u w; w.x = cvtpk(p[8 * s2 + 0], p[8 * s2 + 1]); w.y = cvtpk(p[8 * s2 + 2], p[8 * s2 + 3]); w.z = cvtpk(p[8 * s2 + 4], p[8 * s2 + 5]); w.w = cvtpk(p[8 * s2 + 6], p[8 * s2 + 7]); pa[s2] = __builtin_bit_cast(bf16x8, w); }
#pragma unroll
        for (int d0 = 0; d0 < 2; ++d0)
#pragma unroll
            for (int s2 = 0; s2 < 2; ++s2) {
                const LAS unsigned char* a1 = vb + (16 * s2 + 4 * hi + q_) * 128 + (32 * d0 + 16 * kq + 4 * p_) * 2;
                const v4i16_t lo4 = __builtin_amdgcn_ds_read_tr16_b64_v4i16((LAS v4i16_t*)a1), hi4 = __builtin_amdgcn_ds_read_tr16_b64_v4i16((LAS v4i16_t*)(a1 + 8 * 128));
                const bf16x8 vf = (bf16x8){lo4[0], lo4[1], lo4[2], lo4[3], hi4[0], hi4[1], hi4[2], hi4[3]};
                o[d0] = __builtin_amdgcn_mfma_f32_32x32x16_bf16(vf, pa[s2], o[d0], 0, 0, 0);
            }
    };
    auto compute2 = [&](int ta, int slot) {
        const LAS unsigned char* kb0 = lds + slot * 16384; const LAS unsigned char* vb0 = kb0 + 4096; const LAS unsigned char* kb1 = kb0 + 8192; const LAS unsigned char* vb1 = kb1 + 4096;
        const LAS float* bb0 = bl + slot * 64; const LAS float* bb1 = bb0 + 32;
        if (ta != tlast) { const float bmax = bb0[31]; if (__all(m > bmax + stopc)) { gone = true; return; } }
        f32x16 p1, p2;
#pragma unroll
        for (int r = 0; r < 16; ++r) { p1[r] = 0.f; p2[r] = 0.f; }
#pragma unroll
        for (int ks = 0; ks < 4; ++ks) { const int ko = r32 * 128 + (((2 * ks + hi) ^ (r32 & 7)) * 16); const bf16x8 kf1 = *(const LAS bf16x8*)(kb0 + ko), kf2 = *(const LAS bf16x8*)(kb1 + ko);
            p1 = __builtin_amdgcn_mfma_f32_32x32x16_bf16(kf1, qr[ks], p1, 0, 0, 0); p2 = __builtin_amdgcn_mfma_f32_32x32x16_bf16(kf2, qr[ks], p2, 0, 0, 0); }
#pragma unroll
        for (int g = 0; g < 4; ++g) { const f32x4 c4 = *(const LAS f32x4*)(bb0 + 8 * g + 4 * hi), d4 = *(const LAS f32x4*)(bb1 + 8 * g + 4 * hi);
#pragma unroll
            for (int jj = 0; jj < 4; ++jj) { p1[4 * g + jj] += c4[jj]; p2[4 * g + jj] += d4[jj]; } }
        if (ta == tlast) {
#pragma unroll
            for (int r = 0; r < 16; ++r) if (32 * ta + crow(r, hi) > qlocal) p1[r] = -INFINITY;
        }
        float mt = fmaxf(p1[0], p2[0]);
#pragma unroll
        for (int r = 1; r < 16; ++r) mt = fmaxf(mt, fmaxf(p1[r], p2[r]));
        mt = fmaxf(mt, __shfl_xor(mt, 32));
        if (__any(mt > m)) {
            const float mn_ = fmaxf(m, mt); const float alpha = __builtin_amdgcn_exp2f(m - mn_); m = mn_;
            l *= alpha;
#pragma unroll
            for (int d0 = 0; d0 < 2; ++d0)
#pragma unroll
                for (int r = 0; r < 16; ++r) o[d0][r] *= alpha;
        }
        const float mn = m;
        float ls = 0.f, ls2 = 0.f;
#pragma unroll
        for (int r = 0; r < 16; ++r) { p1[r] = __builtin_amdgcn_exp2f(p1[r] - mn); ls += p1[r]; p2[r] = __builtin_amdgcn_exp2f(p2[r] - mn); ls2 += p2[r]; }
        l += ls + ls2;
        bf16x8 pa1[2], pa2[2];
#pragma unroll
        for (int s2 = 0; s2 < 2; ++s2) { v4u w; w.x = cvtpk(p1[8 * s2 + 0], p1[8 * s2 + 1]); w.y = cvtpk(p1[8 * s2 + 2], p1[8 * s2 + 3]); w.z = cvtpk(p1[8 * s2 + 4], p1[8 * s2 + 5]); w.w = cvtpk(p1[8 * s2 + 6], p1[8 * s2 + 7]); pa1[s2] = __builtin_bit_cast(bf16x8, w);
            v4u x; x.x = cvtpk(p2[8 * s2 + 0], p2[8 * s2 + 1]); x.y = cvtpk(p2[8 * s2 + 2], p2[8 * s2 + 3]); x.z = cvtpk(p2[8 * s2 + 4], p2[8 * s2 + 5]); x.w = cvtpk(p2[8 * s2 + 6], p2[8 * s2 + 7]); pa2[s2] = __builtin_bit_cast(bf16x8, x); }
#pragma unroll
        for (int s2 = 0; s2 < 2; ++s2)
#pragma unroll
            for (int d0 = 0; d0 < 2; ++d0) {
                const int vo = (16 * s2 + 4 * hi + q_) * 128 + (32 * d0 + 16 * kq + 4 * p_) * 2;
                const v4i16_t lo4 = __builtin_amdgcn_ds_read_tr16_b64_v4i16((LAS v4i16_t*)(vb0 + vo)), hi4 = __builtin_amdgcn_ds_read_tr16_b64_v4i16((LAS v4i16_t*)(vb0 + vo + 8 * 128));
                const v4i16_t lo5 = __builtin_amdgcn_ds_read_tr16_b64_v4i16((LAS v4i16_t*)(vb1 + vo)), hi5 = __builtin_amdgcn_ds_read_tr16_b64_v4i16((LAS v4i16_t*)(vb1 + vo + 8 * 128));
                const bf16x8 vf1 = (bf16x8){lo4[0], lo4[1], lo4[2], lo4[3], hi4[0], hi4[1], hi4[2], hi4[3]}, vf2 = (bf16x8){lo5[0], lo5[1], lo5[2], lo5[3], hi5[0], hi5[1], hi5[2], hi5[3]};
                o[d0] = __builtin_amdgcn_mfma_f32_32x32x16_bf16(vf1, pa1[s2], o[d0], 0, 0, 0); o[d0] = __builtin_amdgcn_mfma_f32_32x32x16_bf16(vf2, pa2[s2], o[d0], 0, 0, 0);
            }
    };
#define FB_STEP(i_, NA, NB, NC, FA, FB_, FC) do { \
        FB_LOAD(FA, FB_, FC, (i_) + 4); \
        if ((i_) < nwalk && !gone) { const int ta_ = Thi - 2 * (i_), tb_ = ta_ - 1; const bool ina = ta_ <= tlast && ta_ >= tstart, inb = tb_ <= tlast && tb_ >= tstart; \
            if (ina && inb) compute2(ta_, (i_) & 1); else if (ina) { compute1(ta_, (i_) & 1, 0); gone = true; } else if (inb) compute1(tb_, (i_) & 1, 1); else if (ta_ < tstart) gone = true; } \
        FB_PUT(((i_) + 1) & 1, NA, NB, NC); \
        asm volatile("s_waitcnt lgkmcnt(0)" ::: "memory"); __builtin_amdgcn_s_barrier(); asm volatile("" ::: "memory"); } while (0)
    for (int i = 0; i < nwalk; i += 4) {
        FB_STEP(i, sa1, sb1, sc1, sa0, sb0, sc0); FB_STEP(i + 1, sa2, sb2, sc2, sa1, sb1, sc1); FB_STEP(i + 2, sa3, sb3, sc3, sa2, sb2, sc2); FB_STEP(i + 3, sa0, sb0, sc0, sa3, sb3, sc3);
        if (lane == 0 && gone) flg[wave] = 1;
        asm volatile("s_waitcnt lgkmcnt(0)" ::: "memory"); __builtin_amdgcn_s_barrier(); asm volatile("" ::: "memory");
        int all = 1;
#pragma unroll
        for (int w8 = 0; w8 < 8; ++w8) all &= flg[w8];
        if (all) break;
    }
#undef FB_STEP
#undef FB_LOAD
#undef FB_PUT
#undef FB_TA
    l += __shfl_xor(l, 32);
    const float inv = 1.0f / l;
    bf16* orow = Ow + (size_t)r32 * 512;
#pragma unroll
    for (int d0 = 0; d0 < 2; ++d0)
#pragma unroll
        for (int g = 0; g < 4; ++g) { u32x2 w; w.x = cvtpk(o[d0][4 * g] * inv, o[d0][4 * g + 1] * inv); w.y = cvtpk(o[d0][4 * g + 2] * inv, o[d0][4 * g + 3] * inv);
            *(u32x2*)(orow + d0 * 32 + 8 * g + 4 * hi) = w; }
    asm volatile("s_waitcnt vmcnt(0)" ::: "memory"); __syncthreads();
}
__device__ __forceinline__ void mem_block(int u, bf16* MQ, const bf16* KMB, const bf16* VNB, const float* gq, LAS unsigned char* lds, int wave, int lane, int tid) {
    const int head = u & 3, rg = (u >> 2) * 8 + wave, row0 = rg * 32, b = row0 / SEQ;
    const int r32 = lane & 31, hi = lane >> 5;
    {   const bf16* ks_ = KMB + (size_t)b * MEMLEN * 512 + head * 128; const bf16* vs_ = VNB + (size_t)b * MEMLEN * 512 + head * 128;
#pragma unroll
        for (int i = 0; i < 8; ++i) { const int e = tid + 512 * i, key = e >> 4, c = e & 15;
            const v4u kv = *(const v4u*)(ks_ + (size_t)key * 512 + c * 8), vv = *(const v4u*)(vs_ + (size_t)key * 512 + c * 8);
            *(LAS v4u*)(lds + key * 256 + ((c ^ (key & 7)) * 16)) = kv; *(LAS v4u*)(lds + 65536 + key * 256 + c * 16) = vv; } }
    bf16* Qw = MQ + (size_t)row0 * 512 + head * 128;
    bf16x8 raw[8]; float ss = 0.f;
#pragma unroll
    for (int ks = 0; ks < 8; ++ks) { raw[ks] = *(const bf16x8*)(Qw + (size_t)r32 * 512 + ks * 16 + hi * 8);
#pragma unroll
        for (int j = 0; j < 8; ++j) { const float f = bf2f((bf16)raw[ks][j]); ss += f * f; } }
    ss += __shfl_xor(ss, 32);
    const float rstd = __builtin_amdgcn_rsqf(ss * (1.0f / 128.0f) + 1e-6f) * C2_128;
    bf16x8 qr[8];
#pragma unroll
    for (int ks = 0; ks < 8; ++ks) { const f32x4 g0 = *(const f32x4*)(gq + ks * 16 + hi * 8), g1 = *(const f32x4*)(gq + ks * 16 + hi * 8 + 4); v4u w;
        w.x = cvtpk(bf2f((bf16)raw[ks][0]) * rstd * g0[0], bf2f((bf16)raw[ks][1]) * rstd * g0[1]); w.y = cvtpk(bf2f((bf16)raw[ks][2]) * rstd * g0[2], bf2f((bf16)raw[ks][3]) * rstd * g0[3]);
        w.z = cvtpk(bf2f((bf16)raw[ks][4]) * rstd * g1[0], bf2f((bf16)raw[ks][5]) * rstd * g1[1]); w.w = cvtpk(bf2f((bf16)raw[ks][6]) * rstd * g1[2], bf2f((bf16)raw[ks][7]) * rstd * g1[3]);
        qr[ks] = __builtin_bit_cast(bf16x8, w); }
    __syncthreads();
    f32x16 o[4];
#pragma unroll
    for (int d0 = 0; d0 < 4; ++d0)
#pragma unroll
        for (int r = 0; r < 16; ++r) o[d0][r] = 0.f;
    float m = -1e30f, l = 0.f;
    const int kq = (lane >> 4) & 1, q_ = (lane & 15) >> 2, p_ = lane & 3;
#pragma unroll 1
    for (int t = 0; t < MEMLEN / 32; ++t) {
        const LAS unsigned char* kb = lds + (32 * t) * 256; const LAS unsigned char* vb = lds + 65536 + (32 * t) * 256;
        f32x16 p;
#pragma unroll
        for (int r = 0; r < 16; ++r) p[r] = 0.f;
#pragma unroll
        for (int ks = 0; ks < 8; ++ks) { const bf16x8 kf = *(const LAS bf16x8*)(kb + r32 * 256 + (((2 * ks + hi) ^ (r32 & 7)) * 16)); p = __builtin_amdgcn_mfma_f32_32x32x16_bf16(kf, qr[ks], p, 0, 0, 0); }
        float mt = p[0];
#pragma unroll
        for (int r = 1; r < 16; ++r) mt = fmaxf(mt, p[r]);
        mt = fmaxf(mt, __shfl_xor(mt, 32));
        if (__any(mt > m)) { const float mn_ = fmaxf(m, mt); const float alpha = __builtin_amdgcn_exp2f(m - mn_); m = mn_; l *= alpha;
#pragma unroll
            for (int d0 = 0; d0 < 4; ++d0)
#pragma unroll
                for (int r = 0; r < 16; ++r) o[d0][r] *= alpha; }
        const float mn = m; float ls = 0.f;
#pragma unroll
        for (int r = 0; r < 16; ++r) { p[r] = __builtin_amdgcn_exp2f(p[r] - mn); ls += p[r]; }
        l += ls;
        bf16x8 pa[2];
#pragma unroll
        for (int s2 = 0; s2 < 2; ++s2) { v4u w; w.x = cvtpk(p[8 * s2 + 0], p[8 * s2 + 1]); w.y = cvtpk(p[8 * s2 + 2], p[8 * s2 + 3]); w.z = cvtpk(p[8 * s2 + 4], p[8 * s2 + 5]); w.w = cvtpk(p[8 * s2 + 6], p[8 * s2 + 7]); pa[s2] = __builtin_bit_cast(bf16x8, w); }
#pragma unroll
        for (int d0 = 0; d0 < 4; ++d0)
#pragma unroll
            for (int s2 = 0; s2 < 2; ++s2) {
                const LAS unsigned char* a1 = vb + (16 * s2 + 4 * hi + q_) * 256 + (32 * d0 + 16 * kq + 4 * p_) * 2;
                const v4i16_t lo4 = __builtin_amdgcn_ds_read_tr16_b64_v4i16((LAS v4i16_t*)a1), hi4 = __builtin_amdgcn_ds_read_tr16_b64_v4i16((LAS v4i16_t*)(a1 + 8 * 256));
                const bf16x8 vf = (bf16x8){lo4[0], lo4[1], lo4[2], lo4[3], hi4[0], hi4[1], hi4[2], hi4[3]};
                o[d0] = __builtin_amdgcn_mfma_f32_32x32x16_bf16(vf, pa[s2], o[d0], 0, 0, 0); }
    }
    l += __shfl_xor(l, 32);
    const float inv = 1.0f / l;
    bf16* orow = Qw + (size_t)r32 * 512;
#pragma unroll
    for (int d0 = 0; d0 < 4; ++d0)
#pragma unroll
        for (int g = 0; g < 4; ++g) { u32x2 w; w.x = cvtpk(o[d0][4 * g] * inv, o[d0][4 * g + 1] * inv); w.y = cvtpk(o[d0][4 * g + 2] * inv, o[d0][4 * g + 3] * inv);
            *(u32x2*)(orow + d0 * 32 + 8 * g + 4 * hi) = w; }
    __syncthreads();
}
__device__ __forceinline__ void scan_unit(int bh, const float* LOGF, float* CUM, int* T0, const float* gq, const float* gk, LAS float* sx, LAS float* cl, int tid) {
    const int b = bh >> 3, h = bh & 7, lane = tid & 63, wave = tid >> 6;
    float v[16]; float run = 0.f;
#pragma unroll
    for (int i = 0; i < 16; ++i) v[i] = LOGF[((size_t)b * SEQ + 16 * tid + i) * 8 + h];
#pragma unroll
    for (int i = 0; i < 16; ++i) { run += v[i]; v[i] = run; }
    float tot = run;
#pragma unroll
    for (int off = 1; off < 64; off <<= 1) { const float nb = __shfl_up(tot, off); if (lane >= off) tot += nb; }
    if (lane == 63) sx[wave] = tot;
    __syncthreads();
    float woff = 0.f;
    for (int w = 0; w < wave; ++w) woff += sx[w];
    const float excl = tot - run + woff;
    float* dst = CUM + (size_t)bh * SEQ + 16 * tid;
#pragma unroll
    for (int i = 0; i < 16; i += 4) { const f32x4 o4 = (f32x4){v[i] + excl, v[i + 1] + excl, v[i + 2] + excl, v[i + 3] + excl}; *(f32x4*)(dst + i) = o4; *(LAS f32x4*)(cl + 16 * tid + i) = o4; }
    const float smax = 8.0f * wave_max(fabsf(gq[lane])) * wave_max(fabsf(gk[lane]));
    __syncthreads();
    if (tid < 256) { const float cq = cl[32 * tid]; const float lim = -(30.0f + 2.0f * smax);
        int lo = 0, hi = tid;
        while (lo < hi) { const int mid = (lo + hi) >> 1; if (cq - cl[32 * mid + 31] >= lim) hi = mid; else lo = mid + 1; }
        T0[bh * 256 + tid] = lo; }
    __syncthreads();
}
constexpr int D2_LST = RING_BYTES + 1024;
constexpr int D2_CNT = RING_BYTES + 3072;
constexpr int D2_CL = RING_BYTES + 4096;
typedef float f32x4d __attribute__((ext_vector_type(4)));
__device__ __forceinline__ unsigned sortable_u32(float f) { const unsigned u = __float_as_uint(f); return u ^ ((u >> 31) ? 0xFFFFFFFFu : 0x80000000u); }
__device__ __forceinline__ int lane_rank(unsigned long long mask) { return (int)__builtin_amdgcn_mbcnt_hi((unsigned)(mask >> 32), __builtin_amdgcn_mbcnt_lo((unsigned)mask, 0u)); }
__device__ __forceinline__ int bcount(bool p) { return (int)__popcll(__ballot(p)); }
__device__ __forceinline__ void select_full(const LAS unsigned* my, int npad, LAS unsigned short* lst, int lane) {
    unsigned thr = 0u;
    for (int bit = 31; bit >= 0; --bit) {
        const unsigned cand = thr | (1u << bit); int cnt = 0;
        for (int i0 = 0; i0 < npad; i0 += 256) { const int idx = i0 + 4 * lane; v4u v = (v4u){0u, 0u, 0u, 0u}; if (idx < npad) v = *(const LAS v4u*)(my + idx);
            cnt += bcount(v.x >= cand) + bcount(v.y >= cand) + bcount(v.z >= cand) + bcount(v.w >= cand); }
        if (cnt >= 256) thr = cand;
    }
    int cgt = 0;
    for (int i0 = 0; i0 < npad; i0 += 256) { const int idx = i0 + 4 * lane; v4u v = (v4u){0u, 0u, 0u, 0u}; if (idx < npad) v = *(const LAS v4u*)(my + idx);
        cgt += bcount(v.x > thr) + bcount(v.y > thr) + bcount(v.z > thr) + bcount(v.w > thr); }
    const int quota = 256 - cgt; int eqseen = 0, nsel = 0;
    for (int base = 0; base < npad; base += 64) { const int idx = base + lane; unsigned u = 0u; if (idx < npad) u = my[idx];
        const bool gt = u > thr, eq = (u == thr);
        const unsigned long long em = __ballot(eq); const int er = eqseen + lane_rank(em);
        const bool sel = gt || (eq && er < quota);
        const unsigned long long sm = __ballot(sel); const int pos = nsel + lane_rank(sm);
        if (sel && pos < 256) lst[pos] = (unsigned short)idx;
        nsel += __popcll(sm); eqseen += __popcll(em); }
}
template <int KMAX> __device__ __forceinline__ void select_cands(const unsigned (&uu)[16], const unsigned (&id)[16], LAS unsigned short* lst, int lane, unsigned lb = 0u) {
    unsigned thr = 0u;
    for (int bit = 31; bit >= 0; --bit) {
        if ((((thr ^ lb) >> bit) >> 1) == 0u && ((lb >> bit) & 1u)) { thr |= (1u << bit); continue; }
        const unsigned cand = thr | (1u << bit); int cnt = 0;
#pragma unroll
        for (int k = 0; k < KMAX; ++k) cnt += bcount(uu[k] >= cand);
        if (cnt >= 256) { thr = cand; if (cnt == 256) break; }
    }
    int cgt = 0, ceq = 0;
#pragma unroll
    for (int k = 0; k < KMAX; ++k) { cgt += bcount(uu[k] > thr); ceq += bcount(uu[k] == thr); }
    const int quota = 256 - cgt; unsigned ilim = 0xFFFFu;
    if (ceq != quota) {
        unsigned I = 0u;
        for (int bit = 12; bit >= 0; --bit) { const unsigned cand = I | (1u << bit); int cnt = 0;
#pragma unroll
            for (int k = 0; k < KMAX; ++k) cnt += bcount(uu[k] == thr && id[k] < cand);
            if (cnt < quota) I = cand; }
        ilim = I;
    }
    int nsel = 0;
#pragma unroll
    for (int k = 0; k < KMAX; ++k) { const bool sel = (uu[k] > thr) || (uu[k] == thr && id[k] <= ilim);
        const unsigned long long sm = __ballot(sel); const int pos = nsel + lane_rank(sm);
        if (sel && pos < 256) lst[pos] = (unsigned short)id[k];
        nsel += __popcll(sm); }
}
__device__ __forceinline__ void dsa2_unit(int b, int qg, const bf16* IQ, const bf16* IK, const float* IW, const bf16* DQ, const bf16* DK, const bf16* DV, bf16* OB, LAS unsigned char* lds, int wave, int lane) {
    LAS unsigned* sc = (LAS unsigned*)lds;
    LAS unsigned short* LST = (LAS unsigned short*)(lds + D2_LST);
    LAS int* CNT = (LAS int*)(lds + D2_CNT);
    LAS unsigned short* CL = (LAS unsigned short*)(lds + D2_CL);
    const int q0 = 4 * qg, r32 = lane & 31, hi = lane >> 5; const size_t rowbase = (size_t)b * SEQ;
    const int ntile = (q0 + 3) / 32 + 1, npad = ntile * 32;
#ifndef REP_A
#define REP_A 1
#define REP_B1 1
#define REP_B2 1
#define REP_C 1
#endif
    for (int repa = 0; repa < REP_A; ++repa)
    {
        const int qi = 2 * ((r32 >> 2) & 1) + (r32 >> 4), hd = 4 * ((r32 >> 3) & 1) + (r32 & 3);
        bf16x8 aq[4];
#pragma unroll
        for (int ks = 0; ks < 4; ++ks) aq[ks] = *(const bf16x8*)(IQ + (rowbase + q0 + qi) * 512 + hd * 64 + ks * 16 + hi * 8);
        const float* w0p = IW + (rowbase + q0 + 2 * hi) * 8;
        const f32x4 w0a = *(const f32x4*)(w0p), w0b = *(const f32x4*)(w0p + 4), w1a = *(const f32x4*)(w0p + 8), w1b = *(const f32x4*)(w0p + 12);
        for (int t = wave; t < ntile; t += 32) {
            bf16x8 bk[4][4];
#pragma unroll
            for (int u = 0; u < 4; ++u) { const int tt = t + 8 * u; const bf16* kr = IK + (rowbase + 32 * (tt < ntile ? tt : t)) * 64 + lane * 8;
#pragma unroll
                for (int ks = 0; ks < 4; ++ks) bk[u][ks] = *(const bf16x8*)(kr + ks * 512); }
#pragma unroll
            for (int u = 0; u < 4; ++u) { const int tt = t + 8 * u;
                if (tt < ntile) {
                    const int key = 32 * tt + r32;
                    f32x16 a;
#pragma unroll
                    for (int r = 0; r < 16; ++r) a[r] = 0.f;
#pragma unroll
                    for (int ks = 0; ks < 4; ++ks) a = __builtin_amdgcn_mfma_f32_32x32x16_bf16(aq[ks], bk[u][ks], a, 0, 0, 0);
                    float s0 = 0.f, s1 = 0.f;
#pragma unroll
                    for (int j = 0; j < 4; ++j) { s0 += w0a[j] * fmaxf(a[j], 0.f); s1 += w1a[j] * fmaxf(a[8 + j], 0.f); }
#pragma unroll
                    for (int j = 0; j < 4; ++j) { s0 += w0b[j] * fmaxf(a[4 + j], 0.f); s1 += w1b[j] * fmaxf(a[12 + j], 0.f); }
                    sc[(2 * hi) * 8192 + key] = (key <= q0 + 2 * hi) ? sortable_u32(s0) : 0u;
                    sc[(2 * hi + 1) * 8192 + key] = (key <= q0 + 2 * hi + 1) ? sortable_u32(s1) : 0u;
                } }
        }
    }
    __syncthreads();
    const int qi = wave & 3, hf = wave >> 2, q = q0 + qi, n = q + 1;
    const LAS unsigned* my = sc + qi * 8192;
    for (int repb = 0; repb < REP_B1; ++repb)
    {
        int c = 0; bool ovf = false;
        if (n > 256) {
            unsigned pivot = 1u;
            if (n > 640) {
                unsigned s[8];
#pragma unroll
                for (int k = 0; k < 8; ++k) s[k] = my[(int)(((unsigned)(lane * 8 + k) * (unsigned)n) >> 9)];
                const int r = (256 * 512 * 7 / 4) / n + 8;
                unsigned t16 = 0u;
                for (int bit = 15; bit >= 0; --bit) { const unsigned cand = (t16 | (1u << bit)) << 16; int cnt = 0;
#pragma unroll
                    for (int k = 0; k < 8; ++k) cnt += bcount(s[k] >= cand);
                    if (cnt >= r) t16 |= (1u << bit); }
                pivot = t16 << 16; if (pivot == 0u) pivot = 1u;
            }
            const int half = ((npad + 511) >> 9) << 8; const int lo = hf * half; const int hiend = (lo + half < npad) ? lo + half : npad;
            LAS unsigned short* cl = CL + wave * 1024;
            for (int i0 = lo; i0 < hiend; i0 += 256) { const int idx = i0 + 4 * lane; v4u v = (v4u){0u, 0u, 0u, 0u}; if (idx < hiend) v = *(const LAS v4u*)(my + idx);
#pragma unroll
                for (int e = 0; e < 4; ++e) { const bool f = v[e] >= pivot; const unsigned long long m = __ballot(f); const int pos = c + lane_rank(m);
                    if (f) { if (pos < 1024) cl[pos] = (unsigned short)(idx + e); }
                    c += __popcll(m); } }
            if (c > 1024) ovf = true;
        }
        if (lane == 0) CNT[wave] = ovf ? -1 : c;
    }
    __syncthreads();
    for (int repb2 = 0; repb2 < REP_B2; ++repb2)
    if (wave < 4) {
        LAS unsigned short* lst = LST + wave * 256; int nsel;
        if (n <= 256) { for (int i = lane; i < n; i += 64) lst[i] = (unsigned short)i; nsel = n; }
        else {
            const int c0 = CNT[wave], c1 = CNT[wave + 4]; const int c = c0 + c1;
            if (c0 < 0 || c1 < 0 || c < 256 || c > 1024) select_full(my, npad, lst, lane);
            else {
                unsigned uu[16], id[16];
#pragma unroll
                for (int k = 0; k < 16; ++k) { const int j = k * 64 + lane; unsigned ix = 0u, u = 0u;
                    if (j < c) { ix = (j < c0) ? (unsigned)CL[wave * 1024 + j] : (unsigned)CL[(wave + 4) * 1024 + (j - c0)]; u = my[ix]; }
                    uu[k] = u; id[k] = ix; }
                if (c <= 512) select_cands<8>(uu, id, lst, lane); else select_cands<16>(uu, id, lst, lane);
            }
            nsel = 256;
        }
        if (lane == 0) CNT[8 + wave] = nsel;
    }
    __syncthreads();
    for (int repc = 0; repc < REP_C; ++repc)
    {
        const int nsel = CNT[8 + qi]; const int j0 = 128 * hf; int cntk = nsel - j0; cntk = cntk < 0 ? 0 : (cntk > 128 ? 128 : cntk);
        const LAS unsigned short* lst = LST + qi * 256;
        LAS unsigned char* tile = lds + wave * 16384;
        LAS float* tf = (LAS float*)tile;
        const int l15 = lane & 15, kq = lane >> 4;
        if (cntk == 0) {
#pragma unroll
            for (int i = 0; i < 8; ++i) tf[i * 64 + lane] = 0.f;
            if (lane < 8) { tf[512 + lane] = -INFINITY; tf[520 + lane] = 0.f; }
        } else {
#pragma unroll
            for (int it = 0; it < 16; ++it) { const int r = 8 * it + (lane >> 3), ch = lane & 7; int j = j0 + r; j = j < nsel ? j : nsel - 1;
                const int idxv = (int)lst[j]; const v4u v = *(const v4u*)(DV + (rowbase + idxv) * 64 + 8 * ch);
                *(LAS v4u*)(tile + r * 128 + ch * 16) = v; }
            bf16x8 qf[2];
#pragma unroll
            for (int ks = 0; ks < 2; ++ks) { v4u z = (v4u){0u, 0u, 0u, 0u}; if (l15 < 8) z = *(const v4u*)(DQ + (rowbase + q) * 512 + l15 * 64 + 32 * ks + 8 * kq); qf[ks] = __builtin_bit_cast(bf16x8, z); }
            f32x4d acc[8];
#pragma unroll
            for (int g = 0; g < 8; ++g) { int j = j0 + 16 * g + l15; j = j < nsel ? j : nsel - 1; const int idxk = (int)lst[j];
                const bf16* kp = DK + (rowbase + idxk) * 64 + 8 * kq;
                const bf16x8 k0 = *(const bf16x8*)(kp), k1 = *(const bf16x8*)(kp + 32);
                f32x4d a = (f32x4d){0.f, 0.f, 0.f, 0.f};
                a = __builtin_amdgcn_mfma_f32_16x16x32_bf16(k0, qf[0], a, 0, 0, 0); a = __builtin_amdgcn_mfma_f32_16x16x32_bf16(k1, qf[1], a, 0, 0, 0); acc[g] = a; }
            float mx = -INFINITY;
#pragma unroll
            for (int g = 0; g < 8; ++g)
#pragma unroll
                for (int e = 0; e < 4; ++e) { if (16 * g + 4 * kq + e >= cntk) acc[g][e] = -INFINITY; mx = fmaxf(mx, acc[g][e]); }
            mx = fmaxf(mx, __shfl_xor(mx, 16)); mx = fmaxf(mx, __shfl_xor(mx, 32));
            float ls = 0.f;
#pragma unroll
            for (int g = 0; g < 8; ++g)
#pragma unroll
                for (int e = 0; e < 4; ++e) { acc[g][e] = __builtin_amdgcn_exp2f(acc[g][e] - mx); ls += acc[g][e]; }
            ls += __shfl_xor(ls, 16); ls += __shfl_xor(ls, 32);
            bf16x8 pa[4];
#pragma unroll
            for (int t = 0; t < 4; ++t) { v4u w; w.x = cvtpk(acc[2 * t][0], acc[2 * t][1]); w.y = cvtpk(acc[2 * t][2], acc[2 * t][3]); w.z = cvtpk(acc[2 * t + 1][0], acc[2 * t + 1][1]); w.w = cvtpk(acc[2 * t + 1][2], acc[2 * t + 1][3]); pa[t] = __builtin_bit_cast(bf16x8, w); }
            f32x4d o[4];
            const int q_ = l15 >> 2, p_ = lane & 3;
#pragma unroll
            for (int cb = 0; cb < 4; ++cb) { f32x4d oc = (f32x4d){0.f, 0.f, 0.f, 0.f};
#pragma unroll
                for (int t = 0; t < 4; ++t) {
                    const LAS unsigned char* a1 = tile + (32 * t + 4 * kq + q_) * 128 + (16 * cb + 4 * p_) * 2;
                    const v4i16_t lo4 = __builtin_amdgcn_ds_read_tr16_b64_v4i16((LAS v4i16_t*)a1), hi4 = __builtin_amdgcn_ds_read_tr16_b64_v4i16((LAS v4i16_t*)(a1 + 16 * 128));
                    const bf16x8 vf = (bf16x8){lo4[0], lo4[1], lo4[2], lo4[3], hi4[0], hi4[1], hi4[2], hi4[3]};
                    oc = __builtin_amdgcn_mfma_f32_16x16x32_bf16(pa[t], vf, oc, 0, 0, 0); }
                o[cb] = oc; }
            if (kq < 2) {
#pragma unroll
                for (int cb = 0; cb < 4; ++cb)
#pragma unroll
                    for (int e = 0; e < 4; ++e) tf[(4 * kq + e) * 64 + 16 * cb + l15] = o[cb][e];
            }
            if (lane < 8) { tf[512 + lane] = mx; tf[520 + lane] = ls; }
        }
    }
    __syncthreads();
    if (wave < 4) {
        const LAS float* ta = (const LAS float*)(lds + wave * 16384); const LAS float* tb = (const LAS float*)(lds + (wave + 4) * 16384);
        const int h = lane >> 3, d0 = (lane & 7) * 8;
        const float ma = ta[512 + h], mb = tb[512 + h], la = ta[520 + h], lb = tb[520 + h];
        const float m = fmaxf(ma, mb), fa = __builtin_amdgcn_exp2f(ma - m), fb = __builtin_amdgcn_exp2f(mb - m);
        const float inv = 1.0f / (la * fa + lb * fb);
        const f32x4 a0 = *(const LAS f32x4*)(ta + h * 64 + d0), a1 = *(const LAS f32x4*)(ta + h * 64 + d0 + 4), b0 = *(const LAS f32x4*)(tb + h * 64 + d0), b1 = *(const LAS f32x4*)(tb + h * 64 + d0 + 4);
        const f32x4 r0 = (a0 * fa + b0 * fb) * inv, r1 = (a1 * fa + b1 * fb) * inv;
        v4u w; w.x = cvtpk(r0[0], r0[1]); w.y = cvtpk(r0[2], r0[3]); w.z = cvtpk(r1[0], r1[1]); w.w = cvtpk(r1[2], r1[3]);
        *(v4u*)(OB + (rowbase + q) * 512 + h * 64 + d0) = w;
    }
    __syncthreads();
}
constexpr int D3_RING = RING_BYTES + 1024;
constexpr int D3_LST = D3_RING + 16384;
constexpr int D3_CNT = D3_LST + 8192;
constexpr int D3_QW = D3_CNT + 512;
typedef unsigned long long u64d;
template <int KMAX> __device__ __forceinline__ void select_cands3(const unsigned (&uu)[16], const unsigned (&id)[16], LAS unsigned short* lst, int lane) { select_cands<KMAX>(uu, id, lst, lane); }
__device__ __forceinline__ void dsa3_unit(int b, int g16, const bf16* IQ, const bf16* IK, const float* IW, const bf16* DQ, const bf16* DK, const bf16* DV, bf16* OB, LAS unsigned char* lds, int wave, int lane_in) {
    int lane = lane_in; asm volatile("" : "+v"(lane));
    LAS u64d* LISTS = (LAS u64d*)lds;
    LAS unsigned short* LST = (LAS unsigned short*)(lds + D3_LST);
    LAS int* CNT = (LAS int*)(lds + D3_CNT);
    const int tid = wave * 64 + lane, r32 = lane & 31, hi = lane >> 5; const size_t rowbase = (size_t)b * SEQ;
    const int q0 = 16 * g16, ntile = (q0 + 15) / 32 + 1, nstep = (ntile + 1) >> 1;
    const int qgrp = wave & 3, par = wave >> 2;
    const int qA = q0 + 4 * qgrp + 2 * hi, qB = qA + 1;
    const int qi = 2 * ((r32 >> 2) & 1) + (r32 >> 4), hd = 4 * ((r32 >> 3) & 1) + (r32 & 3);
    bf16x8 aq[4];
#pragma unroll
    for (int ks = 0; ks < 4; ++ks) aq[ks] = *(const bf16x8*)(IQ + (rowbase + q0 + 4 * qgrp + qi) * 512 + hd * 64 + ks * 16 + hi * 8);
    const float* w0p = IW + (rowbase + qA) * 8;
    const f32x4 w0a = *(const f32x4*)(w0p), w0b = *(const f32x4*)(w0p + 4), w1a = *(const f32x4*)(w0p + 8), w1b = *(const f32x4*)(w0p + 12);
    f32x4 l0a, l0b, l1a, l1b;
#pragma unroll
    for (int j = 0; j < 4; ++j) { l0a[j] = w0a[j] >= 0.f ? INFINITY : -INFINITY; l0b[j] = w0b[j] >= 0.f ? INFINITY : -INFINITY; l1a[j] = w1a[j] >= 0.f ? INFINITY : -INFINITY; l1b[j] = w1b[j] >= 0.f ? INFINITY : -INFINITY; }
#define D3_SCORE(BK, S0, S1) do { f32x16 a_; _Pragma("unroll") for (int r = 0; r < 16; ++r) a_[r] = 0.f; \
        _Pragma("unroll") for (int ks = 0; ks < 4; ++ks) a_ = __builtin_amdgcn_mfma_f32_32x32x16_bf16(aq[ks], BK[ks], a_, 0, 0, 0); \
        S0 = 0.f; S1 = 0.f; \
        _Pragma("unroll") for (int j = 0; j < 4; ++j) { S0 += __builtin_amdgcn_fmed3f(w0a[j] * a_[j], 0.f, l0a[j]); S1 += __builtin_amdgcn_fmed3f(w1a[j] * a_[8 + j], 0.f, l1a[j]); } \
        _Pragma("unroll") for (int j = 0; j < 4; ++j) { S0 += __builtin_amdgcn_fmed3f(w0b[j] * a_[4 + j], 0.f, l0b[j]); S1 += __builtin_amdgcn_fmed3f(w1b[j] * a_[12 + j], 0.f, l1b[j]); } } while (0)
#ifndef REP_S
#define REP_S 1
#define REP_M 1
#define REP_B 1
#define REP_CD 1
#endif
    unsigned pivA = 1u, pivB = 1u;
    if (ntile <= 16 && tid < 16) CNT[64 + tid] = 0;
    for (int reps = 0; reps < REP_S; ++reps)
    if (ntile > 16) {
#pragma unroll
        for (int k = 0; k < 4; ++k) { const int c = tid + 512 * k; const int ts = ((c >> 8) * ntile) >> 3;
            *(LAS v4u*)(lds + c * 16) = *(const v4u*)(IK + (rowbase + 32 * ts) * 64 + (c & 255) * 8); }
        __syncthreads();
        unsigned uA[8], uB[8];
#pragma unroll
        for (int i = 0; i < 8; ++i) { bf16x8 bk[4];
#pragma unroll
            for (int ks = 0; ks < 4; ++ks) bk[ks] = *(const LAS bf16x8*)(lds + i * 4096 + ks * 1024 + lane * 16);
            float s0, s1; D3_SCORE(bk, s0, s1); uA[i] = sortable_u32(s0); uB[i] = sortable_u32(s1); asm volatile("" ::: "memory"); }
        const int qs = q0 + 4 * qgrp + par;
        const int r0 = (256 * 256 * 7 / 4) / (qs + 1) + 6, r1 = (256 * 256 * 7 / 4) / (qs + 3) + 6;
        unsigned us[8];
#pragma unroll
        for (int i = 0; i < 8; ++i) us[i] = par ? uB[i] : uA[i];
        unsigned t0 = 0u, t1 = 0u;
        for (int bit = 15; bit >= 0; --bit) {
            const unsigned c = ((hi ? t1 : t0) | (1u << bit)) << 16; int n0 = 0, n1 = 0;
#pragma unroll
            for (int i = 0; i < 8; ++i) { const unsigned long long m = __builtin_amdgcn_ballot_w64(us[i] >= c); n0 += __popc((unsigned)m); n1 += __popc((unsigned)(m >> 32)); }
            if (n0 >= r0) t0 |= (1u << bit);
            if (n1 >= r1) t1 |= (1u << bit);
        }
        LAS unsigned* PV = (LAS unsigned*)(CNT + 64);
        if (lane == 0) { PV[4 * qgrp + par] = t0; PV[4 * qgrp + 2 + par] = t1; }
        __syncthreads();
        const unsigned tA = PV[4 * qgrp + 2 * hi], tB = PV[4 * qgrp + 2 * hi + 1];
        pivA = tA << 16; pivB = tB << 16; if (pivA == 0u) pivA = 1u; if (pivB == 0u) pivB = 1u;
        __syncthreads();
    }
    for (int repm = 0; repm < REP_M; ++repm)
    {
        const bf16* src0 = IK + rowbase * 64 + (size_t)(tid & 255) * 8;
#define D3_LOAD(k_) (*(const v4u*)(src0 + (size_t)32 * ((2 * (k_) + (tid >> 8)) < ntile ? (2 * (k_) + (tid >> 8)) : ntile - 1) * 64))
        v4u st0 = (v4u){0u, 0u, 0u, 0u}, st1 = st0, st2 = st0, st3 = st0;
        st0 = D3_LOAD(0); st1 = D3_LOAD(1); st2 = D3_LOAD(2); st3 = D3_LOAD(3);
        *(LAS v4u*)(lds + D3_RING + tid * 16) = st0;
        __syncthreads();
        int cntA = 0, cntB = 0;
        LAS u64d* lA = LISTS + ((4 * qgrp + 2 * hi) * 2 + par) * 512; LAS u64d* lB = lA + 1024;
        LAS u64d* dmy = (LAS u64d*)(lds + D3_QW + 64) + lane;
        f32x16 acc;
#pragma unroll
        for (int r = 0; r < 16; ++r) acc[r] = 0.f;
#define D3_SUMS(S0, S1) do { S0 = 0.f; S1 = 0.f; \
            _Pragma("unroll") for (int j = 0; j < 4; ++j) { S0 += __builtin_amdgcn_fmed3f(w0a[j] * acc[j], 0.f, l0a[j]); S1 += __builtin_amdgcn_fmed3f(w1a[j] * acc[8 + j], 0.f, l1a[j]); } \
            _Pragma("unroll") for (int j = 0; j < 4; ++j) { S0 += __builtin_amdgcn_fmed3f(w0b[j] * acc[4 + j], 0.f, l0b[j]); S1 += __builtin_amdgcn_fmed3f(w1b[j] * acc[12 + j], 0.f, l1b[j]); } } while (0)
#define D3_FILTER(TP, S0, S1) do { const int key = 32 * (TP) + r32; const unsigned u0 = sortable_u32(S0), u1 = sortable_u32(S1);     \
                const bool psa = (key <= qA) && (u0 >= pivA), psb = (key <= qB) && (u1 >= pivB); \
                const unsigned long long ma = __ballot(psa), mb = __ballot(psb); const unsigned mla = (unsigned)ma, mha = (unsigned)(ma >> 32), mlb = (unsigned)mb, mhb = (unsigned)(mb >> 32); \
                const int posa = cntA + (int)__builtin_amdgcn_mbcnt_hi(mha, __builtin_amdgcn_mbcnt_lo(mla, 0u)) - (hi ? __popc(mla) : 0); \
                const int posb = cntB + (int)__builtin_amdgcn_mbcnt_hi(mhb, __builtin_amdgcn_mbcnt_lo(mlb, 0u)) - (hi ? __popc(mlb) : 0); \
                LAS u64d* wa_ = (psa && posa < 512) ? lA + posa : dmy; LAS u64d* wb_ = (psb && posb < 512) ? lB + posb : dmy; \
                *wa_ = ((u64d)(unsigned)key << 32) | u0; *wb_ = ((u64d)(unsigned)key << 32) | u1; \
                cntA += hi ? __popc(mha) : __popc(mla); cntB += hi ? __popc(mhb) : __popc(mlb); } while (0)
#define D3_STEP(k_, STNEXT, STFREE) do { \
            STFREE = D3_LOAD((k_) + 4); \
            const int tp_ = 2 * (k_) - 2 + par; \
            const LAS unsigned char* sb = lds + D3_RING + ((k_) & 1) * 8192 + par * 4096; bf16x8 bk[4]; \
            _Pragma("unroll") for (int ks = 0; ks < 4; ++ks) bk[ks] = *(const LAS bf16x8*)(sb + ks * 1024 + lane * 16); \
            __builtin_amdgcn_sched_barrier(0); \
            float s0, s1; D3_SUMS(s0, s1); asm volatile("" : "+v"(s0), "+v"(s1));     \
            __builtin_amdgcn_sched_barrier(0); \
            _Pragma("unroll") for (int r = 0; r < 16; ++r) acc[r] = 0.f; \
            _Pragma("unroll") for (int ks = 0; ks < 4; ++ks) acc = __builtin_amdgcn_mfma_f32_32x32x16_bf16(aq[ks], bk[ks], acc, 0, 0, 0); \
            __builtin_amdgcn_sched_barrier(0); \
            if (tp_ >= 0 && tp_ < ntile) D3_FILTER(tp_, s0, s1); \
            *(LAS v4u*)(lds + D3_RING + (((k_) + 1) & 1) * 8192 + tid * 16) = STNEXT; \
            asm volatile("s_waitcnt lgkmcnt(0)" ::: "memory"); __builtin_amdgcn_s_barrier(); asm volatile("" ::: "memory"); } while (0)
        int kend = 0;
        for (int k = 0; k < nstep; k += 4) {
            D3_STEP(k, st1, st0); D3_STEP(k + 1, st2, st1); D3_STEP(k + 2, st3, st2); D3_STEP(k + 3, st0, st3); kend = k + 4;
        }
        {   const int tp_ = 2 * kend - 2 + par; if (tp_ < ntile) { float s0, s1; D3_SUMS(s0, s1); D3_FILTER(tp_, s0, s1); } }
#undef D3_SUMS
#undef D3_FILTER
#undef D3_STEP
#undef D3_LOAD
        if (r32 == 0) { CNT[(4 * qgrp + 2 * hi) * 2 + par] = cntA; CNT[(4 * qgrp + 2 * hi + 1) * 2 + par] = cntB; }
        if (tid < 4) CNT[48 + tid] = 0;
    }
#undef D3_SCORE
    __syncthreads();
#if defined(DBG_D3_STAGE) && DBG_D3_STAGE == 1
    for (int grp = 0; grp < 4; ++grp) dsa2_unit(b, 4 * g16 + grp, IQ, IK, IW, DQ, DK, DV, OB, lds, wave, lane);
    return;
#endif
#pragma unroll 1
    for (int rr = 0; rr < 2 * REP_B; ++rr) {
        const int qx = wave + 8 * (rr & 1), q = q0 + qx, n = q + 1; LAS unsigned short* lst = LST + qx * 256; int nsel;
        if (n <= 256) { for (int i = lane; i < n; i += 64) lst[i] = (unsigned short)i; nsel = n; }
        else {
            const int c0 = CNT[2 * qx], c1 = CNT[2 * qx + 1]; const int c = c0 + c1;
#ifdef DBG_D3_ALLFAIL
            if (true) { if (lane == 0) CNT[48 + (qx >> 2)] = 1; nsel = 0; }
#else
            if (c0 > 512 || c1 > 512 || c < 256) { if (lane == 0) CNT[48 + (qx >> 2)] = 1; nsel = 0; }
#endif
            else {
                unsigned uu[16], id[16]; const LAS u64d* L0 = LISTS + (qx * 2) * 512; const LAS u64d* L1 = L0 + 512;
#pragma unroll
                for (int k = 0; k < 16; ++k) { const int j = k * 64 + lane, jj = j < c ? j : c - 1;
                    const u64d e = *((jj < c0) ? (L0 + jj) : (L1 + (jj - c0))); uu[k] = j < c ? (unsigned)e : 0u; id[k] = (unsigned)(e >> 32); }
                const unsigned lb = (unsigned)CNT[64 + qx] << 16;
                if (c <= 512) select_cands<8>(uu, id, lst, lane, lb); else if (c <= 640) select_cands<10>(uu, id, lst, lane, lb); else if (c <= 768) select_cands<12>(uu, id, lst, lane, lb); else select_cands<16>(uu, id, lst, lane, lb);
                nsel = 256;
            }
        }
        if (lane == 0) CNT[32 + qx] = nsel;
    }
    __syncthreads();
#pragma unroll 1
    for (int rr_ = 0; rr_ < 2 * REP_CD; ++rr_) { const int rr = rr_ & 1;
        const int qx = wave + 8 * rr, q = q0 + qx; const int nsel = CNT[32 + qx];
        const LAS unsigned short* lst = LST + qx * 256;
        LAS unsigned char* tile = lds + wave * 16384; LAS float* tf = (LAS float*)tile;
        const int l15 = lane & 15, kq = lane >> 4, q_ = l15 >> 2, p_ = lane & 3;
        bf16x8 qf[2];
#pragma unroll
        for (int ks = 0; ks < 2; ++ks) { v4u z = (v4u){0u, 0u, 0u, 0u}; if (l15 < 8) z = *(const v4u*)(DQ + (rowbase + q) * 512 + l15 * 64 + 32 * ks + 8 * kq); qf[ks] = __builtin_bit_cast(bf16x8, z); }
        float mrun = -INFINITY, lrun = 0.f; f32x4d orun[4];
#pragma unroll
        for (int cb = 0; cb < 4; ++cb) orun[cb] = (f32x4d){0.f, 0.f, 0.f, 0.f};
#pragma unroll 1
        for (int hf = 0; hf < 2; ++hf) {
            const int j0 = 128 * hf; int cntk = nsel - j0; cntk = cntk > 128 ? 128 : cntk;
            if (cntk <= 0) break;
            int iv[16], ik[8];
#pragma unroll
            for (int it = 0; it < 16; ++it) { int j = j0 + 8 * it + (lane >> 3); j = j < nsel ? j : nsel - 1; iv[it] = (int)lst[j]; }
#pragma unroll
            for (int g = 0; g < 8; ++g) { int j = j0 + 16 * g + l15; j = j < nsel ? j : nsel - 1; ik[g] = (int)lst[j]; }
            asm volatile("s_waitcnt lgkmcnt(0)" ::: "memory");
#pragma unroll
            for (int it = 0; it < 16; ++it)
                __builtin_amdgcn_global_load_lds((const unsigned*)(DV + (rowbase + iv[it]) * 64 + 8 * (lane & 7)), (LAS unsigned*)(tile + it * 1024), 16, 0, 0);
            bf16x8 kk0[8], kk1[8];
#pragma unroll
            for (int g = 0; g < 8; ++g) { const bf16* kp = DK + (rowbase + ik[g]) * 64 + 8 * kq; kk0[g] = *(const bf16x8*)(kp); kk1[g] = *(const bf16x8*)(kp + 32); }
            asm volatile("" ::: "memory");
            f32x4d acc[8];
#pragma unroll
            for (int g = 0; g < 8; ++g) { f32x4d a = (f32x4d){0.f, 0.f, 0.f, 0.f};
                a = __builtin_amdgcn_mfma_f32_16x16x32_bf16(kk0[g], qf[0], a, 0, 0, 0); a = __builtin_amdgcn_mfma_f32_16x16x32_bf16(kk1[g], qf[1], a, 0, 0, 0); acc[g] = a; }
            float mx = -INFINITY;
#pragma unroll
            for (int g = 0; g < 8; ++g)
#pragma unroll
                for (int e = 0; e < 4; ++e) { if (16 * g + 4 * kq + e >= cntk) acc[g][e] = -INFINITY; mx = fmaxf(mx, acc[g][e]); }
            mx = fmaxf(mx, __shfl_xor(mx, 16)); mx = fmaxf(mx, __shfl_xor(mx, 32));
            const float mnew = fmaxf(mrun, mx), fold = __builtin_amdgcn_exp2f(mrun - mnew);
            float ls = 0.f;
#pragma unroll
            for (int g = 0; g < 8; ++g)
#pragma unroll
                for (int e = 0; e < 4; ++e) { acc[g][e] = __builtin_amdgcn_exp2f(acc[g][e] - mnew); ls += acc[g][e]; }
            ls += __shfl_xor(ls, 16); ls += __shfl_xor(ls, 32);
            lrun = lrun * fold + ls; mrun = mnew;
            float fo[4];
#pragma unroll
            for (int e = 0; e < 4; ++e) fo[e] = __shfl(fold, 4 * kq + e);
            asm volatile("s_waitcnt vmcnt(0)" ::: "memory");
            bf16x8 pa[4];
#pragma unroll
            for (int t = 0; t < 4; ++t) { v4u w; w.x = cvtpk(acc[2 * t][0], acc[2 * t][1]); w.y = cvtpk(acc[2 * t][2], acc[2 * t][3]); w.z = cvtpk(acc[2 * t + 1][0], acc[2 * t + 1][1]); w.w = cvtpk(acc[2 * t + 1][2], acc[2 * t + 1][3]); pa[t] = __builtin_bit_cast(bf16x8, w); }
#pragma unroll
            for (int cb = 0; cb < 4; ++cb) { f32x4d oc = orun[cb];
#pragma unroll
                for (int e = 0; e < 4; ++e) oc[e] *= fo[e];
#pragma unroll
                for (int t = 0; t < 4; ++t) {
                    const LAS unsigned char* a1 = tile + (32 * t + 4 * kq + q_) * 128 + (16 * cb + 4 * p_) * 2;
                    const v4i16_t lo4 = __builtin_amdgcn_ds_read_tr16_b64_v4i16((LAS v4i16_t*)a1), hi4 = __builtin_amdgcn_ds_read_tr16_b64_v4i16((LAS v4i16_t*)(a1 + 16 * 128));
                    const bf16x8 vf = (bf16x8){lo4[0], lo4[1], lo4[2], lo4[3], hi4[0], hi4[1], hi4[2], hi4[3]};
                    oc = __builtin_amdgcn_mfma_f32_16x16x32_bf16(pa[t], vf, oc, 0, 0, 0); }
                orun[cb] = oc; }
        }
        float li[4];
#pragma unroll
        for (int e = 0; e < 4; ++e) li[e] = 1.0f / __shfl(lrun, 4 * kq + e);
        if (kq < 2) {
#pragma unroll
            for (int cb = 0; cb < 4; ++cb)
#pragma unroll
                for (int e = 0; e < 4; ++e) tf[(4 * kq + e) * 64 + 16 * cb + l15] = orun[cb][e] * li[e];
        }
        { const int h = lane >> 3, d0 = (lane & 7) * 8;
          const f32x4 r0 = *(const LAS f32x4*)(tf + h * 64 + d0), r1 = *(const LAS f32x4*)(tf + h * 64 + d0 + 4);
          v4u w; w.x = cvtpk(r0[0], r0[1]); w.y = cvtpk(r0[2], r0[3]); w.z = cvtpk(r1[0], r1[1]); w.w = cvtpk(r1[2], r1[3]);
          *(v4u*)(OB + (rowbase + q) * 512 + h * 64 + d0) = w; }
    }
    __syncthreads();
    const int f0 = CNT[48], f1 = CNT[49], f2 = CNT[50], f3 = CNT[51];
    __syncthreads();
    const int fm = (f0 ? 1 : 0) | (f1 ? 2 : 0) | (f2 ? 4 : 0) | (f3 ? 8 : 0);
#pragma unroll 1
    for (int grp = 0; grp < 4; ++grp) if ((fm >> grp) & 1) dsa2_unit(b, 4 * g16 + grp, IQ, IK, IW, DQ, DK, DV, OB, lds, wave, lane);
}
__device__ __forceinline__ void fox_unit2(int bh, int qb, const bf16* FQ, const bf16* FK, const bf16* FV, const float* CUM, const int* T0, bf16* OA, LAS unsigned char* lds, int wave, int lane) {
    const int b = bh >> 3, h = bh & 7, r32 = lane & 31, hi = lane >> 5; const size_t rowbase = (size_t)b * SEQ; const int q0 = qb * 256 + wave * 32;
    const bf16* Qw = FQ + (rowbase + q0) * 512 + h * 64; bf16* Ow = OA + (rowbase + q0) * 512 + h * 64;
    const bf16* Kp = FK + rowbase * 512 + h * 64; const bf16* Vp = FV + rowbase * 512 + h * 64; const float* cb = CUM + (size_t)bh * SEQ;
    LAS unsigned char* wl = lds + wave * 16384;
    LAS float* bl = (LAS float*)(lds + RING_BYTES + 8192 + wave * 256);
    bf16x8 qr[4];
#pragma unroll
    for (int ks = 0; ks < 4; ++ks) qr[ks] = *(const bf16x8*)(Qw + (size_t)r32 * 512 + ks * 16 + hi * 8);
    const int tstart = T0[bh * 256 + q0 / 32], ntiles = q0 / 32 + 1, qlocal = q0 + r32;
    f32x16 o[2];
#pragma unroll
    for (int d0 = 0; d0 < 2; ++d0)
#pragma unroll
        for (int r = 0; r < 16; ++r) o[d0][r] = 0.f;
    float m = -1e30f, l = 0.f;
    const int lrow = lane >> 3, lch = lane & 7;
#define FOX_LOAD(KR, VR, BR, tt) do { _Pragma("unroll") for (int it = 0; it < 4; ++it) { const size_t ro = (size_t)(32 * (tt) + 8 * it + lrow) * 512 + lch * 8; KR[it] = *(const v4u*)(Kp + ro); VR[it] = *(const v4u*)(Vp + ro); } BR = cb[32 * (tt) + r32]; } while (0)
#define FOX_STORE(KR, VR, BR, bf) do { _Pragma("unroll") for (int it = 0; it < 4; ++it) { const int row = 8 * it + lrow; *(LAS v4u*)(wl + (bf) * 4096 + row * 128 + ((lch ^ (row & 7)) * 16)) = KR[it]; *(LAS v4u*)(wl + 8192 + (bf) * 4096 + row * 128 + lch * 16) = VR[it]; } if (lane < 32) bl[(bf) * 32 + lane] = -L2E * BR; } while (0)
    v4u krA[4], vrA[4], krB[4], vrB[4]; float brA = 0.f, brB = 0.f;
    const int kq = (lane >> 4) & 1, q_ = (lane & 15) >> 2, p_ = lane & 3;
    FOX_LOAD(krA, vrA, brA, tstart);
    if (tstart + 1 < ntiles) FOX_LOAD(krB, vrB, brB, tstart + 1);
    FOX_STORE(krA, vrA, brA, 0);
    auto compute = [&](int t, int buf) {
        const LAS unsigned char* kb = wl + buf * 4096; const LAS unsigned char* vb = wl + 8192 + buf * 4096; const LAS float* bb = bl + buf * 32;
        f32x16 p;
#pragma unroll
        for (int r = 0; r < 16; ++r) p[r] = 0.f;
#pragma unroll
        for (int ks = 0; ks < 4; ++ks) { const bf16x8 kf = *(const LAS bf16x8*)(kb + r32 * 128 + (((2 * ks + hi) ^ (r32 & 7)) * 16)); p = __builtin_amdgcn_mfma_f32_32x32x16_bf16(kf, qr[ks], p, 0, 0, 0); }
#pragma unroll
        for (int g = 0; g < 4; ++g) { const f32x4 c4 = *(const LAS f32x4*)(bb + 8 * g + 4 * hi);
#pragma unroll
            for (int jj = 0; jj < 4; ++jj) p[4 * g + jj] += c4[jj]; }
        if (t == ntiles - 1) {
#pragma unroll
            for (int r = 0; r < 16; ++r) if (32 * t + crow(r, hi) > qlocal) p[r] = -INFINITY;
        }
        float mt = p[0];
#pragma unroll
        for (int r = 1; r < 16; ++r) mt = fmaxf(mt, p[r]);
        mt = fmaxf(mt, __shfl_xor(mt, 32));
        const float mn = fmaxf(m, mt); const float alpha = __builtin_amdgcn_exp2f(m - mn); m = mn;
        l *= alpha;
#pragma unroll
        for (int d0 = 0; d0 < 2; ++d0)
#pragma unroll
            for (int r = 0; r < 16; ++r) o[d0][r] *= alpha;
        float ls = 0.f;
#pragma unroll
        for (int r = 0; r < 16; ++r) { p[r] = __builtin_amdgcn_exp2f(p[r] - mn); ls += p[r]; }
        l += ls;
        bf16x8 pa[2];
#pragma unroll
        for (int s2 = 0; s2 < 2; ++s2) { v4u w; w.x = cvtpk(p[8 * s2 + 0], p[8 * s2 + 1]); w.y = cvtpk(p[8 * s2 + 2], p[8 * s2 + 3]); w.z = cvtpk(p[8 * s2 + 4], p[8 * s2 + 5]); w.w = cvtpk(p[8 * s2 + 6], p[8 * s2 + 7]); pa[s2] = __builtin_bit_cast(bf16x8, w); }
#pragma unroll
        for (int d0 = 0; d0 < 2; ++d0)
#pragma unroll
            for (int s2 = 0; s2 < 2; ++s2) {
                const LAS unsigned char* a1 = vb + (16 * s2 + 4 * hi + q_) * 128 + (32 * d0 + 16 * kq + 4 * p_) * 2;
                const v4i16_t lo4 = __builtin_amdgcn_ds_read_tr16_b64_v4i16((LAS v4i16_t*)a1), hi4 = __builtin_amdgcn_ds_read_tr16_b64_v4i16((LAS v4i16_t*)(a1 + 8 * 128));
                const bf16x8 vf = (bf16x8){lo4[0], lo4[1], lo4[2], lo4[3], hi4[0], hi4[1], hi4[2], hi4[3]};
                o[d0] = __builtin_amdgcn_mfma_f32_32x32x16_bf16(vf, pa[s2], o[d0], 0, 0, 0);
            }
    };
    for (int t = tstart; t < ntiles; t += 2) {
        if (t + 2 < ntiles) FOX_LOAD(krA, vrA, brA, t + 2);
        compute(t, 0);
        if (t + 1 < ntiles) {
            FOX_STORE(krB, vrB, brB, 1);
            if (t + 3 < ntiles) FOX_LOAD(krB, vrB, brB, t + 3);
            compute(t + 1, 1);
            if (t + 2 < ntiles) FOX_STORE(krA, vrA, brA, 0);
        }
    }
#undef FOX_LOAD
#undef FOX_STORE
    l += __shfl_xor(l, 32);
    const float inv = 1.0f / l;
    bf16* orow = Ow + (size_t)r32 * 512;
#pragma unroll
    for (int d0 = 0; d0 < 2; ++d0)
#pragma unroll
        for (int g = 0; g < 4; ++g) { u32x2 w; w.x = cvtpk(o[d0][4 * g] * inv, o[d0][4 * g + 1] * inv); w.y = cvtpk(o[d0][4 * g + 2] * inv, o[d0][4 * g + 3] * inv);
            *(u32x2*)(orow + d0 * 32 + 8 * g + 4 * hi) = w; }
}
__device__ __forceinline__ void fox_unit4(int bh, int qb, const bf16* FQ, const bf16* FK, const bf16* FV, const float* CUM, const int* T0, const float* gq, const float* gk, bf16* OA, LAS unsigned char* lds, int wave, int lane) {
    const int b = bh >> 3, h = bh & 7, r32 = lane & 31, hi = lane >> 5; const size_t rowbase = (size_t)b * SEQ; const int q0 = qb * 256 + wave * 32;
    const bf16* Qw = FQ + (rowbase + q0) * 512 + h * 64; bf16* Ow = OA + (rowbase + q0) * 512 + h * 64;
    const bf16* Kp = FK + rowbase * 512 + h * 64; const bf16* Vp = FV + rowbase * 512 + h * 64; const float* cb = CUM + (size_t)bh * SEQ;
    LAS unsigned char* wl = lds + wave * 16384;
    LAS float* bl = (LAS float*)(lds + RING_BYTES + 8192 + wave * 256);
    bf16x8 qr[4];
#pragma unroll
    for (int ks = 0; ks < 4; ++ks) qr[ks] = *(const bf16x8*)(Qw + (size_t)r32 * 512 + ks * 16 + hi * 8);
    const int tstart = T0[bh * 256 + q0 / 32], tlast = q0 / 32, nseq = tlast - tstart + 1, qlocal = q0 + r32;
    const float stopc = (8.0f * wave_max(fabsf(gq[lane])) * wave_max(fabsf(gk[lane])) + 30.0f) * L2E;
    f32x16 o[2];
#pragma unroll
    for (int d0 = 0; d0 < 2; ++d0)
#pragma unroll
        for (int r = 0; r < 16; ++r) o[d0][r] = 0.f;
    float m = -1e30f, l = 0.f;
    const int lrow = lane >> 3, lch = lane & 7;
#define FOX_LOAD(KR, VR, BR, tt) do { _Pragma("unroll") for (int it = 0; it < 4; ++it) { const size_t ro = (size_t)(32 * (tt) + 8 * it + lrow) * 512 + lch * 8; KR[it] = *(const v4u*)(Kp + ro); VR[it] = *(const v4u*)(Vp + ro); } BR = cb[32 * (tt) + r32]; } while (0)
#define FOX_STORE(KR, VR, BR, bf) do { _Pragma("unroll") for (int it = 0; it < 4; ++it) { const int row = 8 * it + lrow; *(LAS v4u*)(wl + (bf) * 4096 + row * 128 + ((lch ^ (row & 7)) * 16)) = KR[it]; *(LAS v4u*)(wl + 8192 + (bf) * 4096 + row * 128 + lch * 16) = VR[it]; } if (lane < 32) bl[(bf) * 32 + lane] = -L2E * BR; } while (0)
    v4u krA[4], vrA[4], krB[4], vrB[4]; float brA = 0.f, brB = 0.f;
    const int kq = (lane >> 4) & 1, q_ = (lane & 15) >> 2, p_ = lane & 3;
    FOX_LOAD(krA, vrA, brA, tlast);
    if (1 < nseq) FOX_LOAD(krB, vrB, brB, tlast - 1);
    FOX_STORE(krA, vrA, brA, 0);
    auto compute = [&](int t, int buf) -> bool {
        const LAS unsigned char* kb = wl + buf * 4096; const LAS unsigned char* vb = wl + 8192 + buf * 4096; const LAS float* bb = bl + buf * 32;
        if (t != tlast) { const float bmax = bb[31]; if (__all(m > bmax + stopc)) return true; }
        f32x16 p;
#pragma unroll
        for (int r = 0; r < 16; ++r) p[r] = 0.f;
#pragma unroll
        for (int ks = 0; ks < 4; ++ks) { const bf16x8 kf = *(const LAS bf16x8*)(kb + r32 * 128 + (((2 * ks + hi) ^ (r32 & 7)) * 16)); p = __builtin_amdgcn_mfma_f32_32x32x16_bf16(kf, qr[ks], p, 0, 0, 0); }
#pragma unroll
        for (int g = 0; g < 4; ++g) { const f32x4 c4 = *(const LAS f32x4*)(bb + 8 * g + 4 * hi);
#pragma unroll
            for (int jj = 0; jj < 4; ++jj) p[4 * g + jj] += c4[jj]; }
        if (t == tlast) {
#pragma unroll
            for (int r = 0; r < 16; ++r) if (32 * t + crow(r, hi) > qlocal) p[r] = -INFINITY;
        }
        float mt = p[0];
#pragma unroll
        for (int r = 1; r < 16; ++r) mt = fmaxf(mt, p[r]);
        mt = fmaxf(mt, __shfl_xor(mt, 32));
        if (__any(mt > m)) {
            const float mn = fmaxf(m, mt); const float alpha = __builtin_amdgcn_exp2f(m - mn); m = mn;
            l *= alpha;
#pragma unroll
            for (int d0 = 0; d0 < 2; ++d0)
#pragma unroll
                for (int r = 0; r < 16; ++r) o[d0][r] *= alpha;
        }
        const float mn = m;
        float ls = 0.f;
#pragma unroll
        for (int r = 0; r < 16; ++r) { p[r] = __builtin_amdgcn_exp2f(p[r] - mn); ls += p[r]; }
        l += ls;
        bf16x8 pa[2];
#pragma unroll
        for (int s2 = 0; s2 < 2; ++s2) { v4u w; w.x = cvtpk(p[8 * s2 + 0], p[8 * s2 + 1]); w.y = cvtpk(p[8 * s2 + 2], p[8 * s2 + 3]); w.z = cvtpk(p[8 * s2 + 4], p[8 * s2 + 5]); w.w = cvtpk(p[8 * s2 + 6], p[8 * s2 + 7]); pa[s2] = __builtin_bit_cast(bf16x8, w); }
#pragma unroll
        for (int d0 = 0; d0 < 2; ++d0)
#pragma unroll
            for (int s2 = 0; s2 < 2; ++s2) {
                const LAS unsigned char* a1 = vb + (16 * s2 + 4 * hi + q_) * 128 + (32 * d0 + 16 * kq + 4 * p_) * 2;
                const v4i16_t lo4 = __builtin_amdgcn_ds_read_tr16_b64_v4i16((LAS v4i16_t*)a1), hi4 = __builtin_amdgcn_ds_read_tr16_b64_v4i16((LAS v4i16_t*)(a1 + 8 * 128));
                const bf16x8 vf = (bf16x8){lo4[0], lo4[1], lo4[2], lo4[3], hi4[0], hi4[1], hi4[2], hi4[3]};
                o[d0] = __builtin_amdgcn_mfma_f32_32x32x16_bf16(vf, pa[s2], o[d0], 0, 0, 0);
            }
        return false;
    };
    for (int i = 0; i < nseq; i += 2) {
        if (i + 2 < nseq) FOX_LOAD(krA, vrA, brA, tlast - (i + 2));
        if (compute(tlast - i, 0)) break;
        if (i + 1 < nseq) {
            FOX_STORE(krB, vrB, brB, 1);
            if (i + 3 < nseq) FOX_LOAD(krB, vrB, brB, tlast - (i + 3));
            if (compute(tlast - (i + 1), 1)) break;
            if (i + 2 < nseq) FOX_STORE(krA, vrA, brA, 0);
        }
    }
#undef FOX_LOAD
#undef FOX_STORE
    l += __shfl_xor(l, 32);
    const float inv = 1.0f / l;
    bf16* orow = Ow + (size_t)r32 * 512;
#pragma unroll
    for (int d0 = 0; d0 < 2; ++d0)
#pragma unroll
        for (int g = 0; g < 4; ++g) { u32x2 w; w.x = cvtpk(o[d0][4 * g] * inv, o[d0][4 * g + 1] * inv); w.y = cvtpk(o[d0][4 * g + 2] * inv, o[d0][4 * g + 3] * inv);
            *(u32x2*)(orow + d0 * 32 + 8 * g + 4 * hi) = w; }
}
#ifndef DBG_BRANCH_MASK
#define DBG_BRANCH_MASK 7
#endif
#ifndef DBG_NBR
#define DBG_NBR 3
#endif
#ifndef DBG_NOGATE
#define DBG_NOGATE 0
#endif
#ifndef DBG_NOBRANCH
#define DBG_NOBRANCH 0
#endif
#ifndef DBG_GATE_W
#define DBG_GATE_W WS_WGATE
#endif
#ifndef DBG_GATE_AS_BRANCH
#define DBG_GATE_AS_BRANCH 0
#endif
#ifndef REP_FOX
#define REP_FOX 1
#endif
#ifndef REP_DSA
#define REP_DSA 1
#endif
#ifndef REP_GEMM
#define REP_GEMM 1
#endif
#ifndef DBG_SUBST
#define DBG_SUBST 0
#endif
#ifndef P7SEL
#define P7SEL 3
#endif
#ifndef PHMASK
#define PHMASK 0xFFFF
#endif
struct Args { const void* in[24]; float* out; unsigned char* ws; };
#define CONVERT_GROUP(GRP, w_, nw_) do { \
    constexpr int I_GU = 16 * 176, I_D = 44 * 32, I_IN = 16 * 104, I_GT = 16 * 96, I_BR = 8 * 32, I_SQ = 16 * 32; \
    constexpr int NIT = (GRP) == 0 ? I_GU + I_SQ : (GRP) == 1 ? I_D + I_IN + I_GT + 3 * I_BR + I_SQ : I_GU + I_D; \
    LAS float* scr_ = (LAS float*)(L + RING_OFF + wave * 16384); \
    for (int it = (w_); it < NIT; it += (nw_)) { int r = it; \
        if ((GRP) == 0) { \
            if (r < I_GU) { transpose_item<true>(0, ARG_IN(4), ARG_IN(5), 1024, DFF, ARG_IN(3), WSP(bf16, WS_WGU1), scr_, r, 176, lane); continue; } r -= I_GU; \
            transpose_item<true>(1, ARG_IN(17), nullptr, 1024, 1024, ARG_IN(8), WSP(bf16, WS_WMKV), scr_, r, 32, lane); \
        } else if ((GRP) == 1) { \
            if (r < I_D) { transpose_item<false>(1, ARG_IN(6), nullptr, DFF, 1024, nullptr, WSP(bf16, WS_WD1), scr_, r, 32, lane); continue; } r -= I_D; \
            if (r < I_IN) { transpose_item<true>(2, ARG_IN(9), nullptr, 1024, DIN, ARG_IN(7), WSP(bf16, WS_WIN), scr_, r, 104, lane); continue; } r -= I_IN; \
            if (r < I_GT) { transpose_item<true>(3, ARG_IN(9), nullptr, 1024, DIN, ARG_IN(7), WSP(bf16, WS_WGATE), scr_, r, 96, lane); continue; } r -= I_GT; \
            if (r < 3 * I_BR) { const int i = r / I_BR; transpose_item<false>(1, ARG_IN(18) + (size_t)i * 512 * 1024, nullptr, 512, 1024, nullptr, WSP(bf16, WS_WBR) + (size_t)i * 1024 * 512, scr_, r % I_BR, 32, lane); continue; } r -= 3 * I_BR; \
            transpose_item<false>(1, ARG_IN(19), nullptr, 1024, 1024, nullptr, WSP(bf16, WS_WOUT), scr_, r, 32, lane); \
        } else { \
            if (r < I_GU) { transpose_item<true>(0, ARG_IN(21), ARG_IN(22), 1024, DFF, ARG_IN(20), WSP(bf16, WS_WGU2), scr_, r, 176, lane); continue; } r -= I_GU; \
            transpose_item<false>(1, ARG_IN(23), nullptr, DFF, 1024, nullptr, WSP(bf16, WS_WD2), scr_, r, 32, lane); \
        } } } while (0)
__global__ void __launch_bounds__(NWAVES * 64, 2) fwd_mega(Args args) {
    extern __shared__ __attribute__((aligned(16))) unsigned char lds[];
    LAS unsigned char* L = (LAS unsigned char*)lds;
    volatile LAS unsigned* MISC = (volatile LAS unsigned*)(L + MISC_OFF);
    const int tid = threadIdx.x, lane = tid & 63, wave = __builtin_amdgcn_readfirstlane(tid >> 6);
    const int G = gridDim.x; const int bx = blockIdx.x; const int vcu = (G % 8 == 0) ? (bx % 8) * (G / 8) + bx / 8 : bx;
    const Args* ap = (const Args*)__builtin_amdgcn_kernarg_segment_ptr();
#define ARG_IN(k) ((const float*)ap->in[k])
#define WSP(type, off) ((type*)(ap->ws + (off)))
    gu32* ctl = (gu32*)(ap->ws + WS_CTL);
    for (int u = tid; u < (LDS_BYTES - LDSCTL_OFF) / 4; u += NWAVES * 64) ((LAS unsigned*)(L + LDSCTL_OFF))[u] = 0u;
    __syncthreads();
    XcdBarrier bar = xcd_barrier_post((unsigned*)(ctl + CW_BAR), MISC + 8);
#define GRID_BAR() xcd_barrier(bar)
    const int gw = vcu * NWAVES + wave, NGW = G * NWAVES;

#if (PHMASK >> 0) & 1
    {
        LAS float* scr = (LAS float*)(L + RING_OFF + wave * 16384);
        CONVERT_GROUP(0, gw, NGW);
        for (int m0 = gw; m0 < T + 512; m0 += 4 * NGW) {
            const float* xr[4]; bf16* orw[4]; float* ro[4]; bool ok[4];
#pragma unroll
            for (int r = 0; r < 4; ++r) { const int m = m0 + r * NGW; ok[r] = m < T + 512; const int mc = ok[r] ? m : gw;
                if (mc < T) { xr[r] = ARG_IN(0) + (size_t)mc * 1024; orw[r] = WSP(bf16, WS_HB) + (size_t)mc * 1024; ro[r] = WSP(float, WS_RSTDX) + mc; }
                else { xr[r] = ARG_IN(1) + (size_t)(mc - T) * 1024; orw[r] = WSP(bf16, WS_MEMB) + (size_t)(mc - T) * 1024; ro[r] = WSP(float, WS_RSTDM) + (mc - T); } }
            rows4_to_bf16_rstd(xr, orw, ro, ok, lane);
        }
        VM_WAIT(); __syncthreads();
        GRID_BAR();
    }
#endif
#if (PHMASK >> 1) & 1
    {
        if (bx >= G - 8) { pg8::Gemm g{WSP(bf16, WS_MEMB), WSP(bf16, WS_WMKV), 512, 1024, 1024}; pg8::StaticOrder S; S.init(512, 1024, G, bx - (G - 8));
        pg8::EpiMemKV E{WSP(float, WS_KVM), WSP(float, WS_RSTDM)};
        pg8::gemm_phase<pg8::EpiMemKV, pg8::StaticOrder, true, true>(L + RING_OFF, g, S, E); }
    }
#endif
#if (PHMASK >> 2) & 1
    {
        pg8::Gemm g{WSP(bf16, WS_HB), WSP(bf16, WS_WGU1), T, 2 * DFF, 1024}; pg8::StaticOrder S; S.init(T, 2 * DFF, G, bx);
        pg8::build_row_tab<0>(WSP(float, WS_RSTDX), S, (LAS float*)(L + RING_BYTES + 1024)); pg8::EpiSwiGLU<0> E{WSP(bf16, WS_HID), DFF, (LAS float*)(L + RING_BYTES + 1024)};
#pragma unroll 1
        for (int rep_ = 0; rep_ < REP_GEMM; ++rep_)
        pg8::gemm_phase<pg8::EpiSwiGLU<0>, pg8::StaticOrder, true, true>(L + RING_OFF, g, S, E);
        {
            const int nfull = (64 * 22) % G; const int nidle = (nfull == 0) ? G : G - nfull; const int first = G - nidle;
            const int nconv = nidle > 8 ? nidle - 8 : nidle; const bool conv = (bx >= first) && (bx - first < nconv);
            if (conv) { CONVERT_GROUP(1, (bx - first) * NWAVES + wave, nconv * NWAVES);
                for (int e = (bx - first) * NWAVES * 64 + tid; e < T * 32; e += nconv * NWAVES * 64) {
                    const int row = e >> 5, i = e & 31; const float inv_freq = powf(10000.0f, -(float)i * (1.0f / 32.0f));
                    const float ang = (float)((const int*)ap->in[2])[row] * inv_freq; float sn, cs; sincosf(ang, &sn, &cs); WSP(float, WS_COS)[e] = cs; WSP(float, WS_SIN)[e] = sn; } }
        }
        GRID_BAR();
    }
#endif
#if (PHMASK >> 3) & 1
    {
        pg8::Gemm g{WSP(bf16, WS_HID), WSP(bf16, WS_WD1), T, 1024, DFF}; pg8::StaticOrder S; S.init(T, 1024, G, bx);
        pg8::EpiResid3<1> E{nullptr, nullptr, WSP(bf16, WS_HB), WSP(float, WS_SSQ1), 0.5f};
#pragma unroll 1
        for (int rep_ = 0; rep_ < REP_GEMM; ++rep_)
        pg8::gemm_phase<pg8::EpiResid3<1>, pg8::StaticOrder, true, true>(L + RING_OFF, g, S, E);
        GRID_BAR();
    }
#endif
#if (PHMASK >> 4) & 1
    {
        pg8::Gemm g{WSP(bf16, WS_HB), WSP(bf16, WS_WIN), T, NPROJ, 1024}; pg8::StaticOrder S; S.init(T, NPROJ, G, bx);
        pg8::ProjOut PO{WSP(bf16, WS_FQ), WSP(bf16, WS_FK), WSP(bf16, WS_FV), WSP(bf16, WS_DQ), WSP(bf16, WS_IQ), WSP(bf16, WS_MQ), WSP(bf16, WS_DK), WSP(bf16, WS_DV), WSP(bf16, WS_IK), WSP(float, WS_LOGF), WSP(float, WS_IW), WSP(float, WS_COS), WSP(float, WS_SIN), ARG_IN(11), ARG_IN(12), ARG_IN(13), ARG_IN(14), ARG_IN(10)};
        pg8::build_row_tab<16>(WSP(float, WS_SSQ1), S, (LAS float*)(L + RING_BYTES + 1024)); pg8::EpiProj<16> E{PO, (LAS float*)(L + RING_BYTES + 1024), C2_64};
#pragma unroll 1
        for (int rep_ = 0; rep_ < REP_GEMM; ++rep_)
        pg8::gemm_phase<pg8::EpiProj<16>, pg8::StaticOrder, true, true>(L + RING_OFF, g, S, E);
        {
            const int nfull = (64 * 13) % G; const int nidle = (nfull == 0) ? G : G - nfull; const int first = G - nidle;
            if (bx >= first) { CONVERT_GROUP(2, (bx - first) * NWAVES + wave, nidle * NWAVES);
        int lt_ = tid; asm volatile("" : "+v"(lt_)); const int lane = lt_ & 63;
        for (int it = (bx - first) * NWAVES + wave; it < 2048; it += nidle * NWAVES) { const int row = it >> 2, h = it & 3;
                    const f32x2g kv = *(const f32x2g*)(WSP(float, WS_KVM) + (size_t)row * 1024 + h * 128 + 2 * lane); const f32x2g vv = *(const f32x2g*)(WSP(float, WS_KVM) + (size_t)row * 1024 + 512 + h * 128 + 2 * lane);
                    const float ss = wave_sum(kv.x * kv.x + kv.y * kv.y); const float rstd = 1.0f / sqrtf(ss * (1.0f / 128.0f) + 1e-6f);
                    const f32x2g gk = *(const f32x2g*)(ARG_IN(16) + 2 * lane);
                    *(unsigned*)(WSP(bf16, WS_KMB) + (size_t)row * 512 + h * 128 + 2 * lane) = pk2(kv.x * rstd * gk.x, kv.y * rstd * gk.y);
                    *(unsigned*)(WSP(bf16, WS_VMB) + (size_t)row * 512 + h * 128 + 2 * lane) = pk2(vv.x, vv.y); } }
        }
        GRID_BAR();
#if defined(DBG_DUMP_AFTER) && DBG_DUMP_AFTER == 4
        {
            const bf16* sa = WSP(bf16, DBG_DUMP_A); const bf16* sb = WSP(bf16, DBG_DUMP_B);
            for (size_t e = (size_t)vcu * 512 + tid; e < (size_t)T * 512; e += (size_t)G * 512) { const size_t row = e >> 9, c = e & 511;
                ap->out[row * 1024 + c] = bf2f(sa[row * DBG_PITCH + c]); ap->out[row * 1024 + 512 + c] = bf2f(sb[row * DBG_PITCH + c]); }
            return;
        }
#endif

    }
#endif
#if ((PHMASK >> 5) & 1) && !DBG_SUBST
    {
        int lt_ = tid; asm volatile("" : "+v"(lt_)); const int lane = lt_ & 63;
        for (int u = vcu; u < 256; u += G) mem_block(u, WSP(bf16, WS_MQ), WSP(bf16, WS_KMB), WSP(bf16, WS_VMB), ARG_IN(15), L, wave, lane, tid);
    }
#endif
#if ((PHMASK >> 6) & 1) && !DBG_SUBST
    {
        int lt_ = tid; asm volatile("" : "+v"(lt_)); const int lane = lt_ & 63;
        for (int rep_ = 0; rep_ < REP_FOX; ++rep_)
        for (int v = vcu; v < 256; v += G) { const int bh = v >> 4, s = v & 15;
            scan_unit(bh, WSP(float, WS_LOGF), WSP(float, WS_CUM), WSP(int, WS_T0), ARG_IN(11), ARG_IN(12), (LAS float*)(L + SCANX_OFF), (LAS float*)(L + RING_OFF), tid);
            asm volatile("s_waitcnt vmcnt(0)" ::: "memory"); __syncthreads();
            fox_block(bh, s, WSP(bf16, WS_FQ), WSP(bf16, WS_FK), WSP(bf16, WS_FV), WSP(float, WS_CUM), WSP(int, WS_T0), ARG_IN(11), ARG_IN(12), WSP(bf16, WS_OA), L, wave, lane, tid); fox_block(bh, 31 - s, WSP(bf16, WS_FQ), WSP(bf16, WS_FK), WSP(bf16, WS_FV), WSP(float, WS_CUM), WSP(int, WS_T0), ARG_IN(11), ARG_IN(12), WSP(bf16, WS_OA), L, wave, lane, tid); }
        __syncthreads();
        {
            gu32* qctr = ctl + CW_Q; LAS int* QW = (LAS int*)(L + D3_QW);
            const int pref = (vcu >> 5) & 1;
            unsigned raw = 0u; int cur;
            if (tid == 0) { unsigned u = __hip_atomic_fetch_add(qctr + 64 * pref, 1u, RLX_AGENT); int bsel = pref; if (u >= 512u) { bsel = pref ^ 1; u = __hip_atomic_fetch_add(qctr + 64 * bsel, 1u, RLX_AGENT); } QW[0] = (u < 512u) ? ((bsel << 16) | (int)u) : -1; }
            __syncthreads(); cur = QW[0]; __syncthreads();
            while (cur >= 0) {
                if (tid == 0) raw = __hip_atomic_fetch_add(qctr + 64 * pref, 1u, RLX_AGENT);
                dsa3_unit(cur >> 16, 511 - (cur & 0xffff), WSP(bf16, WS_IQ), WSP(bf16, WS_IK), WSP(float, WS_IW), WSP(bf16, WS_DQ), WSP(bf16, WS_DK), WSP(bf16, WS_DV), WSP(bf16, WS_OB), L, wave, lane);
                if (tid == 0) { unsigned u = raw; int bsel = pref; if (u >= 512u) { bsel = pref ^ 1; u = __hip_atomic_fetch_add(qctr + 64 * bsel, 1u, RLX_AGENT); } QW[0] = (u < 512u) ? ((bsel << 16) | (int)u) : -1; }
                __syncthreads(); cur = QW[0]; __syncthreads();
            }
        }
        GRID_BAR();
    }
#endif
#if (PHMASK >> 7) & 1
    {
        pg8::StaticOrder S; S.init(T, 1024, G, bx); pg8::build_row_tab<16>(WSP(float, WS_SSQ1), S, (LAS float*)(L + RING_BYTES + 1024));
#ifndef P7STREAM
#define P7STREAM 1
#endif
#if P7STREAM
        {   typedef pg8::P7Order<WS_HB, WS_WGATE, WS_OA, WS_OB, WS_MQ, WS_WBR> P7O; P7O O{S, (const char*)WSP(char, 0)};
            pg8::EpiP7 E{WSP(bf16, WS_GSCR), WSP(bf16, WS_MERGED), (LAS float*)(L + RING_BYTES + 1024)};
#ifndef REP_P7
#define REP_P7 1
#endif
#pragma unroll 1
            for (int rep7_ = 0; rep7_ < REP_P7; ++rep7_) pg8::gemm_stream<pg8::EpiP7, P7O>(L + RING_OFF, O, E); }
#pragma unroll 1
        for (int i = 0; i < 0; ++i) {
#else
#pragma unroll 1
        for (int rep_ = 0; rep_ < REP_GEMM; ++rep_)
#pragma unroll 1
        for (int i = 0; i < DBG_NBR; ++i) {
#endif
#if DBG_GATE_AS_BRANCH
            {   pg8::Gemm g{WSP(bf16, WS_HB), WSP(bf16, DBG_GATE_W), T, 1024, 1024}; pg8::EpiBranch E{WSP(bf16, WS_GSCR), WSP(bf16, WS_MERGED), true, 1.0f}; pg8::gemm_phase<pg8::EpiBranch, pg8::StaticOrder, true, true>(L + RING_OFF, g, S, E); }
#elif !DBG_NOGATE
            {   pg8::Gemm g{WSP(bf16, WS_HB), WSP(bf16, DBG_GATE_W) + (size_t)i * 1024 * 1024, T, 1024, 1024}; pg8::EpiGate<16> E{WSP(bf16, WS_GSCR), (LAS float*)(L + RING_BYTES + 1024)}; pg8::gemm_phase<pg8::EpiGate<16>, pg8::StaticOrder, true, true>(L + RING_OFF, g, S, E); }
#endif
#if !DBG_NOBRANCH
#if DBG_SUBST == 1
            {   const bf16* A = (i == 0) ? WSP(bf16, WS_FQ) : (i == 1) ? WSP(bf16, WS_DQ) : WSP(bf16, WS_IQ);
#elif DBG_SUBST == 2
            {   const bf16* A = (i == 0) ? WSP(bf16, WS_FK) : (i == 1) ? WSP(bf16, WS_FV) : WSP(bf16, WS_MQ);
#else
            {   const bf16* A = (i == 0) ? WSP(bf16, WS_OA) : (i == 1) ? WSP(bf16, WS_OB) : WSP(bf16, WS_MQ);
#endif
                pg8::Gemm g{A, WSP(bf16, WS_WBR) + (size_t)i * 1024 * 512, T, 1024, 512}; pg8::EpiBranch E{WSP(bf16, WS_GSCR), WSP(bf16, WS_MERGED), i == 0, ((DBG_BRANCH_MASK >> i) & 1) ? 1.0f : 0.0f}; pg8::gemm_phase<pg8::EpiBranch, pg8::StaticOrder, true, true>(L + RING_OFF, g, S, E); }
#endif
        }
        GRID_BAR();
#if defined(DBG_DUMP_AFTER) && DBG_DUMP_AFTER == 7
        {
            const bf16* sa = WSP(bf16, DBG_DUMP_A); const bf16* sb = WSP(bf16, DBG_DUMP_B);
            for (size_t e = (size_t)vcu * 512 + tid; e < (size_t)T * 512; e += (size_t)G * 512) { const size_t row = e >> 9, c = e & 511;
                ap->out[row * 1024 + c] = bf2f(sa[row * DBG_PITCH + c]); ap->out[row * 1024 + 512 + c] = bf2f(sb[row * DBG_PITCH + c]); }
            return;
        }
#endif

    }
#endif
#if (PHMASK >> 8) & 1
    {
        pg8::Gemm g{WSP(bf16, WS_MERGED), WSP(bf16, WS_WOUT), T, 1024, 1024}; pg8::StaticOrder S; S.init(T, 1024, G, bx);
        pg8::EpiResid3<1> E{nullptr, nullptr, WSP(bf16, WS_HB), WSP(float, WS_SSQ2), 1.0f};
        pg8::gemm_phase<pg8::EpiResid3<1>, pg8::StaticOrder, true, true>(L + RING_OFF, g, S, E);
        GRID_BAR();
    }
#endif
#if (PHMASK >> 9) & 1
    {
        pg8::Gemm g{WSP(bf16, WS_HB), WSP(bf16, WS_WGU2), T, 2 * DFF, 1024}; pg8::StaticOrder S; S.init(T, 2 * DFF, G, bx);
        pg8::build_row_tab<16>(WSP(float, WS_SSQ2), S, (LAS float*)(L + RING_BYTES + 1024)); pg8::EpiSwiGLU<16> E{WSP(bf16, WS_HID), DFF, (LAS float*)(L + RING_BYTES + 1024)};
#pragma unroll 1
        for (int rep_ = 0; rep_ < REP_GEMM; ++rep_)
        pg8::gemm_phase<pg8::EpiSwiGLU<16>, pg8::StaticOrder, true, true>(L + RING_OFF, g, S, E);
        GRID_BAR();
    }
#endif
#if (PHMASK >> 10) & 1
    {
        pg8::Gemm g{WSP(bf16, WS_HID), WSP(bf16, WS_WD2), T, 1024, DFF}; pg8::StaticOrder S; S.init(T, 1024, G, bx);
        pg8::EpiResid3<2> E{nullptr, ap->out, WSP(bf16, WS_HB), nullptr, 0.5f};
        pg8::gemm_phase<pg8::EpiResid3<2>, pg8::StaticOrder, true, true>(L + RING_OFF, g, S, E);
    }
#endif
}

extern "C" void kernel_launch(void* const* d_in, const int* in_sizes, int n_in, void* d_out, int out_size, void* d_ws, size_t ws_size, hipStream_t stream) {
    static int grid = 0;
    if (grid == 0) {
        if (n_in != 24 || out_size != T * DM || ws_size < WS_END) { fprintf(stderr, "kernel_launch: unexpected problem (n_in %d, out %d, ws %zu)\n", n_in, out_size, ws_size); grid = -1; return; }
        int dev = 0, cus = 0, per_cu = 0;
        if (hipGetDevice(&dev) != hipSuccess || hipDeviceGetAttribute(&cus, hipDeviceAttributeMultiprocessorCount, dev) != hipSuccess) { grid = -1; return; }
        if (hipFuncSetAttribute((const void*)fwd_mega, hipFuncAttributeMaxDynamicSharedMemorySize, LDS_BYTES) != hipSuccess) { fprintf(stderr, "kernel_launch: hipFuncSetAttribute failed\n"); grid = -1; return; }
        if (hipOccupancyMaxActiveBlocksPerMultiprocessor(&per_cu, (const void*)fwd_mega, NWAVES * 64, LDS_BYTES) != hipSuccess || per_cu < 1) { fprintf(stderr, "kernel_launch: occupancy query says %d blocks per CU\n", per_cu); (void)hipGetLastError(); grid = -1; return; }
        grid = cus;
    }
    if (grid < 0) return;
    (void)hipMemsetAsync((char*)d_ws + WS_CTL, 0, CTL_ZERO_BYTES, stream);
    Args a{};
    for (int i = 0; i < 24; ++i) a.in[i] = d_in[i];
    a.out = (float*)d_out; a.ws = (unsigned char*)d_ws;
    hipLaunchKernelGGL(fwd_mega, dim3(grid), dim3(NWAVES * 64), LDS_BYTES, stream, a);
}
```

```cpp
#include <hip/hip_runtime.h>
#include <cstdio>
#include <cstdint>
namespace pg8 {
#define PG8_LAS __attribute__((address_space(3)))
typedef unsigned short bf16_t;
typedef short bf16x8 __attribute__((ext_vector_type(8)));
typedef float f32x4 __attribute__((ext_vector_type(4)));
typedef unsigned u32x4 __attribute__((ext_vector_type(4)));
constexpr int BM = 256, BK = 64, HALF = 128, HTB = HALF * BK * 2  , STAGE_BYTES = 8 * HTB, NXCD = 8, WGM = 8;

__host__ __device__ __forceinline__ int lds_byte(int r, int c) { const int st = (r >> 4) * 2 + (c >> 5), rr = r & 15, cc = c & 31, ob = rr * 64 + cc * 2; return st * 1024 + (ob ^ (((ob >> 9) & 1) << 5)); }
__host__ __device__ __forceinline__ void stage_rc(int b, int& R, int& C) { const int st = b / 1024, sb = b % 1024, swz = sb ^ (((sb >> 9) & 1) << 5); R = (st >> 1) * 16 + swz / 64; C = (st & 1) * 32 + (swz % 64) / 2; }
__host__ __device__ __forceinline__ int perm32(int rho) { const int n = rho >> 4, i = rho & 15; return 8 * (i >> 2) + 4 * n + (i & 3); }

struct Unit { int pm, pn; };
struct Gemm { const bf16_t* A; const bf16_t* Bt; int M, N, K; };

struct StaticOrder {
    int nM, nN, nwg, G, c;
    __host__ __device__ void init(int M, int N, int G_, int c_) { nM = M / BM; nN = N / BM; nwg = nM * nN; G = G_; c = c_; }
    __host__ __device__ bool next(int i, Unit& u) const {
        const long L = (long)i * G + c; if (L >= nwg) return false;
        int wgid = (int)L; { const int q = nwg / NXCD, r = nwg % NXCD, xcd = wgid % NXCD, off = wgid / NXCD; wgid = (xcd < r ? xcd * (q + 1) : r * (q + 1) + (xcd - r) * q) + off; }
        const int nig = WGM * nN, gid = wgid / nig, fm = gid * WGM, gsz = (nM - fm) < WGM ? (nM - fm) : WGM;
        u.pm = fm + ((wgid % nig) % gsz); u.pn = (wgid % nig) / gsz; return true;
    }
    __device__ __forceinline__ void a_ready(const Unit&) const {}
    __device__ __forceinline__ void done(const Unit&) const {}
};

typedef float f32x2cv __attribute__((ext_vector_type(2))); typedef __bf16 bf16x2cv __attribute__((ext_vector_type(2)));
__device__ __forceinline__ unsigned cvt_pk_bf16(float lo, float hi) { const f32x2cv v = {lo, hi}; const bf16x2cv b = __builtin_convertvector(v, bf16x2cv); return __builtin_bit_cast(unsigned, b); }
typedef float f32x2 __attribute__((ext_vector_type(2)));
typedef unsigned u32x2p __attribute__((ext_vector_type(2)));
__device__ __forceinline__ float x32_sum(float x) { const unsigned u = __float_as_uint(x); const u32x2p r = __builtin_amdgcn_permlane32_swap(u, u, false, false); return __uint_as_float(r[0]) + __uint_as_float(r[1]); }
__device__ __forceinline__ float x32_max(float x) { const unsigned u = __float_as_uint(x); const u32x2p r = __builtin_amdgcn_permlane32_swap(u, u, false, false); return fmaxf(__uint_as_float(r[0]), __uint_as_float(r[1])); }
__device__ __forceinline__ float x16_sum(float x) { const unsigned u = __float_as_uint(x); const u32x2p r = __builtin_amdgcn_permlane16_swap(u, u, false, false); return __uint_as_float(r[0]) + __uint_as_float(r[1]); }
__device__ __forceinline__ float x16_max(float x) { const unsigned u = __float_as_uint(x); const u32x2p r = __builtin_amdgcn_permlane16_swap(u, u, false, false); return fmaxf(__uint_as_float(r[0]), __uint_as_float(r[1])); }
template <class Epi, class Sched, bool ALIGN_EPI = false, bool SP2 = false>
__device__ __forceinline__ void gemm_phase(PG8_LAS unsigned char* lds, const Gemm g, const Sched& S, const Epi& E) {
    int tid_ = threadIdx.x; asm volatile("" : "+v"(tid_));
    const int tid = tid_, wid = __builtin_amdgcn_readfirstlane(tid >> 6), lane = tid & 63, wr = wid >> 2, wc = wid & 3, fr = lane & 15, fq = lane >> 4;
    const int K = g.K, nt = K / BK;
    unsigned voffA[2], voffB[2];
#pragma unroll
    for (int i = 0; i < 2; ++i) { int R, C; stage_rc(tid * 16 + i * 8192, R, C); const int Rb = Epi::PERM ? ((R & ~31) + perm32(R & 31)) : R;
        voffA[i] = (unsigned)(R * K + C) * 2u; voffB[i] = (unsigned)(Rb * K + C) * 2u; }
    const size_t kstep = (size_t)(BK * 2);
    const size_t hstep = (size_t)HALF * K * 2;
    const size_t tstep = 2 * hstep;
    const unsigned ldsw = (unsigned)wid * 1024u;
    const int aoff = lds_byte(wr * 64 + fr, fq * 8), boff = lds_byte(wc * 32 + fr, fq * 8);
#define PG8_SA(b, h) (((b) * 2 + (h)) * HTB)
#define PG8_SB(b, h) ((4 + (b) * 2 + (h)) * HTB)
#define PG8_STAGE(bufoff, gbase, voff) do { _Pragma("unroll") for (int _i = 0; _i < 2; ++_i) \
        __builtin_amdgcn_global_load_lds((const unsigned*)((const char*)(gbase) + (voff)[_i]), (PG8_LAS unsigned*)(lds + (bufoff) + ldsw + _i * 8192), 16, 0, 0); } while (0)
#define PG8_LDA(dst, b, h) do { _Pragma("unroll") for (int m = 0; m < 4; ++m) _Pragma("unroll") for (int k = 0; k < 2; ++k) dst[m][k] = *(const PG8_LAS bf16x8*)(lds + PG8_SA(b, h) + aoff + m * 2048 + k * 1024); } while (0)
#define PG8_LDB(dst, b, h) do { _Pragma("unroll") for (int n = 0; n < 2; ++n) _Pragma("unroll") for (int k = 0; k < 2; ++k) dst[n][k] = *(const PG8_LAS bf16x8*)(lds + PG8_SB(b, h) + boff + n * 2048 + k * 1024); } while (0)
#define PG8_MMA(ai, bj, At, Bt) do { __builtin_amdgcn_s_setprio(1); _Pragma("unroll") for (int m = 0; m < 4; ++m) _Pragma("unroll") for (int n = 0; n < 2; ++n) _Pragma("unroll") for (int k = 0; k < 2; ++k) \
        acc[ai][bj][m][n] = __builtin_amdgcn_mfma_f32_16x16x32_bf16(Bt[n][k], At[m][k], acc[ai][bj][m][n], 0, 0, 0); __builtin_amdgcn_s_setprio(0); } while (0)
#define PG8_WAIT_V(n) asm volatile("s_waitcnt vmcnt(" #n ")" ::: "memory")
#define PG8_WAIT_L(n) asm volatile("s_waitcnt lgkmcnt(" #n ")" ::: "memory")
#define PG8_BAR __builtin_amdgcn_s_barrier()
#define PG8_SCHED __builtin_amdgcn_sched_barrier(0)
    Unit cur, nxt; int ui = 0;
    if (!S.next(0, cur)) return;
    f32x4 acc[2][2][4][2];
#pragma unroll
    for (int a = 0; a < 2; ++a)
#pragma unroll
        for (int b = 0; b < 2; ++b)
#pragma unroll
            for (int m = 0; m < 4; ++m)
#pragma unroll
                for (int n = 0; n < 2; ++n) acc[a][b][m][n] = (f32x4){0.f, 0.f, 0.f, 0.f};
    bf16x8 At[4][2], B0[2][2], B1[2][2];
    const char* cA = (const char*)g.A + (size_t)cur.pm * tstep; const char* cB = (const char*)g.Bt + (size_t)cur.pn * tstep;
    S.a_ready(cur);
    if constexpr (SP2) {
        PG8_STAGE(PG8_SB(0, 0), cB, voffB); PG8_STAGE(PG8_SB(0, 1), cB + hstep, voffB); PG8_STAGE(PG8_SA(0, 0), cA, voffA); PG8_STAGE(PG8_SA(0, 1), cA + hstep, voffA);
        if (wr == 1) PG8_BAR;
        PG8_WAIT_V(2); PG8_BAR;
        PG8_STAGE(PG8_SB(1, 0), cB + kstep, voffB); PG8_STAGE(PG8_SA(1, 0), cA + kstep, voffA); PG8_STAGE(PG8_SB(1, 1), cB + hstep + kstep, voffB);
        PG8_WAIT_V(6); PG8_BAR;
    } else {
        PG8_STAGE(PG8_SB(0, 0), cB, voffB); PG8_STAGE(PG8_SA(0, 0), cA, voffA); PG8_STAGE(PG8_SB(0, 1), cB + hstep, voffB); PG8_STAGE(PG8_SA(0, 1), cA + hstep, voffA);
        if (wr == 1) PG8_BAR;
        PG8_WAIT_V(4); PG8_BAR;
        PG8_STAGE(PG8_SB(1, 0), cB + kstep, voffB); PG8_STAGE(PG8_SA(1, 0), cA + kstep, voffA); PG8_STAGE(PG8_SB(1, 1), cB + hstep + kstep, voffB);
        PG8_WAIT_V(6); PG8_BAR;
    }
    for (;;) {
        const bool has_next = S.next(ui + 1, nxt);
        const char* nA = has_next ? (const char*)g.A + (size_t)nxt.pm * tstep : cA; const char* nB = has_next ? (const char*)g.Bt + (size_t)nxt.pn * tstep : cB;
        for (int t = 0; t < nt; t += 2) {
            const bool last = (t == nt - 2);
            const char* a1 = cA + (size_t)(t + 1) * kstep;
            const char* a2 = last ? nA : cA + (size_t)(t + 2) * kstep; const char* b2 = last ? nB : cB + (size_t)(t + 2) * kstep;
            const char* a3 = a2 + kstep; const char* b3 = b2 + kstep;
            if (last && has_next) S.a_ready(nxt);
            if constexpr (SP2) {
            PG8_LDB(B0, 0, 0); PG8_LDB(B1, 0, 1); PG8_SCHED; PG8_LDA(At, 0, 0); PG8_STAGE(PG8_SA(1, 1), a1 + hstep, voffA);
            PG8_WAIT_V(8); PG8_WAIT_L(0); PG8_BAR; PG8_MMA(0, 0, At, B0); PG8_MMA(0, 1, At, B1); PG8_BAR; PG8_SCHED;
            PG8_LDA(At, 0, 1); PG8_STAGE(PG8_SB(0, 0), b2, voffB); PG8_STAGE(PG8_SB(0, 1), b2 + hstep, voffB); PG8_STAGE(PG8_SA(0, 0), a2, voffA);
            PG8_WAIT_V(8); PG8_WAIT_L(0); PG8_BAR; PG8_MMA(1, 0, At, B0); PG8_MMA(1, 1, At, B1); PG8_BAR; PG8_SCHED;
            PG8_LDB(B0, 1, 0); PG8_LDB(B1, 1, 1); PG8_SCHED; PG8_LDA(At, 1, 0); PG8_STAGE(PG8_SA(0, 1), a2 + hstep, voffA);
            PG8_WAIT_V(8); PG8_WAIT_L(0); PG8_BAR; PG8_MMA(0, 0, At, B0); PG8_MMA(0, 1, At, B1); PG8_BAR; PG8_SCHED;
            PG8_LDA(At, 1, 1); PG8_STAGE(PG8_SB(1, 0), b3, voffB); PG8_STAGE(PG8_SB(1, 1), b3 + hstep, voffB); PG8_STAGE(PG8_SA(1, 0), a3, voffA);
            PG8_WAIT_V(8); PG8_WAIT_L(0); PG8_BAR; PG8_MMA(1, 0, At, B0); PG8_MMA(1, 1, At, B1); PG8_BAR; PG8_SCHED;
            } else {
            PG8_LDB(B0, 0, 0); PG8_SCHED; PG8_LDA(At, 0, 0); PG8_STAGE(PG8_SA(1, 1), a1 + hstep, voffA);
            PG8_WAIT_L(8); PG8_BAR; PG8_WAIT_L(0); PG8_MMA(0, 0, At, B0); PG8_BAR; PG8_SCHED;
            PG8_LDB(B1, 0, 1); PG8_STAGE(PG8_SB(0, 0), b2, voffB);
            PG8_BAR; PG8_WAIT_L(0); PG8_MMA(0, 1, At, B1); PG8_BAR;
            PG8_LDA(At, 0, 1); PG8_STAGE(PG8_SA(0, 0), a2, voffA);
            PG8_BAR; PG8_WAIT_L(0); PG8_MMA(1, 0, At, B0); PG8_BAR; PG8_SCHED;
            PG8_STAGE(PG8_SB(0, 1), b2 + hstep, voffB);
            PG8_WAIT_V(6); PG8_BAR; PG8_MMA(1, 1, At, B1); PG8_BAR;
            PG8_LDB(B0, 1, 0); PG8_SCHED; PG8_LDA(At, 1, 0); PG8_STAGE(PG8_SA(0, 1), a2 + hstep, voffA);
            PG8_WAIT_L(8); PG8_BAR; PG8_WAIT_L(0); PG8_MMA(0, 0, At, B0); PG8_BAR; PG8_SCHED;
            PG8_LDB(B1, 1, 1); PG8_STAGE(PG8_SB(1, 0), b3, voffB);
            PG8_BAR; PG8_WAIT_L(0); PG8_MMA(0, 1, At, B1); PG8_BAR;
            PG8_LDA(At, 1, 1); PG8_STAGE(PG8_SA(1, 0), a3, voffA);
            PG8_BAR; PG8_WAIT_L(0); PG8_MMA(1, 0, At, B0); PG8_BAR; PG8_SCHED;
            PG8_STAGE(PG8_SB(1, 1), b3 + hstep, voffB);
            PG8_WAIT_V(6); PG8_BAR; PG8_MMA(1, 1, At, B1); PG8_BAR;
            }
        }
        if constexpr (ALIGN_EPI) { if (wr == 0) PG8_BAR; }
        if constexpr (!Epi::AFTER_DRAIN) { E(acc, cur, wr, wc, fr, fq); S.done(cur); }
        if (!has_next) break;
#pragma unroll
        for (int a = 0; a < 2; ++a)
#pragma unroll
            for (int b = 0; b < 2; ++b)
#pragma unroll
                for (int m = 0; m < 4; ++m)
#pragma unroll
                    for (int n = 0; n < 2; ++n) acc[a][b][m][n] = (f32x4){0.f, 0.f, 0.f, 0.f};
        cur = nxt; cA = nA; cB = nB; ++ui;
        if constexpr (ALIGN_EPI) { if (wr == 1) PG8_BAR; }
    }
    PG8_WAIT_V(0);
    if constexpr (!ALIGN_EPI) { if (wr == 0) PG8_BAR; }
    PG8_BAR;
    if constexpr (Epi::AFTER_DRAIN) { E.fused(acc, cur, wr, wc, fr, fq, lds, wid, lane); S.done(cur); }
#undef PG8_SA
#undef PG8_SB
#undef PG8_STAGE
#undef PG8_LDA
#undef PG8_LDB
#undef PG8_MMA
#undef PG8_WAIT_V
#undef PG8_WAIT_L
#undef PG8_BAR
#undef PG8_SCHED
}

struct UnitX { int pm, pn, kind, round; };
struct OpsX { const char* A; const char* Bt; int K; };
template <class Epi, class Sched>
__device__ __forceinline__ void gemm_stream(PG8_LAS unsigned char* lds, const Sched& S, const Epi& E) {
    int tid_ = threadIdx.x; asm volatile("" : "+v"(tid_));
    const int tid = tid_, wid = __builtin_amdgcn_readfirstlane(tid >> 6), lane = tid & 63, wr = wid >> 2, wc = wid & 3, fr = lane & 15, fq = lane >> 4;
    unsigned rA[2], rB[2], c2[2];
#pragma unroll
    for (int i = 0; i < 2; ++i) { int R, C; stage_rc(tid * 16 + i * 8192, R, C); rA[i] = (unsigned)R; rB[i] = (unsigned)((R & ~31) + perm32(R & 31)); c2[i] = (unsigned)C * 2u; }
    const size_t kstep = (size_t)(BK * 2);
    const unsigned ldsw = (unsigned)wid * 1024u;
    const int aoff = lds_byte(wr * 64 + fr, fq * 8), boff = lds_byte(wc * 32 + fr, fq * 8);
#define PG8_SA(b, h) (((b) * 2 + (h)) * HTB)
#define PG8_SB(b, h) ((4 + (b) * 2 + (h)) * HTB)
#define PGX_STAGE(bufoff, gbase, rr, pb) do { _Pragma("unroll") for (int _i = 0; _i < 2; ++_i) \
        __builtin_amdgcn_global_load_lds((const unsigned*)((const char*)(gbase) + ((rr)[_i] * (pb) + c2[_i])), (PG8_LAS unsigned*)(lds + (bufoff) + ldsw + _i * 8192), 16, 0, 0); } while (0)
#define PG8_LDA(dst, b, h) do { _Pragma("unroll") for (int m = 0; m < 4; ++m) _Pragma("unroll") for (int k = 0; k < 2; ++k) dst[m][k] = *(const PG8_LAS bf16x8*)(lds + PG8_SA(b, h) + aoff + m * 2048 + k * 1024); } while (0)
#define PG8_LDB(dst, b, h) do { _Pragma("unroll") for (int n = 0; n < 2; ++n) _Pragma("unroll") for (int k = 0; k < 2; ++k) dst[n][k] = *(const PG8_LAS bf16x8*)(lds + PG8_SB(b, h) + boff + n * 2048 + k * 1024); } while (0)
#define PG8_MMA(ai, bj, At, Bt) do { __builtin_amdgcn_s_setprio(1); _Pragma("unroll") for (int m = 0; m < 4; ++m) _Pragma("unroll") for (int n = 0; n < 2; ++n) _Pragma("unroll") for (int k = 0; k < 2; ++k) \
        acc[ai][bj][m][n] = __builtin_amdgcn_mfma_f32_16x16x32_bf16(Bt[n][k], At[m][k], acc[ai][bj][m][n], 0, 0, 0); __builtin_amdgcn_s_setprio(0); } while (0)
#define PG8_WAIT_V(n) asm volatile("s_waitcnt vmcnt(" #n ")" ::: "memory")
#define PG8_WAIT_L(n) asm volatile("s_waitcnt lgkmcnt(" #n ")" ::: "memory")
#define PG8_BAR __builtin_amdgcn_s_barrier()
#define PG8_SCHED __builtin_amdgcn_sched_barrier(0)
    UnitX cur, nxt; int ui = 0;
    if (!S.next(0, cur)) return;
    f32x4 acc[2][2][4][2];
#pragma unroll
    for (int a = 0; a < 2; ++a)
#pragma unroll
        for (int b = 0; b < 2; ++b)
#pragma unroll
            for (int m = 0; m < 4; ++m)
#pragma unroll
                for (int n = 0; n < 2; ++n) acc[a][b][m][n] = (f32x4){0.f, 0.f, 0.f, 0.f};
    bf16x8 At[4][2], B0[2][2], B1[2][2];
    OpsX oc = S.ops(cur);
    const char* cA = oc.A; const char* cB = oc.Bt; int Kc = oc.K;
    {   const unsigned pb = (unsigned)Kc * 2u; const size_t hstep = (size_t)HALF * pb;
        PGX_STAGE(PG8_SB(0, 0), cB, rB, pb); PGX_STAGE(PG8_SB(0, 1), cB + hstep, rB, pb); PGX_STAGE(PG8_SA(0, 0), cA, rA, pb); PGX_STAGE(PG8_SA(0, 1), cA + hstep, rA, pb);
        if (wr == 1) PG8_BAR;
        PG8_WAIT_V(2); PG8_BAR;
        PGX_STAGE(PG8_SB(1, 0), cB + kstep, rB, pb); PGX_STAGE(PG8_SA(1, 0), cA + kstep, rA, pb); PGX_STAGE(PG8_SB(1, 1), cB + hstep + kstep, rB, pb);
        PG8_WAIT_V(6); PG8_BAR; }
    for (;;) {
        const bool has_next = S.next(ui + 1, nxt);
        OpsX on = oc; if (has_next) on = S.ops(nxt);
        const char* nA = on.A; const char* nB = on.Bt; const int Kn = on.K;
        const int nt = Kc / BK; const unsigned pbc = (unsigned)Kc * 2u; const size_t hstep = (size_t)HALF * pbc;
        for (int t = 0; t < nt; t += 2) {
            const bool last = (t == nt - 2);
            const char* a1 = cA + (size_t)(t + 1) * kstep;
            const char* a2 = last ? nA : cA + (size_t)(t + 2) * kstep; const char* b2 = last ? nB : cB + (size_t)(t + 2) * kstep;
            const char* a3 = a2 + kstep; const char* b3 = b2 + kstep;
            const unsigned pb2 = last ? (unsigned)Kn * 2u : pbc; const size_t h2 = (size_t)HALF * pb2;
            PG8_LDB(B0, 0, 0); PG8_LDB(B1, 0, 1); PG8_SCHED; PG8_LDA(At, 0, 0); PGX_STAGE(PG8_SA(1, 1), a1 + hstep, rA, pbc);
            PG8_WAIT_V(8); PG8_WAIT_L(0); PG8_BAR; PG8_MMA(0, 0, At, B0); PG8_MMA(0, 1, At, B1); PG8_BAR; PG8_SCHED;
            PG8_LDA(At, 0, 1); PGX_STAGE(PG8_SB(0, 0), b2, rB, pb2); PGX_STAGE(PG8_SB(0, 1), b2 + h2, rB, pb2); PGX_STAGE(PG8_SA(0, 0), a2, rA, pb2);
            PG8_WAIT_V(8); PG8_WAIT_L(0); PG8_BAR; PG8_MMA(1, 0, At, B0); PG8_MMA(1, 1, At, B1); PG8_BAR; PG8_SCHED;
            PG8_LDB(B0, 1, 0); PG8_LDB(B1, 1, 1); PG8_SCHED; PG8_LDA(At, 1, 0); PGX_STAGE(PG8_SA(0, 1), a2 + h2, rA, pb2);
            PG8_WAIT_V(8); PG8_WAIT_L(0); PG8_BAR; PG8_MMA(0, 0, At, B0); PG8_MMA(0, 1, At, B1); PG8_BAR; PG8_SCHED;
            PG8_LDA(At, 1, 1); PGX_STAGE(PG8_SB(1, 0), b3, rB, pb2); PGX_STAGE(PG8_SB(1, 1), b3 + h2, rB, pb2); PGX_STAGE(PG8_SA(1, 0), a3, rA, pb2);
            PG8_WAIT_V(8); PG8_WAIT_L(0); PG8_BAR; PG8_MMA(1, 0, At, B0); PG8_MMA(1, 1, At, B1); PG8_BAR; PG8_SCHED;
        }
        if (wr == 0) PG8_BAR;
        E(acc, cur, wr, wc, fr, fq);
        if (!has_next) break;
#pragma unroll
        for (int a = 0; a < 2; ++a)
#pragma unroll
            for (int b = 0; b < 2; ++b)
#pragma unroll
                for (int m = 0; m < 4; ++m)
#pragma unroll
                    for (int n = 0; n < 2; ++n) acc[a][b][m][n] = (f32x4){0.f, 0.f, 0.f, 0.f};
        cur = nxt; oc = on; cA = nA; cB = nB; Kc = Kn; ++ui;
        if (wr == 1) PG8_BAR;
    }
    PG8_WAIT_V(0);
    PG8_BAR;
#undef PG8_SA
#undef PG8_SB
#undef PGX_STAGE
#undef PG8_LDA
#undef PG8_LDB
#undef PG8_MMA
#undef PG8_WAIT_V
#undef PG8_WAIT_L
#undef PG8_BAR
#undef PG8_SCHED
}
}
namespace pg8 {
constexpr int TOK = 16384;
constexpr float RMS_EPS = 1e-6f;
typedef float f32x2e __attribute__((ext_vector_type(2)));
template <int NP> __device__ __forceinline__ void row_scales(const float* src, int rowbase, int lane, int fr, float (&r)[2][4]) {
#pragma unroll
    for (int ai = 0; ai < 2; ++ai) {
        const int row = rowbase + 128 * ai + lane; float v;
        if (NP == 0) v = src[row];
        else { float s = 0.f;
#pragma unroll
            for (int p = 0; p < NP; ++p) s += src[(size_t)p * TOK + row];
            v = __builtin_amdgcn_rsqf(s * (1.0f / 1024.0f) + RMS_EPS); }
#pragma unroll
        for (int m = 0; m < 4; ++m) r[ai][m] = __shfl(v, 16 * m + fr);
    }
}
template <int NP, class Sched> __device__ __forceinline__ void build_row_tab(const float* src, const Sched& S, PG8_LAS float* tab) {
    Unit u;
    for (int i = 0; S.next(i, u); ++i)
        for (int r = (int)threadIdx.x; r < 256; r += 512) { const int row = u.pm * BM + r; float v;
            if (NP == 0) v = src[row];
            else { float s = 0.f;
#pragma unroll
                for (int p = 0; p < NP; ++p) s += src[(size_t)p * TOK + row];
                v = __builtin_amdgcn_rsqf(s * (1.0f / 1024.0f) + RMS_EPS); }
            tab[i * 256 + r] = v; }
    __syncthreads();
}
__device__ __forceinline__ void row_scales_tab(const PG8_LAS float* tab, int ui, int wr, int fr, float (&r)[2][4]) {
#pragma unroll
    for (int ai = 0; ai < 2; ++ai)
#pragma unroll
        for (int m = 0; m < 4; ++m) r[ai][m] = tab[ui * 256 + ai * 128 + wr * 64 + 16 * m + fr];
}
__device__ __forceinline__ float silu_f(float x) { return x * __builtin_amdgcn_rcpf(1.0f + __expf(-x)); }
__device__ __forceinline__ float sigmoid_f(float x) { return __builtin_amdgcn_rcpf(1.0f + __expf(-x)); }

template <int NP> struct EpiSwiGLU {
    static constexpr bool PERM = true, AFTER_DRAIN = false;
    bf16_t* H; int ldh; const PG8_LAS float* tab; mutable int ui = 0;
    __device__ __forceinline__ void operator()(const f32x4 (&acc)[2][2][4][2], const Unit& u, int wr, int wc, int fr0, int fq0) const {
        int fr = fr0, fq = fq0; asm volatile("" : "+v"(fr), "+v"(fq));
        float r[2][4]; row_scales_tab(tab, ui++, wr, fr, r);
        const int col0 = u.pn * 128 + wc * 32 + 8 * fq;
#pragma unroll
        for (int ai = 0; ai < 2; ++ai)
#pragma unroll
            for (int m = 0; m < 4; ++m) {
                const int row = u.pm * BM + ai * HALF + wr * 64 + m * 16 + fr; const float rr = r[ai][m];
                float o[8]; const float k1 = -1.44269504f * rr, rr2 = rr * rr;
#pragma unroll
                for (int n = 0; n < 2; ++n)
#pragma unroll
                    for (int j = 0; j < 4; j += 2) { const f32x2 g2 = (f32x2){acc[ai][0][m][n][j], acc[ai][0][m][n][j + 1]}, u2 = (f32x2){acc[ai][1][m][n][j], acc[ai][1][m][n][j + 1]};
                        const f32x2 t2 = g2 * k1; const f32x2 d2 = (f32x2){__builtin_amdgcn_exp2f(t2[0]), __builtin_amdgcn_exp2f(t2[1])} + 1.0f;
                        const f32x2 r2 = (f32x2){__builtin_amdgcn_rcpf(d2[0]), __builtin_amdgcn_rcpf(d2[1])} * rr2; const f32x2 o2 = (g2 * u2) * r2;
                        o[4 * n + j] = o2[0]; o[4 * n + j + 1] = o2[1]; }
                u32x4 w; w.x = cvt_pk_bf16(o[0], o[1]); w.y = cvt_pk_bf16(o[2], o[3]); w.z = cvt_pk_bf16(o[4], o[5]); w.w = cvt_pk_bf16(o[6], o[7]);
                *(u32x4*)(H + (size_t)row * ldh + col0) = w;
            }
    }
};
template <bool WRITE_HB> struct EpiResid {
    static constexpr bool PERM = true, AFTER_DRAIN = false;
    const float* base; float* out; bf16_t* hb; float* part; float sc;
    __device__ __forceinline__ void operator()(const f32x4 (&acc)[2][2][4][2], const Unit& u, int wr, int wc, int fr0, int fq0) const {
        int fr = fr0, fq = fq0; asm volatile("" : "+v"(fr), "+v"(fq));
        const int col0 = u.pn * BM + wc * 32 + 8 * fq;
#pragma unroll
        for (int ai = 0; ai < 2; ++ai)
#pragma unroll
            for (int m = 0; m < 4; ++m) {
                const int row = u.pm * BM + ai * HALF + wr * 64 + m * 16 + fr; float ss = 0.f;
#pragma unroll
                for (int bj = 0; bj < 2; ++bj) {
                    const size_t off = (size_t)row * 1024 + col0 + bj * HALF;
                    const f32x4 b0 = *(const f32x4*)(base + off), b1 = *(const f32x4*)(base + off + 4);
                    const f32x4 o0 = b0 + acc[ai][bj][m][0] * sc, o1 = b1 + acc[ai][bj][m][1] * sc;
                    *(f32x4*)(out + off) = o0; *(f32x4*)(out + off + 4) = o1;
                    if (WRITE_HB) {
                        ss += (o0[0] * o0[0] + o0[1] * o0[1]) + (o0[2] * o0[2] + o0[3] * o0[3]) + (o1[0] * o1[0] + o1[1] * o1[1]) + (o1[2] * o1[2] + o1[3] * o1[3]);
                        u32x4 w; w.x = cvt_pk_bf16(o0[0], o0[1]); w.y = cvt_pk_bf16(o0[2], o0[3]); w.z = cvt_pk_bf16(o1[0], o1[1]); w.w = cvt_pk_bf16(o1[2], o1[3]);
                        *(u32x4*)(hb + off) = w; }
                }
                if (WRITE_HB) { ss = x16_sum(ss); ss = x32_sum(ss); if (fq == 0) part[(size_t)(u.pn * 4 + wc) * TOK + row] = ss; }
                if (m == 3) asm volatile("" ::: "memory");
            }
    }
};
template <bool WRITE_HB> struct EpiResid2 {
    static constexpr bool PERM = true, AFTER_DRAIN = false;
    const float* base; float* out; bf16_t* hb; float* part; float sc;
    __device__ __forceinline__ void operator()(const f32x4 (&acc)[2][2][4][2], const Unit& u, int wr, int wc, int fr0, int fq0) const {
        int fr = fr0, fq = fq0; asm volatile("" : "+v"(fr), "+v"(fq));
        const int row0 = u.pm * BM + wr * 64 + fr; const size_t o00 = (size_t)row0 * 1024 + u.pn * BM + wc * 32 + 8 * fq;
        const float* bp = base + o00; float* op = out + o00; bf16_t* hp = hb + o00;
        f32x4 bq[2][8];
#define ER2_ISSUE(G, B) do { _Pragma("unroll") for (int c = 0; c < 8; ++c) { const int ai = (G) >> 1, m = 2 * ((G) & 1) + (c >> 2), bj = (c >> 1) & 1, n = c & 1; \
            bq[B][c] = *(const f32x4*)(bp + (size_t)(ai * 128 + m * 16) * 1024 + bj * 128 + 4 * n); } } while (0)
        ER2_ISSUE(0, 0);
#pragma unroll
        for (int G = 0; G < 4; ++G) {
            if (G + 1 < 4) { if ((G & 1) == 0) ER2_ISSUE(G + 1, 1); else ER2_ISSUE(G + 1, 0); }
            asm volatile("" ::: "memory");
#pragma unroll
            for (int mm = 0; mm < 2; ++mm) { const int ai = G >> 1, m = 2 * (G & 1) + mm; float ss = 0.f;
#pragma unroll
                for (int bj = 0; bj < 2; ++bj) { const size_t off = (size_t)(ai * 128 + m * 16) * 1024 + bj * 128;
                    const f32x4 o0 = bq[G & 1][mm * 4 + bj * 2] + acc[ai][bj][m][0] * sc, o1 = bq[G & 1][mm * 4 + bj * 2 + 1] + acc[ai][bj][m][1] * sc;
                    *(f32x4*)(op + off) = o0; *(f32x4*)(op + off + 4) = o1;
                    if (WRITE_HB) {
                        ss += (o0[0] * o0[0] + o0[1] * o0[1]) + (o0[2] * o0[2] + o0[3] * o0[3]) + (o1[0] * o1[0] + o1[1] * o1[1]) + (o1[2] * o1[2] + o1[3] * o1[3]);
                        u32x4 w; w.x = cvt_pk_bf16(o0[0], o0[1]); w.y = cvt_pk_bf16(o0[2], o0[3]); w.z = cvt_pk_bf16(o1[0], o1[1]); w.w = cvt_pk_bf16(o1[2], o1[3]);
                        *(u32x4*)(hp + off) = w; } }
                if (WRITE_HB) { ss = x16_sum(ss); ss = x32_sum(ss); if (fq == 0) part[(size_t)(u.pn * 4 + wc) * TOK + row0 + ai * 128 + m * 16] = ss; } }
            asm volatile("" ::: "memory");
        }
#undef ER2_ISSUE
    }
};
__device__ __forceinline__ float bf_lo(unsigned w) { return __uint_as_float(w << 16); }
__device__ __forceinline__ float bf_hi(unsigned w) { return __uint_as_float(w & 0xffff0000u); }
template <int MODE> struct EpiResid3 {
    static constexpr bool PERM = true, AFTER_DRAIN = false;
    static constexpr int NS = 0;
    const float* basef; float* out; bf16_t* hb; float* part; float sc;
    __device__ __forceinline__ void operator()(const f32x4 (&acc)[2][2][4][2], const Unit& u, int wr, int wc, int fr0, int fq0) const {
        int fr = fr0, fq = fq0; asm volatile("" : "+v"(fr), "+v"(fq));
        const int row0 = u.pm * BM + wr * 64 + fr; const size_t o00 = (size_t)row0 * 1024 + u.pn * BM + wc * 32 + 8 * fq;
        const float* bp = basef + o00; float* op = out + o00; bf16_t* hp = hb + o00;
        f32x4 bq[2][8]; u32x4 hq[2][4];
#define ER3_ISSUE(G, B) do { if (MODE == 0) { _Pragma("unroll") for (int c = 0; c < 8; ++c) { const int ai = (G) >> 1, m = 2 * ((G) & 1) + (c >> 2), bj = (c >> 1) & 1, n = c & 1; \
                bq[B][c] = *(const f32x4*)(bp + (size_t)(ai * 128 + m * 16) * 1024 + bj * 128 + 4 * n); } } \
            else { _Pragma("unroll") for (int c = 0; c < 4; ++c) { const int ai = (G) >> 1, m = 2 * ((G) & 1) + (c >> 1), bj = c & 1; hq[B][c] = *(const u32x4*)(hp + (size_t)(ai * 128 + m * 16) * 1024 + bj * 128); } } } while (0)
        ER3_ISSUE(0, 0);
#pragma unroll
        for (int G = 0; G < 4; ++G) {
            if (G + 1 < 4) { if ((G & 1) == 0) ER3_ISSUE(G + 1, 1); else ER3_ISSUE(G + 1, 0); }
            asm volatile("" ::: "memory");
#pragma unroll
            for (int mm = 0; mm < 2; ++mm) { const int ai = G >> 1, m = 2 * (G & 1) + mm; float ss = 0.f;
#pragma unroll
                for (int bj = 0; bj < 2; ++bj) { const size_t off = (size_t)(ai * 128 + m * 16) * 1024 + bj * 128;
                    f32x4 b0, b1;
                    if (MODE == 0) { b0 = bq[G & 1][mm * 4 + bj * 2]; b1 = bq[G & 1][mm * 4 + bj * 2 + 1]; }
                    else { const u32x4 h = hq[G & 1][mm * 2 + bj]; b0 = (f32x4){bf_lo(h.x), bf_hi(h.x), bf_lo(h.y), bf_hi(h.y)}; b1 = (f32x4){bf_lo(h.z), bf_hi(h.z), bf_lo(h.w), bf_hi(h.w)}; }
                    const f32x4 o0 = b0 + acc[ai][bj][m][0] * sc, o1 = b1 + acc[ai][bj][m][1] * sc;
                    if (MODE == 2) { __builtin_nontemporal_store(o0, (f32x4*)(op + off)); __builtin_nontemporal_store(o1, (f32x4*)(op + off + 4)); }
                    else {
                        ss += (o0[0] * o0[0] + o0[1] * o0[1]) + (o0[2] * o0[2] + o0[3] * o0[3]) + (o1[0] * o1[0] + o1[1] * o1[1]) + (o1[2] * o1[2] + o1[3] * o1[3]);
                        u32x4 w; w.x = cvt_pk_bf16(o0[0], o0[1]); w.y = cvt_pk_bf16(o0[2], o0[3]); w.z = cvt_pk_bf16(o1[0], o1[1]); w.w = cvt_pk_bf16(o1[2], o1[3]);
                        *(u32x4*)(hp + off) = w; } }
                if (MODE != 2) { ss = x16_sum(ss); ss = x32_sum(ss); if (fq == 0) part[(size_t)(u.pn * 4 + wc) * TOK + row0 + ai * 128 + m * 16] = ss; } }
            asm volatile("" ::: "memory");
        }
#undef ER3_ISSUE
    }
};
struct EpiMemKV {
    static constexpr bool PERM = true, AFTER_DRAIN = false;
    float* KV; const float* rs;
    __device__ __forceinline__ void operator()(const f32x4 (&acc)[2][2][4][2], const Unit& u, int wr, int wc, int fr0, int fq0) const {
        int fr = fr0, fq = fq0; asm volatile("" : "+v"(fr), "+v"(fq));
        float r[2][4]; row_scales<0>(rs, u.pm * BM + wr * 64, (int)(threadIdx.x & 63), fr, r);
        const int col0 = u.pn * BM + wc * 32 + 8 * fq;
#pragma unroll
        for (int ai = 0; ai < 2; ++ai)
#pragma unroll
            for (int m = 0; m < 4; ++m) { const int row = u.pm * BM + ai * HALF + wr * 64 + m * 16 + fr;
#pragma unroll
                for (int bj = 0; bj < 2; ++bj) { const size_t off = (size_t)row * 1024 + col0 + bj * HALF;
                    *(f32x4*)(KV + off) = acc[ai][bj][m][0] * r[ai][m]; *(f32x4*)(KV + off + 4) = acc[ai][bj][m][1] * r[ai][m]; } }
    }
};
template <int NP> struct EpiGate {
    static constexpr bool PERM = true, AFTER_DRAIN = false;
    bf16_t* scr; const PG8_LAS float* tab; mutable int ui = 0;
    __device__ __forceinline__ void operator()(const f32x4 (&acc)[2][2][4][2], const Unit& u, int wr, int wc, int fr0, int fq0) const {
        int fr = fr0, fq = fq0; asm volatile("" : "+v"(fr), "+v"(fq));
        float r[2][4];
#ifdef DBG_GATE_NOSCALE
        for (int a_ = 0; a_ < 2; ++a_) for (int m_ = 0; m_ < 4; ++m_) r[a_][m_] = 1.0f;
#else
        row_scales_tab(tab, ui++, wr, fr, r);
#endif
        bf16_t* t = scr + (size_t)(u.pm * 4 + u.pn) * 65536;
#pragma unroll
        for (int ai = 0; ai < 2; ++ai)
#pragma unroll
            for (int m = 0; m < 4; ++m) { const int lr = ai * HALF + wr * 64 + m * 16 + fr; const float rr = r[ai][m];
#pragma unroll
                for (int bj = 0; bj < 2; ++bj) { float o[8];
#pragma unroll
                    for (int n = 0; n < 2; ++n)
#pragma unroll
                        for (int j = 0; j < 4; ++j) o[4 * n + j] = sigmoid_f(acc[ai][bj][m][n][j] * rr);
                    u32x4 w; w.x = cvt_pk_bf16(o[0], o[1]); w.y = cvt_pk_bf16(o[2], o[3]); w.z = cvt_pk_bf16(o[4], o[5]); w.w = cvt_pk_bf16(o[6], o[7]);
                    *(u32x4*)(t + lr * 256 + bj * HALF + wc * 32 + 8 * fq) = w; } }
    }
};
struct EpiBranch {
    static constexpr bool PERM = true, AFTER_DRAIN = false;
    const bf16_t* scr; bf16_t* mg; bool first; float bscale;
    __device__ __forceinline__ void operator()(const f32x4 (&acc)[2][2][4][2], const Unit& u, int wr, int wc, int fr0, int fq0) const {
        int fr = fr0, fq = fq0; asm volatile("" : "+v"(fr), "+v"(fq));
        const bf16_t* t = scr + (size_t)(u.pm * 4 + u.pn) * 65536;
        __builtin_amdgcn_fence(__ATOMIC_ACQUIRE, "agent");
        asm volatile("s_waitcnt vmcnt(0)" ::: "memory");
#pragma unroll
        for (int ai = 0; ai < 2; ++ai)
#pragma unroll
            for (int m = 0; m < 4; ++m) { const int lr = ai * HALF + wr * 64 + m * 16 + fr; const int row = u.pm * BM + lr;
#pragma unroll
                for (int bj = 0; bj < 2; ++bj) { const int lc = bj * HALF + wc * 32 + 8 * fq;
#if defined(DBG_NOGATE) && DBG_NOGATE
                    const u32x4 g = (u32x4){0x3f803f80u, 0x3f803f80u, 0x3f803f80u, 0x3f803f80u};
#else
                    const u32x4 g = *(const u32x4*)(t + lr * 256 + lc);
#endif
                    bf16_t* mp = mg + (size_t)row * 1024 + u.pn * BM + lc;
                    float o[8];
                    o[0] = bf_lo(g.x) * acc[ai][bj][m][0][0]; o[1] = bf_hi(g.x) * acc[ai][bj][m][0][1]; o[2] = bf_lo(g.y) * acc[ai][bj][m][0][2]; o[3] = bf_hi(g.y) * acc[ai][bj][m][0][3];
                    o[4] = bf_lo(g.z) * acc[ai][bj][m][1][0]; o[5] = bf_hi(g.z) * acc[ai][bj][m][1][1]; o[6] = bf_lo(g.w) * acc[ai][bj][m][1][2]; o[7] = bf_hi(g.w) * acc[ai][bj][m][1][3];
#ifdef DBG_BRANCH_SIGMOID
#pragma unroll
                    for (int e = 0; e < 8; ++e) o[e] = DBG_NONLIN(o[e]);
#endif
#pragma unroll
                    for (int e = 0; e < 8; ++e) o[e] *= bscale;
                    if (!first) { const u32x4 p = *(const u32x4*)mp;
                        o[0] += bf_lo(p.x); o[1] += bf_hi(p.x); o[2] += bf_lo(p.y); o[3] += bf_hi(p.y); o[4] += bf_lo(p.z); o[5] += bf_hi(p.z); o[6] += bf_lo(p.w); o[7] += bf_hi(p.w); }
                    u32x4 w; w.x = cvt_pk_bf16(o[0], o[1]); w.y = cvt_pk_bf16(o[2], o[3]); w.z = cvt_pk_bf16(o[4], o[5]); w.w = cvt_pk_bf16(o[6], o[7]);
                    *(u32x4*)mp = w; }
                if (m & 1) asm volatile("" ::: "memory"); }
    }
};
template <bool FIRST> struct EpiBranch2 {
    const bf16_t* scr; bf16_t* mg;
    __device__ __forceinline__ void operator()(const f32x4 (&acc)[2][2][4][2], const Unit& u, int wr, int wc, int fr0, int fq0) const {
        int fr = fr0, fq = fq0; asm volatile("" : "+v"(fr), "+v"(fq));
        const bf16_t* t = scr + (size_t)(u.pm * 4 + u.pn) * 65536 + (wr * 64 + fr) * 256 + wc * 32 + 8 * fq;
        bf16_t* mp0 = mg + (size_t)(u.pm * BM + wr * 64 + fr) * 1024 + u.pn * BM + wc * 32 + 8 * fq;
        u32x4 gq[2][4], pq[2][4];
#define EB2_ISSUE(G, B) do { _Pragma("unroll") for (int c = 0; c < 4; ++c) { const int ai = (G) >> 1, m = 2 * ((G) & 1) + (c >> 1), bj = c & 1; \
            gq[B][c] = *(const u32x4*)(t + (ai * 128 + m * 16) * 256 + bj * 128); if (!FIRST) pq[B][c] = *(const u32x4*)(mp0 + (size_t)(ai * 128 + m * 16) * 1024 + bj * 128); } } while (0)
        EB2_ISSUE(0, 0);
#pragma unroll
        for (int G = 0; G < 4; ++G) {
            if (G + 1 < 4) { if ((G & 1) == 0) EB2_ISSUE(G + 1, 1); else EB2_ISSUE(G + 1, 0); }
            asm volatile("" ::: "memory");
#pragma unroll
            for (int c = 0; c < 4; ++c) { const int ai = G >> 1, m = 2 * (G & 1) + (c >> 1), bj = c & 1; const u32x4 g = gq[G & 1][c];
                float o[8];
                o[0] = bf_lo(g.x) * acc[ai][bj][m][0][0]; o[1] = bf_hi(g.x) * acc[ai][bj][m][0][1]; o[2] = bf_lo(g.y) * acc[ai][bj][m][0][2]; o[3] = bf_hi(g.y) * acc[ai][bj][m][0][3];
                o[4] = bf_lo(g.z) * acc[ai][bj][m][1][0]; o[5] = bf_hi(g.z) * acc[ai][bj][m][1][1]; o[6] = bf_lo(g.w) * acc[ai][bj][m][1][2]; o[7] = bf_hi(g.w) * acc[ai][bj][m][1][3];
                if (!FIRST) { const u32x4 p = pq[G & 1][c];
                    o[0] += bf_lo(p.x); o[1] += bf_hi(p.x); o[2] += bf_lo(p.y); o[3] += bf_hi(p.y); o[4] += bf_lo(p.z); o[5] += bf_hi(p.z); o[6] += bf_lo(p.w); o[7] += bf_hi(p.w); }
                u32x4 w; w.x = cvt_pk_bf16(o[0], o[1]); w.y = cvt_pk_bf16(o[2], o[3]); w.z = cvt_pk_bf16(o[4], o[5]); w.w = cvt_pk_bf16(o[6], o[7]);
                *(u32x4*)(mp0 + (size_t)(ai * 128 + m * 16) * 1024 + bj * 128) = w; }
            asm volatile("" ::: "memory");
        }
#undef EB2_ISSUE
    }
};
__device__ __forceinline__ unsigned pack4_u8(float a, float b, float c, float d) {
    return (unsigned)(a * 255.0f + 0.5f) | ((unsigned)(b * 255.0f + 0.5f) << 8) | ((unsigned)(c * 255.0f + 0.5f) << 16) | ((unsigned)(d * 255.0f + 0.5f) << 24); }
template <int NP> struct EpiGate8 {
    bf16_t* scr; const PG8_LAS float* tab; int ui;
    __device__ __forceinline__ void operator()(const f32x4 (&acc)[2][2][4][2], const Unit& u, int wr, int wc, int fr0, int fq0) const {
        int fr = fr0, fq = fq0; asm volatile("" : "+v"(fr), "+v"(fq));
        float r[2][4]; row_scales_tab(tab, ui, wr, fr, r);
        unsigned char* t8 = (unsigned char*)(scr + (size_t)(u.pm * 4 + u.pn) * 65536) + (size_t)threadIdx.x * 16;
#pragma unroll
        for (int ai = 0; ai < 2; ++ai)
#pragma unroll
            for (int m = 0; m < 4; ++m) { const float rr = r[ai][m]; u32x4 w;
#pragma unroll
                for (int bj = 0; bj < 2; ++bj) { float o[8];
#pragma unroll
                    for (int n = 0; n < 2; ++n)
#pragma unroll
                        for (int j = 0; j < 4; ++j) o[4 * n + j] = sigmoid_f(acc[ai][bj][m][n][j] * rr);
                    w[2 * bj] = pack4_u8(o[0], o[1], o[2], o[3]); w[2 * bj + 1] = pack4_u8(o[4], o[5], o[6], o[7]); }
                *(u32x4*)(t8 + (ai * 4 + m) * 8192) = w; }
    }
};
template <bool FIRST> struct EpiBranch8 {
    const bf16_t* scr; bf16_t* mg;
    __device__ __forceinline__ void operator()(const f32x4 (&acc)[2][2][4][2], const Unit& u, int wr, int wc, int fr0, int fq0) const {
        int fr = fr0, fq = fq0; asm volatile("" : "+v"(fr), "+v"(fq));
        const unsigned char* t8 = (const unsigned char*)(scr + (size_t)(u.pm * 4 + u.pn) * 65536) + (size_t)threadIdx.x * 16;
        bf16_t* mp0 = mg + (size_t)(u.pm * BM + wr * 64 + fr) * 1024 + u.pn * BM + wc * 32 + 8 * fq;
        u32x4 gq[2][2], pq[2][4];
#define EB8_ISSUE(G, B) do { _Pragma("unroll") for (int c = 0; c < 4; ++c) { const int ai = (G) >> 1, m = 2 * ((G) & 1) + (c >> 1), bj = c & 1; \
            if (bj == 0) gq[B][c >> 1] = *(const u32x4*)(t8 + (ai * 4 + m) * 8192); if (!FIRST) pq[B][c] = *(const u32x4*)(mp0 + (size_t)(ai * 128 + m * 16) * 1024 + bj * 128); } } while (0)
        EB8_ISSUE(0, 0);
#pragma unroll
        for (int G = 0; G < 4; ++G) {
            if (G + 1 < 4) { if ((G & 1) == 0) EB8_ISSUE(G + 1, 1); else EB8_ISSUE(G + 1, 0); }
            asm volatile("" ::: "memory");
#pragma unroll
            for (int c = 0; c < 4; ++c) { const int ai = G >> 1, m = 2 * (G & 1) + (c >> 1), bj = c & 1; const u32x4 gg = gq[G & 1][c >> 1];
                const unsigned g0 = bj ? gg.z : gg.x, g1 = bj ? gg.w : gg.y; const float k = 1.0f / 255.0f;
                float o[8];
                o[0] = (float)(g0 & 0xffu) * (acc[ai][bj][m][0][0] * k); o[1] = (float)((g0 >> 8) & 0xffu) * (acc[ai][bj][m][0][1] * k); o[2] = (float)((g0 >> 16) & 0xffu) * (acc[ai][bj][m][0][2] * k); o[3] = (float)(g0 >> 24) * (acc[ai][bj][m][0][3] * k);
                o[4] = (float)(g1 & 0xffu) * (acc[ai][bj][m][1][0] * k); o[5] = (float)((g1 >> 8) & 0xffu) * (acc[ai][bj][m][1][1] * k); o[6] = (float)((g1 >> 16) & 0xffu) * (acc[ai][bj][m][1][2] * k); o[7] = (float)(g1 >> 24) * (acc[ai][bj][m][1][3] * k);
                if (!FIRST) { const u32x4 p = pq[G & 1][c];
                    o[0] += bf_lo(p.x); o[1] += bf_hi(p.x); o[2] += bf_lo(p.y); o[3] += bf_hi(p.y); o[4] += bf_lo(p.z); o[5] += bf_hi(p.z); o[6] += bf_lo(p.w); o[7] += bf_hi(p.w); }
                u32x4 w; w.x = cvt_pk_bf16(o[0], o[1]); w.y = cvt_pk_bf16(o[2], o[3]); w.z = cvt_pk_bf16(o[4], o[5]); w.w = cvt_pk_bf16(o[6], o[7]);
                *(u32x4*)(mp0 + (size_t)(ai * 128 + m * 16) * 1024 + bj * 128) = w; }
            asm volatile("" ::: "memory");
        }
#undef EB8_ISSUE
    }
};
template <size_t O_HB, size_t O_WG, size_t O_A0, size_t O_A1, size_t O_A2, size_t O_WB> struct P7Order {
    StaticOrder T; const char* ws;
    __device__ __forceinline__ bool next(int i, UnitX& u) const { const int rd = i / 6; Unit t; if (!T.next(rd, t)) return false; u.pm = t.pm; u.pn = t.pn; u.kind = i - 6 * rd; u.round = rd; return true; }
    __device__ __forceinline__ OpsX ops(const UnitX& u) const { const int j = u.kind >> 1; OpsX o;
        if (u.kind & 1) { o.K = 512; o.A = ws + (j == 0 ? O_A0 : j == 1 ? O_A1 : O_A2) + (size_t)u.pm * (256 * 512 * 2); o.Bt = ws + O_WB + (size_t)j * (1024 * 512 * 2) + (size_t)u.pn * (256 * 512 * 2); }
        else { o.K = 1024; o.A = ws + O_HB + (size_t)u.pm * (256 * 1024 * 2); o.Bt = ws + O_WG + (size_t)j * (1024 * 1024 * 2) + (size_t)u.pn * (256 * 1024 * 2); }
        return o; }
};
struct EpiP7 {
    bf16_t* scr; bf16_t* mg; const PG8_LAS float* tab;
    __device__ __forceinline__ void operator()(const f32x4 (&acc)[2][2][4][2], const UnitX& u, int wr, int wc, int fr, int fq) const {
        const Unit uu{u.pm, u.pn};
        if (u.kind == 1) { const EpiBranch8<true> b{scr, mg}; b(acc, uu, wr, wc, fr, fq); }
        else if (u.kind & 1) { const EpiBranch8<false> b{scr, mg}; b(acc, uu, wr, wc, fr, fq); }
        else { const EpiGate8<16> g{scr, tab, u.round}; g(acc, uu, wr, wc, fr, fq); }
    }
};
struct ProjOut { bf16_t *FQ, *FK, *FV, *DQ, *IQ, *MQ, *DK, *DV, *IK; float *LOGF, *IW; const float *cosT, *sinT, *g_fq, *g_fk, *g_dq, *g_dk, *b_forget; };
__device__ __forceinline__ float log_sigmoid_f(float z) { const float t = __builtin_amdgcn_exp2f(-fabsf(z) * 1.44269504f); return fminf(z, 0.f) - __builtin_amdgcn_logf(1.0f + t) * 0.69314718f; }
template <int NP> struct EpiProj {
    static constexpr bool PERM = true, AFTER_DRAIN = false;
    ProjOut P; const PG8_LAS float* tab; float qscale; mutable int ui = 0;
    __device__ __forceinline__ void operator()(const f32x4 (&acc)[2][2][4][2], const Unit& u, int wr, int wc, int fr0, int fq0) const {
        int fr = fr0, fq = fq0; asm volatile("" : "+v"(fr), "+v"(fq));
        float r[2][4]; row_scales_tab(tab, ui++, wr, fr, r);
        const int pn = u.pn;
        bool do_norm = false, do_rope = false; const float* gain = nullptr; bf16_t* dst = nullptr; int pitch = 512, hoff = 0; float osc = 1.f;
        if (pn < 2)       { do_norm = true; gain = P.g_fq; dst = P.FQ; hoff = (4 * pn + wc) * 64; osc = qscale; }
        else if (pn < 4)  { do_norm = true; gain = P.g_fk; dst = P.FK; hoff = (4 * (pn - 2) + wc) * 64; }
        else if (pn < 6)  { dst = P.FV; hoff = (4 * (pn - 4) + wc) * 64; }
        else if (pn < 8)  { do_norm = true; do_rope = true; gain = P.g_dq; dst = P.DQ; hoff = (4 * (pn - 6) + wc) * 64; osc = qscale; }
        else if (pn < 10) { do_rope = true; dst = P.IQ; hoff = (4 * (pn - 8) + wc) * 64; }
        else if (pn < 12) { dst = P.MQ; hoff = (2 * (pn - 10) + (wc >> 1)) * 128 + (wc & 1) * 64; }
        else { pitch = 64;
            if (wc == 0)      { do_norm = true; do_rope = true; gain = P.g_dk; dst = P.DK; }
            else if (wc == 1) { dst = P.DV; }
            else if (wc == 2) { do_rope = true; dst = P.IK; }
            else dst = nullptr; }
        if (dst == nullptr) {
            if (fq < 2) {
#pragma unroll
                for (int ai = 0; ai < 2; ++ai)
#pragma unroll
                    for (int m = 0; m < 4; ++m) { const int row = u.pm * BM + ai * HALF + wr * 64 + m * 16 + fr; const float rr = r[ai][m];
                        f32x4 v0 = acc[ai][0][m][0] * rr, v1 = acc[ai][0][m][1] * rr;
                        if (fq == 0) {
                            const f32x4 b0 = *(const f32x4*)(P.b_forget), b1 = *(const f32x4*)(P.b_forget + 4);
#pragma unroll
                            for (int j = 0; j < 4; ++j) { v0[j] = log_sigmoid_f(v0[j] + b0[j]); v1[j] = log_sigmoid_f(v1[j] + b1[j]); }
                            *(f32x4*)(P.LOGF + (size_t)row * 8) = v0; *(f32x4*)(P.LOGF + (size_t)row * 8 + 4) = v1;
                        } else { const float c = 0.04419417382f; *(f32x4*)(P.IW + (size_t)row * 8) = v0 * c; *(f32x4*)(P.IW + (size_t)row * 8 + 4) = v1 * c; } }
            }
            return;
        }
        const bool ikl = (pn == 12 && wc == 2);
        if (do_norm) { if (do_rope) body<true, true, false>(acc, u, r, gain, dst, pitch, hoff, osc, wr, fr, fq); else body<true, false, false>(acc, u, r, gain, dst, pitch, hoff, osc, wr, fr, fq); }
        else if (do_rope) { if (ikl) body<false, true, true>(acc, u, r, gain, dst, pitch, hoff, osc, wr, fr, fq); else body<false, true, false>(acc, u, r, gain, dst, pitch, hoff, osc, wr, fr, fq); }
        else body<false, false, false>(acc, u, r, gain, dst, pitch, hoff, osc, wr, fr, fq);
    }
    template <bool NORM, bool ROPE, bool IKL>
    __device__ __forceinline__ void body(const f32x4 (&acc)[2][2][4][2], const Unit& u, const float (&r)[2][4], const float* gain, bf16_t* dst, int pitch, int hoff, float osc, int wr, int fr, int fq) const {
        f32x4 gv[2][2];
        if (NORM) {
#pragma unroll
            for (int bj = 0; bj < 2; ++bj)
#pragma unroll
                for (int n = 0; n < 2; ++n) gv[bj][n] = *(const f32x4*)(gain + bj * 32 + 8 * fq + 4 * n);
        }
        f32x4 cq[2][4];
        const int rowb = u.pm * BM + wr * 64 + fr;
#define EP_ISSUE(I, B) do { const size_t ro_ = (size_t)(rowb + ((I) >> 2) * HALF + ((I) & 3) * 16) * 32 + 8 * fq; \
            cq[B][0] = *(const f32x4*)(P.cosT + ro_); cq[B][1] = *(const f32x4*)(P.cosT + ro_ + 4); cq[B][2] = *(const f32x4*)(P.sinT + ro_); cq[B][3] = *(const f32x4*)(P.sinT + ro_ + 4); } while (0)
        if (ROPE) EP_ISSUE(0, 0);
#pragma unroll
        for (int ai = 0; ai < 2; ++ai)
#pragma unroll
            for (int m = 0; m < 4; ++m) {
                const int row = u.pm * BM + ai * HALF + wr * 64 + m * 16 + fr; const float rr = r[ai][m];
                if (ROPE) { if (4 * ai + m + 1 < 8) { if (((4 * ai + m) & 1) == 0) EP_ISSUE(4 * ai + m + 1, 1); else EP_ISSUE(4 * ai + m + 1, 0); } asm volatile("" ::: "memory"); }
                f32x4 v[2][2];
#pragma unroll
                for (int bj = 0; bj < 2; ++bj)
#pragma unroll
                    for (int n = 0; n < 2; ++n) v[bj][n] = acc[ai][bj][m][n] * rr;
                if (NORM) {
                    float ss = 0.f;
#pragma unroll
                    for (int bj = 0; bj < 2; ++bj)
#pragma unroll
                        for (int n = 0; n < 2; ++n) ss += (v[bj][n][0] * v[bj][n][0] + v[bj][n][1] * v[bj][n][1]) + (v[bj][n][2] * v[bj][n][2] + v[bj][n][3] * v[bj][n][3]);
                    ss = x16_sum(ss); ss = x32_sum(ss);
                    const float inv = __builtin_amdgcn_rsqf(ss * (1.0f / 64.0f) + RMS_EPS);
#pragma unroll
                    for (int bj = 0; bj < 2; ++bj)
#pragma unroll
                        for (int n = 0; n < 2; ++n) v[bj][n] = v[bj][n] * inv * gv[bj][n];
                }
                if (ROPE) {
#pragma unroll
                    for (int n = 0; n < 2; ++n) {
                        const f32x4 c = cq[(4 * ai + m) & 1][n], s = cq[(4 * ai + m) & 1][2 + n];
                        const f32x4 x1 = v[0][n], x2 = v[1][n];
                        v[0][n] = x1 * c - x2 * s; v[1][n] = x2 * c + x1 * s; }
                }
#pragma unroll
                for (int bj = 0; bj < 2; ++bj) {
                    const f32x4 a = v[bj][0] * osc, b = v[bj][1] * osc;
                    u32x4 w; w.x = cvt_pk_bf16(a[0], a[1]); w.y = cvt_pk_bf16(a[2], a[3]); w.z = cvt_pk_bf16(b[0], b[1]); w.w = cvt_pk_bf16(b[2], b[3]);
                    if (IKL) {
                        const int d = bj * 32 + 8 * fq; *(u32x4*)(dst + (size_t)(row >> 5) * 2048 + (d >> 4) * 512 + ((d >> 3) & 1) * 256 + (row & 31) * 8) = w;
                    } else *(u32x4*)(dst + (size_t)row * pitch + hoff + bj * 32 + 8 * fq) = w; }
                if (ROPE) asm volatile("" ::: "memory");
            }
#undef EP_ISSUE
    }
};
}
#define GAS __attribute__((address_space(1)))
#define LAS __attribute__((address_space(3)))
typedef unsigned short bf16;
typedef unsigned v4u __attribute__((ext_vector_type(4)));
typedef float f32x4 __attribute__((ext_vector_type(4)));
typedef short bf16x8 __attribute__((ext_vector_type(8)));
typedef GAS unsigned gu32;
typedef GAS unsigned long long gu64;
#define RLX_AGENT __ATOMIC_RELAXED, __HIP_MEMORY_SCOPE_AGENT
#define LDS_WAIT() asm volatile("s_waitcnt lgkmcnt(0)" ::: "memory")
#define VM_WAIT() asm volatile("s_waitcnt vmcnt(0)" ::: "memory")
__device__ __forceinline__ unsigned long long rt() { return __builtin_amdgcn_s_memrealtime(); }
__device__ __forceinline__ unsigned f2bf(float f) { unsigned u = __builtin_bit_cast(unsigned, f); return (u + 0x7fffu + ((u >> 16) & 1u)) >> 16; }
__device__ __forceinline__ unsigned pk2(float lo, float hi) { return f2bf(lo) | (f2bf(hi) << 16); }
typedef float f32x2g __attribute__((ext_vector_type(2)));
__device__ __forceinline__ float bf_lo32(unsigned w) { return __uint_as_float(w << 16); }
__device__ __forceinline__ float bf_hi32(unsigned w) { return __uint_as_float(w & 0xffff0000u); }
constexpr int NWAVES = 8;
constexpr int BATCH = 2, SEQ = 8192, DM = 1024, T = BATCH * SEQ, DFF = 2816, MEMLEN = 256, BW = 512, DIN = 6352;
constexpr int NPROJ = 13 * 256, NGATE = 3072;
constexpr float L2E = 1.4426950408889634f;
constexpr float C2_64 = 0.125f * L2E;
constexpr float C2_128 = 0.08838834764831845f * L2E;
constexpr size_t MiB = 1u << 20;
constexpr size_t WS_CTL = 0, CTL_ZERO_BYTES = 128 * 1024;
constexpr size_t WS_RSTDX = 1 * MiB;
constexpr size_t WS_RSTDM = WS_RSTDX + 64 * 1024;
constexpr size_t WS_T0 = WS_RSTDM + 4096;
constexpr size_t WS_SSQ1 = 2 * MiB;
constexpr size_t WS_SSQ2 = 3 * MiB;
constexpr size_t WS_LOGF = 4 * MiB;
constexpr size_t WS_CUM = WS_LOGF + 512 * 1024;
constexpr size_t WS_IW = 5 * MiB;
constexpr size_t WS_COS = 6 * MiB, WS_SIN = 8 * MiB;
constexpr size_t WS_MEMB = 10 * MiB;
constexpr size_t WS_KVM = 11 * MiB;
constexpr size_t WS_KMB = 13 * MiB, WS_VMB = 14 * MiB;
constexpr size_t WS_WGU1 = 16 * MiB;
constexpr size_t WS_WD1 = 27 * MiB;
constexpr size_t WS_WIN = 33 * MiB;
constexpr size_t WS_WGATE = 40 * MiB;
constexpr size_t WS_WBR = 46 * MiB;
constexpr size_t WS_WOUT = 49 * MiB;
constexpr size_t WS_WGU2 = 51 * MiB;
constexpr size_t WS_WD2 = 62 * MiB;
constexpr size_t WS_WMKV = 68 * MiB;
constexpr size_t WS_HB = 70 * MiB;
constexpr size_t WS_ACT = 102 * MiB;
constexpr size_t WS_HID = WS_ACT;
constexpr size_t WS_FQ = WS_ACT, WS_FK = WS_ACT + 16 * MiB, WS_FV = WS_ACT + 32 * MiB, WS_DQ = WS_ACT + 48 * MiB, WS_IQ = WS_ACT + 64 * MiB, WS_MQ = WS_ACT + 80 * MiB;
constexpr size_t WS_DK = WS_ACT + 96 * MiB, WS_DV = WS_ACT + 98 * MiB, WS_IK = WS_ACT + 100 * MiB;
#if defined(DBG_SUBST) && DBG_SUBST == 2
constexpr size_t WS_MERGED = WS_DQ;
#else
constexpr size_t WS_MERGED = WS_FK;
#endif
#ifdef DBG_GSCR_AT
constexpr size_t WS_GSCR = DBG_GSCR_AT;
#else
constexpr size_t WS_GSCR = 204 * MiB;
#endif
constexpr size_t WS_OA = 236 * MiB;
constexpr size_t WS_OB = 16 * MiB;
constexpr size_t WS_END = 252 * MiB;
#ifndef DBG_GSCR_AT
static_assert(WS_HID + (size_t)T * DFF * 2 <= WS_GSCR && WS_IK + (size_t)T * 64 * 2 <= WS_GSCR, "d_ws map");
#endif
constexpr int CW_BAR = 4096;
constexpr int CW_GRP = 20480;
constexpr int CW_Q = 16384;
constexpr int RING_OFF = 0, RING_BYTES = 131072;
constexpr int LDSCTL_OFF = RING_BYTES, MISC_OFF = LDSCTL_OFF + 320;
constexpr int LIST_OFF = RING_BYTES + 1024;
constexpr int SCANX_OFF = RING_BYTES + 6144;
constexpr int LDS_BYTES = 163840;
#define XB_TMO      128
#define XB_XCNT(j)  (256  + 64 * (j))
#define XB_XSUB(j)  (1280 + 64 * (j))
#define XB_XGEN(j)  (2304 + 64 * (j))
#define XB_TOP      3328
#define XB_TOPGEN   3392
#define XCD_BAR_WORDS 3456
#define XB_SPIN_CAP (1u << 18)

__device__ __forceinline__ unsigned xb_ld(unsigned* p)              { return __hip_atomic_load(p, __ATOMIC_RELAXED, __HIP_MEMORY_SCOPE_AGENT); }
__device__ __forceinline__ unsigned xb_add(unsigned* p, unsigned v) { return __hip_atomic_fetch_add(p, v, __ATOMIC_RELAXED, __HIP_MEMORY_SCOPE_AGENT); }
__device__ __forceinline__ unsigned xb_xcc_id() { return (unsigned)__builtin_amdgcn_s_getreg((3 << 11) | 20) & 0xFu; }
#define XB_SPIN(cond, bar) do { unsigned _sp = 0; while (cond) { __builtin_amdgcn_s_sleep(1); \
    if ((++_sp & 255u) == 0u) { if (xb_ld(&(bar)[XB_TMO])) break; if (_sp > XB_SPIN_CAP) { atomicAdd(&(bar)[XB_TMO], 1u); break; } } } } while (0)

struct XcdBarrier {
    unsigned* bar; unsigned x;
    volatile LAS unsigned* st;
};

__device__ __forceinline__ XcdBarrier xcd_barrier_post(unsigned* bar, volatile LAS unsigned* st) {
    XcdBarrier b; b.bar = bar; b.x = xb_xcc_id(); b.st = st;
    if (threadIdx.x == 0) (void)xb_add(&bar[XB_XCNT(b.x)], 1u);
    return b;
}
__device__ __forceinline__ void xcd_barrier_complete(unsigned* bar, unsigned x, unsigned& nloc, unsigned& nx) {
    const unsigned G = gridDim.x * gridDim.y * gridDim.z;
    unsigned sum, cnt, mine, sp = 0u;
    for (;;) {
        sum = 0u; cnt = 0u; mine = 0u;
#pragma unroll
        for (unsigned j = 0; j < 16; ++j) { const unsigned c = xb_ld(&bar[XB_XCNT(j)]); sum += c; cnt += (c > 0u) ? 1u : 0u; mine = (j == x) ? c : mine; }
        if (sum == G) break;
        __builtin_amdgcn_s_sleep(1);
        if ((++sp & 255u) == 0u) { if (xb_ld(&bar[XB_TMO])) break; if (sp > XB_SPIN_CAP) { atomicAdd(&bar[XB_TMO], 1u); break; } }
    }
    nloc = mine > 0u ? mine : 1u; nx = cnt > 0u ? cnt : 1u;
}

__device__ __forceinline__ void xcd_barrier(const XcdBarrier& b) {
    asm volatile("s_waitcnt vmcnt(0)" ::: "memory");
    __syncthreads();
    if (threadIdx.x == 0) {
        unsigned* bar = b.bar;
        __builtin_amdgcn_s_waitcnt(0);
        unsigned nloc = b.st[0], nx = b.st[1];
        if (nloc == 0u) { xcd_barrier_complete(bar, b.x, nloc, nx); b.st[0] = nloc; b.st[1] = nx; }
        const unsigned old = xb_add(&bar[XB_XSUB(b.x)], 1u);
        const unsigned gen = old / nloc;
        if (old + 1u == (gen + 1u) * nloc) {
            __builtin_amdgcn_fence(__ATOMIC_RELEASE, "agent");
            asm volatile("s_waitcnt vmcnt(0)" ::: "memory");
            const unsigned og = xb_add(&bar[XB_TOP], 1u);
            const unsigned tg = og / nx;
            if (og + 1u == (tg + 1u) * nx) xb_add(&bar[XB_TOPGEN], 1u);
            else XB_SPIN(xb_ld(&bar[XB_TOPGEN]) == tg, bar);
            __builtin_amdgcn_fence(__ATOMIC_ACQUIRE, "agent");
            xb_add(&bar[XB_XGEN(b.x)], 1u);
            asm volatile("s_waitcnt vmcnt(0)" ::: "memory");
        } else {
            XB_SPIN(xb_ld(&bar[XB_XGEN(b.x)]) == gen, bar);
            __builtin_amdgcn_fence(__ATOMIC_ACQUIRE, "agent");
            asm volatile("s_waitcnt vmcnt(0)" ::: "memory");
        }
    }
    __syncthreads();
}
__device__ __forceinline__ void grp_barrier(const XcdBarrier& b, unsigned* gw, unsigned g, unsigned gsz) {
    asm volatile("s_waitcnt vmcnt(0)" ::: "memory");
    __syncthreads();
    if (threadIdx.x == 0) {
        __builtin_amdgcn_s_waitcnt(0);
        const unsigned old = xb_add(&gw[1024 + 64 * g], 1u);
        const unsigned gen = old / gsz;
        if (old + 1u == (gen + 1u) * gsz) xb_add(&gw[2048 + 64 * g], 1u);
        else XB_SPIN(xb_ld(&gw[2048 + 64 * g]) == gen, b.bar);
        __builtin_amdgcn_fence(__ATOMIC_ACQUIRE, "agent");
        asm volatile("s_waitcnt vmcnt(0)" ::: "memory");
    }
    __syncthreads();
}
__device__ __forceinline__ float wave_sum(float v) {
#pragma unroll
    for (int o = 1; o < 64; o <<= 1) v += __shfl_xor(v, o);
    return v;
}
__device__ __forceinline__ float wave_max(float v) {
#pragma unroll
    for (int o = 1; o < 64; o <<= 1) v = fmaxf(v, __shfl_xor(v, o));
    return v;
}
__device__ __forceinline__ int colmap(int mat, int n) {
    if (mat == 1) return n;
    if (mat == 3) return 3280 + n;
    const int tile = n >> 8, t = n & 255;
    if (mat == 0) return (t < 128 ? 0 : DFF) + 128 * tile + (t & 127);
    const int bj = t >> 7, wc = (t >> 5) & 3, i = t & 31, d = bj * 32 + i;
    if (tile < 2) return 0 + (4 * tile + wc) * 64 + d;
    if (tile < 4) return 512 + (4 * (tile - 2) + wc) * 64 + d;
    if (tile < 6) return 1024 + (4 * (tile - 4) + wc) * 64 + d;
    if (tile < 8) return 1544 + (4 * (tile - 6) + wc) * 64 + d;
    if (tile < 10) return 2184 + (4 * (tile - 8) + wc) * 64 + d;
    if (tile < 12) return 2768 + (2 * (tile - 10) + (wc >> 1)) * 128 + (wc & 1) * 64 + d;
    if (wc == 0) return 2056 + d;
    if (wc == 1) return 2120 + d;
    if (wc == 2) return 2696 + d;
    if (bj == 0 && i < 8) return 1536 + i;
    if (bj == 0 && i < 16) return 2760 + (i - 8);
    return -1;
}
template <bool GAIN> __device__ __forceinline__ void transpose_item(int mat, const float* Wa, const float* Wb, int K, int Nsrc, const float* gain, bf16* WT, LAS float* scr, int item, int nblk, int lane) {
    const int kb = item / nblk, nb = item % nblk, k0 = 64 * kb, n0 = 32 * nb;
    int col = colmap(mat, n0 + (lane & 31)); const float* W = Wa;
    if (mat == 0 && col >= DFF) { W = Wb; col -= DFF; }
    const bool okc = col >= 0; const float* wp = W + (size_t)(k0 + (lane >> 5)) * Nsrc + (okc ? col : 0); const float* gp = gain + k0 + (lane >> 5);
    float v[32];
#pragma unroll
    for (int i = 0; i < 32; ++i) v[i] = __builtin_nontemporal_load(wp + (size_t)(2 * i) * Nsrc);
    if (GAIN) {
#pragma unroll
        for (int i = 0; i < 32; ++i) v[i] *= gp[2 * i]; }
#pragma unroll
    for (int i = 0; i < 32; ++i) scr[(2 * i + (lane >> 5)) * 33 + (lane & 31)] = okc ? v[i] : 0.f;
    LDS_WAIT(); asm volatile("" ::: "memory");
    const int c = lane & 7;
#pragma unroll
    for (int j = 0; j < 4; ++j) { const int n = (lane >> 3) + 8 * j; const LAS float* s = scr + (8 * c) * 33 + n;
        v4u o; o.x = pk2(s[0 * 33], s[1 * 33]); o.y = pk2(s[2 * 33], s[3 * 33]); o.z = pk2(s[4 * 33], s[5 * 33]); o.w = pk2(s[6 * 33], s[7 * 33]);
        *(GAS v4u*)(WT + (size_t)(n0 + n) * K + k0 + 8 * c) = o; }
    LDS_WAIT(); asm volatile("" ::: "memory");
}
__device__ __forceinline__ void row_to_bf16_rstd(const float* xrow, bf16* orow, float* rstd_out, int lane) {
    const GAS f32x4* xr = (const GAS f32x4*)xrow + lane;
    f32x4 v[4]; float s = 0.f;
#pragma unroll
    for (int j = 0; j < 4; ++j) { v[j] = xr[64 * j]; s += (v[j].x * v[j].x + v[j].y * v[j].y) + (v[j].z * v[j].z + v[j].w * v[j].w); }
    const float rstd = 1.0f / sqrtf(wave_sum(s) * (1.f / 1024.f) + 1e-6f);
    GAS unsigned long long* o8 = (GAS unsigned long long*)orow + lane;
#pragma unroll
    for (int j = 0; j < 4; ++j) o8[64 * j] = (unsigned long long)pk2(v[j].x, v[j].y) | ((unsigned long long)pk2(v[j].z, v[j].w) << 32);
    if (lane == 0) *rstd_out = rstd;
}
__device__ __forceinline__ void rows4_to_bf16_rstd(const float* const (&xrow)[4], bf16* const (&orow)[4], float* const (&rout)[4], const bool (&ok)[4], int lane) {
    f32x4 v[4][4];
#pragma unroll
    for (int r = 0; r < 4; ++r) { const GAS f32x4* xr = (const GAS f32x4*)xrow[r] + lane;
#pragma unroll
        for (int j = 0; j < 4; ++j) v[r][j] = __builtin_nontemporal_load(xr + 64 * j); }
#pragma unroll
    for (int r = 0; r < 4; ++r) { float s = 0.f;
#pragma unroll
        for (int j = 0; j < 4; ++j) s += (v[r][j].x * v[r][j].x + v[r][j].y * v[r][j].y) + (v[r][j].z * v[r][j].z + v[r][j].w * v[r][j].w);
        const float rstd = 1.0f / sqrtf(wave_sum(s) * (1.f / 1024.f) + 1e-6f);
        if (ok[r]) { GAS unsigned long long* o8 = (GAS unsigned long long*)orow[r] + lane;
#pragma unroll
            for (int j = 0; j < 4; ++j) o8[64 * j] = (unsigned long long)pk2(v[r][j].x, v[r][j].y) | ((unsigned long long)pk2(v[r][j].z, v[r][j].w) << 32);
            if (lane == 0) *rout[r] = rstd; } }
}
typedef float f32x16 __attribute__((ext_vector_type(16)));
typedef unsigned u32x2 __attribute__((ext_vector_type(2)));
__device__ __forceinline__ int crow(int r, int hi) { return (r & 3) + 8 * (r >> 2) + 4 * hi; }
__device__ __forceinline__ float bf2f(bf16 v) { return __uint_as_float((unsigned)v << 16); }
__device__ __forceinline__ unsigned cvtpk(float lo, float hi) { return pg8::cvt_pk_bf16(lo, hi); }
template <int HD, bool FOX, bool VT>
__device__ __forceinline__ void attn_wave_simple(const bf16x8 (&qr)[HD / 16], const bf16* Kp, int kpitch, const bf16* Vp, int vpitch, int tstart, int ntiles, int qlocal, const float* cb, bf16* Op, int opitch, int lane) {
    const int r32 = lane & 31, hi = lane >> 5;
    f32x16 o[HD / 32];
#pragma unroll
    for (int d0 = 0; d0 < HD / 32; ++d0)
#pragma unroll
        for (int r = 0; r < 16; ++r) o[d0][r] = 0.f;
    float m = -1e30f, l = 0.f;
    for (int t = tstart; t < ntiles; ++t) {
        const int kv0 = 32 * t;
        f32x16 p;
#pragma unroll
        for (int r = 0; r < 16; ++r) p[r] = 0.f;
        const bf16* kr = Kp + (size_t)(kv0 + r32) * kpitch + hi * 8;
#pragma unroll
        for (int ks = 0; ks < HD / 16; ++ks) { const bf16x8 kf = *(const bf16x8*)(kr + ks * 16); p = __builtin_amdgcn_mfma_f32_32x32x16_bf16(kf, qr[ks], p, 0, 0, 0); }
        if (FOX) {
#pragma unroll
            for (int g = 0; g < 4; ++g) { const f32x4 c4 = *(const f32x4*)(cb + kv0 + 8 * g + 4 * hi);
#pragma unroll
                for (int jj = 0; jj < 4; ++jj) p[4 * g + jj] -= L2E * c4[jj]; }
            if (t == ntiles - 1) {
#pragma unroll
                for (int r = 0; r < 16; ++r) if (kv0 + crow(r, hi) > qlocal) p[r] = -INFINITY;
            }
        }
        float mt = p[0];
#pragma unroll
        for (int r = 1; r < 16; ++r) mt = fmaxf(mt, p[r]);
        mt = pg8::x32_max(mt);
        const float mn = fmaxf(m, mt); const float alpha = __builtin_amdgcn_exp2f(m - mn); m = mn;
        l *= alpha;
#pragma unroll
        for (int d0 = 0; d0 < HD / 32; ++d0)
#pragma unroll
            for (int r = 0; r < 16; ++r) o[d0][r] *= alpha;
        float ls = 0.f;
#pragma unroll
        for (int r = 0; r < 16; ++r) { p[r] = __builtin_amdgcn_exp2f(p[r] - mn); ls += p[r]; }
        l += ls;
        bf16x8 pa[2];
#pragma unroll
        for (int s = 0; s < 2; ++s) { v4u w; w.x = cvtpk(p[8 * s + 0], p[8 * s + 1]); w.y = cvtpk(p[8 * s + 2], p[8 * s + 3]); w.z = cvtpk(p[8 * s + 4], p[8 * s + 5]); w.w = cvtpk(p[8 * s + 6], p[8 * s + 7]); pa[s] = __builtin_bit_cast(bf16x8, w); }
#pragma unroll
        for (int d0 = 0; d0 < HD / 32; ++d0)
#pragma unroll
            for (int s = 0; s < 2; ++s) {
                bf16x8 vf;
                if (VT) {
                    const bf16* vp = Vp + (size_t)(d0 * 32 + r32) * vpitch + kv0 + 16 * s + 4 * hi;
                    const u32x2 lo = *(const u32x2*)vp, hi2 = *(const u32x2*)(vp + 8);
                    vf = __builtin_bit_cast(bf16x8, (v4u){lo.x, lo.y, hi2.x, hi2.y});
                } else {
#pragma unroll
                    for (int j = 0; j < 8; ++j) vf[j] = (short)Vp[(size_t)(kv0 + 16 * s + 8 * (j >> 2) + 4 * hi + (j & 3)) * vpitch + d0 * 32 + r32];
                }
                o[d0] = __builtin_amdgcn_mfma_f32_32x32x16_bf16(vf, pa[s], o[d0], 0, 0, 0);
            }
    }
    l = pg8::x32_sum(l);
    const float inv = 1.0f / l;
    bf16* orow = Op + (size_t)r32 * opitch;
#pragma unroll
    for (int d0 = 0; d0 < HD / 32; ++d0)
#pragma unroll
        for (int g = 0; g < 4; ++g) { u32x2 w; w.x = cvtpk(o[d0][4 * g] * inv, o[d0][4 * g + 1] * inv); w.y = cvtpk(o[d0][4 * g + 2] * inv, o[d0][4 * g + 3] * inv);
            *(u32x2*)(orow + d0 * 32 + 8 * g + 4 * hi) = w; }
}
__device__ __forceinline__ void fox_unit(int bh, int qb, const bf16* FQ, const bf16* FK, const bf16* FV, const float* CUM, const int* T0, bf16* OA, int wave, int lane) {
    const int b = bh >> 3, h = bh & 7, r32 = lane & 31, hi = lane >> 5; const size_t rowbase = (size_t)b * SEQ; const int q0 = qb * 256 + wave * 32;
    const bf16* Qw = FQ + (rowbase + q0) * 512 + h * 64; bf16* Ow = OA + (rowbase + q0) * 512 + h * 64;
    bf16x8 qr[4];
#pragma unroll
    for (int ks = 0; ks < 4; ++ks) qr[ks] = *(const bf16x8*)(Qw + (size_t)r32 * 512 + ks * 16 + hi * 8);
    attn_wave_simple<64, true, false>(qr, FK + rowbase * 512 + h * 64, 512, FV + rowbase * 512 + h * 64, 512, T0[bh * 256 + q0 / 32], q0 / 32 + 1, q0 + r32, CUM + (size_t)bh * SEQ, Ow, 512, lane);
}
__device__ __forceinline__ void mem_unit(int rg, int head, bf16* MQ, const bf16* KMB, const bf16* VMB, const float* gq, int lane) {
    const int r32 = lane & 31, hi = lane >> 5; const int row0 = rg * 32; const int b = row0 / SEQ;
    bf16* Qw = MQ + (size_t)row0 * 512 + head * 128;
    bf16x8 raw[8]; float ss = 0.f;
#pragma unroll
    for (int ks = 0; ks < 8; ++ks) { raw[ks] = *(const bf16x8*)(Qw + (size_t)r32 * 512 + ks * 16 + hi * 8);
#pragma unroll
        for (int j = 0; j < 8; ++j) { const float f = bf2f((bf16)raw[ks][j]); ss += f * f; } }
    ss = pg8::x32_sum(ss);
    const float rstd = __builtin_amdgcn_rsqf(ss * (1.0f / 128.0f) + 1e-6f) * C2_128;
    bf16x8 qr[8];
#pragma unroll
    for (int ks = 0; ks < 8; ++ks) { const f32x4 g0 = *(const f32x4*)(gq + ks * 16 + hi * 8), g1 = *(const f32x4*)(gq + ks * 16 + hi * 8 + 4); v4u w;
        w.x = cvtpk(bf2f((bf16)raw[ks][0]) * rstd * g0[0], bf2f((bf16)raw[ks][1]) * rstd * g0[1]); w.y = cvtpk(bf2f((bf16)raw[ks][2]) * rstd * g0[2], bf2f((bf16)raw[ks][3]) * rstd * g0[3]);
        w.z = cvtpk(bf2f((bf16)raw[ks][4]) * rstd * g1[0], bf2f((bf16)raw[ks][5]) * rstd * g1[1]); w.w = cvtpk(bf2f((bf16)raw[ks][6]) * rstd * g1[2], bf2f((bf16)raw[ks][7]) * rstd * g1[3]);
        qr[ks] = __builtin_bit_cast(bf16x8, w); }
    attn_wave_simple<128, false, true>(qr, KMB + (size_t)b * MEMLEN * 512 + head * 128, 512, VMB + (size_t)(b * 4 + head) * 128 * MEMLEN, MEMLEN, 0, MEMLEN / 32, 0, nullptr, Qw, 512, lane);
}
typedef short v4i16_t __attribute__((ext_vector_type(4)));
__device__ __forceinline__ void fox_block(int bh, int qb, const bf16* FQ, const bf16* FK, const bf16* FV, const float* CUM, const int* T0, const float* gq, const float* gk, bf16* OA, LAS unsigned char* lds, int wave, int lane, int tid) {
    const int b = bh >> 3, h = bh & 7, r32 = lane & 31, hi = lane >> 5; const size_t rowbase = (size_t)b * SEQ; const int q0 = qb * 256 + wave * 32;
    const bf16* Qw = FQ + (rowbase + q0) * 512 + h * 64; bf16* Ow = OA + (rowbase + q0) * 512 + h * 64;
    const bf16* Kp = FK + rowbase * 512 + h * 64; const bf16* Vp = FV + rowbase * 512 + h * 64; const float* cb = CUM + (size_t)bh * SEQ;
    LAS float* bl = (LAS float*)(lds + 32768);
    LAS int* flg = (LAS int*)(lds + 32768 + 512);
    bf16x8 qr[4];
#pragma unroll
    for (int ks = 0; ks < 4; ++ks) qr[ks] = *(const bf16x8*)(Qw + (size_t)r32 * 512 + ks * 16 + hi * 8);
    const int tlast = q0 / 32, tstart = T0[bh * 256 + tlast], qlocal = q0 + r32;
    int Tlo = tstart;
#pragma unroll
    for (int w8 = 0; w8 < 8; ++w8) { const int tv = T0[bh * 256 + qb * 8 + w8]; Tlo = tv < Tlo ? tv : Tlo; }
    const int Thi = qb * 8 + 7, nwalk = (Thi - Tlo + 2) >> 1;
    const float stopc = (8.0f * wave_max(fabsf(gq[lane])) * wave_max(fabsf(gk[lane])) + 30.0f) * L2E;
    f32x16 o[2];
#pragma unroll
    for (int d0 = 0; d0 < 2; ++d0)
#pragma unroll
        for (int r = 0; r < 16; ++r) o[d0][r] = 0.f;
    float m = -1e30f, l = 0.f; bool gone = false;
    const int kq = (lane >> 4) & 1, q_ = (lane & 15) >> 2, p_ = lane & 3;
    if (lane == 0) flg[wave] = 0;
    const int lrow = (tid & 255) >> 3, lch = tid & 7; const bf16* src = (tid < 256 ? Kp : Vp) + (size_t)lrow * 512 + lch * 8;
    const unsigned ldso = (tid < 256) ? (unsigned)(lrow * 128 + ((lch ^ (lrow & 7)) * 16)) : (unsigned)(4096 + lrow * 128 + lch * 16);
#define FB_TA(i_) (Thi - 2 * ((i_) < nwalk ? (i_) : nwalk - 1))
#define FB_LOAD(SA, SB, SC, i_) do { const int ta_ = FB_TA(i_), tb_ = ta_ > 0 ? ta_ - 1 : 0; SA = *(const v4u*)(src + (size_t)(32 * ta_) * 512); SB = *(const v4u*)(src + (size_t)(32 * tb_) * 512); SC = cb[32 * ((tid & 32) ? tb_ : ta_) + (tid & 31)]; } while (0)
#define FB_PUT(SLOT, SA, SB, SC) do { *(LAS v4u*)(lds + (SLOT) * 16384 + ldso) = SA; *(LAS v4u*)(lds + (SLOT) * 16384 + 8192 + ldso) = SB; if (tid < 64) bl[(SLOT) * 64 + tid] = -L2E * SC; } while (0)
    v4u sa0, sa1, sa2, sa3, sb0, sb1, sb2, sb3; float sc0, sc1, sc2, sc3;
    FB_LOAD(sa0, sb0, sc0, 0); FB_LOAD(sa1, sb1, sc1, 1); FB_LOAD(sa2, sb2, sc2, 2); FB_LOAD(sa3, sb3, sc3, 3);
    FB_PUT(0, sa0, sb0, sc0);
    __syncthreads();
    auto compute1 = [&](int t, int slot, int half) {
        const LAS unsigned char* kb = lds + slot * 16384 + half * 8192; const LAS unsigned char* vb = kb + 4096; const LAS float* bb = bl + slot * 64 + half * 32;
        if (t != tlast) { const float bmax = bb[31]; if (__all(m > bmax + stopc)) { gone = true; return; } }
        f32x16 p;
#pragma unroll
        for (int r = 0; r < 16; ++r) p[r] = 0.f;
#pragma unroll
        for (int ks = 0; ks < 4; ++ks) { const bf16x8 kf = *(const LAS bf16x8*)(kb + r32 * 128 + (((2 * ks + hi) ^ (r32 & 7)) * 16)); p = __builtin_amdgcn_mfma_f32_32x32x16_bf16(kf, qr[ks], p, 0, 0, 0); }
#pragma unroll
        for (int g = 0; g < 4; ++g) { const f32x4 c4 = *(const LAS f32x4*)(bb + 8 * g + 4 * hi);
#pragma unroll
            for (int jj = 0; jj < 4; ++jj) p[4 * g + jj] += c4[jj]; }
        if (t == tlast) {
#pragma unroll
            for (int r = 0; r < 16; ++r) if (32 * t + crow(r, hi) > qlocal) p[r] = -INFINITY;
        }
        float mt = p[0];
#pragma unroll
        for (int r = 1; r < 16; ++r) mt = fmaxf(mt, p[r]);
        mt = pg8::x32_max(mt);
        if (__any(mt > m)) {
            const float mn_ = fmaxf(m, mt); const float alpha = __builtin_amdgcn_exp2f(m - mn_); m = mn_;
            l *= alpha;
#pragma unroll
            for (int d0 = 0; d0 < 2; ++d0)
#pragma unroll
                for (int r = 0; r < 16; ++r) o[d0][r] *= alpha;
        }
        const float mn = m;
        float ls = 0.f;
#pragma unroll
        for (int r = 0; r < 16; ++r) { p[r] = __builtin_amdgcn_exp2f(p[r] - mn); ls += p[r]; }
        l += ls;
        bf16x8 pa[2];
#pragma unroll
        for (int s2 = 0; s2 < 2; ++s2) { v4u w; w.x = cvtpk(p[8 * s2 + 0], p[8 * s2 + 1]); w.y = cvtpk(p[8 * s2 + 2], p[8 * s2 + 3]); w.z = cvtpk(p[8 * s2 + 4], p[8 * s2 + 5]); w.w = cvtpk(p[8 * s2 + 6], p[8 * s2 + 7]); pa[s2] = __builtin_bit_cast(bf16x8, w); }
#pragma unroll
        for (int d0 = 0; d0 < 2; ++d0)
#pragma unroll
            for (int s2 = 0; s2 < 2; ++s2) {
                const LAS unsigned char* a1 = vb + (16 * s2 + 4 * hi + q_) * 128 + (32 * d0 + 16 * kq + 4 * p_) * 2;
                const v4i16_t lo4 = __builtin_amdgcn_ds_read_tr16_b64_v4i16((LAS v4i16_t*)a1), hi4 = __builtin_amdgcn_ds_read_tr16_b64_v4i16((LAS v4i16_t*)(a1 + 8 * 128));
                const bf16x8 vf = (bf16x8){lo4[0], lo4[1], lo4[2], lo4[3], hi4[0], hi4[1], hi4[2], hi4[3]};
                o[d0] = __builtin_amdgcn_mfma_f32_32x32x16_bf16(vf, pa[s2], o[d0], 0, 0, 0);
            }
    };
    auto compute2 = [&](int ta, int slot) {
        const LAS unsigned char* kb0 = lds + slot * 16384; const LAS unsigned char* vb0 = kb0 + 4096; const LAS unsigned char* kb1 = kb0 + 8192; const LAS unsigned char* vb1 = kb1 + 4096;
        const LAS float* bb0 = bl + slot * 64; const LAS float* bb1 = bb0 + 32;
        if (ta != tlast) { const float bmax = bb0[31]; if (__all(m > bmax + stopc)) { gone = true; return; } }
        f32x16 p1, p2;
#pragma unroll
        for (int r = 0; r < 16; ++r) { p1[r] = 0.f; p2[r] = 0.f; }
#pragma unroll
        for (int ks = 0; ks < 4; ++ks) { const int ko = r32 * 128 + (((2 * ks + hi) ^ (r32 & 7)) * 16); const bf16x8 kf1 = *(const LAS bf16x8*)(kb0 + ko), kf2 = *(const LAS bf16x8*)(kb1 + ko);
            p1 = __builtin_amdgcn_mfma_f32_32x32x16_bf16(kf1, qr[ks], p1, 0, 0, 0); p2 = __builtin_amdgcn_mfma_f32_32x32x16_bf16(kf2, qr[ks], p2, 0, 0, 0); }
#pragma unroll
        for (int g = 0; g < 4; ++g) { const f32x4 c4 = *(const LAS f32x4*)(bb0 + 8 * g + 4 * hi), d4 = *(const LAS f32x4*)(bb1 + 8 * g + 4 * hi);
#pragma unroll
            for (int jj = 0; jj < 4; ++jj) { p1[4 * g + jj] += c4[jj]; p2[4 * g + jj] += d4[jj]; } }
        if (ta == tlast) {
#pragma unroll
            for (int r = 0; r < 16; ++r) if (32 * ta + crow(r, hi) > qlocal) p1[r] = -INFINITY;
        }
        float mt = fmaxf(p1[0], p2[0]);
#pragma unroll
        for (int r = 1; r < 16; ++r) mt = fmaxf(mt, fmaxf(p1[r], p2[r]));
        mt = pg8::x32_max(mt);
        if (__any(mt > m)) {
            const float mn_ = fmaxf(m, mt); const float alpha = __builtin_amdgcn_exp2f(m - mn_); m = mn_;
            l *= alpha;
#pragma unroll
            for (int d0 = 0; d0 < 2; ++d0)
#pragma unroll
                for (int r = 0; r < 16; ++r) o[d0][r] *= alpha;
        }
        const float mn = m;
        float ls = 0.f, ls2 = 0.f;
#pragma unroll
        for (int r = 0; r < 16; ++r) { p1[r] = __builtin_amdgcn_exp2f(p1[r] - mn); ls += p1[r]; p2[r] = __builtin_amdgcn_exp2f(p2[r] - mn); ls2 += p2[r]; }
        l += ls + ls2;
        bf16x8 pa1[2], pa2[2];
#pragma unroll
        for (int s2 = 0; s2 < 2; ++s2) { v4u w; w.x = cvtpk(p1[8 * s2 + 0], p1[8 * s2 + 1]); w.y = cvtpk(p1[8 * s2 + 2], p1[8 * s2 + 3]); w.z = cvtpk(p1[8 * s2 + 4], p1[8 * s2 + 5]); w.w = cvtpk(p1[8 * s2 + 6], p1[8 * s2 + 7]); pa1[s2] = __builtin_bit_cast(bf16x8, w);
            v4u x; x.x = cvtpk(p2[8 * s2 + 0], p2[8 * s2 + 1]); x.y = cvtpk(p2[8 * s2 + 2], p2[8 * s2 + 3]); x.z = cvtpk(p2[8 * s2 + 4], p2[8 * s2 + 5]); x.w = cvtpk(p2[8 * s2 + 6], p2[8 * s2 + 7]); pa2[s2] = __builtin_bit_cast(bf16x8, x); }
#pragma unroll
        for (int s2 = 0; s2 < 2; ++s2)
#pragma unroll
            for (int d0 = 0; d0 < 2; ++d0) {
                const int vo = (16 * s2 + 4 * hi + q_) * 128 + (32 * d0 + 16 * kq + 4 * p_) * 2;
                const v4i16_t lo4 = __builtin_amdgcn_ds_read_tr16_b64_v4i16((LAS v4i16_t*)(vb0 + vo)), hi4 = __builtin_amdgcn_ds_read_tr16_b64_v4i16((LAS v4i16_t*)(vb0 + vo + 8 * 128));
                const v4i16_t lo5 = __builtin_amdgcn_ds_read_tr16_b64_v4i16((LAS v4i16_t*)(vb1 + vo)), hi5 = __builtin_amdgcn_ds_read_tr16_b64_v4i16((LAS v4i16_t*)(vb1 + vo + 8 * 128));
                const bf16x8 vf1 = (bf16x8){lo4[0], lo4[1], lo4[2], lo4[3], hi4[0], hi4[1], hi4[2], hi4[3]}, vf2 = (bf16x8){lo5[0], lo5[1], lo5[2], lo5[3], hi5[0], hi5[1], hi5[2], hi5[3]};
                o[d0] = __builtin_amdgcn_mfma_f32_32x32x16_bf16(vf1, pa1[s2], o[d0], 0, 0, 0); o[d0] = __builtin_amdgcn_mfma_f32_32x32x16_bf16(vf2, pa2[s2], o[d0], 0, 0, 0);
            }
    };
#define FB_STEP(i_, NA, NB, NC, FA, FB_, FC) do { \
        FB_LOAD(FA, FB_, FC, (i_) + 4); \
        if ((i_) < nwalk && !gone) { const int ta_ = Thi - 2 * (i_), tb_ = ta_ - 1; const bool ina = ta_ <= tlast && ta_ >= tstart, inb = tb_ <= tlast && tb_ >= tstart; \
            if (ina && inb) compute2(ta_, (i_) & 1); else if (ina) { compute1(ta_, (i_) & 1, 0); gone = true; } else if (inb) compute1(tb_, (i_) & 1, 1); else if (ta_ < tstart) gone = true; } \
        FB_PUT(((i_) + 1) & 1, NA, NB, NC); \
        asm volatile("s_waitcnt lgkmcnt(0)" ::: "memory"); __builtin_amdgcn_s_barrier(); asm volatile("" ::: "memory"); } while (0)
    for (int i = 0; i < nwalk; i += 4) {
        FB_STEP(i, sa1, sb1, sc1, sa0, sb0, sc0); FB_STEP(i + 1, sa2, sb2, sc2, sa1, sb1, sc1); FB_STEP(i + 2, sa3, sb3, sc3, sa2, sb2, sc2); FB_STEP(i + 3, sa0, sb0, sc0, sa3, sb3, sc3);
        if (lane == 0 && gone) flg[wave] = 1;
        asm volatile("s_waitcnt lgkmcnt(0)" ::: "memory"); __builtin_amdgcn_s_barrier(); asm volatile("" ::: "memory");
        int all = 1;
#pragma unroll
        for (int w8 = 0; w8 < 8; ++w8) all &= flg[w8];
        if (all) break;
    }
#undef FB_STEP
#undef FB_LOAD
#undef FB_PUT
#undef FB_TA
    l = pg8::x32_sum(l);
    const float inv = 1.0f / l;
    bf16* orow = Ow + (size_t)r32 * 512;
#pragma unroll
    for (int d0 = 0; d0 < 2; ++d0)
#pragma unroll
        for (int g = 0; g < 4; ++g) { u32x2 w; w.x = cvtpk(o[d0][4 * g] * inv, o[d0][4 * g + 1] * inv); w.y = cvtpk(o[d0][4 * g + 2] * inv, o[d0][4 * g + 3] * inv);
            *(u32x2*)(orow + d0 * 32 + 8 * g + 4 * hi) = w; }
    asm volatile("s_waitcnt vmcnt(0)" ::: "memory"); __syncthreads();
}
__device__ __forceinline__ void mem_block(int u, bf16* MQ, const bf16* KMB, const bf16* VNB, const float* gq, LAS unsigned char* lds, int wave, int lane, int tid) {
    const int head = u & 3, rg = (u >> 2) * 8 + wave, row0 = rg * 32, b = row0 / SEQ;
    const int r32 = lane & 31, hi = lane >> 5;
    {   const bf16* ks_ = KMB + (size_t)b * MEMLEN * 512 + head * 128; const bf16* vs_ = VNB + (size_t)b * MEMLEN * 512 + head * 128;
#pragma unroll
        for (int i = 0; i < 8; ++i) { const int e = tid + 512 * i, key = e >> 4, c = e & 15;
            const v4u kv = *(const v4u*)(ks_ + (size_t)key * 512 + c * 8), vv = *(const v4u*)(vs_ + (size_t)key * 512 + c * 8);
            *(LAS v4u*)(lds + key * 256 + ((c ^ (key & 7)) * 16)) = kv; *(LAS v4u*)(lds + 65536 + key * 256 + c * 16) = vv; } }
    bf16* Qw = MQ + (size_t)row0 * 512 + head * 128;
    bf16x8 raw[8]; float ss = 0.f;
#pragma unroll
    for (int ks = 0; ks < 8; ++ks) { raw[ks] = *(const bf16x8*)(Qw + (size_t)r32 * 512 + ks * 16 + hi * 8);
#pragma unroll
        for (int j = 0; j < 8; ++j) { const float f = bf2f((bf16)raw[ks][j]); ss += f * f; } }
    ss = pg8::x32_sum(ss);
    const float rstd = __builtin_amdgcn_rsqf(ss * (1.0f / 128.0f) + 1e-6f) * C2_128;
    bf16x8 qr[8];
#pragma unroll
    for (int ks = 0; ks < 8; ++ks) { const f32x4 g0 = *(const f32x4*)(gq + ks * 16 + hi * 8), g1 = *(const f32x4*)(gq + ks * 16 + hi * 8 + 4); v4u w;
        w.x = cvtpk(bf2f((bf16)raw[ks][0]) * rstd * g0[0], bf2f((bf16)raw[ks][1]) * rstd * g0[1]); w.y = cvtpk(bf2f((bf16)raw[ks][2]) * rstd * g0[2], bf2f((bf16)raw[ks][3]) * rstd * g0[3]);
        w.z = cvtpk(bf2f((bf16)raw[ks][4]) * rstd * g1[0], bf2f((bf16)raw[ks][5]) * rstd * g1[1]); w.w = cvtpk(bf2f((bf16)raw[ks][6]) * rstd * g1[2], bf2f((bf16)raw[ks][7]) * rstd * g1[3]);
        qr[ks] = __builtin_bit_cast(bf16x8, w); }
    __syncthreads();
    f32x16 o[4];
#pragma unroll
    for (int d0 = 0; d0 < 4; ++d0)
#pragma unroll
        for (int r = 0; r < 16; ++r) o[d0][r] = 0.f;
    float m = -1e30f, l = 0.f;
    const int kq = (lane >> 4) & 1, q_ = (lane & 15) >> 2, p_ = lane & 3;
#pragma unroll 1
    for (int t = 0; t < MEMLEN / 32; ++t) {
        const LAS unsigned char* kb = lds + (32 * t) * 256; const LAS unsigned char* vb = lds + 65536 + (32 * t) * 256;
        f32x16 p;
#pragma unroll
        for (int r = 0; r < 16; ++r) p[r] = 0.f;
#pragma unroll
        for (int ks = 0; ks < 8; ++ks) { const bf16x8 kf = *(const LAS bf16x8*)(kb + r32 * 256 + (((2 * ks + hi) ^ (r32 & 7)) * 16)); p = __builtin_amdgcn_mfma_f32_32x32x16_bf16(kf, qr[ks], p, 0, 0, 0); }
        float mt = p[0];
#pragma unroll
        for (int r = 1; r < 16; ++r) mt = fmaxf(mt, p[r]);
        mt = pg8::x32_max(mt);
        if (__any(mt > m)) { const float mn_ = fmaxf(m, mt); const float alpha = __builtin_amdgcn_exp2f(m - mn_); m = mn_; l *= alpha;
#pragma unroll
            for (int d0 = 0; d0 < 4; ++d0)
#pragma unroll
                for (int r = 0; r < 16; ++r) o[d0][r] *= alpha; }
        const float mn = m; float ls = 0.f;
#pragma unroll
        for (int r = 0; r < 16; ++r) { p[r] = __builtin_amdgcn_exp2f(p[r] - mn); ls += p[r]; }
        l += ls;
        bf16x8 pa[2];
#pragma unroll
        for (int s2 = 0; s2 < 2; ++s2) { v4u w; w.x = cvtpk(p[8 * s2 + 0], p[8 * s2 + 1]); w.y = cvtpk(p[8 * s2 + 2], p[8 * s2 + 3]); w.z = cvtpk(p[8 * s2 + 4], p[8 * s2 + 5]); w.w = cvtpk(p[8 * s2 + 6], p[8 * s2 + 7]); pa[s2] = __builtin_bit_cast(bf16x8, w); }
#pragma unroll
        for (int d0 = 0; d0 < 4; ++d0)
#pragma unroll
            for (int s2 = 0; s2 < 2; ++s2) {
                const LAS unsigned char* a1 = vb + (16 * s2 + 4 * hi + q_) * 256 + (32 * d0 + 16 * kq + 4 * p_) * 2;
                const v4i16_t lo4 = __builtin_amdgcn_ds_read_tr16_b64_v4i16((LAS v4i16_t*)a1), hi4 = __builtin_amdgcn_ds_read_tr16_b64_v4i16((LAS v4i16_t*)(a1 + 8 * 256));
                const bf16x8 vf = (bf16x8){lo4[0], lo4[1], lo4[2], lo4[3], hi4[0], hi4[1], hi4[2], hi4[3]};
                o[d0] = __builtin_amdgcn_mfma_f32_32x32x16_bf16(vf, pa[s2], o[d0], 0, 0, 0); }
    }
    l = pg8::x32_sum(l);
    const float inv = 1.0f / l;
    bf16* orow = Qw + (size_t)r32 * 512;
#pragma unroll
    for (int d0 = 0; d0 < 4; ++d0)
#pragma unroll
        for (int g = 0; g < 4; ++g) { u32x2 w; w.x = cvtpk(o[d0][4 * g] * inv, o[d0][4 * g + 1] * inv); w.y = cvtpk(o[d0][4 * g + 2] * inv, o[d0][4 * g + 3] * inv);
            *(u32x2*)(orow + d0 * 32 + 8 * g + 4 * hi) = w; }
    __syncthreads();
}
__device__ __forceinline__ void scan_unit(int bh, const float* LOGF, float* CUM, int* T0, const float* gq, const float* gk, LAS float* sx, LAS float* cl, int tid) {
    const int b = bh >> 3, h = bh & 7, lane = tid & 63, wave = tid >> 6;
    float v[16]; float run = 0.f;
#pragma unroll
    for (int i = 0; i < 16; ++i) v[i] = LOGF[((size_t)b * SEQ + 16 * tid + i) * 8 + h];
#pragma unroll
    for (int i = 0; i < 16; ++i) { run += v[i]; v[i] = run; }
    float tot = run;
#pragma unroll
    for (int off = 1; off < 64; off <<= 1) { const float nb = __shfl_up(tot, off); if (lane >= off) tot += nb; }
    if (lane == 63) sx[wave] = tot;
    __syncthreads();
    float woff = 0.f;
    for (int w = 0; w < wave; ++w) woff += sx[w];
    const float excl = tot - run + woff;
    float* dst = CUM + (size_t)bh * SEQ + 16 * tid;
#pragma unroll
    for (int i = 0; i < 16; i += 4) { const f32x4 o4 = (f32x4){v[i] + excl, v[i + 1] + excl, v[i + 2] + excl, v[i + 3] + excl}; *(f32x4*)(dst + i) = o4; *(LAS f32x4*)(cl + 16 * tid + i) = o4; }
    const float smax = 8.0f * wave_max(fabsf(gq[lane])) * wave_max(fabsf(gk[lane]));
    __syncthreads();
    if (tid < 256) { const float cq = cl[32 * tid]; const float lim = -(30.0f + 2.0f * smax);
        int lo = 0, hi = tid;
        while (lo < hi) { const int mid = (lo + hi) >> 1; if (cq - cl[32 * mid + 31] >= lim) hi = mid; else lo = mid + 1; }
        T0[bh * 256 + tid] = lo; }
    __syncthreads();
}
constexpr int D2_LST = RING_BYTES + 1024;
constexpr int D2_CNT = RING_BYTES + 3072;
constexpr int D2_CL = RING_BYTES + 4096;
typedef float f32x4d __attribute__((ext_vector_type(4)));
__device__ __forceinline__ unsigned sortable_u32(float f) { const unsigned u = __float_as_uint(f); return u ^ ((u >> 31) ? 0xFFFFFFFFu : 0x80000000u); }
__device__ __forceinline__ int lane_rank(unsigned long long mask) { return (int)__builtin_amdgcn_mbcnt_hi((unsigned)(mask >> 32), __builtin_amdgcn_mbcnt_lo((unsigned)mask, 0u)); }
__device__ __forceinline__ int bcount(bool p) { return (int)__popcll(__ballot(p)); }
__device__ __forceinline__ void select_full(const LAS unsigned* my, int npad, LAS unsigned short* lst, int lane) {
    unsigned thr = 0u;
    for (int bit = 31; bit >= 0; --bit) {
        const unsigned cand = thr | (1u << bit); int cnt = 0;
        for (int i0 = 0; i0 < npad; i0 += 256) { const int idx = i0 + 4 * lane; v4u v = (v4u){0u, 0u, 0u, 0u}; if (idx < npad) v = *(const LAS v4u*)(my + idx);
            cnt += bcount(v.x >= cand) + bcount(v.y >= cand) + bcount(v.z >= cand) + bcount(v.w >= cand); }
        if (cnt >= 256) thr = cand;
    }
    int cgt = 0;
    for (int i0 = 0; i0 < npad; i0 += 256) { const int idx = i0 + 4 * lane; v4u v = (v4u){0u, 0u, 0u, 0u}; if (idx < npad) v = *(const LAS v4u*)(my + idx);
        cgt += bcount(v.x > thr) + bcount(v.y > thr) + bcount(v.z > thr) + bcount(v.w > thr); }
    const int quota = 256 - cgt; int eqseen = 0, nsel = 0;
    for (int base = 0; base < npad; base += 64) { const int idx = base + lane; unsigned u = 0u; if (idx < npad) u = my[idx];
        const bool gt = u > thr, eq = (u == thr);
        const unsigned long long em = __ballot(eq); const int er = eqseen + lane_rank(em);
        const bool sel = gt || (eq && er < quota);
        const unsigned long long sm = __ballot(sel); const int pos = nsel + lane_rank(sm);
        if (sel && pos < 256) lst[pos] = (unsigned short)idx;
        nsel += __popcll(sm); eqseen += __popcll(em); }
}
template <int KMAX> __device__ __forceinline__ void select_cands(const unsigned (&uu)[16], const unsigned (&id)[16], LAS unsigned short* lst, int lane, unsigned lb = 0u) {
    unsigned thr = 0u;
    for (int bit = 31; bit >= 0; --bit) {
        if ((((thr ^ lb) >> bit) >> 1) == 0u && ((lb >> bit) & 1u)) { thr |= (1u << bit); continue; }
        const unsigned cand = thr | (1u << bit); int cnt = 0;
#pragma unroll
        for (int k = 0; k < KMAX; ++k) cnt += bcount(uu[k] >= cand);
        if (cnt >= 256) { thr = cand; if (cnt == 256) break; }
    }
    int cgt = 0, ceq = 0;
#pragma unroll
    for (int k = 0; k < KMAX; ++k) { cgt += bcount(uu[k] > thr); ceq += bcount(uu[k] == thr); }
    const int quota = 256 - cgt; unsigned ilim = 0xFFFFu;
    if (ceq != quota) {
        unsigned I = 0u;
        for (int bit = 12; bit >= 0; --bit) { const unsigned cand = I | (1u << bit); int cnt = 0;
#pragma unroll
            for (int k = 0; k < KMAX; ++k) cnt += bcount(uu[k] == thr && id[k] < cand);
            if (cnt < quota) I = cand; }
        ilim = I;
    }
    int nsel = 0;
#pragma unroll
    for (int k = 0; k < KMAX; ++k) { const bool sel = (uu[k] > thr) || (uu[k] == thr && id[k] <= ilim);
        const unsigned long long sm = __ballot(sel); const int pos = nsel + lane_rank(sm);
        if (sel && pos < 256) lst[pos] = (unsigned short)id[k];
        nsel += __popcll(sm); }
}
__device__ __forceinline__ void dsa2_unit(int b, int qg, const bf16* IQ, const bf16* IK, const float* IW, const bf16* DQ, const bf16* DK, const bf16* DV, bf16* OB, LAS unsigned char* lds, int wave, int lane) {
    LAS unsigned* sc = (LAS unsigned*)lds;
    LAS unsigned short* LST = (LAS unsigned short*)(lds + D2_LST);
    LAS int* CNT = (LAS int*)(lds + D2_CNT);
    LAS unsigned short* CL = (LAS unsigned short*)(lds + D2_CL);
    const int q0 = 4 * qg, r32 = lane & 31, hi = lane >> 5; const size_t rowbase = (size_t)b * SEQ;
    const int ntile = (q0 + 3) / 32 + 1, npad = ntile * 32;
#ifndef REP_A
#define REP_A 1
#define REP_B1 1
#define REP_B2 1
#define REP_C 1
#endif
    for (int repa = 0; repa < REP_A; ++repa)
    {
        const int qi = 2 * ((r32 >> 2) & 1) + (r32 >> 4), hd = 4 * ((r32 >> 3) & 1) + (r32 & 3);
        bf16x8 aq[4];
#pragma unroll
        for (int ks = 0; ks < 4; ++ks) aq[ks] = *(const bf16x8*)(IQ + (rowbase + q0 + qi) * 512 + hd * 64 + ks * 16 + hi * 8);
        const float* w0p = IW + (rowbase + q0 + 2 * hi) * 8;
        const f32x4 w0a = *(const f32x4*)(w0p), w0b = *(const f32x4*)(w0p + 4), w1a = *(const f32x4*)(w0p + 8), w1b = *(const f32x4*)(w0p + 12);
        for (int t = wave; t < ntile; t += 32) {
            bf16x8 bk[4][4];
#pragma unroll
            for (int u = 0; u < 4; ++u) { const int tt = t + 8 * u; const bf16* kr = IK + (rowbase + 32 * (tt < ntile ? tt : t)) * 64 + lane * 8;
#pragma unroll
                for (int ks = 0; ks < 4; ++ks) bk[u][ks] = *(const bf16x8*)(kr + ks * 512); }
#pragma unroll
            for (int u = 0; u < 4; ++u) { const int tt = t + 8 * u;
                if (tt < ntile) {
                    const int key = 32 * tt + r32;
                    f32x16 a;
#pragma unroll
                    for (int r = 0; r < 16; ++r) a[r] = 0.f;
#pragma unroll
                    for (int ks = 0; ks < 4; ++ks) a = __builtin_amdgcn_mfma_f32_32x32x16_bf16(aq[ks], bk[u][ks], a, 0, 0, 0);
                    float s0 = 0.f, s1 = 0.f;
#pragma unroll
                    for (int j = 0; j < 4; ++j) { s0 += w0a[j] * fmaxf(a[j], 0.f); s1 += w1a[j] * fmaxf(a[8 + j], 0.f); }
#pragma unroll
                    for (int j = 0; j < 4; ++j) { s0 += w0b[j] * fmaxf(a[4 + j], 0.f); s1 += w1b[j] * fmaxf(a[12 + j], 0.f); }
                    sc[(2 * hi) * 8192 + key] = (key <= q0 + 2 * hi) ? sortable_u32(s0) : 0u;
                    sc[(2 * hi + 1) * 8192 + key] = (key <= q0 + 2 * hi + 1) ? sortable_u32(s1) : 0u;
                } }
        }
    }
    __syncthreads();
    const int qi = wave & 3, hf = wave >> 2, q = q0 + qi, n = q + 1;
    const LAS unsigned* my = sc + qi * 8192;
    for (int repb = 0; repb < REP_B1; ++repb)
    {
        int c = 0; bool ovf = false;
        if (n > 256) {
            unsigned pivot = 1u;
            if (n > 640) {
                unsigned s[8];
#pragma unroll
                for (int k = 0; k < 8; ++k) s[k] = my[(int)(((unsigned)(lane * 8 + k) * (unsigned)n) >> 9)];
                const int r = (256 * 512 * 7 / 4) / n + 8;
                unsigned t16 = 0u;
                for (int bit = 15; bit >= 0; --bit) { const unsigned cand = (t16 | (1u << bit)) << 16; int cnt = 0;
#pragma unroll
                    for (int k = 0; k < 8; ++k) cnt += bcount(s[k] >= cand);
                    if (cnt >= r) t16 |= (1u << bit); }
                pivot = t16 << 16; if (pivot == 0u) pivot = 1u;
            }
            const int half = ((npad + 511) >> 9) << 8; const int lo = hf * half; const int hiend = (lo + half < npad) ? lo + half : npad;
            LAS unsigned short* cl = CL + wave * 1024;
            for (int i0 = lo; i0 < hiend; i0 += 256) { const int idx = i0 + 4 * lane; v4u v = (v4u){0u, 0u, 0u, 0u}; if (idx < hiend) v = *(const LAS v4u*)(my + idx);
#pragma unroll
                for (int e = 0; e < 4; ++e) { const bool f = v[e] >= pivot; const unsigned long long m = __ballot(f); const int pos = c + lane_rank(m);
                    if (f) { if (pos < 1024) cl[pos] = (unsigned short)(idx + e); }
                    c += __popcll(m); } }
            if (c > 1024) ovf = true;
        }
        if (lane == 0) CNT[wave] = ovf ? -1 : c;
    }
    __syncthreads();
    for (int repb2 = 0; repb2 < REP_B2; ++repb2)
    if (wave < 4) {
        LAS unsigned short* lst = LST + wave * 256; int nsel;
        if (n <= 256) { for (int i = lane; i < n; i += 64) lst[i] = (unsigned short)i; nsel = n; }
        else {
            const int c0 = CNT[wave], c1 = CNT[wave + 4]; const int c = c0 + c1;
            if (c0 < 0 || c1 < 0 || c < 256 || c > 1024) select_full(my, npad, lst, lane);
            else {
                unsigned uu[16], id[16];
#pragma unroll
                for (int k = 0; k < 16; ++k) { const int j = k * 64 + lane; unsigned ix = 0u, u = 0u;
                    if (j < c) { ix = (j < c0) ? (unsigned)CL[wave * 1024 + j] : (unsigned)CL[(wave + 4) * 1024 + (j - c0)]; u = my[ix]; }
                    uu[k] = u; id[k] = ix; }
                if (c <= 512) select_cands<8>(uu, id, lst, lane); else select_cands<16>(uu, id, lst, lane);
            }
            nsel = 256;
        }
        if (lane == 0) CNT[8 + wave] = nsel;
    }
    __syncthreads();
    for (int repc = 0; repc < REP_C; ++repc)
    {
        const int nsel = CNT[8 + qi]; const int j0 = 128 * hf; int cntk = nsel - j0; cntk = cntk < 0 ? 0 : (cntk > 128 ? 128 : cntk);
        const LAS unsigned short* lst = LST + qi * 256;
        LAS unsigned char* tile = lds + wave * 16384;
        LAS float* tf = (LAS float*)tile;
        const int l15 = lane & 15, kq = lane >> 4;
        if (cntk == 0) {
#pragma unroll
            for (int i = 0; i < 8; ++i) tf[i * 64 + lane] = 0.f;
            if (lane < 8) { tf[512 + lane] = -INFINITY; tf[520 + lane] = 0.f; }
        } else {
#pragma unroll
            for (int it = 0; it < 16; ++it) { const int r = 8 * it + (lane >> 3), ch = lane & 7; int j = j0 + r; j = j < nsel ? j : nsel - 1;
                const int idxv = (int)lst[j]; const v4u v = *(const v4u*)(DV + (rowbase + idxv) * 64 + 8 * ch);
                *(LAS v4u*)(tile + r * 128 + ch * 16) = v; }
            bf16x8 qf[2];
#pragma unroll
            for (int ks = 0; ks < 2; ++ks) { v4u z = (v4u){0u, 0u, 0u, 0u}; if (l15 < 8) z = *(const v4u*)(DQ + (rowbase + q) * 512 + l15 * 64 + 32 * ks + 8 * kq); qf[ks] = __builtin_bit_cast(bf16x8, z); }
            f32x4d acc[8];
#pragma unroll
            for (int g = 0; g < 8; ++g) { int j = j0 + 16 * g + l15; j = j < nsel ? j : nsel - 1; const int idxk = (int)lst[j];
                const bf16* kp = DK + (rowbase + idxk) * 64 + 8 * kq;
                const bf16x8 k0 = *(const bf16x8*)(kp), k1 = *(const bf16x8*)(kp + 32);
                f32x4d a = (f32x4d){0.f, 0.f, 0.f, 0.f};
                a = __builtin_amdgcn_mfma_f32_16x16x32_bf16(k0, qf[0], a, 0, 0, 0); a = __builtin_amdgcn_mfma_f32_16x16x32_bf16(k1, qf[1], a, 0, 0, 0); acc[g] = a; }
            float mx = -INFINITY;
#pragma unroll
            for (int g = 0; g < 8; ++g)
#pragma unroll
                for (int e = 0; e < 4; ++e) { if (16 * g + 4 * kq + e >= cntk) acc[g][e] = -INFINITY; mx = fmaxf(mx, acc[g][e]); }
            mx = pg8::x16_max(mx); mx = pg8::x32_max(mx);
            float ls = 0.f;
#pragma unroll
            for (int g = 0; g < 8; ++g)
#pragma unroll
                for (int e = 0; e < 4; ++e) { acc[g][e] = __builtin_amdgcn_exp2f(acc[g][e] - mx); ls += acc[g][e]; }
            ls = pg8::x16_sum(ls); ls = pg8::x32_sum(ls);
            bf16x8 pa[4];
#pragma unroll
            for (int t = 0; t < 4; ++t) { v4u w; w.x = cvtpk(acc[2 * t][0], acc[2 * t][1]); w.y = cvtpk(acc[2 * t][2], acc[2 * t][3]); w.z = cvtpk(acc[2 * t + 1][0], acc[2 * t + 1][1]); w.w = cvtpk(acc[2 * t + 1][2], acc[2 * t + 1][3]); pa[t] = __builtin_bit_cast(bf16x8, w); }
            f32x4d o[4];
            const int q_ = l15 >> 2, p_ = lane & 3;
#pragma unroll
            for (int cb = 0; cb < 4; ++cb) { f32x4d oc = (f32x4d){0.f, 0.f, 0.f, 0.f};
#pragma unroll
                for (int t = 0; t < 4; ++t) {
                    const LAS unsigned char* a1 = tile + (32 * t + 4 * kq + q_) * 128 + (16 * cb + 4 * p_) * 2;
                    const v4i16_t lo4 = __builtin_amdgcn_ds_read_tr16_b64_v4i16((LAS v4i16_t*)a1), hi4 = __builtin_amdgcn_ds_read_tr16_b64_v4i16((LAS v4i16_t*)(a1 + 16 * 128));
                    const bf16x8 vf = (bf16x8){lo4[0], lo4[1], lo4[2], lo4[3], hi4[0], hi4[1], hi4[2], hi4[3]};
                    oc = __builtin_amdgcn_mfma_f32_16x16x32_bf16(pa[t], vf, oc, 0, 0, 0); }
                o[cb] = oc; }
            if (kq < 2) {
#pragma unroll
                for (int cb = 0; cb < 4; ++cb)
#pragma unroll
                    for (int e = 0; e < 4; ++e) tf[(4 * kq + e) * 64 + 16 * cb + l15] = o[cb][e];
            }
            if (lane < 8) { tf[512 + lane] = mx; tf[520 + lane] = ls; }
        }
    }
    __syncthreads();
    if (wave < 4) {
        const LAS float* ta = (const LAS float*)(lds + wave * 16384); const LAS float* tb = (const LAS float*)(lds + (wave + 4) * 16384);
        const int h = lane >> 3, d0 = (lane & 7) * 8;
        const float ma = ta[512 + h], mb = tb[512 + h], la = ta[520 + h], lb = tb[520 + h];
        const float m = fmaxf(ma, mb), fa = __builtin_amdgcn_exp2f(ma - m), fb = __builtin_amdgcn_exp2f(mb - m);
        const float inv = 1.0f / (la * fa + lb * fb);
        const f32x4 a0 = *(const LAS f32x4*)(ta + h * 64 + d0), a1 = *(const LAS f32x4*)(ta + h * 64 + d0 + 4), b0 = *(const LAS f32x4*)(tb + h * 64 + d0), b1 = *(const LAS f32x4*)(tb + h * 64 + d0 + 4);
        const f32x4 r0 = (a0 * fa + b0 * fb) * inv, r1 = (a1 * fa + b1 * fb) * inv;
        v4u w; w.x = cvtpk(r0[0], r0[1]); w.y = cvtpk(r0[2], r0[3]); w.z = cvtpk(r1[0], r1[1]); w.w = cvtpk(r1[2], r1[3]);
        *(v4u*)(OB + (rowbase + q) * 512 + h * 64 + d0) = w;
    }
    __syncthreads();
}
constexpr int D3_RING = RING_BYTES + 1024;
constexpr int D3_LST = D3_RING + 16384;
constexpr int D3_CNT = D3_LST + 8192;
constexpr int D3_QW = D3_CNT + 512;
typedef unsigned long long u64d;
typedef unsigned u32x2q __attribute__((ext_vector_type(2)));
template <int KMAX> __device__ __forceinline__ void select_cands3(const unsigned (&uu)[16], const unsigned (&id)[16], LAS unsigned short* lst, int lane) { select_cands<KMAX>(uu, id, lst, lane); }
__device__ __forceinline__ void dsa3_unit(int b, int g16, const bf16* IQ, const bf16* IK, const float* IW, const bf16* DQ, const bf16* DK, const bf16* DV, bf16* OB, LAS unsigned char* lds, int wave, int lane_in) {
    int lane = lane_in; asm volatile("" : "+v"(lane));
    LAS u64d* LISTS = (LAS u64d*)lds;
    LAS unsigned short* LST = (LAS unsigned short*)(lds + D3_LST);
    LAS int* CNT = (LAS int*)(lds + D3_CNT);
    const int tid = wave * 64 + lane, r32 = lane & 31, hi = lane >> 5; const size_t rowbase = (size_t)b * SEQ;
    const int q0 = 16 * g16, ntile = (q0 + 15) / 32 + 1, nstep = (ntile + 1) >> 1;
    const int qgrp = wave & 3, par = wave >> 2;
    const int qA = q0 + 4 * qgrp + 2 * hi, qB = qA + 1;
    const int qi = 2 * ((r32 >> 2) & 1) + (r32 >> 4), hd = 4 * ((r32 >> 3) & 1) + (r32 & 3);
    bf16x8 aq[4];
#pragma unroll
    for (int ks = 0; ks < 4; ++ks) aq[ks] = *(const bf16x8*)(IQ + (rowbase + q0 + 4 * qgrp + qi) * 512 + hd * 64 + ks * 16 + hi * 8);
    const float* w0p = IW + (rowbase + qA) * 8;
    const f32x4 w0a = *(const f32x4*)(w0p), w0b = *(const f32x4*)(w0p + 4), w1a = *(const f32x4*)(w0p + 8), w1b = *(const f32x4*)(w0p + 12);
    f32x4 l0a, l0b, l1a, l1b;
#pragma unroll
    for (int j = 0; j < 4; ++j) { l0a[j] = w0a[j] >= 0.f ? INFINITY : -INFINITY; l0b[j] = w0b[j] >= 0.f ? INFINITY : -INFINITY; l1a[j] = w1a[j] >= 0.f ? INFINITY : -INFINITY; l1b[j] = w1b[j] >= 0.f ? INFINITY : -INFINITY; }
#define D3_SCORE(BK, S0, S1) do { f32x16 a_; _Pragma("unroll") for (int r = 0; r < 16; ++r) a_[r] = 0.f; \
        _Pragma("unroll") for (int ks = 0; ks < 4; ++ks) a_ = __builtin_amdgcn_mfma_f32_32x32x16_bf16(aq[ks], BK[ks], a_, 0, 0, 0); \
        S0 = 0.f; S1 = 0.f; \
        _Pragma("unroll") for (int j = 0; j < 4; ++j) { S0 += __builtin_amdgcn_fmed3f(w0a[j] * a_[j], 0.f, l0a[j]); S1 += __builtin_amdgcn_fmed3f(w1a[j] * a_[8 + j], 0.f, l1a[j]); } \
        _Pragma("unroll") for (int j = 0; j < 4; ++j) { S0 += __builtin_amdgcn_fmed3f(w0b[j] * a_[4 + j], 0.f, l0b[j]); S1 += __builtin_amdgcn_fmed3f(w1b[j] * a_[12 + j], 0.f, l1b[j]); } } while (0)
#ifndef REP_S
#define REP_S 1
#define REP_M 1
#define REP_B 1
#define REP_CD 1
#endif
    unsigned pivA = 1u, pivB = 1u;
    if (ntile <= 16 && tid < 16) CNT[64 + tid] = 0;
    for (int reps = 0; reps < REP_S; ++reps)
    if (ntile > 16) {
#pragma unroll
        for (int k = 0; k < 4; ++k) { const int c = tid + 512 * k; const int ts = ((c >> 8) * ntile) >> 3;
            *(LAS v4u*)(lds + c * 16) = *(const v4u*)(IK + (rowbase + 32 * ts) * 64 + (c & 255) * 8); }
        __syncthreads();
        unsigned uA[8], uB[8];
#pragma unroll
        for (int i = 0; i < 8; ++i) { bf16x8 bk[4];
#pragma unroll
            for (int ks = 0; ks < 4; ++ks) bk[ks] = *(const LAS bf16x8*)(lds + i * 4096 + ks * 1024 + lane * 16);
            float s0, s1; D3_SCORE(bk, s0, s1); uA[i] = sortable_u32(s0); uB[i] = sortable_u32(s1); asm volatile("" ::: "memory"); }
        const int qs = q0 + 4 * qgrp + par;
        const int r0 = (256 * 256 * 7 / 4) / (qs + 1) + 6, r1 = (256 * 256 * 7 / 4) / (qs + 3) + 6;
        unsigned us[8];
#pragma unroll
        for (int i = 0; i < 8; ++i) us[i] = par ? uB[i] : uA[i];
        unsigned t0 = 0u, t1 = 0u;
        for (int bit = 15; bit >= 0; --bit) {
            const unsigned c = ((hi ? t1 : t0) | (1u << bit)) << 16; int n0 = 0, n1 = 0;
#pragma unroll
            for (int i = 0; i < 8; ++i) { const unsigned long long m = __builtin_amdgcn_ballot_w64(us[i] >= c); n0 += __popc((unsigned)m); n1 += __popc((unsigned)(m >> 32)); }
            if (n0 >= r0) t0 |= (1u << bit);
            if (n1 >= r1) t1 |= (1u << bit);
        }
        LAS unsigned* PV = (LAS unsigned*)(CNT + 64);
        if (lane == 0) { PV[4 * qgrp + par] = t0; PV[4 * qgrp + 2 + par] = t1; }
        __syncthreads();
        const unsigned tA = PV[4 * qgrp + 2 * hi], tB = PV[4 * qgrp + 2 * hi + 1];
        pivA = tA << 16; pivB = tB << 16; if (pivA == 0u) pivA = 1u; if (pivB == 0u) pivB = 1u;
        __syncthreads();
    }
    for (int repm = 0; repm < REP_M; ++repm)
    {
        const bf16* src0 = IK + rowbase * 64 + (size_t)(tid & 255) * 8;
#define D3_LOAD(k_) (*(const v4u*)(src0 + (size_t)2048 * ((2 * (k_) + par) < ntile ? (2 * (k_) + par) : ntile - 1)))
        v4u st0 = (v4u){0u, 0u, 0u, 0u}, st1 = st0, st2 = st0, st3 = st0;
        st0 = D3_LOAD(0); st1 = D3_LOAD(1); st2 = D3_LOAD(2); st3 = D3_LOAD(3);
        *(LAS v4u*)(lds + D3_RING + tid * 16) = st0;
        __syncthreads();
        int cntA = 0, cntB = 0;
        LAS u64d* lA = LISTS + ((4 * qgrp + 2 * hi) * 2 + par) * 512; LAS u64d* lB = lA + 1024;
        LAS u64d* dmy = (LAS u64d*)(lds + D3_QW + 64) + lane;
        const unsigned pAl = (32 * (ntile - 1) + r32 <= qA) ? pivA : 0xFFFFFFFFu, pBl = (32 * (ntile - 1) + r32 <= qB) ? pivB : 0xFFFFFFFFu;
        f32x16 acc;
#pragma unroll
        for (int r = 0; r < 16; ++r) acc[r] = 0.f;
#define D3_SUMS(S0, S1) do { S0 = 0.f; S1 = 0.f; \
            _Pragma("unroll") for (int j = 0; j < 4; ++j) { S0 += __builtin_amdgcn_fmed3f(w0a[j] * acc[j], 0.f, l0a[j]); S1 += __builtin_amdgcn_fmed3f(w1a[j] * acc[8 + j], 0.f, l1a[j]); } \
            _Pragma("unroll") for (int j = 0; j < 4; ++j) { S0 += __builtin_amdgcn_fmed3f(w0b[j] * acc[4 + j], 0.f, l0b[j]); S1 += __builtin_amdgcn_fmed3f(w1b[j] * acc[12 + j], 0.f, l1b[j]); } } while (0)
#define D3_FILTER(TP, S0, S1) do { const int key = 32 * (TP) + r32; const unsigned u0 = sortable_u32(S0), u1 = sortable_u32(S1);     \
                const bool lastt_ = (TP) == ntile - 1;     \
                const unsigned pa_ = lastt_ ? pAl : pivA, pb_ = lastt_ ? pBl : pivB; \
                const bool psa = u0 >= pa_, psb = u1 >= pb_; \
                const unsigned long long ma = __builtin_amdgcn_ballot_w64(psa), mb = __builtin_amdgcn_ballot_w64(psb); const unsigned mla = (unsigned)ma, mha = (unsigned)(ma >> 32), mlb = (unsigned)mb, mhb = (unsigned)(mb >> 32); \
                const int posa = cntA + (int)__builtin_amdgcn_mbcnt_hi(mha, __builtin_amdgcn_mbcnt_lo(mla, 0u)) - (hi ? __popc(mla) : 0); \
                const int posb = cntB + (int)__builtin_amdgcn_mbcnt_hi(mhb, __builtin_amdgcn_mbcnt_lo(mlb, 0u)) - (hi ? __popc(mlb) : 0); \
                LAS u64d* wa_ = (psa && posa < 512) ? lA + posa : dmy; LAS u64d* wb_ = (psb && posb < 512) ? lB + posb : dmy; \
                *(LAS u32x2q*)wa_ = (u32x2q){u0, (unsigned)key}; *(LAS u32x2q*)wb_ = (u32x2q){u1, (unsigned)key}; \
                cntA += hi ? __popc(mha) : __popc(mla); cntB += hi ? __popc(mhb) : __popc(mlb); } while (0)
#define D3_STEP(k_, STNEXT, STFREE) do { \
            STFREE = D3_LOAD((k_) + 4); \
            const int tp_ = 2 * (k_) - 2 + par; \
            const LAS unsigned char* sb = lds + D3_RING + ((k_) & 1) * 8192 + par * 4096; bf16x8 bk[4]; \
            _Pragma("unroll") for (int ks = 0; ks < 4; ++ks) bk[ks] = *(const LAS bf16x8*)(sb + ks * 1024 + lane * 16); \
            __builtin_amdgcn_sched_barrier(0); \
            float s0, s1; D3_SUMS(s0, s1); asm volatile("" : "+v"(s0), "+v"(s1));     \
            __builtin_amdgcn_sched_barrier(0); \
            _Pragma("unroll") for (int r = 0; r < 16; ++r) acc[r] = 0.f; \
            _Pragma("unroll") for (int ks = 0; ks < 4; ++ks) acc = __builtin_amdgcn_mfma_f32_32x32x16_bf16(aq[ks], bk[ks], acc, 0, 0, 0); \
            __builtin_amdgcn_sched_barrier(0); \
            if (tp_ >= 0 && tp_ < ntile) D3_FILTER(tp_, s0, s1); \
            *(LAS v4u*)(lds + D3_RING + (((k_) + 1) & 1) * 8192 + tid * 16) = STNEXT; \
            asm volatile("s_waitcnt lgkmcnt(0)" ::: "memory"); __builtin_amdgcn_s_barrier(); asm volatile("" ::: "memory"); } while (0)
        int kend = 0;
        for (int k = 0; k < nstep; k += 4) {
            D3_STEP(k, st1, st0); D3_STEP(k + 1, st2, st1); D3_STEP(k + 2, st3, st2); D3_STEP(k + 3, st0, st3); kend = k + 4;
        }
        {   const int tp_ = 2 * kend - 2 + par; if (tp_ < ntile) { float s0, s1; D3_SUMS(s0, s1); D3_FILTER(tp_, s0, s1); } }
#undef D3_SUMS
#undef D3_FILTER
#undef D3_STEP
#undef D3_LOAD
        if (r32 == 0) { CNT[(4 * qgrp + 2 * hi) * 2 + par] = cntA; CNT[(4 * qgrp + 2 * hi + 1) * 2 + par] = cntB; }
        if (tid < 4) CNT[48 + tid] = 0;
    }
#undef D3_SCORE
    __syncthreads();
#if defined(DBG_D3_STAGE) && DBG_D3_STAGE == 1
    for (int grp = 0; grp < 4; ++grp) dsa2_unit(b, 4 * g16 + grp, IQ, IK, IW, DQ, DK, DV, OB, lds, wave, lane);
    return;
#endif
    {
        unsigned uu[2][16], id[2][16]; int cc[2] = {0, 0}, nselq[2] = {0, 0}; bool reg_[2] = {false, false}; unsigned lbq[2] = {0u, 0u};
#pragma unroll
        for (int rr = 0; rr < 2; ++rr) {
            const int qx = wave + 8 * rr, q = q0 + qx, n = q + 1; int nsel = 256;
            if (n <= 256) nsel = n;
            else {
                const int c0 = CNT[2 * qx], c1 = CNT[2 * qx + 1]; const int c = c0 + c1;
#ifdef DBG_D3_ALLFAIL
                if (true) { if (lane == 0) CNT[48 + (qx >> 2)] = 1; nsel = 0; }
#else
                if (c0 > 512 || c1 > 512 || c < 256) { if (lane == 0) CNT[48 + (qx >> 2)] = 1; nsel = 0; }
#endif
                else {
                    const LAS u64d* L0 = LISTS + (qx * 2) * 512; const LAS u64d* L1 = L0 + 512;
#pragma unroll
                    for (int k = 0; k < 16; ++k) { const int j = k * 64 + lane, jj = j < c ? j : c - 1;
                        const u64d e = *((jj < c0) ? (L0 + jj) : (L1 + (jj - c0))); uu[rr][k] = j < c ? (unsigned)e : 0u; id[rr][k] = (unsigned)(e >> 32); }
                    lbq[rr] = (unsigned)CNT[64 + qx] << 16; cc[rr] = c; reg_[rr] = true;
                }
            }
            nselq[rr] = nsel;
        }
        asm volatile("s_waitcnt lgkmcnt(0)" ::: "memory");
        LAS unsigned char* tileA = lds + wave * 8192; LAS unsigned char* tileB = lds + (wave + 8) * 8192;
        LAS float* tf = (LAS float*)tileA;
        const int l15 = lane & 15, kq = lane >> 4, q_ = l15 >> 2, p_ = lane & 3;
#pragma unroll
        for (int rr = 0; rr < 2; ++rr) {
            const int qx = wave + 8 * rr, q = q0 + qx, n = q + 1; LAS unsigned short* lst = LST + qx * 256; const int nsel = nselq[rr];
            if (n <= 256) { for (int i = lane; i < n; i += 64) lst[i] = (unsigned short)i; }
            else if (reg_[rr]) { const int c = cc[rr]; const unsigned lb = lbq[rr];
                if (c <= 512) select_cands<8>(uu[rr], id[rr], lst, lane, lb); else if (c <= 640) select_cands<10>(uu[rr], id[rr], lst, lane, lb); else if (c <= 768) select_cands<12>(uu[rr], id[rr], lst, lane, lb); else select_cands<16>(uu[rr], id[rr], lst, lane, lb); }
            bf16x8 qf[2];
#pragma unroll
            for (int ks = 0; ks < 2; ++ks) { v4u z = (v4u){0u, 0u, 0u, 0u}; if (l15 < 8) z = *(const v4u*)(DQ + (rowbase + q) * 512 + l15 * 64 + 32 * ks + 8 * kq); qf[ks] = __builtin_bit_cast(bf16x8, z); }
            float mrun = -INFINITY, lrun = 0.f; f32x4d orun[4];
#pragma unroll
            for (int cb = 0; cb < 4; ++cb) orun[cb] = (f32x4d){0.f, 0.f, 0.f, 0.f};
#pragma unroll 1
            for (int hf = 0; hf < 2; ++hf) {
                const int j0 = 128 * hf; int cntk = nsel - j0; cntk = cntk > 128 ? 128 : cntk;
                if (cntk <= 0) break;
                int iv[16], ik[8];
#pragma unroll
                for (int it = 0; it < 16; ++it) { int j = j0 + 8 * it + (lane >> 3); j = j < nsel ? j : nsel - 1; iv[it] = (int)lst[j]; }
#pragma unroll
                for (int g = 0; g < 8; ++g) { int j = j0 + 16 * g + l15; j = j < nsel ? j : nsel - 1; ik[g] = (int)lst[j]; }
                asm volatile("s_waitcnt lgkmcnt(0)" ::: "memory");
#pragma unroll
                for (int it = 0; it < 16; ++it)
                    __builtin_amdgcn_global_load_lds((const unsigned*)(DV + (rowbase + iv[it]) * 64 + 8 * (lane & 7)), (LAS unsigned*)((it < 8 ? tileA : tileB) + (it & 7) * 1024), 16, 0, 0);
                bf16x8 kk0[8], kk1[8];
#pragma unroll
                for (int g = 0; g < 8; ++g) { const bf16* kp = DK + (rowbase + ik[g]) * 64 + 8 * kq; kk0[g] = *(const bf16x8*)(kp); kk1[g] = *(const bf16x8*)(kp + 32); }
                asm volatile("" ::: "memory");
                f32x4d acc[8];
#pragma unroll
                for (int g = 0; g < 8; ++g) { f32x4d a = (f32x4d){0.f, 0.f, 0.f, 0.f};
                    a = __builtin_amdgcn_mfma_f32_16x16x32_bf16(kk0[g], qf[0], a, 0, 0, 0); a = __builtin_amdgcn_mfma_f32_16x16x32_bf16(kk1[g], qf[1], a, 0, 0, 0); acc[g] = a; }
                float mx = -INFINITY;
#pragma unroll
                for (int g = 0; g < 8; ++g)
#pragma unroll
                    for (int e = 0; e < 4; ++e) { if (16 * g + 4 * kq + e >= cntk) acc[g][e] = -INFINITY; mx = fmaxf(mx, acc[g][e]); }
                mx = pg8::x16_max(mx); mx = pg8::x32_max(mx);
                const float mnew = fmaxf(mrun, mx), fold = __builtin_amdgcn_exp2f(mrun - mnew);
                float ls = 0.f;
#pragma unroll
                for (int g = 0; g < 8; ++g)
#pragma unroll
                    for (int e = 0; e < 4; ++e) { acc[g][e] = __builtin_amdgcn_exp2f(acc[g][e] - mnew); ls += acc[g][e]; }
                ls = pg8::x16_sum(ls); ls = pg8::x32_sum(ls);
                lrun = lrun * fold + ls; mrun = mnew;
                float fo[4];
#pragma unroll
                for (int e = 0; e < 4; ++e) fo[e] = __shfl(fold, 4 * kq + e);
                asm volatile("s_waitcnt vmcnt(0)" ::: "memory");
                bf16x8 pa[4];
#pragma unroll
                for (int t = 0; t < 4; ++t) { v4u w; w.x = cvtpk(acc[2 * t][0], acc[2 * t][1]); w.y = cvtpk(acc[2 * t][2], acc[2 * t][3]); w.z = cvtpk(acc[2 * t + 1][0], acc[2 * t + 1][1]); w.w = cvtpk(acc[2 * t + 1][2], acc[2 * t + 1][3]); pa[t] = __builtin_bit_cast(bf16x8, w); }
#pragma unroll
                for (int cb = 0; cb < 4; ++cb) { f32x4d oc = orun[cb];
#pragma unroll
                    for (int e = 0; e < 4; ++e) oc[e] *= fo[e];
#pragma unroll
                    for (int t = 0; t < 4; ++t) {
                        const LAS unsigned char* a1 = (t < 2 ? tileA : tileB) + (32 * (t & 1) + 4 * kq + q_) * 128 + (16 * cb + 4 * p_) * 2;
                        const v4i16_t lo4 = __builtin_amdgcn_ds_read_tr16_b64_v4i16((LAS v4i16_t*)a1), hi4 = __builtin_amdgcn_ds_read_tr16_b64_v4i16((LAS v4i16_t*)(a1 + 16 * 128));
                        const bf16x8 vf = (bf16x8){lo4[0], lo4[1], lo4[2], lo4[3], hi4[0], hi4[1], hi4[2], hi4[3]};
                        oc = __builtin_amdgcn_mfma_f32_16x16x32_bf16(pa[t], vf, oc, 0, 0, 0); }
                    orun[cb] = oc; }
            }
            float li[4];
#pragma unroll
            for (int e = 0; e < 4; ++e) li[e] = 1.0f / __shfl(lrun, 4 * kq + e);
            asm volatile("s_waitcnt lgkmcnt(0)" ::: "memory");
            if (kq < 2) {
#pragma unroll
                for (int cb = 0; cb < 4; ++cb)
#pragma unroll
                    for (int e = 0; e < 4; ++e) tf[(4 * kq + e) * 64 + 16 * cb + l15] = orun[cb][e] * li[e];
            }
            { const int h = lane >> 3, d0 = (lane & 7) * 8;
              const f32x4 r0 = *(const LAS f32x4*)(tf + h * 64 + d0), r1 = *(const LAS f32x4*)(tf + h * 64 + d0 + 4);
              v4u w; w.x = cvtpk(r0[0], r0[1]); w.y = cvtpk(r0[2], r0[3]); w.z = cvtpk(r1[0], r1[1]); w.w = cvtpk(r1[2], r1[3]);
              *(v4u*)(OB + (rowbase + q) * 512 + h * 64 + d0) = w; }
        }
    }
    __syncthreads();
    const int f0 = CNT[48], f1 = CNT[49], f2 = CNT[50], f3 = CNT[51];
    __syncthreads();
    const int fm = (f0 ? 1 : 0) | (f1 ? 2 : 0) | (f2 ? 4 : 0) | (f3 ? 8 : 0);
#pragma unroll 1
    for (int grp = 0; grp < 4; ++grp) if ((fm >> grp) & 1) dsa2_unit(b, 4 * g16 + grp, IQ, IK, IW, DQ, DK, DV, OB, lds, wave, lane);
}
__device__ __forceinline__ void fox_unit2(int bh, int qb, const bf16* FQ, const bf16* FK, const bf16* FV, const float* CUM, const int* T0, bf16* OA, LAS unsigned char* lds, int wave, int lane) {
    const int b = bh >> 3, h = bh & 7, r32 = lane & 31, hi = lane >> 5; const size_t rowbase = (size_t)b * SEQ; const int q0 = qb * 256 + wave * 32;
    const bf16* Qw = FQ + (rowbase + q0) * 512 + h * 64; bf16* Ow = OA + (rowbase + q0) * 512 + h * 64;
    const bf16* Kp = FK + rowbase * 512 + h * 64; const bf16* Vp = FV + rowbase * 512 + h * 64; const float* cb = CUM + (size_t)bh * SEQ;
    LAS unsigned char* wl = lds + wave * 16384;
    LAS float* bl = (LAS float*)(lds + RING_BYTES + 8192 + wave * 256);
    bf16x8 qr[4];
#pragma unroll
    for (int ks = 0; ks < 4; ++ks) qr[ks] = *(const bf16x8*)(Qw + (size_t)r32 * 512 + ks * 16 + hi * 8);
    const int tstart = T0[bh * 256 + q0 / 32], ntiles = q0 / 32 + 1, qlocal = q0 + r32;
    f32x16 o[2];
#pragma unroll
    for (int d0 = 0; d0 < 2; ++d0)
#pragma unroll
        for (int r = 0; r < 16; ++r) o[d0][r] = 0.f;
    float m = -1e30f, l = 0.f;
    const int lrow = lane >> 3, lch = lane & 7;
#define FOX_LOAD(KR, VR, BR, tt) do { _Pragma("unroll") for (int it = 0; it < 4; ++it) { const size_t ro = (size_t)(32 * (tt) + 8 * it + lrow) * 512 + lch * 8; KR[it] = *(const v4u*)(Kp + ro); VR[it] = *(const v4u*)(Vp + ro); } BR = cb[32 * (tt) + r32]; } while (0)
#define FOX_STORE(KR, VR, BR, bf) do { _Pragma("unroll") for (int it = 0; it < 4; ++it) { const int row = 8 * it + lrow; *(LAS v4u*)(wl + (bf) * 4096 + row * 128 + ((lch ^ (row & 7)) * 16)) = KR[it]; *(LAS v4u*)(wl + 8192 + (bf) * 4096 + row * 128 + lch * 16) = VR[it]; } if (lane < 32) bl[(bf) * 32 + lane] = -L2E * BR; } while (0)
    v4u krA[4], vrA[4], krB[4], vrB[4]; float brA = 0.f, brB = 0.f;
    const int kq = (lane >> 4) & 1, q_ = (lane & 15) >> 2, p_ = lane & 3;
    FOX_LOAD(krA, vrA, brA, tstart);
    if (tstart + 1 < ntiles) FOX_LOAD(krB, vrB, brB, tstart + 1);
    FOX_STORE(krA, vrA, brA, 0);
    auto compute = [&](int t, int buf) {
        const LAS unsigned char* kb = wl + buf * 4096; const LAS unsigned char* vb = wl + 8192 + buf * 4096; const LAS float* bb = bl + buf * 32;
        f32x16 p;
#pragma unroll
        for (int r = 0; r < 16; ++r) p[r] = 0.f;
#pragma unroll
        for (int ks = 0; ks < 4; ++ks) { const bf16x8 kf = *(const LAS bf16x8*)(kb + r32 * 128 + (((2 * ks + hi) ^ (r32 & 7)) * 16)); p = __builtin_amdgcn_mfma_f32_32x32x16_bf16(kf, qr[ks], p, 0, 0, 0); }
#pragma unroll
        for (int g = 0; g < 4; ++g) { const f32x4 c4 = *(const LAS f32x4*)(bb + 8 * g + 4 * hi);
#pragma unroll
            for (int jj = 0; jj < 4; ++jj) p[4 * g + jj] += c4[jj]; }
        if (t == ntiles - 1) {
#pragma unroll
            for (int r = 0; r < 16; ++r) if (32 * t + crow(r, hi) > qlocal) p[r] = -INFINITY;
        }
        float mt = p[0];
#pragma unroll
        for (int r = 1; r < 16; ++r) mt = fmaxf(mt, p[r]);
        mt = pg8::x32_max(mt);
        const float mn = fmaxf(m, mt); const float alpha = __builtin_amdgcn_exp2f(m - mn); m = mn;
        l *= alpha;
#pragma unroll
        for (int d0 = 0; d0 < 2; ++d0)
#pragma unroll
            for (int r = 0; r < 16; ++r) o[d0][r] *= alpha;
        float ls = 0.f;
#pragma unroll
        for (int r = 0; r < 16; ++r) { p[r] = __builtin_amdgcn_exp2f(p[r] - mn); ls += p[r]; }
        l += ls;
        bf16x8 pa[2];
#pragma unroll
        for (int s2 = 0; s2 < 2; ++s2) { v4u w; w.x = cvtpk(p[8 * s2 + 0], p[8 * s2 + 1]); w.y = cvtpk(p[8 * s2 + 2], p[8 * s2 + 3]); w.z = cvtpk(p[8 * s2 + 4], p[8 * s2 + 5]); w.w = cvtpk(p[8 * s2 + 6], p[8 * s2 + 7]); pa[s2] = __builtin_bit_cast(bf16x8, w); }
#pragma unroll
        for (int d0 = 0; d0 < 2; ++d0)
#pragma unroll
            for (int s2 = 0; s2 < 2; ++s2) {
                const LAS unsigned char* a1 = vb + (16 * s2 + 4 * hi + q_) * 128 + (32 * d0 + 16 * kq + 4 * p_) * 2;
                const v4i16_t lo4 = __builtin_amdgcn_ds_read_tr16_b64_v4i16((LAS v4i16_t*)a1), hi4 = __builtin_amdgcn_ds_read_tr16_b64_v4i16((LAS v4i16_t*)(a1 + 8 * 128));
                const bf16x8 vf = (bf16x8){lo4[0], lo4[1], lo4[2], lo4[3], hi4[0], hi4[1], hi4[2], hi4[3]};
                o[d0] = __builtin_amdgcn_mfma_f32_32x32x16_bf16(vf, pa[s2], o[d0], 0, 0, 0);
            }
    };
    for (int t = tstart; t < ntiles; t += 2) {
        if (t + 2 < ntiles) FOX_LOAD(krA, vrA, brA, t + 2);
        compute(t, 0);
        if (t + 1 < ntiles) {
            FOX_STORE(krB, vrB, brB, 1);
            if (t + 3 < ntiles) FOX_LOAD(krB, vrB, brB, t + 3);
            compute(t + 1, 1);
            if (t + 2 < ntiles) FOX_STORE(krA, vrA, brA, 0);
        }
    }
#undef FOX_LOAD
#undef FOX_STORE
    l = pg8::x32_sum(l);
    const float inv = 1.0f / l;
    bf16* orow = Ow + (size_t)r32 * 512;
#pragma unroll
    for (int d0 = 0; d0 < 2; ++d0)
#pragma unroll
        for (int g = 0; g < 4; ++g) { u32x2 w; w.x = cvtpk(o[d0][4 * g] * inv, o[d0][4 * g + 1] * inv); w.y = cvtpk(o[d0][4 * g + 2] * inv, o[d0][4 * g + 3] * inv);
            *(u32x2*)(orow + d0 * 32 + 8 * g + 4 * hi) = w; }
}
__device__ __forceinline__ void fox_unit4(int bh, int qb, const bf16* FQ, const bf16* FK, const bf16* FV, const float* CUM, const int* T0, const float* gq, const float* gk, bf16* OA, LAS unsigned char* lds, int wave, int lane) {
    const int b = bh >> 3, h = bh & 7, r32 = lane & 31, hi = lane >> 5; const size_t rowbase = (size_t)b * SEQ; const int q0 = qb * 256 + wave * 32;
    const bf16* Qw = FQ + (rowbase + q0) * 512 + h * 64; bf16* Ow = OA + (rowbase + q0) * 512 + h * 64;
    const bf16* Kp = FK + rowbase * 512 + h * 64; const bf16* Vp = FV + rowbase * 512 + h * 64; const float* cb = CUM + (size_t)bh * SEQ;
    LAS unsigned char* wl = lds + wave * 16384;
    LAS float* bl = (LAS float*)(lds + RING_BYTES + 8192 + wave * 256);
    bf16x8 qr[4];
#pragma unroll
    for (int ks = 0; ks < 4; ++ks) qr[ks] = *(const bf16x8*)(Qw + (size_t)r32 * 512 + ks * 16 + hi * 8);
    const int tstart = T0[bh * 256 + q0 / 32], tlast = q0 / 32, nseq = tlast - tstart + 1, qlocal = q0 + r32;
    const float stopc = (8.0f * wave_max(fabsf(gq[lane])) * wave_max(fabsf(gk[lane])) + 30.0f) * L2E;
    f32x16 o[2];
#pragma unroll
    for (int d0 = 0; d0 < 2; ++d0)
#pragma unroll
        for (int r = 0; r < 16; ++r) o[d0][r] = 0.f;
    float m = -1e30f, l = 0.f;
    const int lrow = lane >> 3, lch = lane & 7;
#define FOX_LOAD(KR, VR, BR, tt) do { _Pragma("unroll") for (int it = 0; it < 4; ++it) { const size_t ro = (size_t)(32 * (tt) + 8 * it + lrow) * 512 + lch * 8; KR[it] = *(const v4u*)(Kp + ro); VR[it] = *(const v4u*)(Vp + ro); } BR = cb[32 * (tt) + r32]; } while (0)
#define FOX_STORE(KR, VR, BR, bf) do { _Pragma("unroll") for (int it = 0; it < 4; ++it) { const int row = 8 * it + lrow; *(LAS v4u*)(wl + (bf) * 4096 + row * 128 + ((lch ^ (row & 7)) * 16)) = KR[it]; *(LAS v4u*)(wl + 8192 + (bf) * 4096 + row * 128 + lch * 16) = VR[it]; } if (lane < 32) bl[(bf) * 32 + lane] = -L2E * BR; } while (0)
    v4u krA[4], vrA[4], krB[4], vrB[4]; float brA = 0.f, brB = 0.f;
    const int kq = (lane >> 4) & 1, q_ = (lane & 15) >> 2, p_ = lane & 3;
    FOX_LOAD(krA, vrA, brA, tlast);
    if (1 < nseq) FOX_LOAD(krB, vrB, brB, tlast - 1);
    FOX_STORE(krA, vrA, brA, 0);
    auto compute = [&](int t, int buf) -> bool {
        const LAS unsigned char* kb = wl + buf * 4096; const LAS unsigned char* vb = wl + 8192 + buf * 4096; const LAS float* bb = bl + buf * 32;
        if (t != tlast) { const float bmax = bb[31]; if (__all(m > bmax + stopc)) return true; }
        f32x16 p;
#pragma unroll
        for (int r = 0; r < 16; ++r) p[r] = 0.f;
#pragma unroll
        for (int ks = 0; ks < 4; ++ks) { const bf16x8 kf = *(const LAS bf16x8*)(kb + r32 * 128 + (((2 * ks + hi) ^ (r32 & 7)) * 16)); p = __builtin_amdgcn_mfma_f32_32x32x16_bf16(kf, qr[ks], p, 0, 0, 0); }
#pragma unroll
        for (int g = 0; g < 4; ++g) { const f32x4 c4 = *(const LAS f32x4*)(bb + 8 * g + 4 * hi);
#pragma unroll
            for (int jj = 0; jj < 4; ++jj) p[4 * g + jj] += c4[jj]; }
        if (t == tlast) {
#pragma unroll
            for (int r = 0; r < 16; ++r) if (32 * t + crow(r, hi) > qlocal) p[r] = -INFINITY;
        }
        float mt = p[0];
#pragma unroll
        for (int r = 1; r < 16; ++r) mt = fmaxf(mt, p[r]);
        mt = pg8::x32_max(mt);
        if (__any(mt > m)) {
            const float mn = fmaxf(m, mt); const float alpha = __builtin_amdgcn_exp2f(m - mn); m = mn;
            l *= alpha;
#pragma unroll
            for (int d0 = 0; d0 < 2; ++d0)
#pragma unroll
                for (int r = 0; r < 16; ++r) o[d0][r] *= alpha;
        }
        const float mn = m;
        float ls = 0.f;
#pragma unroll
        for (int r = 0; r < 16; ++r) { p[r] = __builtin_amdgcn_exp2f(p[r] - mn); ls += p[r]; }
        l += ls;
        bf16x8 pa[2];
#pragma unroll
        for (int s2 = 0; s2 < 2; ++s2) { v4u w; w.x = cvtpk(p[8 * s2 + 0], p[8 * s2 + 1]); w.y = cvtpk(p[8 * s2 + 2], p[8 * s2 + 3]); w.z = cvtpk(p[8 * s2 + 4], p[8 * s2 + 5]); w.w = cvtpk(p[8 * s2 + 6], p[8 * s2 + 7]); pa[s2] = __builtin_bit_cast(bf16x8, w); }
#pragma unroll
        for (int d0 = 0; d0 < 2; ++d0)
#pragma unroll
            for (int s2 = 0; s2 < 2; ++s2) {
                const LAS unsigned char* a1 = vb + (16 * s2 + 4 * hi + q_) * 128 + (32 * d0 + 16 * kq + 4 * p_) * 2;
                const v4i16_t lo4 = __builtin_amdgcn_ds_read_tr16_b64_v4i16((LAS v4i16_t*)a1), hi4 = __builtin_amdgcn_ds_read_tr16_b64_v4i16((LAS v4i16_t*)(a1 + 8 * 128));
                const bf16x8 vf = (bf16x8){lo4[0], lo4[1], lo4[2], lo4[3], hi4[0], hi4[1], hi4[2], hi4[3]};
                o[d0] = __builtin_amdgcn_mfma_f32_32x32x16_bf16(vf, pa[s2], o[d0], 0, 0, 0);
            }
        return false;
    };
    for (int i = 0; i < nseq; i += 2) {
        if (i + 2 < nseq) FOX_LOAD(krA, vrA, brA, tlast - (i + 2));
        if (compute(tlast - i, 0)) break;
        if (i + 1 < nseq) {
            FOX_STORE(krB, vrB, brB, 1);
            if (i + 3 < nseq) FOX_LOAD(krB, vrB, brB, tlast - (i + 3));
            if (compute(tlast - (i + 1), 1)) break;
            if (i + 2 < nseq) FOX_STORE(krA, vrA, brA, 0);
        }
    }
#undef FOX_LOAD
#undef FOX_STORE
    l = pg8::x32_sum(l);
    const float inv = 1.0f / l;
    bf16* orow = Ow + (size_t)r32 * 512;
#pragma unroll
    for (int d0 = 0; d0 < 2; ++d0)
#pragma unroll
        for (int g = 0; g < 4; ++g) { u32x2 w; w.x = cvtpk(o[d0][4 * g] * inv, o[d0][4 * g + 1] * inv); w.y = cvtpk(o[d0][4 * g + 2] * inv, o[d0][4 * g + 3] * inv);
            *(u32x2*)(orow + d0 * 32 + 8 * g + 4 * hi) = w; }
}
#ifndef DBG_BRANCH_MASK
#define DBG_BRANCH_MASK 7
#endif
#ifndef DBG_NBR
#define DBG_NBR 3
#endif
#ifndef DBG_NOGATE
#define DBG_NOGATE 0
#endif
#ifndef DBG_NOBRANCH
#define DBG_NOBRANCH 0
#endif
#ifndef DBG_GATE_W
#define DBG_GATE_W WS_WGATE
#endif
#ifndef DBG_GATE_AS_BRANCH
#define DBG_GATE_AS_BRANCH 0
#endif
#ifndef REP_FOX
#define REP_FOX 1
#endif
#ifndef REP_DSA
#define REP_DSA 1
#endif
#ifndef REP_GEMM
#define REP_GEMM 1
#endif
#ifndef DBG_SUBST
#define DBG_SUBST 0
#endif
#ifndef P7SEL
#define P7SEL 3
#endif
#ifndef PHMASK
#define PHMASK 0xFFFF
#endif
struct Args { const void* in[24]; float* out; unsigned char* ws; };
#define CONVERT_GROUP(GRP, w_, nw_) do { \
    constexpr int I_GU = 16 * 176, I_D = 44 * 32, I_IN = 16 * 104, I_GT = 16 * 96, I_BR = 8 * 32, I_SQ = 16 * 32; \
    constexpr int NIT = (GRP) == 0 ? I_GU + I_SQ : (GRP) == 1 ? I_D + I_IN + I_GT + 3 * I_BR + I_SQ : I_GU + I_D; \
    LAS float* scr_ = (LAS float*)(L + RING_OFF + wave * 16384); \
    for (int it = (w_); it < NIT; it += (nw_)) { int r = it; \
        if ((GRP) == 0) { \
            if (r < I_GU) { transpose_item<true>(0, ARG_IN(4), ARG_IN(5), 1024, DFF, ARG_IN(3), WSP(bf16, WS_WGU1), scr_, r, 176, lane); continue; } r -= I_GU; \
            transpose_item<true>(1, ARG_IN(17), nullptr, 1024, 1024, ARG_IN(8), WSP(bf16, WS_WMKV), scr_, r, 32, lane); \
        } else if ((GRP) == 1) { \
            if (r < I_D) { transpose_item<false>(1, ARG_IN(6), nullptr, DFF, 1024, nullptr, WSP(bf16, WS_WD1), scr_, r, 32, lane); continue; } r -= I_D; \
            if (r < I_IN) { transpose_item<true>(2, ARG_IN(9), nullptr, 1024, DIN, ARG_IN(7), WSP(bf16, WS_WIN), scr_, r, 104, lane); continue; } r -= I_IN; \
            if (r < I_GT) { transpose_item<true>(3, ARG_IN(9), nullptr, 1024, DIN, ARG_IN(7), WSP(bf16, WS_WGATE), scr_, r, 96, lane); continue; } r -= I_GT; \
            if (r < 3 * I_BR) { const int i = r / I_BR; transpose_item<false>(1, ARG_IN(18) + (size_t)i * 512 * 1024, nullptr, 512, 1024, nullptr, WSP(bf16, WS_WBR) + (size_t)i * 1024 * 512, scr_, r % I_BR, 32, lane); continue; } r -= 3 * I_BR; \
            transpose_item<false>(1, ARG_IN(19), nullptr, 1024, 1024, nullptr, WSP(bf16, WS_WOUT), scr_, r, 32, lane); \
        } else { \
            if (r < I_GU) { transpose_item<true>(0, ARG_IN(21), ARG_IN(22), 1024, DFF, ARG_IN(20), WSP(bf16, WS_WGU2), scr_, r, 176, lane); continue; } r -= I_GU; \
            transpose_item<false>(1, ARG_IN(23), nullptr, DFF, 1024, nullptr, WSP(bf16, WS_WD2), scr_, r, 32, lane); \
        } } } while (0)
__global__ void __launch_bounds__(NWAVES * 64, 2) fwd_mega(Args args) {
    extern __shared__ __attribute__((aligned(16))) unsigned char lds[];
    LAS unsigned char* L = (LAS unsigned char*)lds;
    volatile LAS unsigned* MISC = (volatile LAS unsigned*)(L + MISC_OFF);
    const int tid = threadIdx.x, lane = tid & 63, wave = __builtin_amdgcn_readfirstlane(tid >> 6);
    const int G = gridDim.x; const int bx = blockIdx.x; const int vcu = (G % 8 == 0) ? (bx % 8) * (G / 8) + bx / 8 : bx;
    const Args* ap = (const Args*)__builtin_amdgcn_kernarg_segment_ptr();
#define ARG_IN(k) ((const float*)ap->in[k])
#define WSP(type, off) ((type*)(ap->ws + (off)))
    gu32* ctl = (gu32*)(ap->ws + WS_CTL);
    for (int u = tid; u < (LDS_BYTES - LDSCTL_OFF) / 4; u += NWAVES * 64) ((LAS unsigned*)(L + LDSCTL_OFF))[u] = 0u;
    __syncthreads();
    XcdBarrier bar = xcd_barrier_post((unsigned*)(ctl + CW_BAR), MISC + 8);
#define GRID_BAR() xcd_barrier(bar)
    if (tid == 0) (void)__hip_atomic_fetch_or((unsigned*)(ctl + CW_GRP) + 64 * (bx & 7), 1u << bar.x, __ATOMIC_RELAXED, __HIP_MEMORY_SCOPE_AGENT);
#define ROWGRP_BAR() do { if (MISC[10] == 1u) grp_barrier(bar, (unsigned*)(ctl + CW_GRP), (unsigned)(bx & 7), (unsigned)(G >> 3)); else xcd_barrier(bar); } while (0)
    const int gw = vcu * NWAVES + wave, NGW = G * NWAVES;

#if (PHMASK >> 0) & 1
    {
        LAS float* scr = (LAS float*)(L + RING_OFF + wave * 16384);
        CONVERT_GROUP(0, gw, NGW);
        for (int m0 = gw; m0 < T + 512; m0 += 4 * NGW) {
            const float* xr[4]; bf16* orw[4]; float* ro[4]; bool ok[4];
#pragma unroll
            for (int r = 0; r < 4; ++r) { const int m = m0 + r * NGW; ok[r] = m < T + 512; const int mc = ok[r] ? m : gw;
                if (mc < T) { xr[r] = ARG_IN(0) + (size_t)mc * 1024; orw[r] = WSP(bf16, WS_HB) + (size_t)mc * 1024; ro[r] = WSP(float, WS_RSTDX) + mc; }
                else { xr[r] = ARG_IN(1) + (size_t)(mc - T) * 1024; orw[r] = WSP(bf16, WS_MEMB) + (size_t)(mc - T) * 1024; ro[r] = WSP(float, WS_RSTDM) + (mc - T); } }
            rows4_to_bf16_rstd(xr, orw, ro, ok, lane);
        }
        VM_WAIT(); __syncthreads();
        GRID_BAR();
        if (tid == 0) {
            bool ok = (G % 8 == 0);
            for (int j = 0; j < 8; ++j) { const unsigned m = xb_ld((unsigned*)(ctl + CW_GRP) + 64 * j); ok = ok && (m != 0u) && ((m & (m - 1u)) == 0u); }
            MISC[10] = ok ? 1u : 2u; }
        __syncthreads();
    }
#endif
#if (PHMASK >> 1) & 1
    {
        if (bx >= G - 8) { pg8::Gemm g{WSP(bf16, WS_MEMB), WSP(bf16, WS_WMKV), 512, 1024, 1024}; pg8::StaticOrder S; S.init(512, 1024, G, bx - (G - 8));
        pg8::EpiMemKV E{WSP(float, WS_KVM), WSP(float, WS_RSTDM)};
        pg8::gemm_phase<pg8::EpiMemKV, pg8::StaticOrder, true, true>(L + RING_OFF, g, S, E); }
    }
#endif
#if (PHMASK >> 2) & 1
    {
        pg8::Gemm g{WSP(bf16, WS_HB), WSP(bf16, WS_WGU1), T, 2 * DFF, 1024}; pg8::StaticOrder S; S.init(T, 2 * DFF, G, bx);
        pg8::build_row_tab<0>(WSP(float, WS_RSTDX), S, (LAS float*)(L + RING_BYTES + 1024)); pg8::EpiSwiGLU<0> E{WSP(bf16, WS_HID), DFF, (LAS float*)(L + RING_BYTES + 1024)};
#pragma unroll 1
        for (int rep_ = 0; rep_ < REP_GEMM; ++rep_)
        pg8::gemm_phase<pg8::EpiSwiGLU<0>, pg8::StaticOrder, true, true>(L + RING_OFF, g, S, E);
        {
            const int nfull = (64 * 22) % G; const int nidle = (nfull == 0) ? G : G - nfull; const int first = G - nidle;
            const int nconv = nidle > 8 ? nidle - 8 : nidle; const bool conv = (bx >= first) && (bx - first < nconv);
            if (conv) { CONVERT_GROUP(1, (bx - first) * NWAVES + wave, nconv * NWAVES);
                for (int e = (bx - first) * NWAVES * 64 + tid; e < T * 32; e += nconv * NWAVES * 64) {
                    const int row = e >> 5, i = e & 31; const float inv_freq = powf(10000.0f, -(float)i * (1.0f / 32.0f));
                    const float ang = (float)((const int*)ap->in[2])[row] * inv_freq; float sn, cs; sincosf(ang, &sn, &cs); WSP(float, WS_COS)[e] = cs; WSP(float, WS_SIN)[e] = sn; } }
        }
        GRID_BAR();
    }
#endif
#if (PHMASK >> 3) & 1
    {
        pg8::Gemm g{WSP(bf16, WS_HID), WSP(bf16, WS_WD1), T, 1024, DFF}; pg8::StaticOrder S; S.init(T, 1024, G, bx);
        pg8::EpiResid3<1> E{nullptr, nullptr, WSP(bf16, WS_HB), WSP(float, WS_SSQ1), 0.5f};
#pragma unroll 1
        for (int rep_ = 0; rep_ < REP_GEMM; ++rep_)
        pg8::gemm_phase<pg8::EpiResid3<1>, pg8::StaticOrder, true, true>(L + RING_OFF, g, S, E);
        ROWGRP_BAR();
    }
#endif
#if (PHMASK >> 4) & 1
    {
        pg8::Gemm g{WSP(bf16, WS_HB), WSP(bf16, WS_WIN), T, NPROJ, 1024}; pg8::StaticOrder S; S.init(T, NPROJ, G, bx);
        pg8::ProjOut PO{WSP(bf16, WS_FQ), WSP(bf16, WS_FK), WSP(bf16, WS_FV), WSP(bf16, WS_DQ), WSP(bf16, WS_IQ), WSP(bf16, WS_MQ), WSP(bf16, WS_DK), WSP(bf16, WS_DV), WSP(bf16, WS_IK), WSP(float, WS_LOGF), WSP(float, WS_IW), WSP(float, WS_COS), WSP(float, WS_SIN), ARG_IN(11), ARG_IN(12), ARG_IN(13), ARG_IN(14), ARG_IN(10)};
        pg8::build_row_tab<16>(WSP(float, WS_SSQ1), S, (LAS float*)(L + RING_BYTES + 1024)); pg8::EpiProj<16> E{PO, (LAS float*)(L + RING_BYTES + 1024), C2_64};
#pragma unroll 1
        for (int rep_ = 0; rep_ < REP_GEMM; ++rep_)
        pg8::gemm_phase<pg8::EpiProj<16>, pg8::StaticOrder, true, true>(L + RING_OFF, g, S, E);
        {
            const int nfull = (64 * 13) % G; const int nidle = (nfull == 0) ? G : G - nfull; const int first = G - nidle;
            if (bx >= first) { CONVERT_GROUP(2, (bx - first) * NWAVES + wave, nidle * NWAVES);
        int lt_ = tid; asm volatile("" : "+v"(lt_)); const int lane = lt_ & 63;
        for (int it = (bx - first) * NWAVES + wave; it < 2048; it += nidle * NWAVES) { const int row = it >> 2, h = it & 3;
                    const f32x2g kv = *(const f32x2g*)(WSP(float, WS_KVM) + (size_t)row * 1024 + h * 128 + 2 * lane); const f32x2g vv = *(const f32x2g*)(WSP(float, WS_KVM) + (size_t)row * 1024 + 512 + h * 128 + 2 * lane);
                    const float ss = wave_sum(kv.x * kv.x + kv.y * kv.y); const float rstd = 1.0f / sqrtf(ss * (1.0f / 128.0f) + 1e-6f);
                    const f32x2g gk = *(const f32x2g*)(ARG_IN(16) + 2 * lane);
                    *(unsigned*)(WSP(bf16, WS_KMB) + (size_t)row * 512 + h * 128 + 2 * lane) = pk2(kv.x * rstd * gk.x, kv.y * rstd * gk.y);
                    *(unsigned*)(WSP(bf16, WS_VMB) + (size_t)row * 512 + h * 128 + 2 * lane) = pk2(vv.x, vv.y); } }
        }
        GRID_BAR();
#if defined(DBG_DUMP_AFTER) && DBG_DUMP_AFTER == 4
        {
            const bf16* sa = WSP(bf16, DBG_DUMP_A); const bf16* sb = WSP(bf16, DBG_DUMP_B);
            for (size_t e = (size_t)vcu * 512 + tid; e < (size_t)T * 512; e += (size_t)G * 512) { const size_t row = e >> 9, c = e & 511;
                ap->out[row * 1024 + c] = bf2f(sa[row * DBG_PITCH + c]); ap->out[row * 1024 + 512 + c] = bf2f(sb[row * DBG_PITCH + c]); }
            return;
        }
#endif

    }
#endif
#if ((PHMASK >> 5) & 1) && !DBG_SUBST
    {
        int lt_ = tid; asm volatile("" : "+v"(lt_)); const int lane = lt_ & 63;
    }
#endif
#if ((PHMASK >> 6) & 1) && !DBG_SUBST
    {
        int lt_ = tid; asm volatile("" : "+v"(lt_)); const int lane = lt_ & 63;
        for (int rep_ = 0; rep_ < REP_FOX; ++rep_)
        for (int v = vcu; v < 256; v += G) { const int bh = v >> 4, s = v & 15;
            scan_unit(bh, WSP(float, WS_LOGF), WSP(float, WS_CUM), WSP(int, WS_T0), ARG_IN(11), ARG_IN(12), (LAS float*)(L + SCANX_OFF), (LAS float*)(L + RING_OFF), tid);
            asm volatile("s_waitcnt vmcnt(0)" ::: "memory"); __syncthreads();
            fox_block(bh, s, WSP(bf16, WS_FQ), WSP(bf16, WS_FK), WSP(bf16, WS_FV), WSP(float, WS_CUM), WSP(int, WS_T0), ARG_IN(11), ARG_IN(12), WSP(bf16, WS_OA), L, wave, lane, tid); fox_block(bh, 31 - s, WSP(bf16, WS_FQ), WSP(bf16, WS_FK), WSP(bf16, WS_FV), WSP(float, WS_CUM), WSP(int, WS_T0), ARG_IN(11), ARG_IN(12), WSP(bf16, WS_OA), L, wave, lane, tid); }
        __syncthreads();
        {
            gu32* qctr = ctl + CW_Q; LAS int* QW = (LAS int*)(L + D3_QW);
            const int pref = (vcu >> 5) & 1;
            unsigned raw = 0u; int cur;
            if (tid == 0) { unsigned u = __hip_atomic_fetch_add(qctr + 64 * pref, 1u, RLX_AGENT); int bsel = pref; if (u >= 512u) { bsel = pref ^ 1; u = __hip_atomic_fetch_add(qctr + 64 * bsel, 1u, RLX_AGENT); } QW[0] = (u < 512u) ? ((bsel << 16) | (int)u) : -1; }
            __syncthreads(); cur = QW[0]; __syncthreads();
            while (cur >= 0) {
                if (tid == 0) raw = __hip_atomic_fetch_add(qctr + 64 * pref, 1u, RLX_AGENT);
                dsa3_unit(cur >> 16, 511 - (cur & 0xffff), WSP(bf16, WS_IQ), WSP(bf16, WS_IK), WSP(float, WS_IW), WSP(bf16, WS_DQ), WSP(bf16, WS_DK), WSP(bf16, WS_DV), WSP(bf16, WS_OB), L, wave, lane);
                if (tid == 0) { unsigned u = raw; int bsel = pref; if (u >= 512u) { bsel = pref ^ 1; u = __hip_atomic_fetch_add(qctr + 64 * bsel, 1u, RLX_AGENT); } QW[0] = (u < 512u) ? ((bsel << 16) | (int)u) : -1; }
                __syncthreads(); cur = QW[0]; __syncthreads();
            }
            for (;;) {
                if (tid == 0) QW[0] = (int)__hip_atomic_fetch_add(qctr + 128, 1u, RLX_AGENT);
                __syncthreads(); const int mu = QW[0]; __syncthreads();
                if (mu >= 256) break;
                mem_block(mu, WSP(bf16, WS_MQ), WSP(bf16, WS_KMB), WSP(bf16, WS_VMB), ARG_IN(15), L, wave, lane, tid);
            }
        }
        GRID_BAR();
    }
#endif
#if (PHMASK >> 7) & 1
    {
        pg8::StaticOrder S; S.init(T, 1024, G, bx); pg8::build_row_tab<16>(WSP(float, WS_SSQ1), S, (LAS float*)(L + RING_BYTES + 1024));
#ifndef P7STREAM
#define P7STREAM 1
#endif
#if P7STREAM
        {   typedef pg8::P7Order<WS_HB, WS_WGATE, WS_OA, WS_OB, WS_MQ, WS_WBR> P7O; P7O O{S, (const char*)WSP(char, 0)};
            pg8::EpiP7 E{WSP(bf16, WS_GSCR), WSP(bf16, WS_MERGED), (LAS float*)(L + RING_BYTES + 1024)};
#ifndef REP_P7
#define REP_P7 1
#endif
#pragma unroll 1
            for (int rep7_ = 0; rep7_ < REP_P7; ++rep7_) pg8::gemm_stream<pg8::EpiP7, P7O>(L + RING_OFF, O, E); }
#pragma unroll 1
        for (int i = 0; i < 0; ++i) {
#else
#pragma unroll 1
        for (int rep_ = 0; rep_ < REP_GEMM; ++rep_)
#pragma unroll 1
        for (int i = 0; i < DBG_NBR; ++i) {
#endif
#if DBG_GATE_AS_BRANCH
            {   pg8::Gemm g{WSP(bf16, WS_HB), WSP(bf16, DBG_GATE_W), T, 1024, 1024}; pg8::EpiBranch E{WSP(bf16, WS_GSCR), WSP(bf16, WS_MERGED), true, 1.0f}; pg8::gemm_phase<pg8::EpiBranch, pg8::StaticOrder, true, true>(L + RING_OFF, g, S, E); }
#elif !DBG_NOGATE
            {   pg8::Gemm g{WSP(bf16, WS_HB), WSP(bf16, DBG_GATE_W) + (size_t)i * 1024 * 1024, T, 1024, 1024}; pg8::EpiGate<16> E{WSP(bf16, WS_GSCR), (LAS float*)(L + RING_BYTES + 1024)}; pg8::gemm_phase<pg8::EpiGate<16>, pg8::StaticOrder, true, true>(L + RING_OFF, g, S, E); }
#endif
#if !DBG_NOBRANCH
#if DBG_SUBST == 1
            {   const bf16* A = (i == 0) ? WSP(bf16, WS_FQ) : (i == 1) ? WSP(bf16, WS_DQ) : WSP(bf16, WS_IQ);
#elif DBG_SUBST == 2
            {   const bf16* A = (i == 0) ? WSP(bf16, WS_FK) : (i == 1) ? WSP(bf16, WS_FV) : WSP(bf16, WS_MQ);
#else
            {   const bf16* A = (i == 0) ? WSP(bf16, WS_OA) : (i == 1) ? WSP(bf16, WS_OB) : WSP(bf16, WS_MQ);
#endif
                pg8::Gemm g{A, WSP(bf16, WS_WBR) + (size_t)i * 1024 * 512, T, 1024, 512}; pg8::EpiBranch E{WSP(bf16, WS_GSCR), WSP(bf16, WS_MERGED), i == 0, ((DBG_BRANCH_MASK >> i) & 1) ? 1.0f : 0.0f}; pg8::gemm_phase<pg8::EpiBranch, pg8::StaticOrder, true, true>(L + RING_OFF, g, S, E); }
#endif
        }
        ROWGRP_BAR();
#if defined(DBG_DUMP_AFTER) && DBG_DUMP_AFTER == 7
        {
            const bf16* sa = WSP(bf16, DBG_DUMP_A); const bf16* sb = WSP(bf16, DBG_DUMP_B);
            for (size_t e = (size_t)vcu * 512 + tid; e < (size_t)T * 512; e += (size_t)G * 512) { const size_t row = e >> 9, c = e & 511;
                ap->out[row * 1024 + c] = bf2f(sa[row * DBG_PITCH + c]); ap->out[row * 1024 + 512 + c] = bf2f(sb[row * DBG_PITCH + c]); }
            return;
        }
#endif

    }
#endif
#if (PHMASK >> 8) & 1
    {
        pg8::Gemm g{WSP(bf16, WS_MERGED), WSP(bf16, WS_WOUT), T, 1024, 1024}; pg8::StaticOrder S; S.init(T, 1024, G, bx);
        pg8::EpiResid3<1> E{nullptr, nullptr, WSP(bf16, WS_HB), WSP(float, WS_SSQ2), 1.0f};
        pg8::gemm_phase<pg8::EpiResid3<1>, pg8::StaticOrder, true, true>(L + RING_OFF, g, S, E);
        ROWGRP_BAR();
    }
#endif
#if (PHMASK >> 9) & 1
    {
        pg8::Gemm g{WSP(bf16, WS_HB), WSP(bf16, WS_WGU2), T, 2 * DFF, 1024}; pg8::StaticOrder S; S.init(T, 2 * DFF, G, bx);
        pg8::build_row_tab<16>(WSP(float, WS_SSQ2), S, (LAS float*)(L + RING_BYTES + 1024)); pg8::EpiSwiGLU<16> E{WSP(bf16, WS_HID), DFF, (LAS float*)(L + RING_BYTES + 1024)};
#pragma unroll 1
        for (int rep_ = 0; rep_ < REP_GEMM; ++rep_)
        pg8::gemm_phase<pg8::EpiSwiGLU<16>, pg8::StaticOrder, true, true>(L + RING_OFF, g, S, E);
        ROWGRP_BAR();
    }
#endif
#if (PHMASK >> 10) & 1
    {
        pg8::Gemm g{WSP(bf16, WS_HID), WSP(bf16, WS_WD2), T, 1024, DFF}; pg8::StaticOrder S; S.init(T, 1024, G, bx);
        pg8::EpiResid3<2> E{nullptr, ap->out, WSP(bf16, WS_HB), nullptr, 0.5f};
        pg8::gemm_phase<pg8::EpiResid3<2>, pg8::StaticOrder, true, true>(L + RING_OFF, g, S, E);
    }
#endif
}

extern "C" void kernel_launch(void* const* d_in, const int* in_sizes, int n_in, void* d_out, int out_size, void* d_ws, size_t ws_size, hipStream_t stream) {
    static int grid = 0;
    if (grid == 0) {
        if (n_in != 24 || out_size != T * DM || ws_size < WS_END) { fprintf(stderr, "kernel_launch: unexpected problem (n_in %d, out %d, ws %zu)\n", n_in, out_size, ws_size); grid = -1; return; }
        int dev = 0, cus = 0, per_cu = 0;
        if (hipGetDevice(&dev) != hipSuccess || hipDeviceGetAttribute(&cus, hipDeviceAttributeMultiprocessorCount, dev) != hipSuccess) { grid = -1; return; }
        if (hipFuncSetAttribute((const void*)fwd_mega, hipFuncAttributeMaxDynamicSharedMemorySize, LDS_BYTES) != hipSuccess) { fprintf(stderr, "kernel_launch: hipFuncSetAttribute failed\n"); grid = -1; return; }
        if (hipOccupancyMaxActiveBlocksPerMultiprocessor(&per_cu, (const void*)fwd_mega, NWAVES * 64, LDS_BYTES) != hipSuccess || per_cu < 1) { fprintf(stderr, "kernel_launch: occupancy query says %d blocks per CU\n", per_cu); (void)hipGetLastError(); grid = -1; return; }
        grid = cus;
    }
    if (grid < 0) return;
    (void)hipMemsetAsync((char*)d_ws + WS_CTL, 0, CTL_ZERO_BYTES, stream);
    Args a{};
    for (int i = 0; i < 24; ++i) a.in[i] = d_in[i];
    a.out = (float*)d_out; a.ws = (unsigned char*)d_ws;
    hipLaunchKernelGGL(fwd_mega, dim3(grid), dim3(NWAVES * 64), LDS_BYTES, stream, a);
}
```
